# Optimizing an MI355X kernel written in HIP

```python
import jax
import jax.numpy as jnp
from jax import lax
import numpy as np

D_MODEL = 1024
BATCH = 2
SEQ = 8192
DEPTH = 2

D_MIX = D_MODEL
RW_HEADS = 6
RW_HEAD_DIM = 64
RW_WIDTH = RW_HEADS * RW_HEAD_DIM
RW_DECAY_LORA = 64
RW_ICLR_LORA = 64
RW_VRES_LORA = 32
RW_SHIFT_DIM = 3 * RW_WIDTH + RW_DECAY_LORA + RW_ICLR_LORA
RW_GN_EPS = 64e-5
HG_HEADS = 6
HG_EXPAND = 64
HG_HEAD_DIM = 64
HG_KEY = HG_HEADS * HG_EXPAND
HG_WIDTH = HG_HEADS * HG_HEAD_DIM
HG_CHUNK = 64
LRU_WIDTH = D_MIX - RW_WIDTH - HG_WIDTH
LRU_BLOCKS = 4
LRU_BLOCK_DIM = LRU_WIDTH // LRU_BLOCKS
CONV_WIDTH = 4
LRU_C = 8.0
NORM_EPS = 1e-6
IN_SEGMENTS = (RW_SHIFT_DIM, RW_WIDTH,
               HG_KEY, HG_KEY, HG_WIDTH, HG_WIDTH,
               LRU_WIDTH, LRU_WIDTH)
N_IN = sum(IN_SEGMENTS)

kernel_name = "hymba_rwkv7_hgrn2_rglru_trunk"


def _rmsnorm(x, w, eps=NORM_EPS):
    xf = x.astype(jnp.float32)
    y = xf * lax.rsqrt(jnp.mean(xf * xf, axis=-1, keepdims=True) + eps)
    return y * w.astype(jnp.float32)


def _token_shift(u):
    return jnp.pad(u, ((0, 0), (1, 0), (0, 0)))[:, :-1, :]


def _rwkv7_recurrence(r, w, k, v, a_in, b_in):
    B, T, H, N = r.shape

    def step(S, inp):
        r_t, w_t, k_t, v_t, a_t, b_t = inp
        sa = jnp.einsum('bhvk,bhk->bhv', S, a_t)
        S = (S * w_t[:, :, None, :] + sa[..., None] * b_t[:, :, None, :]
             + v_t[..., None] * k_t[:, :, None, :])
        return S, jnp.einsum('bhvk,bhk->bhv', S, r_t)

    xs = (jnp.moveaxis(r, 1, 0), jnp.moveaxis(w, 1, 0), jnp.moveaxis(k, 1, 0),
          jnp.moveaxis(v, 1, 0), jnp.moveaxis(a_in, 1, 0), jnp.moveaxis(b_in, 1, 0))
    S0 = jnp.zeros((B, H, N, N), jnp.float32)
    _, ys = lax.scan(step, S0, xs)
    return jnp.moveaxis(ys, 0, 1)


def _rwkv7_mixer(u_shift, z, v_first, mu, w0, w_up, a0, a_up, k_k, k_a, r_k, ln_w, ln_b, vres):
    B, T, _ = u_shift.shape
    u = u_shift.astype(jnp.float32)
    u = u + mu * (_token_shift(u) - u)
    r, k, v, wl, al = jnp.split(
        u, [RW_WIDTH, 2 * RW_WIDTH, 3 * RW_WIDTH, 3 * RW_WIDTH + RW_DECAY_LORA], axis=-1)
    w_log = -jax.nn.softplus(-(w0 + jnp.tanh(wl) @ w_up)) - 0.5
    w = jnp.exp(-jnp.exp(w_log))
    a = jax.nn.sigmoid(a0 + al @ a_up)
    if vres is None:
        v_first = v
    else:
        v0, v_dn, v_up = vres
        v = v + (v_first - v) * jax.nn.sigmoid(v0 + (v @ v_dn) @ v_up)

    def hd(t):
        return t.reshape(B, T, RW_HEADS, RW_HEAD_DIM)

    kk = hd(k * k_k)
    kk = kk / jnp.maximum(jnp.sqrt(jnp.sum(kk * kk, axis=-1, keepdims=True)), 1e-12)
    k = k * (1.0 + (a - 1.0) * k_a)
    y = _rwkv7_recurrence(hd(r), hd(w), hd(k), hd(v), -kk, kk * hd(a))
    mean = jnp.mean(y, axis=-1, keepdims=True)
    var = jnp.mean(jnp.square(y - mean), axis=-1, keepdims=True)
    y = ((y - mean) * lax.rsqrt(var + RW_GN_EPS)).reshape(B, T, RW_WIDTH) * ln_w + ln_b
    bonus = jnp.sum(hd(r) * hd(k) * r_k, axis=-1, keepdims=True) * hd(v)
    out = (y + bonus.reshape(B, T, RW_WIDTH)) * jax.nn.silu(z.astype(jnp.float32))
    return out, v_first


def _hgrn2_mixer(q, f_raw, i, z, lb, norm_w):
    B, T, _ = q.shape
    n_chunks = T // HG_CHUNK
    f = lb + (1.0 - lb) * jax.nn.sigmoid(f_raw.astype(jnp.float32))
    g = jnp.log(f)
    k = 1.0 - f

    def to_chunks(t, d):
        return t.astype(jnp.float32).reshape(B, n_chunks, HG_CHUNK, HG_HEADS, d).transpose(1, 0, 3, 2, 4)

    causal = jnp.tril(jnp.ones((HG_CHUNK, HG_CHUNK), dtype=bool))[:, :, None]

    def chunk_step(S, inp):
        q_c, k_c, v_c, g_c = inp
        b = jnp.cumsum(g_c, axis=2)
        o_inter = jnp.einsum('bhtk,bhkv->bhtv', q_c * jnp.exp(b), S)
        diff = b[:, :, :, None, :] - b[:, :, None, :, :]
        decay = jnp.where(causal, jnp.exp(jnp.where(causal, diff, 0.0)), 0.0)
        scores = jnp.einsum('bhtk,bhsk,bhtsk->bhts', q_c, k_c, decay)
        o = o_inter + jnp.einsum('bhts,bhsv->bhtv', scores, v_c)
        b_last = b[:, :, -1:, :]
        S = (S * jnp.exp(b_last)[:, :, 0, :, None]
             + jnp.einsum('bhsk,bhsv->bhkv', k_c * jnp.exp(b_last - b), v_c))
        return S, o

    S0 = jnp.zeros((B, HG_HEADS, HG_EXPAND, HG_HEAD_DIM), jnp.float32)
    xs = (to_chunks(q, HG_EXPAND), to_chunks(k, HG_EXPAND),
          to_chunks(i, HG_HEAD_DIM), to_chunks(g, HG_EXPAND))
    _, o = lax.scan(chunk_step, S0, xs)
    o = o.transpose(1, 0, 3, 2, 4).reshape(B, T, HG_HEADS, HG_HEAD_DIM)
    o = o * lax.rsqrt(jnp.mean(o * o, axis=-1, keepdims=True) + NORM_EPS)
    return o.reshape(B, T, HG_WIDTH) * norm_w * jax.nn.silu(z.astype(jnp.float32))


def _lin_rec_combine(left, right):
    a_l, b_l = left
    a_r, b_r = right
    return a_l * a_r, a_r * b_l + b_r


def _rglru_mixer(xb, z, conv_w, conv_b, wa, ba, wx, bx, lam):
    B, T, W = xb.shape
    xf = xb.astype(jnp.float32)
    y = lax.conv_general_dilated(
        xf, conv_w.astype(jnp.float32)[:, None, :], window_strides=(1,),
        padding=((CONV_WIDTH - 1, 0),), dimension_numbers=('NWC', 'WIO', 'NWC'),
        feature_group_count=W) + conv_b
    yg = y.reshape(B, T, LRU_BLOCKS, LRU_BLOCK_DIM)
    r = jax.nn.sigmoid(jnp.einsum('btgi,gij->btgj', yg, wa).reshape(B, T, W) + ba)
    ig = jax.nn.sigmoid(jnp.einsum('btgi,gij->btgj', yg, wx).reshape(B, T, W) + bx)
    log_a = -LRU_C * r * jax.nn.softplus(-lam)
    a = jnp.exp(log_a)
    u = jnp.sqrt(-jnp.expm1(2.0 * log_a)) * (ig * y)
    _, h = lax.associative_scan(_lin_rec_combine, (a, u), axis=1)
    return h * jax.nn.silu(z.astype(jnp.float32))


def setup_inputs(seed: int = 0) -> dict:
    key = jax.random.key(seed)
    ks = jax.random.split(key, 28)
    f32 = jnp.float32
    L = DEPTH

    def nrm(k, shape, scale):
        return scale * jax.random.normal(k, shape, f32)

    a_base = jax.random.uniform(ks[24], (L, LRU_WIDTH), f32, 0.9, 0.999) ** (1.0 / LRU_C)
    return {
        "x": nrm(ks[0], (BATCH, SEQ, D_MODEL), 1.0),
        "norm_w": 1.0 + nrm(ks[1], (L, D_MODEL), 0.02),
        "w_in": nrm(ks[2], (L, D_MODEL, N_IN), D_MODEL ** -0.5),
        "rw_mu": jax.random.uniform(ks[3], (L, RW_SHIFT_DIM), f32),
        "rw_w0": jax.random.uniform(ks[4], (L, RW_WIDTH), f32, -5.0, 1.0),
        "rw_w_up": nrm(ks[5], (L, RW_DECAY_LORA, RW_WIDTH), 0.1 * RW_DECAY_LORA ** -0.5),
        "rw_a0": nrm(ks[6], (L, RW_WIDTH), 0.5),
        "rw_a_up": nrm(ks[7], (L, RW_ICLR_LORA, RW_WIDTH), 0.1 * RW_ICLR_LORA ** -0.5),
        "rw_v0": 1.0 + nrm(ks[8], (L - 1, RW_WIDTH), 0.1),
        "rw_v_dn": nrm(ks[9], (L - 1, RW_WIDTH, RW_VRES_LORA), RW_WIDTH ** -0.5),
        "rw_v_up": nrm(ks[10], (L - 1, RW_VRES_LORA, RW_WIDTH), 0.1 * RW_VRES_LORA ** -0.5),
        "rw_k_k": 0.85 + nrm(ks[11], (L, RW_WIDTH), 0.02),
        "rw_k_a": 1.0 + nrm(ks[12], (L, RW_WIDTH), 0.02),
        "rw_r_k": nrm(ks[13], (L, RW_HEADS, RW_HEAD_DIM), 0.1),
        "rw_ln_w": 1.0 + nrm(ks[14], (L, RW_WIDTH), 0.02),
        "rw_ln_b": nrm(ks[15], (L, RW_WIDTH), 0.02),
        "hg_lb_raw": nrm(ks[16], (L, HG_KEY), 1.0),
        "hg_norm_w": 1.0 + nrm(ks[17], (L, HG_WIDTH), 0.02),
        "lru_conv_w": nrm(ks[18], (L, CONV_WIDTH, LRU_WIDTH), CONV_WIDTH ** -0.5),
        "lru_conv_b": nrm(ks[19], (L, LRU_WIDTH), 0.02),
        "lru_wa": nrm(ks[20], (L, LRU_BLOCKS, LRU_BLOCK_DIM, LRU_BLOCK_DIM), LRU_BLOCK_DIM ** -0.5),
        "lru_ba": nrm(ks[21], (L, LRU_WIDTH), 0.02),
        "lru_wx": nrm(ks[22], (L, LRU_BLOCKS, LRU_BLOCK_DIM, LRU_BLOCK_DIM), LRU_BLOCK_DIM ** -0.5),
        "lru_bx": nrm(ks[23], (L, LRU_WIDTH), 0.02),
        "lru_lambda": jnp.log(a_base) - jnp.log1p(-a_base),
        "w_out": nrm(ks[25], (L, D_MIX, D_MODEL), D_MIX ** -0.5),
        "final_norm_w": 1.0 + nrm(ks[26], (D_MODEL,), 0.02),
    }


def reference(x, norm_w, w_in, rw_mu, rw_w0, rw_w_up, rw_a0, rw_a_up, rw_v0, rw_v_dn, rw_v_up,
              rw_k_k, rw_k_a, rw_r_k, rw_ln_w, rw_ln_b, hg_lb_raw, hg_norm_w,
              lru_conv_w, lru_conv_b, lru_wa, lru_ba, lru_wx, lru_bx, lru_lambda,
              w_out, final_norm_w):
    splits = np.cumsum(IN_SEGMENTS)[:-1].tolist()
    lb_w = jax.nn.softmax(hg_lb_raw.astype(jnp.float32), axis=0)
    lower_bounds = jnp.cumsum(lb_w, axis=0) - lb_w[0]
    v_first = None
    for l in range(DEPTH):
        h = _rmsnorm(x, norm_w[l]).astype(x.dtype)
        u = h @ w_in[l]
        rw_u, rw_z, hg_q, hg_f, hg_i, hg_z, lru_x, lru_z = jnp.split(u, splits, axis=-1)
        vres = None if l == 0 else (rw_v0[l - 1], rw_v_dn[l - 1], rw_v_up[l - 1])
        rw_out, v_first = _rwkv7_mixer(rw_u, rw_z, v_first, rw_mu[l], rw_w0[l], rw_w_up[l],
                                       rw_a0[l], rw_a_up[l], rw_k_k[l], rw_k_a[l], rw_r_k[l],
                                       rw_ln_w[l], rw_ln_b[l], vres)
        hg_out = _hgrn2_mixer(hg_q, hg_f, hg_i, hg_z, lower_bounds[l], hg_norm_w[l])
        lru_out = _rglru_mixer(lru_x, lru_z, lru_conv_w[l], lru_conv_b[l], lru_wa[l], lru_ba[l],
                               lru_wx[l], lru_bx[l], lru_lambda[l])
        mix = jnp.concatenate([rw_out, hg_out, lru_out], axis=-1).astype(x.dtype)
        x = x + mix @ w_out[l]
    return _rmsnorm(x, final_norm_w).astype(x.dtype)
```

```cpp
#include <hip/hip_runtime.h>
#include <hip/hip_cooperative_groups.h>
#include <cstdio>
#include <cstdint>
namespace cg = cooperative_groups;
typedef _Float16 f16x8_t __attribute__((ext_vector_type(8)));
#define MK_MFMA(a, b, c) __builtin_amdgcn_mfma_f32_16x16x32_f16(__builtin_bit_cast(f16x8_t, (a)), __builtin_bit_cast(f16x8_t, (b)), (c), 0, 0, 0)
namespace pg8 {
#define PG8_LAS __attribute__((address_space(3)))
typedef unsigned short bf16_t;
typedef short bf16x8 __attribute__((ext_vector_type(8)));
typedef float f32x4 __attribute__((ext_vector_type(4)));
typedef unsigned u32x4 __attribute__((ext_vector_type(4)));
constexpr int BM = 256, BK = 64, HALF = 128, HTB = HALF * BK * 2  , STAGE_BYTES = 8 * HTB, NXCD = 8, WGM = 8;

__host__ __device__ __forceinline__ int lds_byte(int r, int c) { const int st = (r >> 4) * 2 + (c >> 5), rr = r & 15, cc = c & 31, ob = rr * 64 + cc * 2; return st * 1024 + (ob ^ (((ob >> 9) & 1) << 5)); }
__host__ __device__ __forceinline__ void stage_rc(int b, int& R, int& C) { const int st = b / 1024, sb = b % 1024, swz = sb ^ (((sb >> 9) & 1) << 5); R = (st >> 1) * 16 + swz / 64; C = (st & 1) * 32 + (swz % 64) / 2; }
__host__ __device__ __forceinline__ int perm32(int rho) { const int n = rho >> 4, i = rho & 15; return 8 * (i >> 2) + 4 * n + (i & 3); }

struct Unit { int pm, pn; };
struct Gemm { const bf16_t* A; const bf16_t* Bt; int M, N, K; };

struct StaticOrder {
    int nM, nN, nwg, G, c;
    __host__ __device__ void init(int M, int N, int G_, int c_) { nM = M / BM; nN = N / BM; nwg = nM * nN; G = G_; c = c_; }
    __host__ __device__ bool next(int i, Unit& u) const {
        const long L = (long)i * G + c; if (L >= nwg) return false;
        int wgid = (int)L; { const int q = nwg / NXCD, r = nwg % NXCD, xcd = wgid % NXCD, off = wgid / NXCD; wgid = (xcd < r ? xcd * (q + 1) : r * (q + 1) + (xcd - r) * q) + off; }
        const int nig = WGM * nN, gid = wgid / nig, fm = gid * WGM, gsz = (nM - fm) < WGM ? (nM - fm) : WGM;
        u.pm = fm + ((wgid % nig) % gsz); u.pn = (wgid % nig) / gsz; return true;
    }
    __device__ __forceinline__ void a_ready(const Unit&) const {}
    __device__ __forceinline__ void done(const Unit&) const {}
};

__device__ __forceinline__ unsigned pk_f16(float lo, float hi) { typedef _Float16 h2 __attribute__((ext_vector_type(2))); h2 v; v.x = (_Float16)lo; v.y = (_Float16)hi; return __builtin_bit_cast(unsigned, v); }
struct EpiF16 {
    static constexpr bool PERM = true, AFTER_DRAIN = false;
    bf16_t* O; int ldc;
    __device__ __forceinline__ void operator()(const f32x4 (&acc)[2][2][4][2], const Unit& u, int wr, int wc, int fr, int fq) const {
        const int row0 = u.pm * BM + wr * 64 + fr; const int col0 = u.pn * BM + wc * 32 + 8 * fq;
#pragma unroll
        for (int ai = 0; ai < 2; ++ai)
#pragma unroll
            for (int m = 0; m < 4; ++m) { bf16_t* rowp = O + (size_t)(row0 + ai * HALF + m * 16) * ldc + col0;
#pragma unroll
                for (int bj = 0; bj < 2; ++bj) { const f32x4 v0 = acc[ai][bj][m][0], v1 = acc[ai][bj][m][1];
                    u32x4 w; w.x = pk_f16(v0[0], v0[1]); w.y = pk_f16(v0[2], v0[3]); w.z = pk_f16(v1[0], v1[1]); w.w = pk_f16(v1[2], v1[3]);
                    *(u32x4*)(rowp + bj * HALF) = w; } }
    }
};
struct EpiRes {
    static constexpr bool PERM = false, AFTER_DRAIN = false;
    const float* base; float* out; int ldc;
    __device__ __forceinline__ void operator()(const f32x4 (&acc)[2][2][4][2], const Unit& u, int wr, int wc, int fr, int fq) const {
        const int row0 = u.pm * BM + wr * 64 + fr; const int col0 = u.pn * BM + wc * 32 + 4 * fq;
#pragma unroll
        for (int ai = 0; ai < 2; ++ai)
#pragma unroll
            for (int m = 0; m < 4; ++m) { const size_t off = (size_t)(row0 + ai * HALF + m * 16) * ldc + col0;
#pragma unroll
                for (int bj = 0; bj < 2; ++bj)
#pragma unroll
                    for (int n = 0; n < 2; ++n) { const size_t o = off + bj * HALF + n * 16; const f32x4 b = *(const f32x4*)(base + o); *(f32x4*)(out + o) = b + acc[ai][bj][m][n]; }
                asm volatile("" ::: "memory"); }
    }
};

template <class Epi, class Sched, bool ALIGN_EPI = false, bool SP2 = false>
__device__ __forceinline__ void gemm_phase(PG8_LAS unsigned char* lds, const Gemm g, const Sched& S, const Epi& E) {
    int tid_ = threadIdx.x; asm volatile("" : "+v"(tid_)); const int tid = tid_, wid = __builtin_amdgcn_readfirstlane(tid >> 6), lane = tid & 63, wr = wid >> 2, wc = wid & 3, fr = lane & 15, fq = lane >> 4;
    const int K = g.K, nt = K / BK;
    unsigned voffA[2], voffB[2];
#pragma unroll
    for (int i = 0; i < 2; ++i) { int R, C; stage_rc(tid * 16 + i * 8192, R, C); const int Rb = Epi::PERM ? ((R & ~31) + perm32(R & 31)) : R;
        voffA[i] = (unsigned)(R * K + C) * 2u; voffB[i] = (unsigned)(Rb * K + C) * 2u; }
    const size_t kstep = (size_t)(BK * 2);
    const size_t hstep = (size_t)HALF * K * 2;
    const size_t tstep = 2 * hstep;
    const unsigned ldsw = (unsigned)wid * 1024u;
    const int aoff = lds_byte(wr * 64 + fr, fq * 8), boff = lds_byte(wc * 32 + fr, fq * 8);
#define PG8_SA(b, h) (((b) * 2 + (h)) * HTB)
#define PG8_SB(b, h) ((4 + (b) * 2 + (h)) * HTB)
#define PG8_STAGE(bufoff, gbase, voff) do { _Pragma("unroll") for (int _i = 0; _i < 2; ++_i) \
        __builtin_amdgcn_global_load_lds((const unsigned*)((const char*)(gbase) + (voff)[_i]), (PG8_LAS unsigned*)(lds + (bufoff) + ldsw + _i * 8192), 16, 0, 0); } while (0)
#define PG8_LDA(dst, b, h) do { _Pragma("unroll") for (int m = 0; m < 4; ++m) _Pragma("unroll") for (int k = 0; k < 2; ++k) dst[m][k] = *(const PG8_LAS bf16x8*)(lds + PG8_SA(b, h) + aoff + m * 2048 + k * 1024); } while (0)
#define PG8_LDB(dst, b, h) do { _Pragma("unroll") for (int n = 0; n < 2; ++n) _Pragma("unroll") for (int k = 0; k < 2; ++k) dst[n][k] = *(const PG8_LAS bf16x8*)(lds + PG8_SB(b, h) + boff + n * 2048 + k * 1024); } while (0)
#define PG8_MMA(ai, bj, At, Bt) do { __builtin_amdgcn_s_setprio(1); _Pragma("unroll") for (int m = 0; m < 4; ++m) _Pragma("unroll") for (int n = 0; n < 2; ++n) _Pragma("unroll") for (int k = 0; k < 2; ++k) \
        acc[ai][bj][m][n] = MK_MFMA(Bt[n][k], At[m][k], acc[ai][bj][m][n]); __builtin_amdgcn_s_setprio(0); } while (0)
#define PG8_WAIT_V(n) asm volatile("s_waitcnt vmcnt(" #n ")" ::: "memory")
#define PG8_WAIT_L(n) asm volatile("s_waitcnt lgkmcnt(" #n ")" ::: "memory")
#define PG8_BAR __builtin_amdgcn_s_barrier()
#define PG8_SCHED __builtin_amdgcn_sched_barrier(0)
    Unit cur, nxt; int ui = 0;
    if (!S.next(0, cur)) return;
    f32x4 acc[2][2][4][2];
#pragma unroll
    for (int a = 0; a < 2; ++a)
#pragma unroll
        for (int b = 0; b < 2; ++b)
#pragma unroll
            for (int m = 0; m < 4; ++m)
#pragma unroll
                for (int n = 0; n < 2; ++n) acc[a][b][m][n] = (f32x4){0.f, 0.f, 0.f, 0.f};
    bf16x8 At[4][2], B0[2][2], B1[2][2];
    const char* cA = (const char*)g.A + (size_t)cur.pm * tstep; const char* cB = (const char*)g.Bt + (size_t)cur.pn * tstep;
    S.a_ready(cur);
    if constexpr (SP2) {
        PG8_STAGE(PG8_SB(0, 0), cB, voffB); PG8_STAGE(PG8_SB(0, 1), cB + hstep, voffB); PG8_STAGE(PG8_SA(0, 0), cA, voffA); PG8_STAGE(PG8_SA(0, 1), cA + hstep, voffA);
        if (wr == 1) PG8_BAR;
        PG8_WAIT_V(2); PG8_BAR;
        PG8_STAGE(PG8_SB(1, 0), cB + kstep, voffB); PG8_STAGE(PG8_SA(1, 0), cA + kstep, voffA); PG8_STAGE(PG8_SB(1, 1), cB + hstep + kstep, voffB);
        PG8_WAIT_V(6); PG8_BAR;
    } else {
        PG8_STAGE(PG8_SB(0, 0), cB, voffB); PG8_STAGE(PG8_SA(0, 0), cA, voffA); PG8_STAGE(PG8_SB(0, 1), cB + hstep, voffB); PG8_STAGE(PG8_SA(0, 1), cA + hstep, voffA);
        if (wr == 1) PG8_BAR;
        PG8_WAIT_V(4); PG8_BAR;
        PG8_STAGE(PG8_SB(1, 0), cB + kstep, voffB); PG8_STAGE(PG8_SA(1, 0), cA + kstep, voffA); PG8_STAGE(PG8_SB(1, 1), cB + hstep + kstep, voffB);
        PG8_WAIT_V(6); PG8_BAR;
    }
    for (;;) {
        const bool has_next = S.next(ui + 1, nxt);
        const char* nA = has_next ? (const char*)g.A + (size_t)nxt.pm * tstep : cA; const char* nB = has_next ? (const char*)g.Bt + (size_t)nxt.pn * tstep : cB;
        for (int t = 0; t < nt; t += 2) {
            const bool last = (t == nt - 2);
            const char* a1 = cA + (size_t)(t + 1) * kstep;
            const char* a2 = last ? nA : cA + (size_t)(t + 2) * kstep; const char* b2 = last ? nB : cB + (size_t)(t + 2) * kstep;
            const char* a3 = a2 + kstep; const char* b3 = b2 + kstep;
            if (last && has_next) S.a_ready(nxt);
            if constexpr (SP2) {
            PG8_LDB(B0, 0, 0); PG8_LDB(B1, 0, 1); PG8_SCHED; PG8_LDA(At, 0, 0); PG8_STAGE(PG8_SA(1, 1), a1 + hstep, voffA);
            PG8_WAIT_V(8); PG8_WAIT_L(0); PG8_BAR; PG8_MMA(0, 0, At, B0); PG8_MMA(0, 1, At, B1); PG8_BAR; PG8_SCHED;
            PG8_LDA(At, 0, 1); PG8_STAGE(PG8_SB(0, 0), b2, voffB); PG8_STAGE(PG8_SB(0, 1), b2 + hstep, voffB); PG8_STAGE(PG8_SA(0, 0), a2, voffA);
            PG8_WAIT_V(8); PG8_WAIT_L(0); PG8_BAR; PG8_MMA(1, 0, At, B0); PG8_MMA(1, 1, At, B1); PG8_BAR; PG8_SCHED;
            PG8_LDB(B0, 1, 0); PG8_LDB(B1, 1, 1); PG8_SCHED; PG8_LDA(At, 1, 0); PG8_STAGE(PG8_SA(0, 1), a2 + hstep, voffA);
            PG8_WAIT_V(8); PG8_WAIT_L(0); PG8_BAR; PG8_MMA(0, 0, At, B0); PG8_MMA(0, 1, At, B1); PG8_BAR; PG8_SCHED;
            PG8_LDA(At, 1, 1); PG8_STAGE(PG8_SB(1, 0), b3, voffB); PG8_STAGE(PG8_SB(1, 1), b3 + hstep, voffB); PG8_STAGE(PG8_SA(1, 0), a3, voffA);
            PG8_WAIT_V(8); PG8_WAIT_L(0); PG8_BAR; PG8_MMA(1, 0, At, B0); PG8_MMA(1, 1, At, B1); PG8_BAR; PG8_SCHED;
            } else {
            PG8_LDB(B0, 0, 0); PG8_SCHED; PG8_LDA(At, 0, 0); PG8_STAGE(PG8_SA(1, 1), a1 + hstep, voffA);
            PG8_WAIT_L(8); PG8_BAR; PG8_WAIT_L(0); PG8_MMA(0, 0, At, B0); PG8_BAR; PG8_SCHED;
            PG8_LDB(B1, 0, 1); PG8_STAGE(PG8_SB(0, 0), b2, voffB);
            PG8_BAR; PG8_WAIT_L(0); PG8_MMA(0, 1, At, B1); PG8_BAR;
            PG8_LDA(At, 0, 1); PG8_STAGE(PG8_SA(0, 0), a2, voffA);
            PG8_BAR; PG8_WAIT_L(0); PG8_MMA(1, 0, At, B0); PG8_BAR; PG8_SCHED;
            PG8_STAGE(PG8_SB(0, 1), b2 + hstep, voffB);
            PG8_WAIT_V(6); PG8_BAR; PG8_MMA(1, 1, At, B1); PG8_BAR;
            PG8_LDB(B0, 1, 0); PG8_SCHED; PG8_LDA(At, 1, 0); PG8_STAGE(PG8_SA(0, 1), a2 + hstep, voffA);
            PG8_WAIT_L(8); PG8_BAR; PG8_WAIT_L(0); PG8_MMA(0, 0, At, B0); PG8_BAR; PG8_SCHED;
            PG8_LDB(B1, 1, 1); PG8_STAGE(PG8_SB(1, 0), b3, voffB);
            PG8_BAR; PG8_WAIT_L(0); PG8_MMA(0, 1, At, B1); PG8_BAR;
            PG8_LDA(At, 1, 1); PG8_STAGE(PG8_SA(1, 0), a3, voffA);
            PG8_BAR; PG8_WAIT_L(0); PG8_MMA(1, 0, At, B0); PG8_BAR; PG8_SCHED;
            PG8_STAGE(PG8_SB(1, 1), b3 + hstep, voffB);
            PG8_WAIT_V(6); PG8_BAR; PG8_MMA(1, 1, At, B1); PG8_BAR;
            }
        }
        if constexpr (ALIGN_EPI) { if (wr == 0) PG8_BAR; }
        if constexpr (!Epi::AFTER_DRAIN) { E(acc, cur, wr, wc, fr, fq); S.done(cur); }
        if (!has_next) break;
#pragma unroll
        for (int a = 0; a < 2; ++a)
#pragma unroll
            for (int b = 0; b < 2; ++b)
#pragma unroll
                for (int m = 0; m < 4; ++m)
#pragma unroll
                    for (int n = 0; n < 2; ++n) acc[a][b][m][n] = (f32x4){0.f, 0.f, 0.f, 0.f};
        cur = nxt; cA = nA; cB = nB; ++ui;
        if constexpr (ALIGN_EPI) { if (wr == 1) PG8_BAR; }
    }
    PG8_WAIT_V(0);
    if constexpr (!ALIGN_EPI) { if (wr == 0) PG8_BAR; }
    PG8_BAR;
    if constexpr (Epi::AFTER_DRAIN) { E.fused(acc, cur, wr, wc, fr, fq, lds, wid, lane); S.done(cur); }
#undef PG8_SA
#undef PG8_SB
#undef PG8_STAGE
#undef PG8_LDA
#undef PG8_LDB
#undef PG8_MMA
#undef PG8_WAIT_V
#undef PG8_WAIT_L
#undef PG8_BAR
#undef PG8_SCHED
}
}

constexpr int BATCH = 2, SEQ = 8192, DM = 1024, DEPTH = 2, M = BATCH * SEQ;
constexpr int RW_H = 6, HD = 64, RW_W = 384, RW_SHIFT = 1280;
constexpr int NIN = 3712, NU = 3840;
constexpr int C_R = 0, C_K = 384, C_V = 768, C_WL = 1152, C_AL = 1216, C_RWZ = 1280, C_HGQ = 1664, C_HGF = 2048, C_HGI = 2432, C_HGZ = 2816, C_LRUX = 3200, C_LRUZ = 3456;
constexpr int CH = 64;
constexpr int NWAVES = 8, NT = NWAVES * 64;
constexpr int LDS_BYTES = 147456;
constexpr size_t MiB = 1u << 20;
constexpr size_t WS_WIN = 1 * MiB, WIN_L = (size_t)NU * DM * 2;
constexpr size_t WS_WOUT = 16 * MiB, WOUT_L = (size_t)DM * DM * 2;
constexpr size_t WS_XN = 20 * MiB;
constexpr size_t WS_U = 52 * MiB;
constexpr size_t WS_MIX = 172 * MiB;
constexpr size_t WS_VFIRST = 204 * MiB;
constexpr size_t WS_END = 228 * MiB;

#define LAS __attribute__((address_space(3)))
typedef float f32x4 __attribute__((ext_vector_type(4)));
typedef unsigned u32x2 __attribute__((ext_vector_type(2)));
typedef unsigned u32x4 __attribute__((ext_vector_type(4)));
typedef _Float16 f16;
#define LDS_WAIT() asm volatile("s_waitcnt lgkmcnt(0)" ::: "memory")

struct Args { const float* in[27]; float* out; unsigned char* ws; };

__device__ __forceinline__ float wave_sum(float v) {
#pragma unroll
    for (int o = 1; o < 64; o <<= 1) v += __shfl_xor(v, o);
    return v;
}
__device__ __forceinline__ float sigmoidf_(float x) { return 1.0f / (1.0f + __expf(-x)); }
__device__ __forceinline__ float siluf_(float x) { return x / (1.0f + __expf(-x)); }

__device__ __forceinline__ void p0_transpose_item(const float* W, int K, int N, unsigned short* WT, LAS float* scr, int item, int lane) {
    const int nblk = N / 32, kb = item / nblk, nb = item % nblk, k0 = 64 * kb, n0 = 32 * nb;
#pragma unroll 8
    for (int i = 0; i < 32; ++i) { const int kk = 2 * i + (lane >> 5); scr[kk * 33 + (lane & 31)] = W[(size_t)(k0 + kk) * N + n0 + (lane & 31)]; }
    LDS_WAIT(); asm volatile("" ::: "memory");
    const int c = lane & 7;
#pragma unroll
    for (int j = 0; j < 4; ++j) { const int n = (lane >> 3) + 8 * j; const LAS float* s = scr + (8 * c) * 33 + n;
        u32x4 o; o.x = pg8::pk_f16(s[0 * 33], s[1 * 33]); o.y = pg8::pk_f16(s[2 * 33], s[3 * 33]); o.z = pg8::pk_f16(s[4 * 33], s[5 * 33]); o.w = pg8::pk_f16(s[6 * 33], s[7 * 33]);
        *(u32x4*)(WT + (size_t)(n0 + n) * K + k0 + 8 * c) = o; }
    LDS_WAIT(); asm volatile("" ::: "memory");
}
__device__ __forceinline__ void rms_row_f16(const float* xrow, const float* w, unsigned short* orow, int lane) {
    const f32x4* xr = (const f32x4*)xrow + lane; const f32x4* wr = (const f32x4*)w + lane;
    f32x4 v[4]; float s = 0.f;
#pragma unroll
    for (int j = 0; j < 4; ++j) { v[j] = xr[64 * j]; s += (v[j].x * v[j].x + v[j].y * v[j].y) + (v[j].z * v[j].z + v[j].w * v[j].w); }
    const float rs = 1.0f / sqrtf(wave_sum(s) * (1.0f / DM) + 1e-6f);
    u32x2* o8 = (u32x2*)orow + lane;
#pragma unroll
    for (int j = 0; j < 4; ++j) { const f32x4 ww = wr[64 * j]; u32x2 o; o.x = pg8::pk_f16(v[j].x * rs * ww.x, v[j].y * rs * ww.y); o.y = pg8::pk_f16(v[j].z * rs * ww.z, v[j].w * rs * ww.w); o8[64 * j] = o; }
}
__device__ __forceinline__ void rms_row_f32(float* xrow, const float* w, int lane) {
    f32x4* xr = (f32x4*)xrow + lane; const f32x4* wr = (const f32x4*)w + lane;
    f32x4 v[4]; float s = 0.f;
#pragma unroll
    for (int j = 0; j < 4; ++j) { v[j] = xr[64 * j]; s += (v[j].x * v[j].x + v[j].y * v[j].y) + (v[j].z * v[j].z + v[j].w * v[j].w); }
    const float rs = 1.0f / sqrtf(wave_sum(s) * (1.0f / DM) + 1e-6f);
#pragma unroll
    for (int j = 0; j < 4; ++j) { const f32x4 ww = wr[64 * j]; xr[64 * j] = v[j] * rs * ww; }
}

__device__ __forceinline__ void rwkv_seq(const Args& a, int l, int b, int h, LAS unsigned char* lds, int tid) {
    asm volatile("" : "+v"(tid));
    const int lane = tid & 63, wave = __builtin_amdgcn_readfirstlane(tid >> 6);
    const f16* U = (const f16*)(a.ws + WS_U); f16* MIX = (f16*)(a.ws + WS_MIX); float* VF = (float*)(a.ws + WS_VFIRST);
    const float* mu = a.in[3] + l * RW_SHIFT; const float* w0 = a.in[4] + l * RW_W; const float* w_up = a.in[5] + (size_t)l * 64 * RW_W;
    const float* a0 = a.in[6] + l * RW_W; const float* a_up = a.in[7] + (size_t)l * 64 * RW_W;
    const float* v0 = a.in[8]; const float* v_dn = a.in[9]; const float* v_up = a.in[10];
    const float* k_k = a.in[11] + l * RW_W; const float* k_a = a.in[12] + l * RW_W; const float* r_k = a.in[13] + l * RW_W;
    const float* ln_w = a.in[14] + l * RW_W; const float* ln_b = a.in[15] + l * RW_W;
    LAS float* VEC = (LAS float*)lds;
    LAS float* VV = (LAS float*)(lds + 81920);
    LAS float* TW = (LAS float*)(lds + 98304);
    LAS float* TA = (LAS float*)(lds + 114688);
    LAS float* VD = (LAS float*)(lds + 131072);
    LAS float* BON = (LAS float*)(lds + 139264);
    const int tt = tid >> 3, sub = tid & 7;
    float S[64];
#pragma unroll
    for (int k = 0; k < 64; ++k) S[k] = 0.f;
    for (int c = 0; c < SEQ / CH; ++c) {
        const int t = c * CH + tt; const size_t m = (size_t)b * SEQ + t;
        const f16* urow = U + m * NU; const f16* prow = urow - NU; const bool hp = t > 0;
#define SH(col) ({ const float cur_ = (float)urow[(col)]; const float prev_ = hp ? (float)prow[(col)] : 0.f; cur_ + mu[(col)] * (prev_ - cur_); })
#pragma unroll 1
        for (int i = 0; i < 8; ++i) { const int ii = sub * 8 + i; TW[tt * 64 + ii] = tanhf(SH(C_WL + ii)); TA[tt * 64 + ii] = SH(C_AL + ii); }
        if (l > 0) {
            float vd[4] = {0.f, 0.f, 0.f, 0.f};
#pragma unroll 2
            for (int c2 = 0; c2 < RW_W; ++c2) { const float vs = SH(C_V + c2);
#pragma unroll
                for (int jj = 0; jj < 4; ++jj) vd[jj] += vs * v_dn[c2 * 32 + sub * 4 + jj]; }
#pragma unroll
            for (int jj = 0; jj < 4; ++jj) VD[tt * 32 + sub * 4 + jj] = vd[jj];
        }
        __syncthreads();
        float ssq = 0.f, bon = 0.f;
#pragma unroll 1
        for (int i = 0; i < 8; ++i) {
            const int j = sub * 8 + i, col = h * 64 + j;
            float dw = 0.f, da = 0.f;
#pragma unroll 4
            for (int i2 = 0; i2 < 64; ++i2) { dw += TW[tt * 64 + i2] * w_up[i2 * RW_W + col]; da += TA[tt * 64 + i2] * a_up[i2 * RW_W + col]; }
            const float w = __expf(-0.6065306597126334f * sigmoidf_(w0[col] + dw));
            const float aa = sigmoidf_(a0[col] + da);
            const float rs = SH(C_R + col), ks = SH(C_K + col), vs = SH(C_V + col);
            float vv;
            if (l == 0) { VF[m * RW_W + col] = vs; vv = vs; }
            else { float g = v0[col];
#pragma unroll 4
                for (int j2 = 0; j2 < 32; ++j2) g += VD[tt * 32 + j2] * v_up[j2 * RW_W + col]; vv = vs + (VF[m * RW_W + col] - vs) * sigmoidf_(g); }
            const float kv = ks * k_k[col]; VEC[tt * 320 + j] = kv; VEC[tt * 320 + 128 + j] = aa; ssq += kv * kv;
            const float kmod = ks * (1.0f + (aa - 1.0f) * k_a[col]);
            bon += rs * kmod * r_k[col];
            VEC[tt * 320 + 64 + j] = w; VEC[tt * 320 + 192 + j] = kmod; VEC[tt * 320 + 256 + j] = rs; VV[tt * 64 + j] = vv;
        }
        ssq += __shfl_xor(ssq, 1); ssq += __shfl_xor(ssq, 2); ssq += __shfl_xor(ssq, 4);
        bon += __shfl_xor(bon, 1); bon += __shfl_xor(bon, 2); bon += __shfl_xor(bon, 4);
        const float inv = 1.0f / fmaxf(sqrtf(ssq), 1e-12f);
#pragma unroll 1
        for (int i = 0; i < 8; ++i) { const int j = sub * 8 + i; const float kk = VEC[tt * 320 + j] * inv; const float aa = VEC[tt * 320 + 128 + j]; VEC[tt * 320 + j] = -kk; VEC[tt * 320 + 128 + j] = kk * aa; }
        if (sub == 0) BON[tt] = bon;
#undef SH
        __syncthreads();
        if (wave == 0) {
            for (int t2 = 0; t2 < CH; ++t2) {
                const LAS float* ve = VEC + t2 * 320; const size_t m2 = (size_t)b * SEQ + c * CH + t2;
                const float vv = VV[t2 * 64 + lane];
                float s0 = 0.f, s1 = 0.f, s2 = 0.f, s3 = 0.f;
#pragma unroll
                for (int k = 0; k < 64; k += 4) { const f32x4 a4 = *(const LAS f32x4*)(ve + k); s0 += S[k] * a4.x; s1 += S[k + 1] * a4.y; s2 += S[k + 2] * a4.z; s3 += S[k + 3] * a4.w; }
                const float sa = (s0 + s1) + (s2 + s3);
                float y0 = 0.f, y1 = 0.f, y2 = 0.f, y3 = 0.f;
#pragma unroll
                for (int k = 0; k < 64; k += 4) {
                    const f32x4 w4 = *(const LAS f32x4*)(ve + 64 + k), b4 = *(const LAS f32x4*)(ve + 128 + k), k4 = *(const LAS f32x4*)(ve + 192 + k), r4 = *(const LAS f32x4*)(ve + 256 + k);
                    S[k] = S[k] * w4.x + (sa * b4.x + vv * k4.x); y0 += S[k] * r4.x;
                    S[k + 1] = S[k + 1] * w4.y + (sa * b4.y + vv * k4.y); y1 += S[k + 1] * r4.y;
                    S[k + 2] = S[k + 2] * w4.z + (sa * b4.z + vv * k4.z); y2 += S[k + 2] * r4.z;
                    S[k + 3] = S[k + 3] * w4.w + (sa * b4.w + vv * k4.w); y3 += S[k + 3] * r4.w;
                }
                const float y = (y0 + y1) + (y2 + y3);
                const float mean = wave_sum(y) * (1.0f / 64.0f); const float d = y - mean; const float var = wave_sum(d * d) * (1.0f / 64.0f);
                const int col = h * 64 + lane;
                const float yn = d * (1.0f / sqrtf(var + 64e-5f)) * ln_w[col] + ln_b[col];
                const float z = (float)U[m2 * NU + C_RWZ + col];
                MIX[m2 * DM + col] = (f16)((yn + BON[t2] * vv) * siluf_(z));
            }
        }
        __syncthreads();
    }
}

__device__ __forceinline__ void hgrn_seq(const Args& a, int l, int b, int h, LAS unsigned char* lds, int tid) {
    asm volatile("" : "+v"(tid));
    const int lane = tid & 63, wave = __builtin_amdgcn_readfirstlane(tid >> 6);
    const f16* U = (const f16*)(a.ws + WS_U); f16* MIX = (f16*)(a.ws + WS_MIX);
    const float* lbr = a.in[16]; const float* nw = a.in[17] + l * 384;
    LAS float* FQ = (LAS float*)lds;
    const int tt = tid >> 3, sub = tid & 7;
    float S[64];
#pragma unroll
    for (int k = 0; k < 64; ++k) S[k] = 0.f;
    for (int c = 0; c < SEQ / CH; ++c) {
        const size_t m = (size_t)b * SEQ + c * CH + tt;
#pragma unroll 1
        for (int i = 0; i < 8; ++i) { const int j = sub * 8 + i, col = h * 64 + j;
            const float lb = (l == 0) ? 0.f : sigmoidf_(lbr[384 + col] - lbr[col]);
            FQ[tt * 128 + j] = lb + (1.0f - lb) * sigmoidf_((float)U[m * NU + C_HGF + col]);
            FQ[tt * 128 + 64 + j] = (float)U[m * NU + C_HGQ + col]; }
        __syncthreads();
        if (wave == 0) {
            for (int t2 = 0; t2 < CH; ++t2) {
                const LAS float* fq = FQ + t2 * 128; const size_t m2 = (size_t)b * SEQ + c * CH + t2; const int col = h * 64 + lane;
                const float vi = (float)U[m2 * NU + C_HGI + col];
                float o0 = 0.f, o1 = 0.f, o2 = 0.f, o3 = 0.f;
#pragma unroll
                for (int k = 0; k < 64; k += 4) { const f32x4 f4 = *(const LAS f32x4*)(fq + k), q4 = *(const LAS f32x4*)(fq + 64 + k);
                    S[k] = f4.x * S[k] + (1.0f - f4.x) * vi; o0 += q4.x * S[k];
                    S[k + 1] = f4.y * S[k + 1] + (1.0f - f4.y) * vi; o1 += q4.y * S[k + 1];
                    S[k + 2] = f4.z * S[k + 2] + (1.0f - f4.z) * vi; o2 += q4.z * S[k + 2];
                    S[k + 3] = f4.w * S[k + 3] + (1.0f - f4.w) * vi; o3 += q4.w * S[k + 3]; }
                const float o = (o0 + o1) + (o2 + o3);
                const float ms = wave_sum(o * o) * (1.0f / 64.0f);
                const float z = (float)U[m2 * NU + C_HGZ + col];
                MIX[m2 * DM + 384 + col] = (f16)(o * (1.0f / sqrtf(ms + 1e-6f)) * nw[col] * siluf_(z));
            }
        }
        __syncthreads();
    }
}

__device__ __forceinline__ void lru_seq(const Args& a, int l, int b, int g, LAS unsigned char* lds, int tid) {
    asm volatile("" : "+v"(tid));
    const int lane = tid & 63, wave = __builtin_amdgcn_readfirstlane(tid >> 6);
    const f16* U = (const f16*)(a.ws + WS_U); f16* MIX = (f16*)(a.ws + WS_MIX);
    const float* cw = a.in[18] + l * 4 * 256; const float* cb = a.in[19] + l * 256;
    const float* wa = a.in[20] + (size_t)(l * 4 + g) * 4096; const float* ba = a.in[21] + l * 256;
    const float* wx = a.in[22] + (size_t)(l * 4 + g) * 4096; const float* bx = a.in[23] + l * 256; const float* lam = a.in[24] + l * 256;
    LAS float* Y = (LAS float*)lds; LAS float* AA = (LAS float*)(lds + 16384); LAS float* UU = (LAS float*)(lds + 32768);
    const int tt = tid >> 3, sub = tid & 7;
    float hst = 0.f;
    for (int c = 0; c < SEQ / CH; ++c) {
        const int t = c * CH + tt; const size_t m = (size_t)b * SEQ + t;
#pragma unroll 1
        for (int i = 0; i < 8; ++i) { const int j = sub * 8 + i, ch = g * 64 + j; float y = cb[ch];
#pragma unroll
            for (int jj = 0; jj < 4; ++jj) { const int ts = t - 3 + jj; if (ts >= 0) y += cw[jj * 256 + ch] * (float)U[((size_t)b * SEQ + ts) * NU + C_LRUX + ch]; }
            Y[tt * 64 + j] = y; }
        __syncthreads();
#pragma unroll 1
        for (int i = 0; i < 8; ++i) { const int j = sub * 8 + i, ch = g * 64 + j; float ra = ba[ch], rx = bx[ch];
#pragma unroll 4
            for (int i2 = 0; i2 < 64; ++i2) { const float yv = Y[tt * 64 + i2]; ra += yv * wa[i2 * 64 + j]; rx += yv * wx[i2 * 64 + j]; }
            const float r = sigmoidf_(ra), ig = sigmoidf_(rx);
            const float la = -8.0f * r * log1pf(expf(-lam[ch]));
            AA[tt * 64 + j] = expf(la); UU[tt * 64 + j] = sqrtf(-expm1f(2.0f * la)) * (ig * Y[tt * 64 + j]); }
        __syncthreads();
        if (wave == 0) {
            const int ch = g * 64 + lane;
            for (int t2 = 0; t2 < CH; ++t2) { const size_t m2 = (size_t)b * SEQ + c * CH + t2;
                hst = AA[t2 * 64 + lane] * hst + UU[t2 * 64 + lane];
                MIX[m2 * DM + 768 + ch] = (f16)(hst * siluf_((float)U[m2 * NU + C_LRUZ + ch])); }
        }
        __syncthreads();
    }
}

__global__ void __launch_bounds__(NT, 2) fwd(Args args) {
    extern __shared__ __attribute__((aligned(16))) unsigned char lds_raw[];
    LAS unsigned char* lds = (LAS unsigned char*)lds_raw;
    cg::grid_group grid = cg::this_grid();
    int tid_ = threadIdx.x; asm volatile("" : "+v"(tid_)); const int tid = tid_; const int lane = tid & 63, wave = __builtin_amdgcn_readfirstlane(tid >> 6);
    const int G = gridDim.x, gw = blockIdx.x * NWAVES + wave, NGW = G * NWAVES;
    unsigned char* ws = args.ws;
    unsigned short* XN = (unsigned short*)(ws + WS_XN);
    {
        LAS float* scr = (LAS float*)(lds + wave * 16384);
        constexpr int I_IN = (DM / 64) * (NIN / 32), I_OUT = (DM / 64) * (DM / 32), NITEMS = DEPTH * (I_IN + I_OUT);
        for (int it = gw; it < NITEMS; it += NGW) {
            int r = it; const int l = r / (I_IN + I_OUT); r -= l * (I_IN + I_OUT);
            if (r < I_IN) p0_transpose_item(args.in[2] + (size_t)l * DM * NIN, DM, NIN, (unsigned short*)(ws + WS_WIN + l * WIN_L), scr, r, lane);
            else p0_transpose_item(args.in[25] + (size_t)l * DM * DM, DM, DM, (unsigned short*)(ws + WS_WOUT + l * WOUT_L), scr, r - I_IN, lane);
        }
        for (int i = gw; i < DEPTH * (NU - NIN) * DM * 2 / 1024; i += NGW) { const int l = i / ((NU - NIN) * DM * 2 / 1024), r = i % ((NU - NIN) * DM * 2 / 1024);
            *(u32x4*)(ws + WS_WIN + l * WIN_L + (size_t)NIN * DM * 2 + (size_t)r * 1024 + lane * 16) = (u32x4){0u, 0u, 0u, 0u}; }
        for (int m = gw; m < M; m += NGW) rms_row_f16(args.in[0] + (size_t)m * DM, args.in[1], XN + (size_t)m * DM, lane);
    }
    grid.sync();
#pragma unroll 1
    for (int l = 0; l < DEPTH; ++l) {
        { pg8::Gemm g{XN, (const unsigned short*)(ws + WS_WIN + l * WIN_L), M, NU, DM}; pg8::StaticOrder S; S.init(M, NU, G, (int)blockIdx.x);
          pg8::EpiF16 E{(unsigned short*)(ws + WS_U), NU};
          pg8::gemm_phase<pg8::EpiF16, pg8::StaticOrder, true, true>(lds, g, S, E); }
        grid.sync();
        { const int bx = blockIdx.x;
          if (bx < 12) rwkv_seq(args, l, bx / 6, bx % 6, lds, tid);
          else if (bx < 24) hgrn_seq(args, l, (bx - 12) / 6, (bx - 12) % 6, lds, tid);
          else if (bx < 32) lru_seq(args, l, (bx - 24) / 4, (bx - 24) % 4, lds, tid); }
        grid.sync();
        { pg8::Gemm g{(const unsigned short*)(ws + WS_MIX), (const unsigned short*)(ws + WS_WOUT + l * WOUT_L), M, DM, DM}; pg8::StaticOrder S; S.init(M, DM, G, (int)blockIdx.x);
          pg8::EpiRes E{l == 0 ? args.in[0] : args.out, args.out, DM};
          pg8::gemm_phase<pg8::EpiRes, pg8::StaticOrder, true, true>(lds, g, S, E); }
        grid.sync();
        if (l + 1 < DEPTH) { for (int m = gw; m < M; m += NGW) rms_row_f16(args.out + (size_t)m * DM, args.in[1] + (l + 1) * DM, XN + (size_t)m * DM, lane); grid.sync(); }
        else { for (int m = gw; m < M; m += NGW) rms_row_f32(args.out + (size_t)m * DM, args.in[26], lane); }
    }
}

extern "C" void kernel_launch(void* const* d_in, const int* in_sizes, int n_in, void* d_out, int out_size, void* d_ws, size_t ws_size, hipStream_t stream) {
    static int grid = 0;
    if (grid == 0) {
        if (n_in != 27 || in_sizes[0] != M * DM || out_size != M * DM || ws_size < WS_END) { fprintf(stderr, "kernel_launch: unexpected problem: n_in %d in0 %d out %d ws %zu\n", n_in, n_in > 0 ? in_sizes[0] : -1, out_size, ws_size); grid = -1; return; }
        int dev = 0, cus = 0, per_cu = 0;
        hipGetDevice(&dev); hipDeviceGetAttribute(&cus, hipDeviceAttributeMultiprocessorCount, dev);
        if (hipFuncSetAttribute((const void*)fwd, hipFuncAttributeMaxDynamicSharedMemorySize, LDS_BYTES) != hipSuccess) { fprintf(stderr, "kernel_launch: hipFuncSetAttribute failed\n"); grid = -1; return; }
        if (hipOccupancyMaxActiveBlocksPerMultiprocessor(&per_cu, (const void*)fwd, NT, LDS_BYTES) != hipSuccess || per_cu < 1) { fprintf(stderr, "kernel_launch: occupancy query failed (%d)\n", per_cu); grid = -1; return; }
        grid = cus * per_cu;
    }
    if (grid < 0) return;
    Args a{};
    for (int i = 0; i < 27; ++i) a.in[i] = (const float*)d_in[i];
    a.out = (float*)d_out; a.ws = (unsigned char*)d_ws;
    void* kargs[] = {&a};
    hipError_t e = hipLaunchCooperativeKernel((const void*)fwd, dim3(grid), dim3(NT), kargs, LDS_BYTES, stream);
    if (e != hipSuccess) fprintf(stderr, "cooperative launch failed: %s (grid %d)\n", hipGetErrorString(e), grid);
}
```

```cpp
#include <hip/hip_runtime.h>
#include <hip/hip_cooperative_groups.h>
#include <cstdio>
#include <cstdint>
namespace cg = cooperative_groups;
typedef _Float16 f16x8_t __attribute__((ext_vector_type(8)));
#define MK_MFMA(a, b, c) __builtin_amdgcn_mfma_f32_16x16x32_f16(__builtin_bit_cast(f16x8_t, (a)), __builtin_bit_cast(f16x8_t, (b)), (c), 0, 0, 0)
__device__ __forceinline__ int lane_now() { int z; asm volatile("v_mbcnt_lo_u32_b32 %0, -1, 0\n\tv_mbcnt_hi_u32_b32 %0, -1, %0" : "=v"(z)); return z; }
namespace pg8 {
#define PG8_LAS __attribute__((address_space(3)))
typedef unsigned short bf16_t;
typedef short bf16x8 __attribute__((ext_vector_type(8)));
typedef float f32x4 __attribute__((ext_vector_type(4)));
typedef unsigned u32x4 __attribute__((ext_vector_type(4)));
constexpr int BM = 256, BK = 64, HALF = 128, HTB = HALF * BK * 2  , STAGE_BYTES = 8 * HTB, NXCD = 8, WGM = 8;

__host__ __device__ __forceinline__ int lds_byte(int r, int c) { const int st = (r >> 4) * 2 + (c >> 5), rr = r & 15, cc = c & 31, ob = rr * 64 + cc * 2; return st * 1024 + (ob ^ (((ob >> 9) & 1) << 5)); }
__host__ __device__ __forceinline__ void stage_rc(int b, int& R, int& C) { const int st = b / 1024, sb = b % 1024, swz = sb ^ (((sb >> 9) & 1) << 5); R = (st >> 1) * 16 + swz / 64; C = (st & 1) * 32 + (swz % 64) / 2; }
__host__ __device__ __forceinline__ int perm32(int rho) { const int n = rho >> 4, i = rho & 15; return 8 * (i >> 2) + 4 * n + (i & 3); }

struct Unit { int pm, pn; };
struct Gemm { const bf16_t* A; const bf16_t* Bt; int M, N, K; };

struct StaticOrder {
    int nM, nN, nwg, G, c;
    __host__ __device__ void init(int M, int N, int G_, int c_) { nM = M / BM; nN = N / BM; nwg = nM * nN; G = G_; c = c_; }
    __host__ __device__ bool next(int i, Unit& u) const {
        const long L = (long)i * G + c; if (L >= nwg) return false;
        int wgid = (int)L; { const int q = nwg / NXCD, r = nwg % NXCD, xcd = wgid % NXCD, off = wgid / NXCD; wgid = (xcd < r ? xcd * (q + 1) : r * (q + 1) + (xcd - r) * q) + off; }
        const int nig = WGM * nN, gid = wgid / nig, fm = gid * WGM, gsz = (nM - fm) < WGM ? (nM - fm) : WGM;
        u.pm = fm + ((wgid % nig) % gsz); u.pn = (wgid % nig) / gsz; return true;
    }
    __device__ __forceinline__ void a_ready(const Unit&) const {}
    __device__ __forceinline__ void done(const Unit&) const {}
};

__device__ __forceinline__ unsigned pk_f16(float lo, float hi) { typedef _Float16 h2 __attribute__((ext_vector_type(2))); h2 v; v.x = (_Float16)lo; v.y = (_Float16)hi; return __builtin_bit_cast(unsigned, v); }
struct EpiF16 {
    static constexpr bool PERM = true, AFTER_DRAIN = false;
    bf16_t* O; int ldc;
    __device__ __forceinline__ void operator()(const f32x4 (&acc)[2][2][4][2], const Unit& u, int wr, int wc, int fr, int fq) const {
        const int row0 = u.pm * BM + wr * 64 + fr; const int col0 = u.pn * BM + wc * 32 + 8 * fq;
#pragma unroll
        for (int ai = 0; ai < 2; ++ai)
#pragma unroll
            for (int m = 0; m < 4; ++m) { bf16_t* rowp = O + (size_t)(row0 + ai * HALF + m * 16) * ldc + col0;
#pragma unroll
                for (int bj = 0; bj < 2; ++bj) { const f32x4 v0 = acc[ai][bj][m][0], v1 = acc[ai][bj][m][1];
                    u32x4 w; w.x = pk_f16(v0[0], v0[1]); w.y = pk_f16(v0[2], v0[3]); w.z = pk_f16(v1[0], v1[1]); w.w = pk_f16(v1[2], v1[3]);
                    *(u32x4*)(rowp + bj * HALF) = w; } }
    }
};
struct EpiRes {
    static constexpr bool PERM = false, AFTER_DRAIN = false;
    const float* base; float* out; int ldc;
    __device__ __forceinline__ void operator()(const f32x4 (&acc)[2][2][4][2], const Unit& u, int wr, int wc, int fr, int fq) const {
        const int row0 = u.pm * BM + wr * 64 + fr; const int col0 = u.pn * BM + wc * 32 + 4 * fq;
#pragma unroll
        for (int ai = 0; ai < 2; ++ai)
#pragma unroll
            for (int m = 0; m < 4; ++m) { const size_t off = (size_t)(row0 + ai * HALF + m * 16) * ldc + col0;
#pragma unroll
                for (int bj = 0; bj < 2; ++bj)
#pragma unroll
                    for (int n = 0; n < 2; ++n) { const size_t o = off + bj * HALF + n * 16; const f32x4 b = *(const f32x4*)(base + o); *(f32x4*)(out + o) = b + acc[ai][bj][m][n]; }
                asm volatile("" ::: "memory"); }
    }
};

template <class Epi, class Sched, bool ALIGN_EPI = false, bool SP2 = false>
__device__ __forceinline__ void gemm_phase(PG8_LAS unsigned char* lds, const Gemm g, const Sched& S, const Epi& E, const int wave_) {
    int tid_ = lane_now() + 64 * wave_; const int tid = tid_, wid = wave_, lane = tid & 63, wr = wid >> 2, wc = wid & 3, fr = lane & 15, fq = lane >> 4;
    const int K = g.K, nt = K / BK;
    unsigned voffA[2], voffB[2];
#pragma unroll
    for (int i = 0; i < 2; ++i) { int R, C; stage_rc(tid * 16 + i * 8192, R, C); const int Rb = Epi::PERM ? ((R & ~31) + perm32(R & 31)) : R;
        voffA[i] = (unsigned)(R * K + C) * 2u; voffB[i] = (unsigned)(Rb * K + C) * 2u; }
    const size_t kstep = (size_t)(BK * 2);
    const size_t hstep = (size_t)HALF * K * 2;
    const size_t tstep = 2 * hstep;
    const unsigned ldsw = (unsigned)wid * 1024u;
    const int aoff = lds_byte(wr * 64 + fr, fq * 8), boff = lds_byte(wc * 32 + fr, fq * 8);
#define PG8_SA(b, h) (((b) * 2 + (h)) * HTB)
#define PG8_SB(b, h) ((4 + (b) * 2 + (h)) * HTB)
#define PG8_STAGE(bufoff, gbase, voff) do { _Pragma("unroll") for (int _i = 0; _i < 2; ++_i) \
        __builtin_amdgcn_global_load_lds((const unsigned*)((const char*)(gbase) + (voff)[_i]), (PG8_LAS unsigned*)(lds + (bufoff) + ldsw + _i * 8192), 16, 0, 0); } while (0)
#define PG8_LDA(dst, b, h) do { _Pragma("unroll") for (int m = 0; m < 4; ++m) _Pragma("unroll") for (int k = 0; k < 2; ++k) dst[m][k] = *(const PG8_LAS bf16x8*)(lds + PG8_SA(b, h) + aoff + m * 2048 + k * 1024); } while (0)
#define PG8_LDB(dst, b, h) do { _Pragma("unroll") for (int n = 0; n < 2; ++n) _Pragma("unroll") for (int k = 0; k < 2; ++k) dst[n][k] = *(const PG8_LAS bf16x8*)(lds + PG8_SB(b, h) + boff + n * 2048 + k * 1024); } while (0)
#define PG8_MMA(ai, bj, At, Bt) do { __builtin_amdgcn_s_setprio(1); _Pragma("unroll") for (int m = 0; m < 4; ++m) _Pragma("unroll") for (int n = 0; n < 2; ++n) _Pragma("unroll") for (int k = 0; k < 2; ++k) \
        acc[ai][bj][m][n] = MK_MFMA(Bt[n][k], At[m][k], acc[ai][bj][m][n]); __builtin_amdgcn_s_setprio(0); } while (0)
#define PG8_WAIT_V(n) asm volatile("s_waitcnt vmcnt(" #n ")" ::: "memory")
#define PG8_WAIT_L(n) asm volatile("s_waitcnt lgkmcnt(" #n ")" ::: "memory")
#define PG8_BAR __builtin_amdgcn_s_barrier()
#define PG8_SCHED __builtin_amdgcn_sched_barrier(0)
    Unit cur, nxt; int ui = 0;
    if (!S.next(0, cur)) return;
    f32x4 acc[2][2][4][2];
#pragma unroll
    for (int a = 0; a < 2; ++a)
#pragma unroll
        for (int b = 0; b < 2; ++b)
#pragma unroll
            for (int m = 0; m < 4; ++m)
#pragma unroll
                for (int n = 0; n < 2; ++n) acc[a][b][m][n] = (f32x4){0.f, 0.f, 0.f, 0.f};
    bf16x8 At[4][2], B0[2][2], B1[2][2];
    const char* cA = (const char*)g.A + (size_t)cur.pm * tstep; const char* cB = (const char*)g.Bt + (size_t)cur.pn * tstep;
    S.a_ready(cur);
    if constexpr (SP2) {
        PG8_STAGE(PG8_SB(0, 0), cB, voffB); PG8_STAGE(PG8_SB(0, 1), cB + hstep, voffB); PG8_STAGE(PG8_SA(0, 0), cA, voffA); PG8_STAGE(PG8_SA(0, 1), cA + hstep, voffA);
        if (wr == 1) PG8_BAR;
        PG8_WAIT_V(2); PG8_BAR;
        PG8_STAGE(PG8_SB(1, 0), cB + kstep, voffB); PG8_STAGE(PG8_SA(1, 0), cA + kstep, voffA); PG8_STAGE(PG8_SB(1, 1), cB + hstep + kstep, voffB);
        PG8_WAIT_V(6); PG8_BAR;
    } else {
        PG8_STAGE(PG8_SB(0, 0), cB, voffB); PG8_STAGE(PG8_SA(0, 0), cA, voffA); PG8_STAGE(PG8_SB(0, 1), cB + hstep, voffB); PG8_STAGE(PG8_SA(0, 1), cA + hstep, voffA);
        if (wr == 1) PG8_BAR;
        PG8_WAIT_V(4); PG8_BAR;
        PG8_STAGE(PG8_SB(1, 0), cB + kstep, voffB); PG8_STAGE(PG8_SA(1, 0), cA + kstep, voffA); PG8_STAGE(PG8_SB(1, 1), cB + hstep + kstep, voffB);
        PG8_WAIT_V(6); PG8_BAR;
    }
    for (;;) {
        const bool has_next = S.next(ui + 1, nxt);
        const char* nA = has_next ? (const char*)g.A + (size_t)nxt.pm * tstep : cA; const char* nB = has_next ? (const char*)g.Bt + (size_t)nxt.pn * tstep : cB;
        for (int t = 0; t < nt; t += 2) {
            const bool last = (t == nt - 2);
            const char* a1 = cA + (size_t)(t + 1) * kstep;
            const char* a2 = last ? nA : cA + (size_t)(t + 2) * kstep; const char* b2 = last ? nB : cB + (size_t)(t + 2) * kstep;
            const char* a3 = a2 + kstep; const char* b3 = b2 + kstep;
            if (last && has_next) S.a_ready(nxt);
            if constexpr (SP2) {
            PG8_LDB(B0, 0, 0); PG8_LDB(B1, 0, 1); PG8_SCHED; PG8_LDA(At, 0, 0); PG8_STAGE(PG8_SA(1, 1), a1 + hstep, voffA);
            PG8_WAIT_V(8); PG8_WAIT_L(0); PG8_BAR; PG8_MMA(0, 0, At, B0); PG8_MMA(0, 1, At, B1); PG8_BAR; PG8_SCHED;
            PG8_LDA(At, 0, 1); PG8_STAGE(PG8_SB(0, 0), b2, voffB); PG8_STAGE(PG8_SB(0, 1), b2 + hstep, voffB); PG8_STAGE(PG8_SA(0, 0), a2, voffA);
            PG8_WAIT_V(8); PG8_WAIT_L(0); PG8_BAR; PG8_MMA(1, 0, At, B0); PG8_MMA(1, 1, At, B1); PG8_BAR; PG8_SCHED;
            PG8_LDB(B0, 1, 0); PG8_LDB(B1, 1, 1); PG8_SCHED; PG8_LDA(At, 1, 0); PG8_STAGE(PG8_SA(0, 1), a2 + hstep, voffA);
            PG8_WAIT_V(8); PG8_WAIT_L(0); PG8_BAR; PG8_MMA(0, 0, At, B0); PG8_MMA(0, 1, At, B1); PG8_BAR; PG8_SCHED;
            PG8_LDA(At, 1, 1); PG8_STAGE(PG8_SB(1, 0), b3, voffB); PG8_STAGE(PG8_SB(1, 1), b3 + hstep, voffB); PG8_STAGE(PG8_SA(1, 0), a3, voffA);
            PG8_WAIT_V(8); PG8_WAIT_L(0); PG8_BAR; PG8_MMA(1, 0, At, B0); PG8_MMA(1, 1, At, B1); PG8_BAR; PG8_SCHED;
            } else {
            PG8_LDB(B0, 0, 0); PG8_SCHED; PG8_LDA(At, 0, 0); PG8_STAGE(PG8_SA(1, 1), a1 + hstep, voffA);
            PG8_WAIT_L(8); PG8_BAR; PG8_WAIT_L(0); PG8_MMA(0, 0, At, B0); PG8_BAR; PG8_SCHED;
            PG8_LDB(B1, 0, 1); PG8_STAGE(PG8_SB(0, 0), b2, voffB);
            PG8_BAR; PG8_WAIT_L(0); PG8_MMA(0, 1, At, B1); PG8_BAR;
            PG8_LDA(At, 0, 1); PG8_STAGE(PG8_SA(0, 0), a2, voffA);
            PG8_BAR; PG8_WAIT_L(0); PG8_MMA(1, 0, At, B0); PG8_BAR; PG8_SCHED;
            PG8_STAGE(PG8_SB(0, 1), b2 + hstep, voffB);
            PG8_WAIT_V(6); PG8_BAR; PG8_MMA(1, 1, At, B1); PG8_BAR;
            PG8_LDB(B0, 1, 0); PG8_SCHED; PG8_LDA(At, 1, 0); PG8_STAGE(PG8_SA(0, 1), a2 + hstep, voffA);
            PG8_WAIT_L(8); PG8_BAR; PG8_WAIT_L(0); PG8_MMA(0, 0, At, B0); PG8_BAR; PG8_SCHED;
            PG8_LDB(B1, 1, 1); PG8_STAGE(PG8_SB(1, 0), b3, voffB);
            PG8_BAR; PG8_WAIT_L(0); PG8_MMA(0, 1, At, B1); PG8_BAR;
            PG8_LDA(At, 1, 1); PG8_STAGE(PG8_SA(1, 0), a3, voffA);
            PG8_BAR; PG8_WAIT_L(0); PG8_MMA(1, 0, At, B0); PG8_BAR; PG8_SCHED;
            PG8_STAGE(PG8_SB(1, 1), b3 + hstep, voffB);
            PG8_WAIT_V(6); PG8_BAR; PG8_MMA(1, 1, At, B1); PG8_BAR;
            }
        }
        if constexpr (ALIGN_EPI) { if (wr == 0) PG8_BAR; }
        if constexpr (!Epi::AFTER_DRAIN) { E(acc, cur, wr, wc, fr, fq); S.done(cur); }
        if (!has_next) break;
#pragma unroll
        for (int a = 0; a < 2; ++a)
#pragma unroll
            for (int b = 0; b < 2; ++b)
#pragma unroll
                for (int m = 0; m < 4; ++m)
#pragma unroll
                    for (int n = 0; n < 2; ++n) acc[a][b][m][n] = (f32x4){0.f, 0.f, 0.f, 0.f};
        cur = nxt; cA = nA; cB = nB; ++ui;
        if constexpr (ALIGN_EPI) { if (wr == 1) PG8_BAR; }
    }
    PG8_WAIT_V(0);
    if constexpr (!ALIGN_EPI) { if (wr == 0) PG8_BAR; }
    PG8_BAR;
    if constexpr (Epi::AFTER_DRAIN) { E.fused(acc, cur, wr, wc, fr, fq, lds, wid, lane); S.done(cur); }
#undef PG8_SA
#undef PG8_SB
#undef PG8_STAGE
#undef PG8_LDA
#undef PG8_LDB
#undef PG8_MMA
#undef PG8_WAIT_V
#undef PG8_WAIT_L
#undef PG8_BAR
#undef PG8_SCHED
}
}

constexpr int BATCH = 2, SEQ = 8192, DM = 1024, DEPTH = 2, M = BATCH * SEQ;
constexpr int RW_H = 6, HD = 64, RW_W = 384, RW_SHIFT = 1280;
constexpr int NIN = 3712, NU = 3840;
constexpr int C_R = 0, C_K = 384, C_V = 768, C_WL = 1152, C_AL = 1216, C_RWZ = 1280, C_HGQ = 1664, C_HGF = 2048, C_HGI = 2432, C_HGZ = 2816, C_LRUX = 3200, C_LRUZ = 3456;
constexpr int CH = 64;
constexpr int NWAVES = 8, NT = NWAVES * 64;
constexpr int LDS_BYTES = 147456;
constexpr size_t MiB = 1u << 20;
constexpr size_t WS_WIN = 1 * MiB, WIN_L = (size_t)NU * DM * 2;
constexpr size_t WS_WOUT = 16 * MiB, WOUT_L = (size_t)DM * DM * 2;
constexpr size_t WS_XN = 20 * MiB;
constexpr size_t WS_QT = 20 * MiB;
constexpr size_t WS_PT = 32 * MiB;
constexpr size_t WS_CA = 44 * MiB;
constexpr size_t WS_U = 52 * MiB;
constexpr size_t WS_MIX = 172 * MiB;
constexpr size_t WS_VF = 204 * MiB;
constexpr size_t WS_VP = 216 * MiB;
constexpr size_t WS_RL = 228 * MiB;
constexpr size_t WS_HL = 240 * MiB;
constexpr size_t WS_BON = 252 * MiB;
constexpr size_t WS_DC = WS_BON + 512 * 1024;
constexpr size_t WS_LA = WS_DC + 512 * 1024;
constexpr size_t WS_LH = WS_LA + 256 * 1024;
constexpr size_t WS_END = 254 * MiB;
constexpr int NCH = SEQ / CH;

#define LAS __attribute__((address_space(3)))
typedef float f32x4 __attribute__((ext_vector_type(4)));
typedef unsigned u32x2 __attribute__((ext_vector_type(2)));
typedef unsigned u32x4 __attribute__((ext_vector_type(4)));
typedef _Float16 f16;
typedef _Float16 f16x8 __attribute__((ext_vector_type(8)));
#define LDS_WAIT() asm volatile("s_waitcnt lgkmcnt(0)" ::: "memory")

struct Args { const float* in[27]; float* out; unsigned char* ws; };

__device__ __forceinline__ float wave_sum(float v) {
#pragma unroll
    for (int o = 1; o < 64; o <<= 1) v += __shfl_xor(v, o);
    return v;
}
__device__ __forceinline__ float sigmoidf_(float x) { return 1.0f / (1.0f + __expf(-x)); }
__device__ __forceinline__ float siluf_(float x) { return x / (1.0f + __expf(-x)); }

__device__ __forceinline__ void p0_transpose_item(const float* W, int K, int N, unsigned short* WT, LAS float* scr, int item, int lane) {
    const int nblk = N / 32, kb = item / nblk, nb = item % nblk, k0 = 64 * kb, n0 = 32 * nb;
#pragma unroll 8
    for (int i = 0; i < 32; ++i) { const int kk = 2 * i + (lane >> 5); scr[kk * 33 + (lane & 31)] = W[(size_t)(k0 + kk) * N + n0 + (lane & 31)]; }
    LDS_WAIT(); asm volatile("" ::: "memory");
    const int c = lane & 7;
#pragma unroll
    for (int j = 0; j < 4; ++j) { const int n = (lane >> 3) + 8 * j; const LAS float* s = scr + (8 * c) * 33 + n;
        u32x4 o; o.x = pg8::pk_f16(s[0 * 33], s[1 * 33]); o.y = pg8::pk_f16(s[2 * 33], s[3 * 33]); o.z = pg8::pk_f16(s[4 * 33], s[5 * 33]); o.w = pg8::pk_f16(s[6 * 33], s[7 * 33]);
        *(u32x4*)(WT + (size_t)(n0 + n) * K + k0 + 8 * c) = o; }
    LDS_WAIT(); asm volatile("" ::: "memory");
}
__device__ __forceinline__ void rms_row_f16(const float* xrow, const float* w, unsigned short* orow, int lane) {
    const f32x4* xr = (const f32x4*)xrow + lane; const f32x4* wr = (const f32x4*)w + lane;
    f32x4 v[4]; float s = 0.f;
#pragma unroll
    for (int j = 0; j < 4; ++j) { v[j] = xr[64 * j]; s += (v[j].x * v[j].x + v[j].y * v[j].y) + (v[j].z * v[j].z + v[j].w * v[j].w); }
    const float rs = 1.0f / sqrtf(wave_sum(s) * (1.0f / DM) + 1e-6f);
    u32x2* o8 = (u32x2*)orow + lane;
#pragma unroll
    for (int j = 0; j < 4; ++j) { const f32x4 ww = wr[64 * j]; u32x2 o; o.x = pg8::pk_f16(v[j].x * rs * ww.x, v[j].y * rs * ww.y); o.y = pg8::pk_f16(v[j].z * rs * ww.z, v[j].w * rs * ww.w); o8[64 * j] = o; }
}
__device__ __forceinline__ void rms_row_f32(float* xrow, const float* w, int lane) {
    f32x4* xr = (f32x4*)xrow + lane; const f32x4* wr = (const f32x4*)w + lane;
    f32x4 v[4]; float s = 0.f;
#pragma unroll
    for (int j = 0; j < 4; ++j) { v[j] = xr[64 * j]; s += (v[j].x * v[j].x + v[j].y * v[j].y) + (v[j].z * v[j].z + v[j].w * v[j].w); }
    const float rs = 1.0f / sqrtf(wave_sum(s) * (1.0f / DM) + 1e-6f);
#pragma unroll
    for (int j = 0; j < 4; ++j) { const f32x4 ww = wr[64 * j]; xr[64 * j] = v[j] * rs * ww; }
}


#define SHV(col) ({ const float cur_ = (float)urow[(col)]; const float prev_ = hp ? (float)prow[(col)] : 0.f; cur_ + mu[(col)] * (prev_ - cur_); })

__device__ __forceinline__ void store_row64_f16(f16* dst, const float (&S)[64]) {
#pragma unroll
    for (int q = 0; q < 8; ++q) { u32x4 w; w.x = pg8::pk_f16(S[8 * q], S[8 * q + 1]); w.y = pg8::pk_f16(S[8 * q + 2], S[8 * q + 3]); w.z = pg8::pk_f16(S[8 * q + 4], S[8 * q + 5]); w.w = pg8::pk_f16(S[8 * q + 6], S[8 * q + 7]); *(u32x4*)(dst + 8 * q) = w; }
}

__device__ __forceinline__ void phaseA(const Args& a, int l, int task, LAS unsigned char* lds, int tid) {
    asm volatile("" : "+v"(tid));
    const int lane = tid & 63, wave = __builtin_amdgcn_readfirstlane(tid >> 6);
    const int b = task / NCH, c = task % NCH;
    const f16* U = (const f16*)(a.ws + WS_U); f16* MIX = (f16*)(a.ws + WS_MIX); f16* VF = (f16*)(a.ws + WS_VF); f16* VP = (f16*)(a.ws + WS_VP);
    f16* QT = (f16*)(a.ws + WS_QT); f16* PT = (f16*)(a.ws + WS_PT); f16* RL = (f16*)(a.ws + WS_RL); float* BONG = (float*)(a.ws + WS_BON);
    const int tt = tid >> 3, sub = tid & 7;
    const int t = c * CH + tt; const size_t m = (size_t)b * SEQ + t;
    const f16* urow = U + m * NU; const f16* prow = urow - NU; const bool hp = t > 0;
    {
        const float* mu = a.in[3] + l * RW_SHIFT; const float* w0 = a.in[4] + l * RW_W; const float* w_up = a.in[5] + (size_t)l * 64 * RW_W;
        const float* a0 = a.in[6] + l * RW_W; const float* a_up = a.in[7] + (size_t)l * 64 * RW_W;
        const float* v0 = a.in[8]; const float* v_dn = a.in[9]; const float* v_up = a.in[10];
        const float* k_k = a.in[11] + l * RW_W; const float* k_a = a.in[12] + l * RW_W; const float* r_k = a.in[13] + l * RW_W;
        LAS float* VEC = (LAS float*)lds;
        LAS float* VV = (LAS float*)(lds + 81920);
        LAS float* TW = (LAS float*)(lds + 98304);
        LAS float* TA = (LAS float*)(lds + 114688);
        LAS float* VD = (LAS float*)(lds + 131072);
#pragma unroll 1
        for (int i = 0; i < 8; ++i) { const int ii = sub * 8 + i; TW[tt * 64 + ii] = tanhf(SHV(C_WL + ii)); TA[tt * 64 + ii] = SHV(C_AL + ii); }
        if (l > 0) {
            float vd[4] = {0.f, 0.f, 0.f, 0.f};
#pragma unroll 2
            for (int c2 = 0; c2 < RW_W; ++c2) { const float vs = SHV(C_V + c2);
#pragma unroll
                for (int jj = 0; jj < 4; ++jj) vd[jj] += vs * v_dn[c2 * 32 + sub * 4 + jj]; }
#pragma unroll
            for (int jj = 0; jj < 4; ++jj) VD[tt * 32 + sub * 4 + jj] = vd[jj];
        }
        __syncthreads();
#pragma unroll 1
        for (int h = 0; h < RW_H; ++h) {
            float ssq = 0.f, bon = 0.f;
#pragma unroll 1
            for (int i = 0; i < 8; ++i) {
                const int j = sub * 8 + i, col = h * 64 + j;
                float dw = 0.f, da = 0.f;
#pragma unroll 4
                for (int i2 = 0; i2 < 64; ++i2) { dw += TW[tt * 64 + i2] * w_up[i2 * RW_W + col]; da += TA[tt * 64 + i2] * a_up[i2 * RW_W + col]; }
                const float w = __expf(-0.6065306597126334f * sigmoidf_(w0[col] + dw));
                const float aa = sigmoidf_(a0[col] + da);
                const float rs = SHV(C_R + col), ks = SHV(C_K + col), vs = SHV(C_V + col);
                float vv;
                if (l == 0) { VF[m * RW_W + col] = (f16)vs; vv = vs; }
                else { float g = v0[col];
#pragma unroll 4
                    for (int j2 = 0; j2 < 32; ++j2) g += VD[tt * 32 + j2] * v_up[j2 * RW_W + col];
                    vv = vs + ((float)VF[m * RW_W + col] - vs) * sigmoidf_(g); }
                VP[m * RW_W + col] = (f16)vv;
                const float kv = ks * k_k[col]; VEC[tt * 320 + j] = kv; VEC[tt * 320 + 128 + j] = aa; ssq += kv * kv;
                const float kmod = ks * (1.0f + (aa - 1.0f) * k_a[col]);
                bon += rs * kmod * r_k[col];
                VEC[tt * 320 + 64 + j] = w; VEC[tt * 320 + 192 + j] = kmod; VEC[tt * 320 + 256 + j] = rs; VV[tt * 64 + j] = vv;
            }
            ssq += __shfl_xor(ssq, 1); ssq += __shfl_xor(ssq, 2); ssq += __shfl_xor(ssq, 4);
            bon += __shfl_xor(bon, 1); bon += __shfl_xor(bon, 2); bon += __shfl_xor(bon, 4);
            const float inv = 1.0f / fmaxf(sqrtf(ssq), 1e-12f);
#pragma unroll 1
            for (int i = 0; i < 8; ++i) { const int j = sub * 8 + i; const float kk = VEC[tt * 320 + j] * inv; const float aa = VEC[tt * 320 + 128 + j]; VEC[tt * 320 + j] = -kk; VEC[tt * 320 + 128 + j] = kk * aa; }
            if (sub == 0) BONG[m * 8 + h] = bon;
            __syncthreads();
            const int bh = b * RW_H + h; const int col = h * 64 + lane;
            if (wave < 2) {
                const bool isL = (wave == 0);
                float S[64];
#pragma unroll
                for (int k = 0; k < 64; ++k) S[k] = (!isL && k == lane) ? 1.f : 0.f;
                for (int t2 = 0; t2 < CH; ++t2) {
                    const LAS float* ve = VEC + t2 * 320; const size_t m2 = (size_t)b * SEQ + c * CH + t2;
                    const float vv = isL ? VV[t2 * 64 + lane] : 0.f;
                    float s0 = 0.f, s1 = 0.f, s2 = 0.f, s3 = 0.f;
#pragma unroll
                    for (int k = 0; k < 64; k += 4) { const f32x4 a4 = *(const LAS f32x4*)(ve + k); s0 += S[k] * a4.x; s1 += S[k + 1] * a4.y; s2 += S[k + 2] * a4.z; s3 += S[k + 3] * a4.w; }
                    const float sa = (s0 + s1) + (s2 + s3);
                    float y0 = 0.f, y1 = 0.f, y2 = 0.f, y3 = 0.f;
#pragma unroll
                    for (int k = 0; k < 64; k += 4) {
                        const f32x4 w4 = *(const LAS f32x4*)(ve + 64 + k), b4 = *(const LAS f32x4*)(ve + 128 + k), k4 = *(const LAS f32x4*)(ve + 192 + k), r4 = *(const LAS f32x4*)(ve + 256 + k);
                        S[k] = S[k] * w4.x + (sa * b4.x + vv * k4.x); y0 += S[k] * r4.x;
                        S[k + 1] = S[k + 1] * w4.y + (sa * b4.y + vv * k4.y); y1 += S[k + 1] * r4.y;
                        S[k + 2] = S[k + 2] * w4.z + (sa * b4.z + vv * k4.z); y2 += S[k + 2] * r4.z;
                        S[k + 3] = S[k + 3] * w4.w + (sa * b4.w + vv * k4.w); y3 += S[k + 3] * r4.w;
                        if ((k & 12) == 12) asm volatile("" ::: "memory");
                    }
                    const f16 yo = (f16)((y0 + y1) + (y2 + y3));
                    if (isL) MIX[m2 * DM + col] = yo; else QT[m2 * RW_W + col] = yo;
                }
                if (isL) store_row64_f16(RL + (((size_t)bh * NCH + c) * 64 + lane) * 64, S);
                else { f16* pt = PT + ((size_t)bh * NCH + c) * 4096;
#pragma unroll
                    for (int k = 0; k < 64; ++k) pt[k * 64 + lane] = (f16)S[k]; }
            }
            __syncthreads();
        }
    }
    {
        f16* HL = (f16*)(a.ws + WS_HL); float* DC = (float*)(a.ws + WS_DC);
        const float* lbr = a.in[16];
        LAS float* FQ = (LAS float*)lds;
#pragma unroll 1
        for (int h = 0; h < 6; ++h) {
#pragma unroll 1
            for (int i = 0; i < 8; ++i) { const int j = sub * 8 + i, col = h * 64 + j;
                const float lb = (l == 0) ? 0.f : sigmoidf_(lbr[384 + col] - lbr[col]);
                FQ[tt * 128 + j] = lb + (1.0f - lb) * sigmoidf_((float)urow[C_HGF + col]);
                FQ[tt * 128 + 64 + j] = (float)urow[C_HGQ + col]; }
            __syncthreads();
            const int bh = b * 6 + h;
            if (wave == 0) {
                float S[64]; float dprod = 1.f;
#pragma unroll
                for (int k = 0; k < 64; ++k) S[k] = 0.f;
                const int col = h * 64 + lane;
                for (int t2 = 0; t2 < CH; ++t2) {
                    const LAS float* fq = FQ + t2 * 128; const size_t m2 = (size_t)b * SEQ + c * CH + t2;
                    const float vi = (float)U[m2 * NU + C_HGI + col];
                    dprod *= fq[lane];
                    float o0 = 0.f, o1 = 0.f, o2 = 0.f, o3 = 0.f;
#pragma unroll
                    for (int k = 0; k < 64; k += 4) { const f32x4 f4 = *(const LAS f32x4*)(fq + k), q4 = *(const LAS f32x4*)(fq + 64 + k);
                        S[k] = f4.x * S[k] + (1.0f - f4.x) * vi; o0 += q4.x * S[k];
                        S[k + 1] = f4.y * S[k + 1] + (1.0f - f4.y) * vi; o1 += q4.y * S[k + 1];
                        S[k + 2] = f4.z * S[k + 2] + (1.0f - f4.z) * vi; o2 += q4.z * S[k + 2];
                        S[k + 3] = f4.w * S[k + 3] + (1.0f - f4.w) * vi; o3 += q4.w * S[k + 3]; }
                    MIX[m2 * DM + 384 + col] = (f16)((o0 + o1) + (o2 + o3));
                }
                f16* hl = HL + ((size_t)bh * NCH + c) * 4096;
#pragma unroll
                for (int k = 0; k < 64; ++k) hl[k * 64 + lane] = (f16)S[k];
                DC[((size_t)bh * NCH + c) * 64 + lane] = dprod;
            }
            __syncthreads();
        }
    }
    {
        f16* CA = (f16*)(a.ws + WS_CA); float* LA = (float*)(a.ws + WS_LA); float* LH = (float*)(a.ws + WS_LH);
        const float* cw = a.in[18] + l * 4 * 256; const float* cb = a.in[19] + l * 256;
        const float* ba = a.in[21] + l * 256; const float* bx = a.in[23] + l * 256; const float* lam = a.in[24] + l * 256;
        LAS float* Y = (LAS float*)lds; LAS float* AA = (LAS float*)(lds + 16384); LAS float* UU = (LAS float*)(lds + 32768);
#pragma unroll 1
        for (int g = 0; g < 4; ++g) {
            const float* wa = a.in[20] + (size_t)(l * 4 + g) * 4096; const float* wx = a.in[22] + (size_t)(l * 4 + g) * 4096;
#pragma unroll 1
            for (int i = 0; i < 8; ++i) { const int j = sub * 8 + i, ch = g * 64 + j; float y = cb[ch];
#pragma unroll
                for (int jj = 0; jj < 4; ++jj) { const int ts = t - 3 + jj; if (ts >= 0) y += cw[jj * 256 + ch] * (float)U[((size_t)b * SEQ + ts) * NU + C_LRUX + ch]; }
                Y[tt * 64 + j] = y; }
            __syncthreads();
#pragma unroll 1
            for (int i = 0; i < 8; ++i) { const int j = sub * 8 + i, ch = g * 64 + j; float ra = ba[ch], rx = bx[ch];
#pragma unroll 4
                for (int i2 = 0; i2 < 64; ++i2) { const float yv = Y[tt * 64 + i2]; ra += yv * wa[i2 * 64 + j]; rx += yv * wx[i2 * 64 + j]; }
                const float r = sigmoidf_(ra), ig = sigmoidf_(rx);
                const float la = -8.0f * r * log1pf(expf(-lam[ch]));
                AA[tt * 64 + j] = expf(la); UU[tt * 64 + j] = sqrtf(-expm1f(2.0f * la)) * (ig * Y[tt * 64 + j]); }
            __syncthreads();
            if (wave == 0) {
                const int ch = g * 64 + lane; float hst = 0.f, ap = 1.f;
                for (int t2 = 0; t2 < CH; ++t2) { const size_t m2 = (size_t)b * SEQ + c * CH + t2; const float av = AA[t2 * 64 + lane];
                    hst = av * hst + UU[t2 * 64 + lane]; ap *= av;
                    MIX[m2 * DM + 768 + ch] = (f16)hst; CA[m2 * 256 + ch] = (f16)ap; }
                LA[((size_t)b * NCH + c) * 256 + ch] = ap; LH[((size_t)b * NCH + c) * 256 + ch] = hst;
            }
            __syncthreads();
        }
    }
}

__device__ __forceinline__ void phaseB(const Args& a, LAS unsigned char* lds, int tid) {
    asm volatile("" : "+v"(tid));
    const int lane = tid & 63, wave = __builtin_amdgcn_readfirstlane(tid >> 6);
    const int bx = blockIdx.x;
    if (bx < 12) {
        const int bh = bx;
        f16* PT = (f16*)(a.ws + WS_PT); f16* RL = (f16*)(a.ws + WS_RL);
        LAS float* PTL = (LAS float*)lds;
        LAS float* SN = (LAS float*)(lds + 16384);
        float S[64];
#pragma unroll
        for (int k = 0; k < 64; ++k) S[k] = 0.f;
        for (int c = 0; c < NCH; ++c) {
            const f16* pt = PT + ((size_t)bh * NCH + c) * 4096; f16* rl = RL + ((size_t)bh * NCH + c) * 4096;
            { const f16x8 p8 = *(const f16x8*)(pt + tid * 8);
#pragma unroll
              for (int j = 0; j < 8; ++j) PTL[tid * 8 + j] = (float)p8[j]; }
            const f16x8 l8 = *(const f16x8*)(rl + lane * 64 + wave * 8);
            asm volatile("s_waitcnt vmcnt(0)" ::: "memory");
            __syncthreads();
            if (wave == 0) store_row64_f16(rl + lane * 64, S);
#pragma unroll
            for (int j = 0; j < 8; ++j) SN[lane * 65 + wave * 8 + j] = (float)l8[j];
#pragma unroll 1
            for (int j = 0; j < 8; ++j) { float acc = SN[lane * 65 + wave * 8 + j];
                const LAS float* pr = PTL + (wave * 8 + j) * 64;
                float a0 = 0.f, a1 = 0.f, a2 = 0.f, a3 = 0.f;
#pragma unroll
                for (int k = 0; k < 64; k += 4) { const f32x4 p4 = *(const LAS f32x4*)(pr + k); a0 += S[k] * p4.x; a1 += S[k + 1] * p4.y; a2 += S[k + 2] * p4.z; a3 += S[k + 3] * p4.w; }
                SN[lane * 65 + wave * 8 + j] = acc + ((a0 + a1) + (a2 + a3)); }
            __syncthreads();
#pragma unroll
            for (int k = 0; k < 64; ++k) S[k] = SN[lane * 65 + k];
            __syncthreads();
        }
    } else if (bx < 12 + 96) {
        const int idx = (bx - 12) * NT + tid; const int bh = idx >> 12, e = idx & 4095, k = e >> 6;
        f16* HL = (f16*)(a.ws + WS_HL); const float* DC = (const float*)(a.ws + WS_DC);
        float s = 0.f;
        for (int c = 0; c < NCH; ++c) { f16* p = HL + ((size_t)bh * NCH + c) * 4096 + e; const float Lc = (float)*p; const float d = DC[((size_t)bh * NCH + c) * 64 + k];
            *p = (f16)s; s = d * s + Lc; }
    } else if (bx == 12 + 96) {
        const int bb = tid >> 8, ch = tid & 255; const float* LA = (const float*)(a.ws + WS_LA); float* LH = (float*)(a.ws + WS_LH);
        float cy = 0.f;
        for (int c = 0; c < NCH; ++c) { const size_t o = ((size_t)bb * NCH + c) * 256 + ch; const float A = LA[o], H = LH[o]; LH[o] = cy; cy = A * cy + H; }
    }
}

__device__ __forceinline__ void phaseC(const Args& a, int l, int task, LAS unsigned char* lds, int tid) {
    asm volatile("" : "+v"(tid));
    const int lane = tid & 63, wave = __builtin_amdgcn_readfirstlane(tid >> 6);
    const int b = task / NCH, c = task % NCH;
    const f16* U = (const f16*)(a.ws + WS_U); f16* MIX = (f16*)(a.ws + WS_MIX); const f16* VP = (const f16*)(a.ws + WS_VP);
    const f16* QT = (const f16*)(a.ws + WS_QT); const f16* RL = (const f16*)(a.ws + WS_RL); const float* BONG = (const float*)(a.ws + WS_BON);
    const int tt = tid >> 3, sub = tid & 7;
    const size_t m = (size_t)b * SEQ + c * CH + tt;
    const f16* urow = U + m * NU;
    {
        const float* ln_w = a.in[14] + l * RW_W; const float* ln_b = a.in[15] + l * RW_W;
        LAS float* SL = (LAS float*)lds;
#pragma unroll 1
        for (int h = 0; h < RW_H; ++h) {
            const int bh = b * RW_H + h;
            { const f16x8 s8 = *(const f16x8*)(RL + ((size_t)bh * NCH + c) * 4096 + tid * 8); const int v = tid >> 3, k0 = (tid & 7) * 8;
#pragma unroll
              for (int j = 0; j < 8; ++j) SL[v * 68 + k0 + j] = (float)s8[j]; }
            float q[64];
#pragma unroll
            for (int qq = 0; qq < 8; ++qq) { const f16x8 q8 = *(const f16x8*)(QT + m * RW_W + h * 64 + qq * 8);
#pragma unroll
                for (int j = 0; j < 8; ++j) q[qq * 8 + j] = (float)q8[j]; }
            __syncthreads();
            const f16x8 yl = *(const f16x8*)(MIX + m * DM + h * 64 + sub * 8);
            LAS float* YS = (LAS float*)(lds + 20480) + tid * 9;
#pragma unroll
            for (int i = 0; i < 8; ++i) YS[i] = (float)yl[i];
#pragma unroll 1
            for (int i = 0; i < 8; ++i) { const LAS float* sr = SL + (sub * 8 + i) * 68;
                float a0 = 0.f, a1 = 0.f, a2 = 0.f, a3 = 0.f;
#pragma unroll
                for (int k = 0; k < 64; k += 4) { const f32x4 s4 = *(const LAS f32x4*)(sr + k); a0 += q[k] * s4.x; a1 += q[k + 1] * s4.y; a2 += q[k + 2] * s4.z; a3 += q[k + 3] * s4.w; }
                YS[i] += (a0 + a1) + (a2 + a3); }
            float y[8]; float sm = 0.f;
#pragma unroll
            for (int i = 0; i < 8; ++i) { y[i] = YS[i]; sm += y[i]; }
            sm += __shfl_xor(sm, 1); sm += __shfl_xor(sm, 2); sm += __shfl_xor(sm, 4);
            const float mean = sm * (1.0f / 64.0f); float vr = 0.f;
#pragma unroll
            for (int i = 0; i < 8; ++i) { const float d = y[i] - mean; vr += d * d; }
            vr += __shfl_xor(vr, 1); vr += __shfl_xor(vr, 2); vr += __shfl_xor(vr, 4);
            const float rstd = 1.0f / sqrtf(vr * (1.0f / 64.0f) + 64e-5f);
            const float bon = BONG[m * 8 + h];
            const f16x8 vp = *(const f16x8*)(VP + m * RW_W + h * 64 + sub * 8); const f16x8 z8 = *(const f16x8*)(urow + C_RWZ + h * 64 + sub * 8);
            float o[8];
#pragma unroll
            for (int i = 0; i < 8; ++i) { const int col = h * 64 + sub * 8 + i; o[i] = ((y[i] - mean) * rstd * ln_w[col] + ln_b[col] + bon * (float)vp[i]) * siluf_((float)z8[i]); }
            u32x4 w; w.x = pg8::pk_f16(o[0], o[1]); w.y = pg8::pk_f16(o[2], o[3]); w.z = pg8::pk_f16(o[4], o[5]); w.w = pg8::pk_f16(o[6], o[7]);
            *(u32x4*)(MIX + m * DM + h * 64 + sub * 8) = w;
            __syncthreads();
        }
    }
    {
        const f16* HL = (const f16*)(a.ws + WS_HL); const float* lbr = a.in[16]; const float* nw = a.in[17] + l * 384;
        LAS float* SL = (LAS float*)lds;
        LAS float* QE = (LAS float*)(lds + 16384);
#pragma unroll 1
        for (int h = 0; h < 6; ++h) {
            const int bh = b * 6 + h;
            { const f16x8 s8 = *(const f16x8*)(HL + ((size_t)bh * NCH + c) * 4096 + tid * 8);
#pragma unroll
              for (int j = 0; j < 8; ++j) SL[tid * 8 + j] = (float)s8[j]; }
            if (wave == 0) {
                const int col = h * 64 + lane; const float lb = (l == 0) ? 0.f : sigmoidf_(lbr[384 + col] - lbr[col]); float cp = 1.f;
                for (int t2 = 0; t2 < CH; ++t2) { const f16* ur = U + ((size_t)b * SEQ + c * CH + t2) * NU;
                    cp *= lb + (1.0f - lb) * sigmoidf_((float)ur[C_HGF + col]); QE[t2 * 68 + lane] = (float)ur[C_HGQ + col] * cp; }
            }
            __syncthreads();
            const f16x8 ol = *(const f16x8*)(MIX + m * DM + 384 + h * 64 + sub * 8);
            float o[8];
#pragma unroll
            for (int i = 0; i < 8; ++i) o[i] = (float)ol[i];
#pragma unroll 8
            for (int k = 0; k < 64; ++k) { const float qe = QE[tt * 68 + k]; const f32x4 s0 = *(const LAS f32x4*)(SL + k * 64 + sub * 8), s1 = *(const LAS f32x4*)(SL + k * 64 + sub * 8 + 4);
                o[0] += qe * s0.x; o[1] += qe * s0.y; o[2] += qe * s0.z; o[3] += qe * s0.w; o[4] += qe * s1.x; o[5] += qe * s1.y; o[6] += qe * s1.z; o[7] += qe * s1.w; }
            float ss = 0.f;
#pragma unroll
            for (int i = 0; i < 8; ++i) ss += o[i] * o[i];
            ss += __shfl_xor(ss, 1); ss += __shfl_xor(ss, 2); ss += __shfl_xor(ss, 4);
            const float rs = 1.0f / sqrtf(ss * (1.0f / 64.0f) + 1e-6f);
            const f16x8 z8 = *(const f16x8*)(urow + C_HGZ + h * 64 + sub * 8);
#pragma unroll
            for (int i = 0; i < 8; ++i) o[i] = o[i] * rs * nw[h * 64 + sub * 8 + i] * siluf_((float)z8[i]);
            u32x4 w; w.x = pg8::pk_f16(o[0], o[1]); w.y = pg8::pk_f16(o[2], o[3]); w.z = pg8::pk_f16(o[4], o[5]); w.w = pg8::pk_f16(o[6], o[7]);
            *(u32x4*)(MIX + m * DM + 384 + h * 64 + sub * 8) = w;
            __syncthreads();
        }
    }
    {
        const f16* CA = (const f16*)(a.ws + WS_CA); const float* LH = (const float*)(a.ws + WS_LH);
#pragma unroll 1
        for (int q = 0; q < 4; ++q) { const int ch0 = q * 64 + sub * 8;
            const f16x8 hl = *(const f16x8*)(MIX + m * DM + 768 + ch0), ca = *(const f16x8*)(CA + m * 256 + ch0), z8 = *(const f16x8*)(urow + C_LRUZ + ch0);
            float o[8];
#pragma unroll
            for (int i = 0; i < 8; ++i) o[i] = ((float)hl[i] + (float)ca[i] * LH[((size_t)b * NCH + c) * 256 + ch0 + i]) * siluf_((float)z8[i]);
            u32x4 w; w.x = pg8::pk_f16(o[0], o[1]); w.y = pg8::pk_f16(o[2], o[3]); w.z = pg8::pk_f16(o[4], o[5]); w.w = pg8::pk_f16(o[6], o[7]);
            *(u32x4*)(MIX + m * DM + 768 + ch0) = w; }
    }
}
__global__ void __launch_bounds__(NT, 2) fwd(Args args) {
    extern __shared__ __attribute__((aligned(16))) unsigned char lds_raw[];
    LAS unsigned char* lds = (LAS unsigned char*)lds_raw;
    cg::grid_group grid = cg::this_grid();
    const int wave = __builtin_amdgcn_readfirstlane((int)threadIdx.x >> 6);
#define TID_NOW() (wave * 64 + lane_now())
    const int tid = TID_NOW(); const int lane = tid & 63;
    const int G = gridDim.x, gw = blockIdx.x * NWAVES + wave, NGW = G * NWAVES;
    unsigned char* ws = args.ws;
    unsigned short* XN = (unsigned short*)(ws + WS_XN);
    {
        LAS float* scr = (LAS float*)(lds + wave * 16384);
        constexpr int I_IN = (DM / 64) * (NIN / 32), I_OUT = (DM / 64) * (DM / 32), NITEMS = DEPTH * (I_IN + I_OUT);
        for (int it = gw; it < NITEMS; it += NGW) {
            int r = it; const int l = r / (I_IN + I_OUT); r -= l * (I_IN + I_OUT);
            if (r < I_IN) p0_transpose_item(args.in[2] + (size_t)l * DM * NIN, DM, NIN, (unsigned short*)(ws + WS_WIN + l * WIN_L), scr, r, lane);
            else p0_transpose_item(args.in[25] + (size_t)l * DM * DM, DM, DM, (unsigned short*)(ws + WS_WOUT + l * WOUT_L), scr, r - I_IN, lane);
        }
        for (int i = gw; i < DEPTH * (NU - NIN) * DM * 2 / 1024; i += NGW) { const int l = i / ((NU - NIN) * DM * 2 / 1024), r = i % ((NU - NIN) * DM * 2 / 1024);
            *(u32x4*)(ws + WS_WIN + l * WIN_L + (size_t)NIN * DM * 2 + (size_t)r * 1024 + lane * 16) = (u32x4){0u, 0u, 0u, 0u}; }
        for (int m = gw; m < M; m += NGW) rms_row_f16(args.in[0] + (size_t)m * DM, args.in[1], XN + (size_t)m * DM, lane);
    }
    grid.sync();
#pragma unroll 1
    for (int l = 0; l < DEPTH; ++l) {
        { pg8::Gemm g{XN, (const unsigned short*)(ws + WS_WIN + l * WIN_L), M, NU, DM}; pg8::StaticOrder S; S.init(M, NU, G, (int)blockIdx.x);
          pg8::EpiF16 E{(unsigned short*)(ws + WS_U), NU};
          pg8::gemm_phase<pg8::EpiF16, pg8::StaticOrder, true, true>(lds, g, S, E, wave); }
        grid.sync();
        for (int task = blockIdx.x; task < BATCH * NCH; task += G) phaseA(args, l, task, lds, TID_NOW());
        grid.sync();
        phaseB(args, lds, TID_NOW());
        grid.sync();
        for (int task = blockIdx.x; task < BATCH * NCH; task += G) phaseC(args, l, task, lds, TID_NOW());
        grid.sync();
        { pg8::Gemm g{(const unsigned short*)(ws + WS_MIX), (const unsigned short*)(ws + WS_WOUT + l * WOUT_L), M, DM, DM}; pg8::StaticOrder S; S.init(M, DM, G, (int)blockIdx.x);
          pg8::EpiRes E{l == 0 ? args.in[0] : args.out, args.out, DM};
          pg8::gemm_phase<pg8::EpiRes, pg8::StaticOrder, true, true>(lds, g, S, E, wave); }
        grid.sync();
        { int ln = TID_NOW() & 63; asm volatile("" : "+v"(ln));
          if (l + 1 < DEPTH) { for (int m = gw; m < M; m += NGW) rms_row_f16(args.out + (size_t)m * DM, args.in[1] + (l + 1) * DM, XN + (size_t)m * DM, ln); grid.sync(); }
          else { for (int m = gw; m < M; m += NGW) rms_row_f32(args.out + (size_t)m * DM, args.in[26], ln); } }
    }
}

extern "C" void kernel_launch(void* const* d_in, const int* in_sizes, int n_in, void* d_out, int out_size, void* d_ws, size_t ws_size, hipStream_t stream) {
    static int grid = 0;
    if (grid == 0) {
        if (n_in != 27 || in_sizes[0] != M * DM || out_size != M * DM || ws_size < WS_END) { fprintf(stderr, "kernel_launch: unexpected problem: n_in %d in0 %d out %d ws %zu\n", n_in, n_in > 0 ? in_sizes[0] : -1, out_size, ws_size); grid = -1; return; }
        int dev = 0, cus = 0, per_cu = 0;
        hipGetDevice(&dev); hipDeviceGetAttribute(&cus, hipDeviceAttributeMultiprocessorCount, dev);
        if (hipFuncSetAttribute((const void*)fwd, hipFuncAttributeMaxDynamicSharedMemorySize, LDS_BYTES) != hipSuccess) { fprintf(stderr, "kernel_launch: hipFuncSetAttribute failed\n"); grid = -1; return; }
        if (hipOccupancyMaxActiveBlocksPerMultiprocessor(&per_cu, (const void*)fwd, NT, LDS_BYTES) != hipSuccess || per_cu < 1) { fprintf(stderr, "kernel_launch: occupancy query failed (%d)\n", per_cu); grid = -1; return; }
        grid = cus * per_cu;
    }
    if (grid < 0) return;
    Args a{};
    for (int i = 0; i < 27; ++i) a.in[i] = (const float*)d_in[i];
    a.out = (float*)d_out; a.ws = (unsigned char*)d_ws;
    void* kargs[] = {&a};
    hipError_t e = hipLaunchCooperativeKernel((const void*)fwd, dim3(grid), dim3(NT), kargs, LDS_BYTES, stream);
    if (e != hipSuccess) fprintf(stderr, "cooperative launch failed: %s (grid %d)\n", hipGetErrorString(e), grid);
}
```

```cpp
#include <hip/hip_runtime.h>
#include <hip/hip_cooperative_groups.h>
#include <cstdio>
#include <cstdint>
namespace cg = cooperative_groups;
typedef _Float16 f16x8_t __attribute__((ext_vector_type(8)));
#define MK_MFMA(a, b, c) __builtin_amdgcn_mfma_f32_16x16x32_f16(__builtin_bit_cast(f16x8_t, (a)), __builtin_bit_cast(f16x8_t, (b)), (c), 0, 0, 0)
__device__ __forceinline__ int lane_now() { int z; asm volatile("v_mbcnt_lo_u32_b32 %0, -1, 0\n\tv_mbcnt_hi_u32_b32 %0, -1, %0" : "=v"(z)); return z; }
namespace pg8 {
#define PG8_LAS __attribute__((address_space(3)))
typedef unsigned short bf16_t;
typedef short bf16x8 __attribute__((ext_vector_type(8)));
typedef float f32x4 __attribute__((ext_vector_type(4)));
typedef unsigned u32x4 __attribute__((ext_vector_type(4)));
constexpr int BM = 256, BK = 64, HALF = 128, HTB = HALF * BK * 2  , STAGE_BYTES = 8 * HTB, NXCD = 8, WGM = 8;

__host__ __device__ __forceinline__ int lds_byte(int r, int c) { const int st = (r >> 4) * 2 + (c >> 5), rr = r & 15, cc = c & 31, ob = rr * 64 + cc * 2; return st * 1024 + (ob ^ (((ob >> 9) & 1) << 5)); }
__host__ __device__ __forceinline__ void stage_rc(int b, int& R, int& C) { const int st = b / 1024, sb = b % 1024, swz = sb ^ (((sb >> 9) & 1) << 5); R = (st >> 1) * 16 + swz / 64; C = (st & 1) * 32 + (swz % 64) / 2; }
__host__ __device__ __forceinline__ int perm32(int rho) { const int n = rho >> 4, i = rho & 15; return 8 * (i >> 2) + 4 * n + (i & 3); }

struct Unit { int pm, pn; };
struct Gemm { const bf16_t* A; const bf16_t* Bt; int M, N, K; };

struct StaticOrder {
    int nM, nN, nwg, G, c;
    __host__ __device__ void init(int M, int N, int G_, int c_) { nM = M / BM; nN = N / BM; nwg = nM * nN; G = G_; c = c_; }
    __host__ __device__ bool next(int i, Unit& u) const {
        const long L = (long)i * G + c; if (L >= nwg) return false;
        int wgid = (int)L; { const int q = nwg / NXCD, r = nwg % NXCD, xcd = wgid % NXCD, off = wgid / NXCD; wgid = (xcd < r ? xcd * (q + 1) : r * (q + 1) + (xcd - r) * q) + off; }
        const int nig = WGM * nN, gid = wgid / nig, fm = gid * WGM, gsz = (nM - fm) < WGM ? (nM - fm) : WGM;
        u.pm = fm + ((wgid % nig) % gsz); u.pn = (wgid % nig) / gsz; return true;
    }
    __device__ __forceinline__ void a_ready(const Unit&) const {}
    __device__ __forceinline__ void done(const Unit&) const {}
};

__device__ __forceinline__ unsigned pk_f16(float lo, float hi) { typedef _Float16 h2 __attribute__((ext_vector_type(2))); h2 v; v.x = (_Float16)lo; v.y = (_Float16)hi; return __builtin_bit_cast(unsigned, v); }
struct EpiF16 {
    static constexpr bool PERM = true, AFTER_DRAIN = false;
    bf16_t* O; int ldc;
    __device__ __forceinline__ void operator()(const f32x4 (&acc)[2][2][4][2], const Unit& u, int wr, int wc, int fr, int fq) const {
        const int row0 = u.pm * BM + wr * 64 + fr; const int col0 = u.pn * BM + wc * 32 + 8 * fq;
#pragma unroll
        for (int ai = 0; ai < 2; ++ai)
#pragma unroll
            for (int m = 0; m < 4; ++m) { bf16_t* rowp = O + (size_t)(row0 + ai * HALF + m * 16) * ldc + col0;
#pragma unroll
                for (int bj = 0; bj < 2; ++bj) { const f32x4 v0 = acc[ai][bj][m][0], v1 = acc[ai][bj][m][1];
                    u32x4 w; w.x = pk_f16(v0[0], v0[1]); w.y = pk_f16(v0[2], v0[3]); w.z = pk_f16(v1[0], v1[1]); w.w = pk_f16(v1[2], v1[3]);
                    *(u32x4*)(rowp + bj * HALF) = w; } }
    }
};
struct EpiRes {
    static constexpr bool PERM = false, AFTER_DRAIN = false;
    const float* base; float* out; int ldc;
    __device__ __forceinline__ void operator()(const f32x4 (&acc)[2][2][4][2], const Unit& u, int wr, int wc, int fr, int fq) const {
        const int row0 = u.pm * BM + wr * 64 + fr; const int col0 = u.pn * BM + wc * 32 + 4 * fq;
#pragma unroll
        for (int ai = 0; ai < 2; ++ai)
#pragma unroll
            for (int m = 0; m < 4; ++m) { const size_t off = (size_t)(row0 + ai * HALF + m * 16) * ldc + col0;
#pragma unroll
                for (int bj = 0; bj < 2; ++bj)
#pragma unroll
                    for (int n = 0; n < 2; ++n) { const size_t o = off + bj * HALF + n * 16; const f32x4 b = *(const f32x4*)(base + o); *(f32x4*)(out + o) = b + acc[ai][bj][m][n]; }
                asm volatile("" ::: "memory"); }
    }
};

template <class Epi, class Sched, bool ALIGN_EPI = false, bool SP2 = false>
__device__ __forceinline__ void gemm_phase(PG8_LAS unsigned char* lds, const Gemm g, const Sched& S, const Epi& E, const int wave_) {
    int tid_ = lane_now() + 64 * wave_; const int tid = tid_, wid = wave_, lane = tid & 63, wr = wid >> 2, wc = wid & 3, fr = lane & 15, fq = lane >> 4;
    const int K = g.K, nt = K / BK;
    unsigned voffA[2], voffB[2];
#pragma unroll
    for (int i = 0; i < 2; ++i) { int R, C; stage_rc(tid * 16 + i * 8192, R, C); const int Rb = Epi::PERM ? ((R & ~31) + perm32(R & 31)) : R;
        voffA[i] = (unsigned)(R * K + C) * 2u; voffB[i] = (unsigned)(Rb * K + C) * 2u; }
    const size_t kstep = (size_t)(BK * 2);
    const size_t hstep = (size_t)HALF * K * 2;
    const size_t tstep = 2 * hstep;
    const unsigned ldsw = (unsigned)wid * 1024u;
    const int aoff = lds_byte(wr * 64 + fr, fq * 8), boff = lds_byte(wc * 32 + fr, fq * 8);
#define PG8_SA(b, h) (((b) * 2 + (h)) * HTB)
#define PG8_SB(b, h) ((4 + (b) * 2 + (h)) * HTB)
#define PG8_STAGE(bufoff, gbase, voff) do { _Pragma("unroll") for (int _i = 0; _i < 2; ++_i) \
        __builtin_amdgcn_global_load_lds((const unsigned*)((const char*)(gbase) + (voff)[_i]), (PG8_LAS unsigned*)(lds + (bufoff) + ldsw + _i * 8192), 16, 0, 0); } while (0)
#define PG8_LDA(dst, b, h) do { _Pragma("unroll") for (int m = 0; m < 4; ++m) _Pragma("unroll") for (int k = 0; k < 2; ++k) dst[m][k] = *(const PG8_LAS bf16x8*)(lds + PG8_SA(b, h) + aoff + m * 2048 + k * 1024); } while (0)
#define PG8_LDB(dst, b, h) do { _Pragma("unroll") for (int n = 0; n < 2; ++n) _Pragma("unroll") for (int k = 0; k < 2; ++k) dst[n][k] = *(const PG8_LAS bf16x8*)(lds + PG8_SB(b, h) + boff + n * 2048 + k * 1024); } while (0)
#define PG8_MMA(ai, bj, At, Bt) do { __builtin_amdgcn_s_setprio(1); _Pragma("unroll") for (int m = 0; m < 4; ++m) _Pragma("unroll") for (int n = 0; n < 2; ++n) _Pragma("unroll") for (int k = 0; k < 2; ++k) \
        acc[ai][bj][m][n] = MK_MFMA(Bt[n][k], At[m][k], acc[ai][bj][m][n]); __builtin_amdgcn_s_setprio(0); } while (0)
#define PG8_WAIT_V(n) asm volatile("s_waitcnt vmcnt(" #n ")" ::: "memory")
#define PG8_WAIT_L(n) asm volatile("s_waitcnt lgkmcnt(" #n ")" ::: "memory")
#define PG8_BAR __builtin_amdgcn_s_barrier()
#define PG8_SCHED __builtin_amdgcn_sched_barrier(0)
    Unit cur, nxt; int ui = 0;
    if (!S.next(0, cur)) return;
    f32x4 acc[2][2][4][2];
#pragma unroll
    for (int a = 0; a < 2; ++a)
#pragma unroll
        for (int b = 0; b < 2; ++b)
#pragma unroll
            for (int m = 0; m < 4; ++m)
#pragma unroll
                for (int n = 0; n < 2; ++n) acc[a][b][m][n] = (f32x4){0.f, 0.f, 0.f, 0.f};
    bf16x8 At[4][2], B0[2][2], B1[2][2];
    const char* cA = (const char*)g.A + (size_t)cur.pm * tstep; const char* cB = (const char*)g.Bt + (size_t)cur.pn * tstep;
    S.a_ready(cur);
    if constexpr (SP2) {
        PG8_STAGE(PG8_SB(0, 0), cB, voffB); PG8_STAGE(PG8_SB(0, 1), cB + hstep, voffB); PG8_STAGE(PG8_SA(0, 0), cA, voffA); PG8_STAGE(PG8_SA(0, 1), cA + hstep, voffA);
        if (wr == 1) PG8_BAR;
        PG8_WAIT_V(2); PG8_BAR;
        PG8_STAGE(PG8_SB(1, 0), cB + kstep, voffB); PG8_STAGE(PG8_SA(1, 0), cA + kstep, voffA); PG8_STAGE(PG8_SB(1, 1), cB + hstep + kstep, voffB);
        PG8_WAIT_V(6); PG8_BAR;
    } else {
        PG8_STAGE(PG8_SB(0, 0), cB, voffB); PG8_STAGE(PG8_SA(0, 0), cA, voffA); PG8_STAGE(PG8_SB(0, 1), cB + hstep, voffB); PG8_STAGE(PG8_SA(0, 1), cA + hstep, voffA);
        if (wr == 1) PG8_BAR;
        PG8_WAIT_V(4); PG8_BAR;
        PG8_STAGE(PG8_SB(1, 0), cB + kstep, voffB); PG8_STAGE(PG8_SA(1, 0), cA + kstep, voffA); PG8_STAGE(PG8_SB(1, 1), cB + hstep + kstep, voffB);
        PG8_WAIT_V(6); PG8_BAR;
    }
    for (;;) {
        const bool has_next = S.next(ui + 1, nxt);
        const char* nA = has_next ? (const char*)g.A + (size_t)nxt.pm * tstep : cA; const char* nB = has_next ? (const char*)g.Bt + (size_t)nxt.pn * tstep : cB;
        for (int t = 0; t < nt; t += 2) {
            const bool last = (t == nt - 2);
            const char* a1 = cA + (size_t)(t + 1) * kstep;
            const char* a2 = last ? nA : cA + (size_t)(t + 2) * kstep; const char* b2 = last ? nB : cB + (size_t)(t + 2) * kstep;
            const char* a3 = a2 + kstep; const char* b3 = b2 + kstep;
            if (last && has_next) S.a_ready(nxt);
            if constexpr (SP2) {
            PG8_LDB(B0, 0, 0); PG8_LDB(B1, 0, 1); PG8_SCHED; PG8_LDA(At, 0, 0); PG8_STAGE(PG8_SA(1, 1), a1 + hstep, voffA);
            PG8_WAIT_V(8); PG8_WAIT_L(0); PG8_BAR; PG8_MMA(0, 0, At, B0); PG8_MMA(0, 1, At, B1); PG8_BAR; PG8_SCHED;
            PG8_LDA(At, 0, 1); PG8_STAGE(PG8_SB(0, 0), b2, voffB); PG8_STAGE(PG8_SB(0, 1), b2 + hstep, voffB); PG8_STAGE(PG8_SA(0, 0), a2, voffA);
            PG8_WAIT_V(8); PG8_WAIT_L(0); PG8_BAR; PG8_MMA(1, 0, At, B0); PG8_MMA(1, 1, At, B1); PG8_BAR; PG8_SCHED;
            PG8_LDB(B0, 1, 0); PG8_LDB(B1, 1, 1); PG8_SCHED; PG8_LDA(At, 1, 0); PG8_STAGE(PG8_SA(0, 1), a2 + hstep, voffA);
            PG8_WAIT_V(8); PG8_WAIT_L(0); PG8_BAR; PG8_MMA(0, 0, At, B0); PG8_MMA(0, 1, At, B1); PG8_BAR; PG8_SCHED;
            PG8_LDA(At, 1, 1); PG8_STAGE(PG8_SB(1, 0), b3, voffB); PG8_STAGE(PG8_SB(1, 1), b3 + hstep, voffB); PG8_STAGE(PG8_SA(1, 0), a3, voffA);
            PG8_WAIT_V(8); PG8_WAIT_L(0); PG8_BAR; PG8_MMA(1, 0, At, B0); PG8_MMA(1, 1, At, B1); PG8_BAR; PG8_SCHED;
            } else {
            PG8_LDB(B0, 0, 0); PG8_SCHED; PG8_LDA(At, 0, 0); PG8_STAGE(PG8_SA(1, 1), a1 + hstep, voffA);
            PG8_WAIT_L(8); PG8_BAR; PG8_WAIT_L(0); PG8_MMA(0, 0, At, B0); PG8_BAR; PG8_SCHED;
            PG8_LDB(B1, 0, 1); PG8_STAGE(PG8_SB(0, 0), b2, voffB);
            PG8_BAR; PG8_WAIT_L(0); PG8_MMA(0, 1, At, B1); PG8_BAR;
            PG8_LDA(At, 0, 1); PG8_STAGE(PG8_SA(0, 0), a2, voffA);
            PG8_BAR; PG8_WAIT_L(0); PG8_MMA(1, 0, At, B0); PG8_BAR; PG8_SCHED;
            PG8_STAGE(PG8_SB(0, 1), b2 + hstep, voffB);
            PG8_WAIT_V(6); PG8_BAR; PG8_MMA(1, 1, At, B1); PG8_BAR;
            PG8_LDB(B0, 1, 0); PG8_SCHED; PG8_LDA(At, 1, 0); PG8_STAGE(PG8_SA(0, 1), a2 + hstep, voffA);
            PG8_WAIT_L(8); PG8_BAR; PG8_WAIT_L(0); PG8_MMA(0, 0, At, B0); PG8_BAR; PG8_SCHED;
            PG8_LDB(B1, 1, 1); PG8_STAGE(PG8_SB(1, 0), b3, voffB);
            PG8_BAR; PG8_WAIT_L(0); PG8_MMA(0, 1, At, B1); PG8_BAR;
            PG8_LDA(At, 1, 1); PG8_STAGE(PG8_SA(1, 0), a3, voffA);
            PG8_BAR; PG8_WAIT_L(0); PG8_MMA(1, 0, At, B0); PG8_BAR; PG8_SCHED;
            PG8_STAGE(PG8_SB(1, 1), b3 + hstep, voffB);
            PG8_WAIT_V(6); PG8_BAR; PG8_MMA(1, 1, At, B1); PG8_BAR;
            }
        }
        if constexpr (ALIGN_EPI) { if (wr == 0) PG8_BAR; }
        if constexpr (!Epi::AFTER_DRAIN) { E(acc, cur, wr, wc, fr, fq); S.done(cur); }
        if (!has_next) break;
#pragma unroll
        for (int a = 0; a < 2; ++a)
#pragma unroll
            for (int b = 0; b < 2; ++b)
#pragma unroll
                for (int m = 0; m < 4; ++m)
#pragma unroll
                    for (int n = 0; n < 2; ++n) acc[a][b][m][n] = (f32x4){0.f, 0.f, 0.f, 0.f};
        cur = nxt; cA = nA; cB = nB; ++ui;
        if constexpr (ALIGN_EPI) { if (wr == 1) PG8_BAR; }
    }
    PG8_WAIT_V(0);
    if constexpr (!ALIGN_EPI) { if (wr == 0) PG8_BAR; }
    PG8_BAR;
    if constexpr (Epi::AFTER_DRAIN) { E.fused(acc, cur, wr, wc, fr, fq, lds, wid, lane); S.done(cur); }
#undef PG8_SA
#undef PG8_SB
#undef PG8_STAGE
#undef PG8_LDA
#undef PG8_LDB
#undef PG8_MMA
#undef PG8_WAIT_V
#undef PG8_WAIT_L
#undef PG8_BAR
#undef PG8_SCHED
}
}

constexpr int BATCH = 2, SEQ = 8192, DM = 1024, DEPTH = 2, M = BATCH * SEQ;
constexpr int RW_H = 6, HD = 64, RW_W = 384, RW_SHIFT = 1280;
constexpr int NIN = 3712, NU = 3840;
constexpr int C_R = 0, C_K = 384, C_V = 768, C_WL = 1152, C_AL = 1216, C_RWZ = 1280, C_HGQ = 1664, C_HGF = 2048, C_HGI = 2432, C_HGZ = 2816, C_LRUX = 3200, C_LRUZ = 3456;
constexpr int CH = 64;
constexpr int NWAVES = 8, NT = NWAVES * 64;
constexpr int LDS_BYTES = 147456;
constexpr size_t MiB = 1u << 20;
constexpr size_t WS_WUPT = 65536, WS_AUPT = WS_WUPT + 98304, WS_VDNT = WS_AUPT + 98304, WS_VUPT = WS_VDNT + 24576;
constexpr size_t WS_WIN = 1 * MiB, WIN_L = (size_t)NU * DM * 2;
constexpr size_t WS_WOUT = 16 * MiB, WOUT_L = (size_t)DM * DM * 2;
constexpr size_t WS_XN = 20 * MiB;
constexpr size_t WS_QT = 20 * MiB;
constexpr size_t WS_PT = 32 * MiB;
constexpr size_t WS_CA = 44 * MiB;
constexpr size_t WS_U = 52 * MiB;
constexpr size_t WS_MIX = 172 * MiB;
constexpr size_t WS_VF = 204 * MiB;
constexpr size_t WS_VP = 216 * MiB;
constexpr size_t WS_RL = 228 * MiB;
constexpr size_t WS_HL = 240 * MiB;
constexpr size_t WS_BON = 252 * MiB;
constexpr size_t WS_DC = WS_BON + 512 * 1024;
constexpr size_t WS_LA = WS_DC + 512 * 1024;
constexpr size_t WS_LH = WS_LA + 256 * 1024;
constexpr size_t WS_END = 254 * MiB;
constexpr int NCH = SEQ / CH;

#define LAS __attribute__((address_space(3)))
typedef float f32x4 __attribute__((ext_vector_type(4)));
typedef unsigned u32x2 __attribute__((ext_vector_type(2)));
typedef unsigned u32x4 __attribute__((ext_vector_type(4)));
typedef _Float16 f16;
typedef _Float16 f16x8 __attribute__((ext_vector_type(8)));
#define LDS_WAIT() asm volatile("s_waitcnt lgkmcnt(0)" ::: "memory")

struct Args { const float* in[27]; float* out; unsigned char* ws; };

__device__ __forceinline__ float wave_sum(float v) {
#pragma unroll
    for (int o = 1; o < 64; o <<= 1) v += __shfl_xor(v, o);
    return v;
}
__device__ __forceinline__ float sigmoidf_(float x) { return 1.0f / (1.0f + __expf(-x)); }
__device__ __forceinline__ float siluf_(float x) { return x / (1.0f + __expf(-x)); }

__device__ __forceinline__ void p0_transpose_item(const float* W, int K, int N, unsigned short* WT, LAS float* scr, int item, int lane) {
    const int nblk = N / 32, kb = item / nblk, nb = item % nblk, k0 = 64 * kb, n0 = 32 * nb;
#pragma unroll 8
    for (int i = 0; i < 32; ++i) { const int kk = 2 * i + (lane >> 5); scr[kk * 33 + (lane & 31)] = W[(size_t)(k0 + kk) * N + n0 + (lane & 31)]; }
    LDS_WAIT(); asm volatile("" ::: "memory");
    const int c = lane & 7;
#pragma unroll
    for (int j = 0; j < 4; ++j) { const int n = (lane >> 3) + 8 * j; const LAS float* s = scr + (8 * c) * 33 + n;
        u32x4 o; o.x = pg8::pk_f16(s[0 * 33], s[1 * 33]); o.y = pg8::pk_f16(s[2 * 33], s[3 * 33]); o.z = pg8::pk_f16(s[4 * 33], s[5 * 33]); o.w = pg8::pk_f16(s[6 * 33], s[7 * 33]);
        *(u32x4*)(WT + (size_t)(n0 + n) * K + k0 + 8 * c) = o; }
    LDS_WAIT(); asm volatile("" ::: "memory");
}
__device__ __forceinline__ void rms_row_f16(const float* xrow, const float* w, unsigned short* orow, int lane) {
    const f32x4* xr = (const f32x4*)xrow + lane; const f32x4* wr = (const f32x4*)w + lane;
    f32x4 v[4]; float s = 0.f;
#pragma unroll
    for (int j = 0; j < 4; ++j) { v[j] = xr[64 * j]; s += (v[j].x * v[j].x + v[j].y * v[j].y) + (v[j].z * v[j].z + v[j].w * v[j].w); }
    const float rs = 1.0f / sqrtf(wave_sum(s) * (1.0f / DM) + 1e-6f);
    u32x2* o8 = (u32x2*)orow + lane;
#pragma unroll
    for (int j = 0; j < 4; ++j) { const f32x4 ww = wr[64 * j]; u32x2 o; o.x = pg8::pk_f16(v[j].x * rs * ww.x, v[j].y * rs * ww.y); o.y = pg8::pk_f16(v[j].z * rs * ww.z, v[j].w * rs * ww.w); o8[64 * j] = o; }
}
__device__ __forceinline__ void rms_row_f32(float* xrow, const float* w, int lane) {
    f32x4* xr = (f32x4*)xrow + lane; const f32x4* wr = (const f32x4*)w + lane;
    f32x4 v[4]; float s = 0.f;
#pragma unroll
    for (int j = 0; j < 4; ++j) { v[j] = xr[64 * j]; s += (v[j].x * v[j].x + v[j].y * v[j].y) + (v[j].z * v[j].z + v[j].w * v[j].w); }
    const float rs = 1.0f / sqrtf(wave_sum(s) * (1.0f / DM) + 1e-6f);
#pragma unroll
    for (int j = 0; j < 4; ++j) { const f32x4 ww = wr[64 * j]; xr[64 * j] = v[j] * rs * ww; }
}


#define SHV(col) ({ const float cur_ = (float)urow[(col)]; const float prev_ = hp ? (float)prow[(col)] : 0.f; cur_ + mu[(col)] * (prev_ - cur_); })

__device__ __forceinline__ void store_row64_f16(f16* dst, const float (&S)[64]) {
#pragma unroll
    for (int q = 0; q < 8; ++q) { u32x4 w; w.x = pg8::pk_f16(S[8 * q], S[8 * q + 1]); w.y = pg8::pk_f16(S[8 * q + 2], S[8 * q + 3]); w.z = pg8::pk_f16(S[8 * q + 4], S[8 * q + 5]); w.w = pg8::pk_f16(S[8 * q + 6], S[8 * q + 7]); *(u32x4*)(dst + 8 * q) = w; }
}


constexpr int RWA_REC = 768, RWA_VPL = 16 * RWA_REC, RWA_SCR = RWA_VPL + 2048, RWA_BYTES = RWA_SCR + 1024;
typedef float f32x2 __attribute__((ext_vector_type(2)));
typedef _Float16 f16x4 __attribute__((ext_vector_type(4)));
__device__ __forceinline__ float fmix_lo(float a, unsigned b, float c) { float d; asm("v_fma_mix_f32 %0, %1, %2, %3 op_sel:[0,0,0] op_sel_hi:[0,1,0]" : "=v"(d) : "v"(a), "v"(b), "v"(c)); return d; }
__device__ __forceinline__ float fmix_hi(float a, unsigned b, float c) { float d; asm("v_fma_mix_f32 %0, %1, %2, %3 op_sel:[0,1,0] op_sel_hi:[0,1,0]" : "=v"(d) : "v"(a), "v"(b), "v"(c)); return d; }
__device__ __forceinline__ float mmix_lo(float a, unsigned b) { float d; asm("v_fma_mix_f32 %0, %1, %2, 0 op_sel:[0,0,0] op_sel_hi:[0,1,0]" : "=v"(d) : "v"(a), "v"(b)); return d; }
__device__ __forceinline__ float mmix_hi(float a, unsigned b) { float d; asm("v_fma_mix_f32 %0, %1, %2, 0 op_sel:[0,1,0] op_sel_hi:[0,1,0]" : "=v"(d) : "v"(a), "v"(b)); return d; }
__device__ __forceinline__ float fma_asm(float a, float b, float c) { float d; asm("v_fma_f32 %0, %1, %2, %3" : "=v"(d) : "v"(a), "v"(b), "v"(c)); return d; }
#define FMIX(a, u, j, c) (((j) & 1) ? fmix_hi((a), (u)[(j) >> 1], (c)) : fmix_lo((a), (u)[(j) >> 1], (c)))
#define MMIX(a, u, j) (((j) & 1) ? mmix_hi((a), (u)[(j) >> 1]) : mmix_lo((a), (u)[(j) >> 1]))
__device__ __forceinline__ float fast_tanh(float x) { return 1.0f - 2.0f / (__expf(2.0f * x) + 1.0f); }
__device__ __forceinline__ void lerp8(const char* ub, unsigned uo, unsigned po, bool hp, const char* mub, unsigned col, float (&x)[8]) {
    const f16x8 cu = *(const f16x8*)(ub + (uo + col * 2u)); f16x8 pv = *(const f16x8*)(ub + (po + col * 2u)); const f32x4 m0 = *(const f32x4*)(mub + col * 4u), m1 = *(const f32x4*)(mub + col * 4u + 16u);
#pragma unroll
    for (int j = 0; j < 8; ++j) { const float c = (float)cu[j], p = hp ? (float)pv[j] : 0.f; x[j] = c + (j < 4 ? m0[j] : m1[j - 4]) * (p - c); }
}
__device__ __forceinline__ void lerp4(const char* ub, unsigned uo, unsigned po, bool hp, const char* mub, unsigned col, float (&x)[4]) {
    const f16x4 cu = *(const f16x4*)(ub + (uo + col * 2u)); f16x4 pv = *(const f16x4*)(ub + (po + col * 2u)); const f32x4 m0 = *(const f32x4*)(mub + col * 4u);
#pragma unroll
    for (int j = 0; j < 4; ++j) { const float c = (float)cu[j], p = hp ? (float)pv[j] : 0.f; x[j] = c + m0[j] * (p - c); }
}
__device__ __forceinline__ f16x8 pack8(const float (&x)[8]) { f16x8 r;
#pragma unroll
    for (int j = 0; j < 8; ++j) r[j] = (f16)x[j];
    return r; }

__device__ __forceinline__ void rwkv_waveA(const Args& a, int l, int b, int c, int h, LAS unsigned char* wl, int lane) {
    const f16* U = (const f16*)(a.ws + WS_U); f16* MIX = (f16*)(a.ws + WS_MIX); f16* VF = (f16*)(a.ws + WS_VF); f16* VP = (f16*)(a.ws + WS_VP);
    f16* QT = (f16*)(a.ws + WS_QT); f16* PT = (f16*)(a.ws + WS_PT); f16* RL = (f16*)(a.ws + WS_RL); float* BONG = (float*)(a.ws + WS_BON);
    const f16* WUPT = (const f16*)(a.ws + WS_WUPT) + (size_t)l * 384 * 64; const f16* AUPT = (const f16*)(a.ws + WS_AUPT) + (size_t)l * 384 * 64;
    const f16* VDNT = (const f16*)(a.ws + WS_VDNT); const f16* VUPT = (const f16*)(a.ws + WS_VUPT);
    const float* mu = a.in[3] + l * RW_SHIFT; const float* w0 = a.in[4] + l * RW_W; const float* a0 = a.in[6] + l * RW_W; const float* v0 = a.in[8];
    const float* k_k = a.in[11] + l * RW_W; const float* k_a = a.in[12] + l * RW_W; const float* r_k = a.in[13] + l * RW_W;
    const int bh = b * RW_H + h;
    float P[64], L[64];
#pragma unroll
    for (int k = 0; k < 64; ++k) { P[k] = (k == lane) ? 1.f : 0.f; L[k] = 0.f; }
#pragma unroll 1
    for (int blk = 0; blk < 4; ++blk) {
        int lane_ = lane; asm volatile("" : "+v"(lane_));
        const int tok = lane_ & 15, fq = lane_ >> 4;
        const int t = c * CH + blk * 16 + tok; const unsigned m = (unsigned)(b * SEQ + t); const bool hp = t > 0;
        const char* ub = (const char*)U; const char* mub = (const char*)mu; const unsigned uo = m * (unsigned)(NU * 2), po = hp ? uo - (unsigned)(NU * 2) : uo;
        f16x8 bW[2], bA[2], bVD;
#pragma unroll
        for (int s = 0; s < 2; ++s) {
            float x[8]; lerp8(ub, uo, po, hp, mub, (unsigned)(C_WL + 8 * fq + 32 * s), x);
#pragma unroll
            for (int j = 0; j < 8; ++j) x[j] = fast_tanh(x[j]);
            bW[s] = pack8(x);
            lerp8(ub, uo, po, hp, mub, (unsigned)(C_AL + 8 * fq + 32 * s), x);
            bA[s] = pack8(x);
            asm volatile("" ::: "memory");
        }
        if (l > 0) {
            f32x4 VD0 = (f32x4){0.f, 0.f, 0.f, 0.f}, VD1 = VD0;
#pragma unroll 1
            for (int s = 0; s < 12; ++s) {
                float x[8]; lerp8(ub, uo, po, hp, mub, (unsigned)(C_V + 8 * fq + 32 * s), x);
                const f16x8 bv = pack8(x);
                VD0 = __builtin_amdgcn_mfma_f32_16x16x32_f16(*(const f16x8*)((const char*)VDNT + (unsigned)(tok * 384 + 8 * fq + 32 * s) * 2u), bv, VD0, 0, 0, 0);
                VD1 = __builtin_amdgcn_mfma_f32_16x16x32_f16(*(const f16x8*)((const char*)VDNT + (unsigned)((16 + tok) * 384 + 8 * fq + 32 * s) * 2u), bv, VD1, 0, 0, 0);
            }
            LAS f16* scr = (LAS f16*)(wl + RWA_SCR);
            { f16x4 p0, p1;
#pragma unroll
              for (int i = 0; i < 4; ++i) { p0[i] = (f16)VD0[i]; p1[i] = (f16)VD1[i]; }
              *(LAS f16x4*)(scr + tok * 32 + 4 * fq) = p0; *(LAS f16x4*)(scr + tok * 32 + 16 + 4 * fq) = p1; }
            asm volatile("s_waitcnt lgkmcnt(0)" ::: "memory");
            bVD = *(const LAS f16x8*)(scr + tok * 32 + 8 * fq);
        }
        float ssq = 0.f;
#pragma unroll 1
        for (int nt = 0; nt < 4; ++nt) { const int cb = h * 64 + 16 * nt + 4 * fq; float ks[4]; lerp4(ub, uo, po, hp, mub, (unsigned)(C_K + cb), ks); const f32x4 kk4 = *(const f32x4*)((const char*)k_k + (unsigned)cb * 4u);
#pragma unroll
            for (int i = 0; i < 4; ++i) { const float kv = ks[i] * kk4[i]; ssq += kv * kv; }
            asm volatile("" ::: "memory"); }
        ssq += __shfl_xor(ssq, 16); ssq += __shfl_xor(ssq, 32);
        const float inv = 1.0f / fmaxf(sqrtf(ssq), 1e-12f);
        float bon = 0.f;
        LAS unsigned char* rec = wl + tok * RWA_REC;
#pragma unroll 1
        for (int nt = 0; nt < 4; ++nt) {
            const int cb = h * 64 + 16 * nt + 4 * fq, co = 16 * nt + 4 * fq; const int n = h * 64 + 16 * nt + tok;
            f32x4 DWn = (f32x4){0.f, 0.f, 0.f, 0.f}, DAn = DWn, Gn = DWn;
#pragma unroll
            for (int s = 0; s < 2; ++s) {
                DWn = __builtin_amdgcn_mfma_f32_16x16x32_f16(*(const f16x8*)((const char*)WUPT + (unsigned)(n * 64 + 8 * fq + 32 * s) * 2u), bW[s], DWn, 0, 0, 0);
                DAn = __builtin_amdgcn_mfma_f32_16x16x32_f16(*(const f16x8*)((const char*)AUPT + (unsigned)(n * 64 + 8 * fq + 32 * s) * 2u), bA[s], DAn, 0, 0, 0); }
            if (l > 0) Gn = __builtin_amdgcn_mfma_f32_16x16x32_f16(*(const f16x8*)((const char*)VUPT + (unsigned)(n * 32 + 8 * fq) * 2u), bVD, Gn, 0, 0, 0);
            float rs[4], ks[4], vs[4];
            lerp4(ub, uo, po, hp, mub, (unsigned)(C_R + cb), rs); lerp4(ub, uo, po, hp, mub, (unsigned)(C_K + cb), ks); lerp4(ub, uo, po, hp, mub, (unsigned)(C_V + cb), vs);
            const unsigned cb4 = (unsigned)cb * 4u; const f32x4 w04 = *(const f32x4*)((const char*)w0 + cb4), a04 = *(const f32x4*)((const char*)a0 + cb4), kk4 = *(const f32x4*)((const char*)k_k + cb4), ka4 = *(const f32x4*)((const char*)k_a + cb4), rk4 = *(const f32x4*)((const char*)r_k + cb4);
            f32x4 wv; f16x4 al, be, km, rr, vo;
            f16x4 vf4; f32x4 v04;
            const unsigned vo_b = (m * (unsigned)RW_W + (unsigned)cb) * 2u;
            if (l > 0) { vf4 = *(const f16x4*)((const char*)VF + vo_b); v04 = *(const f32x4*)((const char*)v0 + cb4); }
#pragma unroll
            for (int i = 0; i < 4; ++i) {
                wv[i] = __expf(-0.6065306597126334f * sigmoidf_(w04[i] + DWn[i]));
                const float aa = sigmoidf_(a04[i] + DAn[i]);
                float vv = vs[i];
                if (l > 0) vv = vs[i] + ((float)vf4[i] - vs[i]) * sigmoidf_(v04[i] + Gn[i]);
                const float kk = ks[i] * kk4[i] * inv;
                const float kmod = ks[i] * (1.0f + (aa - 1.0f) * ka4[i]);
                bon += rs[i] * kmod * rk4[i];
                al[i] = (f16)(-kk); be[i] = (f16)(kk * aa); km[i] = (f16)kmod; rr[i] = (f16)rs[i]; vo[i] = (f16)vv;
            }
            *(LAS f32x4*)(rec + co * 4) = wv;
            *(LAS f16x4*)(rec + 256 + co * 2) = al; *(LAS f16x4*)(rec + 384 + co * 2) = be; *(LAS f16x4*)(rec + 512 + co * 2) = km; *(LAS f16x4*)(rec + 640 + co * 2) = rr;
            *(LAS f16x4*)(wl + RWA_VPL + tok * 128 + co * 2) = vo;
            *(f16x4*)((char*)VP + vo_b) = vo;
            if (l == 0) *(f16x4*)((char*)VF + vo_b) = vo;
            asm volatile("" ::: "memory");
        }
        bon += __shfl_xor(bon, 16); bon += __shfl_xor(bon, 32);
        if (fq == 0) *(float*)((char*)BONG + (m * 8u + (unsigned)h) * 4u) = bon;
        const unsigned mb = (unsigned)(b * SEQ + c * CH + blk * 16);
#pragma unroll 1
        for (int t2 = 0; t2 < 16; ++t2) {
            const LAS unsigned char* rc = wl + t2 * RWA_REC;
            const float vv = (float)*(const LAS f16*)(wl + RWA_VPL + t2 * 128 + lane * 2);
            float sP0 = 0.f, sP1 = 0.f, sL0 = 0.f, sL1 = 0.f;
#pragma unroll
            for (int g = 0; g < 8; ++g) { const u32x4 a4 = *(const LAS u32x4*)(rc + 256 + g * 16);
#pragma unroll
                for (int j = 0; j < 8; j += 2) { sP0 = FMIX(P[8 * g + j], a4, j, sP0); sL0 = FMIX(L[8 * g + j], a4, j, sL0); sP1 = FMIX(P[8 * g + j + 1], a4, j + 1, sP1); sL1 = FMIX(L[8 * g + j + 1], a4, j + 1, sL1); } }
            const float saP = sP0 + sP1, saL = sL0 + sL1;
            float q0 = 0.f, q1 = 0.f, y0 = 0.f, y1 = 0.f;
#pragma unroll
            for (int g = 0; g < 8; ++g) {
                const f32x4 wA = *(const LAS f32x4*)(rc + g * 32), wB = *(const LAS f32x4*)(rc + g * 32 + 16);
                const u32x4 b4 = *(const LAS u32x4*)(rc + 384 + g * 16), k4 = *(const LAS u32x4*)(rc + 512 + g * 16), r4 = *(const LAS u32x4*)(rc + 640 + g * 16);
#pragma unroll
                for (int j = 0; j < 8; ++j) { const int k = 8 * g + j; const float w = (j < 4) ? wA[j] : wB[j - 4];
                    const float tP = MMIX(saP, b4, j); float tL = MMIX(saL, b4, j); tL = FMIX(vv, k4, j, tL);
                    P[k] = fma_asm(P[k], w, tP); L[k] = fma_asm(L[k], w, tL);
                    if (j & 1) { q1 = FMIX(P[k], r4, j, q1); y1 = FMIX(L[k], r4, j, y1); } else { q0 = FMIX(P[k], r4, j, q0); y0 = FMIX(L[k], r4, j, y0); } }
            }
            *(f16*)((char*)MIX + ((mb + t2) * (unsigned)DM + (unsigned)(h * 64 + lane)) * 2u) = (f16)(y0 + y1);
            *(f16*)((char*)QT + ((mb + t2) * (unsigned)RW_W + (unsigned)(h * 64 + lane)) * 2u) = (f16)(q0 + q1);
        }
    }
    store_row64_f16(RL + (((size_t)bh * NCH + c) * 64 + lane) * 64, L);
    f16* pt = PT + ((size_t)bh * NCH + c) * 4096;
#pragma unroll
    for (int k = 0; k < 64; ++k) pt[k * 64 + lane] = (f16)P[k];
}
__device__ __forceinline__ void phaseA(const Args& a, int l, int task, LAS unsigned char* lds, int tid) {
    asm volatile("" : "+v"(tid));
    const int lane = tid & 63, wave = __builtin_amdgcn_readfirstlane(tid >> 6);
    const int b = task / NCH, c = task % NCH;
    const f16* U = (const f16*)(a.ws + WS_U); f16* MIX = (f16*)(a.ws + WS_MIX); f16* VF = (f16*)(a.ws + WS_VF); f16* VP = (f16*)(a.ws + WS_VP);
    f16* QT = (f16*)(a.ws + WS_QT); f16* PT = (f16*)(a.ws + WS_PT); f16* RL = (f16*)(a.ws + WS_RL); float* BONG = (float*)(a.ws + WS_BON);
    const int tt = tid >> 3, sub = tid & 7;
    const int t = c * CH + tt; const size_t m = (size_t)b * SEQ + t;
    const f16* urow = U + m * NU; const f16* prow = urow - NU; const bool hp = t > 0;
    if (wave < RW_H) rwkv_waveA(a, l, b, c, wave, lds + wave * RWA_BYTES, lane);
    __syncthreads();
    {
        f16* HL = (f16*)(a.ws + WS_HL); float* DC = (float*)(a.ws + WS_DC);
        const float* lbr = a.in[16];
        LAS float* FQ = (LAS float*)lds;
#pragma unroll 1
        for (int h = 0; h < 6; ++h) {
#pragma unroll 1
            for (int i = 0; i < 8; ++i) { const int j = sub * 8 + i, col = h * 64 + j;
                const float lb = (l == 0) ? 0.f : sigmoidf_(lbr[384 + col] - lbr[col]);
                FQ[tt * 128 + j] = lb + (1.0f - lb) * sigmoidf_((float)urow[C_HGF + col]);
                FQ[tt * 128 + 64 + j] = (float)urow[C_HGQ + col]; }
            __syncthreads();
            const int bh = b * 6 + h;
            if (wave == 0) {
                float S[64]; float dprod = 1.f;
#pragma unroll
                for (int k = 0; k < 64; ++k) S[k] = 0.f;
                const int col = h * 64 + lane;
                for (int t2 = 0; t2 < CH; ++t2) {
                    const LAS float* fq = FQ + t2 * 128; const size_t m2 = (size_t)b * SEQ + c * CH + t2;
                    const float vi = (float)U[m2 * NU + C_HGI + col];
                    dprod *= fq[lane];
                    float o0 = 0.f, o1 = 0.f, o2 = 0.f, o3 = 0.f;
#pragma unroll
                    for (int k = 0; k < 64; k += 4) { const f32x4 f4 = *(const LAS f32x4*)(fq + k), q4 = *(const LAS f32x4*)(fq + 64 + k);
                        S[k] = f4.x * S[k] + (1.0f - f4.x) * vi; o0 += q4.x * S[k];
                        S[k + 1] = f4.y * S[k + 1] + (1.0f - f4.y) * vi; o1 += q4.y * S[k + 1];
                        S[k + 2] = f4.z * S[k + 2] + (1.0f - f4.z) * vi; o2 += q4.z * S[k + 2];
                        S[k + 3] = f4.w * S[k + 3] + (1.0f - f4.w) * vi; o3 += q4.w * S[k + 3]; }
                    MIX[m2 * DM + 384 + col] = (f16)((o0 + o1) + (o2 + o3));
                }
                f16* hl = HL + ((size_t)bh * NCH + c) * 4096;
#pragma unroll
                for (int k = 0; k < 64; ++k) hl[k * 64 + lane] = (f16)S[k];
                DC[((size_t)bh * NCH + c) * 64 + lane] = dprod;
            }
            __syncthreads();
        }
    }
    {
        f16* CA = (f16*)(a.ws + WS_CA); float* LA = (float*)(a.ws + WS_LA); float* LH = (float*)(a.ws + WS_LH);
        const float* cw = a.in[18] + l * 4 * 256; const float* cb = a.in[19] + l * 256;
        const float* ba = a.in[21] + l * 256; const float* bx = a.in[23] + l * 256; const float* lam = a.in[24] + l * 256;
        LAS float* Y = (LAS float*)lds; LAS float* AA = (LAS float*)(lds + 16384); LAS float* UU = (LAS float*)(lds + 32768);
#pragma unroll 1
        for (int g = 0; g < 4; ++g) {
            const float* wa = a.in[20] + (size_t)(l * 4 + g) * 4096; const float* wx = a.in[22] + (size_t)(l * 4 + g) * 4096;
#pragma unroll 1
            for (int i = 0; i < 8; ++i) { const int j = sub * 8 + i, ch = g * 64 + j; float y = cb[ch];
#pragma unroll
                for (int jj = 0; jj < 4; ++jj) { const int ts = t - 3 + jj; if (ts >= 0) y += cw[jj * 256 + ch] * (float)U[((size_t)b * SEQ + ts) * NU + C_LRUX + ch]; }
                Y[tt * 64 + j] = y; }
            __syncthreads();
#pragma unroll 1
            for (int i = 0; i < 8; ++i) { const int j = sub * 8 + i, ch = g * 64 + j; float ra = ba[ch], rx = bx[ch];
#pragma unroll 4
                for (int i2 = 0; i2 < 64; ++i2) { const float yv = Y[tt * 64 + i2]; ra += yv * wa[i2 * 64 + j]; rx += yv * wx[i2 * 64 + j]; }
                const float r = sigmoidf_(ra), ig = sigmoidf_(rx);
                const float la = -8.0f * r * log1pf(expf(-lam[ch]));
                AA[tt * 64 + j] = expf(la); UU[tt * 64 + j] = sqrtf(-expm1f(2.0f * la)) * (ig * Y[tt * 64 + j]); }
            __syncthreads();
            if (wave == 0) {
                const int ch = g * 64 + lane; float hst = 0.f, ap = 1.f;
                for (int t2 = 0; t2 < CH; ++t2) { const size_t m2 = (size_t)b * SEQ + c * CH + t2; const float av = AA[t2 * 64 + lane];
                    hst = av * hst + UU[t2 * 64 + lane]; ap *= av;
                    MIX[m2 * DM + 768 + ch] = (f16)hst; CA[m2 * 256 + ch] = (f16)ap; }
                LA[((size_t)b * NCH + c) * 256 + ch] = ap; LH[((size_t)b * NCH + c) * 256 + ch] = hst;
            }
            __syncthreads();
        }
    }
}

__device__ __forceinline__ void phaseB(const Args& a, LAS unsigned char* lds, int tid) {
    asm volatile("" : "+v"(tid));
    const int lane = tid & 63, wave = __builtin_amdgcn_readfirstlane(tid >> 6);
    const int bx = blockIdx.x;
    if (bx < 12) {
        const int bh = bx;
        f16* PT = (f16*)(a.ws + WS_PT); f16* RL = (f16*)(a.ws + WS_RL);
        LAS float* PTL = (LAS float*)lds;
        LAS float* SN = (LAS float*)(lds + 16384);
        float S[64];
#pragma unroll
        for (int k = 0; k < 64; ++k) S[k] = 0.f;
        for (int c = 0; c < NCH; ++c) {
            const f16* pt = PT + ((size_t)bh * NCH + c) * 4096; f16* rl = RL + ((size_t)bh * NCH + c) * 4096;
            { const f16x8 p8 = *(const f16x8*)(pt + tid * 8);
#pragma unroll
              for (int j = 0; j < 8; ++j) PTL[tid * 8 + j] = (float)p8[j]; }
            const f16x8 l8 = *(const f16x8*)(rl + lane * 64 + wave * 8);
            asm volatile("s_waitcnt vmcnt(0)" ::: "memory");
            __syncthreads();
            if (wave == 0) store_row64_f16(rl + lane * 64, S);
#pragma unroll
            for (int j = 0; j < 8; ++j) SN[lane * 65 + wave * 8 + j] = (float)l8[j];
#pragma unroll 1
            for (int j = 0; j < 8; ++j) { float acc = SN[lane * 65 + wave * 8 + j];
                const LAS float* pr = PTL + (wave * 8 + j) * 64;
                float a0 = 0.f, a1 = 0.f, a2 = 0.f, a3 = 0.f;
#pragma unroll
                for (int k = 0; k < 64; k += 4) { const f32x4 p4 = *(const LAS f32x4*)(pr + k); a0 += S[k] * p4.x; a1 += S[k + 1] * p4.y; a2 += S[k + 2] * p4.z; a3 += S[k + 3] * p4.w; }
                SN[lane * 65 + wave * 8 + j] = acc + ((a0 + a1) + (a2 + a3)); }
            __syncthreads();
#pragma unroll
            for (int k = 0; k < 64; ++k) S[k] = SN[lane * 65 + k];
            __syncthreads();
        }
    } else if (bx < 12 + 96) {
        const int idx = (bx - 12) * NT + tid; const int bh = idx >> 12, e = idx & 4095, k = e >> 6;
        f16* HL = (f16*)(a.ws + WS_HL); const float* DC = (const float*)(a.ws + WS_DC);
        float s = 0.f;
        for (int c = 0; c < NCH; ++c) { f16* p = HL + ((size_t)bh * NCH + c) * 4096 + e; const float Lc = (float)*p; const float d = DC[((size_t)bh * NCH + c) * 64 + k];
            *p = (f16)s; s = d * s + Lc; }
    } else if (bx == 12 + 96) {
        const int bb = tid >> 8, ch = tid & 255; const float* LA = (const float*)(a.ws + WS_LA); float* LH = (float*)(a.ws + WS_LH);
        float cy = 0.f;
        for (int c = 0; c < NCH; ++c) { const size_t o = ((size_t)bb * NCH + c) * 256 + ch; const float A = LA[o], H = LH[o]; LH[o] = cy; cy = A * cy + H; }
    }
}

__device__ __forceinline__ void phaseC(const Args& a, int l, int task, LAS unsigned char* lds, int tid) {
    asm volatile("" : "+v"(tid));
    const int lane = tid & 63, wave = __builtin_amdgcn_readfirstlane(tid >> 6);
    const int b = task / NCH, c = task % NCH;
    const f16* U = (const f16*)(a.ws + WS_U); f16* MIX = (f16*)(a.ws + WS_MIX); const f16* VP = (const f16*)(a.ws + WS_VP);
    const f16* QT = (const f16*)(a.ws + WS_QT); const f16* RL = (const f16*)(a.ws + WS_RL); const float* BONG = (const float*)(a.ws + WS_BON);
    const int tt = tid >> 3, sub = tid & 7;
    const size_t m = (size_t)b * SEQ + c * CH + tt;
    const f16* urow = U + m * NU;
    {
        const float* ln_w = a.in[14] + l * RW_W; const float* ln_b = a.in[15] + l * RW_W;
        LAS float* SL = (LAS float*)lds;
#pragma unroll 1
        for (int h = 0; h < RW_H; ++h) {
            const int bh = b * RW_H + h;
            { const f16x8 s8 = *(const f16x8*)(RL + ((size_t)bh * NCH + c) * 4096 + tid * 8); const int v = tid >> 3, k0 = (tid & 7) * 8;
#pragma unroll
              for (int j = 0; j < 8; ++j) SL[v * 68 + k0 + j] = (float)s8[j]; }
            float q[64];
#pragma unroll
            for (int qq = 0; qq < 8; ++qq) { const f16x8 q8 = *(const f16x8*)(QT + m * RW_W + h * 64 + qq * 8);
#pragma unroll
                for (int j = 0; j < 8; ++j) q[qq * 8 + j] = (float)q8[j]; }
            __syncthreads();
            const f16x8 yl = *(const f16x8*)(MIX + m * DM + h * 64 + sub * 8);
            LAS float* YS = (LAS float*)(lds + 20480) + tid * 9;
#pragma unroll
            for (int i = 0; i < 8; ++i) YS[i] = (float)yl[i];
#pragma unroll 1
            for (int i = 0; i < 8; ++i) { const LAS float* sr = SL + (sub * 8 + i) * 68;
                float a0 = 0.f, a1 = 0.f, a2 = 0.f, a3 = 0.f;
#pragma unroll
                for (int k = 0; k < 64; k += 4) { const f32x4 s4 = *(const LAS f32x4*)(sr + k); a0 += q[k] * s4.x; a1 += q[k + 1] * s4.y; a2 += q[k + 2] * s4.z; a3 += q[k + 3] * s4.w; }
                YS[i] += (a0 + a1) + (a2 + a3); }
            float y[8]; float sm = 0.f;
#pragma unroll
            for (int i = 0; i < 8; ++i) { y[i] = YS[i]; sm += y[i]; }
            sm += __shfl_xor(sm, 1); sm += __shfl_xor(sm, 2); sm += __shfl_xor(sm, 4);
            const float mean = sm * (1.0f / 64.0f); float vr = 0.f;
#pragma unroll
            for (int i = 0; i < 8; ++i) { const float d = y[i] - mean; vr += d * d; }
            vr += __shfl_xor(vr, 1); vr += __shfl_xor(vr, 2); vr += __shfl_xor(vr, 4);
            const float rstd = 1.0f / sqrtf(vr * (1.0f / 64.0f) + 64e-5f);
            const float bon = BONG[m * 8 + h];
            const f16x8 vp = *(const f16x8*)(VP + m * RW_W + h * 64 + sub * 8); const f16x8 z8 = *(const f16x8*)(urow + C_RWZ + h * 64 + sub * 8);
            float o[8];
#pragma unroll
            for (int i = 0; i < 8; ++i) { const int col = h * 64 + sub * 8 + i; o[i] = ((y[i] - mean) * rstd * ln_w[col] + ln_b[col] + bon * (float)vp[i]) * siluf_((float)z8[i]); }
            u32x4 w; w.x = pg8::pk_f16(o[0], o[1]); w.y = pg8::pk_f16(o[2], o[3]); w.z = pg8::pk_f16(o[4], o[5]); w.w = pg8::pk_f16(o[6], o[7]);
            *(u32x4*)(MIX + m * DM + h * 64 + sub * 8) = w;
            __syncthreads();
        }
    }
    {
        const f16* HL = (const f16*)(a.ws + WS_HL); const float* lbr = a.in[16]; const float* nw = a.in[17] + l * 384;
        LAS float* SL = (LAS float*)lds;
        LAS float* QE = (LAS float*)(lds + 16384);
#pragma unroll 1
        for (int h = 0; h < 6; ++h) {
            const int bh = b * 6 + h;
            { const f16x8 s8 = *(const f16x8*)(HL + ((size_t)bh * NCH + c) * 4096 + tid * 8);
#pragma unroll
              for (int j = 0; j < 8; ++j) SL[tid * 8 + j] = (float)s8[j]; }
            if (wave == 0) {
                const int col = h * 64 + lane; const float lb = (l == 0) ? 0.f : sigmoidf_(lbr[384 + col] - lbr[col]); float cp = 1.f;
                for (int t2 = 0; t2 < CH; ++t2) { const f16* ur = U + ((size_t)b * SEQ + c * CH + t2) * NU;
                    cp *= lb + (1.0f - lb) * sigmoidf_((float)ur[C_HGF + col]); QE[t2 * 68 + lane] = (float)ur[C_HGQ + col] * cp; }
            }
            __syncthreads();
            const f16x8 ol = *(const f16x8*)(MIX + m * DM + 384 + h * 64 + sub * 8);
            float o[8];
#pragma unroll
            for (int i = 0; i < 8; ++i) o[i] = (float)ol[i];
#pragma unroll 8
            for (int k = 0; k < 64; ++k) { const float qe = QE[tt * 68 + k]; const f32x4 s0 = *(const LAS f32x4*)(SL + k * 64 + sub * 8), s1 = *(const LAS f32x4*)(SL + k * 64 + sub * 8 + 4);
                o[0] += qe * s0.x; o[1] += qe * s0.y; o[2] += qe * s0.z; o[3] += qe * s0.w; o[4] += qe * s1.x; o[5] += qe * s1.y; o[6] += qe * s1.z; o[7] += qe * s1.w; }
            float ss = 0.f;
#pragma unroll
            for (int i = 0; i < 8; ++i) ss += o[i] * o[i];
            ss += __shfl_xor(ss, 1); ss += __shfl_xor(ss, 2); ss += __shfl_xor(ss, 4);
            const float rs = 1.0f / sqrtf(ss * (1.0f / 64.0f) + 1e-6f);
            const f16x8 z8 = *(const f16x8*)(urow + C_HGZ + h * 64 + sub * 8);
#pragma unroll
            for (int i = 0; i < 8; ++i) o[i] = o[i] * rs * nw[h * 64 + sub * 8 + i] * siluf_((float)z8[i]);
            u32x4 w; w.x = pg8::pk_f16(o[0], o[1]); w.y = pg8::pk_f16(o[2], o[3]); w.z = pg8::pk_f16(o[4], o[5]); w.w = pg8::pk_f16(o[6], o[7]);
            *(u32x4*)(MIX + m * DM + 384 + h * 64 + sub * 8) = w;
            __syncthreads();
        }
    }
    {
        const f16* CA = (const f16*)(a.ws + WS_CA); const float* LH = (const float*)(a.ws + WS_LH);
#pragma unroll 1
        for (int q = 0; q < 4; ++q) { const int ch0 = q * 64 + sub * 8;
            const f16x8 hl = *(const f16x8*)(MIX + m * DM + 768 + ch0), ca = *(const f16x8*)(CA + m * 256 + ch0), z8 = *(const f16x8*)(urow + C_LRUZ + ch0);
            float o[8];
#pragma unroll
            for (int i = 0; i < 8; ++i) o[i] = ((float)hl[i] + (float)ca[i] * LH[((size_t)b * NCH + c) * 256 + ch0 + i]) * siluf_((float)z8[i]);
            u32x4 w; w.x = pg8::pk_f16(o[0], o[1]); w.y = pg8::pk_f16(o[2], o[3]); w.z = pg8::pk_f16(o[4], o[5]); w.w = pg8::pk_f16(o[6], o[7]);
            *(u32x4*)(MIX + m * DM + 768 + ch0) = w; }
    }
}
__global__ void __launch_bounds__(NT, 2) fwd(Args args) {
    extern __shared__ __attribute__((aligned(16))) unsigned char lds_raw[];
    LAS unsigned char* lds = (LAS unsigned char*)lds_raw;
    cg::grid_group grid = cg::this_grid();
    const int wave = __builtin_amdgcn_readfirstlane((int)threadIdx.x >> 6);
#define TID_NOW() (wave * 64 + lane_now())
    const int tid = TID_NOW(); const int lane = tid & 63;
    const int G = gridDim.x, gw = blockIdx.x * NWAVES + wave, NGW = G * NWAVES;
    unsigned char* ws = args.ws;
    unsigned short* XN = (unsigned short*)(ws + WS_XN);
    {
        LAS float* scr = (LAS float*)(lds + wave * 16384);
        constexpr int I_IN = (DM / 64) * (NIN / 32), I_OUT = (DM / 64) * (DM / 32), NITEMS = DEPTH * (I_IN + I_OUT);
        for (int it = gw; it < NITEMS; it += NGW) {
            int r = it; const int l = r / (I_IN + I_OUT); r -= l * (I_IN + I_OUT);
            if (r < I_IN) p0_transpose_item(args.in[2] + (size_t)l * DM * NIN, DM, NIN, (unsigned short*)(ws + WS_WIN + l * WIN_L), scr, r, lane);
            else p0_transpose_item(args.in[25] + (size_t)l * DM * DM, DM, DM, (unsigned short*)(ws + WS_WOUT + l * WOUT_L), scr, r - I_IN, lane);
        }
        for (int i = gw; i < DEPTH * (NU - NIN) * DM * 2 / 1024; i += NGW) { const int l = i / ((NU - NIN) * DM * 2 / 1024), r = i % ((NU - NIN) * DM * 2 / 1024);
            *(u32x4*)(ws + WS_WIN + l * WIN_L + (size_t)NIN * DM * 2 + (size_t)r * 1024 + lane * 16) = (u32x4){0u, 0u, 0u, 0u}; }
        for (int m = gw; m < M; m += NGW) rms_row_f16(args.in[0] + (size_t)m * DM, args.in[1], XN + (size_t)m * DM, lane);
        { f16* WUPT = (f16*)(ws + WS_WUPT); f16* AUPT = (f16*)(ws + WS_AUPT); f16* VDNT = (f16*)(ws + WS_VDNT); f16* VUPT = (f16*)(ws + WS_VUPT);
          for (int i = blockIdx.x * NT + tid; i < 122880; i += G * NT) {
              if (i < 49152) { const int ll = i / 24576, r = i % 24576, n = r / 64, k = r % 64; WUPT[i] = (f16)args.in[5][(size_t)ll * 24576 + k * 384 + n]; }
              else if (i < 98304) { const int i2 = i - 49152, ll = i2 / 24576, r = i2 % 24576, n = r / 64, k = r % 64; AUPT[i2] = (f16)args.in[7][(size_t)ll * 24576 + k * 384 + n]; }
              else if (i < 110592) { const int i2 = i - 98304, j2 = i2 / 384, cc = i2 % 384; VDNT[i2] = (f16)args.in[9][cc * 32 + j2]; }
              else { const int i2 = i - 110592, n = i2 / 32, j2 = i2 % 32; VUPT[i2] = (f16)args.in[10][j2 * 384 + n]; } } }
    }
    grid.sync();
#pragma unroll 1
    for (int l = 0; l < DEPTH; ++l) {
        { pg8::Gemm g{XN, (const unsigned short*)(ws + WS_WIN + l * WIN_L), M, NU, DM}; pg8::StaticOrder S; S.init(M, NU, G, (int)blockIdx.x);
          pg8::EpiF16 E{(unsigned short*)(ws + WS_U), NU};
          pg8::gemm_phase<pg8::EpiF16, pg8::StaticOrder, true, true>(lds, g, S, E, wave); }
        grid.sync();
        for (int task = blockIdx.x; task < BATCH * NCH; task += G) phaseA(args, l, task, lds, TID_NOW());
        grid.sync();
        phaseB(args, lds, TID_NOW());
        grid.sync();
        for (int task = blockIdx.x; task < BATCH * NCH; task += G) phaseC(args, l, task, lds, TID_NOW());
        grid.sync();
        { pg8::Gemm g{(const unsigned short*)(ws + WS_MIX), (const unsigned short*)(ws + WS_WOUT + l * WOUT_L), M, DM, DM}; pg8::StaticOrder S; S.init(M, DM, G, (int)blockIdx.x);
          pg8::EpiRes E{l == 0 ? args.in[0] : args.out, args.out, DM};
          pg8::gemm_phase<pg8::EpiRes, pg8::StaticOrder, true, true>(lds, g, S, E, wave); }
        grid.sync();
        { int ln = TID_NOW() & 63; asm volatile("" : "+v"(ln));
          if (l + 1 < DEPTH) { for (int m = gw; m < M; m += NGW) rms_row_f16(args.out + (size_t)m * DM, args.in[1] + (l + 1) * DM, XN + (size_t)m * DM, ln); grid.sync(); }
          else { for (int m = gw; m < M; m += NGW) rms_row_f32(args.out + (size_t)m * DM, args.in[26], ln); } }
    }
}

extern "C" void kernel_launch(void* const* d_in, const int* in_sizes, int n_in, void* d_out, int out_size, void* d_ws, size_t ws_size, hipStream_t stream) {
    static int grid = 0;
    if (grid == 0) {
        if (n_in != 27 || in_sizes[0] != M * DM || out_size != M * DM || ws_size < WS_END) { fprintf(stderr, "kernel_launch: unexpected problem: n_in %d in0 %d out %d ws %zu\n", n_in, n_in > 0 ? in_sizes[0] : -1, out_size, ws_size); grid = -1; return; }
        int dev = 0, cus = 0, per_cu = 0;
        hipGetDevice(&dev); hipDeviceGetAttribute(&cus, hipDeviceAttributeMultiprocessorCount, dev);
        if (hipFuncSetAttribute((const void*)fwd, hipFuncAttributeMaxDynamicSharedMemorySize, LDS_BYTES) != hipSuccess) { fprintf(stderr, "kernel_launch: hipFuncSetAttribute failed\n"); grid = -1; return; }
        if (hipOccupancyMaxActiveBlocksPerMultiprocessor(&per_cu, (const void*)fwd, NT, LDS_BYTES) != hipSuccess || per_cu < 1) { fprintf(stderr, "kernel_launch: occupancy query failed (%d)\n", per_cu); grid = -1; return; }
        grid = cus * per_cu;
    }
    if (grid < 0) return;
    Args a{};
    for (int i = 0; i < 27; ++i) a.in[i] = (const float*)d_in[i];
    a.out = (float*)d_out; a.ws = (unsigned char*)d_ws;
    void* kargs[] = {&a};
    hipError_t e = hipLaunchCooperativeKernel((const void*)fwd, dim3(grid), dim3(NT), kargs, LDS_BYTES, stream);
    if (e != hipSuccess) fprintf(stderr, "cooperative launch failed: %s (grid %d)\n", hipGetErrorString(e), grid);
}
```

```cpp
#include <hip/hip_runtime.h>
#include <hip/hip_cooperative_groups.h>
#include <cstdio>
#include <cstdint>
namespace cg = cooperative_groups;
typedef _Float16 f16x8_t __attribute__((ext_vector_type(8)));
#define MK_MFMA(a, b, c) __builtin_amdgcn_mfma_f32_16x16x32_f16(__builtin_bit_cast(f16x8_t, (a)), __builtin_bit_cast(f16x8_t, (b)), (c), 0, 0, 0)
__device__ __forceinline__ int lane_now() { int z; asm volatile("v_mbcnt_lo_u32_b32 %0, -1, 0\n\tv_mbcnt_hi_u32_b32 %0, -1, %0" : "=v"(z)); return z; }
namespace pg8 {
#define PG8_LAS __attribute__((address_space(3)))
typedef unsigned short bf16_t;
typedef short bf16x8 __attribute__((ext_vector_type(8)));
typedef float f32x4 __attribute__((ext_vector_type(4)));
typedef unsigned u32x4 __attribute__((ext_vector_type(4)));
constexpr int BM = 256, BK = 64, HALF = 128, HTB = HALF * BK * 2  , STAGE_BYTES = 8 * HTB, NXCD = 8, WGM = 8;

__host__ __device__ __forceinline__ int lds_byte(int r, int c) { const int st = (r >> 4) * 2 + (c >> 5), rr = r & 15, cc = c & 31, ob = rr * 64 + cc * 2; return st * 1024 + (ob ^ (((ob >> 9) & 1) << 5)); }
__host__ __device__ __forceinline__ void stage_rc(int b, int& R, int& C) { const int st = b / 1024, sb = b % 1024, swz = sb ^ (((sb >> 9) & 1) << 5); R = (st >> 1) * 16 + swz / 64; C = (st & 1) * 32 + (swz % 64) / 2; }
__host__ __device__ __forceinline__ int perm32(int rho) { const int n = rho >> 4, i = rho & 15; return 8 * (i >> 2) + 4 * n + (i & 3); }

struct Unit { int pm, pn; };
struct Gemm { const bf16_t* A; const bf16_t* Bt; int M, N, K; };

struct StaticOrder {
    int nM, nN, nwg, G, c;
    __host__ __device__ void init(int M, int N, int G_, int c_) { nM = M / BM; nN = N / BM; nwg = nM * nN; G = G_; c = c_; }
    __host__ __device__ bool next(int i, Unit& u) const {
        const long L = (long)i * G + c; if (L >= nwg) return false;
        int wgid = (int)L; { const int q = nwg / NXCD, r = nwg % NXCD, xcd = wgid % NXCD, off = wgid / NXCD; wgid = (xcd < r ? xcd * (q + 1) : r * (q + 1) + (xcd - r) * q) + off; }
        const int nig = WGM * nN, gid = wgid / nig, fm = gid * WGM, gsz = (nM - fm) < WGM ? (nM - fm) : WGM;
        u.pm = fm + ((wgid % nig) % gsz); u.pn = (wgid % nig) / gsz; return true;
    }
    __device__ __forceinline__ void a_ready(const Unit&) const {}
    __device__ __forceinline__ void done(const Unit&) const {}
};

__device__ __forceinline__ unsigned pk_f16(float lo, float hi) { typedef _Float16 h2 __attribute__((ext_vector_type(2))); h2 v; v.x = (_Float16)lo; v.y = (_Float16)hi; return __builtin_bit_cast(unsigned, v); }
struct EpiF16 {
    static constexpr bool PERM = true, AFTER_DRAIN = false;
    bf16_t* O; int ldc;
    __device__ __forceinline__ void operator()(const f32x4 (&acc)[2][2][4][2], const Unit& u, int wr, int wc, int fr, int fq) const {
        const int row0 = u.pm * BM + wr * 64 + fr; const int col0 = u.pn * BM + wc * 32 + 8 * fq;
#pragma unroll
        for (int ai = 0; ai < 2; ++ai)
#pragma unroll
            for (int m = 0; m < 4; ++m) { bf16_t* rowp = O + (size_t)(row0 + ai * HALF + m * 16) * ldc + col0;
#pragma unroll
                for (int bj = 0; bj < 2; ++bj) { const f32x4 v0 = acc[ai][bj][m][0], v1 = acc[ai][bj][m][1];
                    u32x4 w; w.x = pk_f16(v0[0], v0[1]); w.y = pk_f16(v0[2], v0[3]); w.z = pk_f16(v1[0], v1[1]); w.w = pk_f16(v1[2], v1[3]);
                    *(u32x4*)(rowp + bj * HALF) = w; } }
    }
};
struct EpiRes {
    static constexpr bool PERM = false, AFTER_DRAIN = false;
    const float* base; float* out; int ldc;
    __device__ __forceinline__ void operator()(const f32x4 (&acc)[2][2][4][2], const Unit& u, int wr, int wc, int fr, int fq) const {
        const int row0 = u.pm * BM + wr * 64 + fr; const int col0 = u.pn * BM + wc * 32 + 4 * fq;
#pragma unroll
        for (int ai = 0; ai < 2; ++ai)
#pragma unroll
            for (int m = 0; m < 4; ++m) { const size_t off = (size_t)(row0 + ai * HALF + m * 16) * ldc + col0;
#pragma unroll
                for (int bj = 0; bj < 2; ++bj)
#pragma unroll
                    for (int n = 0; n < 2; ++n) { const size_t o = off + bj * HALF + n * 16; const f32x4 b = *(const f32x4*)(base + o); *(f32x4*)(out + o) = b + acc[ai][bj][m][n]; }
                asm volatile("" ::: "memory"); }
    }
};

template <class Epi, class Sched, bool ALIGN_EPI = false, bool SP2 = false>
__device__ __forceinline__ void gemm_phase(PG8_LAS unsigned char* lds, const Gemm g, const Sched& S, const Epi& E, const int wave_) {
    int tid_ = lane_now() + 64 * wave_; const int tid = tid_, wid = wave_, lane = tid & 63, wr = wid >> 2, wc = wid & 3, fr = lane & 15, fq = lane >> 4;
    const int K = g.K, nt = K / BK;
    unsigned voffA[2], voffB[2];
#pragma unroll
    for (int i = 0; i < 2; ++i) { int R, C; stage_rc(tid * 16 + i * 8192, R, C); const int Rb = Epi::PERM ? ((R & ~31) + perm32(R & 31)) : R;
        voffA[i] = (unsigned)(R * K + C) * 2u; voffB[i] = (unsigned)(Rb * K + C) * 2u; }
    const size_t kstep = (size_t)(BK * 2);
    const size_t hstep = (size_t)HALF * K * 2;
    const size_t tstep = 2 * hstep;
    const unsigned ldsw = (unsigned)wid * 1024u;
    const int aoff = lds_byte(wr * 64 + fr, fq * 8), boff = lds_byte(wc * 32 + fr, fq * 8);
#define PG8_SA(b, h) (((b) * 2 + (h)) * HTB)
#define PG8_SB(b, h) ((4 + (b) * 2 + (h)) * HTB)
#define PG8_STAGE(bufoff, gbase, voff) do { _Pragma("unroll") for (int _i = 0; _i < 2; ++_i) \
        __builtin_amdgcn_global_load_lds((const unsigned*)((const char*)(gbase) + (voff)[_i]), (PG8_LAS unsigned*)(lds + (bufoff) + ldsw + _i * 8192), 16, 0, 0); } while (0)
#define PG8_LDA(dst, b, h) do { _Pragma("unroll") for (int m = 0; m < 4; ++m) _Pragma("unroll") for (int k = 0; k < 2; ++k) dst[m][k] = *(const PG8_LAS bf16x8*)(lds + PG8_SA(b, h) + aoff + m * 2048 + k * 1024); } while (0)
#define PG8_LDB(dst, b, h) do { _Pragma("unroll") for (int n = 0; n < 2; ++n) _Pragma("unroll") for (int k = 0; k < 2; ++k) dst[n][k] = *(const PG8_LAS bf16x8*)(lds + PG8_SB(b, h) + boff + n * 2048 + k * 1024); } while (0)
#define PG8_MMA(ai, bj, At, Bt) do { __builtin_amdgcn_s_setprio(1); _Pragma("unroll") for (int m = 0; m < 4; ++m) _Pragma("unroll") for (int n = 0; n < 2; ++n) _Pragma("unroll") for (int k = 0; k < 2; ++k) \
        acc[ai][bj][m][n] = MK_MFMA(Bt[n][k], At[m][k], acc[ai][bj][m][n]); __builtin_amdgcn_s_setprio(0); } while (0)
#define PG8_WAIT_V(n) asm volatile("s_waitcnt vmcnt(" #n ")" ::: "memory")
#define PG8_WAIT_L(n) asm volatile("s_waitcnt lgkmcnt(" #n ")" ::: "memory")
#define PG8_BAR __builtin_amdgcn_s_barrier()
#define PG8_SCHED __builtin_amdgcn_sched_barrier(0)
    Unit cur, nxt; int ui = 0;
    if (!S.next(0, cur)) return;
    f32x4 acc[2][2][4][2];
#pragma unroll
    for (int a = 0; a < 2; ++a)
#pragma unroll
        for (int b = 0; b < 2; ++b)
#pragma unroll
            for (int m = 0; m < 4; ++m)
#pragma unroll
                for (int n = 0; n < 2; ++n) acc[a][b][m][n] = (f32x4){0.f, 0.f, 0.f, 0.f};
    bf16x8 At[4][2], B0[2][2], B1[2][2];
    const char* cA = (const char*)g.A + (size_t)cur.pm * tstep; const char* cB = (const char*)g.Bt + (size_t)cur.pn * tstep;
    S.a_ready(cur);
    if constexpr (SP2) {
        PG8_STAGE(PG8_SB(0, 0), cB, voffB); PG8_STAGE(PG8_SB(0, 1), cB + hstep, voffB); PG8_STAGE(PG8_SA(0, 0), cA, voffA); PG8_STAGE(PG8_SA(0, 1), cA + hstep, voffA);
        if (wr == 1) PG8_BAR;
        PG8_WAIT_V(2); PG8_BAR;
        PG8_STAGE(PG8_SB(1, 0), cB + kstep, voffB); PG8_STAGE(PG8_SA(1, 0), cA + kstep, voffA); PG8_STAGE(PG8_SB(1, 1), cB + hstep + kstep, voffB);
        PG8_WAIT_V(6); PG8_BAR;
    } else {
        PG8_STAGE(PG8_SB(0, 0), cB, voffB); PG8_STAGE(PG8_SA(0, 0), cA, voffA); PG8_STAGE(PG8_SB(0, 1), cB + hstep, voffB); PG8_STAGE(PG8_SA(0, 1), cA + hstep, voffA);
        if (wr == 1) PG8_BAR;
        PG8_WAIT_V(4); PG8_BAR;
        PG8_STAGE(PG8_SB(1, 0), cB + kstep, voffB); PG8_STAGE(PG8_SA(1, 0), cA + kstep, voffA); PG8_STAGE(PG8_SB(1, 1), cB + hstep + kstep, voffB);
        PG8_WAIT_V(6); PG8_BAR;
    }
    for (;;) {
        const bool has_next = S.next(ui + 1, nxt);
        const char* nA = has_next ? (const char*)g.A + (size_t)nxt.pm * tstep : cA; const char* nB = has_next ? (const char*)g.Bt + (size_t)nxt.pn * tstep : cB;
        for (int t = 0; t < nt; t += 2) {
            const bool last = (t == nt - 2);
            const char* a1 = cA + (size_t)(t + 1) * kstep;
            const char* a2 = last ? nA : cA + (size_t)(t + 2) * kstep; const char* b2 = last ? nB : cB + (size_t)(t + 2) * kstep;
            const char* a3 = a2 + kstep; const char* b3 = b2 + kstep;
            if (last && has_next) S.a_ready(nxt);
            if constexpr (SP2) {
            PG8_LDB(B0, 0, 0); PG8_LDB(B1, 0, 1); PG8_SCHED; PG8_LDA(At, 0, 0); PG8_STAGE(PG8_SA(1, 1), a1 + hstep, voffA);
            PG8_WAIT_V(8); PG8_WAIT_L(0); PG8_BAR; PG8_MMA(0, 0, At, B0); PG8_MMA(0, 1, At, B1); PG8_BAR; PG8_SCHED;
            PG8_LDA(At, 0, 1); PG8_STAGE(PG8_SB(0, 0), b2, voffB); PG8_STAGE(PG8_SB(0, 1), b2 + hstep, voffB); PG8_STAGE(PG8_SA(0, 0), a2, voffA);
            PG8_WAIT_V(8); PG8_WAIT_L(0); PG8_BAR; PG8_MMA(1, 0, At, B0); PG8_MMA(1, 1, At, B1); PG8_BAR; PG8_SCHED;
            PG8_LDB(B0, 1, 0); PG8_LDB(B1, 1, 1); PG8_SCHED; PG8_LDA(At, 1, 0); PG8_STAGE(PG8_SA(0, 1), a2 + hstep, voffA);
            PG8_WAIT_V(8); PG8_WAIT_L(0); PG8_BAR; PG8_MMA(0, 0, At, B0); PG8_MMA(0, 1, At, B1); PG8_BAR; PG8_SCHED;
            PG8_LDA(At, 1, 1); PG8_STAGE(PG8_SB(1, 0), b3, voffB); PG8_STAGE(PG8_SB(1, 1), b3 + hstep, voffB); PG8_STAGE(PG8_SA(1, 0), a3, voffA);
            PG8_WAIT_V(8); PG8_WAIT_L(0); PG8_BAR; PG8_MMA(1, 0, At, B0); PG8_MMA(1, 1, At, B1); PG8_BAR; PG8_SCHED;
            } else {
            PG8_LDB(B0, 0, 0); PG8_SCHED; PG8_LDA(At, 0, 0); PG8_STAGE(PG8_SA(1, 1), a1 + hstep, voffA);
            PG8_WAIT_L(8); PG8_BAR; PG8_WAIT_L(0); PG8_MMA(0, 0, At, B0); PG8_BAR; PG8_SCHED;
            PG8_LDB(B1, 0, 1); PG8_STAGE(PG8_SB(0, 0), b2, voffB);
            PG8_BAR; PG8_WAIT_L(0); PG8_MMA(0, 1, At, B1); PG8_BAR;
            PG8_LDA(At, 0, 1); PG8_STAGE(PG8_SA(0, 0), a2, voffA);
            PG8_BAR; PG8_WAIT_L(0); PG8_MMA(1, 0, At, B0); PG8_BAR; PG8_SCHED;
            PG8_STAGE(PG8_SB(0, 1), b2 + hstep, voffB);
            PG8_WAIT_V(6); PG8_BAR; PG8_MMA(1, 1, At, B1); PG8_BAR;
            PG8_LDB(B0, 1, 0); PG8_SCHED; PG8_LDA(At, 1, 0); PG8_STAGE(PG8_SA(0, 1), a2 + hstep, voffA);
            PG8_WAIT_L(8); PG8_BAR; PG8_WAIT_L(0); PG8_MMA(0, 0, At, B0); PG8_BAR; PG8_SCHED;
            PG8_LDB(B1, 1, 1); PG8_STAGE(PG8_SB(1, 0), b3, voffB);
            PG8_BAR; PG8_WAIT_L(0); PG8_MMA(0, 1, At, B1); PG8_BAR;
            PG8_LDA(At, 1, 1); PG8_STAGE(PG8_SA(1, 0), a3, voffA);
            PG8_BAR; PG8_WAIT_L(0); PG8_MMA(1, 0, At, B0); PG8_BAR; PG8_SCHED;
            PG8_STAGE(PG8_SB(1, 1), b3 + hstep, voffB);
            PG8_WAIT_V(6); PG8_BAR; PG8_MMA(1, 1, At, B1); PG8_BAR;
            }
        }
        if constexpr (ALIGN_EPI) { if (wr == 0) PG8_BAR; }
        if constexpr (!Epi::AFTER_DRAIN) { E(acc, cur, wr, wc, fr, fq); S.done(cur); }
        if (!has_next) break;
#pragma unroll
        for (int a = 0; a < 2; ++a)
#pragma unroll
            for (int b = 0; b < 2; ++b)
#pragma unroll
                for (int m = 0; m < 4; ++m)
#pragma unroll
                    for (int n = 0; n < 2; ++n) acc[a][b][m][n] = (f32x4){0.f, 0.f, 0.f, 0.f};
        cur = nxt; cA = nA; cB = nB; ++ui;
        if constexpr (ALIGN_EPI) { if (wr == 1) PG8_BAR; }
    }
    PG8_WAIT_V(0);
    if constexpr (!ALIGN_EPI) { if (wr == 0) PG8_BAR; }
    PG8_BAR;
    if constexpr (Epi::AFTER_DRAIN) { E.fused(acc, cur, wr, wc, fr, fq, lds, wid, lane); S.done(cur); }
#undef PG8_SA
#undef PG8_SB
#undef PG8_STAGE
#undef PG8_LDA
#undef PG8_LDB
#undef PG8_MMA
#undef PG8_WAIT_V
#undef PG8_WAIT_L
#undef PG8_BAR
#undef PG8_SCHED
}
}

constexpr int BATCH = 2, SEQ = 8192, DM = 1024, DEPTH = 2, M = BATCH * SEQ;
constexpr int RW_H = 6, HD = 64, RW_W = 384, RW_SHIFT = 1280;
constexpr int NIN = 3712, NU = 3840;
constexpr int C_R = 0, C_K = 384, C_V = 768, C_WL = 1152, C_AL = 1216, C_RWZ = 1280, C_HGQ = 1664, C_HGF = 2048, C_HGI = 2432, C_HGZ = 2816, C_LRUX = 3200, C_LRUZ = 3456;
constexpr int CH = 64;
constexpr int NWAVES = 8, NT = NWAVES * 64;
constexpr int LDS_BYTES = 147456;
constexpr size_t MiB = 1u << 20;
constexpr size_t WS_WUPT = 65536, WS_AUPT = WS_WUPT + 98304, WS_VDNT = WS_AUPT + 98304, WS_VUPT = WS_VDNT + 24576;
constexpr size_t WS_WIN = 1 * MiB, WIN_L = (size_t)NU * DM * 2;
constexpr size_t WS_WOUT = 16 * MiB, WOUT_L = (size_t)DM * DM * 2;
constexpr size_t WS_XN = 20 * MiB;
constexpr size_t WS_QT = 20 * MiB;
constexpr size_t WS_PT = 32 * MiB;
constexpr size_t WS_CA = 44 * MiB;
constexpr size_t WS_U = 52 * MiB;
constexpr size_t WS_MIX = 172 * MiB;
constexpr size_t WS_VF = 204 * MiB;
constexpr size_t WS_VP = 216 * MiB;
constexpr size_t WS_RL = 228 * MiB;
constexpr size_t WS_HL = 240 * MiB;
constexpr size_t WS_BON = 252 * MiB;
constexpr size_t WS_DC = WS_BON + 512 * 1024;
constexpr size_t WS_LA = WS_DC + 512 * 1024;
constexpr size_t WS_LH = WS_LA + 256 * 1024;
constexpr size_t WS_END = 254 * MiB;
constexpr int NCH = SEQ / CH;

#define LAS __attribute__((address_space(3)))
typedef float f32x4 __attribute__((ext_vector_type(4)));
typedef unsigned u32x2 __attribute__((ext_vector_type(2)));
typedef unsigned u32x4 __attribute__((ext_vector_type(4)));
typedef _Float16 f16;
typedef _Float16 f16x8 __attribute__((ext_vector_type(8)));
#define LDS_WAIT() asm volatile("s_waitcnt lgkmcnt(0)" ::: "memory")

struct Args { const float* in[27]; float* out; unsigned char* ws; };

__device__ __forceinline__ float wave_sum(float v) {
#pragma unroll
    for (int o = 1; o < 64; o <<= 1) v += __shfl_xor(v, o);
    return v;
}
__device__ __forceinline__ float sigmoidf_(float x) { return 1.0f / (1.0f + __expf(-x)); }
__device__ __forceinline__ float siluf_(float x) { return x / (1.0f + __expf(-x)); }

__device__ __forceinline__ void p0_transpose_item(const float* W, int K, int N, unsigned short* WT, LAS float* scr, int item, int lane) {
    const int nblk = N / 32, kb = item / nblk, nb = item % nblk, k0 = 64 * kb, n0 = 32 * nb;
#pragma unroll 8
    for (int i = 0; i < 32; ++i) { const int kk = 2 * i + (lane >> 5); scr[kk * 33 + (lane & 31)] = W[(size_t)(k0 + kk) * N + n0 + (lane & 31)]; }
    LDS_WAIT(); asm volatile("" ::: "memory");
    const int c = lane & 7;
#pragma unroll
    for (int j = 0; j < 4; ++j) { const int n = (lane >> 3) + 8 * j; const LAS float* s = scr + (8 * c) * 33 + n;
        u32x4 o; o.x = pg8::pk_f16(s[0 * 33], s[1 * 33]); o.y = pg8::pk_f16(s[2 * 33], s[3 * 33]); o.z = pg8::pk_f16(s[4 * 33], s[5 * 33]); o.w = pg8::pk_f16(s[6 * 33], s[7 * 33]);
        *(u32x4*)(WT + (size_t)(n0 + n) * K + k0 + 8 * c) = o; }
    LDS_WAIT(); asm volatile("" ::: "memory");
}
__device__ __forceinline__ void rms_row_f16(const float* xrow, const float* w, unsigned short* orow, int lane) {
    const f32x4* xr = (const f32x4*)xrow + lane; const f32x4* wr = (const f32x4*)w + lane;
    f32x4 v[4]; float s = 0.f;
#pragma unroll
    for (int j = 0; j < 4; ++j) { v[j] = xr[64 * j]; s += (v[j].x * v[j].x + v[j].y * v[j].y) + (v[j].z * v[j].z + v[j].w * v[j].w); }
    const float rs = 1.0f / sqrtf(wave_sum(s) * (1.0f / DM) + 1e-6f);
    u32x2* o8 = (u32x2*)orow + lane;
#pragma unroll
    for (int j = 0; j < 4; ++j) { const f32x4 ww = wr[64 * j]; u32x2 o; o.x = pg8::pk_f16(v[j].x * rs * ww.x, v[j].y * rs * ww.y); o.y = pg8::pk_f16(v[j].z * rs * ww.z, v[j].w * rs * ww.w); o8[64 * j] = o; }
}
__device__ __forceinline__ void rms_row_f32(float* xrow, const float* w, int lane) {
    f32x4* xr = (f32x4*)xrow + lane; const f32x4* wr = (const f32x4*)w + lane;
    f32x4 v[4]; float s = 0.f;
#pragma unroll
    for (int j = 0; j < 4; ++j) { v[j] = xr[64 * j]; s += (v[j].x * v[j].x + v[j].y * v[j].y) + (v[j].z * v[j].z + v[j].w * v[j].w); }
    const float rs = 1.0f / sqrtf(wave_sum(s) * (1.0f / DM) + 1e-6f);
#pragma unroll
    for (int j = 0; j < 4; ++j) { const f32x4 ww = wr[64 * j]; xr[64 * j] = v[j] * rs * ww; }
}


#define SHV(col) ({ const float cur_ = (float)urow[(col)]; const float prev_ = hp ? (float)prow[(col)] : 0.f; cur_ + mu[(col)] * (prev_ - cur_); })

__device__ __forceinline__ void store_row64_f16(f16* dst, const float (&S)[64]) {
#pragma unroll
    for (int q = 0; q < 8; ++q) { u32x4 w; w.x = pg8::pk_f16(S[8 * q], S[8 * q + 1]); w.y = pg8::pk_f16(S[8 * q + 2], S[8 * q + 3]); w.z = pg8::pk_f16(S[8 * q + 4], S[8 * q + 5]); w.w = pg8::pk_f16(S[8 * q + 6], S[8 * q + 7]); *(u32x4*)(dst + 8 * q) = w; }
}


constexpr int RWA_REC = 768, RWA_VPL = 16 * RWA_REC, RWA_SCR = RWA_VPL + 2048, RWA_BYTES = RWA_SCR + 1024;
typedef float f32x2 __attribute__((ext_vector_type(2)));
typedef _Float16 f16x4 __attribute__((ext_vector_type(4)));
__device__ __forceinline__ float fmix_lo(float a, unsigned b, float c) { float d; asm("v_fma_mix_f32 %0, %1, %2, %3 op_sel:[0,0,0] op_sel_hi:[0,1,0]" : "=v"(d) : "v"(a), "v"(b), "v"(c)); return d; }
__device__ __forceinline__ float fmix_hi(float a, unsigned b, float c) { float d; asm("v_fma_mix_f32 %0, %1, %2, %3 op_sel:[0,1,0] op_sel_hi:[0,1,0]" : "=v"(d) : "v"(a), "v"(b), "v"(c)); return d; }
__device__ __forceinline__ float mmix_lo(float a, unsigned b) { float d; asm("v_fma_mix_f32 %0, %1, %2, 0 op_sel:[0,0,0] op_sel_hi:[0,1,0]" : "=v"(d) : "v"(a), "v"(b)); return d; }
__device__ __forceinline__ float mmix_hi(float a, unsigned b) { float d; asm("v_fma_mix_f32 %0, %1, %2, 0 op_sel:[0,1,0] op_sel_hi:[0,1,0]" : "=v"(d) : "v"(a), "v"(b)); return d; }
__device__ __forceinline__ float fma_asm(float a, float b, float c) { float d; asm("v_fma_f32 %0, %1, %2, %3" : "=v"(d) : "v"(a), "v"(b), "v"(c)); return d; }
#define FMIX(a, u, j, c) (((j) & 1) ? fmix_hi((a), (u)[(j) >> 1], (c)) : fmix_lo((a), (u)[(j) >> 1], (c)))
#define MMIX(a, u, j) (((j) & 1) ? mmix_hi((a), (u)[(j) >> 1]) : mmix_lo((a), (u)[(j) >> 1]))
__device__ __forceinline__ float fast_tanh(float x) { return 1.0f - 2.0f / (__expf(2.0f * x) + 1.0f); }
__device__ __forceinline__ void lerp8(const char* ub, unsigned uo, unsigned po, bool hp, const char* mub, unsigned col, float (&x)[8]) {
    const f16x8 cu = *(const f16x8*)(ub + (uo + col * 2u)); f16x8 pv = *(const f16x8*)(ub + (po + col * 2u)); const f32x4 m0 = *(const f32x4*)(mub + col * 4u), m1 = *(const f32x4*)(mub + col * 4u + 16u);
#pragma unroll
    for (int j = 0; j < 8; ++j) { const float c = (float)cu[j], p = hp ? (float)pv[j] : 0.f; x[j] = c + (j < 4 ? m0[j] : m1[j - 4]) * (p - c); }
}
__device__ __forceinline__ void lerp4(const char* ub, unsigned uo, unsigned po, bool hp, const char* mub, unsigned col, float (&x)[4]) {
    const f16x4 cu = *(const f16x4*)(ub + (uo + col * 2u)); f16x4 pv = *(const f16x4*)(ub + (po + col * 2u)); const f32x4 m0 = *(const f32x4*)(mub + col * 4u);
#pragma unroll
    for (int j = 0; j < 4; ++j) { const float c = (float)cu[j], p = hp ? (float)pv[j] : 0.f; x[j] = c + m0[j] * (p - c); }
}
__device__ __forceinline__ f16x8 pack8(const float (&x)[8]) { f16x8 r;
#pragma unroll
    for (int j = 0; j < 8; ++j) r[j] = (f16)x[j];
    return r; }

__device__ __forceinline__ void rwkv_waveA(const Args& a, int l, int b, int c, int h, LAS unsigned char* wl, int lane) {
    const f16* U = (const f16*)(a.ws + WS_U); f16* MIX = (f16*)(a.ws + WS_MIX); f16* VF = (f16*)(a.ws + WS_VF); f16* VP = (f16*)(a.ws + WS_VP);
    f16* QT = (f16*)(a.ws + WS_QT); f16* PT = (f16*)(a.ws + WS_PT); f16* RL = (f16*)(a.ws + WS_RL); float* BONG = (float*)(a.ws + WS_BON);
    const f16* WUPT = (const f16*)(a.ws + WS_WUPT) + (size_t)l * 384 * 64; const f16* AUPT = (const f16*)(a.ws + WS_AUPT) + (size_t)l * 384 * 64;
    const f16* VDNT = (const f16*)(a.ws + WS_VDNT); const f16* VUPT = (const f16*)(a.ws + WS_VUPT);
    const float* mu = a.in[3] + l * RW_SHIFT; const float* w0 = a.in[4] + l * RW_W; const float* a0 = a.in[6] + l * RW_W; const float* v0 = a.in[8];
    const float* k_k = a.in[11] + l * RW_W; const float* k_a = a.in[12] + l * RW_W; const float* r_k = a.in[13] + l * RW_W;
    const int bh = b * RW_H + h;
    float P[64], L[64];
#pragma unroll
    for (int k = 0; k < 64; ++k) { P[k] = (k == lane) ? 1.f : 0.f; L[k] = 0.f; }
#pragma unroll 1
    for (int blk = 0; blk < 4; ++blk) {
        int lane_ = lane; asm volatile("" : "+v"(lane_));
        const int tok = lane_ & 15, fq = lane_ >> 4;
        const int t = c * CH + blk * 16 + tok; const unsigned m = (unsigned)(b * SEQ + t); const bool hp = t > 0;
        const char* ub = (const char*)U; const char* mub = (const char*)mu; const unsigned uo = m * (unsigned)(NU * 2), po = hp ? uo - (unsigned)(NU * 2) : uo;
        f16x8 bW[2], bA[2], bVD;
#pragma unroll
        for (int s = 0; s < 2; ++s) {
            float x[8]; lerp8(ub, uo, po, hp, mub, (unsigned)(C_WL + 8 * fq + 32 * s), x);
#pragma unroll
            for (int j = 0; j < 8; ++j) x[j] = fast_tanh(x[j]);
            bW[s] = pack8(x);
            lerp8(ub, uo, po, hp, mub, (unsigned)(C_AL + 8 * fq + 32 * s), x);
            bA[s] = pack8(x);
            asm volatile("" ::: "memory");
        }
        if (l > 0) {
            f32x4 VD0 = (f32x4){0.f, 0.f, 0.f, 0.f}, VD1 = VD0;
#pragma unroll 1
            for (int s = 0; s < 12; ++s) {
                float x[8]; lerp8(ub, uo, po, hp, mub, (unsigned)(C_V + 8 * fq + 32 * s), x);
                const f16x8 bv = pack8(x);
                VD0 = __builtin_amdgcn_mfma_f32_16x16x32_f16(*(const f16x8*)((const char*)VDNT + (unsigned)(tok * 384 + 8 * fq + 32 * s) * 2u), bv, VD0, 0, 0, 0);
                VD1 = __builtin_amdgcn_mfma_f32_16x16x32_f16(*(const f16x8*)((const char*)VDNT + (unsigned)((16 + tok) * 384 + 8 * fq + 32 * s) * 2u), bv, VD1, 0, 0, 0);
            }
            LAS f16* scr = (LAS f16*)(wl + RWA_SCR);
            { f16x4 p0, p1;
#pragma unroll
              for (int i = 0; i < 4; ++i) { p0[i] = (f16)VD0[i]; p1[i] = (f16)VD1[i]; }
              *(LAS f16x4*)(scr + tok * 32 + 4 * fq) = p0; *(LAS f16x4*)(scr + tok * 32 + 16 + 4 * fq) = p1; }
            asm volatile("s_waitcnt lgkmcnt(0)" ::: "memory");
            bVD = *(const LAS f16x8*)(scr + tok * 32 + 8 * fq);
        }
        float ssq = 0.f;
#pragma unroll 1
        for (int nt = 0; nt < 4; ++nt) { const int cb = h * 64 + 16 * nt + 4 * fq; float ks[4]; lerp4(ub, uo, po, hp, mub, (unsigned)(C_K + cb), ks); const f32x4 kk4 = *(const f32x4*)((const char*)k_k + (unsigned)cb * 4u);
#pragma unroll
            for (int i = 0; i < 4; ++i) { const float kv = ks[i] * kk4[i]; ssq += kv * kv; }
            asm volatile("" ::: "memory"); }
        ssq += __shfl_xor(ssq, 16); ssq += __shfl_xor(ssq, 32);
        const float inv = 1.0f / fmaxf(sqrtf(ssq), 1e-12f);
        float bon = 0.f;
        LAS unsigned char* rec = wl + tok * RWA_REC;
#pragma unroll 1
        for (int nt = 0; nt < 4; ++nt) {
            const int cb = h * 64 + 16 * nt + 4 * fq, co = 16 * nt + 4 * fq; const int n = h * 64 + 16 * nt + tok;
            f32x4 DWn = (f32x4){0.f, 0.f, 0.f, 0.f}, DAn = DWn, Gn = DWn;
#pragma unroll
            for (int s = 0; s < 2; ++s) {
                DWn = __builtin_amdgcn_mfma_f32_16x16x32_f16(*(const f16x8*)((const char*)WUPT + (unsigned)(n * 64 + 8 * fq + 32 * s) * 2u), bW[s], DWn, 0, 0, 0);
                DAn = __builtin_amdgcn_mfma_f32_16x16x32_f16(*(const f16x8*)((const char*)AUPT + (unsigned)(n * 64 + 8 * fq + 32 * s) * 2u), bA[s], DAn, 0, 0, 0); }
            if (l > 0) Gn = __builtin_amdgcn_mfma_f32_16x16x32_f16(*(const f16x8*)((const char*)VUPT + (unsigned)(n * 32 + 8 * fq) * 2u), bVD, Gn, 0, 0, 0);
            float rs[4], ks[4], vs[4];
            lerp4(ub, uo, po, hp, mub, (unsigned)(C_R + cb), rs); lerp4(ub, uo, po, hp, mub, (unsigned)(C_K + cb), ks); lerp4(ub, uo, po, hp, mub, (unsigned)(C_V + cb), vs);
            const unsigned cb4 = (unsigned)cb * 4u; const f32x4 w04 = *(const f32x4*)((const char*)w0 + cb4), a04 = *(const f32x4*)((const char*)a0 + cb4), kk4 = *(const f32x4*)((const char*)k_k + cb4), ka4 = *(const f32x4*)((const char*)k_a + cb4), rk4 = *(const f32x4*)((const char*)r_k + cb4);
            f32x4 wv; f16x4 al, be, km, rr, vo;
            f16x4 vf4; f32x4 v04;
            const unsigned vo_b = (m * (unsigned)RW_W + (unsigned)cb) * 2u;
            if (l > 0) { vf4 = *(const f16x4*)((const char*)VF + vo_b); v04 = *(const f32x4*)((const char*)v0 + cb4); }
#pragma unroll
            for (int i = 0; i < 4; ++i) {
                wv[i] = __expf(-0.6065306597126334f * sigmoidf_(w04[i] + DWn[i]));
                const float aa = sigmoidf_(a04[i] + DAn[i]);
                float vv = vs[i];
                if (l > 0) vv = vs[i] + ((float)vf4[i] - vs[i]) * sigmoidf_(v04[i] + Gn[i]);
                const float kk = ks[i] * kk4[i] * inv;
                const float kmod = ks[i] * (1.0f + (aa - 1.0f) * ka4[i]);
                bon += rs[i] * kmod * rk4[i];
                al[i] = (f16)(-kk); be[i] = (f16)(kk * aa); km[i] = (f16)kmod; rr[i] = (f16)rs[i]; vo[i] = (f16)vv;
            }
            *(LAS f32x4*)(rec + co * 4) = wv;
            *(LAS f16x4*)(rec + 256 + co * 2) = al; *(LAS f16x4*)(rec + 384 + co * 2) = be; *(LAS f16x4*)(rec + 512 + co * 2) = km; *(LAS f16x4*)(rec + 640 + co * 2) = rr;
            *(LAS f16x4*)(wl + RWA_VPL + tok * 128 + co * 2) = vo;
            *(f16x4*)((char*)VP + vo_b) = vo;
            if (l == 0) *(f16x4*)((char*)VF + vo_b) = vo;
            asm volatile("" ::: "memory");
        }
        bon += __shfl_xor(bon, 16); bon += __shfl_xor(bon, 32);
        if (fq == 0) *(float*)((char*)BONG + (m * 8u + (unsigned)h) * 4u) = bon;
        const unsigned mb = (unsigned)(b * SEQ + c * CH + blk * 16);
#pragma unroll 1
        for (int t2 = 0; t2 < 16; ++t2) {
            const LAS unsigned char* rc = wl + t2 * RWA_REC;
            const float vv = (float)*(const LAS f16*)(wl + RWA_VPL + t2 * 128 + lane * 2);
            float sP0 = 0.f, sP1 = 0.f, sL0 = 0.f, sL1 = 0.f;
#pragma unroll
            for (int g = 0; g < 8; ++g) { const u32x4 a4 = *(const LAS u32x4*)(rc + 256 + g * 16);
#pragma unroll
                for (int j = 0; j < 8; j += 2) { sP0 = FMIX(P[8 * g + j], a4, j, sP0); sL0 = FMIX(L[8 * g + j], a4, j, sL0); sP1 = FMIX(P[8 * g + j + 1], a4, j + 1, sP1); sL1 = FMIX(L[8 * g + j + 1], a4, j + 1, sL1); } }
            const float saP = sP0 + sP1, saL = sL0 + sL1;
            float q0 = 0.f, q1 = 0.f, y0 = 0.f, y1 = 0.f;
#pragma unroll
            for (int g = 0; g < 8; ++g) {
                const f32x4 wA = *(const LAS f32x4*)(rc + g * 32), wB = *(const LAS f32x4*)(rc + g * 32 + 16);
                const u32x4 b4 = *(const LAS u32x4*)(rc + 384 + g * 16), k4 = *(const LAS u32x4*)(rc + 512 + g * 16), r4 = *(const LAS u32x4*)(rc + 640 + g * 16);
#pragma unroll
                for (int j = 0; j < 8; ++j) { const int k = 8 * g + j; const float w = (j < 4) ? wA[j] : wB[j - 4];
                    const float tP = MMIX(saP, b4, j); float tL = MMIX(saL, b4, j); tL = FMIX(vv, k4, j, tL);
                    P[k] = fma_asm(P[k], w, tP); L[k] = fma_asm(L[k], w, tL);
                    if (j & 1) { q1 = FMIX(P[k], r4, j, q1); y1 = FMIX(L[k], r4, j, y1); } else { q0 = FMIX(P[k], r4, j, q0); y0 = FMIX(L[k], r4, j, y0); } }
            }
            *(f16*)((char*)MIX + ((mb + t2) * (unsigned)DM + (unsigned)(h * 64 + lane)) * 2u) = (f16)(y0 + y1);
            *(f16*)((char*)QT + ((mb + t2) * (unsigned)RW_W + (unsigned)(h * 64 + lane)) * 2u) = (f16)(q0 + q1);
        }
    }
    store_row64_f16(RL + (((size_t)bh * NCH + c) * 64 + lane) * 64, L);
    f16* pt = PT + ((size_t)bh * NCH + c) * 4096;
#pragma unroll
    for (int k = 0; k < 64; ++k) pt[k * 64 + lane] = (f16)P[k];
}

constexpr int HGA_REC = 512, HGA_HEAD = 16 * HGA_REC, HGA_BYTES = 3 * HGA_HEAD;
__device__ __forceinline__ void hgrn_waveA(const Args& a, int l, int b, int c, int h0, LAS unsigned char* wl, int lane) {
    const f16* U = (const f16*)(a.ws + WS_U); f16* MIX = (f16*)(a.ws + WS_MIX); f16* HL = (f16*)(a.ws + WS_HL); float* DC = (float*)(a.ws + WS_DC);
    const float* lbr = a.in[16];
    float S0[64], S1[64], S2[64];
#pragma unroll
    for (int k = 0; k < 64; ++k) { S0[k] = 0.f; S1[k] = 0.f; S2[k] = 0.f; }
    float dp0 = 1.f, dp1 = 1.f, dp2 = 1.f;
#pragma unroll 1
    for (int blk = 0; blk < 4; ++blk) {
        int lane_ = lane; asm volatile("" : "+v"(lane_));
        const unsigned mb = (unsigned)(b * SEQ + c * CH + blk * 16);
#pragma unroll 1
        for (int j = 0; j < 3; ++j) {
            const int col = (h0 + j) * 64 + lane_;
            const float lb = (l == 0) ? 0.f : sigmoidf_(lbr[384 + col] - lbr[col]);
            float dp = 1.f;
#pragma unroll 4
            for (int tk = 0; tk < 16; ++tk) {
                const char* ur = (const char*)U + (mb + tk) * (unsigned)(NU * 2);
                const float f = lb + (1.0f - lb) * sigmoidf_((float)*(const f16*)(ur + (unsigned)(C_HGF + col) * 2u));
                const f16 q = *(const f16*)(ur + (unsigned)(C_HGQ + col) * 2u);
                LAS unsigned char* rec = wl + j * HGA_HEAD + tk * HGA_REC;
                *(LAS float*)(rec + lane_ * 4) = f; *(LAS f16*)(rec + 256 + lane_ * 2) = (f16)(1.0f - f); *(LAS f16*)(rec + 384 + lane_ * 2) = q;
                dp *= f;
            }
            if (j == 0) dp0 *= dp; else if (j == 1) dp1 *= dp; else dp2 *= dp;
        }
#pragma unroll 1
        for (int t2 = 0; t2 < 16; ++t2) {
            const char* ur = (const char*)U + (mb + t2) * (unsigned)(NU * 2);
            const float v0 = (float)*(const f16*)(ur + (unsigned)(C_HGI + h0 * 64 + lane_) * 2u);
            const float v1 = (float)*(const f16*)(ur + (unsigned)(C_HGI + h0 * 64 + 64 + lane_) * 2u);
            const float v2 = (float)*(const f16*)(ur + (unsigned)(C_HGI + h0 * 64 + 128 + lane_) * 2u);
#define HG_STEP(S, vi, j, oo) { const LAS unsigned char* rc = wl + (j) * HGA_HEAD + t2 * HGA_REC; float o0 = 0.f, o1 = 0.f; \
            _Pragma("unroll") for (int g = 0; g < 8; ++g) { \
                const f32x4 fA = *(const LAS f32x4*)(rc + g * 32), fB = *(const LAS f32x4*)(rc + g * 32 + 16); \
                const u32x4 k4 = *(const LAS u32x4*)(rc + 256 + g * 16), q4 = *(const LAS u32x4*)(rc + 384 + g * 16); \
                _Pragma("unroll") for (int jj = 0; jj < 8; ++jj) { const int k = 8 * g + jj; const float f = (jj < 4) ? fA[jj] : fB[jj - 4]; \
                    const float tt = MMIX(vi, k4, jj); S[k] = fma_asm(S[k], f, tt); \
                    if (jj & 1) o1 = FMIX(S[k], q4, jj, o1); else o0 = FMIX(S[k], q4, jj, o0); } } \
            oo = o0 + o1; }
            float oa, ob, oc;
            HG_STEP(S0, v0, 0, oa) HG_STEP(S1, v1, 1, ob) HG_STEP(S2, v2, 2, oc)
#undef HG_STEP
            char* mo = (char*)MIX + ((mb + t2) * (unsigned)DM + (unsigned)(384 + h0 * 64 + lane_)) * 2u;
            *(f16*)mo = (f16)oa; *(f16*)(mo + 128) = (f16)ob; *(f16*)(mo + 256) = (f16)oc;
        }
    }
#define HG_OUT(S, j, dp) { const int bh = b * 6 + h0 + (j); f16* hl = HL + ((size_t)bh * NCH + c) * 4096; \
        _Pragma("unroll") for (int k = 0; k < 64; ++k) hl[k * 64 + lane] = (f16)S[k]; \
        DC[((size_t)bh * NCH + c) * 64 + lane] = dp; }
    HG_OUT(S0, 0, dp0) HG_OUT(S1, 1, dp1) HG_OUT(S2, 2, dp2)
#undef HG_OUT
}
__device__ __forceinline__ void phaseA(const Args& a, int l, int task, LAS unsigned char* lds, int tid) {
    asm volatile("" : "+v"(tid));
    const int lane = tid & 63, wave = __builtin_amdgcn_readfirstlane(tid >> 6);
    const int b = task / NCH, c = task % NCH;
    const f16* U = (const f16*)(a.ws + WS_U); f16* MIX = (f16*)(a.ws + WS_MIX); f16* VF = (f16*)(a.ws + WS_VF); f16* VP = (f16*)(a.ws + WS_VP);
    f16* QT = (f16*)(a.ws + WS_QT); f16* PT = (f16*)(a.ws + WS_PT); f16* RL = (f16*)(a.ws + WS_RL); float* BONG = (float*)(a.ws + WS_BON);
    const int tt = tid >> 3, sub = tid & 7;
    const int t = c * CH + tt; const size_t m = (size_t)b * SEQ + t;
    const f16* urow = U + m * NU; const f16* prow = urow - NU; const bool hp = t > 0;
    if (wave < RW_H) rwkv_waveA(a, l, b, c, wave, lds + wave * RWA_BYTES, lane);
    else hgrn_waveA(a, l, b, c, 3 * (wave - RW_H), lds + RW_H * RWA_BYTES + (wave - RW_H) * HGA_BYTES, lane);
    __syncthreads();
    {
        f16* CA = (f16*)(a.ws + WS_CA); float* LA = (float*)(a.ws + WS_LA); float* LH = (float*)(a.ws + WS_LH);
        const float* cw = a.in[18] + l * 4 * 256; const float* cb = a.in[19] + l * 256;
        const float* ba = a.in[21] + l * 256; const float* bx = a.in[23] + l * 256; const float* lam = a.in[24] + l * 256;
        LAS float* Y = (LAS float*)lds; LAS float* AA = (LAS float*)(lds + 16384); LAS float* UU = (LAS float*)(lds + 32768);
#pragma unroll 1
        for (int g = 0; g < 4; ++g) {
            const float* wa = a.in[20] + (size_t)(l * 4 + g) * 4096; const float* wx = a.in[22] + (size_t)(l * 4 + g) * 4096;
#pragma unroll 1
            for (int i = 0; i < 8; ++i) { const int j = sub * 8 + i, ch = g * 64 + j; float y = cb[ch];
#pragma unroll
                for (int jj = 0; jj < 4; ++jj) { const int ts = t - 3 + jj; if (ts >= 0) y += cw[jj * 256 + ch] * (float)U[((size_t)b * SEQ + ts) * NU + C_LRUX + ch]; }
                Y[tt * 64 + j] = y; }
            __syncthreads();
#pragma unroll 1
            for (int i = 0; i < 8; ++i) { const int j = sub * 8 + i, ch = g * 64 + j; float ra = ba[ch], rx = bx[ch];
#pragma unroll 4
                for (int i2 = 0; i2 < 64; ++i2) { const float yv = Y[tt * 64 + i2]; ra += yv * wa[i2 * 64 + j]; rx += yv * wx[i2 * 64 + j]; }
                const float r = sigmoidf_(ra), ig = sigmoidf_(rx);
                const float la = -8.0f * r * log1pf(expf(-lam[ch]));
                AA[tt * 64 + j] = expf(la); UU[tt * 64 + j] = sqrtf(-expm1f(2.0f * la)) * (ig * Y[tt * 64 + j]); }
            __syncthreads();
            if (wave == 0) {
                const int ch = g * 64 + lane; float hst = 0.f, ap = 1.f;
                for (int t2 = 0; t2 < CH; ++t2) { const size_t m2 = (size_t)b * SEQ + c * CH + t2; const float av = AA[t2 * 64 + lane];
                    hst = av * hst + UU[t2 * 64 + lane]; ap *= av;
                    MIX[m2 * DM + 768 + ch] = (f16)hst; CA[m2 * 256 + ch] = (f16)ap; }
                LA[((size_t)b * NCH + c) * 256 + ch] = ap; LH[((size_t)b * NCH + c) * 256 + ch] = hst;
            }
            __syncthreads();
        }
    }
}

__device__ __forceinline__ void phaseB(const Args& a, LAS unsigned char* lds, int tid) {
    asm volatile("" : "+v"(tid));
    const int lane = tid & 63, wave = __builtin_amdgcn_readfirstlane(tid >> 6);
    const int bx = blockIdx.x;
    if (bx < 12) {
        const int bh = bx;
        f16* PT = (f16*)(a.ws + WS_PT); f16* RL = (f16*)(a.ws + WS_RL);
        LAS float* PTL = (LAS float*)lds;
        LAS float* SN = (LAS float*)(lds + 16384);
        float S[64];
#pragma unroll
        for (int k = 0; k < 64; ++k) S[k] = 0.f;
        for (int c = 0; c < NCH; ++c) {
            const f16* pt = PT + ((size_t)bh * NCH + c) * 4096; f16* rl = RL + ((size_t)bh * NCH + c) * 4096;
            { const f16x8 p8 = *(const f16x8*)(pt + tid * 8);
#pragma unroll
              for (int j = 0; j < 8; ++j) PTL[tid * 8 + j] = (float)p8[j]; }
            const f16x8 l8 = *(const f16x8*)(rl + lane * 64 + wave * 8);
            asm volatile("s_waitcnt vmcnt(0)" ::: "memory");
            __syncthreads();
            if (wave == 0) store_row64_f16(rl + lane * 64, S);
#pragma unroll
            for (int j = 0; j < 8; ++j) SN[lane * 65 + wave * 8 + j] = (float)l8[j];
#pragma unroll 1
            for (int j = 0; j < 8; ++j) { float acc = SN[lane * 65 + wave * 8 + j];
                const LAS float* pr = PTL + (wave * 8 + j) * 64;
                float a0 = 0.f, a1 = 0.f, a2 = 0.f, a3 = 0.f;
#pragma unroll
                for (int k = 0; k < 64; k += 4) { const f32x4 p4 = *(const LAS f32x4*)(pr + k); a0 += S[k] * p4.x; a1 += S[k + 1] * p4.y; a2 += S[k + 2] * p4.z; a3 += S[k + 3] * p4.w; }
                SN[lane * 65 + wave * 8 + j] = acc + ((a0 + a1) + (a2 + a3)); }
            __syncthreads();
#pragma unroll
            for (int k = 0; k < 64; ++k) S[k] = SN[lane * 65 + k];
            __syncthreads();
        }
    } else if (bx < 12 + 96) {
        const int idx = (bx - 12) * NT + tid; const int bh = idx >> 12, e = idx & 4095, k = e >> 6;
        f16* HL = (f16*)(a.ws + WS_HL); const float* DC = (const float*)(a.ws + WS_DC);
        float s = 0.f;
        for (int c = 0; c < NCH; ++c) { f16* p = HL + ((size_t)bh * NCH + c) * 4096 + e; const float Lc = (float)*p; const float d = DC[((size_t)bh * NCH + c) * 64 + k];
            *p = (f16)s; s = d * s + Lc; }
    } else if (bx == 12 + 96) {
        const int bb = tid >> 8, ch = tid & 255; const float* LA = (const float*)(a.ws + WS_LA); float* LH = (float*)(a.ws + WS_LH);
        float cy = 0.f;
        for (int c = 0; c < NCH; ++c) { const size_t o = ((size_t)bb * NCH + c) * 256 + ch; const float A = LA[o], H = LH[o]; LH[o] = cy; cy = A * cy + H; }
    }
}

__device__ __forceinline__ void phaseC(const Args& a, int l, int task, LAS unsigned char* lds, int tid) {
    asm volatile("" : "+v"(tid));
    const int lane = tid & 63, wave = __builtin_amdgcn_readfirstlane(tid >> 6);
    const int b = task / NCH, c = task % NCH;
    const f16* U = (const f16*)(a.ws + WS_U); f16* MIX = (f16*)(a.ws + WS_MIX); const f16* VP = (const f16*)(a.ws + WS_VP);
    const f16* QT = (const f16*)(a.ws + WS_QT); const f16* RL = (const f16*)(a.ws + WS_RL); const float* BONG = (const float*)(a.ws + WS_BON);
    const int tt = tid >> 3, sub = tid & 7;
    const size_t m = (size_t)b * SEQ + c * CH + tt;
    const f16* urow = U + m * NU;
    {
        const float* ln_w = a.in[14] + l * RW_W; const float* ln_b = a.in[15] + l * RW_W;
        LAS float* SL = (LAS float*)lds;
#pragma unroll 1
        for (int h = 0; h < RW_H; ++h) {
            const int bh = b * RW_H + h;
            { const f16x8 s8 = *(const f16x8*)(RL + ((size_t)bh * NCH + c) * 4096 + tid * 8); const int v = tid >> 3, k0 = (tid & 7) * 8;
#pragma unroll
              for (int j = 0; j < 8; ++j) SL[v * 68 + k0 + j] = (float)s8[j]; }
            float q[64];
#pragma unroll
            for (int qq = 0; qq < 8; ++qq) { const f16x8 q8 = *(const f16x8*)(QT + m * RW_W + h * 64 + qq * 8);
#pragma unroll
                for (int j = 0; j < 8; ++j) q[qq * 8 + j] = (float)q8[j]; }
            __syncthreads();
            const f16x8 yl = *(const f16x8*)(MIX + m * DM + h * 64 + sub * 8);
            LAS float* YS = (LAS float*)(lds + 20480) + tid * 9;
#pragma unroll
            for (int i = 0; i < 8; ++i) YS[i] = (float)yl[i];
#pragma unroll 1
            for (int i = 0; i < 8; ++i) { const LAS float* sr = SL + (sub * 8 + i) * 68;
                float a0 = 0.f, a1 = 0.f, a2 = 0.f, a3 = 0.f;
#pragma unroll
                for (int k = 0; k < 64; k += 4) { const f32x4 s4 = *(const LAS f32x4*)(sr + k); a0 += q[k] * s4.x; a1 += q[k + 1] * s4.y; a2 += q[k + 2] * s4.z; a3 += q[k + 3] * s4.w; }
                YS[i] += (a0 + a1) + (a2 + a3); }
            float y[8]; float sm = 0.f;
#pragma unroll
            for (int i = 0; i < 8; ++i) { y[i] = YS[i]; sm += y[i]; }
            sm += __shfl_xor(sm, 1); sm += __shfl_xor(sm, 2); sm += __shfl_xor(sm, 4);
            const float mean = sm * (1.0f / 64.0f); float vr = 0.f;
#pragma unroll
            for (int i = 0; i < 8; ++i) { const float d = y[i] - mean; vr += d * d; }
            vr += __shfl_xor(vr, 1); vr += __shfl_xor(vr, 2); vr += __shfl_xor(vr, 4);
            const float rstd = 1.0f / sqrtf(vr * (1.0f / 64.0f) + 64e-5f);
            const float bon = BONG[m * 8 + h];
            const f16x8 vp = *(const f16x8*)(VP + m * RW_W + h * 64 + sub * 8); const f16x8 z8 = *(const f16x8*)(urow + C_RWZ + h * 64 + sub * 8);
            float o[8];
#pragma unroll
            for (int i = 0; i < 8; ++i) { const int col = h * 64 + sub * 8 + i; o[i] = ((y[i] - mean) * rstd * ln_w[col] + ln_b[col] + bon * (float)vp[i]) * siluf_((float)z8[i]); }
            u32x4 w; w.x = pg8::pk_f16(o[0], o[1]); w.y = pg8::pk_f16(o[2], o[3]); w.z = pg8::pk_f16(o[4], o[5]); w.w = pg8::pk_f16(o[6], o[7]);
            *(u32x4*)(MIX + m * DM + h * 64 + sub * 8) = w;
            __syncthreads();
        }
    }
    {
        const f16* HL = (const f16*)(a.ws + WS_HL); const float* lbr = a.in[16]; const float* nw = a.in[17] + l * 384;
        LAS float* SL = (LAS float*)lds;
        LAS float* QE = (LAS float*)(lds + 16384);
#pragma unroll 1
        for (int h = 0; h < 6; ++h) {
            const int bh = b * 6 + h;
            { const f16x8 s8 = *(const f16x8*)(HL + ((size_t)bh * NCH + c) * 4096 + tid * 8);
#pragma unroll
              for (int j = 0; j < 8; ++j) SL[tid * 8 + j] = (float)s8[j]; }
            if (wave == 0) {
                const int col = h * 64 + lane; const float lb = (l == 0) ? 0.f : sigmoidf_(lbr[384 + col] - lbr[col]); float cp = 1.f;
                for (int t2 = 0; t2 < CH; ++t2) { const f16* ur = U + ((size_t)b * SEQ + c * CH + t2) * NU;
                    cp *= lb + (1.0f - lb) * sigmoidf_((float)ur[C_HGF + col]); QE[t2 * 68 + lane] = (float)ur[C_HGQ + col] * cp; }
            }
            __syncthreads();
            const f16x8 ol = *(const f16x8*)(MIX + m * DM + 384 + h * 64 + sub * 8);
            float o[8];
#pragma unroll
            for (int i = 0; i < 8; ++i) o[i] = (float)ol[i];
#pragma unroll 8
            for (int k = 0; k < 64; ++k) { const float qe = QE[tt * 68 + k]; const f32x4 s0 = *(const LAS f32x4*)(SL + k * 64 + sub * 8), s1 = *(const LAS f32x4*)(SL + k * 64 + sub * 8 + 4);
                o[0] += qe * s0.x; o[1] += qe * s0.y; o[2] += qe * s0.z; o[3] += qe * s0.w; o[4] += qe * s1.x; o[5] += qe * s1.y; o[6] += qe * s1.z; o[7] += qe * s1.w; }
            float ss = 0.f;
#pragma unroll
            for (int i = 0; i < 8; ++i) ss += o[i] * o[i];
            ss += __shfl_xor(ss, 1); ss += __shfl_xor(ss, 2); ss += __shfl_xor(ss, 4);
            const float rs = 1.0f / sqrtf(ss * (1.0f / 64.0f) + 1e-6f);
            const f16x8 z8 = *(const f16x8*)(urow + C_HGZ + h * 64 + sub * 8);
#pragma unroll
            for (int i = 0; i < 8; ++i) o[i] = o[i] * rs * nw[h * 64 + sub * 8 + i] * siluf_((float)z8[i]);
            u32x4 w; w.x = pg8::pk_f16(o[0], o[1]); w.y = pg8::pk_f16(o[2], o[3]); w.z = pg8::pk_f16(o[4], o[5]); w.w = pg8::pk_f16(o[6], o[7]);
            *(u32x4*)(MIX + m * DM + 384 + h * 64 + sub * 8) = w;
            __syncthreads();
        }
    }
    {
        const f16* CA = (const f16*)(a.ws + WS_CA); const float* LH = (const float*)(a.ws + WS_LH);
#pragma unroll 1
        for (int q = 0; q < 4; ++q) { const int ch0 = q * 64 + sub * 8;
            const f16x8 hl = *(const f16x8*)(MIX + m * DM + 768 + ch0), ca = *(const f16x8*)(CA + m * 256 + ch0), z8 = *(const f16x8*)(urow + C_LRUZ + ch0);
            float o[8];
#pragma unroll
            for (int i = 0; i < 8; ++i) o[i] = ((float)hl[i] + (float)ca[i] * LH[((size_t)b * NCH + c) * 256 + ch0 + i]) * siluf_((float)z8[i]);
            u32x4 w; w.x = pg8::pk_f16(o[0], o[1]); w.y = pg8::pk_f16(o[2], o[3]); w.z = pg8::pk_f16(o[4], o[5]); w.w = pg8::pk_f16(o[6], o[7]);
            *(u32x4*)(MIX + m * DM + 768 + ch0) = w; }
    }
}
__global__ void __launch_bounds__(NT, 2) fwd(Args args) {
    extern __shared__ __attribute__((aligned(16))) unsigned char lds_raw[];
    LAS unsigned char* lds = (LAS unsigned char*)lds_raw;
    cg::grid_group grid = cg::this_grid();
    const int wave = __builtin_amdgcn_readfirstlane((int)threadIdx.x >> 6);
#define TID_NOW() (wave * 64 + lane_now())
    const int tid = TID_NOW(); const int lane = tid & 63;
    const int G = gridDim.x, gw = blockIdx.x * NWAVES + wave, NGW = G * NWAVES;
    unsigned char* ws = args.ws;
    unsigned short* XN = (unsigned short*)(ws + WS_XN);
    {
        LAS float* scr = (LAS float*)(lds + wave * 16384);
        constexpr int I_IN = (DM / 64) * (NIN / 32), I_OUT = (DM / 64) * (DM / 32), NITEMS = DEPTH * (I_IN + I_OUT);
        for (int it = gw; it < NITEMS; it += NGW) {
            int r = it; const int l = r / (I_IN + I_OUT); r -= l * (I_IN + I_OUT);
            if (r < I_IN) p0_transpose_item(args.in[2] + (size_t)l * DM * NIN, DM, NIN, (unsigned short*)(ws + WS_WIN + l * WIN_L), scr, r, lane);
            else p0_transpose_item(args.in[25] + (size_t)l * DM * DM, DM, DM, (unsigned short*)(ws + WS_WOUT + l * WOUT_L), scr, r - I_IN, lane);
        }
        for (int i = gw; i < DEPTH * (NU - NIN) * DM * 2 / 1024; i += NGW) { const int l = i / ((NU - NIN) * DM * 2 / 1024), r = i % ((NU - NIN) * DM * 2 / 1024);
            *(u32x4*)(ws + WS_WIN + l * WIN_L + (size_t)NIN * DM * 2 + (size_t)r * 1024 + lane * 16) = (u32x4){0u, 0u, 0u, 0u}; }
        for (int m = gw; m < M; m += NGW) rms_row_f16(args.in[0] + (size_t)m * DM, args.in[1], XN + (size_t)m * DM, lane);
        { f16* WUPT = (f16*)(ws + WS_WUPT); f16* AUPT = (f16*)(ws + WS_AUPT); f16* VDNT = (f16*)(ws + WS_VDNT); f16* VUPT = (f16*)(ws + WS_VUPT);
          for (int i = blockIdx.x * NT + tid; i < 122880; i += G * NT) {
              if (i < 49152) { const int ll = i / 24576, r = i % 24576, n = r / 64, k = r % 64; WUPT[i] = (f16)args.in[5][(size_t)ll * 24576 + k * 384 + n]; }
              else if (i < 98304) { const int i2 = i - 49152, ll = i2 / 24576, r = i2 % 24576, n = r / 64, k = r % 64; AUPT[i2] = (f16)args.in[7][(size_t)ll * 24576 + k * 384 + n]; }
              else if (i < 110592) { const int i2 = i - 98304, j2 = i2 / 384, cc = i2 % 384; VDNT[i2] = (f16)args.in[9][cc * 32 + j2]; }
              else { const int i2 = i - 110592, n = i2 / 32, j2 = i2 % 32; VUPT[i2] = (f16)args.in[10][j2 * 384 + n]; } } }
    }
    grid.sync();
#pragma unroll 1
    for (int l = 0; l < DEPTH; ++l) {
        { pg8::Gemm g{XN, (const unsigned short*)(ws + WS_WIN + l * WIN_L), M, NU, DM}; pg8::StaticOrder S; S.init(M, NU, G, (int)blockIdx.x);
          pg8::EpiF16 E{(unsigned short*)(ws + WS_U), NU};
          pg8::gemm_phase<pg8::EpiF16, pg8::StaticOrder, true, true>(lds, g, S, E, wave); }
        grid.sync();
        for (int task = blockIdx.x; task < BATCH * NCH; task += G) phaseA(args, l, task, lds, TID_NOW());
        grid.sync();
        phaseB(args, lds, TID_NOW());
        grid.sync();
        for (int task = blockIdx.x; task < BATCH * NCH; task += G) phaseC(args, l, task, lds, TID_NOW());
        grid.sync();
        { pg8::Gemm g{(const unsigned short*)(ws + WS_MIX), (const unsigned short*)(ws + WS_WOUT + l * WOUT_L), M, DM, DM}; pg8::StaticOrder S; S.init(M, DM, G, (int)blockIdx.x);
          pg8::EpiRes E{l == 0 ? args.in[0] : args.out, args.out, DM};
          pg8::gemm_phase<pg8::EpiRes, pg8::StaticOrder, true, true>(lds, g, S, E, wave); }
        grid.sync();
        { int ln = TID_NOW() & 63; asm volatile("" : "+v"(ln));
          if (l + 1 < DEPTH) { for (int m = gw; m < M; m += NGW) rms_row_f16(args.out + (size_t)m * DM, args.in[1] + (l + 1) * DM, XN + (size_t)m * DM, ln); grid.sync(); }
          else { for (int m = gw; m < M; m += NGW) rms_row_f32(args.out + (size_t)m * DM, args.in[26], ln); } }
    }
}

extern "C" void kernel_launch(void* const* d_in, const int* in_sizes, int n_in, void* d_out, int out_size, void* d_ws, size_t ws_size, hipStream_t stream) {
    static int grid = 0;
    if (grid == 0) {
        if (n_in != 27 || in_sizes[0] != M * DM || out_size != M * DM || ws_size < WS_END) { fprintf(stderr, "kernel_launch: unexpected problem: n_in %d in0 %d out %d ws %zu\n", n_in, n_in > 0 ? in_sizes[0] : -1, out_size, ws_size); grid = -1; return; }
        int dev = 0, cus = 0, per_cu = 0;
        hipGetDevice(&dev); hipDeviceGetAttribute(&cus, hipDeviceAttributeMultiprocessorCount, dev);
        if (hipFuncSetAttribute((const void*)fwd, hipFuncAttributeMaxDynamicSharedMemorySize, LDS_BYTES) != hipSuccess) { fprintf(stderr, "kernel_launch: hipFuncSetAttribute failed\n"); grid = -1; return; }
        if (hipOccupancyMaxActiveBlocksPerMultiprocessor(&per_cu, (const void*)fwd, NT, LDS_BYTES) != hipSuccess || per_cu < 1) { fprintf(stderr, "kernel_launch: occupancy query failed (%d)\n", per_cu); grid = -1; return; }
        grid = cus * per_cu;
    }
    if (grid < 0) return;
    Args a{};
    for (int i = 0; i < 27; ++i) a.in[i] = (const float*)d_in[i];
    a.out = (float*)d_out; a.ws = (unsigned char*)d_ws;
    void* kargs[] = {&a};
    hipError_t e = hipLaunchCooperativeKernel((const void*)fwd, dim3(grid), dim3(NT), kargs, LDS_BYTES, stream);
    if (e != hipSuccess) fprintf(stderr, "cooperative launch failed: %s (grid %d)\n", hipGetErrorString(e), grid);
}
```

```cpp
#include <hip/hip_runtime.h>
#include <hip/hip_cooperative_groups.h>
#include <cstdio>
#include <cstdint>
namespace cg = cooperative_groups;
typedef _Float16 f16x8_t __attribute__((ext_vector_type(8)));
#define MK_MFMA(a, b, c) __builtin_amdgcn_mfma_f32_16x16x32_f16(__builtin_bit_cast(f16x8_t, (a)), __builtin_bit_cast(f16x8_t, (b)), (c), 0, 0, 0)
__device__ __forceinline__ int lane_now() { int z; asm volatile("v_mbcnt_lo_u32_b32 %0, -1, 0\n\tv_mbcnt_hi_u32_b32 %0, -1, %0" : "=v"(z)); return z; }
namespace pg8 {
#define PG8_LAS __attribute__((address_space(3)))
typedef unsigned short bf16_t;
typedef short bf16x8 __attribute__((ext_vector_type(8)));
typedef float f32x4 __attribute__((ext_vector_type(4)));
typedef unsigned u32x4 __attribute__((ext_vector_type(4)));
constexpr int BM = 256, BK = 64, HALF = 128, HTB = HALF * BK * 2  , STAGE_BYTES = 8 * HTB, NXCD = 8, WGM = 8;

__host__ __device__ __forceinline__ int lds_byte(int r, int c) { const int st = (r >> 4) * 2 + (c >> 5), rr = r & 15, cc = c & 31, ob = rr * 64 + cc * 2; return st * 1024 + (ob ^ (((ob >> 9) & 1) << 5)); }
__host__ __device__ __forceinline__ void stage_rc(int b, int& R, int& C) { const int st = b / 1024, sb = b % 1024, swz = sb ^ (((sb >> 9) & 1) << 5); R = (st >> 1) * 16 + swz / 64; C = (st & 1) * 32 + (swz % 64) / 2; }
__host__ __device__ __forceinline__ int perm32(int rho) { const int n = rho >> 4, i = rho & 15; return 8 * (i >> 2) + 4 * n + (i & 3); }

struct Unit { int pm, pn; };
struct Gemm { const bf16_t* A; const bf16_t* Bt; int M, N, K; };

struct StaticOrder {
    int nM, nN, nwg, G, c;
    __host__ __device__ void init(int M, int N, int G_, int c_) { nM = M / BM; nN = N / BM; nwg = nM * nN; G = G_; c = c_; }
    __host__ __device__ bool next(int i, Unit& u) const {
        const long L = (long)i * G + c; if (L >= nwg) return false;
        int wgid = (int)L; { const int q = nwg / NXCD, r = nwg % NXCD, xcd = wgid % NXCD, off = wgid / NXCD; wgid = (xcd < r ? xcd * (q + 1) : r * (q + 1) + (xcd - r) * q) + off; }
        const int nig = WGM * nN, gid = wgid / nig, fm = gid * WGM, gsz = (nM - fm) < WGM ? (nM - fm) : WGM;
        u.pm = fm + ((wgid % nig) % gsz); u.pn = (wgid % nig) / gsz; return true;
    }
    __device__ __forceinline__ void a_ready(const Unit&) const {}
    __device__ __forceinline__ void done(const Unit&) const {}
};

__device__ __forceinline__ unsigned pk_f16(float lo, float hi) { typedef _Float16 h2 __attribute__((ext_vector_type(2))); h2 v; v.x = (_Float16)lo; v.y = (_Float16)hi; return __builtin_bit_cast(unsigned, v); }
struct EpiF16 {
    static constexpr bool PERM = true, AFTER_DRAIN = false;
    bf16_t* O; int ldc;
    __device__ __forceinline__ void operator()(const f32x4 (&acc)[2][2][4][2], const Unit& u, int wr, int wc, int fr, int fq) const {
        const int row0 = u.pm * BM + wr * 64 + fr; const int col0 = u.pn * BM + wc * 32 + 8 * fq;
#pragma unroll
        for (int ai = 0; ai < 2; ++ai)
#pragma unroll
            for (int m = 0; m < 4; ++m) { bf16_t* rowp = O + (size_t)(row0 + ai * HALF + m * 16) * ldc + col0;
#pragma unroll
                for (int bj = 0; bj < 2; ++bj) { const f32x4 v0 = acc[ai][bj][m][0], v1 = acc[ai][bj][m][1];
                    u32x4 w; w.x = pk_f16(v0[0], v0[1]); w.y = pk_f16(v0[2], v0[3]); w.z = pk_f16(v1[0], v1[1]); w.w = pk_f16(v1[2], v1[3]);
                    *(u32x4*)(rowp + bj * HALF) = w; } }
    }
};
struct EpiRes {
    static constexpr bool PERM = false, AFTER_DRAIN = false;
    const float* base; float* out; int ldc;
    __device__ __forceinline__ void operator()(const f32x4 (&acc)[2][2][4][2], const Unit& u, int wr, int wc, int fr, int fq) const {
        const int row0 = u.pm * BM + wr * 64 + fr; const int col0 = u.pn * BM + wc * 32 + 4 * fq;
#pragma unroll
        for (int ai = 0; ai < 2; ++ai)
#pragma unroll
            for (int m = 0; m < 4; ++m) { const size_t off = (size_t)(row0 + ai * HALF + m * 16) * ldc + col0;
#pragma unroll
                for (int bj = 0; bj < 2; ++bj)
#pragma unroll
                    for (int n = 0; n < 2; ++n) { const size_t o = off + bj * HALF + n * 16; const f32x4 b = *(const f32x4*)(base + o); *(f32x4*)(out + o) = b + acc[ai][bj][m][n]; }
                asm volatile("" ::: "memory"); }
    }
};

template <class Epi, class Sched, bool ALIGN_EPI = false, bool SP2 = false>
__device__ __forceinline__ void gemm_phase(PG8_LAS unsigned char* lds, const Gemm g, const Sched& S, const Epi& E, const int wave_) {
    int wv_ = wave_; asm volatile("" : "+s"(wv_)); int tid_ = lane_now() + 64 * wv_; const int tid = tid_, wid = wv_, lane = tid & 63, wr = wid >> 2, wc = wid & 3, fr = lane & 15, fq = lane >> 4;
    const int K = g.K, nt = K / BK;
    unsigned voffA[2], voffB[2];
#pragma unroll
    for (int i = 0; i < 2; ++i) { int R, C; stage_rc(tid * 16 + i * 8192, R, C); const int Rb = Epi::PERM ? ((R & ~31) + perm32(R & 31)) : R;
        voffA[i] = (unsigned)(R * K + C) * 2u; voffB[i] = (unsigned)(Rb * K + C) * 2u; }
    const size_t kstep = (size_t)(BK * 2);
    const size_t hstep = (size_t)HALF * K * 2;
    const size_t tstep = 2 * hstep;
    const unsigned ldsw = (unsigned)wid * 1024u;
    const int aoff = lds_byte(wr * 64 + fr, fq * 8), boff = lds_byte(wc * 32 + fr, fq * 8);
#define PG8_SA(b, h) (((b) * 2 + (h)) * HTB)
#define PG8_SB(b, h) ((4 + (b) * 2 + (h)) * HTB)
#define PG8_STAGE(bufoff, gbase, voff) do { _Pragma("unroll") for (int _i = 0; _i < 2; ++_i) \
        __builtin_amdgcn_global_load_lds((const unsigned*)((const char*)(gbase) + (voff)[_i]), (PG8_LAS unsigned*)(lds + (bufoff) + ldsw + _i * 8192), 16, 0, 0); } while (0)
#define PG8_LDA(dst, b, h) do { _Pragma("unroll") for (int m = 0; m < 4; ++m) _Pragma("unroll") for (int k = 0; k < 2; ++k) dst[m][k] = *(const PG8_LAS bf16x8*)(lds + PG8_SA(b, h) + aoff + m * 2048 + k * 1024); } while (0)
#define PG8_LDB(dst, b, h) do { _Pragma("unroll") for (int n = 0; n < 2; ++n) _Pragma("unroll") for (int k = 0; k < 2; ++k) dst[n][k] = *(const PG8_LAS bf16x8*)(lds + PG8_SB(b, h) + boff + n * 2048 + k * 1024); } while (0)
#define PG8_MMA(ai, bj, At, Bt) do { __builtin_amdgcn_s_setprio(1); _Pragma("unroll") for (int m = 0; m < 4; ++m) _Pragma("unroll") for (int n = 0; n < 2; ++n) _Pragma("unroll") for (int k = 0; k < 2; ++k) \
        acc[ai][bj][m][n] = MK_MFMA(Bt[n][k], At[m][k], acc[ai][bj][m][n]); __builtin_amdgcn_s_setprio(0); } while (0)
#define PG8_WAIT_V(n) asm volatile("s_waitcnt vmcnt(" #n ")" ::: "memory")
#define PG8_WAIT_L(n) asm volatile("s_waitcnt lgkmcnt(" #n ")" ::: "memory")
#define PG8_BAR __builtin_amdgcn_s_barrier()
#define PG8_SCHED __builtin_amdgcn_sched_barrier(0)
    Unit cur, nxt; int ui = 0;
    if (!S.next(0, cur)) return;
    f32x4 acc[2][2][4][2];
#pragma unroll
    for (int a = 0; a < 2; ++a)
#pragma unroll
        for (int b = 0; b < 2; ++b)
#pragma unroll
            for (int m = 0; m < 4; ++m)
#pragma unroll
                for (int n = 0; n < 2; ++n) acc[a][b][m][n] = (f32x4){0.f, 0.f, 0.f, 0.f};
    bf16x8 At[4][2], B0[2][2], B1[2][2];
    const char* cA = (const char*)g.A + (size_t)cur.pm * tstep; const char* cB = (const char*)g.Bt + (size_t)cur.pn * tstep;
    S.a_ready(cur);
    if constexpr (SP2) {
        PG8_STAGE(PG8_SB(0, 0), cB, voffB); PG8_STAGE(PG8_SB(0, 1), cB + hstep, voffB); PG8_STAGE(PG8_SA(0, 0), cA, voffA); PG8_STAGE(PG8_SA(0, 1), cA + hstep, voffA);
        if (wr == 1) PG8_BAR;
        PG8_WAIT_V(2); PG8_BAR;
        PG8_STAGE(PG8_SB(1, 0), cB + kstep, voffB); PG8_STAGE(PG8_SA(1, 0), cA + kstep, voffA); PG8_STAGE(PG8_SB(1, 1), cB + hstep + kstep, voffB);
        PG8_WAIT_V(6); PG8_BAR;
    } else {
        PG8_STAGE(PG8_SB(0, 0), cB, voffB); PG8_STAGE(PG8_SA(0, 0), cA, voffA); PG8_STAGE(PG8_SB(0, 1), cB + hstep, voffB); PG8_STAGE(PG8_SA(0, 1), cA + hstep, voffA);
        if (wr == 1) PG8_BAR;
        PG8_WAIT_V(4); PG8_BAR;
        PG8_STAGE(PG8_SB(1, 0), cB + kstep, voffB); PG8_STAGE(PG8_SA(1, 0), cA + kstep, voffA); PG8_STAGE(PG8_SB(1, 1), cB + hstep + kstep, voffB);
        PG8_WAIT_V(6); PG8_BAR;
    }
    for (;;) {
        const bool has_next = S.next(ui + 1, nxt);
        const char* nA = has_next ? (const char*)g.A + (size_t)nxt.pm * tstep : cA; const char* nB = has_next ? (const char*)g.Bt + (size_t)nxt.pn * tstep : cB;
        for (int t = 0; t < nt; t += 2) {
            const bool last = (t == nt - 2);
            const char* a1 = cA + (size_t)(t + 1) * kstep;
            const char* a2 = last ? nA : cA + (size_t)(t + 2) * kstep; const char* b2 = last ? nB : cB + (size_t)(t + 2) * kstep;
            const char* a3 = a2 + kstep; const char* b3 = b2 + kstep;
            if (last && has_next) S.a_ready(nxt);
            if constexpr (SP2) {
            PG8_LDB(B0, 0, 0); PG8_LDB(B1, 0, 1); PG8_SCHED; PG8_LDA(At, 0, 0); PG8_STAGE(PG8_SA(1, 1), a1 + hstep, voffA);
            PG8_WAIT_V(8); PG8_WAIT_L(0); PG8_BAR; PG8_MMA(0, 0, At, B0); PG8_MMA(0, 1, At, B1); PG8_BAR; PG8_SCHED;
            PG8_LDA(At, 0, 1); PG8_STAGE(PG8_SB(0, 0), b2, voffB); PG8_STAGE(PG8_SB(0, 1), b2 + hstep, voffB); PG8_STAGE(PG8_SA(0, 0), a2, voffA);
            PG8_WAIT_V(8); PG8_WAIT_L(0); PG8_BAR; PG8_MMA(1, 0, At, B0); PG8_MMA(1, 1, At, B1); PG8_BAR; PG8_SCHED;
            PG8_LDB(B0, 1, 0); PG8_LDB(B1, 1, 1); PG8_SCHED; PG8_LDA(At, 1, 0); PG8_STAGE(PG8_SA(0, 1), a2 + hstep, voffA);
            PG8_WAIT_V(8); PG8_WAIT_L(0); PG8_BAR; PG8_MMA(0, 0, At, B0); PG8_MMA(0, 1, At, B1); PG8_BAR; PG8_SCHED;
            PG8_LDA(At, 1, 1); PG8_STAGE(PG8_SB(1, 0), b3, voffB); PG8_STAGE(PG8_SB(1, 1), b3 + hstep, voffB); PG8_STAGE(PG8_SA(1, 0), a3, voffA);
            PG8_WAIT_V(8); PG8_WAIT_L(0); PG8_BAR; PG8_MMA(1, 0, At, B0); PG8_MMA(1, 1, At, B1); PG8_BAR; PG8_SCHED;
            } else {
            PG8_LDB(B0, 0, 0); PG8_SCHED; PG8_LDA(At, 0, 0); PG8_STAGE(PG8_SA(1, 1), a1 + hstep, voffA);
            PG8_WAIT_L(8); PG8_BAR; PG8_WAIT_L(0); PG8_MMA(0, 0, At, B0); PG8_BAR; PG8_SCHED;
            PG8_LDB(B1, 0, 1); PG8_STAGE(PG8_SB(0, 0), b2, voffB);
            PG8_BAR; PG8_WAIT_L(0); PG8_MMA(0, 1, At, B1); PG8_BAR;
            PG8_LDA(At, 0, 1); PG8_STAGE(PG8_SA(0, 0), a2, voffA);
            PG8_BAR; PG8_WAIT_L(0); PG8_MMA(1, 0, At, B0); PG8_BAR; PG8_SCHED;
            PG8_STAGE(PG8_SB(0, 1), b2 + hstep, voffB);
            PG8_WAIT_V(6); PG8_BAR; PG8_MMA(1, 1, At, B1); PG8_BAR;
            PG8_LDB(B0, 1, 0); PG8_SCHED; PG8_LDA(At, 1, 0); PG8_STAGE(PG8_SA(0, 1), a2 + hstep, voffA);
            PG8_WAIT_L(8); PG8_BAR; PG8_WAIT_L(0); PG8_MMA(0, 0, At, B0); PG8_BAR; PG8_SCHED;
            PG8_LDB(B1, 1, 1); PG8_STAGE(PG8_SB(1, 0), b3, voffB);
            PG8_BAR; PG8_WAIT_L(0); PG8_MMA(0, 1, At, B1); PG8_BAR;
            PG8_LDA(At, 1, 1); PG8_STAGE(PG8_SA(1, 0), a3, voffA);
            PG8_BAR; PG8_WAIT_L(0); PG8_MMA(1, 0, At, B0); PG8_BAR; PG8_SCHED;
            PG8_STAGE(PG8_SB(1, 1), b3 + hstep, voffB);
            PG8_WAIT_V(6); PG8_BAR; PG8_MMA(1, 1, At, B1); PG8_BAR;
            }
        }
        if constexpr (ALIGN_EPI) { if (wr == 0) PG8_BAR; }
        if constexpr (!Epi::AFTER_DRAIN) { E(acc, cur, wr, wc, fr, fq); S.done(cur); }
        if (!has_next) break;
#pragma unroll
        for (int a = 0; a < 2; ++a)
#pragma unroll
            for (int b = 0; b < 2; ++b)
#pragma unroll
                for (int m = 0; m < 4; ++m)
#pragma unroll
                    for (int n = 0; n < 2; ++n) acc[a][b][m][n] = (f32x4){0.f, 0.f, 0.f, 0.f};
        cur = nxt; cA = nA; cB = nB; ++ui;
        if constexpr (ALIGN_EPI) { if (wr == 1) PG8_BAR; }
    }
    PG8_WAIT_V(0);
    if constexpr (!ALIGN_EPI) { if (wr == 0) PG8_BAR; }
    PG8_BAR;
    if constexpr (Epi::AFTER_DRAIN) { E.fused(acc, cur, wr, wc, fr, fq, lds, wid, lane); S.done(cur); }
#undef PG8_SA
#undef PG8_SB
#undef PG8_STAGE
#undef PG8_LDA
#undef PG8_LDB
#undef PG8_MMA
#undef PG8_WAIT_V
#undef PG8_WAIT_L
#undef PG8_BAR
#undef PG8_SCHED
}
}

constexpr int BATCH = 2, SEQ = 8192, DM = 1024, DEPTH = 2, M = BATCH * SEQ;
constexpr int RW_H = 6, HD = 64, RW_W = 384, RW_SHIFT = 1280;
constexpr int NIN = 3712, NU = 3840;
constexpr int C_R = 0, C_K = 384, C_V = 768, C_WL = 1152, C_AL = 1216, C_RWZ = 1280, C_HGQ = 1664, C_HGF = 2048, C_HGI = 2432, C_HGZ = 2816, C_LRUX = 3200, C_LRUZ = 3456;
constexpr int CH = 64;
constexpr int NWAVES = 8, NT = NWAVES * 64;
constexpr int LDS_BYTES = 147456;
constexpr size_t MiB = 1u << 20;
constexpr size_t WS_WUPT = 65536, WS_AUPT = WS_WUPT + 98304, WS_VDNT = WS_AUPT + 98304, WS_VUPT = WS_VDNT + 24576;
constexpr size_t WS_WIN = 1 * MiB, WIN_L = (size_t)NU * DM * 2;
constexpr size_t WS_WOUT = 16 * MiB, WOUT_L = (size_t)DM * DM * 2;
constexpr size_t WS_XN = 20 * MiB;
constexpr size_t WS_QT = 20 * MiB;
constexpr size_t WS_PT = 32 * MiB;
constexpr size_t WS_CA = 44 * MiB;
constexpr size_t WS_U = 52 * MiB;
constexpr size_t WS_MIX = 172 * MiB;
constexpr size_t WS_VF = 204 * MiB;
constexpr size_t WS_VP = 216 * MiB;
constexpr size_t WS_RL = 228 * MiB;
constexpr size_t WS_HL = 240 * MiB;
constexpr size_t WS_BON = 252 * MiB;
constexpr size_t WS_DC = WS_BON + 512 * 1024;
constexpr size_t WS_LA = WS_DC + 512 * 1024;
constexpr size_t WS_LH = WS_LA + 256 * 1024;
constexpr size_t WS_END = 254 * MiB;
constexpr int NCH = SEQ / CH;

#define LAS __attribute__((address_space(3)))
typedef float f32x4 __attribute__((ext_vector_type(4)));
typedef unsigned u32x2 __attribute__((ext_vector_type(2)));
typedef unsigned u32x4 __attribute__((ext_vector_type(4)));
typedef _Float16 f16;
typedef _Float16 f16x8 __attribute__((ext_vector_type(8)));
#define LDS_WAIT() asm volatile("s_waitcnt lgkmcnt(0)" ::: "memory")

struct Args { const float* in[27]; float* out; unsigned char* ws; };

__device__ __forceinline__ float wave_sum(float v) {
#pragma unroll
    for (int o = 1; o < 64; o <<= 1) v += __shfl_xor(v, o);
    return v;
}
__device__ __forceinline__ float sigmoidf_(float x) { return 1.0f / (1.0f + __expf(-x)); }
__device__ __forceinline__ float siluf_(float x) { return x / (1.0f + __expf(-x)); }

__device__ __forceinline__ void p0_transpose_item(const float* W, int K, int N, unsigned short* WT, LAS float* scr, int item, int lane) {
    const int nblk = N / 32, kb = item / nblk, nb = item % nblk, k0 = 64 * kb, n0 = 32 * nb;
#pragma unroll 8
    for (int i = 0; i < 32; ++i) { const int kk = 2 * i + (lane >> 5); scr[kk * 33 + (lane & 31)] = W[(size_t)(k0 + kk) * N + n0 + (lane & 31)]; }
    LDS_WAIT(); asm volatile("" ::: "memory");
    const int c = lane & 7;
#pragma unroll
    for (int j = 0; j < 4; ++j) { const int n = (lane >> 3) + 8 * j; const LAS float* s = scr + (8 * c) * 33 + n;
        u32x4 o; o.x = pg8::pk_f16(s[0 * 33], s[1 * 33]); o.y = pg8::pk_f16(s[2 * 33], s[3 * 33]); o.z = pg8::pk_f16(s[4 * 33], s[5 * 33]); o.w = pg8::pk_f16(s[6 * 33], s[7 * 33]);
        *(u32x4*)(WT + (size_t)(n0 + n) * K + k0 + 8 * c) = o; }
    LDS_WAIT(); asm volatile("" ::: "memory");
}
__device__ __forceinline__ void rms_row_f16(const float* xrow, const float* w, unsigned short* orow, int lane) {
    const f32x4* xr = (const f32x4*)xrow + lane; const f32x4* wr = (const f32x4*)w + lane;
    f32x4 v[4]; float s = 0.f;
#pragma unroll
    for (int j = 0; j < 4; ++j) { v[j] = xr[64 * j]; s += (v[j].x * v[j].x + v[j].y * v[j].y) + (v[j].z * v[j].z + v[j].w * v[j].w); }
    const float rs = 1.0f / sqrtf(wave_sum(s) * (1.0f / DM) + 1e-6f);
    u32x2* o8 = (u32x2*)orow + lane;
#pragma unroll
    for (int j = 0; j < 4; ++j) { const f32x4 ww = wr[64 * j]; u32x2 o; o.x = pg8::pk_f16(v[j].x * rs * ww.x, v[j].y * rs * ww.y); o.y = pg8::pk_f16(v[j].z * rs * ww.z, v[j].w * rs * ww.w); o8[64 * j] = o; }
}
__device__ __forceinline__ void rms_row_f32(float* xrow, const float* w, int lane) {
    f32x4* xr = (f32x4*)xrow + lane; const f32x4* wr = (const f32x4*)w + lane;
    f32x4 v[4]; float s = 0.f;
#pragma unroll
    for (int j = 0; j < 4; ++j) { v[j] = xr[64 * j]; s += (v[j].x * v[j].x + v[j].y * v[j].y) + (v[j].z * v[j].z + v[j].w * v[j].w); }
    const float rs = 1.0f / sqrtf(wave_sum(s) * (1.0f / DM) + 1e-6f);
#pragma unroll
    for (int j = 0; j < 4; ++j) { const f32x4 ww = wr[64 * j]; xr[64 * j] = v[j] * rs * ww; }
}


#define SHV(col) ({ const float cur_ = (float)urow[(col)]; const float prev_ = hp ? (float)prow[(col)] : 0.f; cur_ + mu[(col)] * (prev_ - cur_); })

__device__ __forceinline__ void store_row64_f16(f16* dst, const float (&S)[64]) {
#pragma unroll
    for (int q = 0; q < 8; ++q) { u32x4 w; w.x = pg8::pk_f16(S[8 * q], S[8 * q + 1]); w.y = pg8::pk_f16(S[8 * q + 2], S[8 * q + 3]); w.z = pg8::pk_f16(S[8 * q + 4], S[8 * q + 5]); w.w = pg8::pk_f16(S[8 * q + 6], S[8 * q + 7]); *(u32x4*)(dst + 8 * q) = w; }
}


constexpr int RWA_REC = 768, RWA_VPL = 16 * RWA_REC, RWA_SCR = RWA_VPL + 2048, RWA_BYTES = RWA_SCR + 1024;
typedef float f32x2 __attribute__((ext_vector_type(2)));
typedef _Float16 f16x4 __attribute__((ext_vector_type(4)));
__device__ __forceinline__ float fmix_lo(float a, unsigned b, float c) { float d; asm("v_fma_mix_f32 %0, %1, %2, %3 op_sel:[0,0,0] op_sel_hi:[0,1,0]" : "=v"(d) : "v"(a), "v"(b), "v"(c)); return d; }
__device__ __forceinline__ float fmix_hi(float a, unsigned b, float c) { float d; asm("v_fma_mix_f32 %0, %1, %2, %3 op_sel:[0,1,0] op_sel_hi:[0,1,0]" : "=v"(d) : "v"(a), "v"(b), "v"(c)); return d; }
__device__ __forceinline__ float mmix_lo(float a, unsigned b) { float d; asm("v_fma_mix_f32 %0, %1, %2, 0 op_sel:[0,0,0] op_sel_hi:[0,1,0]" : "=v"(d) : "v"(a), "v"(b)); return d; }
__device__ __forceinline__ float mmix_hi(float a, unsigned b) { float d; asm("v_fma_mix_f32 %0, %1, %2, 0 op_sel:[0,1,0] op_sel_hi:[0,1,0]" : "=v"(d) : "v"(a), "v"(b)); return d; }
__device__ __forceinline__ float fma_asm(float a, float b, float c) { float d; asm("v_fma_f32 %0, %1, %2, %3" : "=v"(d) : "v"(a), "v"(b), "v"(c)); return d; }
#define FMIX(a, u, j, c) (((j) & 1) ? fmix_hi((a), (u)[(j) >> 1], (c)) : fmix_lo((a), (u)[(j) >> 1], (c)))
#define MMIX(a, u, j) (((j) & 1) ? mmix_hi((a), (u)[(j) >> 1]) : mmix_lo((a), (u)[(j) >> 1]))
__device__ __forceinline__ float fast_tanh(float x) { return 1.0f - 2.0f / (__expf(2.0f * x) + 1.0f); }
__device__ __forceinline__ void lerp8(const char* ub, unsigned uo, unsigned po, bool hp, const char* mub, unsigned col, float (&x)[8]) {
    const f16x8 cu = *(const f16x8*)(ub + (uo + col * 2u)); f16x8 pv = *(const f16x8*)(ub + (po + col * 2u)); const f32x4 m0 = *(const f32x4*)(mub + col * 4u), m1 = *(const f32x4*)(mub + col * 4u + 16u);
#pragma unroll
    for (int j = 0; j < 8; ++j) { const float c = (float)cu[j], p = hp ? (float)pv[j] : 0.f; x[j] = c + (j < 4 ? m0[j] : m1[j - 4]) * (p - c); }
}
__device__ __forceinline__ void lerp4(const char* ub, unsigned uo, unsigned po, bool hp, const char* mub, unsigned col, float (&x)[4]) {
    const f16x4 cu = *(const f16x4*)(ub + (uo + col * 2u)); f16x4 pv = *(const f16x4*)(ub + (po + col * 2u)); const f32x4 m0 = *(const f32x4*)(mub + col * 4u);
#pragma unroll
    for (int j = 0; j < 4; ++j) { const float c = (float)cu[j], p = hp ? (float)pv[j] : 0.f; x[j] = c + m0[j] * (p - c); }
}
__device__ __forceinline__ f16x8 pack8(const float (&x)[8]) { f16x8 r;
#pragma unroll
    for (int j = 0; j < 8; ++j) r[j] = (f16)x[j];
    return r; }

__device__ __forceinline__ void rwkv_waveA(const Args& a, int l, int b, int c, int h, LAS unsigned char* wl, int lane) {
    const f16* U = (const f16*)(a.ws + WS_U); f16* MIX = (f16*)(a.ws + WS_MIX); f16* VF = (f16*)(a.ws + WS_VF); f16* VP = (f16*)(a.ws + WS_VP);
    f16* QT = (f16*)(a.ws + WS_QT); f16* PT = (f16*)(a.ws + WS_PT); f16* RL = (f16*)(a.ws + WS_RL); float* BONG = (float*)(a.ws + WS_BON);
    const f16* WUPT = (const f16*)(a.ws + WS_WUPT) + (size_t)l * 384 * 64; const f16* AUPT = (const f16*)(a.ws + WS_AUPT) + (size_t)l * 384 * 64;
    const f16* VDNT = (const f16*)(a.ws + WS_VDNT); const f16* VUPT = (const f16*)(a.ws + WS_VUPT);
    const float* mu = a.in[3] + l * RW_SHIFT; const float* w0 = a.in[4] + l * RW_W; const float* a0 = a.in[6] + l * RW_W; const float* v0 = a.in[8];
    const float* k_k = a.in[11] + l * RW_W; const float* k_a = a.in[12] + l * RW_W; const float* r_k = a.in[13] + l * RW_W;
    const int bh = b * RW_H + h;
    float P[64], L[64];
#pragma unroll
    for (int k = 0; k < 64; ++k) { P[k] = (k == lane) ? 1.f : 0.f; L[k] = 0.f; }
#pragma unroll 1
    for (int blk = 0; blk < 4; ++blk) {
        int lane_ = lane; asm volatile("" : "+v"(lane_));
        const int tok = lane_ & 15, fq = lane_ >> 4;
        const int t = c * CH + blk * 16 + tok; const unsigned m = (unsigned)(b * SEQ + t); const bool hp = t > 0;
        const char* ub = (const char*)U; const char* mub = (const char*)mu; const unsigned uo = m * (unsigned)(NU * 2), po = hp ? uo - (unsigned)(NU * 2) : uo;
        f16x8 bW[2], bA[2], bVD;
#pragma unroll
        for (int s = 0; s < 2; ++s) {
            float x[8]; lerp8(ub, uo, po, hp, mub, (unsigned)(C_WL + 8 * fq + 32 * s), x);
#pragma unroll
            for (int j = 0; j < 8; ++j) x[j] = fast_tanh(x[j]);
            bW[s] = pack8(x);
            lerp8(ub, uo, po, hp, mub, (unsigned)(C_AL + 8 * fq + 32 * s), x);
            bA[s] = pack8(x);
            asm volatile("" ::: "memory");
        }
        if (l > 0) {
            f32x4 VD0 = (f32x4){0.f, 0.f, 0.f, 0.f}, VD1 = VD0;
#pragma unroll 1
            for (int s = 0; s < 12; ++s) {
                float x[8]; lerp8(ub, uo, po, hp, mub, (unsigned)(C_V + 8 * fq + 32 * s), x);
                const f16x8 bv = pack8(x);
                VD0 = __builtin_amdgcn_mfma_f32_16x16x32_f16(*(const f16x8*)((const char*)VDNT + (unsigned)(tok * 384 + 8 * fq + 32 * s) * 2u), bv, VD0, 0, 0, 0);
                VD1 = __builtin_amdgcn_mfma_f32_16x16x32_f16(*(const f16x8*)((const char*)VDNT + (unsigned)((16 + tok) * 384 + 8 * fq + 32 * s) * 2u), bv, VD1, 0, 0, 0);
            }
            LAS f16* scr = (LAS f16*)(wl + RWA_SCR);
            { f16x4 p0, p1;
#pragma unroll
              for (int i = 0; i < 4; ++i) { p0[i] = (f16)VD0[i]; p1[i] = (f16)VD1[i]; }
              *(LAS f16x4*)(scr + tok * 32 + 4 * fq) = p0; *(LAS f16x4*)(scr + tok * 32 + 16 + 4 * fq) = p1; }
            asm volatile("s_waitcnt lgkmcnt(0)" ::: "memory");
            bVD = *(const LAS f16x8*)(scr + tok * 32 + 8 * fq);
        }
        float ssq = 0.f;
#pragma unroll 1
        for (int nt = 0; nt < 4; ++nt) { const int cb = h * 64 + 16 * nt + 4 * fq; float ks[4]; lerp4(ub, uo, po, hp, mub, (unsigned)(C_K + cb), ks); const f32x4 kk4 = *(const f32x4*)((const char*)k_k + (unsigned)cb * 4u);
#pragma unroll
            for (int i = 0; i < 4; ++i) { const float kv = ks[i] * kk4[i]; ssq += kv * kv; }
            asm volatile("" ::: "memory"); }
        ssq += __shfl_xor(ssq, 16); ssq += __shfl_xor(ssq, 32);
        const float inv = 1.0f / fmaxf(sqrtf(ssq), 1e-12f);
        float bon = 0.f;
        LAS unsigned char* rec = wl + tok * RWA_REC;
#pragma unroll 1
        for (int nt = 0; nt < 4; ++nt) {
            const int cb = h * 64 + 16 * nt + 4 * fq, co = 16 * nt + 4 * fq; const int n = h * 64 + 16 * nt + tok;
            f32x4 DWn = (f32x4){0.f, 0.f, 0.f, 0.f}, DAn = DWn, Gn = DWn;
#pragma unroll
            for (int s = 0; s < 2; ++s) {
                DWn = __builtin_amdgcn_mfma_f32_16x16x32_f16(*(const f16x8*)((const char*)WUPT + (unsigned)(n * 64 + 8 * fq + 32 * s) * 2u), bW[s], DWn, 0, 0, 0);
                DAn = __builtin_amdgcn_mfma_f32_16x16x32_f16(*(const f16x8*)((const char*)AUPT + (unsigned)(n * 64 + 8 * fq + 32 * s) * 2u), bA[s], DAn, 0, 0, 0); }
            if (l > 0) Gn = __builtin_amdgcn_mfma_f32_16x16x32_f16(*(const f16x8*)((const char*)VUPT + (unsigned)(n * 32 + 8 * fq) * 2u), bVD, Gn, 0, 0, 0);
            float rs[4], ks[4], vs[4];
            lerp4(ub, uo, po, hp, mub, (unsigned)(C_R + cb), rs); lerp4(ub, uo, po, hp, mub, (unsigned)(C_K + cb), ks); lerp4(ub, uo, po, hp, mub, (unsigned)(C_V + cb), vs);
            const unsigned cb4 = (unsigned)cb * 4u; const f32x4 w04 = *(const f32x4*)((const char*)w0 + cb4), a04 = *(const f32x4*)((const char*)a0 + cb4), kk4 = *(const f32x4*)((const char*)k_k + cb4), ka4 = *(const f32x4*)((const char*)k_a + cb4), rk4 = *(const f32x4*)((const char*)r_k + cb4);
            f32x4 wv; f16x4 al, be, km, rr, vo;
            f16x4 vf4; f32x4 v04;
            const unsigned vo_b = (m * (unsigned)RW_W + (unsigned)cb) * 2u;
            if (l > 0) { vf4 = *(const f16x4*)((const char*)VF + vo_b); v04 = *(const f32x4*)((const char*)v0 + cb4); }
#pragma unroll
            for (int i = 0; i < 4; ++i) {
                wv[i] = __expf(-0.6065306597126334f * sigmoidf_(w04[i] + DWn[i]));
                const float aa = sigmoidf_(a04[i] + DAn[i]);
                float vv = vs[i];
                if (l > 0) vv = vs[i] + ((float)vf4[i] - vs[i]) * sigmoidf_(v04[i] + Gn[i]);
                const float kk = ks[i] * kk4[i] * inv;
                const float kmod = ks[i] * (1.0f + (aa - 1.0f) * ka4[i]);
                bon += rs[i] * kmod * rk4[i];
                al[i] = (f16)(-kk); be[i] = (f16)(kk * aa); km[i] = (f16)kmod; rr[i] = (f16)rs[i]; vo[i] = (f16)vv;
            }
            *(LAS f32x4*)(rec + co * 4) = wv;
            *(LAS f16x4*)(rec + 256 + co * 2) = al; *(LAS f16x4*)(rec + 384 + co * 2) = be; *(LAS f16x4*)(rec + 512 + co * 2) = km; *(LAS f16x4*)(rec + 640 + co * 2) = rr;
            *(LAS f16x4*)(wl + RWA_VPL + tok * 128 + co * 2) = vo;
            *(f16x4*)((char*)VP + vo_b) = vo;
            if (l == 0) *(f16x4*)((char*)VF + vo_b) = vo;
            asm volatile("" ::: "memory");
        }
        bon += __shfl_xor(bon, 16); bon += __shfl_xor(bon, 32);
        if (fq == 0) *(float*)((char*)BONG + (m * 8u + (unsigned)h) * 4u) = bon;
        const unsigned mb = (unsigned)(b * SEQ + c * CH + blk * 16);
#pragma unroll 1
        for (int t2 = 0; t2 < 16; ++t2) {
            const LAS unsigned char* rc = wl + t2 * RWA_REC;
            const float vv = (float)*(const LAS f16*)(wl + RWA_VPL + t2 * 128 + lane * 2);
            float sP0 = 0.f, sP1 = 0.f, sL0 = 0.f, sL1 = 0.f;
#pragma unroll
            for (int g = 0; g < 8; ++g) { const u32x4 a4 = *(const LAS u32x4*)(rc + 256 + g * 16);
#pragma unroll
                for (int j = 0; j < 8; j += 2) { sP0 = FMIX(P[8 * g + j], a4, j, sP0); sL0 = FMIX(L[8 * g + j], a4, j, sL0); sP1 = FMIX(P[8 * g + j + 1], a4, j + 1, sP1); sL1 = FMIX(L[8 * g + j + 1], a4, j + 1, sL1); } }
            const float saP = sP0 + sP1, saL = sL0 + sL1;
            float q0 = 0.f, q1 = 0.f, y0 = 0.f, y1 = 0.f;
#pragma unroll
            for (int g = 0; g < 8; ++g) {
                const f32x4 wA = *(const LAS f32x4*)(rc + g * 32), wB = *(const LAS f32x4*)(rc + g * 32 + 16);
                const u32x4 b4 = *(const LAS u32x4*)(rc + 384 + g * 16), k4 = *(const LAS u32x4*)(rc + 512 + g * 16), r4 = *(const LAS u32x4*)(rc + 640 + g * 16);
#pragma unroll
                for (int j = 0; j < 8; ++j) { const int k = 8 * g + j; const float w = (j < 4) ? wA[j] : wB[j - 4];
                    const float tP = MMIX(saP, b4, j); float tL = MMIX(saL, b4, j); tL = FMIX(vv, k4, j, tL);
                    P[k] = fma_asm(P[k], w, tP); L[k] = fma_asm(L[k], w, tL);
                    if (j & 1) { q1 = FMIX(P[k], r4, j, q1); y1 = FMIX(L[k], r4, j, y1); } else { q0 = FMIX(P[k], r4, j, q0); y0 = FMIX(L[k], r4, j, y0); } }
            }
            *(f16*)((char*)MIX + ((mb + t2) * (unsigned)DM + (unsigned)(h * 64 + lane)) * 2u) = (f16)(y0 + y1);
            *(f16*)((char*)QT + ((mb + t2) * (unsigned)RW_W + (unsigned)(h * 64 + lane)) * 2u) = (f16)(q0 + q1);
        }
    }
    store_row64_f16(RL + (((size_t)bh * NCH + c) * 64 + lane) * 64, L);
    f16* pt = PT + ((size_t)bh * NCH + c) * 4096;
#pragma unroll
    for (int k = 0; k < 64; ++k) pt[k * 64 + lane] = (f16)P[k];
}

constexpr int HGA_REC = 512, HGA_HEAD = 16 * HGA_REC, HGA_BYTES = 3 * HGA_HEAD;
__device__ __forceinline__ void hgrn_waveA(const Args& a, int l, int b, int c, int h0, LAS unsigned char* wl, int lane) {
    const f16* U = (const f16*)(a.ws + WS_U); f16* MIX = (f16*)(a.ws + WS_MIX); f16* HL = (f16*)(a.ws + WS_HL); float* DC = (float*)(a.ws + WS_DC);
    const float* lbr = a.in[16];
    float S0[64], S1[64], S2[64];
#pragma unroll
    for (int k = 0; k < 64; ++k) { S0[k] = 0.f; S1[k] = 0.f; S2[k] = 0.f; }
    float dp0 = 1.f, dp1 = 1.f, dp2 = 1.f;
#pragma unroll 1
    for (int blk = 0; blk < 4; ++blk) {
        int lane_ = lane; asm volatile("" : "+v"(lane_));
        const unsigned mb = (unsigned)(b * SEQ + c * CH + blk * 16);
#pragma unroll 1
        for (int j = 0; j < 3; ++j) {
            const int col = (h0 + j) * 64 + lane_;
            const float lb = (l == 0) ? 0.f : sigmoidf_(lbr[384 + col] - lbr[col]);
            float dp = 1.f;
#pragma unroll 4
            for (int tk = 0; tk < 16; ++tk) {
                const char* ur = (const char*)U + (mb + tk) * (unsigned)(NU * 2);
                const float f = lb + (1.0f - lb) * sigmoidf_((float)*(const f16*)(ur + (unsigned)(C_HGF + col) * 2u));
                const f16 q = *(const f16*)(ur + (unsigned)(C_HGQ + col) * 2u);
                LAS unsigned char* rec = wl + j * HGA_HEAD + tk * HGA_REC;
                *(LAS float*)(rec + lane_ * 4) = f; *(LAS f16*)(rec + 256 + lane_ * 2) = (f16)(1.0f - f); *(LAS f16*)(rec + 384 + lane_ * 2) = q;
                dp *= f;
            }
            if (j == 0) dp0 *= dp; else if (j == 1) dp1 *= dp; else dp2 *= dp;
        }
#pragma unroll 1
        for (int t2 = 0; t2 < 16; ++t2) {
            const char* ur = (const char*)U + (mb + t2) * (unsigned)(NU * 2);
            const float v0 = (float)*(const f16*)(ur + (unsigned)(C_HGI + h0 * 64 + lane_) * 2u);
            const float v1 = (float)*(const f16*)(ur + (unsigned)(C_HGI + h0 * 64 + 64 + lane_) * 2u);
            const float v2 = (float)*(const f16*)(ur + (unsigned)(C_HGI + h0 * 64 + 128 + lane_) * 2u);
#define HG_STEP(S, vi, j, oo) { const LAS unsigned char* rc = wl + (j) * HGA_HEAD + t2 * HGA_REC; float o0 = 0.f, o1 = 0.f; \
            _Pragma("unroll") for (int g = 0; g < 8; ++g) { \
                const f32x4 fA = *(const LAS f32x4*)(rc + g * 32), fB = *(const LAS f32x4*)(rc + g * 32 + 16); \
                const u32x4 k4 = *(const LAS u32x4*)(rc + 256 + g * 16), q4 = *(const LAS u32x4*)(rc + 384 + g * 16); \
                _Pragma("unroll") for (int jj = 0; jj < 8; ++jj) { const int k = 8 * g + jj; const float f = (jj < 4) ? fA[jj] : fB[jj - 4]; \
                    const float tt = MMIX(vi, k4, jj); S[k] = fma_asm(S[k], f, tt); \
                    if (jj & 1) o1 = FMIX(S[k], q4, jj, o1); else o0 = FMIX(S[k], q4, jj, o0); } } \
            oo = o0 + o1; }
            float oa, ob, oc;
            HG_STEP(S0, v0, 0, oa) HG_STEP(S1, v1, 1, ob) HG_STEP(S2, v2, 2, oc)
#undef HG_STEP
            char* mo = (char*)MIX + ((mb + t2) * (unsigned)DM + (unsigned)(384 + h0 * 64 + lane_)) * 2u;
            *(f16*)mo = (f16)oa; *(f16*)(mo + 128) = (f16)ob; *(f16*)(mo + 256) = (f16)oc;
        }
    }
#define HG_OUT(S, j, dp) { const int bh = b * 6 + h0 + (j); f16* hl = HL + ((size_t)bh * NCH + c) * 4096; \
        _Pragma("unroll") for (int k = 0; k < 64; ++k) hl[k * 64 + lane] = (f16)S[k]; \
        DC[((size_t)bh * NCH + c) * 64 + lane] = dp; }
    HG_OUT(S0, 0, dp0) HG_OUT(S1, 1, dp1) HG_OUT(S2, 2, dp2)
#undef HG_OUT
}
__device__ __forceinline__ void phaseA(const Args& a, int l, int task, LAS unsigned char* lds, int tid) {
    asm volatile("" : "+v"(tid));
    const int lane = tid & 63, wave = __builtin_amdgcn_readfirstlane(tid >> 6);
    const int b = task / NCH, c = task % NCH;
    const f16* U = (const f16*)(a.ws + WS_U); f16* MIX = (f16*)(a.ws + WS_MIX); f16* VF = (f16*)(a.ws + WS_VF); f16* VP = (f16*)(a.ws + WS_VP);
    f16* QT = (f16*)(a.ws + WS_QT); f16* PT = (f16*)(a.ws + WS_PT); f16* RL = (f16*)(a.ws + WS_RL); float* BONG = (float*)(a.ws + WS_BON);
    const int tt = tid >> 3, sub = tid & 7;
    const int t = c * CH + tt; const size_t m = (size_t)b * SEQ + t;
    const f16* urow = U + m * NU; const f16* prow = urow - NU; const bool hp = t > 0;
    if (wave < RW_H) rwkv_waveA(a, l, b, c, wave, lds + wave * RWA_BYTES, lane);
    else hgrn_waveA(a, l, b, c, 3 * (wave - RW_H), lds + RW_H * RWA_BYTES + (wave - RW_H) * HGA_BYTES, lane);
    __syncthreads();
    {
        f16* CA = (f16*)(a.ws + WS_CA); float* LA = (float*)(a.ws + WS_LA); float* LH = (float*)(a.ws + WS_LH);
        const float* cw = a.in[18] + l * 4 * 256; const float* cb = a.in[19] + l * 256;
        const float* ba = a.in[21] + l * 256; const float* bx = a.in[23] + l * 256; const float* lam = a.in[24] + l * 256;
        LAS float* Y = (LAS float*)lds; LAS float* AA = (LAS float*)(lds + 16384); LAS float* UU = (LAS float*)(lds + 32768);
#pragma unroll 1
        for (int g = 0; g < 4; ++g) {
            const float* wa = a.in[20] + (size_t)(l * 4 + g) * 4096; const float* wx = a.in[22] + (size_t)(l * 4 + g) * 4096;
#pragma unroll 1
            for (int i = 0; i < 8; ++i) { const int j = sub * 8 + i, ch = g * 64 + j; float y = cb[ch];
#pragma unroll
                for (int jj = 0; jj < 4; ++jj) { const int ts = t - 3 + jj; if (ts >= 0) y += cw[jj * 256 + ch] * (float)U[((size_t)b * SEQ + ts) * NU + C_LRUX + ch]; }
                Y[tt * 64 + j] = y; }
            __syncthreads();
#pragma unroll 1
            for (int i = 0; i < 8; ++i) { const int j = sub * 8 + i, ch = g * 64 + j; float ra = ba[ch], rx = bx[ch];
#pragma unroll 4
                for (int i2 = 0; i2 < 64; ++i2) { const float yv = Y[tt * 64 + i2]; ra += yv * wa[i2 * 64 + j]; rx += yv * wx[i2 * 64 + j]; }
                const float r = sigmoidf_(ra), ig = sigmoidf_(rx);
                const float la = -8.0f * r * log1pf(expf(-lam[ch]));
                AA[tt * 64 + j] = expf(la); UU[tt * 64 + j] = sqrtf(-expm1f(2.0f * la)) * (ig * Y[tt * 64 + j]); }
            __syncthreads();
            if (wave == 0) {
                const int ch = g * 64 + lane; float hst = 0.f, ap = 1.f;
                for (int t2 = 0; t2 < CH; ++t2) { const size_t m2 = (size_t)b * SEQ + c * CH + t2; const float av = AA[t2 * 64 + lane];
                    hst = av * hst + UU[t2 * 64 + lane]; ap *= av;
                    MIX[m2 * DM + 768 + ch] = (f16)hst; CA[m2 * 256 + ch] = (f16)ap; }
                LA[((size_t)b * NCH + c) * 256 + ch] = ap; LH[((size_t)b * NCH + c) * 256 + ch] = hst;
            }
            __syncthreads();
        }
    }
}

__device__ __forceinline__ void phaseB(const Args& a, LAS unsigned char* lds, int tid) {
    asm volatile("" : "+v"(tid));
    const int lane = tid & 63, wave = __builtin_amdgcn_readfirstlane(tid >> 6);
    const int bx = blockIdx.x;
    if (bx < 12) {
        const int bh = bx;
        f16* PT = (f16*)(a.ws + WS_PT); f16* RL = (f16*)(a.ws + WS_RL);
        LAS float* PTL = (LAS float*)lds;
        LAS float* SN = (LAS float*)(lds + 16384);
        float S[64];
#pragma unroll
        for (int k = 0; k < 64; ++k) S[k] = 0.f;
        for (int c = 0; c < NCH; ++c) {
            const f16* pt = PT + ((size_t)bh * NCH + c) * 4096; f16* rl = RL + ((size_t)bh * NCH + c) * 4096;
            { const f16x8 p8 = *(const f16x8*)(pt + tid * 8);
#pragma unroll
              for (int j = 0; j < 8; ++j) PTL[tid * 8 + j] = (float)p8[j]; }
            const f16x8 l8 = *(const f16x8*)(rl + lane * 64 + wave * 8);
            asm volatile("s_waitcnt vmcnt(0)" ::: "memory");
            __syncthreads();
            if (wave == 0) store_row64_f16(rl + lane * 64, S);
#pragma unroll
            for (int j = 0; j < 8; ++j) SN[lane * 65 + wave * 8 + j] = (float)l8[j];
#pragma unroll 1
            for (int j = 0; j < 8; ++j) { float acc = SN[lane * 65 + wave * 8 + j];
                const LAS float* pr = PTL + (wave * 8 + j) * 64;
                float a0 = 0.f, a1 = 0.f, a2 = 0.f, a3 = 0.f;
#pragma unroll
                for (int k = 0; k < 64; k += 4) { const f32x4 p4 = *(const LAS f32x4*)(pr + k); a0 += S[k] * p4.x; a1 += S[k + 1] * p4.y; a2 += S[k + 2] * p4.z; a3 += S[k + 3] * p4.w; }
                SN[lane * 65 + wave * 8 + j] = acc + ((a0 + a1) + (a2 + a3)); }
            __syncthreads();
#pragma unroll
            for (int k = 0; k < 64; ++k) S[k] = SN[lane * 65 + k];
            __syncthreads();
        }
    } else if (bx < 12 + 96) {
        const int idx = (bx - 12) * NT + tid; const int bh = idx >> 12, e = idx & 4095, k = e >> 6;
        f16* HL = (f16*)(a.ws + WS_HL); const float* DC = (const float*)(a.ws + WS_DC);
        float s = 0.f;
        for (int c0 = 0; c0 < NCH; c0 += 8) { float Lc[8], d[8];
#pragma unroll
            for (int j = 0; j < 8; ++j) { Lc[j] = (float)HL[((size_t)bh * NCH + c0 + j) * 4096 + e]; d[j] = DC[((size_t)bh * NCH + c0 + j) * 64 + k]; }
#pragma unroll
            for (int j = 0; j < 8; ++j) { HL[((size_t)bh * NCH + c0 + j) * 4096 + e] = (f16)s; s = d[j] * s + Lc[j]; } }
    } else if (bx == 12 + 96) {
        const int bb = tid >> 8, ch = tid & 255; const float* LA = (const float*)(a.ws + WS_LA); float* LH = (float*)(a.ws + WS_LH);
        float cy = 0.f;
        for (int c0 = 0; c0 < NCH; c0 += 8) { float A[8], H[8];
#pragma unroll
            for (int j = 0; j < 8; ++j) { const size_t o = ((size_t)bb * NCH + c0 + j) * 256 + ch; A[j] = LA[o]; H[j] = LH[o]; }
#pragma unroll
            for (int j = 0; j < 8; ++j) { const size_t o = ((size_t)bb * NCH + c0 + j) * 256 + ch; LH[o] = cy; cy = A[j] * cy + H[j]; } }
    }
}

__device__ __forceinline__ void phaseC(const Args& a, int l, int task, LAS unsigned char* lds, int tid) {
    asm volatile("" : "+v"(tid));
    const int lane = tid & 63, wave = __builtin_amdgcn_readfirstlane(tid >> 6);
    const int b = task / NCH, c = task % NCH;
    const f16* U = (const f16*)(a.ws + WS_U); f16* MIX = (f16*)(a.ws + WS_MIX); const f16* VP = (const f16*)(a.ws + WS_VP);
    const f16* QT = (const f16*)(a.ws + WS_QT); const f16* RL = (const f16*)(a.ws + WS_RL); const float* BONG = (const float*)(a.ws + WS_BON);
    const int tt = tid >> 3, sub = tid & 7;
    const size_t m = (size_t)b * SEQ + c * CH + tt;
    const f16* urow = U + m * NU;
    {
        const float* ln_w = a.in[14] + l * RW_W; const float* ln_b = a.in[15] + l * RW_W;
        LAS float* SL = (LAS float*)lds;
#pragma unroll 1
        for (int h = 0; h < RW_H; ++h) {
            const int bh = b * RW_H + h;
            { const f16x8 s8 = *(const f16x8*)(RL + ((size_t)bh * NCH + c) * 4096 + tid * 8); const int v = tid >> 3, k0 = (tid & 7) * 8;
#pragma unroll
              for (int j = 0; j < 8; ++j) SL[v * 68 + k0 + j] = (float)s8[j]; }
            float q[64];
#pragma unroll
            for (int qq = 0; qq < 8; ++qq) { const f16x8 q8 = *(const f16x8*)(QT + m * RW_W + h * 64 + qq * 8);
#pragma unroll
                for (int j = 0; j < 8; ++j) q[qq * 8 + j] = (float)q8[j]; }
            __syncthreads();
            const f16x8 yl = *(const f16x8*)(MIX + m * DM + h * 64 + sub * 8);
            LAS float* YS = (LAS float*)(lds + 20480) + tid * 9;
#pragma unroll
            for (int i = 0; i < 8; ++i) YS[i] = (float)yl[i];
#pragma unroll 1
            for (int i = 0; i < 8; ++i) { const LAS float* sr = SL + (sub * 8 + i) * 68;
                float a0 = 0.f, a1 = 0.f, a2 = 0.f, a3 = 0.f;
#pragma unroll
                for (int k = 0; k < 64; k += 4) { const f32x4 s4 = *(const LAS f32x4*)(sr + k); a0 += q[k] * s4.x; a1 += q[k + 1] * s4.y; a2 += q[k + 2] * s4.z; a3 += q[k + 3] * s4.w; }
                YS[i] += (a0 + a1) + (a2 + a3); }
            float y[8]; float sm = 0.f;
#pragma unroll
            for (int i = 0; i < 8; ++i) { y[i] = YS[i]; sm += y[i]; }
            sm += __shfl_xor(sm, 1); sm += __shfl_xor(sm, 2); sm += __shfl_xor(sm, 4);
            const float mean = sm * (1.0f / 64.0f); float vr = 0.f;
#pragma unroll
            for (int i = 0; i < 8; ++i) { const float d = y[i] - mean; vr += d * d; }
            vr += __shfl_xor(vr, 1); vr += __shfl_xor(vr, 2); vr += __shfl_xor(vr, 4);
            const float rstd = 1.0f / sqrtf(vr * (1.0f / 64.0f) + 64e-5f);
            const float bon = BONG[m * 8 + h];
            const f16x8 vp = *(const f16x8*)(VP + m * RW_W + h * 64 + sub * 8); const f16x8 z8 = *(const f16x8*)(urow + C_RWZ + h * 64 + sub * 8);
            float o[8];
#pragma unroll
            for (int i = 0; i < 8; ++i) { const int col = h * 64 + sub * 8 + i; o[i] = ((y[i] - mean) * rstd * ln_w[col] + ln_b[col] + bon * (float)vp[i]) * siluf_((float)z8[i]); }
            u32x4 w; w.x = pg8::pk_f16(o[0], o[1]); w.y = pg8::pk_f16(o[2], o[3]); w.z = pg8::pk_f16(o[4], o[5]); w.w = pg8::pk_f16(o[6], o[7]);
            *(u32x4*)(MIX + m * DM + h * 64 + sub * 8) = w;
            __syncthreads();
        }
    }
    {
        const f16* HL = (const f16*)(a.ws + WS_HL); const float* lbr = a.in[16]; const float* nw = a.in[17] + l * 384;
        LAS float* SL = (LAS float*)lds;
        LAS float* QE = (LAS float*)(lds + 16384);
#pragma unroll 1
        for (int h = 0; h < 6; ++h) {
            const int bh = b * 6 + h;
            { const f16x8 s8 = *(const f16x8*)(HL + ((size_t)bh * NCH + c) * 4096 + tid * 8);
#pragma unroll
              for (int j = 0; j < 8; ++j) SL[tid * 8 + j] = (float)s8[j]; }
            { LAS float* FT = (LAS float*)(lds + 16384 + 17408);
              const f16x8 f8 = *(const f16x8*)(urow + C_HGF + h * 64 + sub * 8), q8 = *(const f16x8*)(urow + C_HGQ + h * 64 + sub * 8);
#pragma unroll
              for (int i = 0; i < 8; ++i) { const int col = h * 64 + sub * 8 + i; const float lb = (l == 0) ? 0.f : sigmoidf_(lbr[384 + col] - lbr[col]);
                  FT[(sub * 8 + i) * 68 + tt] = lb + (1.0f - lb) * sigmoidf_((float)f8[i]); QE[tt * 68 + sub * 8 + i] = (float)q8[i]; }
              __syncthreads();
              if (wave == 0) {
                  float cp = 1.f;
#pragma unroll
                  for (int t4 = 0; t4 < 64; t4 += 4) { const f32x4 f4 = *(const LAS f32x4*)(FT + lane * 68 + t4);
#pragma unroll
                      for (int i = 0; i < 4; ++i) { cp *= f4[i]; QE[(t4 + i) * 68 + lane] *= cp; } }
              } }
            __syncthreads();
            const f16x8 ol = *(const f16x8*)(MIX + m * DM + 384 + h * 64 + sub * 8);
            float o[8];
#pragma unroll
            for (int i = 0; i < 8; ++i) o[i] = (float)ol[i];
#pragma unroll 8
            for (int k = 0; k < 64; ++k) { const float qe = QE[tt * 68 + k]; const f32x4 s0 = *(const LAS f32x4*)(SL + k * 64 + sub * 8), s1 = *(const LAS f32x4*)(SL + k * 64 + sub * 8 + 4);
                o[0] += qe * s0.x; o[1] += qe * s0.y; o[2] += qe * s0.z; o[3] += qe * s0.w; o[4] += qe * s1.x; o[5] += qe * s1.y; o[6] += qe * s1.z; o[7] += qe * s1.w; }
            float ss = 0.f;
#pragma unroll
            for (int i = 0; i < 8; ++i) ss += o[i] * o[i];
            ss += __shfl_xor(ss, 1); ss += __shfl_xor(ss, 2); ss += __shfl_xor(ss, 4);
            const float rs = 1.0f / sqrtf(ss * (1.0f / 64.0f) + 1e-6f);
            const f16x8 z8 = *(const f16x8*)(urow + C_HGZ + h * 64 + sub * 8);
#pragma unroll
            for (int i = 0; i < 8; ++i) o[i] = o[i] * rs * nw[h * 64 + sub * 8 + i] * siluf_((float)z8[i]);
            u32x4 w; w.x = pg8::pk_f16(o[0], o[1]); w.y = pg8::pk_f16(o[2], o[3]); w.z = pg8::pk_f16(o[4], o[5]); w.w = pg8::pk_f16(o[6], o[7]);
            *(u32x4*)(MIX + m * DM + 384 + h * 64 + sub * 8) = w;
            __syncthreads();
        }
    }
    {
        const f16* CA = (const f16*)(a.ws + WS_CA); const float* LH = (const float*)(a.ws + WS_LH);
#pragma unroll 1
        for (int q = 0; q < 4; ++q) { const int ch0 = q * 64 + sub * 8;
            const f16x8 hl = *(const f16x8*)(MIX + m * DM + 768 + ch0), ca = *(const f16x8*)(CA + m * 256 + ch0), z8 = *(const f16x8*)(urow + C_LRUZ + ch0);
            float o[8];
#pragma unroll
            for (int i = 0; i < 8; ++i) o[i] = ((float)hl[i] + (float)ca[i] * LH[((size_t)b * NCH + c) * 256 + ch0 + i]) * siluf_((float)z8[i]);
            u32x4 w; w.x = pg8::pk_f16(o[0], o[1]); w.y = pg8::pk_f16(o[2], o[3]); w.z = pg8::pk_f16(o[4], o[5]); w.w = pg8::pk_f16(o[6], o[7]);
            *(u32x4*)(MIX + m * DM + 768 + ch0) = w; }
    }
}
#define XB_TMO      128
#define XB_XCNT(j)  (256  + 64 * (j))
#define XB_XSUB(j)  (1280 + 64 * (j))
#define XB_XGEN(j)  (2304 + 64 * (j))
#define XB_TOP      3328
#define XB_TOPGEN   3392
#define XCD_BAR_WORDS 3456
#define XB_SPIN_CAP (1u << 18)

__device__ __forceinline__ unsigned xb_ld(unsigned* p)              { return __hip_atomic_load(p, __ATOMIC_RELAXED, __HIP_MEMORY_SCOPE_AGENT); }
__device__ __forceinline__ unsigned xb_add(unsigned* p, unsigned v) { return __hip_atomic_fetch_add(p, v, __ATOMIC_RELAXED, __HIP_MEMORY_SCOPE_AGENT); }
__device__ __forceinline__ unsigned xb_xcc_id() { return (unsigned)__builtin_amdgcn_s_getreg((3 << 11) | 20) & 0xFu; }
#define XB_SPIN(cond, bar) do { unsigned _sp = 0; while (cond) { __builtin_amdgcn_s_sleep(1); \
    if ((++_sp & 255u) == 0u) { if (xb_ld(&(bar)[XB_TMO])) break; if (_sp > XB_SPIN_CAP) { atomicAdd(&(bar)[XB_TMO], 1u); break; } } } } while (0)

struct XcdBarrier {
    unsigned* bar; unsigned x; int isw0;
    volatile LAS unsigned* st;
};

__device__ __forceinline__ XcdBarrier xcd_barrier_post(unsigned* bar, volatile LAS unsigned* st, int isw0) {
    XcdBarrier b; b.bar = bar; b.x = xb_xcc_id(); b.st = st; b.isw0 = isw0;
    if (isw0 && lane_now() == 0) (void)xb_add(&bar[XB_XCNT(b.x)], 1u);
    return b;
}
__device__ __forceinline__ void xcd_barrier_complete(unsigned* bar, unsigned x, unsigned& nloc, unsigned& nx) {
    const unsigned G = gridDim.x * gridDim.y * gridDim.z;
    unsigned sum, cnt, mine, sp = 0u;
    for (;;) {
        sum = 0u; cnt = 0u; mine = 0u;
#pragma unroll
        for (unsigned j = 0; j < 16; ++j) { const unsigned c = xb_ld(&bar[XB_XCNT(j)]); sum += c; cnt += (c > 0u) ? 1u : 0u; mine = (j == x) ? c : mine; }
        if (sum == G) break;
        __builtin_amdgcn_s_sleep(1);
        if ((++sp & 255u) == 0u) { if (xb_ld(&bar[XB_TMO])) break; if (sp > XB_SPIN_CAP) { atomicAdd(&bar[XB_TMO], 1u); break; } }
    }
    nloc = mine > 0u ? mine : 1u; nx = cnt > 0u ? cnt : 1u;
}

__device__ __forceinline__ void xcd_barrier(const XcdBarrier& b) {
    asm volatile("s_waitcnt vmcnt(0)" ::: "memory");
    __syncthreads();
    if (b.isw0 && lane_now() == 0) {
        unsigned* bar = b.bar;
        __builtin_amdgcn_s_waitcnt(0);
        unsigned nloc = b.st[0], nx = b.st[1];
        if (nloc == 0u) { xcd_barrier_complete(bar, b.x, nloc, nx); b.st[0] = nloc; b.st[1] = nx; }
        const unsigned old = xb_add(&bar[XB_XSUB(b.x)], 1u);
        const unsigned gen = old / nloc;
        if (old + 1u == (gen + 1u) * nloc) {
            __builtin_amdgcn_fence(__ATOMIC_RELEASE, "agent");
            asm volatile("s_waitcnt vmcnt(0)" ::: "memory");
            const unsigned og = xb_add(&bar[XB_TOP], 1u);
            const unsigned tg = og / nx;
            if (og + 1u == (tg + 1u) * nx) xb_add(&bar[XB_TOPGEN], 1u);
            else XB_SPIN(xb_ld(&bar[XB_TOPGEN]) == tg, bar);
            __builtin_amdgcn_fence(__ATOMIC_ACQUIRE, "agent");
            xb_add(&bar[XB_XGEN(b.x)], 1u);
            asm volatile("s_waitcnt vmcnt(0)" ::: "memory");
        } else {
            XB_SPIN(xb_ld(&bar[XB_XGEN(b.x)]) == gen, bar);
            __builtin_amdgcn_fence(__ATOMIC_ACQUIRE, "agent");
            asm volatile("s_waitcnt vmcnt(0)" ::: "memory");
        }
    }
    __syncthreads();
}

constexpr size_t WS_BAR = 16384;
constexpr int MISC_OFF = LDS_BYTES - 16;
__global__ void __launch_bounds__(NT, 2) fwd(Args args) {
    extern __shared__ __attribute__((aligned(16))) unsigned char lds_raw[];
    LAS unsigned char* lds = (LAS unsigned char*)lds_raw;
    cg::grid_group grid = cg::this_grid();
    const int wave = __builtin_amdgcn_readfirstlane((int)threadIdx.x >> 6);
#define TID_NOW() (wave * 64 + lane_now())
    const int tid = TID_NOW(); const int lane = tid & 63;
    if (wave == 0 && lane < 4) ((LAS unsigned*)(lds + MISC_OFF))[lane] = 0u;
    __syncthreads();
    XcdBarrier xbar = xcd_barrier_post((unsigned*)(args.ws + WS_BAR), (volatile LAS unsigned*)(lds + MISC_OFF), __builtin_amdgcn_readfirstlane(wave == 0 ? 1 : 0));
#define GRID_BAR() do { XcdBarrier xb_ = xbar; asm volatile("" : "+s"(xb_.bar), "+s"(xb_.x)); xcd_barrier(xb_); } while (0)
    const int G = gridDim.x, gw = blockIdx.x * NWAVES + wave, NGW = G * NWAVES;
    unsigned char* ws = args.ws;
    unsigned short* XN = (unsigned short*)(ws + WS_XN);
    {
        LAS float* scr = (LAS float*)(lds + wave * 16384);
        constexpr int I_IN = (DM / 64) * (NIN / 32), I_OUT = (DM / 64) * (DM / 32), NITEMS = DEPTH * (I_IN + I_OUT);
        for (int it = gw; it < NITEMS; it += NGW) {
            int r = it; const int l = r / (I_IN + I_OUT); r -= l * (I_IN + I_OUT);
            if (r < I_IN) p0_transpose_item(args.in[2] + (size_t)l * DM * NIN, DM, NIN, (unsigned short*)(ws + WS_WIN + l * WIN_L), scr, r, lane);
            else p0_transpose_item(args.in[25] + (size_t)l * DM * DM, DM, DM, (unsigned short*)(ws + WS_WOUT + l * WOUT_L), scr, r - I_IN, lane);
        }
        for (int i = gw; i < DEPTH * (NU - NIN) * DM * 2 / 1024; i += NGW) { const int l = i / ((NU - NIN) * DM * 2 / 1024), r = i % ((NU - NIN) * DM * 2 / 1024);
            *(u32x4*)(ws + WS_WIN + l * WIN_L + (size_t)NIN * DM * 2 + (size_t)r * 1024 + lane * 16) = (u32x4){0u, 0u, 0u, 0u}; }
        for (int m = gw; m < M; m += NGW) rms_row_f16(args.in[0] + (size_t)m * DM, args.in[1], XN + (size_t)m * DM, lane);
        { f16* WUPT = (f16*)(ws + WS_WUPT); f16* AUPT = (f16*)(ws + WS_AUPT); f16* VDNT = (f16*)(ws + WS_VDNT); f16* VUPT = (f16*)(ws + WS_VUPT);
          for (int i = blockIdx.x * NT + tid; i < 122880; i += G * NT) {
              if (i < 49152) { const int ll = i / 24576, r = i % 24576, n = r / 64, k = r % 64; WUPT[i] = (f16)args.in[5][(size_t)ll * 24576 + k * 384 + n]; }
              else if (i < 98304) { const int i2 = i - 49152, ll = i2 / 24576, r = i2 % 24576, n = r / 64, k = r % 64; AUPT[i2] = (f16)args.in[7][(size_t)ll * 24576 + k * 384 + n]; }
              else if (i < 110592) { const int i2 = i - 98304, j2 = i2 / 384, cc = i2 % 384; VDNT[i2] = (f16)args.in[9][cc * 32 + j2]; }
              else { const int i2 = i - 110592, n = i2 / 32, j2 = i2 % 32; VUPT[i2] = (f16)args.in[10][j2 * 384 + n]; } } }
    }
    grid.sync();
#pragma unroll 1
    for (int l = 0; l < DEPTH; ++l) {
        { pg8::Gemm g{XN, (const unsigned short*)(ws + WS_WIN + l * WIN_L), M, NU, DM}; pg8::StaticOrder S; S.init(M, NU, G, (int)blockIdx.x);
          pg8::EpiF16 E{(unsigned short*)(ws + WS_U), NU};
          pg8::gemm_phase<pg8::EpiF16, pg8::StaticOrder, true, true>(lds, g, S, E, wave); }
        GRID_BAR();
        for (int task = blockIdx.x; task < BATCH * NCH; task += G) phaseA(args, l, task, lds, TID_NOW());
        GRID_BAR();
        phaseB(args, lds, TID_NOW());
        GRID_BAR();
        for (int task = blockIdx.x; task < BATCH * NCH; task += G) phaseC(args, l, task, lds, TID_NOW());
        GRID_BAR();
        { pg8::Gemm g{(const unsigned short*)(ws + WS_MIX), (const unsigned short*)(ws + WS_WOUT + l * WOUT_L), M, DM, DM}; pg8::StaticOrder S; S.init(M, DM, G, (int)blockIdx.x);
          pg8::EpiRes E{l == 0 ? args.in[0] : args.out, args.out, DM};
          pg8::gemm_phase<pg8::EpiRes, pg8::StaticOrder, true, true>(lds, g, S, E, wave); }
        GRID_BAR();
        { int ln = TID_NOW() & 63; asm volatile("" : "+v"(ln));
          if (l + 1 < DEPTH) { for (int m = gw; m < M; m += NGW) rms_row_f16(args.out + (size_t)m * DM, args.in[1] + (l + 1) * DM, XN + (size_t)m * DM, ln); GRID_BAR(); }
          else { for (int m = gw; m < M; m += NGW) rms_row_f32(args.out + (size_t)m * DM, args.in[26], ln); } }
    }
}

extern "C" void kernel_launch(void* const* d_in, const int* in_sizes, int n_in, void* d_out, int out_size, void* d_ws, size_t ws_size, hipStream_t stream) {
    static int grid = 0;
    if (grid == 0) {
        if (n_in != 27 || in_sizes[0] != M * DM || out_size != M * DM || ws_size < WS_END) { fprintf(stderr, "kernel_launch: unexpected problem: n_in %d in0 %d out %d ws %zu\n", n_in, n_in > 0 ? in_sizes[0] : -1, out_size, ws_size); grid = -1; return; }
        int dev = 0, cus = 0, per_cu = 0;
        hipGetDevice(&dev); hipDeviceGetAttribute(&cus, hipDeviceAttributeMultiprocessorCount, dev);
        if (hipFuncSetAttribute((const void*)fwd, hipFuncAttributeMaxDynamicSharedMemorySize, LDS_BYTES) != hipSuccess) { fprintf(stderr, "kernel_launch: hipFuncSetAttribute failed\n"); grid = -1; return; }
        if (hipOccupancyMaxActiveBlocksPerMultiprocessor(&per_cu, (const void*)fwd, NT, LDS_BYTES) != hipSuccess || per_cu < 1) { fprintf(stderr, "kernel_launch: occupancy query failed (%d)\n", per_cu); grid = -1; return; }
        grid = cus * per_cu;
    }
    if (grid < 0) return;
    if (hipMemsetAsync((char*)d_ws, 0, 65536, stream) != hipSuccess) { fprintf(stderr, "kernel_launch: memset of the barrier words failed\n"); return; }
    Args a{};
    for (int i = 0; i < 27; ++i) a.in[i] = (const float*)d_in[i];
    a.out = (float*)d_out; a.ws = (unsigned char*)d_ws;
    void* kargs[] = {&a};
    hipError_t e = hipLaunchCooperativeKernel((const void*)fwd, dim3(grid), dim3(NT), kargs, LDS_BYTES, stream);
    if (e != hipSuccess) fprintf(stderr, "cooperative launch failed: %s (grid %d)\n", hipGetErrorString(e), grid);
}
```

```cpp
#include <hip/hip_runtime.h>
#include <hip/hip_cooperative_groups.h>
#include <cstdio>
#include <cstdint>
namespace cg = cooperative_groups;
typedef _Float16 f16x8_t __attribute__((ext_vector_type(8)));
#define MK_MFMA(a, b, c) __builtin_amdgcn_mfma_f32_16x16x32_f16(__builtin_bit_cast(f16x8_t, (a)), __builtin_bit_cast(f16x8_t, (b)), (c), 0, 0, 0)
__device__ __forceinline__ int lane_now() { int z; asm volatile("v_mbcnt_lo_u32_b32 %0, -1, 0\n\tv_mbcnt_hi_u32_b32 %0, -1, %0" : "=v"(z)); return z; }
namespace pg8 {
#define PG8_LAS __attribute__((address_space(3)))
typedef unsigned short bf16_t;
typedef short bf16x8 __attribute__((ext_vector_type(8)));
typedef float f32x4 __attribute__((ext_vector_type(4)));
typedef unsigned u32x4 __attribute__((ext_vector_type(4)));
constexpr int BM = 256, BK = 64, HALF = 128, HTB = HALF * BK * 2  , STAGE_BYTES = 8 * HTB, NXCD = 8, WGM = 8;

__host__ __device__ __forceinline__ int lds_byte(int r, int c) { const int st = (r >> 4) * 2 + (c >> 5), rr = r & 15, cc = c & 31, ob = rr * 64 + cc * 2; return st * 1024 + (ob ^ (((ob >> 9) & 1) << 5)); }
__host__ __device__ __forceinline__ void stage_rc(int b, int& R, int& C) { const int st = b / 1024, sb = b % 1024, swz = sb ^ (((sb >> 9) & 1) << 5); R = (st >> 1) * 16 + swz / 64; C = (st & 1) * 32 + (swz % 64) / 2; }
__host__ __device__ __forceinline__ int perm32(int rho) { const int n = rho >> 4, i = rho & 15; return 8 * (i >> 2) + 4 * n + (i & 3); }

struct Unit { int pm, pn; };
struct Gemm { const bf16_t* A; const bf16_t* Bt; int M, N, K; };

struct StaticOrder {
    int nM, nN, nwg, G, c;
    __host__ __device__ void init(int M, int N, int G_, int c_) { nM = M / BM; nN = N / BM; nwg = nM * nN; G = G_; c = c_; }
    __host__ __device__ bool next(int i, Unit& u) const {
        const long L = (long)i * G + c; if (L >= nwg) return false;
        int wgid = (int)L; { const int q = nwg / NXCD, r = nwg % NXCD, xcd = wgid % NXCD, off = wgid / NXCD; wgid = (xcd < r ? xcd * (q + 1) : r * (q + 1) + (xcd - r) * q) + off; }
        const int nig = WGM * nN, gid = wgid / nig, fm = gid * WGM, gsz = (nM - fm) < WGM ? (nM - fm) : WGM;
        u.pm = fm + ((wgid % nig) % gsz); u.pn = (wgid % nig) / gsz; return true;
    }
    __device__ __forceinline__ void a_ready(const Unit&) const {}
    __device__ __forceinline__ void done(const Unit&) const {}
};

__device__ __forceinline__ unsigned pk_f16(float lo, float hi) { typedef _Float16 h2 __attribute__((ext_vector_type(2))); h2 v; v.x = (_Float16)lo; v.y = (_Float16)hi; return __builtin_bit_cast(unsigned, v); }
struct EpiF16 {
    static constexpr bool PERM = true, AFTER_DRAIN = false;
    bf16_t* O; int ldc;
    __device__ __forceinline__ void operator()(const f32x4 (&acc)[2][2][4][2], const Unit& u, int wr, int wc, int fr, int fq) const {
        const int row0 = u.pm * BM + wr * 64 + fr; const int col0 = u.pn * BM + wc * 32 + 8 * fq;
#pragma unroll
        for (int ai = 0; ai < 2; ++ai)
#pragma unroll
            for (int m = 0; m < 4; ++m) { bf16_t* rowp = O + (size_t)(row0 + ai * HALF + m * 16) * ldc + col0;
#pragma unroll
                for (int bj = 0; bj < 2; ++bj) { const f32x4 v0 = acc[ai][bj][m][0], v1 = acc[ai][bj][m][1];
                    u32x4 w; w.x = pk_f16(v0[0], v0[1]); w.y = pk_f16(v0[2], v0[3]); w.z = pk_f16(v1[0], v1[1]); w.w = pk_f16(v1[2], v1[3]);
                    *(u32x4*)(rowp + bj * HALF) = w; } }
    }
};
struct EpiRes {
    static constexpr bool PERM = false, AFTER_DRAIN = false;
    const float* base; float* out; int ldc;
    __device__ __forceinline__ void operator()(const f32x4 (&acc)[2][2][4][2], const Unit& u, int wr, int wc, int fr, int fq) const {
        const int row0 = u.pm * BM + wr * 64 + fr; const int col0 = u.pn * BM + wc * 32 + 4 * fq;
#pragma unroll
        for (int ai = 0; ai < 2; ++ai)
#pragma unroll
            for (int m = 0; m < 4; ++m) { const size_t off = (size_t)(row0 + ai * HALF + m * 16) * ldc + col0;
#pragma unroll
                for (int bj = 0; bj < 2; ++bj)
#pragma unroll
                    for (int n = 0; n < 2; ++n) { const size_t o = off + bj * HALF + n * 16; const f32x4 b = *(const f32x4*)(base + o); *(f32x4*)(out + o) = b + acc[ai][bj][m][n]; }
                asm volatile("" ::: "memory"); }
    }
};

template <class Epi, class Sched, bool ALIGN_EPI = false, bool SP2 = false>
__device__ __forceinline__ void gemm_phase(PG8_LAS unsigned char* lds, const Gemm g, const Sched& S, const Epi& E, const int wave_) {
    int wv_ = wave_; asm volatile("" : "+s"(wv_)); int tid_ = lane_now() + 64 * wv_; const int tid = tid_, wid = wv_, lane = tid & 63, wr = wid >> 2, wc = wid & 3, fr = lane & 15, fq = lane >> 4;
    const int K = g.K, nt = K / BK;
    unsigned voffA[2], voffB[2];
#pragma unroll
    for (int i = 0; i < 2; ++i) { int R, C; stage_rc(tid * 16 + i * 8192, R, C); const int Rb = Epi::PERM ? ((R & ~31) + perm32(R & 31)) : R;
        voffA[i] = (unsigned)(R * K + C) * 2u; voffB[i] = (unsigned)(Rb * K + C) * 2u; }
    const size_t kstep = (size_t)(BK * 2);
    const size_t hstep = (size_t)HALF * K * 2;
    const size_t tstep = 2 * hstep;
    const unsigned ldsw = (unsigned)wid * 1024u;
    const int aoff = lds_byte(wr * 64 + fr, fq * 8), boff = lds_byte(wc * 32 + fr, fq * 8);
#define PG8_SA(b, h) (((b) * 2 + (h)) * HTB)
#define PG8_SB(b, h) ((4 + (b) * 2 + (h)) * HTB)
#define PG8_STAGE(bufoff, gbase, voff) do { _Pragma("unroll") for (int _i = 0; _i < 2; ++_i) \
        __builtin_amdgcn_global_load_lds((const unsigned*)((const char*)(gbase) + (voff)[_i]), (PG8_LAS unsigned*)(lds + (bufoff) + ldsw + _i * 8192), 16, 0, 0); } while (0)
#define PG8_LDA(dst, b, h) do { _Pragma("unroll") for (int m = 0; m < 4; ++m) _Pragma("unroll") for (int k = 0; k < 2; ++k) dst[m][k] = *(const PG8_LAS bf16x8*)(lds + PG8_SA(b, h) + aoff + m * 2048 + k * 1024); } while (0)
#define PG8_LDB(dst, b, h) do { _Pragma("unroll") for (int n = 0; n < 2; ++n) _Pragma("unroll") for (int k = 0; k < 2; ++k) dst[n][k] = *(const PG8_LAS bf16x8*)(lds + PG8_SB(b, h) + boff + n * 2048 + k * 1024); } while (0)
#define PG8_MMA(ai, bj, At, Bt) do { __builtin_amdgcn_s_setprio(1); _Pragma("unroll") for (int m = 0; m < 4; ++m) _Pragma("unroll") for (int n = 0; n < 2; ++n) _Pragma("unroll") for (int k = 0; k < 2; ++k) \
        acc[ai][bj][m][n] = MK_MFMA(Bt[n][k], At[m][k], acc[ai][bj][m][n]); __builtin_amdgcn_s_setprio(0); } while (0)
#define PG8_WAIT_V(n) asm volatile("s_waitcnt vmcnt(" #n ")" ::: "memory")
#define PG8_WAIT_L(n) asm volatile("s_waitcnt lgkmcnt(" #n ")" ::: "memory")
#define PG8_BAR __builtin_amdgcn_s_barrier()
#define PG8_SCHED __builtin_amdgcn_sched_barrier(0)
    Unit cur, nxt; int ui = 0;
    if (!S.next(0, cur)) return;
    f32x4 acc[2][2][4][2];
#pragma unroll
    for (int a = 0; a < 2; ++a)
#pragma unroll
        for (int b = 0; b < 2; ++b)
#pragma unroll
            for (int m = 0; m < 4; ++m)
#pragma unroll
                for (int n = 0; n < 2; ++n) acc[a][b][m][n] = (f32x4){0.f, 0.f, 0.f, 0.f};
    bf16x8 At[4][2], B0[2][2], B1[2][2];
    const char* cA = (const char*)g.A + (size_t)cur.pm * tstep; const char* cB = (const char*)g.Bt + (size_t)cur.pn * tstep;
    S.a_ready(cur);
    if constexpr (SP2) {
        PG8_STAGE(PG8_SB(0, 0), cB, voffB); PG8_STAGE(PG8_SB(0, 1), cB + hstep, voffB); PG8_STAGE(PG8_SA(0, 0), cA, voffA); PG8_STAGE(PG8_SA(0, 1), cA + hstep, voffA);
        if (wr == 1) PG8_BAR;
        PG8_WAIT_V(2); PG8_BAR;
        PG8_STAGE(PG8_SB(1, 0), cB + kstep, voffB); PG8_STAGE(PG8_SA(1, 0), cA + kstep, voffA); PG8_STAGE(PG8_SB(1, 1), cB + hstep + kstep, voffB);
        PG8_WAIT_V(6); PG8_BAR;
    } else {
        PG8_STAGE(PG8_SB(0, 0), cB, voffB); PG8_STAGE(PG8_SA(0, 0), cA, voffA); PG8_STAGE(PG8_SB(0, 1), cB + hstep, voffB); PG8_STAGE(PG8_SA(0, 1), cA + hstep, voffA);
        if (wr == 1) PG8_BAR;
        PG8_WAIT_V(4); PG8_BAR;
        PG8_STAGE(PG8_SB(1, 0), cB + kstep, voffB); PG8_STAGE(PG8_SA(1, 0), cA + kstep, voffA); PG8_STAGE(PG8_SB(1, 1), cB + hstep + kstep, voffB);
        PG8_WAIT_V(6); PG8_BAR;
    }
    for (;;) {
        const bool has_next = S.next(ui + 1, nxt);
        const char* nA = has_next ? (const char*)g.A + (size_t)nxt.pm * tstep : cA; const char* nB = has_next ? (const char*)g.Bt + (size_t)nxt.pn * tstep : cB;
        for (int t = 0; t < nt; t += 2) {
            const bool last = (t == nt - 2);
            const char* a1 = cA + (size_t)(t + 1) * kstep;
            const char* a2 = last ? nA : cA + (size_t)(t + 2) * kstep; const char* b2 = last ? nB : cB + (size_t)(t + 2) * kstep;
            const char* a3 = a2 + kstep; const char* b3 = b2 + kstep;
            if (last && has_next) S.a_ready(nxt);
            if constexpr (SP2) {
            PG8_LDB(B0, 0, 0); PG8_LDB(B1, 0, 1); PG8_SCHED; PG8_LDA(At, 0, 0); PG8_STAGE(PG8_SA(1, 1), a1 + hstep, voffA);
            PG8_WAIT_V(8); PG8_WAIT_L(0); PG8_BAR; PG8_MMA(0, 0, At, B0); PG8_MMA(0, 1, At, B1); PG8_BAR; PG8_SCHED;
            PG8_LDA(At, 0, 1); PG8_STAGE(PG8_SB(0, 0), b2, voffB); PG8_STAGE(PG8_SB(0, 1), b2 + hstep, voffB); PG8_STAGE(PG8_SA(0, 0), a2, voffA);
            PG8_WAIT_V(8); PG8_WAIT_L(0); PG8_BAR; PG8_MMA(1, 0, At, B0); PG8_MMA(1, 1, At, B1); PG8_BAR; PG8_SCHED;
            PG8_LDB(B0, 1, 0); PG8_LDB(B1, 1, 1); PG8_SCHED; PG8_LDA(At, 1, 0); PG8_STAGE(PG8_SA(0, 1), a2 + hstep, voffA);
            PG8_WAIT_V(8); PG8_WAIT_L(0); PG8_BAR; PG8_MMA(0, 0, At, B0); PG8_MMA(0, 1, At, B1); PG8_BAR; PG8_SCHED;
            PG8_LDA(At, 1, 1); PG8_STAGE(PG8_SB(1, 0), b3, voffB); PG8_STAGE(PG8_SB(1, 1), b3 + hstep, voffB); PG8_STAGE(PG8_SA(1, 0), a3, voffA);
            PG8_WAIT_V(8); PG8_WAIT_L(0); PG8_BAR; PG8_MMA(1, 0, At, B0); PG8_MMA(1, 1, At, B1); PG8_BAR; PG8_SCHED;
            } else {
            PG8_LDB(B0, 0, 0); PG8_SCHED; PG8_LDA(At, 0, 0); PG8_STAGE(PG8_SA(1, 1), a1 + hstep, voffA);
            PG8_WAIT_L(8); PG8_BAR; PG8_WAIT_L(0); PG8_MMA(0, 0, At, B0); PG8_BAR; PG8_SCHED;
            PG8_LDB(B1, 0, 1); PG8_STAGE(PG8_SB(0, 0), b2, voffB);
            PG8_BAR; PG8_WAIT_L(0); PG8_MMA(0, 1, At, B1); PG8_BAR;
            PG8_LDA(At, 0, 1); PG8_STAGE(PG8_SA(0, 0), a2, voffA);
            PG8_BAR; PG8_WAIT_L(0); PG8_MMA(1, 0, At, B0); PG8_BAR; PG8_SCHED;
            PG8_STAGE(PG8_SB(0, 1), b2 + hstep, voffB);
            PG8_WAIT_V(6); PG8_BAR; PG8_MMA(1, 1, At, B1); PG8_BAR;
            PG8_LDB(B0, 1, 0); PG8_SCHED; PG8_LDA(At, 1, 0); PG8_STAGE(PG8_SA(0, 1), a2 + hstep, voffA);
            PG8_WAIT_L(8); PG8_BAR; PG8_WAIT_L(0); PG8_MMA(0, 0, At, B0); PG8_BAR; PG8_SCHED;
            PG8_LDB(B1, 1, 1); PG8_STAGE(PG8_SB(1, 0), b3, voffB);
            PG8_BAR; PG8_WAIT_L(0); PG8_MMA(0, 1, At, B1); PG8_BAR;
            PG8_LDA(At, 1, 1); PG8_STAGE(PG8_SA(1, 0), a3, voffA);
            PG8_BAR; PG8_WAIT_L(0); PG8_MMA(1, 0, At, B0); PG8_BAR; PG8_SCHED;
            PG8_STAGE(PG8_SB(1, 1), b3 + hstep, voffB);
            PG8_WAIT_V(6); PG8_BAR; PG8_MMA(1, 1, At, B1); PG8_BAR;
            }
        }
        if constexpr (ALIGN_EPI) { if (wr == 0) PG8_BAR; }
        if constexpr (!Epi::AFTER_DRAIN) { E(acc, cur, wr, wc, fr, fq); S.done(cur); }
        if (!has_next) break;
#pragma unroll
        for (int a = 0; a < 2; ++a)
#pragma unroll
            for (int b = 0; b < 2; ++b)
#pragma unroll
                for (int m = 0; m < 4; ++m)
#pragma unroll
                    for (int n = 0; n < 2; ++n) acc[a][b][m][n] = (f32x4){0.f, 0.f, 0.f, 0.f};
        cur = nxt; cA = nA; cB = nB; ++ui;
        if constexpr (ALIGN_EPI) { if (wr == 1) PG8_BAR; }
    }
    PG8_WAIT_V(0);
    if constexpr (!ALIGN_EPI) { if (wr == 0) PG8_BAR; }
    PG8_BAR;
    if constexpr (Epi::AFTER_DRAIN) { E.fused(acc, cur, wr, wc, fr, fq, lds, wid, lane); S.done(cur); }
#undef PG8_SA
#undef PG8_SB
#undef PG8_STAGE
#undef PG8_LDA
#undef PG8_LDB
#undef PG8_MMA
#undef PG8_WAIT_V
#undef PG8_WAIT_L
#undef PG8_BAR
#undef PG8_SCHED
}
}

constexpr int BATCH = 2, SEQ = 8192, DM = 1024, DEPTH = 2, M = BATCH * SEQ;
constexpr int RW_H = 6, HD = 64, RW_W = 384, RW_SHIFT = 1280;
constexpr int NIN = 3712, NU = 3840;
constexpr int C_R = 0, C_K = 384, C_V = 768, C_WL = 1152, C_AL = 1216, C_RWZ = 1280, C_HGQ = 1664, C_HGF = 2048, C_HGI = 2432, C_HGZ = 2816, C_LRUX = 3200, C_LRUZ = 3456;
constexpr int CH = 64;
constexpr int NWAVES = 8, NT = NWAVES * 64;
constexpr int LDS_BYTES = 147456;
constexpr size_t MiB = 1u << 20;
constexpr size_t WS_WUPT = 65536, WS_AUPT = WS_WUPT + 98304, WS_VDNT = WS_AUPT + 98304, WS_VUPT = WS_VDNT + 24576;
constexpr size_t WS_WIN = 1 * MiB, WIN_L = (size_t)NU * DM * 2;
constexpr size_t WS_WOUT = 16 * MiB, WOUT_L = (size_t)DM * DM * 2;
constexpr size_t WS_XN = 20 * MiB;
constexpr size_t WS_QT = 20 * MiB;
constexpr size_t WS_PT = 32 * MiB;
constexpr size_t WS_CA = 44 * MiB;
constexpr size_t WS_U = 52 * MiB;
constexpr size_t WS_MIX = 172 * MiB;
constexpr size_t WS_VF = 204 * MiB;
constexpr size_t WS_VP = 216 * MiB;
constexpr size_t WS_RL = 228 * MiB;
constexpr size_t WS_HL = 240 * MiB;
constexpr size_t WS_BON = 252 * MiB;
constexpr size_t WS_DC = WS_BON + 512 * 1024;
constexpr size_t WS_LA = WS_DC + 512 * 1024;
constexpr size_t WS_LH = WS_LA + 256 * 1024;
constexpr size_t WS_END = 254 * MiB;
constexpr int NCH = SEQ / CH;

#define LAS __attribute__((address_space(3)))
typedef float f32x4 __attribute__((ext_vector_type(4)));
typedef unsigned u32x2 __attribute__((ext_vector_type(2)));
typedef unsigned u32x4 __attribute__((ext_vector_type(4)));
typedef _Float16 f16;
typedef _Float16 f16x8 __attribute__((ext_vector_type(8)));
#define LDS_WAIT() asm volatile("s_waitcnt lgkmcnt(0)" ::: "memory")

struct Args { const float* in[27]; float* out; unsigned char* ws; };

__device__ __forceinline__ float wave_sum(float v) {
#pragma unroll
    for (int o = 1; o < 64; o <<= 1) v += __shfl_xor(v, o);
    return v;
}
__device__ __forceinline__ float sigmoidf_(float x) { return 1.0f / (1.0f + __expf(-x)); }
__device__ __forceinline__ float siluf_(float x) { return x / (1.0f + __expf(-x)); }

__device__ __forceinline__ void p0_transpose_item(const float* W, int K, int N, unsigned short* WT, LAS float* scr, int item, int lane) {
    const int nblk = N / 32, kb = item / nblk, nb = item % nblk, k0 = 64 * kb, n0 = 32 * nb;
#pragma unroll 8
    for (int i = 0; i < 32; ++i) { const int kk = 2 * i + (lane >> 5); scr[kk * 33 + (lane & 31)] = W[(size_t)(k0 + kk) * N + n0 + (lane & 31)]; }
    LDS_WAIT(); asm volatile("" ::: "memory");
    const int c = lane & 7;
#pragma unroll
    for (int j = 0; j < 4; ++j) { const int n = (lane >> 3) + 8 * j; const LAS float* s = scr + (8 * c) * 33 + n;
        u32x4 o; o.x = pg8::pk_f16(s[0 * 33], s[1 * 33]); o.y = pg8::pk_f16(s[2 * 33], s[3 * 33]); o.z = pg8::pk_f16(s[4 * 33], s[5 * 33]); o.w = pg8::pk_f16(s[6 * 33], s[7 * 33]);
        *(u32x4*)(WT + (size_t)(n0 + n) * K + k0 + 8 * c) = o; }
    LDS_WAIT(); asm volatile("" ::: "memory");
}
__device__ __forceinline__ void rms_row_f16(const float* xrow, const float* w, unsigned short* orow, int lane) {
    const f32x4* xr = (const f32x4*)xrow + lane; const f32x4* wr = (const f32x4*)w + lane;
    f32x4 v[4]; float s = 0.f;
#pragma unroll
    for (int j = 0; j < 4; ++j) { v[j] = xr[64 * j]; s += (v[j].x * v[j].x + v[j].y * v[j].y) + (v[j].z * v[j].z + v[j].w * v[j].w); }
    const float rs = 1.0f / sqrtf(wave_sum(s) * (1.0f / DM) + 1e-6f);
    u32x2* o8 = (u32x2*)orow + lane;
#pragma unroll
    for (int j = 0; j < 4; ++j) { const f32x4 ww = wr[64 * j]; u32x2 o; o.x = pg8::pk_f16(v[j].x * rs * ww.x, v[j].y * rs * ww.y); o.y = pg8::pk_f16(v[j].z * rs * ww.z, v[j].w * rs * ww.w); o8[64 * j] = o; }
}
__device__ __forceinline__ void rms_row_f32(float* xrow, const float* w, int lane) {
    f32x4* xr = (f32x4*)xrow + lane; const f32x4* wr = (const f32x4*)w + lane;
    f32x4 v[4]; float s = 0.f;
#pragma unroll
    for (int j = 0; j < 4; ++j) { v[j] = xr[64 * j]; s += (v[j].x * v[j].x + v[j].y * v[j].y) + (v[j].z * v[j].z + v[j].w * v[j].w); }
    const float rs = 1.0f / sqrtf(wave_sum(s) * (1.0f / DM) + 1e-6f);
#pragma unroll
    for (int j = 0; j < 4; ++j) { const f32x4 ww = wr[64 * j]; xr[64 * j] = v[j] * rs * ww; }
}


#define SHV(col) ({ const float cur_ = (float)urow[(col)]; const float prev_ = hp ? (float)prow[(col)] : 0.f; cur_ + mu[(col)] * (prev_ - cur_); })

__device__ __forceinline__ void store_row64_f16(f16* dst, const float (&S)[64]) {
#pragma unroll
    for (int q = 0; q < 8; ++q) { u32x4 w; w.x = pg8::pk_f16(S[8 * q], S[8 * q + 1]); w.y = pg8::pk_f16(S[8 * q + 2], S[8 * q + 3]); w.z = pg8::pk_f16(S[8 * q + 4], S[8 * q + 5]); w.w = pg8::pk_f16(S[8 * q + 6], S[8 * q + 7]); *(u32x4*)(dst + 8 * q) = w; }
}


constexpr int RWA_REC = 768, RWA_VPL = 16 * RWA_REC, RWA_SCR = RWA_VPL + 2048, RWA_BYTES = RWA_SCR + 1024;
typedef float f32x2 __attribute__((ext_vector_type(2)));
typedef _Float16 f16x4 __attribute__((ext_vector_type(4)));
__device__ __forceinline__ float fmix_lo(float a, unsigned b, float c) { float d; asm("v_fma_mix_f32 %0, %1, %2, %3 op_sel:[0,0,0] op_sel_hi:[0,1,0]" : "=v"(d) : "v"(a), "v"(b), "v"(c)); return d; }
__device__ __forceinline__ float fmix_hi(float a, unsigned b, float c) { float d; asm("v_fma_mix_f32 %0, %1, %2, %3 op_sel:[0,1,0] op_sel_hi:[0,1,0]" : "=v"(d) : "v"(a), "v"(b), "v"(c)); return d; }
__device__ __forceinline__ float mmix_lo(float a, unsigned b) { float d; asm("v_fma_mix_f32 %0, %1, %2, 0 op_sel:[0,0,0] op_sel_hi:[0,1,0]" : "=v"(d) : "v"(a), "v"(b)); return d; }
__device__ __forceinline__ float mmix_hi(float a, unsigned b) { float d; asm("v_fma_mix_f32 %0, %1, %2, 0 op_sel:[0,1,0] op_sel_hi:[0,1,0]" : "=v"(d) : "v"(a), "v"(b)); return d; }
__device__ __forceinline__ float fma_asm(float a, float b, float c) { float d; asm("v_fma_f32 %0, %1, %2, %3" : "=v"(d) : "v"(a), "v"(b), "v"(c)); return d; }
#define FMIX(a, u, j, c) (((j) & 1) ? fmix_hi((a), (u)[(j) >> 1], (c)) : fmix_lo((a), (u)[(j) >> 1], (c)))
#define MMIX(a, u, j) (((j) & 1) ? mmix_hi((a), (u)[(j) >> 1]) : mmix_lo((a), (u)[(j) >> 1]))
__device__ __forceinline__ float fast_tanh(float x) { return 1.0f - 2.0f / (__expf(2.0f * x) + 1.0f); }
__device__ __forceinline__ void lerp8(const char* ub, unsigned uo, unsigned po, bool hp, const char* mub, unsigned col, float (&x)[8]) {
    const f16x8 cu = *(const f16x8*)(ub + (uo + col * 2u)); f16x8 pv = *(const f16x8*)(ub + (po + col * 2u)); const f32x4 m0 = *(const f32x4*)(mub + col * 4u), m1 = *(const f32x4*)(mub + col * 4u + 16u);
#pragma unroll
    for (int j = 0; j < 8; ++j) { const float c = (float)cu[j], p = hp ? (float)pv[j] : 0.f; x[j] = c + (j < 4 ? m0[j] : m1[j - 4]) * (p - c); }
}
__device__ __forceinline__ void lerp4(const char* ub, unsigned uo, unsigned po, bool hp, const char* mub, unsigned col, float (&x)[4]) {
    const f16x4 cu = *(const f16x4*)(ub + (uo + col * 2u)); f16x4 pv = *(const f16x4*)(ub + (po + col * 2u)); const f32x4 m0 = *(const f32x4*)(mub + col * 4u);
#pragma unroll
    for (int j = 0; j < 4; ++j) { const float c = (float)cu[j], p = hp ? (float)pv[j] : 0.f; x[j] = c + m0[j] * (p - c); }
}
__device__ __forceinline__ f16x8 pack8(const float (&x)[8]) { f16x8 r;
#pragma unroll
    for (int j = 0; j < 8; ++j) r[j] = (f16)x[j];
    return r; }

__device__ __forceinline__ void rwkv_waveA(const Args& a, int l, int b, int c, int h, LAS unsigned char* wl, int lane) {
    const f16* U = (const f16*)(a.ws + WS_U); f16* MIX = (f16*)(a.ws + WS_MIX); f16* VF = (f16*)(a.ws + WS_VF); f16* VP = (f16*)(a.ws + WS_VP);
    f16* QT = (f16*)(a.ws + WS_QT); f16* PT = (f16*)(a.ws + WS_PT); f16* RL = (f16*)(a.ws + WS_RL); float* BONG = (float*)(a.ws + WS_BON);
    const f16* WUPT = (const f16*)(a.ws + WS_WUPT) + (size_t)l * 384 * 64; const f16* AUPT = (const f16*)(a.ws + WS_AUPT) + (size_t)l * 384 * 64;
    const f16* VDNT = (const f16*)(a.ws + WS_VDNT); const f16* VUPT = (const f16*)(a.ws + WS_VUPT);
    const float* mu = a.in[3] + l * RW_SHIFT; const float* w0 = a.in[4] + l * RW_W; const float* a0 = a.in[6] + l * RW_W; const float* v0 = a.in[8];
    const float* k_k = a.in[11] + l * RW_W; const float* k_a = a.in[12] + l * RW_W; const float* r_k = a.in[13] + l * RW_W;
    const int bh = b * RW_H + h;
    float P[64], L[64];
#pragma unroll
    for (int k = 0; k < 64; ++k) { P[k] = (k == lane) ? 1.f : 0.f; L[k] = 0.f; }
#pragma unroll 1
    for (int blk = 0; blk < 4; ++blk) {
        int lane_ = lane; asm volatile("" : "+v"(lane_));
        const int tok = lane_ & 15, fq = lane_ >> 4;
        const int t = c * CH + blk * 16 + tok; const unsigned m = (unsigned)(b * SEQ + t); const bool hp = t > 0;
        const char* ub = (const char*)U; const char* mub = (const char*)mu; const unsigned uo = m * (unsigned)(NU * 2), po = hp ? uo - (unsigned)(NU * 2) : uo;
        f16x8 bW[2], bA[2], bVD;
#pragma unroll
        for (int s = 0; s < 2; ++s) {
            float x[8]; lerp8(ub, uo, po, hp, mub, (unsigned)(C_WL + 8 * fq + 32 * s), x);
#pragma unroll
            for (int j = 0; j < 8; ++j) x[j] = fast_tanh(x[j]);
            bW[s] = pack8(x);
            lerp8(ub, uo, po, hp, mub, (unsigned)(C_AL + 8 * fq + 32 * s), x);
            bA[s] = pack8(x);
            asm volatile("" ::: "memory");
        }
        if (l > 0) {
            f32x4 VD0 = (f32x4){0.f, 0.f, 0.f, 0.f}, VD1 = VD0;
#pragma unroll 1
            for (int s = 0; s < 12; ++s) {
                float x[8]; lerp8(ub, uo, po, hp, mub, (unsigned)(C_V + 8 * fq + 32 * s), x);
                const f16x8 bv = pack8(x);
                VD0 = __builtin_amdgcn_mfma_f32_16x16x32_f16(*(const f16x8*)((const char*)VDNT + (unsigned)(tok * 384 + 8 * fq + 32 * s) * 2u), bv, VD0, 0, 0, 0);
                VD1 = __builtin_amdgcn_mfma_f32_16x16x32_f16(*(const f16x8*)((const char*)VDNT + (unsigned)((16 + tok) * 384 + 8 * fq + 32 * s) * 2u), bv, VD1, 0, 0, 0);
            }
            LAS f16* scr = (LAS f16*)(wl + RWA_SCR);
            { f16x4 p0, p1;
#pragma unroll
              for (int i = 0; i < 4; ++i) { p0[i] = (f16)VD0[i]; p1[i] = (f16)VD1[i]; }
              *(LAS f16x4*)(scr + tok * 32 + 4 * fq) = p0; *(LAS f16x4*)(scr + tok * 32 + 16 + 4 * fq) = p1; }
            asm volatile("s_waitcnt lgkmcnt(0)" ::: "memory");
            bVD = *(const LAS f16x8*)(scr + tok * 32 + 8 * fq);
        }
        float ssq = 0.f;
#pragma unroll 1
        for (int nt = 0; nt < 4; ++nt) { const int cb = h * 64 + 16 * nt + 4 * fq; float ks[4]; lerp4(ub, uo, po, hp, mub, (unsigned)(C_K + cb), ks); const f32x4 kk4 = *(const f32x4*)((const char*)k_k + (unsigned)cb * 4u);
#pragma unroll
            for (int i = 0; i < 4; ++i) { const float kv = ks[i] * kk4[i]; ssq += kv * kv; }
            asm volatile("" ::: "memory"); }
        ssq += __shfl_xor(ssq, 16); ssq += __shfl_xor(ssq, 32);
        const float inv = 1.0f / fmaxf(sqrtf(ssq), 1e-12f);
        float bon = 0.f;
        LAS unsigned char* rec = wl + tok * RWA_REC;
#pragma unroll 1
        for (int nt = 0; nt < 4; ++nt) {
            const int cb = h * 64 + 16 * nt + 4 * fq, co = 16 * nt + 4 * fq; const int n = h * 64 + 16 * nt + tok;
            f32x4 DWn = (f32x4){0.f, 0.f, 0.f, 0.f}, DAn = DWn, Gn = DWn;
#pragma unroll
            for (int s = 0; s < 2; ++s) {
                DWn = __builtin_amdgcn_mfma_f32_16x16x32_f16(*(const f16x8*)((const char*)WUPT + (unsigned)(n * 64 + 8 * fq + 32 * s) * 2u), bW[s], DWn, 0, 0, 0);
                DAn = __builtin_amdgcn_mfma_f32_16x16x32_f16(*(const f16x8*)((const char*)AUPT + (unsigned)(n * 64 + 8 * fq + 32 * s) * 2u), bA[s], DAn, 0, 0, 0); }
            if (l > 0) Gn = __builtin_amdgcn_mfma_f32_16x16x32_f16(*(const f16x8*)((const char*)VUPT + (unsigned)(n * 32 + 8 * fq) * 2u), bVD, Gn, 0, 0, 0);
            float rs[4], ks[4], vs[4];
            lerp4(ub, uo, po, hp, mub, (unsigned)(C_R + cb), rs); lerp4(ub, uo, po, hp, mub, (unsigned)(C_K + cb), ks); lerp4(ub, uo, po, hp, mub, (unsigned)(C_V + cb), vs);
            const unsigned cb4 = (unsigned)cb * 4u; const f32x4 w04 = *(const f32x4*)((const char*)w0 + cb4), a04 = *(const f32x4*)((const char*)a0 + cb4), kk4 = *(const f32x4*)((const char*)k_k + cb4), ka4 = *(const f32x4*)((const char*)k_a + cb4), rk4 = *(const f32x4*)((const char*)r_k + cb4);
            f32x4 wv; f16x4 al, be, km, rr, vo;
            f16x4 vf4; f32x4 v04;
            const unsigned vo_b = (m * (unsigned)RW_W + (unsigned)cb) * 2u;
            if (l > 0) { vf4 = *(const f16x4*)((const char*)VF + vo_b); v04 = *(const f32x4*)((const char*)v0 + cb4); }
#pragma unroll
            for (int i = 0; i < 4; ++i) {
                wv[i] = __expf(-0.6065306597126334f * sigmoidf_(w04[i] + DWn[i]));
                const float aa = sigmoidf_(a04[i] + DAn[i]);
                float vv = vs[i];
                if (l > 0) vv = vs[i] + ((float)vf4[i] - vs[i]) * sigmoidf_(v04[i] + Gn[i]);
                const float kk = ks[i] * kk4[i] * inv;
                const float kmod = ks[i] * (1.0f + (aa - 1.0f) * ka4[i]);
                bon += rs[i] * kmod * rk4[i];
                al[i] = (f16)(-kk); be[i] = (f16)(kk * aa); km[i] = (f16)kmod; rr[i] = (f16)rs[i]; vo[i] = (f16)vv;
            }
            *(LAS f32x4*)(rec + co * 4) = wv;
            *(LAS f16x4*)(rec + 256 + co * 2) = al; *(LAS f16x4*)(rec + 384 + co * 2) = be; *(LAS f16x4*)(rec + 512 + co * 2) = km; *(LAS f16x4*)(rec + 640 + co * 2) = rr;
            *(LAS f16x4*)(wl + RWA_VPL + tok * 128 + co * 2) = vo;
            *(f16x4*)((char*)VP + vo_b) = vo;
            if (l == 0) *(f16x4*)((char*)VF + vo_b) = vo;
            asm volatile("" ::: "memory");
        }
        bon += __shfl_xor(bon, 16); bon += __shfl_xor(bon, 32);
        if (fq == 0) *(float*)((char*)BONG + (m * 8u + (unsigned)h) * 4u) = bon;
        const unsigned mb = (unsigned)(b * SEQ + c * CH + blk * 16);
        asm volatile("s_waitcnt lgkmcnt(0)" ::: "memory");
        u32x4 A[8];
#pragma unroll
        for (int g = 0; g < 8; ++g) A[g] = *(const LAS u32x4*)(wl + 256 + g * 16);
        float vv = (float)*(const LAS f16*)(wl + RWA_VPL + lane_ * 2);
#define RW_LDU(WA, WB, B4, K4, R4, g) { WA = *(const LAS f32x4*)(rc + (g) * 32); WB = *(const LAS f32x4*)(rc + (g) * 32 + 16); B4 = *(const LAS u32x4*)(rc + 384 + (g) * 16); K4 = *(const LAS u32x4*)(rc + 512 + (g) * 16); R4 = *(const LAS u32x4*)(rc + 640 + (g) * 16); }
#define RW_COMP(WA, WB, B4, K4, R4, g) { float tP[8], tL[8]; \
            _Pragma("unroll") for (int j = 0; j < 8; ++j) tP[j] = MMIX(saP, B4, j); \
            _Pragma("unroll") for (int j = 0; j < 8; ++j) tL[j] = MMIX(saL, B4, j); \
            _Pragma("unroll") for (int j = 0; j < 8; ++j) tL[j] = FMIX(vv, K4, j, tL[j]); \
            _Pragma("unroll") for (int j = 0; j < 8; ++j) P[8 * (g) + j] = fma_asm(P[8 * (g) + j], (j < 4) ? WA[j & 3] : WB[j & 3], tP[j]); \
            _Pragma("unroll") for (int j = 0; j < 8; ++j) L[8 * (g) + j] = fma_asm(L[8 * (g) + j], (j < 4) ? WA[j & 3] : WB[j & 3], tL[j]); \
            _Pragma("unroll") for (int j = 0; j < 8; ++j) qa[j] = FMIX(P[8 * (g) + j], R4, j, qa[j]); \
            _Pragma("unroll") for (int j = 0; j < 8; ++j) ya[j] = FMIX(L[8 * (g) + j], R4, j, ya[j]); }
#pragma unroll 1
        for (int t2 = 0; t2 < 16; ++t2) {
            const LAS unsigned char* rc = wl + t2 * RWA_REC;
            f32x4 wAe, wBe, wAo, wBo; u32x4 be, ke, re, bo, ko, ro;
            RW_LDU(wAe, wBe, be, ke, re, 0)
            float sP[8], sL[8];
#pragma unroll
            for (int j = 0; j < 8; ++j) { sP[j] = 0.f; sL[j] = 0.f; }
#pragma unroll
            for (int g = 0; g < 8; ++g) {
#pragma unroll
                for (int j = 0; j < 8; ++j) sP[j] = FMIX(P[8 * g + j], A[g], j, sP[j]);
#pragma unroll
                for (int j = 0; j < 8; ++j) sL[j] = FMIX(L[8 * g + j], A[g], j, sL[j]); }
            const float saP = ((sP[0] + sP[1]) + (sP[2] + sP[3])) + ((sP[4] + sP[5]) + (sP[6] + sP[7])), saL = ((sL[0] + sL[1]) + (sL[2] + sL[3])) + ((sL[4] + sL[5]) + (sL[6] + sL[7]));
            float qa[8], ya[8];
#pragma unroll
            for (int j = 0; j < 8; ++j) { qa[j] = 0.f; ya[j] = 0.f; }
            RW_LDU(wAo, wBo, bo, ko, ro, 1) RW_COMP(wAe, wBe, be, ke, re, 0)
            RW_LDU(wAe, wBe, be, ke, re, 2) RW_COMP(wAo, wBo, bo, ko, ro, 1)
            RW_LDU(wAo, wBo, bo, ko, ro, 3) RW_COMP(wAe, wBe, be, ke, re, 2)
            RW_LDU(wAe, wBe, be, ke, re, 4) RW_COMP(wAo, wBo, bo, ko, ro, 3)
            RW_LDU(wAo, wBo, bo, ko, ro, 5) RW_COMP(wAe, wBe, be, ke, re, 4)
            RW_LDU(wAe, wBe, be, ke, re, 6) RW_COMP(wAo, wBo, bo, ko, ro, 5)
            RW_LDU(wAo, wBo, bo, ko, ro, 7) RW_COMP(wAe, wBe, be, ke, re, 6)
            const float vvn = (float)*(const LAS f16*)(wl + RWA_VPL + ((t2 + 1) & 15) * 128 + lane_ * 2);
#pragma unroll
            for (int g = 0; g < 8; ++g) A[g] = *(const LAS u32x4*)(rc + RWA_REC + 256 + g * 16);
            RW_COMP(wAo, wBo, bo, ko, ro, 7)
            vv = vvn;
            *(f16*)((char*)MIX + ((mb + t2) * (unsigned)DM + (unsigned)(h * 64 + lane_)) * 2u) = (f16)(((ya[0] + ya[1]) + (ya[2] + ya[3])) + ((ya[4] + ya[5]) + (ya[6] + ya[7])));
            *(f16*)((char*)QT + ((mb + t2) * (unsigned)RW_W + (unsigned)(h * 64 + lane_)) * 2u) = (f16)(((qa[0] + qa[1]) + (qa[2] + qa[3])) + ((qa[4] + qa[5]) + (qa[6] + qa[7])));
        }
#undef RW_LDU
#undef RW_COMP
    }
    store_row64_f16(RL + (((size_t)bh * NCH + c) * 64 + lane) * 64, L);
    f16* pt = PT + ((size_t)bh * NCH + c) * 4096;
#pragma unroll
    for (int k = 0; k < 64; ++k) pt[k * 64 + lane] = (f16)P[k];
}

constexpr int HGA_REC = 512, HGA_HEAD = 16 * HGA_REC, HGA_BYTES = 3 * HGA_HEAD;
__device__ __forceinline__ void hgrn_waveA(const Args& a, int l, int b, int c, int h0, LAS unsigned char* wl, int lane) {
    const f16* U = (const f16*)(a.ws + WS_U); f16* MIX = (f16*)(a.ws + WS_MIX); f16* HL = (f16*)(a.ws + WS_HL); float* DC = (float*)(a.ws + WS_DC);
    const float* lbr = a.in[16];
    float S0[64], S1[64], S2[64];
#pragma unroll
    for (int k = 0; k < 64; ++k) { S0[k] = 0.f; S1[k] = 0.f; S2[k] = 0.f; }
    float dp0 = 1.f, dp1 = 1.f, dp2 = 1.f;
#pragma unroll 1
    for (int blk = 0; blk < 4; ++blk) {
        int lane_ = lane; asm volatile("" : "+v"(lane_));
        const unsigned mb = (unsigned)(b * SEQ + c * CH + blk * 16);
#pragma unroll 1
        for (int j = 0; j < 3; ++j) {
            const int col = (h0 + j) * 64 + lane_;
            const float lb = (l == 0) ? 0.f : sigmoidf_(lbr[384 + col] - lbr[col]);
            float dp = 1.f;
#pragma unroll 4
            for (int tk = 0; tk < 16; ++tk) {
                const char* ur = (const char*)U + (mb + tk) * (unsigned)(NU * 2);
                const float f = lb + (1.0f - lb) * sigmoidf_((float)*(const f16*)(ur + (unsigned)(C_HGF + col) * 2u));
                const f16 q = *(const f16*)(ur + (unsigned)(C_HGQ + col) * 2u);
                LAS unsigned char* rec = wl + j * HGA_HEAD + tk * HGA_REC;
                *(LAS float*)(rec + lane_ * 4) = f; *(LAS f16*)(rec + 256 + lane_ * 2) = (f16)(1.0f - f); *(LAS f16*)(rec + 384 + lane_ * 2) = q;
                dp *= f;
            }
            if (j == 0) dp0 *= dp; else if (j == 1) dp1 *= dp; else dp2 *= dp;
        }
        asm volatile("s_waitcnt lgkmcnt(0)" ::: "memory");
#define HG_LDF(rcp, g) { fA = *(const LAS f32x4*)((rcp) + (g) * 32); fB = *(const LAS f32x4*)((rcp) + (g) * 32 + 16); }
#define HG_LDKQ(K4, Q4, rcp, g) { K4 = *(const LAS u32x4*)((rcp) + 256 + (g) * 16); Q4 = *(const LAS u32x4*)((rcp) + 384 + (g) * 16); }
#define HG_COMP(S, vi, K4, Q4, g, rcf, gf) { float tt[8]; \
            _Pragma("unroll") for (int jj = 0; jj < 8; ++jj) tt[jj] = MMIX(vi, K4, jj); \
            _Pragma("unroll") for (int jj = 0; jj < 8; ++jj) S[8 * (g) + jj] = fma_asm(S[8 * (g) + jj], (jj < 4) ? fA[jj & 3] : fB[jj & 3], tt[jj]); \
            HG_LDF(rcf, gf) \
            _Pragma("unroll") for (int jj = 0; jj < 8; ++jj) oa[jj] = FMIX(S[8 * (g) + jj], Q4, jj, oa[jj]); }
#define HG_HEAD(S, vi, rcp, rcn, oo) { float oa[8]; _Pragma("unroll") for (int jj = 0; jj < 8; ++jj) oa[jj] = 0.f; \
            HG_LDKQ(k4o, q4o, rcp, 1) HG_COMP(S, vi, k4e, q4e, 0, rcp, 1) \
            HG_LDKQ(k4e, q4e, rcp, 2) HG_COMP(S, vi, k4o, q4o, 1, rcp, 2) \
            HG_LDKQ(k4o, q4o, rcp, 3) HG_COMP(S, vi, k4e, q4e, 2, rcp, 3) \
            HG_LDKQ(k4e, q4e, rcp, 4) HG_COMP(S, vi, k4o, q4o, 3, rcp, 4) \
            HG_LDKQ(k4o, q4o, rcp, 5) HG_COMP(S, vi, k4e, q4e, 4, rcp, 5) \
            HG_LDKQ(k4e, q4e, rcp, 6) HG_COMP(S, vi, k4o, q4o, 5, rcp, 6) \
            HG_LDKQ(k4o, q4o, rcp, 7) HG_COMP(S, vi, k4e, q4e, 6, rcp, 7) \
            HG_LDKQ(k4e, q4e, rcn, 0) HG_COMP(S, vi, k4o, q4o, 7, rcn, 0) \
            oo = ((oa[0] + oa[1]) + (oa[2] + oa[3])) + ((oa[4] + oa[5]) + (oa[6] + oa[7])); }
        f32x4 fA, fB; u32x4 k4e, q4e, k4o, q4o;
        HG_LDF(wl, 0) HG_LDKQ(k4e, q4e, wl, 0)
        const char* ur0 = (const char*)U + mb * (unsigned)(NU * 2) + (unsigned)(C_HGI + h0 * 64 + lane_) * 2u;
        float v0 = (float)*(const f16*)(ur0), v1 = (float)*(const f16*)(ur0 + 128), v2 = (float)*(const f16*)(ur0 + 256);
#pragma unroll 1
        for (int t2 = 0; t2 < 16; ++t2) {
            const LAS unsigned char* rc = wl + t2 * HGA_REC;
            const char* urn = ur0 + (unsigned)((t2 + 1) & 15) * (unsigned)(NU * 2);
            const f16 n0 = *(const f16*)(urn), n1 = *(const f16*)(urn + 128), n2 = *(const f16*)(urn + 256);
            float oa_, ob_, oc_;
            HG_HEAD(S0, v0, rc, rc + HGA_HEAD, oa_)
            HG_HEAD(S1, v1, rc + HGA_HEAD, rc + 2 * HGA_HEAD, ob_)
            HG_HEAD(S2, v2, rc + 2 * HGA_HEAD, rc + HGA_REC, oc_)
            char* mo = (char*)MIX + ((mb + t2) * (unsigned)DM + (unsigned)(384 + h0 * 64 + lane_)) * 2u;
            *(f16*)mo = (f16)oa_; *(f16*)(mo + 128) = (f16)ob_; *(f16*)(mo + 256) = (f16)oc_;
            v0 = (float)n0; v1 = (float)n1; v2 = (float)n2;
        }
#undef HG_LDF
#undef HG_LDKQ
#undef HG_COMP
#undef HG_HEAD
    }
#define HG_OUT(S, j, dp) { const int bh = b * 6 + h0 + (j); f16* hl = HL + ((size_t)bh * NCH + c) * 4096; \
        _Pragma("unroll") for (int k = 0; k < 64; ++k) hl[k * 64 + lane] = (f16)S[k]; \
        DC[((size_t)bh * NCH + c) * 64 + lane] = dp; }
    HG_OUT(S0, 0, dp0) HG_OUT(S1, 1, dp1) HG_OUT(S2, 2, dp2)
#undef HG_OUT
}
__device__ __forceinline__ void phaseA(const Args& a, int l, int task, LAS unsigned char* lds, int tid) {
    asm volatile("" : "+v"(tid));
    const int lane = tid & 63, wave = __builtin_amdgcn_readfirstlane(tid >> 6);
    const int b = task / NCH, c = task % NCH;
    const f16* U = (const f16*)(a.ws + WS_U); f16* MIX = (f16*)(a.ws + WS_MIX); f16* VF = (f16*)(a.ws + WS_VF); f16* VP = (f16*)(a.ws + WS_VP);
    f16* QT = (f16*)(a.ws + WS_QT); f16* PT = (f16*)(a.ws + WS_PT); f16* RL = (f16*)(a.ws + WS_RL); float* BONG = (float*)(a.ws + WS_BON);
    const int tt = tid >> 3, sub = tid & 7;
    const int t = c * CH + tt; const size_t m = (size_t)b * SEQ + t;
    const f16* urow = U + m * NU; const f16* prow = urow - NU; const bool hp = t > 0;
    if (wave < RW_H) rwkv_waveA(a, l, b, c, wave, lds + wave * RWA_BYTES, lane);
    else hgrn_waveA(a, l, b, c, 3 * (wave - RW_H), lds + RW_H * RWA_BYTES + (wave - RW_H) * HGA_BYTES, lane);
    __syncthreads();
    {
        f16* CA = (f16*)(a.ws + WS_CA); float* LA = (float*)(a.ws + WS_LA); float* LH = (float*)(a.ws + WS_LH);
        const float* cw = a.in[18] + l * 4 * 256; const float* cb = a.in[19] + l * 256;
        const float* ba = a.in[21] + l * 256; const float* bx = a.in[23] + l * 256; const float* lam = a.in[24] + l * 256;
        LAS float* Y = (LAS float*)lds; LAS float* AA = (LAS float*)(lds + 16384); LAS float* UU = (LAS float*)(lds + 32768);
#pragma unroll 1
        for (int g = 0; g < 4; ++g) {
            const float* wa = a.in[20] + (size_t)(l * 4 + g) * 4096; const float* wx = a.in[22] + (size_t)(l * 4 + g) * 4096;
#pragma unroll 1
            for (int i = 0; i < 8; ++i) { const int j = sub * 8 + i, ch = g * 64 + j; float y = cb[ch];
#pragma unroll
                for (int jj = 0; jj < 4; ++jj) { const int ts = t - 3 + jj; if (ts >= 0) y += cw[jj * 256 + ch] * (float)U[((size_t)b * SEQ + ts) * NU + C_LRUX + ch]; }
                Y[tt * 64 + j] = y; }
            __syncthreads();
#pragma unroll 1
            for (int i = 0; i < 8; ++i) { const int j = sub * 8 + i, ch = g * 64 + j; float ra = ba[ch], rx = bx[ch];
#pragma unroll 4
                for (int i2 = 0; i2 < 64; ++i2) { const float yv = Y[tt * 64 + i2]; ra += yv * wa[i2 * 64 + j]; rx += yv * wx[i2 * 64 + j]; }
                const float r = sigmoidf_(ra), ig = sigmoidf_(rx);
                const float la = -8.0f * r * log1pf(expf(-lam[ch]));
                AA[tt * 64 + j] = expf(la); UU[tt * 64 + j] = sqrtf(-expm1f(2.0f * la)) * (ig * Y[tt * 64 + j]); }
            __syncthreads();
            if (wave == 0) {
                const int ch = g * 64 + lane; float hst = 0.f, ap = 1.f;
                for (int t2 = 0; t2 < CH; ++t2) { const size_t m2 = (size_t)b * SEQ + c * CH + t2; const float av = AA[t2 * 64 + lane];
                    hst = av * hst + UU[t2 * 64 + lane]; ap *= av;
                    MIX[m2 * DM + 768 + ch] = (f16)hst; CA[m2 * 256 + ch] = (f16)ap; }
                LA[((size_t)b * NCH + c) * 256 + ch] = ap; LH[((size_t)b * NCH + c) * 256 + ch] = hst;
            }
            __syncthreads();
        }
    }
}

__device__ __forceinline__ void phaseB(const Args& a, LAS unsigned char* lds, int tid) {
    asm volatile("" : "+v"(tid));
    const int lane = tid & 63, wave = __builtin_amdgcn_readfirstlane(tid >> 6);
    const int bx = blockIdx.x;
    if (bx < 12) {
        const int bh = bx;
        f16* PT = (f16*)(a.ws + WS_PT); f16* RL = (f16*)(a.ws + WS_RL);
        LAS float* PTL = (LAS float*)lds;
        LAS float* SN = (LAS float*)(lds + 16384);
        float S[64];
#pragma unroll
        for (int k = 0; k < 64; ++k) S[k] = 0.f;
        for (int c = 0; c < NCH; ++c) {
            const f16* pt = PT + ((size_t)bh * NCH + c) * 4096; f16* rl = RL + ((size_t)bh * NCH + c) * 4096;
            { const f16x8 p8 = *(const f16x8*)(pt + tid * 8);
#pragma unroll
              for (int j = 0; j < 8; ++j) PTL[tid * 8 + j] = (float)p8[j]; }
            const f16x8 l8 = *(const f16x8*)(rl + lane * 64 + wave * 8);
            asm volatile("s_waitcnt vmcnt(0)" ::: "memory");
            __syncthreads();
            if (wave == 0) store_row64_f16(rl + lane * 64, S);
#pragma unroll
            for (int j = 0; j < 8; ++j) SN[lane * 65 + wave * 8 + j] = (float)l8[j];
#pragma unroll 1
            for (int j = 0; j < 8; ++j) { float acc = SN[lane * 65 + wave * 8 + j];
                const LAS float* pr = PTL + (wave * 8 + j) * 64;
                float a0 = 0.f, a1 = 0.f, a2 = 0.f, a3 = 0.f;
#pragma unroll
                for (int k = 0; k < 64; k += 4) { const f32x4 p4 = *(const LAS f32x4*)(pr + k); a0 += S[k] * p4.x; a1 += S[k + 1] * p4.y; a2 += S[k + 2] * p4.z; a3 += S[k + 3] * p4.w; }
                SN[lane * 65 + wave * 8 + j] = acc + ((a0 + a1) + (a2 + a3)); }
            __syncthreads();
#pragma unroll
            for (int k = 0; k < 64; ++k) S[k] = SN[lane * 65 + k];
            __syncthreads();
        }
    } else if (bx < 12 + 96) {
        const int idx = (bx - 12) * NT + tid; const int bh = idx >> 12, e = idx & 4095, k = e >> 6;
        f16* HL = (f16*)(a.ws + WS_HL); const float* DC = (const float*)(a.ws + WS_DC);
        float s = 0.f;
        for (int c0 = 0; c0 < NCH; c0 += 8) { float Lc[8], d[8];
#pragma unroll
            for (int j = 0; j < 8; ++j) { Lc[j] = (float)HL[((size_t)bh * NCH + c0 + j) * 4096 + e]; d[j] = DC[((size_t)bh * NCH + c0 + j) * 64 + k]; }
#pragma unroll
            for (int j = 0; j < 8; ++j) { HL[((size_t)bh * NCH + c0 + j) * 4096 + e] = (f16)s; s = d[j] * s + Lc[j]; } }
    } else if (bx == 12 + 96) {
        const int bb = tid >> 8, ch = tid & 255; const float* LA = (const float*)(a.ws + WS_LA); float* LH = (float*)(a.ws + WS_LH);
        float cy = 0.f;
        for (int c0 = 0; c0 < NCH; c0 += 8) { float A[8], H[8];
#pragma unroll
            for (int j = 0; j < 8; ++j) { const size_t o = ((size_t)bb * NCH + c0 + j) * 256 + ch; A[j] = LA[o]; H[j] = LH[o]; }
#pragma unroll
            for (int j = 0; j < 8; ++j) { const size_t o = ((size_t)bb * NCH + c0 + j) * 256 + ch; LH[o] = cy; cy = A[j] * cy + H[j]; } }
    }
}

__device__ __forceinline__ void phaseC(const Args& a, int l, int task, LAS unsigned char* lds, int tid) {
    asm volatile("" : "+v"(tid));
    const int lane = tid & 63, wave = __builtin_amdgcn_readfirstlane(tid >> 6);
    const int b = task / NCH, c = task % NCH;
    const f16* U = (const f16*)(a.ws + WS_U); f16* MIX = (f16*)(a.ws + WS_MIX); const f16* VP = (const f16*)(a.ws + WS_VP);
    const f16* QT = (const f16*)(a.ws + WS_QT); const f16* RL = (const f16*)(a.ws + WS_RL); const float* BONG = (const float*)(a.ws + WS_BON);
    const int tt = tid >> 3, sub = tid & 7;
    const size_t m = (size_t)b * SEQ + c * CH + tt;
    const f16* urow = U + m * NU;
    {
        const float* ln_w = a.in[14] + l * RW_W; const float* ln_b = a.in[15] + l * RW_W;
        LAS float* SL = (LAS float*)lds;
#pragma unroll 1
        for (int h = 0; h < RW_H; ++h) {
            const int bh = b * RW_H + h;
            { const f16x8 s8 = *(const f16x8*)(RL + ((size_t)bh * NCH + c) * 4096 + tid * 8); const int v = tid >> 3, k0 = (tid & 7) * 8;
#pragma unroll
              for (int j = 0; j < 8; ++j) SL[v * 68 + k0 + j] = (float)s8[j]; }
            float q[64];
#pragma unroll
            for (int qq = 0; qq < 8; ++qq) { const f16x8 q8 = *(const f16x8*)(QT + m * RW_W + h * 64 + qq * 8);
#pragma unroll
                for (int j = 0; j < 8; ++j) q[qq * 8 + j] = (float)q8[j]; }
            __syncthreads();
            const f16x8 yl = *(const f16x8*)(MIX + m * DM + h * 64 + sub * 8);
            LAS float* YS = (LAS float*)(lds + 20480) + tid * 9;
#pragma unroll
            for (int i = 0; i < 8; ++i) YS[i] = (float)yl[i];
#pragma unroll 1
            for (int i = 0; i < 8; ++i) { const LAS float* sr = SL + (sub * 8 + i) * 68;
                float a0 = 0.f, a1 = 0.f, a2 = 0.f, a3 = 0.f;
#pragma unroll
                for (int k = 0; k < 64; k += 4) { const f32x4 s4 = *(const LAS f32x4*)(sr + k); a0 += q[k] * s4.x; a1 += q[k + 1] * s4.y; a2 += q[k + 2] * s4.z; a3 += q[k + 3] * s4.w; }
                YS[i] += (a0 + a1) + (a2 + a3); }
            float y[8]; float sm = 0.f;
#pragma unroll
            for (int i = 0; i < 8; ++i) { y[i] = YS[i]; sm += y[i]; }
            sm += __shfl_xor(sm, 1); sm += __shfl_xor(sm, 2); sm += __shfl_xor(sm, 4);
            const float mean = sm * (1.0f / 64.0f); float vr = 0.f;
#pragma unroll
            for (int i = 0; i < 8; ++i) { const float d = y[i] - mean; vr += d * d; }
            vr += __shfl_xor(vr, 1); vr += __shfl_xor(vr, 2); vr += __shfl_xor(vr, 4);
            const float rstd = 1.0f / sqrtf(vr * (1.0f / 64.0f) + 64e-5f);
            const float bon = BONG[m * 8 + h];
            const f16x8 vp = *(const f16x8*)(VP + m * RW_W + h * 64 + sub * 8); const f16x8 z8 = *(const f16x8*)(urow + C_RWZ + h * 64 + sub * 8);
            float o[8];
#pragma unroll
            for (int i = 0; i < 8; ++i) { const int col = h * 64 + sub * 8 + i; o[i] = ((y[i] - mean) * rstd * ln_w[col] + ln_b[col] + bon * (float)vp[i]) * siluf_((float)z8[i]); }
            u32x4 w; w.x = pg8::pk_f16(o[0], o[1]); w.y = pg8::pk_f16(o[2], o[3]); w.z = pg8::pk_f16(o[4], o[5]); w.w = pg8::pk_f16(o[6], o[7]);
            *(u32x4*)(MIX + m * DM + h * 64 + sub * 8) = w;
            __syncthreads();
        }
    }
    {
        const f16* HL = (const f16*)(a.ws + WS_HL); const float* lbr = a.in[16]; const float* nw = a.in[17] + l * 384;
        LAS float* SL = (LAS float*)lds;
        LAS float* QE = (LAS float*)(lds + 16384);
#pragma unroll 1
        for (int h = 0; h < 6; ++h) {
            const int bh = b * 6 + h;
            { const f16x8 s8 = *(const f16x8*)(HL + ((size_t)bh * NCH + c) * 4096 + tid * 8);
#pragma unroll
              for (int j = 0; j < 8; ++j) SL[tid * 8 + j] = (float)s8[j]; }
            { LAS float* FT = (LAS float*)(lds + 16384 + 17408);
              const f16x8 f8 = *(const f16x8*)(urow + C_HGF + h * 64 + sub * 8), q8 = *(const f16x8*)(urow + C_HGQ + h * 64 + sub * 8);
#pragma unroll
              for (int i = 0; i < 8; ++i) { const int col = h * 64 + sub * 8 + i; const float lb = (l == 0) ? 0.f : sigmoidf_(lbr[384 + col] - lbr[col]);
                  FT[(sub * 8 + i) * 68 + tt] = lb + (1.0f - lb) * sigmoidf_((float)f8[i]); QE[tt * 68 + sub * 8 + i] = (float)q8[i]; }
              __syncthreads();
              if (wave == 0) {
                  float cp = 1.f;
#pragma unroll
                  for (int t4 = 0; t4 < 64; t4 += 4) { const f32x4 f4 = *(const LAS f32x4*)(FT + lane * 68 + t4);
#pragma unroll
                      for (int i = 0; i < 4; ++i) { cp *= f4[i]; QE[(t4 + i) * 68 + lane] *= cp; } }
              } }
            __syncthreads();
            const f16x8 ol = *(const f16x8*)(MIX + m * DM + 384 + h * 64 + sub * 8);
            float o[8];
#pragma unroll
            for (int i = 0; i < 8; ++i) o[i] = (float)ol[i];
#pragma unroll 8
            for (int k = 0; k < 64; ++k) { const float qe = QE[tt * 68 + k]; const f32x4 s0 = *(const LAS f32x4*)(SL + k * 64 + sub * 8), s1 = *(const LAS f32x4*)(SL + k * 64 + sub * 8 + 4);
                o[0] += qe * s0.x; o[1] += qe * s0.y; o[2] += qe * s0.z; o[3] += qe * s0.w; o[4] += qe * s1.x; o[5] += qe * s1.y; o[6] += qe * s1.z; o[7] += qe * s1.w; }
            float ss = 0.f;
#pragma unroll
            for (int i = 0; i < 8; ++i) ss += o[i] * o[i];
            ss += __shfl_xor(ss, 1); ss += __shfl_xor(ss, 2); ss += __shfl_xor(ss, 4);
            const float rs = 1.0f / sqrtf(ss * (1.0f / 64.0f) + 1e-6f);
            const f16x8 z8 = *(const f16x8*)(urow + C_HGZ + h * 64 + sub * 8);
#pragma unroll
            for (int i = 0; i < 8; ++i) o[i] = o[i] * rs * nw[h * 64 + sub * 8 + i] * siluf_((float)z8[i]);
            u32x4 w; w.x = pg8::pk_f16(o[0], o[1]); w.y = pg8::pk_f16(o[2], o[3]); w.z = pg8::pk_f16(o[4], o[5]); w.w = pg8::pk_f16(o[6], o[7]);
            *(u32x4*)(MIX + m * DM + 384 + h * 64 + sub * 8) = w;
            __syncthreads();
        }
    }
    {
        const f16* CA = (const f16*)(a.ws + WS_CA); const float* LH = (const float*)(a.ws + WS_LH);
#pragma unroll 1
        for (int q = 0; q < 4; ++q) { const int ch0 = q * 64 + sub * 8;
            const f16x8 hl = *(const f16x8*)(MIX + m * DM + 768 + ch0), ca = *(const f16x8*)(CA + m * 256 + ch0), z8 = *(const f16x8*)(urow + C_LRUZ + ch0);
            float o[8];
#pragma unroll
            for (int i = 0; i < 8; ++i) o[i] = ((float)hl[i] + (float)ca[i] * LH[((size_t)b * NCH + c) * 256 + ch0 + i]) * siluf_((float)z8[i]);
            u32x4 w; w.x = pg8::pk_f16(o[0], o[1]); w.y = pg8::pk_f16(o[2], o[3]); w.z = pg8::pk_f16(o[4], o[5]); w.w = pg8::pk_f16(o[6], o[7]);
            *(u32x4*)(MIX + m * DM + 768 + ch0) = w; }
    }
}
#define XB_TMO      128
#define XB_XCNT(j)  (256  + 64 * (j))
#define XB_XSUB(j)  (1280 + 64 * (j))
#define XB_XGEN(j)  (2304 + 64 * (j))
#define XB_TOP      3328
#define XB_TOPGEN   3392
#define XCD_BAR_WORDS 3456
#define XB_SPIN_CAP (1u << 18)

__device__ __forceinline__ unsigned xb_ld(unsigned* p)              { return __hip_atomic_load(p, __ATOMIC_RELAXED, __HIP_MEMORY_SCOPE_AGENT); }
__device__ __forceinline__ unsigned xb_add(unsigned* p, unsigned v) { return __hip_atomic_fetch_add(p, v, __ATOMIC_RELAXED, __HIP_MEMORY_SCOPE_AGENT); }
__device__ __forceinline__ unsigned xb_xcc_id() { return (unsigned)__builtin_amdgcn_s_getreg((3 << 11) | 20) & 0xFu; }
#define XB_SPIN(cond, bar) do { unsigned _sp = 0; while (cond) { __builtin_amdgcn_s_sleep(1); \
    if ((++_sp & 255u) == 0u) { if (xb_ld(&(bar)[XB_TMO])) break; if (_sp > XB_SPIN_CAP) { atomicAdd(&(bar)[XB_TMO], 1u); break; } } } } while (0)

struct XcdBarrier {
    unsigned* bar; unsigned x; int isw0;
    volatile LAS unsigned* st;
};

__device__ __forceinline__ XcdBarrier xcd_barrier_post(unsigned* bar, volatile LAS unsigned* st, int isw0) {
    XcdBarrier b; b.bar = bar; b.x = xb_xcc_id(); b.st = st; b.isw0 = isw0;
    if (isw0 && lane_now() == 0) (void)xb_add(&bar[XB_XCNT(b.x)], 1u);
    return b;
}
__device__ __forceinline__ void xcd_barrier_complete(unsigned* bar, unsigned x, unsigned& nloc, unsigned& nx) {
    const unsigned G = gridDim.x * gridDim.y * gridDim.z;
    unsigned sum, cnt, mine, sp = 0u;
    for (;;) {
        sum = 0u; cnt = 0u; mine = 0u;
#pragma unroll
        for (unsigned j = 0; j < 16; ++j) { const unsigned c = xb_ld(&bar[XB_XCNT(j)]); sum += c; cnt += (c > 0u) ? 1u : 0u; mine = (j == x) ? c : mine; }
        if (sum == G) break;
        __builtin_amdgcn_s_sleep(1);
        if ((++sp & 255u) == 0u) { if (xb_ld(&bar[XB_TMO])) break; if (sp > XB_SPIN_CAP) { atomicAdd(&bar[XB_TMO], 1u); break; } }
    }
    nloc = mine > 0u ? mine : 1u; nx = cnt > 0u ? cnt : 1u;
}

__device__ __forceinline__ void xcd_barrier(const XcdBarrier& b) {
    asm volatile("s_waitcnt vmcnt(0)" ::: "memory");
    __syncthreads();
    if (b.isw0 && lane_now() == 0) {
        unsigned* bar = b.bar;
        __builtin_amdgcn_s_waitcnt(0);
        unsigned nloc = b.st[0], nx = b.st[1];
        if (nloc == 0u) { xcd_barrier_complete(bar, b.x, nloc, nx); b.st[0] = nloc; b.st[1] = nx; }
        const unsigned old = xb_add(&bar[XB_XSUB(b.x)], 1u);
        const unsigned gen = old / nloc;
        if (old + 1u == (gen + 1u) * nloc) {
            __builtin_amdgcn_fence(__ATOMIC_RELEASE, "agent");
            asm volatile("s_waitcnt vmcnt(0)" ::: "memory");
            const unsigned og = xb_add(&bar[XB_TOP], 1u);
            const unsigned tg = og / nx;
            if (og + 1u == (tg + 1u) * nx) xb_add(&bar[XB_TOPGEN], 1u);
            else XB_SPIN(xb_ld(&bar[XB_TOPGEN]) == tg, bar);
            __builtin_amdgcn_fence(__ATOMIC_ACQUIRE, "agent");
            xb_add(&bar[XB_XGEN(b.x)], 1u);
            asm volatile("s_waitcnt vmcnt(0)" ::: "memory");
        } else {
            XB_SPIN(xb_ld(&bar[XB_XGEN(b.x)]) == gen, bar);
            __builtin_amdgcn_fence(__ATOMIC_ACQUIRE, "agent");
            asm volatile("s_waitcnt vmcnt(0)" ::: "memory");
        }
    }
    __syncthreads();
}

constexpr size_t WS_BAR = 16384;
constexpr int MISC_OFF = LDS_BYTES - 16;
__global__ void __launch_bounds__(NT, 2) fwd(Args args) {
    extern __shared__ __attribute__((aligned(16))) unsigned char lds_raw[];
    LAS unsigned char* lds = (LAS unsigned char*)lds_raw;
    cg::grid_group grid = cg::this_grid();
    const int wave = __builtin_amdgcn_readfirstlane((int)threadIdx.x >> 6);
#define TID_NOW() (wave * 64 + lane_now())
    const int tid = TID_NOW(); const int lane = tid & 63;
    if (wave == 0 && lane < 4) ((LAS unsigned*)(lds + MISC_OFF))[lane] = 0u;
    __syncthreads();
    XcdBarrier xbar = xcd_barrier_post((unsigned*)(args.ws + WS_BAR), (volatile LAS unsigned*)(lds + MISC_OFF), __builtin_amdgcn_readfirstlane(wave == 0 ? 1 : 0));
#define GRID_BAR() do { XcdBarrier xb_ = xbar; asm volatile("" : "+s"(xb_.bar), "+s"(xb_.x)); xcd_barrier(xb_); } while (0)
    const int G = gridDim.x, gw = blockIdx.x * NWAVES + wave, NGW = G * NWAVES;
    unsigned char* ws = args.ws;
    unsigned short* XN = (unsigned short*)(ws + WS_XN);
    {
        LAS float* scr = (LAS float*)(lds + wave * 16384);
        constexpr int I_IN = (DM / 64) * (NIN / 32), I_OUT = (DM / 64) * (DM / 32), NITEMS = DEPTH * (I_IN + I_OUT);
        for (int it = gw; it < NITEMS; it += NGW) {
            int r = it; const int l = r / (I_IN + I_OUT); r -= l * (I_IN + I_OUT);
            if (r < I_IN) p0_transpose_item(args.in[2] + (size_t)l * DM * NIN, DM, NIN, (unsigned short*)(ws + WS_WIN + l * WIN_L), scr, r, lane);
            else p0_transpose_item(args.in[25] + (size_t)l * DM * DM, DM, DM, (unsigned short*)(ws + WS_WOUT + l * WOUT_L), scr, r - I_IN, lane);
        }
        for (int i = gw; i < DEPTH * (NU - NIN) * DM * 2 / 1024; i += NGW) { const int l = i / ((NU - NIN) * DM * 2 / 1024), r = i % ((NU - NIN) * DM * 2 / 1024);
            *(u32x4*)(ws + WS_WIN + l * WIN_L + (size_t)NIN * DM * 2 + (size_t)r * 1024 + lane * 16) = (u32x4){0u, 0u, 0u, 0u}; }
        for (int m = gw; m < M; m += NGW) rms_row_f16(args.in[0] + (size_t)m * DM, args.in[1], XN + (size_t)m * DM, lane);
        { f16* WUPT = (f16*)(ws + WS_WUPT); f16* AUPT = (f16*)(ws + WS_AUPT); f16* VDNT = (f16*)(ws + WS_VDNT); f16* VUPT = (f16*)(ws + WS_VUPT);
          for (int i = blockIdx.x * NT + tid; i < 122880; i += G * NT) {
              if (i < 49152) { const int ll = i / 24576, r = i % 24576, n = r / 64, k = r % 64; WUPT[i] = (f16)args.in[5][(size_t)ll * 24576 + k * 384 + n]; }
              else if (i < 98304) { const int i2 = i - 49152, ll = i2 / 24576, r = i2 % 24576, n = r / 64, k = r % 64; AUPT[i2] = (f16)args.in[7][(size_t)ll * 24576 + k * 384 + n]; }
              else if (i < 110592) { const int i2 = i - 98304, j2 = i2 / 384, cc = i2 % 384; VDNT[i2] = (f16)args.in[9][cc * 32 + j2]; }
              else { const int i2 = i - 110592, n = i2 / 32, j2 = i2 % 32; VUPT[i2] = (f16)args.in[10][j2 * 384 + n]; } } }
    }
    grid.sync();
#pragma unroll 1
    for (int l = 0; l < DEPTH; ++l) {
        { pg8::Gemm g{XN, (const unsigned short*)(ws + WS_WIN + l * WIN_L), M, NU, DM}; pg8::StaticOrder S; S.init(M, NU, G, (int)blockIdx.x);
          pg8::EpiF16 E{(unsigned short*)(ws + WS_U), NU};
          pg8::gemm_phase<pg8::EpiF16, pg8::StaticOrder, true, true>(lds, g, S, E, wave); }
        GRID_BAR();
        for (int task = blockIdx.x; task < BATCH * NCH; task += G) phaseA(args, l, task, lds, TID_NOW());
        GRID_BAR();
        phaseB(args, lds, TID_NOW());
        GRID_BAR();
        for (int task = blockIdx.x; task < BATCH * NCH; task += G) phaseC(args, l, task, lds, TID_NOW());
        GRID_BAR();
        { pg8::Gemm g{(const unsigned short*)(ws + WS_MIX), (const unsigned short*)(ws + WS_WOUT + l * WOUT_L), M, DM, DM}; pg8::StaticOrder S; S.init(M, DM, G, (int)blockIdx.x);
          pg8::EpiRes E{l == 0 ? args.in[0] : args.out, args.out, DM};
          pg8::gemm_phase<pg8::EpiRes, pg8::StaticOrder, true, true>(lds, g, S, E, wave); }
        GRID_BAR();
        { int ln = TID_NOW() & 63; asm volatile("" : "+v"(ln));
          if (l + 1 < DEPTH) { for (int m = gw; m < M; m += NGW) rms_row_f16(args.out + (size_t)m * DM, args.in[1] + (l + 1) * DM, XN + (size_t)m * DM, ln); GRID_BAR(); }
          else { for (int m = gw; m < M; m += NGW) rms_row_f32(args.out + (size_t)m * DM, args.in[26], ln); } }
    }
}

extern "C" void kernel_launch(void* const* d_in, const int* in_sizes, int n_in, void* d_out, int out_size, void* d_ws, size_t ws_size, hipStream_t stream) {
    static int grid = 0;
    if (grid == 0) {
        if (n_in != 27 || in_sizes[0] != M * DM || out_size != M * DM || ws_size < WS_END) { fprintf(stderr, "kernel_launch: unexpected problem: n_in %d in0 %d out %d ws %zu\n", n_in, n_in > 0 ? in_sizes[0] : -1, out_size, ws_size); grid = -1; return; }
        int dev = 0, cus = 0, per_cu = 0;
        hipGetDevice(&dev); hipDeviceGetAttribute(&cus, hipDeviceAttributeMultiprocessorCount, dev);
        if (hipFuncSetAttribute((const void*)fwd, hipFuncAttributeMaxDynamicSharedMemorySize, LDS_BYTES) != hipSuccess) { fprintf(stderr, "kernel_launch: hipFuncSetAttribute failed\n"); grid = -1; return; }
        if (hipOccupancyMaxActiveBlocksPerMultiprocessor(&per_cu, (const void*)fwd, NT, LDS_BYTES) != hipSuccess || per_cu < 1) { fprintf(stderr, "kernel_launch: occupancy query failed (%d)\n", per_cu); grid = -1; return; }
        grid = cus * per_cu;
    }
    if (grid < 0) return;
    if (hipMemsetAsync((char*)d_ws, 0, 65536, stream) != hipSuccess) { fprintf(stderr, "kernel_launch: memset of the barrier words failed\n"); return; }
    Args a{};
    for (int i = 0; i < 27; ++i) a.in[i] = (const float*)d_in[i];
    a.out = (float*)d_out; a.ws = (unsigned char*)d_ws;
    void* kargs[] = {&a};
    hipError_t e = hipLaunchCooperativeKernel((const void*)fwd, dim3(grid), dim3(NT), kargs, LDS_BYTES, stream);
    if (e != hipSuccess) fprintf(stderr, "cooperative launch failed: %s (grid %d)\n", hipGetErrorString(e), grid);
}
```

```cpp
#include <hip/hip_runtime.h>
#include <hip/hip_cooperative_groups.h>
#include <cstdio>
#include <cstdint>
namespace cg = cooperative_groups;
typedef _Float16 f16x8_t __attribute__((ext_vector_type(8)));
#define MK_MFMA(a, b, c) __builtin_amdgcn_mfma_f32_16x16x32_f16(__builtin_bit_cast(f16x8_t, (a)), __builtin_bit_cast(f16x8_t, (b)), (c), 0, 0, 0)
__device__ __forceinline__ int lane_now() { int z; asm volatile("v_mbcnt_lo_u32_b32 %0, -1, 0\n\tv_mbcnt_hi_u32_b32 %0, -1, %0" : "=v"(z)); return z; }
namespace pg8 {
#define PG8_LAS __attribute__((address_space(3)))
typedef unsigned short bf16_t;
typedef short bf16x8 __attribute__((ext_vector_type(8)));
typedef float f32x4 __attribute__((ext_vector_type(4)));
typedef unsigned u32x4 __attribute__((ext_vector_type(4)));
constexpr int BM = 256, BK = 64, HALF = 128, HTB = HALF * BK * 2  , STAGE_BYTES = 8 * HTB, NXCD = 8, WGM = 8;

__host__ __device__ __forceinline__ int lds_byte(int r, int c) { const int st = (r >> 4) * 2 + (c >> 5), rr = r & 15, cc = c & 31, ob = rr * 64 + cc * 2; return st * 1024 + (ob ^ (((ob >> 9) & 1) << 5)); }
__host__ __device__ __forceinline__ void stage_rc(int b, int& R, int& C) { const int st = b / 1024, sb = b % 1024, swz = sb ^ (((sb >> 9) & 1) << 5); R = (st >> 1) * 16 + swz / 64; C = (st & 1) * 32 + (swz % 64) / 2; }
__host__ __device__ __forceinline__ int perm32(int rho) { const int n = rho >> 4, i = rho & 15; return 8 * (i >> 2) + 4 * n + (i & 3); }

struct Unit { int pm, pn; };
struct Gemm { const bf16_t* A; const bf16_t* Bt; int M, N, K; };

struct StaticOrder {
    int nM, nN, nwg, G, c;
    __host__ __device__ void init(int M, int N, int G_, int c_) { nM = M / BM; nN = N / BM; nwg = nM * nN; G = G_; c = c_; }
    __host__ __device__ bool next(int i, Unit& u) const {
        const long L = (long)i * G + c; if (L >= nwg) return false;
        int wgid = (int)L; { const int q = nwg / NXCD, r = nwg % NXCD, xcd = wgid % NXCD, off = wgid / NXCD; wgid = (xcd < r ? xcd * (q + 1) : r * (q + 1) + (xcd - r) * q) + off; }
        const int nig = WGM * nN, gid = wgid / nig, fm = gid * WGM, gsz = (nM - fm) < WGM ? (nM - fm) : WGM;
        u.pm = fm + ((wgid % nig) % gsz); u.pn = (wgid % nig) / gsz; return true;
    }
    __device__ __forceinline__ void a_ready(const Unit&) const {}
    __device__ __forceinline__ void done(const Unit&) const {}
};

__device__ __forceinline__ unsigned pk_f16(float lo, float hi) { typedef _Float16 h2 __attribute__((ext_vector_type(2))); h2 v; v.x = (_Float16)lo; v.y = (_Float16)hi; return __builtin_bit_cast(unsigned, v); }
struct EpiF16 {
    static constexpr bool PERM = true, AFTER_DRAIN = false;
    bf16_t* O; int ldc;
    __device__ __forceinline__ void operator()(const f32x4 (&acc)[2][2][4][2], const Unit& u, int wr, int wc, int fr, int fq) const {
        const int row0 = u.pm * BM + wr * 64 + fr; const int col0 = u.pn * BM + wc * 32 + 8 * fq;
#pragma unroll
        for (int ai = 0; ai < 2; ++ai)
#pragma unroll
            for (int m = 0; m < 4; ++m) { bf16_t* rowp = O + (size_t)(row0 + ai * HALF + m * 16) * ldc + col0;
#pragma unroll
                for (int bj = 0; bj < 2; ++bj) { const f32x4 v0 = acc[ai][bj][m][0], v1 = acc[ai][bj][m][1];
                    u32x4 w; w.x = pk_f16(v0[0], v0[1]); w.y = pk_f16(v0[2], v0[3]); w.z = pk_f16(v1[0], v1[1]); w.w = pk_f16(v1[2], v1[3]);
                    *(u32x4*)(rowp + bj * HALF) = w; } }
    }
};
struct EpiRes {
    static constexpr bool PERM = false, AFTER_DRAIN = false;
    const float* base; float* out; int ldc;
    __device__ __forceinline__ void operator()(const f32x4 (&acc)[2][2][4][2], const Unit& u, int wr, int wc, int fr, int fq) const {
        const int row0 = u.pm * BM + wr * 64 + fr; const int col0 = u.pn * BM + wc * 32 + 4 * fq;
#pragma unroll
        for (int ai = 0; ai < 2; ++ai)
#pragma unroll
            for (int m = 0; m < 4; ++m) { const size_t off = (size_t)(row0 + ai * HALF + m * 16) * ldc + col0;
#pragma unroll
                for (int bj = 0; bj < 2; ++bj)
#pragma unroll
                    for (int n = 0; n < 2; ++n) { const size_t o = off + bj * HALF + n * 16; const f32x4 b = *(const f32x4*)(base + o); *(f32x4*)(out + o) = b + acc[ai][bj][m][n]; }
                asm volatile("" ::: "memory"); }
    }
};

template <class Epi, class Sched, bool ALIGN_EPI = false, bool SP2 = false>
__device__ __forceinline__ void gemm_phase(PG8_LAS unsigned char* lds, const Gemm g, const Sched& S, const Epi& E, const int wave_) {
    int wv_ = wave_; asm volatile("" : "+s"(wv_)); int tid_ = lane_now() + 64 * wv_; const int tid = tid_, wid = wv_, lane = tid & 63, wr = wid >> 2, wc = wid & 3, fr = lane & 15, fq = lane >> 4;
    const int K = g.K, nt = K / BK;
    unsigned voffA[2], voffB[2];
#pragma unroll
    for (int i = 0; i < 2; ++i) { int R, C; stage_rc(tid * 16 + i * 8192, R, C); const int Rb = Epi::PERM ? ((R & ~31) + perm32(R & 31)) : R;
        voffA[i] = (unsigned)(R * K + C) * 2u; voffB[i] = (unsigned)(Rb * K + C) * 2u; }
    const size_t kstep = (size_t)(BK * 2);
    const size_t hstep = (size_t)HALF * K * 2;
    const size_t tstep = 2 * hstep;
    const unsigned ldsw = (unsigned)wid * 1024u;
    const int aoff = lds_byte(wr * 64 + fr, fq * 8), boff = lds_byte(wc * 32 + fr, fq * 8);
#define PG8_SA(b, h) (((b) * 2 + (h)) * HTB)
#define PG8_SB(b, h) ((4 + (b) * 2 + (h)) * HTB)
#define PG8_STAGE(bufoff, gbase, voff) do { _Pragma("unroll") for (int _i = 0; _i < 2; ++_i) \
        __builtin_amdgcn_global_load_lds((const unsigned*)((const char*)(gbase) + (voff)[_i]), (PG8_LAS unsigned*)(lds + (bufoff) + ldsw + _i * 8192), 16, 0, 0); } while (0)
#define PG8_LDA(dst, b, h) do { _Pragma("unroll") for (int m = 0; m < 4; ++m) _Pragma("unroll") for (int k = 0; k < 2; ++k) dst[m][k] = *(const PG8_LAS bf16x8*)(lds + PG8_SA(b, h) + aoff + m * 2048 + k * 1024); } while (0)
#define PG8_LDB(dst, b, h) do { _Pragma("unroll") for (int n = 0; n < 2; ++n) _Pragma("unroll") for (int k = 0; k < 2; ++k) dst[n][k] = *(const PG8_LAS bf16x8*)(lds + PG8_SB(b, h) + boff + n * 2048 + k * 1024); } while (0)
#define PG8_MMA(ai, bj, At, Bt) do { __builtin_amdgcn_s_setprio(1); _Pragma("unroll") for (int m = 0; m < 4; ++m) _Pragma("unroll") for (int n = 0; n < 2; ++n) _Pragma("unroll") for (int k = 0; k < 2; ++k) \
        acc[ai][bj][m][n] = MK_MFMA(Bt[n][k], At[m][k], acc[ai][bj][m][n]); __builtin_amdgcn_s_setprio(0); } while (0)
#define PG8_WAIT_V(n) asm volatile("s_waitcnt vmcnt(" #n ")" ::: "memory")
#define PG8_WAIT_L(n) asm volatile("s_waitcnt lgkmcnt(" #n ")" ::: "memory")
#define PG8_BAR __builtin_amdgcn_s_barrier()
#define PG8_SCHED __builtin_amdgcn_sched_barrier(0)
    Unit cur, nxt; int ui = 0;
    if (!S.next(0, cur)) return;
    f32x4 acc[2][2][4][2];
#pragma unroll
    for (int a = 0; a < 2; ++a)
#pragma unroll
        for (int b = 0; b < 2; ++b)
#pragma unroll
            for (int m = 0; m < 4; ++m)
#pragma unroll
                for (int n = 0; n < 2; ++n) acc[a][b][m][n] = (f32x4){0.f, 0.f, 0.f, 0.f};
    bf16x8 At[4][2], B0[2][2], B1[2][2];
    const char* cA = (const char*)g.A + (size_t)cur.pm * tstep; const char* cB = (const char*)g.Bt + (size_t)cur.pn * tstep;
    S.a_ready(cur);
    if constexpr (SP2) {
        PG8_STAGE(PG8_SB(0, 0), cB, voffB); PG8_STAGE(PG8_SB(0, 1), cB + hstep, voffB); PG8_STAGE(PG8_SA(0, 0), cA, voffA); PG8_STAGE(PG8_SA(0, 1), cA + hstep, voffA);
        if (wr == 1) PG8_BAR;
        PG8_WAIT_V(2); PG8_BAR;
        PG8_STAGE(PG8_SB(1, 0), cB + kstep, voffB); PG8_STAGE(PG8_SA(1, 0), cA + kstep, voffA); PG8_STAGE(PG8_SB(1, 1), cB + hstep + kstep, voffB);
        PG8_WAIT_V(6); PG8_BAR;
    } else {
        PG8_STAGE(PG8_SB(0, 0), cB, voffB); PG8_STAGE(PG8_SA(0, 0), cA, voffA); PG8_STAGE(PG8_SB(0, 1), cB + hstep, voffB); PG8_STAGE(PG8_SA(0, 1), cA + hstep, voffA);
        if (wr == 1) PG8_BAR;
        PG8_WAIT_V(4); PG8_BAR;
        PG8_STAGE(PG8_SB(1, 0), cB + kstep, voffB); PG8_STAGE(PG8_SA(1, 0), cA + kstep, voffA); PG8_STAGE(PG8_SB(1, 1), cB + hstep + kstep, voffB);
        PG8_WAIT_V(6); PG8_BAR;
    }
    for (;;) {
        const bool has_next = S.next(ui + 1, nxt);
        const char* nA = has_next ? (const char*)g.A + (size_t)nxt.pm * tstep : cA; const char* nB = has_next ? (const char*)g.Bt + (size_t)nxt.pn * tstep : cB;
        for (int t = 0; t < nt; t += 2) {
            const bool last = (t == nt - 2);
            const char* a1 = cA + (size_t)(t + 1) * kstep;
            const char* a2 = last ? nA : cA + (size_t)(t + 2) * kstep; const char* b2 = last ? nB : cB + (size_t)(t + 2) * kstep;
            const char* a3 = a2 + kstep; const char* b3 = b2 + kstep;
            if (last && has_next) S.a_ready(nxt);
            if constexpr (SP2) {
            PG8_LDB(B0, 0, 0); PG8_LDB(B1, 0, 1); PG8_SCHED; PG8_LDA(At, 0, 0); PG8_STAGE(PG8_SA(1, 1), a1 + hstep, voffA);
            PG8_WAIT_V(8); PG8_WAIT_L(0); PG8_BAR; PG8_MMA(0, 0, At, B0); PG8_MMA(0, 1, At, B1); PG8_BAR; PG8_SCHED;
            PG8_LDA(At, 0, 1); PG8_STAGE(PG8_SB(0, 0), b2, voffB); PG8_STAGE(PG8_SB(0, 1), b2 + hstep, voffB); PG8_STAGE(PG8_SA(0, 0), a2, voffA);
            PG8_WAIT_V(8); PG8_WAIT_L(0); PG8_BAR; PG8_MMA(1, 0, At, B0); PG8_MMA(1, 1, At, B1); PG8_BAR; PG8_SCHED;
            PG8_LDB(B0, 1, 0); PG8_LDB(B1, 1, 1); PG8_SCHED; PG8_LDA(At, 1, 0); PG8_STAGE(PG8_SA(0, 1), a2 + hstep, voffA);
            PG8_WAIT_V(8); PG8_WAIT_L(0); PG8_BAR; PG8_MMA(0, 0, At, B0); PG8_MMA(0, 1, At, B1); PG8_BAR; PG8_SCHED;
            PG8_LDA(At, 1, 1); PG8_STAGE(PG8_SB(1, 0), b3, voffB); PG8_STAGE(PG8_SB(1, 1), b3 + hstep, voffB); PG8_STAGE(PG8_SA(1, 0), a3, voffA);
            PG8_WAIT_V(8); PG8_WAIT_L(0); PG8_BAR; PG8_MMA(1, 0, At, B0); PG8_MMA(1, 1, At, B1); PG8_BAR; PG8_SCHED;
            } else {
            PG8_LDB(B0, 0, 0); PG8_SCHED; PG8_LDA(At, 0, 0); PG8_STAGE(PG8_SA(1, 1), a1 + hstep, voffA);
            PG8_WAIT_L(8); PG8_BAR; PG8_WAIT_L(0); PG8_MMA(0, 0, At, B0); PG8_BAR; PG8_SCHED;
            PG8_LDB(B1, 0, 1); PG8_STAGE(PG8_SB(0, 0), b2, voffB);
            PG8_BAR; PG8_WAIT_L(0); PG8_MMA(0, 1, At, B1); PG8_BAR;
            PG8_LDA(At, 0, 1); PG8_STAGE(PG8_SA(0, 0), a2, voffA);
            PG8_BAR; PG8_WAIT_L(0); PG8_MMA(1, 0, At, B0); PG8_BAR; PG8_SCHED;
            PG8_STAGE(PG8_SB(0, 1), b2 + hstep, voffB);
            PG8_WAIT_V(6); PG8_BAR; PG8_MMA(1, 1, At, B1); PG8_BAR;
            PG8_LDB(B0, 1, 0); PG8_SCHED; PG8_LDA(At, 1, 0); PG8_STAGE(PG8_SA(0, 1), a2 + hstep, voffA);
            PG8_WAIT_L(8); PG8_BAR; PG8_WAIT_L(0); PG8_MMA(0, 0, At, B0); PG8_BAR; PG8_SCHED;
            PG8_LDB(B1, 1, 1); PG8_STAGE(PG8_SB(1, 0), b3, voffB);
            PG8_BAR; PG8_WAIT_L(0); PG8_MMA(0, 1, At, B1); PG8_BAR;
            PG8_LDA(At, 1, 1); PG8_STAGE(PG8_SA(1, 0), a3, voffA);
            PG8_BAR; PG8_WAIT_L(0); PG8_MMA(1, 0, At, B0); PG8_BAR; PG8_SCHED;
            PG8_STAGE(PG8_SB(1, 1), b3 + hstep, voffB);
            PG8_WAIT_V(6); PG8_BAR; PG8_MMA(1, 1, At, B1); PG8_BAR;
            }
        }
        if constexpr (ALIGN_EPI) { if (wr == 0) PG8_BAR; }
        if constexpr (!Epi::AFTER_DRAIN) { E(acc, cur, wr, wc, fr, fq); S.done(cur); }
        if (!has_next) break;
#pragma unroll
        for (int a = 0; a < 2; ++a)
#pragma unroll
            for (int b = 0; b < 2; ++b)
#pragma unroll
                for (int m = 0; m < 4; ++m)
#pragma unroll
                    for (int n = 0; n < 2; ++n) acc[a][b][m][n] = (f32x4){0.f, 0.f, 0.f, 0.f};
        cur = nxt; cA = nA; cB = nB; ++ui;
        if constexpr (ALIGN_EPI) { if (wr == 1) PG8_BAR; }
    }
    PG8_WAIT_V(0);
    if constexpr (!ALIGN_EPI) { if (wr == 0) PG8_BAR; }
    PG8_BAR;
    if constexpr (Epi::AFTER_DRAIN) { E.fused(acc, cur, wr, wc, fr, fq, lds, wid, lane); S.done(cur); }
#undef PG8_SA
#undef PG8_SB
#undef PG8_STAGE
#undef PG8_LDA
#undef PG8_LDB
#undef PG8_MMA
#undef PG8_WAIT_V
#undef PG8_WAIT_L
#undef PG8_BAR
#undef PG8_SCHED
}
}

constexpr int BATCH = 2, SEQ = 8192, DM = 1024, DEPTH = 2, M = BATCH * SEQ;
constexpr int RW_H = 6, HD = 64, RW_W = 384, RW_SHIFT = 1280;
constexpr int NIN = 3712, NU = 3840;
constexpr int C_R = 0, C_K = 384, C_V = 768, C_WL = 1152, C_AL = 1216, C_RWZ = 1280, C_HGQ = 1664, C_HGF = 2048, C_HGI = 2432, C_HGZ = 2816, C_LRUX = 3200, C_LRUZ = 3456;
constexpr int CH = 64;
constexpr int NWAVES = 8, NT = NWAVES * 64;
constexpr int LDS_BYTES = 147456;
constexpr size_t MiB = 1u << 20;
constexpr size_t WS_WUPT = 65536, WS_AUPT = WS_WUPT + 98304, WS_VDNT = WS_AUPT + 98304, WS_VUPT = WS_VDNT + 24576, WS_WAT = WS_VUPT + 24576, WS_WXT = WS_WAT + 65536;
constexpr size_t WS_WIN = 1 * MiB, WIN_L = (size_t)NU * DM * 2;
constexpr size_t WS_WOUT = 16 * MiB, WOUT_L = (size_t)DM * DM * 2;
constexpr size_t WS_XN = 20 * MiB;
constexpr size_t WS_QT = 20 * MiB;
constexpr size_t WS_PT = 32 * MiB;
constexpr size_t WS_CA = 44 * MiB;
constexpr size_t WS_U = 52 * MiB;
constexpr size_t WS_MIX = 172 * MiB;
constexpr size_t WS_VF = 204 * MiB;
constexpr size_t WS_VP = 216 * MiB;
constexpr size_t WS_RL = 228 * MiB;
constexpr size_t WS_HL = 240 * MiB;
constexpr size_t WS_BON = 252 * MiB;
constexpr size_t WS_DC = WS_BON + 512 * 1024;
constexpr size_t WS_LA = WS_DC + 512 * 1024;
constexpr size_t WS_LH = WS_LA + 256 * 1024;
constexpr size_t WS_END = 254 * MiB;
constexpr int NCH = SEQ / CH;

#define LAS __attribute__((address_space(3)))
typedef float f32x4 __attribute__((ext_vector_type(4)));
typedef unsigned u32x2 __attribute__((ext_vector_type(2)));
typedef unsigned u32x4 __attribute__((ext_vector_type(4)));
typedef _Float16 f16;
typedef _Float16 f16x8 __attribute__((ext_vector_type(8)));
#define LDS_WAIT() asm volatile("s_waitcnt lgkmcnt(0)" ::: "memory")

struct Args { const float* in[27]; float* out; unsigned char* ws; };

__device__ __forceinline__ float wave_sum(float v) {
#pragma unroll
    for (int o = 1; o < 64; o <<= 1) v += __shfl_xor(v, o);
    return v;
}
__device__ __forceinline__ float sigmoidf_(float x) { return 1.0f / (1.0f + __expf(-x)); }
__device__ __forceinline__ float siluf_(float x) { return x / (1.0f + __expf(-x)); }

__device__ __forceinline__ void p0_transpose_item(const float* W, int K, int N, unsigned short* WT, LAS float* scr, int item, int lane) {
    const int nblk = N / 32, kb = item / nblk, nb = item % nblk, k0 = 64 * kb, n0 = 32 * nb;
#pragma unroll 8
    for (int i = 0; i < 32; ++i) { const int kk = 2 * i + (lane >> 5); scr[kk * 33 + (lane & 31)] = W[(size_t)(k0 + kk) * N + n0 + (lane & 31)]; }
    LDS_WAIT(); asm volatile("" ::: "memory");
    const int c = lane & 7;
#pragma unroll
    for (int j = 0; j < 4; ++j) { const int n = (lane >> 3) + 8 * j; const LAS float* s = scr + (8 * c) * 33 + n;
        u32x4 o; o.x = pg8::pk_f16(s[0 * 33], s[1 * 33]); o.y = pg8::pk_f16(s[2 * 33], s[3 * 33]); o.z = pg8::pk_f16(s[4 * 33], s[5 * 33]); o.w = pg8::pk_f16(s[6 * 33], s[7 * 33]);
        *(u32x4*)(WT + (size_t)(n0 + n) * K + k0 + 8 * c) = o; }
    LDS_WAIT(); asm volatile("" ::: "memory");
}
__device__ __forceinline__ void rms_row_f16(const float* xrow, const float* w, unsigned short* orow, int lane) {
    const f32x4* xr = (const f32x4*)xrow + lane; const f32x4* wr = (const f32x4*)w + lane;
    f32x4 v[4]; float s = 0.f;
#pragma unroll
    for (int j = 0; j < 4; ++j) { v[j] = xr[64 * j]; s += (v[j].x * v[j].x + v[j].y * v[j].y) + (v[j].z * v[j].z + v[j].w * v[j].w); }
    const float rs = 1.0f / sqrtf(wave_sum(s) * (1.0f / DM) + 1e-6f);
    u32x2* o8 = (u32x2*)orow + lane;
#pragma unroll
    for (int j = 0; j < 4; ++j) { const f32x4 ww = wr[64 * j]; u32x2 o; o.x = pg8::pk_f16(v[j].x * rs * ww.x, v[j].y * rs * ww.y); o.y = pg8::pk_f16(v[j].z * rs * ww.z, v[j].w * rs * ww.w); o8[64 * j] = o; }
}
__device__ __forceinline__ void rms_row_f32(float* xrow, const float* w, int lane) {
    f32x4* xr = (f32x4*)xrow + lane; const f32x4* wr = (const f32x4*)w + lane;
    f32x4 v[4]; float s = 0.f;
#pragma unroll
    for (int j = 0; j < 4; ++j) { v[j] = xr[64 * j]; s += (v[j].x * v[j].x + v[j].y * v[j].y) + (v[j].z * v[j].z + v[j].w * v[j].w); }
    const float rs = 1.0f / sqrtf(wave_sum(s) * (1.0f / DM) + 1e-6f);
#pragma unroll
    for (int j = 0; j < 4; ++j) { const f32x4 ww = wr[64 * j]; xr[64 * j] = v[j] * rs * ww; }
}


#define SHV(col) ({ const float cur_ = (float)urow[(col)]; const float prev_ = hp ? (float)prow[(col)] : 0.f; cur_ + mu[(col)] * (prev_ - cur_); })

__device__ __forceinline__ void store_row64_f16(f16* dst, const float (&S)[64]) {
#pragma unroll
    for (int q = 0; q < 8; ++q) { u32x4 w; w.x = pg8::pk_f16(S[8 * q], S[8 * q + 1]); w.y = pg8::pk_f16(S[8 * q + 2], S[8 * q + 3]); w.z = pg8::pk_f16(S[8 * q + 4], S[8 * q + 5]); w.w = pg8::pk_f16(S[8 * q + 6], S[8 * q + 7]); *(u32x4*)(dst + 8 * q) = w; }
}


constexpr int RWA_REC = 768, RWA_VPL = 16 * RWA_REC, RWA_SCR = RWA_VPL + 2048, RWA_BYTES = RWA_SCR + 1024;
typedef float f32x2 __attribute__((ext_vector_type(2)));
typedef _Float16 f16x4 __attribute__((ext_vector_type(4)));
__device__ __forceinline__ float fmix_lo(float a, unsigned b, float c) { float d; asm("v_fma_mix_f32 %0, %1, %2, %3 op_sel:[0,0,0] op_sel_hi:[0,1,0]" : "=v"(d) : "v"(a), "v"(b), "v"(c)); return d; }
__device__ __forceinline__ float fmix_hi(float a, unsigned b, float c) { float d; asm("v_fma_mix_f32 %0, %1, %2, %3 op_sel:[0,1,0] op_sel_hi:[0,1,0]" : "=v"(d) : "v"(a), "v"(b), "v"(c)); return d; }
__device__ __forceinline__ float mmix_lo(float a, unsigned b) { float d; asm("v_fma_mix_f32 %0, %1, %2, 0 op_sel:[0,0,0] op_sel_hi:[0,1,0]" : "=v"(d) : "v"(a), "v"(b)); return d; }
__device__ __forceinline__ float mmix_hi(float a, unsigned b) { float d; asm("v_fma_mix_f32 %0, %1, %2, 0 op_sel:[0,1,0] op_sel_hi:[0,1,0]" : "=v"(d) : "v"(a), "v"(b)); return d; }
__device__ __forceinline__ float fma_asm(float a, float b, float c) { float d; asm("v_fma_f32 %0, %1, %2, %3" : "=v"(d) : "v"(a), "v"(b), "v"(c)); return d; }
#define FMIX(a, u, j, c) (((j) & 1) ? fmix_hi((a), (u)[(j) >> 1], (c)) : fmix_lo((a), (u)[(j) >> 1], (c)))
#define MMIX(a, u, j) (((j) & 1) ? mmix_hi((a), (u)[(j) >> 1]) : mmix_lo((a), (u)[(j) >> 1]))
__device__ __forceinline__ float fast_tanh(float x) { return 1.0f - 2.0f / (__expf(2.0f * x) + 1.0f); }
__device__ __forceinline__ void lerp8(const char* ub, unsigned uo, unsigned po, bool hp, const char* mub, unsigned col, float (&x)[8]) {
    const f16x8 cu = *(const f16x8*)(ub + (uo + col * 2u)); f16x8 pv = *(const f16x8*)(ub + (po + col * 2u)); const f32x4 m0 = *(const f32x4*)(mub + col * 4u), m1 = *(const f32x4*)(mub + col * 4u + 16u);
#pragma unroll
    for (int j = 0; j < 8; ++j) { const float c = (float)cu[j], p = hp ? (float)pv[j] : 0.f; x[j] = c + (j < 4 ? m0[j] : m1[j - 4]) * (p - c); }
}
__device__ __forceinline__ void lerp4(const char* ub, unsigned uo, unsigned po, bool hp, const char* mub, unsigned col, float (&x)[4]) {
    const f16x4 cu = *(const f16x4*)(ub + (uo + col * 2u)); f16x4 pv = *(const f16x4*)(ub + (po + col * 2u)); const f32x4 m0 = *(const f32x4*)(mub + col * 4u);
#pragma unroll
    for (int j = 0; j < 4; ++j) { const float c = (float)cu[j], p = hp ? (float)pv[j] : 0.f; x[j] = c + m0[j] * (p - c); }
}
__device__ __forceinline__ f16x8 pack8(const float (&x)[8]) { f16x8 r;
#pragma unroll
    for (int j = 0; j < 8; ++j) r[j] = (f16)x[j];
    return r; }

__device__ __forceinline__ void rwkv_waveA(const Args& a, int l, int b, int c, int h, LAS unsigned char* wl, int lane) {
    const f16* U = (const f16*)(a.ws + WS_U); f16* MIX = (f16*)(a.ws + WS_MIX); f16* VF = (f16*)(a.ws + WS_VF); f16* VP = (f16*)(a.ws + WS_VP);
    f16* QT = (f16*)(a.ws + WS_QT); f16* PT = (f16*)(a.ws + WS_PT); f16* RL = (f16*)(a.ws + WS_RL); float* BONG = (float*)(a.ws + WS_BON);
    const f16* WUPT = (const f16*)(a.ws + WS_WUPT) + (size_t)l * 384 * 64; const f16* AUPT = (const f16*)(a.ws + WS_AUPT) + (size_t)l * 384 * 64;
    const f16* VDNT = (const f16*)(a.ws + WS_VDNT); const f16* VUPT = (const f16*)(a.ws + WS_VUPT);
    const float* mu = a.in[3] + l * RW_SHIFT; const float* w0 = a.in[4] + l * RW_W; const float* a0 = a.in[6] + l * RW_W; const float* v0 = a.in[8];
    const float* k_k = a.in[11] + l * RW_W; const float* k_a = a.in[12] + l * RW_W; const float* r_k = a.in[13] + l * RW_W;
    const int bh = b * RW_H + h;
    float P[64], L[64];
#pragma unroll
    for (int k = 0; k < 64; ++k) { P[k] = (k == lane) ? 1.f : 0.f; L[k] = 0.f; }
#pragma unroll 1
    for (int blk = 0; blk < 4; ++blk) {
        int lane_ = lane; asm volatile("" : "+v"(lane_));
        const int tok = lane_ & 15, fq = lane_ >> 4;
        const int t = c * CH + blk * 16 + tok; const unsigned m = (unsigned)(b * SEQ + t); const bool hp = t > 0;
        const char* ub = (const char*)U; const char* mub = (const char*)mu; const unsigned uo = m * (unsigned)(NU * 2), po = hp ? uo - (unsigned)(NU * 2) : uo;
        f16x8 bW[2], bA[2], bVD;
#pragma unroll
        for (int s = 0; s < 2; ++s) {
            float x[8]; lerp8(ub, uo, po, hp, mub, (unsigned)(C_WL + 8 * fq + 32 * s), x);
#pragma unroll
            for (int j = 0; j < 8; ++j) x[j] = fast_tanh(x[j]);
            bW[s] = pack8(x);
            lerp8(ub, uo, po, hp, mub, (unsigned)(C_AL + 8 * fq + 32 * s), x);
            bA[s] = pack8(x);
            asm volatile("" ::: "memory");
        }
        if (l > 0) {
            f32x4 VD0 = (f32x4){0.f, 0.f, 0.f, 0.f}, VD1 = VD0;
#pragma unroll 1
            for (int s = 0; s < 12; ++s) {
                float x[8]; lerp8(ub, uo, po, hp, mub, (unsigned)(C_V + 8 * fq + 32 * s), x);
                const f16x8 bv = pack8(x);
                VD0 = __builtin_amdgcn_mfma_f32_16x16x32_f16(*(const f16x8*)((const char*)VDNT + (unsigned)(tok * 384 + 8 * fq + 32 * s) * 2u), bv, VD0, 0, 0, 0);
                VD1 = __builtin_amdgcn_mfma_f32_16x16x32_f16(*(const f16x8*)((const char*)VDNT + (unsigned)((16 + tok) * 384 + 8 * fq + 32 * s) * 2u), bv, VD1, 0, 0, 0);
            }
            LAS f16* scr = (LAS f16*)(wl + RWA_SCR);
            { f16x4 p0, p1;
#pragma unroll
              for (int i = 0; i < 4; ++i) { p0[i] = (f16)VD0[i]; p1[i] = (f16)VD1[i]; }
              *(LAS f16x4*)(scr + tok * 32 + 4 * fq) = p0; *(LAS f16x4*)(scr + tok * 32 + 16 + 4 * fq) = p1; }
            asm volatile("s_waitcnt lgkmcnt(0)" ::: "memory");
            bVD = *(const LAS f16x8*)(scr + tok * 32 + 8 * fq);
        }
        float ssq = 0.f;
#pragma unroll 1
        for (int nt = 0; nt < 4; ++nt) { const int cb = h * 64 + 16 * nt + 4 * fq; float ks[4]; lerp4(ub, uo, po, hp, mub, (unsigned)(C_K + cb), ks); const f32x4 kk4 = *(const f32x4*)((const char*)k_k + (unsigned)cb * 4u);
#pragma unroll
            for (int i = 0; i < 4; ++i) { const float kv = ks[i] * kk4[i]; ssq += kv * kv; }
            asm volatile("" ::: "memory"); }
        ssq += __shfl_xor(ssq, 16); ssq += __shfl_xor(ssq, 32);
        const float inv = 1.0f / fmaxf(sqrtf(ssq), 1e-12f);
        float bon = 0.f;
        LAS unsigned char* rec = wl + tok * RWA_REC;
#pragma unroll 1
        for (int nt = 0; nt < 4; ++nt) {
            const int cb = h * 64 + 16 * nt + 4 * fq, co = 16 * nt + 4 * fq; const int n = h * 64 + 16 * nt + tok;
            f32x4 DWn = (f32x4){0.f, 0.f, 0.f, 0.f}, DAn = DWn, Gn = DWn;
#pragma unroll
            for (int s = 0; s < 2; ++s) {
                DWn = __builtin_amdgcn_mfma_f32_16x16x32_f16(*(const f16x8*)((const char*)WUPT + (unsigned)(n * 64 + 8 * fq + 32 * s) * 2u), bW[s], DWn, 0, 0, 0);
                DAn = __builtin_amdgcn_mfma_f32_16x16x32_f16(*(const f16x8*)((const char*)AUPT + (unsigned)(n * 64 + 8 * fq + 32 * s) * 2u), bA[s], DAn, 0, 0, 0); }
            if (l > 0) Gn = __builtin_amdgcn_mfma_f32_16x16x32_f16(*(const f16x8*)((const char*)VUPT + (unsigned)(n * 32 + 8 * fq) * 2u), bVD, Gn, 0, 0, 0);
            float rs[4], ks[4], vs[4];
            lerp4(ub, uo, po, hp, mub, (unsigned)(C_R + cb), rs); lerp4(ub, uo, po, hp, mub, (unsigned)(C_K + cb), ks); lerp4(ub, uo, po, hp, mub, (unsigned)(C_V + cb), vs);
            const unsigned cb4 = (unsigned)cb * 4u; const f32x4 w04 = *(const f32x4*)((const char*)w0 + cb4), a04 = *(const f32x4*)((const char*)a0 + cb4), kk4 = *(const f32x4*)((const char*)k_k + cb4), ka4 = *(const f32x4*)((const char*)k_a + cb4), rk4 = *(const f32x4*)((const char*)r_k + cb4);
            f32x4 wv; f16x4 al, be, km, rr, vo;
            f16x4 vf4; f32x4 v04;
            const unsigned vo_b = (m * (unsigned)RW_W + (unsigned)cb) * 2u;
            if (l > 0) { vf4 = *(const f16x4*)((const char*)VF + vo_b); v04 = *(const f32x4*)((const char*)v0 + cb4); }
#pragma unroll
            for (int i = 0; i < 4; ++i) {
                wv[i] = __expf(-0.6065306597126334f * sigmoidf_(w04[i] + DWn[i]));
                const float aa = sigmoidf_(a04[i] + DAn[i]);
                float vv = vs[i];
                if (l > 0) vv = vs[i] + ((float)vf4[i] - vs[i]) * sigmoidf_(v04[i] + Gn[i]);
                const float kk = ks[i] * kk4[i] * inv;
                const float kmod = ks[i] * (1.0f + (aa - 1.0f) * ka4[i]);
                bon += rs[i] * kmod * rk4[i];
                al[i] = (f16)(-kk); be[i] = (f16)(kk * aa); km[i] = (f16)kmod; rr[i] = (f16)rs[i]; vo[i] = (f16)vv;
            }
            *(LAS f32x4*)(rec + co * 4) = wv;
            *(LAS f16x4*)(rec + 256 + co * 2) = al; *(LAS f16x4*)(rec + 384 + co * 2) = be; *(LAS f16x4*)(rec + 512 + co * 2) = km; *(LAS f16x4*)(rec + 640 + co * 2) = rr;
            *(LAS f16x4*)(wl + RWA_VPL + tok * 128 + co * 2) = vo;
            *(f16x4*)((char*)VP + vo_b) = vo;
            if (l == 0) *(f16x4*)((char*)VF + vo_b) = vo;
            asm volatile("" ::: "memory");
        }
        bon += __shfl_xor(bon, 16); bon += __shfl_xor(bon, 32);
        if (fq == 0) *(float*)((char*)BONG + (m * 8u + (unsigned)h) * 4u) = bon;
        const unsigned mb = (unsigned)(b * SEQ + c * CH + blk * 16);
        asm volatile("s_waitcnt lgkmcnt(0)" ::: "memory");
        u32x4 A[8];
#pragma unroll
        for (int g = 0; g < 8; ++g) A[g] = *(const LAS u32x4*)(wl + 256 + g * 16);
        float vv = (float)*(const LAS f16*)(wl + RWA_VPL + lane_ * 2);
#define RW_LDU(WA, WB, B4, K4, R4, g) { WA = *(const LAS f32x4*)(rc + (g) * 32); WB = *(const LAS f32x4*)(rc + (g) * 32 + 16); B4 = *(const LAS u32x4*)(rc + 384 + (g) * 16); K4 = *(const LAS u32x4*)(rc + 512 + (g) * 16); R4 = *(const LAS u32x4*)(rc + 640 + (g) * 16); }
#define RW_COMP(WA, WB, B4, K4, R4, g) { float tP[8], tL[8]; \
            _Pragma("unroll") for (int j = 0; j < 8; ++j) tP[j] = MMIX(saP, B4, j); \
            _Pragma("unroll") for (int j = 0; j < 8; ++j) tL[j] = MMIX(saL, B4, j); \
            _Pragma("unroll") for (int j = 0; j < 8; ++j) tL[j] = FMIX(vv, K4, j, tL[j]); \
            _Pragma("unroll") for (int j = 0; j < 8; ++j) P[8 * (g) + j] = fma_asm(P[8 * (g) + j], (j < 4) ? WA[j & 3] : WB[j & 3], tP[j]); \
            _Pragma("unroll") for (int j = 0; j < 8; ++j) L[8 * (g) + j] = fma_asm(L[8 * (g) + j], (j < 4) ? WA[j & 3] : WB[j & 3], tL[j]); \
            _Pragma("unroll") for (int j = 0; j < 8; ++j) qa[j] = FMIX(P[8 * (g) + j], R4, j, qa[j]); \
            _Pragma("unroll") for (int j = 0; j < 8; ++j) ya[j] = FMIX(L[8 * (g) + j], R4, j, ya[j]); }
#pragma unroll 1
        for (int t2 = 0; t2 < 16; ++t2) {
            const LAS unsigned char* rc = wl + t2 * RWA_REC;
            f32x4 wAe, wBe, wAo, wBo; u32x4 be, ke, re, bo, ko, ro;
            RW_LDU(wAe, wBe, be, ke, re, 0)
            float sP[8], sL[8];
#pragma unroll
            for (int j = 0; j < 8; ++j) { sP[j] = 0.f; sL[j] = 0.f; }
#pragma unroll
            for (int g = 0; g < 8; ++g) {
#pragma unroll
                for (int j = 0; j < 8; ++j) sP[j] = FMIX(P[8 * g + j], A[g], j, sP[j]);
#pragma unroll
                for (int j = 0; j < 8; ++j) sL[j] = FMIX(L[8 * g + j], A[g], j, sL[j]); }
            const float saP = ((sP[0] + sP[1]) + (sP[2] + sP[3])) + ((sP[4] + sP[5]) + (sP[6] + sP[7])), saL = ((sL[0] + sL[1]) + (sL[2] + sL[3])) + ((sL[4] + sL[5]) + (sL[6] + sL[7]));
            float qa[8], ya[8];
#pragma unroll
            for (int j = 0; j < 8; ++j) { qa[j] = 0.f; ya[j] = 0.f; }
            RW_LDU(wAo, wBo, bo, ko, ro, 1) RW_COMP(wAe, wBe, be, ke, re, 0)
            RW_LDU(wAe, wBe, be, ke, re, 2) RW_COMP(wAo, wBo, bo, ko, ro, 1)
            RW_LDU(wAo, wBo, bo, ko, ro, 3) RW_COMP(wAe, wBe, be, ke, re, 2)
            RW_LDU(wAe, wBe, be, ke, re, 4) RW_COMP(wAo, wBo, bo, ko, ro, 3)
            RW_LDU(wAo, wBo, bo, ko, ro, 5) RW_COMP(wAe, wBe, be, ke, re, 4)
            RW_LDU(wAe, wBe, be, ke, re, 6) RW_COMP(wAo, wBo, bo, ko, ro, 5)
            RW_LDU(wAo, wBo, bo, ko, ro, 7) RW_COMP(wAe, wBe, be, ke, re, 6)
            const float vvn = (float)*(const LAS f16*)(wl + RWA_VPL + ((t2 + 1) & 15) * 128 + lane_ * 2);
#pragma unroll
            for (int g = 0; g < 8; ++g) A[g] = *(const LAS u32x4*)(rc + RWA_REC + 256 + g * 16);
            RW_COMP(wAo, wBo, bo, ko, ro, 7)
            vv = vvn;
            *(f16*)((char*)MIX + ((mb + t2) * (unsigned)DM + (unsigned)(h * 64 + lane_)) * 2u) = (f16)(((ya[0] + ya[1]) + (ya[2] + ya[3])) + ((ya[4] + ya[5]) + (ya[6] + ya[7])));
            *(f16*)((char*)QT + ((mb + t2) * (unsigned)RW_W + (unsigned)(h * 64 + lane_)) * 2u) = (f16)(((qa[0] + qa[1]) + (qa[2] + qa[3])) + ((qa[4] + qa[5]) + (qa[6] + qa[7])));
        }
#undef RW_LDU
#undef RW_COMP
    }
    store_row64_f16(RL + (((size_t)bh * NCH + c) * 64 + lane) * 64, L);
    f16* pt = PT + ((size_t)bh * NCH + c) * 4096;
#pragma unroll
    for (int k = 0; k < 64; ++k) pt[k * 64 + lane] = (f16)P[k];
}

constexpr int HGA_REC = 512, HGA_HEAD = 16 * HGA_REC, HGA_BYTES = 3 * HGA_HEAD;
__device__ __forceinline__ void hgrn_waveA(const Args& a, int l, int b, int c, int h0, LAS unsigned char* wl, int lane) {
    f16* U = (f16*)(a.ws + WS_U); f16* MIX = (f16*)(a.ws + WS_MIX); f16* HL = (f16*)(a.ws + WS_HL); float* DC = (float*)(a.ws + WS_DC);
    const float* lbr = a.in[16];
    float S0[64], S1[64], S2[64];
#pragma unroll
    for (int k = 0; k < 64; ++k) { S0[k] = 0.f; S1[k] = 0.f; S2[k] = 0.f; }
    float dp0 = 1.f, dp1 = 1.f, dp2 = 1.f;
#pragma unroll 1
    for (int blk = 0; blk < 4; ++blk) {
        int lane_ = lane; asm volatile("" : "+v"(lane_));
        const unsigned mb = (unsigned)(b * SEQ + c * CH + blk * 16);
#pragma unroll 1
        for (int j = 0; j < 3; ++j) {
            const int col = (h0 + j) * 64 + lane_;
            const float lb = (l == 0) ? 0.f : sigmoidf_(lbr[384 + col] - lbr[col]);
            float dp = (j == 0) ? dp0 : (j == 1) ? dp1 : dp2;
            f16 fr[16], qr[16];
#pragma unroll
            for (int tk = 0; tk < 16; ++tk) { const char* ur = (const char*)U + (mb + tk) * (unsigned)(NU * 2); fr[tk] = *(const f16*)(ur + (unsigned)(C_HGF + col) * 2u); qr[tk] = *(const f16*)(ur + (unsigned)(C_HGQ + col) * 2u); }
#pragma unroll
            for (int tk = 0; tk < 16; ++tk) {
                const float f = lb + (1.0f - lb) * sigmoidf_((float)fr[tk]);
                LAS unsigned char* rec = wl + j * HGA_HEAD + tk * HGA_REC;
                *(LAS float*)(rec + lane_ * 4) = f; *(LAS f16*)(rec + 256 + lane_ * 2) = (f16)(1.0f - f); *(LAS f16*)(rec + 384 + lane_ * 2) = qr[tk];
                dp *= f;
                *(f16*)((char*)U + (mb + tk) * (unsigned)(NU * 2) + (unsigned)(C_HGQ + col) * 2u) = (f16)((float)qr[tk] * dp);
            }
            if (j == 0) dp0 = dp; else if (j == 1) dp1 = dp; else dp2 = dp;
        }
        asm volatile("s_waitcnt lgkmcnt(0)" ::: "memory");
#define HG_LDF(rcp, g) { fA = *(const LAS f32x4*)((rcp) + (g) * 32); fB = *(const LAS f32x4*)((rcp) + (g) * 32 + 16); }
#define HG_LDKQ(K4, Q4, rcp, g) { K4 = *(const LAS u32x4*)((rcp) + 256 + (g) * 16); Q4 = *(const LAS u32x4*)((rcp) + 384 + (g) * 16); }
#define HG_COMP(S, vi, K4, Q4, g, rcf, gf) { float tt[8]; \
            _Pragma("unroll") for (int jj = 0; jj < 8; ++jj) tt[jj] = MMIX(vi, K4, jj); \
            _Pragma("unroll") for (int jj = 0; jj < 8; ++jj) S[8 * (g) + jj] = fma_asm(S[8 * (g) + jj], (jj < 4) ? fA[jj & 3] : fB[jj & 3], tt[jj]); \
            HG_LDF(rcf, gf) \
            _Pragma("unroll") for (int jj = 0; jj < 8; ++jj) oa[jj] = FMIX(S[8 * (g) + jj], Q4, jj, oa[jj]); }
#define HG_HEAD(S, vi, rcp, rcn, oo) { float oa[8]; _Pragma("unroll") for (int jj = 0; jj < 8; ++jj) oa[jj] = 0.f; \
            HG_LDKQ(k4o, q4o, rcp, 1) HG_COMP(S, vi, k4e, q4e, 0, rcp, 1) \
            HG_LDKQ(k4e, q4e, rcp, 2) HG_COMP(S, vi, k4o, q4o, 1, rcp, 2) \
            HG_LDKQ(k4o, q4o, rcp, 3) HG_COMP(S, vi, k4e, q4e, 2, rcp, 3) \
            HG_LDKQ(k4e, q4e, rcp, 4) HG_COMP(S, vi, k4o, q4o, 3, rcp, 4) \
            HG_LDKQ(k4o, q4o, rcp, 5) HG_COMP(S, vi, k4e, q4e, 4, rcp, 5) \
            HG_LDKQ(k4e, q4e, rcp, 6) HG_COMP(S, vi, k4o, q4o, 5, rcp, 6) \
            HG_LDKQ(k4o, q4o, rcp, 7) HG_COMP(S, vi, k4e, q4e, 6, rcp, 7) \
            HG_LDKQ(k4e, q4e, rcn, 0) HG_COMP(S, vi, k4o, q4o, 7, rcn, 0) \
            oo = ((oa[0] + oa[1]) + (oa[2] + oa[3])) + ((oa[4] + oa[5]) + (oa[6] + oa[7])); }
        f32x4 fA, fB; u32x4 k4e, q4e, k4o, q4o;
        HG_LDF(wl, 0) HG_LDKQ(k4e, q4e, wl, 0)
        const char* ur0 = (const char*)U + mb * (unsigned)(NU * 2) + (unsigned)(C_HGI + h0 * 64 + lane_) * 2u;
        float v0 = (float)*(const f16*)(ur0), v1 = (float)*(const f16*)(ur0 + 128), v2 = (float)*(const f16*)(ur0 + 256);
#pragma unroll 1
        for (int t2 = 0; t2 < 16; ++t2) {
            const LAS unsigned char* rc = wl + t2 * HGA_REC;
            const char* urn = ur0 + (unsigned)((t2 + 1) & 15) * (unsigned)(NU * 2);
            const f16 n0 = *(const f16*)(urn), n1 = *(const f16*)(urn + 128), n2 = *(const f16*)(urn + 256);
            float oa_, ob_, oc_;
            HG_HEAD(S0, v0, rc, rc + HGA_HEAD, oa_)
            HG_HEAD(S1, v1, rc + HGA_HEAD, rc + 2 * HGA_HEAD, ob_)
            HG_HEAD(S2, v2, rc + 2 * HGA_HEAD, rc + HGA_REC, oc_)
            char* mo = (char*)MIX + ((mb + t2) * (unsigned)DM + (unsigned)(384 + h0 * 64 + lane_)) * 2u;
            *(f16*)mo = (f16)oa_; *(f16*)(mo + 128) = (f16)ob_; *(f16*)(mo + 256) = (f16)oc_;
            v0 = (float)n0; v1 = (float)n1; v2 = (float)n2;
        }
#undef HG_LDF
#undef HG_LDKQ
#undef HG_COMP
#undef HG_HEAD
    }
#define HG_OUT(S, j, dp) { const int bh = b * 6 + h0 + (j); store_row64_f16(HL + (((size_t)bh * NCH + c) * 64 + lane) * 64, S);     \
        DC[((size_t)bh * NCH + c) * 64 + lane] = dp; }
    HG_OUT(S0, 0, dp0) HG_OUT(S1, 1, dp1) HG_OUT(S2, 2, dp2)
#undef HG_OUT
}
__device__ __forceinline__ void phaseA(const Args& a, int l, int task, LAS unsigned char* lds, int tid) {
    asm volatile("" : "+v"(tid));
    const int lane = tid & 63, wave = __builtin_amdgcn_readfirstlane(tid >> 6);
    const int b = task / NCH, c = task % NCH;
    const f16* U = (const f16*)(a.ws + WS_U); f16* MIX = (f16*)(a.ws + WS_MIX); f16* VF = (f16*)(a.ws + WS_VF); f16* VP = (f16*)(a.ws + WS_VP);
    f16* QT = (f16*)(a.ws + WS_QT); f16* PT = (f16*)(a.ws + WS_PT); f16* RL = (f16*)(a.ws + WS_RL); float* BONG = (float*)(a.ws + WS_BON);
    if (wave < RW_H) rwkv_waveA(a, l, b, c, wave, lds + wave * RWA_BYTES, lane);
    else hgrn_waveA(a, l, b, c, 3 * (wave - RW_H), lds + RW_H * RWA_BYTES + (wave - RW_H) * HGA_BYTES, lane);
    __syncthreads();
    {
        const int ln = lane_now(); const int tid2 = wave * 64 + ln;
        const char* Ub = (const char*)U; char* MIXb = (char*)MIX; char* CA = (char*)(a.ws + WS_CA); float* LA = (float*)(a.ws + WS_LA); float* LH = (float*)(a.ws + WS_LH);
        const float* cw = a.in[18] + l * 4 * 256; const float* cb = a.in[19] + l * 256;
        const float* ba = a.in[21] + l * 256; const float* bx = a.in[23] + l * 256; const float* lam = a.in[24] + l * 256;
        const char* WAT = (const char*)(a.ws + WS_WAT) + (size_t)l * 4 * 8192; const char* WXT = (const char*)(a.ws + WS_WXT) + (size_t)l * 4 * 8192;
        LAS unsigned char* Y = lds;
        LAS float* AGG = (LAS float*)(lds + 34816);
        const unsigned mrow0 = (unsigned)(b * SEQ + c * CH);
#pragma unroll
        for (int it = 0; it < 4; ++it) { const int item = tid2 + 512 * it, tok = item >> 5, co = item & 31; const int t = c * CH + tok;
            const f32x4 b0 = *(const f32x4*)(cb + 8 * co), b1 = *(const f32x4*)(cb + 8 * co + 4);
            float y[8] = {b0[0], b0[1], b0[2], b0[3], b1[0], b1[1], b1[2], b1[3]};
#pragma unroll
            for (int jj = 0; jj < 4; ++jj) { const int ts = t - 3 + jj;
                if (ts >= 0) { const f16x8 x8 = *(const f16x8*)(Ub + ((mrow0 + (unsigned)(tok - 3 + jj)) * (unsigned)NU + (unsigned)(C_LRUX + 8 * co)) * 2u);
                    const f32x4 w0 = *(const f32x4*)(cw + jj * 256 + 8 * co), w1 = *(const f32x4*)(cw + jj * 256 + 8 * co + 4);
#pragma unroll
                    for (int i = 0; i < 8; ++i) y[i] += (i < 4 ? w0[i & 3] : w1[i & 3]) * (float)x8[i]; } }
            *(LAS f16x8*)(Y + tok * 528 + co * 16) = pack8(y); }
        __syncthreads();
        const int tl = ln & 15, fq = ln >> 4, tt = wave & 3, gp = wave >> 2;
        float Asc[32], Hsc[32];
#pragma unroll
        for (int gg = 0; gg < 2; ++gg) { const int g = 2 * gp + gg;
            f16x8 by[2];
#pragma unroll
            for (int s2 = 0; s2 < 2; ++s2) by[s2] = *(const LAS f16x8*)(Y + (16 * tt + tl) * 528 + (g * 64 + 8 * fq + 32 * s2) * 2);
#pragma unroll
            for (int nt = 0; nt < 4; ++nt) {
                f32x4 ra = (f32x4){0.f, 0.f, 0.f, 0.f}, rx = ra;
#pragma unroll
                for (int s2 = 0; s2 < 2; ++s2) { const unsigned wo = (unsigned)(g * 8192 + ((16 * nt + tl) * 64 + 8 * fq + 32 * s2) * 2);
                    ra = __builtin_amdgcn_mfma_f32_16x16x32_f16(*(const f16x8*)(WAT + wo), by[s2], ra, 0, 0, 0);
                    rx = __builtin_amdgcn_mfma_f32_16x16x32_f16(*(const f16x8*)(WXT + wo), by[s2], rx, 0, 0, 0); }
                const int ch0 = g * 64 + 16 * nt + 4 * fq;
                const f32x4 ba4 = *(const f32x4*)(ba + ch0), bx4 = *(const f32x4*)(bx + ch0), lm4 = *(const f32x4*)(lam + ch0);
                const f16x4 y4 = *(const LAS f16x4*)(Y + (16 * tt + tl) * 528 + ch0 * 2);
#pragma unroll
                for (int i = 0; i < 4; ++i) {
                    const float r = sigmoidf_(ra[i] + ba4[i]), ig = sigmoidf_(rx[i] + bx4[i]);
                    const float la = -8.0f * r * log1pf(__expf(-lm4[i]));
                    float av = __expf(la), uv = sqrtf(-expm1f(2.0f * la)) * (ig * (float)y4[i]);
#define LRU_SCAN(d) { const float ap = __builtin_bit_cast(float, __builtin_amdgcn_update_dpp(0x3f800000, __builtin_bit_cast(int, av), 0x110 + (d), 0xf, 0xf, false)); \
                      const float up = __builtin_bit_cast(float, __builtin_amdgcn_update_dpp(0, __builtin_bit_cast(int, uv), 0x110 + (d), 0xf, 0xf, false)); \
                      uv = av * up + uv; av = av * ap; }
                    LRU_SCAN(1) LRU_SCAN(2) LRU_SCAN(4) LRU_SCAN(8)
#undef LRU_SCAN
                    Asc[gg * 16 + nt * 4 + i] = av; Hsc[gg * 16 + nt * 4 + i] = uv;
                    if (tl == 15) { AGG[(tt * 256 + ch0 + i) * 2] = av; AGG[(tt * 256 + ch0 + i) * 2 + 1] = uv; }
                }
            }
        }
        __syncthreads();
        const unsigned m = mrow0 + (unsigned)(16 * tt + tl);
#pragma unroll
        for (int gg = 0; gg < 2; ++gg)
#pragma unroll
            for (int nt = 0; nt < 4; ++nt) { const int ch0 = (2 * gp + gg) * 64 + 16 * nt + 4 * fq;
                f16x4 ho, co;
#pragma unroll
                for (int i = 0; i < 4; ++i) { float cy = 0.f, cpv = 1.f;
#pragma unroll
                    for (int t3 = 0; t3 < 3; ++t3) if (t3 < tt) { const float A3 = AGG[(t3 * 256 + ch0 + i) * 2], H3 = AGG[(t3 * 256 + ch0 + i) * 2 + 1]; cy = A3 * cy + H3; cpv *= A3; }
                    const float hl = Hsc[gg * 16 + nt * 4 + i] + Asc[gg * 16 + nt * 4 + i] * cy, ca = Asc[gg * 16 + nt * 4 + i] * cpv;
                    ho[i] = (f16)hl; co[i] = (f16)ca;
                    if (tt == 3 && tl == 15) { LA[((size_t)b * NCH + c) * 256 + ch0 + i] = ca; LH[((size_t)b * NCH + c) * 256 + ch0 + i] = hl; } }
                *(f16x4*)(MIXb + (m * (unsigned)DM + 768u + (unsigned)ch0) * 2u) = ho; *(f16x4*)(CA + (m * 256u + (unsigned)ch0) * 2u) = co; }
    }
}

__device__ __forceinline__ void phaseB(const Args& a, LAS unsigned char* lds, int tid) {
    asm volatile("" : "+v"(tid));
    const int lane = tid & 63, wave = __builtin_amdgcn_readfirstlane(tid >> 6);
    const int bx = blockIdx.x;
    if (bx < 12) {
        if (wave < 4) {
            const int bh = bx, vt = wave, vl = lane & 15, fq = lane >> 4, v = 16 * vt + vl;
            const char* PT = (const char*)(a.ws + WS_PT) + (size_t)bh * NCH * 8192; char* RL = (char*)(a.ws + WS_RL) + (size_t)bh * NCH * 8192;
            f32x4 Sacc[4];
#pragma unroll
            for (int mt = 0; mt < 4; ++mt) Sacc[mt] = (f32x4){0.f, 0.f, 0.f, 0.f};
            u32x2 Af[4][2][2], Lf[4];
#define PB_LOAD(cc) { const char* pt = PT + (size_t)(cc) * 8192; const char* rl = RL + (size_t)(cc) * 8192; \
                _Pragma("unroll") for (int mt = 0; mt < 4; ++mt) { \
                    _Pragma("unroll") for (int s = 0; s < 2; ++s) { Af[mt][s][0] = *(const u32x2*)(pt + ((16 * mt + vl) * 64 + 32 * s + 4 * fq) * 2); Af[mt][s][1] = *(const u32x2*)(pt + ((16 * mt + vl) * 64 + 32 * s + 16 + 4 * fq) * 2); } \
                    Lf[mt] = *(const u32x2*)(rl + (v * 64 + 16 * mt + 4 * fq) * 2); } }
            PB_LOAD(0)
#pragma unroll 1
            for (int c = 0; c < NCH; ++c) {
                u32x2 Ac[4][2][2], Lc[4];
#pragma unroll
                for (int mt = 0; mt < 4; ++mt) { Lc[mt] = Lf[mt];
#pragma unroll
                    for (int s = 0; s < 2; ++s) { Ac[mt][s][0] = Af[mt][s][0]; Ac[mt][s][1] = Af[mt][s][1]; } }
                asm volatile("s_waitcnt vmcnt(0)" ::: "memory");
                f16x8 Bhi[2], Blo[2];
#pragma unroll
                for (int mt = 0; mt < 4; ++mt) { f16x4 hi;
#pragma unroll
                    for (int i = 0; i < 4; ++i) { hi[i] = (f16)Sacc[mt][i]; const f16 lo = (f16)(Sacc[mt][i] - (float)hi[i]); Bhi[mt >> 1][4 * (mt & 1) + i] = hi[i]; Blo[mt >> 1][4 * (mt & 1) + i] = lo; }
                    *(f16x4*)(RL + (size_t)c * 8192 + (v * 64 + 16 * mt + 4 * fq) * 2) = hi; }
                if (c + 1 < NCH) PB_LOAD(c + 1)
#pragma unroll
                for (int mt = 0; mt < 4; ++mt) {
                    const f16x4 l4 = __builtin_bit_cast(f16x4, Lc[mt]);
                    f32x4 d = (f32x4){(float)l4[0], (float)l4[1], (float)l4[2], (float)l4[3]};
#pragma unroll
                    for (int s = 0; s < 2; ++s) { u32x4 aw; aw.x = Ac[mt][s][0].x; aw.y = Ac[mt][s][0].y; aw.z = Ac[mt][s][1].x; aw.w = Ac[mt][s][1].y; const f16x8 af = __builtin_bit_cast(f16x8, aw);
                        d = __builtin_amdgcn_mfma_f32_16x16x32_f16(af, Bhi[s], d, 0, 0, 0); d = __builtin_amdgcn_mfma_f32_16x16x32_f16(af, Blo[s], d, 0, 0, 0); }
                    Sacc[mt] = d; }
            }
#undef PB_LOAD
        }
    } else if (bx < 12 + 96) {
        const int idx = (bx - 12) * NT + tid; const int bh = idx >> 12, e = idx & 4095, k = e & 63;
        f16* HL = (f16*)(a.ws + WS_HL); const float* DC = (const float*)(a.ws + WS_DC);
        float s = 0.f;
        for (int c0 = 0; c0 < NCH; c0 += 8) { float Lc[8], d[8];
#pragma unroll
            for (int j = 0; j < 8; ++j) { Lc[j] = (float)HL[((size_t)bh * NCH + c0 + j) * 4096 + e]; d[j] = DC[((size_t)bh * NCH + c0 + j) * 64 + k]; }
#pragma unroll
            for (int j = 0; j < 8; ++j) { HL[((size_t)bh * NCH + c0 + j) * 4096 + e] = (f16)s; s = d[j] * s + Lc[j]; } }
    } else if (bx == 12 + 96) {
        const int bb = tid >> 8, ch = tid & 255; const float* LA = (const float*)(a.ws + WS_LA); float* LH = (float*)(a.ws + WS_LH);
        float cy = 0.f;
        for (int c0 = 0; c0 < NCH; c0 += 8) { float A[8], H[8];
#pragma unroll
            for (int j = 0; j < 8; ++j) { const size_t o = ((size_t)bb * NCH + c0 + j) * 256 + ch; A[j] = LA[o]; H[j] = LH[o]; }
#pragma unroll
            for (int j = 0; j < 8; ++j) { const size_t o = ((size_t)bb * NCH + c0 + j) * 256 + ch; LH[o] = cy; cy = A[j] * cy + H[j]; } }
    }
}

__device__ __forceinline__ void phaseC(const Args& a, int l, int task, LAS unsigned char* lds, int tid) {
    asm volatile("" : "+v"(tid));
    const int lane = tid & 63, wave = __builtin_amdgcn_readfirstlane(tid >> 6);
    const int b = task / NCH, c = task % NCH;
    const int tl = lane & 15, fq = lane >> 4, tt = wave & 3, hg = wave >> 2;
    const unsigned m = (unsigned)(b * SEQ + c * CH + 16 * tt + tl);
    const char* U = (const char*)(a.ws + WS_U); char* MIX = (char*)(a.ws + WS_MIX); const char* VP = (const char*)(a.ws + WS_VP);
    const char* QT = (const char*)(a.ws + WS_QT); const char* RL = (const char*)(a.ws + WS_RL); const char* HL = (const char*)(a.ws + WS_HL); const float* BONG = (const float*)(a.ws + WS_BON);
    const unsigned uo = m * (unsigned)(NU * 2);
#pragma unroll 1
    for (int hh = 0; hh < 3; ++hh) {
        const int h = 3 * hg + hh; const int bh = b * RW_H + h;
        const char* sl = RL + ((size_t)bh * NCH + c) * 8192;
        f16x8 bq[2];
#pragma unroll
        for (int s = 0; s < 2; ++s) bq[s] = *(const f16x8*)(QT + (m * (unsigned)RW_W + (unsigned)(h * 64 + 8 * fq + 32 * s)) * 2u);
        f32x4 D[4];
#pragma unroll
        for (int vt = 0; vt < 4; ++vt) { const f16x4 yl = *(const f16x4*)(MIX + (m * (unsigned)DM + (unsigned)(h * 64 + 16 * vt + 4 * fq)) * 2u);
            f32x4 d = (f32x4){(float)yl[0], (float)yl[1], (float)yl[2], (float)yl[3]};
#pragma unroll
            for (int s = 0; s < 2; ++s) d = __builtin_amdgcn_mfma_f32_16x16x32_f16(*(const f16x8*)(sl + ((16 * vt + tl) * 64 + 8 * fq + 32 * s) * 2), bq[s], d, 0, 0, 0);
            D[vt] = d; }
        float sm = 0.f;
#pragma unroll
        for (int vt = 0; vt < 4; ++vt) sm += (D[vt][0] + D[vt][1]) + (D[vt][2] + D[vt][3]);
        sm += __shfl_xor(sm, 16); sm += __shfl_xor(sm, 32);
        const float mean = sm * (1.0f / 64.0f); float vr = 0.f;
#pragma unroll
        for (int vt = 0; vt < 4; ++vt)
#pragma unroll
            for (int i = 0; i < 4; ++i) { const float d = D[vt][i] - mean; vr += d * d; }
        vr += __shfl_xor(vr, 16); vr += __shfl_xor(vr, 32);
        const float rstd = 1.0f / sqrtf(vr * (1.0f / 64.0f) + 64e-5f);
        const float bon = BONG[m * 8u + (unsigned)h];
        const float* ln_w = a.in[14] + l * RW_W; const float* ln_b = a.in[15] + l * RW_W;
#pragma unroll
        for (int vt = 0; vt < 4; ++vt) { const unsigned col = (unsigned)(h * 64 + 16 * vt + 4 * fq);
            const f16x4 vp = *(const f16x4*)(VP + (m * (unsigned)RW_W + col) * 2u), z4 = *(const f16x4*)(U + uo + ((unsigned)C_RWZ + col) * 2u);
            const f32x4 lw = *(const f32x4*)(ln_w + col), lb = *(const f32x4*)(ln_b + col);
            f16x4 o;
#pragma unroll
            for (int i = 0; i < 4; ++i) o[i] = (f16)(((D[vt][i] - mean) * rstd * lw[i] + lb[i] + bon * (float)vp[i]) * siluf_((float)z4[i]));
            *(f16x4*)(MIX + (m * (unsigned)DM + col) * 2u) = o; }
    }
#pragma unroll 1
    for (int hh = 0; hh < 3; ++hh) {
        const int h = 3 * hg + hh; const int bh = b * 6 + h;
        const char* sl = HL + ((size_t)bh * NCH + c) * 8192;
        f16x8 bq[2];
#pragma unroll
        for (int s = 0; s < 2; ++s) bq[s] = *(const f16x8*)(U + uo + (unsigned)(C_HGQ + h * 64 + 8 * fq + 32 * s) * 2u);
        f32x4 D[4];
#pragma unroll
        for (int vt = 0; vt < 4; ++vt) { const f16x4 ol = *(const f16x4*)(MIX + (m * (unsigned)DM + (unsigned)(384 + h * 64 + 16 * vt + 4 * fq)) * 2u);
            f32x4 d = (f32x4){(float)ol[0], (float)ol[1], (float)ol[2], (float)ol[3]};
#pragma unroll
            for (int s = 0; s < 2; ++s) d = __builtin_amdgcn_mfma_f32_16x16x32_f16(*(const f16x8*)(sl + ((16 * vt + tl) * 64 + 8 * fq + 32 * s) * 2), bq[s], d, 0, 0, 0);
            D[vt] = d; }
        float ss = 0.f;
#pragma unroll
        for (int vt = 0; vt < 4; ++vt) ss += (D[vt][0] * D[vt][0] + D[vt][1] * D[vt][1]) + (D[vt][2] * D[vt][2] + D[vt][3] * D[vt][3]);
        ss += __shfl_xor(ss, 16); ss += __shfl_xor(ss, 32);
        const float rs = 1.0f / sqrtf(ss * (1.0f / 64.0f) + 1e-6f);
        const float* nw = a.in[17] + l * 384;
#pragma unroll
        for (int vt = 0; vt < 4; ++vt) { const unsigned col = (unsigned)(h * 64 + 16 * vt + 4 * fq);
            const f16x4 z4 = *(const f16x4*)(U + uo + ((unsigned)C_HGZ + col) * 2u); const f32x4 w4 = *(const f32x4*)(nw + col);
            f16x4 o;
#pragma unroll
            for (int i = 0; i < 4; ++i) o[i] = (f16)(D[vt][i] * rs * w4[i] * siluf_((float)z4[i]));
            *(f16x4*)(MIX + (m * (unsigned)DM + 384u + col) * 2u) = o; }
    }
    {
        const char* CA = (const char*)(a.ws + WS_CA); const float* LH = (const float*)(a.ws + WS_LH) + ((size_t)b * NCH + c) * 256;
#pragma unroll
        for (int q = 0; q < 4; ++q) { const unsigned ch0 = (unsigned)(128 * hg + 32 * fq + 8 * q);
            const f16x8 hl = *(const f16x8*)(MIX + (m * (unsigned)DM + 768u + ch0) * 2u), ca = *(const f16x8*)(CA + (m * 256u + ch0) * 2u), z8 = *(const f16x8*)(U + uo + ((unsigned)C_LRUZ + ch0) * 2u);
            const f32x4 c0 = *(const f32x4*)(LH + ch0), c1 = *(const f32x4*)(LH + ch0 + 4);
            f16x8 o;
#pragma unroll
            for (int i = 0; i < 8; ++i) o[i] = (f16)(((float)hl[i] + (float)ca[i] * (i < 4 ? c0[i & 3] : c1[i & 3])) * siluf_((float)z8[i]));
            *(f16x8*)(MIX + (m * (unsigned)DM + 768u + ch0) * 2u) = o; }
    }
}
#define XB_TMO      128
#define XB_XCNT(j)  (256  + 64 * (j))
#define XB_XSUB(j)  (1280 + 64 * (j))
#define XB_XGEN(j)  (2304 + 64 * (j))
#define XB_TOP      3328
#define XB_TOPGEN   3392
#define XCD_BAR_WORDS 3456
#define XB_SPIN_CAP (1u << 18)

__device__ __forceinline__ unsigned xb_ld(unsigned* p)              { return __hip_atomic_load(p, __ATOMIC_RELAXED, __HIP_MEMORY_SCOPE_AGENT); }
__device__ __forceinline__ unsigned xb_add(unsigned* p, unsigned v) { return __hip_atomic_fetch_add(p, v, __ATOMIC_RELAXED, __HIP_MEMORY_SCOPE_AGENT); }
__device__ __forceinline__ unsigned xb_xcc_id() { return (unsigned)__builtin_amdgcn_s_getreg((3 << 11) | 20) & 0xFu; }
#define XB_SPIN(cond, bar) do { unsigned _sp = 0; while (cond) { __builtin_amdgcn_s_sleep(1); \
    if ((++_sp & 255u) == 0u) { if (xb_ld(&(bar)[XB_TMO])) break; if (_sp > XB_SPIN_CAP) { atomicAdd(&(bar)[XB_TMO], 1u); break; } } } } while (0)

struct XcdBarrier {
    unsigned* bar; unsigned x; int isw0;
    volatile LAS unsigned* st;
};

__device__ __forceinline__ XcdBarrier xcd_barrier_post(unsigned* bar, volatile LAS unsigned* st, int isw0) {
    XcdBarrier b; b.bar = bar; b.x = xb_xcc_id(); b.st = st; b.isw0 = isw0;
    if (isw0 && lane_now() == 0) (void)xb_add(&bar[XB_XCNT(b.x)], 1u);
    return b;
}
__device__ __forceinline__ void xcd_barrier_complete(unsigned* bar, unsigned x, unsigned& nloc, unsigned& nx) {
    const unsigned G = gridDim.x * gridDim.y * gridDim.z;
    unsigned sum, cnt, mine, sp = 0u;
    for (;;) {
        sum = 0u; cnt = 0u; mine = 0u;
#pragma unroll
        for (unsigned j = 0; j < 16; ++j) { const unsigned c = xb_ld(&bar[XB_XCNT(j)]); sum += c; cnt += (c > 0u) ? 1u : 0u; mine = (j == x) ? c : mine; }
        if (sum == G) break;
        __builtin_amdgcn_s_sleep(1);
        if ((++sp & 255u) == 0u) { if (xb_ld(&bar[XB_TMO])) break; if (sp > XB_SPIN_CAP) { atomicAdd(&bar[XB_TMO], 1u); break; } }
    }
    nloc = mine > 0u ? mine : 1u; nx = cnt > 0u ? cnt : 1u;
}

__device__ __forceinline__ void xcd_barrier(const XcdBarrier& b) {
    asm volatile("s_waitcnt vmcnt(0)" ::: "memory");
    __syncthreads();
    if (b.isw0 && lane_now() == 0) {
        unsigned* bar = b.bar;
        __builtin_amdgcn_s_waitcnt(0);
        unsigned nloc = b.st[0], nx = b.st[1];
        if (nloc == 0u) { xcd_barrier_complete(bar, b.x, nloc, nx); b.st[0] = nloc; b.st[1] = nx; }
        const unsigned old = xb_add(&bar[XB_XSUB(b.x)], 1u);
        const unsigned gen = old / nloc;
        if (old + 1u == (gen + 1u) * nloc) {
            __builtin_amdgcn_fence(__ATOMIC_RELEASE, "agent");
            asm volatile("s_waitcnt vmcnt(0)" ::: "memory");
            const unsigned og = xb_add(&bar[XB_TOP], 1u);
            const unsigned tg = og / nx;
            if (og + 1u == (tg + 1u) * nx) xb_add(&bar[XB_TOPGEN], 1u);
            else XB_SPIN(xb_ld(&bar[XB_TOPGEN]) == tg, bar);
            __builtin_amdgcn_fence(__ATOMIC_ACQUIRE, "agent");
            xb_add(&bar[XB_XGEN(b.x)], 1u);
            asm volatile("s_waitcnt vmcnt(0)" ::: "memory");
        } else {
            XB_SPIN(xb_ld(&bar[XB_XGEN(b.x)]) == gen, bar);
            __builtin_amdgcn_fence(__ATOMIC_ACQUIRE, "agent");
            asm volatile("s_waitcnt vmcnt(0)" ::: "memory");
        }
    }
    __syncthreads();
}

constexpr size_t WS_BAR = 16384;
constexpr int MISC_OFF = LDS_BYTES - 16;
__global__ void __launch_bounds__(NT, 2) fwd(Args args) {
    extern __shared__ __attribute__((aligned(16))) unsigned char lds_raw[];
    LAS unsigned char* lds = (LAS unsigned char*)lds_raw;
    cg::grid_group grid = cg::this_grid();
    const int wave = __builtin_amdgcn_readfirstlane((int)threadIdx.x >> 6);
#define TID_NOW() (wave * 64 + lane_now())
    const int tid = TID_NOW(); const int lane = tid & 63;
    if (wave == 0 && lane < 4) ((LAS unsigned*)(lds + MISC_OFF))[lane] = 0u;
    __syncthreads();
    XcdBarrier xbar = xcd_barrier_post((unsigned*)(args.ws + WS_BAR), (volatile LAS unsigned*)(lds + MISC_OFF), __builtin_amdgcn_readfirstlane(wave == 0 ? 1 : 0));
#define GRID_BAR() do { XcdBarrier xb_ = xbar; asm volatile("" : "+s"(xb_.bar), "+s"(xb_.x)); xcd_barrier(xb_); } while (0)
    const int G = gridDim.x, gw = blockIdx.x * NWAVES + wave, NGW = G * NWAVES;
    unsigned char* ws = args.ws;
    unsigned short* XN = (unsigned short*)(ws + WS_XN);
    {
        LAS float* scr = (LAS float*)(lds + wave * 16384);
        constexpr int I_IN = (DM / 64) * (NIN / 32), I_OUT = (DM / 64) * (DM / 32), NITEMS = DEPTH * (I_IN + I_OUT);
        for (int it = gw; it < NITEMS; it += NGW) {
            int r = it; const int l = r / (I_IN + I_OUT); r -= l * (I_IN + I_OUT);
            if (r < I_IN) p0_transpose_item(args.in[2] + (size_t)l * DM * NIN, DM, NIN, (unsigned short*)(ws + WS_WIN + l * WIN_L), scr, r, lane);
            else p0_transpose_item(args.in[25] + (size_t)l * DM * DM, DM, DM, (unsigned short*)(ws + WS_WOUT + l * WOUT_L), scr, r - I_IN, lane);
        }
        for (int i = gw; i < DEPTH * (NU - NIN) * DM * 2 / 1024; i += NGW) { const int l = i / ((NU - NIN) * DM * 2 / 1024), r = i % ((NU - NIN) * DM * 2 / 1024);
            *(u32x4*)(ws + WS_WIN + l * WIN_L + (size_t)NIN * DM * 2 + (size_t)r * 1024 + lane * 16) = (u32x4){0u, 0u, 0u, 0u}; }
        for (int m = gw; m < M; m += NGW) rms_row_f16(args.in[0] + (size_t)m * DM, args.in[1], XN + (size_t)m * DM, lane);
        { f16* WUPT = (f16*)(ws + WS_WUPT); f16* AUPT = (f16*)(ws + WS_AUPT); f16* VDNT = (f16*)(ws + WS_VDNT); f16* VUPT = (f16*)(ws + WS_VUPT);
          for (int i = blockIdx.x * NT + tid; i < 122880; i += G * NT) {
              if (i < 49152) { const int ll = i / 24576, r = i % 24576, n = r / 64, k = r % 64; WUPT[i] = (f16)args.in[5][(size_t)ll * 24576 + k * 384 + n]; }
              else if (i < 98304) { const int i2 = i - 49152, ll = i2 / 24576, r = i2 % 24576, n = r / 64, k = r % 64; AUPT[i2] = (f16)args.in[7][(size_t)ll * 24576 + k * 384 + n]; }
              else if (i < 110592) { const int i2 = i - 98304, j2 = i2 / 384, cc = i2 % 384; VDNT[i2] = (f16)args.in[9][cc * 32 + j2]; }
              else { const int i2 = i - 110592, n = i2 / 32, j2 = i2 % 32; VUPT[i2] = (f16)args.in[10][j2 * 384 + n]; } }
          f16* WAT = (f16*)(ws + WS_WAT); f16* WXT = (f16*)(ws + WS_WXT);
          for (int i = blockIdx.x * NT + tid; i < 32768; i += G * NT) { const int lg = i >> 12, r = i & 4095, j = r >> 6, ii = r & 63; WAT[i] = (f16)args.in[20][(size_t)lg * 4096 + ii * 64 + j]; WXT[i] = (f16)args.in[22][(size_t)lg * 4096 + ii * 64 + j]; } }
    }
    grid.sync();
#pragma unroll 1
    for (int l = 0; l < DEPTH; ++l) {
        { pg8::Gemm g{XN, (const unsigned short*)(ws + WS_WIN + l * WIN_L), M, NU, DM}; pg8::StaticOrder S; S.init(M, NU, G, (int)blockIdx.x);
          pg8::EpiF16 E{(unsigned short*)(ws + WS_U), NU};
          pg8::gemm_phase<pg8::EpiF16, pg8::StaticOrder, true, true>(lds, g, S, E, wave); }
        GRID_BAR();
        for (int task = blockIdx.x; task < BATCH * NCH; task += G) phaseA(args, l, task, lds, TID_NOW());
        GRID_BAR();
        phaseB(args, lds, TID_NOW());
        GRID_BAR();
        for (int task = blockIdx.x; task < BATCH * NCH; task += G) phaseC(args, l, task, lds, TID_NOW());
        GRID_BAR();
        { pg8::Gemm g{(const unsigned short*)(ws + WS_MIX), (const unsigned short*)(ws + WS_WOUT + l * WOUT_L), M, DM, DM}; pg8::StaticOrder S; S.init(M, DM, G, (int)blockIdx.x);
          pg8::EpiRes E{l == 0 ? args.in[0] : args.out, args.out, DM};
          pg8::gemm_phase<pg8::EpiRes, pg8::StaticOrder, true, true>(lds, g, S, E, wave); }
        GRID_BAR();
        { int ln = TID_NOW() & 63; asm volatile("" : "+v"(ln));
          if (l + 1 < DEPTH) { for (int m = gw; m < M; m += NGW) rms_row_f16(args.out + (size_t)m * DM, args.in[1] + (l + 1) * DM, XN + (size_t)m * DM, ln); GRID_BAR(); }
          else { for (int m = gw; m < M; m += NGW) rms_row_f32(args.out + (size_t)m * DM, args.in[26], ln); } }
    }
}

extern "C" void kernel_launch(void* const* d_in, const int* in_sizes, int n_in, void* d_out, int out_size, void* d_ws, size_t ws_size, hipStream_t stream) {
    static int grid = 0;
    if (grid == 0) {
        if (n_in != 27 || in_sizes[0] != M * DM || out_size != M * DM || ws_size < WS_END) { fprintf(stderr, "kernel_launch: unexpected problem: n_in %d in0 %d out %d ws %zu\n", n_in, n_in > 0 ? in_sizes[0] : -1, out_size, ws_size); grid = -1; return; }
        int dev = 0, cus = 0, per_cu = 0;
        hipGetDevice(&dev); hipDeviceGetAttribute(&cus, hipDeviceAttributeMultiprocessorCount, dev);
        if (hipFuncSetAttribute((const void*)fwd, hipFuncAttributeMaxDynamicSharedMemorySize, LDS_BYTES) != hipSuccess) { fprintf(stderr, "kernel_launch: hipFuncSetAttribute failed\n"); grid = -1; return; }
        if (hipOccupancyMaxActiveBlocksPerMultiprocessor(&per_cu, (const void*)fwd, NT, LDS_BYTES) != hipSuccess || per_cu < 1) { fprintf(stderr, "kernel_launch: occupancy query failed (%d)\n", per_cu); grid = -1; return; }
        grid = cus * per_cu;
    }
    if (grid < 0) return;
    if (hipMemsetAsync((char*)d_ws, 0, 65536, stream) != hipSuccess) { fprintf(stderr, "kernel_launch: memset of the barrier words failed\n"); return; }
    Args a{};
    for (int i = 0; i < 27; ++i) a.in[i] = (const float*)d_in[i];
    a.out = (float*)d_out; a.ws = (unsigned char*)d_ws;
    void* kargs[] = {&a};
    hipError_t e = hipLaunchCooperativeKernel((const void*)fwd, dim3(grid), dim3(NT), kargs, LDS_BYTES, stream);
    if (e != hipSuccess) fprintf(stderr, "cooperative launch failed: %s (grid %d)\n", hipGetErrorString(e), grid);
}
```

```cpp
#include <hip/hip_runtime.h>
#include <hip/hip_cooperative_groups.h>
#include <cstdio>
#include <cstdint>
namespace cg = cooperative_groups;
typedef _Float16 f16x8_t __attribute__((ext_vector_type(8)));
#define MK_MFMA(a, b, c) __builtin_amdgcn_mfma_f32_16x16x32_f16(__builtin_bit_cast(f16x8_t, (a)), __builtin_bit_cast(f16x8_t, (b)), (c), 0, 0, 0)
__device__ __forceinline__ int lane_now() { int z; asm volatile("v_mbcnt_lo_u32_b32 %0, -1, 0\n\tv_mbcnt_hi_u32_b32 %0, -1, %0" : "=v"(z)); return z; }
namespace pg8 {
#define PG8_LAS __attribute__((address_space(3)))
typedef unsigned short bf16_t;
typedef short bf16x8 __attribute__((ext_vector_type(8)));
typedef float f32x4 __attribute__((ext_vector_type(4)));
typedef unsigned u32x4 __attribute__((ext_vector_type(4)));
constexpr int BM = 256, BK = 64, HALF = 128, HTB = HALF * BK * 2  , STAGE_BYTES = 8 * HTB, NXCD = 8, WGM = 8;

__host__ __device__ __forceinline__ int lds_byte(int r, int c) { const int st = (r >> 4) * 2 + (c >> 5), rr = r & 15, cc = c & 31, ob = rr * 64 + cc * 2; return st * 1024 + (ob ^ (((ob >> 9) & 1) << 5)); }
__host__ __device__ __forceinline__ void stage_rc(int b, int& R, int& C) { const int st = b / 1024, sb = b % 1024, swz = sb ^ (((sb >> 9) & 1) << 5); R = (st >> 1) * 16 + swz / 64; C = (st & 1) * 32 + (swz % 64) / 2; }
__host__ __device__ __forceinline__ int perm32(int rho) { const int n = rho >> 4, i = rho & 15; return 8 * (i >> 2) + 4 * n + (i & 3); }

struct Unit { int pm, pn; };
struct Gemm { const bf16_t* A; const bf16_t* Bt; int M, N, K; };

struct StaticOrder {
    int nM, nN, nwg, G, c;
    __host__ __device__ void init(int M, int N, int G_, int c_) { nM = M / BM; nN = N / BM; nwg = nM * nN; G = G_; c = c_; }
    __host__ __device__ bool next(int i, Unit& u) const {
        const long L = (long)i * G + c; if (L >= nwg) return false;
        int wgid = (int)L; { const int q = nwg / NXCD, r = nwg % NXCD, xcd = wgid % NXCD, off = wgid / NXCD; wgid = (xcd < r ? xcd * (q + 1) : r * (q + 1) + (xcd - r) * q) + off; }
        const int nig = WGM * nN, gid = wgid / nig, fm = gid * WGM, gsz = (nM - fm) < WGM ? (nM - fm) : WGM;
        u.pm = fm + ((wgid % nig) % gsz); u.pn = (wgid % nig) / gsz; return true;
    }
    __device__ __forceinline__ void a_ready(const Unit&) const {}
    __device__ __forceinline__ void done(const Unit&) const {}
};

__device__ __forceinline__ unsigned pk_f16(float lo, float hi) { typedef _Float16 h2 __attribute__((ext_vector_type(2))); h2 v; v.x = (_Float16)lo; v.y = (_Float16)hi; return __builtin_bit_cast(unsigned, v); }
struct EpiF16 {
    static constexpr bool PERM = true, AFTER_DRAIN = false;
    bf16_t* O; int ldc;
    __device__ __forceinline__ void operator()(const f32x4 (&acc)[2][2][4][2], const Unit& u, int wr, int wc, int fr, int fq) const {
        const int row0 = u.pm * BM + wr * 64 + fr; const int col0 = u.pn * BM + wc * 32 + 8 * fq;
#pragma unroll
        for (int ai = 0; ai < 2; ++ai)
#pragma unroll
            for (int m = 0; m < 4; ++m) { bf16_t* rowp = O + (size_t)(row0 + ai * HALF + m * 16) * ldc + col0;
#pragma unroll
                for (int bj = 0; bj < 2; ++bj) { const f32x4 v0 = acc[ai][bj][m][0], v1 = acc[ai][bj][m][1];
                    u32x4 w; w.x = pk_f16(v0[0], v0[1]); w.y = pk_f16(v0[2], v0[3]); w.z = pk_f16(v1[0], v1[1]); w.w = pk_f16(v1[2], v1[3]);
                    *(u32x4*)(rowp + bj * HALF) = w; } }
    }
};
struct EpiRes {
    static constexpr bool PERM = false, AFTER_DRAIN = false;
    const float* base; float* out; int ldc;
    __device__ __forceinline__ void operator()(const f32x4 (&acc)[2][2][4][2], const Unit& u, int wr, int wc, int fr, int fq) const {
        const int row0 = u.pm * BM + wr * 64 + fr; const int col0 = u.pn * BM + wc * 32 + 4 * fq;
#pragma unroll
        for (int ai = 0; ai < 2; ++ai)
#pragma unroll
            for (int m = 0; m < 4; ++m) { const size_t off = (size_t)(row0 + ai * HALF + m * 16) * ldc + col0;
#pragma unroll
                for (int bj = 0; bj < 2; ++bj)
#pragma unroll
                    for (int n = 0; n < 2; ++n) { const size_t o = off + bj * HALF + n * 16; const f32x4 b = *(const f32x4*)(base + o); *(f32x4*)(out + o) = b + acc[ai][bj][m][n]; }
                asm volatile("" ::: "memory"); }
    }
};

template <class Epi, class Sched, bool ALIGN_EPI = false, bool SP2 = false>
__device__ __forceinline__ void gemm_phase(PG8_LAS unsigned char* lds, const Gemm g, const Sched& S, const Epi& E, const int wave_) {
    int wv_ = wave_; asm volatile("" : "+s"(wv_)); int tid_ = lane_now() + 64 * wv_; const int tid = tid_, wid = wv_, lane = tid & 63, wr = wid >> 2, wc = wid & 3, fr = lane & 15, fq = lane >> 4;
    const int K = g.K, nt = K / BK;
    unsigned voffA[2], voffB[2];
#pragma unroll
    for (int i = 0; i < 2; ++i) { int R, C; stage_rc(tid * 16 + i * 8192, R, C); const int Rb = Epi::PERM ? ((R & ~31) + perm32(R & 31)) : R;
        voffA[i] = (unsigned)(R * K + C) * 2u; voffB[i] = (unsigned)(Rb * K + C) * 2u; }
    const size_t kstep = (size_t)(BK * 2);
    const size_t hstep = (size_t)HALF * K * 2;
    const size_t tstep = 2 * hstep;
    const unsigned ldsw = (unsigned)wid * 1024u;
    const int aoff = lds_byte(wr * 64 + fr, fq * 8), boff = lds_byte(wc * 32 + fr, fq * 8);
#define PG8_SA(b, h) (((b) * 2 + (h)) * HTB)
#define PG8_SB(b, h) ((4 + (b) * 2 + (h)) * HTB)
#define PG8_STAGE(bufoff, gbase, voff) do { _Pragma("unroll") for (int _i = 0; _i < 2; ++_i) \
        __builtin_amdgcn_global_load_lds((const unsigned*)((const char*)(gbase) + (voff)[_i]), (PG8_LAS unsigned*)(lds + (bufoff) + ldsw + _i * 8192), 16, 0, 0); } while (0)
#define PG8_LDA(dst, b, h) do { _Pragma("unroll") for (int m = 0; m < 4; ++m) _Pragma("unroll") for (int k = 0; k < 2; ++k) dst[m][k] = *(const PG8_LAS bf16x8*)(lds + PG8_SA(b, h) + aoff + m * 2048 + k * 1024); } while (0)
#define PG8_LDB(dst, b, h) do { _Pragma("unroll") for (int n = 0; n < 2; ++n) _Pragma("unroll") for (int k = 0; k < 2; ++k) dst[n][k] = *(const PG8_LAS bf16x8*)(lds + PG8_SB(b, h) + boff + n * 2048 + k * 1024); } while (0)
#define PG8_MMA(ai, bj, At, Bt) do { __builtin_amdgcn_s_setprio(1); _Pragma("unroll") for (int m = 0; m < 4; ++m) _Pragma("unroll") for (int n = 0; n < 2; ++n) _Pragma("unroll") for (int k = 0; k < 2; ++k) \
        acc[ai][bj][m][n] = MK_MFMA(Bt[n][k], At[m][k], acc[ai][bj][m][n]); __builtin_amdgcn_s_setprio(0); } while (0)
#define PG8_WAIT_V(n) asm volatile("s_waitcnt vmcnt(" #n ")" ::: "memory")
#define PG8_WAIT_L(n) asm volatile("s_waitcnt lgkmcnt(" #n ")" ::: "memory")
#define PG8_BAR __builtin_amdgcn_s_barrier()
#define PG8_SCHED __builtin_amdgcn_sched_barrier(0)
    Unit cur, nxt; int ui = 0;
    if (!S.next(0, cur)) return;
    f32x4 acc[2][2][4][2];
#pragma unroll
    for (int a = 0; a < 2; ++a)
#pragma unroll
        for (int b = 0; b < 2; ++b)
#pragma unroll
            for (int m = 0; m < 4; ++m)
#pragma unroll
                for (int n = 0; n < 2; ++n) acc[a][b][m][n] = (f32x4){0.f, 0.f, 0.f, 0.f};
    bf16x8 At[4][2], B0[2][2], B1[2][2];
    const char* cA = (const char*)g.A + (size_t)cur.pm * tstep; const char* cB = (const char*)g.Bt + (size_t)cur.pn * tstep;
    S.a_ready(cur);
    if constexpr (SP2) {
        PG8_STAGE(PG8_SB(0, 0), cB, voffB); PG8_STAGE(PG8_SB(0, 1), cB + hstep, voffB); PG8_STAGE(PG8_SA(0, 0), cA, voffA); PG8_STAGE(PG8_SA(0, 1), cA + hstep, voffA);
        if (wr == 1) PG8_BAR;
        PG8_WAIT_V(2); PG8_BAR;
        PG8_STAGE(PG8_SB(1, 0), cB + kstep, voffB); PG8_STAGE(PG8_SA(1, 0), cA + kstep, voffA); PG8_STAGE(PG8_SB(1, 1), cB + hstep + kstep, voffB);
        PG8_WAIT_V(6); PG8_BAR;
    } else {
        PG8_STAGE(PG8_SB(0, 0), cB, voffB); PG8_STAGE(PG8_SA(0, 0), cA, voffA); PG8_STAGE(PG8_SB(0, 1), cB + hstep, voffB); PG8_STAGE(PG8_SA(0, 1), cA + hstep, voffA);
        if (wr == 1) PG8_BAR;
        PG8_WAIT_V(4); PG8_BAR;
        PG8_STAGE(PG8_SB(1, 0), cB + kstep, voffB); PG8_STAGE(PG8_SA(1, 0), cA + kstep, voffA); PG8_STAGE(PG8_SB(1, 1), cB + hstep + kstep, voffB);
        PG8_WAIT_V(6); PG8_BAR;
    }
    for (;;) {
        const bool has_next = S.next(ui + 1, nxt);
        const char* nA = has_next ? (const char*)g.A + (size_t)nxt.pm * tstep : cA; const char* nB = has_next ? (const char*)g.Bt + (size_t)nxt.pn * tstep : cB;
        for (int t = 0; t < nt; t += 2) {
            const bool last = (t == nt - 2);
            const char* a1 = cA + (size_t)(t + 1) * kstep;
            const char* a2 = last ? nA : cA + (size_t)(t + 2) * kstep; const char* b2 = last ? nB : cB + (size_t)(t + 2) * kstep;
            const char* a3 = a2 + kstep; const char* b3 = b2 + kstep;
            if (last && has_next) S.a_ready(nxt);
            if constexpr (SP2) {
            PG8_LDB(B0, 0, 0); PG8_LDB(B1, 0, 1); PG8_SCHED; PG8_LDA(At, 0, 0); PG8_STAGE(PG8_SA(1, 1), a1 + hstep, voffA);
            PG8_WAIT_V(8); PG8_WAIT_L(0); PG8_BAR; PG8_MMA(0, 0, At, B0); PG8_MMA(0, 1, At, B1); PG8_BAR; PG8_SCHED;
            PG8_LDA(At, 0, 1); PG8_STAGE(PG8_SB(0, 0), b2, voffB); PG8_STAGE(PG8_SB(0, 1), b2 + hstep, voffB); PG8_STAGE(PG8_SA(0, 0), a2, voffA);
            PG8_WAIT_V(8); PG8_WAIT_L(0); PG8_BAR; PG8_MMA(1, 0, At, B0); PG8_MMA(1, 1, At, B1); PG8_BAR; PG8_SCHED;
            PG8_LDB(B0, 1, 0); PG8_LDB(B1, 1, 1); PG8_SCHED; PG8_LDA(At, 1, 0); PG8_STAGE(PG8_SA(0, 1), a2 + hstep, voffA);
            PG8_WAIT_V(8); PG8_WAIT_L(0); PG8_BAR; PG8_MMA(0, 0, At, B0); PG8_MMA(0, 1, At, B1); PG8_BAR; PG8_SCHED;
            PG8_LDA(At, 1, 1); PG8_STAGE(PG8_SB(1, 0), b3, voffB); PG8_STAGE(PG8_SB(1, 1), b3 + hstep, voffB); PG8_STAGE(PG8_SA(1, 0), a3, voffA);
            PG8_WAIT_V(8); PG8_WAIT_L(0); PG8_BAR; PG8_MMA(1, 0, At, B0); PG8_MMA(1, 1, At, B1); PG8_BAR; PG8_SCHED;
            } else {
            PG8_LDB(B0, 0, 0); PG8_SCHED; PG8_LDA(At, 0, 0); PG8_STAGE(PG8_SA(1, 1), a1 + hstep, voffA);
            PG8_WAIT_L(8); PG8_BAR; PG8_WAIT_L(0); PG8_MMA(0, 0, At, B0); PG8_BAR; PG8_SCHED;
            PG8_LDB(B1, 0, 1); PG8_STAGE(PG8_SB(0, 0), b2, voffB);
            PG8_BAR; PG8_WAIT_L(0); PG8_MMA(0, 1, At, B1); PG8_BAR;
            PG8_LDA(At, 0, 1); PG8_STAGE(PG8_SA(0, 0), a2, voffA);
            PG8_BAR; PG8_WAIT_L(0); PG8_MMA(1, 0, At, B0); PG8_BAR; PG8_SCHED;
            PG8_STAGE(PG8_SB(0, 1), b2 + hstep, voffB);
            PG8_WAIT_V(6); PG8_BAR; PG8_MMA(1, 1, At, B1); PG8_BAR;
            PG8_LDB(B0, 1, 0); PG8_SCHED; PG8_LDA(At, 1, 0); PG8_STAGE(PG8_SA(0, 1), a2 + hstep, voffA);
            PG8_WAIT_L(8); PG8_BAR; PG8_WAIT_L(0); PG8_MMA(0, 0, At, B0); PG8_BAR; PG8_SCHED;
            PG8_LDB(B1, 1, 1); PG8_STAGE(PG8_SB(1, 0), b3, voffB);
            PG8_BAR; PG8_WAIT_L(0); PG8_MMA(0, 1, At, B1); PG8_BAR;
            PG8_LDA(At, 1, 1); PG8_STAGE(PG8_SA(1, 0), a3, voffA);
            PG8_BAR; PG8_WAIT_L(0); PG8_MMA(1, 0, At, B0); PG8_BAR; PG8_SCHED;
            PG8_STAGE(PG8_SB(1, 1), b3 + hstep, voffB);
            PG8_WAIT_V(6); PG8_BAR; PG8_MMA(1, 1, At, B1); PG8_BAR;
            }
        }
        if constexpr (ALIGN_EPI) { if (wr == 0) PG8_BAR; }
        if constexpr (!Epi::AFTER_DRAIN) { E(acc, cur, wr, wc, fr, fq); S.done(cur); }
        if (!has_next) break;
#pragma unroll
        for (int a = 0; a < 2; ++a)
#pragma unroll
            for (int b = 0; b < 2; ++b)
#pragma unroll
                for (int m = 0; m < 4; ++m)
#pragma unroll
                    for (int n = 0; n < 2; ++n) acc[a][b][m][n] = (f32x4){0.f, 0.f, 0.f, 0.f};
        cur = nxt; cA = nA; cB = nB; ++ui;
        if constexpr (ALIGN_EPI) { if (wr == 1) PG8_BAR; }
    }
    PG8_WAIT_V(0);
    if constexpr (!ALIGN_EPI) { if (wr == 0) PG8_BAR; }
    PG8_BAR;
    if constexpr (Epi::AFTER_DRAIN) { E.fused(acc, cur, wr, wc, fr, fq, lds, wid, lane); S.done(cur); }
#undef PG8_SA
#undef PG8_SB
#undef PG8_STAGE
#undef PG8_LDA
#undef PG8_LDB
#undef PG8_MMA
#undef PG8_WAIT_V
#undef PG8_WAIT_L
#undef PG8_BAR
#undef PG8_SCHED
}
}

constexpr int BATCH = 2, SEQ = 8192, DM = 1024, DEPTH = 2, M = BATCH * SEQ;
constexpr int RW_H = 6, HD = 64, RW_W = 384, RW_SHIFT = 1280;
constexpr int NIN = 3712, NU = 3840;
constexpr int C_R = 0, C_K = 384, C_V = 768, C_WL = 1152, C_AL = 1216, C_RWZ = 1280, C_HGQ = 1664, C_HGF = 2048, C_HGI = 2432, C_HGZ = 2816, C_LRUX = 3200, C_LRUZ = 3456;
constexpr int CH = 64;
constexpr int NWAVES = 8, NT = NWAVES * 64;
constexpr int LDS_BYTES = 147456;
constexpr size_t MiB = 1u << 20;
constexpr size_t WS_WUPT = 65536, WS_AUPT = WS_WUPT + 98304, WS_VDNT = WS_AUPT + 98304, WS_VUPT = WS_VDNT + 24576, WS_WAT = WS_VUPT + 24576, WS_WXT = WS_WAT + 65536;
constexpr size_t WS_WIN = 1 * MiB, WIN_L = (size_t)NU * DM * 2;
constexpr size_t WS_WOUT = 16 * MiB, WOUT_L = (size_t)DM * DM * 2;
constexpr size_t WS_XN = 20 * MiB;
constexpr size_t WS_QT = 20 * MiB;
constexpr size_t WS_PT = 32 * MiB;
constexpr size_t WS_CA = 44 * MiB;
constexpr size_t WS_U = 52 * MiB;
constexpr size_t WS_MIX = 172 * MiB;
constexpr size_t WS_VF = 204 * MiB;
constexpr size_t WS_VP = 216 * MiB;
constexpr size_t WS_RL = 228 * MiB;
constexpr size_t WS_HL = 240 * MiB;
constexpr size_t WS_BON = 252 * MiB;
constexpr size_t WS_DC = WS_BON + 512 * 1024;
constexpr size_t WS_LA = WS_DC + 512 * 1024;
constexpr size_t WS_LH = WS_LA + 256 * 1024;
constexpr size_t WS_END = 254 * MiB;
constexpr int NCH = SEQ / CH;

#define LAS __attribute__((address_space(3)))
typedef float f32x4 __attribute__((ext_vector_type(4)));
typedef unsigned u32x2 __attribute__((ext_vector_type(2)));
typedef unsigned u32x4 __attribute__((ext_vector_type(4)));
typedef _Float16 f16;
typedef _Float16 f16x8 __attribute__((ext_vector_type(8)));
#define LDS_WAIT() asm volatile("s_waitcnt lgkmcnt(0)" ::: "memory")

struct Args { const float* in[27]; float* out; unsigned char* ws; };

__device__ __forceinline__ float wave_sum(float v) {
#pragma unroll
    for (int o = 1; o < 64; o <<= 1) v += __shfl_xor(v, o);
    return v;
}
__device__ __forceinline__ float sigmoidf_(float x) { return 1.0f / (1.0f + __expf(-x)); }
__device__ __forceinline__ float siluf_(float x) { return x / (1.0f + __expf(-x)); }

__device__ __forceinline__ void p0_transpose_item(const float* W, int K, int N, unsigned short* WT, LAS float* scr, int item, int lane) {
    const int nblk = N / 32, kb = item / nblk, nb = item % nblk, k0 = 64 * kb, n0 = 32 * nb;
#pragma unroll 8
    for (int i = 0; i < 32; ++i) { const int kk = 2 * i + (lane >> 5); scr[kk * 33 + (lane & 31)] = W[(size_t)(k0 + kk) * N + n0 + (lane & 31)]; }
    LDS_WAIT(); asm volatile("" ::: "memory");
    const int c = lane & 7;
#pragma unroll
    for (int j = 0; j < 4; ++j) { const int n = (lane >> 3) + 8 * j; const LAS float* s = scr + (8 * c) * 33 + n;
        u32x4 o; o.x = pg8::pk_f16(s[0 * 33], s[1 * 33]); o.y = pg8::pk_f16(s[2 * 33], s[3 * 33]); o.z = pg8::pk_f16(s[4 * 33], s[5 * 33]); o.w = pg8::pk_f16(s[6 * 33], s[7 * 33]);
        *(u32x4*)(WT + (size_t)(n0 + n) * K + k0 + 8 * c) = o; }
    LDS_WAIT(); asm volatile("" ::: "memory");
}
__device__ __forceinline__ void rms_row_f16(const float* xrow, const float* w, unsigned short* orow, int lane) {
    const f32x4* xr = (const f32x4*)xrow + lane; const f32x4* wr = (const f32x4*)w + lane;
    f32x4 v[4]; float s = 0.f;
#pragma unroll
    for (int j = 0; j < 4; ++j) { v[j] = xr[64 * j]; s += (v[j].x * v[j].x + v[j].y * v[j].y) + (v[j].z * v[j].z + v[j].w * v[j].w); }
    const float rs = 1.0f / sqrtf(wave_sum(s) * (1.0f / DM) + 1e-6f);
    u32x2* o8 = (u32x2*)orow + lane;
#pragma unroll
    for (int j = 0; j < 4; ++j) { const f32x4 ww = wr[64 * j]; u32x2 o; o.x = pg8::pk_f16(v[j].x * rs * ww.x, v[j].y * rs * ww.y); o.y = pg8::pk_f16(v[j].z * rs * ww.z, v[j].w * rs * ww.w); o8[64 * j] = o; }
}
__device__ __forceinline__ void rms_row_f32(float* xrow, const float* w, int lane) {
    f32x4* xr = (f32x4*)xrow + lane; const f32x4* wr = (const f32x4*)w + lane;
    f32x4 v[4]; float s = 0.f;
#pragma unroll
    for (int j = 0; j < 4; ++j) { v[j] = xr[64 * j]; s += (v[j].x * v[j].x + v[j].y * v[j].y) + (v[j].z * v[j].z + v[j].w * v[j].w); }
    const float rs = 1.0f / sqrtf(wave_sum(s) * (1.0f / DM) + 1e-6f);
#pragma unroll
    for (int j = 0; j < 4; ++j) { const f32x4 ww = wr[64 * j]; xr[64 * j] = v[j] * rs * ww; }
}


#define SHV(col) ({ const float cur_ = (float)urow[(col)]; const float prev_ = hp ? (float)prow[(col)] : 0.f; cur_ + mu[(col)] * (prev_ - cur_); })

__device__ __forceinline__ void store_row64_f16(f16* dst, const float (&S)[64]) {
#pragma unroll
    for (int q = 0; q < 8; ++q) { u32x4 w; w.x = pg8::pk_f16(S[8 * q], S[8 * q + 1]); w.y = pg8::pk_f16(S[8 * q + 2], S[8 * q + 3]); w.z = pg8::pk_f16(S[8 * q + 4], S[8 * q + 5]); w.w = pg8::pk_f16(S[8 * q + 6], S[8 * q + 7]); *(u32x4*)(dst + 8 * q) = w; }
}


constexpr int RWA_REC = 768, RWA_VPL = 16 * RWA_REC, RWA_SCR = RWA_VPL + 2048, RWA_BYTES = RWA_SCR + 1024;
typedef float f32x2 __attribute__((ext_vector_type(2)));
typedef _Float16 f16x4 __attribute__((ext_vector_type(4)));
__device__ __forceinline__ float fmix_lo(float a, unsigned b, float c) { float d; asm("v_fma_mix_f32 %0, %1, %2, %3 op_sel:[0,0,0] op_sel_hi:[0,1,0]" : "=v"(d) : "v"(a), "v"(b), "v"(c)); return d; }
__device__ __forceinline__ float fmix_hi(float a, unsigned b, float c) { float d; asm("v_fma_mix_f32 %0, %1, %2, %3 op_sel:[0,1,0] op_sel_hi:[0,1,0]" : "=v"(d) : "v"(a), "v"(b), "v"(c)); return d; }
__device__ __forceinline__ float mmix_lo(float a, unsigned b) { float d; asm("v_fma_mix_f32 %0, %1, %2, 0 op_sel:[0,0,0] op_sel_hi:[0,1,0]" : "=v"(d) : "v"(a), "v"(b)); return d; }
__device__ __forceinline__ float mmix_hi(float a, unsigned b) { float d; asm("v_fma_mix_f32 %0, %1, %2, 0 op_sel:[0,1,0] op_sel_hi:[0,1,0]" : "=v"(d) : "v"(a), "v"(b)); return d; }
__device__ __forceinline__ float fma_asm(float a, float b, float c) { float d; asm("v_fma_f32 %0, %1, %2, %3" : "=v"(d) : "v"(a), "v"(b), "v"(c)); return d; }
#define FMIX(a, u, j, c) (((j) & 1) ? fmix_hi((a), (u)[(j) >> 1], (c)) : fmix_lo((a), (u)[(j) >> 1], (c)))
#define MMIX(a, u, j) (((j) & 1) ? mmix_hi((a), (u)[(j) >> 1]) : mmix_lo((a), (u)[(j) >> 1]))
__device__ __forceinline__ float fast_tanh(float x) { return 1.0f - 2.0f / (__expf(2.0f * x) + 1.0f); }
__device__ __forceinline__ void lerp8(const char* ub, unsigned uo, unsigned po, bool hp, const char* mub, unsigned col, float (&x)[8]) {
    const f16x8 cu = *(const f16x8*)(ub + (uo + col * 2u)); f16x8 pv = *(const f16x8*)(ub + (po + col * 2u)); const f32x4 m0 = *(const f32x4*)(mub + col * 4u), m1 = *(const f32x4*)(mub + col * 4u + 16u);
#pragma unroll
    for (int j = 0; j < 8; ++j) { const float c = (float)cu[j], p = hp ? (float)pv[j] : 0.f; x[j] = c + (j < 4 ? m0[j] : m1[j - 4]) * (p - c); }
}
__device__ __forceinline__ void lerp4(const char* ub, unsigned uo, unsigned po, bool hp, const char* mub, unsigned col, float (&x)[4]) {
    const f16x4 cu = *(const f16x4*)(ub + (uo + col * 2u)); f16x4 pv = *(const f16x4*)(ub + (po + col * 2u)); const f32x4 m0 = *(const f32x4*)(mub + col * 4u);
#pragma unroll
    for (int j = 0; j < 4; ++j) { const float c = (float)cu[j], p = hp ? (float)pv[j] : 0.f; x[j] = c + m0[j] * (p - c); }
}
__device__ __forceinline__ f16x8 pack8(const float (&x)[8]) { f16x8 r;
#pragma unroll
    for (int j = 0; j < 8; ++j) r[j] = (f16)x[j];
    return r; }

__device__ __forceinline__ void rwkv_waveA(const Args& a, int l, int b, int c, int h, LAS unsigned char* wl, int lane) {
    const f16* U = (const f16*)(a.ws + WS_U); f16* MIX = (f16*)(a.ws + WS_MIX); f16* VF = (f16*)(a.ws + WS_VF); f16* VP = (f16*)(a.ws + WS_VP);
    f16* QT = (f16*)(a.ws + WS_QT); f16* PT = (f16*)(a.ws + WS_PT); f16* RL = (f16*)(a.ws + WS_RL); float* BONG = (float*)(a.ws + WS_BON);
    const f16* WUPT = (const f16*)(a.ws + WS_WUPT) + (size_t)l * 384 * 64; const f16* AUPT = (const f16*)(a.ws + WS_AUPT) + (size_t)l * 384 * 64;
    const f16* VDNT = (const f16*)(a.ws + WS_VDNT); const f16* VUPT = (const f16*)(a.ws + WS_VUPT);
    const float* mu = a.in[3] + l * RW_SHIFT; const float* w0 = a.in[4] + l * RW_W; const float* a0 = a.in[6] + l * RW_W; const float* v0 = a.in[8];
    const float* k_k = a.in[11] + l * RW_W; const float* k_a = a.in[12] + l * RW_W; const float* r_k = a.in[13] + l * RW_W;
    const int bh = b * RW_H + h;
    float P[64], L[64];
#pragma unroll
    for (int k = 0; k < 64; ++k) { P[k] = (k == lane) ? 1.f : 0.f; L[k] = 0.f; }
#pragma unroll 1
    for (int blk = 0; blk < 4; ++blk) {
        int lane_ = lane; asm volatile("" : "+v"(lane_));
        const int tok = lane_ & 15, fq = lane_ >> 4;
        const int t = c * CH + blk * 16 + tok; const unsigned m = (unsigned)(b * SEQ + t); const bool hp = t > 0;
        const char* ub = (const char*)U; const char* mub = (const char*)mu; const unsigned uo = m * (unsigned)(NU * 2), po = hp ? uo - (unsigned)(NU * 2) : uo;
        f16x8 bW[2], bA[2], bVD;
#pragma unroll
        for (int s = 0; s < 2; ++s) {
            float x[8]; lerp8(ub, uo, po, hp, mub, (unsigned)(C_WL + 8 * fq + 32 * s), x);
#pragma unroll
            for (int j = 0; j < 8; ++j) x[j] = fast_tanh(x[j]);
            bW[s] = pack8(x);
            lerp8(ub, uo, po, hp, mub, (unsigned)(C_AL + 8 * fq + 32 * s), x);
            bA[s] = pack8(x);
            asm volatile("" ::: "memory");
        }
        if (l > 0) {
            f32x4 VD0 = (f32x4){0.f, 0.f, 0.f, 0.f}, VD1 = VD0;
#pragma unroll 1
            for (int s = 0; s < 12; ++s) {
                float x[8]; lerp8(ub, uo, po, hp, mub, (unsigned)(C_V + 8 * fq + 32 * s), x);
                const f16x8 bv = pack8(x);
                VD0 = __builtin_amdgcn_mfma_f32_16x16x32_f16(*(const f16x8*)((const char*)VDNT + (unsigned)(tok * 384 + 8 * fq + 32 * s) * 2u), bv, VD0, 0, 0, 0);
                VD1 = __builtin_amdgcn_mfma_f32_16x16x32_f16(*(const f16x8*)((const char*)VDNT + (unsigned)((16 + tok) * 384 + 8 * fq + 32 * s) * 2u), bv, VD1, 0, 0, 0);
            }
            LAS f16* scr = (LAS f16*)(wl + RWA_SCR);
            { f16x4 p0, p1;
#pragma unroll
              for (int i = 0; i < 4; ++i) { p0[i] = (f16)VD0[i]; p1[i] = (f16)VD1[i]; }
              *(LAS f16x4*)(scr + tok * 32 + 4 * fq) = p0; *(LAS f16x4*)(scr + tok * 32 + 16 + 4 * fq) = p1; }
            asm volatile("s_waitcnt lgkmcnt(0)" ::: "memory");
            bVD = *(const LAS f16x8*)(scr + tok * 32 + 8 * fq);
        }
        float ssq = 0.f;
#pragma unroll 1
        for (int nt = 0; nt < 4; ++nt) { const int cb = h * 64 + 16 * nt + 4 * fq; float ks[4]; lerp4(ub, uo, po, hp, mub, (unsigned)(C_K + cb), ks); const f32x4 kk4 = *(const f32x4*)((const char*)k_k + (unsigned)cb * 4u);
#pragma unroll
            for (int i = 0; i < 4; ++i) { const float kv = ks[i] * kk4[i]; ssq += kv * kv; }
            asm volatile("" ::: "memory"); }
        ssq += __shfl_xor(ssq, 16); ssq += __shfl_xor(ssq, 32);
        const float inv = 1.0f / fmaxf(sqrtf(ssq), 1e-12f);
        float bon = 0.f;
        LAS unsigned char* rec = wl + tok * RWA_REC;
#pragma unroll 1
        for (int nt = 0; nt < 4; ++nt) {
            const int cb = h * 64 + 16 * nt + 4 * fq, co = 16 * nt + 4 * fq; const int n = h * 64 + 16 * nt + tok;
            f32x4 DWn = (f32x4){0.f, 0.f, 0.f, 0.f}, DAn = DWn, Gn = DWn;
#pragma unroll
            for (int s = 0; s < 2; ++s) {
                DWn = __builtin_amdgcn_mfma_f32_16x16x32_f16(*(const f16x8*)((const char*)WUPT + (unsigned)(n * 64 + 8 * fq + 32 * s) * 2u), bW[s], DWn, 0, 0, 0);
                DAn = __builtin_amdgcn_mfma_f32_16x16x32_f16(*(const f16x8*)((const char*)AUPT + (unsigned)(n * 64 + 8 * fq + 32 * s) * 2u), bA[s], DAn, 0, 0, 0); }
            if (l > 0) Gn = __builtin_amdgcn_mfma_f32_16x16x32_f16(*(const f16x8*)((const char*)VUPT + (unsigned)(n * 32 + 8 * fq) * 2u), bVD, Gn, 0, 0, 0);
            float rs[4], ks[4], vs[4];
            lerp4(ub, uo, po, hp, mub, (unsigned)(C_R + cb), rs); lerp4(ub, uo, po, hp, mub, (unsigned)(C_K + cb), ks); lerp4(ub, uo, po, hp, mub, (unsigned)(C_V + cb), vs);
            const unsigned cb4 = (unsigned)cb * 4u; const f32x4 w04 = *(const f32x4*)((const char*)w0 + cb4), a04 = *(const f32x4*)((const char*)a0 + cb4), kk4 = *(const f32x4*)((const char*)k_k + cb4), ka4 = *(const f32x4*)((const char*)k_a + cb4), rk4 = *(const f32x4*)((const char*)r_k + cb4);
            f32x4 wv; f16x4 al, be, km, rr, vo;
            f16x4 vf4; f32x4 v04;
            const unsigned vo_b = (m * (unsigned)RW_W + (unsigned)cb) * 2u;
            if (l > 0) { vf4 = *(const f16x4*)((const char*)VF + vo_b); v04 = *(const f32x4*)((const char*)v0 + cb4); }
#pragma unroll
            for (int i = 0; i < 4; ++i) {
                wv[i] = __expf(-0.6065306597126334f * sigmoidf_(w04[i] + DWn[i]));
                const float aa = sigmoidf_(a04[i] + DAn[i]);
                float vv = vs[i];
                if (l > 0) vv = vs[i] + ((float)vf4[i] - vs[i]) * sigmoidf_(v04[i] + Gn[i]);
                const float kk = ks[i] * kk4[i] * inv;
                const float kmod = ks[i] * (1.0f + (aa - 1.0f) * ka4[i]);
                bon += rs[i] * kmod * rk4[i];
                al[i] = (f16)(-kk); be[i] = (f16)(kk * aa); km[i] = (f16)kmod; rr[i] = (f16)rs[i]; vo[i] = (f16)vv;
            }
            *(LAS f32x4*)(rec + co * 4) = wv;
            *(LAS f16x4*)(rec + 256 + co * 2) = al; *(LAS f16x4*)(rec + 384 + co * 2) = be; *(LAS f16x4*)(rec + 512 + co * 2) = km; *(LAS f16x4*)(rec + 640 + co * 2) = rr;
            *(LAS f16x4*)(wl + RWA_VPL + tok * 128 + co * 2) = vo;
            *(f16x4*)((char*)VP + vo_b) = vo;
            if (l == 0) *(f16x4*)((char*)VF + vo_b) = vo;
            asm volatile("" ::: "memory");
        }
        bon += __shfl_xor(bon, 16); bon += __shfl_xor(bon, 32);
        if (fq == 0) *(float*)((char*)BONG + (m * 8u + (unsigned)h) * 4u) = bon;
        const unsigned mb = (unsigned)(b * SEQ + c * CH + blk * 16);
        asm volatile("s_waitcnt lgkmcnt(0)" ::: "memory");
        u32x4 A[8];
#pragma unroll
        for (int g = 0; g < 8; ++g) A[g] = *(const LAS u32x4*)(wl + 256 + g * 16);
        float vv = (float)*(const LAS f16*)(wl + RWA_VPL + lane_ * 2);
#define RW_LDU(WA, WB, B4, K4, R4, g) { WA = *(const LAS f32x4*)(rc + (g) * 32); WB = *(const LAS f32x4*)(rc + (g) * 32 + 16); B4 = *(const LAS u32x4*)(rc + 384 + (g) * 16); K4 = *(const LAS u32x4*)(rc + 512 + (g) * 16); R4 = *(const LAS u32x4*)(rc + 640 + (g) * 16); }
#define RW_COMP(WA, WB, B4, K4, R4, g) { float tP[8], tL[8]; \
            _Pragma("unroll") for (int j = 0; j < 8; ++j) tP[j] = MMIX(saP, B4, j); \
            _Pragma("unroll") for (int j = 0; j < 8; ++j) tL[j] = MMIX(saL, B4, j); \
            _Pragma("unroll") for (int j = 0; j < 8; ++j) tL[j] = FMIX(vv, K4, j, tL[j]); \
            _Pragma("unroll") for (int j = 0; j < 8; ++j) P[8 * (g) + j] = fma_asm(P[8 * (g) + j], (j < 4) ? WA[j & 3] : WB[j & 3], tP[j]); \
            _Pragma("unroll") for (int j = 0; j < 8; ++j) L[8 * (g) + j] = fma_asm(L[8 * (g) + j], (j < 4) ? WA[j & 3] : WB[j & 3], tL[j]); \
            _Pragma("unroll") for (int j = 0; j < 8; ++j) qa[j] = FMIX(P[8 * (g) + j], R4, j, qa[j]); \
            _Pragma("unroll") for (int j = 0; j < 8; ++j) ya[j] = FMIX(L[8 * (g) + j], R4, j, ya[j]); }
#pragma unroll 1
        for (int t2 = 0; t2 < 16; ++t2) {
            const LAS unsigned char* rc = wl + t2 * RWA_REC;
            f32x4 wAe, wBe, wAo, wBo; u32x4 be, ke, re, bo, ko, ro;
            RW_LDU(wAe, wBe, be, ke, re, 0)
            float sP[8], sL[8];
#pragma unroll
            for (int j = 0; j < 8; ++j) { sP[j] = 0.f; sL[j] = 0.f; }
#pragma unroll
            for (int g = 0; g < 8; ++g) {
#pragma unroll
                for (int j = 0; j < 8; ++j) sP[j] = FMIX(P[8 * g + j], A[g], j, sP[j]);
#pragma unroll
                for (int j = 0; j < 8; ++j) sL[j] = FMIX(L[8 * g + j], A[g], j, sL[j]); }
            const float saP = ((sP[0] + sP[1]) + (sP[2] + sP[3])) + ((sP[4] + sP[5]) + (sP[6] + sP[7])), saL = ((sL[0] + sL[1]) + (sL[2] + sL[3])) + ((sL[4] + sL[5]) + (sL[6] + sL[7]));
            float qa[8], ya[8];
#pragma unroll
            for (int j = 0; j < 8; ++j) { qa[j] = 0.f; ya[j] = 0.f; }
            RW_LDU(wAo, wBo, bo, ko, ro, 1) RW_COMP(wAe, wBe, be, ke, re, 0)
            RW_LDU(wAe, wBe, be, ke, re, 2) RW_COMP(wAo, wBo, bo, ko, ro, 1)
            RW_LDU(wAo, wBo, bo, ko, ro, 3) RW_COMP(wAe, wBe, be, ke, re, 2)
            RW_LDU(wAe, wBe, be, ke, re, 4) RW_COMP(wAo, wBo, bo, ko, ro, 3)
            RW_LDU(wAo, wBo, bo, ko, ro, 5) RW_COMP(wAe, wBe, be, ke, re, 4)
            RW_LDU(wAe, wBe, be, ke, re, 6) RW_COMP(wAo, wBo, bo, ko, ro, 5)
            RW_LDU(wAo, wBo, bo, ko, ro, 7) RW_COMP(wAe, wBe, be, ke, re, 6)
            const float vvn = (float)*(const LAS f16*)(wl + RWA_VPL + ((t2 + 1) & 15) * 128 + lane_ * 2);
#pragma unroll
            for (int g = 0; g < 8; ++g) A[g] = *(const LAS u32x4*)(rc + RWA_REC + 256 + g * 16);
            RW_COMP(wAo, wBo, bo, ko, ro, 7)
            vv = vvn;
            *(f16*)((char*)MIX + ((mb + t2) * (unsigned)DM + (unsigned)(h * 64 + lane_)) * 2u) = (f16)(((ya[0] + ya[1]) + (ya[2] + ya[3])) + ((ya[4] + ya[5]) + (ya[6] + ya[7])));
            *(f16*)((char*)QT + ((mb + t2) * (unsigned)RW_W + (unsigned)(h * 64 + lane_)) * 2u) = (f16)(((qa[0] + qa[1]) + (qa[2] + qa[3])) + ((qa[4] + qa[5]) + (qa[6] + qa[7])));
        }
#undef RW_LDU
#undef RW_COMP
    }
    store_row64_f16(RL + (((size_t)bh * NCH + c) * 64 + lane) * 64, L);
    f16* pt = PT + ((size_t)bh * NCH + c) * 4096;
#pragma unroll
    for (int k = 0; k < 64; ++k) pt[k * 64 + lane] = (f16)P[k];
}

constexpr int HGA_REC = 512, HGA_HEAD = 16 * HGA_REC, HGA_BYTES = 3 * HGA_HEAD;
__device__ __forceinline__ void hgrn_waveA(const Args& a, int l, int b, int c, int h0, LAS unsigned char* wl, int lane) {
    f16* U = (f16*)(a.ws + WS_U); f16* MIX = (f16*)(a.ws + WS_MIX); f16* HL = (f16*)(a.ws + WS_HL); float* DC = (float*)(a.ws + WS_DC);
    const float* lbr = a.in[16];
    float S0[64], S1[64], S2[64];
#pragma unroll
    for (int k = 0; k < 64; ++k) { S0[k] = 0.f; S1[k] = 0.f; S2[k] = 0.f; }
    float dp0 = 1.f, dp1 = 1.f, dp2 = 1.f;
#pragma unroll 1
    for (int blk = 0; blk < 4; ++blk) {
        int lane_ = lane; asm volatile("" : "+v"(lane_));
        const unsigned mb = (unsigned)(b * SEQ + c * CH + blk * 16);
#pragma unroll 1
        for (int j = 0; j < 3; ++j) {
            const int col = (h0 + j) * 64 + lane_;
            const float lb = (l == 0) ? 0.f : sigmoidf_(lbr[384 + col] - lbr[col]);
            float dp = (j == 0) ? dp0 : (j == 1) ? dp1 : dp2;
            f16 fr[16], qr[16];
#pragma unroll
            for (int tk = 0; tk < 16; ++tk) { const char* ur = (const char*)U + (mb + tk) * (unsigned)(NU * 2); fr[tk] = *(const f16*)(ur + (unsigned)(C_HGF + col) * 2u); qr[tk] = *(const f16*)(ur + (unsigned)(C_HGQ + col) * 2u); }
#pragma unroll
            for (int tk = 0; tk < 16; ++tk) {
                const float f = lb + (1.0f - lb) * sigmoidf_((float)fr[tk]);
                LAS unsigned char* rec = wl + j * HGA_HEAD + tk * HGA_REC;
                *(LAS float*)(rec + lane_ * 4) = f; *(LAS f16*)(rec + 256 + lane_ * 2) = (f16)(1.0f - f); *(LAS f16*)(rec + 384 + lane_ * 2) = qr[tk];
                dp *= f;
                *(f16*)((char*)U + (mb + tk) * (unsigned)(NU * 2) + (unsigned)(C_HGQ + col) * 2u) = (f16)((float)qr[tk] * dp);
            }
            if (j == 0) dp0 = dp; else if (j == 1) dp1 = dp; else dp2 = dp;
        }
        asm volatile("s_waitcnt lgkmcnt(0)" ::: "memory");
#define HG_LDF(rcp, g) { fA = *(const LAS f32x4*)((rcp) + (g) * 32); fB = *(const LAS f32x4*)((rcp) + (g) * 32 + 16); }
#define HG_LDKQ(K4, Q4, rcp, g) { K4 = *(const LAS u32x4*)((rcp) + 256 + (g) * 16); Q4 = *(const LAS u32x4*)((rcp) + 384 + (g) * 16); }
#define HG_COMP(S, vi, K4, Q4, g, rcf, gf) { float tt[8]; \
            _Pragma("unroll") for (int jj = 0; jj < 8; ++jj) tt[jj] = MMIX(vi, K4, jj); \
            _Pragma("unroll") for (int jj = 0; jj < 8; ++jj) S[8 * (g) + jj] = fma_asm(S[8 * (g) + jj], (jj < 4) ? fA[jj & 3] : fB[jj & 3], tt[jj]); \
            HG_LDF(rcf, gf) \
            _Pragma("unroll") for (int jj = 0; jj < 8; ++jj) oa[jj] = FMIX(S[8 * (g) + jj], Q4, jj, oa[jj]); }
#define HG_HEAD(S, vi, rcp, rcn, oo) { float oa[8]; _Pragma("unroll") for (int jj = 0; jj < 8; ++jj) oa[jj] = 0.f; \
            HG_LDKQ(k4o, q4o, rcp, 1) HG_COMP(S, vi, k4e, q4e, 0, rcp, 1) \
            HG_LDKQ(k4e, q4e, rcp, 2) HG_COMP(S, vi, k4o, q4o, 1, rcp, 2) \
            HG_LDKQ(k4o, q4o, rcp, 3) HG_COMP(S, vi, k4e, q4e, 2, rcp, 3) \
            HG_LDKQ(k4e, q4e, rcp, 4) HG_COMP(S, vi, k4o, q4o, 3, rcp, 4) \
            HG_LDKQ(k4o, q4o, rcp, 5) HG_COMP(S, vi, k4e, q4e, 4, rcp, 5) \
            HG_LDKQ(k4e, q4e, rcp, 6) HG_COMP(S, vi, k4o, q4o, 5, rcp, 6) \
            HG_LDKQ(k4o, q4o, rcp, 7) HG_COMP(S, vi, k4e, q4e, 6, rcp, 7) \
            HG_LDKQ(k4e, q4e, rcn, 0) HG_COMP(S, vi, k4o, q4o, 7, rcn, 0) \
            oo = ((oa[0] + oa[1]) + (oa[2] + oa[3])) + ((oa[4] + oa[5]) + (oa[6] + oa[7])); }
        f32x4 fA, fB; u32x4 k4e, q4e, k4o, q4o;
        HG_LDF(wl, 0) HG_LDKQ(k4e, q4e, wl, 0)
        const char* ur0 = (const char*)U + mb * (unsigned)(NU * 2) + (unsigned)(C_HGI + h0 * 64 + lane_) * 2u;
        float v0 = (float)*(const f16*)(ur0), v1 = (float)*(const f16*)(ur0 + 128), v2 = (float)*(const f16*)(ur0 + 256);
#pragma unroll 1
        for (int t2 = 0; t2 < 16; ++t2) {
            const LAS unsigned char* rc = wl + t2 * HGA_REC;
            const char* urn = ur0 + (unsigned)((t2 + 1) & 15) * (unsigned)(NU * 2);
            const f16 n0 = *(const f16*)(urn), n1 = *(const f16*)(urn + 128), n2 = *(const f16*)(urn + 256);
            float oa_, ob_, oc_;
            HG_HEAD(S0, v0, rc, rc + HGA_HEAD, oa_)
            HG_HEAD(S1, v1, rc + HGA_HEAD, rc + 2 * HGA_HEAD, ob_)
            HG_HEAD(S2, v2, rc + 2 * HGA_HEAD, rc + HGA_REC, oc_)
            char* mo = (char*)MIX + ((mb + t2) * (unsigned)DM + (unsigned)(384 + h0 * 64 + lane_)) * 2u;
            *(f16*)mo = (f16)oa_; *(f16*)(mo + 128) = (f16)ob_; *(f16*)(mo + 256) = (f16)oc_;
            v0 = (float)n0; v1 = (float)n1; v2 = (float)n2;
        }
#undef HG_LDF
#undef HG_LDKQ
#undef HG_COMP
#undef HG_HEAD
    }
#define HG_OUT(S, j, dp) { const int bh = b * 6 + h0 + (j); store_row64_f16(HL + (((size_t)bh * NCH + c) * 64 + lane) * 64, S);     \
        DC[((size_t)bh * NCH + c) * 64 + lane] = dp; }
    HG_OUT(S0, 0, dp0) HG_OUT(S1, 1, dp1) HG_OUT(S2, 2, dp2)
#undef HG_OUT
}
__device__ __forceinline__ void phaseA(const Args& a, int l, int task, LAS unsigned char* lds, int tid) {
    asm volatile("" : "+v"(tid));
    const int lane = tid & 63, wave = __builtin_amdgcn_readfirstlane(tid >> 6);
    const int b = task / NCH, c = task % NCH;
    const f16* U = (const f16*)(a.ws + WS_U); f16* MIX = (f16*)(a.ws + WS_MIX); f16* VF = (f16*)(a.ws + WS_VF); f16* VP = (f16*)(a.ws + WS_VP);
    f16* QT = (f16*)(a.ws + WS_QT); f16* PT = (f16*)(a.ws + WS_PT); f16* RL = (f16*)(a.ws + WS_RL); float* BONG = (float*)(a.ws + WS_BON);
    if (wave < RW_H) rwkv_waveA(a, l, b, c, wave, lds + wave * RWA_BYTES, lane);
    else hgrn_waveA(a, l, b, c, 3 * (wave - RW_H), lds + RW_H * RWA_BYTES + (wave - RW_H) * HGA_BYTES, lane);
    __syncthreads();
    {
        const int ln = lane_now(); const int tid2 = wave * 64 + ln;
        const char* Ub = (const char*)U; char* MIXb = (char*)MIX; char* CA = (char*)(a.ws + WS_CA); float* LA = (float*)(a.ws + WS_LA); float* LH = (float*)(a.ws + WS_LH);
        const float* cw = a.in[18] + l * 4 * 256; const float* cb = a.in[19] + l * 256;
        const float* ba = a.in[21] + l * 256; const float* bx = a.in[23] + l * 256; const float* lam = a.in[24] + l * 256;
        const char* WAT = (const char*)(a.ws + WS_WAT) + (size_t)l * 4 * 8192; const char* WXT = (const char*)(a.ws + WS_WXT) + (size_t)l * 4 * 8192;
        LAS unsigned char* Y = lds;
        LAS float* AGG = (LAS float*)(lds + 34816);
        const unsigned mrow0 = (unsigned)(b * SEQ + c * CH);
#pragma unroll
        for (int it = 0; it < 4; ++it) { const int item = tid2 + 512 * it, tok = item >> 5, co = item & 31; const int t = c * CH + tok;
            const f32x4 b0 = *(const f32x4*)(cb + 8 * co), b1 = *(const f32x4*)(cb + 8 * co + 4);
            float y[8] = {b0[0], b0[1], b0[2], b0[3], b1[0], b1[1], b1[2], b1[3]};
#pragma unroll
            for (int jj = 0; jj < 4; ++jj) { const int ts = t - 3 + jj;
                if (ts >= 0) { const f16x8 x8 = *(const f16x8*)(Ub + ((mrow0 + (unsigned)(tok - 3 + jj)) * (unsigned)NU + (unsigned)(C_LRUX + 8 * co)) * 2u);
                    const f32x4 w0 = *(const f32x4*)(cw + jj * 256 + 8 * co), w1 = *(const f32x4*)(cw + jj * 256 + 8 * co + 4);
#pragma unroll
                    for (int i = 0; i < 8; ++i) y[i] += (i < 4 ? w0[i & 3] : w1[i & 3]) * (float)x8[i]; } }
            *(LAS f16x8*)(Y + tok * 528 + co * 16) = pack8(y); }
        __syncthreads();
        const int tl = ln & 15, fq = ln >> 4, tt = wave & 3, gp = wave >> 2;
        float Asc[32], Hsc[32];
#pragma unroll
        for (int gg = 0; gg < 2; ++gg) { const int g = 2 * gp + gg;
            f16x8 by[2];
#pragma unroll
            for (int s2 = 0; s2 < 2; ++s2) by[s2] = *(const LAS f16x8*)(Y + (16 * tt + tl) * 528 + (g * 64 + 8 * fq + 32 * s2) * 2);
#pragma unroll
            for (int nt = 0; nt < 4; ++nt) {
                f32x4 ra = (f32x4){0.f, 0.f, 0.f, 0.f}, rx = ra;
#pragma unroll
                for (int s2 = 0; s2 < 2; ++s2) { const unsigned wo = (unsigned)(g * 8192 + ((16 * nt + tl) * 64 + 8 * fq + 32 * s2) * 2);
                    ra = __builtin_amdgcn_mfma_f32_16x16x32_f16(*(const f16x8*)(WAT + wo), by[s2], ra, 0, 0, 0);
                    rx = __builtin_amdgcn_mfma_f32_16x16x32_f16(*(const f16x8*)(WXT + wo), by[s2], rx, 0, 0, 0); }
                const int ch0 = g * 64 + 16 * nt + 4 * fq;
                const f32x4 ba4 = *(const f32x4*)(ba + ch0), bx4 = *(const f32x4*)(bx + ch0), lm4 = *(const f32x4*)(lam + ch0);
                const f16x4 y4 = *(const LAS f16x4*)(Y + (16 * tt + tl) * 528 + ch0 * 2);
#pragma unroll
                for (int i = 0; i < 4; ++i) {
                    const float r = sigmoidf_(ra[i] + ba4[i]), ig = sigmoidf_(rx[i] + bx4[i]);
                    const float la = -8.0f * r * log1pf(__expf(-lm4[i]));
                    float av = __expf(la), uv = sqrtf(-expm1f(2.0f * la)) * (ig * (float)y4[i]);
#define LRU_SCAN(d) { const float ap = __builtin_bit_cast(float, __builtin_amdgcn_update_dpp(0x3f800000, __builtin_bit_cast(int, av), 0x110 + (d), 0xf, 0xf, false)); \
                      const float up = __builtin_bit_cast(float, __builtin_amdgcn_update_dpp(0, __builtin_bit_cast(int, uv), 0x110 + (d), 0xf, 0xf, false)); \
                      uv = av * up + uv; av = av * ap; }
                    LRU_SCAN(1) LRU_SCAN(2) LRU_SCAN(4) LRU_SCAN(8)
#undef LRU_SCAN
                    Asc[gg * 16 + nt * 4 + i] = av; Hsc[gg * 16 + nt * 4 + i] = uv;
                    if (tl == 15) { AGG[(tt * 256 + ch0 + i) * 2] = av; AGG[(tt * 256 + ch0 + i) * 2 + 1] = uv; }
                }
            }
        }
        __syncthreads();
        const unsigned m = mrow0 + (unsigned)(16 * tt + tl);
#pragma unroll
        for (int gg = 0; gg < 2; ++gg)
#pragma unroll
            for (int nt = 0; nt < 4; ++nt) { const int ch0 = (2 * gp + gg) * 64 + 16 * nt + 4 * fq;
                f16x4 ho, co;
#pragma unroll
                for (int i = 0; i < 4; ++i) { float cy = 0.f, cpv = 1.f;
#pragma unroll
                    for (int t3 = 0; t3 < 3; ++t3) if (t3 < tt) { const float A3 = AGG[(t3 * 256 + ch0 + i) * 2], H3 = AGG[(t3 * 256 + ch0 + i) * 2 + 1]; cy = A3 * cy + H3; cpv *= A3; }
                    const float hl = Hsc[gg * 16 + nt * 4 + i] + Asc[gg * 16 + nt * 4 + i] * cy, ca = Asc[gg * 16 + nt * 4 + i] * cpv;
                    ho[i] = (f16)hl; co[i] = (f16)ca;
                    if (tt == 3 && tl == 15) { LA[((size_t)b * NCH + c) * 256 + ch0 + i] = ca; LH[((size_t)b * NCH + c) * 256 + ch0 + i] = hl; } }
                *(f16x4*)(MIXb + (m * (unsigned)DM + 768u + (unsigned)ch0) * 2u) = ho; *(f16x4*)(CA + (m * 256u + (unsigned)ch0) * 2u) = co; }
    }
}


constexpr int PB_SLOT = 16384, PB_NS = 8, PB_AHEAD = 6;
__device__ __forceinline__ void phaseB(const Args& a, LAS unsigned char* lds, int tid) {
    asm volatile("" : "+v"(tid));
    const int lane = tid & 63, wave = __builtin_amdgcn_readfirstlane(tid >> 6);
    const int bx = blockIdx.x;
    if (bx < 12) {
        const int bh = bx;
        const char* PT = (const char*)(a.ws + WS_PT) + (size_t)bh * NCH * 8192; char* RL = (char*)(a.ws + WS_RL) + (size_t)bh * NCH * 8192;
        const bool loader = wave >= 4;
        const int vt = wave & 3, vl = lane & 15, fq = lane >> 4, v = 16 * vt + vl;
        const int lq = (wave - 4) * 64 + lane, lrow = lq >> 3, lpp = lq & 7;
        const unsigned lsrc = (unsigned)(lrow * 128 + ((lpp ^ (lrow & 7)) << 4));
#define PB_ISSUE(cc) { const unsigned so = (unsigned)(((cc) & (PB_NS - 1)) * PB_SLOT) + (unsigned)((wave - 4) * 1024); const size_t go = (size_t)(cc) * 8192 + lsrc; \
            __builtin_amdgcn_global_load_lds((const unsigned*)(PT + go), (LAS unsigned*)(lds + so), 16, 0, 0); \
            __builtin_amdgcn_global_load_lds((const unsigned*)(PT + go + 4096), (LAS unsigned*)(lds + so + 4096), 16, 0, 0); \
            __builtin_amdgcn_global_load_lds((const unsigned*)(RL + go), (LAS unsigned*)(lds + so + 8192), 16, 0, 0); \
            __builtin_amdgcn_global_load_lds((const unsigned*)(RL + go + 4096), (LAS unsigned*)(lds + so + 12288), 16, 0, 0); }
#define PB_SWZ(row, o) ((row) * 128 + (((((o) >> 4) ^ ((row) & 7)) << 4) | ((o) & 15)))
        if (loader) {
#pragma unroll
            for (int cc = 0; cc < PB_AHEAD; ++cc) PB_ISSUE(cc)
            asm volatile("s_waitcnt vmcnt(20)" ::: "memory");
        }
        __builtin_amdgcn_s_barrier();
        f32x4 Sacc[4];
#pragma unroll
        for (int mt = 0; mt < 4; ++mt) Sacc[mt] = (f32x4){0.f, 0.f, 0.f, 0.f};
#pragma unroll 1
        for (int c = 0; c < NCH; ++c) {
            if (loader) {
                if (c + PB_AHEAD < NCH) { PB_ISSUE(c + PB_AHEAD) asm volatile("s_waitcnt vmcnt(20)" ::: "memory"); }
                else asm volatile("s_waitcnt vmcnt(0)" ::: "memory");
            } else {
                const LAS unsigned char* sl = lds + (c & (PB_NS - 1)) * PB_SLOT;
                f16x8 Bhi[2], Blo[2];
#pragma unroll
                for (int mt = 0; mt < 4; ++mt) { f16x4 hi;
#pragma unroll
                    for (int i = 0; i < 4; ++i) { hi[i] = (f16)Sacc[mt][i]; const f16 lo = (f16)(Sacc[mt][i] - (float)hi[i]); Bhi[mt >> 1][4 * (mt & 1) + i] = hi[i]; Blo[mt >> 1][4 * (mt & 1) + i] = lo; }
                    *(f16x4*)(RL + (size_t)c * 8192 + (v * 64 + 16 * mt + 4 * fq) * 2) = hi; }
#pragma unroll
                for (int mt = 0; mt < 4; ++mt) {
                    const f16x4 l4 = *(const LAS f16x4*)(sl + 8192 + PB_SWZ(v, 32 * mt + 8 * fq));
                    f32x4 d = (f32x4){(float)l4[0], (float)l4[1], (float)l4[2], (float)l4[3]};
#pragma unroll
                    for (int s = 0; s < 2; ++s) { const u32x2 a0 = *(const LAS u32x2*)(sl + PB_SWZ(16 * mt + vl, 64 * s + 8 * fq)), a1 = *(const LAS u32x2*)(sl + PB_SWZ(16 * mt + vl, 64 * s + 32 + 8 * fq));
                        u32x4 aw; aw.x = a0.x; aw.y = a0.y; aw.z = a1.x; aw.w = a1.y; const f16x8 af = __builtin_bit_cast(f16x8, aw);
                        d = __builtin_amdgcn_mfma_f32_16x16x32_f16(af, Bhi[s], d, 0, 0, 0); d = __builtin_amdgcn_mfma_f32_16x16x32_f16(af, Blo[s], d, 0, 0, 0); }
                    Sacc[mt] = d; }
                asm volatile("s_waitcnt lgkmcnt(0)" ::: "memory");
            }
            __builtin_amdgcn_s_barrier();
        }
#undef PB_ISSUE
#undef PB_SWZ
        asm volatile("s_waitcnt vmcnt(0)" ::: "memory");
    } else if (bx < 12 + 96) {
        const int idx = (bx - 12) * NT + tid; const int bh = idx >> 12, e = idx & 4095, k = e & 63;
        f16* HL = (f16*)(a.ws + WS_HL); const float* DC = (const float*)(a.ws + WS_DC);
        float s = 0.f;
        for (int c0 = 0; c0 < NCH; c0 += 8) { float Lc[8], d[8];
#pragma unroll
            for (int j = 0; j < 8; ++j) { Lc[j] = (float)HL[((size_t)bh * NCH + c0 + j) * 4096 + e]; d[j] = DC[((size_t)bh * NCH + c0 + j) * 64 + k]; }
#pragma unroll
            for (int j = 0; j < 8; ++j) { HL[((size_t)bh * NCH + c0 + j) * 4096 + e] = (f16)s; s = d[j] * s + Lc[j]; } }
    } else if (bx == 12 + 96) {
        const int bb = tid >> 8, ch = tid & 255; const float* LA = (const float*)(a.ws + WS_LA); float* LH = (float*)(a.ws + WS_LH);
        float cy = 0.f;
        for (int c0 = 0; c0 < NCH; c0 += 8) { float A[8], H[8];
#pragma unroll
            for (int j = 0; j < 8; ++j) { const size_t o = ((size_t)bb * NCH + c0 + j) * 256 + ch; A[j] = LA[o]; H[j] = LH[o]; }
#pragma unroll
            for (int j = 0; j < 8; ++j) { const size_t o = ((size_t)bb * NCH + c0 + j) * 256 + ch; LH[o] = cy; cy = A[j] * cy + H[j]; } }
    }
}

__device__ __forceinline__ void phaseC(const Args& a, int l, int task, LAS unsigned char* lds, int tid) {
    asm volatile("" : "+v"(tid));
    const int lane = tid & 63, wave = __builtin_amdgcn_readfirstlane(tid >> 6);
    const int b = task / NCH, c = task % NCH;
    const int tl = lane & 15, fq = lane >> 4, tt = wave & 3, hg = wave >> 2;
    const unsigned m = (unsigned)(b * SEQ + c * CH + 16 * tt + tl);
    const char* U = (const char*)(a.ws + WS_U); char* MIX = (char*)(a.ws + WS_MIX); const char* VP = (const char*)(a.ws + WS_VP);
    const char* QT = (const char*)(a.ws + WS_QT); const char* RL = (const char*)(a.ws + WS_RL); const char* HL = (const char*)(a.ws + WS_HL); const float* BONG = (const float*)(a.ws + WS_BON);
    const unsigned uo = m * (unsigned)(NU * 2);
#pragma unroll 1
    for (int hh = 0; hh < 3; ++hh) {
        const int h = 3 * hg + hh; const int bh = b * RW_H + h;
        const char* sl = RL + ((size_t)bh * NCH + c) * 8192;
        f16x8 bq[2];
#pragma unroll
        for (int s = 0; s < 2; ++s) bq[s] = *(const f16x8*)(QT + (m * (unsigned)RW_W + (unsigned)(h * 64 + 8 * fq + 32 * s)) * 2u);
        f32x4 D[4];
#pragma unroll
        for (int vt = 0; vt < 4; ++vt) { const f16x4 yl = *(const f16x4*)(MIX + (m * (unsigned)DM + (unsigned)(h * 64 + 16 * vt + 4 * fq)) * 2u);
            f32x4 d = (f32x4){(float)yl[0], (float)yl[1], (float)yl[2], (float)yl[3]};
#pragma unroll
            for (int s = 0; s < 2; ++s) d = __builtin_amdgcn_mfma_f32_16x16x32_f16(*(const f16x8*)(sl + ((16 * vt + tl) * 64 + 8 * fq + 32 * s) * 2), bq[s], d, 0, 0, 0);
            D[vt] = d; }
        float sm = 0.f;
#pragma unroll
        for (int vt = 0; vt < 4; ++vt) sm += (D[vt][0] + D[vt][1]) + (D[vt][2] + D[vt][3]);
        sm += __shfl_xor(sm, 16); sm += __shfl_xor(sm, 32);
        const float mean = sm * (1.0f / 64.0f); float vr = 0.f;
#pragma unroll
        for (int vt = 0; vt < 4; ++vt)
#pragma unroll
            for (int i = 0; i < 4; ++i) { const float d = D[vt][i] - mean; vr += d * d; }
        vr += __shfl_xor(vr, 16); vr += __shfl_xor(vr, 32);
        const float rstd = 1.0f / sqrtf(vr * (1.0f / 64.0f) + 64e-5f);
        const float bon = BONG[m * 8u + (unsigned)h];
        const float* ln_w = a.in[14] + l * RW_W; const float* ln_b = a.in[15] + l * RW_W;
#pragma unroll
        for (int vt = 0; vt < 4; ++vt) { const unsigned col = (unsigned)(h * 64 + 16 * vt + 4 * fq);
            const f16x4 vp = *(const f16x4*)(VP + (m * (unsigned)RW_W + col) * 2u), z4 = *(const f16x4*)(U + uo + ((unsigned)C_RWZ + col) * 2u);
            const f32x4 lw = *(const f32x4*)(ln_w + col), lb = *(const f32x4*)(ln_b + col);
            f16x4 o;
#pragma unroll
            for (int i = 0; i < 4; ++i) o[i] = (f16)(((D[vt][i] - mean) * rstd * lw[i] + lb[i] + bon * (float)vp[i]) * siluf_((float)z4[i]));
            *(f16x4*)(MIX + (m * (unsigned)DM + col) * 2u) = o; }
    }
#pragma unroll 1
    for (int hh = 0; hh < 3; ++hh) {
        const int h = 3 * hg + hh; const int bh = b * 6 + h;
        const char* sl = HL + ((size_t)bh * NCH + c) * 8192;
        f16x8 bq[2];
#pragma unroll
        for (int s = 0; s < 2; ++s) bq[s] = *(const f16x8*)(U + uo + (unsigned)(C_HGQ + h * 64 + 8 * fq + 32 * s) * 2u);
        f32x4 D[4];
#pragma unroll
        for (int vt = 0; vt < 4; ++vt) { const f16x4 ol = *(const f16x4*)(MIX + (m * (unsigned)DM + (unsigned)(384 + h * 64 + 16 * vt + 4 * fq)) * 2u);
            f32x4 d = (f32x4){(float)ol[0], (float)ol[1], (float)ol[2], (float)ol[3]};
#pragma unroll
            for (int s = 0; s < 2; ++s) d = __builtin_amdgcn_mfma_f32_16x16x32_f16(*(const f16x8*)(sl + ((16 * vt + tl) * 64 + 8 * fq + 32 * s) * 2), bq[s], d, 0, 0, 0);
            D[vt] = d; }
        float ss = 0.f;
#pragma unroll
        for (int vt = 0; vt < 4; ++vt) ss += (D[vt][0] * D[vt][0] + D[vt][1] * D[vt][1]) + (D[vt][2] * D[vt][2] + D[vt][3] * D[vt][3]);
        ss += __shfl_xor(ss, 16); ss += __shfl_xor(ss, 32);
        const float rs = 1.0f / sqrtf(ss * (1.0f / 64.0f) + 1e-6f);
        const float* nw = a.in[17] + l * 384;
#pragma unroll
        for (int vt = 0; vt < 4; ++vt) { const unsigned col = (unsigned)(h * 64 + 16 * vt + 4 * fq);
            const f16x4 z4 = *(const f16x4*)(U + uo + ((unsigned)C_HGZ + col) * 2u); const f32x4 w4 = *(const f32x4*)(nw + col);
            f16x4 o;
#pragma unroll
            for (int i = 0; i < 4; ++i) o[i] = (f16)(D[vt][i] * rs * w4[i] * siluf_((float)z4[i]));
            *(f16x4*)(MIX + (m * (unsigned)DM + 384u + col) * 2u) = o; }
    }
    {
        const char* CA = (const char*)(a.ws + WS_CA); const float* LH = (const float*)(a.ws + WS_LH) + ((size_t)b * NCH + c) * 256;
#pragma unroll
        for (int q = 0; q < 4; ++q) { const unsigned ch0 = (unsigned)(128 * hg + 32 * fq + 8 * q);
            const f16x8 hl = *(const f16x8*)(MIX + (m * (unsigned)DM + 768u + ch0) * 2u), ca = *(const f16x8*)(CA + (m * 256u + ch0) * 2u), z8 = *(const f16x8*)(U + uo + ((unsigned)C_LRUZ + ch0) * 2u);
            const f32x4 c0 = *(const f32x4*)(LH + ch0), c1 = *(const f32x4*)(LH + ch0 + 4);
            f16x8 o;
#pragma unroll
            for (int i = 0; i < 8; ++i) o[i] = (f16)(((float)hl[i] + (float)ca[i] * (i < 4 ? c0[i & 3] : c1[i & 3])) * siluf_((float)z8[i]));
            *(f16x8*)(MIX + (m * (unsigned)DM + 768u + ch0) * 2u) = o; }
    }
}
#define XB_TMO      128
#define XB_XCNT(j)  (256  + 64 * (j))
#define XB_XSUB(j)  (1280 + 64 * (j))
#define XB_XGEN(j)  (2304 + 64 * (j))
#define XB_TOP      3328
#define XB_TOPGEN   3392
#define XCD_BAR_WORDS 3456
#define XB_SPIN_CAP (1u << 18)

__device__ __forceinline__ unsigned xb_ld(unsigned* p)              { return __hip_atomic_load(p, __ATOMIC_RELAXED, __HIP_MEMORY_SCOPE_AGENT); }
__device__ __forceinline__ unsigned xb_add(unsigned* p, unsigned v) { return __hip_atomic_fetch_add(p, v, __ATOMIC_RELAXED, __HIP_MEMORY_SCOPE_AGENT); }
__device__ __forceinline__ unsigned xb_xcc_id() { return (unsigned)__builtin_amdgcn_s_getreg((3 << 11) | 20) & 0xFu; }
#define XB_SPIN(cond, bar) do { unsigned _sp = 0; while (cond) { __builtin_amdgcn_s_sleep(1); \
    if ((++_sp & 255u) == 0u) { if (xb_ld(&(bar)[XB_TMO])) break; if (_sp > XB_SPIN_CAP) { atomicAdd(&(bar)[XB_TMO], 1u); break; } } } } while (0)

struct XcdBarrier {
    unsigned* bar; unsigned x; int isw0;
    volatile LAS unsigned* st;
};

__device__ __forceinline__ XcdBarrier xcd_barrier_post(unsigned* bar, volatile LAS unsigned* st, int isw0) {
    XcdBarrier b; b.bar = bar; b.x = xb_xcc_id(); b.st = st; b.isw0 = isw0;
    if (isw0 && lane_now() == 0) (void)xb_add(&bar[XB_XCNT(b.x)], 1u);
    return b;
}
__device__ __forceinline__ void xcd_barrier_complete(unsigned* bar, unsigned x, unsigned& nloc, unsigned& nx) {
    const unsigned G = gridDim.x * gridDim.y * gridDim.z;
    unsigned sum, cnt, mine, sp = 0u;
    for (;;) {
        sum = 0u; cnt = 0u; mine = 0u;
#pragma unroll
        for (unsigned j = 0; j < 16; ++j) { const unsigned c = xb_ld(&bar[XB_XCNT(j)]); sum += c; cnt += (c > 0u) ? 1u : 0u; mine = (j == x) ? c : mine; }
        if (sum == G) break;
        __builtin_amdgcn_s_sleep(1);
        if ((++sp & 255u) == 0u) { if (xb_ld(&bar[XB_TMO])) break; if (sp > XB_SPIN_CAP) { atomicAdd(&bar[XB_TMO], 1u); break; } }
    }
    nloc = mine > 0u ? mine : 1u; nx = cnt > 0u ? cnt : 1u;
}

__device__ __forceinline__ void xcd_barrier(const XcdBarrier& b) {
    asm volatile("s_waitcnt vmcnt(0)" ::: "memory");
    __syncthreads();
    if (b.isw0 && lane_now() == 0) {
        unsigned* bar = b.bar;
        __builtin_amdgcn_s_waitcnt(0);
        unsigned nloc = b.st[0], nx = b.st[1];
        if (nloc == 0u) { xcd_barrier_complete(bar, b.x, nloc, nx); b.st[0] = nloc; b.st[1] = nx; }
        const unsigned old = xb_add(&bar[XB_XSUB(b.x)], 1u);
        const unsigned gen = old / nloc;
        if (old + 1u == (gen + 1u) * nloc) {
            __builtin_amdgcn_fence(__ATOMIC_RELEASE, "agent");
            asm volatile("s_waitcnt vmcnt(0)" ::: "memory");
            const unsigned og = xb_add(&bar[XB_TOP], 1u);
            const unsigned tg = og / nx;
            if (og + 1u == (tg + 1u) * nx) xb_add(&bar[XB_TOPGEN], 1u);
            else XB_SPIN(xb_ld(&bar[XB_TOPGEN]) == tg, bar);
            __builtin_amdgcn_fence(__ATOMIC_ACQUIRE, "agent");
            xb_add(&bar[XB_XGEN(b.x)], 1u);
            asm volatile("s_waitcnt vmcnt(0)" ::: "memory");
        } else {
            XB_SPIN(xb_ld(&bar[XB_XGEN(b.x)]) == gen, bar);
            __builtin_amdgcn_fence(__ATOMIC_ACQUIRE, "agent");
            asm volatile("s_waitcnt vmcnt(0)" ::: "memory");
        }
    }
    __syncthreads();
}

constexpr size_t WS_BAR = 16384;
constexpr int MISC_OFF = LDS_BYTES - 16;
__global__ void __launch_bounds__(NT, 2) fwd(Args args) {
    extern __shared__ __attribute__((aligned(16))) unsigned char lds_raw[];
    LAS unsigned char* lds = (LAS unsigned char*)lds_raw;
    cg::grid_group grid = cg::this_grid();
    const int wave = __builtin_amdgcn_readfirstlane((int)threadIdx.x >> 6);
#define TID_NOW() (wave * 64 + lane_now())
    const int tid = TID_NOW(); const int lane = tid & 63;
    if (wave == 0 && lane < 4) ((LAS unsigned*)(lds + MISC_OFF))[lane] = 0u;
    __syncthreads();
    XcdBarrier xbar = xcd_barrier_post((unsigned*)(args.ws + WS_BAR), (volatile LAS unsigned*)(lds + MISC_OFF), __builtin_amdgcn_readfirstlane(wave == 0 ? 1 : 0));
#define GRID_BAR() do { XcdBarrier xb_ = xbar; asm volatile("" : "+s"(xb_.bar), "+s"(xb_.x)); xcd_barrier(xb_); } while (0)
    const int G = gridDim.x, gw = blockIdx.x * NWAVES + wave, NGW = G * NWAVES;
    unsigned char* ws = args.ws;
    unsigned short* XN = (unsigned short*)(ws + WS_XN);
    {
        LAS float* scr = (LAS float*)(lds + wave * 16384);
        constexpr int I_IN = (DM / 64) * (NIN / 32), I_OUT = (DM / 64) * (DM / 32), NITEMS = DEPTH * (I_IN + I_OUT);
        for (int it = gw; it < NITEMS; it += NGW) {
            int r = it; const int l = r / (I_IN + I_OUT); r -= l * (I_IN + I_OUT);
            if (r < I_IN) p0_transpose_item(args.in[2] + (size_t)l * DM * NIN, DM, NIN, (unsigned short*)(ws + WS_WIN + l * WIN_L), scr, r, lane);
            else p0_transpose_item(args.in[25] + (size_t)l * DM * DM, DM, DM, (unsigned short*)(ws + WS_WOUT + l * WOUT_L), scr, r - I_IN, lane);
        }
        for (int i = gw; i < DEPTH * (NU - NIN) * DM * 2 / 1024; i += NGW) { const int l = i / ((NU - NIN) * DM * 2 / 1024), r = i % ((NU - NIN) * DM * 2 / 1024);
            *(u32x4*)(ws + WS_WIN + l * WIN_L + (size_t)NIN * DM * 2 + (size_t)r * 1024 + lane * 16) = (u32x4){0u, 0u, 0u, 0u}; }
        for (int m = gw; m < M; m += NGW) rms_row_f16(args.in[0] + (size_t)m * DM, args.in[1], XN + (size_t)m * DM, lane);
        { f16* WUPT = (f16*)(ws + WS_WUPT); f16* AUPT = (f16*)(ws + WS_AUPT); f16* VDNT = (f16*)(ws + WS_VDNT); f16* VUPT = (f16*)(ws + WS_VUPT);
          for (int i = blockIdx.x * NT + tid; i < 122880; i += G * NT) {
              if (i < 49152) { const int ll = i / 24576, r = i % 24576, n = r / 64, k = r % 64; WUPT[i] = (f16)args.in[5][(size_t)ll * 24576 + k * 384 + n]; }
              else if (i < 98304) { const int i2 = i - 49152, ll = i2 / 24576, r = i2 % 24576, n = r / 64, k = r % 64; AUPT[i2] = (f16)args.in[7][(size_t)ll * 24576 + k * 384 + n]; }
              else if (i < 110592) { const int i2 = i - 98304, j2 = i2 / 384, cc = i2 % 384; VDNT[i2] = (f16)args.in[9][cc * 32 + j2]; }
              else { const int i2 = i - 110592, n = i2 / 32, j2 = i2 % 32; VUPT[i2] = (f16)args.in[10][j2 * 384 + n]; } }
          f16* WAT = (f16*)(ws + WS_WAT); f16* WXT = (f16*)(ws + WS_WXT);
          for (int i = blockIdx.x * NT + tid; i < 32768; i += G * NT) { const int lg = i >> 12, r = i & 4095, j = r >> 6, ii = r & 63; WAT[i] = (f16)args.in[20][(size_t)lg * 4096 + ii * 64 + j]; WXT[i] = (f16)args.in[22][(size_t)lg * 4096 + ii * 64 + j]; } }
    }
    grid.sync();
#pragma unroll 1
    for (int l = 0; l < DEPTH; ++l) {
        { pg8::Gemm g{XN, (const unsigned short*)(ws + WS_WIN + l * WIN_L), M, NU, DM}; pg8::StaticOrder S; S.init(M, NU, G, (int)blockIdx.x);
          pg8::EpiF16 E{(unsigned short*)(ws + WS_U), NU};
          pg8::gemm_phase<pg8::EpiF16, pg8::StaticOrder, true, true>(lds, g, S, E, wave); }
        GRID_BAR();
        for (int task = blockIdx.x; task < BATCH * NCH; task += G) phaseA(args, l, task, lds, TID_NOW());
        GRID_BAR();
        phaseB(args, lds, TID_NOW());
        GRID_BAR();
        for (int task = blockIdx.x; task < BATCH * NCH; task += G) phaseC(args, l, task, lds, TID_NOW());
        GRID_BAR();
        { pg8::Gemm g{(const unsigned short*)(ws + WS_MIX), (const unsigned short*)(ws + WS_WOUT + l * WOUT_L), M, DM, DM}; pg8::StaticOrder S; S.init(M, DM, G, (int)blockIdx.x);
          pg8::EpiRes E{l == 0 ? args.in[0] : args.out, args.out, DM};
          pg8::gemm_phase<pg8::EpiRes, pg8::StaticOrder, true, true>(lds, g, S, E, wave); }
        GRID_BAR();
        { int ln = TID_NOW() & 63; asm volatile("" : "+v"(ln));
          if (l + 1 < DEPTH) { for (int m = gw; m < M; m += NGW) rms_row_f16(args.out + (size_t)m * DM, args.in[1] + (l + 1) * DM, XN + (size_t)m * DM, ln); GRID_BAR(); }
          else { for (int m = gw; m < M; m += NGW) rms_row_f32(args.out + (size_t)m * DM, args.in[26], ln); } }
    }
}

extern "C" void kernel_launch(void* const* d_in, const int* in_sizes, int n_in, void* d_out, int out_size, void* d_ws, size_t ws_size, hipStream_t stream) {
    static int grid = 0;
    if (grid == 0) {
        if (n_in != 27 || in_sizes[0] != M * DM || out_size != M * DM || ws_size < WS_END) { fprintf(stderr, "kernel_launch: unexpected problem: n_in %d in0 %d out %d ws %zu\n", n_in, n_in > 0 ? in_sizes[0] : -1, out_size, ws_size); grid = -1; return; }
        int dev = 0, cus = 0, per_cu = 0;
        hipGetDevice(&dev); hipDeviceGetAttribute(&cus, hipDeviceAttributeMultiprocessorCount, dev);
        if (hipFuncSetAttribute((const void*)fwd, hipFuncAttributeMaxDynamicSharedMemorySize, LDS_BYTES) != hipSuccess) { fprintf(stderr, "kernel_launch: hipFuncSetAttribute failed\n"); grid = -1; return; }
        if (hipOccupancyMaxActiveBlocksPerMultiprocessor(&per_cu, (const void*)fwd, NT, LDS_BYTES) != hipSuccess || per_cu < 1) { fprintf(stderr, "kernel_launch: occupancy query failed (%d)\n", per_cu); grid = -1; return; }
        grid = cus * per_cu;
    }
    if (grid < 0) return;
    if (hipMemsetAsync((char*)d_ws, 0, 65536, stream) != hipSuccess) { fprintf(stderr, "kernel_launch: memset of the barrier words failed\n"); return; }
    Args a{};
    for (int i = 0; i < 27; ++i) a.in[i] = (const float*)d_in[i];
    a.out = (float*)d_out; a.ws = (unsigned char*)d_ws;
    void* kargs[] = {&a};
    hipError_t e = hipLaunchCooperativeKernel((const void*)fwd, dim3(grid), dim3(NT), kargs, LDS_BYTES, stream);
    if (e != hipSuccess) fprintf(stderr, "cooperative launch failed: %s (grid %d)\n", hipGetErrorString(e), grid);
}
```

```cpp
#include <hip/hip_runtime.h>
#include <hip/hip_cooperative_groups.h>
#include <cstdio>
#include <cstdint>
namespace cg = cooperative_groups;
typedef _Float16 f16x8_t __attribute__((ext_vector_type(8)));
#define MK_MFMA(a, b, c) __builtin_amdgcn_mfma_f32_16x16x32_f16(__builtin_bit_cast(f16x8_t, (a)), __builtin_bit_cast(f16x8_t, (b)), (c), 0, 0, 0)
__device__ __forceinline__ int lane_now() { int z; asm volatile("v_mbcnt_lo_u32_b32 %0, -1, 0\n\tv_mbcnt_hi_u32_b32 %0, -1, %0" : "=v"(z)); return z; }
__device__ __forceinline__ float shfl_xor_f(float v, int mask) { const int ln = lane_now(); return __builtin_bit_cast(float, __builtin_amdgcn_ds_bpermute((ln ^ mask) << 2, __builtin_bit_cast(int, v))); }
namespace pg8 {
#define PG8_LAS __attribute__((address_space(3)))
typedef unsigned short bf16_t;
typedef short bf16x8 __attribute__((ext_vector_type(8)));
typedef float f32x4 __attribute__((ext_vector_type(4)));
typedef unsigned u32x4 __attribute__((ext_vector_type(4)));
constexpr int BM = 256, BK = 64, HALF = 128, HTB = HALF * BK * 2  , STAGE_BYTES = 8 * HTB, NXCD = 8, WGM = 8;

__host__ __device__ __forceinline__ int lds_byte(int r, int c) { const int st = (r >> 4) * 2 + (c >> 5), rr = r & 15, cc = c & 31, ob = rr * 64 + cc * 2; return st * 1024 + (ob ^ (((ob >> 9) & 1) << 5)); }
__host__ __device__ __forceinline__ void stage_rc(int b, int& R, int& C) { const int st = b / 1024, sb = b % 1024, swz = sb ^ (((sb >> 9) & 1) << 5); R = (st >> 1) * 16 + swz / 64; C = (st & 1) * 32 + (swz % 64) / 2; }
__host__ __device__ __forceinline__ int perm32(int rho) { const int n = rho >> 4, i = rho & 15; return 8 * (i >> 2) + 4 * n + (i & 3); }

struct Unit { int pm, pn; };
struct Gemm { const bf16_t* A; const bf16_t* Bt; int M, N, K; };

struct StaticOrder {
    int nM, nN, nwg, G, c;
    __host__ __device__ void init(int M, int N, int G_, int c_) { nM = M / BM; nN = N / BM; nwg = nM * nN; G = G_; c = c_; }
    __host__ __device__ bool next(int i, Unit& u) const {
        const long L = (long)i * G + c; if (L >= nwg) return false;
        int wgid = (int)L; { const int q = nwg / NXCD, r = nwg % NXCD, xcd = wgid % NXCD, off = wgid / NXCD; wgid = (xcd < r ? xcd * (q + 1) : r * (q + 1) + (xcd - r) * q) + off; }
        const int nig = WGM * nN, gid = wgid / nig, fm = gid * WGM, gsz = (nM - fm) < WGM ? (nM - fm) : WGM;
        u.pm = fm + ((wgid % nig) % gsz); u.pn = (wgid % nig) / gsz; return true;
    }
    __device__ __forceinline__ void a_ready(const Unit&) const {}
    __device__ __forceinline__ void done(const Unit&) const {}
};

__device__ __forceinline__ unsigned pk_f16(float lo, float hi) { typedef _Float16 h2 __attribute__((ext_vector_type(2))); h2 v; v.x = (_Float16)lo; v.y = (_Float16)hi; return __builtin_bit_cast(unsigned, v); }
struct EpiF16 {
    static constexpr bool PERM = true, AFTER_DRAIN = false;
    bf16_t* O; int ldc;
    __device__ __forceinline__ void operator()(const f32x4 (&acc)[2][2][4][2], const Unit& u, int wr, int wc, int fr, int fq) const {
        const int row0 = u.pm * BM + wr * 64 + fr; const int col0 = u.pn * BM + wc * 32 + 8 * fq;
#pragma unroll
        for (int ai = 0; ai < 2; ++ai)
#pragma unroll
            for (int m = 0; m < 4; ++m) { bf16_t* rowp = O + (size_t)(row0 + ai * HALF + m * 16) * ldc + col0;
#pragma unroll
                for (int bj = 0; bj < 2; ++bj) { const f32x4 v0 = acc[ai][bj][m][0], v1 = acc[ai][bj][m][1];
                    u32x4 w; w.x = pk_f16(v0[0], v0[1]); w.y = pk_f16(v0[2], v0[3]); w.z = pk_f16(v1[0], v1[1]); w.w = pk_f16(v1[2], v1[3]);
                    *(u32x4*)(rowp + bj * HALF) = w; } }
    }
};
struct EpiRes {
    static constexpr bool PERM = false, AFTER_DRAIN = false;
    const float* base; float* out; int ldc;
    __device__ __forceinline__ void operator()(const f32x4 (&acc)[2][2][4][2], const Unit& u, int wr, int wc, int fr, int fq) const {
        const int row0 = u.pm * BM + wr * 64 + fr; const int col0 = u.pn * BM + wc * 32 + 4 * fq;
#pragma unroll
        for (int ai = 0; ai < 2; ++ai)
#pragma unroll
            for (int m = 0; m < 4; ++m) { const size_t off = (size_t)(row0 + ai * HALF + m * 16) * ldc + col0;
#pragma unroll
                for (int bj = 0; bj < 2; ++bj)
#pragma unroll
                    for (int n = 0; n < 2; ++n) { const size_t o = off + bj * HALF + n * 16; const f32x4 b = *(const f32x4*)(base + o); *(f32x4*)(out + o) = b + acc[ai][bj][m][n]; }
                asm volatile("" ::: "memory"); }
    }
};

template <class Epi, class Sched, bool ALIGN_EPI = false, bool SP2 = false>
__device__ __forceinline__ void gemm_phase(PG8_LAS unsigned char* lds, const Gemm g, const Sched& S, const Epi& E, const int wave_) {
    int wv_ = wave_; asm volatile("" : "+s"(wv_)); int tid_ = lane_now() + 64 * wv_; const int tid = tid_, wid = wv_, lane = tid & 63, wr = wid >> 2, wc = wid & 3, fr = lane & 15, fq = lane >> 4;
    const int K = g.K, nt = K / BK;
    unsigned voffA[2], voffB[2];
#pragma unroll
    for (int i = 0; i < 2; ++i) { int R, C; stage_rc(tid * 16 + i * 8192, R, C); const int Rb = Epi::PERM ? ((R & ~31) + perm32(R & 31)) : R;
        voffA[i] = (unsigned)(R * K + C) * 2u; voffB[i] = (unsigned)(Rb * K + C) * 2u; }
    const size_t kstep = (size_t)(BK * 2);
    const size_t hstep = (size_t)HALF * K * 2;
    const size_t tstep = 2 * hstep;
    const unsigned ldsw = (unsigned)wid * 1024u;
    const int aoff = lds_byte(wr * 64 + fr, fq * 8), boff = lds_byte(wc * 32 + fr, fq * 8);
#define PG8_SA(b, h) (((b) * 2 + (h)) * HTB)
#define PG8_SB(b, h) ((4 + (b) * 2 + (h)) * HTB)
#define PG8_STAGE(bufoff, gbase, voff) do { _Pragma("unroll") for (int _i = 0; _i < 2; ++_i) \
        __builtin_amdgcn_global_load_lds((const unsigned*)((const char*)(gbase) + (voff)[_i]), (PG8_LAS unsigned*)(lds + (bufoff) + ldsw + _i * 8192), 16, 0, 0); } while (0)
#define PG8_LDA(dst, b, h) do { _Pragma("unroll") for (int m = 0; m < 4; ++m) _Pragma("unroll") for (int k = 0; k < 2; ++k) dst[m][k] = *(const PG8_LAS bf16x8*)(lds + PG8_SA(b, h) + aoff + m * 2048 + k * 1024); } while (0)
#define PG8_LDB(dst, b, h) do { _Pragma("unroll") for (int n = 0; n < 2; ++n) _Pragma("unroll") for (int k = 0; k < 2; ++k) dst[n][k] = *(const PG8_LAS bf16x8*)(lds + PG8_SB(b, h) + boff + n * 2048 + k * 1024); } while (0)
#define PG8_MMA(ai, bj, At, Bt) do { __builtin_amdgcn_s_setprio(1); _Pragma("unroll") for (int m = 0; m < 4; ++m) _Pragma("unroll") for (int n = 0; n < 2; ++n) _Pragma("unroll") for (int k = 0; k < 2; ++k) \
        acc[ai][bj][m][n] = MK_MFMA(Bt[n][k], At[m][k], acc[ai][bj][m][n]); __builtin_amdgcn_s_setprio(0); } while (0)
#define PG8_WAIT_V(n) asm volatile("s_waitcnt vmcnt(" #n ")" ::: "memory")
#define PG8_WAIT_L(n) asm volatile("s_waitcnt lgkmcnt(" #n ")" ::: "memory")
#define PG8_BAR __builtin_amdgcn_s_barrier()
#define PG8_SCHED __builtin_amdgcn_sched_barrier(0)
    Unit cur, nxt; int ui = 0;
    if (!S.next(0, cur)) return;
    f32x4 acc[2][2][4][2];
#pragma unroll
    for (int a = 0; a < 2; ++a)
#pragma unroll
        for (int b = 0; b < 2; ++b)
#pragma unroll
            for (int m = 0; m < 4; ++m)
#pragma unroll
                for (int n = 0; n < 2; ++n) acc[a][b][m][n] = (f32x4){0.f, 0.f, 0.f, 0.f};
    bf16x8 At[4][2], B0[2][2], B1[2][2];
    const char* cA = (const char*)g.A + (size_t)cur.pm * tstep; const char* cB = (const char*)g.Bt + (size_t)cur.pn * tstep;
    S.a_ready(cur);
    if constexpr (SP2) {
        PG8_STAGE(PG8_SB(0, 0), cB, voffB); PG8_STAGE(PG8_SB(0, 1), cB + hstep, voffB); PG8_STAGE(PG8_SA(0, 0), cA, voffA); PG8_STAGE(PG8_SA(0, 1), cA + hstep, voffA);
        if (wr == 1) PG8_BAR;
        PG8_WAIT_V(2); PG8_BAR;
        PG8_STAGE(PG8_SB(1, 0), cB + kstep, voffB); PG8_STAGE(PG8_SA(1, 0), cA + kstep, voffA); PG8_STAGE(PG8_SB(1, 1), cB + hstep + kstep, voffB);
        PG8_WAIT_V(6); PG8_BAR;
    } else {
        PG8_STAGE(PG8_SB(0, 0), cB, voffB); PG8_STAGE(PG8_SA(0, 0), cA, voffA); PG8_STAGE(PG8_SB(0, 1), cB + hstep, voffB); PG8_STAGE(PG8_SA(0, 1), cA + hstep, voffA);
        if (wr == 1) PG8_BAR;
        PG8_WAIT_V(4); PG8_BAR;
        PG8_STAGE(PG8_SB(1, 0), cB + kstep, voffB); PG8_STAGE(PG8_SA(1, 0), cA + kstep, voffA); PG8_STAGE(PG8_SB(1, 1), cB + hstep + kstep, voffB);
        PG8_WAIT_V(6); PG8_BAR;
    }
    for (;;) {
        const bool has_next = S.next(ui + 1, nxt);
        const char* nA = has_next ? (const char*)g.A + (size_t)nxt.pm * tstep : cA; const char* nB = has_next ? (const char*)g.Bt + (size_t)nxt.pn * tstep : cB;
        for (int t = 0; t < nt; t += 2) {
            const bool last = (t == nt - 2);
            const char* a1 = cA + (size_t)(t + 1) * kstep;
            const char* a2 = last ? nA : cA + (size_t)(t + 2) * kstep; const char* b2 = last ? nB : cB + (size_t)(t + 2) * kstep;
            const char* a3 = a2 + kstep; const char* b3 = b2 + kstep;
            if (last && has_next) S.a_ready(nxt);
            if constexpr (SP2) {
            PG8_LDB(B0, 0, 0); PG8_LDB(B1, 0, 1); PG8_SCHED; PG8_LDA(At, 0, 0); PG8_STAGE(PG8_SA(1, 1), a1 + hstep, voffA);
            PG8_WAIT_V(8); PG8_WAIT_L(0); PG8_BAR; PG8_MMA(0, 0, At, B0); PG8_MMA(0, 1, At, B1); PG8_BAR; PG8_SCHED;
            PG8_LDA(At, 0, 1); PG8_STAGE(PG8_SB(0, 0), b2, voffB); PG8_STAGE(PG8_SB(0, 1), b2 + hstep, voffB); PG8_STAGE(PG8_SA(0, 0), a2, voffA);
            PG8_WAIT_V(8); PG8_WAIT_L(0); PG8_BAR; PG8_MMA(1, 0, At, B0); PG8_MMA(1, 1, At, B1); PG8_BAR; PG8_SCHED;
            PG8_LDB(B0, 1, 0); PG8_LDB(B1, 1, 1); PG8_SCHED; PG8_LDA(At, 1, 0); PG8_STAGE(PG8_SA(0, 1), a2 + hstep, voffA);
            PG8_WAIT_V(8); PG8_WAIT_L(0); PG8_BAR; PG8_MMA(0, 0, At, B0); PG8_MMA(0, 1, At, B1); PG8_BAR; PG8_SCHED;
            PG8_LDA(At, 1, 1); PG8_STAGE(PG8_SB(1, 0), b3, voffB); PG8_STAGE(PG8_SB(1, 1), b3 + hstep, voffB); PG8_STAGE(PG8_SA(1, 0), a3, voffA);
            PG8_WAIT_V(8); PG8_WAIT_L(0); PG8_BAR; PG8_MMA(1, 0, At, B0); PG8_MMA(1, 1, At, B1); PG8_BAR; PG8_SCHED;
            } else {
            PG8_LDB(B0, 0, 0); PG8_SCHED; PG8_LDA(At, 0, 0); PG8_STAGE(PG8_SA(1, 1), a1 + hstep, voffA);
            PG8_WAIT_L(8); PG8_BAR; PG8_WAIT_L(0); PG8_MMA(0, 0, At, B0); PG8_BAR; PG8_SCHED;
            PG8_LDB(B1, 0, 1); PG8_STAGE(PG8_SB(0, 0), b2, voffB);
            PG8_BAR; PG8_WAIT_L(0); PG8_MMA(0, 1, At, B1); PG8_BAR;
            PG8_LDA(At, 0, 1); PG8_STAGE(PG8_SA(0, 0), a2, voffA);
            PG8_BAR; PG8_WAIT_L(0); PG8_MMA(1, 0, At, B0); PG8_BAR; PG8_SCHED;
            PG8_STAGE(PG8_SB(0, 1), b2 + hstep, voffB);
            PG8_WAIT_V(6); PG8_BAR; PG8_MMA(1, 1, At, B1); PG8_BAR;
            PG8_LDB(B0, 1, 0); PG8_SCHED; PG8_LDA(At, 1, 0); PG8_STAGE(PG8_SA(0, 1), a2 + hstep, voffA);
            PG8_WAIT_L(8); PG8_BAR; PG8_WAIT_L(0); PG8_MMA(0, 0, At, B0); PG8_BAR; PG8_SCHED;
            PG8_LDB(B1, 1, 1); PG8_STAGE(PG8_SB(1, 0), b3, voffB);
            PG8_BAR; PG8_WAIT_L(0); PG8_MMA(0, 1, At, B1); PG8_BAR;
            PG8_LDA(At, 1, 1); PG8_STAGE(PG8_SA(1, 0), a3, voffA);
            PG8_BAR; PG8_WAIT_L(0); PG8_MMA(1, 0, At, B0); PG8_BAR; PG8_SCHED;
            PG8_STAGE(PG8_SB(1, 1), b3 + hstep, voffB);
            PG8_WAIT_V(6); PG8_BAR; PG8_MMA(1, 1, At, B1); PG8_BAR;
            }
        }
        if constexpr (ALIGN_EPI) { if (wr == 0) PG8_BAR; }
        if constexpr (!Epi::AFTER_DRAIN) { E(acc, cur, wr, wc, fr, fq); S.done(cur); }
        if (!has_next) break;
#pragma unroll
        for (int a = 0; a < 2; ++a)
#pragma unroll
            for (int b = 0; b < 2; ++b)
#pragma unroll
                for (int m = 0; m < 4; ++m)
#pragma unroll
                    for (int n = 0; n < 2; ++n) acc[a][b][m][n] = (f32x4){0.f, 0.f, 0.f, 0.f};
        cur = nxt; cA = nA; cB = nB; ++ui;
        if constexpr (ALIGN_EPI) { if (wr == 1) PG8_BAR; }
    }
    PG8_WAIT_V(0);
    if constexpr (!ALIGN_EPI) { if (wr == 0) PG8_BAR; }
    PG8_BAR;
    if constexpr (Epi::AFTER_DRAIN) { E.fused(acc, cur, wr, wc, fr, fq, lds, wid, lane); S.done(cur); }
#undef PG8_SA
#undef PG8_SB
#undef PG8_STAGE
#undef PG8_LDA
#undef PG8_LDB
#undef PG8_MMA
#undef PG8_WAIT_V
#undef PG8_WAIT_L
#undef PG8_BAR
#undef PG8_SCHED
}
}

constexpr int BATCH = 2, SEQ = 8192, DM = 1024, DEPTH = 2, M = BATCH * SEQ;
constexpr int RW_H = 6, HD = 64, RW_W = 384, RW_SHIFT = 1280;
constexpr int NIN = 3712, NU = 3840;
constexpr int C_R = 0, C_K = 384, C_V = 768, C_WL = 1152, C_AL = 1216, C_RWZ = 1280, C_HGQ = 1664, C_HGF = 2048, C_HGI = 2432, C_HGZ = 2816, C_LRUX = 3200, C_LRUZ = 3456;
constexpr int CH = 64;
constexpr int NWAVES = 8, NT = NWAVES * 64;
constexpr int LDS_BYTES = 163840;
constexpr int PRM_OFF = 138240;
constexpr size_t MiB = 1u << 20;
constexpr size_t WS_WUPT = 65536, WS_AUPT = WS_WUPT + 98304, WS_VDNT = WS_AUPT + 98304, WS_VUPT = WS_VDNT + 24576, WS_WAT = WS_VUPT + 24576, WS_WXT = WS_WAT + 65536;
constexpr size_t WS_WIN = 1 * MiB, WIN_L = (size_t)NU * DM * 2;
constexpr size_t WS_WOUT = 16 * MiB, WOUT_L = (size_t)DM * DM * 2;
constexpr size_t WS_XN = 20 * MiB;
constexpr size_t WS_QT = 20 * MiB;
constexpr size_t WS_PT = 32 * MiB;
constexpr size_t WS_CA = 44 * MiB;
constexpr size_t WS_U = 52 * MiB;
constexpr size_t WS_MIX = 172 * MiB;
constexpr size_t WS_VF = 204 * MiB;
constexpr size_t WS_VP = 216 * MiB;
constexpr size_t WS_RL = 228 * MiB;
constexpr size_t WS_HL = 240 * MiB;
constexpr size_t WS_BON = 252 * MiB;
constexpr size_t WS_DC = WS_BON + 512 * 1024;
constexpr size_t WS_LA = WS_DC + 512 * 1024;
constexpr size_t WS_LH = WS_LA + 256 * 1024;
constexpr size_t WS_END = 254 * MiB;
constexpr int NCH = SEQ / CH;

#define LAS __attribute__((address_space(3)))
typedef float f32x4 __attribute__((ext_vector_type(4)));
typedef unsigned u32x2 __attribute__((ext_vector_type(2)));
typedef unsigned u32x4 __attribute__((ext_vector_type(4)));
typedef _Float16 f16;
typedef _Float16 f16x8 __attribute__((ext_vector_type(8)));
#define LDS_WAIT() asm volatile("s_waitcnt lgkmcnt(0)" ::: "memory")

struct Args { const float* in[27]; float* out; unsigned char* ws; };

__device__ __forceinline__ float wave_sum(float v) {
#pragma unroll
    for (int o = 1; o < 64; o <<= 1) v += shfl_xor_f(v, o);
    return v;
}
__device__ __forceinline__ float sigmoidf_(float x) { return 1.0f / (1.0f + __expf(-x)); }
__device__ __forceinline__ float siluf_(float x) { return x / (1.0f + __expf(-x)); }

__device__ __forceinline__ void p0_transpose_item(const float* W, int K, int N, unsigned short* WT, LAS float* scr, int item, int lane) {
    const int nblk = N / 32, kb = item / nblk, nb = item % nblk, k0 = 64 * kb, n0 = 32 * nb;
#pragma unroll 8
    for (int i = 0; i < 32; ++i) { const int kk = 2 * i + (lane >> 5); scr[kk * 33 + (lane & 31)] = W[(size_t)(k0 + kk) * N + n0 + (lane & 31)]; }
    LDS_WAIT(); asm volatile("" ::: "memory");
    const int c = lane & 7;
#pragma unroll
    for (int j = 0; j < 4; ++j) { const int n = (lane >> 3) + 8 * j; const LAS float* s = scr + (8 * c) * 33 + n;
        u32x4 o; o.x = pg8::pk_f16(s[0 * 33], s[1 * 33]); o.y = pg8::pk_f16(s[2 * 33], s[3 * 33]); o.z = pg8::pk_f16(s[4 * 33], s[5 * 33]); o.w = pg8::pk_f16(s[6 * 33], s[7 * 33]);
        *(u32x4*)(WT + (size_t)(n0 + n) * K + k0 + 8 * c) = o; }
    LDS_WAIT(); asm volatile("" ::: "memory");
}
__device__ __forceinline__ void rms_row_f16(const float* xrow, const float* w, unsigned short* orow, int lane) {
    const f32x4* xr = (const f32x4*)xrow + lane; const f32x4* wr = (const f32x4*)w + lane;
    f32x4 v[4]; float s = 0.f;
#pragma unroll
    for (int j = 0; j < 4; ++j) { v[j] = xr[64 * j]; s += (v[j].x * v[j].x + v[j].y * v[j].y) + (v[j].z * v[j].z + v[j].w * v[j].w); }
    const float rs = 1.0f / sqrtf(wave_sum(s) * (1.0f / DM) + 1e-6f);
    u32x2* o8 = (u32x2*)orow + lane;
#pragma unroll
    for (int j = 0; j < 4; ++j) { const f32x4 ww = wr[64 * j]; u32x2 o; o.x = pg8::pk_f16(v[j].x * rs * ww.x, v[j].y * rs * ww.y); o.y = pg8::pk_f16(v[j].z * rs * ww.z, v[j].w * rs * ww.w); o8[64 * j] = o; }
}
__device__ __forceinline__ void rms_row_f32(float* xrow, const float* w, int lane) {
    f32x4* xr = (f32x4*)xrow + lane; const f32x4* wr = (const f32x4*)w + lane;
    f32x4 v[4]; float s = 0.f;
#pragma unroll
    for (int j = 0; j < 4; ++j) { v[j] = xr[64 * j]; s += (v[j].x * v[j].x + v[j].y * v[j].y) + (v[j].z * v[j].z + v[j].w * v[j].w); }
    const float rs = 1.0f / sqrtf(wave_sum(s) * (1.0f / DM) + 1e-6f);
#pragma unroll
    for (int j = 0; j < 4; ++j) { const f32x4 ww = wr[64 * j]; xr[64 * j] = v[j] * rs * ww; }
}


#define SHV(col) ({ const float cur_ = (float)urow[(col)]; const float prev_ = hp ? (float)prow[(col)] : 0.f; cur_ + mu[(col)] * (prev_ - cur_); })

__device__ __forceinline__ void store_row64_f16(f16* dst, const float (&S)[64]) {
#pragma unroll
    for (int q = 0; q < 8; ++q) { u32x4 w; w.x = pg8::pk_f16(S[8 * q], S[8 * q + 1]); w.y = pg8::pk_f16(S[8 * q + 2], S[8 * q + 3]); w.z = pg8::pk_f16(S[8 * q + 4], S[8 * q + 5]); w.w = pg8::pk_f16(S[8 * q + 6], S[8 * q + 7]); *(u32x4*)(dst + 8 * q) = w; }
}


constexpr int RWA_REC = 656  , RWA_VROW = 136, RWA_VPL = 16 * RWA_REC, RWA_INV = RWA_VPL + 16 * RWA_VROW, RWA_BYTES = 12800;
constexpr int C_VD0 = 3712, C_VD1 = 3744;
constexpr int PRM_MU = 0, PRM_W0 = 1280, PRM_A0 = 1664, PRM_KK = 2048, PRM_KA = 2432, PRM_RK = 2816, PRM_V0 = 3200, PRM_FLOATS = 3584;
typedef float f32x2 __attribute__((ext_vector_type(2)));
typedef _Float16 f16x4 __attribute__((ext_vector_type(4)));
__device__ __forceinline__ float fmix_lo(float a, unsigned b, float c) { float d; asm("v_fma_mix_f32 %0, %1, %2, %3 op_sel:[0,0,0] op_sel_hi:[0,1,0]" : "=v"(d) : "v"(a), "v"(b), "v"(c)); return d; }
__device__ __forceinline__ float fmix_hi(float a, unsigned b, float c) { float d; asm("v_fma_mix_f32 %0, %1, %2, %3 op_sel:[0,1,0] op_sel_hi:[0,1,0]" : "=v"(d) : "v"(a), "v"(b), "v"(c)); return d; }
__device__ __forceinline__ float mmix_lo(float a, unsigned b) { float d; asm("v_fma_mix_f32 %0, %1, %2, 0 op_sel:[0,0,0] op_sel_hi:[0,1,0]" : "=v"(d) : "v"(a), "v"(b)); return d; }
__device__ __forceinline__ float mmix_hi(float a, unsigned b) { float d; asm("v_fma_mix_f32 %0, %1, %2, 0 op_sel:[0,1,0] op_sel_hi:[0,1,0]" : "=v"(d) : "v"(a), "v"(b)); return d; }
__device__ __forceinline__ float fma_asm(float a, float b, float c) { float d; asm("v_fma_f32 %0, %1, %2, %3" : "=v"(d) : "v"(a), "v"(b), "v"(c)); return d; }
#define FMIX(a, u, j, c) (((j) & 1) ? fmix_hi((a), (u)[(j) >> 1], (c)) : fmix_lo((a), (u)[(j) >> 1], (c)))
#define MMIX(a, u, j) (((j) & 1) ? mmix_hi((a), (u)[(j) >> 1]) : mmix_lo((a), (u)[(j) >> 1]))
__device__ __forceinline__ float fast_tanh(float x) { return 1.0f - 2.0f / (__expf(2.0f * x) + 1.0f); }
__device__ __forceinline__ void lerp8(const char* ub, unsigned uo, unsigned po, bool hp, const char* mub, unsigned col, float (&x)[8]) {
    const f16x8 cu = *(const f16x8*)(ub + (uo + col * 2u)); f16x8 pv = *(const f16x8*)(ub + (po + col * 2u)); const f32x4 m0 = *(const f32x4*)(mub + col * 4u), m1 = *(const f32x4*)(mub + col * 4u + 16u);
#pragma unroll
    for (int j = 0; j < 8; ++j) { const float c = (float)cu[j], p = hp ? (float)pv[j] : 0.f; x[j] = c + (j < 4 ? m0[j] : m1[j - 4]) * (p - c); }
}
__device__ __forceinline__ void lerp4(const char* ub, unsigned uo, unsigned po, bool hp, const char* mub, unsigned col, float (&x)[4]) {
    const f16x4 cu = *(const f16x4*)(ub + (uo + col * 2u)); f16x4 pv = *(const f16x4*)(ub + (po + col * 2u)); const f32x4 m0 = *(const f32x4*)(mub + col * 4u);
#pragma unroll
    for (int j = 0; j < 4; ++j) { const float c = (float)cu[j], p = hp ? (float)pv[j] : 0.f; x[j] = c + m0[j] * (p - c); }
}
__device__ __forceinline__ f16x8 pack8(const float (&x)[8]) { f16x8 r;
#pragma unroll
    for (int j = 0; j < 8; ++j) r[j] = (f16)x[j];
    return r; }

__device__ __forceinline__ void rwkv_waveA(const Args& a, int l, int b, int c, int h, LAS unsigned char* wl, const LAS float* prm, int lane) {
    const char* Ub = (const char*)(a.ws + WS_U); f16* MIX = (f16*)(a.ws + WS_MIX); char* VF = (char*)(a.ws + WS_VF); char* VP = (char*)(a.ws + WS_VP);
    f16* QT = (f16*)(a.ws + WS_QT); f16* PT = (f16*)(a.ws + WS_PT); f16* RL = (f16*)(a.ws + WS_RL); float* BONG = (float*)(a.ws + WS_BON);
    const char* WUPT = (const char*)(a.ws + WS_WUPT) + (size_t)l * 384 * 64 * 2; const char* AUPT = (const char*)(a.ws + WS_AUPT) + (size_t)l * 384 * 64 * 2;
    const char* VUPT = (const char*)(a.ws + WS_VUPT);
    const int bh = b * RW_H + h;
    float P[64], L[64];
#pragma unroll
    for (int k = 0; k < 64; ++k) { P[k] = (k == lane) ? 1.f : 0.f; L[k] = 0.f; }
#pragma unroll 1
    for (int blk = 0; blk < 4; ++blk) {
        const int lane_ = lane_now();
        const int tok = lane_ & 15, fq = lane_ >> 4;
        const int t = c * CH + blk * 16 + tok; const unsigned m = (unsigned)(b * SEQ + t); const bool hp = t > 0;
        const unsigned uo = m * (unsigned)(NU * 2), po = hp ? uo - (unsigned)(NU * 2) : uo;
        f16x8 cW[2], pW[2], cA[2], pA[2], vd0, vd1;
#pragma unroll
        for (int s = 0; s < 2; ++s) { const unsigned cw = (unsigned)(C_WL + 8 * fq + 32 * s) * 2u, ca = (unsigned)(C_AL + 8 * fq + 32 * s) * 2u;
            cW[s] = *(const f16x8*)(Ub + uo + cw); pW[s] = *(const f16x8*)(Ub + po + cw); cA[s] = *(const f16x8*)(Ub + uo + ca); pA[s] = *(const f16x8*)(Ub + po + ca); }
        if (l > 0) { vd0 = *(const f16x8*)(Ub + uo + (unsigned)(C_VD0 + 8 * fq) * 2u); vd1 = *(const f16x8*)(Ub + po + (unsigned)(C_VD1 + 8 * fq) * 2u); }
#define RW_TLOAD(X, nt) f16x8 X##wu0, X##wu1, X##au0, X##au1, X##vu; f16x4 X##cr, X##pr, X##ck, X##pk, X##cv, X##pv, X##vf; { \
            const unsigned n_ = (unsigned)(h * 64 + 16 * (nt) + tok), cb_ = (unsigned)(h * 64 + 16 * (nt) + 4 * fq); \
            X##wu0 = *(const f16x8*)(WUPT + (n_ * 64u + 8u * fq) * 2u); X##wu1 = *(const f16x8*)(WUPT + (n_ * 64u + 8u * fq + 32u) * 2u); \
            X##au0 = *(const f16x8*)(AUPT + (n_ * 64u + 8u * fq) * 2u); X##au1 = *(const f16x8*)(AUPT + (n_ * 64u + 8u * fq + 32u) * 2u); \
            if (l > 0) { X##vu = *(const f16x8*)(VUPT + (n_ * 32u + 8u * fq) * 2u); X##vf = *(const f16x4*)(VF + (m * (unsigned)RW_W + cb_) * 2u); } \
            X##cr = *(const f16x4*)(Ub + uo + ((unsigned)C_R + cb_) * 2u); X##pr = *(const f16x4*)(Ub + po + ((unsigned)C_R + cb_) * 2u); \
            X##ck = *(const f16x4*)(Ub + uo + ((unsigned)C_K + cb_) * 2u); X##pk = *(const f16x4*)(Ub + po + ((unsigned)C_K + cb_) * 2u); \
            X##cv = *(const f16x4*)(Ub + uo + ((unsigned)C_V + cb_) * 2u); X##pv = *(const f16x4*)(Ub + po + ((unsigned)C_V + cb_) * 2u); }
        f16x8 bW[2], bA[2], bVD;
#pragma unroll
        for (int s = 0; s < 2; ++s) { float xw[8], xa[8];
            const f32x4 mw0 = *(const LAS f32x4*)(prm + PRM_MU + C_WL + 8 * fq + 32 * s), mw1 = *(const LAS f32x4*)(prm + PRM_MU + C_WL + 8 * fq + 32 * s + 4);
            const f32x4 ma0 = *(const LAS f32x4*)(prm + PRM_MU + C_AL + 8 * fq + 32 * s), ma1 = *(const LAS f32x4*)(prm + PRM_MU + C_AL + 8 * fq + 32 * s + 4);
#pragma unroll
            for (int j = 0; j < 8; ++j) { const float cw_ = (float)cW[s][j], pw_ = hp ? (float)pW[s][j] : 0.f, ca_ = (float)cA[s][j], pa_ = hp ? (float)pA[s][j] : 0.f;
                xw[j] = fast_tanh(cw_ + (j < 4 ? mw0[j & 3] : mw1[j & 3]) * (pw_ - cw_)); xa[j] = ca_ + (j < 4 ? ma0[j & 3] : ma1[j & 3]) * (pa_ - ca_); }
            bW[s] = pack8(xw); bA[s] = pack8(xa); }
        if (l > 0) { float xv[8];
#pragma unroll
            for (int j = 0; j < 8; ++j) xv[j] = (float)vd0[j] + (hp ? (float)vd1[j] : 0.f);
            bVD = pack8(xv); }
        float ssq = 0.f, bon = 0.f;
        LAS unsigned char* rec = wl + tok * RWA_REC;
#define RW_TCOMP(X, nt) { const int cb = h * 64 + 16 * (nt) + 4 * fq, co = 16 * (nt) + 4 * fq; \
            f32x4 DWn = (f32x4){0.f, 0.f, 0.f, 0.f}, DAn = DWn, Gn = DWn; \
            DWn = __builtin_amdgcn_mfma_f32_16x16x32_f16(X##wu0, bW[0], DWn, 0, 0, 0); DWn = __builtin_amdgcn_mfma_f32_16x16x32_f16(X##wu1, bW[1], DWn, 0, 0, 0); \
            DAn = __builtin_amdgcn_mfma_f32_16x16x32_f16(X##au0, bA[0], DAn, 0, 0, 0); DAn = __builtin_amdgcn_mfma_f32_16x16x32_f16(X##au1, bA[1], DAn, 0, 0, 0); \
            if (l > 0) Gn = __builtin_amdgcn_mfma_f32_16x16x32_f16(X##vu, bVD, Gn, 0, 0, 0); \
            f16x4 wv, al, be, km, rr, vo; \
            _Pragma("unroll") for (int i = 0; i < 4; ++i) { const LAS float* pc = prm + cb + i; \
                const float cr_ = (float)X##cr[i], ck_ = (float)X##ck[i], cv_ = (float)X##cv[i]; \
                const float rs = cr_ + pc[PRM_MU + C_R] * ((hp ? (float)X##pr[i] : 0.f) - cr_), ks = ck_ + pc[PRM_MU + C_K] * ((hp ? (float)X##pk[i] : 0.f) - ck_), vs = cv_ + pc[PRM_MU + C_V] * ((hp ? (float)X##pv[i] : 0.f) - cv_); \
                wv[i] = (f16)__expf(-0.6065306597126334f * sigmoidf_(pc[PRM_W0] + DWn[i])); \
                const float aa = sigmoidf_(pc[PRM_A0] + DAn[i]); \
                float vv = vs; if (l > 0) vv = vs + ((float)X##vf[i] - vs) * sigmoidf_(pc[PRM_V0] + Gn[i]); \
                const float kk = ks * pc[PRM_KK]; ssq += kk * kk; \
                const float kmod = ks * (1.0f + (aa - 1.0f) * pc[PRM_KA]); \
                bon += rs * kmod * pc[PRM_RK]; \
                al[i] = (f16)(-kk); be[i] = (f16)(kk * aa); km[i] = (f16)kmod; rr[i] = (f16)rs; vo[i] = (f16)vv; \
                asm volatile("" ::: "memory"); } \
            *(LAS f16x4*)(rec + co * 2) = wv; \
            *(LAS f16x4*)(rec + 128 + co * 2) = al; *(LAS f16x4*)(rec + 256 + co * 2) = be; *(LAS f16x4*)(rec + 384 + co * 2) = km; *(LAS f16x4*)(rec + 512 + co * 2) = rr; \
            *(LAS f16x4*)(wl + RWA_VPL + tok * RWA_VROW + co * 2) = vo; \
            *(f16x4*)(VP + (m * (unsigned)RW_W + (unsigned)cb) * 2u) = vo; \
            if (l == 0) *(f16x4*)(VF + (m * (unsigned)RW_W + (unsigned)cb) * 2u) = vo; }
#pragma unroll 1
        for (int nt = 0; nt < 4; ++nt) { RW_TLOAD(T0, nt) RW_TCOMP(T0, nt) asm volatile("" ::: "memory"); }
#undef RW_TLOAD
#undef RW_TCOMP
        ssq += shfl_xor_f(ssq, 16); ssq += shfl_xor_f(ssq, 32);
        bon += shfl_xor_f(bon, 16); bon += shfl_xor_f(bon, 32);
        { const float inv = 1.0f / fmaxf(sqrtf(ssq), 1e-12f);
          if (fq == 0) { *(LAS float*)(wl + RWA_INV + tok * 4) = inv * inv; *(float*)((char*)BONG + (m * 8u + (unsigned)h) * 4u) = bon; } }
        const unsigned mb = (unsigned)(b * SEQ + c * CH + blk * 16);
        asm volatile("s_waitcnt lgkmcnt(0)" ::: "memory");
        u32x4 A[8];
#pragma unroll
        for (int g = 0; g < 8; ++g) A[g] = *(const LAS u32x4*)(wl + 128 + g * 16);
        float vv = (float)*(const LAS f16*)(wl + RWA_VPL + lane_ * 2); float inv2 = *(const LAS float*)(wl + RWA_INV);
#define RW_LDU(W4, B4, K4, R4, g) { W4 = *(const LAS u32x4*)(rc + (g) * 16); B4 = *(const LAS u32x4*)(rc + 256 + (g) * 16); K4 = *(const LAS u32x4*)(rc + 384 + (g) * 16); R4 = *(const LAS u32x4*)(rc + 512 + (g) * 16); }
#define RW_COMP(W4, B4, K4, R4, g) { float tP[8], tL[8]; \
            _Pragma("unroll") for (int j = 0; j < 8; ++j) tP[j] = MMIX(saP, B4, j); \
            _Pragma("unroll") for (int j = 0; j < 8; ++j) tL[j] = MMIX(saL, B4, j); \
            _Pragma("unroll") for (int j = 0; j < 8; ++j) tL[j] = FMIX(vv, K4, j, tL[j]); \
            _Pragma("unroll") for (int j = 0; j < 8; ++j) P[8 * (g) + j] = FMIX(P[8 * (g) + j], W4, j, tP[j]); \
            _Pragma("unroll") for (int j = 0; j < 8; ++j) L[8 * (g) + j] = FMIX(L[8 * (g) + j], W4, j, tL[j]); \
            _Pragma("unroll") for (int j = 0; j < 8; ++j) qa[j] = FMIX(P[8 * (g) + j], R4, j, qa[j]); \
            _Pragma("unroll") for (int j = 0; j < 8; ++j) ya[j] = FMIX(L[8 * (g) + j], R4, j, ya[j]); }
#pragma unroll 1
        for (int t2 = 0; t2 < 16; ++t2) {
            const LAS unsigned char* rc = wl + t2 * RWA_REC;
            u32x4 we, be, ke, re, wo, bo, ko, ro;
            RW_LDU(we, be, ke, re, 0)
            float sP[8], sL[8];
#pragma unroll
            for (int j = 0; j < 8; ++j) { sP[j] = 0.f; sL[j] = 0.f; }
#pragma unroll
            for (int g = 0; g < 8; ++g) {
#pragma unroll
                for (int j = 0; j < 8; ++j) sP[j] = FMIX(P[8 * g + j], A[g], j, sP[j]);
#pragma unroll
                for (int j = 0; j < 8; ++j) sL[j] = FMIX(L[8 * g + j], A[g], j, sL[j]); }
            const float saP = inv2 * (((sP[0] + sP[1]) + (sP[2] + sP[3])) + ((sP[4] + sP[5]) + (sP[6] + sP[7]))), saL = inv2 * (((sL[0] + sL[1]) + (sL[2] + sL[3])) + ((sL[4] + sL[5]) + (sL[6] + sL[7])));
            float qa[8], ya[8];
#pragma unroll
            for (int j = 0; j < 8; ++j) { qa[j] = 0.f; ya[j] = 0.f; }
            RW_LDU(wo, bo, ko, ro, 1) RW_COMP(we, be, ke, re, 0)
            RW_LDU(we, be, ke, re, 2) RW_COMP(wo, bo, ko, ro, 1)
            RW_LDU(wo, bo, ko, ro, 3) RW_COMP(we, be, ke, re, 2)
            RW_LDU(we, be, ke, re, 4) RW_COMP(wo, bo, ko, ro, 3)
            RW_LDU(wo, bo, ko, ro, 5) RW_COMP(we, be, ke, re, 4)
            RW_LDU(we, be, ke, re, 6) RW_COMP(wo, bo, ko, ro, 5)
            RW_LDU(wo, bo, ko, ro, 7) RW_COMP(we, be, ke, re, 6)
            const float vvn = (float)*(const LAS f16*)(wl + RWA_VPL + ((t2 + 1) & 15) * RWA_VROW + lane_ * 2); const float inv2n = *(const LAS float*)(wl + RWA_INV + ((t2 + 1) & 15) * 4);
#pragma unroll
            for (int g = 0; g < 8; ++g) A[g] = *(const LAS u32x4*)(rc + RWA_REC + 128 + g * 16);
            RW_COMP(wo, bo, ko, ro, 7)
            vv = vvn; inv2 = inv2n;
            *(f16*)((char*)MIX + ((mb + t2) * (unsigned)DM + (unsigned)(h * 64 + lane_)) * 2u) = (f16)(((ya[0] + ya[1]) + (ya[2] + ya[3])) + ((ya[4] + ya[5]) + (ya[6] + ya[7])));
            *(f16*)((char*)QT + ((mb + t2) * (unsigned)RW_W + (unsigned)(h * 64 + lane_)) * 2u) = (f16)(((qa[0] + qa[1]) + (qa[2] + qa[3])) + ((qa[4] + qa[5]) + (qa[6] + qa[7])));
        }
#undef RW_LDU
#undef RW_COMP
    }
    store_row64_f16(RL + (((size_t)bh * NCH + c) * 64 + lane) * 64, L);
    f16* pt = PT + ((size_t)bh * NCH + c) * 4096;
#pragma unroll
    for (int k = 0; k < 64; ++k) pt[k * 64 + lane] = (f16)P[k];
}

constexpr int HGA_REC = 384, HGA_HEAD = 16 * HGA_REC, HGA_DP = 3 * HGA_HEAD, HGA_BYTES = HGA_DP + 768;
__device__ __forceinline__ void hgrn_waveA(const Args& a, int l, int b, int c, int h0, LAS unsigned char* wl, int lane) {
    f16* U = (f16*)(a.ws + WS_U); f16* MIX = (f16*)(a.ws + WS_MIX); f16* HL = (f16*)(a.ws + WS_HL); float* DC = (float*)(a.ws + WS_DC);
    const float* lbr = a.in[16];
    float S0[64], S1[64], S2[64];
#pragma unroll
    for (int k = 0; k < 64; ++k) { S0[k] = 0.f; S1[k] = 0.f; S2[k] = 0.f; }
    { LAS float* dpl = (LAS float*)(wl + HGA_DP); dpl[lane] = 1.f; dpl[64 + lane] = 1.f; dpl[128 + lane] = 1.f; }
#pragma unroll 1
    for (int blk = 0; blk < 4; ++blk) {
        const int lane_ = lane_now();
        const unsigned mb = (unsigned)(b * SEQ + c * CH + blk * 16);
#pragma unroll 1
        for (int j = 0; j < 3; ++j) {
            const int col = (h0 + j) * 64 + lane_;
            const float lb = (l == 0) ? 0.f : sigmoidf_(lbr[384 + col] - lbr[col]);
            float dp = *(const LAS float*)(wl + HGA_DP + (j * 64 + lane_) * 4);
#pragma unroll 1
            for (int t8 = 0; t8 < 16; t8 += 8) {
                f16 fr[8], qr[8];
#pragma unroll
                for (int tk = 0; tk < 8; ++tk) { const char* ur = (const char*)U + (mb + t8 + tk) * (unsigned)(NU * 2); fr[tk] = *(const f16*)(ur + (unsigned)(C_HGF + col) * 2u); qr[tk] = *(const f16*)(ur + (unsigned)(C_HGQ + col) * 2u); }
#pragma unroll
                for (int tk = 0; tk < 8; ++tk) {
                    const float f = lb + (1.0f - lb) * sigmoidf_((float)fr[tk]);
                    LAS unsigned char* rec = wl + j * HGA_HEAD + (t8 + tk) * HGA_REC;
                    *(LAS f16*)(rec + lane_ * 2) = (f16)f; *(LAS f16*)(rec + 128 + lane_ * 2) = (f16)(1.0f - f); *(LAS f16*)(rec + 256 + lane_ * 2) = qr[tk];
                    dp *= f;
                    *(f16*)((char*)U + (mb + t8 + tk) * (unsigned)(NU * 2) + (unsigned)(C_HGQ + col) * 2u) = (f16)((float)qr[tk] * dp);
                }
            }
            *(LAS float*)(wl + HGA_DP + (j * 64 + lane_) * 4) = dp;
        }
        asm volatile("s_waitcnt lgkmcnt(0)" ::: "memory");
#define HG_LD(F4, K4, Q4, rcp, g) { F4 = *(const LAS u32x4*)((rcp) + (g) * 16); K4 = *(const LAS u32x4*)((rcp) + 128 + (g) * 16); Q4 = *(const LAS u32x4*)((rcp) + 256 + (g) * 16); }
#define HG_COMP(S, vi, F4, K4, Q4, g) { float tt[8]; \
            _Pragma("unroll") for (int jj = 0; jj < 8; ++jj) tt[jj] = MMIX(vi, K4, jj); \
            _Pragma("unroll") for (int jj = 0; jj < 8; ++jj) S[8 * (g) + jj] = FMIX(S[8 * (g) + jj], F4, jj, tt[jj]); \
            _Pragma("unroll") for (int jj = 0; jj < 8; ++jj) oa[jj] = FMIX(S[8 * (g) + jj], Q4, jj, oa[jj]); }
#define HG_HEAD(S, vi, rcp, rcn, oo) { float oa[8]; _Pragma("unroll") for (int jj = 0; jj < 8; ++jj) oa[jj] = 0.f; \
            HG_LD(f4o, k4o, q4o, rcp, 1) HG_COMP(S, vi, f4e, k4e, q4e, 0) \
            HG_LD(f4e, k4e, q4e, rcp, 2) HG_COMP(S, vi, f4o, k4o, q4o, 1) \
            HG_LD(f4o, k4o, q4o, rcp, 3) HG_COMP(S, vi, f4e, k4e, q4e, 2) \
            HG_LD(f4e, k4e, q4e, rcp, 4) HG_COMP(S, vi, f4o, k4o, q4o, 3) \
            HG_LD(f4o, k4o, q4o, rcp, 5) HG_COMP(S, vi, f4e, k4e, q4e, 4) \
            HG_LD(f4e, k4e, q4e, rcp, 6) HG_COMP(S, vi, f4o, k4o, q4o, 5) \
            HG_LD(f4o, k4o, q4o, rcp, 7) HG_COMP(S, vi, f4e, k4e, q4e, 6) \
            HG_LD(f4e, k4e, q4e, rcn, 0) HG_COMP(S, vi, f4o, k4o, q4o, 7) \
            oo = ((oa[0] + oa[1]) + (oa[2] + oa[3])) + ((oa[4] + oa[5]) + (oa[6] + oa[7])); }
        u32x4 f4e, k4e, q4e, f4o, k4o, q4o;
        HG_LD(f4e, k4e, q4e, wl, 0)
        const char* ur0 = (const char*)U + mb * (unsigned)(NU * 2) + (unsigned)(C_HGI + h0 * 64 + lane_) * 2u;
        f16 v0h = *(const f16*)(ur0), v1h = *(const f16*)(ur0 + 128), v2h = *(const f16*)(ur0 + 256);
#pragma unroll 1
        for (int t2 = 0; t2 < 16; ++t2) {
            const LAS unsigned char* rc = wl + t2 * HGA_REC;
            const char* urn = ur0 + (unsigned)((t2 + 1) & 15) * (unsigned)(NU * 2);
            float oa_, ob_, oc_;
            { const float vi = (float)v0h; HG_HEAD(S0, vi, rc, rc + HGA_HEAD, oa_) } v0h = *(const f16*)(urn);
            { const float vi = (float)v1h; HG_HEAD(S1, vi, rc + HGA_HEAD, rc + 2 * HGA_HEAD, ob_) } v1h = *(const f16*)(urn + 128);
            { const float vi = (float)v2h; HG_HEAD(S2, vi, rc + 2 * HGA_HEAD, rc + HGA_REC, oc_) } v2h = *(const f16*)(urn + 256);
            char* mo = (char*)MIX + ((mb + t2) * (unsigned)DM + (unsigned)(384 + h0 * 64 + lane_)) * 2u;
            *(f16*)mo = (f16)oa_; *(f16*)(mo + 128) = (f16)ob_; *(f16*)(mo + 256) = (f16)oc_;
        }
#undef HG_LD
#undef HG_COMP
#undef HG_HEAD
    }
    const int lane2 = lane_now();
#define HG_OUT(S, j, dp) { const int bh = b * 6 + h0 + (j); store_row64_f16(HL + (((size_t)bh * NCH + c) * 64 + lane2) * 64, S);     \
        DC[((size_t)bh * NCH + c) * 64 + lane2] = dp; }
    HG_OUT(S0, 0, *(const LAS float*)(wl + HGA_DP + lane2 * 4)) HG_OUT(S1, 1, *(const LAS float*)(wl + HGA_DP + (64 + lane2) * 4)) HG_OUT(S2, 2, *(const LAS float*)(wl + HGA_DP + (128 + lane2) * 4))
#undef HG_OUT
}
__device__ __forceinline__ void phaseA(const Args& a, int l, int task, LAS unsigned char* lds, int tid) {
    asm volatile("" : "+v"(tid));
    const int lane = tid & 63, wave = __builtin_amdgcn_readfirstlane(tid >> 6);
    const int b = task / NCH, c = task % NCH;
    const f16* U = (const f16*)(a.ws + WS_U); f16* MIX = (f16*)(a.ws + WS_MIX); f16* VF = (f16*)(a.ws + WS_VF); f16* VP = (f16*)(a.ws + WS_VP);
    f16* QT = (f16*)(a.ws + WS_QT); f16* PT = (f16*)(a.ws + WS_PT); f16* RL = (f16*)(a.ws + WS_RL); float* BONG = (float*)(a.ws + WS_BON);
    {
        LAS float* prm = (LAS float*)(lds + PRM_OFF);
        for (int i = tid; i < PRM_FLOATS; i += NT) { float v;
            if (i < 1280) v = a.in[3][l * RW_SHIFT + i];
            else { const int q = (i - 1280) / 384, cc = (i - 1280) % 384;
                v = (q == 0) ? a.in[4][l * RW_W + cc] : (q == 1) ? a.in[6][l * RW_W + cc] : (q == 2) ? a.in[11][l * RW_W + cc] : (q == 3) ? a.in[12][l * RW_W + cc] : (q == 4) ? a.in[13][l * RW_W + cc] : a.in[8][cc]; }
            prm[i] = v; }
        __syncthreads();
        if (wave < RW_H) rwkv_waveA(a, l, b, c, wave, lds + wave * RWA_BYTES, prm, lane);
        else hgrn_waveA(a, l, b, c, 3 * (wave - RW_H), lds + RW_H * RWA_BYTES + (wave - RW_H) * HGA_BYTES, lane);
        __syncthreads();
    }
    {
        const int ln = lane_now(); const int tid2 = wave * 64 + ln;
        const char* Ub = (const char*)(a.ws + WS_U); char* MIXb = (char*)(a.ws + WS_MIX); char* CA = (char*)(a.ws + WS_CA); float* LA = (float*)(a.ws + WS_LA); float* LH = (float*)(a.ws + WS_LH);
        const float* cw = a.in[18] + l * 4 * 256; const float* cb = a.in[19] + l * 256;
        const float* ba = a.in[21] + l * 256; const float* bx = a.in[23] + l * 256; const float* lam = a.in[24] + l * 256;
        const char* WAT = (const char*)(a.ws + WS_WAT) + (size_t)l * 4 * 8192; const char* WXT = (const char*)(a.ws + WS_WXT) + (size_t)l * 4 * 8192;
        LAS unsigned char* Y = lds;
        LAS float* AGG = (LAS float*)(lds + 34816);
        const unsigned mrow0 = (unsigned)(b * SEQ + c * CH);
#pragma unroll
        for (int it = 0; it < 4; ++it) { const int item = tid2 + 512 * it, tok = item >> 5, co = item & 31; const int t = c * CH + tok;
            const f32x4 b0 = *(const f32x4*)(cb + 8 * co), b1 = *(const f32x4*)(cb + 8 * co + 4);
            float y[8] = {b0[0], b0[1], b0[2], b0[3], b1[0], b1[1], b1[2], b1[3]};
#pragma unroll
            for (int jj = 0; jj < 4; ++jj) { const int ts = t - 3 + jj;
                if (ts >= 0) { const f16x8 x8 = *(const f16x8*)(Ub + ((mrow0 + (unsigned)(tok - 3 + jj)) * (unsigned)NU + (unsigned)(C_LRUX + 8 * co)) * 2u);
                    const f32x4 w0 = *(const f32x4*)(cw + jj * 256 + 8 * co), w1 = *(const f32x4*)(cw + jj * 256 + 8 * co + 4);
#pragma unroll
                    for (int i = 0; i < 8; ++i) y[i] += (i < 4 ? w0[i & 3] : w1[i & 3]) * (float)x8[i]; } }
            *(LAS f16x8*)(Y + tok * 528 + co * 16) = pack8(y); }
        __syncthreads();
        const int tl = ln & 15, fq = ln >> 4, tt = wave & 3, gp = wave >> 2;
        float Asc[32], Hsc[32];
#pragma unroll
        for (int gg = 0; gg < 2; ++gg) { const int g = 2 * gp + gg;
            f16x8 by[2];
#pragma unroll
            for (int s2 = 0; s2 < 2; ++s2) by[s2] = *(const LAS f16x8*)(Y + (16 * tt + tl) * 528 + (g * 64 + 8 * fq + 32 * s2) * 2);
#pragma unroll
            for (int nt = 0; nt < 4; ++nt) {
                f32x4 ra = (f32x4){0.f, 0.f, 0.f, 0.f}, rx = ra;
#pragma unroll
                for (int s2 = 0; s2 < 2; ++s2) { const unsigned wo = (unsigned)(g * 8192 + ((16 * nt + tl) * 64 + 8 * fq + 32 * s2) * 2);
                    ra = __builtin_amdgcn_mfma_f32_16x16x32_f16(*(const f16x8*)(WAT + wo), by[s2], ra, 0, 0, 0);
                    rx = __builtin_amdgcn_mfma_f32_16x16x32_f16(*(const f16x8*)(WXT + wo), by[s2], rx, 0, 0, 0); }
                const int ch0 = g * 64 + 16 * nt + 4 * fq;
                const f32x4 ba4 = *(const f32x4*)(ba + ch0), bx4 = *(const f32x4*)(bx + ch0), lm4 = *(const f32x4*)(lam + ch0);
                const f16x4 y4 = *(const LAS f16x4*)(Y + (16 * tt + tl) * 528 + ch0 * 2);
#pragma unroll
                for (int i = 0; i < 4; ++i) {
                    const float r = sigmoidf_(ra[i] + ba4[i]), ig = sigmoidf_(rx[i] + bx4[i]);
                    const float la = -8.0f * r * log1pf(__expf(-lm4[i]));
                    float av = __expf(la), uv = sqrtf(-expm1f(2.0f * la)) * (ig * (float)y4[i]);
#define LRU_SCAN(d) { const float ap = __builtin_bit_cast(float, __builtin_amdgcn_update_dpp(0x3f800000, __builtin_bit_cast(int, av), 0x110 + (d), 0xf, 0xf, false)); \
                      const float up = __builtin_bit_cast(float, __builtin_amdgcn_update_dpp(0, __builtin_bit_cast(int, uv), 0x110 + (d), 0xf, 0xf, false)); \
                      uv = av * up + uv; av = av * ap; }
                    LRU_SCAN(1) LRU_SCAN(2) LRU_SCAN(4) LRU_SCAN(8)
#undef LRU_SCAN
                    Asc[gg * 16 + nt * 4 + i] = av; Hsc[gg * 16 + nt * 4 + i] = uv;
                    if (tl == 15) { AGG[(tt * 256 + ch0 + i) * 2] = av; AGG[(tt * 256 + ch0 + i) * 2 + 1] = uv; }
                }
            }
        }
        __syncthreads();
        const unsigned m = mrow0 + (unsigned)(16 * tt + tl);
#pragma unroll
        for (int gg = 0; gg < 2; ++gg)
#pragma unroll
            for (int nt = 0; nt < 4; ++nt) { const int ch0 = (2 * gp + gg) * 64 + 16 * nt + 4 * fq;
                f16x4 ho, co;
#pragma unroll
                for (int i = 0; i < 4; ++i) { float cy = 0.f, cpv = 1.f;
#pragma unroll
                    for (int t3 = 0; t3 < 3; ++t3) if (t3 < tt) { const float A3 = AGG[(t3 * 256 + ch0 + i) * 2], H3 = AGG[(t3 * 256 + ch0 + i) * 2 + 1]; cy = A3 * cy + H3; cpv *= A3; }
                    const float hl = Hsc[gg * 16 + nt * 4 + i] + Asc[gg * 16 + nt * 4 + i] * cy, ca = Asc[gg * 16 + nt * 4 + i] * cpv;
                    ho[i] = (f16)hl; co[i] = (f16)ca;
                    if (tt == 3 && tl == 15) { LA[((size_t)b * NCH + c) * 256 + ch0 + i] = ca; LH[((size_t)b * NCH + c) * 256 + ch0 + i] = hl; } }
                *(f16x4*)(MIXb + (m * (unsigned)DM + 768u + (unsigned)ch0) * 2u) = ho; *(f16x4*)(CA + (m * 256u + (unsigned)ch0) * 2u) = co; }
    }
}


constexpr int PB_SLOT = 16384, PB_NS = 8, PB_AHEAD = 6;
__device__ __forceinline__ void phaseB(const Args& a, LAS unsigned char* lds, int tid) {
    asm volatile("" : "+v"(tid));
    const int lane = tid & 63, wave = __builtin_amdgcn_readfirstlane(tid >> 6);
    const int bx = blockIdx.x;
    if (bx < 12) {
        const int bh = bx;
        const char* PT = (const char*)(a.ws + WS_PT) + (size_t)bh * NCH * 8192; char* RL = (char*)(a.ws + WS_RL) + (size_t)bh * NCH * 8192;
        const bool loader = wave >= 4;
        const int vt = wave & 3, vl = lane & 15, fq = lane >> 4, v = 16 * vt + vl;
        const int lq = (wave - 4) * 64 + lane, lrow = lq >> 3, lpp = lq & 7;
        const unsigned lsrc = (unsigned)(lrow * 128 + ((lpp ^ (lrow & 7)) << 4));
#define PB_ISSUE(cc) { const unsigned so = (unsigned)(((cc) & (PB_NS - 1)) * PB_SLOT) + (unsigned)((wave - 4) * 1024); const size_t go = (size_t)(cc) * 8192 + lsrc; \
            __builtin_amdgcn_global_load_lds((const unsigned*)(PT + go), (LAS unsigned*)(lds + so), 16, 0, 0); \
            __builtin_amdgcn_global_load_lds((const unsigned*)(PT + go + 4096), (LAS unsigned*)(lds + so + 4096), 16, 0, 0); \
            __builtin_amdgcn_global_load_lds((const unsigned*)(RL + go), (LAS unsigned*)(lds + so + 8192), 16, 0, 0); \
            __builtin_amdgcn_global_load_lds((const unsigned*)(RL + go + 4096), (LAS unsigned*)(lds + so + 12288), 16, 0, 0); }
#define PB_SWZ(row, o) ((row) * 128 + (((((o) >> 4) ^ ((row) & 7)) << 4) | ((o) & 15)))
        if (loader) {
#pragma unroll
            for (int cc = 0; cc < PB_AHEAD; ++cc) PB_ISSUE(cc)
            asm volatile("s_waitcnt vmcnt(20)" ::: "memory");
        }
        __builtin_amdgcn_s_barrier();
        f32x4 Sacc[4];
#pragma unroll
        for (int mt = 0; mt < 4; ++mt) Sacc[mt] = (f32x4){0.f, 0.f, 0.f, 0.f};
#pragma unroll 1
        for (int c = 0; c < NCH; ++c) {
            if (loader) {
                if (c + PB_AHEAD < NCH) { PB_ISSUE(c + PB_AHEAD) asm volatile("s_waitcnt vmcnt(20)" ::: "memory"); }
                else asm volatile("s_waitcnt vmcnt(0)" ::: "memory");
            } else {
                const LAS unsigned char* sl = lds + (c & (PB_NS - 1)) * PB_SLOT;
                f16x8 Bhi[2], Blo[2];
#pragma unroll
                for (int mt = 0; mt < 4; ++mt) { f16x4 hi;
#pragma unroll
                    for (int i = 0; i < 4; ++i) { hi[i] = (f16)Sacc[mt][i]; const f16 lo = (f16)(Sacc[mt][i] - (float)hi[i]); Bhi[mt >> 1][4 * (mt & 1) + i] = hi[i]; Blo[mt >> 1][4 * (mt & 1) + i] = lo; }
                    *(f16x4*)(RL + (size_t)c * 8192 + (v * 64 + 16 * mt + 4 * fq) * 2) = hi; }
#pragma unroll
                for (int mt = 0; mt < 4; ++mt) {
                    const f16x4 l4 = *(const LAS f16x4*)(sl + 8192 + PB_SWZ(v, 32 * mt + 8 * fq));
                    f32x4 d = (f32x4){(float)l4[0], (float)l4[1], (float)l4[2], (float)l4[3]};
#pragma unroll
                    for (int s = 0; s < 2; ++s) { const u32x2 a0 = *(const LAS u32x2*)(sl + PB_SWZ(16 * mt + vl, 64 * s + 8 * fq)), a1 = *(const LAS u32x2*)(sl + PB_SWZ(16 * mt + vl, 64 * s + 32 + 8 * fq));
                        u32x4 aw; aw.x = a0.x; aw.y = a0.y; aw.z = a1.x; aw.w = a1.y; const f16x8 af = __builtin_bit_cast(f16x8, aw);
                        d = __builtin_amdgcn_mfma_f32_16x16x32_f16(af, Bhi[s], d, 0, 0, 0); d = __builtin_amdgcn_mfma_f32_16x16x32_f16(af, Blo[s], d, 0, 0, 0); }
                    Sacc[mt] = d; }
                asm volatile("s_waitcnt lgkmcnt(0)" ::: "memory");
            }
            __builtin_amdgcn_s_barrier();
        }
#undef PB_ISSUE
#undef PB_SWZ
        asm volatile("s_waitcnt vmcnt(0)" ::: "memory");
    } else if (bx < 12 + 96) {
        const int idx = (bx - 12) * NT + tid; const int bh = idx >> 12, e = idx & 4095, k = e & 63;
        f16* HL = (f16*)(a.ws + WS_HL); const float* DC = (const float*)(a.ws + WS_DC);
        float s = 0.f;
        for (int c0 = 0; c0 < NCH; c0 += 8) { float Lc[8], d[8];
#pragma unroll
            for (int j = 0; j < 8; ++j) { Lc[j] = (float)HL[((size_t)bh * NCH + c0 + j) * 4096 + e]; d[j] = DC[((size_t)bh * NCH + c0 + j) * 64 + k]; }
#pragma unroll
            for (int j = 0; j < 8; ++j) { HL[((size_t)bh * NCH + c0 + j) * 4096 + e] = (f16)s; s = d[j] * s + Lc[j]; } }
    } else if (bx == 12 + 96) {
        const int bb = tid >> 8, ch = tid & 255; const float* LA = (const float*)(a.ws + WS_LA); float* LH = (float*)(a.ws + WS_LH);
        float cy = 0.f;
        for (int c0 = 0; c0 < NCH; c0 += 8) { float A[8], H[8];
#pragma unroll
            for (int j = 0; j < 8; ++j) { const size_t o = ((size_t)bb * NCH + c0 + j) * 256 + ch; A[j] = LA[o]; H[j] = LH[o]; }
#pragma unroll
            for (int j = 0; j < 8; ++j) { const size_t o = ((size_t)bb * NCH + c0 + j) * 256 + ch; LH[o] = cy; cy = A[j] * cy + H[j]; } }
    }
}

__device__ __forceinline__ void phaseC(const Args& a, int l, int task, LAS unsigned char* lds, int tid) {
    asm volatile("" : "+v"(tid));
    const int lane = tid & 63, wave = __builtin_amdgcn_readfirstlane(tid >> 6);
    const int b = task / NCH, c = task % NCH;
    const int tl = lane & 15, fq = lane >> 4, tt = wave & 3, hg = wave >> 2;
    const unsigned m = (unsigned)(b * SEQ + c * CH + 16 * tt + tl);
    const char* U = (const char*)(a.ws + WS_U); char* MIX = (char*)(a.ws + WS_MIX); const char* VP = (const char*)(a.ws + WS_VP);
    const char* QT = (const char*)(a.ws + WS_QT); const char* RL = (const char*)(a.ws + WS_RL); const char* HL = (const char*)(a.ws + WS_HL); const float* BONG = (const float*)(a.ws + WS_BON);
    const unsigned uo = m * (unsigned)(NU * 2);
#pragma unroll 1
    for (int hh = 0; hh < 3; ++hh) {
        const int h = 3 * hg + hh; const int bh = b * RW_H + h;
        const char* sl = RL + ((size_t)bh * NCH + c) * 8192;
        f16x8 bq[2];
#pragma unroll
        for (int s = 0; s < 2; ++s) bq[s] = *(const f16x8*)(QT + (m * (unsigned)RW_W + (unsigned)(h * 64 + 8 * fq + 32 * s)) * 2u);
        f32x4 D[4];
#pragma unroll
        for (int vt = 0; vt < 4; ++vt) { const f16x4 yl = *(const f16x4*)(MIX + (m * (unsigned)DM + (unsigned)(h * 64 + 16 * vt + 4 * fq)) * 2u);
            f32x4 d = (f32x4){(float)yl[0], (float)yl[1], (float)yl[2], (float)yl[3]};
#pragma unroll
            for (int s = 0; s < 2; ++s) d = __builtin_amdgcn_mfma_f32_16x16x32_f16(*(const f16x8*)(sl + ((16 * vt + tl) * 64 + 8 * fq + 32 * s) * 2), bq[s], d, 0, 0, 0);
            D[vt] = d; }
        float sm = 0.f;
#pragma unroll
        for (int vt = 0; vt < 4; ++vt) sm += (D[vt][0] + D[vt][1]) + (D[vt][2] + D[vt][3]);
        sm += shfl_xor_f(sm, 16); sm += shfl_xor_f(sm, 32);
        const float mean = sm * (1.0f / 64.0f); float vr = 0.f;
#pragma unroll
        for (int vt = 0; vt < 4; ++vt)
#pragma unroll
            for (int i = 0; i < 4; ++i) { const float d = D[vt][i] - mean; vr += d * d; }
        vr += shfl_xor_f(vr, 16); vr += shfl_xor_f(vr, 32);
        const float rstd = 1.0f / sqrtf(vr * (1.0f / 64.0f) + 64e-5f);
        const float bon = BONG[m * 8u + (unsigned)h];
        const float* ln_w = a.in[14] + l * RW_W; const float* ln_b = a.in[15] + l * RW_W;
#pragma unroll
        for (int vt = 0; vt < 4; ++vt) { const unsigned col = (unsigned)(h * 64 + 16 * vt + 4 * fq);
            const f16x4 vp = *(const f16x4*)(VP + (m * (unsigned)RW_W + col) * 2u), z4 = *(const f16x4*)(U + uo + ((unsigned)C_RWZ + col) * 2u);
            const f32x4 lw = *(const f32x4*)(ln_w + col), lb = *(const f32x4*)(ln_b + col);
            f16x4 o;
#pragma unroll
            for (int i = 0; i < 4; ++i) o[i] = (f16)(((D[vt][i] - mean) * rstd * lw[i] + lb[i] + bon * (float)vp[i]) * siluf_((float)z4[i]));
            *(f16x4*)(MIX + (m * (unsigned)DM + col) * 2u) = o; }
    }
#pragma unroll 1
    for (int hh = 0; hh < 3; ++hh) {
        const int h = 3 * hg + hh; const int bh = b * 6 + h;
        const char* sl = HL + ((size_t)bh * NCH + c) * 8192;
        f16x8 bq[2];
#pragma unroll
        for (int s = 0; s < 2; ++s) bq[s] = *(const f16x8*)(U + uo + (unsigned)(C_HGQ + h * 64 + 8 * fq + 32 * s) * 2u);
        f32x4 D[4];
#pragma unroll
        for (int vt = 0; vt < 4; ++vt) { const f16x4 ol = *(const f16x4*)(MIX + (m * (unsigned)DM + (unsigned)(384 + h * 64 + 16 * vt + 4 * fq)) * 2u);
            f32x4 d = (f32x4){(float)ol[0], (float)ol[1], (float)ol[2], (float)ol[3]};
#pragma unroll
            for (int s = 0; s < 2; ++s) d = __builtin_amdgcn_mfma_f32_16x16x32_f16(*(const f16x8*)(sl + ((16 * vt + tl) * 64 + 8 * fq + 32 * s) * 2), bq[s], d, 0, 0, 0);
            D[vt] = d; }
        float ss = 0.f;
#pragma unroll
        for (int vt = 0; vt < 4; ++vt) ss += (D[vt][0] * D[vt][0] + D[vt][1] * D[vt][1]) + (D[vt][2] * D[vt][2] + D[vt][3] * D[vt][3]);
        ss += shfl_xor_f(ss, 16); ss += shfl_xor_f(ss, 32);
        const float rs = 1.0f / sqrtf(ss * (1.0f / 64.0f) + 1e-6f);
        const float* nw = a.in[17] + l * 384;
#pragma unroll
        for (int vt = 0; vt < 4; ++vt) { const unsigned col = (unsigned)(h * 64 + 16 * vt + 4 * fq);
            const f16x4 z4 = *(const f16x4*)(U + uo + ((unsigned)C_HGZ + col) * 2u); const f32x4 w4 = *(const f32x4*)(nw + col);
            f16x4 o;
#pragma unroll
            for (int i = 0; i < 4; ++i) o[i] = (f16)(D[vt][i] * rs * w4[i] * siluf_((float)z4[i]));
            *(f16x4*)(MIX + (m * (unsigned)DM + 384u + col) * 2u) = o; }
    }
    {
        const char* CA = (const char*)(a.ws + WS_CA); const float* LH = (const float*)(a.ws + WS_LH) + ((size_t)b * NCH + c) * 256;
#pragma unroll
        for (int q = 0; q < 4; ++q) { const unsigned ch0 = (unsigned)(128 * hg + 32 * fq + 8 * q);
            const f16x8 hl = *(const f16x8*)(MIX + (m * (unsigned)DM + 768u + ch0) * 2u), ca = *(const f16x8*)(CA + (m * 256u + ch0) * 2u), z8 = *(const f16x8*)(U + uo + ((unsigned)C_LRUZ + ch0) * 2u);
            const f32x4 c0 = *(const f32x4*)(LH + ch0), c1 = *(const f32x4*)(LH + ch0 + 4);
            f16x8 o;
#pragma unroll
            for (int i = 0; i < 8; ++i) o[i] = (f16)(((float)hl[i] + (float)ca[i] * (i < 4 ? c0[i & 3] : c1[i & 3])) * siluf_((float)z8[i]));
            *(f16x8*)(MIX + (m * (unsigned)DM + 768u + ch0) * 2u) = o; }
    }
}
#define XB_TMO      128
#define XB_XCNT(j)  (256  + 64 * (j))
#define XB_XSUB(j)  (1280 + 64 * (j))
#define XB_XGEN(j)  (2304 + 64 * (j))
#define XB_TOP      3328
#define XB_TOPGEN   3392
#define XCD_BAR_WORDS 3456
#define XB_SPIN_CAP (1u << 18)

__device__ __forceinline__ unsigned xb_ld(unsigned* p)              { return __hip_atomic_load(p, __ATOMIC_RELAXED, __HIP_MEMORY_SCOPE_AGENT); }
__device__ __forceinline__ unsigned xb_add(unsigned* p, unsigned v) { return __hip_atomic_fetch_add(p, v, __ATOMIC_RELAXED, __HIP_MEMORY_SCOPE_AGENT); }
__device__ __forceinline__ unsigned xb_xcc_id() { return (unsigned)__builtin_amdgcn_s_getreg((3 << 11) | 20) & 0xFu; }
#define XB_SPIN(cond, bar) do { unsigned _sp = 0; while (cond) { __builtin_amdgcn_s_sleep(1); \
    if ((++_sp & 255u) == 0u) { if (xb_ld(&(bar)[XB_TMO])) break; if (_sp > XB_SPIN_CAP) { atomicAdd(&(bar)[XB_TMO], 1u); break; } } } } while (0)

struct XcdBarrier {
    unsigned* bar; unsigned x; int isw0;
    volatile LAS unsigned* st;
};

__device__ __forceinline__ XcdBarrier xcd_barrier_post(unsigned* bar, volatile LAS unsigned* st, int isw0) {
    XcdBarrier b; b.bar = bar; b.x = xb_xcc_id(); b.st = st; b.isw0 = isw0;
    if (isw0 && lane_now() == 0) (void)xb_add(&bar[XB_XCNT(b.x)], 1u);
    return b;
}
__device__ __forceinline__ void xcd_barrier_complete(unsigned* bar, unsigned x, unsigned& nloc, unsigned& nx) {
    const unsigned G = gridDim.x * gridDim.y * gridDim.z;
    unsigned sum, cnt, mine, sp = 0u;
    for (;;) {
        sum = 0u; cnt = 0u; mine = 0u;
#pragma unroll
        for (unsigned j = 0; j < 16; ++j) { const unsigned c = xb_ld(&bar[XB_XCNT(j)]); sum += c; cnt += (c > 0u) ? 1u : 0u; mine = (j == x) ? c : mine; }
        if (sum == G) break;
        __builtin_amdgcn_s_sleep(1);
        if ((++sp & 255u) == 0u) { if (xb_ld(&bar[XB_TMO])) break; if (sp > XB_SPIN_CAP) { atomicAdd(&bar[XB_TMO], 1u); break; } }
    }
    nloc = mine > 0u ? mine : 1u; nx = cnt > 0u ? cnt : 1u;
}

__device__ __forceinline__ void xcd_barrier(const XcdBarrier& b) {
    asm volatile("s_waitcnt vmcnt(0)" ::: "memory");
    __syncthreads();
    if (b.isw0 && lane_now() == 0) {
        unsigned* bar = b.bar;
        __builtin_amdgcn_s_waitcnt(0);
        unsigned nloc = b.st[0], nx = b.st[1];
        if (nloc == 0u) { xcd_barrier_complete(bar, b.x, nloc, nx); b.st[0] = nloc; b.st[1] = nx; }
        const unsigned old = xb_add(&bar[XB_XSUB(b.x)], 1u);
        const unsigned gen = old / nloc;
        if (old + 1u == (gen + 1u) * nloc) {
            __builtin_amdgcn_fence(__ATOMIC_RELEASE, "agent");
            asm volatile("s_waitcnt vmcnt(0)" ::: "memory");
            const unsigned og = xb_add(&bar[XB_TOP], 1u);
            const unsigned tg = og / nx;
            if (og + 1u == (tg + 1u) * nx) xb_add(&bar[XB_TOPGEN], 1u);
            else XB_SPIN(xb_ld(&bar[XB_TOPGEN]) == tg, bar);
            __builtin_amdgcn_fence(__ATOMIC_ACQUIRE, "agent");
            xb_add(&bar[XB_XGEN(b.x)], 1u);
            asm volatile("s_waitcnt vmcnt(0)" ::: "memory");
        } else {
            XB_SPIN(xb_ld(&bar[XB_XGEN(b.x)]) == gen, bar);
            __builtin_amdgcn_fence(__ATOMIC_ACQUIRE, "agent");
            asm volatile("s_waitcnt vmcnt(0)" ::: "memory");
        }
    }
    __syncthreads();
}

constexpr size_t WS_BAR = 16384;
constexpr int MISC_OFF = LDS_BYTES - 16;
__global__ void __launch_bounds__(NT, 2) fwd(Args args) {
    extern __shared__ __attribute__((aligned(16))) unsigned char lds_raw[];
    LAS unsigned char* lds = (LAS unsigned char*)lds_raw;
    cg::grid_group grid = cg::this_grid();
    const int wave = __builtin_amdgcn_readfirstlane((int)threadIdx.x >> 6);
#define TID_NOW() (wave * 64 + lane_now())
    const int tid = TID_NOW(); const int lane = tid & 63;
    if (wave == 0 && lane < 4) ((LAS unsigned*)(lds + MISC_OFF))[lane] = 0u;
    __syncthreads();
    XcdBarrier xbar = xcd_barrier_post((unsigned*)(args.ws + WS_BAR), (volatile LAS unsigned*)(lds + MISC_OFF), __builtin_amdgcn_readfirstlane(wave == 0 ? 1 : 0));
#define GRID_BAR() do { XcdBarrier xb_ = xbar; xb_.st = (volatile LAS unsigned*)(lds + MISC_OFF); asm volatile("" : "+s"(xb_.bar), "+s"(xb_.x)); xcd_barrier(xb_); } while (0)
    const int G = gridDim.x, gw = blockIdx.x * NWAVES + wave, NGW = G * NWAVES;
    unsigned char* ws = args.ws;
    unsigned short* XN = (unsigned short*)(ws + WS_XN);
    {
        LAS float* scr = (LAS float*)(lds + wave * 16384);
        constexpr int I_IN = (DM / 64) * (NIN / 32), I_OUT = (DM / 64) * (DM / 32), NITEMS = DEPTH * (I_IN + I_OUT);
        for (int it = gw; it < NITEMS; it += NGW) {
            int r = it; const int l = r / (I_IN + I_OUT); r -= l * (I_IN + I_OUT);
            if (r < I_IN) p0_transpose_item(args.in[2] + (size_t)l * DM * NIN, DM, NIN, (unsigned short*)(ws + WS_WIN + l * WIN_L), scr, r, lane);
            else p0_transpose_item(args.in[25] + (size_t)l * DM * DM, DM, DM, (unsigned short*)(ws + WS_WOUT + l * WOUT_L), scr, r - I_IN, lane);
        }
        for (int i = gw; i < DEPTH * (NU - NIN) * DM * 2 / 1024; i += NGW) { const int l = i / ((NU - NIN) * DM * 2 / 1024), r = i % ((NU - NIN) * DM * 2 / 1024);
            if (l == 1 && r < 64 * DM * 2 / 1024) continue;
            *(u32x4*)(ws + WS_WIN + l * WIN_L + (size_t)NIN * DM * 2 + (size_t)r * 1024 + lane * 16) = (u32x4){0u, 0u, 0u, 0u}; }
        for (int i = blockIdx.x * NT + tid; i < 64 * DM; i += G * NT) { const int k = i >> 6, n = i & 63, j = n & 31;
            const float* wrow = args.in[2] + (size_t)DM * NIN + (size_t)k * NIN + C_V; const float* mu1 = args.in[3] + RW_SHIFT + C_V; const float* vdn = args.in[9];
            float acc = 0.f;
            for (int cc = 0; cc < RW_W; ++cc) { const float mm = mu1[cc]; acc += wrow[cc] * ((n < 32) ? (1.0f - mm) : mm) * vdn[cc * 32 + j]; }
            ((f16*)(ws + WS_WIN + WIN_L))[(size_t)(NIN + n) * DM + k] = (f16)acc; }
        for (int m = gw; m < M; m += NGW) rms_row_f16(args.in[0] + (size_t)m * DM, args.in[1], XN + (size_t)m * DM, lane);
        { f16* WUPT = (f16*)(ws + WS_WUPT); f16* AUPT = (f16*)(ws + WS_AUPT); f16* VDNT = (f16*)(ws + WS_VDNT); f16* VUPT = (f16*)(ws + WS_VUPT);
          for (int i = blockIdx.x * NT + tid; i < 122880; i += G * NT) {
              if (i < 49152) { const int ll = i / 24576, r = i % 24576, n = r / 64, k = r % 64; WUPT[i] = (f16)args.in[5][(size_t)ll * 24576 + k * 384 + n]; }
              else if (i < 98304) { const int i2 = i - 49152, ll = i2 / 24576, r = i2 % 24576, n = r / 64, k = r % 64; AUPT[i2] = (f16)args.in[7][(size_t)ll * 24576 + k * 384 + n]; }
              else if (i < 110592) { const int i2 = i - 98304, j2 = i2 / 384, cc = i2 % 384; VDNT[i2] = (f16)args.in[9][cc * 32 + j2]; }
              else { const int i2 = i - 110592, n = i2 / 32, j2 = i2 % 32; VUPT[i2] = (f16)args.in[10][j2 * 384 + n]; } }
          f16* WAT = (f16*)(ws + WS_WAT); f16* WXT = (f16*)(ws + WS_WXT);
          for (int i = blockIdx.x * NT + tid; i < 32768; i += G * NT) { const int lg = i >> 12, r = i & 4095, j = r >> 6, ii = r & 63; WAT[i] = (f16)args.in[20][(size_t)lg * 4096 + ii * 64 + j]; WXT[i] = (f16)args.in[22][(size_t)lg * 4096 + ii * 64 + j]; } }
    }
    grid.sync();
#pragma unroll 1
    for (int l = 0; l < DEPTH; ++l) {
        { pg8::Gemm g{XN, (const unsigned short*)(ws + WS_WIN + l * WIN_L), M, NU, DM}; pg8::StaticOrder S; S.init(M, NU, G, (int)blockIdx.x);
          pg8::EpiF16 E{(unsigned short*)(ws + WS_U), NU};
          pg8::gemm_phase<pg8::EpiF16, pg8::StaticOrder, true, true>(lds, g, S, E, wave); }
        GRID_BAR();
        for (int task = blockIdx.x; task < BATCH * NCH; task += G) phaseA(args, l, task, lds, TID_NOW());
        GRID_BAR();
        phaseB(args, lds, TID_NOW());
        GRID_BAR();
        for (int task = blockIdx.x; task < BATCH * NCH; task += G) phaseC(args, l, task, lds, TID_NOW());
        GRID_BAR();
        { pg8::Gemm g{(const unsigned short*)(ws + WS_MIX), (const unsigned short*)(ws + WS_WOUT + l * WOUT_L), M, DM, DM}; pg8::StaticOrder S; S.init(M, DM, G, (int)blockIdx.x);
          pg8::EpiRes E{l == 0 ? args.in[0] : args.out, args.out, DM};
          pg8::gemm_phase<pg8::EpiRes, pg8::StaticOrder, true, true>(lds, g, S, E, wave); }
        GRID_BAR();
        { int ln = TID_NOW() & 63; asm volatile("" : "+v"(ln));
          if (l + 1 < DEPTH) { for (int m = gw; m < M; m += NGW) rms_row_f16(args.out + (size_t)m * DM, args.in[1] + (l + 1) * DM, XN + (size_t)m * DM, ln); GRID_BAR(); }
          else { for (int m = gw; m < M; m += NGW) rms_row_f32(args.out + (size_t)m * DM, args.in[26], ln); } }
    }
}

extern "C" void kernel_launch(void* const* d_in, const int* in_sizes, int n_in, void* d_out, int out_size, void* d_ws, size_t ws_size, hipStream_t stream) {
    static int grid = 0;
    if (grid == 0) {
        if (n_in != 27 || in_sizes[0] != M * DM || out_size != M * DM || ws_size < WS_END) { fprintf(stderr, "kernel_launch: unexpected problem: n_in %d in0 %d out %d ws %zu\n", n_in, n_in > 0 ? in_sizes[0] : -1, out_size, ws_size); grid = -1; return; }
        int dev = 0, cus = 0, per_cu = 0;
        hipGetDevice(&dev); hipDeviceGetAttribute(&cus, hipDeviceAttributeMultiprocessorCount, dev);
        if (hipFuncSetAttribute((const void*)fwd, hipFuncAttributeMaxDynamicSharedMemorySize, LDS_BYTES) != hipSuccess) { fprintf(stderr, "kernel_launch: hipFuncSetAttribute failed\n"); grid = -1; return; }
        if (hipOccupancyMaxActiveBlocksPerMultiprocessor(&per_cu, (const void*)fwd, NT, LDS_BYTES) != hipSuccess || per_cu < 1) { fprintf(stderr, "kernel_launch: occupancy query failed (%d)\n", per_cu); grid = -1; return; }
        grid = cus * per_cu;
    }
    if (grid < 0) return;
    if (hipMemsetAsync((char*)d_ws, 0, 65536, stream) != hipSuccess) { fprintf(stderr, "kernel_launch: memset of the barrier words failed\n"); return; }
    Args a{};
    for (int i = 0; i < 27; ++i) a.in[i] = (const float*)d_in[i];
    a.out = (float*)d_out; a.ws = (unsigned char*)d_ws;
    void* kargs[] = {&a};
    hipError_t e = hipLaunchCooperativeKernel((const void*)fwd, dim3(grid), dim3(NT), kargs, LDS_BYTES, stream);
    if (e != hipSuccess) fprintf(stderr, "cooperative launch failed: %s (grid %d)\n", hipGetErrorString(e), grid);
}
```

```cpp
#include <hip/hip_runtime.h>
#include <hip/hip_cooperative_groups.h>
#include <cstdio>
#include <cstdint>
namespace cg = cooperative_groups;
typedef _Float16 f16x8_t __attribute__((ext_vector_type(8)));
#define MK_MFMA(a, b, c) __builtin_amdgcn_mfma_f32_16x16x32_f16(__builtin_bit_cast(f16x8_t, (a)), __builtin_bit_cast(f16x8_t, (b)), (c), 0, 0, 0)
__device__ __forceinline__ int lane_now() { int z; asm volatile("v_mbcnt_lo_u32_b32 %0, -1, 0\n\tv_mbcnt_hi_u32_b32 %0, -1, %0" : "=v"(z)); return z; }
__device__ __forceinline__ float shfl_xor_f(float v, int mask) { const int ln = lane_now(); return __builtin_bit_cast(float, __builtin_amdgcn_ds_bpermute((ln ^ mask) << 2, __builtin_bit_cast(int, v))); }
namespace pg8 {
#define PG8_LAS __attribute__((address_space(3)))
typedef unsigned short bf16_t;
typedef short bf16x8 __attribute__((ext_vector_type(8)));
typedef float f32x4 __attribute__((ext_vector_type(4)));
typedef unsigned u32x4 __attribute__((ext_vector_type(4)));
constexpr int BM = 256, BK = 64, HALF = 128, HTB = HALF * BK * 2  , STAGE_BYTES = 8 * HTB, NXCD = 8, WGM = 8;

__host__ __device__ __forceinline__ int lds_byte(int r, int c) { const int st = (r >> 4) * 2 + (c >> 5), rr = r & 15, cc = c & 31, ob = rr * 64 + cc * 2; return st * 1024 + (ob ^ (((ob >> 9) & 1) << 5)); }
__host__ __device__ __forceinline__ void stage_rc(int b, int& R, int& C) { const int st = b / 1024, sb = b % 1024, swz = sb ^ (((sb >> 9) & 1) << 5); R = (st >> 1) * 16 + swz / 64; C = (st & 1) * 32 + (swz % 64) / 2; }
__host__ __device__ __forceinline__ int perm32(int rho) { const int n = rho >> 4, i = rho & 15; return 8 * (i >> 2) + 4 * n + (i & 3); }

struct Unit { int pm, pn; };
struct Gemm { const bf16_t* A; const bf16_t* Bt; int M, N, K; };

struct StaticOrder {
    int nM, nN, nwg, G, c;
    __host__ __device__ void init(int M, int N, int G_, int c_) { nM = M / BM; nN = N / BM; nwg = nM * nN; G = G_; c = c_; }
    __host__ __device__ bool next(int i, Unit& u) const {
        const long L = (long)i * G + c; if (L >= nwg) return false;
        int wgid = (int)L; { const int q = nwg / NXCD, r = nwg % NXCD, xcd = wgid % NXCD, off = wgid / NXCD; wgid = (xcd < r ? xcd * (q + 1) : r * (q + 1) + (xcd - r) * q) + off; }
        const int nig = WGM * nN, gid = wgid / nig, fm = gid * WGM, gsz = (nM - fm) < WGM ? (nM - fm) : WGM;
        u.pm = fm + ((wgid % nig) % gsz); u.pn = (wgid % nig) / gsz; return true;
    }
    __device__ __forceinline__ void a_ready(const Unit&) const {}
    __device__ __forceinline__ void done(const Unit&) const {}
};

__device__ __forceinline__ unsigned pk_f16(float lo, float hi) { typedef _Float16 h2 __attribute__((ext_vector_type(2))); h2 v; v.x = (_Float16)lo; v.y = (_Float16)hi; return __builtin_bit_cast(unsigned, v); }
typedef unsigned u32x2 __attribute__((ext_vector_type(2)));
struct EpiF16 {
    static constexpr bool PERM = true, AFTER_DRAIN = false;
    bf16_t* O; int ldc; const float* rss;
    __device__ __forceinline__ void operator()(const f32x4 (&acc)[2][2][4][2], const Unit& u, int wr, int wc, int fr, int fq) const {
        const int row0 = u.pm * BM + wr * 64 + fr; const int col0 = u.pn * BM + wc * 32 + 8 * fq;
#pragma unroll
        for (int ai = 0; ai < 2; ++ai)
#pragma unroll
            for (int m = 0; m < 4; ++m) { const int row = row0 + ai * HALF + m * 16; bf16_t* rowp = O + (size_t)row * ldc + col0;
                const float sc = rss ? 1.0f / sqrtf(rss[row] * (1.0f / 1024.0f) + 1e-6f) : 1.0f;
#pragma unroll
                for (int bj = 0; bj < 2; ++bj) { const f32x4 v0 = acc[ai][bj][m][0] * sc, v1 = acc[ai][bj][m][1] * sc;
                    u32x4 w; w.x = pk_f16(v0[0], v0[1]); w.y = pk_f16(v0[2], v0[3]); w.z = pk_f16(v1[0], v1[1]); w.w = pk_f16(v1[2], v1[3]);
                    *(u32x4*)(rowp + bj * HALF) = w; } }
    }
};
struct EpiRes {
    static constexpr bool PERM = false, AFTER_DRAIN = false;
    const float* base; float* out; int ldc; bf16_t* xh; float* rss;
    __device__ __forceinline__ void operator()(const f32x4 (&acc)[2][2][4][2], const Unit& u, int wr, int wc, int fr, int fq) const {
        const int row0 = u.pm * BM + wr * 64 + fr; const int col0 = u.pn * BM + wc * 32 + 4 * fq;
#pragma unroll
        for (int ai = 0; ai < 2; ++ai)
#pragma unroll
            for (int m = 0; m < 4; ++m) { const size_t off = (size_t)(row0 + ai * HALF + m * 16) * ldc + col0; float ss = 0.f;
#pragma unroll
                for (int bj = 0; bj < 2; ++bj)
#pragma unroll
                    for (int n = 0; n < 2; ++n) { const size_t o = off + bj * HALF + n * 16; const f32x4 b = *(const f32x4*)(base + o); const f32x4 x = b + acc[ai][bj][m][n]; *(f32x4*)(out + o) = x;
                        if (xh) { u32x2 h; h.x = pk_f16(x[0], x[1]); h.y = pk_f16(x[2], x[3]); *(u32x2*)(xh + o) = h; ss += (x[0] * x[0] + x[1] * x[1]) + (x[2] * x[2] + x[3] * x[3]); } }
                if (xh) { ss += shfl_xor_f(ss, 16); ss += shfl_xor_f(ss, 32); if (fq == 0) atomicAdd(rss + row0 + ai * HALF + m * 16, ss); }
                asm volatile("" ::: "memory"); }
    }
};

template <class Epi, class Sched, bool ALIGN_EPI = false, bool SP2 = false>
__device__ __forceinline__ void gemm_phase(PG8_LAS unsigned char* lds, const Gemm g, const Sched& S, const Epi& E, const int wave_) {
    int wv_ = wave_; asm volatile("" : "+s"(wv_)); int tid_ = lane_now() + 64 * wv_; const int tid = tid_, wid = wv_, lane = tid & 63, wr = wid >> 2, wc = wid & 3, fr = lane & 15, fq = lane >> 4;
    const int K = g.K, nt = K / BK;
    unsigned voffA[2], voffB[2];
#pragma unroll
    for (int i = 0; i < 2; ++i) { int R, C; stage_rc(tid * 16 + i * 8192, R, C); const int Rb = Epi::PERM ? ((R & ~31) + perm32(R & 31)) : R;
        voffA[i] = (unsigned)(R * K + C) * 2u; voffB[i] = (unsigned)(Rb * K + C) * 2u; }
    const size_t kstep = (size_t)(BK * 2);
    const size_t hstep = (size_t)HALF * K * 2;
    const size_t tstep = 2 * hstep;
    const unsigned ldsw = (unsigned)wid * 1024u;
    const int aoff = lds_byte(wr * 64 + fr, fq * 8), boff = lds_byte(wc * 32 + fr, fq * 8);
#define PG8_SA(b, h) (((b) * 2 + (h)) * HTB)
#define PG8_SB(b, h) ((4 + (b) * 2 + (h)) * HTB)
#define PG8_STAGE(bufoff, gbase, voff) do { _Pragma("unroll") for (int _i = 0; _i < 2; ++_i) \
        __builtin_amdgcn_global_load_lds((const unsigned*)((const char*)(gbase) + (voff)[_i]), (PG8_LAS unsigned*)(lds + (bufoff) + ldsw + _i * 8192), 16, 0, 0); } while (0)
#define PG8_LDA(dst, b, h) do { _Pragma("unroll") for (int m = 0; m < 4; ++m) _Pragma("unroll") for (int k = 0; k < 2; ++k) dst[m][k] = *(const PG8_LAS bf16x8*)(lds + PG8_SA(b, h) + aoff + m * 2048 + k * 1024); } while (0)
#define PG8_LDB(dst, b, h) do { _Pragma("unroll") for (int n = 0; n < 2; ++n) _Pragma("unroll") for (int k = 0; k < 2; ++k) dst[n][k] = *(const PG8_LAS bf16x8*)(lds + PG8_SB(b, h) + boff + n * 2048 + k * 1024); } while (0)
#define PG8_MMA(ai, bj, At, Bt) do { __builtin_amdgcn_s_setprio(1); _Pragma("unroll") for (int m = 0; m < 4; ++m) _Pragma("unroll") for (int n = 0; n < 2; ++n) _Pragma("unroll") for (int k = 0; k < 2; ++k) \
        acc[ai][bj][m][n] = MK_MFMA(Bt[n][k], At[m][k], acc[ai][bj][m][n]); __builtin_amdgcn_s_setprio(0); } while (0)
#define PG8_WAIT_V(n) asm volatile("s_waitcnt vmcnt(" #n ")" ::: "memory")
#define PG8_WAIT_L(n) asm volatile("s_waitcnt lgkmcnt(" #n ")" ::: "memory")
#define PG8_BAR __builtin_amdgcn_s_barrier()
#define PG8_SCHED __builtin_amdgcn_sched_barrier(0)
    Unit cur, nxt; int ui = 0;
    if (!S.next(0, cur)) return;
    f32x4 acc[2][2][4][2];
#pragma unroll
    for (int a = 0; a < 2; ++a)
#pragma unroll
        for (int b = 0; b < 2; ++b)
#pragma unroll
            for (int m = 0; m < 4; ++m)
#pragma unroll
                for (int n = 0; n < 2; ++n) acc[a][b][m][n] = (f32x4){0.f, 0.f, 0.f, 0.f};
    bf16x8 At[4][2], B0[2][2], B1[2][2];
    const char* cA = (const char*)g.A + (size_t)cur.pm * tstep; const char* cB = (const char*)g.Bt + (size_t)cur.pn * tstep;
    S.a_ready(cur);
    if constexpr (SP2) {
        PG8_STAGE(PG8_SB(0, 0), cB, voffB); PG8_STAGE(PG8_SB(0, 1), cB + hstep, voffB); PG8_STAGE(PG8_SA(0, 0), cA, voffA); PG8_STAGE(PG8_SA(0, 1), cA + hstep, voffA);
        if (wr == 1) PG8_BAR;
        PG8_WAIT_V(2); PG8_BAR;
        PG8_STAGE(PG8_SB(1, 0), cB + kstep, voffB); PG8_STAGE(PG8_SA(1, 0), cA + kstep, voffA); PG8_STAGE(PG8_SB(1, 1), cB + hstep + kstep, voffB);
        PG8_WAIT_V(6); PG8_BAR;
    } else {
        PG8_STAGE(PG8_SB(0, 0), cB, voffB); PG8_STAGE(PG8_SA(0, 0), cA, voffA); PG8_STAGE(PG8_SB(0, 1), cB + hstep, voffB); PG8_STAGE(PG8_SA(0, 1), cA + hstep, voffA);
        if (wr == 1) PG8_BAR;
        PG8_WAIT_V(4); PG8_BAR;
        PG8_STAGE(PG8_SB(1, 0), cB + kstep, voffB); PG8_STAGE(PG8_SA(1, 0), cA + kstep, voffA); PG8_STAGE(PG8_SB(1, 1), cB + hstep + kstep, voffB);
        PG8_WAIT_V(6); PG8_BAR;
    }
    for (;;) {
        const bool has_next = S.next(ui + 1, nxt);
        const char* nA = has_next ? (const char*)g.A + (size_t)nxt.pm * tstep : cA; const char* nB = has_next ? (const char*)g.Bt + (size_t)nxt.pn * tstep : cB;
        for (int t = 0; t < nt; t += 2) {
            const bool last = (t == nt - 2);
            const char* a1 = cA + (size_t)(t + 1) * kstep;
            const char* a2 = last ? nA : cA + (size_t)(t + 2) * kstep; const char* b2 = last ? nB : cB + (size_t)(t + 2) * kstep;
            const char* a3 = a2 + kstep; const char* b3 = b2 + kstep;
            if (last && has_next) S.a_ready(nxt);
            if constexpr (SP2) {
            PG8_LDB(B0, 0, 0); PG8_LDB(B1, 0, 1); PG8_SCHED; PG8_LDA(At, 0, 0); PG8_STAGE(PG8_SA(1, 1), a1 + hstep, voffA);
            PG8_WAIT_V(8); PG8_WAIT_L(0); PG8_BAR; PG8_MMA(0, 0, At, B0); PG8_MMA(0, 1, At, B1); PG8_BAR; PG8_SCHED;
            PG8_LDA(At, 0, 1); PG8_STAGE(PG8_SB(0, 0), b2, voffB); PG8_STAGE(PG8_SB(0, 1), b2 + hstep, voffB); PG8_STAGE(PG8_SA(0, 0), a2, voffA);
            PG8_WAIT_V(8); PG8_WAIT_L(0); PG8_BAR; PG8_MMA(1, 0, At, B0); PG8_MMA(1, 1, At, B1); PG8_BAR; PG8_SCHED;
            PG8_LDB(B0, 1, 0); PG8_LDB(B1, 1, 1); PG8_SCHED; PG8_LDA(At, 1, 0); PG8_STAGE(PG8_SA(0, 1), a2 + hstep, voffA);
            PG8_WAIT_V(8); PG8_WAIT_L(0); PG8_BAR; PG8_MMA(0, 0, At, B0); PG8_MMA(0, 1, At, B1); PG8_BAR; PG8_SCHED;
            PG8_LDA(At, 1, 1); PG8_STAGE(PG8_SB(1, 0), b3, voffB); PG8_STAGE(PG8_SB(1, 1), b3 + hstep, voffB); PG8_STAGE(PG8_SA(1, 0), a3, voffA);
            PG8_WAIT_V(8); PG8_WAIT_L(0); PG8_BAR; PG8_MMA(1, 0, At, B0); PG8_MMA(1, 1, At, B1); PG8_BAR; PG8_SCHED;
            } else {
            PG8_LDB(B0, 0, 0); PG8_SCHED; PG8_LDA(At, 0, 0); PG8_STAGE(PG8_SA(1, 1), a1 + hstep, voffA);
            PG8_WAIT_L(8); PG8_BAR; PG8_WAIT_L(0); PG8_MMA(0, 0, At, B0); PG8_BAR; PG8_SCHED;
            PG8_LDB(B1, 0, 1); PG8_STAGE(PG8_SB(0, 0), b2, voffB);
            PG8_BAR; PG8_WAIT_L(0); PG8_MMA(0, 1, At, B1); PG8_BAR;
            PG8_LDA(At, 0, 1); PG8_STAGE(PG8_SA(0, 0), a2, voffA);
            PG8_BAR; PG8_WAIT_L(0); PG8_MMA(1, 0, At, B0); PG8_BAR; PG8_SCHED;
            PG8_STAGE(PG8_SB(0, 1), b2 + hstep, voffB);
            PG8_WAIT_V(6); PG8_BAR; PG8_MMA(1, 1, At, B1); PG8_BAR;
            PG8_LDB(B0, 1, 0); PG8_SCHED; PG8_LDA(At, 1, 0); PG8_STAGE(PG8_SA(0, 1), a2 + hstep, voffA);
            PG8_WAIT_L(8); PG8_BAR; PG8_WAIT_L(0); PG8_MMA(0, 0, At, B0); PG8_BAR; PG8_SCHED;
            PG8_LDB(B1, 1, 1); PG8_STAGE(PG8_SB(1, 0), b3, voffB);
            PG8_BAR; PG8_WAIT_L(0); PG8_MMA(0, 1, At, B1); PG8_BAR;
            PG8_LDA(At, 1, 1); PG8_STAGE(PG8_SA(1, 0), a3, voffA);
            PG8_BAR; PG8_WAIT_L(0); PG8_MMA(1, 0, At, B0); PG8_BAR; PG8_SCHED;
            PG8_STAGE(PG8_SB(1, 1), b3 + hstep, voffB);
            PG8_WAIT_V(6); PG8_BAR; PG8_MMA(1, 1, At, B1); PG8_BAR;
            }
        }
        if constexpr (ALIGN_EPI) { if (wr == 0) PG8_BAR; }
        if constexpr (!Epi::AFTER_DRAIN) { E(acc, cur, wr, wc, fr, fq); S.done(cur); }
        if (!has_next) break;
#pragma unroll
        for (int a = 0; a < 2; ++a)
#pragma unroll
            for (int b = 0; b < 2; ++b)
#pragma unroll
                for (int m = 0; m < 4; ++m)
#pragma unroll
                    for (int n = 0; n < 2; ++n) acc[a][b][m][n] = (f32x4){0.f, 0.f, 0.f, 0.f};
        cur = nxt; cA = nA; cB = nB; ++ui;
        if constexpr (ALIGN_EPI) { if (wr == 1) PG8_BAR; }
    }
    PG8_WAIT_V(0);
    if constexpr (!ALIGN_EPI) { if (wr == 0) PG8_BAR; }
    PG8_BAR;
    if constexpr (Epi::AFTER_DRAIN) { E.fused(acc, cur, wr, wc, fr, fq, lds, wid, lane); S.done(cur); }
#undef PG8_SA
#undef PG8_SB
#undef PG8_STAGE
#undef PG8_LDA
#undef PG8_LDB
#undef PG8_MMA
#undef PG8_WAIT_V
#undef PG8_WAIT_L
#undef PG8_BAR
#undef PG8_SCHED
}
}

constexpr int BATCH = 2, SEQ = 8192, DM = 1024, DEPTH = 2, M = BATCH * SEQ;
constexpr int RW_H = 6, HD = 64, RW_W = 384, RW_SHIFT = 1280;
constexpr int NIN = 3712, NU = 3840;
constexpr int C_R = 0, C_K = 384, C_V = 768, C_WL = 1152, C_AL = 1216, C_RWZ = 1280, C_HGQ = 1664, C_HGF = 2048, C_HGI = 2432, C_HGZ = 2816, C_LRUX = 3200, C_LRUZ = 3456;
constexpr int CH = 64;
constexpr int NWAVES = 8, NT = NWAVES * 64;
constexpr int LDS_BYTES = 163840;
constexpr int PRM_OFF = 138240;
constexpr size_t MiB = 1u << 20;
constexpr size_t WS_WUPT = 65536, WS_AUPT = WS_WUPT + 98304, WS_VDNT = WS_AUPT + 98304, WS_VUPT = WS_VDNT + 24576, WS_WAT = WS_VUPT + 24576, WS_WXT = WS_WAT + 65536;
constexpr size_t WS_WIN = 1 * MiB, WIN_L = (size_t)NU * DM * 2;
constexpr size_t WS_WOUT = 16 * MiB, WOUT_L = (size_t)DM * DM * 2;
constexpr size_t WS_XN = 20 * MiB;
constexpr size_t WS_QT = 20 * MiB;
constexpr size_t WS_PT = 32 * MiB;
constexpr size_t WS_CA = 44 * MiB;
constexpr size_t WS_U = 52 * MiB;
constexpr size_t WS_MIX = 172 * MiB;
constexpr size_t WS_VF = 204 * MiB;
constexpr size_t WS_VP = 216 * MiB;
constexpr size_t WS_RL = 228 * MiB;
constexpr size_t WS_HL = 240 * MiB;
constexpr size_t WS_BON = 252 * MiB;
constexpr size_t WS_DC = WS_BON + 512 * 1024;
constexpr size_t WS_LA = WS_DC + 512 * 1024;
constexpr size_t WS_LH = WS_LA + 256 * 1024;
constexpr size_t WS_RSS = WS_LH + 256 * 1024;
constexpr size_t WS_END = 254 * MiB;
constexpr int NCH = SEQ / CH;

#define LAS __attribute__((address_space(3)))
typedef float f32x4 __attribute__((ext_vector_type(4)));
typedef unsigned u32x2 __attribute__((ext_vector_type(2)));
typedef unsigned u32x4 __attribute__((ext_vector_type(4)));
typedef _Float16 f16;
typedef _Float16 f16x8 __attribute__((ext_vector_type(8)));
#define LDS_WAIT() asm volatile("s_waitcnt lgkmcnt(0)" ::: "memory")

struct Args { const float* in[27]; float* out; unsigned char* ws; };

__device__ __forceinline__ float wave_sum(float v) {
#pragma unroll
    for (int o = 1; o < 64; o <<= 1) v += shfl_xor_f(v, o);
    return v;
}
__device__ __forceinline__ float sigmoidf_(float x) { return 1.0f / (1.0f + __expf(-x)); }
__device__ __forceinline__ float siluf_(float x) { return x / (1.0f + __expf(-x)); }

__device__ __forceinline__ void p0_transpose_item(const float* W, int K, int N, unsigned short* WT, LAS float* scr, int item, int lane, const float* rsc) {
    const int nblk = N / 32, kb = item / nblk, nb = item % nblk, k0 = 64 * kb, n0 = 32 * nb;
#pragma unroll 8
    for (int i = 0; i < 32; ++i) { const int kk = 2 * i + (lane >> 5); scr[kk * 33 + (lane & 31)] = W[(size_t)(k0 + kk) * N + n0 + (lane & 31)] * (rsc ? rsc[k0 + kk] : 1.0f); }
    LDS_WAIT(); asm volatile("" ::: "memory");
    const int c = lane & 7;
#pragma unroll
    for (int j = 0; j < 4; ++j) { const int n = (lane >> 3) + 8 * j; const LAS float* s = scr + (8 * c) * 33 + n;
        u32x4 o; o.x = pg8::pk_f16(s[0 * 33], s[1 * 33]); o.y = pg8::pk_f16(s[2 * 33], s[3 * 33]); o.z = pg8::pk_f16(s[4 * 33], s[5 * 33]); o.w = pg8::pk_f16(s[6 * 33], s[7 * 33]);
        *(u32x4*)(WT + (size_t)(n0 + n) * K + k0 + 8 * c) = o; }
    LDS_WAIT(); asm volatile("" ::: "memory");
}
__device__ __forceinline__ void rms_row_f16(const float* xrow, const float* w, unsigned short* orow, int lane) {
    const f32x4* xr = (const f32x4*)xrow + lane; const f32x4* wr = (const f32x4*)w + lane;
    f32x4 v[4]; float s = 0.f;
#pragma unroll
    for (int j = 0; j < 4; ++j) { v[j] = xr[64 * j]; s += (v[j].x * v[j].x + v[j].y * v[j].y) + (v[j].z * v[j].z + v[j].w * v[j].w); }
    const float rs = 1.0f / sqrtf(wave_sum(s) * (1.0f / DM) + 1e-6f);
    u32x2* o8 = (u32x2*)orow + lane;
#pragma unroll
    for (int j = 0; j < 4; ++j) { const f32x4 ww = wr[64 * j]; u32x2 o; o.x = pg8::pk_f16(v[j].x * rs * ww.x, v[j].y * rs * ww.y); o.y = pg8::pk_f16(v[j].z * rs * ww.z, v[j].w * rs * ww.w); o8[64 * j] = o; }
}
__device__ __forceinline__ void rms_row_f32(float* xrow, const float* w, int lane) {
    f32x4* xr = (f32x4*)xrow + lane; const f32x4* wr = (const f32x4*)w + lane;
    f32x4 v[4]; float s = 0.f;
#pragma unroll
    for (int j = 0; j < 4; ++j) { v[j] = xr[64 * j]; s += (v[j].x * v[j].x + v[j].y * v[j].y) + (v[j].z * v[j].z + v[j].w * v[j].w); }
    const float rs = 1.0f / sqrtf(wave_sum(s) * (1.0f / DM) + 1e-6f);
#pragma unroll
    for (int j = 0; j < 4; ++j) { const f32x4 ww = wr[64 * j]; xr[64 * j] = v[j] * rs * ww; }
}


#define SHV(col) ({ const float cur_ = (float)urow[(col)]; const float prev_ = hp ? (float)prow[(col)] : 0.f; cur_ + mu[(col)] * (prev_ - cur_); })

__device__ __forceinline__ void store_row64_f16(f16* dst, const float (&S)[64]) {
#pragma unroll
    for (int q = 0; q < 8; ++q) { u32x4 w; w.x = pg8::pk_f16(S[8 * q], S[8 * q + 1]); w.y = pg8::pk_f16(S[8 * q + 2], S[8 * q + 3]); w.z = pg8::pk_f16(S[8 * q + 4], S[8 * q + 5]); w.w = pg8::pk_f16(S[8 * q + 6], S[8 * q + 7]); *(u32x4*)(dst + 8 * q) = w; }
}


constexpr int RWA_REC = 656  , RWA_VROW = 136, RWA_VPL = 16 * RWA_REC, RWA_INV = RWA_VPL + 16 * RWA_VROW, RWA_BYTES = 12800;
constexpr int C_VD0 = 3712, C_VD1 = 3744;
constexpr int PRM_MU = 0, PRM_W0 = 1280, PRM_A0 = 1664, PRM_KK = 2048, PRM_KA = 2432, PRM_RK = 2816, PRM_V0 = 3200, PRM_FLOATS = 3584;
typedef float f32x2 __attribute__((ext_vector_type(2)));
typedef _Float16 f16x4 __attribute__((ext_vector_type(4)));
__device__ __forceinline__ float fmix_lo(float a, unsigned b, float c) { float d; asm("v_fma_mix_f32 %0, %1, %2, %3 op_sel:[0,0,0] op_sel_hi:[0,1,0]" : "=v"(d) : "v"(a), "v"(b), "v"(c)); return d; }
__device__ __forceinline__ float fmix_hi(float a, unsigned b, float c) { float d; asm("v_fma_mix_f32 %0, %1, %2, %3 op_sel:[0,1,0] op_sel_hi:[0,1,0]" : "=v"(d) : "v"(a), "v"(b), "v"(c)); return d; }
__device__ __forceinline__ float mmix_lo(float a, unsigned b) { float d; asm("v_fma_mix_f32 %0, %1, %2, 0 op_sel:[0,0,0] op_sel_hi:[0,1,0]" : "=v"(d) : "v"(a), "v"(b)); return d; }
__device__ __forceinline__ float mmix_hi(float a, unsigned b) { float d; asm("v_fma_mix_f32 %0, %1, %2, 0 op_sel:[0,1,0] op_sel_hi:[0,1,0]" : "=v"(d) : "v"(a), "v"(b)); return d; }
__device__ __forceinline__ float fma_asm(float a, float b, float c) { float d; asm("v_fma_f32 %0, %1, %2, %3" : "=v"(d) : "v"(a), "v"(b), "v"(c)); return d; }
#define FMIX(a, u, j, c) (((j) & 1) ? fmix_hi((a), (u)[(j) >> 1], (c)) : fmix_lo((a), (u)[(j) >> 1], (c)))
#define MMIX(a, u, j) (((j) & 1) ? mmix_hi((a), (u)[(j) >> 1]) : mmix_lo((a), (u)[(j) >> 1]))
__device__ __forceinline__ float fast_tanh(float x) { return 1.0f - 2.0f / (__expf(2.0f * x) + 1.0f); }
__device__ __forceinline__ void lerp8(const char* ub, unsigned uo, unsigned po, bool hp, const char* mub, unsigned col, float (&x)[8]) {
    const f16x8 cu = *(const f16x8*)(ub + (uo + col * 2u)); f16x8 pv = *(const f16x8*)(ub + (po + col * 2u)); const f32x4 m0 = *(const f32x4*)(mub + col * 4u), m1 = *(const f32x4*)(mub + col * 4u + 16u);
#pragma unroll
    for (int j = 0; j < 8; ++j) { const float c = (float)cu[j], p = hp ? (float)pv[j] : 0.f; x[j] = c + (j < 4 ? m0[j] : m1[j - 4]) * (p - c); }
}
__device__ __forceinline__ void lerp4(const char* ub, unsigned uo, unsigned po, bool hp, const char* mub, unsigned col, float (&x)[4]) {
    const f16x4 cu = *(const f16x4*)(ub + (uo + col * 2u)); f16x4 pv = *(const f16x4*)(ub + (po + col * 2u)); const f32x4 m0 = *(const f32x4*)(mub + col * 4u);
#pragma unroll
    for (int j = 0; j < 4; ++j) { const float c = (float)cu[j], p = hp ? (float)pv[j] : 0.f; x[j] = c + m0[j] * (p - c); }
}
__device__ __forceinline__ f16x8 pack8(const float (&x)[8]) { f16x8 r;
#pragma unroll
    for (int j = 0; j < 8; ++j) r[j] = (f16)x[j];
    return r; }

__device__ __forceinline__ void rwkv_waveA(const Args& a, int l, int b, int c, int h, LAS unsigned char* wl, const LAS float* prm, int lane) {
    const char* Ub = (const char*)(a.ws + WS_U); f16* MIX = (f16*)(a.ws + WS_MIX); char* VF = (char*)(a.ws + WS_VF); char* VP = (char*)(a.ws + WS_VP);
    f16* QT = (f16*)(a.ws + WS_QT); f16* PT = (f16*)(a.ws + WS_PT); f16* RL = (f16*)(a.ws + WS_RL); float* BONG = (float*)(a.ws + WS_BON);
    const char* WUPT = (const char*)(a.ws + WS_WUPT) + (size_t)l * 384 * 64 * 2; const char* AUPT = (const char*)(a.ws + WS_AUPT) + (size_t)l * 384 * 64 * 2;
    const char* VUPT = (const char*)(a.ws + WS_VUPT);
    const int bh = b * RW_H + h;
    float P[64], L[64];
#pragma unroll
    for (int k = 0; k < 64; ++k) { P[k] = (k == lane) ? 1.f : 0.f; L[k] = 0.f; }
#pragma unroll 1
    for (int blk = 0; blk < 4; ++blk) {
        const int lane_ = lane_now();
        const int tok = lane_ & 15, fq = lane_ >> 4;
        const int t = c * CH + blk * 16 + tok; const unsigned m = (unsigned)(b * SEQ + t); const bool hp = t > 0;
        const unsigned uo = m * (unsigned)(NU * 2), po = hp ? uo - (unsigned)(NU * 2) : uo;
        f16x8 cW[2], pW[2], cA[2], pA[2], vd0, vd1;
#pragma unroll
        for (int s = 0; s < 2; ++s) { const unsigned cw = (unsigned)(C_WL + 8 * fq + 32 * s) * 2u, ca = (unsigned)(C_AL + 8 * fq + 32 * s) * 2u;
            cW[s] = *(const f16x8*)(Ub + uo + cw); pW[s] = *(const f16x8*)(Ub + po + cw); cA[s] = *(const f16x8*)(Ub + uo + ca); pA[s] = *(const f16x8*)(Ub + po + ca); }
        if (l > 0) { vd0 = *(const f16x8*)(Ub + uo + (unsigned)(C_VD0 + 8 * fq) * 2u); vd1 = *(const f16x8*)(Ub + po + (unsigned)(C_VD1 + 8 * fq) * 2u); }
#define RW_TLOAD(X, nt) f16x8 X##wu0, X##wu1, X##au0, X##au1, X##vu; f16x4 X##cr, X##pr, X##ck, X##pk, X##cv, X##pv, X##vf; { \
            const unsigned n_ = (unsigned)(h * 64 + 16 * (nt) + tok), cb_ = (unsigned)(h * 64 + 16 * (nt) + 4 * fq); \
            X##wu0 = *(const f16x8*)(WUPT + (n_ * 64u + 8u * fq) * 2u); X##wu1 = *(const f16x8*)(WUPT + (n_ * 64u + 8u * fq + 32u) * 2u); \
            X##au0 = *(const f16x8*)(AUPT + (n_ * 64u + 8u * fq) * 2u); X##au1 = *(const f16x8*)(AUPT + (n_ * 64u + 8u * fq + 32u) * 2u); \
            if (l > 0) { X##vu = *(const f16x8*)(VUPT + (n_ * 32u + 8u * fq) * 2u); X##vf = *(const f16x4*)(VF + (m * (unsigned)RW_W + cb_) * 2u); } \
            X##cr = *(const f16x4*)(Ub + uo + ((unsigned)C_R + cb_) * 2u); X##pr = *(const f16x4*)(Ub + po + ((unsigned)C_R + cb_) * 2u); \
            X##ck = *(const f16x4*)(Ub + uo + ((unsigned)C_K + cb_) * 2u); X##pk = *(const f16x4*)(Ub + po + ((unsigned)C_K + cb_) * 2u); \
            X##cv = *(const f16x4*)(Ub + uo + ((unsigned)C_V + cb_) * 2u); X##pv = *(const f16x4*)(Ub + po + ((unsigned)C_V + cb_) * 2u); }
        f16x8 bW[2], bA[2], bVD;
#pragma unroll
        for (int s = 0; s < 2; ++s) { float xw[8], xa[8];
            const f32x4 mw0 = *(const LAS f32x4*)(prm + PRM_MU + C_WL + 8 * fq + 32 * s), mw1 = *(const LAS f32x4*)(prm + PRM_MU + C_WL + 8 * fq + 32 * s + 4);
            const f32x4 ma0 = *(const LAS f32x4*)(prm + PRM_MU + C_AL + 8 * fq + 32 * s), ma1 = *(const LAS f32x4*)(prm + PRM_MU + C_AL + 8 * fq + 32 * s + 4);
#pragma unroll
            for (int j = 0; j < 8; ++j) { const float cw_ = (float)cW[s][j], pw_ = hp ? (float)pW[s][j] : 0.f, ca_ = (float)cA[s][j], pa_ = hp ? (float)pA[s][j] : 0.f;
                xw[j] = fast_tanh(cw_ + (j < 4 ? mw0[j & 3] : mw1[j & 3]) * (pw_ - cw_)); xa[j] = ca_ + (j < 4 ? ma0[j & 3] : ma1[j & 3]) * (pa_ - ca_); }
            bW[s] = pack8(xw); bA[s] = pack8(xa); }
        if (l > 0) { float xv[8];
#pragma unroll
            for (int j = 0; j < 8; ++j) xv[j] = (float)vd0[j] + (hp ? (float)vd1[j] : 0.f);
            bVD = pack8(xv); }
        float ssq = 0.f, bon = 0.f;
        LAS unsigned char* rec = wl + tok * RWA_REC;
#define RW_TCOMP(X, nt) { const int cb = h * 64 + 16 * (nt) + 4 * fq, co = 16 * (nt) + 4 * fq; \
            f32x4 DWn = (f32x4){0.f, 0.f, 0.f, 0.f}, DAn = DWn, Gn = DWn; \
            DWn = __builtin_amdgcn_mfma_f32_16x16x32_f16(X##wu0, bW[0], DWn, 0, 0, 0); DWn = __builtin_amdgcn_mfma_f32_16x16x32_f16(X##wu1, bW[1], DWn, 0, 0, 0); \
            DAn = __builtin_amdgcn_mfma_f32_16x16x32_f16(X##au0, bA[0], DAn, 0, 0, 0); DAn = __builtin_amdgcn_mfma_f32_16x16x32_f16(X##au1, bA[1], DAn, 0, 0, 0); \
            if (l > 0) Gn = __builtin_amdgcn_mfma_f32_16x16x32_f16(X##vu, bVD, Gn, 0, 0, 0); \
            f16x4 wv, al, be, km, rr, vo; \
            _Pragma("unroll") for (int i = 0; i < 4; ++i) { const LAS float* pc = prm + cb + i; \
                const float cr_ = (float)X##cr[i], ck_ = (float)X##ck[i], cv_ = (float)X##cv[i]; \
                const float rs = cr_ + pc[PRM_MU + C_R] * ((hp ? (float)X##pr[i] : 0.f) - cr_), ks = ck_ + pc[PRM_MU + C_K] * ((hp ? (float)X##pk[i] : 0.f) - ck_), vs = cv_ + pc[PRM_MU + C_V] * ((hp ? (float)X##pv[i] : 0.f) - cv_); \
                wv[i] = (f16)__expf(-0.6065306597126334f * sigmoidf_(pc[PRM_W0] + DWn[i])); \
                const float aa = sigmoidf_(pc[PRM_A0] + DAn[i]); \
                float vv = vs; if (l > 0) vv = vs + ((float)X##vf[i] - vs) * sigmoidf_(pc[PRM_V0] + Gn[i]); \
                const float kk = ks * pc[PRM_KK]; ssq += kk * kk; \
                const float kmod = ks * (1.0f + (aa - 1.0f) * pc[PRM_KA]); \
                bon += rs * kmod * pc[PRM_RK]; \
                al[i] = (f16)(-kk); be[i] = (f16)(kk * aa); km[i] = (f16)kmod; rr[i] = (f16)rs; vo[i] = (f16)vv; \
                asm volatile("" ::: "memory"); } \
            *(LAS f16x4*)(rec + co * 2) = wv; \
            *(LAS f16x4*)(rec + 128 + co * 2) = al; *(LAS f16x4*)(rec + 256 + co * 2) = be; *(LAS f16x4*)(rec + 384 + co * 2) = km; *(LAS f16x4*)(rec + 512 + co * 2) = rr; \
            *(LAS f16x4*)(wl + RWA_VPL + tok * RWA_VROW + co * 2) = vo; \
            *(f16x4*)(VP + (m * (unsigned)RW_W + (unsigned)cb) * 2u) = vo; \
            if (l == 0) *(f16x4*)(VF + (m * (unsigned)RW_W + (unsigned)cb) * 2u) = vo; }
#pragma unroll 1
        for (int nt = 0; nt < 4; ++nt) { RW_TLOAD(T0, nt) RW_TCOMP(T0, nt) asm volatile("" ::: "memory"); }
#undef RW_TLOAD
#undef RW_TCOMP
        ssq += shfl_xor_f(ssq, 16); ssq += shfl_xor_f(ssq, 32);
        bon += shfl_xor_f(bon, 16); bon += shfl_xor_f(bon, 32);
        { const float inv = 1.0f / fmaxf(sqrtf(ssq), 1e-12f);
          if (fq == 0) { *(LAS float*)(wl + RWA_INV + tok * 4) = inv * inv; *(float*)((char*)BONG + (m * 8u + (unsigned)h) * 4u) = bon; } }
        const unsigned mb = (unsigned)(b * SEQ + c * CH + blk * 16);
        asm volatile("s_waitcnt lgkmcnt(0)" ::: "memory");
        u32x4 A[8];
#pragma unroll
        for (int g = 0; g < 8; ++g) A[g] = *(const LAS u32x4*)(wl + 128 + g * 16);
        float vv = (float)*(const LAS f16*)(wl + RWA_VPL + lane_ * 2); float inv2 = *(const LAS float*)(wl + RWA_INV);
#define RW_LDU(W4, B4, K4, R4, g) { W4 = *(const LAS u32x4*)(rc + (g) * 16); B4 = *(const LAS u32x4*)(rc + 256 + (g) * 16); K4 = *(const LAS u32x4*)(rc + 384 + (g) * 16); R4 = *(const LAS u32x4*)(rc + 512 + (g) * 16); }
#define RW_COMP(W4, B4, K4, R4, g) { float tP[8], tL[8]; \
            _Pragma("unroll") for (int j = 0; j < 8; ++j) tP[j] = MMIX(saP, B4, j); \
            _Pragma("unroll") for (int j = 0; j < 8; ++j) tL[j] = MMIX(saL, B4, j); \
            _Pragma("unroll") for (int j = 0; j < 8; ++j) tL[j] = FMIX(vv, K4, j, tL[j]); \
            _Pragma("unroll") for (int j = 0; j < 8; ++j) P[8 * (g) + j] = FMIX(P[8 * (g) + j], W4, j, tP[j]); \
            _Pragma("unroll") for (int j = 0; j < 8; ++j) L[8 * (g) + j] = FMIX(L[8 * (g) + j], W4, j, tL[j]); \
            _Pragma("unroll") for (int j = 0; j < 8; ++j) qa[j] = FMIX(P[8 * (g) + j], R4, j, qa[j]); \
            _Pragma("unroll") for (int j = 0; j < 8; ++j) ya[j] = FMIX(L[8 * (g) + j], R4, j, ya[j]); }
#pragma unroll 1
        for (int t2 = 0; t2 < 16; ++t2) {
            const LAS unsigned char* rc = wl + t2 * RWA_REC;
            u32x4 we, be, ke, re, wo, bo, ko, ro;
            RW_LDU(we, be, ke, re, 0)
            float sP[8], sL[8];
#pragma unroll
            for (int j = 0; j < 8; ++j) { sP[j] = 0.f; sL[j] = 0.f; }
#pragma unroll
            for (int g = 0; g < 8; ++g) {
#pragma unroll
                for (int j = 0; j < 8; ++j) sP[j] = FMIX(P[8 * g + j], A[g], j, sP[j]);
#pragma unroll
                for (int j = 0; j < 8; ++j) sL[j] = FMIX(L[8 * g + j], A[g], j, sL[j]); }
            const float saP = inv2 * (((sP[0] + sP[1]) + (sP[2] + sP[3])) + ((sP[4] + sP[5]) + (sP[6] + sP[7]))), saL = inv2 * (((sL[0] + sL[1]) + (sL[2] + sL[3])) + ((sL[4] + sL[5]) + (sL[6] + sL[7])));
            float qa[8], ya[8];
#pragma unroll
            for (int j = 0; j < 8; ++j) { qa[j] = 0.f; ya[j] = 0.f; }
            RW_LDU(wo, bo, ko, ro, 1) RW_COMP(we, be, ke, re, 0)
            RW_LDU(we, be, ke, re, 2) RW_COMP(wo, bo, ko, ro, 1)
            RW_LDU(wo, bo, ko, ro, 3) RW_COMP(we, be, ke, re, 2)
            RW_LDU(we, be, ke, re, 4) RW_COMP(wo, bo, ko, ro, 3)
            RW_LDU(wo, bo, ko, ro, 5) RW_COMP(we, be, ke, re, 4)
            RW_LDU(we, be, ke, re, 6) RW_COMP(wo, bo, ko, ro, 5)
            RW_LDU(wo, bo, ko, ro, 7) RW_COMP(we, be, ke, re, 6)
            const float vvn = (float)*(const LAS f16*)(wl + RWA_VPL + ((t2 + 1) & 15) * RWA_VROW + lane_ * 2); const float inv2n = *(const LAS float*)(wl + RWA_INV + ((t2 + 1) & 15) * 4);
#pragma unroll
            for (int g = 0; g < 8; ++g) A[g] = *(const LAS u32x4*)(rc + RWA_REC + 128 + g * 16);
            RW_COMP(wo, bo, ko, ro, 7)
            vv = vvn; inv2 = inv2n;
            *(f16*)((char*)MIX + ((mb + t2) * (unsigned)DM + (unsigned)(h * 64 + lane_)) * 2u) = (f16)(((ya[0] + ya[1]) + (ya[2] + ya[3])) + ((ya[4] + ya[5]) + (ya[6] + ya[7])));
            *(f16*)((char*)QT + ((mb + t2) * (unsigned)RW_W + (unsigned)(h * 64 + lane_)) * 2u) = (f16)(((qa[0] + qa[1]) + (qa[2] + qa[3])) + ((qa[4] + qa[5]) + (qa[6] + qa[7])));
        }
#undef RW_LDU
#undef RW_COMP
    }
    store_row64_f16(RL + (((size_t)bh * NCH + c) * 64 + lane) * 64, L);
    f16* pt = PT + ((size_t)bh * NCH + c) * 4096;
#pragma unroll
    for (int k = 0; k < 64; ++k) pt[k * 64 + lane] = (f16)P[k];
}

constexpr int HGA_REC = 384, HGA_V = 16 * HGA_REC, HGA_HEAD = HGA_V + 2048, HGA_BYTES = 2 * HGA_HEAD;
template <int NH>
__device__ __forceinline__ void hgrn_waveA(const Args& a, int l, int b, int c, int h0, LAS unsigned char* wl) {
    char* U = (char*)(a.ws + WS_U); char* MIX = (char*)(a.ws + WS_MIX); f16* HL = (f16*)(a.ws + WS_HL); float* DC = (float*)(a.ws + WS_DC);
    const float* lbr = a.in[16];
    float S[NH][64]; float dpr[NH];
#pragma unroll
    for (int j = 0; j < NH; ++j) { dpr[j] = 1.f;
#pragma unroll
        for (int k = 0; k < 64; ++k) S[j][k] = 0.f; }
#pragma unroll 1
    for (int blk = 0; blk < 4; ++blk) {
        const int lane_ = lane_now();
        const unsigned mb = (unsigned)(b * SEQ + c * CH + blk * 16);
        {
            f16 fr[NH][16], qr[NH][16], vr[NH][16];
#pragma unroll
            for (int j = 0; j < NH; ++j)
#pragma unroll
                for (int tk = 0; tk < 16; ++tk) { const char* ur = U + (mb + tk) * (unsigned)(NU * 2) + (unsigned)((h0 + j) * 64 + lane_) * 2u; fr[j][tk] = *(const f16*)(ur + C_HGF * 2); qr[j][tk] = *(const f16*)(ur + C_HGQ * 2); vr[j][tk] = *(const f16*)(ur + C_HGI * 2); }
#pragma unroll
            for (int j = 0; j < NH; ++j) { const int col = (h0 + j) * 64 + lane_;
                const float lb = (l == 0) ? 0.f : sigmoidf_(lbr[384 + col] - lbr[col]);
                float dp = dpr[j];
#pragma unroll
                for (int tk = 0; tk < 16; ++tk) {
                    const float f = lb + (1.0f - lb) * sigmoidf_((float)fr[j][tk]);
                    LAS unsigned char* rec = wl + j * HGA_HEAD + tk * HGA_REC;
                    *(LAS f16*)(rec + lane_ * 2) = (f16)f; *(LAS f16*)(rec + 128 + lane_ * 2) = (f16)(1.0f - f); *(LAS f16*)(rec + 256 + lane_ * 2) = qr[j][tk];
                    *(LAS f16*)(wl + j * HGA_HEAD + HGA_V + tk * 128 + lane_ * 2) = vr[j][tk];
                    dp *= f;
                    *(f16*)(U + (mb + tk) * (unsigned)(NU * 2) + (unsigned)(C_HGQ + col) * 2u) = (f16)((float)qr[j][tk] * dp);
                }
                dpr[j] = dp; }
        }
        asm volatile("s_waitcnt lgkmcnt(0)" ::: "memory");
#define HG_LD(F4, K4, Q4, rcp, g) { F4 = *(const LAS u32x4*)((rcp) + (g) * 16); K4 = *(const LAS u32x4*)((rcp) + 128 + (g) * 16); Q4 = *(const LAS u32x4*)((rcp) + 256 + (g) * 16); }
#define HG_COMP(Sx, vi, F4, K4, Q4, g) { float tt[8]; \
            _Pragma("unroll") for (int jj = 0; jj < 8; ++jj) tt[jj] = MMIX(vi, K4, jj); \
            _Pragma("unroll") for (int jj = 0; jj < 8; ++jj) Sx[8 * (g) + jj] = FMIX(Sx[8 * (g) + jj], F4, jj, tt[jj]); \
            _Pragma("unroll") for (int jj = 0; jj < 8; ++jj) oa[jj] = FMIX(Sx[8 * (g) + jj], Q4, jj, oa[jj]); }
#define HG_HEAD(Sx, vi, rcp, rcn, oo) { float oa[8]; _Pragma("unroll") for (int jj = 0; jj < 8; ++jj) oa[jj] = 0.f; \
            HG_LD(f4o, k4o, q4o, rcp, 1) HG_COMP(Sx, vi, f4e, k4e, q4e, 0) \
            HG_LD(f4e, k4e, q4e, rcp, 2) HG_COMP(Sx, vi, f4o, k4o, q4o, 1) \
            HG_LD(f4o, k4o, q4o, rcp, 3) HG_COMP(Sx, vi, f4e, k4e, q4e, 2) \
            HG_LD(f4e, k4e, q4e, rcp, 4) HG_COMP(Sx, vi, f4o, k4o, q4o, 3) \
            HG_LD(f4o, k4o, q4o, rcp, 5) HG_COMP(Sx, vi, f4e, k4e, q4e, 4) \
            HG_LD(f4e, k4e, q4e, rcp, 6) HG_COMP(Sx, vi, f4o, k4o, q4o, 5) \
            HG_LD(f4o, k4o, q4o, rcp, 7) HG_COMP(Sx, vi, f4e, k4e, q4e, 6) \
            HG_LD(f4e, k4e, q4e, rcn, 0) HG_COMP(Sx, vi, f4o, k4o, q4o, 7) \
            oo = ((oa[0] + oa[1]) + (oa[2] + oa[3])) + ((oa[4] + oa[5]) + (oa[6] + oa[7])); }
        u32x4 f4e, k4e, q4e, f4o, k4o, q4o;
        HG_LD(f4e, k4e, q4e, wl, 0)
        f16 vh[NH], vn[NH];
#pragma unroll
        for (int j = 0; j < NH; ++j) vh[j] = *(const LAS f16*)(wl + j * HGA_HEAD + HGA_V + lane_ * 2);
#pragma unroll 1
        for (int t2 = 0; t2 < 16; ++t2) {
            const LAS unsigned char* rc = wl + t2 * HGA_REC;
#pragma unroll
            for (int j = 0; j < NH; ++j) vn[j] = *(const LAS f16*)(wl + j * HGA_HEAD + HGA_V + ((t2 + 1) & 15) * 128 + lane_ * 2);
            float oo[NH];
#pragma unroll
            for (int j = 0; j < NH; ++j) { const float vi = (float)vh[j];
                const LAS unsigned char* rcp = rc + j * HGA_HEAD; const LAS unsigned char* rcn = (j + 1 < NH) ? rc + (j + 1) * HGA_HEAD : rc + HGA_REC;
                HG_HEAD(S[j], vi, rcp, rcn, oo[j]) }
            char* mo = MIX + ((mb + t2) * (unsigned)DM + (unsigned)(384 + h0 * 64 + lane_)) * 2u;
#pragma unroll
            for (int j = 0; j < NH; ++j) { *(f16*)(mo + 128 * j) = (f16)oo[j]; vh[j] = vn[j]; }
        }
#undef HG_LD
#undef HG_COMP
#undef HG_HEAD
    }
    const int lane2 = lane_now();
#pragma unroll
    for (int j = 0; j < NH; ++j) { const int bh = b * 6 + h0 + j; store_row64_f16(HL + (((size_t)bh * NCH + c) * 64 + lane2) * 64, S[j]);
        DC[((size_t)bh * NCH + c) * 64 + lane2] = dpr[j]; }
}
__device__ __forceinline__ void phaseA(const Args& a, int l, int task, LAS unsigned char* lds, int tid) {
    asm volatile("" : "+v"(tid));
    const int lane = tid & 63, wave = __builtin_amdgcn_readfirstlane(tid >> 6);
    const int b = task / NCH, c = task % NCH;
    const f16* U = (const f16*)(a.ws + WS_U); f16* MIX = (f16*)(a.ws + WS_MIX); f16* VF = (f16*)(a.ws + WS_VF); f16* VP = (f16*)(a.ws + WS_VP);
    f16* QT = (f16*)(a.ws + WS_QT); f16* PT = (f16*)(a.ws + WS_PT); f16* RL = (f16*)(a.ws + WS_RL); float* BONG = (float*)(a.ws + WS_BON);
    {
        LAS float* prm = (LAS float*)(lds + PRM_OFF);
        for (int i = tid; i < PRM_FLOATS; i += NT) { float v;
            if (i < 1280) v = a.in[3][l * RW_SHIFT + i];
            else { const int q = (i - 1280) / 384, cc = (i - 1280) % 384;
                v = (q == 0) ? a.in[4][l * RW_W + cc] : (q == 1) ? a.in[6][l * RW_W + cc] : (q == 2) ? a.in[11][l * RW_W + cc] : (q == 3) ? a.in[12][l * RW_W + cc] : (q == 4) ? a.in[13][l * RW_W + cc] : a.in[8][cc]; }
            prm[i] = v; }
        __syncthreads();
        if (wave < RW_H) rwkv_waveA(a, l, b, c, wave, lds + wave * RWA_BYTES, prm, lane);
        else { LAS unsigned char* hw = lds + RW_H * RWA_BYTES + (wave - RW_H) * HGA_BYTES;
               hgrn_waveA<2>(a, l, b, c, 2 * (wave - RW_H), hw); hgrn_waveA<1>(a, l, b, c, 4 + (wave - RW_H), hw); }
        __syncthreads();
    }
    {
        const int ln = lane_now(); const int tid2 = wave * 64 + ln;
        const char* Ub = (const char*)(a.ws + WS_U); char* MIXb = (char*)(a.ws + WS_MIX); char* CA = (char*)(a.ws + WS_CA); float* LA = (float*)(a.ws + WS_LA); float* LH = (float*)(a.ws + WS_LH);
        const float* cw = a.in[18] + l * 4 * 256; const float* cb = a.in[19] + l * 256;
        const float* ba = a.in[21] + l * 256; const float* bx = a.in[23] + l * 256; const float* lam = a.in[24] + l * 256;
        const char* WAT = (const char*)(a.ws + WS_WAT) + (size_t)l * 4 * 8192; const char* WXT = (const char*)(a.ws + WS_WXT) + (size_t)l * 4 * 8192;
        LAS unsigned char* Y = lds;
        LAS float* AGG = (LAS float*)(lds + 34816);
        const unsigned mrow0 = (unsigned)(b * SEQ + c * CH);
#pragma unroll
        for (int it = 0; it < 4; ++it) { const int item = tid2 + 512 * it, tok = item >> 5, co = item & 31; const int t = c * CH + tok;
            const f32x4 b0 = *(const f32x4*)(cb + 8 * co), b1 = *(const f32x4*)(cb + 8 * co + 4);
            float y[8] = {b0[0], b0[1], b0[2], b0[3], b1[0], b1[1], b1[2], b1[3]};
#pragma unroll
            for (int jj = 0; jj < 4; ++jj) { const int ts = t - 3 + jj;
                if (ts >= 0) { const f16x8 x8 = *(const f16x8*)(Ub + ((mrow0 + (unsigned)(tok - 3 + jj)) * (unsigned)NU + (unsigned)(C_LRUX + 8 * co)) * 2u);
                    const f32x4 w0 = *(const f32x4*)(cw + jj * 256 + 8 * co), w1 = *(const f32x4*)(cw + jj * 256 + 8 * co + 4);
#pragma unroll
                    for (int i = 0; i < 8; ++i) y[i] += (i < 4 ? w0[i & 3] : w1[i & 3]) * (float)x8[i]; } }
            *(LAS f16x8*)(Y + tok * 528 + co * 16) = pack8(y); }
        __syncthreads();
        const int tl = ln & 15, fq = ln >> 4, tt = wave & 3, gp = wave >> 2;
        float Asc[32], Hsc[32];
#pragma unroll
        for (int gg = 0; gg < 2; ++gg) { const int g = 2 * gp + gg;
            f16x8 by[2];
#pragma unroll
            for (int s2 = 0; s2 < 2; ++s2) by[s2] = *(const LAS f16x8*)(Y + (16 * tt + tl) * 528 + (g * 64 + 8 * fq + 32 * s2) * 2);
#pragma unroll
            for (int nt = 0; nt < 4; ++nt) {
                f32x4 ra = (f32x4){0.f, 0.f, 0.f, 0.f}, rx = ra;
#pragma unroll
                for (int s2 = 0; s2 < 2; ++s2) { const unsigned wo = (unsigned)(g * 8192 + ((16 * nt + tl) * 64 + 8 * fq + 32 * s2) * 2);
                    ra = __builtin_amdgcn_mfma_f32_16x16x32_f16(*(const f16x8*)(WAT + wo), by[s2], ra, 0, 0, 0);
                    rx = __builtin_amdgcn_mfma_f32_16x16x32_f16(*(const f16x8*)(WXT + wo), by[s2], rx, 0, 0, 0); }
                const int ch0 = g * 64 + 16 * nt + 4 * fq;
                const f32x4 ba4 = *(const f32x4*)(ba + ch0), bx4 = *(const f32x4*)(bx + ch0), lm4 = *(const f32x4*)(lam + ch0);
                const f16x4 y4 = *(const LAS f16x4*)(Y + (16 * tt + tl) * 528 + ch0 * 2);
#pragma unroll
                for (int i = 0; i < 4; ++i) {
                    const float r = sigmoidf_(ra[i] + ba4[i]), ig = sigmoidf_(rx[i] + bx4[i]);
                    const float la = -8.0f * r * log1pf(__expf(-lm4[i]));
                    float av = __expf(la), uv = sqrtf(-expm1f(2.0f * la)) * (ig * (float)y4[i]);
#define LRU_SCAN(d) { const float ap = __builtin_bit_cast(float, __builtin_amdgcn_update_dpp(0x3f800000, __builtin_bit_cast(int, av), 0x110 + (d), 0xf, 0xf, false)); \
                      const float up = __builtin_bit_cast(float, __builtin_amdgcn_update_dpp(0, __builtin_bit_cast(int, uv), 0x110 + (d), 0xf, 0xf, false)); \
                      uv = av * up + uv; av = av * ap; }
                    LRU_SCAN(1) LRU_SCAN(2) LRU_SCAN(4) LRU_SCAN(8)
#undef LRU_SCAN
                    Asc[gg * 16 + nt * 4 + i] = av; Hsc[gg * 16 + nt * 4 + i] = uv;
                    if (tl == 15) { AGG[(tt * 256 + ch0 + i) * 2] = av; AGG[(tt * 256 + ch0 + i) * 2 + 1] = uv; }
                }
            }
        }
        __syncthreads();
        const unsigned m = mrow0 + (unsigned)(16 * tt + tl);
#pragma unroll
        for (int gg = 0; gg < 2; ++gg)
#pragma unroll
            for (int nt = 0; nt < 4; ++nt) { const int ch0 = (2 * gp + gg) * 64 + 16 * nt + 4 * fq;
                f16x4 ho, co;
#pragma unroll
                for (int i = 0; i < 4; ++i) { float cy = 0.f, cpv = 1.f;
#pragma unroll
                    for (int t3 = 0; t3 < 3; ++t3) if (t3 < tt) { const float A3 = AGG[(t3 * 256 + ch0 + i) * 2], H3 = AGG[(t3 * 256 + ch0 + i) * 2 + 1]; cy = A3 * cy + H3; cpv *= A3; }
                    const float hl = Hsc[gg * 16 + nt * 4 + i] + Asc[gg * 16 + nt * 4 + i] * cy, ca = Asc[gg * 16 + nt * 4 + i] * cpv;
                    ho[i] = (f16)hl; co[i] = (f16)ca;
                    if (tt == 3 && tl == 15) { LA[((size_t)b * NCH + c) * 256 + ch0 + i] = ca; LH[((size_t)b * NCH + c) * 256 + ch0 + i] = hl; } }
                *(f16x4*)(MIXb + (m * (unsigned)DM + 768u + (unsigned)ch0) * 2u) = ho; *(f16x4*)(CA + (m * 256u + (unsigned)ch0) * 2u) = co; }
    }
}


constexpr int PB_SLOT = 16384, PB_NS = 8, PB_AHEAD = 6;
__device__ __forceinline__ void phaseB(const Args& a, LAS unsigned char* lds, int tid) {
    asm volatile("" : "+v"(tid));
    const int lane = tid & 63, wave = __builtin_amdgcn_readfirstlane(tid >> 6);
    const int bx = blockIdx.x;
    if (bx < 12) {
        const int bh = bx;
        const char* PT = (const char*)(a.ws + WS_PT) + (size_t)bh * NCH * 8192; char* RL = (char*)(a.ws + WS_RL) + (size_t)bh * NCH * 8192;
        const bool loader = wave >= 4;
        const int vt = wave & 3, vl = lane & 15, fq = lane >> 4, v = 16 * vt + vl;
        const int lq = (wave - 4) * 64 + lane, lrow = lq >> 3, lpp = lq & 7;
        const unsigned lsrc = (unsigned)(lrow * 128 + ((lpp ^ (lrow & 7)) << 4));
#define PB_ISSUE(cc) { const unsigned so = (unsigned)(((cc) & (PB_NS - 1)) * PB_SLOT) + (unsigned)((wave - 4) * 1024); const size_t go = (size_t)(cc) * 8192 + lsrc; \
            __builtin_amdgcn_global_load_lds((const unsigned*)(PT + go), (LAS unsigned*)(lds + so), 16, 0, 0); \
            __builtin_amdgcn_global_load_lds((const unsigned*)(PT + go + 4096), (LAS unsigned*)(lds + so + 4096), 16, 0, 0); \
            __builtin_amdgcn_global_load_lds((const unsigned*)(RL + go), (LAS unsigned*)(lds + so + 8192), 16, 0, 0); \
            __builtin_amdgcn_global_load_lds((const unsigned*)(RL + go + 4096), (LAS unsigned*)(lds + so + 12288), 16, 0, 0); }
#define PB_SWZ(row, o) ((row) * 128 + (((((o) >> 4) ^ ((row) & 7)) << 4) | ((o) & 15)))
        if (loader) {
#pragma unroll
            for (int cc = 0; cc < PB_AHEAD; ++cc) PB_ISSUE(cc)
            asm volatile("s_waitcnt vmcnt(20)" ::: "memory");
        }
        __builtin_amdgcn_s_barrier();
        f32x4 Sacc[4];
#pragma unroll
        for (int mt = 0; mt < 4; ++mt) Sacc[mt] = (f32x4){0.f, 0.f, 0.f, 0.f};
#pragma unroll 1
        for (int c = 0; c < NCH; ++c) {
            if (loader) {
                if (c + PB_AHEAD < NCH) { PB_ISSUE(c + PB_AHEAD) asm volatile("s_waitcnt vmcnt(20)" ::: "memory"); }
                else asm volatile("s_waitcnt vmcnt(0)" ::: "memory");
            } else {
                const LAS unsigned char* sl = lds + (c & (PB_NS - 1)) * PB_SLOT;
                f16x8 Bhi[2], Blo[2];
#pragma unroll
                for (int mt = 0; mt < 4; ++mt) { f16x4 hi;
#pragma unroll
                    for (int i = 0; i < 4; ++i) { hi[i] = (f16)Sacc[mt][i]; const f16 lo = (f16)(Sacc[mt][i] - (float)hi[i]); Bhi[mt >> 1][4 * (mt & 1) + i] = hi[i]; Blo[mt >> 1][4 * (mt & 1) + i] = lo; }
                    *(f16x4*)(RL + (size_t)c * 8192 + (v * 64 + 16 * mt + 4 * fq) * 2) = hi; }
#pragma unroll
                for (int mt = 0; mt < 4; ++mt) {
                    const f16x4 l4 = *(const LAS f16x4*)(sl + 8192 + PB_SWZ(v, 32 * mt + 8 * fq));
                    f32x4 d = (f32x4){(float)l4[0], (float)l4[1], (float)l4[2], (float)l4[3]};
#pragma unroll
                    for (int s = 0; s < 2; ++s) { const u32x2 a0 = *(const LAS u32x2*)(sl + PB_SWZ(16 * mt + vl, 64 * s + 8 * fq)), a1 = *(const LAS u32x2*)(sl + PB_SWZ(16 * mt + vl, 64 * s + 32 + 8 * fq));
                        u32x4 aw; aw.x = a0.x; aw.y = a0.y; aw.z = a1.x; aw.w = a1.y; const f16x8 af = __builtin_bit_cast(f16x8, aw);
                        d = __builtin_amdgcn_mfma_f32_16x16x32_f16(af, Bhi[s], d, 0, 0, 0); d = __builtin_amdgcn_mfma_f32_16x16x32_f16(af, Blo[s], d, 0, 0, 0); }
                    Sacc[mt] = d; }
                asm volatile("s_waitcnt lgkmcnt(0)" ::: "memory");
            }
            __builtin_amdgcn_s_barrier();
        }
#undef PB_ISSUE
#undef PB_SWZ
        asm volatile("s_waitcnt vmcnt(0)" ::: "memory");
    } else if (bx < 12 + 96) {
        const int idx = (bx - 12) * NT + tid; const int bh = idx >> 12, e = idx & 4095, k = e & 63;
        f16* HL = (f16*)(a.ws + WS_HL); const float* DC = (const float*)(a.ws + WS_DC);
        float s = 0.f;
        for (int c0 = 0; c0 < NCH; c0 += 8) { float Lc[8], d[8];
#pragma unroll
            for (int j = 0; j < 8; ++j) { Lc[j] = (float)HL[((size_t)bh * NCH + c0 + j) * 4096 + e]; d[j] = DC[((size_t)bh * NCH + c0 + j) * 64 + k]; }
#pragma unroll
            for (int j = 0; j < 8; ++j) { HL[((size_t)bh * NCH + c0 + j) * 4096 + e] = (f16)s; s = d[j] * s + Lc[j]; } }
    } else if (bx == 12 + 96) {
        const int bb = tid >> 8, ch = tid & 255; const float* LA = (const float*)(a.ws + WS_LA); float* LH = (float*)(a.ws + WS_LH);
        float cy = 0.f;
        for (int c0 = 0; c0 < NCH; c0 += 8) { float A[8], H[8];
#pragma unroll
            for (int j = 0; j < 8; ++j) { const size_t o = ((size_t)bb * NCH + c0 + j) * 256 + ch; A[j] = LA[o]; H[j] = LH[o]; }
#pragma unroll
            for (int j = 0; j < 8; ++j) { const size_t o = ((size_t)bb * NCH + c0 + j) * 256 + ch; LH[o] = cy; cy = A[j] * cy + H[j]; } }
    }
}

__device__ __forceinline__ void phaseC(const Args& a, int l, int task, LAS unsigned char* lds, int tid) {
    asm volatile("" : "+v"(tid));
    const int lane = tid & 63, wave = __builtin_amdgcn_readfirstlane(tid >> 6);
    const int b = task / NCH, c = task % NCH;
    const int tl = lane & 15, fq = lane >> 4, tt = wave & 3, hg = wave >> 2;
    const unsigned m = (unsigned)(b * SEQ + c * CH + 16 * tt + tl);
    const char* U = (const char*)(a.ws + WS_U); char* MIX = (char*)(a.ws + WS_MIX); const char* VP = (const char*)(a.ws + WS_VP);
    const char* QT = (const char*)(a.ws + WS_QT); const char* RL = (const char*)(a.ws + WS_RL); const char* HL = (const char*)(a.ws + WS_HL); const float* BONG = (const float*)(a.ws + WS_BON);
    const unsigned uo = m * (unsigned)(NU * 2);
#pragma unroll
    for (int hh = 0; hh < 3; ++hh) {
        const int h = 3 * hg + hh; const int bh = b * RW_H + h;
        const char* sl = RL + ((size_t)bh * NCH + c) * 8192;
        f16x8 bq[2];
#pragma unroll
        for (int s = 0; s < 2; ++s) bq[s] = *(const f16x8*)(QT + (m * (unsigned)RW_W + (unsigned)(h * 64 + 8 * fq + 32 * s)) * 2u);
        f32x4 D[4];
#pragma unroll
        for (int vt = 0; vt < 4; ++vt) { const f16x4 yl = *(const f16x4*)(MIX + (m * (unsigned)DM + (unsigned)(h * 64 + 16 * vt + 4 * fq)) * 2u);
            f32x4 d = (f32x4){(float)yl[0], (float)yl[1], (float)yl[2], (float)yl[3]};
#pragma unroll
            for (int s = 0; s < 2; ++s) d = __builtin_amdgcn_mfma_f32_16x16x32_f16(*(const f16x8*)(sl + ((16 * vt + tl) * 64 + 8 * fq + 32 * s) * 2), bq[s], d, 0, 0, 0);
            D[vt] = d; }
        float sm = 0.f;
#pragma unroll
        for (int vt = 0; vt < 4; ++vt) sm += (D[vt][0] + D[vt][1]) + (D[vt][2] + D[vt][3]);
        sm += shfl_xor_f(sm, 16); sm += shfl_xor_f(sm, 32);
        const float mean = sm * (1.0f / 64.0f); float vr = 0.f;
#pragma unroll
        for (int vt = 0; vt < 4; ++vt)
#pragma unroll
            for (int i = 0; i < 4; ++i) { const float d = D[vt][i] - mean; vr += d * d; }
        vr += shfl_xor_f(vr, 16); vr += shfl_xor_f(vr, 32);
        const float rstd = 1.0f / sqrtf(vr * (1.0f / 64.0f) + 64e-5f);
        const float bon = BONG[m * 8u + (unsigned)h];
        const float* ln_w = a.in[14] + l * RW_W; const float* ln_b = a.in[15] + l * RW_W;
#pragma unroll
        for (int vt = 0; vt < 4; ++vt) { const unsigned col = (unsigned)(h * 64 + 16 * vt + 4 * fq);
            const f16x4 vp = *(const f16x4*)(VP + (m * (unsigned)RW_W + col) * 2u), z4 = *(const f16x4*)(U + uo + ((unsigned)C_RWZ + col) * 2u);
            const f32x4 lw = *(const f32x4*)(ln_w + col), lb = *(const f32x4*)(ln_b + col);
            f16x4 o;
#pragma unroll
            for (int i = 0; i < 4; ++i) o[i] = (f16)(((D[vt][i] - mean) * rstd * lw[i] + lb[i] + bon * (float)vp[i]) * siluf_((float)z4[i]));
            *(f16x4*)(MIX + (m * (unsigned)DM + col) * 2u) = o; }
    }
#pragma unroll
    for (int hh = 0; hh < 3; ++hh) {
        const int h = 3 * hg + hh; const int bh = b * 6 + h;
        const char* sl = HL + ((size_t)bh * NCH + c) * 8192;
        f16x8 bq[2];
#pragma unroll
        for (int s = 0; s < 2; ++s) bq[s] = *(const f16x8*)(U + uo + (unsigned)(C_HGQ + h * 64 + 8 * fq + 32 * s) * 2u);
        f32x4 D[4];
#pragma unroll
        for (int vt = 0; vt < 4; ++vt) { const f16x4 ol = *(const f16x4*)(MIX + (m * (unsigned)DM + (unsigned)(384 + h * 64 + 16 * vt + 4 * fq)) * 2u);
            f32x4 d = (f32x4){(float)ol[0], (float)ol[1], (float)ol[2], (float)ol[3]};
#pragma unroll
            for (int s = 0; s < 2; ++s) d = __builtin_amdgcn_mfma_f32_16x16x32_f16(*(const f16x8*)(sl + ((16 * vt + tl) * 64 + 8 * fq + 32 * s) * 2), bq[s], d, 0, 0, 0);
            D[vt] = d; }
        float ss = 0.f;
#pragma unroll
        for (int vt = 0; vt < 4; ++vt) ss += (D[vt][0] * D[vt][0] + D[vt][1] * D[vt][1]) + (D[vt][2] * D[vt][2] + D[vt][3] * D[vt][3]);
        ss += shfl_xor_f(ss, 16); ss += shfl_xor_f(ss, 32);
        const float rs = 1.0f / sqrtf(ss * (1.0f / 64.0f) + 1e-6f);
        const float* nw = a.in[17] + l * 384;
#pragma unroll
        for (int vt = 0; vt < 4; ++vt) { const unsigned col = (unsigned)(h * 64 + 16 * vt + 4 * fq);
            const f16x4 z4 = *(const f16x4*)(U + uo + ((unsigned)C_HGZ + col) * 2u); const f32x4 w4 = *(const f32x4*)(nw + col);
            f16x4 o;
#pragma unroll
            for (int i = 0; i < 4; ++i) o[i] = (f16)(D[vt][i] * rs * w4[i] * siluf_((float)z4[i]));
            *(f16x4*)(MIX + (m * (unsigned)DM + 384u + col) * 2u) = o; }
    }
    {
        const char* CA = (const char*)(a.ws + WS_CA); const float* LH = (const float*)(a.ws + WS_LH) + ((size_t)b * NCH + c) * 256;
#pragma unroll
        for (int q = 0; q < 4; ++q) { const unsigned ch0 = (unsigned)(128 * hg + 32 * fq + 8 * q);
            const f16x8 hl = *(const f16x8*)(MIX + (m * (unsigned)DM + 768u + ch0) * 2u), ca = *(const f16x8*)(CA + (m * 256u + ch0) * 2u), z8 = *(const f16x8*)(U + uo + ((unsigned)C_LRUZ + ch0) * 2u);
            const f32x4 c0 = *(const f32x4*)(LH + ch0), c1 = *(const f32x4*)(LH + ch0 + 4);
            f16x8 o;
#pragma unroll
            for (int i = 0; i < 8; ++i) o[i] = (f16)(((float)hl[i] + (float)ca[i] * (i < 4 ? c0[i & 3] : c1[i & 3])) * siluf_((float)z8[i]));
            *(f16x8*)(MIX + (m * (unsigned)DM + 768u + ch0) * 2u) = o; }
    }
}
#define XB_TMO      128
#define XB_XCNT(j)  (256  + 64 * (j))
#define XB_XSUB(j)  (1280 + 64 * (j))
#define XB_XGEN(j)  (2304 + 64 * (j))
#define XB_TOP      3328
#define XB_TOPGEN   3392
#define XCD_BAR_WORDS 3456
#define XB_SPIN_CAP (1u << 18)

__device__ __forceinline__ unsigned xb_ld(unsigned* p)              { return __hip_atomic_load(p, __ATOMIC_RELAXED, __HIP_MEMORY_SCOPE_AGENT); }
__device__ __forceinline__ unsigned xb_add(unsigned* p, unsigned v) { return __hip_atomic_fetch_add(p, v, __ATOMIC_RELAXED, __HIP_MEMORY_SCOPE_AGENT); }
__device__ __forceinline__ unsigned xb_xcc_id() { return (unsigned)__builtin_amdgcn_s_getreg((3 << 11) | 20) & 0xFu; }
#define XB_SPIN(cond, bar) do { unsigned _sp = 0; while (cond) { __builtin_amdgcn_s_sleep(1); \
    if ((++_sp & 255u) == 0u) { if (xb_ld(&(bar)[XB_TMO])) break; if (_sp > XB_SPIN_CAP) { atomicAdd(&(bar)[XB_TMO], 1u); break; } } } } while (0)

struct XcdBarrier {
    unsigned* bar; unsigned x; int isw0;
    volatile LAS unsigned* st;
};

__device__ __forceinline__ XcdBarrier xcd_barrier_post(unsigned* bar, volatile LAS unsigned* st, int isw0) {
    XcdBarrier b; b.bar = bar; b.x = xb_xcc_id(); b.st = st; b.isw0 = isw0;
    if (isw0 && lane_now() == 0) (void)xb_add(&bar[XB_XCNT(b.x)], 1u);
    return b;
}
__device__ __forceinline__ void xcd_barrier_complete(unsigned* bar, unsigned x, unsigned& nloc, unsigned& nx) {
    const unsigned G = gridDim.x * gridDim.y * gridDim.z;
    unsigned sum, cnt, mine, sp = 0u;
    for (;;) {
        sum = 0u; cnt = 0u; mine = 0u;
#pragma unroll
        for (unsigned j = 0; j < 16; ++j) { const unsigned c = xb_ld(&bar[XB_XCNT(j)]); sum += c; cnt += (c > 0u) ? 1u : 0u; mine = (j == x) ? c : mine; }
        if (sum == G) break;
        __builtin_amdgcn_s_sleep(1);
        if ((++sp & 255u) == 0u) { if (xb_ld(&bar[XB_TMO])) break; if (sp > XB_SPIN_CAP) { atomicAdd(&bar[XB_TMO], 1u); break; } }
    }
    nloc = mine > 0u ? mine : 1u; nx = cnt > 0u ? cnt : 1u;
}

__device__ __forceinline__ void xcd_barrier(const XcdBarrier& b) {
    asm volatile("s_waitcnt vmcnt(0)" ::: "memory");
    __syncthreads();
    if (b.isw0 && lane_now() == 0) {
        unsigned* bar = b.bar;
        __builtin_amdgcn_s_waitcnt(0);
        unsigned nloc = b.st[0], nx = b.st[1];
        if (nloc == 0u) { xcd_barrier_complete(bar, b.x, nloc, nx); b.st[0] = nloc; b.st[1] = nx; }
        const unsigned old = xb_add(&bar[XB_XSUB(b.x)], 1u);
        const unsigned gen = old / nloc;
        if (old + 1u == (gen + 1u) * nloc) {
            __builtin_amdgcn_fence(__ATOMIC_RELEASE, "agent");
            asm volatile("s_waitcnt vmcnt(0)" ::: "memory");
            const unsigned og = xb_add(&bar[XB_TOP], 1u);
            const unsigned tg = og / nx;
            if (og + 1u == (tg + 1u) * nx) xb_add(&bar[XB_TOPGEN], 1u);
            else XB_SPIN(xb_ld(&bar[XB_TOPGEN]) == tg, bar);
            __builtin_amdgcn_fence(__ATOMIC_ACQUIRE, "agent");
            xb_add(&bar[XB_XGEN(b.x)], 1u);
            asm volatile("s_waitcnt vmcnt(0)" ::: "memory");
        } else {
            XB_SPIN(xb_ld(&bar[XB_XGEN(b.x)]) == gen, bar);
            __builtin_amdgcn_fence(__ATOMIC_ACQUIRE, "agent");
            asm volatile("s_waitcnt vmcnt(0)" ::: "memory");
        }
    }
    __syncthreads();
}

constexpr size_t WS_BAR = 16384;
constexpr int MISC_OFF = LDS_BYTES - 16;
__global__ void __launch_bounds__(NT, 2) fwd(Args args) {
    extern __shared__ __attribute__((aligned(16))) unsigned char lds_raw[];
    LAS unsigned char* lds = (LAS unsigned char*)lds_raw;
    cg::grid_group grid = cg::this_grid();
    const int wave = __builtin_amdgcn_readfirstlane((int)threadIdx.x >> 6);
#define TID_NOW() (wave * 64 + lane_now())
    const int tid = TID_NOW(); const int lane = tid & 63;
    if (wave == 0 && lane < 4) ((LAS unsigned*)(lds + MISC_OFF))[lane] = 0u;
    __syncthreads();
    XcdBarrier xbar = xcd_barrier_post((unsigned*)(args.ws + WS_BAR), (volatile LAS unsigned*)(lds + MISC_OFF), __builtin_amdgcn_readfirstlane(wave == 0 ? 1 : 0));
#define GRID_BAR() do { XcdBarrier xb_ = xbar; xb_.st = (volatile LAS unsigned*)(lds + MISC_OFF); asm volatile("" : "+s"(xb_.bar), "+s"(xb_.x)); xcd_barrier(xb_); } while (0)
    const int G = gridDim.x, gw = blockIdx.x * NWAVES + wave, NGW = G * NWAVES;
    unsigned char* ws = args.ws;
    unsigned short* XN = (unsigned short*)(ws + WS_XN);
    {
        LAS float* scr = (LAS float*)(lds + wave * 16384);
        constexpr int I_IN = (DM / 64) * (NIN / 32), I_OUT = (DM / 64) * (DM / 32), NITEMS = DEPTH * (I_IN + I_OUT);
        for (int it = gw; it < NITEMS; it += NGW) {
            int r = it; const int l = r / (I_IN + I_OUT); r -= l * (I_IN + I_OUT);
            if (r < I_IN) p0_transpose_item(args.in[2] + (size_t)l * DM * NIN, DM, NIN, (unsigned short*)(ws + WS_WIN + l * WIN_L), scr, r, lane, l == 0 ? nullptr : args.in[1] + DM);
            else p0_transpose_item(args.in[25] + (size_t)l * DM * DM, DM, DM, (unsigned short*)(ws + WS_WOUT + l * WOUT_L), scr, r - I_IN, lane, nullptr);
        }
        for (int i = gw; i < DEPTH * (NU - NIN) * DM * 2 / 1024; i += NGW) { const int l = i / ((NU - NIN) * DM * 2 / 1024), r = i % ((NU - NIN) * DM * 2 / 1024);
            if (l == 1 && r < 64 * DM * 2 / 1024) continue;
            *(u32x4*)(ws + WS_WIN + l * WIN_L + (size_t)NIN * DM * 2 + (size_t)r * 1024 + lane * 16) = (u32x4){0u, 0u, 0u, 0u}; }
        for (int i = blockIdx.x * NT + tid; i < 64 * DM; i += G * NT) { const int k = i >> 6, n = i & 63, j = n & 31;
            const float* wrow = args.in[2] + (size_t)DM * NIN + (size_t)k * NIN + C_V; const float* mu1 = args.in[3] + RW_SHIFT + C_V; const float* vdn = args.in[9];
            float acc = 0.f;
            for (int cc = 0; cc < RW_W; ++cc) { const float mm = mu1[cc]; acc += wrow[cc] * ((n < 32) ? (1.0f - mm) : mm) * vdn[cc * 32 + j]; }
            ((f16*)(ws + WS_WIN + WIN_L))[(size_t)(NIN + n) * DM + k] = (f16)(acc * args.in[1][DM + k]); }
        for (int i = blockIdx.x * NT + tid; i < M; i += G * NT) ((float*)(ws + WS_RSS))[i] = 0.f;
        for (int m = gw; m < M; m += NGW) rms_row_f16(args.in[0] + (size_t)m * DM, args.in[1], XN + (size_t)m * DM, lane);
        { f16* WUPT = (f16*)(ws + WS_WUPT); f16* AUPT = (f16*)(ws + WS_AUPT); f16* VDNT = (f16*)(ws + WS_VDNT); f16* VUPT = (f16*)(ws + WS_VUPT);
          for (int i = blockIdx.x * NT + tid; i < 122880; i += G * NT) {
              if (i < 49152) { const int ll = i / 24576, r = i % 24576, n = r / 64, k = r % 64; WUPT[i] = (f16)args.in[5][(size_t)ll * 24576 + k * 384 + n]; }
              else if (i < 98304) { const int i2 = i - 49152, ll = i2 / 24576, r = i2 % 24576, n = r / 64, k = r % 64; AUPT[i2] = (f16)args.in[7][(size_t)ll * 24576 + k * 384 + n]; }
              else if (i < 110592) { const int i2 = i - 98304, j2 = i2 / 384, cc = i2 % 384; VDNT[i2] = (f16)args.in[9][cc * 32 + j2]; }
              else { const int i2 = i - 110592, n = i2 / 32, j2 = i2 % 32; VUPT[i2] = (f16)args.in[10][j2 * 384 + n]; } }
          f16* WAT = (f16*)(ws + WS_WAT); f16* WXT = (f16*)(ws + WS_WXT);
          for (int i = blockIdx.x * NT + tid; i < 32768; i += G * NT) { const int lg = i >> 12, r = i & 4095, j = r >> 6, ii = r & 63; WAT[i] = (f16)args.in[20][(size_t)lg * 4096 + ii * 64 + j]; WXT[i] = (f16)args.in[22][(size_t)lg * 4096 + ii * 64 + j]; } }
    }
    grid.sync();
#pragma unroll 1
    for (int l = 0; l < DEPTH; ++l) {
        { pg8::Gemm g{XN, (const unsigned short*)(ws + WS_WIN + l * WIN_L), M, NU, DM}; pg8::StaticOrder S; S.init(M, NU, G, (int)blockIdx.x);
          pg8::EpiF16 E{(unsigned short*)(ws + WS_U), NU, l == 0 ? nullptr : (const float*)(ws + WS_RSS)};
          pg8::gemm_phase<pg8::EpiF16, pg8::StaticOrder, true, true>(lds, g, S, E, wave); }
        GRID_BAR();
        for (int task = blockIdx.x; task < BATCH * NCH; task += G) phaseA(args, l, task, lds, TID_NOW());
        GRID_BAR();
        phaseB(args, lds, TID_NOW());
        GRID_BAR();
        for (int task = blockIdx.x; task < BATCH * NCH; task += G) phaseC(args, l, task, lds, TID_NOW());
        GRID_BAR();
        { pg8::Gemm g{(const unsigned short*)(ws + WS_MIX), (const unsigned short*)(ws + WS_WOUT + l * WOUT_L), M, DM, DM}; pg8::StaticOrder S; S.init(M, DM, G, (int)blockIdx.x);
          pg8::EpiRes E{l == 0 ? args.in[0] : args.out, args.out, DM, l == 0 ? XN : nullptr, (float*)(ws + WS_RSS)};
          pg8::gemm_phase<pg8::EpiRes, pg8::StaticOrder, true, true>(lds, g, S, E, wave); }
        GRID_BAR();
        { int ln = TID_NOW() & 63; asm volatile("" : "+v"(ln));
          if (l + 1 < DEPTH) { }
          else { for (int m = gw; m < M; m += NGW) rms_row_f32(args.out + (size_t)m * DM, args.in[26], ln); } }
    }
}

extern "C" void kernel_launch(void* const* d_in, const int* in_sizes, int n_in, void* d_out, int out_size, void* d_ws, size_t ws_size, hipStream_t stream) {
    static int grid = 0;
    if (grid == 0) {
        if (n_in != 27 || in_sizes[0] != M * DM || out_size != M * DM || ws_size < WS_END) { fprintf(stderr, "kernel_launch: unexpected problem: n_in %d in0 %d out %d ws %zu\n", n_in, n_in > 0 ? in_sizes[0] : -1, out_size, ws_size); grid = -1; return; }
        int dev = 0, cus = 0, per_cu = 0;
        hipGetDevice(&dev); hipDeviceGetAttribute(&cus, hipDeviceAttributeMultiprocessorCount, dev);
        if (hipFuncSetAttribute((const void*)fwd, hipFuncAttributeMaxDynamicSharedMemorySize, LDS_BYTES) != hipSuccess) { fprintf(stderr, "kernel_launch: hipFuncSetAttribute failed\n"); grid = -1; return; }
        if (hipOccupancyMaxActiveBlocksPerMultiprocessor(&per_cu, (const void*)fwd, NT, LDS_BYTES) != hipSuccess || per_cu < 1) { fprintf(stderr, "kernel_launch: occupancy query failed (%d)\n", per_cu); grid = -1; return; }
        grid = cus * per_cu;
    }
    if (grid < 0) return;
    if (hipMemsetAsync((char*)d_ws, 0, 65536, stream) != hipSuccess) { fprintf(stderr, "kernel_launch: memset of the barrier words failed\n"); return; }
    Args a{};
    for (int i = 0; i < 27; ++i) a.in[i] = (const float*)d_in[i];
    a.out = (float*)d_out; a.ws = (unsigned char*)d_ws;
    void* kargs[] = {&a};
    hipError_t e = hipLaunchCooperativeKernel((const void*)fwd, dim3(grid), dim3(NT), kargs, LDS_BYTES, stream);
    if (e != hipSuccess) fprintf(stderr, "cooperative launch failed: %s (grid %d)\n", hipGetErrorString(e), grid);
}
```

```cpp
#include <hip/hip_runtime.h>
#include <hip/hip_cooperative_groups.h>
#include <cstdio>
#include <cstdint>
namespace cg = cooperative_groups;
typedef _Float16 f16x8_t __attribute__((ext_vector_type(8)));
#define MK_MFMA(a, b, c) __builtin_amdgcn_mfma_f32_16x16x32_f16(__builtin_bit_cast(f16x8_t, (a)), __builtin_bit_cast(f16x8_t, (b)), (c), 0, 0, 0)
__device__ __forceinline__ int lane_now() { int z; asm volatile("v_mbcnt_lo_u32_b32 %0, -1, 0\n\tv_mbcnt_hi_u32_b32 %0, -1, %0" : "=v"(z)); return z; }
__device__ __forceinline__ float shfl_xor_f(float v, int mask) { const int ln = lane_now(); return __builtin_bit_cast(float, __builtin_amdgcn_ds_bpermute((ln ^ mask) << 2, __builtin_bit_cast(int, v))); }
namespace pg8 {
#define PG8_LAS __attribute__((address_space(3)))
typedef unsigned short bf16_t;
typedef short bf16x8 __attribute__((ext_vector_type(8)));
typedef float f32x4 __attribute__((ext_vector_type(4)));
typedef unsigned u32x4 __attribute__((ext_vector_type(4)));
constexpr int BM = 256, BK = 64, HALF = 128, HTB = HALF * BK * 2  , STAGE_BYTES = 8 * HTB, NXCD = 8, WGM = 8;

__host__ __device__ __forceinline__ int lds_byte(int r, int c) { const int st = (r >> 4) * 2 + (c >> 5), rr = r & 15, cc = c & 31, ob = rr * 64 + cc * 2; return st * 1024 + (ob ^ (((ob >> 9) & 1) << 5)); }
__host__ __device__ __forceinline__ void stage_rc(int b, int& R, int& C) { const int st = b / 1024, sb = b % 1024, swz = sb ^ (((sb >> 9) & 1) << 5); R = (st >> 1) * 16 + swz / 64; C = (st & 1) * 32 + (swz % 64) / 2; }
__host__ __device__ __forceinline__ int perm32(int rho) { const int n = rho >> 4, i = rho & 15; return 8 * (i >> 2) + 4 * n + (i & 3); }

struct Unit { int pm, pn; };
struct Gemm { const bf16_t* A; const bf16_t* Bt; int M, N, K; };

struct StaticOrder {
    int nM, nN, nwg, G, c;
    __host__ __device__ void init(int M, int N, int G_, int c_) { nM = M / BM; nN = N / BM; nwg = nM * nN; G = G_; c = c_; }
    __host__ __device__ bool next(int i, Unit& u) const {
        const long L = (long)i * G + c; if (L >= nwg) return false;
        int wgid = (int)L; { const int q = nwg / NXCD, r = nwg % NXCD, xcd = wgid % NXCD, off = wgid / NXCD; wgid = (xcd < r ? xcd * (q + 1) : r * (q + 1) + (xcd - r) * q) + off; }
        const int nig = WGM * nN, gid = wgid / nig, fm = gid * WGM, gsz = (nM - fm) < WGM ? (nM - fm) : WGM;
        u.pm = fm + ((wgid % nig) % gsz); u.pn = (wgid % nig) / gsz; return true;
    }
    __device__ __forceinline__ void a_ready(const Unit&) const {}
    __device__ __forceinline__ void done(const Unit&) const {}
};

__device__ __forceinline__ unsigned pk_f16(float lo, float hi) { typedef _Float16 h2 __attribute__((ext_vector_type(2))); h2 v; v.x = (_Float16)lo; v.y = (_Float16)hi; return __builtin_bit_cast(unsigned, v); }
typedef unsigned u32x2 __attribute__((ext_vector_type(2)));
struct EpiF16 {
    static constexpr bool PERM = true, AFTER_DRAIN = false;
    bf16_t* O; int ldc; const float* rss;
    __device__ __forceinline__ void operator()(const f32x4 (&acc)[2][2][4][2], const Unit& u, int wr, int wc, int fr, int fq) const {
        const int row0 = u.pm * BM + wr * 64 + fr; const int col0 = u.pn * BM + wc * 32 + 8 * fq;
#pragma unroll
        for (int ai = 0; ai < 2; ++ai)
#pragma unroll
            for (int m = 0; m < 4; ++m) { const int row = row0 + ai * HALF + m * 16; bf16_t* rowp = O + (size_t)row * ldc + col0;
                const float sc = rss ? 1.0f / sqrtf(rss[row] * (1.0f / 1024.0f) + 1e-6f) : 1.0f;
#pragma unroll
                for (int bj = 0; bj < 2; ++bj) { const f32x4 v0 = acc[ai][bj][m][0] * sc, v1 = acc[ai][bj][m][1] * sc;
                    u32x4 w; w.x = pk_f16(v0[0], v0[1]); w.y = pk_f16(v0[2], v0[3]); w.z = pk_f16(v1[0], v1[1]); w.w = pk_f16(v1[2], v1[3]);
                    *(u32x4*)(rowp + bj * HALF) = w; } }
    }
};
struct EpiRes {
    static constexpr bool PERM = false, AFTER_DRAIN = false;
    const float* base; float* out; int ldc; bf16_t* xh; float* rss;
    __device__ __forceinline__ void operator()(const f32x4 (&acc)[2][2][4][2], const Unit& u, int wr, int wc, int fr, int fq) const {
        const int row0 = u.pm * BM + wr * 64 + fr; const int col0 = u.pn * BM + wc * 32 + 4 * fq;
#pragma unroll
        for (int ai = 0; ai < 2; ++ai)
#pragma unroll
            for (int m = 0; m < 4; ++m) { const size_t off = (size_t)(row0 + ai * HALF + m * 16) * ldc + col0; float ss = 0.f;
#pragma unroll
                for (int bj = 0; bj < 2; ++bj)
#pragma unroll
                    for (int n = 0; n < 2; ++n) { const size_t o = off + bj * HALF + n * 16; const f32x4 b = *(const f32x4*)(base + o); const f32x4 x = b + acc[ai][bj][m][n]; *(f32x4*)(out + o) = x;
                        if (xh) { u32x2 h; h.x = pk_f16(x[0], x[1]); h.y = pk_f16(x[2], x[3]); *(u32x2*)(xh + o) = h; ss += (x[0] * x[0] + x[1] * x[1]) + (x[2] * x[2] + x[3] * x[3]); } }
                if (xh) { ss += shfl_xor_f(ss, 16); ss += shfl_xor_f(ss, 32); if (fq == 0) atomicAdd(rss + row0 + ai * HALF + m * 16, ss); }
                asm volatile("" ::: "memory"); }
    }
};

template <class Epi, class Sched, bool ALIGN_EPI = false, bool SP2 = false>
__device__ __forceinline__ void gemm_phase(PG8_LAS unsigned char* lds, const Gemm g, const Sched& S, const Epi& E, const int wave_) {
    int wv_ = wave_; asm volatile("" : "+s"(wv_)); int tid_ = lane_now() + 64 * wv_; const int tid = tid_, wid = wv_, lane = tid & 63, wr = wid >> 2, wc = wid & 3, fr = lane & 15, fq = lane >> 4;
    const int K = g.K, nt = K / BK;
    unsigned voffA[2], voffB[2];
#pragma unroll
    for (int i = 0; i < 2; ++i) { int R, C; stage_rc(tid * 16 + i * 8192, R, C); const int Rb = Epi::PERM ? ((R & ~31) + perm32(R & 31)) : R;
        voffA[i] = (unsigned)(R * K + C) * 2u; voffB[i] = (unsigned)(Rb * K + C) * 2u; }
    const size_t kstep = (size_t)(BK * 2);
    const size_t hstep = (size_t)HALF * K * 2;
    const size_t tstep = 2 * hstep;
    const unsigned ldsw = (unsigned)wid * 1024u;
    const int aoff = lds_byte(wr * 64 + fr, fq * 8), boff = lds_byte(wc * 32 + fr, fq * 8);
#define PG8_SA(b, h) (((b) * 2 + (h)) * HTB)
#define PG8_SB(b, h) ((4 + (b) * 2 + (h)) * HTB)
#define PG8_STAGE(bufoff, gbase, voff) do { _Pragma("unroll") for (int _i = 0; _i < 2; ++_i) \
        __builtin_amdgcn_global_load_lds((const unsigned*)((const char*)(gbase) + (voff)[_i]), (PG8_LAS unsigned*)(lds + (bufoff) + ldsw + _i * 8192), 16, 0, 0); } while (0)
#define PG8_LDA(dst, b, h) do { _Pragma("unroll") for (int m = 0; m < 4; ++m) _Pragma("unroll") for (int k = 0; k < 2; ++k) dst[m][k] = *(const PG8_LAS bf16x8*)(lds + PG8_SA(b, h) + aoff + m * 2048 + k * 1024); } while (0)
#define PG8_LDB(dst, b, h) do { _Pragma("unroll") for (int n = 0; n < 2; ++n) _Pragma("unroll") for (int k = 0; k < 2; ++k) dst[n][k] = *(const PG8_LAS bf16x8*)(lds + PG8_SB(b, h) + boff + n * 2048 + k * 1024); } while (0)
#define PG8_MMA(ai, bj, At, Bt) do { __builtin_amdgcn_s_setprio(1); _Pragma("unroll") for (int m = 0; m < 4; ++m) _Pragma("unroll") for (int n = 0; n < 2; ++n) _Pragma("unroll") for (int k = 0; k < 2; ++k) \
        acc[ai][bj][m][n] = MK_MFMA(Bt[n][k], At[m][k], acc[ai][bj][m][n]); __builtin_amdgcn_s_setprio(0); } while (0)
#define PG8_WAIT_V(n) asm volatile("s_waitcnt vmcnt(" #n ")" ::: "memory")
#define PG8_WAIT_L(n) asm volatile("s_waitcnt lgkmcnt(" #n ")" ::: "memory")
#define PG8_BAR __builtin_amdgcn_s_barrier()
#define PG8_SCHED __builtin_amdgcn_sched_barrier(0)
    Unit cur, nxt; int ui = 0;
    if (!S.next(0, cur)) return;
    f32x4 acc[2][2][4][2];
#pragma unroll
    for (int a = 0; a < 2; ++a)
#pragma unroll
        for (int b = 0; b < 2; ++b)
#pragma unroll
            for (int m = 0; m < 4; ++m)
#pragma unroll
                for (int n = 0; n < 2; ++n) acc[a][b][m][n] = (f32x4){0.f, 0.f, 0.f, 0.f};
    bf16x8 At[4][2], B0[2][2], B1[2][2];
    const char* cA = (const char*)g.A + (size_t)cur.pm * tstep; const char* cB = (const char*)g.Bt + (size_t)cur.pn * tstep;
    S.a_ready(cur);
    if constexpr (SP2) {
        PG8_STAGE(PG8_SB(0, 0), cB, voffB); PG8_STAGE(PG8_SB(0, 1), cB + hstep, voffB); PG8_STAGE(PG8_SA(0, 0), cA, voffA); PG8_STAGE(PG8_SA(0, 1), cA + hstep, voffA);
        if (wr == 1) PG8_BAR;
        PG8_WAIT_V(2); PG8_BAR;
        PG8_STAGE(PG8_SB(1, 0), cB + kstep, voffB); PG8_STAGE(PG8_SA(1, 0), cA + kstep, voffA); PG8_STAGE(PG8_SB(1, 1), cB + hstep + kstep, voffB);
        PG8_WAIT_V(6); PG8_BAR;
    } else {
        PG8_STAGE(PG8_SB(0, 0), cB, voffB); PG8_STAGE(PG8_SA(0, 0), cA, voffA); PG8_STAGE(PG8_SB(0, 1), cB + hstep, voffB); PG8_STAGE(PG8_SA(0, 1), cA + hstep, voffA);
        if (wr == 1) PG8_BAR;
        PG8_WAIT_V(4); PG8_BAR;
        PG8_STAGE(PG8_SB(1, 0), cB + kstep, voffB); PG8_STAGE(PG8_SA(1, 0), cA + kstep, voffA); PG8_STAGE(PG8_SB(1, 1), cB + hstep + kstep, voffB);
        PG8_WAIT_V(6); PG8_BAR;
    }
    for (;;) {
        const bool has_next = S.next(ui + 1, nxt);
        const char* nA = has_next ? (const char*)g.A + (size_t)nxt.pm * tstep : cA; const char* nB = has_next ? (const char*)g.Bt + (size_t)nxt.pn * tstep : cB;
        for (int t = 0; t < nt; t += 2) {
            const bool last = (t == nt - 2);
            const char* a1 = cA + (size_t)(t + 1) * kstep;
            const char* a2 = last ? nA : cA + (size_t)(t + 2) * kstep; const char* b2 = last ? nB : cB + (size_t)(t + 2) * kstep;
            const char* a3 = a2 + kstep; const char* b3 = b2 + kstep;
            if (last && has_next) S.a_ready(nxt);
            if constexpr (SP2) {
            PG8_LDB(B0, 0, 0); PG8_LDB(B1, 0, 1); PG8_SCHED; PG8_LDA(At, 0, 0); PG8_STAGE(PG8_SA(1, 1), a1 + hstep, voffA);
            PG8_WAIT_V(8); PG8_WAIT_L(0); PG8_BAR; PG8_MMA(0, 0, At, B0); PG8_MMA(0, 1, At, B1); PG8_BAR; PG8_SCHED;
            PG8_LDA(At, 0, 1); PG8_STAGE(PG8_SB(0, 0), b2, voffB); PG8_STAGE(PG8_SB(0, 1), b2 + hstep, voffB); PG8_STAGE(PG8_SA(0, 0), a2, voffA);
            PG8_WAIT_V(8); PG8_WAIT_L(0); PG8_BAR; PG8_MMA(1, 0, At, B0); PG8_MMA(1, 1, At, B1); PG8_BAR; PG8_SCHED;
            PG8_LDB(B0, 1, 0); PG8_LDB(B1, 1, 1); PG8_SCHED; PG8_LDA(At, 1, 0); PG8_STAGE(PG8_SA(0, 1), a2 + hstep, voffA);
            PG8_WAIT_V(8); PG8_WAIT_L(0); PG8_BAR; PG8_MMA(0, 0, At, B0); PG8_MMA(0, 1, At, B1); PG8_BAR; PG8_SCHED;
            PG8_LDA(At, 1, 1); PG8_STAGE(PG8_SB(1, 0), b3, voffB); PG8_STAGE(PG8_SB(1, 1), b3 + hstep, voffB); PG8_STAGE(PG8_SA(1, 0), a3, voffA);
            PG8_WAIT_V(8); PG8_WAIT_L(0); PG8_BAR; PG8_MMA(1, 0, At, B0); PG8_MMA(1, 1, At, B1); PG8_BAR; PG8_SCHED;
            } else {
            PG8_LDB(B0, 0, 0); PG8_SCHED; PG8_LDA(At, 0, 0); PG8_STAGE(PG8_SA(1, 1), a1 + hstep, voffA);
            PG8_WAIT_L(8); PG8_BAR; PG8_WAIT_L(0); PG8_MMA(0, 0, At, B0); PG8_BAR; PG8_SCHED;
            PG8_LDB(B1, 0, 1); PG8_STAGE(PG8_SB(0, 0), b2, voffB);
            PG8_BAR; PG8_WAIT_L(0); PG8_MMA(0, 1, At, B1); PG8_BAR;
            PG8_LDA(At, 0, 1); PG8_STAGE(PG8_SA(0, 0), a2, voffA);
            PG8_BAR; PG8_WAIT_L(0); PG8_MMA(1, 0, At, B0); PG8_BAR; PG8_SCHED;
            PG8_STAGE(PG8_SB(0, 1), b2 + hstep, voffB);
            PG8_WAIT_V(6); PG8_BAR; PG8_MMA(1, 1, At, B1); PG8_BAR;
            PG8_LDB(B0, 1, 0); PG8_SCHED; PG8_LDA(At, 1, 0); PG8_STAGE(PG8_SA(0, 1), a2 + hstep, voffA);
            PG8_WAIT_L(8); PG8_BAR; PG8_WAIT_L(0); PG8_MMA(0, 0, At, B0); PG8_BAR; PG8_SCHED;
            PG8_LDB(B1, 1, 1); PG8_STAGE(PG8_SB(1, 0), b3, voffB);
            PG8_BAR; PG8_WAIT_L(0); PG8_MMA(0, 1, At, B1); PG8_BAR;
            PG8_LDA(At, 1, 1); PG8_STAGE(PG8_SA(1, 0), a3, voffA);
            PG8_BAR; PG8_WAIT_L(0); PG8_MMA(1, 0, At, B0); PG8_BAR; PG8_SCHED;
            PG8_STAGE(PG8_SB(1, 1), b3 + hstep, voffB);
            PG8_WAIT_V(6); PG8_BAR; PG8_MMA(1, 1, At, B1); PG8_BAR;
            }
        }
        if constexpr (ALIGN_EPI) { if (wr == 0) PG8_BAR; }
        if constexpr (!Epi::AFTER_DRAIN) { E(acc, cur, wr, wc, fr, fq); S.done(cur); }
        if (!has_next) break;
#pragma unroll
        for (int a = 0; a < 2; ++a)
#pragma unroll
            for (int b = 0; b < 2; ++b)
#pragma unroll
                for (int m = 0; m < 4; ++m)
#pragma unroll
                    for (int n = 0; n < 2; ++n) acc[a][b][m][n] = (f32x4){0.f, 0.f, 0.f, 0.f};
        cur = nxt; cA = nA; cB = nB; ++ui;
        if constexpr (ALIGN_EPI) { if (wr == 1) PG8_BAR; }
    }
    PG8_WAIT_V(0);
    if constexpr (!ALIGN_EPI) { if (wr == 0) PG8_BAR; }
    PG8_BAR;
    if constexpr (Epi::AFTER_DRAIN) { E.fused(acc, cur, wr, wc, fr, fq, lds, wid, lane); S.done(cur); }
#undef PG8_SA
#undef PG8_SB
#undef PG8_STAGE
#undef PG8_LDA
#undef PG8_LDB
#undef PG8_MMA
#undef PG8_WAIT_V
#undef PG8_WAIT_L
#undef PG8_BAR
#undef PG8_SCHED
}
}

constexpr int BATCH = 2, SEQ = 8192, DM = 1024, DEPTH = 2, M = BATCH * SEQ;
constexpr int RW_H = 6, HD = 64, RW_W = 384, RW_SHIFT = 1280;
constexpr int NIN = 3712, NU = 3840;
constexpr int C_R = 0, C_K = 384, C_V = 768, C_WL = 1152, C_AL = 1216, C_RWZ = 1280, C_HGQ = 1664, C_HGF = 2048, C_HGI = 2432, C_HGZ = 2816, C_LRUX = 3200, C_LRUZ = 3456;
constexpr int CH = 64;
constexpr int NWAVES = 8, NT = NWAVES * 64;
constexpr int LDS_BYTES = 163840;
constexpr int PRM_OFF = 138240;
constexpr size_t MiB = 1u << 20;
constexpr size_t WS_WUPT = 65536, WS_AUPT = WS_WUPT + 98304, WS_VDNT = WS_AUPT + 98304, WS_VUPT = WS_VDNT + 24576, WS_WAT = WS_VUPT + 24576, WS_WXT = WS_WAT + 65536;
constexpr size_t WS_WIN = 1 * MiB, WIN_L = (size_t)NU * DM * 2;
constexpr size_t WS_WOUT = 16 * MiB, WOUT_L = (size_t)DM * DM * 2;
constexpr size_t WS_XN = 20 * MiB;
constexpr size_t WS_QT = 20 * MiB;
constexpr size_t WS_PT = 32 * MiB;
constexpr size_t WS_CA = 44 * MiB;
constexpr size_t WS_U = 52 * MiB;
constexpr size_t WS_MIX = 172 * MiB;
constexpr size_t WS_VF = 204 * MiB;
constexpr size_t WS_VP = 216 * MiB;
constexpr size_t WS_RL = 228 * MiB;
constexpr size_t WS_HL = 240 * MiB;
constexpr size_t WS_BON = 252 * MiB;
constexpr size_t WS_DC = WS_BON + 512 * 1024;
constexpr size_t WS_LA = WS_DC + 512 * 1024;
constexpr size_t WS_LH = WS_LA + 256 * 1024;
constexpr size_t WS_RSS = WS_LH + 256 * 1024;
constexpr size_t WS_END = 254 * MiB;
constexpr int NCH = SEQ / CH;

#define LAS __attribute__((address_space(3)))
typedef float f32x4 __attribute__((ext_vector_type(4)));
typedef unsigned u32x2 __attribute__((ext_vector_type(2)));
typedef unsigned u32x4 __attribute__((ext_vector_type(4)));
typedef _Float16 f16;
typedef _Float16 f16x8 __attribute__((ext_vector_type(8)));
#define LDS_WAIT() asm volatile("s_waitcnt lgkmcnt(0)" ::: "memory")

struct Args { const float* in[27]; float* out; unsigned char* ws; };

__device__ __forceinline__ float wave_sum(float v) {
#pragma unroll
    for (int o = 1; o < 64; o <<= 1) v += shfl_xor_f(v, o);
    return v;
}
__device__ __forceinline__ float sigmoidf_(float x) { return 1.0f / (1.0f + __expf(-x)); }
__device__ __forceinline__ float siluf_(float x) { return x / (1.0f + __expf(-x)); }

__device__ __forceinline__ void p0_transpose_item(const float* W, int K, int N, unsigned short* WT, LAS float* scr, int item, int lane, const float* rsc) {
    const int nblk = N / 32, kb = item / nblk, nb = item % nblk, k0 = 64 * kb, n0 = 32 * nb;
#pragma unroll 8
    for (int i = 0; i < 32; ++i) { const int kk = 2 * i + (lane >> 5); scr[kk * 33 + (lane & 31)] = W[(size_t)(k0 + kk) * N + n0 + (lane & 31)] * (rsc ? rsc[k0 + kk] : 1.0f); }
    LDS_WAIT(); asm volatile("" ::: "memory");
    const int c = lane & 7;
#pragma unroll
    for (int j = 0; j < 4; ++j) { const int n = (lane >> 3) + 8 * j; const LAS float* s = scr + (8 * c) * 33 + n;
        u32x4 o; o.x = pg8::pk_f16(s[0 * 33], s[1 * 33]); o.y = pg8::pk_f16(s[2 * 33], s[3 * 33]); o.z = pg8::pk_f16(s[4 * 33], s[5 * 33]); o.w = pg8::pk_f16(s[6 * 33], s[7 * 33]);
        *(u32x4*)(WT + (size_t)(n0 + n) * K + k0 + 8 * c) = o; }
    LDS_WAIT(); asm volatile("" ::: "memory");
}
__device__ __forceinline__ void rms_row_f16(const float* xrow, const float* w, unsigned short* orow, int lane) {
    const f32x4* xr = (const f32x4*)xrow + lane; const f32x4* wr = (const f32x4*)w + lane;
    f32x4 v[4]; float s = 0.f;
#pragma unroll
    for (int j = 0; j < 4; ++j) { v[j] = xr[64 * j]; s += (v[j].x * v[j].x + v[j].y * v[j].y) + (v[j].z * v[j].z + v[j].w * v[j].w); }
    const float rs = 1.0f / sqrtf(wave_sum(s) * (1.0f / DM) + 1e-6f);
    u32x2* o8 = (u32x2*)orow + lane;
#pragma unroll
    for (int j = 0; j < 4; ++j) { const f32x4 ww = wr[64 * j]; u32x2 o; o.x = pg8::pk_f16(v[j].x * rs * ww.x, v[j].y * rs * ww.y); o.y = pg8::pk_f16(v[j].z * rs * ww.z, v[j].w * rs * ww.w); o8[64 * j] = o; }
}
__device__ __forceinline__ void rms_row_f32(float* xrow, const float* w, int lane) {
    f32x4* xr = (f32x4*)xrow + lane; const f32x4* wr = (const f32x4*)w + lane;
    f32x4 v[4]; float s = 0.f;
#pragma unroll
    for (int j = 0; j < 4; ++j) { v[j] = xr[64 * j]; s += (v[j].x * v[j].x + v[j].y * v[j].y) + (v[j].z * v[j].z + v[j].w * v[j].w); }
    const float rs = 1.0f / sqrtf(wave_sum(s) * (1.0f / DM) + 1e-6f);
#pragma unroll
    for (int j = 0; j < 4; ++j) { const f32x4 ww = wr[64 * j]; xr[64 * j] = v[j] * rs * ww; }
}


#define SHV(col) ({ const float cur_ = (float)urow[(col)]; const float prev_ = hp ? (float)prow[(col)] : 0.f; cur_ + mu[(col)] * (prev_ - cur_); })

__device__ __forceinline__ void store_row64_f16(f16* dst, const float (&S)[64]) {
#pragma unroll
    for (int q = 0; q < 8; ++q) { u32x4 w; w.x = pg8::pk_f16(S[8 * q], S[8 * q + 1]); w.y = pg8::pk_f16(S[8 * q + 2], S[8 * q + 3]); w.z = pg8::pk_f16(S[8 * q + 4], S[8 * q + 5]); w.w = pg8::pk_f16(S[8 * q + 6], S[8 * q + 7]); *(u32x4*)(dst + 8 * q) = w; }
}


constexpr int RWA_REC = 656  , RWA_VROW = 136, RWA_VPL = 16 * RWA_REC, RWA_INV = RWA_VPL + 16 * RWA_VROW, RWA_BYTES = 12800;
constexpr int C_VD0 = 3712, C_VD1 = 3744;
constexpr int PRM_MU = 0, PRM_W0 = 1280, PRM_A0 = 1664, PRM_KK = 2048, PRM_KA = 2432, PRM_RK = 2816, PRM_V0 = 3200, PRM_FLOATS = 3584;
typedef float f32x2 __attribute__((ext_vector_type(2)));
typedef _Float16 f16x4 __attribute__((ext_vector_type(4)));
__device__ __forceinline__ float fmix_lo(float a, unsigned b, float c) { float d; asm("v_fma_mix_f32 %0, %1, %2, %3 op_sel:[0,0,0] op_sel_hi:[0,1,0]" : "=v"(d) : "v"(a), "v"(b), "v"(c)); return d; }
__device__ __forceinline__ float fmix_hi(float a, unsigned b, float c) { float d; asm("v_fma_mix_f32 %0, %1, %2, %3 op_sel:[0,1,0] op_sel_hi:[0,1,0]" : "=v"(d) : "v"(a), "v"(b), "v"(c)); return d; }
__device__ __forceinline__ float mmix_lo(float a, unsigned b) { float d; asm("v_fma_mix_f32 %0, %1, %2, 0 op_sel:[0,0,0] op_sel_hi:[0,1,0]" : "=v"(d) : "v"(a), "v"(b)); return d; }
__device__ __forceinline__ float mmix_hi(float a, unsigned b) { float d; asm("v_fma_mix_f32 %0, %1, %2, 0 op_sel:[0,1,0] op_sel_hi:[0,1,0]" : "=v"(d) : "v"(a), "v"(b)); return d; }
__device__ __forceinline__ float fma_asm(float a, float b, float c) { float d; asm("v_fma_f32 %0, %1, %2, %3" : "=v"(d) : "v"(a), "v"(b), "v"(c)); return d; }
#define FMIX(a, u, j, c) (((j) & 1) ? fmix_hi((a), (u)[(j) >> 1], (c)) : fmix_lo((a), (u)[(j) >> 1], (c)))
#define MMIX(a, u, j) (((j) & 1) ? mmix_hi((a), (u)[(j) >> 1]) : mmix_lo((a), (u)[(j) >> 1]))
__device__ __forceinline__ float fast_tanh(float x) { return 1.0f - 2.0f / (__expf(2.0f * x) + 1.0f); }
__device__ __forceinline__ void lerp8(const char* ub, unsigned uo, unsigned po, bool hp, const char* mub, unsigned col, float (&x)[8]) {
    const f16x8 cu = *(const f16x8*)(ub + (uo + col * 2u)); f16x8 pv = *(const f16x8*)(ub + (po + col * 2u)); const f32x4 m0 = *(const f32x4*)(mub + col * 4u), m1 = *(const f32x4*)(mub + col * 4u + 16u);
#pragma unroll
    for (int j = 0; j < 8; ++j) { const float c = (float)cu[j], p = hp ? (float)pv[j] : 0.f; x[j] = c + (j < 4 ? m0[j] : m1[j - 4]) * (p - c); }
}
__device__ __forceinline__ void lerp4(const char* ub, unsigned uo, unsigned po, bool hp, const char* mub, unsigned col, float (&x)[4]) {
    const f16x4 cu = *(const f16x4*)(ub + (uo + col * 2u)); f16x4 pv = *(const f16x4*)(ub + (po + col * 2u)); const f32x4 m0 = *(const f32x4*)(mub + col * 4u);
#pragma unroll
    for (int j = 0; j < 4; ++j) { const float c = (float)cu[j], p = hp ? (float)pv[j] : 0.f; x[j] = c + m0[j] * (p - c); }
}
__device__ __forceinline__ f16x8 pack8(const float (&x)[8]) { f16x8 r;
#pragma unroll
    for (int j = 0; j < 8; ++j) r[j] = (f16)x[j];
    return r; }

__device__ __forceinline__ void rwkv_waveA(const Args& a, int l, int b, int c, int h, LAS unsigned char* wl, const LAS float* prm, int lane) {
    const char* Ub = (const char*)(a.ws + WS_U); f16* MIX = (f16*)(a.ws + WS_MIX); char* VF = (char*)(a.ws + WS_VF); char* VP = (char*)(a.ws + WS_VP);
    f16* QT = (f16*)(a.ws + WS_QT); f16* PT = (f16*)(a.ws + WS_PT); f16* RL = (f16*)(a.ws + WS_RL); float* BONG = (float*)(a.ws + WS_BON);
    const char* WUPT = (const char*)(a.ws + WS_WUPT) + (size_t)l * 384 * 64 * 2; const char* AUPT = (const char*)(a.ws + WS_AUPT) + (size_t)l * 384 * 64 * 2;
    const char* VUPT = (const char*)(a.ws + WS_VUPT);
    const int bh = b * RW_H + h;
    float P[64], L[64];
#pragma unroll
    for (int k = 0; k < 64; ++k) { P[k] = (k == lane) ? 1.f : 0.f; L[k] = 0.f; }
#pragma unroll 1
    for (int blk = 0; blk < 4; ++blk) {
        const int lane_ = lane_now();
        const int tok = lane_ & 15, fq = lane_ >> 4;
        const int t = c * CH + blk * 16 + tok; const unsigned m = (unsigned)(b * SEQ + t); const bool hp = t > 0;
        const unsigned uo = m * (unsigned)(NU * 2), po = hp ? uo - (unsigned)(NU * 2) : uo;
        f16x8 cW[2], pW[2], cA[2], pA[2], vd0, vd1;
#pragma unroll
        for (int s = 0; s < 2; ++s) { const unsigned cw = (unsigned)(C_WL + 8 * fq + 32 * s) * 2u, ca = (unsigned)(C_AL + 8 * fq + 32 * s) * 2u;
            cW[s] = *(const f16x8*)(Ub + uo + cw); pW[s] = *(const f16x8*)(Ub + po + cw); cA[s] = *(const f16x8*)(Ub + uo + ca); pA[s] = *(const f16x8*)(Ub + po + ca); }
        if (l > 0) { vd0 = *(const f16x8*)(Ub + uo + (unsigned)(C_VD0 + 8 * fq) * 2u); vd1 = *(const f16x8*)(Ub + po + (unsigned)(C_VD1 + 8 * fq) * 2u); }
#define RW_TLOAD(X, nt) f16x8 X##wu0, X##wu1, X##au0, X##au1, X##vu; f16x4 X##cr, X##pr, X##ck, X##pk, X##cv, X##pv, X##vf; { \
            const unsigned n_ = (unsigned)(h * 64 + 16 * (nt) + tok), cb_ = (unsigned)(h * 64 + 16 * (nt) + 4 * fq); \
            X##wu0 = *(const f16x8*)(WUPT + (n_ * 64u + 8u * fq) * 2u); X##wu1 = *(const f16x8*)(WUPT + (n_ * 64u + 8u * fq + 32u) * 2u); \
            X##au0 = *(const f16x8*)(AUPT + (n_ * 64u + 8u * fq) * 2u); X##au1 = *(const f16x8*)(AUPT + (n_ * 64u + 8u * fq + 32u) * 2u); \
            if (l > 0) { X##vu = *(const f16x8*)(VUPT + (n_ * 32u + 8u * fq) * 2u); X##vf = *(const f16x4*)(VF + (m * (unsigned)RW_W + cb_) * 2u); } \
            X##cr = *(const f16x4*)(Ub + uo + ((unsigned)C_R + cb_) * 2u); X##pr = *(const f16x4*)(Ub + po + ((unsigned)C_R + cb_) * 2u); \
            X##ck = *(const f16x4*)(Ub + uo + ((unsigned)C_K + cb_) * 2u); X##pk = *(const f16x4*)(Ub + po + ((unsigned)C_K + cb_) * 2u); \
            X##cv = *(const f16x4*)(Ub + uo + ((unsigned)C_V + cb_) * 2u); X##pv = *(const f16x4*)(Ub + po + ((unsigned)C_V + cb_) * 2u); }
        f16x8 bW[2], bA[2], bVD;
#pragma unroll
        for (int s = 0; s < 2; ++s) { float xw[8], xa[8];
            const f32x4 mw0 = *(const LAS f32x4*)(prm + PRM_MU + C_WL + 8 * fq + 32 * s), mw1 = *(const LAS f32x4*)(prm + PRM_MU + C_WL + 8 * fq + 32 * s + 4);
            const f32x4 ma0 = *(const LAS f32x4*)(prm + PRM_MU + C_AL + 8 * fq + 32 * s), ma1 = *(const LAS f32x4*)(prm + PRM_MU + C_AL + 8 * fq + 32 * s + 4);
#pragma unroll
            for (int j = 0; j < 8; ++j) { const float cw_ = (float)cW[s][j], pw_ = hp ? (float)pW[s][j] : 0.f, ca_ = (float)cA[s][j], pa_ = hp ? (float)pA[s][j] : 0.f;
                xw[j] = fast_tanh(cw_ + (j < 4 ? mw0[j & 3] : mw1[j & 3]) * (pw_ - cw_)); xa[j] = ca_ + (j < 4 ? ma0[j & 3] : ma1[j & 3]) * (pa_ - ca_); }
            bW[s] = pack8(xw); bA[s] = pack8(xa); }
        if (l > 0) { float xv[8];
#pragma unroll
            for (int j = 0; j < 8; ++j) xv[j] = (float)vd0[j] + (hp ? (float)vd1[j] : 0.f);
            bVD = pack8(xv); }
        float ssq = 0.f, bon = 0.f;
        LAS unsigned char* rec = wl + tok * RWA_REC;
#define RW_TCOMP(X, nt) { const int cb = h * 64 + 16 * (nt) + 4 * fq, co = 16 * (nt) + 4 * fq; \
            f32x4 DWn = (f32x4){0.f, 0.f, 0.f, 0.f}, DAn = DWn, Gn = DWn; \
            DWn = __builtin_amdgcn_mfma_f32_16x16x32_f16(X##wu0, bW[0], DWn, 0, 0, 0); DWn = __builtin_amdgcn_mfma_f32_16x16x32_f16(X##wu1, bW[1], DWn, 0, 0, 0); \
            DAn = __builtin_amdgcn_mfma_f32_16x16x32_f16(X##au0, bA[0], DAn, 0, 0, 0); DAn = __builtin_amdgcn_mfma_f32_16x16x32_f16(X##au1, bA[1], DAn, 0, 0, 0); \
            if (l > 0) Gn = __builtin_amdgcn_mfma_f32_16x16x32_f16(X##vu, bVD, Gn, 0, 0, 0); \
            f16x4 wv, al, be, km, rr, vo; \
            _Pragma("unroll") for (int i = 0; i < 4; ++i) { const LAS float* pc = prm + cb + i; \
                const float cr_ = (float)X##cr[i], ck_ = (float)X##ck[i], cv_ = (float)X##cv[i]; \
                const float rs = cr_ + pc[PRM_MU + C_R] * ((hp ? (float)X##pr[i] : 0.f) - cr_), ks = ck_ + pc[PRM_MU + C_K] * ((hp ? (float)X##pk[i] : 0.f) - ck_), vs = cv_ + pc[PRM_MU + C_V] * ((hp ? (float)X##pv[i] : 0.f) - cv_); \
                wv[i] = (f16)__expf(-0.6065306597126334f * sigmoidf_(pc[PRM_W0] + DWn[i])); \
                const float aa = sigmoidf_(pc[PRM_A0] + DAn[i]); \
                float vv = vs; if (l > 0) vv = vs + ((float)X##vf[i] - vs) * sigmoidf_(pc[PRM_V0] + Gn[i]); \
                const float kk = ks * pc[PRM_KK]; ssq += kk * kk; \
                const float kmod = ks * (1.0f + (aa - 1.0f) * pc[PRM_KA]); \
                bon += rs * kmod * pc[PRM_RK]; \
                al[i] = (f16)(-kk); be[i] = (f16)(kk * aa); km[i] = (f16)kmod; rr[i] = (f16)rs; vo[i] = (f16)vv; \
                asm volatile("" ::: "memory"); } \
            *(LAS f16x4*)(rec + co * 2) = wv; \
            *(LAS f16x4*)(rec + 128 + co * 2) = al; *(LAS f16x4*)(rec + 256 + co * 2) = be; *(LAS f16x4*)(rec + 384 + co * 2) = km; *(LAS f16x4*)(rec + 512 + co * 2) = rr; \
            *(LAS f16x4*)(wl + RWA_VPL + tok * RWA_VROW + co * 2) = vo; \
            *(f16x4*)(VP + (m * (unsigned)RW_W + (unsigned)cb) * 2u) = vo; \
            if (l == 0) *(f16x4*)(VF + (m * (unsigned)RW_W + (unsigned)cb) * 2u) = vo; }
#pragma unroll 1
        for (int nt = 0; nt < 4; ++nt) { RW_TLOAD(T0, nt) RW_TCOMP(T0, nt) asm volatile("" ::: "memory"); }
#undef RW_TLOAD
#undef RW_TCOMP
        ssq += shfl_xor_f(ssq, 16); ssq += shfl_xor_f(ssq, 32);
        bon += shfl_xor_f(bon, 16); bon += shfl_xor_f(bon, 32);
        { const float inv = 1.0f / fmaxf(sqrtf(ssq), 1e-12f);
          if (fq == 0) { *(LAS float*)(wl + RWA_INV + tok * 4) = inv * inv; *(float*)((char*)BONG + (m * 8u + (unsigned)h) * 4u) = bon; } }
        const unsigned mb = (unsigned)(b * SEQ + c * CH + blk * 16);
        asm volatile("s_waitcnt lgkmcnt(0)" ::: "memory");
        u32x4 A[8];
#pragma unroll
        for (int g = 0; g < 8; ++g) A[g] = *(const LAS u32x4*)(wl + 128 + g * 16);
        float vv = (float)*(const LAS f16*)(wl + RWA_VPL + lane_ * 2); float inv2 = *(const LAS float*)(wl + RWA_INV);
#define RW_LDU(W4, B4, K4, R4, g) { W4 = *(const LAS u32x4*)(rc + (g) * 16); B4 = *(const LAS u32x4*)(rc + 256 + (g) * 16); K4 = *(const LAS u32x4*)(rc + 384 + (g) * 16); R4 = *(const LAS u32x4*)(rc + 512 + (g) * 16); }
#define RW_COMP(W4, B4, K4, R4, g) { float tP[8], tL[8]; \
            _Pragma("unroll") for (int j = 0; j < 8; ++j) tP[j] = MMIX(saP, B4, j); \
            _Pragma("unroll") for (int j = 0; j < 8; ++j) tL[j] = MMIX(saL, B4, j); \
            _Pragma("unroll") for (int j = 0; j < 8; ++j) tL[j] = FMIX(vv, K4, j, tL[j]); \
            _Pragma("unroll") for (int j = 0; j < 8; ++j) P[8 * (g) + j] = FMIX(P[8 * (g) + j], W4, j, tP[j]); \
            _Pragma("unroll") for (int j = 0; j < 8; ++j) L[8 * (g) + j] = FMIX(L[8 * (g) + j], W4, j, tL[j]); \
            _Pragma("unroll") for (int j = 0; j < 8; ++j) qa[j] = FMIX(P[8 * (g) + j], R4, j, qa[j]); \
            _Pragma("unroll") for (int j = 0; j < 8; ++j) ya[j] = FMIX(L[8 * (g) + j], R4, j, ya[j]); }
#pragma unroll 1
        for (int t2 = 0; t2 < 16; ++t2) {
            const LAS unsigned char* rc = wl + t2 * RWA_REC;
            u32x4 we, be, ke, re, wo, bo, ko, ro;
            RW_LDU(we, be, ke, re, 0)
            float sP[8], sL[8];
#pragma unroll
            for (int j = 0; j < 8; ++j) { sP[j] = 0.f; sL[j] = 0.f; }
#pragma unroll
            for (int g = 0; g < 8; ++g) {
#pragma unroll
                for (int j = 0; j < 8; ++j) sP[j] = FMIX(P[8 * g + j], A[g], j, sP[j]);
#pragma unroll
                for (int j = 0; j < 8; ++j) sL[j] = FMIX(L[8 * g + j], A[g], j, sL[j]); }
            const float saP = inv2 * (((sP[0] + sP[1]) + (sP[2] + sP[3])) + ((sP[4] + sP[5]) + (sP[6] + sP[7]))), saL = inv2 * (((sL[0] + sL[1]) + (sL[2] + sL[3])) + ((sL[4] + sL[5]) + (sL[6] + sL[7])));
            float qa[8], ya[8];
#pragma unroll
            for (int j = 0; j < 8; ++j) { qa[j] = 0.f; ya[j] = 0.f; }
            RW_LDU(wo, bo, ko, ro, 1) RW_COMP(we, be, ke, re, 0)
            RW_LDU(we, be, ke, re, 2) RW_COMP(wo, bo, ko, ro, 1)
            RW_LDU(wo, bo, ko, ro, 3) RW_COMP(we, be, ke, re, 2)
            RW_LDU(we, be, ke, re, 4) RW_COMP(wo, bo, ko, ro, 3)
            RW_LDU(wo, bo, ko, ro, 5) RW_COMP(we, be, ke, re, 4)
            RW_LDU(we, be, ke, re, 6) RW_COMP(wo, bo, ko, ro, 5)
            RW_LDU(wo, bo, ko, ro, 7) RW_COMP(we, be, ke, re, 6)
            const float vvn = (float)*(const LAS f16*)(wl + RWA_VPL + ((t2 + 1) & 15) * RWA_VROW + lane_ * 2); const float inv2n = *(const LAS float*)(wl + RWA_INV + ((t2 + 1) & 15) * 4);
#pragma unroll
            for (int g = 0; g < 8; ++g) A[g] = *(const LAS u32x4*)(rc + RWA_REC + 128 + g * 16);
            RW_COMP(wo, bo, ko, ro, 7)
            vv = vvn; inv2 = inv2n;
            *(f16*)((char*)MIX + ((mb + t2) * (unsigned)DM + (unsigned)(h * 64 + lane_)) * 2u) = (f16)(((ya[0] + ya[1]) + (ya[2] + ya[3])) + ((ya[4] + ya[5]) + (ya[6] + ya[7])));
            *(f16*)((char*)QT + ((mb + t2) * (unsigned)RW_W + (unsigned)(h * 64 + lane_)) * 2u) = (f16)(((qa[0] + qa[1]) + (qa[2] + qa[3])) + ((qa[4] + qa[5]) + (qa[6] + qa[7])));
        }
#undef RW_LDU
#undef RW_COMP
    }
    store_row64_f16(RL + (((size_t)bh * NCH + c) * 64 + lane) * 64, L);
    f16* pt = PT + ((size_t)bh * NCH + c) * 4096;
#pragma unroll
    for (int k = 0; k < 64; ++k) pt[k * 64 + lane] = (f16)P[k];
}

constexpr int HGA_REC = 384, HGA_V = 16 * HGA_REC, HGA_HEAD = HGA_V + 2048, HGA_BYTES = 2 * HGA_HEAD;
template <int NH>
__device__ __forceinline__ void hgrn_waveA(const Args& a, int l, int b, int c, int h0, LAS unsigned char* wl) {
    char* U = (char*)(a.ws + WS_U); char* MIX = (char*)(a.ws + WS_MIX); f16* HL = (f16*)(a.ws + WS_HL); float* DC = (float*)(a.ws + WS_DC);
    const float* lbr = a.in[16];
    float S[NH][64]; float dpr[NH];
#pragma unroll
    for (int j = 0; j < NH; ++j) { dpr[j] = 1.f;
#pragma unroll
        for (int k = 0; k < 64; ++k) S[j][k] = 0.f; }
#pragma unroll 1
    for (int blk = 0; blk < 4; ++blk) {
        const int lane_ = lane_now();
        const unsigned mb = (unsigned)(b * SEQ + c * CH + blk * 16);
        {
            f16 fr[NH][16], qr[NH][16], vr[NH][16];
#pragma unroll
            for (int j = 0; j < NH; ++j)
#pragma unroll
                for (int tk = 0; tk < 16; ++tk) { const char* ur = U + (mb + tk) * (unsigned)(NU * 2) + (unsigned)((h0 + j) * 64 + lane_) * 2u; fr[j][tk] = *(const f16*)(ur + C_HGF * 2); qr[j][tk] = *(const f16*)(ur + C_HGQ * 2); vr[j][tk] = *(const f16*)(ur + C_HGI * 2); }
#pragma unroll
            for (int j = 0; j < NH; ++j) { const int col = (h0 + j) * 64 + lane_;
                const float lb = (l == 0) ? 0.f : sigmoidf_(lbr[384 + col] - lbr[col]);
                float dp = dpr[j];
#pragma unroll
                for (int tk = 0; tk < 16; ++tk) {
                    const float f = lb + (1.0f - lb) * sigmoidf_((float)fr[j][tk]);
                    LAS unsigned char* rec = wl + j * HGA_HEAD + tk * HGA_REC;
                    *(LAS f16*)(rec + lane_ * 2) = (f16)f; *(LAS f16*)(rec + 128 + lane_ * 2) = (f16)(1.0f - f); *(LAS f16*)(rec + 256 + lane_ * 2) = qr[j][tk];
                    *(LAS f16*)(wl + j * HGA_HEAD + HGA_V + tk * 128 + lane_ * 2) = vr[j][tk];
                    dp *= f;
                    *(f16*)(U + (mb + tk) * (unsigned)(NU * 2) + (unsigned)(C_HGQ + col) * 2u) = (f16)((float)qr[j][tk] * dp);
                }
                dpr[j] = dp; }
        }
        asm volatile("s_waitcnt lgkmcnt(0)" ::: "memory");
#define HG_LD(F4, K4, Q4, rcp, g) { F4 = *(const LAS u32x4*)((rcp) + (g) * 16); K4 = *(const LAS u32x4*)((rcp) + 128 + (g) * 16); Q4 = *(const LAS u32x4*)((rcp) + 256 + (g) * 16); }
#define HG_COMP(Sx, vi, F4, K4, Q4, g) { float tt[8]; \
            _Pragma("unroll") for (int jj = 0; jj < 8; ++jj) tt[jj] = MMIX(vi, K4, jj); \
            _Pragma("unroll") for (int jj = 0; jj < 8; ++jj) Sx[8 * (g) + jj] = FMIX(Sx[8 * (g) + jj], F4, jj, tt[jj]); \
            _Pragma("unroll") for (int jj = 0; jj < 8; ++jj) oa[jj] = FMIX(Sx[8 * (g) + jj], Q4, jj, oa[jj]); }
#define HG_HEAD(Sx, vi, rcp, rcn, oo) { float oa[8]; _Pragma("unroll") for (int jj = 0; jj < 8; ++jj) oa[jj] = 0.f; \
            HG_LD(f4o, k4o, q4o, rcp, 1) HG_COMP(Sx, vi, f4e, k4e, q4e, 0) \
            HG_LD(f4e, k4e, q4e, rcp, 2) HG_COMP(Sx, vi, f4o, k4o, q4o, 1) \
            HG_LD(f4o, k4o, q4o, rcp, 3) HG_COMP(Sx, vi, f4e, k4e, q4e, 2) \
            HG_LD(f4e, k4e, q4e, rcp, 4) HG_COMP(Sx, vi, f4o, k4o, q4o, 3) \
            HG_LD(f4o, k4o, q4o, rcp, 5) HG_COMP(Sx, vi, f4e, k4e, q4e, 4) \
            HG_LD(f4e, k4e, q4e, rcp, 6) HG_COMP(Sx, vi, f4o, k4o, q4o, 5) \
            HG_LD(f4o, k4o, q4o, rcp, 7) HG_COMP(Sx, vi, f4e, k4e, q4e, 6) \
            HG_LD(f4e, k4e, q4e, rcn, 0) HG_COMP(Sx, vi, f4o, k4o, q4o, 7) \
            oo = ((oa[0] + oa[1]) + (oa[2] + oa[3])) + ((oa[4] + oa[5]) + (oa[6] + oa[7])); }
        u32x4 f4e, k4e, q4e, f4o, k4o, q4o;
        HG_LD(f4e, k4e, q4e, wl, 0)
        f16 vh[NH], vn[NH];
#pragma unroll
        for (int j = 0; j < NH; ++j) vh[j] = *(const LAS f16*)(wl + j * HGA_HEAD + HGA_V + lane_ * 2);
#pragma unroll 1
        for (int t2 = 0; t2 < 16; ++t2) {
            const LAS unsigned char* rc = wl + t2 * HGA_REC;
#pragma unroll
            for (int j = 0; j < NH; ++j) vn[j] = *(const LAS f16*)(wl + j * HGA_HEAD + HGA_V + ((t2 + 1) & 15) * 128 + lane_ * 2);
            float oo[NH];
#pragma unroll
            for (int j = 0; j < NH; ++j) { const float vi = (float)vh[j];
                const LAS unsigned char* rcp = rc + j * HGA_HEAD; const LAS unsigned char* rcn = (j + 1 < NH) ? rc + (j + 1) * HGA_HEAD : rc + HGA_REC;
                HG_HEAD(S[j], vi, rcp, rcn, oo[j]) }
            char* mo = MIX + ((mb + t2) * (unsigned)DM + (unsigned)(384 + h0 * 64 + lane_)) * 2u;
#pragma unroll
            for (int j = 0; j < NH; ++j) { *(f16*)(mo + 128 * j) = (f16)oo[j]; vh[j] = vn[j]; }
        }
#undef HG_LD
#undef HG_COMP
#undef HG_HEAD
    }
    const int lane2 = lane_now();
#pragma unroll
    for (int j = 0; j < NH; ++j) { const int bh = b * 6 + h0 + j; store_row64_f16(HL + (((size_t)bh * NCH + c) * 64 + lane2) * 64, S[j]);
        DC[((size_t)bh * NCH + c) * 64 + lane2] = dpr[j]; }
}
__device__ __forceinline__ void phaseA(const Args& a, int l, int task, LAS unsigned char* lds, int tid) {
    asm volatile("" : "+v"(tid));
    const int lane = tid & 63, wave = __builtin_amdgcn_readfirstlane(tid >> 6);
    const int b = task / NCH, c = task % NCH;
    const f16* U = (const f16*)(a.ws + WS_U); f16* MIX = (f16*)(a.ws + WS_MIX); f16* VF = (f16*)(a.ws + WS_VF); f16* VP = (f16*)(a.ws + WS_VP);
    f16* QT = (f16*)(a.ws + WS_QT); f16* PT = (f16*)(a.ws + WS_PT); f16* RL = (f16*)(a.ws + WS_RL); float* BONG = (float*)(a.ws + WS_BON);
    {
        LAS float* prm = (LAS float*)(lds + PRM_OFF);
        for (int i = tid; i < PRM_FLOATS; i += NT) { float v;
            if (i < 1280) v = a.in[3][l * RW_SHIFT + i];
            else { const int q = (i - 1280) / 384, cc = (i - 1280) % 384;
                v = (q == 0) ? a.in[4][l * RW_W + cc] : (q == 1) ? a.in[6][l * RW_W + cc] : (q == 2) ? a.in[11][l * RW_W + cc] : (q == 3) ? a.in[12][l * RW_W + cc] : (q == 4) ? a.in[13][l * RW_W + cc] : a.in[8][cc]; }
            prm[i] = v; }
        __syncthreads();
        if (wave < RW_H) rwkv_waveA(a, l, b, c, wave, lds + wave * RWA_BYTES, prm, lane);
        else { LAS unsigned char* hw = lds + RW_H * RWA_BYTES + (wave - RW_H) * HGA_BYTES;
               hgrn_waveA<2>(a, l, b, c, 2 * (wave - RW_H), hw); hgrn_waveA<1>(a, l, b, c, 4 + (wave - RW_H), hw); }
        __syncthreads();
    }
    {
        const int ln = lane_now(); const int tid2 = wave * 64 + ln;
        const char* Ub = (const char*)(a.ws + WS_U); char* MIXb = (char*)(a.ws + WS_MIX); char* CA = (char*)(a.ws + WS_CA); float* LA = (float*)(a.ws + WS_LA); float* LH = (float*)(a.ws + WS_LH);
        const float* cw = a.in[18] + l * 4 * 256; const float* cb = a.in[19] + l * 256;
        const float* ba = a.in[21] + l * 256; const float* bx = a.in[23] + l * 256; const float* lam = a.in[24] + l * 256;
        const char* WAT = (const char*)(a.ws + WS_WAT) + (size_t)l * 4 * 8192; const char* WXT = (const char*)(a.ws + WS_WXT) + (size_t)l * 4 * 8192;
        LAS unsigned char* Y = lds;
        LAS float* AGG = (LAS float*)(lds + 34816);
        const unsigned mrow0 = (unsigned)(b * SEQ + c * CH);
#pragma unroll
        for (int it = 0; it < 4; ++it) { const int item = tid2 + 512 * it, tok = item >> 5, co = item & 31; const int t = c * CH + tok;
            const f32x4 b0 = *(const f32x4*)(cb + 8 * co), b1 = *(const f32x4*)(cb + 8 * co + 4);
            float y[8] = {b0[0], b0[1], b0[2], b0[3], b1[0], b1[1], b1[2], b1[3]};
#pragma unroll
            for (int jj = 0; jj < 4; ++jj) { const int ts = t - 3 + jj;
                if (ts >= 0) { const f16x8 x8 = *(const f16x8*)(Ub + ((mrow0 + (unsigned)(tok - 3 + jj)) * (unsigned)NU + (unsigned)(C_LRUX + 8 * co)) * 2u);
                    const f32x4 w0 = *(const f32x4*)(cw + jj * 256 + 8 * co), w1 = *(const f32x4*)(cw + jj * 256 + 8 * co + 4);
#pragma unroll
                    for (int i = 0; i < 8; ++i) y[i] += (i < 4 ? w0[i & 3] : w1[i & 3]) * (float)x8[i]; } }
            *(LAS f16x8*)(Y + tok * 528 + co * 16) = pack8(y); }
        __syncthreads();
        const int tl = ln & 15, fq = ln >> 4, tt = wave & 3, gp = wave >> 2;
        float Asc[32], Hsc[32];
#pragma unroll
        for (int gg = 0; gg < 2; ++gg) { const int g = 2 * gp + gg;
            f16x8 by[2];
#pragma unroll
            for (int s2 = 0; s2 < 2; ++s2) by[s2] = *(const LAS f16x8*)(Y + (16 * tt + tl) * 528 + (g * 64 + 8 * fq + 32 * s2) * 2);
#pragma unroll
            for (int nt = 0; nt < 4; ++nt) {
                f32x4 ra = (f32x4){0.f, 0.f, 0.f, 0.f}, rx = ra;
#pragma unroll
                for (int s2 = 0; s2 < 2; ++s2) { const unsigned wo = (unsigned)(g * 8192 + ((16 * nt + tl) * 64 + 8 * fq + 32 * s2) * 2);
                    ra = __builtin_amdgcn_mfma_f32_16x16x32_f16(*(const f16x8*)(WAT + wo), by[s2], ra, 0, 0, 0);
                    rx = __builtin_amdgcn_mfma_f32_16x16x32_f16(*(const f16x8*)(WXT + wo), by[s2], rx, 0, 0, 0); }
                const int ch0 = g * 64 + 16 * nt + 4 * fq;
                const f32x4 ba4 = *(const f32x4*)(ba + ch0), bx4 = *(const f32x4*)(bx + ch0), lm4 = *(const f32x4*)(lam + ch0);
                const f16x4 y4 = *(const LAS f16x4*)(Y + (16 * tt + tl) * 528 + ch0 * 2);
#pragma unroll
                for (int i = 0; i < 4; ++i) {
                    const float r = sigmoidf_(ra[i] + ba4[i]), ig = sigmoidf_(rx[i] + bx4[i]);
                    const float la = -8.0f * r * log1pf(__expf(-lm4[i]));
                    float av = __expf(la), uv = sqrtf(-expm1f(2.0f * la)) * (ig * (float)y4[i]);
#define LRU_SCAN(d) { const float ap = __builtin_bit_cast(float, __builtin_amdgcn_update_dpp(0x3f800000, __builtin_bit_cast(int, av), 0x110 + (d), 0xf, 0xf, false)); \
                      const float up = __builtin_bit_cast(float, __builtin_amdgcn_update_dpp(0, __builtin_bit_cast(int, uv), 0x110 + (d), 0xf, 0xf, false)); \
                      uv = av * up + uv; av = av * ap; }
                    LRU_SCAN(1) LRU_SCAN(2) LRU_SCAN(4) LRU_SCAN(8)
#undef LRU_SCAN
                    Asc[gg * 16 + nt * 4 + i] = av; Hsc[gg * 16 + nt * 4 + i] = uv;
                    if (tl == 15) { AGG[(tt * 256 + ch0 + i) * 2] = av; AGG[(tt * 256 + ch0 + i) * 2 + 1] = uv; }
                }
            }
        }
        __syncthreads();
        const unsigned m = mrow0 + (unsigned)(16 * tt + tl);
#pragma unroll
        for (int gg = 0; gg < 2; ++gg)
#pragma unroll
            for (int nt = 0; nt < 4; ++nt) { const int ch0 = (2 * gp + gg) * 64 + 16 * nt + 4 * fq;
                f16x4 ho, co;
#pragma unroll
                for (int i = 0; i < 4; ++i) { float cy = 0.f, cpv = 1.f;
#pragma unroll
                    for (int t3 = 0; t3 < 3; ++t3) if (t3 < tt) { const float A3 = AGG[(t3 * 256 + ch0 + i) * 2], H3 = AGG[(t3 * 256 + ch0 + i) * 2 + 1]; cy = A3 * cy + H3; cpv *= A3; }
                    const float hl = Hsc[gg * 16 + nt * 4 + i] + Asc[gg * 16 + nt * 4 + i] * cy, ca = Asc[gg * 16 + nt * 4 + i] * cpv;
                    ho[i] = (f16)hl; co[i] = (f16)ca;
                    if (tt == 3 && tl == 15) { LA[((size_t)b * NCH + c) * 256 + ch0 + i] = ca; LH[((size_t)b * NCH + c) * 256 + ch0 + i] = hl; } }
                *(f16x4*)(MIXb + (m * (unsigned)DM + 768u + (unsigned)ch0) * 2u) = ho; *(f16x4*)(CA + (m * 256u + (unsigned)ch0) * 2u) = co; }
    }
}


constexpr int PB_SLOT = 16384, PB_NS = 8, PB_AHEAD = 6, NGRP = NCH / 8;
#define ARENA(ws, off) ((char*)(ws) + WS_U + (size_t)((off) >> 11) * (size_t)(NU * 2) + (size_t)((off) & 2047))
constexpr size_t AR_PGT = 0, AR_LG = 2u << 20, AR_SG = 4u << 20;
#define PB_SWZ(row, o) ((row) * 128 + (((((o) >> 4) ^ ((row) & 7)) << 4) | ((o) & 15)))
template <bool ADD_L>
__device__ __forceinline__ void pb_step(f32x4 (&Sacc)[4], const LAS unsigned char* sl, int xrow, int vl, int fq) {
    f16x8 Bhi[2], Blo[2];
#pragma unroll
    for (int mt = 0; mt < 4; ++mt)
#pragma unroll
        for (int i = 0; i < 4; ++i) { const f16 hi = (f16)Sacc[mt][i]; const f16 lo = (f16)(Sacc[mt][i] - (float)hi); Bhi[mt >> 1][4 * (mt & 1) + i] = hi; Blo[mt >> 1][4 * (mt & 1) + i] = lo; }
#pragma unroll
    for (int mt = 0; mt < 4; ++mt) {
        f32x4 d = (f32x4){0.f, 0.f, 0.f, 0.f};
        if (ADD_L) { const f16x4 l4 = *(const LAS f16x4*)(sl + 8192 + PB_SWZ(xrow, 32 * mt + 8 * fq)); d = (f32x4){(float)l4[0], (float)l4[1], (float)l4[2], (float)l4[3]}; }
#pragma unroll
        for (int s = 0; s < 2; ++s) { const u32x2 a0 = *(const LAS u32x2*)(sl + PB_SWZ(16 * mt + vl, 64 * s + 8 * fq)), a1 = *(const LAS u32x2*)(sl + PB_SWZ(16 * mt + vl, 64 * s + 32 + 8 * fq));
            u32x4 aw; aw.x = a0.x; aw.y = a0.y; aw.z = a1.x; aw.w = a1.y; const f16x8 af = __builtin_bit_cast(f16x8, aw);
            d = __builtin_amdgcn_mfma_f32_16x16x32_f16(af, Bhi[s], d, 0, 0, 0); d = __builtin_amdgcn_mfma_f32_16x16x32_f16(af, Blo[s], d, 0, 0, 0); }
        Sacc[mt] = d; }
}
__device__ __forceinline__ void pb_stage8(const Args& a, LAS unsigned char* lds, int bh, int c0, int wave, int lane) {
    const char* PT = (const char*)(a.ws + WS_PT) + ((size_t)bh * NCH + c0) * 8192; const char* RL = (const char*)(a.ws + WS_RL) + ((size_t)bh * NCH + c0) * 8192;
    const int lq = wave * 64 + lane, lrow = lq >> 3, lpp = lq & 7; const unsigned lsrc = (unsigned)(lrow * 128 + ((lpp ^ (lrow & 7)) << 4));
#pragma unroll
    for (int sl = 0; sl < 8; ++sl) { const unsigned so = (unsigned)(sl * PB_SLOT + wave * 1024); const size_t go = (size_t)sl * 8192 + lsrc;
        __builtin_amdgcn_global_load_lds((const unsigned*)(PT + go), (LAS unsigned*)(lds + so), 16, 0, 0);
        __builtin_amdgcn_global_load_lds((const unsigned*)(RL + go), (LAS unsigned*)(lds + so + 8192), 16, 0, 0); }
    asm volatile("s_waitcnt vmcnt(0)" ::: "memory");
    __builtin_amdgcn_s_barrier();
}
__device__ __forceinline__ void phaseB1(const Args& a, LAS unsigned char* lds, int tid) {
    asm volatile("" : "+v"(tid));
    const int lane = tid & 63, wave = __builtin_amdgcn_readfirstlane(tid >> 6);
    for (int task = blockIdx.x; task < 12 * NGRP; task += gridDim.x) {
        const int bh = task / NGRP, g = task % NGRP, c0 = 8 * g;
        pb_stage8(a, lds, bh, c0, wave, lane);
        const int vt = wave & 3, vl = lane & 15, fq = lane >> 4, xr = 16 * vt + vl;
        f32x4 X[4];
        if (wave < 4) {
#pragma unroll
            for (int mt = 0; mt < 4; ++mt) { const f16x4 l4 = *(const LAS f16x4*)(lds + 8192 + PB_SWZ(xr, 32 * mt + 8 * fq)); X[mt] = (f32x4){(float)l4[0], (float)l4[1], (float)l4[2], (float)l4[3]}; }
#pragma unroll 1
            for (int s = 1; s < 8; ++s) pb_step<true>(X, lds + s * PB_SLOT, xr, vl, fq);
#pragma unroll
            for (int mt = 0; mt < 4; ++mt) { f16x4 o;
#pragma unroll
                for (int i = 0; i < 4; ++i) o[i] = (f16)X[mt][i];
                *(f16x4*)ARENA(a.ws, AR_LG + ((size_t)bh * NGRP + g) * 8192 + (size_t)((xr * 64 + 16 * mt + 4 * fq) * 2)) = o; }
        } else {
#pragma unroll
            for (int mt = 0; mt < 4; ++mt)
#pragma unroll
                for (int i = 0; i < 4; ++i) X[mt][i] = (16 * mt + 4 * fq + i == xr) ? 1.f : 0.f;
#pragma unroll 1
            for (int s = 0; s < 8; ++s) pb_step<false>(X, lds + s * PB_SLOT, xr, vl, fq);
#pragma unroll
            for (int mt = 0; mt < 4; ++mt)
#pragma unroll
                for (int i = 0; i < 4; ++i) *(f16*)ARENA(a.ws, AR_PGT + ((size_t)bh * NGRP + g) * 8192 + (size_t)(((16 * mt + 4 * fq + i) * 64 + xr) * 2)) = (f16)X[mt][i];
        }
        asm volatile("s_waitcnt vmcnt(0) lgkmcnt(0)" ::: "memory");
        __builtin_amdgcn_s_barrier();
    }
}
__device__ __forceinline__ void phaseB3(const Args& a, LAS unsigned char* lds, int tid) {
    asm volatile("" : "+v"(tid));
    const int lane = tid & 63, wave = __builtin_amdgcn_readfirstlane(tid >> 6);
    for (int task = blockIdx.x; task < 12 * NGRP; task += gridDim.x) {
        const int bh = task / NGRP, g = task % NGRP, c0 = 8 * g;
        pb_stage8(a, lds, bh, c0, wave, lane);
        if (wave < 4) {
            const int vt = wave, vl = lane & 15, fq = lane >> 4, xr = 16 * vt + vl;
            char* RL = (char*)(a.ws + WS_RL) + ((size_t)bh * NCH + c0) * 8192;
            f32x4 X[4];
#pragma unroll
            for (int mt = 0; mt < 4; ++mt) { const f16x4 s4 = *(const f16x4*)ARENA(a.ws, AR_SG + ((size_t)bh * NGRP + g) * 8192 + (size_t)((xr * 64 + 16 * mt + 4 * fq) * 2)); X[mt] = (f32x4){(float)s4[0], (float)s4[1], (float)s4[2], (float)s4[3]}; }
#pragma unroll 1
            for (int s = 0; s < 8; ++s) {
#pragma unroll
                for (int mt = 0; mt < 4; ++mt) { f16x4 o;
#pragma unroll
                    for (int i = 0; i < 4; ++i) o[i] = (f16)X[mt][i];
                    *(f16x4*)(RL + (size_t)s * 8192 + (xr * 64 + 16 * mt + 4 * fq) * 2) = o; }
                if (s < 7) pb_step<true>(X, lds + s * PB_SLOT, xr, vl, fq);
            }
        }
        asm volatile("s_waitcnt vmcnt(0) lgkmcnt(0)" ::: "memory");
        __builtin_amdgcn_s_barrier();
    }
}
__device__ __forceinline__ void phaseB(const Args& a, LAS unsigned char* lds, int tid) {
    asm volatile("" : "+v"(tid));
    const int lane = tid & 63, wave = __builtin_amdgcn_readfirstlane(tid >> 6);
    const int bx = blockIdx.x;
    if (bx < 12) {
        const int bh = bx;
        const bool loader = wave >= 4;
        const int vt = wave & 3, vl = lane & 15, fq = lane >> 4, v = 16 * vt + vl;
        const int lq = (wave - 4) * 64 + lane, lrow = lq >> 3, lpp = lq & 7;
        const unsigned lsrc = (unsigned)(lrow * 128 + ((lpp ^ (lrow & 7)) << 4));
#define PB_ISSUE(cc) { const unsigned so = (unsigned)(((cc) & (PB_NS - 1)) * PB_SLOT) + (unsigned)((wave - 4) * 1024); const size_t go = ((size_t)bh * NGRP + (cc)) * 8192 + lsrc; \
            __builtin_amdgcn_global_load_lds((const unsigned*)ARENA(a.ws, AR_PGT + go), (LAS unsigned*)(lds + so), 16, 0, 0); \
            __builtin_amdgcn_global_load_lds((const unsigned*)ARENA(a.ws, AR_PGT + go + 4096), (LAS unsigned*)(lds + so + 4096), 16, 0, 0); \
            __builtin_amdgcn_global_load_lds((const unsigned*)ARENA(a.ws, AR_LG + go), (LAS unsigned*)(lds + so + 8192), 16, 0, 0); \
            __builtin_amdgcn_global_load_lds((const unsigned*)ARENA(a.ws, AR_LG + go + 4096), (LAS unsigned*)(lds + so + 12288), 16, 0, 0); }
        if (loader) {
#pragma unroll
            for (int cc = 0; cc < PB_AHEAD; ++cc) PB_ISSUE(cc)
            asm volatile("s_waitcnt vmcnt(20)" ::: "memory");
        }
        __builtin_amdgcn_s_barrier();
        f32x4 Sacc[4];
#pragma unroll
        for (int mt = 0; mt < 4; ++mt) Sacc[mt] = (f32x4){0.f, 0.f, 0.f, 0.f};
#pragma unroll 1
        for (int c = 0; c < NGRP; ++c) {
            if (loader) {
                if (c + PB_AHEAD < NGRP) { PB_ISSUE(c + PB_AHEAD) asm volatile("s_waitcnt vmcnt(20)" ::: "memory"); }
                else asm volatile("s_waitcnt vmcnt(0)" ::: "memory");
            } else {
#pragma unroll
                for (int mt = 0; mt < 4; ++mt) { f16x4 o;
#pragma unroll
                    for (int i = 0; i < 4; ++i) o[i] = (f16)Sacc[mt][i];
                    *(f16x4*)ARENA(a.ws, AR_SG + ((size_t)bh * NGRP + c) * 8192 + (size_t)((v * 64 + 16 * mt + 4 * fq) * 2)) = o; }
                pb_step<true>(Sacc, lds + (c & (PB_NS - 1)) * PB_SLOT, v, vl, fq);
                asm volatile("s_waitcnt lgkmcnt(0)" ::: "memory");
            }
            __builtin_amdgcn_s_barrier();
        }
#undef PB_ISSUE
        asm volatile("s_waitcnt vmcnt(0)" ::: "memory");
    } else if (bx < 12 + 96) {
        const int idx = (bx - 12) * NT + tid; const int bh = idx >> 12, e = idx & 4095, k = e & 63;
        f16* HL = (f16*)(a.ws + WS_HL); const float* DC = (const float*)(a.ws + WS_DC);
        float s = 0.f;
        for (int c0 = 0; c0 < NCH; c0 += 8) { float Lc[8], d[8];
#pragma unroll
            for (int j = 0; j < 8; ++j) { Lc[j] = (float)HL[((size_t)bh * NCH + c0 + j) * 4096 + e]; d[j] = DC[((size_t)bh * NCH + c0 + j) * 64 + k]; }
#pragma unroll
            for (int j = 0; j < 8; ++j) { HL[((size_t)bh * NCH + c0 + j) * 4096 + e] = (f16)s; s = d[j] * s + Lc[j]; } }
    } else if (bx == 12 + 96) {
        const int bb = tid >> 8, ch = tid & 255; const float* LA = (const float*)(a.ws + WS_LA); float* LH = (float*)(a.ws + WS_LH);
        float cy = 0.f;
        for (int c0 = 0; c0 < NCH; c0 += 8) { float A[8], H[8];
#pragma unroll
            for (int j = 0; j < 8; ++j) { const size_t o = ((size_t)bb * NCH + c0 + j) * 256 + ch; A[j] = LA[o]; H[j] = LH[o]; }
#pragma unroll
            for (int j = 0; j < 8; ++j) { const size_t o = ((size_t)bb * NCH + c0 + j) * 256 + ch; LH[o] = cy; cy = A[j] * cy + H[j]; } }
    }
}

__device__ __forceinline__ void phaseC(const Args& a, int l, int task, LAS unsigned char* lds, int tid) {
    asm volatile("" : "+v"(tid));
    const int lane = tid & 63, wave = __builtin_amdgcn_readfirstlane(tid >> 6);
    const int b = task / NCH, c = task % NCH;
    const int tl = lane & 15, fq = lane >> 4, tt = wave & 3, hg = wave >> 2;
    const unsigned m = (unsigned)(b * SEQ + c * CH + 16 * tt + tl);
    const char* U = (const char*)(a.ws + WS_U); char* MIX = (char*)(a.ws + WS_MIX); const char* VP = (const char*)(a.ws + WS_VP);
    const char* QT = (const char*)(a.ws + WS_QT); const char* RL = (const char*)(a.ws + WS_RL); const char* HL = (const char*)(a.ws + WS_HL); const float* BONG = (const float*)(a.ws + WS_BON);
    const unsigned uo = m * (unsigned)(NU * 2);
#pragma unroll
    for (int hh = 0; hh < 3; ++hh) {
        const int h = 3 * hg + hh; const int bh = b * RW_H + h;
        const char* sl = RL + ((size_t)bh * NCH + c) * 8192;
        f16x8 bq[2];
#pragma unroll
        for (int s = 0; s < 2; ++s) bq[s] = *(const f16x8*)(QT + (m * (unsigned)RW_W + (unsigned)(h * 64 + 8 * fq + 32 * s)) * 2u);
        f32x4 D[4];
#pragma unroll
        for (int vt = 0; vt < 4; ++vt) { const f16x4 yl = *(const f16x4*)(MIX + (m * (unsigned)DM + (unsigned)(h * 64 + 16 * vt + 4 * fq)) * 2u);
            f32x4 d = (f32x4){(float)yl[0], (float)yl[1], (float)yl[2], (float)yl[3]};
#pragma unroll
            for (int s = 0; s < 2; ++s) d = __builtin_amdgcn_mfma_f32_16x16x32_f16(*(const f16x8*)(sl + ((16 * vt + tl) * 64 + 8 * fq + 32 * s) * 2), bq[s], d, 0, 0, 0);
            D[vt] = d; }
        float sm = 0.f;
#pragma unroll
        for (int vt = 0; vt < 4; ++vt) sm += (D[vt][0] + D[vt][1]) + (D[vt][2] + D[vt][3]);
        sm += shfl_xor_f(sm, 16); sm += shfl_xor_f(sm, 32);
        const float mean = sm * (1.0f / 64.0f); float vr = 0.f;
#pragma unroll
        for (int vt = 0; vt < 4; ++vt)
#pragma unroll
            for (int i = 0; i < 4; ++i) { const float d = D[vt][i] - mean; vr += d * d; }
        vr += shfl_xor_f(vr, 16); vr += shfl_xor_f(vr, 32);
        const float rstd = 1.0f / sqrtf(vr * (1.0f / 64.0f) + 64e-5f);
        const float bon = BONG[m * 8u + (unsigned)h];
        const float* ln_w = a.in[14] + l * RW_W; const float* ln_b = a.in[15] + l * RW_W;
#pragma unroll
        for (int vt = 0; vt < 4; ++vt) { const unsigned col = (unsigned)(h * 64 + 16 * vt + 4 * fq);
            const f16x4 vp = *(const f16x4*)(VP + (m * (unsigned)RW_W + col) * 2u), z4 = *(const f16x4*)(U + uo + ((unsigned)C_RWZ + col) * 2u);
            const f32x4 lw = *(const f32x4*)(ln_w + col), lb = *(const f32x4*)(ln_b + col);
            f16x4 o;
#pragma unroll
            for (int i = 0; i < 4; ++i) o[i] = (f16)(((D[vt][i] - mean) * rstd * lw[i] + lb[i] + bon * (float)vp[i]) * siluf_((float)z4[i]));
            *(f16x4*)(MIX + (m * (unsigned)DM + col) * 2u) = o; }
    }
#pragma unroll
    for (int hh = 0; hh < 3; ++hh) {
        const int h = 3 * hg + hh; const int bh = b * 6 + h;
        const char* sl = HL + ((size_t)bh * NCH + c) * 8192;
        f16x8 bq[2];
#pragma unroll
        for (int s = 0; s < 2; ++s) bq[s] = *(const f16x8*)(U + uo + (unsigned)(C_HGQ + h * 64 + 8 * fq + 32 * s) * 2u);
        f32x4 D[4];
#pragma unroll
        for (int vt = 0; vt < 4; ++vt) { const f16x4 ol = *(const f16x4*)(MIX + (m * (unsigned)DM + (unsigned)(384 + h * 64 + 16 * vt + 4 * fq)) * 2u);
            f32x4 d = (f32x4){(float)ol[0], (float)ol[1], (float)ol[2], (float)ol[3]};
#pragma unroll
            for (int s = 0; s < 2; ++s) d = __builtin_amdgcn_mfma_f32_16x16x32_f16(*(const f16x8*)(sl + ((16 * vt + tl) * 64 + 8 * fq + 32 * s) * 2), bq[s], d, 0, 0, 0);
            D[vt] = d; }
        float ss = 0.f;
#pragma unroll
        for (int vt = 0; vt < 4; ++vt) ss += (D[vt][0] * D[vt][0] + D[vt][1] * D[vt][1]) + (D[vt][2] * D[vt][2] + D[vt][3] * D[vt][3]);
        ss += shfl_xor_f(ss, 16); ss += shfl_xor_f(ss, 32);
        const float rs = 1.0f / sqrtf(ss * (1.0f / 64.0f) + 1e-6f);
        const float* nw = a.in[17] + l * 384;
#pragma unroll
        for (int vt = 0; vt < 4; ++vt) { const unsigned col = (unsigned)(h * 64 + 16 * vt + 4 * fq);
            const f16x4 z4 = *(const f16x4*)(U + uo + ((unsigned)C_HGZ + col) * 2u); const f32x4 w4 = *(const f32x4*)(nw + col);
            f16x4 o;
#pragma unroll
            for (int i = 0; i < 4; ++i) o[i] = (f16)(D[vt][i] * rs * w4[i] * siluf_((float)z4[i]));
            *(f16x4*)(MIX + (m * (unsigned)DM + 384u + col) * 2u) = o; }
    }
    {
        const char* CA = (const char*)(a.ws + WS_CA); const float* LH = (const float*)(a.ws + WS_LH) + ((size_t)b * NCH + c) * 256;
#pragma unroll
        for (int q = 0; q < 4; ++q) { const unsigned ch0 = (unsigned)(128 * hg + 32 * fq + 8 * q);
            const f16x8 hl = *(const f16x8*)(MIX + (m * (unsigned)DM + 768u + ch0) * 2u), ca = *(const f16x8*)(CA + (m * 256u + ch0) * 2u), z8 = *(const f16x8*)(U + uo + ((unsigned)C_LRUZ + ch0) * 2u);
            const f32x4 c0 = *(const f32x4*)(LH + ch0), c1 = *(const f32x4*)(LH + ch0 + 4);
            f16x8 o;
#pragma unroll
            for (int i = 0; i < 8; ++i) o[i] = (f16)(((float)hl[i] + (float)ca[i] * (i < 4 ? c0[i & 3] : c1[i & 3])) * siluf_((float)z8[i]));
            *(f16x8*)(MIX + (m * (unsigned)DM + 768u + ch0) * 2u) = o; }
    }
}
#define XB_TMO      128
#define XB_XCNT(j)  (256  + 64 * (j))
#define XB_XSUB(j)  (1280 + 64 * (j))
#define XB_XGEN(j)  (2304 + 64 * (j))
#define XB_TOP      3328
#define XB_TOPGEN   3392
#define XCD_BAR_WORDS 3456
#define XB_SPIN_CAP (1u << 18)

__device__ __forceinline__ unsigned xb_ld(unsigned* p)              { return __hip_atomic_load(p, __ATOMIC_RELAXED, __HIP_MEMORY_SCOPE_AGENT); }
__device__ __forceinline__ unsigned xb_add(unsigned* p, unsigned v) { return __hip_atomic_fetch_add(p, v, __ATOMIC_RELAXED, __HIP_MEMORY_SCOPE_AGENT); }
__device__ __forceinline__ unsigned xb_xcc_id() { return (unsigned)__builtin_amdgcn_s_getreg((3 << 11) | 20) & 0xFu; }
#define XB_SPIN(cond, bar) do { unsigned _sp = 0; while (cond) { __builtin_amdgcn_s_sleep(1); \
    if ((++_sp & 255u) == 0u) { if (xb_ld(&(bar)[XB_TMO])) break; if (_sp > XB_SPIN_CAP) { atomicAdd(&(bar)[XB_TMO], 1u); break; } } } } while (0)

struct XcdBarrier {
    unsigned* bar; unsigned x; int isw0;
    volatile LAS unsigned* st;
};

__device__ __forceinline__ XcdBarrier xcd_barrier_post(unsigned* bar, volatile LAS unsigned* st, int isw0) {
    XcdBarrier b; b.bar = bar; b.x = xb_xcc_id(); b.st = st; b.isw0 = isw0;
    if (isw0 && lane_now() == 0) (void)xb_add(&bar[XB_XCNT(b.x)], 1u);
    return b;
}
__device__ __forceinline__ void xcd_barrier_complete(unsigned* bar, unsigned x, unsigned& nloc, unsigned& nx) {
    const unsigned G = gridDim.x * gridDim.y * gridDim.z;
    unsigned sum, cnt, mine, sp = 0u;
    for (;;) {
        sum = 0u; cnt = 0u; mine = 0u;
#pragma unroll
        for (unsigned j = 0; j < 16; ++j) { const unsigned c = xb_ld(&bar[XB_XCNT(j)]); sum += c; cnt += (c > 0u) ? 1u : 0u; mine = (j == x) ? c : mine; }
        if (sum == G) break;
        __builtin_amdgcn_s_sleep(1);
        if ((++sp & 255u) == 0u) { if (xb_ld(&bar[XB_TMO])) break; if (sp > XB_SPIN_CAP) { atomicAdd(&bar[XB_TMO], 1u); break; } }
    }
    nloc = mine > 0u ? mine : 1u; nx = cnt > 0u ? cnt : 1u;
}

__device__ __forceinline__ void xcd_barrier(const XcdBarrier& b) {
    asm volatile("s_waitcnt vmcnt(0)" ::: "memory");
    __syncthreads();
    if (b.isw0 && lane_now() == 0) {
        unsigned* bar = b.bar;
        __builtin_amdgcn_s_waitcnt(0);
        unsigned nloc = b.st[0], nx = b.st[1];
        if (nloc == 0u) { xcd_barrier_complete(bar, b.x, nloc, nx); b.st[0] = nloc; b.st[1] = nx; }
        const unsigned old = xb_add(&bar[XB_XSUB(b.x)], 1u);
        const unsigned gen = old / nloc;
        if (old + 1u == (gen + 1u) * nloc) {
            __builtin_amdgcn_fence(__ATOMIC_RELEASE, "agent");
            asm volatile("s_waitcnt vmcnt(0)" ::: "memory");
            const unsigned og = xb_add(&bar[XB_TOP], 1u);
            const unsigned tg = og / nx;
            if (og + 1u == (tg + 1u) * nx) xb_add(&bar[XB_TOPGEN], 1u);
            else XB_SPIN(xb_ld(&bar[XB_TOPGEN]) == tg, bar);
            __builtin_amdgcn_fence(__ATOMIC_ACQUIRE, "agent");
            xb_add(&bar[XB_XGEN(b.x)], 1u);
            asm volatile("s_waitcnt vmcnt(0)" ::: "memory");
        } else {
            XB_SPIN(xb_ld(&bar[XB_XGEN(b.x)]) == gen, bar);
            __builtin_amdgcn_fence(__ATOMIC_ACQUIRE, "agent");
            asm volatile("s_waitcnt vmcnt(0)" ::: "memory");
        }
    }
    __syncthreads();
}

constexpr size_t WS_BAR = 16384;
constexpr int MISC_OFF = LDS_BYTES - 16;
__global__ void __launch_bounds__(NT, 2) fwd(Args args) {
    extern __shared__ __attribute__((aligned(16))) unsigned char lds_raw[];
    LAS unsigned char* lds = (LAS unsigned char*)lds_raw;
    cg::grid_group grid = cg::this_grid();
    const int wave = __builtin_amdgcn_readfirstlane((int)threadIdx.x >> 6);
#define TID_NOW() (wave * 64 + lane_now())
    const int tid = TID_NOW(); const int lane = tid & 63;
    if (wave == 0 && lane < 4) ((LAS unsigned*)(lds + MISC_OFF))[lane] = 0u;
    __syncthreads();
    XcdBarrier xbar = xcd_barrier_post((unsigned*)(args.ws + WS_BAR), (volatile LAS unsigned*)(lds + MISC_OFF), __builtin_amdgcn_readfirstlane(wave == 0 ? 1 : 0));
#define GRID_BAR() do { XcdBarrier xb_ = xbar; xb_.st = (volatile LAS unsigned*)(lds + MISC_OFF); asm volatile("" : "+s"(xb_.bar), "+s"(xb_.x)); xcd_barrier(xb_); } while (0)
    const int G = gridDim.x, gw = blockIdx.x * NWAVES + wave, NGW = G * NWAVES;
    unsigned char* ws = args.ws;
    unsigned short* XN = (unsigned short*)(ws + WS_XN);
    {
        LAS float* scr = (LAS float*)(lds + wave * 16384);
        constexpr int I_IN = (DM / 64) * (NIN / 32), I_OUT = (DM / 64) * (DM / 32), NITEMS = DEPTH * (I_IN + I_OUT);
        for (int it = gw; it < NITEMS; it += NGW) {
            int r = it; const int l = r / (I_IN + I_OUT); r -= l * (I_IN + I_OUT);
            if (r < I_IN) p0_transpose_item(args.in[2] + (size_t)l * DM * NIN, DM, NIN, (unsigned short*)(ws + WS_WIN + l * WIN_L), scr, r, lane, l == 0 ? nullptr : args.in[1] + DM);
            else p0_transpose_item(args.in[25] + (size_t)l * DM * DM, DM, DM, (unsigned short*)(ws + WS_WOUT + l * WOUT_L), scr, r - I_IN, lane, nullptr);
        }
        for (int i = gw; i < DEPTH * (NU - NIN) * DM * 2 / 1024; i += NGW) { const int l = i / ((NU - NIN) * DM * 2 / 1024), r = i % ((NU - NIN) * DM * 2 / 1024);
            if (l == 1 && r < 64 * DM * 2 / 1024) continue;
            *(u32x4*)(ws + WS_WIN + l * WIN_L + (size_t)NIN * DM * 2 + (size_t)r * 1024 + lane * 16) = (u32x4){0u, 0u, 0u, 0u}; }
        for (int i = blockIdx.x * NT + tid; i < 64 * DM; i += G * NT) { const int k = i >> 6, n = i & 63, j = n & 31;
            const float* wrow = args.in[2] + (size_t)DM * NIN + (size_t)k * NIN + C_V; const float* mu1 = args.in[3] + RW_SHIFT + C_V; const float* vdn = args.in[9];
            float acc = 0.f;
            for (int cc = 0; cc < RW_W; ++cc) { const float mm = mu1[cc]; acc += wrow[cc] * ((n < 32) ? (1.0f - mm) : mm) * vdn[cc * 32 + j]; }
            ((f16*)(ws + WS_WIN + WIN_L))[(size_t)(NIN + n) * DM + k] = (f16)(acc * args.in[1][DM + k]); }
        for (int i = blockIdx.x * NT + tid; i < M; i += G * NT) ((float*)(ws + WS_RSS))[i] = 0.f;
        for (int m = gw; m < M; m += NGW) rms_row_f16(args.in[0] + (size_t)m * DM, args.in[1], XN + (size_t)m * DM, lane);
        { f16* WUPT = (f16*)(ws + WS_WUPT); f16* AUPT = (f16*)(ws + WS_AUPT); f16* VDNT = (f16*)(ws + WS_VDNT); f16* VUPT = (f16*)(ws + WS_VUPT);
          for (int i = blockIdx.x * NT + tid; i < 122880; i += G * NT) {
              if (i < 49152) { const int ll = i / 24576, r = i % 24576, n = r / 64, k = r % 64; WUPT[i] = (f16)args.in[5][(size_t)ll * 24576 + k * 384 + n]; }
              else if (i < 98304) { const int i2 = i - 49152, ll = i2 / 24576, r = i2 % 24576, n = r / 64, k = r % 64; AUPT[i2] = (f16)args.in[7][(size_t)ll * 24576 + k * 384 + n]; }
              else if (i < 110592) { const int i2 = i - 98304, j2 = i2 / 384, cc = i2 % 384; VDNT[i2] = (f16)args.in[9][cc * 32 + j2]; }
              else { const int i2 = i - 110592, n = i2 / 32, j2 = i2 % 32; VUPT[i2] = (f16)args.in[10][j2 * 384 + n]; } }
          f16* WAT = (f16*)(ws + WS_WAT); f16* WXT = (f16*)(ws + WS_WXT);
          for (int i = blockIdx.x * NT + tid; i < 32768; i += G * NT) { const int lg = i >> 12, r = i & 4095, j = r >> 6, ii = r & 63; WAT[i] = (f16)args.in[20][(size_t)lg * 4096 + ii * 64 + j]; WXT[i] = (f16)args.in[22][(size_t)lg * 4096 + ii * 64 + j]; } }
    }
    grid.sync();
#pragma unroll 1
    for (int l = 0; l < DEPTH; ++l) {
        { pg8::Gemm g{XN, (const unsigned short*)(ws + WS_WIN + l * WIN_L), M, NU, DM}; pg8::StaticOrder S; S.init(M, NU, G, (int)blockIdx.x);
          pg8::EpiF16 E{(unsigned short*)(ws + WS_U), NU, l == 0 ? nullptr : (const float*)(ws + WS_RSS)};
          pg8::gemm_phase<pg8::EpiF16, pg8::StaticOrder, true, true>(lds, g, S, E, wave); }
        GRID_BAR();
        for (int task = blockIdx.x; task < BATCH * NCH; task += G) phaseA(args, l, task, lds, TID_NOW());
        GRID_BAR();
        phaseB1(args, lds, TID_NOW());
        GRID_BAR();
        phaseB(args, lds, TID_NOW());
        GRID_BAR();
        phaseB3(args, lds, TID_NOW());
        GRID_BAR();
        for (int task = blockIdx.x; task < BATCH * NCH; task += G) phaseC(args, l, task, lds, TID_NOW());
        GRID_BAR();
        { pg8::Gemm g{(const unsigned short*)(ws + WS_MIX), (const unsigned short*)(ws + WS_WOUT + l * WOUT_L), M, DM, DM}; pg8::StaticOrder S; S.init(M, DM, G, (int)blockIdx.x);
          pg8::EpiRes E{l == 0 ? args.in[0] : args.out, args.out, DM, l == 0 ? XN : nullptr, (float*)(ws + WS_RSS)};
          pg8::gemm_phase<pg8::EpiRes, pg8::StaticOrder, true, true>(lds, g, S, E, wave); }
        GRID_BAR();
        { int ln = TID_NOW() & 63; asm volatile("" : "+v"(ln));
          if (l + 1 < DEPTH) { }
          else { for (int m = gw; m < M; m += NGW) rms_row_f32(args.out + (size_t)m * DM, args.in[26], ln); } }
    }
}

extern "C" void kernel_launch(void* const* d_in, const int* in_sizes, int n_in, void* d_out, int out_size, void* d_ws, size_t ws_size, hipStream_t stream) {
    static int grid = 0;
    if (grid == 0) {
        if (n_in != 27 || in_sizes[0] != M * DM || out_size != M * DM || ws_size < WS_END) { fprintf(stderr, "kernel_launch: unexpected problem: n_in %d in0 %d out %d ws %zu\n", n_in, n_in > 0 ? in_sizes[0] : -1, out_size, ws_size); grid = -1; return; }
        int dev = 0, cus = 0, per_cu = 0;
        hipGetDevice(&dev); hipDeviceGetAttribute(&cus, hipDeviceAttributeMultiprocessorCount, dev);
        if (hipFuncSetAttribute((const void*)fwd, hipFuncAttributeMaxDynamicSharedMemorySize, LDS_BYTES) != hipSuccess) { fprintf(stderr, "kernel_launch: hipFuncSetAttribute failed\n"); grid = -1; return; }
        if (hipOccupancyMaxActiveBlocksPerMultiprocessor(&per_cu, (const void*)fwd, NT, LDS_BYTES) != hipSuccess || per_cu < 1) { fprintf(stderr, "kernel_launch: occupancy query failed (%d)\n", per_cu); grid = -1; return; }
        grid = cus * per_cu;
    }
    if (grid < 0) return;
    if (hipMemsetAsync((char*)d_ws, 0, 65536, stream) != hipSuccess) { fprintf(stderr, "kernel_launch: memset of the barrier words failed\n"); return; }
    Args a{};
    for (int i = 0; i < 27; ++i) a.in[i] = (const float*)d_in[i];
    a.out = (float*)d_out; a.ws = (unsigned char*)d_ws;
    void* kargs[] = {&a};
    hipError_t e = hipLaunchCooperativeKernel((const void*)fwd, dim3(grid), dim3(NT), kargs, LDS_BYTES, stream);
    if (e != hipSuccess) fprintf(stderr, "cooperative launch failed: %s (grid %d)\n", hipGetErrorString(e), grid);
}
```

```cpp
#include <hip/hip_runtime.h>
#include <hip/hip_cooperative_groups.h>
#include <cstdio>
#include <cstdint>
namespace cg = cooperative_groups;
typedef _Float16 f16x8_t __attribute__((ext_vector_type(8)));
#define MK_MFMA(a, b, c) __builtin_amdgcn_mfma_f32_16x16x32_f16(__builtin_bit_cast(f16x8_t, (a)), __builtin_bit_cast(f16x8_t, (b)), (c), 0, 0, 0)
__device__ __forceinline__ int lane_now() { int z; asm volatile("v_mbcnt_lo_u32_b32 %0, -1, 0\n\tv_mbcnt_hi_u32_b32 %0, -1, %0" : "=v"(z)); return z; }
__device__ __forceinline__ float shfl_xor_f(float v, int mask) { const int ln = lane_now(); return __builtin_bit_cast(float, __builtin_amdgcn_ds_bpermute((ln ^ mask) << 2, __builtin_bit_cast(int, v))); }
namespace pg8 {
#define PG8_LAS __attribute__((address_space(3)))
typedef unsigned short bf16_t;
typedef short bf16x8 __attribute__((ext_vector_type(8)));
typedef float f32x4 __attribute__((ext_vector_type(4)));
typedef unsigned u32x4 __attribute__((ext_vector_type(4)));
constexpr int BM = 256, BK = 64, HALF = 128, HTB = HALF * BK * 2  , STAGE_BYTES = 8 * HTB, NXCD = 8, WGM = 8;

__host__ __device__ __forceinline__ int lds_byte(int r, int c) { const int st = (r >> 4) * 2 + (c >> 5), rr = r & 15, cc = c & 31, ob = rr * 64 + cc * 2; return st * 1024 + (ob ^ (((ob >> 9) & 1) << 5)); }
__host__ __device__ __forceinline__ void stage_rc(int b, int& R, int& C) { const int st = b / 1024, sb = b % 1024, swz = sb ^ (((sb >> 9) & 1) << 5); R = (st >> 1) * 16 + swz / 64; C = (st & 1) * 32 + (swz % 64) / 2; }
__host__ __device__ __forceinline__ int perm32(int rho) { const int n = rho >> 4, i = rho & 15; return 8 * (i >> 2) + 4 * n + (i & 3); }

struct Unit { int pm, pn; };
struct Gemm { const bf16_t* A; const bf16_t* Bt; int M, N, K; };

struct StaticOrder {
    int nM, nN, nwg, G, c;
    __host__ __device__ void init(int M, int N, int G_, int c_) { nM = M / BM; nN = N / BM; nwg = nM * nN; G = G_; c = c_; }
    __host__ __device__ bool next(int i, Unit& u) const {
        const long L = (long)i * G + c; if (L >= nwg) return false;
        int wgid = (int)L; { const int q = nwg / NXCD, r = nwg % NXCD, xcd = wgid % NXCD, off = wgid / NXCD; wgid = (xcd < r ? xcd * (q + 1) : r * (q + 1) + (xcd - r) * q) + off; }
        const int nig = WGM * nN, gid = wgid / nig, fm = gid * WGM, gsz = (nM - fm) < WGM ? (nM - fm) : WGM;
        u.pm = fm + ((wgid % nig) % gsz); u.pn = (wgid % nig) / gsz; return true;
    }
    __device__ __forceinline__ void a_ready(const Unit&) const {}
    __device__ __forceinline__ void done(const Unit&) const {}
};

__device__ __forceinline__ unsigned pk_f16(float lo, float hi) { typedef _Float16 h2 __attribute__((ext_vector_type(2))); h2 v; v.x = (_Float16)lo; v.y = (_Float16)hi; return __builtin_bit_cast(unsigned, v); }
typedef unsigned u32x2 __attribute__((ext_vector_type(2)));
struct EpiF16 {
    static constexpr bool PERM = true, AFTER_DRAIN = false;
    bf16_t* O; int ldc; const float* rss;
    __device__ __forceinline__ void operator()(const f32x4 (&acc)[2][2][4][2], const Unit& u, int wr, int wc, int fr, int fq) const {
        const int row0 = u.pm * BM + wr * 64 + fr; const int col0 = u.pn * BM + wc * 32 + 8 * fq;
#pragma unroll
        for (int ai = 0; ai < 2; ++ai)
#pragma unroll
            for (int m = 0; m < 4; ++m) { const int row = row0 + ai * HALF + m * 16; bf16_t* rowp = O + (size_t)row * ldc + col0;
                const float sc = rss ? 1.0f / sqrtf(rss[row] * (1.0f / 1024.0f) + 1e-6f) : 1.0f;
#pragma unroll
                for (int bj = 0; bj < 2; ++bj) { const f32x4 v0 = acc[ai][bj][m][0] * sc, v1 = acc[ai][bj][m][1] * sc;
                    u32x4 w; w.x = pk_f16(v0[0], v0[1]); w.y = pk_f16(v0[2], v0[3]); w.z = pk_f16(v1[0], v1[1]); w.w = pk_f16(v1[2], v1[3]);
                    *(u32x4*)(rowp + bj * HALF) = w; } }
    }
};
struct EpiRes {
    static constexpr bool PERM = false, AFTER_DRAIN = false;
    const float* base; float* out; int ldc; bf16_t* xh; float* rss;
    __device__ __forceinline__ void operator()(const f32x4 (&acc)[2][2][4][2], const Unit& u, int wr, int wc, int fr, int fq) const {
        const int row0 = u.pm * BM + wr * 64 + fr; const int col0 = u.pn * BM + wc * 32 + 4 * fq;
#pragma unroll
        for (int ai = 0; ai < 2; ++ai)
#pragma unroll
            for (int m = 0; m < 4; ++m) { const size_t off = (size_t)(row0 + ai * HALF + m * 16) * ldc + col0; float ss = 0.f;
#pragma unroll
                for (int bj = 0; bj < 2; ++bj)
#pragma unroll
                    for (int n = 0; n < 2; ++n) { const size_t o = off + bj * HALF + n * 16; const f32x4 b = *(const f32x4*)(base + o); const f32x4 x = b + acc[ai][bj][m][n]; *(f32x4*)(out + o) = x;
                        if (xh) { u32x2 h; h.x = pk_f16(x[0], x[1]); h.y = pk_f16(x[2], x[3]); *(u32x2*)(xh + o) = h; ss += (x[0] * x[0] + x[1] * x[1]) + (x[2] * x[2] + x[3] * x[3]); } }
                if (xh) { ss += shfl_xor_f(ss, 16); ss += shfl_xor_f(ss, 32); if (fq == 0) atomicAdd(rss + row0 + ai * HALF + m * 16, ss); }
                asm volatile("" ::: "memory"); }
    }
};

template <class Epi, class Sched, bool ALIGN_EPI = false, bool SP2 = false>
__device__ __forceinline__ void gemm_phase(PG8_LAS unsigned char* lds, const Gemm g, const Sched& S, const Epi& E, const int wave_) {
    int wv_ = wave_; asm volatile("" : "+s"(wv_)); int tid_ = lane_now() + 64 * wv_; const int tid = tid_, wid = wv_, lane = tid & 63, wr = wid >> 2, wc = wid & 3, fr = lane & 15, fq = lane >> 4;
    const int K = g.K, nt = K / BK;
    unsigned voffA[2], voffB[2];
#pragma unroll
    for (int i = 0; i < 2; ++i) { int R, C; stage_rc(tid * 16 + i * 8192, R, C); const int Rb = Epi::PERM ? ((R & ~31) + perm32(R & 31)) : R;
        voffA[i] = (unsigned)(R * K + C) * 2u; voffB[i] = (unsigned)(Rb * K + C) * 2u; }
    const size_t kstep = (size_t)(BK * 2);
    const size_t hstep = (size_t)HALF * K * 2;
    const size_t tstep = 2 * hstep;
    const unsigned ldsw = (unsigned)wid * 1024u;
    const int aoff = lds_byte(wr * 64 + fr, fq * 8), boff = lds_byte(wc * 32 + fr, fq * 8);
#define PG8_SA(b, h) (((b) * 2 + (h)) * HTB)
#define PG8_SB(b, h) ((4 + (b) * 2 + (h)) * HTB)
#define PG8_STAGE(bufoff, gbase, voff) do { _Pragma("unroll") for (int _i = 0; _i < 2; ++_i) \
        __builtin_amdgcn_global_load_lds((const unsigned*)((const char*)(gbase) + (voff)[_i]), (PG8_LAS unsigned*)(lds + (bufoff) + ldsw + _i * 8192), 16, 0, 0); } while (0)
#define PG8_LDA(dst, b, h) do { _Pragma("unroll") for (int m = 0; m < 4; ++m) _Pragma("unroll") for (int k = 0; k < 2; ++k) dst[m][k] = *(const PG8_LAS bf16x8*)(lds + PG8_SA(b, h) + aoff + m * 2048 + k * 1024); } while (0)
#define PG8_LDB(dst, b, h) do { _Pragma("unroll") for (int n = 0; n < 2; ++n) _Pragma("unroll") for (int k = 0; k < 2; ++k) dst[n][k] = *(const PG8_LAS bf16x8*)(lds + PG8_SB(b, h) + boff + n * 2048 + k * 1024); } while (0)
#define PG8_MMA(ai, bj, At, Bt) do { __builtin_amdgcn_s_setprio(1); _Pragma("unroll") for (int m = 0; m < 4; ++m) _Pragma("unroll") for (int n = 0; n < 2; ++n) _Pragma("unroll") for (int k = 0; k < 2; ++k) \
        acc[ai][bj][m][n] = MK_MFMA(Bt[n][k], At[m][k], acc[ai][bj][m][n]); __builtin_amdgcn_s_setprio(0); } while (0)
#define PG8_WAIT_V(n) asm volatile("s_waitcnt vmcnt(" #n ")" ::: "memory")
#define PG8_WAIT_L(n) asm volatile("s_waitcnt lgkmcnt(" #n ")" ::: "memory")
#define PG8_BAR __builtin_amdgcn_s_barrier()
#define PG8_SCHED __builtin_amdgcn_sched_barrier(0)
    Unit cur, nxt; int ui = 0;
    if (!S.next(0, cur)) return;
    f32x4 acc[2][2][4][2];
#pragma unroll
    for (int a = 0; a < 2; ++a)
#pragma unroll
        for (int b = 0; b < 2; ++b)
#pragma unroll
            for (int m = 0; m < 4; ++m)
#pragma unroll
                for (int n = 0; n < 2; ++n) acc[a][b][m][n] = (f32x4){0.f, 0.f, 0.f, 0.f};
    bf16x8 At[4][2], B0[2][2], B1[2][2];
    const char* cA = (const char*)g.A + (size_t)cur.pm * tstep; const char* cB = (const char*)g.Bt + (size_t)cur.pn * tstep;
    S.a_ready(cur);
    if constexpr (SP2) {
        PG8_STAGE(PG8_SB(0, 0), cB, voffB); PG8_STAGE(PG8_SB(0, 1), cB + hstep, voffB); PG8_STAGE(PG8_SA(0, 0), cA, voffA); PG8_STAGE(PG8_SA(0, 1), cA + hstep, voffA);
        if (wr == 1) PG8_BAR;
        PG8_WAIT_V(2); PG8_BAR;
        PG8_STAGE(PG8_SB(1, 0), cB + kstep, voffB); PG8_STAGE(PG8_SA(1, 0), cA + kstep, voffA); PG8_STAGE(PG8_SB(1, 1), cB + hstep + kstep, voffB);
        PG8_WAIT_V(6); PG8_BAR;
    } else {
        PG8_STAGE(PG8_SB(0, 0), cB, voffB); PG8_STAGE(PG8_SA(0, 0), cA, voffA); PG8_STAGE(PG8_SB(0, 1), cB + hstep, voffB); PG8_STAGE(PG8_SA(0, 1), cA + hstep, voffA);
        if (wr == 1) PG8_BAR;
        PG8_WAIT_V(4); PG8_BAR;
        PG8_STAGE(PG8_SB(1, 0), cB + kstep, voffB); PG8_STAGE(PG8_SA(1, 0), cA + kstep, voffA); PG8_STAGE(PG8_SB(1, 1), cB + hstep + kstep, voffB);
        PG8_WAIT_V(6); PG8_BAR;
    }
    for (;;) {
        const bool has_next = S.next(ui + 1, nxt);
        const char* nA = has_next ? (const char*)g.A + (size_t)nxt.pm * tstep : cA; const char* nB = has_next ? (const char*)g.Bt + (size_t)nxt.pn * tstep : cB;
        for (int t = 0; t < nt; t += 2) {
            const bool last = (t == nt - 2);
            const char* a1 = cA + (size_t)(t + 1) * kstep;
            const char* a2 = last ? nA : cA + (size_t)(t + 2) * kstep; const char* b2 = last ? nB : cB + (size_t)(t + 2) * kstep;
            const char* a3 = a2 + kstep; const char* b3 = b2 + kstep;
            if (last && has_next) S.a_ready(nxt);
            if constexpr (SP2) {
            PG8_LDB(B0, 0, 0); PG8_LDB(B1, 0, 1); PG8_SCHED; PG8_LDA(At, 0, 0); PG8_STAGE(PG8_SA(1, 1), a1 + hstep, voffA);
            PG8_WAIT_V(8); PG8_WAIT_L(0); PG8_BAR; PG8_MMA(0, 0, At, B0); PG8_MMA(0, 1, At, B1); PG8_BAR; PG8_SCHED;
            PG8_LDA(At, 0, 1); PG8_STAGE(PG8_SB(0, 0), b2, voffB); PG8_STAGE(PG8_SB(0, 1), b2 + hstep, voffB); PG8_STAGE(PG8_SA(0, 0), a2, voffA);
            PG8_WAIT_V(8); PG8_WAIT_L(0); PG8_BAR; PG8_MMA(1, 0, At, B0); PG8_MMA(1, 1, At, B1); PG8_BAR; PG8_SCHED;
            PG8_LDB(B0, 1, 0); PG8_LDB(B1, 1, 1); PG8_SCHED; PG8_LDA(At, 1, 0); PG8_STAGE(PG8_SA(0, 1), a2 + hstep, voffA);
            PG8_WAIT_V(8); PG8_WAIT_L(0); PG8_BAR; PG8_MMA(0, 0, At, B0); PG8_MMA(0, 1, At, B1); PG8_BAR; PG8_SCHED;
            PG8_LDA(At, 1, 1); PG8_STAGE(PG8_SB(1, 0), b3, voffB); PG8_STAGE(PG8_SB(1, 1), b3 + hstep, voffB); PG8_STAGE(PG8_SA(1, 0), a3, voffA);
            PG8_WAIT_V(8); PG8_WAIT_L(0); PG8_BAR; PG8_MMA(1, 0, At, B0); PG8_MMA(1, 1, At, B1); PG8_BAR; PG8_SCHED;
            } else {
            PG8_LDB(B0, 0, 0); PG8_SCHED; PG8_LDA(At, 0, 0); PG8_STAGE(PG8_SA(1, 1), a1 + hstep, voffA);
            PG8_WAIT_L(8); PG8_BAR; PG8_WAIT_L(0); PG8_MMA(0, 0, At, B0); PG8_BAR; PG8_SCHED;
            PG8_LDB(B1, 0, 1); PG8_STAGE(PG8_SB(0, 0), b2, voffB);
            PG8_BAR; PG8_WAIT_L(0); PG8_MMA(0, 1, At, B1); PG8_BAR;
            PG8_LDA(At, 0, 1); PG8_STAGE(PG8_SA(0, 0), a2, voffA);
            PG8_BAR; PG8_WAIT_L(0); PG8_MMA(1, 0, At, B0); PG8_BAR; PG8_SCHED;
            PG8_STAGE(PG8_SB(0, 1), b2 + hstep, voffB);
            PG8_WAIT_V(6); PG8_BAR; PG8_MMA(1, 1, At, B1); PG8_BAR;
            PG8_LDB(B0, 1, 0); PG8_SCHED; PG8_LDA(At, 1, 0); PG8_STAGE(PG8_SA(0, 1), a2 + hstep, voffA);
            PG8_WAIT_L(8); PG8_BAR; PG8_WAIT_L(0); PG8_MMA(0, 0, At, B0); PG8_BAR; PG8_SCHED;
            PG8_LDB(B1, 1, 1); PG8_STAGE(PG8_SB(1, 0), b3, voffB);
            PG8_BAR; PG8_WAIT_L(0); PG8_MMA(0, 1, At, B1); PG8_BAR;
            PG8_LDA(At, 1, 1); PG8_STAGE(PG8_SA(1, 0), a3, voffA);
            PG8_BAR; PG8_WAIT_L(0); PG8_MMA(1, 0, At, B0); PG8_BAR; PG8_SCHED;
            PG8_STAGE(PG8_SB(1, 1), b3 + hstep, voffB);
            PG8_WAIT_V(6); PG8_BAR; PG8_MMA(1, 1, At, B1); PG8_BAR;
            }
        }
        if constexpr (ALIGN_EPI) { if (wr == 0) PG8_BAR; }
        if constexpr (!Epi::AFTER_DRAIN) { E(acc, cur, wr, wc, fr, fq); S.done(cur); }
        if (!has_next) break;
#pragma unroll
        for (int a = 0; a < 2; ++a)
#pragma unroll
            for (int b = 0; b < 2; ++b)
#pragma unroll
                for (int m = 0; m < 4; ++m)
#pragma unroll
                    for (int n = 0; n < 2; ++n) acc[a][b][m][n] = (f32x4){0.f, 0.f, 0.f, 0.f};
        cur = nxt; cA = nA; cB = nB; ++ui;
        if constexpr (ALIGN_EPI) { if (wr == 1) PG8_BAR; }
    }
    PG8_WAIT_V(0);
    if constexpr (!ALIGN_EPI) { if (wr == 0) PG8_BAR; }
    PG8_BAR;
    if constexpr (Epi::AFTER_DRAIN) { E.fused(acc, cur, wr, wc, fr, fq, lds, wid, lane); S.done(cur); }
#undef PG8_SA
#undef PG8_SB
#undef PG8_STAGE
#undef PG8_LDA
#undef PG8_LDB
#undef PG8_MMA
#undef PG8_WAIT_V
#undef PG8_WAIT_L
#undef PG8_BAR
#undef PG8_SCHED
}
}

constexpr int BATCH = 2, SEQ = 8192, DM = 1024, DEPTH = 2, M = BATCH * SEQ;
constexpr int RW_H = 6, HD = 64, RW_W = 384, RW_SHIFT = 1280;
constexpr int NIN = 3712, NU = 3840;
constexpr int C_R = 0, C_K = 384, C_V = 768, C_WL = 1152, C_AL = 1216, C_RWZ = 1280, C_HGQ = 1664, C_HGF = 2048, C_HGI = 2432, C_HGZ = 2816, C_LRUX = 3200, C_LRUZ = 3456;
constexpr int CH = 64;
constexpr int NWAVES = 8, NT = NWAVES * 64;
constexpr int LDS_BYTES = 163840;
constexpr int PRM_OFF = 138240;
constexpr size_t MiB = 1u << 20;
constexpr size_t WS_WUPT = 65536, WS_AUPT = WS_WUPT + 98304, WS_VDNT = WS_AUPT + 98304, WS_VUPT = WS_VDNT + 24576, WS_WAT = WS_VUPT + 24576, WS_WXT = WS_WAT + 65536;
constexpr size_t WS_WIN = 1 * MiB, WIN_L = (size_t)NU * DM * 2;
constexpr size_t WS_WOUT = 16 * MiB, WOUT_L = (size_t)DM * DM * 2;
constexpr size_t WS_XN = 20 * MiB;
constexpr size_t WS_QT = 20 * MiB;
constexpr size_t WS_PT = 32 * MiB;
constexpr size_t WS_CA = 44 * MiB;
constexpr size_t WS_U = 52 * MiB;
constexpr size_t WS_MIX = 172 * MiB;
constexpr size_t WS_VF = 204 * MiB;
constexpr size_t WS_VP = 216 * MiB;
constexpr size_t WS_RL = 228 * MiB;
constexpr size_t WS_HL = 240 * MiB;
constexpr size_t WS_BON = 252 * MiB;
constexpr size_t WS_DC = WS_BON + 512 * 1024;
constexpr size_t WS_LA = WS_DC + 512 * 1024;
constexpr size_t WS_LH = WS_LA + 256 * 1024;
constexpr size_t WS_RSS = WS_LH + 256 * 1024;
constexpr size_t WS_END = 254 * MiB;
constexpr int NCH = SEQ / CH;

#define LAS __attribute__((address_space(3)))
typedef float f32x4 __attribute__((ext_vector_type(4)));
typedef unsigned u32x2 __attribute__((ext_vector_type(2)));
typedef unsigned u32x4 __attribute__((ext_vector_type(4)));
typedef _Float16 f16;
typedef _Float16 f16x8 __attribute__((ext_vector_type(8)));
#define LDS_WAIT() asm volatile("s_waitcnt lgkmcnt(0)" ::: "memory")

struct Args { const float* in[27]; float* out; unsigned char* ws; };

__device__ __forceinline__ float wave_sum(float v) {
#pragma unroll
    for (int o = 1; o < 64; o <<= 1) v += shfl_xor_f(v, o);
    return v;
}
__device__ __forceinline__ float sigmoidf_(float x) { return 1.0f / (1.0f + __expf(-x)); }
__device__ __forceinline__ float siluf_(float x) { return x / (1.0f + __expf(-x)); }

__device__ __forceinline__ void p0_transpose_item(const float* W, int K, int N, unsigned short* WT, LAS float* scr, int item, int lane, const float* rsc) {
    const int nblk = N / 32, kb = item / nblk, nb = item % nblk, k0 = 64 * kb, n0 = 32 * nb;
#pragma unroll 8
    for (int i = 0; i < 32; ++i) { const int kk = 2 * i + (lane >> 5); scr[kk * 33 + (lane & 31)] = W[(size_t)(k0 + kk) * N + n0 + (lane & 31)] * (rsc ? rsc[k0 + kk] : 1.0f); }
    LDS_WAIT(); asm volatile("" ::: "memory");
    const int c = lane & 7;
#pragma unroll
    for (int j = 0; j < 4; ++j) { const int n = (lane >> 3) + 8 * j; const LAS float* s = scr + (8 * c) * 33 + n;
        u32x4 o; o.x = pg8::pk_f16(s[0 * 33], s[1 * 33]); o.y = pg8::pk_f16(s[2 * 33], s[3 * 33]); o.z = pg8::pk_f16(s[4 * 33], s[5 * 33]); o.w = pg8::pk_f16(s[6 * 33], s[7 * 33]);
        *(u32x4*)(WT + (size_t)(n0 + n) * K + k0 + 8 * c) = o; }
    LDS_WAIT(); asm volatile("" ::: "memory");
}
__device__ __forceinline__ void rms_row_f16(const float* xrow, const float* w, unsigned short* orow, int lane) {
    const f32x4* xr = (const f32x4*)xrow + lane; const f32x4* wr = (const f32x4*)w + lane;
    f32x4 v[4]; float s = 0.f;
#pragma unroll
    for (int j = 0; j < 4; ++j) { v[j] = xr[64 * j]; s += (v[j].x * v[j].x + v[j].y * v[j].y) + (v[j].z * v[j].z + v[j].w * v[j].w); }
    const float rs = 1.0f / sqrtf(wave_sum(s) * (1.0f / DM) + 1e-6f);
    u32x2* o8 = (u32x2*)orow + lane;
#pragma unroll
    for (int j = 0; j < 4; ++j) { const f32x4 ww = wr[64 * j]; u32x2 o; o.x = pg8::pk_f16(v[j].x * rs * ww.x, v[j].y * rs * ww.y); o.y = pg8::pk_f16(v[j].z * rs * ww.z, v[j].w * rs * ww.w); o8[64 * j] = o; }
}
__device__ __forceinline__ void rms_row_f32(float* xrow, const float* w, int lane) {
    f32x4* xr = (f32x4*)xrow + lane; const f32x4* wr = (const f32x4*)w + lane;
    f32x4 v[4]; float s = 0.f;
#pragma unroll
    for (int j = 0; j < 4; ++j) { v[j] = xr[64 * j]; s += (v[j].x * v[j].x + v[j].y * v[j].y) + (v[j].z * v[j].z + v[j].w * v[j].w); }
    const float rs = 1.0f / sqrtf(wave_sum(s) * (1.0f / DM) + 1e-6f);
#pragma unroll
    for (int j = 0; j < 4; ++j) { const f32x4 ww = wr[64 * j]; xr[64 * j] = v[j] * rs * ww; }
}

__device__ __forceinline__ void rms_row2_f32(float* xa, float* xb, const float* w, int lane) {
    f32x4* ra = (f32x4*)xa + lane; f32x4* rb = (f32x4*)xb + lane; const f32x4* wr = (const f32x4*)w + lane;
    f32x4 va[4], vb[4]; float sa = 0.f, sb = 0.f;
#pragma unroll
    for (int j = 0; j < 4; ++j) { va[j] = ra[64 * j]; vb[j] = rb[64 * j]; }
#pragma unroll
    for (int j = 0; j < 4; ++j) { sa += (va[j].x * va[j].x + va[j].y * va[j].y) + (va[j].z * va[j].z + va[j].w * va[j].w); sb += (vb[j].x * vb[j].x + vb[j].y * vb[j].y) + (vb[j].z * vb[j].z + vb[j].w * vb[j].w); }
    const float rsa = 1.0f / sqrtf(wave_sum(sa) * (1.0f / DM) + 1e-6f), rsb = 1.0f / sqrtf(wave_sum(sb) * (1.0f / DM) + 1e-6f);
#pragma unroll
    for (int j = 0; j < 4; ++j) { const f32x4 ww = wr[64 * j]; ra[64 * j] = va[j] * rsa * ww; rb[64 * j] = vb[j] * rsb * ww; }
}

#define SHV(col) ({ const float cur_ = (float)urow[(col)]; const float prev_ = hp ? (float)prow[(col)] : 0.f; cur_ + mu[(col)] * (prev_ - cur_); })

__device__ __forceinline__ void store_row64_f16(f16* dst, const float (&S)[64]) {
#pragma unroll
    for (int q = 0; q < 8; ++q) { u32x4 w; w.x = pg8::pk_f16(S[8 * q], S[8 * q + 1]); w.y = pg8::pk_f16(S[8 * q + 2], S[8 * q + 3]); w.z = pg8::pk_f16(S[8 * q + 4], S[8 * q + 5]); w.w = pg8::pk_f16(S[8 * q + 6], S[8 * q + 7]); *(u32x4*)(dst + 8 * q) = w; }
}


constexpr int RWA_REC = 656  , RWA_VROW = 136, RWA_VPL = 16 * RWA_REC, RWA_INV = RWA_VPL + 16 * RWA_VROW, RWA_BYTES = 12800;
constexpr int C_VD0 = 3712, C_VD1 = 3744;
constexpr int PRM_MU = 0, PRM_W0 = 1280, PRM_A0 = 1664, PRM_KK = 2048, PRM_KA = 2432, PRM_RK = 2816, PRM_V0 = 3200, PRM_FLOATS = 3584;
typedef float f32x2 __attribute__((ext_vector_type(2)));
typedef _Float16 f16x4 __attribute__((ext_vector_type(4)));
__device__ __forceinline__ float fmix_lo(float a, unsigned b, float c) { float d; asm("v_fma_mix_f32 %0, %1, %2, %3 op_sel:[0,0,0] op_sel_hi:[0,1,0]" : "=v"(d) : "v"(a), "v"(b), "v"(c)); return d; }
__device__ __forceinline__ float fmix_hi(float a, unsigned b, float c) { float d; asm("v_fma_mix_f32 %0, %1, %2, %3 op_sel:[0,1,0] op_sel_hi:[0,1,0]" : "=v"(d) : "v"(a), "v"(b), "v"(c)); return d; }
__device__ __forceinline__ float mmix_lo(float a, unsigned b) { float d; asm("v_fma_mix_f32 %0, %1, %2, 0 op_sel:[0,0,0] op_sel_hi:[0,1,0]" : "=v"(d) : "v"(a), "v"(b)); return d; }
__device__ __forceinline__ float mmix_hi(float a, unsigned b) { float d; asm("v_fma_mix_f32 %0, %1, %2, 0 op_sel:[0,1,0] op_sel_hi:[0,1,0]" : "=v"(d) : "v"(a), "v"(b)); return d; }
__device__ __forceinline__ float fma_asm(float a, float b, float c) { float d; asm("v_fma_f32 %0, %1, %2, %3" : "=v"(d) : "v"(a), "v"(b), "v"(c)); return d; }
#define FMIX(a, u, j, c) (((j) & 1) ? fmix_hi((a), (u)[(j) >> 1], (c)) : fmix_lo((a), (u)[(j) >> 1], (c)))
#define MMIX(a, u, j) (((j) & 1) ? mmix_hi((a), (u)[(j) >> 1]) : mmix_lo((a), (u)[(j) >> 1]))
__device__ __forceinline__ float fast_tanh(float x) { return 1.0f - 2.0f / (__expf(2.0f * x) + 1.0f); }
__device__ __forceinline__ void lerp8(const char* ub, unsigned uo, unsigned po, bool hp, const char* mub, unsigned col, float (&x)[8]) {
    const f16x8 cu = *(const f16x8*)(ub + (uo + col * 2u)); f16x8 pv = *(const f16x8*)(ub + (po + col * 2u)); const f32x4 m0 = *(const f32x4*)(mub + col * 4u), m1 = *(const f32x4*)(mub + col * 4u + 16u);
#pragma unroll
    for (int j = 0; j < 8; ++j) { const float c = (float)cu[j], p = hp ? (float)pv[j] : 0.f; x[j] = c + (j < 4 ? m0[j] : m1[j - 4]) * (p - c); }
}
__device__ __forceinline__ void lerp4(const char* ub, unsigned uo, unsigned po, bool hp, const char* mub, unsigned col, float (&x)[4]) {
    const f16x4 cu = *(const f16x4*)(ub + (uo + col * 2u)); f16x4 pv = *(const f16x4*)(ub + (po + col * 2u)); const f32x4 m0 = *(const f32x4*)(mub + col * 4u);
#pragma unroll
    for (int j = 0; j < 4; ++j) { const float c = (float)cu[j], p = hp ? (float)pv[j] : 0.f; x[j] = c + m0[j] * (p - c); }
}
__device__ __forceinline__ f16x8 pack8(const float (&x)[8]) { f16x8 r;
#pragma unroll
    for (int j = 0; j < 8; ++j) r[j] = (f16)x[j];
    return r; }

__device__ __forceinline__ void rwkv_waveA(const Args& a, int l, int b, int c, int h, LAS unsigned char* wl, const LAS float* prm, int lane) {
    const char* Ub = (const char*)(a.ws + WS_U); f16* MIX = (f16*)(a.ws + WS_MIX); char* VF = (char*)(a.ws + WS_VF); char* VP = (char*)(a.ws + WS_VP);
    f16* QT = (f16*)(a.ws + WS_QT); f16* PT = (f16*)(a.ws + WS_PT); f16* RL = (f16*)(a.ws + WS_RL); float* BONG = (float*)(a.ws + WS_BON);
    const char* WUPT = (const char*)(a.ws + WS_WUPT) + (size_t)l * 384 * 64 * 2; const char* AUPT = (const char*)(a.ws + WS_AUPT) + (size_t)l * 384 * 64 * 2;
    const char* VUPT = (const char*)(a.ws + WS_VUPT);
    const int bh = b * RW_H + h;
    float P[64], L[64];
#pragma unroll
    for (int k = 0; k < 64; ++k) { P[k] = (k == lane) ? 1.f : 0.f; L[k] = 0.f; }
#pragma unroll 1
    for (int blk = 0; blk < 4; ++blk) {
        const int lane_ = lane_now();
        const int tok = lane_ & 15, fq = lane_ >> 4;
        const int t = c * CH + blk * 16 + tok; const unsigned m = (unsigned)(b * SEQ + t); const bool hp = t > 0;
        const unsigned uo = m * (unsigned)(NU * 2), po = hp ? uo - (unsigned)(NU * 2) : uo;
        f16x8 cW[2], pW[2], cA[2], pA[2], vd0, vd1;
#pragma unroll
        for (int s = 0; s < 2; ++s) { const unsigned cw = (unsigned)(C_WL + 8 * fq + 32 * s) * 2u, ca = (unsigned)(C_AL + 8 * fq + 32 * s) * 2u;
            cW[s] = *(const f16x8*)(Ub + uo + cw); pW[s] = *(const f16x8*)(Ub + po + cw); cA[s] = *(const f16x8*)(Ub + uo + ca); pA[s] = *(const f16x8*)(Ub + po + ca); }
        if (l > 0) { vd0 = *(const f16x8*)(Ub + uo + (unsigned)(C_VD0 + 8 * fq) * 2u); vd1 = *(const f16x8*)(Ub + po + (unsigned)(C_VD1 + 8 * fq) * 2u); }
#define RW_TLOAD(X, nt) f16x8 X##wu0, X##wu1, X##au0, X##au1, X##vu; f16x4 X##cr, X##pr, X##ck, X##pk, X##cv, X##pv, X##vf; { \
            const unsigned n_ = (unsigned)(h * 64 + 16 * (nt) + tok), cb_ = (unsigned)(h * 64 + 16 * (nt) + 4 * fq); \
            X##wu0 = *(const f16x8*)(WUPT + (n_ * 64u + 8u * fq) * 2u); X##wu1 = *(const f16x8*)(WUPT + (n_ * 64u + 8u * fq + 32u) * 2u); \
            X##au0 = *(const f16x8*)(AUPT + (n_ * 64u + 8u * fq) * 2u); X##au1 = *(const f16x8*)(AUPT + (n_ * 64u + 8u * fq + 32u) * 2u); \
            if (l > 0) { X##vu = *(const f16x8*)(VUPT + (n_ * 32u + 8u * fq) * 2u); X##vf = *(const f16x4*)(VF + (m * (unsigned)RW_W + cb_) * 2u); } \
            X##cr = *(const f16x4*)(Ub + uo + ((unsigned)C_R + cb_) * 2u); X##pr = *(const f16x4*)(Ub + po + ((unsigned)C_R + cb_) * 2u); \
            X##ck = *(const f16x4*)(Ub + uo + ((unsigned)C_K + cb_) * 2u); X##pk = *(const f16x4*)(Ub + po + ((unsigned)C_K + cb_) * 2u); \
            X##cv = *(const f16x4*)(Ub + uo + ((unsigned)C_V + cb_) * 2u); X##pv = *(const f16x4*)(Ub + po + ((unsigned)C_V + cb_) * 2u); }
        f16x8 bW[2], bA[2], bVD;
#pragma unroll
        for (int s = 0; s < 2; ++s) { float xw[8], xa[8];
            const f32x4 mw0 = *(const LAS f32x4*)(prm + PRM_MU + C_WL + 8 * fq + 32 * s), mw1 = *(const LAS f32x4*)(prm + PRM_MU + C_WL + 8 * fq + 32 * s + 4);
            const f32x4 ma0 = *(const LAS f32x4*)(prm + PRM_MU + C_AL + 8 * fq + 32 * s), ma1 = *(const LAS f32x4*)(prm + PRM_MU + C_AL + 8 * fq + 32 * s + 4);
#pragma unroll
            for (int j = 0; j < 8; ++j) { const float cw_ = (float)cW[s][j], pw_ = hp ? (float)pW[s][j] : 0.f, ca_ = (float)cA[s][j], pa_ = hp ? (float)pA[s][j] : 0.f;
                xw[j] = fast_tanh(cw_ + (j < 4 ? mw0[j & 3] : mw1[j & 3]) * (pw_ - cw_)); xa[j] = ca_ + (j < 4 ? ma0[j & 3] : ma1[j & 3]) * (pa_ - ca_); }
            bW[s] = pack8(xw); bA[s] = pack8(xa); }
        if (l > 0) { float xv[8];
#pragma unroll
            for (int j = 0; j < 8; ++j) xv[j] = (float)vd0[j] + (hp ? (float)vd1[j] : 0.f);
            bVD = pack8(xv); }
        float ssq = 0.f, bon = 0.f;
        LAS unsigned char* rec = wl + tok * RWA_REC;
#define RW_TCOMP(X, nt) { const int cb = h * 64 + 16 * (nt) + 4 * fq, co = 16 * (nt) + 4 * fq; \
            f32x4 DWn = (f32x4){0.f, 0.f, 0.f, 0.f}, DAn = DWn, Gn = DWn; \
            DWn = __builtin_amdgcn_mfma_f32_16x16x32_f16(X##wu0, bW[0], DWn, 0, 0, 0); DWn = __builtin_amdgcn_mfma_f32_16x16x32_f16(X##wu1, bW[1], DWn, 0, 0, 0); \
            DAn = __builtin_amdgcn_mfma_f32_16x16x32_f16(X##au0, bA[0], DAn, 0, 0, 0); DAn = __builtin_amdgcn_mfma_f32_16x16x32_f16(X##au1, bA[1], DAn, 0, 0, 0); \
            if (l > 0) Gn = __builtin_amdgcn_mfma_f32_16x16x32_f16(X##vu, bVD, Gn, 0, 0, 0); \
            f16x4 wv, al, be, km, rr, vo; \
            _Pragma("unroll") for (int i = 0; i < 4; ++i) { const LAS float* pc = prm + cb + i; \
                const float cr_ = (float)X##cr[i], ck_ = (float)X##ck[i], cv_ = (float)X##cv[i]; \
                const float rs = cr_ + pc[PRM_MU + C_R] * ((hp ? (float)X##pr[i] : 0.f) - cr_), ks = ck_ + pc[PRM_MU + C_K] * ((hp ? (float)X##pk[i] : 0.f) - ck_), vs = cv_ + pc[PRM_MU + C_V] * ((hp ? (float)X##pv[i] : 0.f) - cv_); \
                wv[i] = (f16)__expf(-0.6065306597126334f * sigmoidf_(pc[PRM_W0] + DWn[i])); \
                const float aa = sigmoidf_(pc[PRM_A0] + DAn[i]); \
                float vv = vs; if (l > 0) vv = vs + ((float)X##vf[i] - vs) * sigmoidf_(pc[PRM_V0] + Gn[i]); \
                const float kk = ks * pc[PRM_KK]; ssq += kk * kk; \
                const float kmod = ks * (1.0f + (aa - 1.0f) * pc[PRM_KA]); \
                bon += rs * kmod * pc[PRM_RK]; \
                al[i] = (f16)(-kk); be[i] = (f16)(kk * aa); km[i] = (f16)kmod; rr[i] = (f16)rs; vo[i] = (f16)vv; \
                asm volatile("" ::: "memory"); } \
            *(LAS f16x4*)(rec + co * 2) = wv; \
            *(LAS f16x4*)(rec + 128 + co * 2) = al; *(LAS f16x4*)(rec + 256 + co * 2) = be; *(LAS f16x4*)(rec + 384 + co * 2) = km; *(LAS f16x4*)(rec + 512 + co * 2) = rr; \
            *(LAS f16x4*)(wl + RWA_VPL + tok * RWA_VROW + co * 2) = vo; \
            *(f16x4*)(VP + (m * (unsigned)RW_W + (unsigned)cb) * 2u) = vo; \
            if (l == 0) *(f16x4*)(VF + (m * (unsigned)RW_W + (unsigned)cb) * 2u) = vo; }
#pragma unroll 1
        for (int nt = 0; nt < 4; ++nt) { RW_TLOAD(T0, nt) RW_TCOMP(T0, nt) asm volatile("" ::: "memory"); }
#undef RW_TLOAD
#undef RW_TCOMP
        ssq += shfl_xor_f(ssq, 16); ssq += shfl_xor_f(ssq, 32);
        bon += shfl_xor_f(bon, 16); bon += shfl_xor_f(bon, 32);
        { const float inv = 1.0f / fmaxf(sqrtf(ssq), 1e-12f);
          if (fq == 0) { *(LAS float*)(wl + RWA_INV + tok * 4) = inv * inv; *(float*)((char*)BONG + (m * 8u + (unsigned)h) * 4u) = bon; } }
        const unsigned mb = (unsigned)(b * SEQ + c * CH + blk * 16);
        asm volatile("s_waitcnt lgkmcnt(0)" ::: "memory");
        u32x4 A[8];
#pragma unroll
        for (int g = 0; g < 8; ++g) A[g] = *(const LAS u32x4*)(wl + 128 + g * 16);
        float vv = (float)*(const LAS f16*)(wl + RWA_VPL + lane_ * 2); float inv2 = *(const LAS float*)(wl + RWA_INV);
#define RW_LDU(W4, B4, K4, R4, g) { W4 = *(const LAS u32x4*)(rc + (g) * 16); B4 = *(const LAS u32x4*)(rc + 256 + (g) * 16); K4 = *(const LAS u32x4*)(rc + 384 + (g) * 16); R4 = *(const LAS u32x4*)(rc + 512 + (g) * 16); }
#define RW_COMP(W4, B4, K4, R4, g) { float tP[8], tL[8]; \
            _Pragma("unroll") for (int j = 0; j < 8; ++j) tP[j] = MMIX(saP, B4, j); \
            _Pragma("unroll") for (int j = 0; j < 8; ++j) tL[j] = MMIX(saL, B4, j); \
            _Pragma("unroll") for (int j = 0; j < 8; ++j) tL[j] = FMIX(vv, K4, j, tL[j]); \
            _Pragma("unroll") for (int j = 0; j < 8; ++j) P[8 * (g) + j] = FMIX(P[8 * (g) + j], W4, j, tP[j]); \
            _Pragma("unroll") for (int j = 0; j < 8; ++j) L[8 * (g) + j] = FMIX(L[8 * (g) + j], W4, j, tL[j]); \
            _Pragma("unroll") for (int j = 0; j < 8; ++j) qa[j] = FMIX(P[8 * (g) + j], R4, j, qa[j]); \
            _Pragma("unroll") for (int j = 0; j < 8; ++j) ya[j] = FMIX(L[8 * (g) + j], R4, j, ya[j]); }
#pragma unroll 1
        for (int t2 = 0; t2 < 16; ++t2) {
            const LAS unsigned char* rc = wl + t2 * RWA_REC;
            u32x4 we, be, ke, re, wo, bo, ko, ro;
            RW_LDU(we, be, ke, re, 0)
            float sP[8], sL[8];
#pragma unroll
            for (int j = 0; j < 8; ++j) { sP[j] = 0.f; sL[j] = 0.f; }
#pragma unroll
            for (int g = 0; g < 8; ++g) {
#pragma unroll
                for (int j = 0; j < 8; ++j) sP[j] = FMIX(P[8 * g + j], A[g], j, sP[j]);
#pragma unroll
                for (int j = 0; j < 8; ++j) sL[j] = FMIX(L[8 * g + j], A[g], j, sL[j]); }
            const float saP = inv2 * (((sP[0] + sP[1]) + (sP[2] + sP[3])) + ((sP[4] + sP[5]) + (sP[6] + sP[7]))), saL = inv2 * (((sL[0] + sL[1]) + (sL[2] + sL[3])) + ((sL[4] + sL[5]) + (sL[6] + sL[7])));
            float qa[8], ya[8];
#pragma unroll
            for (int j = 0; j < 8; ++j) { qa[j] = 0.f; ya[j] = 0.f; }
            RW_LDU(wo, bo, ko, ro, 1) RW_COMP(we, be, ke, re, 0)
            RW_LDU(we, be, ke, re, 2) RW_COMP(wo, bo, ko, ro, 1)
            RW_LDU(wo, bo, ko, ro, 3) RW_COMP(we, be, ke, re, 2)
            RW_LDU(we, be, ke, re, 4) RW_COMP(wo, bo, ko, ro, 3)
            RW_LDU(wo, bo, ko, ro, 5) RW_COMP(we, be, ke, re, 4)
            RW_LDU(we, be, ke, re, 6) RW_COMP(wo, bo, ko, ro, 5)
            RW_LDU(wo, bo, ko, ro, 7) RW_COMP(we, be, ke, re, 6)
            const float vvn = (float)*(const LAS f16*)(wl + RWA_VPL + ((t2 + 1) & 15) * RWA_VROW + lane_ * 2); const float inv2n = *(const LAS float*)(wl + RWA_INV + ((t2 + 1) & 15) * 4);
#pragma unroll
            for (int g = 0; g < 8; ++g) A[g] = *(const LAS u32x4*)(rc + RWA_REC + 128 + g * 16);
            RW_COMP(wo, bo, ko, ro, 7)
            vv = vvn; inv2 = inv2n;
            *(f16*)((char*)MIX + ((mb + t2) * (unsigned)DM + (unsigned)(h * 64 + lane_)) * 2u) = (f16)(((ya[0] + ya[1]) + (ya[2] + ya[3])) + ((ya[4] + ya[5]) + (ya[6] + ya[7])));
            *(f16*)((char*)QT + ((mb + t2) * (unsigned)RW_W + (unsigned)(h * 64 + lane_)) * 2u) = (f16)(((qa[0] + qa[1]) + (qa[2] + qa[3])) + ((qa[4] + qa[5]) + (qa[6] + qa[7])));
        }
#undef RW_LDU
#undef RW_COMP
    }
    store_row64_f16(RL + (((size_t)bh * NCH + c) * 64 + lane) * 64, L);
    f16* pt = PT + ((size_t)bh * NCH + c) * 4096;
#pragma unroll
    for (int k = 0; k < 64; ++k) pt[k * 64 + lane] = (f16)P[k];
}

constexpr int HGA_REC = 384, HGA_V = 16 * HGA_REC, HGA_HEAD = HGA_V + 2048, HGA_BYTES = 2 * HGA_HEAD;
template <int NH>
__device__ __forceinline__ void hgrn_waveA(const Args& a, int l, int b, int c, int h0, LAS unsigned char* wl) {
    char* U = (char*)(a.ws + WS_U); char* MIX = (char*)(a.ws + WS_MIX); f16* HL = (f16*)(a.ws + WS_HL); float* DC = (float*)(a.ws + WS_DC);
    const float* lbr = a.in[16];
    float S[NH][64]; float dpr[NH];
#pragma unroll
    for (int j = 0; j < NH; ++j) { dpr[j] = 1.f;
#pragma unroll
        for (int k = 0; k < 64; ++k) S[j][k] = 0.f; }
#pragma unroll 1
    for (int blk = 0; blk < 4; ++blk) {
        const int lane_ = lane_now();
        const unsigned mb = (unsigned)(b * SEQ + c * CH + blk * 16);
        {
            f16 fr[NH][16], qr[NH][16], vr[NH][16];
#pragma unroll
            for (int j = 0; j < NH; ++j)
#pragma unroll
                for (int tk = 0; tk < 16; ++tk) { const char* ur = U + (mb + tk) * (unsigned)(NU * 2) + (unsigned)((h0 + j) * 64 + lane_) * 2u; fr[j][tk] = *(const f16*)(ur + C_HGF * 2); qr[j][tk] = *(const f16*)(ur + C_HGQ * 2); vr[j][tk] = *(const f16*)(ur + C_HGI * 2); }
#pragma unroll
            for (int j = 0; j < NH; ++j) { const int col = (h0 + j) * 64 + lane_;
                const float lb = (l == 0) ? 0.f : sigmoidf_(lbr[384 + col] - lbr[col]);
                float dp = dpr[j];
#pragma unroll
                for (int tk = 0; tk < 16; ++tk) {
                    const float f = lb + (1.0f - lb) * sigmoidf_((float)fr[j][tk]);
                    LAS unsigned char* rec = wl + j * HGA_HEAD + tk * HGA_REC;
                    *(LAS f16*)(rec + lane_ * 2) = (f16)f; *(LAS f16*)(rec + 128 + lane_ * 2) = (f16)(1.0f - f); *(LAS f16*)(rec + 256 + lane_ * 2) = qr[j][tk];
                    *(LAS f16*)(wl + j * HGA_HEAD + HGA_V + tk * 128 + lane_ * 2) = vr[j][tk];
                    dp *= f;
                    *(f16*)(U + (mb + tk) * (unsigned)(NU * 2) + (unsigned)(C_HGQ + col) * 2u) = (f16)((float)qr[j][tk] * dp);
                }
                dpr[j] = dp; }
        }
        asm volatile("s_waitcnt lgkmcnt(0)" ::: "memory");
#define HG_LD(F4, K4, Q4, rcp, g) { F4 = *(const LAS u32x4*)((rcp) + (g) * 16); K4 = *(const LAS u32x4*)((rcp) + 128 + (g) * 16); Q4 = *(const LAS u32x4*)((rcp) + 256 + (g) * 16); }
#define HG_COMP(Sx, vi, F4, K4, Q4, g) { float tt[8]; \
            _Pragma("unroll") for (int jj = 0; jj < 8; ++jj) tt[jj] = MMIX(vi, K4, jj); \
            _Pragma("unroll") for (int jj = 0; jj < 8; ++jj) Sx[8 * (g) + jj] = FMIX(Sx[8 * (g) + jj], F4, jj, tt[jj]); \
            _Pragma("unroll") for (int jj = 0; jj < 8; ++jj) oa[jj] = FMIX(Sx[8 * (g) + jj], Q4, jj, oa[jj]); }
#define HG_HEAD(Sx, vi, rcp, rcn, oo) { float oa[8]; _Pragma("unroll") for (int jj = 0; jj < 8; ++jj) oa[jj] = 0.f; \
            HG_LD(f4o, k4o, q4o, rcp, 1) HG_COMP(Sx, vi, f4e, k4e, q4e, 0) \
            HG_LD(f4e, k4e, q4e, rcp, 2) HG_COMP(Sx, vi, f4o, k4o, q4o, 1) \
            HG_LD(f4o, k4o, q4o, rcp, 3) HG_COMP(Sx, vi, f4e, k4e, q4e, 2) \
            HG_LD(f4e, k4e, q4e, rcp, 4) HG_COMP(Sx, vi, f4o, k4o, q4o, 3) \
            HG_LD(f4o, k4o, q4o, rcp, 5) HG_COMP(Sx, vi, f4e, k4e, q4e, 4) \
            HG_LD(f4e, k4e, q4e, rcp, 6) HG_COMP(Sx, vi, f4o, k4o, q4o, 5) \
            HG_LD(f4o, k4o, q4o, rcp, 7) HG_COMP(Sx, vi, f4e, k4e, q4e, 6) \
            HG_LD(f4e, k4e, q4e, rcn, 0) HG_COMP(Sx, vi, f4o, k4o, q4o, 7) \
            oo = ((oa[0] + oa[1]) + (oa[2] + oa[3])) + ((oa[4] + oa[5]) + (oa[6] + oa[7])); }
        u32x4 f4e, k4e, q4e, f4o, k4o, q4o;
        HG_LD(f4e, k4e, q4e, wl, 0)
        f16 vh[NH], vn[NH];
#pragma unroll
        for (int j = 0; j < NH; ++j) vh[j] = *(const LAS f16*)(wl + j * HGA_HEAD + HGA_V + lane_ * 2);
#pragma unroll 1
        for (int t2 = 0; t2 < 16; ++t2) {
            const LAS unsigned char* rc = wl + t2 * HGA_REC;
#pragma unroll
            for (int j = 0; j < NH; ++j) vn[j] = *(const LAS f16*)(wl + j * HGA_HEAD + HGA_V + ((t2 + 1) & 15) * 128 + lane_ * 2);
            float oo[NH];
#pragma unroll
            for (int j = 0; j < NH; ++j) { const float vi = (float)vh[j];
                const LAS unsigned char* rcp = rc + j * HGA_HEAD; const LAS unsigned char* rcn = (j + 1 < NH) ? rc + (j + 1) * HGA_HEAD : rc + HGA_REC;
                HG_HEAD(S[j], vi, rcp, rcn, oo[j]) }
            char* mo = MIX + ((mb + t2) * (unsigned)DM + (unsigned)(384 + h0 * 64 + lane_)) * 2u;
#pragma unroll
            for (int j = 0; j < NH; ++j) { *(f16*)(mo + 128 * j) = (f16)oo[j]; vh[j] = vn[j]; }
        }
#undef HG_LD
#undef HG_COMP
#undef HG_HEAD
    }
    const int lane2 = lane_now();
#pragma unroll
    for (int j = 0; j < NH; ++j) { const int bh = b * 6 + h0 + j; store_row64_f16(HL + (((size_t)bh * NCH + c) * 64 + lane2) * 64, S[j]);
        DC[((size_t)bh * NCH + c) * 64 + lane2] = dpr[j]; }
}
__device__ __forceinline__ void phaseA(const Args& a, int l, int task, LAS unsigned char* lds, int tid) {
    asm volatile("" : "+v"(tid));
    const int lane = tid & 63, wave = __builtin_amdgcn_readfirstlane(tid >> 6);
    const int b = task / NCH, c = task % NCH;
    const f16* U = (const f16*)(a.ws + WS_U); f16* MIX = (f16*)(a.ws + WS_MIX); f16* VF = (f16*)(a.ws + WS_VF); f16* VP = (f16*)(a.ws + WS_VP);
    f16* QT = (f16*)(a.ws + WS_QT); f16* PT = (f16*)(a.ws + WS_PT); f16* RL = (f16*)(a.ws + WS_RL); float* BONG = (float*)(a.ws + WS_BON);
    {
        LAS float* prm = (LAS float*)(lds + PRM_OFF);
        for (int i = tid; i < PRM_FLOATS; i += NT) { float v;
            if (i < 1280) v = a.in[3][l * RW_SHIFT + i];
            else { const int q = (i - 1280) / 384, cc = (i - 1280) % 384;
                v = (q == 0) ? a.in[4][l * RW_W + cc] : (q == 1) ? a.in[6][l * RW_W + cc] : (q == 2) ? a.in[11][l * RW_W + cc] : (q == 3) ? a.in[12][l * RW_W + cc] : (q == 4) ? a.in[13][l * RW_W + cc] : a.in[8][cc]; }
            prm[i] = v; }
        __syncthreads();
        if (wave < RW_H) rwkv_waveA(a, l, b, c, wave, lds + wave * RWA_BYTES, prm, lane);
        else { LAS unsigned char* hw = lds + RW_H * RWA_BYTES + (wave - RW_H) * HGA_BYTES;
               hgrn_waveA<2>(a, l, b, c, 2 * (wave - RW_H), hw); hgrn_waveA<1>(a, l, b, c, 4 + (wave - RW_H), hw); }
        __syncthreads();
    }
    {
        const int ln = lane_now(); const int tid2 = wave * 64 + ln;
        const char* Ub = (const char*)(a.ws + WS_U); char* MIXb = (char*)(a.ws + WS_MIX); char* CA = (char*)(a.ws + WS_CA); float* LA = (float*)(a.ws + WS_LA); float* LH = (float*)(a.ws + WS_LH);
        const float* cw = a.in[18] + l * 4 * 256; const float* cb = a.in[19] + l * 256;
        const float* ba = a.in[21] + l * 256; const float* bx = a.in[23] + l * 256; const float* lam = a.in[24] + l * 256;
        const char* WAT = (const char*)(a.ws + WS_WAT) + (size_t)l * 4 * 8192; const char* WXT = (const char*)(a.ws + WS_WXT) + (size_t)l * 4 * 8192;
        LAS unsigned char* Y = lds;
        LAS float* AGG = (LAS float*)(lds + 34816);
        const unsigned mrow0 = (unsigned)(b * SEQ + c * CH);
#pragma unroll
        for (int it = 0; it < 4; ++it) { const int item = tid2 + 512 * it, tok = item >> 5, co = item & 31; const int t = c * CH + tok;
            const f32x4 b0 = *(const f32x4*)(cb + 8 * co), b1 = *(const f32x4*)(cb + 8 * co + 4);
            float y[8] = {b0[0], b0[1], b0[2], b0[3], b1[0], b1[1], b1[2], b1[3]};
#pragma unroll
            for (int jj = 0; jj < 4; ++jj) { const int ts = t - 3 + jj;
                if (ts >= 0) { const f16x8 x8 = *(const f16x8*)(Ub + ((mrow0 + (unsigned)(tok - 3 + jj)) * (unsigned)NU + (unsigned)(C_LRUX + 8 * co)) * 2u);
                    const f32x4 w0 = *(const f32x4*)(cw + jj * 256 + 8 * co), w1 = *(const f32x4*)(cw + jj * 256 + 8 * co + 4);
#pragma unroll
                    for (int i = 0; i < 8; ++i) y[i] += (i < 4 ? w0[i & 3] : w1[i & 3]) * (float)x8[i]; } }
            *(LAS f16x8*)(Y + tok * 528 + co * 16) = pack8(y); }
        __syncthreads();
        const int tl = ln & 15, fq = ln >> 4, tt = wave & 3, gp = wave >> 2;
        float Asc[32], Hsc[32];
#pragma unroll
        for (int gg = 0; gg < 2; ++gg) { const int g = 2 * gp + gg;
            f16x8 by[2];
#pragma unroll
            for (int s2 = 0; s2 < 2; ++s2) by[s2] = *(const LAS f16x8*)(Y + (16 * tt + tl) * 528 + (g * 64 + 8 * fq + 32 * s2) * 2);
#pragma unroll
            for (int nt = 0; nt < 4; ++nt) {
                f32x4 ra = (f32x4){0.f, 0.f, 0.f, 0.f}, rx = ra;
#pragma unroll
                for (int s2 = 0; s2 < 2; ++s2) { const unsigned wo = (unsigned)(g * 8192 + ((16 * nt + tl) * 64 + 8 * fq + 32 * s2) * 2);
                    ra = __builtin_amdgcn_mfma_f32_16x16x32_f16(*(const f16x8*)(WAT + wo), by[s2], ra, 0, 0, 0);
                    rx = __builtin_amdgcn_mfma_f32_16x16x32_f16(*(const f16x8*)(WXT + wo), by[s2], rx, 0, 0, 0); }
                const int ch0 = g * 64 + 16 * nt + 4 * fq;
                const f32x4 ba4 = *(const f32x4*)(ba + ch0), bx4 = *(const f32x4*)(bx + ch0), lm4 = *(const f32x4*)(lam + ch0);
                const f16x4 y4 = *(const LAS f16x4*)(Y + (16 * tt + tl) * 528 + ch0 * 2);
#pragma unroll
                for (int i = 0; i < 4; ++i) {
                    const float r = sigmoidf_(ra[i] + ba4[i]), ig = sigmoidf_(rx[i] + bx4[i]);
                    const float la = -8.0f * r * log1pf(__expf(-lm4[i]));
                    float av = __expf(la), uv = sqrtf(-expm1f(2.0f * la)) * (ig * (float)y4[i]);
#define LRU_SCAN(d) { const float ap = __builtin_bit_cast(float, __builtin_amdgcn_update_dpp(0x3f800000, __builtin_bit_cast(int, av), 0x110 + (d), 0xf, 0xf, false)); \
                      const float up = __builtin_bit_cast(float, __builtin_amdgcn_update_dpp(0, __builtin_bit_cast(int, uv), 0x110 + (d), 0xf, 0xf, false)); \
                      uv = av * up + uv; av = av * ap; }
                    LRU_SCAN(1) LRU_SCAN(2) LRU_SCAN(4) LRU_SCAN(8)
#undef LRU_SCAN
                    Asc[gg * 16 + nt * 4 + i] = av; Hsc[gg * 16 + nt * 4 + i] = uv;
                    if (tl == 15) { AGG[(tt * 256 + ch0 + i) * 2] = av; AGG[(tt * 256 + ch0 + i) * 2 + 1] = uv; }
                }
            }
        }
        __syncthreads();
        const unsigned m = mrow0 + (unsigned)(16 * tt + tl);
#pragma unroll
        for (int gg = 0; gg < 2; ++gg)
#pragma unroll
            for (int nt = 0; nt < 4; ++nt) { const int ch0 = (2 * gp + gg) * 64 + 16 * nt + 4 * fq;
                f16x4 ho, co;
#pragma unroll
                for (int i = 0; i < 4; ++i) { float cy = 0.f, cpv = 1.f;
#pragma unroll
                    for (int t3 = 0; t3 < 3; ++t3) if (t3 < tt) { const float A3 = AGG[(t3 * 256 + ch0 + i) * 2], H3 = AGG[(t3 * 256 + ch0 + i) * 2 + 1]; cy = A3 * cy + H3; cpv *= A3; }
                    const float hl = Hsc[gg * 16 + nt * 4 + i] + Asc[gg * 16 + nt * 4 + i] * cy, ca = Asc[gg * 16 + nt * 4 + i] * cpv;
                    ho[i] = (f16)hl; co[i] = (f16)ca;
                    if (tt == 3 && tl == 15) { LA[((size_t)b * NCH + c) * 256 + ch0 + i] = ca; LH[((size_t)b * NCH + c) * 256 + ch0 + i] = hl; } }
                *(f16x4*)(MIXb + (m * (unsigned)DM + 768u + (unsigned)ch0) * 2u) = ho; *(f16x4*)(CA + (m * 256u + (unsigned)ch0) * 2u) = co; }
    }
}


constexpr int PB_SLOT = 16384, PB_NS = 8, PB_AHEAD = 6, NGRP = NCH / 8;
#define ARENA(ws, off) ((char*)(ws) + WS_U + (size_t)((off) >> 11) * (size_t)(NU * 2) + (size_t)((off) & 2047))
constexpr size_t AR_PGT = 0, AR_LG = 2u << 20, AR_SG = 4u << 20;
#define PB_SWZ(row, o) ((row) * 128 + (((((o) >> 4) ^ ((row) & 7)) << 4) | ((o) & 15)))
template <bool ADD_L>
__device__ __forceinline__ void pb_step(f32x4 (&Sacc)[4], const LAS unsigned char* sl, int xrow, int vl, int fq) {
    f16x8 Bhi[2], Blo[2];
#pragma unroll
    for (int mt = 0; mt < 4; ++mt)
#pragma unroll
        for (int i = 0; i < 4; ++i) { const f16 hi = (f16)Sacc[mt][i]; const f16 lo = (f16)(Sacc[mt][i] - (float)hi); Bhi[mt >> 1][4 * (mt & 1) + i] = hi; Blo[mt >> 1][4 * (mt & 1) + i] = lo; }
#pragma unroll
    for (int mt = 0; mt < 4; ++mt) {
        f32x4 d = (f32x4){0.f, 0.f, 0.f, 0.f};
        if (ADD_L) { const f16x4 l4 = *(const LAS f16x4*)(sl + 8192 + PB_SWZ(xrow, 32 * mt + 8 * fq)); d = (f32x4){(float)l4[0], (float)l4[1], (float)l4[2], (float)l4[3]}; }
#pragma unroll
        for (int s = 0; s < 2; ++s) { const u32x2 a0 = *(const LAS u32x2*)(sl + PB_SWZ(16 * mt + vl, 64 * s + 8 * fq)), a1 = *(const LAS u32x2*)(sl + PB_SWZ(16 * mt + vl, 64 * s + 32 + 8 * fq));
            u32x4 aw; aw.x = a0.x; aw.y = a0.y; aw.z = a1.x; aw.w = a1.y; const f16x8 af = __builtin_bit_cast(f16x8, aw);
            d = __builtin_amdgcn_mfma_f32_16x16x32_f16(af, Bhi[s], d, 0, 0, 0); d = __builtin_amdgcn_mfma_f32_16x16x32_f16(af, Blo[s], d, 0, 0, 0); }
        Sacc[mt] = d; }
}
__device__ __forceinline__ void pb_stage8(const Args& a, LAS unsigned char* lds, int bh, int c0, int wave, int lane) {
    const char* PT = (const char*)(a.ws + WS_PT) + ((size_t)bh * NCH + c0) * 8192; const char* RL = (const char*)(a.ws + WS_RL) + ((size_t)bh * NCH + c0) * 8192;
    const int lq = wave * 64 + lane, lrow = lq >> 3, lpp = lq & 7; const unsigned lsrc = (unsigned)(lrow * 128 + ((lpp ^ (lrow & 7)) << 4));
#pragma unroll
    for (int sl = 0; sl < 8; ++sl) { const unsigned so = (unsigned)(sl * PB_SLOT + wave * 1024); const size_t go = (size_t)sl * 8192 + lsrc;
        __builtin_amdgcn_global_load_lds((const unsigned*)(PT + go), (LAS unsigned*)(lds + so), 16, 0, 0);
        __builtin_amdgcn_global_load_lds((const unsigned*)(RL + go), (LAS unsigned*)(lds + so + 8192), 16, 0, 0); }
    asm volatile("s_waitcnt vmcnt(0)" ::: "memory");
    __builtin_amdgcn_s_barrier();
}
__device__ __forceinline__ void phaseB1(const Args& a, LAS unsigned char* lds, int tid) {
    asm volatile("" : "+v"(tid));
    const int lane = tid & 63, wave = __builtin_amdgcn_readfirstlane(tid >> 6);
    for (int task = blockIdx.x; task < 12 * NGRP; task += gridDim.x) {
        const int bh = task / NGRP, g = task % NGRP, c0 = 8 * g;
        pb_stage8(a, lds, bh, c0, wave, lane);
        const int vt = wave & 3, vl = lane & 15, fq = lane >> 4, xr = 16 * vt + vl;
        f32x4 X[4];
        if (wave < 4) {
#pragma unroll
            for (int mt = 0; mt < 4; ++mt) { const f16x4 l4 = *(const LAS f16x4*)(lds + 8192 + PB_SWZ(xr, 32 * mt + 8 * fq)); X[mt] = (f32x4){(float)l4[0], (float)l4[1], (float)l4[2], (float)l4[3]}; }
#pragma unroll 1
            for (int s = 1; s < 8; ++s) pb_step<true>(X, lds + s * PB_SLOT, xr, vl, fq);
#pragma unroll
            for (int mt = 0; mt < 4; ++mt) { f16x4 o;
#pragma unroll
                for (int i = 0; i < 4; ++i) o[i] = (f16)X[mt][i];
                *(f16x4*)ARENA(a.ws, AR_LG + ((size_t)bh * NGRP + g) * 8192 + (size_t)((xr * 64 + 16 * mt + 4 * fq) * 2)) = o; }
        } else {
#pragma unroll
            for (int mt = 0; mt < 4; ++mt)
#pragma unroll
                for (int i = 0; i < 4; ++i) X[mt][i] = (16 * mt + 4 * fq + i == xr) ? 1.f : 0.f;
#pragma unroll 1
            for (int s = 0; s < 8; ++s) pb_step<false>(X, lds + s * PB_SLOT, xr, vl, fq);
#pragma unroll
            for (int mt = 0; mt < 4; ++mt)
#pragma unroll
                for (int i = 0; i < 4; ++i) *(f16*)ARENA(a.ws, AR_PGT + ((size_t)bh * NGRP + g) * 8192 + (size_t)(((16 * mt + 4 * fq + i) * 64 + xr) * 2)) = (f16)X[mt][i];
        }
        asm volatile("s_waitcnt vmcnt(0) lgkmcnt(0)" ::: "memory");
        __builtin_amdgcn_s_barrier();
    }
}
__device__ __forceinline__ void phaseB3(const Args& a, LAS unsigned char* lds, int tid) {
    asm volatile("" : "+v"(tid));
    const int lane = tid & 63, wave = __builtin_amdgcn_readfirstlane(tid >> 6);
    for (int task = blockIdx.x; task < 12 * NGRP; task += gridDim.x) {
        const int bh = task / NGRP, g = task % NGRP, c0 = 8 * g;
        pb_stage8(a, lds, bh, c0, wave, lane);
        if (wave < 4) {
            const int vt = wave, vl = lane & 15, fq = lane >> 4, xr = 16 * vt + vl;
            char* RL = (char*)(a.ws + WS_RL) + ((size_t)bh * NCH + c0) * 8192;
            f32x4 X[4];
#pragma unroll
            for (int mt = 0; mt < 4; ++mt) { const f16x4 s4 = *(const f16x4*)ARENA(a.ws, AR_SG + ((size_t)bh * NGRP + g) * 8192 + (size_t)((xr * 64 + 16 * mt + 4 * fq) * 2)); X[mt] = (f32x4){(float)s4[0], (float)s4[1], (float)s4[2], (float)s4[3]}; }
#pragma unroll 1
            for (int s = 0; s < 8; ++s) {
#pragma unroll
                for (int mt = 0; mt < 4; ++mt) { f16x4 o;
#pragma unroll
                    for (int i = 0; i < 4; ++i) o[i] = (f16)X[mt][i];
                    *(f16x4*)(RL + (size_t)s * 8192 + (xr * 64 + 16 * mt + 4 * fq) * 2) = o; }
                if (s < 7) pb_step<true>(X, lds + s * PB_SLOT, xr, vl, fq);
            }
        }
        asm volatile("s_waitcnt vmcnt(0) lgkmcnt(0)" ::: "memory");
        __builtin_amdgcn_s_barrier();
    }
}
__device__ __forceinline__ void phaseB(const Args& a, LAS unsigned char* lds, int tid) {
    asm volatile("" : "+v"(tid));
    const int lane = tid & 63, wave = __builtin_amdgcn_readfirstlane(tid >> 6);
    const int bx = blockIdx.x;
    if (bx < 12) {
        const int bh = bx;
        const bool loader = wave >= 4;
        const int vt = wave & 3, vl = lane & 15, fq = lane >> 4, v = 16 * vt + vl;
        const int lq = (wave - 4) * 64 + lane, lrow = lq >> 3, lpp = lq & 7;
        const unsigned lsrc = (unsigned)(lrow * 128 + ((lpp ^ (lrow & 7)) << 4));
#define PB_ISSUE(cc) { const unsigned so = (unsigned)(((cc) & (PB_NS - 1)) * PB_SLOT) + (unsigned)((wave - 4) * 1024); const size_t go = ((size_t)bh * NGRP + (cc)) * 8192 + lsrc; \
            __builtin_amdgcn_global_load_lds((const unsigned*)ARENA(a.ws, AR_PGT + go), (LAS unsigned*)(lds + so), 16, 0, 0); \
            __builtin_amdgcn_global_load_lds((const unsigned*)ARENA(a.ws, AR_PGT + go + 4096), (LAS unsigned*)(lds + so + 4096), 16, 0, 0); \
            __builtin_amdgcn_global_load_lds((const unsigned*)ARENA(a.ws, AR_LG + go), (LAS unsigned*)(lds + so + 8192), 16, 0, 0); \
            __builtin_amdgcn_global_load_lds((const unsigned*)ARENA(a.ws, AR_LG + go + 4096), (LAS unsigned*)(lds + so + 12288), 16, 0, 0); }
        if (loader) {
#pragma unroll
            for (int cc = 0; cc < PB_AHEAD; ++cc) PB_ISSUE(cc)
            asm volatile("s_waitcnt vmcnt(20)" ::: "memory");
        }
        __builtin_amdgcn_s_barrier();
        f32x4 Sacc[4];
#pragma unroll
        for (int mt = 0; mt < 4; ++mt) Sacc[mt] = (f32x4){0.f, 0.f, 0.f, 0.f};
#pragma unroll 1
        for (int c = 0; c < NGRP; ++c) {
            if (loader) {
                if (c + PB_AHEAD < NGRP) { PB_ISSUE(c + PB_AHEAD) asm volatile("s_waitcnt vmcnt(20)" ::: "memory"); }
                else asm volatile("s_waitcnt vmcnt(0)" ::: "memory");
            } else {
#pragma unroll
                for (int mt = 0; mt < 4; ++mt) { f16x4 o;
#pragma unroll
                    for (int i = 0; i < 4; ++i) o[i] = (f16)Sacc[mt][i];
                    *(f16x4*)ARENA(a.ws, AR_SG + ((size_t)bh * NGRP + c) * 8192 + (size_t)((v * 64 + 16 * mt + 4 * fq) * 2)) = o; }
                pb_step<true>(Sacc, lds + (c & (PB_NS - 1)) * PB_SLOT, v, vl, fq);
                asm volatile("s_waitcnt lgkmcnt(0)" ::: "memory");
            }
            __builtin_amdgcn_s_barrier();
        }
#undef PB_ISSUE
        asm volatile("s_waitcnt vmcnt(0)" ::: "memory");
    } else if (bx < 12 + 96) {
        const int idx = (bx - 12) * NT + tid; const int bh = idx >> 12, e = idx & 4095, k = e & 63;
        f16* HL = (f16*)(a.ws + WS_HL); const float* DC = (const float*)(a.ws + WS_DC);
        float s = 0.f;
        for (int c0 = 0; c0 < NCH; c0 += 8) { float Lc[8], d[8];
#pragma unroll
            for (int j = 0; j < 8; ++j) { Lc[j] = (float)HL[((size_t)bh * NCH + c0 + j) * 4096 + e]; d[j] = DC[((size_t)bh * NCH + c0 + j) * 64 + k]; }
#pragma unroll
            for (int j = 0; j < 8; ++j) { HL[((size_t)bh * NCH + c0 + j) * 4096 + e] = (f16)s; s = d[j] * s + Lc[j]; } }
    } else if (bx == 12 + 96) {
        const int bb = tid >> 8, ch = tid & 255; const float* LA = (const float*)(a.ws + WS_LA); float* LH = (float*)(a.ws + WS_LH);
        float cy = 0.f;
        for (int c0 = 0; c0 < NCH; c0 += 8) { float A[8], H[8];
#pragma unroll
            for (int j = 0; j < 8; ++j) { const size_t o = ((size_t)bb * NCH + c0 + j) * 256 + ch; A[j] = LA[o]; H[j] = LH[o]; }
#pragma unroll
            for (int j = 0; j < 8; ++j) { const size_t o = ((size_t)bb * NCH + c0 + j) * 256 + ch; LH[o] = cy; cy = A[j] * cy + H[j]; } }
    }
}

__device__ __forceinline__ void phaseC(const Args& a, int l, int task, LAS unsigned char* lds, int tid) {
    asm volatile("" : "+v"(tid));
    const int lane = tid & 63, wave = __builtin_amdgcn_readfirstlane(tid >> 6);
    const int b = task / NCH, c = task % NCH;
    const int tl = lane & 15, fq = lane >> 4, tt = wave & 3, hg = wave >> 2;
    const unsigned m = (unsigned)(b * SEQ + c * CH + 16 * tt + tl);
    const char* U = (const char*)(a.ws + WS_U); char* MIX = (char*)(a.ws + WS_MIX); const char* VP = (const char*)(a.ws + WS_VP);
    const char* QT = (const char*)(a.ws + WS_QT); const char* RL = (const char*)(a.ws + WS_RL); const char* HL = (const char*)(a.ws + WS_HL); const float* BONG = (const float*)(a.ws + WS_BON);
    const unsigned uo = m * (unsigned)(NU * 2);
#pragma unroll
    for (int hh = 0; hh < 3; ++hh) {
        const int h = 3 * hg + hh; const int bh = b * RW_H + h;
        const char* sl = RL + ((size_t)bh * NCH + c) * 8192;
        f16x8 bq[2];
#pragma unroll
        for (int s = 0; s < 2; ++s) bq[s] = *(const f16x8*)(QT + (m * (unsigned)RW_W + (unsigned)(h * 64 + 8 * fq + 32 * s)) * 2u);
        f32x4 D[4];
#pragma unroll
        for (int vt = 0; vt < 4; ++vt) { const f16x4 yl = *(const f16x4*)(MIX + (m * (unsigned)DM + (unsigned)(h * 64 + 16 * vt + 4 * fq)) * 2u);
            f32x4 d = (f32x4){(float)yl[0], (float)yl[1], (float)yl[2], (float)yl[3]};
#pragma unroll
            for (int s = 0; s < 2; ++s) d = __builtin_amdgcn_mfma_f32_16x16x32_f16(*(const f16x8*)(sl + ((16 * vt + tl) * 64 + 8 * fq + 32 * s) * 2), bq[s], d, 0, 0, 0);
            D[vt] = d; }
        float sm = 0.f;
#pragma unroll
        for (int vt = 0; vt < 4; ++vt) sm += (D[vt][0] + D[vt][1]) + (D[vt][2] + D[vt][3]);
        sm += shfl_xor_f(sm, 16); sm += shfl_xor_f(sm, 32);
        const float mean = sm * (1.0f / 64.0f); float vr = 0.f;
#pragma unroll
        for (int vt = 0; vt < 4; ++vt)
#pragma unroll
            for (int i = 0; i < 4; ++i) { const float d = D[vt][i] - mean; vr += d * d; }
        vr += shfl_xor_f(vr, 16); vr += shfl_xor_f(vr, 32);
        const float rstd = 1.0f / sqrtf(vr * (1.0f / 64.0f) + 64e-5f);
        const float bon = BONG[m * 8u + (unsigned)h];
        const float* ln_w = a.in[14] + l * RW_W; const float* ln_b = a.in[15] + l * RW_W;
#pragma unroll
        for (int vt = 0; vt < 4; ++vt) { const unsigned col = (unsigned)(h * 64 + 16 * vt + 4 * fq);
            const f16x4 vp = *(const f16x4*)(VP + (m * (unsigned)RW_W + col) * 2u), z4 = *(const f16x4*)(U + uo + ((unsigned)C_RWZ + col) * 2u);
            const f32x4 lw = *(const f32x4*)(ln_w + col), lb = *(const f32x4*)(ln_b + col);
            f16x4 o;
#pragma unroll
            for (int i = 0; i < 4; ++i) o[i] = (f16)(((D[vt][i] - mean) * rstd * lw[i] + lb[i] + bon * (float)vp[i]) * siluf_((float)z4[i]));
            *(f16x4*)(MIX + (m * (unsigned)DM + col) * 2u) = o; }
    }
#pragma unroll
    for (int hh = 0; hh < 3; ++hh) {
        const int h = 3 * hg + hh; const int bh = b * 6 + h;
        const char* sl = HL + ((size_t)bh * NCH + c) * 8192;
        f16x8 bq[2];
#pragma unroll
        for (int s = 0; s < 2; ++s) bq[s] = *(const f16x8*)(U + uo + (unsigned)(C_HGQ + h * 64 + 8 * fq + 32 * s) * 2u);
        f32x4 D[4];
#pragma unroll
        for (int vt = 0; vt < 4; ++vt) { const f16x4 ol = *(const f16x4*)(MIX + (m * (unsigned)DM + (unsigned)(384 + h * 64 + 16 * vt + 4 * fq)) * 2u);
            f32x4 d = (f32x4){(float)ol[0], (float)ol[1], (float)ol[2], (float)ol[3]};
#pragma unroll
            for (int s = 0; s < 2; ++s) d = __builtin_amdgcn_mfma_f32_16x16x32_f16(*(const f16x8*)(sl + ((16 * vt + tl) * 64 + 8 * fq + 32 * s) * 2), bq[s], d, 0, 0, 0);
            D[vt] = d; }
        float ss = 0.f;
#pragma unroll
        for (int vt = 0; vt < 4; ++vt) ss += (D[vt][0] * D[vt][0] + D[vt][1] * D[vt][1]) + (D[vt][2] * D[vt][2] + D[vt][3] * D[vt][3]);
        ss += shfl_xor_f(ss, 16); ss += shfl_xor_f(ss, 32);
        const float rs = 1.0f / sqrtf(ss * (1.0f / 64.0f) + 1e-6f);
        const float* nw = a.in[17] + l * 384;
#pragma unroll
        for (int vt = 0; vt < 4; ++vt) { const unsigned col = (unsigned)(h * 64 + 16 * vt + 4 * fq);
            const f16x4 z4 = *(const f16x4*)(U + uo + ((unsigned)C_HGZ + col) * 2u); const f32x4 w4 = *(const f32x4*)(nw + col);
            f16x4 o;
#pragma unroll
            for (int i = 0; i < 4; ++i) o[i] = (f16)(D[vt][i] * rs * w4[i] * siluf_((float)z4[i]));
            *(f16x4*)(MIX + (m * (unsigned)DM + 384u + col) * 2u) = o; }
    }
    {
        const char* CA = (const char*)(a.ws + WS_CA); const float* LH = (const float*)(a.ws + WS_LH) + ((size_t)b * NCH + c) * 256;
#pragma unroll
        for (int q = 0; q < 4; ++q) { const unsigned ch0 = (unsigned)(128 * hg + 32 * fq + 8 * q);
            const f16x8 hl = *(const f16x8*)(MIX + (m * (unsigned)DM + 768u + ch0) * 2u), ca = *(const f16x8*)(CA + (m * 256u + ch0) * 2u), z8 = *(const f16x8*)(U + uo + ((unsigned)C_LRUZ + ch0) * 2u);
            const f32x4 c0 = *(const f32x4*)(LH + ch0), c1 = *(const f32x4*)(LH + ch0 + 4);
            f16x8 o;
#pragma unroll
            for (int i = 0; i < 8; ++i) o[i] = (f16)(((float)hl[i] + (float)ca[i] * (i < 4 ? c0[i & 3] : c1[i & 3])) * siluf_((float)z8[i]));
            *(f16x8*)(MIX + (m * (unsigned)DM + 768u + ch0) * 2u) = o; }
    }
}
#define XB_TMO      128
#define XB_XCNT(j)  (256  + 64 * (j))
#define XB_XSUB(j)  (1280 + 64 * (j))
#define XB_XGEN(j)  (2304 + 64 * (j))
#define XB_TOP      3328
#define XB_TOPGEN   3392
#define XCD_BAR_WORDS 3456
#define XB_SPIN_CAP (1u << 18)

__device__ __forceinline__ unsigned xb_ld(unsigned* p)              { return __hip_atomic_load(p, __ATOMIC_RELAXED, __HIP_MEMORY_SCOPE_AGENT); }
__device__ __forceinline__ unsigned xb_add(unsigned* p, unsigned v) { return __hip_atomic_fetch_add(p, v, __ATOMIC_RELAXED, __HIP_MEMORY_SCOPE_AGENT); }
__device__ __forceinline__ unsigned xb_xcc_id() { return (unsigned)__builtin_amdgcn_s_getreg((3 << 11) | 20) & 0xFu; }
#define XB_SPIN(cond, bar) do { unsigned _sp = 0; while (cond) { __builtin_amdgcn_s_sleep(1); \
    if ((++_sp & 255u) == 0u) { if (xb_ld(&(bar)[XB_TMO])) break; if (_sp > XB_SPIN_CAP) { atomicAdd(&(bar)[XB_TMO], 1u); break; } } } } while (0)

struct XcdBarrier {
    unsigned* bar; unsigned x; int isw0;
    volatile LAS unsigned* st;
};

__device__ __forceinline__ XcdBarrier xcd_barrier_post(unsigned* bar, volatile LAS unsigned* st, int isw0) {
    XcdBarrier b; b.bar = bar; b.x = xb_xcc_id(); b.st = st; b.isw0 = isw0;
    if (isw0 && lane_now() == 0) (void)xb_add(&bar[XB_XCNT(b.x)], 1u);
    return b;
}
__device__ __forceinline__ void xcd_barrier_complete(unsigned* bar, unsigned x, unsigned& nloc, unsigned& nx) {
    const unsigned G = gridDim.x * gridDim.y * gridDim.z;
    unsigned sum, cnt, mine, sp = 0u;
    for (;;) {
        sum = 0u; cnt = 0u; mine = 0u;
#pragma unroll
        for (unsigned j = 0; j < 16; ++j) { const unsigned c = xb_ld(&bar[XB_XCNT(j)]); sum += c; cnt += (c > 0u) ? 1u : 0u; mine = (j == x) ? c : mine; }
        if (sum == G) break;
        __builtin_amdgcn_s_sleep(1);
        if ((++sp & 255u) == 0u) { if (xb_ld(&bar[XB_TMO])) break; if (sp > XB_SPIN_CAP) { atomicAdd(&bar[XB_TMO], 1u); break; } }
    }
    nloc = mine > 0u ? mine : 1u; nx = cnt > 0u ? cnt : 1u;
}

__device__ __forceinline__ void xcd_barrier(const XcdBarrier& b) {
    asm volatile("s_waitcnt vmcnt(0)" ::: "memory");
    __syncthreads();
    if (b.isw0 && lane_now() == 0) {
        unsigned* bar = b.bar;
        __builtin_amdgcn_s_waitcnt(0);
        unsigned nloc = b.st[0], nx = b.st[1];
        if (nloc == 0u) { xcd_barrier_complete(bar, b.x, nloc, nx); b.st[0] = nloc; b.st[1] = nx; }
        const unsigned old = xb_add(&bar[XB_XSUB(b.x)], 1u);
        const unsigned gen = old / nloc;
        if (old + 1u == (gen + 1u) * nloc) {
            __builtin_amdgcn_fence(__ATOMIC_RELEASE, "agent");
            asm volatile("s_waitcnt vmcnt(0)" ::: "memory");
            const unsigned og = xb_add(&bar[XB_TOP], 1u);
            const unsigned tg = og / nx;
            if (og + 1u == (tg + 1u) * nx) xb_add(&bar[XB_TOPGEN], 1u);
            else XB_SPIN(xb_ld(&bar[XB_TOPGEN]) == tg, bar);
            __builtin_amdgcn_fence(__ATOMIC_ACQUIRE, "agent");
            xb_add(&bar[XB_XGEN(b.x)], 1u);
            asm volatile("s_waitcnt vmcnt(0)" ::: "memory");
        } else {
            XB_SPIN(xb_ld(&bar[XB_XGEN(b.x)]) == gen, bar);
            __builtin_amdgcn_fence(__ATOMIC_ACQUIRE, "agent");
            asm volatile("s_waitcnt vmcnt(0)" ::: "memory");
        }
    }
    __syncthreads();
}

constexpr size_t WS_BAR = 16384;
constexpr int MISC_OFF = LDS_BYTES - 16;
__global__ void __launch_bounds__(NT, 2) fwd(Args args) {
    extern __shared__ __attribute__((aligned(16))) unsigned char lds_raw[];
    LAS unsigned char* lds = (LAS unsigned char*)lds_raw;
    cg::grid_group grid = cg::this_grid();
    const int wave = __builtin_amdgcn_readfirstlane((int)threadIdx.x >> 6);
#define TID_NOW() (wave * 64 + lane_now())
    const int tid = TID_NOW(); const int lane = tid & 63;
    if (wave == 0 && lane < 4) ((LAS unsigned*)(lds + MISC_OFF))[lane] = 0u;
    __syncthreads();
    XcdBarrier xbar = xcd_barrier_post((unsigned*)(args.ws + WS_BAR), (volatile LAS unsigned*)(lds + MISC_OFF), __builtin_amdgcn_readfirstlane(wave == 0 ? 1 : 0));
#define GRID_BAR() do { XcdBarrier xb_ = xbar; xb_.st = (volatile LAS unsigned*)(lds + MISC_OFF); asm volatile("" : "+s"(xb_.bar), "+s"(xb_.x)); xcd_barrier(xb_); } while (0)
    const int G = gridDim.x, gw = blockIdx.x * NWAVES + wave, NGW = G * NWAVES;
    unsigned char* ws = args.ws;
    unsigned short* XN = (unsigned short*)(ws + WS_XN);
    {
        LAS float* scr = (LAS float*)(lds + wave * 16384);
        constexpr int I_IN = (DM / 64) * (NIN / 32), I_OUT = (DM / 64) * (DM / 32), NITEMS = DEPTH * (I_IN + I_OUT);
        for (int it = gw; it < NITEMS; it += NGW) {
            int r = it; const int l = r / (I_IN + I_OUT); r -= l * (I_IN + I_OUT);
            if (r < I_IN) p0_transpose_item(args.in[2] + (size_t)l * DM * NIN, DM, NIN, (unsigned short*)(ws + WS_WIN + l * WIN_L), scr, r, lane, l == 0 ? nullptr : args.in[1] + DM);
            else p0_transpose_item(args.in[25] + (size_t)l * DM * DM, DM, DM, (unsigned short*)(ws + WS_WOUT + l * WOUT_L), scr, r - I_IN, lane, nullptr);
        }
        for (int i = gw; i < DEPTH * (NU - NIN) * DM * 2 / 1024; i += NGW) { const int l = i / ((NU - NIN) * DM * 2 / 1024), r = i % ((NU - NIN) * DM * 2 / 1024);
            if (l == 1 && r < 64 * DM * 2 / 1024) continue;
            *(u32x4*)(ws + WS_WIN + l * WIN_L + (size_t)NIN * DM * 2 + (size_t)r * 1024 + lane * 16) = (u32x4){0u, 0u, 0u, 0u}; }
        for (int i4 = blockIdx.x * NT + tid; i4 < 4 * 64 * DM; i4 += G * NT) { const int q = i4 & 3, i = i4 >> 2, k = i >> 6, n = i & 63, j = n & 31;
            const float* wrow = args.in[2] + (size_t)DM * NIN + (size_t)k * NIN + C_V + 96 * q; const float* mu1 = args.in[3] + RW_SHIFT + C_V + 96 * q; const float* vdn = args.in[9] + (96 * q) * 32 + j;
            float acc = 0.f;
#pragma unroll 8
            for (int cc = 0; cc < 96; ++cc) { const float mm = mu1[cc]; acc += wrow[cc] * ((n < 32) ? (1.0f - mm) : mm) * vdn[cc * 32]; }
            acc += shfl_xor_f(acc, 1); acc += shfl_xor_f(acc, 2);
            if (q == 0) ((f16*)(ws + WS_WIN + WIN_L))[(size_t)(NIN + n) * DM + k] = (f16)(acc * args.in[1][DM + k]); }
        for (int i = blockIdx.x * NT + tid; i < M; i += G * NT) ((float*)(ws + WS_RSS))[i] = 0.f;
        for (int m = gw; m < M; m += NGW) rms_row_f16(args.in[0] + (size_t)m * DM, args.in[1], XN + (size_t)m * DM, lane);
        { f16* WUPT = (f16*)(ws + WS_WUPT); f16* AUPT = (f16*)(ws + WS_AUPT); f16* VDNT = (f16*)(ws + WS_VDNT); f16* VUPT = (f16*)(ws + WS_VUPT);
          for (int i = blockIdx.x * NT + tid; i < 122880; i += G * NT) {
              if (i < 49152) { const int ll = i / 24576, r = i % 24576, n = r / 64, k = r % 64; WUPT[i] = (f16)args.in[5][(size_t)ll * 24576 + k * 384 + n]; }
              else if (i < 98304) { const int i2 = i - 49152, ll = i2 / 24576, r = i2 % 24576, n = r / 64, k = r % 64; AUPT[i2] = (f16)args.in[7][(size_t)ll * 24576 + k * 384 + n]; }
              else if (i < 110592) { const int i2 = i - 98304, j2 = i2 / 384, cc = i2 % 384; VDNT[i2] = (f16)args.in[9][cc * 32 + j2]; }
              else { const int i2 = i - 110592, n = i2 / 32, j2 = i2 % 32; VUPT[i2] = (f16)args.in[10][j2 * 384 + n]; } }
          f16* WAT = (f16*)(ws + WS_WAT); f16* WXT = (f16*)(ws + WS_WXT);
          for (int i = blockIdx.x * NT + tid; i < 32768; i += G * NT) { const int lg = i >> 12, r = i & 4095, j = r >> 6, ii = r & 63; WAT[i] = (f16)args.in[20][(size_t)lg * 4096 + ii * 64 + j]; WXT[i] = (f16)args.in[22][(size_t)lg * 4096 + ii * 64 + j]; } }
    }
    if (gridDim.x > 65536u) grid.sync();
    GRID_BAR();
#pragma unroll 1
    for (int l = 0; l < DEPTH; ++l) {
        { pg8::Gemm g{XN, (const unsigned short*)(ws + WS_WIN + l * WIN_L), M, NU, DM}; pg8::StaticOrder S; S.init(M, NU, G, (int)blockIdx.x);
          pg8::EpiF16 E{(unsigned short*)(ws + WS_U), NU, l == 0 ? nullptr : (const float*)(ws + WS_RSS)};
          pg8::gemm_phase<pg8::EpiF16, pg8::StaticOrder, true, true>(lds, g, S, E, wave); }
        GRID_BAR();
        for (int task = blockIdx.x; task < BATCH * NCH; task += G) phaseA(args, l, task, lds, TID_NOW());
        GRID_BAR();
        phaseB1(args, lds, TID_NOW());
        GRID_BAR();
        phaseB(args, lds, TID_NOW());
        GRID_BAR();
        phaseB3(args, lds, TID_NOW());
        GRID_BAR();
        for (int task = blockIdx.x; task < BATCH * NCH; task += G) phaseC(args, l, task, lds, TID_NOW());
        GRID_BAR();
        { pg8::Gemm g{(const unsigned short*)(ws + WS_MIX), (const unsigned short*)(ws + WS_WOUT + l * WOUT_L), M, DM, DM}; pg8::StaticOrder S; S.init(M, DM, G, (int)blockIdx.x);
          pg8::EpiRes E{l == 0 ? args.in[0] : args.out, args.out, DM, l == 0 ? XN : nullptr, (float*)(ws + WS_RSS)};
          pg8::gemm_phase<pg8::EpiRes, pg8::StaticOrder, true, true>(lds, g, S, E, wave); }
        GRID_BAR();
        { int ln = TID_NOW() & 63; asm volatile("" : "+v"(ln));
          if (l + 1 < DEPTH) { }
          else { for (int m = gw; m < M; m += 2 * NGW) rms_row2_f32(args.out + (size_t)m * DM, args.out + (size_t)(m + NGW) * DM, args.in[26], ln); } }
    }
}

extern "C" void kernel_launch(void* const* d_in, const int* in_sizes, int n_in, void* d_out, int out_size, void* d_ws, size_t ws_size, hipStream_t stream) {
    static int grid = 0;
    if (grid == 0) {
        if (n_in != 27 || in_sizes[0] != M * DM || out_size != M * DM || ws_size < WS_END) { fprintf(stderr, "kernel_launch: unexpected problem: n_in %d in0 %d out %d ws %zu\n", n_in, n_in > 0 ? in_sizes[0] : -1, out_size, ws_size); grid = -1; return; }
        int dev = 0, cus = 0, per_cu = 0;
        hipGetDevice(&dev); hipDeviceGetAttribute(&cus, hipDeviceAttributeMultiprocessorCount, dev);
        if (hipFuncSetAttribute((const void*)fwd, hipFuncAttributeMaxDynamicSharedMemorySize, LDS_BYTES) != hipSuccess) { fprintf(stderr, "kernel_launch: hipFuncSetAttribute failed\n"); grid = -1; return; }
        if (hipOccupancyMaxActiveBlocksPerMultiprocessor(&per_cu, (const void*)fwd, NT, LDS_BYTES) != hipSuccess || per_cu < 1) { fprintf(stderr, "kernel_launch: occupancy query failed (%d)\n", per_cu); grid = -1; return; }
        grid = cus * per_cu;
    }
    if (grid < 0) return;
    if (hipMemsetAsync((char*)d_ws, 0, 65536, stream) != hipSuccess) { fprintf(stderr, "kernel_launch: memset of the barrier words failed\n"); return; }
    Args a{};
    for (int i = 0; i < 27; ++i) a.in[i] = (const float*)d_in[i];
    a.out = (float*)d_out; a.ws = (unsigned char*)d_ws;
    void* kargs[] = {&a};
    hipError_t e = hipLaunchCooperativeKernel((const void*)fwd, dim3(grid), dim3(NT), kargs, LDS_BYTES, stream);
    if (e != hipSuccess) fprintf(stderr, "cooperative launch failed: %s (grid %d)\n", hipGetErrorString(e), grid);
}
```

```cpp
#include <hip/hip_runtime.h>
#include <hip/hip_cooperative_groups.h>
#include <cstdio>
#include <cstdint>
namespace cg = cooperative_groups;
typedef _Float16 f16x8_t __attribute__((ext_vector_type(8)));
#define MK_MFMA(a, b, c) __builtin_amdgcn_mfma_f32_16x16x32_f16(__builtin_bit_cast(f16x8_t, (a)), __builtin_bit_cast(f16x8_t, (b)), (c), 0, 0, 0)
__device__ __forceinline__ int lane_now() { int z; asm volatile("v_mbcnt_lo_u32_b32 %0, -1, 0\n\tv_mbcnt_hi_u32_b32 %0, -1, %0" : "=v"(z)); return z; }
__device__ __forceinline__ float shfl_xor_f(float v, int mask) { const int ln = lane_now(); return __builtin_bit_cast(float, __builtin_amdgcn_ds_bpermute((ln ^ mask) << 2, __builtin_bit_cast(int, v))); }
namespace pg8 {
#define PG8_LAS __attribute__((address_space(3)))
typedef unsigned short bf16_t;
typedef short bf16x8 __attribute__((ext_vector_type(8)));
typedef float f32x4 __attribute__((ext_vector_type(4)));
typedef unsigned u32x4 __attribute__((ext_vector_type(4)));
constexpr int BM = 256, BK = 64, HALF = 128, HTB = HALF * BK * 2  , STAGE_BYTES = 8 * HTB, NXCD = 8, WGM = 8;

__host__ __device__ __forceinline__ int lds_byte(int r, int c) { const int st = (r >> 4) * 2 + (c >> 5), rr = r & 15, cc = c & 31, ob = rr * 64 + cc * 2; return st * 1024 + (ob ^ (((ob >> 9) & 1) << 5)); }
__host__ __device__ __forceinline__ void stage_rc(int b, int& R, int& C) { const int st = b / 1024, sb = b % 1024, swz = sb ^ (((sb >> 9) & 1) << 5); R = (st >> 1) * 16 + swz / 64; C = (st & 1) * 32 + (swz % 64) / 2; }
__host__ __device__ __forceinline__ int perm32(int rho) { const int n = rho >> 4, i = rho & 15; return 8 * (i >> 2) + 4 * n + (i & 3); }

struct Unit { int pm, pn; };
struct Gemm { const bf16_t* A; const bf16_t* Bt; int M, N, K; };

struct StaticOrder {
    int nM, nN, nwg, G, c;
    __host__ __device__ void init(int M, int N, int G_, int c_) { nM = M / BM; nN = N / BM; nwg = nM * nN; G = G_; c = c_; }
    __host__ __device__ bool next(int i, Unit& u) const {
        const long L = (long)i * G + c; if (L >= nwg) return false;
        int wgid = (int)L; { const int q = nwg / NXCD, r = nwg % NXCD, xcd = wgid % NXCD, off = wgid / NXCD; wgid = (xcd < r ? xcd * (q + 1) : r * (q + 1) + (xcd - r) * q) + off; }
        const int nig = WGM * nN, gid = wgid / nig, fm = gid * WGM, gsz = (nM - fm) < WGM ? (nM - fm) : WGM;
        u.pm = fm + ((wgid % nig) % gsz); u.pn = (wgid % nig) / gsz; return true;
    }
    __device__ __forceinline__ void a_ready(const Unit&) const {}
    __device__ __forceinline__ void done(const Unit&) const {}
};

__device__ __forceinline__ unsigned pk_f16(float lo, float hi) { typedef _Float16 h2 __attribute__((ext_vector_type(2))); h2 v; v.x = (_Float16)lo; v.y = (_Float16)hi; return __builtin_bit_cast(unsigned, v); }
typedef unsigned u32x2 __attribute__((ext_vector_type(2)));
struct EpiF16 {
    static constexpr bool PERM = true, AFTER_DRAIN = false;
    bf16_t* O; int ldc; const float* rss;
    __device__ __forceinline__ void operator()(const f32x4 (&acc)[2][2][4][2], const Unit& u, int wr, int wc, int fr, int fq) const {
        const int row0 = u.pm * BM + wr * 64 + fr; const int col0 = u.pn * BM + wc * 32 + 8 * fq;
#pragma unroll
        for (int ai = 0; ai < 2; ++ai)
#pragma unroll
            for (int m = 0; m < 4; ++m) { const int row = row0 + ai * HALF + m * 16; bf16_t* rowp = O + (size_t)row * ldc + col0;
                const float sc = rss ? 1.0f / sqrtf(rss[row] * (1.0f / 1024.0f) + 1e-6f) : 1.0f;
#pragma unroll
                for (int bj = 0; bj < 2; ++bj) { const f32x4 v0 = acc[ai][bj][m][0] * sc, v1 = acc[ai][bj][m][1] * sc;
                    u32x4 w; w.x = pk_f16(v0[0], v0[1]); w.y = pk_f16(v0[2], v0[3]); w.z = pk_f16(v1[0], v1[1]); w.w = pk_f16(v1[2], v1[3]);
                    *(u32x4*)(rowp + bj * HALF) = w; } }
    }
};
struct EpiRes {
    static constexpr bool PERM = false, AFTER_DRAIN = false;
    const float* base; float* out; int ldc; bf16_t* xh; float* rss;
    __device__ __forceinline__ void operator()(const f32x4 (&acc)[2][2][4][2], const Unit& u, int wr, int wc, int fr, int fq) const {
        const int row0 = u.pm * BM + wr * 64 + fr; const int col0 = u.pn * BM + wc * 32 + 4 * fq;
#pragma unroll
        for (int ai = 0; ai < 2; ++ai)
#pragma unroll
            for (int m = 0; m < 4; ++m) { const size_t off = (size_t)(row0 + ai * HALF + m * 16) * ldc + col0; float ss = 0.f;
#pragma unroll
                for (int bj = 0; bj < 2; ++bj)
#pragma unroll
                    for (int n = 0; n < 2; ++n) { const size_t o = off + bj * HALF + n * 16; const f32x4 b = *(const f32x4*)(base + o); const f32x4 x = b + acc[ai][bj][m][n]; *(f32x4*)(out + o) = x;
                        if (xh) { u32x2 h; h.x = pk_f16(x[0], x[1]); h.y = pk_f16(x[2], x[3]); *(u32x2*)(xh + o) = h; ss += (x[0] * x[0] + x[1] * x[1]) + (x[2] * x[2] + x[3] * x[3]); } }
                if (xh) { ss += shfl_xor_f(ss, 16); ss += shfl_xor_f(ss, 32); if (fq == 0) atomicAdd(rss + row0 + ai * HALF + m * 16, ss); }
                asm volatile("" ::: "memory"); }
    }
};

template <class Epi, class Sched, bool ALIGN_EPI = false, bool SP2 = false>
__device__ __forceinline__ void gemm_phase(PG8_LAS unsigned char* lds, const Gemm g, const Sched& S, const Epi& E, const int wave_) {
    int wv_ = wave_; asm volatile("" : "+s"(wv_)); int tid_ = lane_now() + 64 * wv_; const int tid = tid_, wid = wv_, lane = tid & 63, wr = wid >> 2, wc = wid & 3, fr = lane & 15, fq = lane >> 4;
    const int K = g.K, nt = K / BK;
    unsigned voffA[2], voffB[2];
#pragma unroll
    for (int i = 0; i < 2; ++i) { int R, C; stage_rc(tid * 16 + i * 8192, R, C); const int Rb = Epi::PERM ? ((R & ~31) + perm32(R & 31)) : R;
        voffA[i] = (unsigned)(R * K + C) * 2u; voffB[i] = (unsigned)(Rb * K + C) * 2u; }
    const size_t kstep = (size_t)(BK * 2);
    const size_t hstep = (size_t)HALF * K * 2;
    const size_t tstep = 2 * hstep;
    const unsigned ldsw = (unsigned)wid * 1024u;
    const int aoff = lds_byte(wr * 64 + fr, fq * 8), boff = lds_byte(wc * 32 + fr, fq * 8);
#define PG8_SA(b, h) (((b) * 2 + (h)) * HTB)
#define PG8_SB(b, h) ((4 + (b) * 2 + (h)) * HTB)
#define PG8_STAGE(bufoff, gbase, voff) do { _Pragma("unroll") for (int _i = 0; _i < 2; ++_i) \
        __builtin_amdgcn_global_load_lds((const unsigned*)((const char*)(gbase) + (voff)[_i]), (PG8_LAS unsigned*)(lds + (bufoff) + ldsw + _i * 8192), 16, 0, 0); } while (0)
#define PG8_LDA(dst, b, h) do { _Pragma("unroll") for (int m = 0; m < 4; ++m) _Pragma("unroll") for (int k = 0; k < 2; ++k) dst[m][k] = *(const PG8_LAS bf16x8*)(lds + PG8_SA(b, h) + aoff + m * 2048 + k * 1024); } while (0)
#define PG8_LDB(dst, b, h) do { _Pragma("unroll") for (int n = 0; n < 2; ++n) _Pragma("unroll") for (int k = 0; k < 2; ++k) dst[n][k] = *(const PG8_LAS bf16x8*)(lds + PG8_SB(b, h) + boff + n * 2048 + k * 1024); } while (0)
#define PG8_MMA(ai, bj, At, Bt) do { __builtin_amdgcn_s_setprio(1); _Pragma("unroll") for (int m = 0; m < 4; ++m) _Pragma("unroll") for (int n = 0; n < 2; ++n) _Pragma("unroll") for (int k = 0; k < 2; ++k) \
        acc[ai][bj][m][n] = MK_MFMA(Bt[n][k], At[m][k], acc[ai][bj][m][n]); __builtin_amdgcn_s_setprio(0); } while (0)
#define PG8_WAIT_V(n) asm volatile("s_waitcnt vmcnt(" #n ")" ::: "memory")
#define PG8_WAIT_L(n) asm volatile("s_waitcnt lgkmcnt(" #n ")" ::: "memory")
#define PG8_BAR __builtin_amdgcn_s_barrier()
#define PG8_SCHED __builtin_amdgcn_sched_barrier(0)
    Unit cur, nxt; int ui = 0;
    if (!S.next(0, cur)) return;
    f32x4 acc[2][2][4][2];
#pragma unroll
    for (int a = 0; a < 2; ++a)
#pragma unroll
        for (int b = 0; b < 2; ++b)
#pragma unroll
            for (int m = 0; m < 4; ++m)
#pragma unroll
                for (int n = 0; n < 2; ++n) acc[a][b][m][n] = (f32x4){0.f, 0.f, 0.f, 0.f};
    bf16x8 At[4][2], B0[2][2], B1[2][2];
    const char* cA = (const char*)g.A + (size_t)cur.pm * tstep; const char* cB = (const char*)g.Bt + (size_t)cur.pn * tstep;
    S.a_ready(cur);
    if constexpr (SP2) {
        PG8_STAGE(PG8_SB(0, 0), cB, voffB); PG8_STAGE(PG8_SB(0, 1), cB + hstep, voffB); PG8_STAGE(PG8_SA(0, 0), cA, voffA); PG8_STAGE(PG8_SA(0, 1), cA + hstep, voffA);
        if (wr == 1) PG8_BAR;
        PG8_WAIT_V(2); PG8_BAR;
        PG8_STAGE(PG8_SB(1, 0), cB + kstep, voffB); PG8_STAGE(PG8_SA(1, 0), cA + kstep, voffA); PG8_STAGE(PG8_SB(1, 1), cB + hstep + kstep, voffB);
        PG8_WAIT_V(6); PG8_BAR;
    } else {
        PG8_STAGE(PG8_SB(0, 0), cB, voffB); PG8_STAGE(PG8_SA(0, 0), cA, voffA); PG8_STAGE(PG8_SB(0, 1), cB + hstep, voffB); PG8_STAGE(PG8_SA(0, 1), cA + hstep, voffA);
        if (wr == 1) PG8_BAR;
        PG8_WAIT_V(4); PG8_BAR;
        PG8_STAGE(PG8_SB(1, 0), cB + kstep, voffB); PG8_STAGE(PG8_SA(1, 0), cA + kstep, voffA); PG8_STAGE(PG8_SB(1, 1), cB + hstep + kstep, voffB);
        PG8_WAIT_V(6); PG8_BAR;
    }
    for (;;) {
        const bool has_next = S.next(ui + 1, nxt);
        const char* nA = has_next ? (const char*)g.A + (size_t)nxt.pm * tstep : cA; const char* nB = has_next ? (const char*)g.Bt + (size_t)nxt.pn * tstep : cB;
        for (int t = 0; t < nt; t += 2) {
            const bool last = (t == nt - 2);
            const char* a1 = cA + (size_t)(t + 1) * kstep;
            const char* a2 = last ? nA : cA + (size_t)(t + 2) * kstep; const char* b2 = last ? nB : cB + (size_t)(t + 2) * kstep;
            const char* a3 = a2 + kstep; const char* b3 = b2 + kstep;
            if (last && has_next) S.a_ready(nxt);
            if constexpr (SP2) {
            PG8_LDB(B0, 0, 0); PG8_LDB(B1, 0, 1); PG8_SCHED; PG8_LDA(At, 0, 0); PG8_STAGE(PG8_SA(1, 1), a1 + hstep, voffA);
            PG8_WAIT_V(8); PG8_WAIT_L(0); PG8_BAR; PG8_MMA(0, 0, At, B0); PG8_MMA(0, 1, At, B1); PG8_BAR; PG8_SCHED;
            PG8_LDA(At, 0, 1); PG8_STAGE(PG8_SB(0, 0), b2, voffB); PG8_STAGE(PG8_SB(0, 1), b2 + hstep, voffB); PG8_STAGE(PG8_SA(0, 0), a2, voffA);
            PG8_WAIT_V(8); PG8_WAIT_L(0); PG8_BAR; PG8_MMA(1, 0, At, B0); PG8_MMA(1, 1, At, B1); PG8_BAR; PG8_SCHED;
            PG8_LDB(B0, 1, 0); PG8_LDB(B1, 1, 1); PG8_SCHED; PG8_LDA(At, 1, 0); PG8_STAGE(PG8_SA(0, 1), a2 + hstep, voffA);
            PG8_WAIT_V(8); PG8_WAIT_L(0); PG8_BAR; PG8_MMA(0, 0, At, B0); PG8_MMA(0, 1, At, B1); PG8_BAR; PG8_SCHED;
            PG8_LDA(At, 1, 1); PG8_STAGE(PG8_SB(1, 0), b3, voffB); PG8_STAGE(PG8_SB(1, 1), b3 + hstep, voffB); PG8_STAGE(PG8_SA(1, 0), a3, voffA);
            PG8_WAIT_V(8); PG8_WAIT_L(0); PG8_BAR; PG8_MMA(1, 0, At, B0); PG8_MMA(1, 1, At, B1); PG8_BAR; PG8_SCHED;
            } else {
            PG8_LDB(B0, 0, 0); PG8_SCHED; PG8_LDA(At, 0, 0); PG8_STAGE(PG8_SA(1, 1), a1 + hstep, voffA);
            PG8_WAIT_L(8); PG8_BAR; PG8_WAIT_L(0); PG8_MMA(0, 0, At, B0); PG8_BAR; PG8_SCHED;
            PG8_LDB(B1, 0, 1); PG8_STAGE(PG8_SB(0, 0), b2, voffB);
            PG8_BAR; PG8_WAIT_L(0); PG8_MMA(0, 1, At, B1); PG8_BAR;
            PG8_LDA(At, 0, 1); PG8_STAGE(PG8_SA(0, 0), a2, voffA);
            PG8_BAR; PG8_WAIT_L(0); PG8_MMA(1, 0, At, B0); PG8_BAR; PG8_SCHED;
            PG8_STAGE(PG8_SB(0, 1), b2 + hstep, voffB);
            PG8_WAIT_V(6); PG8_BAR; PG8_MMA(1, 1, At, B1); PG8_BAR;
            PG8_LDB(B0, 1, 0); PG8_SCHED; PG8_LDA(At, 1, 0); PG8_STAGE(PG8_SA(0, 1), a2 + hstep, voffA);
            PG8_WAIT_L(8); PG8_BAR; PG8_WAIT_L(0); PG8_MMA(0, 0, At, B0); PG8_BAR; PG8_SCHED;
            PG8_LDB(B1, 1, 1); PG8_STAGE(PG8_SB(1, 0), b3, voffB);
            PG8_BAR; PG8_WAIT_L(0); PG8_MMA(0, 1, At, B1); PG8_BAR;
            PG8_LDA(At, 1, 1); PG8_STAGE(PG8_SA(1, 0), a3, voffA);
            PG8_BAR; PG8_WAIT_L(0); PG8_MMA(1, 0, At, B0); PG8_BAR; PG8_SCHED;
            PG8_STAGE(PG8_SB(1, 1), b3 + hstep, voffB);
            PG8_WAIT_V(6); PG8_BAR; PG8_MMA(1, 1, At, B1); PG8_BAR;
            }
        }
        if constexpr (ALIGN_EPI) { if (wr == 0) PG8_BAR; }
        if constexpr (!Epi::AFTER_DRAIN) { E(acc, cur, wr, wc, fr, fq); S.done(cur); }
        if (!has_next) break;
#pragma unroll
        for (int a = 0; a < 2; ++a)
#pragma unroll
            for (int b = 0; b < 2; ++b)
#pragma unroll
                for (int m = 0; m < 4; ++m)
#pragma unroll
                    for (int n = 0; n < 2; ++n) acc[a][b][m][n] = (f32x4){0.f, 0.f, 0.f, 0.f};
        cur = nxt; cA = nA; cB = nB; ++ui;
        if constexpr (ALIGN_EPI) { if (wr == 1) PG8_BAR; }
    }
    PG8_WAIT_V(0);
    if constexpr (!ALIGN_EPI) { if (wr == 0) PG8_BAR; }
    PG8_BAR;
    if constexpr (Epi::AFTER_DRAIN) { E.fused(acc, cur, wr, wc, fr, fq, lds, wid, lane); S.done(cur); }
#undef PG8_SA
#undef PG8_SB
#undef PG8_STAGE
#undef PG8_LDA
#undef PG8_LDB
#undef PG8_MMA
#undef PG8_WAIT_V
#undef PG8_WAIT_L
#undef PG8_BAR
#undef PG8_SCHED
}
}

constexpr int BATCH = 2, SEQ = 8192, DM = 1024, DEPTH = 2, M = BATCH * SEQ;
constexpr int RW_H = 6, HD = 64, RW_W = 384, RW_SHIFT = 1280;
constexpr int NIN = 3712, NU = 3840;
constexpr int C_R = 0, C_K = 384, C_V = 768, C_WL = 1152, C_AL = 1216, C_RWZ = 1280, C_HGQ = 1664, C_HGF = 2048, C_HGI = 2432, C_HGZ = 2816, C_LRUX = 3200, C_LRUZ = 3456;
constexpr int CH = 64;
constexpr int NWAVES = 8, NT = NWAVES * 64;
constexpr int LDS_BYTES = 163840;
constexpr int PRM_OFF = 138240;
constexpr size_t MiB = 1u << 20;
constexpr size_t WS_WUPT = 65536, WS_AUPT = WS_WUPT + 98304, WS_VDNT = WS_AUPT + 98304, WS_VUPT = WS_VDNT + 24576, WS_WAT = WS_VUPT + 24576, WS_WXT = WS_WAT + 65536;
constexpr size_t WS_WIN = 1 * MiB, WIN_L = (size_t)NU * DM * 2;
constexpr size_t WS_WOUT = 16 * MiB, WOUT_L = (size_t)DM * DM * 2;
constexpr size_t WS_XN = 20 * MiB;
constexpr size_t WS_QT = 20 * MiB;
constexpr size_t WS_PT = 32 * MiB;
constexpr size_t WS_CA = 44 * MiB;
constexpr size_t WS_U = 52 * MiB;
constexpr size_t WS_MIX = 172 * MiB;
constexpr size_t WS_VF = 204 * MiB;
constexpr size_t WS_VP = 216 * MiB;
constexpr size_t WS_RL = 228 * MiB;
constexpr size_t WS_HL = 240 * MiB;
constexpr size_t WS_BON = 252 * MiB;
constexpr size_t WS_DC = WS_BON + 512 * 1024;
constexpr size_t WS_LA = WS_DC + 512 * 1024;
constexpr size_t WS_LH = WS_LA + 256 * 1024;
constexpr size_t WS_RSS = WS_LH + 256 * 1024;
constexpr size_t WS_END = 254 * MiB;
constexpr int NCH = SEQ / CH;

#define LAS __attribute__((address_space(3)))
typedef float f32x4 __attribute__((ext_vector_type(4)));
typedef unsigned u32x2 __attribute__((ext_vector_type(2)));
typedef unsigned u32x4 __attribute__((ext_vector_type(4)));
typedef _Float16 f16;
typedef _Float16 f16x8 __attribute__((ext_vector_type(8)));
#define LDS_WAIT() asm volatile("s_waitcnt lgkmcnt(0)" ::: "memory")

struct Args { const float* in[27]; float* out; unsigned char* ws; };

__device__ __forceinline__ float wave_sum(float v) {
#pragma unroll
    for (int o = 1; o < 64; o <<= 1) v += shfl_xor_f(v, o);
    return v;
}
__device__ __forceinline__ float sigmoidf_(float x) { return 1.0f / (1.0f + __expf(-x)); }
__device__ __forceinline__ float siluf_(float x) { return x / (1.0f + __expf(-x)); }

__device__ __forceinline__ void p0_transpose_item(const float* W, int K, int N, unsigned short* WT, LAS float* scr, int item, int lane, const float* rsc) {
    const int nblk = N / 32, kb = item / nblk, nb = item % nblk, k0 = 64 * kb, n0 = 32 * nb;
#pragma unroll 8
    for (int i = 0; i < 32; ++i) { const int kk = 2 * i + (lane >> 5); scr[kk * 33 + (lane & 31)] = W[(size_t)(k0 + kk) * N + n0 + (lane & 31)] * (rsc ? rsc[k0 + kk] : 1.0f); }
    LDS_WAIT(); asm volatile("" ::: "memory");
    const int c = lane & 7;
#pragma unroll
    for (int j = 0; j < 4; ++j) { const int n = (lane >> 3) + 8 * j; const LAS float* s = scr + (8 * c) * 33 + n;
        u32x4 o; o.x = pg8::pk_f16(s[0 * 33], s[1 * 33]); o.y = pg8::pk_f16(s[2 * 33], s[3 * 33]); o.z = pg8::pk_f16(s[4 * 33], s[5 * 33]); o.w = pg8::pk_f16(s[6 * 33], s[7 * 33]);
        *(u32x4*)(WT + (size_t)(n0 + n) * K + k0 + 8 * c) = o; }
    LDS_WAIT(); asm volatile("" ::: "memory");
}
__device__ __forceinline__ void rms_row_f16(const float* xrow, const float* w, unsigned short* orow, int lane) {
    const f32x4* xr = (const f32x4*)xrow + lane; const f32x4* wr = (const f32x4*)w + lane;
    f32x4 v[4]; float s = 0.f;
#pragma unroll
    for (int j = 0; j < 4; ++j) { v[j] = xr[64 * j]; s += (v[j].x * v[j].x + v[j].y * v[j].y) + (v[j].z * v[j].z + v[j].w * v[j].w); }
    const float rs = 1.0f / sqrtf(wave_sum(s) * (1.0f / DM) + 1e-6f);
    u32x2* o8 = (u32x2*)orow + lane;
#pragma unroll
    for (int j = 0; j < 4; ++j) { const f32x4 ww = wr[64 * j]; u32x2 o; o.x = pg8::pk_f16(v[j].x * rs * ww.x, v[j].y * rs * ww.y); o.y = pg8::pk_f16(v[j].z * rs * ww.z, v[j].w * rs * ww.w); o8[64 * j] = o; }
}
__device__ __forceinline__ void rms_row_f32(float* xrow, const float* w, int lane) {
    f32x4* xr = (f32x4*)xrow + lane; const f32x4* wr = (const f32x4*)w + lane;
    f32x4 v[4]; float s = 0.f;
#pragma unroll
    for (int j = 0; j < 4; ++j) { v[j] = xr[64 * j]; s += (v[j].x * v[j].x + v[j].y * v[j].y) + (v[j].z * v[j].z + v[j].w * v[j].w); }
    const float rs = 1.0f / sqrtf(wave_sum(s) * (1.0f / DM) + 1e-6f);
#pragma unroll
    for (int j = 0; j < 4; ++j) { const f32x4 ww = wr[64 * j]; xr[64 * j] = v[j] * rs * ww; }
}

__device__ __forceinline__ void rms_row2_f32(float* xa, float* xb, const float* w, int lane) {
    f32x4* ra = (f32x4*)xa + lane; f32x4* rb = (f32x4*)xb + lane; const f32x4* wr = (const f32x4*)w + lane;
    f32x4 va[4], vb[4]; float sa = 0.f, sb = 0.f;
#pragma unroll
    for (int j = 0; j < 4; ++j) { va[j] = ra[64 * j]; vb[j] = rb[64 * j]; }
#pragma unroll
    for (int j = 0; j < 4; ++j) { sa += (va[j].x * va[j].x + va[j].y * va[j].y) + (va[j].z * va[j].z + va[j].w * va[j].w); sb += (vb[j].x * vb[j].x + vb[j].y * vb[j].y) + (vb[j].z * vb[j].z + vb[j].w * vb[j].w); }
    const float rsa = 1.0f / sqrtf(wave_sum(sa) * (1.0f / DM) + 1e-6f), rsb = 1.0f / sqrtf(wave_sum(sb) * (1.0f / DM) + 1e-6f);
#pragma unroll
    for (int j = 0; j < 4; ++j) { const f32x4 ww = wr[64 * j]; ra[64 * j] = va[j] * rsa * ww; rb[64 * j] = vb[j] * rsb * ww; }
}
__device__ __forceinline__ void rms_row4_f16(const float* x0, size_t rs, const float* w, unsigned short* o0, int lane) {
    f32x4 v[4][4]; float s[4];
#pragma unroll
    for (int r = 0; r < 4; ++r)
#pragma unroll
        for (int j = 0; j < 4; ++j) v[r][j] = ((const f32x4*)(x0 + r * rs) + lane)[64 * j];
    const f32x4* wr = (const f32x4*)w + lane;
#pragma unroll
    for (int r = 0; r < 4; ++r) { float a = 0.f;
#pragma unroll
        for (int j = 0; j < 4; ++j) a += (v[r][j].x * v[r][j].x + v[r][j].y * v[r][j].y) + (v[r][j].z * v[r][j].z + v[r][j].w * v[r][j].w);
        s[r] = 1.0f / sqrtf(wave_sum(a) * (1.0f / DM) + 1e-6f); }
#pragma unroll
    for (int j = 0; j < 4; ++j) { const f32x4 ww = wr[64 * j];
#pragma unroll
        for (int r = 0; r < 4; ++r) { u32x2 o; o.x = pg8::pk_f16(v[r][j].x * s[r] * ww.x, v[r][j].y * s[r] * ww.y); o.y = pg8::pk_f16(v[r][j].z * s[r] * ww.z, v[r][j].w * s[r] * ww.w); ((u32x2*)(o0 + r * rs) + lane)[64 * j] = o; } }
}

#define SHV(col) ({ const float cur_ = (float)urow[(col)]; const float prev_ = hp ? (float)prow[(col)] : 0.f; cur_ + mu[(col)] * (prev_ - cur_); })

__device__ __forceinline__ void store_row64_f16(f16* dst, const float (&S)[64]) {
#pragma unroll
    for (int q = 0; q < 8; ++q) { u32x4 w; w.x = pg8::pk_f16(S[8 * q], S[8 * q + 1]); w.y = pg8::pk_f16(S[8 * q + 2], S[8 * q + 3]); w.z = pg8::pk_f16(S[8 * q + 4], S[8 * q + 5]); w.w = pg8::pk_f16(S[8 * q + 6], S[8 * q + 7]); *(u32x4*)(dst + 8 * q) = w; }
}


constexpr int RWA_REC = 656  , RWA_VROW = 136, RWA_VPL = 16 * RWA_REC, RWA_INV = RWA_VPL + 16 * RWA_VROW, RWA_BYTES = 12800;
constexpr int C_VD0 = 3712, C_VD1 = 3744;
constexpr int PRM_MU = 0, PRM_W0 = 1280, PRM_A0 = 1664, PRM_KK = 2048, PRM_KA = 2432, PRM_RK = 2816, PRM_V0 = 3200, PRM_FLOATS = 3584;
typedef float f32x2 __attribute__((ext_vector_type(2)));
typedef _Float16 f16x4 __attribute__((ext_vector_type(4)));
__device__ __forceinline__ float fmix_lo(float a, unsigned b, float c) { float d; asm("v_fma_mix_f32 %0, %1, %2, %3 op_sel:[0,0,0] op_sel_hi:[0,1,0]" : "=v"(d) : "v"(a), "v"(b), "v"(c)); return d; }
__device__ __forceinline__ float fmix_hi(float a, unsigned b, float c) { float d; asm("v_fma_mix_f32 %0, %1, %2, %3 op_sel:[0,1,0] op_sel_hi:[0,1,0]" : "=v"(d) : "v"(a), "v"(b), "v"(c)); return d; }
__device__ __forceinline__ float mmix_lo(float a, unsigned b) { float d; asm("v_fma_mix_f32 %0, %1, %2, 0 op_sel:[0,0,0] op_sel_hi:[0,1,0]" : "=v"(d) : "v"(a), "v"(b)); return d; }
__device__ __forceinline__ float mmix_hi(float a, unsigned b) { float d; asm("v_fma_mix_f32 %0, %1, %2, 0 op_sel:[0,1,0] op_sel_hi:[0,1,0]" : "=v"(d) : "v"(a), "v"(b)); return d; }
__device__ __forceinline__ float fma_asm(float a, float b, float c) { float d; asm("v_fma_f32 %0, %1, %2, %3" : "=v"(d) : "v"(a), "v"(b), "v"(c)); return d; }
#define FMIX(a, u, j, c) (((j) & 1) ? fmix_hi((a), (u)[(j) >> 1], (c)) : fmix_lo((a), (u)[(j) >> 1], (c)))
#define MMIX(a, u, j) (((j) & 1) ? mmix_hi((a), (u)[(j) >> 1]) : mmix_lo((a), (u)[(j) >> 1]))
__device__ __forceinline__ float fast_tanh(float x) { return 1.0f - 2.0f / (__expf(2.0f * x) + 1.0f); }
__device__ __forceinline__ void lerp8(const char* ub, unsigned uo, unsigned po, bool hp, const char* mub, unsigned col, float (&x)[8]) {
    const f16x8 cu = *(const f16x8*)(ub + (uo + col * 2u)); f16x8 pv = *(const f16x8*)(ub + (po + col * 2u)); const f32x4 m0 = *(const f32x4*)(mub + col * 4u), m1 = *(const f32x4*)(mub + col * 4u + 16u);
#pragma unroll
    for (int j = 0; j < 8; ++j) { const float c = (float)cu[j], p = hp ? (float)pv[j] : 0.f; x[j] = c + (j < 4 ? m0[j] : m1[j - 4]) * (p - c); }
}
__device__ __forceinline__ void lerp4(const char* ub, unsigned uo, unsigned po, bool hp, const char* mub, unsigned col, float (&x)[4]) {
    const f16x4 cu = *(const f16x4*)(ub + (uo + col * 2u)); f16x4 pv = *(const f16x4*)(ub + (po + col * 2u)); const f32x4 m0 = *(const f32x4*)(mub + col * 4u);
#pragma unroll
    for (int j = 0; j < 4; ++j) { const float c = (float)cu[j], p = hp ? (float)pv[j] : 0.f; x[j] = c + m0[j] * (p - c); }
}
__device__ __forceinline__ f16x8 pack8(const float (&x)[8]) { f16x8 r;
#pragma unroll
    for (int j = 0; j < 8; ++j) r[j] = (f16)x[j];
    return r; }

__device__ __forceinline__ void rwkv_waveA(const Args& a, int l, int b, int c, int h, LAS unsigned char* wl, const LAS float* prm, int lane) {
    const char* Ub = (const char*)(a.ws + WS_U); f16* MIX = (f16*)(a.ws + WS_MIX); char* VF = (char*)(a.ws + WS_VF); char* VP = (char*)(a.ws + WS_VP);
    f16* QT = (f16*)(a.ws + WS_QT); f16* PT = (f16*)(a.ws + WS_PT); f16* RL = (f16*)(a.ws + WS_RL); float* BONG = (float*)(a.ws + WS_BON);
    const char* WUPT = (const char*)(a.ws + WS_WUPT) + (size_t)l * 384 * 64 * 2; const char* AUPT = (const char*)(a.ws + WS_AUPT) + (size_t)l * 384 * 64 * 2;
    const char* VUPT = (const char*)(a.ws + WS_VUPT);
    const int bh = b * RW_H + h;
    float P[64], L[64];
#pragma unroll
    for (int k = 0; k < 64; ++k) { P[k] = (k == lane) ? 1.f : 0.f; L[k] = 0.f; }
#pragma unroll 1
    for (int blk = 0; blk < 4; ++blk) {
        const int lane_ = lane_now();
        const int tok = lane_ & 15, fq = lane_ >> 4;
        const int t = c * CH + blk * 16 + tok; const unsigned m = (unsigned)(b * SEQ + t); const bool hp = t > 0;
        const unsigned uo = m * (unsigned)(NU * 2), po = hp ? uo - (unsigned)(NU * 2) : uo;
        f16x8 cW[2], pW[2], cA[2], pA[2], vd0, vd1;
#pragma unroll
        for (int s = 0; s < 2; ++s) { const unsigned cw = (unsigned)(C_WL + 8 * fq + 32 * s) * 2u, ca = (unsigned)(C_AL + 8 * fq + 32 * s) * 2u;
            cW[s] = *(const f16x8*)(Ub + uo + cw); pW[s] = *(const f16x8*)(Ub + po + cw); cA[s] = *(const f16x8*)(Ub + uo + ca); pA[s] = *(const f16x8*)(Ub + po + ca); }
        if (l > 0) { vd0 = *(const f16x8*)(Ub + uo + (unsigned)(C_VD0 + 8 * fq) * 2u); vd1 = *(const f16x8*)(Ub + po + (unsigned)(C_VD1 + 8 * fq) * 2u); }
#define RW_TLOAD(X, nt) f16x8 X##wu0, X##wu1, X##au0, X##au1, X##vu; f16x4 X##cr, X##pr, X##ck, X##pk, X##cv, X##pv, X##vf; { \
            const unsigned n_ = (unsigned)(h * 64 + 16 * (nt) + tok), cb_ = (unsigned)(h * 64 + 16 * (nt) + 4 * fq); \
            X##wu0 = *(const f16x8*)(WUPT + (n_ * 64u + 8u * fq) * 2u); X##wu1 = *(const f16x8*)(WUPT + (n_ * 64u + 8u * fq + 32u) * 2u); \
            X##au0 = *(const f16x8*)(AUPT + (n_ * 64u + 8u * fq) * 2u); X##au1 = *(const f16x8*)(AUPT + (n_ * 64u + 8u * fq + 32u) * 2u); \
            if (l > 0) { X##vu = *(const f16x8*)(VUPT + (n_ * 32u + 8u * fq) * 2u); X##vf = *(const f16x4*)(VF + (m * (unsigned)RW_W + cb_) * 2u); } \
            X##cr = *(const f16x4*)(Ub + uo + ((unsigned)C_R + cb_) * 2u); X##pr = *(const f16x4*)(Ub + po + ((unsigned)C_R + cb_) * 2u); \
            X##ck = *(const f16x4*)(Ub + uo + ((unsigned)C_K + cb_) * 2u); X##pk = *(const f16x4*)(Ub + po + ((unsigned)C_K + cb_) * 2u); \
            X##cv = *(const f16x4*)(Ub + uo + ((unsigned)C_V + cb_) * 2u); X##pv = *(const f16x4*)(Ub + po + ((unsigned)C_V + cb_) * 2u); }
        f16x8 bW[2], bA[2], bVD;
#pragma unroll
        for (int s = 0; s < 2; ++s) { float xw[8], xa[8];
            const f32x4 mw0 = *(const LAS f32x4*)(prm + PRM_MU + C_WL + 8 * fq + 32 * s), mw1 = *(const LAS f32x4*)(prm + PRM_MU + C_WL + 8 * fq + 32 * s + 4);
            const f32x4 ma0 = *(const LAS f32x4*)(prm + PRM_MU + C_AL + 8 * fq + 32 * s), ma1 = *(const LAS f32x4*)(prm + PRM_MU + C_AL + 8 * fq + 32 * s + 4);
#pragma unroll
            for (int j = 0; j < 8; ++j) { const float cw_ = (float)cW[s][j], pw_ = hp ? (float)pW[s][j] : 0.f, ca_ = (float)cA[s][j], pa_ = hp ? (float)pA[s][j] : 0.f;
                xw[j] = fast_tanh(cw_ + (j < 4 ? mw0[j & 3] : mw1[j & 3]) * (pw_ - cw_)); xa[j] = ca_ + (j < 4 ? ma0[j & 3] : ma1[j & 3]) * (pa_ - ca_); }
            bW[s] = pack8(xw); bA[s] = pack8(xa); }
        if (l > 0) { float xv[8];
#pragma unroll
            for (int j = 0; j < 8; ++j) xv[j] = (float)vd0[j] + (hp ? (float)vd1[j] : 0.f);
            bVD = pack8(xv); }
        float ssq = 0.f, bon = 0.f;
        LAS unsigned char* rec = wl + tok * RWA_REC;
#define RW_TCOMP(X, nt) { const int cb = h * 64 + 16 * (nt) + 4 * fq, co = 16 * (nt) + 4 * fq; \
            f32x4 DWn = (f32x4){0.f, 0.f, 0.f, 0.f}, DAn = DWn, Gn = DWn; \
            DWn = __builtin_amdgcn_mfma_f32_16x16x32_f16(X##wu0, bW[0], DWn, 0, 0, 0); DWn = __builtin_amdgcn_mfma_f32_16x16x32_f16(X##wu1, bW[1], DWn, 0, 0, 0); \
            DAn = __builtin_amdgcn_mfma_f32_16x16x32_f16(X##au0, bA[0], DAn, 0, 0, 0); DAn = __builtin_amdgcn_mfma_f32_16x16x32_f16(X##au1, bA[1], DAn, 0, 0, 0); \
            if (l > 0) Gn = __builtin_amdgcn_mfma_f32_16x16x32_f16(X##vu, bVD, Gn, 0, 0, 0); \
            f16x4 wv, al, be, km, rr, vo; \
            _Pragma("unroll") for (int i = 0; i < 4; ++i) { const LAS float* pc = prm + cb + i; \
                const float cr_ = (float)X##cr[i], ck_ = (float)X##ck[i], cv_ = (float)X##cv[i]; \
                const float rs = cr_ + pc[PRM_MU + C_R] * ((hp ? (float)X##pr[i] : 0.f) - cr_), ks = ck_ + pc[PRM_MU + C_K] * ((hp ? (float)X##pk[i] : 0.f) - ck_), vs = cv_ + pc[PRM_MU + C_V] * ((hp ? (float)X##pv[i] : 0.f) - cv_); \
                wv[i] = (f16)__expf(-0.6065306597126334f * sigmoidf_(pc[PRM_W0] + DWn[i])); \
                const float aa = sigmoidf_(pc[PRM_A0] + DAn[i]); \
                float vv = vs; if (l > 0) vv = vs + ((float)X##vf[i] - vs) * sigmoidf_(pc[PRM_V0] + Gn[i]); \
                const float kk = ks * pc[PRM_KK]; ssq += kk * kk; \
                const float kmod = ks * (1.0f + (aa - 1.0f) * pc[PRM_KA]); \
                bon += rs * kmod * pc[PRM_RK]; \
                al[i] = (f16)(-kk); be[i] = (f16)(kk * aa); km[i] = (f16)kmod; rr[i] = (f16)rs; vo[i] = (f16)vv; \
                asm volatile("" ::: "memory"); } \
            *(LAS f16x4*)(rec + co * 2) = wv; \
            *(LAS f16x4*)(rec + 128 + co * 2) = al; *(LAS f16x4*)(rec + 256 + co * 2) = be; *(LAS f16x4*)(rec + 384 + co * 2) = km; *(LAS f16x4*)(rec + 512 + co * 2) = rr; \
            *(LAS f16x4*)(wl + RWA_VPL + tok * RWA_VROW + co * 2) = vo; \
            *(f16x4*)(VP + (m * (unsigned)RW_W + (unsigned)cb) * 2u) = vo; \
            if (l == 0) *(f16x4*)(VF + (m * (unsigned)RW_W + (unsigned)cb) * 2u) = vo; }
#pragma unroll 1
        for (int nt = 0; nt < 4; ++nt) { RW_TLOAD(T0, nt) RW_TCOMP(T0, nt) asm volatile("" ::: "memory"); }
#undef RW_TLOAD
#undef RW_TCOMP
        ssq += shfl_xor_f(ssq, 16); ssq += shfl_xor_f(ssq, 32);
        bon += shfl_xor_f(bon, 16); bon += shfl_xor_f(bon, 32);
        { const float inv = 1.0f / fmaxf(sqrtf(ssq), 1e-12f);
          if (fq == 0) { *(LAS float*)(wl + RWA_INV + tok * 4) = inv * inv; *(float*)((char*)BONG + (m * 8u + (unsigned)h) * 4u) = bon; } }
        const unsigned mb = (unsigned)(b * SEQ + c * CH + blk * 16);
        asm volatile("s_waitcnt lgkmcnt(0)" ::: "memory");
        u32x4 A[8];
#pragma unroll
        for (int g = 0; g < 8; ++g) A[g] = *(const LAS u32x4*)(wl + 128 + g * 16);
        float vv = (float)*(const LAS f16*)(wl + RWA_VPL + lane_ * 2); float inv2 = *(const LAS float*)(wl + RWA_INV);
#define RW_LDU(W4, B4, K4, R4, g) { W4 = *(const LAS u32x4*)(rc + (g) * 16); B4 = *(const LAS u32x4*)(rc + 256 + (g) * 16); K4 = *(const LAS u32x4*)(rc + 384 + (g) * 16); R4 = *(const LAS u32x4*)(rc + 512 + (g) * 16); }
#define RW_COMP(W4, B4, K4, R4, g) { float tP[8], tL[8]; \
            _Pragma("unroll") for (int j = 0; j < 8; ++j) tP[j] = MMIX(saP, B4, j); \
            _Pragma("unroll") for (int j = 0; j < 8; ++j) tL[j] = MMIX(saL, B4, j); \
            _Pragma("unroll") for (int j = 0; j < 8; ++j) tL[j] = FMIX(vv, K4, j, tL[j]); \
            _Pragma("unroll") for (int j = 0; j < 8; ++j) P[8 * (g) + j] = FMIX(P[8 * (g) + j], W4, j, tP[j]); \
            _Pragma("unroll") for (int j = 0; j < 8; ++j) L[8 * (g) + j] = FMIX(L[8 * (g) + j], W4, j, tL[j]); \
            _Pragma("unroll") for (int j = 0; j < 8; ++j) qa[j] = FMIX(P[8 * (g) + j], R4, j, qa[j]); \
            _Pragma("unroll") for (int j = 0; j < 8; ++j) ya[j] = FMIX(L[8 * (g) + j], R4, j, ya[j]); }
#pragma unroll 1
        for (int t2 = 0; t2 < 16; ++t2) {
            const LAS unsigned char* rc = wl + t2 * RWA_REC;
            u32x4 we, be, ke, re, wo, bo, ko, ro;
            RW_LDU(we, be, ke, re, 0)
            float sP[8], sL[8];
#pragma unroll
            for (int j = 0; j < 8; ++j) { sP[j] = 0.f; sL[j] = 0.f; }
#pragma unroll
            for (int g = 0; g < 8; ++g) {
#pragma unroll
                for (int j = 0; j < 8; ++j) sP[j] = FMIX(P[8 * g + j], A[g], j, sP[j]);
#pragma unroll
                for (int j = 0; j < 8; ++j) sL[j] = FMIX(L[8 * g + j], A[g], j, sL[j]); }
            const float saP = inv2 * (((sP[0] + sP[1]) + (sP[2] + sP[3])) + ((sP[4] + sP[5]) + (sP[6] + sP[7]))), saL = inv2 * (((sL[0] + sL[1]) + (sL[2] + sL[3])) + ((sL[4] + sL[5]) + (sL[6] + sL[7])));
            float qa[8], ya[8];
#pragma unroll
            for (int j = 0; j < 8; ++j) { qa[j] = 0.f; ya[j] = 0.f; }
            RW_LDU(wo, bo, ko, ro, 1) RW_COMP(we, be, ke, re, 0)
            RW_LDU(we, be, ke, re, 2) RW_COMP(wo, bo, ko, ro, 1)
            RW_LDU(wo, bo, ko, ro, 3) RW_COMP(we, be, ke, re, 2)
            RW_LDU(we, be, ke, re, 4) RW_COMP(wo, bo, ko, ro, 3)
            RW_LDU(wo, bo, ko, ro, 5) RW_COMP(we, be, ke, re, 4)
            RW_LDU(we, be, ke, re, 6) RW_COMP(wo, bo, ko, ro, 5)
            RW_LDU(wo, bo, ko, ro, 7) RW_COMP(we, be, ke, re, 6)
            const float vvn = (float)*(const LAS f16*)(wl + RWA_VPL + ((t2 + 1) & 15) * RWA_VROW + lane_ * 2); const float inv2n = *(const LAS float*)(wl + RWA_INV + ((t2 + 1) & 15) * 4);
#pragma unroll
            for (int g = 0; g < 8; ++g) A[g] = *(const LAS u32x4*)(rc + RWA_REC + 128 + g * 16);
            RW_COMP(wo, bo, ko, ro, 7)
            vv = vvn; inv2 = inv2n;
            *(f16*)((char*)MIX + ((mb + t2) * (unsigned)DM + (unsigned)(h * 64 + lane_)) * 2u) = (f16)(((ya[0] + ya[1]) + (ya[2] + ya[3])) + ((ya[4] + ya[5]) + (ya[6] + ya[7])));
            *(f16*)((char*)QT + ((mb + t2) * (unsigned)RW_W + (unsigned)(h * 64 + lane_)) * 2u) = (f16)(((qa[0] + qa[1]) + (qa[2] + qa[3])) + ((qa[4] + qa[5]) + (qa[6] + qa[7])));
        }
#undef RW_LDU
#undef RW_COMP
    }
    store_row64_f16(RL + (((size_t)bh * NCH + c) * 64 + lane) * 64, L);
    f16* pt = PT + ((size_t)bh * NCH + c) * 4096;
#pragma unroll
    for (int k = 0; k < 64; ++k) pt[k * 64 + lane] = (f16)P[k];
}

constexpr int HGA_REC = 384, HGA_V = 16 * HGA_REC, HGA_HEAD = HGA_V + 2048, HGA_BYTES = 2 * HGA_HEAD;
template <int NH>
__device__ __forceinline__ void hgrn_waveA(const Args& a, int l, int b, int c, int h0, LAS unsigned char* wl) {
    char* U = (char*)(a.ws + WS_U); char* MIX = (char*)(a.ws + WS_MIX); f16* HL = (f16*)(a.ws + WS_HL); float* DC = (float*)(a.ws + WS_DC);
    const float* lbr = a.in[16];
    float S[NH][64]; float dpr[NH];
#pragma unroll
    for (int j = 0; j < NH; ++j) { dpr[j] = 1.f;
#pragma unroll
        for (int k = 0; k < 64; ++k) S[j][k] = 0.f; }
#pragma unroll 1
    for (int blk = 0; blk < 4; ++blk) {
        const int lane_ = lane_now();
        const unsigned mb = (unsigned)(b * SEQ + c * CH + blk * 16);
        {
            f16 fr[NH][16], qr[NH][16], vr[NH][16];
#pragma unroll
            for (int j = 0; j < NH; ++j)
#pragma unroll
                for (int tk = 0; tk < 16; ++tk) { const char* ur = U + (mb + tk) * (unsigned)(NU * 2) + (unsigned)((h0 + j) * 64 + lane_) * 2u; fr[j][tk] = *(const f16*)(ur + C_HGF * 2); qr[j][tk] = *(const f16*)(ur + C_HGQ * 2); vr[j][tk] = *(const f16*)(ur + C_HGI * 2); }
#pragma unroll
            for (int j = 0; j < NH; ++j) { const int col = (h0 + j) * 64 + lane_;
                const float lb = (l == 0) ? 0.f : sigmoidf_(lbr[384 + col] - lbr[col]);
                float dp = dpr[j];
#pragma unroll
                for (int tk = 0; tk < 16; ++tk) {
                    const float f = lb + (1.0f - lb) * sigmoidf_((float)fr[j][tk]);
                    LAS unsigned char* rec = wl + j * HGA_HEAD + tk * HGA_REC;
                    *(LAS f16*)(rec + lane_ * 2) = (f16)f; *(LAS f16*)(rec + 128 + lane_ * 2) = (f16)(1.0f - f); *(LAS f16*)(rec + 256 + lane_ * 2) = qr[j][tk];
                    *(LAS f16*)(wl + j * HGA_HEAD + HGA_V + tk * 128 + lane_ * 2) = vr[j][tk];
                    dp *= f;
                    *(f16*)(U + (mb + tk) * (unsigned)(NU * 2) + (unsigned)(C_HGQ + col) * 2u) = (f16)((float)qr[j][tk] * dp);
                }
                dpr[j] = dp; }
        }
        asm volatile("s_waitcnt lgkmcnt(0)" ::: "memory");
#define HG_LD(F4, K4, Q4, rcp, g) { F4 = *(const LAS u32x4*)((rcp) + (g) * 16); K4 = *(const LAS u32x4*)((rcp) + 128 + (g) * 16); Q4 = *(const LAS u32x4*)((rcp) + 256 + (g) * 16); }
#define HG_COMP(Sx, vi, F4, K4, Q4, g) { float tt[8]; \
            _Pragma("unroll") for (int jj = 0; jj < 8; ++jj) tt[jj] = MMIX(vi, K4, jj); \
            _Pragma("unroll") for (int jj = 0; jj < 8; ++jj) Sx[8 * (g) + jj] = FMIX(Sx[8 * (g) + jj], F4, jj, tt[jj]); \
            _Pragma("unroll") for (int jj = 0; jj < 8; ++jj) oa[jj] = FMIX(Sx[8 * (g) + jj], Q4, jj, oa[jj]); }
#define HG_HEAD(Sx, vi, rcp, rcn, oo) { float oa[8]; _Pragma("unroll") for (int jj = 0; jj < 8; ++jj) oa[jj] = 0.f; \
            HG_LD(f4o, k4o, q4o, rcp, 1) HG_COMP(Sx, vi, f4e, k4e, q4e, 0) \
            HG_LD(f4e, k4e, q4e, rcp, 2) HG_COMP(Sx, vi, f4o, k4o, q4o, 1) \
            HG_LD(f4o, k4o, q4o, rcp, 3) HG_COMP(Sx, vi, f4e, k4e, q4e, 2) \
            HG_LD(f4e, k4e, q4e, rcp, 4) HG_COMP(Sx, vi, f4o, k4o, q4o, 3) \
            HG_LD(f4o, k4o, q4o, rcp, 5) HG_COMP(Sx, vi, f4e, k4e, q4e, 4) \
            HG_LD(f4e, k4e, q4e, rcp, 6) HG_COMP(Sx, vi, f4o, k4o, q4o, 5) \
            HG_LD(f4o, k4o, q4o, rcp, 7) HG_COMP(Sx, vi, f4e, k4e, q4e, 6) \
            HG_LD(f4e, k4e, q4e, rcn, 0) HG_COMP(Sx, vi, f4o, k4o, q4o, 7) \
            oo = ((oa[0] + oa[1]) + (oa[2] + oa[3])) + ((oa[4] + oa[5]) + (oa[6] + oa[7])); }
        u32x4 f4e, k4e, q4e, f4o, k4o, q4o;
        HG_LD(f4e, k4e, q4e, wl, 0)
        f16 vh[NH], vn[NH];
#pragma unroll
        for (int j = 0; j < NH; ++j) vh[j] = *(const LAS f16*)(wl + j * HGA_HEAD + HGA_V + lane_ * 2);
#pragma unroll 1
        for (int t2 = 0; t2 < 16; ++t2) {
            const LAS unsigned char* rc = wl + t2 * HGA_REC;
#pragma unroll
            for (int j = 0; j < NH; ++j) vn[j] = *(const LAS f16*)(wl + j * HGA_HEAD + HGA_V + ((t2 + 1) & 15) * 128 + lane_ * 2);
            float oo[NH];
#pragma unroll
            for (int j = 0; j < NH; ++j) { const float vi = (float)vh[j];
                const LAS unsigned char* rcp = rc + j * HGA_HEAD; const LAS unsigned char* rcn = (j + 1 < NH) ? rc + (j + 1) * HGA_HEAD : rc + HGA_REC;
                HG_HEAD(S[j], vi, rcp, rcn, oo[j]) }
            char* mo = MIX + ((mb + t2) * (unsigned)DM + (unsigned)(384 + h0 * 64 + lane_)) * 2u;
#pragma unroll
            for (int j = 0; j < NH; ++j) { *(f16*)(mo + 128 * j) = (f16)oo[j]; vh[j] = vn[j]; }
        }
#undef HG_LD
#undef HG_COMP
#undef HG_HEAD
    }
    const int lane2 = lane_now();
#pragma unroll
    for (int j = 0; j < NH; ++j) { const int bh = b * 6 + h0 + j; store_row64_f16(HL + (((size_t)bh * NCH + c) * 64 + lane2) * 64, S[j]);
        DC[((size_t)bh * NCH + c) * 64 + lane2] = dpr[j]; }
}

__device__ __forceinline__ void lru_waveA(const Args& a, int l, int b, int c, int g, LAS unsigned char* wl) {
    const int ln = lane_now();
    const char* Ub = (const char*)(a.ws + WS_U); char* MIXb = (char*)(a.ws + WS_MIX); char* CA = (char*)(a.ws + WS_CA); float* LA = (float*)(a.ws + WS_LA); float* LH = (float*)(a.ws + WS_LH);
    const float* cw = a.in[18] + l * 4 * 256 + g * 64; const float* cb = a.in[19] + l * 256 + g * 64;
    const float* ba = a.in[21] + l * 256 + g * 64; const float* bx = a.in[23] + l * 256 + g * 64; const float* lam = a.in[24] + l * 256 + g * 64;
    const char* WAT = (const char*)(a.ws + WS_WAT) + (size_t)(l * 4 + g) * 8192; const char* WXT = (const char*)(a.ws + WS_WXT) + (size_t)(l * 4 + g) * 8192;
    LAS unsigned char* Y = wl;
    const unsigned mrow0 = (unsigned)(b * SEQ + c * CH);
#pragma unroll 2
    for (int it = 0; it < 8; ++it) { const int item = ln + 64 * it, tok = item >> 3, co = item & 7; const int t = c * CH + tok;
        const f32x4 b0 = *(const f32x4*)(cb + 8 * co), b1 = *(const f32x4*)(cb + 8 * co + 4);
        float y[8] = {b0[0], b0[1], b0[2], b0[3], b1[0], b1[1], b1[2], b1[3]};
#pragma unroll
        for (int jj = 0; jj < 4; ++jj) { const int ts = t - 3 + jj;
            if (ts >= 0) { const f16x8 x8 = *(const f16x8*)(Ub + ((mrow0 + (unsigned)(tok - 3 + jj)) * (unsigned)NU + (unsigned)(C_LRUX + g * 64 + 8 * co)) * 2u);
                const f32x4 w0 = *(const f32x4*)(cw + jj * 256 + 8 * co), w1 = *(const f32x4*)(cw + jj * 256 + 8 * co + 4);
#pragma unroll
                for (int i = 0; i < 8; ++i) y[i] += (i < 4 ? w0[i & 3] : w1[i & 3]) * (float)x8[i]; } }
        *(LAS f16x8*)(Y + tok * 144 + co * 16) = pack8(y); }
    asm volatile("s_waitcnt lgkmcnt(0)" ::: "memory");
    const int tl = ln & 15, fq = ln >> 4;
    float sp[16], cy[16], cp[16];
#pragma unroll
    for (int nt = 0; nt < 4; ++nt) { const f32x4 lm4 = *(const f32x4*)(lam + 16 * nt + 4 * fq);
#pragma unroll
        for (int i = 0; i < 4; ++i) { sp[nt * 4 + i] = log1pf(__expf(-lm4[i])); cy[nt * 4 + i] = 0.f; cp[nt * 4 + i] = 1.f; } }
#pragma unroll 1
    for (int tt = 0; tt < 4; ++tt) {
        f16x8 by[2];
#pragma unroll
        for (int s2 = 0; s2 < 2; ++s2) by[s2] = *(const LAS f16x8*)(Y + (16 * tt + tl) * 144 + (8 * fq + 32 * s2) * 2);
        const unsigned m = mrow0 + (unsigned)(16 * tt + tl);
#pragma unroll
        for (int nt = 0; nt < 4; ++nt) {
            f32x4 ra = (f32x4){0.f, 0.f, 0.f, 0.f}, rx = ra;
#pragma unroll
            for (int s2 = 0; s2 < 2; ++s2) { const unsigned wo = (unsigned)(((16 * nt + tl) * 64 + 8 * fq + 32 * s2) * 2);
                ra = __builtin_amdgcn_mfma_f32_16x16x32_f16(*(const f16x8*)(WAT + wo), by[s2], ra, 0, 0, 0);
                rx = __builtin_amdgcn_mfma_f32_16x16x32_f16(*(const f16x8*)(WXT + wo), by[s2], rx, 0, 0, 0); }
            const int ch0 = 16 * nt + 4 * fq;
            const f32x4 ba4 = *(const f32x4*)(ba + ch0), bx4 = *(const f32x4*)(bx + ch0);
            const f16x4 y4 = *(const LAS f16x4*)(Y + (16 * tt + tl) * 144 + ch0 * 2);
            f16x4 ho, co;
#pragma unroll
            for (int i = 0; i < 4; ++i) { const int q = nt * 4 + i;
                const float r = sigmoidf_(ra[i] + ba4[i]), ig = sigmoidf_(rx[i] + bx4[i]);
                const float la = -8.0f * r * sp[q];
                float av = __expf(la), uv = sqrtf(-expm1f(2.0f * la)) * (ig * (float)y4[i]);
#define LRU_SCAN(d) { const float ap = __builtin_bit_cast(float, __builtin_amdgcn_update_dpp(0x3f800000, __builtin_bit_cast(int, av), 0x110 + (d), 0xf, 0xf, false)); \
                      const float up = __builtin_bit_cast(float, __builtin_amdgcn_update_dpp(0, __builtin_bit_cast(int, uv), 0x110 + (d), 0xf, 0xf, false)); \
                      uv = av * up + uv; av = av * ap; }
                LRU_SCAN(1) LRU_SCAN(2) LRU_SCAN(4) LRU_SCAN(8)
#undef LRU_SCAN
                const float hl = uv + av * cy[q], ca = av * cp[q];
                ho[i] = (f16)hl; co[i] = (f16)ca;
                cy[q] = __builtin_bit_cast(float, __builtin_amdgcn_ds_bpermute((ln | 15) << 2, __builtin_bit_cast(int, hl)));
                cp[q] = __builtin_bit_cast(float, __builtin_amdgcn_ds_bpermute((ln | 15) << 2, __builtin_bit_cast(int, ca)));
            }
            *(f16x4*)(MIXb + (m * (unsigned)DM + 768u + (unsigned)(g * 64 + ch0)) * 2u) = ho; *(f16x4*)(CA + (m * 256u + (unsigned)(g * 64 + ch0)) * 2u) = co;
        }
    }
    if (tl == 15) {
#pragma unroll
        for (int q = 0; q < 16; ++q) { const int ch = g * 64 + 16 * (q >> 2) + 4 * fq + (q & 3); LA[((size_t)b * NCH + c) * 256 + ch] = cp[q]; LH[((size_t)b * NCH + c) * 256 + ch] = cy[q]; } }
}

__device__ __forceinline__ void phaseA(const Args& a, int l, int task, LAS unsigned char* lds, int tid) {
    asm volatile("" : "+v"(tid));
    const int lane = tid & 63, wave = __builtin_amdgcn_readfirstlane(tid >> 6);
    const int b = task / NCH, c = task % NCH;
    const f16* U = (const f16*)(a.ws + WS_U); f16* MIX = (f16*)(a.ws + WS_MIX); f16* VF = (f16*)(a.ws + WS_VF); f16* VP = (f16*)(a.ws + WS_VP);
    f16* QT = (f16*)(a.ws + WS_QT); f16* PT = (f16*)(a.ws + WS_PT); f16* RL = (f16*)(a.ws + WS_RL); float* BONG = (float*)(a.ws + WS_BON);
    {
        LAS float* prm = (LAS float*)(lds + PRM_OFF);
        for (int i = tid; i < PRM_FLOATS; i += NT) { float v;
            if (i < 1280) v = a.in[3][l * RW_SHIFT + i];
            else { const int q = (i - 1280) / 384, cc = (i - 1280) % 384;
                v = (q == 0) ? a.in[4][l * RW_W + cc] : (q == 1) ? a.in[6][l * RW_W + cc] : (q == 2) ? a.in[11][l * RW_W + cc] : (q == 3) ? a.in[12][l * RW_W + cc] : (q == 4) ? a.in[13][l * RW_W + cc] : a.in[8][cc]; }
            prm[i] = v; }
        __syncthreads();
        if (wave < RW_H) { rwkv_waveA(a, l, b, c, wave, lds + wave * RWA_BYTES, prm, lane);
                           if (wave < 4) lru_waveA(a, l, b, c, wave, lds + wave * RWA_BYTES); }
        else { LAS unsigned char* hw = lds + RW_H * RWA_BYTES + (wave - RW_H) * HGA_BYTES;
               hgrn_waveA<2>(a, l, b, c, 2 * (wave - RW_H), hw); hgrn_waveA<1>(a, l, b, c, 4 + (wave - RW_H), hw); }
        __syncthreads();
    }
}

constexpr int PB_SLOT = 16384, PB_NS = 8, PB_AHEAD = 6, NGRP = NCH / 8;
#define ARENA(ws, off) ((char*)(ws) + WS_U + (size_t)((off) >> 11) * (size_t)(NU * 2) + (size_t)((off) & 2047))
constexpr size_t AR_PGT = 0, AR_LG = 2u << 20, AR_SG = 4u << 20;
#define PB_SWZ(row, o) ((row) * 128 + (((((o) >> 4) ^ ((row) & 7)) << 4) | ((o) & 15)))
template <bool ADD_L>
__device__ __forceinline__ void pb_step(f32x4 (&Sacc)[4], const LAS unsigned char* sl, int xrow, int vl, int fq) {
    f16x8 Bhi[2], Blo[2];
#pragma unroll
    for (int mt = 0; mt < 4; ++mt)
#pragma unroll
        for (int i = 0; i < 4; ++i) { const f16 hi = (f16)Sacc[mt][i]; const f16 lo = (f16)(Sacc[mt][i] - (float)hi); Bhi[mt >> 1][4 * (mt & 1) + i] = hi; Blo[mt >> 1][4 * (mt & 1) + i] = lo; }
#pragma unroll
    for (int mt = 0; mt < 4; ++mt) {
        f32x4 d = (f32x4){0.f, 0.f, 0.f, 0.f};
        if (ADD_L) { const f16x4 l4 = *(const LAS f16x4*)(sl + 8192 + PB_SWZ(xrow, 32 * mt + 8 * fq)); d = (f32x4){(float)l4[0], (float)l4[1], (float)l4[2], (float)l4[3]}; }
#pragma unroll
        for (int s = 0; s < 2; ++s) { const u32x2 a0 = *(const LAS u32x2*)(sl + PB_SWZ(16 * mt + vl, 64 * s + 8 * fq)), a1 = *(const LAS u32x2*)(sl + PB_SWZ(16 * mt + vl, 64 * s + 32 + 8 * fq));
            u32x4 aw; aw.x = a0.x; aw.y = a0.y; aw.z = a1.x; aw.w = a1.y; const f16x8 af = __builtin_bit_cast(f16x8, aw);
            d = __builtin_amdgcn_mfma_f32_16x16x32_f16(af, Bhi[s], d, 0, 0, 0); d = __builtin_amdgcn_mfma_f32_16x16x32_f16(af, Blo[s], d, 0, 0, 0); }
        Sacc[mt] = d; }
}
__device__ __forceinline__ void pb_stage8(const Args& a, LAS unsigned char* lds, int bh, int c0, int wave, int lane) {
    const char* PT = (const char*)(a.ws + WS_PT) + ((size_t)bh * NCH + c0) * 8192; const char* RL = (const char*)(a.ws + WS_RL) + ((size_t)bh * NCH + c0) * 8192;
    const int lq = wave * 64 + lane, lrow = lq >> 3, lpp = lq & 7; const unsigned lsrc = (unsigned)(lrow * 128 + ((lpp ^ (lrow & 7)) << 4));
#pragma unroll
    for (int sl = 0; sl < 8; ++sl) { const unsigned so = (unsigned)(sl * PB_SLOT + wave * 1024); const size_t go = (size_t)sl * 8192 + lsrc;
        __builtin_amdgcn_global_load_lds((const unsigned*)(PT + go), (LAS unsigned*)(lds + so), 16, 0, 0);
        __builtin_amdgcn_global_load_lds((const unsigned*)(RL + go), (LAS unsigned*)(lds + so + 8192), 16, 0, 0); }
    asm volatile("s_waitcnt vmcnt(0)" ::: "memory");
    __builtin_amdgcn_s_barrier();
}
__device__ __forceinline__ void phaseB1(const Args& a, LAS unsigned char* lds, int tid) {
    asm volatile("" : "+v"(tid));
    const int lane = tid & 63, wave = __builtin_amdgcn_readfirstlane(tid >> 6);
    for (int task = blockIdx.x; task < 12 * NGRP; task += gridDim.x) {
        const int bh = task / NGRP, g = task % NGRP, c0 = 8 * g;
        pb_stage8(a, lds, bh, c0, wave, lane);
        const int vt = wave & 3, vl = lane & 15, fq = lane >> 4, xr = 16 * vt + vl;
        f32x4 X[4];
        if (wave < 4) {
#pragma unroll
            for (int mt = 0; mt < 4; ++mt) { const f16x4 l4 = *(const LAS f16x4*)(lds + 8192 + PB_SWZ(xr, 32 * mt + 8 * fq)); X[mt] = (f32x4){(float)l4[0], (float)l4[1], (float)l4[2], (float)l4[3]}; }
#pragma unroll 1
            for (int s = 1; s < 8; ++s) pb_step<true>(X, lds + s * PB_SLOT, xr, vl, fq);
#pragma unroll
            for (int mt = 0; mt < 4; ++mt) { f16x4 o;
#pragma unroll
                for (int i = 0; i < 4; ++i) o[i] = (f16)X[mt][i];
                *(f16x4*)ARENA(a.ws, AR_LG + ((size_t)bh * NGRP + g) * 8192 + (size_t)((xr * 64 + 16 * mt + 4 * fq) * 2)) = o; }
        } else {
#pragma unroll
            for (int mt = 0; mt < 4; ++mt)
#pragma unroll
                for (int i = 0; i < 4; ++i) X[mt][i] = (16 * mt + 4 * fq + i == xr) ? 1.f : 0.f;
#pragma unroll 1
            for (int s = 0; s < 8; ++s) pb_step<false>(X, lds + s * PB_SLOT, xr, vl, fq);
#pragma unroll
            for (int mt = 0; mt < 4; ++mt)
#pragma unroll
                for (int i = 0; i < 4; ++i) *(f16*)ARENA(a.ws, AR_PGT + ((size_t)bh * NGRP + g) * 8192 + (size_t)(((16 * mt + 4 * fq + i) * 64 + xr) * 2)) = (f16)X[mt][i];
        }
        asm volatile("s_waitcnt vmcnt(0) lgkmcnt(0)" ::: "memory");
        __builtin_amdgcn_s_barrier();
    }
}
__device__ __forceinline__ void phaseB3(const Args& a, LAS unsigned char* lds, int tid) {
    asm volatile("" : "+v"(tid));
    const int lane = tid & 63, wave = __builtin_amdgcn_readfirstlane(tid >> 6);
    for (int task = blockIdx.x; task < 12 * NGRP; task += gridDim.x) {
        const int bh = task / NGRP, g = task % NGRP, c0 = 8 * g;
        pb_stage8(a, lds, bh, c0, wave, lane);
        if (wave < 4) {
            const int vt = wave, vl = lane & 15, fq = lane >> 4, xr = 16 * vt + vl;
            char* RL = (char*)(a.ws + WS_RL) + ((size_t)bh * NCH + c0) * 8192;
            f32x4 X[4];
#pragma unroll
            for (int mt = 0; mt < 4; ++mt) { const f16x4 s4 = *(const f16x4*)ARENA(a.ws, AR_SG + ((size_t)bh * NGRP + g) * 8192 + (size_t)((xr * 64 + 16 * mt + 4 * fq) * 2)); X[mt] = (f32x4){(float)s4[0], (float)s4[1], (float)s4[2], (float)s4[3]}; }
#pragma unroll 1
            for (int s = 0; s < 8; ++s) {
#pragma unroll
                for (int mt = 0; mt < 4; ++mt) { f16x4 o;
#pragma unroll
                    for (int i = 0; i < 4; ++i) o[i] = (f16)X[mt][i];
                    *(f16x4*)(RL + (size_t)s * 8192 + (xr * 64 + 16 * mt + 4 * fq) * 2) = o; }
                if (s < 7) pb_step<true>(X, lds + s * PB_SLOT, xr, vl, fq);
            }
        }
        asm volatile("s_waitcnt vmcnt(0) lgkmcnt(0)" ::: "memory");
        __builtin_amdgcn_s_barrier();
    }
}
__device__ __forceinline__ void phaseB(const Args& a, LAS unsigned char* lds, int tid) {
    asm volatile("" : "+v"(tid));
    const int lane = tid & 63, wave = __builtin_amdgcn_readfirstlane(tid >> 6);
    const int bx = blockIdx.x;
    if (bx < 12) {
        const int bh = bx;
        const bool loader = wave >= 4;
        const int vt = wave & 3, vl = lane & 15, fq = lane >> 4, v = 16 * vt + vl;
        const int lq = (wave - 4) * 64 + lane, lrow = lq >> 3, lpp = lq & 7;
        const unsigned lsrc = (unsigned)(lrow * 128 + ((lpp ^ (lrow & 7)) << 4));
#define PB_ISSUE(cc) { const unsigned so = (unsigned)(((cc) & (PB_NS - 1)) * PB_SLOT) + (unsigned)((wave - 4) * 1024); const size_t go = ((size_t)bh * NGRP + (cc)) * 8192 + lsrc; \
            __builtin_amdgcn_global_load_lds((const unsigned*)ARENA(a.ws, AR_PGT + go), (LAS unsigned*)(lds + so), 16, 0, 0); \
            __builtin_amdgcn_global_load_lds((const unsigned*)ARENA(a.ws, AR_PGT + go + 4096), (LAS unsigned*)(lds + so + 4096), 16, 0, 0); \
            __builtin_amdgcn_global_load_lds((const unsigned*)ARENA(a.ws, AR_LG + go), (LAS unsigned*)(lds + so + 8192), 16, 0, 0); \
            __builtin_amdgcn_global_load_lds((const unsigned*)ARENA(a.ws, AR_LG + go + 4096), (LAS unsigned*)(lds + so + 12288), 16, 0, 0); }
        if (loader) {
#pragma unroll
            for (int cc = 0; cc < PB_AHEAD; ++cc) PB_ISSUE(cc)
            asm volatile("s_waitcnt vmcnt(20)" ::: "memory");
        }
        __builtin_amdgcn_s_barrier();
        f32x4 Sacc[4];
#pragma unroll
        for (int mt = 0; mt < 4; ++mt) Sacc[mt] = (f32x4){0.f, 0.f, 0.f, 0.f};
#pragma unroll 1
        for (int c = 0; c < NGRP; ++c) {
            if (loader) {
                if (c + PB_AHEAD < NGRP) { PB_ISSUE(c + PB_AHEAD) asm volatile("s_waitcnt vmcnt(20)" ::: "memory"); }
                else asm volatile("s_waitcnt vmcnt(0)" ::: "memory");
            } else {
#pragma unroll
                for (int mt = 0; mt < 4; ++mt) { f16x4 o;
#pragma unroll
                    for (int i = 0; i < 4; ++i) o[i] = (f16)Sacc[mt][i];
                    *(f16x4*)ARENA(a.ws, AR_SG + ((size_t)bh * NGRP + c) * 8192 + (size_t)((v * 64 + 16 * mt + 4 * fq) * 2)) = o; }
                pb_step<true>(Sacc, lds + (c & (PB_NS - 1)) * PB_SLOT, v, vl, fq);
                asm volatile("s_waitcnt lgkmcnt(0)" ::: "memory");
            }
            __builtin_amdgcn_s_barrier();
        }
#undef PB_ISSUE
        asm volatile("s_waitcnt vmcnt(0)" ::: "memory");
    } else if (bx < 12 + 96) {
        const int idx = (bx - 12) * NT + tid; const int bh = idx >> 12, e = idx & 4095, k = e & 63;
        f16* HL = (f16*)(a.ws + WS_HL); const float* DC = (const float*)(a.ws + WS_DC);
        float s = 0.f;
        for (int c0 = 0; c0 < NCH; c0 += 8) { float Lc[8], d[8];
#pragma unroll
            for (int j = 0; j < 8; ++j) { Lc[j] = (float)HL[((size_t)bh * NCH + c0 + j) * 4096 + e]; d[j] = DC[((size_t)bh * NCH + c0 + j) * 64 + k]; }
#pragma unroll
            for (int j = 0; j < 8; ++j) { HL[((size_t)bh * NCH + c0 + j) * 4096 + e] = (f16)s; s = d[j] * s + Lc[j]; } }
    } else if (bx == 12 + 96) {
        const int bb = tid >> 8, ch = tid & 255; const float* LA = (const float*)(a.ws + WS_LA); float* LH = (float*)(a.ws + WS_LH);
        float cy = 0.f;
        for (int c0 = 0; c0 < NCH; c0 += 8) { float A[8], H[8];
#pragma unroll
            for (int j = 0; j < 8; ++j) { const size_t o = ((size_t)bb * NCH + c0 + j) * 256 + ch; A[j] = LA[o]; H[j] = LH[o]; }
#pragma unroll
            for (int j = 0; j < 8; ++j) { const size_t o = ((size_t)bb * NCH + c0 + j) * 256 + ch; LH[o] = cy; cy = A[j] * cy + H[j]; } }
    }
}

__device__ __forceinline__ void phaseC(const Args& a, int l, int task, LAS unsigned char* lds, int tid) {
    asm volatile("" : "+v"(tid));
    const int lane = tid & 63, wave = __builtin_amdgcn_readfirstlane(tid >> 6);
    const int b = task / NCH, c = task % NCH;
    const int tl = lane & 15, fq = lane >> 4, tt = wave & 3, hg = wave >> 2;
    const unsigned m = (unsigned)(b * SEQ + c * CH + 16 * tt + tl);
    const char* U = (const char*)(a.ws + WS_U); char* MIX = (char*)(a.ws + WS_MIX); const char* VP = (const char*)(a.ws + WS_VP);
    const char* QT = (const char*)(a.ws + WS_QT); const char* RL = (const char*)(a.ws + WS_RL); const char* HL = (const char*)(a.ws + WS_HL); const float* BONG = (const float*)(a.ws + WS_BON);
    const unsigned uo = m * (unsigned)(NU * 2);
#pragma unroll
    for (int hh = 0; hh < 3; ++hh) {
        const int h = 3 * hg + hh; const int bh = b * RW_H + h;
        const char* sl = RL + ((size_t)bh * NCH + c) * 8192;
        f16x8 bq[2];
#pragma unroll
        for (int s = 0; s < 2; ++s) bq[s] = *(const f16x8*)(QT + (m * (unsigned)RW_W + (unsigned)(h * 64 + 8 * fq + 32 * s)) * 2u);
        f32x4 D[4];
#pragma unroll
        for (int vt = 0; vt < 4; ++vt) { const f16x4 yl = *(const f16x4*)(MIX + (m * (unsigned)DM + (unsigned)(h * 64 + 16 * vt + 4 * fq)) * 2u);
            f32x4 d = (f32x4){(float)yl[0], (float)yl[1], (float)yl[2], (float)yl[3]};
#pragma unroll
            for (int s = 0; s < 2; ++s) d = __builtin_amdgcn_mfma_f32_16x16x32_f16(*(const f16x8*)(sl + ((16 * vt + tl) * 64 + 8 * fq + 32 * s) * 2), bq[s], d, 0, 0, 0);
            D[vt] = d; }
        float sm = 0.f;
#pragma unroll
        for (int vt = 0; vt < 4; ++vt) sm += (D[vt][0] + D[vt][1]) + (D[vt][2] + D[vt][3]);
        sm += shfl_xor_f(sm, 16); sm += shfl_xor_f(sm, 32);
        const float mean = sm * (1.0f / 64.0f); float vr = 0.f;
#pragma unroll
        for (int vt = 0; vt < 4; ++vt)
#pragma unroll
            for (int i = 0; i < 4; ++i) { const float d = D[vt][i] - mean; vr += d * d; }
        vr += shfl_xor_f(vr, 16); vr += shfl_xor_f(vr, 32);
        const float rstd = 1.0f / sqrtf(vr * (1.0f / 64.0f) + 64e-5f);
        const float bon = BONG[m * 8u + (unsigned)h];
        const float* ln_w = a.in[14] + l * RW_W; const float* ln_b = a.in[15] + l * RW_W;
#pragma unroll
        for (int vt = 0; vt < 4; ++vt) { const unsigned col = (unsigned)(h * 64 + 16 * vt + 4 * fq);
            const f16x4 vp = *(const f16x4*)(VP + (m * (unsigned)RW_W + col) * 2u), z4 = *(const f16x4*)(U + uo + ((unsigned)C_RWZ + col) * 2u);
            const f32x4 lw = *(const f32x4*)(ln_w + col), lb = *(const f32x4*)(ln_b + col);
            f16x4 o;
#pragma unroll
            for (int i = 0; i < 4; ++i) o[i] = (f16)(((D[vt][i] - mean) * rstd * lw[i] + lb[i] + bon * (float)vp[i]) * siluf_((float)z4[i]));
            *(f16x4*)(MIX + (m * (unsigned)DM + col) * 2u) = o; }
    }
#pragma unroll
    for (int hh = 0; hh < 3; ++hh) {
        const int h = 3 * hg + hh; const int bh = b * 6 + h;
        const char* sl = HL + ((size_t)bh * NCH + c) * 8192;
        f16x8 bq[2];
#pragma unroll
        for (int s = 0; s < 2; ++s) bq[s] = *(const f16x8*)(U + uo + (unsigned)(C_HGQ + h * 64 + 8 * fq + 32 * s) * 2u);
        f32x4 D[4];
#pragma unroll
        for (int vt = 0; vt < 4; ++vt) { const f16x4 ol = *(const f16x4*)(MIX + (m * (unsigned)DM + (unsigned)(384 + h * 64 + 16 * vt + 4 * fq)) * 2u);
            f32x4 d = (f32x4){(float)ol[0], (float)ol[1], (float)ol[2], (float)ol[3]};
#pragma unroll
            for (int s = 0; s < 2; ++s) d = __builtin_amdgcn_mfma_f32_16x16x32_f16(*(const f16x8*)(sl + ((16 * vt + tl) * 64 + 8 * fq + 32 * s) * 2), bq[s], d, 0, 0, 0);
            D[vt] = d; }
        float ss = 0.f;
#pragma unroll
        for (int vt = 0; vt < 4; ++vt) ss += (D[vt][0] * D[vt][0] + D[vt][1] * D[vt][1]) + (D[vt][2] * D[vt][2] + D[vt][3] * D[vt][3]);
        ss += shfl_xor_f(ss, 16); ss += shfl_xor_f(ss, 32);
        const float rs = 1.0f / sqrtf(ss * (1.0f / 64.0f) + 1e-6f);
        const float* nw = a.in[17] + l * 384;
#pragma unroll
        for (int vt = 0; vt < 4; ++vt) { const unsigned col = (unsigned)(h * 64 + 16 * vt + 4 * fq);
            const f16x4 z4 = *(const f16x4*)(U + uo + ((unsigned)C_HGZ + col) * 2u); const f32x4 w4 = *(const f32x4*)(nw + col);
            f16x4 o;
#pragma unroll
            for (int i = 0; i < 4; ++i) o[i] = (f16)(D[vt][i] * rs * w4[i] * siluf_((float)z4[i]));
            *(f16x4*)(MIX + (m * (unsigned)DM + 384u + col) * 2u) = o; }
    }
    {
        const char* CA = (const char*)(a.ws + WS_CA); const float* LH = (const float*)(a.ws + WS_LH) + ((size_t)b * NCH + c) * 256;
#pragma unroll
        for (int q = 0; q < 4; ++q) { const unsigned ch0 = (unsigned)(128 * hg + 32 * fq + 8 * q);
            const f16x8 hl = *(const f16x8*)(MIX + (m * (unsigned)DM + 768u + ch0) * 2u), ca = *(const f16x8*)(CA + (m * 256u + ch0) * 2u), z8 = *(const f16x8*)(U + uo + ((unsigned)C_LRUZ + ch0) * 2u);
            const f32x4 c0 = *(const f32x4*)(LH + ch0), c1 = *(const f32x4*)(LH + ch0 + 4);
            f16x8 o;
#pragma unroll
            for (int i = 0; i < 8; ++i) o[i] = (f16)(((float)hl[i] + (float)ca[i] * (i < 4 ? c0[i & 3] : c1[i & 3])) * siluf_((float)z8[i]));
            *(f16x8*)(MIX + (m * (unsigned)DM + 768u + ch0) * 2u) = o; }
    }
}
#define XB_TMO      128
#define XB_XCNT(j)  (256  + 64 * (j))
#define XB_XSUB(j)  (1280 + 64 * (j))
#define XB_XGEN(j)  (2304 + 64 * (j))
#define XB_TOP      3328
#define XB_TOPGEN   3392
#define XCD_BAR_WORDS 3456
#define XB_SPIN_CAP (1u << 18)

__device__ __forceinline__ unsigned xb_ld(unsigned* p)              { return __hip_atomic_load(p, __ATOMIC_RELAXED, __HIP_MEMORY_SCOPE_AGENT); }
__device__ __forceinline__ unsigned xb_add(unsigned* p, unsigned v) { return __hip_atomic_fetch_add(p, v, __ATOMIC_RELAXED, __HIP_MEMORY_SCOPE_AGENT); }
__device__ __forceinline__ unsigned xb_xcc_id() { return (unsigned)__builtin_amdgcn_s_getreg((3 << 11) | 20) & 0xFu; }
#define XB_SPIN(cond, bar) do { unsigned _sp = 0; while (cond) { __builtin_amdgcn_s_sleep(1); \
    if ((++_sp & 255u) == 0u) { if (xb_ld(&(bar)[XB_TMO])) break; if (_sp > XB_SPIN_CAP) { atomicAdd(&(bar)[XB_TMO], 1u); break; } } } } while (0)

struct XcdBarrier {
    unsigned* bar; unsigned x; int isw0;
    volatile LAS unsigned* st;
};

__device__ __forceinline__ XcdBarrier xcd_barrier_post(unsigned* bar, volatile LAS unsigned* st, int isw0) {
    XcdBarrier b; b.bar = bar; b.x = xb_xcc_id(); b.st = st; b.isw0 = isw0;
    if (isw0 && lane_now() == 0) (void)xb_add(&bar[XB_XCNT(b.x)], 1u);
    return b;
}
__device__ __forceinline__ void xcd_barrier_complete(unsigned* bar, unsigned x, unsigned& nloc, unsigned& nx) {
    const unsigned G = gridDim.x * gridDim.y * gridDim.z;
    unsigned sum, cnt, mine, sp = 0u;
    for (;;) {
        sum = 0u; cnt = 0u; mine = 0u;
#pragma unroll
        for (unsigned j = 0; j < 16; ++j) { const unsigned c = xb_ld(&bar[XB_XCNT(j)]); sum += c; cnt += (c > 0u) ? 1u : 0u; mine = (j == x) ? c : mine; }
        if (sum == G) break;
        __builtin_amdgcn_s_sleep(1);
        if ((++sp & 255u) == 0u) { if (xb_ld(&bar[XB_TMO])) break; if (sp > XB_SPIN_CAP) { atomicAdd(&bar[XB_TMO], 1u); break; } }
    }
    nloc = mine > 0u ? mine : 1u; nx = cnt > 0u ? cnt : 1u;
}

__device__ __forceinline__ void xcd_barrier(const XcdBarrier& b) {
    asm volatile("s_waitcnt vmcnt(0)" ::: "memory");
    __syncthreads();
    if (b.isw0 && lane_now() == 0) {
        unsigned* bar = b.bar;
        __builtin_amdgcn_s_waitcnt(0);
        unsigned nloc = b.st[0], nx = b.st[1];
        if (nloc == 0u) { xcd_barrier_complete(bar, b.x, nloc, nx); b.st[0] = nloc; b.st[1] = nx; }
        const unsigned old = xb_add(&bar[XB_XSUB(b.x)], 1u);
        const unsigned gen = old / nloc;
        if (old + 1u == (gen + 1u) * nloc) {
            __builtin_amdgcn_fence(__ATOMIC_RELEASE, "agent");
            asm volatile("s_waitcnt vmcnt(0)" ::: "memory");
            const unsigned og = xb_add(&bar[XB_TOP], 1u);
            const unsigned tg = og / nx;
            if (og + 1u == (tg + 1u) * nx) xb_add(&bar[XB_TOPGEN], 1u);
            else XB_SPIN(xb_ld(&bar[XB_TOPGEN]) == tg, bar);
            __builtin_amdgcn_fence(__ATOMIC_ACQUIRE, "agent");
            xb_add(&bar[XB_XGEN(b.x)], 1u);
            asm volatile("s_waitcnt vmcnt(0)" ::: "memory");
        } else {
            XB_SPIN(xb_ld(&bar[XB_XGEN(b.x)]) == gen, bar);
            __builtin_amdgcn_fence(__ATOMIC_ACQUIRE, "agent");
            asm volatile("s_waitcnt vmcnt(0)" ::: "memory");
        }
    }
    __syncthreads();
}

constexpr size_t WS_BAR = 16384;
constexpr int MISC_OFF = LDS_BYTES - 16;
__global__ void __launch_bounds__(NT, 2) fwd(Args args) {
    extern __shared__ __attribute__((aligned(16))) unsigned char lds_raw[];
    LAS unsigned char* lds = (LAS unsigned char*)lds_raw;
    cg::grid_group grid = cg::this_grid();
    const int wave = __builtin_amdgcn_readfirstlane((int)threadIdx.x >> 6);
#define TID_NOW() (wave * 64 + lane_now())
    const int tid = TID_NOW(); const int lane = tid & 63;
    if (wave == 0 && lane < 4) ((LAS unsigned*)(lds + MISC_OFF))[lane] = 0u;
    __syncthreads();
    XcdBarrier xbar = xcd_barrier_post((unsigned*)(args.ws + WS_BAR), (volatile LAS unsigned*)(lds + MISC_OFF), __builtin_amdgcn_readfirstlane(wave == 0 ? 1 : 0));
#define GRID_BAR() do { XcdBarrier xb_ = xbar; xb_.st = (volatile LAS unsigned*)(lds + MISC_OFF); asm volatile("" : "+s"(xb_.bar), "+s"(xb_.x)); xcd_barrier(xb_); } while (0)
    const int G = gridDim.x, gw = blockIdx.x * NWAVES + wave, NGW = G * NWAVES;
    unsigned char* ws = args.ws;
    unsigned short* XN = (unsigned short*)(ws + WS_XN);
    {
        LAS float* scr = (LAS float*)(lds + wave * 16384);
        constexpr int I_IN = (DM / 64) * (NIN / 32), I_OUT = (DM / 64) * (DM / 32), NITEMS = DEPTH * (I_IN + I_OUT);
        for (int it = gw; it < NITEMS; it += NGW) {
            int r = it; const int l = r / (I_IN + I_OUT); r -= l * (I_IN + I_OUT);
            if (r < I_IN) p0_transpose_item(args.in[2] + (size_t)l * DM * NIN, DM, NIN, (unsigned short*)(ws + WS_WIN + l * WIN_L), scr, r, lane, l == 0 ? nullptr : args.in[1] + DM);
            else p0_transpose_item(args.in[25] + (size_t)l * DM * DM, DM, DM, (unsigned short*)(ws + WS_WOUT + l * WOUT_L), scr, r - I_IN, lane, nullptr);
        }
        for (int i = gw; i < DEPTH * (NU - NIN) * DM * 2 / 1024; i += NGW) { const int l = i / ((NU - NIN) * DM * 2 / 1024), r = i % ((NU - NIN) * DM * 2 / 1024);
            if (l == 1 && r < 64 * DM * 2 / 1024) continue;
            *(u32x4*)(ws + WS_WIN + l * WIN_L + (size_t)NIN * DM * 2 + (size_t)r * 1024 + lane * 16) = (u32x4){0u, 0u, 0u, 0u}; }
        for (int i4 = blockIdx.x * NT + tid; i4 < 4 * 64 * DM; i4 += G * NT) { const int q = i4 & 3, i = i4 >> 2, k = i >> 6, n = i & 63, j = n & 31;
            const float* wrow = args.in[2] + (size_t)DM * NIN + (size_t)k * NIN + C_V + 96 * q; const float* mu1 = args.in[3] + RW_SHIFT + C_V + 96 * q; const float* vdn = args.in[9] + (96 * q) * 32 + j;
            float acc = 0.f;
#pragma unroll 8
            for (int cc = 0; cc < 96; ++cc) { const float mm = mu1[cc]; acc += wrow[cc] * ((n < 32) ? (1.0f - mm) : mm) * vdn[cc * 32]; }
            acc += shfl_xor_f(acc, 1); acc += shfl_xor_f(acc, 2);
            if (q == 0) ((f16*)(ws + WS_WIN + WIN_L))[(size_t)(NIN + n) * DM + k] = (f16)(acc * args.in[1][DM + k]); }
        for (int i = blockIdx.x * NT + tid; i < M; i += G * NT) ((float*)(ws + WS_RSS))[i] = 0.f;
        for (int m = gw; m < M; m += 4 * NGW) rms_row4_f16(args.in[0] + (size_t)m * DM, (size_t)NGW * DM, args.in[1], XN + (size_t)m * DM, lane);
        { f16* WUPT = (f16*)(ws + WS_WUPT); f16* AUPT = (f16*)(ws + WS_AUPT); f16* VDNT = (f16*)(ws + WS_VDNT); f16* VUPT = (f16*)(ws + WS_VUPT);
          for (int i = blockIdx.x * NT + tid; i < 122880; i += G * NT) {
              if (i < 49152) { const int ll = i / 24576, r = i % 24576, n = r / 64, k = r % 64; WUPT[i] = (f16)args.in[5][(size_t)ll * 24576 + k * 384 + n]; }
              else if (i < 98304) { const int i2 = i - 49152, ll = i2 / 24576, r = i2 % 24576, n = r / 64, k = r % 64; AUPT[i2] = (f16)args.in[7][(size_t)ll * 24576 + k * 384 + n]; }
              else if (i < 110592) { const int i2 = i - 98304, j2 = i2 / 384, cc = i2 % 384; VDNT[i2] = (f16)args.in[9][cc * 32 + j2]; }
              else { const int i2 = i - 110592, n = i2 / 32, j2 = i2 % 32; VUPT[i2] = (f16)args.in[10][j2 * 384 + n]; } }
          f16* WAT = (f16*)(ws + WS_WAT); f16* WXT = (f16*)(ws + WS_WXT);
          for (int i = blockIdx.x * NT + tid; i < 32768; i += G * NT) { const int lg = i >> 12, r = i & 4095, j = r >> 6, ii = r & 63; WAT[i] = (f16)args.in[20][(size_t)lg * 4096 + ii * 64 + j]; WXT[i] = (f16)args.in[22][(size_t)lg * 4096 + ii * 64 + j]; } }
    }
    if (gridDim.x > 65536u) grid.sync();
    GRID_BAR();
#pragma unroll 1
    for (int l = 0; l < DEPTH; ++l) {
        { pg8::Gemm g{XN, (const unsigned short*)(ws + WS_WIN + l * WIN_L), M, NU, DM}; pg8::StaticOrder S; S.init(M, NU, G, (int)blockIdx.x);
          pg8::EpiF16 E{(unsigned short*)(ws + WS_U), NU, l == 0 ? nullptr : (const float*)(ws + WS_RSS)};
          pg8::gemm_phase<pg8::EpiF16, pg8::StaticOrder, true, true>(lds, g, S, E, wave); }
        GRID_BAR();
        for (int task = blockIdx.x; task < BATCH * NCH; task += G) phaseA(args, l, task, lds, TID_NOW());
        GRID_BAR();
        phaseB1(args, lds, TID_NOW());
        GRID_BAR();
        phaseB(args, lds, TID_NOW());
        GRID_BAR();
        phaseB3(args, lds, TID_NOW());
        GRID_BAR();
        for (int task = blockIdx.x; task < BATCH * NCH; task += G) phaseC(args, l, task, lds, TID_NOW());
        GRID_BAR();
        { pg8::Gemm g{(const unsigned short*)(ws + WS_MIX), (const unsigned short*)(ws + WS_WOUT + l * WOUT_L), M, DM, DM}; pg8::StaticOrder S; S.init(M, DM, G, (int)blockIdx.x);
          pg8::EpiRes E{l == 0 ? args.in[0] : args.out, args.out, DM, l == 0 ? XN : nullptr, (float*)(ws + WS_RSS)};
          pg8::gemm_phase<pg8::EpiRes, pg8::StaticOrder, true, true>(lds, g, S, E, wave); }
        GRID_BAR();
        { int ln = TID_NOW() & 63; asm volatile("" : "+v"(ln));
          if (l + 1 < DEPTH) { }
          else { for (int m = gw; m < M; m += 2 * NGW) rms_row2_f32(args.out + (size_t)m * DM, args.out + (size_t)(m + NGW) * DM, args.in[26], ln); } }
    }
}

extern "C" void kernel_launch(void* const* d_in, const int* in_sizes, int n_in, void* d_out, int out_size, void* d_ws, size_t ws_size, hipStream_t stream) {
    static int grid = 0;
    if (grid == 0) {
        if (n_in != 27 || in_sizes[0] != M * DM || out_size != M * DM || ws_size < WS_END) { fprintf(stderr, "kernel_launch: unexpected problem: n_in %d in0 %d out %d ws %zu\n", n_in, n_in > 0 ? in_sizes[0] : -1, out_size, ws_size); grid = -1; return; }
        int dev = 0, cus = 0, per_cu = 0;
        hipGetDevice(&dev); hipDeviceGetAttribute(&cus, hipDeviceAttributeMultiprocessorCount, dev);
        if (hipFuncSetAttribute((const void*)fwd, hipFuncAttributeMaxDynamicSharedMemorySize, LDS_BYTES) != hipSuccess) { fprintf(stderr, "kernel_launch: hipFuncSetAttribute failed\n"); grid = -1; return; }
        if (hipOccupancyMaxActiveBlocksPerMultiprocessor(&per_cu, (const void*)fwd, NT, LDS_BYTES) != hipSuccess || per_cu < 1) { fprintf(stderr, "kernel_launch: occupancy query failed (%d)\n", per_cu); grid = -1; return; }
        grid = cus * per_cu;
    }
    if (grid < 0) return;
    if (hipMemsetAsync((char*)d_ws, 0, 65536, stream) != hipSuccess) { fprintf(stderr, "kernel_launch: memset of the barrier words failed\n"); return; }
    Args a{};
    for (int i = 0; i < 27; ++i) a.in[i] = (const float*)d_in[i];
    a.out = (float*)d_out; a.ws = (unsigned char*)d_ws;
    void* kargs[] = {&a};
    hipError_t e = hipLaunchCooperativeKernel((const void*)fwd, dim3(grid), dim3(NT), kargs, LDS_BYTES, stream);
    if (e != hipSuccess) fprintf(stderr, "cooperative launch failed: %s (grid %d)\n", hipGetErrorString(e), grid);
}
```

```cpp
#include <hip/hip_runtime.h>
#include <hip/hip_cooperative_groups.h>
#include <cstdio>
#include <cstdint>
namespace cg = cooperative_groups;
typedef _Float16 f16x8_t __attribute__((ext_vector_type(8)));
#define MK_MFMA(a, b, c) __builtin_amdgcn_mfma_f32_16x16x32_f16(__builtin_bit_cast(f16x8_t, (a)), __builtin_bit_cast(f16x8_t, (b)), (c), 0, 0, 0)
__device__ __forceinline__ int lane_now() { int z; asm volatile("v_mbcnt_lo_u32_b32 %0, -1, 0\n\tv_mbcnt_hi_u32_b32 %0, -1, %0" : "=v"(z)); return z; }
__device__ __forceinline__ float shfl_xor_f(float v, int mask) { const int ln = lane_now(); return __builtin_bit_cast(float, __builtin_amdgcn_ds_bpermute((ln ^ mask) << 2, __builtin_bit_cast(int, v))); }
namespace pg8 {
#define PG8_LAS __attribute__((address_space(3)))
typedef unsigned short bf16_t;
typedef short bf16x8 __attribute__((ext_vector_type(8)));
typedef float f32x4 __attribute__((ext_vector_type(4)));
typedef unsigned u32x4 __attribute__((ext_vector_type(4)));
constexpr int BM = 256, BK = 64, HALF = 128, HTB = HALF * BK * 2  , STAGE_BYTES = 8 * HTB, NXCD = 8, WGM = 8;

__host__ __device__ __forceinline__ int lds_byte(int r, int c) { const int st = (r >> 4) * 2 + (c >> 5), rr = r & 15, cc = c & 31, ob = rr * 64 + cc * 2; return st * 1024 + (ob ^ (((ob >> 9) & 1) << 5)); }
__host__ __device__ __forceinline__ void stage_rc(int b, int& R, int& C) { const int st = b / 1024, sb = b % 1024, swz = sb ^ (((sb >> 9) & 1) << 5); R = (st >> 1) * 16 + swz / 64; C = (st & 1) * 32 + (swz % 64) / 2; }
__host__ __device__ __forceinline__ int perm32(int rho) { const int n = rho >> 4, i = rho & 15; return 8 * (i >> 2) + 4 * n + (i & 3); }

struct Unit { int pm, pn; };
struct Gemm { const bf16_t* A; const bf16_t* Bt; int M, N, K; };

struct StaticOrder {
    int nM, nN, nwg, G, c;
    __host__ __device__ void init(int M, int N, int G_, int c_) { nM = M / BM; nN = N / BM; nwg = nM * nN; G = G_; c = c_; }
    __host__ __device__ bool next(int i, Unit& u) const {
        const long L = (long)i * G + c; if (L >= nwg) return false;
        int wgid = (int)L; { const int q = nwg / NXCD, r = nwg % NXCD, xcd = wgid % NXCD, off = wgid / NXCD; wgid = (xcd < r ? xcd * (q + 1) : r * (q + 1) + (xcd - r) * q) + off; }
        const int nig = WGM * nN, gid = wgid / nig, fm = gid * WGM, gsz = (nM - fm) < WGM ? (nM - fm) : WGM;
        u.pm = fm + ((wgid % nig) % gsz); u.pn = (wgid % nig) / gsz; return true;
    }
    __device__ __forceinline__ void a_ready(const Unit&) const {}
    __device__ __forceinline__ void done(const Unit&) const {}
};

__device__ __forceinline__ unsigned pk_f16(float lo, float hi) { typedef _Float16 h2 __attribute__((ext_vector_type(2))); h2 v; v.x = (_Float16)lo; v.y = (_Float16)hi; return __builtin_bit_cast(unsigned, v); }
typedef unsigned u32x2 __attribute__((ext_vector_type(2)));
struct EpiF16 {
    static constexpr bool PERM = true, AFTER_DRAIN = false;
    bf16_t* O; int ldc; const float* rss;
    __device__ __forceinline__ void operator()(const f32x4 (&acc)[2][2][4][2], const Unit& u, int wr, int wc, int fr, int fq) const {
        const int row0 = u.pm * BM + wr * 64 + fr; const int col0 = u.pn * BM + wc * 32 + 8 * fq;
#pragma unroll
        for (int ai = 0; ai < 2; ++ai)
#pragma unroll
            for (int m = 0; m < 4; ++m) { const int row = row0 + ai * HALF + m * 16; bf16_t* rowp = O + (size_t)row * ldc + col0;
                const float sc = rss ? 1.0f / sqrtf(rss[row] * (1.0f / 1024.0f) + 1e-6f) : 1.0f;
#pragma unroll
                for (int bj = 0; bj < 2; ++bj) { const f32x4 v0 = acc[ai][bj][m][0] * sc, v1 = acc[ai][bj][m][1] * sc;
                    u32x4 w; w.x = pk_f16(v0[0], v0[1]); w.y = pk_f16(v0[2], v0[3]); w.z = pk_f16(v1[0], v1[1]); w.w = pk_f16(v1[2], v1[3]);
                    *(u32x4*)(rowp + bj * HALF) = w; } }
    }
};
struct EpiRes {
    static constexpr bool PERM = false, AFTER_DRAIN = false;
    const float* base; float* out; int ldc; bf16_t* xh; float* rss;
    __device__ __forceinline__ void operator()(const f32x4 (&acc)[2][2][4][2], const Unit& u, int wr, int wc, int fr, int fq) const {
        const int row0 = u.pm * BM + wr * 64 + fr; const int col0 = u.pn * BM + wc * 32 + 4 * fq;
#pragma unroll
        for (int ai = 0; ai < 2; ++ai)
#pragma unroll
            for (int m = 0; m < 4; ++m) { const size_t off = (size_t)(row0 + ai * HALF + m * 16) * ldc + col0; float ss = 0.f;
#pragma unroll
                for (int bj = 0; bj < 2; ++bj)
#pragma unroll
                    for (int n = 0; n < 2; ++n) { const size_t o = off + bj * HALF + n * 16; const f32x4 b = *(const f32x4*)(base + o); const f32x4 x = b + acc[ai][bj][m][n]; *(f32x4*)(out + o) = x;
                        if (xh) { u32x2 h; h.x = pk_f16(x[0], x[1]); h.y = pk_f16(x[2], x[3]); *(u32x2*)(xh + o) = h; ss += (x[0] * x[0] + x[1] * x[1]) + (x[2] * x[2] + x[3] * x[3]); } }
                if (xh) { ss += shfl_xor_f(ss, 16); ss += shfl_xor_f(ss, 32); if (fq == 0) atomicAdd(rss + row0 + ai * HALF + m * 16, ss); }
                asm volatile("" ::: "memory"); }
    }
};

template <class Epi, class Sched, bool ALIGN_EPI = false, bool SP2 = false>
__device__ __forceinline__ void gemm_phase(PG8_LAS unsigned char* lds, const Gemm g, const Sched& S, const Epi& E, const int wave_) {
    int wv_ = wave_; asm volatile("" : "+s"(wv_)); int tid_ = lane_now() + 64 * wv_; const int tid = tid_, wid = wv_, lane = tid & 63, wr = wid >> 2, wc = wid & 3, fr = lane & 15, fq = lane >> 4;
    const int K = g.K, nt = K / BK;
    unsigned voffA[2], voffB[2];
#pragma unroll
    for (int i = 0; i < 2; ++i) { int R, C; stage_rc(tid * 16 + i * 8192, R, C); const int Rb = Epi::PERM ? ((R & ~31) + perm32(R & 31)) : R;
        voffA[i] = (unsigned)(R * K + C) * 2u; voffB[i] = (unsigned)(Rb * K + C) * 2u; }
    const size_t kstep = (size_t)(BK * 2);
    const size_t hstep = (size_t)HALF * K * 2;
    const size_t tstep = 2 * hstep;
    const unsigned ldsw = (unsigned)wid * 1024u;
    const int aoff = lds_byte(wr * 64 + fr, fq * 8), boff = lds_byte(wc * 32 + fr, fq * 8);
#define PG8_SA(b, h) (((b) * 2 + (h)) * HTB)
#define PG8_SB(b, h) ((4 + (b) * 2 + (h)) * HTB)
#define PG8_STAGE(bufoff, gbase, voff) do { _Pragma("unroll") for (int _i = 0; _i < 2; ++_i) \
        __builtin_amdgcn_global_load_lds((const unsigned*)((const char*)(gbase) + (voff)[_i]), (PG8_LAS unsigned*)(lds + (bufoff) + ldsw + _i * 8192), 16, 0, 0); } while (0)
#define PG8_LDA(dst, b, h) do { _Pragma("unroll") for (int m = 0; m < 4; ++m) _Pragma("unroll") for (int k = 0; k < 2; ++k) dst[m][k] = *(const PG8_LAS bf16x8*)(lds + PG8_SA(b, h) + aoff + m * 2048 + k * 1024); } while (0)
#define PG8_LDB(dst, b, h) do { _Pragma("unroll") for (int n = 0; n < 2; ++n) _Pragma("unroll") for (int k = 0; k < 2; ++k) dst[n][k] = *(const PG8_LAS bf16x8*)(lds + PG8_SB(b, h) + boff + n * 2048 + k * 1024); } while (0)
#define PG8_MMA(ai, bj, At, Bt) do { __builtin_amdgcn_s_setprio(1); _Pragma("unroll") for (int m = 0; m < 4; ++m) _Pragma("unroll") for (int n = 0; n < 2; ++n) _Pragma("unroll") for (int k = 0; k < 2; ++k) \
        acc[ai][bj][m][n] = MK_MFMA(Bt[n][k], At[m][k], acc[ai][bj][m][n]); __builtin_amdgcn_s_setprio(0); } while (0)
#define PG8_WAIT_V(n) asm volatile("s_waitcnt vmcnt(" #n ")" ::: "memory")
#define PG8_WAIT_L(n) asm volatile("s_waitcnt lgkmcnt(" #n ")" ::: "memory")
#define PG8_BAR __builtin_amdgcn_s_barrier()
#define PG8_SCHED __builtin_amdgcn_sched_barrier(0)
    Unit cur, nxt; int ui = 0;
    if (!S.next(0, cur)) return;
    f32x4 acc[2][2][4][2];
#pragma unroll
    for (int a = 0; a < 2; ++a)
#pragma unroll
        for (int b = 0; b < 2; ++b)
#pragma unroll
            for (int m = 0; m < 4; ++m)
#pragma unroll
                for (int n = 0; n < 2; ++n) acc[a][b][m][n] = (f32x4){0.f, 0.f, 0.f, 0.f};
    bf16x8 At[4][2], B0[2][2], B1[2][2];
    const char* cA = (const char*)g.A + (size_t)cur.pm * tstep; const char* cB = (const char*)g.Bt + (size_t)cur.pn * tstep;
    S.a_ready(cur);
    if constexpr (SP2) {
        PG8_STAGE(PG8_SB(0, 0), cB, voffB); PG8_STAGE(PG8_SB(0, 1), cB + hstep, voffB); PG8_STAGE(PG8_SA(0, 0), cA, voffA); PG8_STAGE(PG8_SA(0, 1), cA + hstep, voffA);
        if (wr == 1) PG8_BAR;
        PG8_WAIT_V(2); PG8_BAR;
        PG8_STAGE(PG8_SB(1, 0), cB + kstep, voffB); PG8_STAGE(PG8_SA(1, 0), cA + kstep, voffA); PG8_STAGE(PG8_SB(1, 1), cB + hstep + kstep, voffB);
        PG8_WAIT_V(6); PG8_BAR;
    } else {
        PG8_STAGE(PG8_SB(0, 0), cB, voffB); PG8_STAGE(PG8_SA(0, 0), cA, voffA); PG8_STAGE(PG8_SB(0, 1), cB + hstep, voffB); PG8_STAGE(PG8_SA(0, 1), cA + hstep, voffA);
        if (wr == 1) PG8_BAR;
        PG8_WAIT_V(4); PG8_BAR;
        PG8_STAGE(PG8_SB(1, 0), cB + kstep, voffB); PG8_STAGE(PG8_SA(1, 0), cA + kstep, voffA); PG8_STAGE(PG8_SB(1, 1), cB + hstep + kstep, voffB);
        PG8_WAIT_V(6); PG8_BAR;
    }
    for (;;) {
        const bool has_next = S.next(ui + 1, nxt);
        const char* nA = has_next ? (const char*)g.A + (size_t)nxt.pm * tstep : cA; const char* nB = has_next ? (const char*)g.Bt + (size_t)nxt.pn * tstep : cB;
        for (int t = 0; t < nt; t += 2) {
            const bool last = (t == nt - 2);
            const char* a1 = cA + (size_t)(t + 1) * kstep;
            const char* a2 = last ? nA : cA + (size_t)(t + 2) * kstep; const char* b2 = last ? nB : cB + (size_t)(t + 2) * kstep;
            const char* a3 = a2 + kstep; const char* b3 = b2 + kstep;
            if (last && has_next) S.a_ready(nxt);
            if constexpr (SP2) {
            PG8_LDB(B0, 0, 0); PG8_LDB(B1, 0, 1); PG8_SCHED; PG8_LDA(At, 0, 0); PG8_STAGE(PG8_SA(1, 1), a1 + hstep, voffA);
            PG8_WAIT_V(8); PG8_WAIT_L(0); PG8_BAR; PG8_MMA(0, 0, At, B0); PG8_MMA(0, 1, At, B1); PG8_BAR; PG8_SCHED;
            PG8_LDA(At, 0, 1); PG8_STAGE(PG8_SB(0, 0), b2, voffB); PG8_STAGE(PG8_SB(0, 1), b2 + hstep, voffB); PG8_STAGE(PG8_SA(0, 0), a2, voffA);
            PG8_WAIT_V(8); PG8_WAIT_L(0); PG8_BAR; PG8_MMA(1, 0, At, B0); PG8_MMA(1, 1, At, B1); PG8_BAR; PG8_SCHED;
            PG8_LDB(B0, 1, 0); PG8_LDB(B1, 1, 1); PG8_SCHED; PG8_LDA(At, 1, 0); PG8_STAGE(PG8_SA(0, 1), a2 + hstep, voffA);
            PG8_WAIT_V(8); PG8_WAIT_L(0); PG8_BAR; PG8_MMA(0, 0, At, B0); PG8_MMA(0, 1, At, B1); PG8_BAR; PG8_SCHED;
            PG8_LDA(At, 1, 1); PG8_STAGE(PG8_SB(1, 0), b3, voffB); PG8_STAGE(PG8_SB(1, 1), b3 + hstep, voffB); PG8_STAGE(PG8_SA(1, 0), a3, voffA);
            PG8_WAIT_V(8); PG8_WAIT_L(0); PG8_BAR; PG8_MMA(1, 0, At, B0); PG8_MMA(1, 1, At, B1); PG8_BAR; PG8_SCHED;
            } else {
            PG8_LDB(B0, 0, 0); PG8_SCHED; PG8_LDA(At, 0, 0); PG8_STAGE(PG8_SA(1, 1), a1 + hstep, voffA);
            PG8_WAIT_L(8); PG8_BAR; PG8_WAIT_L(0); PG8_MMA(0, 0, At, B0); PG8_BAR; PG8_SCHED;
            PG8_LDB(B1, 0, 1); PG8_STAGE(PG8_SB(0, 0), b2, voffB);
            PG8_BAR; PG8_WAIT_L(0); PG8_MMA(0, 1, At, B1); PG8_BAR;
            PG8_LDA(At, 0, 1); PG8_STAGE(PG8_SA(0, 0), a2, voffA);
            PG8_BAR; PG8_WAIT_L(0); PG8_MMA(1, 0, At, B0); PG8_BAR; PG8_SCHED;
            PG8_STAGE(PG8_SB(0, 1), b2 + hstep, voffB);
            PG8_WAIT_V(6); PG8_BAR; PG8_MMA(1, 1, At, B1); PG8_BAR;
            PG8_LDB(B0, 1, 0); PG8_SCHED; PG8_LDA(At, 1, 0); PG8_STAGE(PG8_SA(0, 1), a2 + hstep, voffA);
            PG8_WAIT_L(8); PG8_BAR; PG8_WAIT_L(0); PG8_MMA(0, 0, At, B0); PG8_BAR; PG8_SCHED;
            PG8_LDB(B1, 1, 1); PG8_STAGE(PG8_SB(1, 0), b3, voffB);
            PG8_BAR; PG8_WAIT_L(0); PG8_MMA(0, 1, At, B1); PG8_BAR;
            PG8_LDA(At, 1, 1); PG8_STAGE(PG8_SA(1, 0), a3, voffA);
            PG8_BAR; PG8_WAIT_L(0); PG8_MMA(1, 0, At, B0); PG8_BAR; PG8_SCHED;
            PG8_STAGE(PG8_SB(1, 1), b3 + hstep, voffB);
            PG8_WAIT_V(6); PG8_BAR; PG8_MMA(1, 1, At, B1); PG8_BAR;
            }
        }
        if constexpr (ALIGN_EPI) { if (wr == 0) PG8_BAR; }
        if constexpr (!Epi::AFTER_DRAIN) { E(acc, cur, wr, wc, fr, fq); S.done(cur); }
        if (!has_next) break;
#pragma unroll
        for (int a = 0; a < 2; ++a)
#pragma unroll
            for (int b = 0; b < 2; ++b)
#pragma unroll
                for (int m = 0; m < 4; ++m)
#pragma unroll
                    for (int n = 0; n < 2; ++n) acc[a][b][m][n] = (f32x4){0.f, 0.f, 0.f, 0.f};
        cur = nxt; cA = nA; cB = nB; ++ui;
        if constexpr (ALIGN_EPI) { if (wr == 1) PG8_BAR; }
    }
    PG8_WAIT_V(0);
    if constexpr (!ALIGN_EPI) { if (wr == 0) PG8_BAR; }
    PG8_BAR;
    if constexpr (Epi::AFTER_DRAIN) { E.fused(acc, cur, wr, wc, fr, fq, lds, wid, lane); S.done(cur); }
#undef PG8_SA
#undef PG8_SB
#undef PG8_STAGE
#undef PG8_LDA
#undef PG8_LDB
#undef PG8_MMA
#undef PG8_WAIT_V
#undef PG8_WAIT_L
#undef PG8_BAR
#undef PG8_SCHED
}
}

constexpr int BATCH = 2, SEQ = 8192, DM = 1024, DEPTH = 2, M = BATCH * SEQ;
constexpr int RW_H = 6, HD = 64, RW_W = 384, RW_SHIFT = 1280;
constexpr int NIN = 3712, NU = 3840;
constexpr int C_R = 0, C_K = 384, C_V = 768, C_WL = 1152, C_AL = 1216, C_RWZ = 1280, C_HGQ = 1664, C_HGF = 2048, C_HGI = 2432, C_HGZ = 2816, C_LRUX = 3200, C_LRUZ = 3456;
constexpr int CH = 64;
constexpr int NWAVES = 8, NT = NWAVES * 64;
constexpr int LDS_BYTES = 163840;
constexpr int PRM_OFF = 138240;
constexpr size_t MiB = 1u << 20;
constexpr size_t WS_WUPT = 65536, WS_AUPT = WS_WUPT + 98304, WS_VDNT = WS_AUPT + 98304, WS_VUPT = WS_VDNT + 24576, WS_WAT = WS_VUPT + 24576, WS_WXT = WS_WAT + 65536;
constexpr size_t WS_WIN = 1 * MiB, WIN_L = (size_t)NU * DM * 2;
constexpr size_t WS_WOUT = 16 * MiB, WOUT_L = (size_t)DM * DM * 2;
constexpr size_t WS_XN = 20 * MiB;
constexpr size_t WS_QT = 20 * MiB;
constexpr size_t WS_PT = 32 * MiB;
constexpr size_t WS_CA = 44 * MiB;
constexpr size_t WS_U = 52 * MiB;
constexpr size_t WS_MIX = 172 * MiB;
constexpr size_t WS_VF = 204 * MiB;
constexpr size_t WS_VP = 216 * MiB;
constexpr size_t WS_RL = 228 * MiB;
constexpr size_t WS_HL = 240 * MiB;
constexpr size_t WS_BON = 252 * MiB;
constexpr size_t WS_DC = WS_BON + 512 * 1024;
constexpr size_t WS_LA = WS_DC + 512 * 1024;
constexpr size_t WS_LH = WS_LA + 256 * 1024;
constexpr size_t WS_RSS = WS_LH + 256 * 1024;
constexpr size_t WS_END = 254 * MiB;
constexpr int NCH = SEQ / CH;

#define LAS __attribute__((address_space(3)))
typedef float f32x4 __attribute__((ext_vector_type(4)));
typedef unsigned u32x2 __attribute__((ext_vector_type(2)));
typedef unsigned u32x4 __attribute__((ext_vector_type(4)));
typedef _Float16 f16;
typedef _Float16 f16x8 __attribute__((ext_vector_type(8)));
#define LDS_WAIT() asm volatile("s_waitcnt lgkmcnt(0)" ::: "memory")

struct Args { const float* in[27]; float* out; unsigned char* ws; };

__device__ __forceinline__ float wave_sum(float v) {
#pragma unroll
    for (int o = 1; o < 64; o <<= 1) v += shfl_xor_f(v, o);
    return v;
}
__device__ __forceinline__ float sigmoidf_(float x) { return __builtin_amdgcn_rcpf(1.0f + __expf(-x)); }
__device__ __forceinline__ float rsq_(float x) { return __builtin_amdgcn_rsqf(x); }
__device__ __forceinline__ float one_minus_exp_(float x) { return (x > -0.03f) ? -x * (1.0f + x * (0.5f + x * (1.0f / 6.0f + x * (1.0f / 24.0f)))) : 1.0f - __expf(x); }
__device__ __forceinline__ float siluf_(float x) { return x * __builtin_amdgcn_rcpf(1.0f + __expf(-x)); }

__device__ __forceinline__ void p0_transpose_item(const float* W, int K, int N, unsigned short* WT, LAS float* scr, int item, int lane, const float* rsc) {
    const int nblk = N / 32, kb = item / nblk, nb = item % nblk, k0 = 64 * kb, n0 = 32 * nb;
#pragma unroll 8
    for (int i = 0; i < 32; ++i) { const int kk = 2 * i + (lane >> 5); scr[kk * 33 + (lane & 31)] = W[(size_t)(k0 + kk) * N + n0 + (lane & 31)] * (rsc ? rsc[k0 + kk] : 1.0f); }
    LDS_WAIT(); asm volatile("" ::: "memory");
    const int c = lane & 7;
#pragma unroll
    for (int j = 0; j < 4; ++j) { const int n = (lane >> 3) + 8 * j; const LAS float* s = scr + (8 * c) * 33 + n;
        u32x4 o; o.x = pg8::pk_f16(s[0 * 33], s[1 * 33]); o.y = pg8::pk_f16(s[2 * 33], s[3 * 33]); o.z = pg8::pk_f16(s[4 * 33], s[5 * 33]); o.w = pg8::pk_f16(s[6 * 33], s[7 * 33]);
        *(u32x4*)(WT + (size_t)(n0 + n) * K + k0 + 8 * c) = o; }
    LDS_WAIT(); asm volatile("" ::: "memory");
}
__device__ __forceinline__ void rms_row_f16(const float* xrow, const float* w, unsigned short* orow, int lane) {
    const f32x4* xr = (const f32x4*)xrow + lane; const f32x4* wr = (const f32x4*)w + lane;
    f32x4 v[4]; float s = 0.f;
#pragma unroll
    for (int j = 0; j < 4; ++j) { v[j] = xr[64 * j]; s += (v[j].x * v[j].x + v[j].y * v[j].y) + (v[j].z * v[j].z + v[j].w * v[j].w); }
    const float rs = 1.0f / sqrtf(wave_sum(s) * (1.0f / DM) + 1e-6f);
    u32x2* o8 = (u32x2*)orow + lane;
#pragma unroll
    for (int j = 0; j < 4; ++j) { const f32x4 ww = wr[64 * j]; u32x2 o; o.x = pg8::pk_f16(v[j].x * rs * ww.x, v[j].y * rs * ww.y); o.y = pg8::pk_f16(v[j].z * rs * ww.z, v[j].w * rs * ww.w); o8[64 * j] = o; }
}
__device__ __forceinline__ void rms_row_f32(float* xrow, const float* w, int lane) {
    f32x4* xr = (f32x4*)xrow + lane; const f32x4* wr = (const f32x4*)w + lane;
    f32x4 v[4]; float s = 0.f;
#pragma unroll
    for (int j = 0; j < 4; ++j) { v[j] = xr[64 * j]; s += (v[j].x * v[j].x + v[j].y * v[j].y) + (v[j].z * v[j].z + v[j].w * v[j].w); }
    const float rs = 1.0f / sqrtf(wave_sum(s) * (1.0f / DM) + 1e-6f);
#pragma unroll
    for (int j = 0; j < 4; ++j) { const f32x4 ww = wr[64 * j]; xr[64 * j] = v[j] * rs * ww; }
}

__device__ __forceinline__ void rms_row2_f32(float* xa, float* xb, const float* w, int lane) {
    f32x4* ra = (f32x4*)xa + lane; f32x4* rb = (f32x4*)xb + lane; const f32x4* wr = (const f32x4*)w + lane;
    f32x4 va[4], vb[4]; float sa = 0.f, sb = 0.f;
#pragma unroll
    for (int j = 0; j < 4; ++j) { va[j] = ra[64 * j]; vb[j] = rb[64 * j]; }
#pragma unroll
    for (int j = 0; j < 4; ++j) { sa += (va[j].x * va[j].x + va[j].y * va[j].y) + (va[j].z * va[j].z + va[j].w * va[j].w); sb += (vb[j].x * vb[j].x + vb[j].y * vb[j].y) + (vb[j].z * vb[j].z + vb[j].w * vb[j].w); }
    const float rsa = 1.0f / sqrtf(wave_sum(sa) * (1.0f / DM) + 1e-6f), rsb = 1.0f / sqrtf(wave_sum(sb) * (1.0f / DM) + 1e-6f);
#pragma unroll
    for (int j = 0; j < 4; ++j) { const f32x4 ww = wr[64 * j]; ra[64 * j] = va[j] * rsa * ww; rb[64 * j] = vb[j] * rsb * ww; }
}
__device__ __forceinline__ void rms_row4_f16(const float* x0, size_t rs, const float* w, unsigned short* o0, int lane) {
    f32x4 v[4][4]; float s[4];
#pragma unroll
    for (int r = 0; r < 4; ++r)
#pragma unroll
        for (int j = 0; j < 4; ++j) v[r][j] = ((const f32x4*)(x0 + r * rs) + lane)[64 * j];
    const f32x4* wr = (const f32x4*)w + lane;
#pragma unroll
    for (int r = 0; r < 4; ++r) { float a = 0.f;
#pragma unroll
        for (int j = 0; j < 4; ++j) a += (v[r][j].x * v[r][j].x + v[r][j].y * v[r][j].y) + (v[r][j].z * v[r][j].z + v[r][j].w * v[r][j].w);
        s[r] = 1.0f / sqrtf(wave_sum(a) * (1.0f / DM) + 1e-6f); }
#pragma unroll
    for (int j = 0; j < 4; ++j) { const f32x4 ww = wr[64 * j];
#pragma unroll
        for (int r = 0; r < 4; ++r) { u32x2 o; o.x = pg8::pk_f16(v[r][j].x * s[r] * ww.x, v[r][j].y * s[r] * ww.y); o.y = pg8::pk_f16(v[r][j].z * s[r] * ww.z, v[r][j].w * s[r] * ww.w); ((u32x2*)(o0 + r * rs) + lane)[64 * j] = o; } }
}

#define SHV(col) ({ const float cur_ = (float)urow[(col)]; const float prev_ = hp ? (float)prow[(col)] : 0.f; cur_ + mu[(col)] * (prev_ - cur_); })

__device__ __forceinline__ void store_row64_f16(f16* dst, const float (&S)[64]) {
#pragma unroll
    for (int q = 0; q < 8; ++q) { u32x4 w; w.x = pg8::pk_f16(S[8 * q], S[8 * q + 1]); w.y = pg8::pk_f16(S[8 * q + 2], S[8 * q + 3]); w.z = pg8::pk_f16(S[8 * q + 4], S[8 * q + 5]); w.w = pg8::pk_f16(S[8 * q + 6], S[8 * q + 7]); *(u32x4*)(dst + 8 * q) = w; }
}


constexpr int RWA_REC = 656  , RWA_VROW = 136, RWA_VPL = 16 * RWA_REC, RWA_INV = RWA_VPL + 16 * RWA_VROW, RWA_BYTES = 12800;
constexpr int C_VD0 = 3712, C_VD1 = 3744;
constexpr int PRM_MU = 0, PRM_W0 = 1280, PRM_A0 = 1664, PRM_KK = 2048, PRM_KA = 2432, PRM_RK = 2816, PRM_V0 = 3200, PRM_FLOATS = 3584;
typedef float f32x2 __attribute__((ext_vector_type(2)));
typedef _Float16 f16x4 __attribute__((ext_vector_type(4)));
__device__ __forceinline__ float fmix_lo(float a, unsigned b, float c) { float d; asm("v_fma_mix_f32 %0, %1, %2, %3 op_sel:[0,0,0] op_sel_hi:[0,1,0]" : "=v"(d) : "v"(a), "v"(b), "v"(c)); return d; }
__device__ __forceinline__ float fmix_hi(float a, unsigned b, float c) { float d; asm("v_fma_mix_f32 %0, %1, %2, %3 op_sel:[0,1,0] op_sel_hi:[0,1,0]" : "=v"(d) : "v"(a), "v"(b), "v"(c)); return d; }
__device__ __forceinline__ float mmix_lo(float a, unsigned b) { float d; asm("v_fma_mix_f32 %0, %1, %2, 0 op_sel:[0,0,0] op_sel_hi:[0,1,0]" : "=v"(d) : "v"(a), "v"(b)); return d; }
__device__ __forceinline__ float mmix_hi(float a, unsigned b) { float d; asm("v_fma_mix_f32 %0, %1, %2, 0 op_sel:[0,1,0] op_sel_hi:[0,1,0]" : "=v"(d) : "v"(a), "v"(b)); return d; }
__device__ __forceinline__ float fma_asm(float a, float b, float c) { float d; asm("v_fma_f32 %0, %1, %2, %3" : "=v"(d) : "v"(a), "v"(b), "v"(c)); return d; }
#define FMIX(a, u, j, c) (((j) & 1) ? fmix_hi((a), (u)[(j) >> 1], (c)) : fmix_lo((a), (u)[(j) >> 1], (c)))
#define MMIX(a, u, j) (((j) & 1) ? mmix_hi((a), (u)[(j) >> 1]) : mmix_lo((a), (u)[(j) >> 1]))
__device__ __forceinline__ float fast_tanh(float x) { return 1.0f - 2.0f * __builtin_amdgcn_rcpf(__expf(2.0f * x) + 1.0f); }
__device__ __forceinline__ void lerp8(const char* ub, unsigned uo, unsigned po, bool hp, const char* mub, unsigned col, float (&x)[8]) {
    const f16x8 cu = *(const f16x8*)(ub + (uo + col * 2u)); f16x8 pv = *(const f16x8*)(ub + (po + col * 2u)); const f32x4 m0 = *(const f32x4*)(mub + col * 4u), m1 = *(const f32x4*)(mub + col * 4u + 16u);
#pragma unroll
    for (int j = 0; j < 8; ++j) { const float c = (float)cu[j], p = hp ? (float)pv[j] : 0.f; x[j] = c + (j < 4 ? m0[j] : m1[j - 4]) * (p - c); }
}
__device__ __forceinline__ void lerp4(const char* ub, unsigned uo, unsigned po, bool hp, const char* mub, unsigned col, float (&x)[4]) {
    const f16x4 cu = *(const f16x4*)(ub + (uo + col * 2u)); f16x4 pv = *(const f16x4*)(ub + (po + col * 2u)); const f32x4 m0 = *(const f32x4*)(mub + col * 4u);
#pragma unroll
    for (int j = 0; j < 4; ++j) { const float c = (float)cu[j], p = hp ? (float)pv[j] : 0.f; x[j] = c + m0[j] * (p - c); }
}
__device__ __forceinline__ f16x8 pack8(const float (&x)[8]) { f16x8 r;
#pragma unroll
    for (int j = 0; j < 8; ++j) r[j] = (f16)x[j];
    return r; }

__device__ __forceinline__ void rwkv_waveA(const Args& a, int l, int b, int c, int h, LAS unsigned char* wl, const LAS float* prm, int lane) {
    const char* Ub = (const char*)(a.ws + WS_U); f16* MIX = (f16*)(a.ws + WS_MIX); char* VF = (char*)(a.ws + WS_VF); char* VP = (char*)(a.ws + WS_VP);
    f16* QT = (f16*)(a.ws + WS_QT); f16* PT = (f16*)(a.ws + WS_PT); f16* RL = (f16*)(a.ws + WS_RL); float* BONG = (float*)(a.ws + WS_BON);
    const char* WUPT = (const char*)(a.ws + WS_WUPT) + (size_t)l * 384 * 64 * 2; const char* AUPT = (const char*)(a.ws + WS_AUPT) + (size_t)l * 384 * 64 * 2;
    const char* VUPT = (const char*)(a.ws + WS_VUPT);
    const int bh = b * RW_H + h;
    float P[64], L[64];
#pragma unroll
    for (int k = 0; k < 64; ++k) { P[k] = (k == lane) ? 1.f : 0.f; L[k] = 0.f; }
#pragma unroll 1
    for (int blk = 0; blk < 4; ++blk) {
        const int lane_ = lane_now();
        const int tok = lane_ & 15, fq = lane_ >> 4;
        const int t = c * CH + blk * 16 + tok; const unsigned m = (unsigned)(b * SEQ + t); const bool hp = t > 0;
        const unsigned uo = m * (unsigned)(NU * 2), po = hp ? uo - (unsigned)(NU * 2) : uo;
        f16x8 cW[2], pW[2], cA[2], pA[2], vd0, vd1;
#pragma unroll
        for (int s = 0; s < 2; ++s) { const unsigned cw = (unsigned)(C_WL + 8 * fq + 32 * s) * 2u, ca = (unsigned)(C_AL + 8 * fq + 32 * s) * 2u;
            cW[s] = *(const f16x8*)(Ub + uo + cw); pW[s] = *(const f16x8*)(Ub + po + cw); cA[s] = *(const f16x8*)(Ub + uo + ca); pA[s] = *(const f16x8*)(Ub + po + ca); }
        if (l > 0) { vd0 = *(const f16x8*)(Ub + uo + (unsigned)(C_VD0 + 8 * fq) * 2u); vd1 = *(const f16x8*)(Ub + po + (unsigned)(C_VD1 + 8 * fq) * 2u); }
#define RW_TLOAD(X, nt) f16x8 X##wu0, X##wu1, X##au0, X##au1, X##vu; f16x4 X##cr, X##pr, X##ck, X##pk, X##cv, X##pv, X##vf; { \
            const unsigned n_ = (unsigned)(h * 64 + 16 * (nt) + tok), cb_ = (unsigned)(h * 64 + 16 * (nt) + 4 * fq); \
            X##wu0 = *(const f16x8*)(WUPT + (n_ * 64u + 8u * fq) * 2u); X##wu1 = *(const f16x8*)(WUPT + (n_ * 64u + 8u * fq + 32u) * 2u); \
            X##au0 = *(const f16x8*)(AUPT + (n_ * 64u + 8u * fq) * 2u); X##au1 = *(const f16x8*)(AUPT + (n_ * 64u + 8u * fq + 32u) * 2u); \
            if (l > 0) { X##vu = *(const f16x8*)(VUPT + (n_ * 32u + 8u * fq) * 2u); X##vf = *(const f16x4*)(VF + (m * (unsigned)RW_W + cb_) * 2u); } \
            X##cr = *(const f16x4*)(Ub + uo + ((unsigned)C_R + cb_) * 2u); X##pr = *(const f16x4*)(Ub + po + ((unsigned)C_R + cb_) * 2u); \
            X##ck = *(const f16x4*)(Ub + uo + ((unsigned)C_K + cb_) * 2u); X##pk = *(const f16x4*)(Ub + po + ((unsigned)C_K + cb_) * 2u); \
            X##cv = *(const f16x4*)(Ub + uo + ((unsigned)C_V + cb_) * 2u); X##pv = *(const f16x4*)(Ub + po + ((unsigned)C_V + cb_) * 2u); }
        f16x8 bW[2], bA[2], bVD;
#pragma unroll
        for (int s = 0; s < 2; ++s) { float xw[8], xa[8];
            const f32x4 mw0 = *(const LAS f32x4*)(prm + PRM_MU + C_WL + 8 * fq + 32 * s), mw1 = *(const LAS f32x4*)(prm + PRM_MU + C_WL + 8 * fq + 32 * s + 4);
            const f32x4 ma0 = *(const LAS f32x4*)(prm + PRM_MU + C_AL + 8 * fq + 32 * s), ma1 = *(const LAS f32x4*)(prm + PRM_MU + C_AL + 8 * fq + 32 * s + 4);
#pragma unroll
            for (int j = 0; j < 8; ++j) { const float cw_ = (float)cW[s][j], pw_ = hp ? (float)pW[s][j] : 0.f, ca_ = (float)cA[s][j], pa_ = hp ? (float)pA[s][j] : 0.f;
                xw[j] = fast_tanh(cw_ + (j < 4 ? mw0[j & 3] : mw1[j & 3]) * (pw_ - cw_)); xa[j] = ca_ + (j < 4 ? ma0[j & 3] : ma1[j & 3]) * (pa_ - ca_); }
            bW[s] = pack8(xw); bA[s] = pack8(xa); }
        if (l > 0) { float xv[8];
#pragma unroll
            for (int j = 0; j < 8; ++j) xv[j] = (float)vd0[j] + (hp ? (float)vd1[j] : 0.f);
            bVD = pack8(xv); }
        float ssq = 0.f, bon = 0.f;
        LAS unsigned char* rec = wl + tok * RWA_REC;
#define RW_TCOMP(X, nt) { const int cb = h * 64 + 16 * (nt) + 4 * fq, co = 16 * (nt) + 4 * fq; \
            f32x4 DWn = (f32x4){0.f, 0.f, 0.f, 0.f}, DAn = DWn, Gn = DWn; \
            DWn = __builtin_amdgcn_mfma_f32_16x16x32_f16(X##wu0, bW[0], DWn, 0, 0, 0); DWn = __builtin_amdgcn_mfma_f32_16x16x32_f16(X##wu1, bW[1], DWn, 0, 0, 0); \
            DAn = __builtin_amdgcn_mfma_f32_16x16x32_f16(X##au0, bA[0], DAn, 0, 0, 0); DAn = __builtin_amdgcn_mfma_f32_16x16x32_f16(X##au1, bA[1], DAn, 0, 0, 0); \
            if (l > 0) Gn = __builtin_amdgcn_mfma_f32_16x16x32_f16(X##vu, bVD, Gn, 0, 0, 0); \
            f16x4 wv, al, be, km, rr, vo; \
            _Pragma("unroll") for (int i = 0; i < 4; ++i) { const LAS float* pc = prm + cb + i; \
                const float cr_ = (float)X##cr[i], ck_ = (float)X##ck[i], cv_ = (float)X##cv[i]; \
                const float rs = cr_ + pc[PRM_MU + C_R] * ((hp ? (float)X##pr[i] : 0.f) - cr_), ks = ck_ + pc[PRM_MU + C_K] * ((hp ? (float)X##pk[i] : 0.f) - ck_), vs = cv_ + pc[PRM_MU + C_V] * ((hp ? (float)X##pv[i] : 0.f) - cv_); \
                wv[i] = (f16)__expf(-0.6065306597126334f * sigmoidf_(pc[PRM_W0] + DWn[i])); \
                const float aa = sigmoidf_(pc[PRM_A0] + DAn[i]); \
                float vv = vs; if (l > 0) vv = vs + ((float)X##vf[i] - vs) * sigmoidf_(pc[PRM_V0] + Gn[i]); \
                const float kk = ks * pc[PRM_KK]; ssq += kk * kk; \
                const float kmod = ks * (1.0f + (aa - 1.0f) * pc[PRM_KA]); \
                bon += rs * kmod * pc[PRM_RK]; \
                al[i] = (f16)(-kk); be[i] = (f16)(kk * aa); km[i] = (f16)kmod; rr[i] = (f16)rs; vo[i] = (f16)vv; \
                asm volatile("" ::: "memory"); } \
            *(LAS f16x4*)(rec + co * 2) = wv; \
            *(LAS f16x4*)(rec + 128 + co * 2) = al; *(LAS f16x4*)(rec + 256 + co * 2) = be; *(LAS f16x4*)(rec + 384 + co * 2) = km; *(LAS f16x4*)(rec + 512 + co * 2) = rr; \
            *(LAS f16x4*)(wl + RWA_VPL + tok * RWA_VROW + co * 2) = vo; \
            *(f16x4*)(VP + (m * (unsigned)RW_W + (unsigned)cb) * 2u) = vo; \
            if (l == 0) *(f16x4*)(VF + (m * (unsigned)RW_W + (unsigned)cb) * 2u) = vo; }
#pragma unroll 1
        for (int nt = 0; nt < 4; ++nt) { RW_TLOAD(T0, nt) RW_TCOMP(T0, nt) asm volatile("" ::: "memory"); }
#undef RW_TLOAD
#undef RW_TCOMP
        ssq += shfl_xor_f(ssq, 16); ssq += shfl_xor_f(ssq, 32);
        bon += shfl_xor_f(bon, 16); bon += shfl_xor_f(bon, 32);
        { const float inv2v = __builtin_amdgcn_rcpf(fmaxf(ssq, 1e-24f));
          if (fq == 0) { *(LAS float*)(wl + RWA_INV + tok * 4) = inv2v; *(float*)((char*)BONG + (m * 8u + (unsigned)h) * 4u) = bon; } }
        const unsigned mb = (unsigned)(b * SEQ + c * CH + blk * 16);
        asm volatile("s_waitcnt lgkmcnt(0)" ::: "memory");
        u32x4 A[8];
#pragma unroll
        for (int g = 0; g < 8; ++g) A[g] = *(const LAS u32x4*)(wl + 128 + g * 16);
        float vv = (float)*(const LAS f16*)(wl + RWA_VPL + lane_ * 2); float inv2 = *(const LAS float*)(wl + RWA_INV);
#define RW_LDU(W4, B4, K4, R4, g) { W4 = *(const LAS u32x4*)(rc + (g) * 16); B4 = *(const LAS u32x4*)(rc + 256 + (g) * 16); K4 = *(const LAS u32x4*)(rc + 384 + (g) * 16); R4 = *(const LAS u32x4*)(rc + 512 + (g) * 16); }
#define RW_COMP(W4, B4, K4, R4, g) { float tP[8], tL[8]; \
            _Pragma("unroll") for (int j = 0; j < 8; ++j) tP[j] = MMIX(saP, B4, j); \
            _Pragma("unroll") for (int j = 0; j < 8; ++j) tL[j] = MMIX(saL, B4, j); \
            _Pragma("unroll") for (int j = 0; j < 8; ++j) tL[j] = FMIX(vv, K4, j, tL[j]); \
            _Pragma("unroll") for (int j = 0; j < 8; ++j) P[8 * (g) + j] = FMIX(P[8 * (g) + j], W4, j, tP[j]); \
            _Pragma("unroll") for (int j = 0; j < 8; ++j) L[8 * (g) + j] = FMIX(L[8 * (g) + j], W4, j, tL[j]); \
            _Pragma("unroll") for (int j = 0; j < 8; ++j) qa[j] = FMIX(P[8 * (g) + j], R4, j, qa[j]); \
            _Pragma("unroll") for (int j = 0; j < 8; ++j) ya[j] = FMIX(L[8 * (g) + j], R4, j, ya[j]); }
#pragma unroll 1
        for (int t2 = 0; t2 < 16; ++t2) {
            const LAS unsigned char* rc = wl + t2 * RWA_REC;
            u32x4 we, be, ke, re, wo, bo, ko, ro;
            RW_LDU(we, be, ke, re, 0)
            float sP[8], sL[8];
#pragma unroll
            for (int j = 0; j < 8; ++j) { sP[j] = 0.f; sL[j] = 0.f; }
#pragma unroll
            for (int g = 0; g < 8; ++g) {
#pragma unroll
                for (int j = 0; j < 8; ++j) sP[j] = FMIX(P[8 * g + j], A[g], j, sP[j]);
#pragma unroll
                for (int j = 0; j < 8; ++j) sL[j] = FMIX(L[8 * g + j], A[g], j, sL[j]); }
            const float saP = inv2 * (((sP[0] + sP[1]) + (sP[2] + sP[3])) + ((sP[4] + sP[5]) + (sP[6] + sP[7]))), saL = inv2 * (((sL[0] + sL[1]) + (sL[2] + sL[3])) + ((sL[4] + sL[5]) + (sL[6] + sL[7])));
            float qa[8], ya[8];
#pragma unroll
            for (int j = 0; j < 8; ++j) { qa[j] = 0.f; ya[j] = 0.f; }
            RW_LDU(wo, bo, ko, ro, 1) RW_COMP(we, be, ke, re, 0)
            RW_LDU(we, be, ke, re, 2) RW_COMP(wo, bo, ko, ro, 1)
            RW_LDU(wo, bo, ko, ro, 3) RW_COMP(we, be, ke, re, 2)
            RW_LDU(we, be, ke, re, 4) RW_COMP(wo, bo, ko, ro, 3)
            RW_LDU(wo, bo, ko, ro, 5) RW_COMP(we, be, ke, re, 4)
            RW_LDU(we, be, ke, re, 6) RW_COMP(wo, bo, ko, ro, 5)
            RW_LDU(wo, bo, ko, ro, 7) RW_COMP(we, be, ke, re, 6)
            const float vvn = (float)*(const LAS f16*)(wl + RWA_VPL + ((t2 + 1) & 15) * RWA_VROW + lane_ * 2); const float inv2n = *(const LAS float*)(wl + RWA_INV + ((t2 + 1) & 15) * 4);
#pragma unroll
            for (int g = 0; g < 8; ++g) A[g] = *(const LAS u32x4*)(rc + RWA_REC + 128 + g * 16);
            RW_COMP(wo, bo, ko, ro, 7)
            vv = vvn; inv2 = inv2n;
            *(f16*)((char*)MIX + ((mb + t2) * (unsigned)DM + (unsigned)(h * 64 + lane_)) * 2u) = (f16)(((ya[0] + ya[1]) + (ya[2] + ya[3])) + ((ya[4] + ya[5]) + (ya[6] + ya[7])));
            *(f16*)((char*)QT + ((mb + t2) * (unsigned)RW_W + (unsigned)(h * 64 + lane_)) * 2u) = (f16)(((qa[0] + qa[1]) + (qa[2] + qa[3])) + ((qa[4] + qa[5]) + (qa[6] + qa[7])));
        }
#undef RW_LDU
#undef RW_COMP
    }
    store_row64_f16(RL + (((size_t)bh * NCH + c) * 64 + lane) * 64, L);
    f16* pt = PT + ((size_t)bh * NCH + c) * 4096;
#pragma unroll
    for (int k = 0; k < 64; ++k) pt[k * 64 + lane] = (f16)P[k];
}

constexpr int HGA_REC = 384, HGA_V = 16 * HGA_REC, HGA_HEAD = HGA_V + 2048, HGA_BYTES = 2 * HGA_HEAD;
template <int NH>
__device__ __forceinline__ void hgrn_waveA(const Args& a, int l, int b, int c, int h0, LAS unsigned char* wl) {
    char* U = (char*)(a.ws + WS_U); char* MIX = (char*)(a.ws + WS_MIX); f16* HL = (f16*)(a.ws + WS_HL); float* DC = (float*)(a.ws + WS_DC);
    const float* lbr = a.in[16];
    float S[NH][64]; float dpr[NH];
#pragma unroll
    for (int j = 0; j < NH; ++j) { dpr[j] = 1.f;
#pragma unroll
        for (int k = 0; k < 64; ++k) S[j][k] = 0.f; }
#pragma unroll 1
    for (int blk = 0; blk < 4; ++blk) {
        const int lane_ = lane_now();
        const unsigned mb = (unsigned)(b * SEQ + c * CH + blk * 16);
        {
            f16 fr[NH][16], qr[NH][16], vr[NH][16];
#pragma unroll
            for (int j = 0; j < NH; ++j)
#pragma unroll
                for (int tk = 0; tk < 16; ++tk) { const char* ur = U + (mb + tk) * (unsigned)(NU * 2) + (unsigned)((h0 + j) * 64 + lane_) * 2u; fr[j][tk] = *(const f16*)(ur + C_HGF * 2); qr[j][tk] = *(const f16*)(ur + C_HGQ * 2); vr[j][tk] = *(const f16*)(ur + C_HGI * 2); }
#pragma unroll
            for (int j = 0; j < NH; ++j) { const int col = (h0 + j) * 64 + lane_;
                const float lb = (l == 0) ? 0.f : sigmoidf_(lbr[384 + col] - lbr[col]);
                float dp = dpr[j];
#pragma unroll
                for (int tk = 0; tk < 16; ++tk) {
                    const float f = lb + (1.0f - lb) * sigmoidf_((float)fr[j][tk]);
                    LAS unsigned char* rec = wl + j * HGA_HEAD + tk * HGA_REC;
                    *(LAS f16*)(rec + lane_ * 2) = (f16)f; *(LAS f16*)(rec + 128 + lane_ * 2) = (f16)(1.0f - f); *(LAS f16*)(rec + 256 + lane_ * 2) = qr[j][tk];
                    *(LAS f16*)(wl + j * HGA_HEAD + HGA_V + tk * 128 + lane_ * 2) = vr[j][tk];
                    dp *= f;
                    *(f16*)(U + (mb + tk) * (unsigned)(NU * 2) + (unsigned)(C_HGQ + col) * 2u) = (f16)((float)qr[j][tk] * dp);
                }
                dpr[j] = dp; }
        }
        asm volatile("s_waitcnt lgkmcnt(0)" ::: "memory");
#define HG_LD(F4, K4, Q4, rcp, g) { F4 = *(const LAS u32x4*)((rcp) + (g) * 16); K4 = *(const LAS u32x4*)((rcp) + 128 + (g) * 16); Q4 = *(const LAS u32x4*)((rcp) + 256 + (g) * 16); }
#define HG_COMP(Sx, vi, F4, K4, Q4, g) { float tt[8]; \
            _Pragma("unroll") for (int jj = 0; jj < 8; ++jj) tt[jj] = MMIX(vi, K4, jj); \
            _Pragma("unroll") for (int jj = 0; jj < 8; ++jj) Sx[8 * (g) + jj] = FMIX(Sx[8 * (g) + jj], F4, jj, tt[jj]); \
            _Pragma("unroll") for (int jj = 0; jj < 8; ++jj) oa[jj] = FMIX(Sx[8 * (g) + jj], Q4, jj, oa[jj]); }
#define HG_HEAD(Sx, vi, rcp, rcn, oo) { float oa[8]; _Pragma("unroll") for (int jj = 0; jj < 8; ++jj) oa[jj] = 0.f; \
            HG_LD(f4o, k4o, q4o, rcp, 1) HG_COMP(Sx, vi, f4e, k4e, q4e, 0) \
            HG_LD(f4e, k4e, q4e, rcp, 2) HG_COMP(Sx, vi, f4o, k4o, q4o, 1) \
            HG_LD(f4o, k4o, q4o, rcp, 3) HG_COMP(Sx, vi, f4e, k4e, q4e, 2) \
            HG_LD(f4e, k4e, q4e, rcp, 4) HG_COMP(Sx, vi, f4o, k4o, q4o, 3) \
            HG_LD(f4o, k4o, q4o, rcp, 5) HG_COMP(Sx, vi, f4e, k4e, q4e, 4) \
            HG_LD(f4e, k4e, q4e, rcp, 6) HG_COMP(Sx, vi, f4o, k4o, q4o, 5) \
            HG_LD(f4o, k4o, q4o, rcp, 7) HG_COMP(Sx, vi, f4e, k4e, q4e, 6) \
            HG_LD(f4e, k4e, q4e, rcn, 0) HG_COMP(Sx, vi, f4o, k4o, q4o, 7) \
            oo = ((oa[0] + oa[1]) + (oa[2] + oa[3])) + ((oa[4] + oa[5]) + (oa[6] + oa[7])); }
        u32x4 f4e, k4e, q4e, f4o, k4o, q4o;
        HG_LD(f4e, k4e, q4e, wl, 0)
        f16 vh[NH], vn[NH];
#pragma unroll
        for (int j = 0; j < NH; ++j) vh[j] = *(const LAS f16*)(wl + j * HGA_HEAD + HGA_V + lane_ * 2);
#pragma unroll 1
        for (int t2 = 0; t2 < 16; ++t2) {
            const LAS unsigned char* rc = wl + t2 * HGA_REC;
#pragma unroll
            for (int j = 0; j < NH; ++j) vn[j] = *(const LAS f16*)(wl + j * HGA_HEAD + HGA_V + ((t2 + 1) & 15) * 128 + lane_ * 2);
            float oo[NH];
#pragma unroll
            for (int j = 0; j < NH; ++j) { const float vi = (float)vh[j];
                const LAS unsigned char* rcp = rc + j * HGA_HEAD; const LAS unsigned char* rcn = (j + 1 < NH) ? rc + (j + 1) * HGA_HEAD : rc + HGA_REC;
                HG_HEAD(S[j], vi, rcp, rcn, oo[j]) }
            char* mo = MIX + ((mb + t2) * (unsigned)DM + (unsigned)(384 + h0 * 64 + lane_)) * 2u;
#pragma unroll
            for (int j = 0; j < NH; ++j) { *(f16*)(mo + 128 * j) = (f16)oo[j]; vh[j] = vn[j]; }
        }
#undef HG_LD
#undef HG_COMP
#undef HG_HEAD
    }
    const int lane2 = lane_now();
#pragma unroll
    for (int j = 0; j < NH; ++j) { const int bh = b * 6 + h0 + j; store_row64_f16(HL + (((size_t)bh * NCH + c) * 64 + lane2) * 64, S[j]);
        DC[((size_t)bh * NCH + c) * 64 + lane2] = dpr[j]; }
}

__device__ __forceinline__ void lru_waveA(const Args& a, int l, int b, int c, int g, LAS unsigned char* wl) {
    const int ln = lane_now();
    const char* Ub = (const char*)(a.ws + WS_U); char* MIXb = (char*)(a.ws + WS_MIX); char* CA = (char*)(a.ws + WS_CA); float* LA = (float*)(a.ws + WS_LA); float* LH = (float*)(a.ws + WS_LH);
    const float* cw = a.in[18] + l * 4 * 256 + g * 64; const float* cb = a.in[19] + l * 256 + g * 64;
    const float* ba = a.in[21] + l * 256 + g * 64; const float* bx = a.in[23] + l * 256 + g * 64; const float* lam = a.in[24] + l * 256 + g * 64;
    const char* WAT = (const char*)(a.ws + WS_WAT) + (size_t)(l * 4 + g) * 8192; const char* WXT = (const char*)(a.ws + WS_WXT) + (size_t)(l * 4 + g) * 8192;
    LAS unsigned char* Y = wl;
    const unsigned mrow0 = (unsigned)(b * SEQ + c * CH);
#pragma unroll 2
    for (int it = 0; it < 8; ++it) { const int item = ln + 64 * it, tok = item >> 3, co = item & 7; const int t = c * CH + tok;
        const f32x4 b0 = *(const f32x4*)(cb + 8 * co), b1 = *(const f32x4*)(cb + 8 * co + 4);
        float y[8] = {b0[0], b0[1], b0[2], b0[3], b1[0], b1[1], b1[2], b1[3]};
#pragma unroll
        for (int jj = 0; jj < 4; ++jj) { const int ts = t - 3 + jj;
            if (ts >= 0) { const f16x8 x8 = *(const f16x8*)(Ub + ((mrow0 + (unsigned)(tok - 3 + jj)) * (unsigned)NU + (unsigned)(C_LRUX + g * 64 + 8 * co)) * 2u);
                const f32x4 w0 = *(const f32x4*)(cw + jj * 256 + 8 * co), w1 = *(const f32x4*)(cw + jj * 256 + 8 * co + 4);
#pragma unroll
                for (int i = 0; i < 8; ++i) y[i] += (i < 4 ? w0[i & 3] : w1[i & 3]) * (float)x8[i]; } }
        *(LAS f16x8*)(Y + tok * 144 + co * 16) = pack8(y); }
    asm volatile("s_waitcnt lgkmcnt(0)" ::: "memory");
    const int tl = ln & 15, fq = ln >> 4;
    float sp[16], cy[16], cp[16];
#pragma unroll
    for (int nt = 0; nt < 4; ++nt) { const f32x4 lm4 = *(const f32x4*)(lam + 16 * nt + 4 * fq);
#pragma unroll
        for (int i = 0; i < 4; ++i) { sp[nt * 4 + i] = log1pf(__expf(-lm4[i])); cy[nt * 4 + i] = 0.f; cp[nt * 4 + i] = 1.f; } }
#pragma unroll 1
    for (int tt = 0; tt < 4; ++tt) {
        f16x8 by[2];
#pragma unroll
        for (int s2 = 0; s2 < 2; ++s2) by[s2] = *(const LAS f16x8*)(Y + (16 * tt + tl) * 144 + (8 * fq + 32 * s2) * 2);
        const unsigned m = mrow0 + (unsigned)(16 * tt + tl);
#pragma unroll
        for (int nt = 0; nt < 4; ++nt) {
            f32x4 ra = (f32x4){0.f, 0.f, 0.f, 0.f}, rx = ra;
#pragma unroll
            for (int s2 = 0; s2 < 2; ++s2) { const unsigned wo = (unsigned)(((16 * nt + tl) * 64 + 8 * fq + 32 * s2) * 2);
                ra = __builtin_amdgcn_mfma_f32_16x16x32_f16(*(const f16x8*)(WAT + wo), by[s2], ra, 0, 0, 0);
                rx = __builtin_amdgcn_mfma_f32_16x16x32_f16(*(const f16x8*)(WXT + wo), by[s2], rx, 0, 0, 0); }
            const int ch0 = 16 * nt + 4 * fq;
            const f32x4 ba4 = *(const f32x4*)(ba + ch0), bx4 = *(const f32x4*)(bx + ch0);
            const f16x4 y4 = *(const LAS f16x4*)(Y + (16 * tt + tl) * 144 + ch0 * 2);
            f16x4 ho, co;
#pragma unroll
            for (int i = 0; i < 4; ++i) { const int q = nt * 4 + i;
                const float r = sigmoidf_(ra[i] + ba4[i]), ig = sigmoidf_(rx[i] + bx4[i]);
                const float la = -8.0f * r * sp[q];
                float av = __expf(la), uv = sqrtf(one_minus_exp_(2.0f * la)) * (ig * (float)y4[i]);
#define LRU_SCAN(d) { const float ap = __builtin_bit_cast(float, __builtin_amdgcn_update_dpp(0x3f800000, __builtin_bit_cast(int, av), 0x110 + (d), 0xf, 0xf, false)); \
                      const float up = __builtin_bit_cast(float, __builtin_amdgcn_update_dpp(0, __builtin_bit_cast(int, uv), 0x110 + (d), 0xf, 0xf, false)); \
                      uv = av * up + uv; av = av * ap; }
                LRU_SCAN(1) LRU_SCAN(2) LRU_SCAN(4) LRU_SCAN(8)
#undef LRU_SCAN
                const float hl = uv + av * cy[q], ca = av * cp[q];
                ho[i] = (f16)hl; co[i] = (f16)ca;
                cy[q] = __builtin_bit_cast(float, __builtin_amdgcn_ds_bpermute((ln | 15) << 2, __builtin_bit_cast(int, hl)));
                cp[q] = __builtin_bit_cast(float, __builtin_amdgcn_ds_bpermute((ln | 15) << 2, __builtin_bit_cast(int, ca)));
            }
            *(f16x4*)(MIXb + (m * (unsigned)DM + 768u + (unsigned)(g * 64 + ch0)) * 2u) = ho; *(f16x4*)(CA + (m * 256u + (unsigned)(g * 64 + ch0)) * 2u) = co;
        }
    }
    if (tl == 15) {
#pragma unroll
        for (int q = 0; q < 16; ++q) { const int ch = g * 64 + 16 * (q >> 2) + 4 * fq + (q & 3); LA[((size_t)b * NCH + c) * 256 + ch] = cp[q]; LH[((size_t)b * NCH + c) * 256 + ch] = cy[q]; } }
}

__device__ __forceinline__ void phaseA(const Args& a, int l, int task, LAS unsigned char* lds, int tid) {
    asm volatile("" : "+v"(tid));
    const int lane = tid & 63, wave = __builtin_amdgcn_readfirstlane(tid >> 6);
    const int b = task / NCH, c = task % NCH;
    const f16* U = (const f16*)(a.ws + WS_U); f16* MIX = (f16*)(a.ws + WS_MIX); f16* VF = (f16*)(a.ws + WS_VF); f16* VP = (f16*)(a.ws + WS_VP);
    f16* QT = (f16*)(a.ws + WS_QT); f16* PT = (f16*)(a.ws + WS_PT); f16* RL = (f16*)(a.ws + WS_RL); float* BONG = (float*)(a.ws + WS_BON);
    {
        LAS float* prm = (LAS float*)(lds + PRM_OFF);
        for (int i = tid; i < PRM_FLOATS; i += NT) { float v;
            if (i < 1280) v = a.in[3][l * RW_SHIFT + i];
            else { const int q = (i - 1280) / 384, cc = (i - 1280) % 384;
                v = (q == 0) ? a.in[4][l * RW_W + cc] : (q == 1) ? a.in[6][l * RW_W + cc] : (q == 2) ? a.in[11][l * RW_W + cc] : (q == 3) ? a.in[12][l * RW_W + cc] : (q == 4) ? a.in[13][l * RW_W + cc] : a.in[8][cc]; }
            prm[i] = v; }
        __syncthreads();
        if (wave < RW_H) { rwkv_waveA(a, l, b, c, wave, lds + wave * RWA_BYTES, prm, lane);
                           if (wave < 4) lru_waveA(a, l, b, c, wave, lds + wave * RWA_BYTES); }
        else { LAS unsigned char* hw = lds + RW_H * RWA_BYTES + (wave - RW_H) * HGA_BYTES;
               hgrn_waveA<2>(a, l, b, c, 2 * (wave - RW_H), hw); hgrn_waveA<1>(a, l, b, c, 4 + (wave - RW_H), hw); }
        __syncthreads();
    }
}

constexpr int PB_SLOT = 16384, PB_NS = 8, PB_AHEAD = 6, NGRP = NCH / 8;
#define ARENA(ws, off) ((char*)(ws) + WS_U + (size_t)((off) >> 11) * (size_t)(NU * 2) + (size_t)((off) & 2047))
constexpr size_t AR_PGT = 0, AR_LG = 2u << 20, AR_SG = 4u << 20;
#define PB_SWZ(row, o) ((row) * 128 + (((((o) >> 4) ^ ((row) & 7)) << 4) | ((o) & 15)))
template <bool ADD_L>
__device__ __forceinline__ void pb_step(f32x4 (&Sacc)[4], const LAS unsigned char* sl, int xrow, int vl, int fq) {
    f16x8 Bhi[2], Blo[2];
#pragma unroll
    for (int mt = 0; mt < 4; ++mt)
#pragma unroll
        for (int i = 0; i < 4; ++i) { const f16 hi = (f16)Sacc[mt][i]; const f16 lo = (f16)(Sacc[mt][i] - (float)hi); Bhi[mt >> 1][4 * (mt & 1) + i] = hi; Blo[mt >> 1][4 * (mt & 1) + i] = lo; }
#pragma unroll
    for (int mt = 0; mt < 4; ++mt) {
        f32x4 d = (f32x4){0.f, 0.f, 0.f, 0.f};
        if (ADD_L) { const f16x4 l4 = *(const LAS f16x4*)(sl + 8192 + PB_SWZ(xrow, 32 * mt + 8 * fq)); d = (f32x4){(float)l4[0], (float)l4[1], (float)l4[2], (float)l4[3]}; }
#pragma unroll
        for (int s = 0; s < 2; ++s) { const u32x2 a0 = *(const LAS u32x2*)(sl + PB_SWZ(16 * mt + vl, 64 * s + 8 * fq)), a1 = *(const LAS u32x2*)(sl + PB_SWZ(16 * mt + vl, 64 * s + 32 + 8 * fq));
            u32x4 aw; aw.x = a0.x; aw.y = a0.y; aw.z = a1.x; aw.w = a1.y; const f16x8 af = __builtin_bit_cast(f16x8, aw);
            d = __builtin_amdgcn_mfma_f32_16x16x32_f16(af, Bhi[s], d, 0, 0, 0); d = __builtin_amdgcn_mfma_f32_16x16x32_f16(af, Blo[s], d, 0, 0, 0); }
        Sacc[mt] = d; }
}
__device__ __forceinline__ void pb_stage8(const Args& a, LAS unsigned char* lds, int bh, int c0, int wave, int lane) {
    const char* PT = (const char*)(a.ws + WS_PT) + ((size_t)bh * NCH + c0) * 8192; const char* RL = (const char*)(a.ws + WS_RL) + ((size_t)bh * NCH + c0) * 8192;
    const int lq = wave * 64 + lane, lrow = lq >> 3, lpp = lq & 7; const unsigned lsrc = (unsigned)(lrow * 128 + ((lpp ^ (lrow & 7)) << 4));
#pragma unroll
    for (int sl = 0; sl < 8; ++sl) { const unsigned so = (unsigned)(sl * PB_SLOT + wave * 1024); const size_t go = (size_t)sl * 8192 + lsrc;
        __builtin_amdgcn_global_load_lds((const unsigned*)(PT + go), (LAS unsigned*)(lds + so), 16, 0, 0);
        __builtin_amdgcn_global_load_lds((const unsigned*)(RL + go), (LAS unsigned*)(lds + so + 8192), 16, 0, 0); }
    asm volatile("s_waitcnt vmcnt(0)" ::: "memory");
    __builtin_amdgcn_s_barrier();
}
__device__ __forceinline__ void phaseB1(const Args& a, LAS unsigned char* lds, int tid) {
    asm volatile("" : "+v"(tid));
    const int lane = tid & 63, wave = __builtin_amdgcn_readfirstlane(tid >> 6);
    for (int task = blockIdx.x; task < 12 * NGRP; task += gridDim.x) {
        const int bh = task / NGRP, g = task % NGRP, c0 = 8 * g;
        pb_stage8(a, lds, bh, c0, wave, lane);
        const int vt = wave & 3, vl = lane & 15, fq = lane >> 4, xr = 16 * vt + vl;
        f32x4 X[4];
        if (wave < 4) {
#pragma unroll
            for (int mt = 0; mt < 4; ++mt) { const f16x4 l4 = *(const LAS f16x4*)(lds + 8192 + PB_SWZ(xr, 32 * mt + 8 * fq)); X[mt] = (f32x4){(float)l4[0], (float)l4[1], (float)l4[2], (float)l4[3]}; }
#pragma unroll 1
            for (int s = 1; s < 8; ++s) pb_step<true>(X, lds + s * PB_SLOT, xr, vl, fq);
#pragma unroll
            for (int mt = 0; mt < 4; ++mt) { f16x4 o;
#pragma unroll
                for (int i = 0; i < 4; ++i) o[i] = (f16)X[mt][i];
                *(f16x4*)ARENA(a.ws, AR_LG + ((size_t)bh * NGRP + g) * 8192 + (size_t)((xr * 64 + 16 * mt + 4 * fq) * 2)) = o; }
        } else {
#pragma unroll
            for (int mt = 0; mt < 4; ++mt)
#pragma unroll
                for (int i = 0; i < 4; ++i) X[mt][i] = (16 * mt + 4 * fq + i == xr) ? 1.f : 0.f;
#pragma unroll 1
            for (int s = 0; s < 8; ++s) pb_step<false>(X, lds + s * PB_SLOT, xr, vl, fq);
#pragma unroll
            for (int mt = 0; mt < 4; ++mt)
#pragma unroll
                for (int i = 0; i < 4; ++i) *(f16*)ARENA(a.ws, AR_PGT + ((size_t)bh * NGRP + g) * 8192 + (size_t)(((16 * mt + 4 * fq + i) * 64 + xr) * 2)) = (f16)X[mt][i];
        }
        asm volatile("s_waitcnt vmcnt(0) lgkmcnt(0)" ::: "memory");
        __builtin_amdgcn_s_barrier();
    }
}
__device__ __forceinline__ void phaseB3(const Args& a, LAS unsigned char* lds, int tid) {
    asm volatile("" : "+v"(tid));
    const int lane = tid & 63, wave = __builtin_amdgcn_readfirstlane(tid >> 6);
    for (int task = blockIdx.x; task < 12 * NGRP; task += gridDim.x) {
        const int bh = task / NGRP, g = task % NGRP, c0 = 8 * g;
        pb_stage8(a, lds, bh, c0, wave, lane);
        if (wave < 4) {
            const int vt = wave, vl = lane & 15, fq = lane >> 4, xr = 16 * vt + vl;
            char* RL = (char*)(a.ws + WS_RL) + ((size_t)bh * NCH + c0) * 8192;
            f32x4 X[4];
#pragma unroll
            for (int mt = 0; mt < 4; ++mt) { const f16x4 s4 = *(const f16x4*)ARENA(a.ws, AR_SG + ((size_t)bh * NGRP + g) * 8192 + (size_t)((xr * 64 + 16 * mt + 4 * fq) * 2)); X[mt] = (f32x4){(float)s4[0], (float)s4[1], (float)s4[2], (float)s4[3]}; }
#pragma unroll 1
            for (int s = 0; s < 8; ++s) {
#pragma unroll
                for (int mt = 0; mt < 4; ++mt) { f16x4 o;
#pragma unroll
                    for (int i = 0; i < 4; ++i) o[i] = (f16)X[mt][i];
                    *(f16x4*)(RL + (size_t)s * 8192 + (xr * 64 + 16 * mt + 4 * fq) * 2) = o; }
                if (s < 7) pb_step<true>(X, lds + s * PB_SLOT, xr, vl, fq);
            }
        }
        asm volatile("s_waitcnt vmcnt(0) lgkmcnt(0)" ::: "memory");
        __builtin_amdgcn_s_barrier();
    }
}
__device__ __forceinline__ void phaseB(const Args& a, LAS unsigned char* lds, int tid) {
    asm volatile("" : "+v"(tid));
    const int lane = tid & 63, wave = __builtin_amdgcn_readfirstlane(tid >> 6);
    const int bx = blockIdx.x;
    if (bx < 12) {
        const int bh = bx;
        const bool loader = wave >= 4;
        const int vt = wave & 3, vl = lane & 15, fq = lane >> 4, v = 16 * vt + vl;
        const int lq = (wave - 4) * 64 + lane, lrow = lq >> 3, lpp = lq & 7;
        const unsigned lsrc = (unsigned)(lrow * 128 + ((lpp ^ (lrow & 7)) << 4));
#define PB_ISSUE(cc) { const unsigned so = (unsigned)(((cc) & (PB_NS - 1)) * PB_SLOT) + (unsigned)((wave - 4) * 1024); const size_t go = ((size_t)bh * NGRP + (cc)) * 8192 + lsrc; \
            __builtin_amdgcn_global_load_lds((const unsigned*)ARENA(a.ws, AR_PGT + go), (LAS unsigned*)(lds + so), 16, 0, 0); \
            __builtin_amdgcn_global_load_lds((const unsigned*)ARENA(a.ws, AR_PGT + go + 4096), (LAS unsigned*)(lds + so + 4096), 16, 0, 0); \
            __builtin_amdgcn_global_load_lds((const unsigned*)ARENA(a.ws, AR_LG + go), (LAS unsigned*)(lds + so + 8192), 16, 0, 0); \
            __builtin_amdgcn_global_load_lds((const unsigned*)ARENA(a.ws, AR_LG + go + 4096), (LAS unsigned*)(lds + so + 12288), 16, 0, 0); }
        if (loader) {
#pragma unroll
            for (int cc = 0; cc < PB_AHEAD; ++cc) PB_ISSUE(cc)
            asm volatile("s_waitcnt vmcnt(20)" ::: "memory");
        }
        __builtin_amdgcn_s_barrier();
        f32x4 Sacc[4];
#pragma unroll
        for (int mt = 0; mt < 4; ++mt) Sacc[mt] = (f32x4){0.f, 0.f, 0.f, 0.f};
#pragma unroll 1
        for (int c = 0; c < NGRP; ++c) {
            if (loader) {
                if (c + PB_AHEAD < NGRP) { PB_ISSUE(c + PB_AHEAD) asm volatile("s_waitcnt vmcnt(20)" ::: "memory"); }
                else asm volatile("s_waitcnt vmcnt(0)" ::: "memory");
            } else {
#pragma unroll
                for (int mt = 0; mt < 4; ++mt) { f16x4 o;
#pragma unroll
                    for (int i = 0; i < 4; ++i) o[i] = (f16)Sacc[mt][i];
                    *(f16x4*)ARENA(a.ws, AR_SG + ((size_t)bh * NGRP + c) * 8192 + (size_t)((v * 64 + 16 * mt + 4 * fq) * 2)) = o; }
                pb_step<true>(Sacc, lds + (c & (PB_NS - 1)) * PB_SLOT, v, vl, fq);
                asm volatile("s_waitcnt lgkmcnt(0)" ::: "memory");
            }
            __builtin_amdgcn_s_barrier();
        }
#undef PB_ISSUE
        asm volatile("s_waitcnt vmcnt(0)" ::: "memory");
    } else if (bx < 12 + 96) {
        const int idx = (bx - 12) * NT + tid; const int bh = idx >> 12, e = idx & 4095, k = e & 63;
        f16* HL = (f16*)(a.ws + WS_HL); const float* DC = (const float*)(a.ws + WS_DC);
        float s = 0.f;
        for (int c0 = 0; c0 < NCH; c0 += 8) { float Lc[8], d[8];
#pragma unroll
            for (int j = 0; j < 8; ++j) { Lc[j] = (float)HL[((size_t)bh * NCH + c0 + j) * 4096 + e]; d[j] = DC[((size_t)bh * NCH + c0 + j) * 64 + k]; }
#pragma unroll
            for (int j = 0; j < 8; ++j) { HL[((size_t)bh * NCH + c0 + j) * 4096 + e] = (f16)s; s = d[j] * s + Lc[j]; } }
    } else if (bx == 12 + 96) {
        const int bb = tid >> 8, ch = tid & 255; const float* LA = (const float*)(a.ws + WS_LA); float* LH = (float*)(a.ws + WS_LH);
        float cy = 0.f;
        for (int c0 = 0; c0 < NCH; c0 += 8) { float A[8], H[8];
#pragma unroll
            for (int j = 0; j < 8; ++j) { const size_t o = ((size_t)bb * NCH + c0 + j) * 256 + ch; A[j] = LA[o]; H[j] = LH[o]; }
#pragma unroll
            for (int j = 0; j < 8; ++j) { const size_t o = ((size_t)bb * NCH + c0 + j) * 256 + ch; LH[o] = cy; cy = A[j] * cy + H[j]; } }
    }
}

__device__ __forceinline__ void phaseC(const Args& a, int l, int task, LAS unsigned char* lds, int tid) {
    asm volatile("" : "+v"(tid));
    const int lane = tid & 63, wave = __builtin_amdgcn_readfirstlane(tid >> 6);
    const int b = task / NCH, c = task % NCH;
    const int tl = lane & 15, fq = lane >> 4, tt = wave & 3, hg = wave >> 2;
    const unsigned m = (unsigned)(b * SEQ + c * CH + 16 * tt + tl);
    const char* U = (const char*)(a.ws + WS_U); char* MIX = (char*)(a.ws + WS_MIX); const char* VP = (const char*)(a.ws + WS_VP);
    const char* QT = (const char*)(a.ws + WS_QT); const char* RL = (const char*)(a.ws + WS_RL); const char* HL = (const char*)(a.ws + WS_HL); const float* BONG = (const float*)(a.ws + WS_BON);
    const unsigned uo = m * (unsigned)(NU * 2);
#pragma unroll
    for (int hh = 0; hh < 3; ++hh) {
        const int h = 3 * hg + hh; const int bh = b * RW_H + h;
        const char* sl = RL + ((size_t)bh * NCH + c) * 8192;
        f16x8 bq[2];
#pragma unroll
        for (int s = 0; s < 2; ++s) bq[s] = *(const f16x8*)(QT + (m * (unsigned)RW_W + (unsigned)(h * 64 + 8 * fq + 32 * s)) * 2u);
        f32x4 D[4];
#pragma unroll
        for (int vt = 0; vt < 4; ++vt) { const f16x4 yl = *(const f16x4*)(MIX + (m * (unsigned)DM + (unsigned)(h * 64 + 16 * vt + 4 * fq)) * 2u);
            f32x4 d = (f32x4){(float)yl[0], (float)yl[1], (float)yl[2], (float)yl[3]};
#pragma unroll
            for (int s = 0; s < 2; ++s) d = __builtin_amdgcn_mfma_f32_16x16x32_f16(*(const f16x8*)(sl + ((16 * vt + tl) * 64 + 8 * fq + 32 * s) * 2), bq[s], d, 0, 0, 0);
            D[vt] = d; }
        float sm = 0.f;
#pragma unroll
        for (int vt = 0; vt < 4; ++vt) sm += (D[vt][0] + D[vt][1]) + (D[vt][2] + D[vt][3]);
        sm += shfl_xor_f(sm, 16); sm += shfl_xor_f(sm, 32);
        const float mean = sm * (1.0f / 64.0f); float vr = 0.f;
#pragma unroll
        for (int vt = 0; vt < 4; ++vt)
#pragma unroll
            for (int i = 0; i < 4; ++i) { const float d = D[vt][i] - mean; vr += d * d; }
        vr += shfl_xor_f(vr, 16); vr += shfl_xor_f(vr, 32);
        const float rstd = rsq_(vr * (1.0f / 64.0f) + 64e-5f);
        const float bon = BONG[m * 8u + (unsigned)h];
        const float* ln_w = a.in[14] + l * RW_W; const float* ln_b = a.in[15] + l * RW_W;
#pragma unroll
        for (int vt = 0; vt < 4; ++vt) { const unsigned col = (unsigned)(h * 64 + 16 * vt + 4 * fq);
            const f16x4 vp = *(const f16x4*)(VP + (m * (unsigned)RW_W + col) * 2u), z4 = *(const f16x4*)(U + uo + ((unsigned)C_RWZ + col) * 2u);
            const f32x4 lw = *(const f32x4*)(ln_w + col), lb = *(const f32x4*)(ln_b + col);
            f16x4 o;
#pragma unroll
            for (int i = 0; i < 4; ++i) o[i] = (f16)(((D[vt][i] - mean) * rstd * lw[i] + lb[i] + bon * (float)vp[i]) * siluf_((float)z4[i]));
            *(f16x4*)(MIX + (m * (unsigned)DM + col) * 2u) = o; }
    }
#pragma unroll
    for (int hh = 0; hh < 3; ++hh) {
        const int h = 3 * hg + hh; const int bh = b * 6 + h;
        const char* sl = HL + ((size_t)bh * NCH + c) * 8192;
        f16x8 bq[2];
#pragma unroll
        for (int s = 0; s < 2; ++s) bq[s] = *(const f16x8*)(U + uo + (unsigned)(C_HGQ + h * 64 + 8 * fq + 32 * s) * 2u);
        f32x4 D[4];
#pragma unroll
        for (int vt = 0; vt < 4; ++vt) { const f16x4 ol = *(const f16x4*)(MIX + (m * (unsigned)DM + (unsigned)(384 + h * 64 + 16 * vt + 4 * fq)) * 2u);
            f32x4 d = (f32x4){(float)ol[0], (float)ol[1], (float)ol[2], (float)ol[3]};
#pragma unroll
            for (int s = 0; s < 2; ++s) d = __builtin_amdgcn_mfma_f32_16x16x32_f16(*(const f16x8*)(sl + ((16 * vt + tl) * 64 + 8 * fq + 32 * s) * 2), bq[s], d, 0, 0, 0);
            D[vt] = d; }
        float ss = 0.f;
#pragma unroll
        for (int vt = 0; vt < 4; ++vt) ss += (D[vt][0] * D[vt][0] + D[vt][1] * D[vt][1]) + (D[vt][2] * D[vt][2] + D[vt][3] * D[vt][3]);
        ss += shfl_xor_f(ss, 16); ss += shfl_xor_f(ss, 32);
        const float rs = rsq_(ss * (1.0f / 64.0f) + 1e-6f);
        const float* nw = a.in[17] + l * 384;
#pragma unroll
        for (int vt = 0; vt < 4; ++vt) { const unsigned col = (unsigned)(h * 64 + 16 * vt + 4 * fq);
            const f16x4 z4 = *(const f16x4*)(U + uo + ((unsigned)C_HGZ + col) * 2u); const f32x4 w4 = *(const f32x4*)(nw + col);
            f16x4 o;
#pragma unroll
            for (int i = 0; i < 4; ++i) o[i] = (f16)(D[vt][i] * rs * w4[i] * siluf_((float)z4[i]));
            *(f16x4*)(MIX + (m * (unsigned)DM + 384u + col) * 2u) = o; }
    }
    {
        const char* CA = (const char*)(a.ws + WS_CA); const float* LH = (const float*)(a.ws + WS_LH) + ((size_t)b * NCH + c) * 256;
#pragma unroll
        for (int q = 0; q < 4; ++q) { const unsigned ch0 = (unsigned)(128 * hg + 32 * fq + 8 * q);
            const f16x8 hl = *(const f16x8*)(MIX + (m * (unsigned)DM + 768u + ch0) * 2u), ca = *(const f16x8*)(CA + (m * 256u + ch0) * 2u), z8 = *(const f16x8*)(U + uo + ((unsigned)C_LRUZ + ch0) * 2u);
            const f32x4 c0 = *(const f32x4*)(LH + ch0), c1 = *(const f32x4*)(LH + ch0 + 4);
            f16x8 o;
#pragma unroll
            for (int i = 0; i < 8; ++i) o[i] = (f16)(((float)hl[i] + (float)ca[i] * (i < 4 ? c0[i & 3] : c1[i & 3])) * siluf_((float)z8[i]));
            *(f16x8*)(MIX + (m * (unsigned)DM + 768u + ch0) * 2u) = o; }
    }
}
#define XB_TMO      128
#define XB_XCNT(j)  (256  + 64 * (j))
#define XB_XSUB(j)  (1280 + 64 * (j))
#define XB_XGEN(j)  (2304 + 64 * (j))
#define XB_TOP      3328
#define XB_TOPGEN   3392
#define XCD_BAR_WORDS 3456
#define XB_SPIN_CAP (1u << 18)

__device__ __forceinline__ unsigned xb_ld(unsigned* p)              { return __hip_atomic_load(p, __ATOMIC_RELAXED, __HIP_MEMORY_SCOPE_AGENT); }
__device__ __forceinline__ unsigned xb_add(unsigned* p, unsigned v) { return __hip_atomic_fetch_add(p, v, __ATOMIC_RELAXED, __HIP_MEMORY_SCOPE_AGENT); }
__device__ __forceinline__ unsigned xb_xcc_id() { return (unsigned)__builtin_amdgcn_s_getreg((3 << 11) | 20) & 0xFu; }
#define XB_SPIN(cond, bar) do { unsigned _sp = 0; while (cond) { __builtin_amdgcn_s_sleep(1); \
    if ((++_sp & 255u) == 0u) { if (xb_ld(&(bar)[XB_TMO])) break; if (_sp > XB_SPIN_CAP) { atomicAdd(&(bar)[XB_TMO], 1u); break; } } } } while (0)

struct XcdBarrier {
    unsigned* bar; unsigned x; int isw0;
    volatile LAS unsigned* st;
};

__device__ __forceinline__ XcdBarrier xcd_barrier_post(unsigned* bar, volatile LAS unsigned* st, int isw0) {
    XcdBarrier b; b.bar = bar; b.x = xb_xcc_id(); b.st = st; b.isw0 = isw0;
    if (isw0 && lane_now() == 0) (void)xb_add(&bar[XB_XCNT(b.x)], 1u);
    return b;
}
__device__ __forceinline__ void xcd_barrier_complete(unsigned* bar, unsigned x, unsigned& nloc, unsigned& nx) {
    const unsigned G = gridDim.x * gridDim.y * gridDim.z;
    unsigned sum, cnt, mine, sp = 0u;
    for (;;) {
        sum = 0u; cnt = 0u; mine = 0u;
#pragma unroll
        for (unsigned j = 0; j < 16; ++j) { const unsigned c = xb_ld(&bar[XB_XCNT(j)]); sum += c; cnt += (c > 0u) ? 1u : 0u; mine = (j == x) ? c : mine; }
        if (sum == G) break;
        __builtin_amdgcn_s_sleep(1);
        if ((++sp & 255u) == 0u) { if (xb_ld(&bar[XB_TMO])) break; if (sp > XB_SPIN_CAP) { atomicAdd(&bar[XB_TMO], 1u); break; } }
    }
    nloc = mine > 0u ? mine : 1u; nx = cnt > 0u ? cnt : 1u;
}

__device__ __forceinline__ void xcd_barrier(const XcdBarrier& b) {
    asm volatile("s_waitcnt vmcnt(0)" ::: "memory");
    __syncthreads();
    if (b.isw0 && lane_now() == 0) {
        unsigned* bar = b.bar;
        __builtin_amdgcn_s_waitcnt(0);
        unsigned nloc = b.st[0], nx = b.st[1];
        if (nloc == 0u) { xcd_barrier_complete(bar, b.x, nloc, nx); b.st[0] = nloc; b.st[1] = nx; }
        const unsigned old = xb_add(&bar[XB_XSUB(b.x)], 1u);
        const unsigned gen = old / nloc;
        if (old + 1u == (gen + 1u) * nloc) {
            __builtin_amdgcn_fence(__ATOMIC_RELEASE, "agent");
            asm volatile("s_waitcnt vmcnt(0)" ::: "memory");
            const unsigned og = xb_add(&bar[XB_TOP], 1u);
            const unsigned tg = og / nx;
            if (og + 1u == (tg + 1u) * nx) xb_add(&bar[XB_TOPGEN], 1u);
            else XB_SPIN(xb_ld(&bar[XB_TOPGEN]) == tg, bar);
            __builtin_amdgcn_fence(__ATOMIC_ACQUIRE, "agent");
            xb_add(&bar[XB_XGEN(b.x)], 1u);
            asm volatile("s_waitcnt vmcnt(0)" ::: "memory");
        } else {
            XB_SPIN(xb_ld(&bar[XB_XGEN(b.x)]) == gen, bar);
            __builtin_amdgcn_fence(__ATOMIC_ACQUIRE, "agent");
            asm volatile("s_waitcnt vmcnt(0)" ::: "memory");
        }
    }
    __syncthreads();
}

constexpr size_t WS_BAR = 16384;
constexpr int MISC_OFF = LDS_BYTES - 16;
__global__ void __launch_bounds__(NT, 2) fwd(Args args) {
    extern __shared__ __attribute__((aligned(16))) unsigned char lds_raw[];
    LAS unsigned char* lds = (LAS unsigned char*)lds_raw;
    cg::grid_group grid = cg::this_grid();
    const int wave = __builtin_amdgcn_readfirstlane((int)threadIdx.x >> 6);
#define TID_NOW() (wave * 64 + lane_now())
    const int tid = TID_NOW(); const int lane = tid & 63;
    if (wave == 0 && lane < 4) ((LAS unsigned*)(lds + MISC_OFF))[lane] = 0u;
    __syncthreads();
    XcdBarrier xbar = xcd_barrier_post((unsigned*)(args.ws + WS_BAR), (volatile LAS unsigned*)(lds + MISC_OFF), __builtin_amdgcn_readfirstlane(wave == 0 ? 1 : 0));
#define GRID_BAR() do { XcdBarrier xb_ = xbar; xb_.st = (volatile LAS unsigned*)(lds + MISC_OFF); asm volatile("" : "+s"(xb_.bar), "+s"(xb_.x)); xcd_barrier(xb_); } while (0)
    const int G = gridDim.x, gw = blockIdx.x * NWAVES + wave, NGW = G * NWAVES;
    unsigned char* ws = args.ws;
    unsigned short* XN = (unsigned short*)(ws + WS_XN);
    {
        LAS float* scr = (LAS float*)(lds + wave * 16384);
        constexpr int I_IN = (DM / 64) * (NIN / 32), I_OUT = (DM / 64) * (DM / 32), NITEMS = DEPTH * (I_IN + I_OUT);
        for (int it = gw; it < NITEMS; it += NGW) {
            int r = it; const int l = r / (I_IN + I_OUT); r -= l * (I_IN + I_OUT);
            if (r < I_IN) p0_transpose_item(args.in[2] + (size_t)l * DM * NIN, DM, NIN, (unsigned short*)(ws + WS_WIN + l * WIN_L), scr, r, lane, l == 0 ? nullptr : args.in[1] + DM);
            else p0_transpose_item(args.in[25] + (size_t)l * DM * DM, DM, DM, (unsigned short*)(ws + WS_WOUT + l * WOUT_L), scr, r - I_IN, lane, nullptr);
        }
        for (int i = gw; i < DEPTH * (NU - NIN) * DM * 2 / 1024; i += NGW) { const int l = i / ((NU - NIN) * DM * 2 / 1024), r = i % ((NU - NIN) * DM * 2 / 1024);
            if (l == 1 && r < 64 * DM * 2 / 1024) continue;
            *(u32x4*)(ws + WS_WIN + l * WIN_L + (size_t)NIN * DM * 2 + (size_t)r * 1024 + lane * 16) = (u32x4){0u, 0u, 0u, 0u}; }
        for (int i4 = blockIdx.x * NT + tid; i4 < 4 * 64 * DM; i4 += G * NT) { const int q = i4 & 3, i = i4 >> 2, k = i >> 6, n = i & 63, j = n & 31;
            const float* wrow = args.in[2] + (size_t)DM * NIN + (size_t)k * NIN + C_V + 96 * q; const float* mu1 = args.in[3] + RW_SHIFT + C_V + 96 * q; const float* vdn = args.in[9] + (96 * q) * 32 + j;
            float acc = 0.f;
#pragma unroll 8
            for (int cc = 0; cc < 96; ++cc) { const float mm = mu1[cc]; acc += wrow[cc] * ((n < 32) ? (1.0f - mm) : mm) * vdn[cc * 32]; }
            acc += shfl_xor_f(acc, 1); acc += shfl_xor_f(acc, 2);
            if (q == 0) ((f16*)(ws + WS_WIN + WIN_L))[(size_t)(NIN + n) * DM + k] = (f16)(acc * args.in[1][DM + k]); }
        for (int i = blockIdx.x * NT + tid; i < M; i += G * NT) ((float*)(ws + WS_RSS))[i] = 0.f;
        for (int m = gw; m < M; m += 4 * NGW) rms_row4_f16(args.in[0] + (size_t)m * DM, (size_t)NGW * DM, args.in[1], XN + (size_t)m * DM, lane);
        { f16* WUPT = (f16*)(ws + WS_WUPT); f16* AUPT = (f16*)(ws + WS_AUPT); f16* VDNT = (f16*)(ws + WS_VDNT); f16* VUPT = (f16*)(ws + WS_VUPT);
          for (int i = blockIdx.x * NT + tid; i < 122880; i += G * NT) {
              if (i < 49152) { const int ll = i / 24576, r = i % 24576, n = r / 64, k = r % 64; WUPT[i] = (f16)args.in[5][(size_t)ll * 24576 + k * 384 + n]; }
              else if (i < 98304) { const int i2 = i - 49152, ll = i2 / 24576, r = i2 % 24576, n = r / 64, k = r % 64; AUPT[i2] = (f16)args.in[7][(size_t)ll * 24576 + k * 384 + n]; }
              else if (i < 110592) { const int i2 = i - 98304, j2 = i2 / 384, cc = i2 % 384; VDNT[i2] = (f16)args.in[9][cc * 32 + j2]; }
              else { const int i2 = i - 110592, n = i2 / 32, j2 = i2 % 32; VUPT[i2] = (f16)args.in[10][j2 * 384 + n]; } }
          f16* WAT = (f16*)(ws + WS_WAT); f16* WXT = (f16*)(ws + WS_WXT);
          for (int i = blockIdx.x * NT + tid; i < 32768; i += G * NT) { const int lg = i >> 12, r = i & 4095, j = r >> 6, ii = r & 63; WAT[i] = (f16)args.in[20][(size_t)lg * 4096 + ii * 64 + j]; WXT[i] = (f16)args.in[22][(size_t)lg * 4096 + ii * 64 + j]; } }
    }
    if (gridDim.x > 65536u) grid.sync();
    GRID_BAR();
#pragma unroll 1
    for (int l = 0; l < DEPTH; ++l) {
        { pg8::Gemm g{XN, (const unsigned short*)(ws + WS_WIN + l * WIN_L), M, NU, DM}; pg8::StaticOrder S; S.init(M, NU, G, (int)blockIdx.x);
          pg8::EpiF16 E{(unsigned short*)(ws + WS_U), NU, l == 0 ? nullptr : (const float*)(ws + WS_RSS)};
          pg8::gemm_phase<pg8::EpiF16, pg8::StaticOrder, true, true>(lds, g, S, E, wave); }
        GRID_BAR();
        for (int task = blockIdx.x; task < BATCH * NCH; task += G) phaseA(args, l, task, lds, TID_NOW());
        GRID_BAR();
        phaseB1(args, lds, TID_NOW());
        GRID_BAR();
        phaseB(args, lds, TID_NOW());
        GRID_BAR();
        phaseB3(args, lds, TID_NOW());
        GRID_BAR();
        for (int task = blockIdx.x; task < BATCH * NCH; task += G) phaseC(args, l, task, lds, TID_NOW());
        GRID_BAR();
        { pg8::Gemm g{(const unsigned short*)(ws + WS_MIX), (const unsigned short*)(ws + WS_WOUT + l * WOUT_L), M, DM, DM}; pg8::StaticOrder S; S.init(M, DM, G, (int)blockIdx.x);
          pg8::EpiRes E{l == 0 ? args.in[0] : args.out, args.out, DM, l == 0 ? XN : nullptr, (float*)(ws + WS_RSS)};
          pg8::gemm_phase<pg8::EpiRes, pg8::StaticOrder, true, true>(lds, g, S, E, wave); }
        GRID_BAR();
        { int ln = TID_NOW() & 63; asm volatile("" : "+v"(ln));
          if (l + 1 < DEPTH) { }
          else { for (int m = gw; m < M; m += 2 * NGW) rms_row2_f32(args.out + (size_t)m * DM, args.out + (size_t)(m + NGW) * DM, args.in[26], ln); } }
    }
}

extern "C" void kernel_launch(void* const* d_in, const int* in_sizes, int n_in, void* d_out, int out_size, void* d_ws, size_t ws_size, hipStream_t stream) {
    static int grid = 0;
    if (grid == 0) {
        if (n_in != 27 || in_sizes[0] != M * DM || out_size != M * DM || ws_size < WS_END) { fprintf(stderr, "kernel_launch: unexpected problem: n_in %d in0 %d out %d ws %zu\n", n_in, n_in > 0 ? in_sizes[0] : -1, out_size, ws_size); grid = -1; return; }
        int dev = 0, cus = 0, per_cu = 0;
        hipGetDevice(&dev); hipDeviceGetAttribute(&cus, hipDeviceAttributeMultiprocessorCount, dev);
        if (hipFuncSetAttribute((const void*)fwd, hipFuncAttributeMaxDynamicSharedMemorySize, LDS_BYTES) != hipSuccess) { fprintf(stderr, "kernel_launch: hipFuncSetAttribute failed\n"); grid = -1; return; }
        if (hipOccupancyMaxActiveBlocksPerMultiprocessor(&per_cu, (const void*)fwd, NT, LDS_BYTES) != hipSuccess || per_cu < 1) { fprintf(stderr, "kernel_launch: occupancy query failed (%d)\n", per_cu); grid = -1; return; }
        grid = cus * per_cu;
    }
    if (grid < 0) return;
    if (hipMemsetAsync((char*)d_ws, 0, 65536, stream) != hipSuccess) { fprintf(stderr, "kernel_launch: memset of the barrier words failed\n"); return; }
    Args a{};
    for (int i = 0; i < 27; ++i) a.in[i] = (const float*)d_in[i];
    a.out = (float*)d_out; a.ws = (unsigned char*)d_ws;
    void* kargs[] = {&a};
    hipError_t e = hipLaunchCooperativeKernel((const void*)fwd, dim3(grid), dim3(NT), kargs, LDS_BYTES, stream);
    if (e != hipSuccess) fprintf(stderr, "cooperative launch failed: %s (grid %d)\n", hipGetErrorString(e), grid);
}
```

```cpp
#include <hip/hip_runtime.h>
#include <hip/hip_cooperative_groups.h>
#include <cstdio>
#include <cstdint>
namespace cg = cooperative_groups;
typedef _Float16 f16x8_t __attribute__((ext_vector_type(8)));
#define MK_MFMA(a, b, c) __builtin_amdgcn_mfma_f32_16x16x32_f16(__builtin_bit_cast(f16x8_t, (a)), __builtin_bit_cast(f16x8_t, (b)), (c), 0, 0, 0)
__device__ __forceinline__ int lane_now() { int z; asm volatile("v_mbcnt_lo_u32_b32 %0, -1, 0\n\tv_mbcnt_hi_u32_b32 %0, -1, %0" : "=v"(z)); return z; }
__device__ __forceinline__ float shfl_xor_f(float v, int mask) { const int ln = lane_now(); return __builtin_bit_cast(float, __builtin_amdgcn_ds_bpermute((ln ^ mask) << 2, __builtin_bit_cast(int, v))); }
namespace pg8 {
#define PG8_LAS __attribute__((address_space(3)))
typedef unsigned short bf16_t;
typedef short bf16x8 __attribute__((ext_vector_type(8)));
typedef float f32x4 __attribute__((ext_vector_type(4)));
typedef unsigned u32x4 __attribute__((ext_vector_type(4)));
constexpr int BM = 256, BK = 64, HALF = 128, HTB = HALF * BK * 2  , STAGE_BYTES = 8 * HTB, NXCD = 8, WGM = 8;

__host__ __device__ __forceinline__ int lds_byte(int r, int c) { const int st = (r >> 4) * 2 + (c >> 5), rr = r & 15, cc = c & 31, ob = rr * 64 + cc * 2; return st * 1024 + (ob ^ (((ob >> 9) & 1) << 5)); }
__host__ __device__ __forceinline__ void stage_rc(int b, int& R, int& C) { const int st = b / 1024, sb = b % 1024, swz = sb ^ (((sb >> 9) & 1) << 5); R = (st >> 1) * 16 + swz / 64; C = (st & 1) * 32 + (swz % 64) / 2; }
__host__ __device__ __forceinline__ int perm32(int rho) { const int n = rho >> 4, i = rho & 15; return 8 * (i >> 2) + 4 * n + (i & 3); }

struct Unit { int pm, pn; };
struct Gemm { const bf16_t* A; const bf16_t* Bt; int M, N, K; };

struct StaticOrder {
    int nM, nN, nwg, G, c;
    __host__ __device__ void init(int M, int N, int G_, int c_) { nM = M / BM; nN = N / BM; nwg = nM * nN; G = G_; c = c_; }
    __host__ __device__ bool next(int i, Unit& u) const {
        const long L = (long)i * G + c; if (L >= nwg) return false;
        int wgid = (int)L; { const int q = nwg / NXCD, r = nwg % NXCD, xcd = wgid % NXCD, off = wgid / NXCD; wgid = (xcd < r ? xcd * (q + 1) : r * (q + 1) + (xcd - r) * q) + off; }
        const int nig = WGM * nN, gid = wgid / nig, fm = gid * WGM, gsz = (nM - fm) < WGM ? (nM - fm) : WGM;
        u.pm = fm + ((wgid % nig) % gsz); u.pn = (wgid % nig) / gsz; return true;
    }
    __device__ __forceinline__ void a_ready(const Unit&) const {}
    __device__ __forceinline__ void done(const Unit&) const {}
};

__device__ __forceinline__ unsigned pk_f16(float lo, float hi) { typedef _Float16 h2 __attribute__((ext_vector_type(2))); h2 v; v.x = (_Float16)lo; v.y = (_Float16)hi; return __builtin_bit_cast(unsigned, v); }
typedef unsigned u32x2 __attribute__((ext_vector_type(2)));
struct EpiF16 {
    static constexpr bool PERM = true, AFTER_DRAIN = false;
    bf16_t* O; int ldc; const float* rss;
    __device__ __forceinline__ void operator()(const f32x4 (&acc)[2][2][4][2], const Unit& u, int wr, int wc, int fr, int fq) const {
        const int row0 = u.pm * BM + wr * 64 + fr; const int col0 = u.pn * BM + wc * 32 + 8 * fq;
#pragma unroll
        for (int ai = 0; ai < 2; ++ai)
#pragma unroll
            for (int m = 0; m < 4; ++m) { const int row = row0 + ai * HALF + m * 16; bf16_t* rowp = O + (size_t)row * ldc + col0;
                const float sc = rss ? 1.0f / sqrtf(rss[row] * (1.0f / 1024.0f) + 1e-6f) : 1.0f;
#pragma unroll
                for (int bj = 0; bj < 2; ++bj) { const f32x4 v0 = acc[ai][bj][m][0] * sc, v1 = acc[ai][bj][m][1] * sc;
                    u32x4 w; w.x = pk_f16(v0[0], v0[1]); w.y = pk_f16(v0[2], v0[3]); w.z = pk_f16(v1[0], v1[1]); w.w = pk_f16(v1[2], v1[3]);
                    *(u32x4*)(rowp + bj * HALF) = w; } }
    }
};
struct EpiRes {
    static constexpr bool PERM = false, AFTER_DRAIN = false;
    const float* base; float* out; int ldc; bf16_t* xh; float* rss;
    __device__ __forceinline__ void operator()(const f32x4 (&acc)[2][2][4][2], const Unit& u, int wr, int wc, int fr, int fq) const {
        const int row0 = u.pm * BM + wr * 64 + fr; const int col0 = u.pn * BM + wc * 32 + 4 * fq;
#pragma unroll
        for (int ai = 0; ai < 2; ++ai)
#pragma unroll
            for (int m = 0; m < 4; ++m) { const size_t off = (size_t)(row0 + ai * HALF + m * 16) * ldc + col0; float ss = 0.f;
#pragma unroll
                for (int bj = 0; bj < 2; ++bj)
#pragma unroll
                    for (int n = 0; n < 2; ++n) { const size_t o = off + bj * HALF + n * 16; const f32x4 b = *(const f32x4*)(base + o); const f32x4 x = b + acc[ai][bj][m][n]; *(f32x4*)(out + o) = x;
                        if (xh) { u32x2 h; h.x = pk_f16(x[0], x[1]); h.y = pk_f16(x[2], x[3]); *(u32x2*)(xh + o) = h; ss += (x[0] * x[0] + x[1] * x[1]) + (x[2] * x[2] + x[3] * x[3]); } }
                if (xh) { ss += shfl_xor_f(ss, 16); ss += shfl_xor_f(ss, 32); if (fq == 0) atomicAdd(rss + row0 + ai * HALF + m * 16, ss); }
                asm volatile("" ::: "memory"); }
    }
};

template <class Epi, class Sched, bool ALIGN_EPI = false, bool SP2 = false>
__device__ __forceinline__ void gemm_phase(PG8_LAS unsigned char* lds, const Gemm g, const Sched& S, const Epi& E, const int wave_) {
    int wv_ = wave_; asm volatile("" : "+s"(wv_)); int tid_ = lane_now() + 64 * wv_; const int tid = tid_, wid = wv_, lane = tid & 63, wr = wid >> 2, wc = wid & 3, fr = lane & 15, fq = lane >> 4;
    const int K = g.K, nt = K / BK;
    unsigned voffA[2], voffB[2];
#pragma unroll
    for (int i = 0; i < 2; ++i) { int R, C; stage_rc(tid * 16 + i * 8192, R, C); const int Rb = Epi::PERM ? ((R & ~31) + perm32(R & 31)) : R;
        voffA[i] = (unsigned)(R * K + C) * 2u; voffB[i] = (unsigned)(Rb * K + C) * 2u; }
    const size_t kstep = (size_t)(BK * 2);
    const size_t hstep = (size_t)HALF * K * 2;
    const size_t tstep = 2 * hstep;
    const unsigned ldsw = (unsigned)wid * 1024u;
    const int aoff = lds_byte(wr * 64 + fr, fq * 8), boff = lds_byte(wc * 32 + fr, fq * 8);
#define PG8_SA(b, h) (((b) * 2 + (h)) * HTB)
#define PG8_SB(b, h) ((4 + (b) * 2 + (h)) * HTB)
#define PG8_STAGE(bufoff, gbase, voff) do { _Pragma("unroll") for (int _i = 0; _i < 2; ++_i) \
        __builtin_amdgcn_global_load_lds((const unsigned*)((const char*)(gbase) + (voff)[_i]), (PG8_LAS unsigned*)(lds + (bufoff) + ldsw + _i * 8192), 16, 0, 0); } while (0)
#define PG8_LDA(dst, b, h) do { _Pragma("unroll") for (int m = 0; m < 4; ++m) _Pragma("unroll") for (int k = 0; k < 2; ++k) dst[m][k] = *(const PG8_LAS bf16x8*)(lds + PG8_SA(b, h) + aoff + m * 2048 + k * 1024); } while (0)
#define PG8_LDB(dst, b, h) do { _Pragma("unroll") for (int n = 0; n < 2; ++n) _Pragma("unroll") for (int k = 0; k < 2; ++k) dst[n][k] = *(const PG8_LAS bf16x8*)(lds + PG8_SB(b, h) + boff + n * 2048 + k * 1024); } while (0)
#define PG8_MMA(ai, bj, At, Bt) do { __builtin_amdgcn_s_setprio(1); _Pragma("unroll") for (int m = 0; m < 4; ++m) _Pragma("unroll") for (int n = 0; n < 2; ++n) _Pragma("unroll") for (int k = 0; k < 2; ++k) \
        acc[ai][bj][m][n] = MK_MFMA(Bt[n][k], At[m][k], acc[ai][bj][m][n]); __builtin_amdgcn_s_setprio(0); } while (0)
#define PG8_WAIT_V(n) asm volatile("s_waitcnt vmcnt(" #n ")" ::: "memory")
#define PG8_WAIT_L(n) asm volatile("s_waitcnt lgkmcnt(" #n ")" ::: "memory")
#define PG8_BAR __builtin_amdgcn_s_barrier()
#define PG8_SCHED __builtin_amdgcn_sched_barrier(0)
    Unit cur, nxt; int ui = 0;
    if (!S.next(0, cur)) return;
    f32x4 acc[2][2][4][2];
#pragma unroll
    for (int a = 0; a < 2; ++a)
#pragma unroll
        for (int b = 0; b < 2; ++b)
#pragma unroll
            for (int m = 0; m < 4; ++m)
#pragma unroll
                for (int n = 0; n < 2; ++n) acc[a][b][m][n] = (f32x4){0.f, 0.f, 0.f, 0.f};
    bf16x8 At[4][2], B0[2][2], B1[2][2];
    const char* cA = (const char*)g.A + (size_t)cur.pm * tstep; const char* cB = (const char*)g.Bt + (size_t)cur.pn * tstep;
    S.a_ready(cur);
    if constexpr (SP2) {
        PG8_STAGE(PG8_SB(0, 0), cB, voffB); PG8_STAGE(PG8_SB(0, 1), cB + hstep, voffB); PG8_STAGE(PG8_SA(0, 0), cA, voffA); PG8_STAGE(PG8_SA(0, 1), cA + hstep, voffA);
        if (wr == 1) PG8_BAR;
        PG8_WAIT_V(2); PG8_BAR;
        PG8_STAGE(PG8_SB(1, 0), cB + kstep, voffB); PG8_STAGE(PG8_SA(1, 0), cA + kstep, voffA); PG8_STAGE(PG8_SB(1, 1), cB + hstep + kstep, voffB);
        PG8_WAIT_V(6); PG8_BAR;
    } else {
        PG8_STAGE(PG8_SB(0, 0), cB, voffB); PG8_STAGE(PG8_SA(0, 0), cA, voffA); PG8_STAGE(PG8_SB(0, 1), cB + hstep, voffB); PG8_STAGE(PG8_SA(0, 1), cA + hstep, voffA);
        if (wr == 1) PG8_BAR;
        PG8_WAIT_V(4); PG8_BAR;
        PG8_STAGE(PG8_SB(1, 0), cB + kstep, voffB); PG8_STAGE(PG8_SA(1, 0), cA + kstep, voffA); PG8_STAGE(PG8_SB(1, 1), cB + hstep + kstep, voffB);
        PG8_WAIT_V(6); PG8_BAR;
    }
    for (;;) {
        const bool has_next = S.next(ui + 1, nxt);
        const char* nA = has_next ? (const char*)g.A + (size_t)nxt.pm * tstep : cA; const char* nB = has_next ? (const char*)g.Bt + (size_t)nxt.pn * tstep : cB;
        for (int t = 0; t < nt; t += 2) {
            const bool last = (t == nt - 2);
            const char* a1 = cA + (size_t)(t + 1) * kstep;
            const char* a2 = last ? nA : cA + (size_t)(t + 2) * kstep; const char* b2 = last ? nB : cB + (size_t)(t + 2) * kstep;
            const char* a3 = a2 + kstep; const char* b3 = b2 + kstep;
            if (last && has_next) S.a_ready(nxt);
            if constexpr (SP2) {
            PG8_LDB(B0, 0, 0); PG8_LDB(B1, 0, 1); PG8_SCHED; PG8_LDA(At, 0, 0); PG8_STAGE(PG8_SA(1, 1), a1 + hstep, voffA);
            PG8_WAIT_V(8); PG8_WAIT_L(0); PG8_BAR; PG8_MMA(0, 0, At, B0); PG8_MMA(0, 1, At, B1); PG8_BAR; PG8_SCHED;
            PG8_LDA(At, 0, 1); PG8_STAGE(PG8_SB(0, 0), b2, voffB); PG8_STAGE(PG8_SB(0, 1), b2 + hstep, voffB); PG8_STAGE(PG8_SA(0, 0), a2, voffA);
            PG8_WAIT_V(8); PG8_WAIT_L(0); PG8_BAR; PG8_MMA(1, 0, At, B0); PG8_MMA(1, 1, At, B1); PG8_BAR; PG8_SCHED;
            PG8_LDB(B0, 1, 0); PG8_LDB(B1, 1, 1); PG8_SCHED; PG8_LDA(At, 1, 0); PG8_STAGE(PG8_SA(0, 1), a2 + hstep, voffA);
            PG8_WAIT_V(8); PG8_WAIT_L(0); PG8_BAR; PG8_MMA(0, 0, At, B0); PG8_MMA(0, 1, At, B1); PG8_BAR; PG8_SCHED;
            PG8_LDA(At, 1, 1); PG8_STAGE(PG8_SB(1, 0), b3, voffB); PG8_STAGE(PG8_SB(1, 1), b3 + hstep, voffB); PG8_STAGE(PG8_SA(1, 0), a3, voffA);
            PG8_WAIT_V(8); PG8_WAIT_L(0); PG8_BAR; PG8_MMA(1, 0, At, B0); PG8_MMA(1, 1, At, B1); PG8_BAR; PG8_SCHED;
            } else {
            PG8_LDB(B0, 0, 0); PG8_SCHED; PG8_LDA(At, 0, 0); PG8_STAGE(PG8_SA(1, 1), a1 + hstep, voffA);
            PG8_WAIT_L(8); PG8_BAR; PG8_WAIT_L(0); PG8_MMA(0, 0, At, B0); PG8_BAR; PG8_SCHED;
            PG8_LDB(B1, 0, 1); PG8_STAGE(PG8_SB(0, 0), b2, voffB);
            PG8_BAR; PG8_WAIT_L(0); PG8_MMA(0, 1, At, B1); PG8_BAR;
            PG8_LDA(At, 0, 1); PG8_STAGE(PG8_SA(0, 0), a2, voffA);
            PG8_BAR; PG8_WAIT_L(0); PG8_MMA(1, 0, At, B0); PG8_BAR; PG8_SCHED;
            PG8_STAGE(PG8_SB(0, 1), b2 + hstep, voffB);
            PG8_WAIT_V(6); PG8_BAR; PG8_MMA(1, 1, At, B1); PG8_BAR;
            PG8_LDB(B0, 1, 0); PG8_SCHED; PG8_LDA(At, 1, 0); PG8_STAGE(PG8_SA(0, 1), a2 + hstep, voffA);
            PG8_WAIT_L(8); PG8_BAR; PG8_WAIT_L(0); PG8_MMA(0, 0, At, B0); PG8_BAR; PG8_SCHED;
            PG8_LDB(B1, 1, 1); PG8_STAGE(PG8_SB(1, 0), b3, voffB);
            PG8_BAR; PG8_WAIT_L(0); PG8_MMA(0, 1, At, B1); PG8_BAR;
            PG8_LDA(At, 1, 1); PG8_STAGE(PG8_SA(1, 0), a3, voffA);
            PG8_BAR; PG8_WAIT_L(0); PG8_MMA(1, 0, At, B0); PG8_BAR; PG8_SCHED;
            PG8_STAGE(PG8_SB(1, 1), b3 + hstep, voffB);
            PG8_WAIT_V(6); PG8_BAR; PG8_MMA(1, 1, At, B1); PG8_BAR;
            }
        }
        if constexpr (ALIGN_EPI) { if (wr == 0) PG8_BAR; }
        if constexpr (!Epi::AFTER_DRAIN) { E(acc, cur, wr, wc, fr, fq); S.done(cur); }
        if (!has_next) break;
#pragma unroll
        for (int a = 0; a < 2; ++a)
#pragma unroll
            for (int b = 0; b < 2; ++b)
#pragma unroll
                for (int m = 0; m < 4; ++m)
#pragma unroll
                    for (int n = 0; n < 2; ++n) acc[a][b][m][n] = (f32x4){0.f, 0.f, 0.f, 0.f};
        cur = nxt; cA = nA; cB = nB; ++ui;
        if constexpr (ALIGN_EPI) { if (wr == 1) PG8_BAR; }
    }
    PG8_WAIT_V(0);
    if constexpr (!ALIGN_EPI) { if (wr == 0) PG8_BAR; }
    PG8_BAR;
    if constexpr (Epi::AFTER_DRAIN) { E.fused(acc, cur, wr, wc, fr, fq, lds, wid, lane); S.done(cur); }
#undef PG8_SA
#undef PG8_SB
#undef PG8_STAGE
#undef PG8_LDA
#undef PG8_LDB
#undef PG8_MMA
#undef PG8_WAIT_V
#undef PG8_WAIT_L
#undef PG8_BAR
#undef PG8_SCHED
}
}

constexpr int BATCH = 2, SEQ = 8192, DM = 1024, DEPTH = 2, M = BATCH * SEQ;
constexpr int RW_H = 6, HD = 64, RW_W = 384, RW_SHIFT = 1280;
constexpr int NIN = 3712, NU = 3840;
constexpr int C_R = 0, C_K = 384, C_V = 768, C_WL = 1152, C_AL = 1216, C_RWZ = 1280, C_HGQ = 1664, C_HGF = 2048, C_HGI = 2432, C_HGZ = 2816, C_LRUX = 3200, C_LRUZ = 3456;
constexpr int CH = 64;
constexpr int NWAVES = 8, NT = NWAVES * 64;
constexpr int LDS_BYTES = 163840;
constexpr int PRM_OFF = 138240;
constexpr size_t MiB = 1u << 20;
constexpr size_t WS_WUPT = 65536, WS_AUPT = WS_WUPT + 98304, WS_VDNT = WS_AUPT + 98304, WS_VUPT = WS_VDNT + 24576, WS_WAT = WS_VUPT + 24576, WS_WXT = WS_WAT + 65536;
constexpr size_t WS_WIN = 1 * MiB, WIN_L = (size_t)NU * DM * 2;
constexpr size_t WS_WOUT = 16 * MiB, WOUT_L = (size_t)DM * DM * 2;
constexpr size_t WS_XN = 20 * MiB;
constexpr size_t WS_QT = 20 * MiB;
constexpr size_t WS_PT = 32 * MiB;
constexpr size_t WS_CA = 44 * MiB;
constexpr size_t WS_U = 52 * MiB;
constexpr size_t WS_MIX = 172 * MiB;
constexpr size_t WS_VF = 204 * MiB;
constexpr size_t WS_VP = 216 * MiB;
constexpr size_t WS_RL = 228 * MiB;
constexpr size_t WS_HL = 240 * MiB;
constexpr size_t WS_BON = 252 * MiB;
constexpr size_t WS_DC = WS_BON + 512 * 1024;
constexpr size_t WS_LA = WS_DC + 512 * 1024;
constexpr size_t WS_LH = WS_LA + 256 * 1024;
constexpr size_t WS_RSS = WS_LH + 256 * 1024;
constexpr size_t WS_END = 254 * MiB;
constexpr int NCH = SEQ / CH;

#define LAS __attribute__((address_space(3)))
typedef float f32x4 __attribute__((ext_vector_type(4)));
typedef unsigned u32x2 __attribute__((ext_vector_type(2)));
typedef unsigned u32x4 __attribute__((ext_vector_type(4)));
typedef _Float16 f16;
typedef _Float16 f16x8 __attribute__((ext_vector_type(8)));
#define LDS_WAIT() asm volatile("s_waitcnt lgkmcnt(0)" ::: "memory")

struct Args { const float* in[27]; float* out; unsigned char* ws; };

__device__ __forceinline__ float wave_sum(float v) {
#pragma unroll
    for (int o = 1; o < 64; o <<= 1) v += shfl_xor_f(v, o);
    return v;
}
__device__ __forceinline__ float sigmoidf_(float x) { return __builtin_amdgcn_rcpf(1.0f + __expf(-x)); }
__device__ __forceinline__ float rsq_(float x) { return __builtin_amdgcn_rsqf(x); }
__device__ __forceinline__ float one_minus_exp_(float x) { return (x > -0.03f) ? -x * (1.0f + x * (0.5f + x * (1.0f / 6.0f + x * (1.0f / 24.0f)))) : 1.0f - __expf(x); }
__device__ __forceinline__ float siluf_(float x) { return x * __builtin_amdgcn_rcpf(1.0f + __expf(-x)); }

__device__ __forceinline__ void p0_transpose_item(const float* W, int K, int N, unsigned short* WT, LAS float* scr, int item, int lane, const float* rsc) {
    const int nblk = N / 32, kb = item / nblk, nb = item % nblk, k0 = 64 * kb, n0 = 32 * nb;
    float tv[32];
#pragma unroll
    for (int i = 0; i < 32; ++i) { const int kk = 2 * i + (lane >> 5); tv[i] = W[(size_t)(k0 + kk) * N + n0 + (lane & 31)]; }
#pragma unroll
    for (int i = 0; i < 32; ++i) { const int kk = 2 * i + (lane >> 5); scr[kk * 33 + (lane & 31)] = tv[i] * (rsc ? rsc[k0 + kk] : 1.0f); }
    LDS_WAIT(); asm volatile("" ::: "memory");
    const int c = lane & 7;
#pragma unroll
    for (int j = 0; j < 4; ++j) { const int n = (lane >> 3) + 8 * j; const LAS float* s = scr + (8 * c) * 33 + n;
        u32x4 o; o.x = pg8::pk_f16(s[0 * 33], s[1 * 33]); o.y = pg8::pk_f16(s[2 * 33], s[3 * 33]); o.z = pg8::pk_f16(s[4 * 33], s[5 * 33]); o.w = pg8::pk_f16(s[6 * 33], s[7 * 33]);
        *(u32x4*)(WT + (size_t)(n0 + n) * K + k0 + 8 * c) = o; }
    LDS_WAIT(); asm volatile("" ::: "memory");
}
__device__ __forceinline__ void rms_row_f16(const float* xrow, const float* w, unsigned short* orow, int lane) {
    const f32x4* xr = (const f32x4*)xrow + lane; const f32x4* wr = (const f32x4*)w + lane;
    f32x4 v[4]; float s = 0.f;
#pragma unroll
    for (int j = 0; j < 4; ++j) { v[j] = xr[64 * j]; s += (v[j].x * v[j].x + v[j].y * v[j].y) + (v[j].z * v[j].z + v[j].w * v[j].w); }
    const float rs = 1.0f / sqrtf(wave_sum(s) * (1.0f / DM) + 1e-6f);
    u32x2* o8 = (u32x2*)orow + lane;
#pragma unroll
    for (int j = 0; j < 4; ++j) { const f32x4 ww = wr[64 * j]; u32x2 o; o.x = pg8::pk_f16(v[j].x * rs * ww.x, v[j].y * rs * ww.y); o.y = pg8::pk_f16(v[j].z * rs * ww.z, v[j].w * rs * ww.w); o8[64 * j] = o; }
}
__device__ __forceinline__ void rms_row_f32(float* xrow, const float* w, int lane) {
    f32x4* xr = (f32x4*)xrow + lane; const f32x4* wr = (const f32x4*)w + lane;
    f32x4 v[4]; float s = 0.f;
#pragma unroll
    for (int j = 0; j < 4; ++j) { v[j] = xr[64 * j]; s += (v[j].x * v[j].x + v[j].y * v[j].y) + (v[j].z * v[j].z + v[j].w * v[j].w); }
    const float rs = 1.0f / sqrtf(wave_sum(s) * (1.0f / DM) + 1e-6f);
#pragma unroll
    for (int j = 0; j < 4; ++j) { const f32x4 ww = wr[64 * j]; xr[64 * j] = v[j] * rs * ww; }
}

__device__ __forceinline__ void rms_row2_f32(float* xa, float* xb, const float* w, int lane) {
    f32x4* ra = (f32x4*)xa + lane; f32x4* rb = (f32x4*)xb + lane; const f32x4* wr = (const f32x4*)w + lane;
    f32x4 va[4], vb[4]; float sa = 0.f, sb = 0.f;
#pragma unroll
    for (int j = 0; j < 4; ++j) { va[j] = ra[64 * j]; vb[j] = rb[64 * j]; }
#pragma unroll
    for (int j = 0; j < 4; ++j) { sa += (va[j].x * va[j].x + va[j].y * va[j].y) + (va[j].z * va[j].z + va[j].w * va[j].w); sb += (vb[j].x * vb[j].x + vb[j].y * vb[j].y) + (vb[j].z * vb[j].z + vb[j].w * vb[j].w); }
    const float rsa = 1.0f / sqrtf(wave_sum(sa) * (1.0f / DM) + 1e-6f), rsb = 1.0f / sqrtf(wave_sum(sb) * (1.0f / DM) + 1e-6f);
#pragma unroll
    for (int j = 0; j < 4; ++j) { const f32x4 ww = wr[64 * j]; ra[64 * j] = va[j] * rsa * ww; rb[64 * j] = vb[j] * rsb * ww; }
}
__device__ __forceinline__ void rms_row4_f16(const float* x0, size_t rs, const float* w, unsigned short* o0, int lane) {
    f32x4 v[4][4]; float s[4];
#pragma unroll
    for (int r = 0; r < 4; ++r)
#pragma unroll
        for (int j = 0; j < 4; ++j) v[r][j] = ((const f32x4*)(x0 + r * rs) + lane)[64 * j];
    const f32x4* wr = (const f32x4*)w + lane;
#pragma unroll
    for (int r = 0; r < 4; ++r) { float a = 0.f;
#pragma unroll
        for (int j = 0; j < 4; ++j) a += (v[r][j].x * v[r][j].x + v[r][j].y * v[r][j].y) + (v[r][j].z * v[r][j].z + v[r][j].w * v[r][j].w);
        s[r] = 1.0f / sqrtf(wave_sum(a) * (1.0f / DM) + 1e-6f); }
#pragma unroll
    for (int j = 0; j < 4; ++j) { const f32x4 ww = wr[64 * j];
#pragma unroll
        for (int r = 0; r < 4; ++r) { u32x2 o; o.x = pg8::pk_f16(v[r][j].x * s[r] * ww.x, v[r][j].y * s[r] * ww.y); o.y = pg8::pk_f16(v[r][j].z * s[r] * ww.z, v[r][j].w * s[r] * ww.w); ((u32x2*)(o0 + r * rs) + lane)[64 * j] = o; } }
}
__device__ __forceinline__ void rms_row4_f32(float* x0, size_t rs, const float* w, int lane) {
    f32x4 v[4][4]; float s[4];
#pragma unroll
    for (int r = 0; r < 4; ++r)
#pragma unroll
        for (int j = 0; j < 4; ++j) v[r][j] = ((const f32x4*)(x0 + r * rs) + lane)[64 * j];
    const f32x4* wr = (const f32x4*)w + lane;
#pragma unroll
    for (int r = 0; r < 4; ++r) { float a = 0.f;
#pragma unroll
        for (int j = 0; j < 4; ++j) a += (v[r][j].x * v[r][j].x + v[r][j].y * v[r][j].y) + (v[r][j].z * v[r][j].z + v[r][j].w * v[r][j].w);
        s[r] = rsq_(wave_sum(a) * (1.0f / DM) + 1e-6f); }
#pragma unroll
    for (int j = 0; j < 4; ++j) { const f32x4 ww = wr[64 * j];
#pragma unroll
        for (int r = 0; r < 4; ++r) ((f32x4*)(x0 + r * rs) + lane)[64 * j] = v[r][j] * s[r] * ww; }
}

#define SHV(col) ({ const float cur_ = (float)urow[(col)]; const float prev_ = hp ? (float)prow[(col)] : 0.f; cur_ + mu[(col)] * (prev_ - cur_); })

__device__ __forceinline__ void store_row64_f16(f16* dst, const float (&S)[64]) {
#pragma unroll
    for (int q = 0; q < 8; ++q) { u32x4 w; w.x = pg8::pk_f16(S[8 * q], S[8 * q + 1]); w.y = pg8::pk_f16(S[8 * q + 2], S[8 * q + 3]); w.z = pg8::pk_f16(S[8 * q + 4], S[8 * q + 5]); w.w = pg8::pk_f16(S[8 * q + 6], S[8 * q + 7]); *(u32x4*)(dst + 8 * q) = w; }
}


constexpr int RWA_REC = 656  , RWA_VROW = 136, RWA_VPL = 16 * RWA_REC, RWA_INV = RWA_VPL + 16 * RWA_VROW, RWA_BYTES = 12800;
constexpr int C_VD0 = 3712, C_VD1 = 3744;
constexpr int PRM_MU = 0, PRM_W0 = 1280, PRM_A0 = 1664, PRM_KK = 2048, PRM_KA = 2432, PRM_RK = 2816, PRM_V0 = 3200, PRM_FLOATS = 3584;
typedef float f32x2 __attribute__((ext_vector_type(2)));
typedef _Float16 f16x4 __attribute__((ext_vector_type(4)));
__device__ __forceinline__ float fmix_lo(float a, unsigned b, float c) { float d; asm("v_fma_mix_f32 %0, %1, %2, %3 op_sel:[0,0,0] op_sel_hi:[0,1,0]" : "=v"(d) : "v"(a), "v"(b), "v"(c)); return d; }
__device__ __forceinline__ float fmix_hi(float a, unsigned b, float c) { float d; asm("v_fma_mix_f32 %0, %1, %2, %3 op_sel:[0,1,0] op_sel_hi:[0,1,0]" : "=v"(d) : "v"(a), "v"(b), "v"(c)); return d; }
__device__ __forceinline__ float mmix_lo(float a, unsigned b) { float d; asm("v_fma_mix_f32 %0, %1, %2, 0 op_sel:[0,0,0] op_sel_hi:[0,1,0]" : "=v"(d) : "v"(a), "v"(b)); return d; }
__device__ __forceinline__ float mmix_hi(float a, unsigned b) { float d; asm("v_fma_mix_f32 %0, %1, %2, 0 op_sel:[0,1,0] op_sel_hi:[0,1,0]" : "=v"(d) : "v"(a), "v"(b)); return d; }
__device__ __forceinline__ float fma_asm(float a, float b, float c) { float d; asm("v_fma_f32 %0, %1, %2, %3" : "=v"(d) : "v"(a), "v"(b), "v"(c)); return d; }
#define FMIX(a, u, j, c) (((j) & 1) ? fmix_hi((a), (u)[(j) >> 1], (c)) : fmix_lo((a), (u)[(j) >> 1], (c)))
#define MMIX(a, u, j) (((j) & 1) ? mmix_hi((a), (u)[(j) >> 1]) : mmix_lo((a), (u)[(j) >> 1]))
__device__ __forceinline__ float fast_tanh(float x) { return 1.0f - 2.0f * __builtin_amdgcn_rcpf(__expf(2.0f * x) + 1.0f); }
__device__ __forceinline__ void lerp8(const char* ub, unsigned uo, unsigned po, bool hp, const char* mub, unsigned col, float (&x)[8]) {
    const f16x8 cu = *(const f16x8*)(ub + (uo + col * 2u)); f16x8 pv = *(const f16x8*)(ub + (po + col * 2u)); const f32x4 m0 = *(const f32x4*)(mub + col * 4u), m1 = *(const f32x4*)(mub + col * 4u + 16u);
#pragma unroll
    for (int j = 0; j < 8; ++j) { const float c = (float)cu[j], p = hp ? (float)pv[j] : 0.f; x[j] = c + (j < 4 ? m0[j] : m1[j - 4]) * (p - c); }
}
__device__ __forceinline__ void lerp4(const char* ub, unsigned uo, unsigned po, bool hp, const char* mub, unsigned col, float (&x)[4]) {
    const f16x4 cu = *(const f16x4*)(ub + (uo + col * 2u)); f16x4 pv = *(const f16x4*)(ub + (po + col * 2u)); const f32x4 m0 = *(const f32x4*)(mub + col * 4u);
#pragma unroll
    for (int j = 0; j < 4; ++j) { const float c = (float)cu[j], p = hp ? (float)pv[j] : 0.f; x[j] = c + m0[j] * (p - c); }
}
__device__ __forceinline__ f16x8 pack8(const float (&x)[8]) { f16x8 r;
#pragma unroll
    for (int j = 0; j < 8; ++j) r[j] = (f16)x[j];
    return r; }

__device__ __forceinline__ void rwkv_waveA(const Args& a, int l, int b, int c, int h, LAS unsigned char* wl, const LAS float* prm, int lane) {
    const char* Ub = (const char*)(a.ws + WS_U); f16* MIX = (f16*)(a.ws + WS_MIX); char* VF = (char*)(a.ws + WS_VF); char* VP = (char*)(a.ws + WS_VP);
    f16* QT = (f16*)(a.ws + WS_QT); f16* PT = (f16*)(a.ws + WS_PT); f16* RL = (f16*)(a.ws + WS_RL); float* BONG = (float*)(a.ws + WS_BON);
    const char* WUPT = (const char*)(a.ws + WS_WUPT) + (size_t)l * 384 * 64 * 2; const char* AUPT = (const char*)(a.ws + WS_AUPT) + (size_t)l * 384 * 64 * 2;
    const char* VUPT = (const char*)(a.ws + WS_VUPT);
    const int bh = b * RW_H + h;
    float P[64], L[64];
#pragma unroll
    for (int k = 0; k < 64; ++k) { P[k] = (k == lane) ? 1.f : 0.f; L[k] = 0.f; }
#pragma unroll 1
    for (int blk = 0; blk < 4; ++blk) {
        const int lane_ = lane_now();
        const int tok = lane_ & 15, fq = lane_ >> 4;
        const int t = c * CH + blk * 16 + tok; const unsigned m = (unsigned)(b * SEQ + t); const bool hp = t > 0;
        const unsigned uo = m * (unsigned)(NU * 2), po = hp ? uo - (unsigned)(NU * 2) : uo;
        f16x8 cW[2], pW[2], cA[2], pA[2], vd0, vd1;
#pragma unroll
        for (int s = 0; s < 2; ++s) { const unsigned cw = (unsigned)(C_WL + 8 * fq + 32 * s) * 2u, ca = (unsigned)(C_AL + 8 * fq + 32 * s) * 2u;
            cW[s] = *(const f16x8*)(Ub + uo + cw); pW[s] = *(const f16x8*)(Ub + po + cw); cA[s] = *(const f16x8*)(Ub + uo + ca); pA[s] = *(const f16x8*)(Ub + po + ca); }
        if (l > 0) { vd0 = *(const f16x8*)(Ub + uo + (unsigned)(C_VD0 + 8 * fq) * 2u); vd1 = *(const f16x8*)(Ub + po + (unsigned)(C_VD1 + 8 * fq) * 2u); }
#define RW_TLOAD(X, nt) f16x8 X##wu0, X##wu1, X##au0, X##au1, X##vu; f16x4 X##cr, X##pr, X##ck, X##pk, X##cv, X##pv, X##vf; { \
            const unsigned n_ = (unsigned)(h * 64 + 16 * (nt) + tok), cb_ = (unsigned)(h * 64 + 16 * (nt) + 4 * fq); \
            X##wu0 = *(const f16x8*)(WUPT + (n_ * 64u + 8u * fq) * 2u); X##wu1 = *(const f16x8*)(WUPT + (n_ * 64u + 8u * fq + 32u) * 2u); \
            X##au0 = *(const f16x8*)(AUPT + (n_ * 64u + 8u * fq) * 2u); X##au1 = *(const f16x8*)(AUPT + (n_ * 64u + 8u * fq + 32u) * 2u); \
            if (l > 0) { X##vu = *(const f16x8*)(VUPT + (n_ * 32u + 8u * fq) * 2u); X##vf = *(const f16x4*)(VF + (m * (unsigned)RW_W + cb_) * 2u); } \
            X##cr = *(const f16x4*)(Ub + uo + ((unsigned)C_R + cb_) * 2u); X##pr = *(const f16x4*)(Ub + po + ((unsigned)C_R + cb_) * 2u); \
            X##ck = *(const f16x4*)(Ub + uo + ((unsigned)C_K + cb_) * 2u); X##pk = *(const f16x4*)(Ub + po + ((unsigned)C_K + cb_) * 2u); \
            X##cv = *(const f16x4*)(Ub + uo + ((unsigned)C_V + cb_) * 2u); X##pv = *(const f16x4*)(Ub + po + ((unsigned)C_V + cb_) * 2u); }
        f16x8 bW[2], bA[2], bVD;
#pragma unroll
        for (int s = 0; s < 2; ++s) { float xw[8], xa[8];
            const f32x4 mw0 = *(const LAS f32x4*)(prm + PRM_MU + C_WL + 8 * fq + 32 * s), mw1 = *(const LAS f32x4*)(prm + PRM_MU + C_WL + 8 * fq + 32 * s + 4);
            const f32x4 ma0 = *(const LAS f32x4*)(prm + PRM_MU + C_AL + 8 * fq + 32 * s), ma1 = *(const LAS f32x4*)(prm + PRM_MU + C_AL + 8 * fq + 32 * s + 4);
#pragma unroll
            for (int j = 0; j < 8; ++j) { const float cw_ = (float)cW[s][j], pw_ = hp ? (float)pW[s][j] : 0.f, ca_ = (float)cA[s][j], pa_ = hp ? (float)pA[s][j] : 0.f;
                xw[j] = fast_tanh(cw_ + (j < 4 ? mw0[j & 3] : mw1[j & 3]) * (pw_ - cw_)); xa[j] = ca_ + (j < 4 ? ma0[j & 3] : ma1[j & 3]) * (pa_ - ca_); }
            bW[s] = pack8(xw); bA[s] = pack8(xa); }
        if (l > 0) { float xv[8];
#pragma unroll
            for (int j = 0; j < 8; ++j) xv[j] = (float)vd0[j] + (hp ? (float)vd1[j] : 0.f);
            bVD = pack8(xv); }
        float ssq = 0.f, bon = 0.f;
        LAS unsigned char* rec = wl + tok * RWA_REC;
#define RW_TCOMP(X, nt) { const int cb = h * 64 + 16 * (nt) + 4 * fq, co = 16 * (nt) + 4 * fq; \
            f32x4 DWn = (f32x4){0.f, 0.f, 0.f, 0.f}, DAn = DWn, Gn = DWn; \
            DWn = __builtin_amdgcn_mfma_f32_16x16x32_f16(X##wu0, bW[0], DWn, 0, 0, 0); DWn = __builtin_amdgcn_mfma_f32_16x16x32_f16(X##wu1, bW[1], DWn, 0, 0, 0); \
            DAn = __builtin_amdgcn_mfma_f32_16x16x32_f16(X##au0, bA[0], DAn, 0, 0, 0); DAn = __builtin_amdgcn_mfma_f32_16x16x32_f16(X##au1, bA[1], DAn, 0, 0, 0); \
            if (l > 0) Gn = __builtin_amdgcn_mfma_f32_16x16x32_f16(X##vu, bVD, Gn, 0, 0, 0); \
            f16x4 wv, al, be, km, rr, vo; \
            _Pragma("unroll") for (int i = 0; i < 4; ++i) { const LAS float* pc = prm + cb + i; \
                const float cr_ = (float)X##cr[i], ck_ = (float)X##ck[i], cv_ = (float)X##cv[i]; \
                const float rs = cr_ + pc[PRM_MU + C_R] * ((hp ? (float)X##pr[i] : 0.f) - cr_), ks = ck_ + pc[PRM_MU + C_K] * ((hp ? (float)X##pk[i] : 0.f) - ck_), vs = cv_ + pc[PRM_MU + C_V] * ((hp ? (float)X##pv[i] : 0.f) - cv_); \
                wv[i] = (f16)__expf(-0.6065306597126334f * sigmoidf_(pc[PRM_W0] + DWn[i])); \
                const float aa = sigmoidf_(pc[PRM_A0] + DAn[i]); \
                float vv = vs; if (l > 0) vv = vs + ((float)X##vf[i] - vs) * sigmoidf_(pc[PRM_V0] + Gn[i]); \
                const float kk = ks * pc[PRM_KK]; ssq += kk * kk; \
                const float kmod = ks * (1.0f + (aa - 1.0f) * pc[PRM_KA]); \
                bon += rs * kmod * pc[PRM_RK]; \
                al[i] = (f16)(-kk); be[i] = (f16)(kk * aa); km[i] = (f16)kmod; rr[i] = (f16)rs; vo[i] = (f16)vv; \
                asm volatile("" ::: "memory"); } \
            *(LAS f16x4*)(rec + co * 2) = wv; \
            *(LAS f16x4*)(rec + 128 + co * 2) = al; *(LAS f16x4*)(rec + 256 + co * 2) = be; *(LAS f16x4*)(rec + 384 + co * 2) = km; *(LAS f16x4*)(rec + 512 + co * 2) = rr; \
            *(LAS f16x4*)(wl + RWA_VPL + tok * RWA_VROW + co * 2) = vo; \
            *(f16x4*)(VP + (m * (unsigned)RW_W + (unsigned)cb) * 2u) = vo; \
            if (l == 0) *(f16x4*)(VF + (m * (unsigned)RW_W + (unsigned)cb) * 2u) = vo; }
#pragma unroll 1
        for (int nt = 0; nt < 4; ++nt) { RW_TLOAD(T0, nt) RW_TCOMP(T0, nt) asm volatile("" ::: "memory"); }
#undef RW_TLOAD
#undef RW_TCOMP
        ssq += shfl_xor_f(ssq, 16); ssq += shfl_xor_f(ssq, 32);
        bon += shfl_xor_f(bon, 16); bon += shfl_xor_f(bon, 32);
        { const float inv2v = __builtin_amdgcn_rcpf(fmaxf(ssq, 1e-24f));
          if (fq == 0) { *(LAS float*)(wl + RWA_INV + tok * 4) = inv2v; *(float*)((char*)BONG + (m * 8u + (unsigned)h) * 4u) = bon; } }
        const unsigned mb = (unsigned)(b * SEQ + c * CH + blk * 16);
        asm volatile("s_waitcnt lgkmcnt(0)" ::: "memory");
        u32x4 A[8];
#pragma unroll
        for (int g = 0; g < 8; ++g) A[g] = *(const LAS u32x4*)(wl + 128 + g * 16);
        float vv = (float)*(const LAS f16*)(wl + RWA_VPL + lane_ * 2); float inv2 = *(const LAS float*)(wl + RWA_INV);
#define RW_LDU(W4, B4, K4, R4, g) { W4 = *(const LAS u32x4*)(rc + (g) * 16); B4 = *(const LAS u32x4*)(rc + 256 + (g) * 16); K4 = *(const LAS u32x4*)(rc + 384 + (g) * 16); R4 = *(const LAS u32x4*)(rc + 512 + (g) * 16); }
#define RW_COMP(W4, B4, K4, R4, g) { float tP[8], tL[8]; \
            _Pragma("unroll") for (int j = 0; j < 8; ++j) tP[j] = MMIX(saP, B4, j); \
            _Pragma("unroll") for (int j = 0; j < 8; ++j) tL[j] = MMIX(saL, B4, j); \
            _Pragma("unroll") for (int j = 0; j < 8; ++j) tL[j] = FMIX(vv, K4, j, tL[j]); \
            _Pragma("unroll") for (int j = 0; j < 8; ++j) P[8 * (g) + j] = FMIX(P[8 * (g) + j], W4, j, tP[j]); \
            _Pragma("unroll") for (int j = 0; j < 8; ++j) L[8 * (g) + j] = FMIX(L[8 * (g) + j], W4, j, tL[j]); \
            _Pragma("unroll") for (int j = 0; j < 8; ++j) qa[j] = FMIX(P[8 * (g) + j], R4, j, qa[j]); \
            _Pragma("unroll") for (int j = 0; j < 8; ++j) ya[j] = FMIX(L[8 * (g) + j], R4, j, ya[j]); }
#pragma unroll 1
        for (int t2 = 0; t2 < 16; ++t2) {
            const LAS unsigned char* rc = wl + t2 * RWA_REC;
            u32x4 we, be, ke, re, wo, bo, ko, ro;
            RW_LDU(we, be, ke, re, 0)
            float sP[8], sL[8];
#pragma unroll
            for (int j = 0; j < 8; ++j) { sP[j] = 0.f; sL[j] = 0.f; }
#pragma unroll
            for (int g = 0; g < 8; ++g) {
#pragma unroll
                for (int j = 0; j < 8; ++j) sP[j] = FMIX(P[8 * g + j], A[g], j, sP[j]);
#pragma unroll
                for (int j = 0; j < 8; ++j) sL[j] = FMIX(L[8 * g + j], A[g], j, sL[j]); }
            const float saP = inv2 * (((sP[0] + sP[1]) + (sP[2] + sP[3])) + ((sP[4] + sP[5]) + (sP[6] + sP[7]))), saL = inv2 * (((sL[0] + sL[1]) + (sL[2] + sL[3])) + ((sL[4] + sL[5]) + (sL[6] + sL[7])));
            float qa[8], ya[8];
#pragma unroll
            for (int j = 0; j < 8; ++j) { qa[j] = 0.f; ya[j] = 0.f; }
            RW_LDU(wo, bo, ko, ro, 1) RW_COMP(we, be, ke, re, 0)
            RW_LDU(we, be, ke, re, 2) RW_COMP(wo, bo, ko, ro, 1)
            RW_LDU(wo, bo, ko, ro, 3) RW_COMP(we, be, ke, re, 2)
            RW_LDU(we, be, ke, re, 4) RW_COMP(wo, bo, ko, ro, 3)
            RW_LDU(wo, bo, ko, ro, 5) RW_COMP(we, be, ke, re, 4)
            RW_LDU(we, be, ke, re, 6) RW_COMP(wo, bo, ko, ro, 5)
            RW_LDU(wo, bo, ko, ro, 7) RW_COMP(we, be, ke, re, 6)
            const float vvn = (float)*(const LAS f16*)(wl + RWA_VPL + ((t2 + 1) & 15) * RWA_VROW + lane_ * 2); const float inv2n = *(const LAS float*)(wl + RWA_INV + ((t2 + 1) & 15) * 4);
#pragma unroll
            for (int g = 0; g < 8; ++g) A[g] = *(const LAS u32x4*)(rc + RWA_REC + 128 + g * 16);
            RW_COMP(wo, bo, ko, ro, 7)
            vv = vvn; inv2 = inv2n;
            *(f16*)((char*)MIX + ((mb + t2) * (unsigned)DM + (unsigned)(h * 64 + lane_)) * 2u) = (f16)(((ya[0] + ya[1]) + (ya[2] + ya[3])) + ((ya[4] + ya[5]) + (ya[6] + ya[7])));
            *(f16*)((char*)QT + ((mb + t2) * (unsigned)RW_W + (unsigned)(h * 64 + lane_)) * 2u) = (f16)(((qa[0] + qa[1]) + (qa[2] + qa[3])) + ((qa[4] + qa[5]) + (qa[6] + qa[7])));
        }
#undef RW_LDU
#undef RW_COMP
    }
    store_row64_f16(RL + (((size_t)bh * NCH + c) * 64 + lane) * 64, L);
    f16* pt = PT + ((size_t)bh * NCH + c) * 4096;
#pragma unroll
    for (int k = 0; k < 64; ++k) pt[k * 64 + lane] = (f16)P[k];
}

constexpr int HGA_REC = 384, HGA_V = 16 * HGA_REC, HGA_HEAD = HGA_V + 2048, HGA_BYTES = 2 * HGA_HEAD;
template <int NH>
__device__ __forceinline__ void hgrn_waveA(const Args& a, int l, int b, int c, int h0, LAS unsigned char* wl) {
    char* U = (char*)(a.ws + WS_U); char* MIX = (char*)(a.ws + WS_MIX); f16* HL = (f16*)(a.ws + WS_HL); float* DC = (float*)(a.ws + WS_DC);
    const float* lbr = a.in[16];
    float S[NH][64]; float dpr[NH];
#pragma unroll
    for (int j = 0; j < NH; ++j) { dpr[j] = 1.f;
#pragma unroll
        for (int k = 0; k < 64; ++k) S[j][k] = 0.f; }
#pragma unroll 1
    for (int blk = 0; blk < 4; ++blk) {
        const int lane_ = lane_now();
        const unsigned mb = (unsigned)(b * SEQ + c * CH + blk * 16);
        {
            f16 fr[NH][16], qr[NH][16], vr[NH][16];
#pragma unroll
            for (int j = 0; j < NH; ++j)
#pragma unroll
                for (int tk = 0; tk < 16; ++tk) { const char* ur = U + (mb + tk) * (unsigned)(NU * 2) + (unsigned)((h0 + j) * 64 + lane_) * 2u; fr[j][tk] = *(const f16*)(ur + C_HGF * 2); qr[j][tk] = *(const f16*)(ur + C_HGQ * 2); vr[j][tk] = *(const f16*)(ur + C_HGI * 2); }
#pragma unroll
            for (int j = 0; j < NH; ++j) { const int col = (h0 + j) * 64 + lane_;
                const float lb = (l == 0) ? 0.f : sigmoidf_(lbr[384 + col] - lbr[col]);
                float dp = dpr[j];
#pragma unroll
                for (int tk = 0; tk < 16; ++tk) {
                    const float f = lb + (1.0f - lb) * sigmoidf_((float)fr[j][tk]);
                    LAS unsigned char* rec = wl + j * HGA_HEAD + tk * HGA_REC;
                    *(LAS f16*)(rec + lane_ * 2) = (f16)f; *(LAS f16*)(rec + 128 + lane_ * 2) = (f16)(1.0f - f); *(LAS f16*)(rec + 256 + lane_ * 2) = qr[j][tk];
                    *(LAS f16*)(wl + j * HGA_HEAD + HGA_V + tk * 128 + lane_ * 2) = vr[j][tk];
                    dp *= f;
                    *(f16*)(U + (mb + tk) * (unsigned)(NU * 2) + (unsigned)(C_HGQ + col) * 2u) = (f16)((float)qr[j][tk] * dp);
                }
                dpr[j] = dp; }
        }
        asm volatile("s_waitcnt lgkmcnt(0)" ::: "memory");
#define HG_LD(F4, K4, Q4, rcp, g) { F4 = *(const LAS u32x4*)((rcp) + (g) * 16); K4 = *(const LAS u32x4*)((rcp) + 128 + (g) * 16); Q4 = *(const LAS u32x4*)((rcp) + 256 + (g) * 16); }
#define HG_COMP(Sx, vi, F4, K4, Q4, g) { float tt[8]; \
            _Pragma("unroll") for (int jj = 0; jj < 8; ++jj) tt[jj] = MMIX(vi, K4, jj); \
            _Pragma("unroll") for (int jj = 0; jj < 8; ++jj) Sx[8 * (g) + jj] = FMIX(Sx[8 * (g) + jj], F4, jj, tt[jj]); \
            _Pragma("unroll") for (int jj = 0; jj < 8; ++jj) oa[jj] = FMIX(Sx[8 * (g) + jj], Q4, jj, oa[jj]); }
#define HG_HEAD(Sx, vi, rcp, rcn, oo) { float oa[8]; _Pragma("unroll") for (int jj = 0; jj < 8; ++jj) oa[jj] = 0.f; \
            HG_LD(f4o, k4o, q4o, rcp, 1) HG_COMP(Sx, vi, f4e, k4e, q4e, 0) \
            HG_LD(f4e, k4e, q4e, rcp, 2) HG_COMP(Sx, vi, f4o, k4o, q4o, 1) \
            HG_LD(f4o, k4o, q4o, rcp, 3) HG_COMP(Sx, vi, f4e, k4e, q4e, 2) \
            HG_LD(f4e, k4e, q4e, rcp, 4) HG_COMP(Sx, vi, f4o, k4o, q4o, 3) \
            HG_LD(f4o, k4o, q4o, rcp, 5) HG_COMP(Sx, vi, f4e, k4e, q4e, 4) \
            HG_LD(f4e, k4e, q4e, rcp, 6) HG_COMP(Sx, vi, f4o, k4o, q4o, 5) \
            HG_LD(f4o, k4o, q4o, rcp, 7) HG_COMP(Sx, vi, f4e, k4e, q4e, 6) \
            HG_LD(f4e, k4e, q4e, rcn, 0) HG_COMP(Sx, vi, f4o, k4o, q4o, 7) \
            oo = ((oa[0] + oa[1]) + (oa[2] + oa[3])) + ((oa[4] + oa[5]) + (oa[6] + oa[7])); }
        u32x4 f4e, k4e, q4e, f4o, k4o, q4o;
        HG_LD(f4e, k4e, q4e, wl, 0)
        f16 vh[NH], vn[NH];
#pragma unroll
        for (int j = 0; j < NH; ++j) vh[j] = *(const LAS f16*)(wl + j * HGA_HEAD + HGA_V + lane_ * 2);
#pragma unroll 1
        for (int t2 = 0; t2 < 16; ++t2) {
            const LAS unsigned char* rc = wl + t2 * HGA_REC;
#pragma unroll
            for (int j = 0; j < NH; ++j) vn[j] = *(const LAS f16*)(wl + j * HGA_HEAD + HGA_V + ((t2 + 1) & 15) * 128 + lane_ * 2);
            float oo[NH];
#pragma unroll
            for (int j = 0; j < NH; ++j) { const float vi = (float)vh[j];
                const LAS unsigned char* rcp = rc + j * HGA_HEAD; const LAS unsigned char* rcn = (j + 1 < NH) ? rc + (j + 1) * HGA_HEAD : rc + HGA_REC;
                HG_HEAD(S[j], vi, rcp, rcn, oo[j]) }
            char* mo = MIX + ((mb + t2) * (unsigned)DM + (unsigned)(384 + h0 * 64 + lane_)) * 2u;
#pragma unroll
            for (int j = 0; j < NH; ++j) { *(f16*)(mo + 128 * j) = (f16)oo[j]; vh[j] = vn[j]; }
        }
#undef HG_LD
#undef HG_COMP
#undef HG_HEAD
    }
    const int lane2 = lane_now();
#pragma unroll
    for (int j = 0; j < NH; ++j) { const int bh = b * 6 + h0 + j; store_row64_f16(HL + (((size_t)bh * NCH + c) * 64 + lane2) * 64, S[j]);
        DC[((size_t)bh * NCH + c) * 64 + lane2] = dpr[j]; }
}

__device__ __forceinline__ void lru_waveA(const Args& a, int l, int b, int c, int g, LAS unsigned char* wl) {
    const int ln = lane_now();
    const char* Ub = (const char*)(a.ws + WS_U); char* MIXb = (char*)(a.ws + WS_MIX); char* CA = (char*)(a.ws + WS_CA); float* LA = (float*)(a.ws + WS_LA); float* LH = (float*)(a.ws + WS_LH);
    const float* cw = a.in[18] + l * 4 * 256 + g * 64; const float* cb = a.in[19] + l * 256 + g * 64;
    const float* ba = a.in[21] + l * 256 + g * 64; const float* bx = a.in[23] + l * 256 + g * 64; const float* lam = a.in[24] + l * 256 + g * 64;
    const char* WAT = (const char*)(a.ws + WS_WAT) + (size_t)(l * 4 + g) * 8192; const char* WXT = (const char*)(a.ws + WS_WXT) + (size_t)(l * 4 + g) * 8192;
    LAS unsigned char* Y = wl;
    const unsigned mrow0 = (unsigned)(b * SEQ + c * CH);
#pragma unroll 2
    for (int it = 0; it < 8; ++it) { const int item = ln + 64 * it, tok = item >> 3, co = item & 7; const int t = c * CH + tok;
        const f32x4 b0 = *(const f32x4*)(cb + 8 * co), b1 = *(const f32x4*)(cb + 8 * co + 4);
        float y[8] = {b0[0], b0[1], b0[2], b0[3], b1[0], b1[1], b1[2], b1[3]};
#pragma unroll
        for (int jj = 0; jj < 4; ++jj) { const int ts = t - 3 + jj;
            if (ts >= 0) { const f16x8 x8 = *(const f16x8*)(Ub + ((mrow0 + (unsigned)(tok - 3 + jj)) * (unsigned)NU + (unsigned)(C_LRUX + g * 64 + 8 * co)) * 2u);
                const f32x4 w0 = *(const f32x4*)(cw + jj * 256 + 8 * co), w1 = *(const f32x4*)(cw + jj * 256 + 8 * co + 4);
#pragma unroll
                for (int i = 0; i < 8; ++i) y[i] += (i < 4 ? w0[i & 3] : w1[i & 3]) * (float)x8[i]; } }
        *(LAS f16x8*)(Y + tok * 144 + co * 16) = pack8(y); }
    asm volatile("s_waitcnt lgkmcnt(0)" ::: "memory");
    const int tl = ln & 15, fq = ln >> 4;
    float sp[16], cy[16], cp[16];
#pragma unroll
    for (int nt = 0; nt < 4; ++nt) { const f32x4 lm4 = *(const f32x4*)(lam + 16 * nt + 4 * fq);
#pragma unroll
        for (int i = 0; i < 4; ++i) { sp[nt * 4 + i] = log1pf(__expf(-lm4[i])); cy[nt * 4 + i] = 0.f; cp[nt * 4 + i] = 1.f; } }
#pragma unroll 1
    for (int tt = 0; tt < 4; ++tt) {
        f16x8 by[2];
#pragma unroll
        for (int s2 = 0; s2 < 2; ++s2) by[s2] = *(const LAS f16x8*)(Y + (16 * tt + tl) * 144 + (8 * fq + 32 * s2) * 2);
        const unsigned m = mrow0 + (unsigned)(16 * tt + tl);
#pragma unroll
        for (int nt = 0; nt < 4; ++nt) {
            f32x4 ra = (f32x4){0.f, 0.f, 0.f, 0.f}, rx = ra;
#pragma unroll
            for (int s2 = 0; s2 < 2; ++s2) { const unsigned wo = (unsigned)(((16 * nt + tl) * 64 + 8 * fq + 32 * s2) * 2);
                ra = __builtin_amdgcn_mfma_f32_16x16x32_f16(*(const f16x8*)(WAT + wo), by[s2], ra, 0, 0, 0);
                rx = __builtin_amdgcn_mfma_f32_16x16x32_f16(*(const f16x8*)(WXT + wo), by[s2], rx, 0, 0, 0); }
            const int ch0 = 16 * nt + 4 * fq;
            const f32x4 ba4 = *(const f32x4*)(ba + ch0), bx4 = *(const f32x4*)(bx + ch0);
            const f16x4 y4 = *(const LAS f16x4*)(Y + (16 * tt + tl) * 144 + ch0 * 2);
            f16x4 ho, co;
#pragma unroll
            for (int i = 0; i < 4; ++i) { const int q = nt * 4 + i;
                const float r = sigmoidf_(ra[i] + ba4[i]), ig = sigmoidf_(rx[i] + bx4[i]);
                const float la = -8.0f * r * sp[q];
                float av = __expf(la), uv = sqrtf(one_minus_exp_(2.0f * la)) * (ig * (float)y4[i]);
#define LRU_SCAN(d) { const float ap = __builtin_bit_cast(float, __builtin_amdgcn_update_dpp(0x3f800000, __builtin_bit_cast(int, av), 0x110 + (d), 0xf, 0xf, false)); \
                      const float up = __builtin_bit_cast(float, __builtin_amdgcn_update_dpp(0, __builtin_bit_cast(int, uv), 0x110 + (d), 0xf, 0xf, false)); \
                      uv = av * up + uv; av = av * ap; }
                LRU_SCAN(1) LRU_SCAN(2) LRU_SCAN(4) LRU_SCAN(8)
#undef LRU_SCAN
                const float hl = uv + av * cy[q], ca = av * cp[q];
                ho[i] = (f16)hl; co[i] = (f16)ca;
                cy[q] = __builtin_bit_cast(float, __builtin_amdgcn_ds_bpermute((ln | 15) << 2, __builtin_bit_cast(int, hl)));
                cp[q] = __builtin_bit_cast(float, __builtin_amdgcn_ds_bpermute((ln | 15) << 2, __builtin_bit_cast(int, ca)));
            }
            *(f16x4*)(MIXb + (m * (unsigned)DM + 768u + (unsigned)(g * 64 + ch0)) * 2u) = ho; *(f16x4*)(CA + (m * 256u + (unsigned)(g * 64 + ch0)) * 2u) = co;
        }
    }
    if (tl == 15) {
#pragma unroll
        for (int q = 0; q < 16; ++q) { const int ch = g * 64 + 16 * (q >> 2) + 4 * fq + (q & 3); LA[((size_t)b * NCH + c) * 256 + ch] = cp[q]; LH[((size_t)b * NCH + c) * 256 + ch] = cy[q]; } }
}

__device__ __forceinline__ void phaseA(const Args& a, int l, int task, LAS unsigned char* lds, int tid) {
    asm volatile("" : "+v"(tid));
    const int lane = tid & 63, wave = __builtin_amdgcn_readfirstlane(tid >> 6);
    const int b = task / NCH, c = task % NCH;
    const f16* U = (const f16*)(a.ws + WS_U); f16* MIX = (f16*)(a.ws + WS_MIX); f16* VF = (f16*)(a.ws + WS_VF); f16* VP = (f16*)(a.ws + WS_VP);
    f16* QT = (f16*)(a.ws + WS_QT); f16* PT = (f16*)(a.ws + WS_PT); f16* RL = (f16*)(a.ws + WS_RL); float* BONG = (float*)(a.ws + WS_BON);
    {
        LAS float* prm = (LAS float*)(lds + PRM_OFF);
        for (int i = tid; i < PRM_FLOATS; i += NT) { float v;
            if (i < 1280) v = a.in[3][l * RW_SHIFT + i];
            else { const int q = (i - 1280) / 384, cc = (i - 1280) % 384;
                v = (q == 0) ? a.in[4][l * RW_W + cc] : (q == 1) ? a.in[6][l * RW_W + cc] : (q == 2) ? a.in[11][l * RW_W + cc] : (q == 3) ? a.in[12][l * RW_W + cc] : (q == 4) ? a.in[13][l * RW_W + cc] : a.in[8][cc]; }
            prm[i] = v; }
        __syncthreads();
        if (wave < RW_H) { rwkv_waveA(a, l, b, c, wave, lds + wave * RWA_BYTES, prm, lane);
                           if (wave < 4) lru_waveA(a, l, b, c, wave, lds + wave * RWA_BYTES); }
        else { LAS unsigned char* hw = lds + RW_H * RWA_BYTES + (wave - RW_H) * HGA_BYTES;
               hgrn_waveA<2>(a, l, b, c, 2 * (wave - RW_H), hw); hgrn_waveA<1>(a, l, b, c, 4 + (wave - RW_H), hw); }
        __syncthreads();
    }
}

constexpr int PB_SLOT = 16384, PB_NS = 8, PB_AHEAD = 6, NGRP = NCH / 8;
#define ARENA(ws, off) ((char*)(ws) + WS_U + (size_t)((off) >> 11) * (size_t)(NU * 2) + (size_t)((off) & 2047))
constexpr size_t AR_PGT = 0, AR_LG = 2u << 20, AR_SG = 4u << 20;
#define PB_SWZ(row, o) ((row) * 128 + (((((o) >> 4) ^ ((row) & 7)) << 4) | ((o) & 15)))
template <bool ADD_L>
__device__ __forceinline__ void pb_step(f32x4 (&Sacc)[4], const LAS unsigned char* sl, int xrow, int vl, int fq) {
    f16x8 Bhi[2], Blo[2];
#pragma unroll
    for (int mt = 0; mt < 4; ++mt)
#pragma unroll
        for (int i = 0; i < 4; ++i) { const f16 hi = (f16)Sacc[mt][i]; const f16 lo = (f16)(Sacc[mt][i] - (float)hi); Bhi[mt >> 1][4 * (mt & 1) + i] = hi; Blo[mt >> 1][4 * (mt & 1) + i] = lo; }
#pragma unroll
    for (int mt = 0; mt < 4; ++mt) {
        f32x4 d = (f32x4){0.f, 0.f, 0.f, 0.f};
        if (ADD_L) { const f16x4 l4 = *(const LAS f16x4*)(sl + 8192 + PB_SWZ(xrow, 32 * mt + 8 * fq)); d = (f32x4){(float)l4[0], (float)l4[1], (float)l4[2], (float)l4[3]}; }
#pragma unroll
        for (int s = 0; s < 2; ++s) { const u32x2 a0 = *(const LAS u32x2*)(sl + PB_SWZ(16 * mt + vl, 64 * s + 8 * fq)), a1 = *(const LAS u32x2*)(sl + PB_SWZ(16 * mt + vl, 64 * s + 32 + 8 * fq));
            u32x4 aw; aw.x = a0.x; aw.y = a0.y; aw.z = a1.x; aw.w = a1.y; const f16x8 af = __builtin_bit_cast(f16x8, aw);
            d = __builtin_amdgcn_mfma_f32_16x16x32_f16(af, Bhi[s], d, 0, 0, 0); d = __builtin_amdgcn_mfma_f32_16x16x32_f16(af, Blo[s], d, 0, 0, 0); }
        Sacc[mt] = d; }
}
__device__ __forceinline__ void pb_stage8(const Args& a, LAS unsigned char* lds, int bh, int c0, int wave, int lane) {
    const char* PT = (const char*)(a.ws + WS_PT) + ((size_t)bh * NCH + c0) * 8192; const char* RL = (const char*)(a.ws + WS_RL) + ((size_t)bh * NCH + c0) * 8192;
    const int lq = wave * 64 + lane, lrow = lq >> 3, lpp = lq & 7; const unsigned lsrc = (unsigned)(lrow * 128 + ((lpp ^ (lrow & 7)) << 4));
#pragma unroll
    for (int sl = 0; sl < 8; ++sl) { const unsigned so = (unsigned)(sl * PB_SLOT + wave * 1024); const size_t go = (size_t)sl * 8192 + lsrc;
        __builtin_amdgcn_global_load_lds((const unsigned*)(PT + go), (LAS unsigned*)(lds + so), 16, 0, 0);
        __builtin_amdgcn_global_load_lds((const unsigned*)(RL + go), (LAS unsigned*)(lds + so + 8192), 16, 0, 0); }
    asm volatile("s_waitcnt vmcnt(0)" ::: "memory");
    __builtin_amdgcn_s_barrier();
}
__device__ __forceinline__ void phaseB1(const Args& a, LAS unsigned char* lds, int tid) {
    asm volatile("" : "+v"(tid));
    const int lane = tid & 63, wave = __builtin_amdgcn_readfirstlane(tid >> 6);
    for (int task = blockIdx.x; task < 12 * NGRP; task += gridDim.x) {
        const int bh = task / NGRP, g = task % NGRP, c0 = 8 * g;
        pb_stage8(a, lds, bh, c0, wave, lane);
        const int vt = wave & 3, vl = lane & 15, fq = lane >> 4, xr = 16 * vt + vl;
        f32x4 X[4];
        if (wave < 4) {
#pragma unroll
            for (int mt = 0; mt < 4; ++mt) { const f16x4 l4 = *(const LAS f16x4*)(lds + 8192 + PB_SWZ(xr, 32 * mt + 8 * fq)); X[mt] = (f32x4){(float)l4[0], (float)l4[1], (float)l4[2], (float)l4[3]}; }
#pragma unroll 1
            for (int s = 1; s < 8; ++s) pb_step<true>(X, lds + s * PB_SLOT, xr, vl, fq);
#pragma unroll
            for (int mt = 0; mt < 4; ++mt) { f16x4 o;
#pragma unroll
                for (int i = 0; i < 4; ++i) o[i] = (f16)X[mt][i];
                *(f16x4*)ARENA(a.ws, AR_LG + ((size_t)bh * NGRP + g) * 8192 + (size_t)((xr * 64 + 16 * mt + 4 * fq) * 2)) = o; }
        } else {
#pragma unroll
            for (int mt = 0; mt < 4; ++mt)
#pragma unroll
                for (int i = 0; i < 4; ++i) X[mt][i] = (16 * mt + 4 * fq + i == xr) ? 1.f : 0.f;
#pragma unroll 1
            for (int s = 0; s < 8; ++s) pb_step<false>(X, lds + s * PB_SLOT, xr, vl, fq);
#pragma unroll
            for (int mt = 0; mt < 4; ++mt)
#pragma unroll
                for (int i = 0; i < 4; ++i) *(f16*)ARENA(a.ws, AR_PGT + ((size_t)bh * NGRP + g) * 8192 + (size_t)(((16 * mt + 4 * fq + i) * 64 + xr) * 2)) = (f16)X[mt][i];
        }
        asm volatile("s_waitcnt vmcnt(0) lgkmcnt(0)" ::: "memory");
        __builtin_amdgcn_s_barrier();
    }
}
__device__ __forceinline__ void phaseB3(const Args& a, LAS unsigned char* lds, int tid) {
    asm volatile("" : "+v"(tid));
    const int lane = tid & 63, wave = __builtin_amdgcn_readfirstlane(tid >> 6);
    for (int task = blockIdx.x; task < 12 * NGRP; task += gridDim.x) {
        const int bh = task / NGRP, g = task % NGRP, c0 = 8 * g;
        pb_stage8(a, lds, bh, c0, wave, lane);
        if (wave < 4) {
            const int vt = wave, vl = lane & 15, fq = lane >> 4, xr = 16 * vt + vl;
            char* RL = (char*)(a.ws + WS_RL) + ((size_t)bh * NCH + c0) * 8192;
            f32x4 X[4];
#pragma unroll
            for (int mt = 0; mt < 4; ++mt) { const f16x4 s4 = *(const f16x4*)ARENA(a.ws, AR_SG + ((size_t)bh * NGRP + g) * 8192 + (size_t)((xr * 64 + 16 * mt + 4 * fq) * 2)); X[mt] = (f32x4){(float)s4[0], (float)s4[1], (float)s4[2], (float)s4[3]}; }
#pragma unroll 1
            for (int s = 0; s < 8; ++s) {
#pragma unroll
                for (int mt = 0; mt < 4; ++mt) { f16x4 o;
#pragma unroll
                    for (int i = 0; i < 4; ++i) o[i] = (f16)X[mt][i];
                    *(f16x4*)(RL + (size_t)s * 8192 + (xr * 64 + 16 * mt + 4 * fq) * 2) = o; }
                if (s < 7) pb_step<true>(X, lds + s * PB_SLOT, xr, vl, fq);
            }
        }
        asm volatile("s_waitcnt vmcnt(0) lgkmcnt(0)" ::: "memory");
        __builtin_amdgcn_s_barrier();
    }
}
__device__ __forceinline__ void phaseB(const Args& a, LAS unsigned char* lds, int tid) {
    asm volatile("" : "+v"(tid));
    const int lane = tid & 63, wave = __builtin_amdgcn_readfirstlane(tid >> 6);
    const int bx = blockIdx.x;
    if (bx < 12) {
        const int bh = bx;
        const bool loader = wave >= 4;
        const int vt = wave & 3, vl = lane & 15, fq = lane >> 4, v = 16 * vt + vl;
        const int lq = (wave - 4) * 64 + lane, lrow = lq >> 3, lpp = lq & 7;
        const unsigned lsrc = (unsigned)(lrow * 128 + ((lpp ^ (lrow & 7)) << 4));
#define PB_ISSUE(cc) { const unsigned so = (unsigned)(((cc) & (PB_NS - 1)) * PB_SLOT) + (unsigned)((wave - 4) * 1024); const size_t go = ((size_t)bh * NGRP + (cc)) * 8192 + lsrc; \
            __builtin_amdgcn_global_load_lds((const unsigned*)ARENA(a.ws, AR_PGT + go), (LAS unsigned*)(lds + so), 16, 0, 0); \
            __builtin_amdgcn_global_load_lds((const unsigned*)ARENA(a.ws, AR_PGT + go + 4096), (LAS unsigned*)(lds + so + 4096), 16, 0, 0); \
            __builtin_amdgcn_global_load_lds((const unsigned*)ARENA(a.ws, AR_LG + go), (LAS unsigned*)(lds + so + 8192), 16, 0, 0); \
            __builtin_amdgcn_global_load_lds((const unsigned*)ARENA(a.ws, AR_LG + go + 4096), (LAS unsigned*)(lds + so + 12288), 16, 0, 0); }
        if (loader) {
#pragma unroll
            for (int cc = 0; cc < PB_AHEAD; ++cc) PB_ISSUE(cc)
            asm volatile("s_waitcnt vmcnt(20)" ::: "memory");
        }
        __builtin_amdgcn_s_barrier();
        f32x4 Sacc[4];
#pragma unroll
        for (int mt = 0; mt < 4; ++mt) Sacc[mt] = (f32x4){0.f, 0.f, 0.f, 0.f};
#pragma unroll 1
        for (int c = 0; c < NGRP; ++c) {
            if (loader) {
                if (c + PB_AHEAD < NGRP) { PB_ISSUE(c + PB_AHEAD) asm volatile("s_waitcnt vmcnt(20)" ::: "memory"); }
                else asm volatile("s_waitcnt vmcnt(0)" ::: "memory");
            } else {
#pragma unroll
                for (int mt = 0; mt < 4; ++mt) { f16x4 o;
#pragma unroll
                    for (int i = 0; i < 4; ++i) o[i] = (f16)Sacc[mt][i];
                    *(f16x4*)ARENA(a.ws, AR_SG + ((size_t)bh * NGRP + c) * 8192 + (size_t)((v * 64 + 16 * mt + 4 * fq) * 2)) = o; }
                pb_step<true>(Sacc, lds + (c & (PB_NS - 1)) * PB_SLOT, v, vl, fq);
                asm volatile("s_waitcnt lgkmcnt(0)" ::: "memory");
            }
            __builtin_amdgcn_s_barrier();
        }
#undef PB_ISSUE
        asm volatile("s_waitcnt vmcnt(0)" ::: "memory");
    } else if (bx < 12 + 96) {
        const int idx = (bx - 12) * NT + tid; const int bh = idx >> 12, e = idx & 4095, k = e & 63;
        f16* HL = (f16*)(a.ws + WS_HL); const float* DC = (const float*)(a.ws + WS_DC);
        float s = 0.f;
        for (int c0 = 0; c0 < NCH; c0 += 8) { float Lc[8], d[8];
#pragma unroll
            for (int j = 0; j < 8; ++j) { Lc[j] = (float)HL[((size_t)bh * NCH + c0 + j) * 4096 + e]; d[j] = DC[((size_t)bh * NCH + c0 + j) * 64 + k]; }
#pragma unroll
            for (int j = 0; j < 8; ++j) { HL[((size_t)bh * NCH + c0 + j) * 4096 + e] = (f16)s; s = d[j] * s + Lc[j]; } }
    } else if (bx == 12 + 96) {
        const int bb = tid >> 8, ch = tid & 255; const float* LA = (const float*)(a.ws + WS_LA); float* LH = (float*)(a.ws + WS_LH);
        float cy = 0.f;
        for (int c0 = 0; c0 < NCH; c0 += 8) { float A[8], H[8];
#pragma unroll
            for (int j = 0; j < 8; ++j) { const size_t o = ((size_t)bb * NCH + c0 + j) * 256 + ch; A[j] = LA[o]; H[j] = LH[o]; }
#pragma unroll
            for (int j = 0; j < 8; ++j) { const size_t o = ((size_t)bb * NCH + c0 + j) * 256 + ch; LH[o] = cy; cy = A[j] * cy + H[j]; } }
    }
}

__device__ __forceinline__ void phaseC(const Args& a, int l, int task, LAS unsigned char* lds, int tid) {
    asm volatile("" : "+v"(tid));
    const int lane = tid & 63, wave = __builtin_amdgcn_readfirstlane(tid >> 6);
    const int b = task / NCH, c = task % NCH;
    const int tl = lane & 15, fq = lane >> 4, tt = wave & 3, hg = wave >> 2;
    const unsigned m = (unsigned)(b * SEQ + c * CH + 16 * tt + tl);
    const char* U = (const char*)(a.ws + WS_U); char* MIX = (char*)(a.ws + WS_MIX); const char* VP = (const char*)(a.ws + WS_VP);
    const char* QT = (const char*)(a.ws + WS_QT); const char* RL = (const char*)(a.ws + WS_RL); const char* HL = (const char*)(a.ws + WS_HL); const float* BONG = (const float*)(a.ws + WS_BON);
    const unsigned uo = m * (unsigned)(NU * 2);
#pragma unroll
    for (int hh = 0; hh < 3; ++hh) {
        const int h = 3 * hg + hh; const int bh = b * RW_H + h;
        const char* sl = RL + ((size_t)bh * NCH + c) * 8192;
        f16x8 bq[2];
#pragma unroll
        for (int s = 0; s < 2; ++s) bq[s] = *(const f16x8*)(QT + (m * (unsigned)RW_W + (unsigned)(h * 64 + 8 * fq + 32 * s)) * 2u);
        f32x4 D[4];
#pragma unroll
        for (int vt = 0; vt < 4; ++vt) { const f16x4 yl = *(const f16x4*)(MIX + (m * (unsigned)DM + (unsigned)(h * 64 + 16 * vt + 4 * fq)) * 2u);
            f32x4 d = (f32x4){(float)yl[0], (float)yl[1], (float)yl[2], (float)yl[3]};
#pragma unroll
            for (int s = 0; s < 2; ++s) d = __builtin_amdgcn_mfma_f32_16x16x32_f16(*(const f16x8*)(sl + ((16 * vt + tl) * 64 + 8 * fq + 32 * s) * 2), bq[s], d, 0, 0, 0);
            D[vt] = d; }
        float sm = 0.f;
#pragma unroll
        for (int vt = 0; vt < 4; ++vt) sm += (D[vt][0] + D[vt][1]) + (D[vt][2] + D[vt][3]);
        sm += shfl_xor_f(sm, 16); sm += shfl_xor_f(sm, 32);
        const float mean = sm * (1.0f / 64.0f); float vr = 0.f;
#pragma unroll
        for (int vt = 0; vt < 4; ++vt)
#pragma unroll
            for (int i = 0; i < 4; ++i) { const float d = D[vt][i] - mean; vr += d * d; }
        vr += shfl_xor_f(vr, 16); vr += shfl_xor_f(vr, 32);
        const float rstd = rsq_(vr * (1.0f / 64.0f) + 64e-5f);
        const float bon = BONG[m * 8u + (unsigned)h];
        const float* ln_w = a.in[14] + l * RW_W; const float* ln_b = a.in[15] + l * RW_W;
#pragma unroll
        for (int vt = 0; vt < 4; ++vt) { const unsigned col = (unsigned)(h * 64 + 16 * vt + 4 * fq);
            const f16x4 vp = *(const f16x4*)(VP + (m * (unsigned)RW_W + col) * 2u), z4 = *(const f16x4*)(U + uo + ((unsigned)C_RWZ + col) * 2u);
            const f32x4 lw = *(const f32x4*)(ln_w + col), lb = *(const f32x4*)(ln_b + col);
            f16x4 o;
#pragma unroll
            for (int i = 0; i < 4; ++i) o[i] = (f16)(((D[vt][i] - mean) * rstd * lw[i] + lb[i] + bon * (float)vp[i]) * siluf_((float)z4[i]));
            *(f16x4*)(MIX + (m * (unsigned)DM + col) * 2u) = o; }
    }
#pragma unroll
    for (int hh = 0; hh < 3; ++hh) {
        const int h = 3 * hg + hh; const int bh = b * 6 + h;
        const char* sl = HL + ((size_t)bh * NCH + c) * 8192;
        f16x8 bq[2];
#pragma unroll
        for (int s = 0; s < 2; ++s) bq[s] = *(const f16x8*)(U + uo + (unsigned)(C_HGQ + h * 64 + 8 * fq + 32 * s) * 2u);
        f32x4 D[4];
#pragma unroll
        for (int vt = 0; vt < 4; ++vt) { const f16x4 ol = *(const f16x4*)(MIX + (m * (unsigned)DM + (unsigned)(384 + h * 64 + 16 * vt + 4 * fq)) * 2u);
            f32x4 d = (f32x4){(float)ol[0], (float)ol[1], (float)ol[2], (float)ol[3]};
#pragma unroll
            for (int s = 0; s < 2; ++s) d = __builtin_amdgcn_mfma_f32_16x16x32_f16(*(const f16x8*)(sl + ((16 * vt + tl) * 64 + 8 * fq + 32 * s) * 2), bq[s], d, 0, 0, 0);
            D[vt] = d; }
        float ss = 0.f;
#pragma unroll
        for (int vt = 0; vt < 4; ++vt) ss += (D[vt][0] * D[vt][0] + D[vt][1] * D[vt][1]) + (D[vt][2] * D[vt][2] + D[vt][3] * D[vt][3]);
        ss += shfl_xor_f(ss, 16); ss += shfl_xor_f(ss, 32);
        const float rs = rsq_(ss * (1.0f / 64.0f) + 1e-6f);
        const float* nw = a.in[17] + l * 384;
#pragma unroll
        for (int vt = 0; vt < 4; ++vt) { const unsigned col = (unsigned)(h * 64 + 16 * vt + 4 * fq);
            const f16x4 z4 = *(const f16x4*)(U + uo + ((unsigned)C_HGZ + col) * 2u); const f32x4 w4 = *(const f32x4*)(nw + col);
            f16x4 o;
#pragma unroll
            for (int i = 0; i < 4; ++i) o[i] = (f16)(D[vt][i] * rs * w4[i] * siluf_((float)z4[i]));
            *(f16x4*)(MIX + (m * (unsigned)DM + 384u + col) * 2u) = o; }
    }
    {
        const char* CA = (const char*)(a.ws + WS_CA); const float* LH = (const float*)(a.ws + WS_LH) + ((size_t)b * NCH + c) * 256;
#pragma unroll
        for (int q = 0; q < 4; ++q) { const unsigned ch0 = (unsigned)(128 * hg + 32 * fq + 8 * q);
            const f16x8 hl = *(const f16x8*)(MIX + (m * (unsigned)DM + 768u + ch0) * 2u), ca = *(const f16x8*)(CA + (m * 256u + ch0) * 2u), z8 = *(const f16x8*)(U + uo + ((unsigned)C_LRUZ + ch0) * 2u);
            const f32x4 c0 = *(const f32x4*)(LH + ch0), c1 = *(const f32x4*)(LH + ch0 + 4);
            f16x8 o;
#pragma unroll
            for (int i = 0; i < 8; ++i) o[i] = (f16)(((float)hl[i] + (float)ca[i] * (i < 4 ? c0[i & 3] : c1[i & 3])) * siluf_((float)z8[i]));
            *(f16x8*)(MIX + (m * (unsigned)DM + 768u + ch0) * 2u) = o; }
    }
}
#define XB_TMO      128
#define XB_XCNT(j)  (256  + 64 * (j))
#define XB_XSUB(j)  (1280 + 64 * (j))
#define XB_XGEN(j)  (2304 + 64 * (j))
#define XB_TOP      3328
#define XB_TOPGEN   3392
#define XCD_BAR_WORDS 3456
#define XB_SPIN_CAP (1u << 18)

__device__ __forceinline__ unsigned xb_ld(unsigned* p)              { return __hip_atomic_load(p, __ATOMIC_RELAXED, __HIP_MEMORY_SCOPE_AGENT); }
__device__ __forceinline__ unsigned xb_add(unsigned* p, unsigned v) { return __hip_atomic_fetch_add(p, v, __ATOMIC_RELAXED, __HIP_MEMORY_SCOPE_AGENT); }
__device__ __forceinline__ unsigned xb_xcc_id() { return (unsigned)__builtin_amdgcn_s_getreg((3 << 11) | 20) & 0xFu; }
#define XB_SPIN(cond, bar) do { unsigned _sp = 0; while (cond) { __builtin_amdgcn_s_sleep(1); \
    if ((++_sp & 255u) == 0u) { if (xb_ld(&(bar)[XB_TMO])) break; if (_sp > XB_SPIN_CAP) { atomicAdd(&(bar)[XB_TMO], 1u); break; } } } } while (0)

struct XcdBarrier {
    unsigned* bar; unsigned x; int isw0;
    volatile LAS unsigned* st;
};

__device__ __forceinline__ XcdBarrier xcd_barrier_post(unsigned* bar, volatile LAS unsigned* st, int isw0) {
    XcdBarrier b; b.bar = bar; b.x = xb_xcc_id(); b.st = st; b.isw0 = isw0;
    if (isw0 && lane_now() == 0) (void)xb_add(&bar[XB_XCNT(b.x)], 1u);
    return b;
}
__device__ __forceinline__ void xcd_barrier_complete(unsigned* bar, unsigned x, unsigned& nloc, unsigned& nx) {
    const unsigned G = gridDim.x * gridDim.y * gridDim.z;
    unsigned sum, cnt, mine, sp = 0u;
    for (;;) {
        sum = 0u; cnt = 0u; mine = 0u;
#pragma unroll
        for (unsigned j = 0; j < 16; ++j) { const unsigned c = xb_ld(&bar[XB_XCNT(j)]); sum += c; cnt += (c > 0u) ? 1u : 0u; mine = (j == x) ? c : mine; }
        if (sum == G) break;
        __builtin_amdgcn_s_sleep(1);
        if ((++sp & 255u) == 0u) { if (xb_ld(&bar[XB_TMO])) break; if (sp > XB_SPIN_CAP) { atomicAdd(&bar[XB_TMO], 1u); break; } }
    }
    nloc = mine > 0u ? mine : 1u; nx = cnt > 0u ? cnt : 1u;
}

__device__ __forceinline__ void xcd_barrier(const XcdBarrier& b) {
    asm volatile("s_waitcnt vmcnt(0)" ::: "memory");
    __syncthreads();
    if (b.isw0 && lane_now() == 0) {
        unsigned* bar = b.bar;
        __builtin_amdgcn_s_waitcnt(0);
        unsigned nloc = b.st[0], nx = b.st[1];
        if (nloc == 0u) { xcd_barrier_complete(bar, b.x, nloc, nx); b.st[0] = nloc; b.st[1] = nx; }
        const unsigned old = xb_add(&bar[XB_XSUB(b.x)], 1u);
        const unsigned gen = old / nloc;
        if (old + 1u == (gen + 1u) * nloc) {
            __builtin_amdgcn_fence(__ATOMIC_RELEASE, "agent");
            asm volatile("s_waitcnt vmcnt(0)" ::: "memory");
            const unsigned og = xb_add(&bar[XB_TOP], 1u);
            const unsigned tg = og / nx;
            if (og + 1u == (tg + 1u) * nx) xb_add(&bar[XB_TOPGEN], 1u);
            else XB_SPIN(xb_ld(&bar[XB_TOPGEN]) == tg, bar);
            __builtin_amdgcn_fence(__ATOMIC_ACQUIRE, "agent");
            xb_add(&bar[XB_XGEN(b.x)], 1u);
            asm volatile("s_waitcnt vmcnt(0)" ::: "memory");
        } else {
            XB_SPIN(xb_ld(&bar[XB_XGEN(b.x)]) == gen, bar);
            __builtin_amdgcn_fence(__ATOMIC_ACQUIRE, "agent");
            asm volatile("s_waitcnt vmcnt(0)" ::: "memory");
        }
    }
    __syncthreads();
}

constexpr size_t WS_BAR = 16384;
constexpr int MISC_OFF = LDS_BYTES - 16;
__global__ void __launch_bounds__(NT, 2) fwd(Args args) {
    extern __shared__ __attribute__((aligned(16))) unsigned char lds_raw[];
    LAS unsigned char* lds = (LAS unsigned char*)lds_raw;
    cg::grid_group grid = cg::this_grid();
    const int wave = __builtin_amdgcn_readfirstlane((int)threadIdx.x >> 6);
#define TID_NOW() (wave * 64 + lane_now())
    const int tid = TID_NOW(); const int lane = tid & 63;
    if (wave == 0 && lane < 4) ((LAS unsigned*)(lds + MISC_OFF))[lane] = 0u;
    __syncthreads();
    XcdBarrier xbar = xcd_barrier_post((unsigned*)(args.ws + WS_BAR), (volatile LAS unsigned*)(lds + MISC_OFF), __builtin_amdgcn_readfirstlane(wave == 0 ? 1 : 0));
#define GRID_BAR() do { XcdBarrier xb_ = xbar; xb_.st = (volatile LAS unsigned*)(lds + MISC_OFF); asm volatile("" : "+s"(xb_.bar), "+s"(xb_.x)); xcd_barrier(xb_); } while (0)
    const int G = gridDim.x, gw = blockIdx.x * NWAVES + wave, NGW = G * NWAVES;
    unsigned char* ws = args.ws;
    unsigned short* XN = (unsigned short*)(ws + WS_XN);
    {
        LAS float* scr = (LAS float*)(lds + wave * 8704);
        constexpr int I_IN = (DM / 64) * (NIN / 32), I_OUT = (DM / 64) * (DM / 32), NITEMS = DEPTH * (I_IN + I_OUT);
        for (int it = gw; it < NITEMS; it += NGW) {
            int r = it; const int l = r / (I_IN + I_OUT); r -= l * (I_IN + I_OUT);
            if (r < I_IN) p0_transpose_item(args.in[2] + (size_t)l * DM * NIN, DM, NIN, (unsigned short*)(ws + WS_WIN + l * WIN_L), scr, r, lane, l == 0 ? nullptr : args.in[1] + DM);
            else p0_transpose_item(args.in[25] + (size_t)l * DM * DM, DM, DM, (unsigned short*)(ws + WS_WOUT + l * WOUT_L), scr, r - I_IN, lane, nullptr);
        }
        for (int i = gw; i < DEPTH * (NU - NIN) * DM * 2 / 1024; i += NGW) { const int l = i / ((NU - NIN) * DM * 2 / 1024), r = i % ((NU - NIN) * DM * 2 / 1024);
            if (l == 1 && r < 64 * DM * 2 / 1024) continue;
            *(u32x4*)(ws + WS_WIN + l * WIN_L + (size_t)NIN * DM * 2 + (size_t)r * 1024 + lane * 16) = (u32x4){0u, 0u, 0u, 0u}; }
        if (blockIdx.x < 32) {
            LAS f16* TT = (LAS f16*)(lds + 8 * 8704);
            for (int i = tid; i < 64 * RW_W; i += NT) { const int n = i / RW_W, cc = i % RW_W; const float mm = args.in[3][RW_SHIFT + C_V + cc]; TT[n * 392 + cc] = (f16)(((n < 32) ? (1.0f - mm) : mm) * args.in[9][cc * 32 + (n & 31)]); }
            __syncthreads();
            const int tile = blockIdx.x * NWAVES + wave, nt = tile & 3, kt = tile >> 2, tl = lane & 15, fq = lane >> 4;
            const float* wrow = args.in[2] + (size_t)DM * NIN + (size_t)(16 * kt + tl) * NIN + C_V + 8 * fq;
            f32x4 bv[12][2];
#pragma unroll
            for (int s2 = 0; s2 < 12; ++s2) { bv[s2][0] = *(const f32x4*)(wrow + 32 * s2); bv[s2][1] = *(const f32x4*)(wrow + 32 * s2 + 4); }
            f32x4 d = (f32x4){0.f, 0.f, 0.f, 0.f};
#pragma unroll
            for (int s2 = 0; s2 < 12; ++s2) { f16x8 bf;
#pragma unroll
                for (int j = 0; j < 8; ++j) bf[j] = (f16)(j < 4 ? bv[s2][0][j & 3] : bv[s2][1][j & 3]);
                d = __builtin_amdgcn_mfma_f32_16x16x32_f16(*(const LAS f16x8*)(TT + (16 * nt + tl) * 392 + 8 * fq + 32 * s2), bf, d, 0, 0, 0); }
            const float nwk = args.in[1][DM + 16 * kt + tl];
#pragma unroll
            for (int i = 0; i < 4; ++i) ((f16*)(ws + WS_WIN + WIN_L))[(size_t)(NIN + 16 * nt + 4 * fq + i) * DM + 16 * kt + tl] = (f16)(d[i] * nwk);
            __syncthreads();
        }
        for (int i = blockIdx.x * NT + tid; i < M; i += G * NT) ((float*)(ws + WS_RSS))[i] = 0.f;
        for (int m = gw; m < M; m += 4 * NGW) rms_row4_f16(args.in[0] + (size_t)m * DM, (size_t)NGW * DM, args.in[1], XN + (size_t)m * DM, lane);
        { f16* WUPT = (f16*)(ws + WS_WUPT); f16* AUPT = (f16*)(ws + WS_AUPT); f16* VDNT = (f16*)(ws + WS_VDNT); f16* VUPT = (f16*)(ws + WS_VUPT);
          for (int i = blockIdx.x * NT + tid; i < 122880; i += G * NT) {
              if (i < 49152) { const int ll = i / 24576, r = i % 24576, n = r / 64, k = r % 64; WUPT[i] = (f16)args.in[5][(size_t)ll * 24576 + k * 384 + n]; }
              else if (i < 98304) { const int i2 = i - 49152, ll = i2 / 24576, r = i2 % 24576, n = r / 64, k = r % 64; AUPT[i2] = (f16)args.in[7][(size_t)ll * 24576 + k * 384 + n]; }
              else if (i < 110592) { const int i2 = i - 98304, j2 = i2 / 384, cc = i2 % 384; VDNT[i2] = (f16)args.in[9][cc * 32 + j2]; }
              else { const int i2 = i - 110592, n = i2 / 32, j2 = i2 % 32; VUPT[i2] = (f16)args.in[10][j2 * 384 + n]; } }
          f16* WAT = (f16*)(ws + WS_WAT); f16* WXT = (f16*)(ws + WS_WXT);
          for (int i = blockIdx.x * NT + tid; i < 32768; i += G * NT) { const int lg = i >> 12, r = i & 4095, j = r >> 6, ii = r & 63; WAT[i] = (f16)args.in[20][(size_t)lg * 4096 + ii * 64 + j]; WXT[i] = (f16)args.in[22][(size_t)lg * 4096 + ii * 64 + j]; } }
    }
    if (gridDim.x > 65536u) grid.sync();
    GRID_BAR();
#pragma unroll 1
    for (int l = 0; l < DEPTH; ++l) {
        { pg8::Gemm g{XN, (const unsigned short*)(ws + WS_WIN + l * WIN_L), M, NU, DM}; pg8::StaticOrder S; S.init(M, NU, G, (int)blockIdx.x);
          pg8::EpiF16 E{(unsigned short*)(ws + WS_U), NU, l == 0 ? nullptr : (const float*)(ws + WS_RSS)};
          pg8::gemm_phase<pg8::EpiF16, pg8::StaticOrder, true, true>(lds, g, S, E, wave); }
        GRID_BAR();
        for (int task = blockIdx.x; task < BATCH * NCH; task += G) phaseA(args, l, task, lds, TID_NOW());
        GRID_BAR();
        phaseB1(args, lds, TID_NOW());
        GRID_BAR();
        phaseB(args, lds, TID_NOW());
        GRID_BAR();
        phaseB3(args, lds, TID_NOW());
        GRID_BAR();
        for (int task = blockIdx.x; task < BATCH * NCH; task += G) phaseC(args, l, task, lds, TID_NOW());
        GRID_BAR();
        { pg8::Gemm g{(const unsigned short*)(ws + WS_MIX), (const unsigned short*)(ws + WS_WOUT + l * WOUT_L), M, DM, DM}; pg8::StaticOrder S; S.init(M, DM, G, (int)blockIdx.x);
          pg8::EpiRes E{l == 0 ? args.in[0] : args.out, args.out, DM, l == 0 ? XN : nullptr, (float*)(ws + WS_RSS)};
          pg8::gemm_phase<pg8::EpiRes, pg8::StaticOrder, true, true>(lds, g, S, E, wave); }
        GRID_BAR();
        { int ln = TID_NOW() & 63; asm volatile("" : "+v"(ln));
          if (l + 1 < DEPTH) { }
          else { for (int m = gw; m < M; m += 4 * NGW) rms_row4_f32(args.out + (size_t)m * DM, (size_t)NGW * DM, args.in[26], ln); } }
    }
}

extern "C" void kernel_launch(void* const* d_in, const int* in_sizes, int n_in, void* d_out, int out_size, void* d_ws, size_t ws_size, hipStream_t stream) {
    static int grid = 0;
    if (grid == 0) {
        if (n_in != 27 || in_sizes[0] != M * DM || out_size != M * DM || ws_size < WS_END) { fprintf(stderr, "kernel_launch: unexpected problem: n_in %d in0 %d out %d ws %zu\n", n_in, n_in > 0 ? in_sizes[0] : -1, out_size, ws_size); grid = -1; return; }
        int dev = 0, cus = 0, per_cu = 0;
        hipGetDevice(&dev); hipDeviceGetAttribute(&cus, hipDeviceAttributeMultiprocessorCount, dev);
        if (hipFuncSetAttribute((const void*)fwd, hipFuncAttributeMaxDynamicSharedMemorySize, LDS_BYTES) != hipSuccess) { fprintf(stderr, "kernel_launch: hipFuncSetAttribute failed\n"); grid = -1; return; }
        if (hipOccupancyMaxActiveBlocksPerMultiprocessor(&per_cu, (const void*)fwd, NT, LDS_BYTES) != hipSuccess || per_cu < 1) { fprintf(stderr, "kernel_launch: occupancy query failed (%d)\n", per_cu); grid = -1; return; }
        grid = cus * per_cu;
    }
    if (grid < 0) return;
    if (hipMemsetAsync((char*)d_ws, 0, 65536, stream) != hipSuccess) { fprintf(stderr, "kernel_launch: memset of the barrier words failed\n"); return; }
    Args a{};
    for (int i = 0; i < 27; ++i) a.in[i] = (const float*)d_in[i];
    a.out = (float*)d_out; a.ws = (unsigned char*)d_ws;
    void* kargs[] = {&a};
    hipError_t e = hipLaunchCooperativeKernel((const void*)fwd, dim3(grid), dim3(NT), kargs, LDS_BYTES, stream);
    if (e != hipSuccess) fprintf(stderr, "cooperative launch failed: %s (grid %d)\n", hipGetErrorString(e), grid);
}
```

```cpp
#include <hip/hip_runtime.h>
#include <hip/hip_cooperative_groups.h>
#include <cstdio>
#include <cstdint>
namespace cg = cooperative_groups;
typedef _Float16 f16x8_t __attribute__((ext_vector_type(8)));
#define MK_MFMA(a, b, c) __builtin_amdgcn_mfma_f32_16x16x32_f16(__builtin_bit_cast(f16x8_t, (a)), __builtin_bit_cast(f16x8_t, (b)), (c), 0, 0, 0)
__device__ __forceinline__ int lane_now() { int z; asm volatile("v_mbcnt_lo_u32_b32 %0, -1, 0\n\tv_mbcnt_hi_u32_b32 %0, -1, %0" : "=v"(z)); return z; }
__device__ __forceinline__ float shfl_xor_f(float v, int mask) { const int ln = lane_now(); return __builtin_bit_cast(float, __builtin_amdgcn_ds_bpermute((ln ^ mask) << 2, __builtin_bit_cast(int, v))); }
namespace pg8 {
#define PG8_LAS __attribute__((address_space(3)))
typedef unsigned short bf16_t;
typedef short bf16x8 __attribute__((ext_vector_type(8)));
typedef float f32x4 __attribute__((ext_vector_type(4)));
typedef unsigned u32x4 __attribute__((ext_vector_type(4)));
constexpr int BM = 256, BK = 64, HALF = 128, HTB = HALF * BK * 2  , STAGE_BYTES = 8 * HTB, NXCD = 8, WGM = 8;

__host__ __device__ __forceinline__ int lds_byte(int r, int c) { const int st = (r >> 4) * 2 + (c >> 5), rr = r & 15, cc = c & 31, ob = rr * 64 + cc * 2; return st * 1024 + (ob ^ (((ob >> 9) & 1) << 5)); }
__host__ __device__ __forceinline__ void stage_rc(int b, int& R, int& C) { const int st = b / 1024, sb = b % 1024, swz = sb ^ (((sb >> 9) & 1) << 5); R = (st >> 1) * 16 + swz / 64; C = (st & 1) * 32 + (swz % 64) / 2; }
__host__ __device__ __forceinline__ int perm32(int rho) { const int n = rho >> 4, i = rho & 15; return 8 * (i >> 2) + 4 * n + (i & 3); }

struct Unit { int pm, pn; };
struct Gemm { const bf16_t* A; const bf16_t* Bt; int M, N, K; };

struct StaticOrder {
    int nM, nN, nwg, G, c;
    __host__ __device__ void init(int M, int N, int G_, int c_) { nM = M / BM; nN = N / BM; nwg = nM * nN; G = G_; c = c_; }
    __host__ __device__ bool next(int i, Unit& u) const {
        const long L = (long)i * G + c; if (L >= nwg) return false;
        int wgid = (int)L; { const int q = nwg / NXCD, r = nwg % NXCD, xcd = wgid % NXCD, off = wgid / NXCD; wgid = (xcd < r ? xcd * (q + 1) : r * (q + 1) + (xcd - r) * q) + off; }
        const int nig = WGM * nN, gid = wgid / nig, fm = gid * WGM, gsz = (nM - fm) < WGM ? (nM - fm) : WGM;
        u.pm = fm + ((wgid % nig) % gsz); u.pn = (wgid % nig) / gsz; return true;
    }
    __device__ __forceinline__ void a_ready(const Unit&) const {}
    __device__ __forceinline__ void done(const Unit&) const {}
};

__device__ __forceinline__ unsigned pk_f16(float lo, float hi) { typedef _Float16 h2 __attribute__((ext_vector_type(2))); h2 v; v.x = (_Float16)lo; v.y = (_Float16)hi; return __builtin_bit_cast(unsigned, v); }
typedef unsigned u32x2 __attribute__((ext_vector_type(2)));
struct EpiF16 {
    static constexpr bool PERM = true, AFTER_DRAIN = false;
    bf16_t* O; int ldc; const float* rss;
    __device__ __forceinline__ void operator()(const f32x4 (&acc)[2][2][4][2], const Unit& u, int wr, int wc, int fr, int fq) const {
        const int row0 = u.pm * BM + wr * 64 + fr; const int col0 = u.pn * BM + wc * 32 + 8 * fq;
#pragma unroll
        for (int ai = 0; ai < 2; ++ai)
#pragma unroll
            for (int m = 0; m < 4; ++m) { const int row = row0 + ai * HALF + m * 16; bf16_t* rowp = O + (size_t)row * ldc + col0;
                const float sc = rss ? 1.0f / sqrtf(rss[row] * (1.0f / 1024.0f) + 1e-6f) : 1.0f;
#pragma unroll
                for (int bj = 0; bj < 2; ++bj) { const f32x4 v0 = acc[ai][bj][m][0] * sc, v1 = acc[ai][bj][m][1] * sc;
                    u32x4 w; w.x = pk_f16(v0[0], v0[1]); w.y = pk_f16(v0[2], v0[3]); w.z = pk_f16(v1[0], v1[1]); w.w = pk_f16(v1[2], v1[3]);
                    *(u32x4*)(rowp + bj * HALF) = w; } }
    }
};
struct EpiRes {
    static constexpr bool PERM = false, AFTER_DRAIN = false;
    const float* base; float* out; int ldc; bf16_t* xh; float* rss;
    __device__ __forceinline__ void operator()(const f32x4 (&acc)[2][2][4][2], const Unit& u, int wr, int wc, int fr, int fq) const {
        const int row0 = u.pm * BM + wr * 64 + fr; const int col0 = u.pn * BM + wc * 32 + 4 * fq;
#pragma unroll
        for (int ai = 0; ai < 2; ++ai)
#pragma unroll
            for (int m = 0; m < 4; ++m) { const size_t off = (size_t)(row0 + ai * HALF + m * 16) * ldc + col0; float ss = 0.f;
#pragma unroll
                for (int bj = 0; bj < 2; ++bj)
#pragma unroll
                    for (int n = 0; n < 2; ++n) { const size_t o = off + bj * HALF + n * 16; const f32x4 b = *(const f32x4*)(base + o); const f32x4 x = b + acc[ai][bj][m][n]; *(f32x4*)(out + o) = x;
                        if (xh) { u32x2 h; h.x = pk_f16(x[0], x[1]); h.y = pk_f16(x[2], x[3]); *(u32x2*)(xh + o) = h; ss += (x[0] * x[0] + x[1] * x[1]) + (x[2] * x[2] + x[3] * x[3]); } }
                if (xh) { ss += shfl_xor_f(ss, 16); ss += shfl_xor_f(ss, 32); if (fq == 0) atomicAdd(rss + row0 + ai * HALF + m * 16, ss); }
                asm volatile("" ::: "memory"); }
    }
};

template <class Epi, class Sched, bool ALIGN_EPI = false, bool SP2 = false>
__device__ __forceinline__ void gemm_phase(PG8_LAS unsigned char* lds, const Gemm g, const Sched& S, const Epi& E, const int wave_) {
    int wv_ = wave_; asm volatile("" : "+s"(wv_)); int tid_ = lane_now() + 64 * wv_; const int tid = tid_, wid = wv_, lane = tid & 63, wr = wid >> 2, wc = wid & 3, fr = lane & 15, fq = lane >> 4;
    const int K = g.K, nt = K / BK;
    unsigned voffA[2], voffB[2];
#pragma unroll
    for (int i = 0; i < 2; ++i) { int R, C; stage_rc(tid * 16 + i * 8192, R, C); const int Rb = Epi::PERM ? ((R & ~31) + perm32(R & 31)) : R;
        voffA[i] = (unsigned)(R * K + C) * 2u; voffB[i] = (unsigned)(Rb * K + C) * 2u; }
    const size_t kstep = (size_t)(BK * 2);
    const size_t hstep = (size_t)HALF * K * 2;
    const size_t tstep = 2 * hstep;
    const unsigned ldsw = (unsigned)wid * 1024u;
    const int aoff = lds_byte(wr * 64 + fr, fq * 8), boff = lds_byte(wc * 32 + fr, fq * 8);
#define PG8_SA(b, h) (((b) * 2 + (h)) * HTB)
#define PG8_SB(b, h) ((4 + (b) * 2 + (h)) * HTB)
#define PG8_STAGE(bufoff, gbase, voff) do { _Pragma("unroll") for (int _i = 0; _i < 2; ++_i) \
        __builtin_amdgcn_global_load_lds((const unsigned*)((const char*)(gbase) + (voff)[_i]), (PG8_LAS unsigned*)(lds + (bufoff) + ldsw + _i * 8192), 16, 0, 0); } while (0)
#define PG8_LDA(dst, b, h) do { _Pragma("unroll") for (int m = 0; m < 4; ++m) _Pragma("unroll") for (int k = 0; k < 2; ++k) dst[m][k] = *(const PG8_LAS bf16x8*)(lds + PG8_SA(b, h) + aoff + m * 2048 + k * 1024); } while (0)
#define PG8_LDB(dst, b, h) do { _Pragma("unroll") for (int n = 0; n < 2; ++n) _Pragma("unroll") for (int k = 0; k < 2; ++k) dst[n][k] = *(const PG8_LAS bf16x8*)(lds + PG8_SB(b, h) + boff + n * 2048 + k * 1024); } while (0)
#define PG8_MMA(ai, bj, At, Bt) do { __builtin_amdgcn_s_setprio(1); _Pragma("unroll") for (int m = 0; m < 4; ++m) _Pragma("unroll") for (int n = 0; n < 2; ++n) _Pragma("unroll") for (int k = 0; k < 2; ++k) \
        acc[ai][bj][m][n] = MK_MFMA(Bt[n][k], At[m][k], acc[ai][bj][m][n]); __builtin_amdgcn_s_setprio(0); } while (0)
#define PG8_WAIT_V(n) asm volatile("s_waitcnt vmcnt(" #n ")" ::: "memory")
#define PG8_WAIT_L(n) asm volatile("s_waitcnt lgkmcnt(" #n ")" ::: "memory")
#define PG8_BAR __builtin_amdgcn_s_barrier()
#define PG8_SCHED __builtin_amdgcn_sched_barrier(0)
    Unit cur, nxt; int ui = 0;
    if (!S.next(0, cur)) return;
    f32x4 acc[2][2][4][2];
#pragma unroll
    for (int a = 0; a < 2; ++a)
#pragma unroll
        for (int b = 0; b < 2; ++b)
#pragma unroll
            for (int m = 0; m < 4; ++m)
#pragma unroll
                for (int n = 0; n < 2; ++n) acc[a][b][m][n] = (f32x4){0.f, 0.f, 0.f, 0.f};
    bf16x8 At[4][2], B0[2][2], B1[2][2];
    const char* cA = (const char*)g.A + (size_t)cur.pm * tstep; const char* cB = (const char*)g.Bt + (size_t)cur.pn * tstep;
    S.a_ready(cur);
    if constexpr (SP2) {
        PG8_STAGE(PG8_SB(0, 0), cB, voffB); PG8_STAGE(PG8_SB(0, 1), cB + hstep, voffB); PG8_STAGE(PG8_SA(0, 0), cA, voffA); PG8_STAGE(PG8_SA(0, 1), cA + hstep, voffA);
        if (wr == 1) PG8_BAR;
        PG8_WAIT_V(2); PG8_BAR;
        PG8_STAGE(PG8_SB(1, 0), cB + kstep, voffB); PG8_STAGE(PG8_SA(1, 0), cA + kstep, voffA); PG8_STAGE(PG8_SB(1, 1), cB + hstep + kstep, voffB);
        PG8_WAIT_V(6); PG8_BAR;
    } else {
        PG8_STAGE(PG8_SB(0, 0), cB, voffB); PG8_STAGE(PG8_SA(0, 0), cA, voffA); PG8_STAGE(PG8_SB(0, 1), cB + hstep, voffB); PG8_STAGE(PG8_SA(0, 1), cA + hstep, voffA);
        if (wr == 1) PG8_BAR;
        PG8_WAIT_V(4); PG8_BAR;
        PG8_STAGE(PG8_SB(1, 0), cB + kstep, voffB); PG8_STAGE(PG8_SA(1, 0), cA + kstep, voffA); PG8_STAGE(PG8_SB(1, 1), cB + hstep + kstep, voffB);
        PG8_WAIT_V(6); PG8_BAR;
    }
    for (;;) {
        const bool has_next = S.next(ui + 1, nxt);
        const char* nA = has_next ? (const char*)g.A + (size_t)nxt.pm * tstep : cA; const char* nB = has_next ? (const char*)g.Bt + (size_t)nxt.pn * tstep : cB;
        for (int t = 0; t < nt; t += 2) {
            const bool last = (t == nt - 2);
            const char* a1 = cA + (size_t)(t + 1) * kstep;
            const char* a2 = last ? nA : cA + (size_t)(t + 2) * kstep; const char* b2 = last ? nB : cB + (size_t)(t + 2) * kstep;
            const char* a3 = a2 + kstep; const char* b3 = b2 + kstep;
            if (last && has_next) S.a_ready(nxt);
            if constexpr (SP2) {
            PG8_LDB(B0, 0, 0); PG8_LDB(B1, 0, 1); PG8_SCHED; PG8_LDA(At, 0, 0); PG8_STAGE(PG8_SA(1, 1), a1 + hstep, voffA);
            PG8_WAIT_V(8); PG8_WAIT_L(0); PG8_BAR; PG8_MMA(0, 0, At, B0); PG8_MMA(0, 1, At, B1); PG8_BAR; PG8_SCHED;
            PG8_LDA(At, 0, 1); PG8_STAGE(PG8_SB(0, 0), b2, voffB); PG8_STAGE(PG8_SB(0, 1), b2 + hstep, voffB); PG8_STAGE(PG8_SA(0, 0), a2, voffA);
            PG8_WAIT_V(8); PG8_WAIT_L(0); PG8_BAR; PG8_MMA(1, 0, At, B0); PG8_MMA(1, 1, At, B1); PG8_BAR; PG8_SCHED;
            PG8_LDB(B0, 1, 0); PG8_LDB(B1, 1, 1); PG8_SCHED; PG8_LDA(At, 1, 0); PG8_STAGE(PG8_SA(0, 1), a2 + hstep, voffA);
            PG8_WAIT_V(8); PG8_WAIT_L(0); PG8_BAR; PG8_MMA(0, 0, At, B0); PG8_MMA(0, 1, At, B1); PG8_BAR; PG8_SCHED;
            PG8_LDA(At, 1, 1); PG8_STAGE(PG8_SB(1, 0), b3, voffB); PG8_STAGE(PG8_SB(1, 1), b3 + hstep, voffB); PG8_STAGE(PG8_SA(1, 0), a3, voffA);
            PG8_WAIT_V(8); PG8_WAIT_L(0); PG8_BAR; PG8_MMA(1, 0, At, B0); PG8_MMA(1, 1, At, B1); PG8_BAR; PG8_SCHED;
            } else {
            PG8_LDB(B0, 0, 0); PG8_SCHED; PG8_LDA(At, 0, 0); PG8_STAGE(PG8_SA(1, 1), a1 + hstep, voffA);
            PG8_WAIT_L(8); PG8_BAR; PG8_WAIT_L(0); PG8_MMA(0, 0, At, B0); PG8_BAR; PG8_SCHED;
            PG8_LDB(B1, 0, 1); PG8_STAGE(PG8_SB(0, 0), b2, voffB);
            PG8_BAR; PG8_WAIT_L(0); PG8_MMA(0, 1, At, B1); PG8_BAR;
            PG8_LDA(At, 0, 1); PG8_STAGE(PG8_SA(0, 0), a2, voffA);
            PG8_BAR; PG8_WAIT_L(0); PG8_MMA(1, 0, At, B0); PG8_BAR; PG8_SCHED;
            PG8_STAGE(PG8_SB(0, 1), b2 + hstep, voffB);
            PG8_WAIT_V(6); PG8_BAR; PG8_MMA(1, 1, At, B1); PG8_BAR;
            PG8_LDB(B0, 1, 0); PG8_SCHED; PG8_LDA(At, 1, 0); PG8_STAGE(PG8_SA(0, 1), a2 + hstep, voffA);
            PG8_WAIT_L(8); PG8_BAR; PG8_WAIT_L(0); PG8_MMA(0, 0, At, B0); PG8_BAR; PG8_SCHED;
            PG8_LDB(B1, 1, 1); PG8_STAGE(PG8_SB(1, 0), b3, voffB);
            PG8_BAR; PG8_WAIT_L(0); PG8_MMA(0, 1, At, B1); PG8_BAR;
            PG8_LDA(At, 1, 1); PG8_STAGE(PG8_SA(1, 0), a3, voffA);
            PG8_BAR; PG8_WAIT_L(0); PG8_MMA(1, 0, At, B0); PG8_BAR; PG8_SCHED;
            PG8_STAGE(PG8_SB(1, 1), b3 + hstep, voffB);
            PG8_WAIT_V(6); PG8_BAR; PG8_MMA(1, 1, At, B1); PG8_BAR;
            }
        }
        if constexpr (ALIGN_EPI) { if (wr == 0) PG8_BAR; }
        if constexpr (!Epi::AFTER_DRAIN) { E(acc, cur, wr, wc, fr, fq); S.done(cur); }
        if (!has_next) break;
#pragma unroll
        for (int a = 0; a < 2; ++a)
#pragma unroll
            for (int b = 0; b < 2; ++b)
#pragma unroll
                for (int m = 0; m < 4; ++m)
#pragma unroll
                    for (int n = 0; n < 2; ++n) acc[a][b][m][n] = (f32x4){0.f, 0.f, 0.f, 0.f};
        cur = nxt; cA = nA; cB = nB; ++ui;
        if constexpr (ALIGN_EPI) { if (wr == 1) PG8_BAR; }
    }
    PG8_WAIT_V(0);
    if constexpr (!ALIGN_EPI) { if (wr == 0) PG8_BAR; }
    PG8_BAR;
    if constexpr (Epi::AFTER_DRAIN) { E.fused(acc, cur, wr, wc, fr, fq, lds, wid, lane); S.done(cur); }
#undef PG8_SA
#undef PG8_SB
#undef PG8_STAGE
#undef PG8_LDA
#undef PG8_LDB
#undef PG8_MMA
#undef PG8_WAIT_V
#undef PG8_WAIT_L
#undef PG8_BAR
#undef PG8_SCHED
}
}

constexpr int BATCH = 2, SEQ = 8192, DM = 1024, DEPTH = 2, M = BATCH * SEQ;
constexpr int RW_H = 6, HD = 64, RW_W = 384, RW_SHIFT = 1280;
constexpr int NIN = 3712, NU = 3840;
constexpr int C_R = 0, C_K = 384, C_V = 768, C_WL = 1152, C_AL = 1216, C_RWZ = 1280, C_HGQ = 1664, C_HGF = 2048, C_HGI = 2432, C_HGZ = 2816, C_LRUX = 3200, C_LRUZ = 3456;
constexpr int CH = 64;
constexpr int NWAVES = 8, NT = NWAVES * 64;
constexpr int LDS_BYTES = 163840;
constexpr int PRM_OFF = 142336;
constexpr size_t MiB = 1u << 20;
constexpr size_t WS_WUPT = 65536, WS_AUPT = WS_WUPT + 98304, WS_VDNT = WS_AUPT + 98304, WS_VUPT = WS_VDNT + 24576, WS_WAT = WS_VUPT + 24576, WS_WXT = WS_WAT + 65536;
constexpr size_t WS_WIN = 1 * MiB, WIN_L = (size_t)NU * DM * 2;
constexpr size_t WS_WOUT = 16 * MiB, WOUT_L = (size_t)DM * DM * 2;
constexpr size_t WS_XN = 20 * MiB;
constexpr size_t WS_QT = 20 * MiB;
constexpr size_t WS_PT = 32 * MiB;
constexpr size_t WS_CA = 44 * MiB;
constexpr size_t WS_U = 52 * MiB;
constexpr size_t WS_MIX = 172 * MiB;
constexpr size_t WS_VF = 204 * MiB;
constexpr size_t WS_VP = 216 * MiB;
constexpr size_t WS_RL = 228 * MiB;
constexpr size_t WS_HL = 240 * MiB;
constexpr size_t WS_BON = 252 * MiB;
constexpr size_t WS_DC = WS_BON + 512 * 1024;
constexpr size_t WS_LA = WS_DC + 512 * 1024;
constexpr size_t WS_LH = WS_LA + 256 * 1024;
constexpr size_t WS_RSS = WS_LH + 256 * 1024;
constexpr size_t WS_END = 254 * MiB;
constexpr int NCH = SEQ / CH;

#define LAS __attribute__((address_space(3)))
typedef float f32x4 __attribute__((ext_vector_type(4)));
typedef unsigned u32x2 __attribute__((ext_vector_type(2)));
typedef unsigned u32x4 __attribute__((ext_vector_type(4)));
typedef _Float16 f16;
typedef _Float16 f16x8 __attribute__((ext_vector_type(8)));
#define LDS_WAIT() asm volatile("s_waitcnt lgkmcnt(0)" ::: "memory")

struct Args { const float* in[27]; float* out; unsigned char* ws; };

__device__ __forceinline__ float wave_sum(float v) {
#pragma unroll
    for (int o = 1; o < 64; o <<= 1) v += shfl_xor_f(v, o);
    return v;
}
__device__ __forceinline__ float sigmoidf_(float x) { return __builtin_amdgcn_rcpf(1.0f + __expf(-x)); }
__device__ __forceinline__ float rsq_(float x) { return __builtin_amdgcn_rsqf(x); }
__device__ __forceinline__ float one_minus_exp_(float x) { return (x > -0.03f) ? -x * (1.0f + x * (0.5f + x * (1.0f / 6.0f + x * (1.0f / 24.0f)))) : 1.0f - __expf(x); }
__device__ __forceinline__ float siluf_(float x) { return x * __builtin_amdgcn_rcpf(1.0f + __expf(-x)); }

__device__ __forceinline__ void p0_transpose_item(const float* W, int K, int N, unsigned short* WT, LAS float* scr, int item, int lane, const float* rsc) {
    const int nblk = N / 32, kb = item / nblk, nb = item % nblk, k0 = 64 * kb, n0 = 32 * nb;
    float tv[32];
#pragma unroll
    for (int i = 0; i < 32; ++i) { const int kk = 2 * i + (lane >> 5); tv[i] = W[(size_t)(k0 + kk) * N + n0 + (lane & 31)]; }
#pragma unroll
    for (int i = 0; i < 32; ++i) { const int kk = 2 * i + (lane >> 5); scr[kk * 33 + (lane & 31)] = tv[i] * (rsc ? rsc[k0 + kk] : 1.0f); }
    LDS_WAIT(); asm volatile("" ::: "memory");
    const int c = lane & 7;
#pragma unroll
    for (int j = 0; j < 4; ++j) { const int n = (lane >> 3) + 8 * j; const LAS float* s = scr + (8 * c) * 33 + n;
        u32x4 o; o.x = pg8::pk_f16(s[0 * 33], s[1 * 33]); o.y = pg8::pk_f16(s[2 * 33], s[3 * 33]); o.z = pg8::pk_f16(s[4 * 33], s[5 * 33]); o.w = pg8::pk_f16(s[6 * 33], s[7 * 33]);
        *(u32x4*)(WT + (size_t)(n0 + n) * K + k0 + 8 * c) = o; }
    LDS_WAIT(); asm volatile("" ::: "memory");
}
__device__ __forceinline__ void rms_row_f16(const float* xrow, const float* w, unsigned short* orow, int lane) {
    const f32x4* xr = (const f32x4*)xrow + lane; const f32x4* wr = (const f32x4*)w + lane;
    f32x4 v[4]; float s = 0.f;
#pragma unroll
    for (int j = 0; j < 4; ++j) { v[j] = xr[64 * j]; s += (v[j].x * v[j].x + v[j].y * v[j].y) + (v[j].z * v[j].z + v[j].w * v[j].w); }
    const float rs = 1.0f / sqrtf(wave_sum(s) * (1.0f / DM) + 1e-6f);
    u32x2* o8 = (u32x2*)orow + lane;
#pragma unroll
    for (int j = 0; j < 4; ++j) { const f32x4 ww = wr[64 * j]; u32x2 o; o.x = pg8::pk_f16(v[j].x * rs * ww.x, v[j].y * rs * ww.y); o.y = pg8::pk_f16(v[j].z * rs * ww.z, v[j].w * rs * ww.w); o8[64 * j] = o; }
}
__device__ __forceinline__ void rms_row_f32(float* xrow, const float* w, int lane) {
    f32x4* xr = (f32x4*)xrow + lane; const f32x4* wr = (const f32x4*)w + lane;
    f32x4 v[4]; float s = 0.f;
#pragma unroll
    for (int j = 0; j < 4; ++j) { v[j] = xr[64 * j]; s += (v[j].x * v[j].x + v[j].y * v[j].y) + (v[j].z * v[j].z + v[j].w * v[j].w); }
    const float rs = 1.0f / sqrtf(wave_sum(s) * (1.0f / DM) + 1e-6f);
#pragma unroll
    for (int j = 0; j < 4; ++j) { const f32x4 ww = wr[64 * j]; xr[64 * j] = v[j] * rs * ww; }
}

__device__ __forceinline__ void rms_row2_f32(float* xa, float* xb, const float* w, int lane) {
    f32x4* ra = (f32x4*)xa + lane; f32x4* rb = (f32x4*)xb + lane; const f32x4* wr = (const f32x4*)w + lane;
    f32x4 va[4], vb[4]; float sa = 0.f, sb = 0.f;
#pragma unroll
    for (int j = 0; j < 4; ++j) { va[j] = ra[64 * j]; vb[j] = rb[64 * j]; }
#pragma unroll
    for (int j = 0; j < 4; ++j) { sa += (va[j].x * va[j].x + va[j].y * va[j].y) + (va[j].z * va[j].z + va[j].w * va[j].w); sb += (vb[j].x * vb[j].x + vb[j].y * vb[j].y) + (vb[j].z * vb[j].z + vb[j].w * vb[j].w); }
    const float rsa = 1.0f / sqrtf(wave_sum(sa) * (1.0f / DM) + 1e-6f), rsb = 1.0f / sqrtf(wave_sum(sb) * (1.0f / DM) + 1e-6f);
#pragma unroll
    for (int j = 0; j < 4; ++j) { const f32x4 ww = wr[64 * j]; ra[64 * j] = va[j] * rsa * ww; rb[64 * j] = vb[j] * rsb * ww; }
}
__device__ __forceinline__ void rms_row4_f16(const float* x0, size_t rs, const float* w, unsigned short* o0, int lane) {
    f32x4 v[4][4]; float s[4];
#pragma unroll
    for (int r = 0; r < 4; ++r)
#pragma unroll
        for (int j = 0; j < 4; ++j) v[r][j] = ((const f32x4*)(x0 + r * rs) + lane)[64 * j];
    const f32x4* wr = (const f32x4*)w + lane;
#pragma unroll
    for (int r = 0; r < 4; ++r) { float a = 0.f;
#pragma unroll
        for (int j = 0; j < 4; ++j) a += (v[r][j].x * v[r][j].x + v[r][j].y * v[r][j].y) + (v[r][j].z * v[r][j].z + v[r][j].w * v[r][j].w);
        s[r] = 1.0f / sqrtf(wave_sum(a) * (1.0f / DM) + 1e-6f); }
#pragma unroll
    for (int j = 0; j < 4; ++j) { const f32x4 ww = wr[64 * j];
#pragma unroll
        for (int r = 0; r < 4; ++r) { u32x2 o; o.x = pg8::pk_f16(v[r][j].x * s[r] * ww.x, v[r][j].y * s[r] * ww.y); o.y = pg8::pk_f16(v[r][j].z * s[r] * ww.z, v[r][j].w * s[r] * ww.w); ((u32x2*)(o0 + r * rs) + lane)[64 * j] = o; } }
}
__device__ __forceinline__ void rms_row4_f32(float* x0, size_t rs, const float* w, int lane) {
    f32x4 v[4][4]; float s[4];
#pragma unroll
    for (int r = 0; r < 4; ++r)
#pragma unroll
        for (int j = 0; j < 4; ++j) v[r][j] = ((const f32x4*)(x0 + r * rs) + lane)[64 * j];
    const f32x4* wr = (const f32x4*)w + lane;
#pragma unroll
    for (int r = 0; r < 4; ++r) { float a = 0.f;
#pragma unroll
        for (int j = 0; j < 4; ++j) a += (v[r][j].x * v[r][j].x + v[r][j].y * v[r][j].y) + (v[r][j].z * v[r][j].z + v[r][j].w * v[r][j].w);
        s[r] = rsq_(wave_sum(a) * (1.0f / DM) + 1e-6f); }
#pragma unroll
    for (int j = 0; j < 4; ++j) { const f32x4 ww = wr[64 * j];
#pragma unroll
        for (int r = 0; r < 4; ++r) ((f32x4*)(x0 + r * rs) + lane)[64 * j] = v[r][j] * s[r] * ww; }
}

#define SHV(col) ({ const float cur_ = (float)urow[(col)]; const float prev_ = hp ? (float)prow[(col)] : 0.f; cur_ + mu[(col)] * (prev_ - cur_); })

__device__ __forceinline__ void store_row64_f16(f16* dst, const float (&S)[64]) {
#pragma unroll
    for (int q = 0; q < 8; ++q) { u32x4 w; w.x = pg8::pk_f16(S[8 * q], S[8 * q + 1]); w.y = pg8::pk_f16(S[8 * q + 2], S[8 * q + 3]); w.z = pg8::pk_f16(S[8 * q + 4], S[8 * q + 5]); w.w = pg8::pk_f16(S[8 * q + 6], S[8 * q + 7]); *(u32x4*)(dst + 8 * q) = w; }
}


constexpr int RWA_REC = 1040  , RWA_VROW = 136, RWA_VPL = 16 * RWA_REC, RWA_INV = RWA_VPL + 16 * RWA_VROW, RWA_BYTES = 18944;
constexpr int C_VD0 = 3712, C_VD1 = 3744;
constexpr int PRM_MU = 0, PRM_A0 = 1280, PRM_KK = 1664, PRM_KA = 2048, PRM_RK = 2432, PRM_V0 = 2816, PRM_HALVES = 3200, PRM_W0_BYTE = 6400, PRM_BYTES = PRM_W0_BYTE + 1536;
typedef float f32x2 __attribute__((ext_vector_type(2)));
typedef _Float16 f16x4 __attribute__((ext_vector_type(4)));
__device__ __forceinline__ float fmix_lo(float a, unsigned b, float c) { float d; asm("v_fma_mix_f32 %0, %1, %2, %3 op_sel:[0,0,0] op_sel_hi:[0,1,0]" : "=v"(d) : "v"(a), "v"(b), "v"(c)); return d; }
__device__ __forceinline__ float fmix_hi(float a, unsigned b, float c) { float d; asm("v_fma_mix_f32 %0, %1, %2, %3 op_sel:[0,1,0] op_sel_hi:[0,1,0]" : "=v"(d) : "v"(a), "v"(b), "v"(c)); return d; }
__device__ __forceinline__ float mmix_lo(float a, unsigned b) { float d; asm("v_fma_mix_f32 %0, %1, %2, 0 op_sel:[0,0,0] op_sel_hi:[0,1,0]" : "=v"(d) : "v"(a), "v"(b)); return d; }
__device__ __forceinline__ float mmix_hi(float a, unsigned b) { float d; asm("v_fma_mix_f32 %0, %1, %2, 0 op_sel:[0,1,0] op_sel_hi:[0,1,0]" : "=v"(d) : "v"(a), "v"(b)); return d; }
__device__ __forceinline__ float mul_asm(float a, float b) { float d; asm("v_mul_f32 %0, %1, %2" : "=v"(d) : "v"(a), "v"(b)); return d; }
__device__ __forceinline__ float fma_asm(float a, float b, float c) { float d; asm("v_fma_f32 %0, %1, %2, %3" : "=v"(d) : "v"(a), "v"(b), "v"(c)); return d; }
#define FMIX(a, u, j, c) (((j) & 1) ? fmix_hi((a), (u)[(j) >> 1], (c)) : fmix_lo((a), (u)[(j) >> 1], (c)))
#define MMIX(a, u, j) (((j) & 1) ? mmix_hi((a), (u)[(j) >> 1]) : mmix_lo((a), (u)[(j) >> 1]))
__device__ __forceinline__ float fast_tanh(float x) { return 1.0f - 2.0f * __builtin_amdgcn_rcpf(__expf(2.0f * x) + 1.0f); }
__device__ __forceinline__ void lerp8(const char* ub, unsigned uo, unsigned po, bool hp, const char* mub, unsigned col, float (&x)[8]) {
    const f16x8 cu = *(const f16x8*)(ub + (uo + col * 2u)); f16x8 pv = *(const f16x8*)(ub + (po + col * 2u)); const f32x4 m0 = *(const f32x4*)(mub + col * 4u), m1 = *(const f32x4*)(mub + col * 4u + 16u);
#pragma unroll
    for (int j = 0; j < 8; ++j) { const float c = (float)cu[j], p = hp ? (float)pv[j] : 0.f; x[j] = c + (j < 4 ? m0[j] : m1[j - 4]) * (p - c); }
}
__device__ __forceinline__ void lerp4(const char* ub, unsigned uo, unsigned po, bool hp, const char* mub, unsigned col, float (&x)[4]) {
    const f16x4 cu = *(const f16x4*)(ub + (uo + col * 2u)); f16x4 pv = *(const f16x4*)(ub + (po + col * 2u)); const f32x4 m0 = *(const f32x4*)(mub + col * 4u);
#pragma unroll
    for (int j = 0; j < 4; ++j) { const float c = (float)cu[j], p = hp ? (float)pv[j] : 0.f; x[j] = c + m0[j] * (p - c); }
}
__device__ __forceinline__ f16x8 pack8(const float (&x)[8]) { f16x8 r;
#pragma unroll
    for (int j = 0; j < 8; ++j) r[j] = (f16)x[j];
    return r; }

__device__ __forceinline__ void rwkv_waveA(const Args& a, int l, int b, int c, int h, LAS unsigned char* wl, const LAS unsigned char* prmb, int lane) {
    const LAS f16* prm = (const LAS f16*)prmb; const LAS float* prw0 = (const LAS float*)(prmb + PRM_W0_BYTE);
    const char* Ub = (const char*)(a.ws + WS_U); f16* MIX = (f16*)(a.ws + WS_MIX); char* VF = (char*)(a.ws + WS_VF); char* VP = (char*)(a.ws + WS_VP);
    f16* QT = (f16*)(a.ws + WS_QT); f16* PT = (f16*)(a.ws + WS_PT); f16* RL = (f16*)(a.ws + WS_RL); float* BONG = (float*)(a.ws + WS_BON);
    const char* WUPT = (const char*)(a.ws + WS_WUPT) + (size_t)l * 384 * 64 * 2; const char* AUPT = (const char*)(a.ws + WS_AUPT) + (size_t)l * 384 * 64 * 2;
    const char* VUPT = (const char*)(a.ws + WS_VUPT);
    const int bh = b * RW_H + h;
    float P[64], L[64];
#pragma unroll
    for (int k = 0; k < 64; ++k) { P[k] = (k == lane) ? 1.f : 0.f; L[k] = 0.f; }
#pragma unroll 1
    for (int blk = 0; blk < 4; ++blk) {
        const int lane_ = lane_now();
        const int tok = lane_ & 15, fq = lane_ >> 4;
        const int t = c * CH + blk * 16 + tok; const unsigned m = (unsigned)(b * SEQ + t); const bool hp = t > 0;
        const unsigned uo = m * (unsigned)(NU * 2), po = hp ? uo - (unsigned)(NU * 2) : uo;
        f16x8 cW[2], pW[2], cA[2], pA[2], vd0, vd1;
#pragma unroll
        for (int s = 0; s < 2; ++s) { const unsigned cw = (unsigned)(C_WL + 8 * fq + 32 * s) * 2u, ca = (unsigned)(C_AL + 8 * fq + 32 * s) * 2u;
            cW[s] = *(const f16x8*)(Ub + uo + cw); pW[s] = *(const f16x8*)(Ub + po + cw); cA[s] = *(const f16x8*)(Ub + uo + ca); pA[s] = *(const f16x8*)(Ub + po + ca); }
        if (l > 0) { vd0 = *(const f16x8*)(Ub + uo + (unsigned)(C_VD0 + 8 * fq) * 2u); vd1 = *(const f16x8*)(Ub + po + (unsigned)(C_VD1 + 8 * fq) * 2u); }
#define RW_TLOAD(X, nt) f16x8 X##wu0, X##wu1, X##au0, X##au1, X##vu; f16x4 X##cr, X##pr, X##ck, X##pk, X##cv, X##pv, X##vf; { \
            const unsigned n_ = (unsigned)(h * 64 + 16 * (nt) + tok), cb_ = (unsigned)(h * 64 + 16 * (nt) + 4 * fq); \
            X##wu0 = *(const f16x8*)(WUPT + (n_ * 64u + 8u * fq) * 2u); X##wu1 = *(const f16x8*)(WUPT + (n_ * 64u + 8u * fq + 32u) * 2u); \
            X##au0 = *(const f16x8*)(AUPT + (n_ * 64u + 8u * fq) * 2u); X##au1 = *(const f16x8*)(AUPT + (n_ * 64u + 8u * fq + 32u) * 2u); \
            if (l > 0) { X##vu = *(const f16x8*)(VUPT + (n_ * 32u + 8u * fq) * 2u); X##vf = *(const f16x4*)(VF + (m * (unsigned)RW_W + cb_) * 2u); } \
            X##cr = *(const f16x4*)(Ub + uo + ((unsigned)C_R + cb_) * 2u); X##pr = *(const f16x4*)(Ub + po + ((unsigned)C_R + cb_) * 2u); \
            X##ck = *(const f16x4*)(Ub + uo + ((unsigned)C_K + cb_) * 2u); X##pk = *(const f16x4*)(Ub + po + ((unsigned)C_K + cb_) * 2u); \
            X##cv = *(const f16x4*)(Ub + uo + ((unsigned)C_V + cb_) * 2u); X##pv = *(const f16x4*)(Ub + po + ((unsigned)C_V + cb_) * 2u); }
        f16x8 bW[2], bA[2], bVD;
#pragma unroll
        for (int s = 0; s < 2; ++s) { float xw[8], xa[8];
            const f16x8 mw = *(const LAS f16x8*)(prm + PRM_MU + C_WL + 8 * fq + 32 * s), ma = *(const LAS f16x8*)(prm + PRM_MU + C_AL + 8 * fq + 32 * s);
#pragma unroll
            for (int j = 0; j < 8; ++j) { const float cw_ = (float)cW[s][j], pw_ = hp ? (float)pW[s][j] : 0.f, ca_ = (float)cA[s][j], pa_ = hp ? (float)pA[s][j] : 0.f;
                xw[j] = fast_tanh(cw_ + (float)mw[j] * (pw_ - cw_)); xa[j] = ca_ + (float)ma[j] * (pa_ - ca_); }
            bW[s] = pack8(xw); bA[s] = pack8(xa); }
        if (l > 0) { float xv[8];
#pragma unroll
            for (int j = 0; j < 8; ++j) xv[j] = (float)vd0[j] + (hp ? (float)vd1[j] : 0.f);
            bVD = pack8(xv); }
        float ssq = 0.f, bon = 0.f;
        LAS unsigned char* rec = wl + tok * RWA_REC;
#define RW_TCOMP(X, nt) { const int cb = h * 64 + 16 * (nt) + 4 * fq, co = 16 * (nt) + 4 * fq; \
            f32x4 DWn = (f32x4){0.f, 0.f, 0.f, 0.f}, DAn = DWn, Gn = DWn; \
            DWn = __builtin_amdgcn_mfma_f32_16x16x32_f16(X##wu0, bW[0], DWn, 0, 0, 0); DWn = __builtin_amdgcn_mfma_f32_16x16x32_f16(X##wu1, bW[1], DWn, 0, 0, 0); \
            DAn = __builtin_amdgcn_mfma_f32_16x16x32_f16(X##au0, bA[0], DAn, 0, 0, 0); DAn = __builtin_amdgcn_mfma_f32_16x16x32_f16(X##au1, bA[1], DAn, 0, 0, 0); \
            if (l > 0) Gn = __builtin_amdgcn_mfma_f32_16x16x32_f16(X##vu, bVD, Gn, 0, 0, 0); \
            f32x4 wv, al, be; f16x4 km, rr, vo; \
            _Pragma("unroll") for (int i = 0; i < 4; ++i) { const LAS f16* pc = prm + cb + i; \
                const float cr_ = (float)X##cr[i], ck_ = (float)X##ck[i], cv_ = (float)X##cv[i]; \
                const float rs = cr_ + (float)pc[PRM_MU + C_R] * ((hp ? (float)X##pr[i] : 0.f) - cr_), ks = ck_ + (float)pc[PRM_MU + C_K] * ((hp ? (float)X##pk[i] : 0.f) - ck_), vs = cv_ + (float)pc[PRM_MU + C_V] * ((hp ? (float)X##pv[i] : 0.f) - cv_); \
                wv[i] = __expf(-0.6065306597126334f * sigmoidf_(prw0[cb + i] + DWn[i])); \
                const float aa = sigmoidf_((float)pc[PRM_A0] + DAn[i]); \
                float vv = vs; if (l > 0) vv = vs + ((float)X##vf[i] - vs) * sigmoidf_((float)pc[PRM_V0] + Gn[i]); \
                const float kk = ks * (float)pc[PRM_KK]; ssq += kk * kk; \
                const float kmod = ks * (1.0f + (aa - 1.0f) * (float)pc[PRM_KA]); \
                bon += rs * kmod * (float)pc[PRM_RK]; \
                al[i] = -kk; be[i] = kk * aa; km[i] = (f16)kmod; rr[i] = (f16)rs; vo[i] = (f16)vv; \
                asm volatile("" ::: "memory"); } \
            *(LAS f32x4*)(rec + co * 4) = wv; *(LAS f32x4*)(rec + 256 + co * 4) = al; *(LAS f32x4*)(rec + 512 + co * 4) = be; \
            *(LAS f16x4*)(rec + 768 + co * 2) = km; *(LAS f16x4*)(rec + 896 + co * 2) = rr; \
            *(LAS f16x4*)(wl + RWA_VPL + tok * RWA_VROW + co * 2) = vo; \
            *(f16x4*)(VP + (m * (unsigned)RW_W + (unsigned)cb) * 2u) = vo; \
            if (l == 0) *(f16x4*)(VF + (m * (unsigned)RW_W + (unsigned)cb) * 2u) = vo; }
#pragma unroll 1
        for (int nt = 0; nt < 4; ++nt) { RW_TLOAD(T0, nt) RW_TCOMP(T0, nt) asm volatile("" ::: "memory"); }
#undef RW_TLOAD
#undef RW_TCOMP
        ssq += shfl_xor_f(ssq, 16); ssq += shfl_xor_f(ssq, 32);
        bon += shfl_xor_f(bon, 16); bon += shfl_xor_f(bon, 32);
        { const float inv2v = __builtin_amdgcn_rcpf(fmaxf(ssq, 1e-24f));
          if (fq == 0) { *(LAS float*)(wl + RWA_INV + tok * 4) = inv2v; *(float*)((char*)BONG + (m * 8u + (unsigned)h) * 4u) = bon; } }
        const unsigned mb = (unsigned)(b * SEQ + c * CH + blk * 16);
        asm volatile("s_waitcnt lgkmcnt(0)" ::: "memory");
        f32x4 Aa[2], Ab[2], Ac[2];
#define RW_LDA(A, rcp, g) { A[0] = *(const LAS f32x4*)((rcp) + 256 + (g) * 32); A[1] = *(const LAS f32x4*)((rcp) + 256 + (g) * 32 + 16); }
#define RW_SA(A, g) { _Pragma("unroll") for (int j = 0; j < 8; ++j) sP[j] = fma_asm(P[8 * (g) + j], A[j >> 2][j & 3], sP[j]); \
                      _Pragma("unroll") for (int j = 0; j < 8; ++j) sL[j] = fma_asm(L[8 * (g) + j], A[j >> 2][j & 3], sL[j]); }
        RW_LDA(Aa, wl, 0) RW_LDA(Ab, wl, 1)
        float vv = (float)*(const LAS f16*)(wl + RWA_VPL + lane_ * 2); float inv2 = *(const LAS float*)(wl + RWA_INV);
#define RW_LDU(W, B, K4, R4, g) { W[0] = *(const LAS f32x4*)(rc + (g) * 32); W[1] = *(const LAS f32x4*)(rc + (g) * 32 + 16); B[0] = *(const LAS f32x4*)(rc + 512 + (g) * 32); B[1] = *(const LAS f32x4*)(rc + 512 + (g) * 32 + 16); K4 = *(const LAS u32x4*)(rc + 768 + (g) * 16); R4 = *(const LAS u32x4*)(rc + 896 + (g) * 16); }
#define RW_COMP(W, B, K4, R4, g) { float tP[8], tL[8]; \
            _Pragma("unroll") for (int j = 0; j < 8; ++j) tP[j] = mul_asm(saP, B[j >> 2][j & 3]); \
            _Pragma("unroll") for (int j = 0; j < 8; ++j) tL[j] = mul_asm(saL, B[j >> 2][j & 3]); \
            _Pragma("unroll") for (int j = 0; j < 8; ++j) tL[j] = FMIX(vv, K4, j, tL[j]); \
            _Pragma("unroll") for (int j = 0; j < 8; ++j) P[8 * (g) + j] = fma_asm(P[8 * (g) + j], W[j >> 2][j & 3], tP[j]); \
            _Pragma("unroll") for (int j = 0; j < 8; ++j) L[8 * (g) + j] = fma_asm(L[8 * (g) + j], W[j >> 2][j & 3], tL[j]); \
            _Pragma("unroll") for (int j = 0; j < 8; ++j) qa[j] = FMIX(P[8 * (g) + j], R4, j, qa[j]); \
            _Pragma("unroll") for (int j = 0; j < 8; ++j) ya[j] = FMIX(L[8 * (g) + j], R4, j, ya[j]); }
#pragma unroll 1
        for (int t2 = 0; t2 < 16; ++t2) {
            const LAS unsigned char* rc = wl + t2 * RWA_REC;
            f32x4 we[2], wo[2], be[2], bo[2]; u32x4 ke, re, ko, ro;
            RW_LDU(we, be, ke, re, 0)
            float sP[8], sL[8];
#pragma unroll
            for (int j = 0; j < 8; ++j) { sP[j] = 0.f; sL[j] = 0.f; }
            RW_LDA(Ac, rc, 2) RW_SA(Aa, 0)
            RW_LDA(Aa, rc, 3) RW_SA(Ab, 1)
            RW_LDA(Ab, rc, 4) RW_SA(Ac, 2)
            RW_LDA(Ac, rc, 5) RW_SA(Aa, 3)
            RW_LDA(Aa, rc, 6) RW_SA(Ab, 4)
            RW_LDA(Ab, rc, 7) RW_SA(Ac, 5)
            RW_SA(Aa, 6)
            RW_SA(Ab, 7)
            const float saP = inv2 * (((sP[0] + sP[1]) + (sP[2] + sP[3])) + ((sP[4] + sP[5]) + (sP[6] + sP[7]))), saL = inv2 * (((sL[0] + sL[1]) + (sL[2] + sL[3])) + ((sL[4] + sL[5]) + (sL[6] + sL[7])));
            float qa[8], ya[8];
#pragma unroll
            for (int j = 0; j < 8; ++j) { qa[j] = 0.f; ya[j] = 0.f; }
            RW_LDU(wo, bo, ko, ro, 1) RW_COMP(we, be, ke, re, 0)
            RW_LDU(we, be, ke, re, 2) RW_COMP(wo, bo, ko, ro, 1)
            RW_LDU(wo, bo, ko, ro, 3) RW_COMP(we, be, ke, re, 2)
            RW_LDU(we, be, ke, re, 4) RW_COMP(wo, bo, ko, ro, 3)
            RW_LDU(wo, bo, ko, ro, 5) RW_COMP(we, be, ke, re, 4)
            RW_LDU(we, be, ke, re, 6) RW_COMP(wo, bo, ko, ro, 5)
            RW_LDU(wo, bo, ko, ro, 7) RW_COMP(we, be, ke, re, 6)
            const float vvn = (float)*(const LAS f16*)(wl + RWA_VPL + ((t2 + 1) & 15) * RWA_VROW + lane_ * 2); const float inv2n = *(const LAS float*)(wl + RWA_INV + ((t2 + 1) & 15) * 4);
            RW_LDA(Aa, rc + RWA_REC, 0) RW_LDA(Ab, rc + RWA_REC, 1)
            RW_COMP(wo, bo, ko, ro, 7)
            vv = vvn; inv2 = inv2n;
            *(f16*)((char*)MIX + ((mb + t2) * (unsigned)DM + (unsigned)(h * 64 + lane_)) * 2u) = (f16)(((ya[0] + ya[1]) + (ya[2] + ya[3])) + ((ya[4] + ya[5]) + (ya[6] + ya[7])));
            *(f16*)((char*)QT + ((mb + t2) * (unsigned)RW_W + (unsigned)(h * 64 + lane_)) * 2u) = (f16)(((qa[0] + qa[1]) + (qa[2] + qa[3])) + ((qa[4] + qa[5]) + (qa[6] + qa[7])));
        }
#undef RW_LDA
#undef RW_SA
#undef RW_LDU
#undef RW_COMP
    }
    store_row64_f16(RL + (((size_t)bh * NCH + c) * 64 + lane) * 64, L);
    f16* pt = PT + ((size_t)bh * NCH + c) * 4096;
#pragma unroll
    for (int k = 0; k < 64; ++k) pt[k * 64 + lane] = (f16)P[k];
}

constexpr int HGA_REC = 768, HGA_TB = 8  , HGA_V = HGA_TB * HGA_REC, HGA_HEAD = HGA_V + HGA_TB * 128, HGA_BYTES = 2 * HGA_HEAD;
template <int NH>
__device__ __forceinline__ void hgrn_waveA(const Args& a, int l, int b, int c, int h0, LAS unsigned char* wl) {
    char* U = (char*)(a.ws + WS_U); char* MIX = (char*)(a.ws + WS_MIX); f16* HL = (f16*)(a.ws + WS_HL); float* DC = (float*)(a.ws + WS_DC);
    const float* lbr = a.in[16];
    float S[NH][64]; float dpr[NH];
#pragma unroll
    for (int j = 0; j < NH; ++j) { dpr[j] = 1.f;
#pragma unroll
        for (int k = 0; k < 64; ++k) S[j][k] = 0.f; }
#pragma unroll 1
    for (int blk = 0; blk < CH / HGA_TB; ++blk) {
        const int lane_ = lane_now();
        const unsigned mb = (unsigned)(b * SEQ + c * CH + blk * HGA_TB);
        {
            f16 fr[NH][HGA_TB], qr[NH][HGA_TB], vr[NH][HGA_TB];
#pragma unroll
            for (int j = 0; j < NH; ++j)
#pragma unroll
                for (int tk = 0; tk < HGA_TB; ++tk) { const char* ur = U + (mb + tk) * (unsigned)(NU * 2) + (unsigned)((h0 + j) * 64 + lane_) * 2u; fr[j][tk] = *(const f16*)(ur + C_HGF * 2); qr[j][tk] = *(const f16*)(ur + C_HGQ * 2); vr[j][tk] = *(const f16*)(ur + C_HGI * 2); }
#pragma unroll
            for (int j = 0; j < NH; ++j) { const int col = (h0 + j) * 64 + lane_;
                const float lb = (l == 0) ? 0.f : sigmoidf_(lbr[384 + col] - lbr[col]);
                float dp = dpr[j];
#pragma unroll
                for (int tk = 0; tk < HGA_TB; ++tk) {
                    const float f = lb + (1.0f - lb) * sigmoidf_((float)fr[j][tk]);
                    LAS unsigned char* rec = wl + j * HGA_HEAD + tk * HGA_REC;
                    *(LAS float*)(rec + lane_ * 4) = f; *(LAS float*)(rec + 256 + lane_ * 4) = 1.0f - f; *(LAS float*)(rec + 512 + lane_ * 4) = (float)qr[j][tk];
                    *(LAS f16*)(wl + j * HGA_HEAD + HGA_V + tk * 128 + lane_ * 2) = vr[j][tk];
                    dp *= f;
                    *(f16*)(U + (mb + tk) * (unsigned)(NU * 2) + (unsigned)(C_HGQ + col) * 2u) = (f16)((float)qr[j][tk] * dp);
                }
                dpr[j] = dp; }
        }
        asm volatile("s_waitcnt lgkmcnt(0)" ::: "memory");
#define HG_LD(F, K, Q, rcp, g) { F[0] = *(const LAS f32x4*)((rcp) + (g) * 32); F[1] = *(const LAS f32x4*)((rcp) + (g) * 32 + 16); K[0] = *(const LAS f32x4*)((rcp) + 256 + (g) * 32); K[1] = *(const LAS f32x4*)((rcp) + 256 + (g) * 32 + 16); \
            Q[0] = *(const LAS f32x4*)((rcp) + 512 + (g) * 32); Q[1] = *(const LAS f32x4*)((rcp) + 512 + (g) * 32 + 16); }
#define HG_COMP(Sx, vi, F, K, Q, g) { float tt[8]; \
            _Pragma("unroll") for (int jj = 0; jj < 8; ++jj) tt[jj] = mul_asm(vi, K[jj >> 2][jj & 3]); \
            _Pragma("unroll") for (int jj = 0; jj < 8; ++jj) Sx[8 * (g) + jj] = fma_asm(Sx[8 * (g) + jj], F[jj >> 2][jj & 3], tt[jj]); \
            _Pragma("unroll") for (int jj = 0; jj < 8; ++jj) oa[jj] = fma_asm(Sx[8 * (g) + jj], Q[jj >> 2][jj & 3], oa[jj]); }
#define HG_HEAD(Sx, vi, rcp, rcn, oo) { float oa[8]; _Pragma("unroll") for (int jj = 0; jj < 8; ++jj) oa[jj] = 0.f; \
            HG_LD(fo, ko, qo, rcp, 1) HG_COMP(Sx, vi, fe, ke, qe, 0) \
            HG_LD(fe, ke, qe, rcp, 2) HG_COMP(Sx, vi, fo, ko, qo, 1) \
            HG_LD(fo, ko, qo, rcp, 3) HG_COMP(Sx, vi, fe, ke, qe, 2) \
            HG_LD(fe, ke, qe, rcp, 4) HG_COMP(Sx, vi, fo, ko, qo, 3) \
            HG_LD(fo, ko, qo, rcp, 5) HG_COMP(Sx, vi, fe, ke, qe, 4) \
            HG_LD(fe, ke, qe, rcp, 6) HG_COMP(Sx, vi, fo, ko, qo, 5) \
            HG_LD(fo, ko, qo, rcp, 7) HG_COMP(Sx, vi, fe, ke, qe, 6) \
            HG_LD(fe, ke, qe, rcn, 0) HG_COMP(Sx, vi, fo, ko, qo, 7) \
            oo = ((oa[0] + oa[1]) + (oa[2] + oa[3])) + ((oa[4] + oa[5]) + (oa[6] + oa[7])); }
        f32x4 fe[2], ke[2], qe[2], fo[2], ko[2], qo[2];
        HG_LD(fe, ke, qe, wl, 0)
        f16 vh[NH], vn[NH];
#pragma unroll
        for (int j = 0; j < NH; ++j) vh[j] = *(const LAS f16*)(wl + j * HGA_HEAD + HGA_V + lane_ * 2);
#pragma unroll 1
        for (int t2 = 0; t2 < HGA_TB; ++t2) {
            const LAS unsigned char* rc = wl + t2 * HGA_REC;
#pragma unroll
            for (int j = 0; j < NH; ++j) vn[j] = *(const LAS f16*)(wl + j * HGA_HEAD + HGA_V + ((t2 + 1) & (HGA_TB - 1)) * 128 + lane_ * 2);
            float oo[NH];
#pragma unroll
            for (int j = 0; j < NH; ++j) { const float vi = (float)vh[j];
                const LAS unsigned char* rcp = rc + j * HGA_HEAD; const LAS unsigned char* rcn = (j + 1 < NH) ? rc + (j + 1) * HGA_HEAD : rc + HGA_REC;
                HG_HEAD(S[j], vi, rcp, rcn, oo[j]) }
            char* mo = MIX + ((mb + t2) * (unsigned)DM + (unsigned)(384 + h0 * 64 + lane_)) * 2u;
#pragma unroll
            for (int j = 0; j < NH; ++j) { *(f16*)(mo + 128 * j) = (f16)oo[j]; vh[j] = vn[j]; }
        }
#undef HG_LD
#undef HG_COMP
#undef HG_HEAD
    }
    const int lane2 = lane_now();
#pragma unroll
    for (int j = 0; j < NH; ++j) { const int bh = b * 6 + h0 + j; store_row64_f16(HL + (((size_t)bh * NCH + c) * 64 + lane2) * 64, S[j]);
        DC[((size_t)bh * NCH + c) * 64 + lane2] = dpr[j]; }
}

__device__ __forceinline__ void lru_waveA(const Args& a, int l, int b, int c, int g, LAS unsigned char* wl) {
    const int ln = lane_now();
    const char* Ub = (const char*)(a.ws + WS_U); char* MIXb = (char*)(a.ws + WS_MIX); char* CA = (char*)(a.ws + WS_CA); float* LA = (float*)(a.ws + WS_LA); float* LH = (float*)(a.ws + WS_LH);
    const float* cw = a.in[18] + l * 4 * 256 + g * 64; const float* cb = a.in[19] + l * 256 + g * 64;
    const float* ba = a.in[21] + l * 256 + g * 64; const float* bx = a.in[23] + l * 256 + g * 64; const float* lam = a.in[24] + l * 256 + g * 64;
    const char* WAT = (const char*)(a.ws + WS_WAT) + (size_t)(l * 4 + g) * 8192; const char* WXT = (const char*)(a.ws + WS_WXT) + (size_t)(l * 4 + g) * 8192;
    LAS unsigned char* Y = wl;
    const unsigned mrow0 = (unsigned)(b * SEQ + c * CH);
#pragma unroll 1
    for (int ib = 0; ib < 8; ib += 4) {
        f16x8 xr[4][4];
#pragma unroll
        for (int it = 0; it < 4; ++it) { const int item = ln + 64 * (ib + it), tok = item >> 3, co = item & 7; const int t = c * CH + tok;
#pragma unroll
            for (int jj = 0; jj < 4; ++jj) { const int ts = t - 3 + jj; const unsigned row = (ts >= 0) ? mrow0 + (unsigned)(tok - 3 + jj) : mrow0 + (unsigned)tok;
                xr[it][jj] = *(const f16x8*)(Ub + (row * (unsigned)NU + (unsigned)(C_LRUX + g * 64 + 8 * co)) * 2u); } }
#pragma unroll
        for (int it = 0; it < 4; ++it) { const int item = ln + 64 * (ib + it), tok = item >> 3, co = item & 7; const int t = c * CH + tok;
            const f32x4 b0 = *(const f32x4*)(cb + 8 * co), b1 = *(const f32x4*)(cb + 8 * co + 4);
            float y[8] = {b0[0], b0[1], b0[2], b0[3], b1[0], b1[1], b1[2], b1[3]};
#pragma unroll
            for (int jj = 0; jj < 4; ++jj) { const int ts = t - 3 + jj;
                if (ts >= 0) { const f32x4 w0 = *(const f32x4*)(cw + jj * 256 + 8 * co), w1 = *(const f32x4*)(cw + jj * 256 + 8 * co + 4);
#pragma unroll
                    for (int i = 0; i < 8; ++i) y[i] += (i < 4 ? w0[i & 3] : w1[i & 3]) * (float)xr[it][jj][i]; } }
            *(LAS f16x8*)(Y + tok * 144 + co * 16) = pack8(y); } }
    asm volatile("s_waitcnt lgkmcnt(0)" ::: "memory");
    const int tl = ln & 15, fq = ln >> 4;
    float sp[16], cy[16], cp[16];
#pragma unroll
    for (int nt = 0; nt < 4; ++nt) { const f32x4 lm4 = *(const f32x4*)(lam + 16 * nt + 4 * fq);
#pragma unroll
        for (int i = 0; i < 4; ++i) { sp[nt * 4 + i] = log1pf(__expf(-lm4[i])); cy[nt * 4 + i] = 0.f; cp[nt * 4 + i] = 1.f; } }
    f16x8 wfa[4][2], wfx[4][2];
#pragma unroll
    for (int nt = 0; nt < 4; ++nt)
#pragma unroll
        for (int s2 = 0; s2 < 2; ++s2) { const unsigned wo = (unsigned)(((16 * nt + (ln & 15)) * 64 + 8 * (ln >> 4) + 32 * s2) * 2); wfa[nt][s2] = *(const f16x8*)(WAT + wo); wfx[nt][s2] = *(const f16x8*)(WXT + wo); }
#pragma unroll 1
    for (int tt = 0; tt < 4; ++tt) {
        f16x8 by[2];
#pragma unroll
        for (int s2 = 0; s2 < 2; ++s2) by[s2] = *(const LAS f16x8*)(Y + (16 * tt + tl) * 144 + (8 * fq + 32 * s2) * 2);
        const unsigned m = mrow0 + (unsigned)(16 * tt + tl);
#pragma unroll
        for (int nt = 0; nt < 4; ++nt) {
            f32x4 ra = (f32x4){0.f, 0.f, 0.f, 0.f}, rx = ra;
#pragma unroll
            for (int s2 = 0; s2 < 2; ++s2) { ra = __builtin_amdgcn_mfma_f32_16x16x32_f16(wfa[nt][s2], by[s2], ra, 0, 0, 0); rx = __builtin_amdgcn_mfma_f32_16x16x32_f16(wfx[nt][s2], by[s2], rx, 0, 0, 0); }
            const int ch0 = 16 * nt + 4 * fq;
            const f32x4 ba4 = *(const f32x4*)(ba + ch0), bx4 = *(const f32x4*)(bx + ch0);
            const f16x4 y4 = *(const LAS f16x4*)(Y + (16 * tt + tl) * 144 + ch0 * 2);
            f16x4 ho, co;
#pragma unroll
            for (int i = 0; i < 4; ++i) { const int q = nt * 4 + i;
                const float r = sigmoidf_(ra[i] + ba4[i]), ig = sigmoidf_(rx[i] + bx4[i]);
                const float la = -8.0f * r * sp[q];
                float av = __expf(la), uv = sqrtf(one_minus_exp_(2.0f * la)) * (ig * (float)y4[i]);
#define LRU_SCAN(d) { const float ap = __builtin_bit_cast(float, __builtin_amdgcn_update_dpp(0x3f800000, __builtin_bit_cast(int, av), 0x110 + (d), 0xf, 0xf, false)); \
                      const float up = __builtin_bit_cast(float, __builtin_amdgcn_update_dpp(0, __builtin_bit_cast(int, uv), 0x110 + (d), 0xf, 0xf, false)); \
                      uv = av * up + uv; av = av * ap; }
                LRU_SCAN(1) LRU_SCAN(2) LRU_SCAN(4) LRU_SCAN(8)
#undef LRU_SCAN
                const float hl = uv + av * cy[q], ca = av * cp[q];
                ho[i] = (f16)hl; co[i] = (f16)ca;
                cy[q] = __builtin_bit_cast(float, __builtin_amdgcn_ds_bpermute((ln | 15) << 2, __builtin_bit_cast(int, hl)));
                cp[q] = __builtin_bit_cast(float, __builtin_amdgcn_ds_bpermute((ln | 15) << 2, __builtin_bit_cast(int, ca)));
            }
            *(f16x4*)(MIXb + (m * (unsigned)DM + 768u + (unsigned)(g * 64 + ch0)) * 2u) = ho; *(f16x4*)(CA + (m * 256u + (unsigned)(g * 64 + ch0)) * 2u) = co;
        }
    }
    if (tl == 15) {
#pragma unroll
        for (int q = 0; q < 16; ++q) { const int ch = g * 64 + 16 * (q >> 2) + 4 * fq + (q & 3); LA[((size_t)b * NCH + c) * 256 + ch] = cp[q]; LH[((size_t)b * NCH + c) * 256 + ch] = cy[q]; } }
}

__device__ __forceinline__ void phaseA(const Args& a, int l, int task, LAS unsigned char* lds, int tid) {
    asm volatile("" : "+v"(tid));
    const int lane = tid & 63, wave = __builtin_amdgcn_readfirstlane(tid >> 6);
    const int b = task / NCH, c = task % NCH;
    const f16* U = (const f16*)(a.ws + WS_U); f16* MIX = (f16*)(a.ws + WS_MIX); f16* VF = (f16*)(a.ws + WS_VF); f16* VP = (f16*)(a.ws + WS_VP);
    f16* QT = (f16*)(a.ws + WS_QT); f16* PT = (f16*)(a.ws + WS_PT); f16* RL = (f16*)(a.ws + WS_RL); float* BONG = (float*)(a.ws + WS_BON);
    {
        LAS f16* prm = (LAS f16*)(lds + PRM_OFF); LAS float* prw0 = (LAS float*)(lds + PRM_OFF + PRM_W0_BYTE);
        for (int i = tid; i < PRM_HALVES + 384; i += NT) {
            if (i < 1280) prm[i] = (f16)a.in[3][l * RW_SHIFT + i];
            else if (i < PRM_HALVES) { const int q = (i - 1280) / 384, cc = (i - 1280) % 384;
                prm[i] = (f16)((q == 0) ? a.in[6][l * RW_W + cc] : (q == 1) ? a.in[11][l * RW_W + cc] : (q == 2) ? a.in[12][l * RW_W + cc] : (q == 3) ? a.in[13][l * RW_W + cc] : a.in[8][cc]); }
            else prw0[i - PRM_HALVES] = a.in[4][l * RW_W + (i - PRM_HALVES)]; }
        __syncthreads();
        if (wave < RW_H) { rwkv_waveA(a, l, b, c, wave, lds + wave * RWA_BYTES, lds + PRM_OFF, lane);
                           if (wave < 4) lru_waveA(a, l, b, c, wave, lds + wave * RWA_BYTES); }
        else { LAS unsigned char* hw = lds + RW_H * RWA_BYTES + (wave - RW_H) * HGA_BYTES;
               hgrn_waveA<2>(a, l, b, c, 2 * (wave - RW_H), hw); hgrn_waveA<1>(a, l, b, c, 4 + (wave - RW_H), hw); }
        __syncthreads();
    }
}

constexpr int PB_SLOT = 16384, PB_NS = 8, PB_AHEAD = 6, NGRP = NCH / 8;
#define ARENA(ws, off) ((char*)(ws) + WS_U + (size_t)((off) >> 11) * (size_t)(NU * 2) + (size_t)((off) & 2047))
constexpr size_t AR_PGT = 0, AR_LG = 2u << 20, AR_SG = 4u << 20;
#define PB_SWZ(row, o) ((row) * 128 + (((((o) >> 4) ^ ((row) & 7)) << 4) | ((o) & 15)))
template <bool ADD_L>
__device__ __forceinline__ void pb_step(f32x4 (&Sacc)[4], const LAS unsigned char* sl, int xrow, int vl, int fq) {
    f16x8 Bhi[2], Blo[2];
#pragma unroll
    for (int mt = 0; mt < 4; ++mt)
#pragma unroll
        for (int i = 0; i < 4; ++i) { const f16 hi = (f16)Sacc[mt][i]; const f16 lo = (f16)(Sacc[mt][i] - (float)hi); Bhi[mt >> 1][4 * (mt & 1) + i] = hi; Blo[mt >> 1][4 * (mt & 1) + i] = lo; }
#pragma unroll
    for (int mt = 0; mt < 4; ++mt) {
        f32x4 d = (f32x4){0.f, 0.f, 0.f, 0.f};
        if (ADD_L) { const f16x4 l4 = *(const LAS f16x4*)(sl + 8192 + PB_SWZ(xrow, 32 * mt + 8 * fq)); d = (f32x4){(float)l4[0], (float)l4[1], (float)l4[2], (float)l4[3]}; }
#pragma unroll
        for (int s = 0; s < 2; ++s) { const u32x2 a0 = *(const LAS u32x2*)(sl + PB_SWZ(16 * mt + vl, 64 * s + 8 * fq)), a1 = *(const LAS u32x2*)(sl + PB_SWZ(16 * mt + vl, 64 * s + 32 + 8 * fq));
            u32x4 aw; aw.x = a0.x; aw.y = a0.y; aw.z = a1.x; aw.w = a1.y; const f16x8 af = __builtin_bit_cast(f16x8, aw);
            d = __builtin_amdgcn_mfma_f32_16x16x32_f16(af, Bhi[s], d, 0, 0, 0); d = __builtin_amdgcn_mfma_f32_16x16x32_f16(af, Blo[s], d, 0, 0, 0); }
        Sacc[mt] = d; }
}
__device__ __forceinline__ void pb_stage8(const Args& a, LAS unsigned char* lds, int bh, int c0, int wave, int lane) {
    const char* PT = (const char*)(a.ws + WS_PT) + ((size_t)bh * NCH + c0) * 8192; const char* RL = (const char*)(a.ws + WS_RL) + ((size_t)bh * NCH + c0) * 8192;
    const int lq = wave * 64 + lane, lrow = lq >> 3, lpp = lq & 7; const unsigned lsrc = (unsigned)(lrow * 128 + ((lpp ^ (lrow & 7)) << 4));
#pragma unroll
    for (int sl = 0; sl < 8; ++sl) { const unsigned so = (unsigned)(sl * PB_SLOT + wave * 1024); const size_t go = (size_t)sl * 8192 + lsrc;
        __builtin_amdgcn_global_load_lds((const unsigned*)(PT + go), (LAS unsigned*)(lds + so), 16, 0, 0);
        __builtin_amdgcn_global_load_lds((const unsigned*)(RL + go), (LAS unsigned*)(lds + so + 8192), 16, 0, 0); }
    asm volatile("s_waitcnt vmcnt(0)" ::: "memory");
    __builtin_amdgcn_s_barrier();
}
__device__ __forceinline__ void phaseB1(const Args& a, LAS unsigned char* lds, int tid) {
    asm volatile("" : "+v"(tid));
    const int lane = tid & 63, wave = __builtin_amdgcn_readfirstlane(tid >> 6);
    for (int task = blockIdx.x; task < 12 * NGRP; task += gridDim.x) {
        const int bh = task / NGRP, g = task % NGRP, c0 = 8 * g;
        pb_stage8(a, lds, bh, c0, wave, lane);
        const int vt = wave & 3, vl = lane & 15, fq = lane >> 4, xr = 16 * vt + vl;
        f32x4 X[4];
        if (wave < 4) {
#pragma unroll
            for (int mt = 0; mt < 4; ++mt) { const f16x4 l4 = *(const LAS f16x4*)(lds + 8192 + PB_SWZ(xr, 32 * mt + 8 * fq)); X[mt] = (f32x4){(float)l4[0], (float)l4[1], (float)l4[2], (float)l4[3]}; }
#pragma unroll 1
            for (int s = 1; s < 8; ++s) pb_step<true>(X, lds + s * PB_SLOT, xr, vl, fq);
#pragma unroll
            for (int mt = 0; mt < 4; ++mt) { f16x4 o;
#pragma unroll
                for (int i = 0; i < 4; ++i) o[i] = (f16)X[mt][i];
                *(f16x4*)ARENA(a.ws, AR_LG + ((size_t)bh * NGRP + g) * 8192 + (size_t)((xr * 64 + 16 * mt + 4 * fq) * 2)) = o; }
        } else {
#pragma unroll
            for (int mt = 0; mt < 4; ++mt)
#pragma unroll
                for (int i = 0; i < 4; ++i) X[mt][i] = (16 * mt + 4 * fq + i == xr) ? 1.f : 0.f;
#pragma unroll 1
            for (int s = 0; s < 8; ++s) pb_step<false>(X, lds + s * PB_SLOT, xr, vl, fq);
#pragma unroll
            for (int mt = 0; mt < 4; ++mt)
#pragma unroll
                for (int i = 0; i < 4; ++i) *(f16*)ARENA(a.ws, AR_PGT + ((size_t)bh * NGRP + g) * 8192 + (size_t)(((16 * mt + 4 * fq + i) * 64 + xr) * 2)) = (f16)X[mt][i];
        }
        asm volatile("s_waitcnt vmcnt(0) lgkmcnt(0)" ::: "memory");
        __builtin_amdgcn_s_barrier();
    }
}
__device__ __forceinline__ void phaseB3(const Args& a, LAS unsigned char* lds, int tid) {
    asm volatile("" : "+v"(tid));
    const int lane = tid & 63, wave = __builtin_amdgcn_readfirstlane(tid >> 6);
    for (int task = blockIdx.x; task < 12 * NGRP; task += gridDim.x) {
        const int bh = task / NGRP, g = task % NGRP, c0 = 8 * g;
        pb_stage8(a, lds, bh, c0, wave, lane);
        if (wave < 4) {
            const int vt = wave, vl = lane & 15, fq = lane >> 4, xr = 16 * vt + vl;
            char* RL = (char*)(a.ws + WS_RL) + ((size_t)bh * NCH + c0) * 8192;
            f32x4 X[4];
#pragma unroll
            for (int mt = 0; mt < 4; ++mt) { const f16x4 s4 = *(const f16x4*)ARENA(a.ws, AR_SG + ((size_t)bh * NGRP + g) * 8192 + (size_t)((xr * 64 + 16 * mt + 4 * fq) * 2)); X[mt] = (f32x4){(float)s4[0], (float)s4[1], (float)s4[2], (float)s4[3]}; }
#pragma unroll 1
            for (int s = 0; s < 8; ++s) {
#pragma unroll
                for (int mt = 0; mt < 4; ++mt) { f16x4 o;
#pragma unroll
                    for (int i = 0; i < 4; ++i) o[i] = (f16)X[mt][i];
                    *(f16x4*)(RL + (size_t)s * 8192 + (xr * 64 + 16 * mt + 4 * fq) * 2) = o; }
                if (s < 7) pb_step<true>(X, lds + s * PB_SLOT, xr, vl, fq);
            }
        }
        asm volatile("s_waitcnt vmcnt(0) lgkmcnt(0)" ::: "memory");
        __builtin_amdgcn_s_barrier();
    }
}
__device__ __forceinline__ void phaseB(const Args& a, LAS unsigned char* lds, int tid) {
    asm volatile("" : "+v"(tid));
    const int lane = tid & 63, wave = __builtin_amdgcn_readfirstlane(tid >> 6);
    const int bx = blockIdx.x;
    if (bx < 12) {
        const int bh = bx;
        const bool loader = wave >= 4;
        const int vt = wave & 3, vl = lane & 15, fq = lane >> 4, v = 16 * vt + vl;
        const int lq = (wave - 4) * 64 + lane, lrow = lq >> 3, lpp = lq & 7;
        const unsigned lsrc = (unsigned)(lrow * 128 + ((lpp ^ (lrow & 7)) << 4));
#define PB_ISSUE(cc) { const unsigned so = (unsigned)(((cc) & (PB_NS - 1)) * PB_SLOT) + (unsigned)((wave - 4) * 1024); const size_t go = ((size_t)bh * NGRP + (cc)) * 8192 + lsrc; \
            __builtin_amdgcn_global_load_lds((const unsigned*)ARENA(a.ws, AR_PGT + go), (LAS unsigned*)(lds + so), 16, 0, 0); \
            __builtin_amdgcn_global_load_lds((const unsigned*)ARENA(a.ws, AR_PGT + go + 4096), (LAS unsigned*)(lds + so + 4096), 16, 0, 0); \
            __builtin_amdgcn_global_load_lds((const unsigned*)ARENA(a.ws, AR_LG + go), (LAS unsigned*)(lds + so + 8192), 16, 0, 0); \
            __builtin_amdgcn_global_load_lds((const unsigned*)ARENA(a.ws, AR_LG + go + 4096), (LAS unsigned*)(lds + so + 12288), 16, 0, 0); }
        if (loader) {
#pragma unroll
            for (int cc = 0; cc < PB_AHEAD; ++cc) PB_ISSUE(cc)
            asm volatile("s_waitcnt vmcnt(20)" ::: "memory");
        }
        __builtin_amdgcn_s_barrier();
        f32x4 Sacc[4];
#pragma unroll
        for (int mt = 0; mt < 4; ++mt) Sacc[mt] = (f32x4){0.f, 0.f, 0.f, 0.f};
#pragma unroll 1
        for (int c = 0; c < NGRP; ++c) {
            if (loader) {
                if (c + PB_AHEAD < NGRP) { PB_ISSUE(c + PB_AHEAD) asm volatile("s_waitcnt vmcnt(20)" ::: "memory"); }
                else asm volatile("s_waitcnt vmcnt(0)" ::: "memory");
            } else {
#pragma unroll
                for (int mt = 0; mt < 4; ++mt) { f16x4 o;
#pragma unroll
                    for (int i = 0; i < 4; ++i) o[i] = (f16)Sacc[mt][i];
                    *(f16x4*)ARENA(a.ws, AR_SG + ((size_t)bh * NGRP + c) * 8192 + (size_t)((v * 64 + 16 * mt + 4 * fq) * 2)) = o; }
                pb_step<true>(Sacc, lds + (c & (PB_NS - 1)) * PB_SLOT, v, vl, fq);
                asm volatile("s_waitcnt lgkmcnt(0)" ::: "memory");
            }
            __builtin_amdgcn_s_barrier();
        }
#undef PB_ISSUE
        asm volatile("s_waitcnt vmcnt(0)" ::: "memory");
    } else if (bx < 12 + 96) {
        const int idx = (bx - 12) * NT + tid; const int bh = idx >> 12, e = idx & 4095, k = e & 63;
        f16* HL = (f16*)(a.ws + WS_HL); const float* DC = (const float*)(a.ws + WS_DC);
        float s = 0.f;
        for (int c0 = 0; c0 < NCH; c0 += 8) { float Lc[8], d[8];
#pragma unroll
            for (int j = 0; j < 8; ++j) { Lc[j] = (float)HL[((size_t)bh * NCH + c0 + j) * 4096 + e]; d[j] = DC[((size_t)bh * NCH + c0 + j) * 64 + k]; }
#pragma unroll
            for (int j = 0; j < 8; ++j) { HL[((size_t)bh * NCH + c0 + j) * 4096 + e] = (f16)s; s = d[j] * s + Lc[j]; } }
    } else if (bx == 12 + 96) {
        const int bb = tid >> 8, ch = tid & 255; const float* LA = (const float*)(a.ws + WS_LA); float* LH = (float*)(a.ws + WS_LH);
        float cy = 0.f;
        for (int c0 = 0; c0 < NCH; c0 += 8) { float A[8], H[8];
#pragma unroll
            for (int j = 0; j < 8; ++j) { const size_t o = ((size_t)bb * NCH + c0 + j) * 256 + ch; A[j] = LA[o]; H[j] = LH[o]; }
#pragma unroll
            for (int j = 0; j < 8; ++j) { const size_t o = ((size_t)bb * NCH + c0 + j) * 256 + ch; LH[o] = cy; cy = A[j] * cy + H[j]; } }
    }
}

__device__ __forceinline__ void phaseC(const Args& a, int l, int task, LAS unsigned char* lds, int tid) {
    asm volatile("" : "+v"(tid));
    const int lane = tid & 63, wave = __builtin_amdgcn_readfirstlane(tid >> 6);
    const int b = task / NCH, c = task % NCH;
    const int tl = lane & 15, fq = lane >> 4, tt = wave & 3, hg = wave >> 2;
    const unsigned m = (unsigned)(b * SEQ + c * CH + 16 * tt + tl);
    const char* U = (const char*)(a.ws + WS_U); char* MIX = (char*)(a.ws + WS_MIX); const char* VP = (const char*)(a.ws + WS_VP);
    const char* QT = (const char*)(a.ws + WS_QT); const char* RL = (const char*)(a.ws + WS_RL); const char* HL = (const char*)(a.ws + WS_HL); const float* BONG = (const float*)(a.ws + WS_BON);
    const unsigned uo = m * (unsigned)(NU * 2);
#pragma unroll
    for (int hh = 0; hh < 3; ++hh) {
        const int h = 3 * hg + hh; const int bh = b * RW_H + h;
        const char* sl = RL + ((size_t)bh * NCH + c) * 8192;
        f16x8 bq[2];
#pragma unroll
        for (int s = 0; s < 2; ++s) bq[s] = *(const f16x8*)(QT + (m * (unsigned)RW_W + (unsigned)(h * 64 + 8 * fq + 32 * s)) * 2u);
        f32x4 D[4];
#pragma unroll
        for (int vt = 0; vt < 4; ++vt) { const f16x4 yl = *(const f16x4*)(MIX + (m * (unsigned)DM + (unsigned)(h * 64 + 16 * vt + 4 * fq)) * 2u);
            f32x4 d = (f32x4){(float)yl[0], (float)yl[1], (float)yl[2], (float)yl[3]};
#pragma unroll
            for (int s = 0; s < 2; ++s) d = __builtin_amdgcn_mfma_f32_16x16x32_f16(*(const f16x8*)(sl + ((16 * vt + tl) * 64 + 8 * fq + 32 * s) * 2), bq[s], d, 0, 0, 0);
            D[vt] = d; }
        float sm = 0.f;
#pragma unroll
        for (int vt = 0; vt < 4; ++vt) sm += (D[vt][0] + D[vt][1]) + (D[vt][2] + D[vt][3]);
        sm += shfl_xor_f(sm, 16); sm += shfl_xor_f(sm, 32);
        const float mean = sm * (1.0f / 64.0f); float vr = 0.f;
#pragma unroll
        for (int vt = 0; vt < 4; ++vt)
#pragma unroll
            for (int i = 0; i < 4; ++i) { const float d = D[vt][i] - mean; vr += d * d; }
        vr += shfl_xor_f(vr, 16); vr += shfl_xor_f(vr, 32);
        const float rstd = rsq_(vr * (1.0f / 64.0f) + 64e-5f);
        const float bon = BONG[m * 8u + (unsigned)h];
        const float* ln_w = a.in[14] + l * RW_W; const float* ln_b = a.in[15] + l * RW_W;
#pragma unroll
        for (int vt = 0; vt < 4; ++vt) { const unsigned col = (unsigned)(h * 64 + 16 * vt + 4 * fq);
            const f16x4 vp = *(const f16x4*)(VP + (m * (unsigned)RW_W + col) * 2u), z4 = *(const f16x4*)(U + uo + ((unsigned)C_RWZ + col) * 2u);
            const f32x4 lw = *(const f32x4*)(ln_w + col), lb = *(const f32x4*)(ln_b + col);
            f16x4 o;
#pragma unroll
            for (int i = 0; i < 4; ++i) o[i] = (f16)(((D[vt][i] - mean) * rstd * lw[i] + lb[i] + bon * (float)vp[i]) * siluf_((float)z4[i]));
            *(f16x4*)(MIX + (m * (unsigned)DM + col) * 2u) = o; }
    }
#pragma unroll
    for (int hh = 0; hh < 3; ++hh) {
        const int h = 3 * hg + hh; const int bh = b * 6 + h;
        const char* sl = HL + ((size_t)bh * NCH + c) * 8192;
        f16x8 bq[2];
#pragma unroll
        for (int s = 0; s < 2; ++s) bq[s] = *(const f16x8*)(U + uo + (unsigned)(C_HGQ + h * 64 + 8 * fq + 32 * s) * 2u);
        f32x4 D[4];
#pragma unroll
        for (int vt = 0; vt < 4; ++vt) { const f16x4 ol = *(const f16x4*)(MIX + (m * (unsigned)DM + (unsigned)(384 + h * 64 + 16 * vt + 4 * fq)) * 2u);
            f32x4 d = (f32x4){(float)ol[0], (float)ol[1], (float)ol[2], (float)ol[3]};
#pragma unroll
            for (int s = 0; s < 2; ++s) d = __builtin_amdgcn_mfma_f32_16x16x32_f16(*(const f16x8*)(sl + ((16 * vt + tl) * 64 + 8 * fq + 32 * s) * 2), bq[s], d, 0, 0, 0);
            D[vt] = d; }
        float ss = 0.f;
#pragma unroll
        for (int vt = 0; vt < 4; ++vt) ss += (D[vt][0] * D[vt][0] + D[vt][1] * D[vt][1]) + (D[vt][2] * D[vt][2] + D[vt][3] * D[vt][3]);
        ss += shfl_xor_f(ss, 16); ss += shfl_xor_f(ss, 32);
        const float rs = rsq_(ss * (1.0f / 64.0f) + 1e-6f);
        const float* nw = a.in[17] + l * 384;
#pragma unroll
        for (int vt = 0; vt < 4; ++vt) { const unsigned col = (unsigned)(h * 64 + 16 * vt + 4 * fq);
            const f16x4 z4 = *(const f16x4*)(U + uo + ((unsigned)C_HGZ + col) * 2u); const f32x4 w4 = *(const f32x4*)(nw + col);
            f16x4 o;
#pragma unroll
            for (int i = 0; i < 4; ++i) o[i] = (f16)(D[vt][i] * rs * w4[i] * siluf_((float)z4[i]));
            *(f16x4*)(MIX + (m * (unsigned)DM + 384u + col) * 2u) = o; }
    }
    {
        const char* CA = (const char*)(a.ws + WS_CA); const float* LH = (const float*)(a.ws + WS_LH) + ((size_t)b * NCH + c) * 256;
#pragma unroll
        for (int q = 0; q < 4; ++q) { const unsigned ch0 = (unsigned)(128 * hg + 32 * fq + 8 * q);
            const f16x8 hl = *(const f16x8*)(MIX + (m * (unsigned)DM + 768u + ch0) * 2u), ca = *(const f16x8*)(CA + (m * 256u + ch0) * 2u), z8 = *(const f16x8*)(U + uo + ((unsigned)C_LRUZ + ch0) * 2u);
            const f32x4 c0 = *(const f32x4*)(LH + ch0), c1 = *(const f32x4*)(LH + ch0 + 4);
            f16x8 o;
#pragma unroll
            for (int i = 0; i < 8; ++i) o[i] = (f16)(((float)hl[i] + (float)ca[i] * (i < 4 ? c0[i & 3] : c1[i & 3])) * siluf_((float)z8[i]));
            *(f16x8*)(MIX + (m * (unsigned)DM + 768u + ch0) * 2u) = o; }
    }
}
#define XB_TMO      128
#define XB_XCNT(j)  (256  + 64 * (j))
#define XB_XSUB(j)  (1280 + 64 * (j))
#define XB_XGEN(j)  (2304 + 64 * (j))
#define XB_TOP      3328
#define XB_TOPGEN   3392
#define XCD_BAR_WORDS 3456
#define XB_SPIN_CAP (1u << 18)

__device__ __forceinline__ unsigned xb_ld(unsigned* p)              { return __hip_atomic_load(p, __ATOMIC_RELAXED, __HIP_MEMORY_SCOPE_AGENT); }
__device__ __forceinline__ unsigned xb_add(unsigned* p, unsigned v) { return __hip_atomic_fetch_add(p, v, __ATOMIC_RELAXED, __HIP_MEMORY_SCOPE_AGENT); }
__device__ __forceinline__ unsigned xb_xcc_id() { return (unsigned)__builtin_amdgcn_s_getreg((3 << 11) | 20) & 0xFu; }
#define XB_SPIN(cond, bar) do { unsigned _sp = 0; while (cond) { __builtin_amdgcn_s_sleep(1); \
    if ((++_sp & 255u) == 0u) { if (xb_ld(&(bar)[XB_TMO])) break; if (_sp > XB_SPIN_CAP) { atomicAdd(&(bar)[XB_TMO], 1u); break; } } } } while (0)

struct XcdBarrier {
    unsigned* bar; unsigned x; int isw0;
    volatile LAS unsigned* st;
};

__device__ __forceinline__ XcdBarrier xcd_barrier_post(unsigned* bar, volatile LAS unsigned* st, int isw0) {
    XcdBarrier b; b.bar = bar; b.x = xb_xcc_id(); b.st = st; b.isw0 = isw0;
    if (isw0 && lane_now() == 0) (void)xb_add(&bar[XB_XCNT(b.x)], 1u);
    return b;
}
__device__ __forceinline__ void xcd_barrier_complete(unsigned* bar, unsigned x, unsigned& nloc, unsigned& nx) {
    const unsigned G = gridDim.x * gridDim.y * gridDim.z;
    unsigned sum, cnt, mine, sp = 0u;
    for (;;) {
        sum = 0u; cnt = 0u; mine = 0u;
#pragma unroll
        for (unsigned j = 0; j < 16; ++j) { const unsigned c = xb_ld(&bar[XB_XCNT(j)]); sum += c; cnt += (c > 0u) ? 1u : 0u; mine = (j == x) ? c : mine; }
        if (sum == G) break;
        __builtin_amdgcn_s_sleep(1);
        if ((++sp & 255u) == 0u) { if (xb_ld(&bar[XB_TMO])) break; if (sp > XB_SPIN_CAP) { atomicAdd(&bar[XB_TMO], 1u); break; } }
    }
    nloc = mine > 0u ? mine : 1u; nx = cnt > 0u ? cnt : 1u;
}

__device__ __forceinline__ void xcd_barrier(const XcdBarrier& b) {
    asm volatile("s_waitcnt vmcnt(0)" ::: "memory");
    __syncthreads();
    if (b.isw0 && lane_now() == 0) {
        unsigned* bar = b.bar;
        __builtin_amdgcn_s_waitcnt(0);
        unsigned nloc = b.st[0], nx = b.st[1];
        if (nloc == 0u) { xcd_barrier_complete(bar, b.x, nloc, nx); b.st[0] = nloc; b.st[1] = nx; }
        const unsigned old = xb_add(&bar[XB_XSUB(b.x)], 1u);
        const unsigned gen = old / nloc;
        if (old + 1u == (gen + 1u) * nloc) {
            __builtin_amdgcn_fence(__ATOMIC_RELEASE, "agent");
            asm volatile("s_waitcnt vmcnt(0)" ::: "memory");
            const unsigned og = xb_add(&bar[XB_TOP], 1u);
            const unsigned tg = og / nx;
            if (og + 1u == (tg + 1u) * nx) xb_add(&bar[XB_TOPGEN], 1u);
            else XB_SPIN(xb_ld(&bar[XB_TOPGEN]) == tg, bar);
            __builtin_amdgcn_fence(__ATOMIC_ACQUIRE, "agent");
            xb_add(&bar[XB_XGEN(b.x)], 1u);
            asm volatile("s_waitcnt vmcnt(0)" ::: "memory");
        } else {
            XB_SPIN(xb_ld(&bar[XB_XGEN(b.x)]) == gen, bar);
            __builtin_amdgcn_fence(__ATOMIC_ACQUIRE, "agent");
            asm volatile("s_waitcnt vmcnt(0)" ::: "memory");
        }
    }
    __syncthreads();
}

constexpr size_t WS_BAR = 16384;
constexpr int MISC_OFF = LDS_BYTES - 16;
__global__ void __launch_bounds__(NT, 2) fwd(Args args) {
    extern __shared__ __attribute__((aligned(16))) unsigned char lds_raw[];
    LAS unsigned char* lds = (LAS unsigned char*)lds_raw;
    cg::grid_group grid = cg::this_grid();
    const int wave = __builtin_amdgcn_readfirstlane((int)threadIdx.x >> 6);
#define TID_NOW() (wave * 64 + lane_now())
    const int tid = TID_NOW(); const int lane = tid & 63;
    if (wave == 0 && lane < 4) ((LAS unsigned*)(lds + MISC_OFF))[lane] = 0u;
    __syncthreads();
    XcdBarrier xbar = xcd_barrier_post((unsigned*)(args.ws + WS_BAR), (volatile LAS unsigned*)(lds + MISC_OFF), __builtin_amdgcn_readfirstlane(wave == 0 ? 1 : 0));
#define GRID_BAR() do { XcdBarrier xb_ = xbar; xb_.st = (volatile LAS unsigned*)(lds + MISC_OFF); asm volatile("" : "+s"(xb_.bar), "+s"(xb_.x)); xcd_barrier(xb_); } while (0)
    const int G = gridDim.x, gw = blockIdx.x * NWAVES + wave, NGW = G * NWAVES;
    unsigned char* ws = args.ws;
    unsigned short* XN = (unsigned short*)(ws + WS_XN);
    {
        LAS float* scr = (LAS float*)(lds + wave * 8704);
        constexpr int I_IN = (DM / 64) * (NIN / 32), I_OUT = (DM / 64) * (DM / 32), NITEMS = DEPTH * (I_IN + I_OUT);
        for (int it = gw; it < NITEMS; it += NGW) {
            int r = it; const int l = r / (I_IN + I_OUT); r -= l * (I_IN + I_OUT);
            if (r < I_IN) p0_transpose_item(args.in[2] + (size_t)l * DM * NIN, DM, NIN, (unsigned short*)(ws + WS_WIN + l * WIN_L), scr, r, lane, l == 0 ? nullptr : args.in[1] + DM);
            else p0_transpose_item(args.in[25] + (size_t)l * DM * DM, DM, DM, (unsigned short*)(ws + WS_WOUT + l * WOUT_L), scr, r - I_IN, lane, nullptr);
        }
        for (int i = gw; i < DEPTH * (NU - NIN) * DM * 2 / 1024; i += NGW) { const int l = i / ((NU - NIN) * DM * 2 / 1024), r = i % ((NU - NIN) * DM * 2 / 1024);
            if (l == 1 && r < 64 * DM * 2 / 1024) continue;
            *(u32x4*)(ws + WS_WIN + l * WIN_L + (size_t)NIN * DM * 2 + (size_t)r * 1024 + lane * 16) = (u32x4){0u, 0u, 0u, 0u}; }
        if (blockIdx.x < 32) {
            LAS f16* TT = (LAS f16*)(lds + 8 * 8704);
            for (int i = tid; i < 64 * RW_W; i += NT) { const int n = i / RW_W, cc = i % RW_W; const float mm = args.in[3][RW_SHIFT + C_V + cc]; TT[n * 392 + cc] = (f16)(((n < 32) ? (1.0f - mm) : mm) * args.in[9][cc * 32 + (n & 31)]); }
            __syncthreads();
            const int tile = blockIdx.x * NWAVES + wave, nt = tile & 3, kt = tile >> 2, tl = lane & 15, fq = lane >> 4;
            const float* wrow = args.in[2] + (size_t)DM * NIN + (size_t)(16 * kt + tl) * NIN + C_V + 8 * fq;
            f32x4 bv[12][2];
#pragma unroll
            for (int s2 = 0; s2 < 12; ++s2) { bv[s2][0] = *(const f32x4*)(wrow + 32 * s2); bv[s2][1] = *(const f32x4*)(wrow + 32 * s2 + 4); }
            f32x4 d = (f32x4){0.f, 0.f, 0.f, 0.f};
#pragma unroll
            for (int s2 = 0; s2 < 12; ++s2) { f16x8 bf;
#pragma unroll
                for (int j = 0; j < 8; ++j) bf[j] = (f16)(j < 4 ? bv[s2][0][j & 3] : bv[s2][1][j & 3]);
                d = __builtin_amdgcn_mfma_f32_16x16x32_f16(*(const LAS f16x8*)(TT + (16 * nt + tl) * 392 + 8 * fq + 32 * s2), bf, d, 0, 0, 0); }
            const float nwk = args.in[1][DM + 16 * kt + tl];
#pragma unroll
            for (int i = 0; i < 4; ++i) ((f16*)(ws + WS_WIN + WIN_L))[(size_t)(NIN + 16 * nt + 4 * fq + i) * DM + 16 * kt + tl] = (f16)(d[i] * nwk);
            __syncthreads();
        }
        for (int i = blockIdx.x * NT + tid; i < M; i += G * NT) ((float*)(ws + WS_RSS))[i] = 0.f;
        for (int m = gw; m < M; m += 4 * NGW) rms_row4_f16(args.in[0] + (size_t)m * DM, (size_t)NGW * DM, args.in[1], XN + (size_t)m * DM, lane);
        { f16* WUPT = (f16*)(ws + WS_WUPT); f16* AUPT = (f16*)(ws + WS_AUPT); f16* VDNT = (f16*)(ws + WS_VDNT); f16* VUPT = (f16*)(ws + WS_VUPT);
          for (int i = blockIdx.x * NT + tid; i < 122880; i += G * NT) {
              if (i < 49152) { const int ll = i / 24576, r = i % 24576, n = r / 64, k = r % 64; WUPT[i] = (f16)args.in[5][(size_t)ll * 24576 + k * 384 + n]; }
              else if (i < 98304) { const int i2 = i - 49152, ll = i2 / 24576, r = i2 % 24576, n = r / 64, k = r % 64; AUPT[i2] = (f16)args.in[7][(size_t)ll * 24576 + k * 384 + n]; }
              else if (i < 110592) { const int i2 = i - 98304, j2 = i2 / 384, cc = i2 % 384; VDNT[i2] = (f16)args.in[9][cc * 32 + j2]; }
              else { const int i2 = i - 110592, n = i2 / 32, j2 = i2 % 32; VUPT[i2] = (f16)args.in[10][j2 * 384 + n]; } }
          f16* WAT = (f16*)(ws + WS_WAT); f16* WXT = (f16*)(ws + WS_WXT);
          for (int i = blockIdx.x * NT + tid; i < 32768; i += G * NT) { const int lg = i >> 12, r = i & 4095, j = r >> 6, ii = r & 63; WAT[i] = (f16)args.in[20][(size_t)lg * 4096 + ii * 64 + j]; WXT[i] = (f16)args.in[22][(size_t)lg * 4096 + ii * 64 + j]; } }
    }
    if (gridDim.x > 65536u) grid.sync();
    GRID_BAR();
#pragma unroll 1
    for (int l = 0; l < DEPTH; ++l) {
        { pg8::Gemm g{XN, (const unsigned short*)(ws + WS_WIN + l * WIN_L), M, NU, DM}; pg8::StaticOrder S; S.init(M, NU, G, (int)blockIdx.x);
          pg8::EpiF16 E{(unsigned short*)(ws + WS_U), NU, l == 0 ? nullptr : (const float*)(ws + WS_RSS)};
          pg8::gemm_phase<pg8::EpiF16, pg8::StaticOrder, true, true>(lds, g, S, E, wave); }
        GRID_BAR();
        for (int task = blockIdx.x; task < BATCH * NCH; task += G) phaseA(args, l, task, lds, TID_NOW());
        GRID_BAR();
        phaseB1(args, lds, TID_NOW());
        GRID_BAR();
        phaseB(args, lds, TID_NOW());
        GRID_BAR();
        phaseB3(args, lds, TID_NOW());
        GRID_BAR();
        for (int task = blockIdx.x; task < BATCH * NCH; task += G) phaseC(args, l, task, lds, TID_NOW());
        GRID_BAR();
        { pg8::Gemm g{(const unsigned short*)(ws + WS_MIX), (const unsigned short*)(ws + WS_WOUT + l * WOUT_L), M, DM, DM}; pg8::StaticOrder S; S.init(M, DM, G, (int)blockIdx.x);
          pg8::EpiRes E{l == 0 ? args.in[0] : args.out, args.out, DM, l == 0 ? XN : nullptr, (float*)(ws + WS_RSS)};
          pg8::gemm_phase<pg8::EpiRes, pg8::StaticOrder, true, true>(lds, g, S, E, wave); }
        GRID_BAR();
        { int ln = TID_NOW() & 63; asm volatile("" : "+v"(ln));
          if (l + 1 < DEPTH) { }
          else { for (int m = gw; m < M; m += 4 * NGW) rms_row4_f32(args.out + (size_t)m * DM, (size_t)NGW * DM, args.in[26], ln); } }
    }
}

extern "C" void kernel_launch(void* const* d_in, const int* in_sizes, int n_in, void* d_out, int out_size, void* d_ws, size_t ws_size, hipStream_t stream) {
    static int grid = 0;
    if (grid == 0) {
        if (n_in != 27 || in_sizes[0] != M * DM || out_size != M * DM || ws_size < WS_END) { fprintf(stderr, "kernel_launch: unexpected problem: n_in %d in0 %d out %d ws %zu\n", n_in, n_in > 0 ? in_sizes[0] : -1, out_size, ws_size); grid = -1; return; }
        int dev = 0, cus = 0, per_cu = 0;
        hipGetDevice(&dev); hipDeviceGetAttribute(&cus, hipDeviceAttributeMultiprocessorCount, dev);
        if (hipFuncSetAttribute((const void*)fwd, hipFuncAttributeMaxDynamicSharedMemorySize, LDS_BYTES) != hipSuccess) { fprintf(stderr, "kernel_launch: hipFuncSetAttribute failed\n"); grid = -1; return; }
        if (hipOccupancyMaxActiveBlocksPerMultiprocessor(&per_cu, (const void*)fwd, NT, LDS_BYTES) != hipSuccess || per_cu < 1) { fprintf(stderr, "kernel_launch: occupancy query failed (%d)\n", per_cu); grid = -1; return; }
        grid = cus * per_cu;
    }
    if (grid < 0) return;
    if (hipMemsetAsync((char*)d_ws, 0, 65536, stream) != hipSuccess) { fprintf(stderr, "kernel_launch: memset of the barrier words failed\n"); return; }
    Args a{};
    for (int i = 0; i < 27; ++i) a.in[i] = (const float*)d_in[i];
    a.out = (float*)d_out; a.ws = (unsigned char*)d_ws;
    void* kargs[] = {&a};
    hipError_t e = hipLaunchCooperativeKernel((const void*)fwd, dim3(grid), dim3(NT), kargs, LDS_BYTES, stream);
    if (e != hipSuccess) fprintf(stderr, "cooperative launch failed: %s (grid %d)\n", hipGetErrorString(e), grid);
}
```

```cpp
#include <hip/hip_runtime.h>
#include <hip/hip_cooperative_groups.h>
#include <cstdio>
#include <cstdint>
namespace cg = cooperative_groups;
typedef _Float16 f16x8_t __attribute__((ext_vector_type(8)));
#define MK_MFMA(a, b, c) __builtin_amdgcn_mfma_f32_16x16x32_f16(__builtin_bit_cast(f16x8_t, (a)), __builtin_bit_cast(f16x8_t, (b)), (c), 0, 0, 0)
__device__ __forceinline__ int lane_now() { int z; asm volatile("v_mbcnt_lo_u32_b32 %0, -1, 0\n\tv_mbcnt_hi_u32_b32 %0, -1, %0" : "=v"(z)); return z; }
__device__ __forceinline__ float shfl_xor_f(float v, int mask) { const int ln = lane_now(); return __builtin_bit_cast(float, __builtin_amdgcn_ds_bpermute((ln ^ mask) << 2, __builtin_bit_cast(int, v))); }
namespace pg8 {
#define PG8_LAS __attribute__((address_space(3)))
typedef unsigned short bf16_t;
typedef short bf16x8 __attribute__((ext_vector_type(8)));
typedef float f32x4 __attribute__((ext_vector_type(4)));
typedef unsigned u32x4 __attribute__((ext_vector_type(4)));
constexpr int BM = 256, BK = 64, HALF = 128, HTB = HALF * BK * 2  , STAGE_BYTES = 8 * HTB, NXCD = 8, WGM = 8;

__host__ __device__ __forceinline__ int lds_byte(int r, int c) { const int st = (r >> 4) * 2 + (c >> 5), rr = r & 15, cc = c & 31, ob = rr * 64 + cc * 2; return st * 1024 + (ob ^ (((ob >> 9) & 1) << 5)); }
__host__ __device__ __forceinline__ void stage_rc(int b, int& R, int& C) { const int st = b / 1024, sb = b % 1024, swz = sb ^ (((sb >> 9) & 1) << 5); R = (st >> 1) * 16 + swz / 64; C = (st & 1) * 32 + (swz % 64) / 2; }
__host__ __device__ __forceinline__ int perm32(int rho) { const int n = rho >> 4, i = rho & 15; return 8 * (i >> 2) + 4 * n + (i & 3); }

struct Unit { int pm, pn; };
struct Gemm { const bf16_t* A; const bf16_t* Bt; int M, N, K; };

struct StaticOrder {
    int nM, nN, nwg, G, c;
    __host__ __device__ void init(int M, int N, int G_, int c_) { nM = M / BM; nN = N / BM; nwg = nM * nN; G = G_; c = c_; }
    __host__ __device__ bool next(int i, Unit& u) const {
        const long L = (long)i * G + c; if (L >= nwg) return false;
        int wgid = (int)L; { const int q = nwg / NXCD, r = nwg % NXCD, xcd = wgid % NXCD, off = wgid / NXCD; wgid = (xcd < r ? xcd * (q + 1) : r * (q + 1) + (xcd - r) * q) + off; }
        const int nig = WGM * nN, gid = wgid / nig, fm = gid * WGM, gsz = (nM - fm) < WGM ? (nM - fm) : WGM;
        u.pm = fm + ((wgid % nig) % gsz); u.pn = (wgid % nig) / gsz; return true;
    }
    __device__ __forceinline__ void a_ready(const Unit&) const {}
    __device__ __forceinline__ void done(const Unit&) const {}
};

__device__ __forceinline__ unsigned pk_f16(float lo, float hi) { typedef _Float16 h2 __attribute__((ext_vector_type(2))); h2 v; v.x = (_Float16)lo; v.y = (_Float16)hi; return __builtin_bit_cast(unsigned, v); }
typedef unsigned u32x2 __attribute__((ext_vector_type(2)));
struct EpiF16 {
    static constexpr bool PERM = true, AFTER_DRAIN = false;
    bf16_t* O; int ldc; const float* rss;
    __device__ __forceinline__ void operator()(const f32x4 (&acc)[2][2][4][2], const Unit& u, int wr, int wc, int fr, int fq) const {
        const int row0 = u.pm * BM + wr * 64 + fr; const int col0 = u.pn * BM + wc * 32 + 8 * fq;
#pragma unroll
        for (int ai = 0; ai < 2; ++ai)
#pragma unroll
            for (int m = 0; m < 4; ++m) { const int row = row0 + ai * HALF + m * 16; bf16_t* rowp = O + (size_t)row * ldc + col0;
                const float sc = rss ? 1.0f / sqrtf(rss[row] * (1.0f / 1024.0f) + 1e-6f) : 1.0f;
#pragma unroll
                for (int bj = 0; bj < 2; ++bj) { const f32x4 v0 = acc[ai][bj][m][0] * sc, v1 = acc[ai][bj][m][1] * sc;
                    u32x4 w; w.x = pk_f16(v0[0], v0[1]); w.y = pk_f16(v0[2], v0[3]); w.z = pk_f16(v1[0], v1[1]); w.w = pk_f16(v1[2], v1[3]);
                    *(u32x4*)(rowp + bj * HALF) = w; } }
    }
};
struct EpiRes {
    static constexpr bool PERM = false, AFTER_DRAIN = false;
    const float* base; float* out; int ldc; bf16_t* xh; float* rss;
    __device__ __forceinline__ void operator()(const f32x4 (&acc)[2][2][4][2], const Unit& u, int wr, int wc, int fr, int fq) const {
        const int row0 = u.pm * BM + wr * 64 + fr; const int col0 = u.pn * BM + wc * 32 + 4 * fq;
#pragma unroll
        for (int ai = 0; ai < 2; ++ai)
#pragma unroll
            for (int m = 0; m < 4; ++m) { const size_t off = (size_t)(row0 + ai * HALF + m * 16) * ldc + col0; float ss = 0.f;
#pragma unroll
                for (int bj = 0; bj < 2; ++bj)
#pragma unroll
                    for (int n = 0; n < 2; ++n) { const size_t o = off + bj * HALF + n * 16; const f32x4 b = *(const f32x4*)(base + o); const f32x4 x = b + acc[ai][bj][m][n]; *(f32x4*)(out + o) = x;
                        if (xh) { u32x2 h; h.x = pk_f16(x[0], x[1]); h.y = pk_f16(x[2], x[3]); *(u32x2*)(xh + o) = h; ss += (x[0] * x[0] + x[1] * x[1]) + (x[2] * x[2] + x[3] * x[3]); } }
                if (xh) { ss += shfl_xor_f(ss, 16); ss += shfl_xor_f(ss, 32); if (fq == 0) atomicAdd(rss + row0 + ai * HALF + m * 16, ss); }
                asm volatile("" ::: "memory"); }
    }
};

struct EpiResNorm {
    static constexpr bool PERM = false, AFTER_DRAIN = false;
    const float* base; float* out; int ldc; float* rss2; unsigned* cnt; const float* w;
    __device__ __forceinline__ void operator()(f32x4 (&acc)[2][2][4][2], const Unit& u, int wr, int wc, int fr, int fq) const {
        const int row0 = u.pm * BM + wr * 64 + fr; const int col0 = u.pn * BM + wc * 32 + 4 * fq;
#pragma unroll
        for (int ai = 0; ai < 2; ++ai)
#pragma unroll
            for (int m = 0; m < 4; ++m) { const size_t off = (size_t)(row0 + ai * HALF + m * 16) * ldc + col0; float ss = 0.f;
#pragma unroll
                for (int bj = 0; bj < 2; ++bj)
#pragma unroll
                    for (int n = 0; n < 2; ++n) { const size_t o = off + bj * HALF + n * 16; const f32x4 x = *(const f32x4*)(base + o) + acc[ai][bj][m][n]; acc[ai][bj][m][n] = x;
                        ss += (x[0] * x[0] + x[1] * x[1]) + (x[2] * x[2] + x[3] * x[3]); }
                ss += shfl_xor_f(ss, 16); ss += shfl_xor_f(ss, 32); if (fq == 0) atomicAdd(rss2 + row0 + ai * HALF + m * 16, ss);
                asm volatile("" ::: "memory"); }
        asm volatile("s_waitcnt vmcnt(0)" ::: "memory");
        unsigned* pc = cnt + 64 * u.pm;
        if (lane_now() == 0) __hip_atomic_fetch_add(pc, 1u, __ATOMIC_RELAXED, __HIP_MEMORY_SCOPE_AGENT);
        for (unsigned spin = 0; spin < (1u << 22); ++spin) { if ((unsigned)__builtin_amdgcn_readfirstlane((int)__hip_atomic_load(pc, __ATOMIC_RELAXED, __HIP_MEMORY_SCOPE_AGENT)) >= 32u) break; __builtin_amdgcn_s_sleep(2); }
#pragma unroll
        for (int ai = 0; ai < 2; ++ai)
#pragma unroll
            for (int m = 0; m < 4; ++m) { const int row = row0 + ai * HALF + m * 16; const size_t off = (size_t)row * ldc + col0;
                const float rs = 1.0f / sqrtf(__hip_atomic_load(rss2 + row, __ATOMIC_RELAXED, __HIP_MEMORY_SCOPE_AGENT) * (1.0f / 1024.0f) + 1e-6f);
#pragma unroll
                for (int bj = 0; bj < 2; ++bj)
#pragma unroll
                    for (int n = 0; n < 2; ++n) { const size_t o = off + bj * HALF + n * 16; const f32x4 ww = *(const f32x4*)(w + col0 + bj * HALF + n * 16); *(f32x4*)(out + o) = acc[ai][bj][m][n] * rs * ww; } }
    }
};

template <class Epi, class Sched, bool ALIGN_EPI = false, bool SP2 = false>
__device__ __forceinline__ void gemm_phase(PG8_LAS unsigned char* lds, const Gemm g, const Sched& S, const Epi& E, const int wave_) {
    int wv_ = wave_; asm volatile("" : "+s"(wv_)); int tid_ = lane_now() + 64 * wv_; const int tid = tid_, wid = wv_, lane = tid & 63, wr = wid >> 2, wc = wid & 3, fr = lane & 15, fq = lane >> 4;
    const int K = g.K, nt = K / BK;
    unsigned voffA[2], voffB[2];
#pragma unroll
    for (int i = 0; i < 2; ++i) { int R, C; stage_rc(tid * 16 + i * 8192, R, C); const int Rb = Epi::PERM ? ((R & ~31) + perm32(R & 31)) : R;
        voffA[i] = (unsigned)(R * K + C) * 2u; voffB[i] = (unsigned)(Rb * K + C) * 2u; }
    const size_t kstep = (size_t)(BK * 2);
    const size_t hstep = (size_t)HALF * K * 2;
    const size_t tstep = 2 * hstep;
    const unsigned ldsw = (unsigned)wid * 1024u;
    const int aoff = lds_byte(wr * 64 + fr, fq * 8), boff = lds_byte(wc * 32 + fr, fq * 8);
#define PG8_SA(b, h) (((b) * 2 + (h)) * HTB)
#define PG8_SB(b, h) ((4 + (b) * 2 + (h)) * HTB)
#define PG8_STAGE(bufoff, gbase, voff) do { _Pragma("unroll") for (int _i = 0; _i < 2; ++_i) \
        __builtin_amdgcn_global_load_lds((const unsigned*)((const char*)(gbase) + (voff)[_i]), (PG8_LAS unsigned*)(lds + (bufoff) + ldsw + _i * 8192), 16, 0, 0); } while (0)
#define PG8_LDA(dst, b, h) do { _Pragma("unroll") for (int m = 0; m < 4; ++m) _Pragma("unroll") for (int k = 0; k < 2; ++k) dst[m][k] = *(const PG8_LAS bf16x8*)(lds + PG8_SA(b, h) + aoff + m * 2048 + k * 1024); } while (0)
#define PG8_LDB(dst, b, h) do { _Pragma("unroll") for (int n = 0; n < 2; ++n) _Pragma("unroll") for (int k = 0; k < 2; ++k) dst[n][k] = *(const PG8_LAS bf16x8*)(lds + PG8_SB(b, h) + boff + n * 2048 + k * 1024); } while (0)
#define PG8_MMA(ai, bj, At, Bt) do { __builtin_amdgcn_s_setprio(1); _Pragma("unroll") for (int m = 0; m < 4; ++m) _Pragma("unroll") for (int n = 0; n < 2; ++n) _Pragma("unroll") for (int k = 0; k < 2; ++k) \
        acc[ai][bj][m][n] = MK_MFMA(Bt[n][k], At[m][k], acc[ai][bj][m][n]); __builtin_amdgcn_s_setprio(0); } while (0)
#define PG8_WAIT_V(n) asm volatile("s_waitcnt vmcnt(" #n ")" ::: "memory")
#define PG8_WAIT_L(n) asm volatile("s_waitcnt lgkmcnt(" #n ")" ::: "memory")
#define PG8_BAR __builtin_amdgcn_s_barrier()
#define PG8_SCHED __builtin_amdgcn_sched_barrier(0)
    Unit cur, nxt; int ui = 0;
    if (!S.next(0, cur)) return;
    f32x4 acc[2][2][4][2];
#pragma unroll
    for (int a = 0; a < 2; ++a)
#pragma unroll
        for (int b = 0; b < 2; ++b)
#pragma unroll
            for (int m = 0; m < 4; ++m)
#pragma unroll
                for (int n = 0; n < 2; ++n) acc[a][b][m][n] = (f32x4){0.f, 0.f, 0.f, 0.f};
    bf16x8 At[4][2], B0[2][2], B1[2][2];
    const char* cA = (const char*)g.A + (size_t)cur.pm * tstep; const char* cB = (const char*)g.Bt + (size_t)cur.pn * tstep;
    S.a_ready(cur);
    if constexpr (SP2) {
        PG8_STAGE(PG8_SB(0, 0), cB, voffB); PG8_STAGE(PG8_SB(0, 1), cB + hstep, voffB); PG8_STAGE(PG8_SA(0, 0), cA, voffA); PG8_STAGE(PG8_SA(0, 1), cA + hstep, voffA);
        if (wr == 1) PG8_BAR;
        PG8_WAIT_V(2); PG8_BAR;
        PG8_STAGE(PG8_SB(1, 0), cB + kstep, voffB); PG8_STAGE(PG8_SA(1, 0), cA + kstep, voffA); PG8_STAGE(PG8_SB(1, 1), cB + hstep + kstep, voffB);
        PG8_WAIT_V(6); PG8_BAR;
    } else {
        PG8_STAGE(PG8_SB(0, 0), cB, voffB); PG8_STAGE(PG8_SA(0, 0), cA, voffA); PG8_STAGE(PG8_SB(0, 1), cB + hstep, voffB); PG8_STAGE(PG8_SA(0, 1), cA + hstep, voffA);
        if (wr == 1) PG8_BAR;
        PG8_WAIT_V(4); PG8_BAR;
        PG8_STAGE(PG8_SB(1, 0), cB + kstep, voffB); PG8_STAGE(PG8_SA(1, 0), cA + kstep, voffA); PG8_STAGE(PG8_SB(1, 1), cB + hstep + kstep, voffB);
        PG8_WAIT_V(6); PG8_BAR;
    }
    for (;;) {
        const bool has_next = S.next(ui + 1, nxt);
        const char* nA = has_next ? (const char*)g.A + (size_t)nxt.pm * tstep : cA; const char* nB = has_next ? (const char*)g.Bt + (size_t)nxt.pn * tstep : cB;
        for (int t = 0; t < nt; t += 2) {
            const bool last = (t == nt - 2);
            const char* a1 = cA + (size_t)(t + 1) * kstep;
            const char* a2 = last ? nA : cA + (size_t)(t + 2) * kstep; const char* b2 = last ? nB : cB + (size_t)(t + 2) * kstep;
            const char* a3 = a2 + kstep; const char* b3 = b2 + kstep;
            if (last && has_next) S.a_ready(nxt);
            if constexpr (SP2) {
            PG8_LDB(B0, 0, 0); PG8_LDB(B1, 0, 1); PG8_SCHED; PG8_LDA(At, 0, 0); PG8_STAGE(PG8_SA(1, 1), a1 + hstep, voffA);
            PG8_WAIT_V(8); PG8_WAIT_L(0); PG8_BAR; PG8_MMA(0, 0, At, B0); PG8_MMA(0, 1, At, B1); PG8_BAR; PG8_SCHED;
            PG8_LDA(At, 0, 1); PG8_STAGE(PG8_SB(0, 0), b2, voffB); PG8_STAGE(PG8_SB(0, 1), b2 + hstep, voffB); PG8_STAGE(PG8_SA(0, 0), a2, voffA);
            PG8_WAIT_V(8); PG8_WAIT_L(0); PG8_BAR; PG8_MMA(1, 0, At, B0); PG8_MMA(1, 1, At, B1); PG8_BAR; PG8_SCHED;
            PG8_LDB(B0, 1, 0); PG8_LDB(B1, 1, 1); PG8_SCHED; PG8_LDA(At, 1, 0); PG8_STAGE(PG8_SA(0, 1), a2 + hstep, voffA);
            PG8_WAIT_V(8); PG8_WAIT_L(0); PG8_BAR; PG8_MMA(0, 0, At, B0); PG8_MMA(0, 1, At, B1); PG8_BAR; PG8_SCHED;
            PG8_LDA(At, 1, 1); PG8_STAGE(PG8_SB(1, 0), b3, voffB); PG8_STAGE(PG8_SB(1, 1), b3 + hstep, voffB); PG8_STAGE(PG8_SA(1, 0), a3, voffA);
            PG8_WAIT_V(8); PG8_WAIT_L(0); PG8_BAR; PG8_MMA(1, 0, At, B0); PG8_MMA(1, 1, At, B1); PG8_BAR; PG8_SCHED;
            } else {
            PG8_LDB(B0, 0, 0); PG8_SCHED; PG8_LDA(At, 0, 0); PG8_STAGE(PG8_SA(1, 1), a1 + hstep, voffA);
            PG8_WAIT_L(8); PG8_BAR; PG8_WAIT_L(0); PG8_MMA(0, 0, At, B0); PG8_BAR; PG8_SCHED;
            PG8_LDB(B1, 0, 1); PG8_STAGE(PG8_SB(0, 0), b2, voffB);
            PG8_BAR; PG8_WAIT_L(0); PG8_MMA(0, 1, At, B1); PG8_BAR;
            PG8_LDA(At, 0, 1); PG8_STAGE(PG8_SA(0, 0), a2, voffA);
            PG8_BAR; PG8_WAIT_L(0); PG8_MMA(1, 0, At, B0); PG8_BAR; PG8_SCHED;
            PG8_STAGE(PG8_SB(0, 1), b2 + hstep, voffB);
            PG8_WAIT_V(6); PG8_BAR; PG8_MMA(1, 1, At, B1); PG8_BAR;
            PG8_LDB(B0, 1, 0); PG8_SCHED; PG8_LDA(At, 1, 0); PG8_STAGE(PG8_SA(0, 1), a2 + hstep, voffA);
            PG8_WAIT_L(8); PG8_BAR; PG8_WAIT_L(0); PG8_MMA(0, 0, At, B0); PG8_BAR; PG8_SCHED;
            PG8_LDB(B1, 1, 1); PG8_STAGE(PG8_SB(1, 0), b3, voffB);
            PG8_BAR; PG8_WAIT_L(0); PG8_MMA(0, 1, At, B1); PG8_BAR;
            PG8_LDA(At, 1, 1); PG8_STAGE(PG8_SA(1, 0), a3, voffA);
            PG8_BAR; PG8_WAIT_L(0); PG8_MMA(1, 0, At, B0); PG8_BAR; PG8_SCHED;
            PG8_STAGE(PG8_SB(1, 1), b3 + hstep, voffB);
            PG8_WAIT_V(6); PG8_BAR; PG8_MMA(1, 1, At, B1); PG8_BAR;
            }
        }
        if constexpr (ALIGN_EPI) { if (wr == 0) PG8_BAR; }
        if constexpr (!Epi::AFTER_DRAIN) { E(acc, cur, wr, wc, fr, fq); S.done(cur); }
        if (!has_next) break;
#pragma unroll
        for (int a = 0; a < 2; ++a)
#pragma unroll
            for (int b = 0; b < 2; ++b)
#pragma unroll
                for (int m = 0; m < 4; ++m)
#pragma unroll
                    for (int n = 0; n < 2; ++n) acc[a][b][m][n] = (f32x4){0.f, 0.f, 0.f, 0.f};
        cur = nxt; cA = nA; cB = nB; ++ui;
        if constexpr (ALIGN_EPI) { if (wr == 1) PG8_BAR; }
    }
    PG8_WAIT_V(0);
    if constexpr (!ALIGN_EPI) { if (wr == 0) PG8_BAR; }
    PG8_BAR;
    if constexpr (Epi::AFTER_DRAIN) { E.fused(acc, cur, wr, wc, fr, fq, lds, wid, lane); S.done(cur); }
#undef PG8_SA
#undef PG8_SB
#undef PG8_STAGE
#undef PG8_LDA
#undef PG8_LDB
#undef PG8_MMA
#undef PG8_WAIT_V
#undef PG8_WAIT_L
#undef PG8_BAR
#undef PG8_SCHED
}
}

constexpr int BATCH = 2, SEQ = 8192, DM = 1024, DEPTH = 2, M = BATCH * SEQ;
constexpr int RW_H = 6, HD = 64, RW_W = 384, RW_SHIFT = 1280;
constexpr int NIN = 3712, NU = 3840;
constexpr int C_R = 0, C_K = 384, C_V = 768, C_WL = 1152, C_AL = 1216, C_RWZ = 1280, C_HGQ = 1664, C_HGF = 2048, C_HGI = 2432, C_HGZ = 2816, C_LRUX = 3200, C_LRUZ = 3456;
constexpr int CH = 64;
constexpr int NWAVES = 8, NT = NWAVES * 64;
constexpr int LDS_BYTES = 163840;
constexpr int PRM_OFF = 142336;
constexpr size_t MiB = 1u << 20;
constexpr size_t WS_WUPT = 65536, WS_AUPT = WS_WUPT + 98304, WS_VDNT = WS_AUPT + 98304, WS_VUPT = WS_VDNT + 24576, WS_WAT = WS_VUPT + 24576, WS_WXT = WS_WAT + 65536;
constexpr size_t WS_WIN = 1 * MiB, WIN_L = (size_t)NU * DM * 2;
constexpr size_t WS_WOUT = 16 * MiB, WOUT_L = (size_t)DM * DM * 2;
constexpr size_t WS_XN = 20 * MiB;
constexpr size_t WS_QT = 20 * MiB;
constexpr size_t WS_PT = 32 * MiB;
constexpr size_t WS_CA = 44 * MiB;
constexpr size_t WS_U = 52 * MiB;
constexpr size_t WS_MIX = 172 * MiB;
constexpr size_t WS_VF = 204 * MiB;
constexpr size_t WS_VP = 216 * MiB;
constexpr size_t WS_RL = 228 * MiB;
constexpr size_t WS_HL = 240 * MiB;
constexpr size_t WS_BON = 252 * MiB;
constexpr size_t WS_DC = WS_BON + 512 * 1024;
constexpr size_t WS_LA = WS_DC + 512 * 1024;
constexpr size_t WS_LH = WS_LA + 256 * 1024;
constexpr size_t WS_RSS = WS_LH + 256 * 1024;
constexpr size_t WS_END = 254 * MiB;
constexpr int NCH = SEQ / CH;

#define LAS __attribute__((address_space(3)))
typedef float f32x4 __attribute__((ext_vector_type(4)));
typedef unsigned u32x2 __attribute__((ext_vector_type(2)));
typedef unsigned u32x4 __attribute__((ext_vector_type(4)));
typedef _Float16 f16;
typedef _Float16 f16x8 __attribute__((ext_vector_type(8)));
#define LDS_WAIT() asm volatile("s_waitcnt lgkmcnt(0)" ::: "memory")

struct Args { const float* in[27]; float* out; unsigned char* ws; };

__device__ __forceinline__ float wave_sum(float v) {
#pragma unroll
    for (int o = 1; o < 64; o <<= 1) v += shfl_xor_f(v, o);
    return v;
}
__device__ __forceinline__ float sigmoidf_(float x) { return __builtin_amdgcn_rcpf(1.0f + __expf(-x)); }
__device__ __forceinline__ float rsq_(float x) { return __builtin_amdgcn_rsqf(x); }
__device__ __forceinline__ float one_minus_exp_(float x) { return (x > -0.03f) ? -x * (1.0f + x * (0.5f + x * (1.0f / 6.0f + x * (1.0f / 24.0f)))) : 1.0f - __expf(x); }
__device__ __forceinline__ float siluf_(float x) { return x * __builtin_amdgcn_rcpf(1.0f + __expf(-x)); }

__device__ __forceinline__ void p0_transpose_item(const float* W, int K, int N, unsigned short* WT, LAS float* scr, int item, int lane, const float* rsc) {
    const int nblk = N / 32, kb = item / nblk, nb = item % nblk, k0 = 64 * kb, n0 = 32 * nb;
    float tv[32];
#pragma unroll
    for (int i = 0; i < 32; ++i) { const int kk = 2 * i + (lane >> 5); tv[i] = W[(size_t)(k0 + kk) * N + n0 + (lane & 31)]; }
#pragma unroll
    for (int i = 0; i < 32; ++i) { const int kk = 2 * i + (lane >> 5); scr[kk * 33 + (lane & 31)] = tv[i] * (rsc ? rsc[k0 + kk] : 1.0f); }
    LDS_WAIT(); asm volatile("" ::: "memory");
    const int c = lane & 7;
#pragma unroll
    for (int j = 0; j < 4; ++j) { const int n = (lane >> 3) + 8 * j; const LAS float* s = scr + (8 * c) * 33 + n;
        u32x4 o; o.x = pg8::pk_f16(s[0 * 33], s[1 * 33]); o.y = pg8::pk_f16(s[2 * 33], s[3 * 33]); o.z = pg8::pk_f16(s[4 * 33], s[5 * 33]); o.w = pg8::pk_f16(s[6 * 33], s[7 * 33]);
        *(u32x4*)(WT + (size_t)(n0 + n) * K + k0 + 8 * c) = o; }
    LDS_WAIT(); asm volatile("" ::: "memory");
}
__device__ __forceinline__ void rms_row_f16(const float* xrow, const float* w, unsigned short* orow, int lane) {
    const f32x4* xr = (const f32x4*)xrow + lane; const f32x4* wr = (const f32x4*)w + lane;
    f32x4 v[4]; float s = 0.f;
#pragma unroll
    for (int j = 0; j < 4; ++j) { v[j] = xr[64 * j]; s += (v[j].x * v[j].x + v[j].y * v[j].y) + (v[j].z * v[j].z + v[j].w * v[j].w); }
    const float rs = 1.0f / sqrtf(wave_sum(s) * (1.0f / DM) + 1e-6f);
    u32x2* o8 = (u32x2*)orow + lane;
#pragma unroll
    for (int j = 0; j < 4; ++j) { const f32x4 ww = wr[64 * j]; u32x2 o; o.x = pg8::pk_f16(v[j].x * rs * ww.x, v[j].y * rs * ww.y); o.y = pg8::pk_f16(v[j].z * rs * ww.z, v[j].w * rs * ww.w); o8[64 * j] = o; }
}
__device__ __forceinline__ void rms_row_f32(float* xrow, const float* w, int lane) {
    f32x4* xr = (f32x4*)xrow + lane; const f32x4* wr = (const f32x4*)w + lane;
    f32x4 v[4]; float s = 0.f;
#pragma unroll
    for (int j = 0; j < 4; ++j) { v[j] = xr[64 * j]; s += (v[j].x * v[j].x + v[j].y * v[j].y) + (v[j].z * v[j].z + v[j].w * v[j].w); }
    const float rs = 1.0f / sqrtf(wave_sum(s) * (1.0f / DM) + 1e-6f);
#pragma unroll
    for (int j = 0; j < 4; ++j) { const f32x4 ww = wr[64 * j]; xr[64 * j] = v[j] * rs * ww; }
}

__device__ __forceinline__ void rms_row2_f32(float* xa, float* xb, const float* w, int lane) {
    f32x4* ra = (f32x4*)xa + lane; f32x4* rb = (f32x4*)xb + lane; const f32x4* wr = (const f32x4*)w + lane;
    f32x4 va[4], vb[4]; float sa = 0.f, sb = 0.f;
#pragma unroll
    for (int j = 0; j < 4; ++j) { va[j] = ra[64 * j]; vb[j] = rb[64 * j]; }
#pragma unroll
    for (int j = 0; j < 4; ++j) { sa += (va[j].x * va[j].x + va[j].y * va[j].y) + (va[j].z * va[j].z + va[j].w * va[j].w); sb += (vb[j].x * vb[j].x + vb[j].y * vb[j].y) + (vb[j].z * vb[j].z + vb[j].w * vb[j].w); }
    const float rsa = 1.0f / sqrtf(wave_sum(sa) * (1.0f / DM) + 1e-6f), rsb = 1.0f / sqrtf(wave_sum(sb) * (1.0f / DM) + 1e-6f);
#pragma unroll
    for (int j = 0; j < 4; ++j) { const f32x4 ww = wr[64 * j]; ra[64 * j] = va[j] * rsa * ww; rb[64 * j] = vb[j] * rsb * ww; }
}
__device__ __forceinline__ void rms_row4_f16(const float* x0, size_t rs, const float* w, unsigned short* o0, int lane) {
    f32x4 v[4][4]; float s[4];
#pragma unroll
    for (int r = 0; r < 4; ++r)
#pragma unroll
        for (int j = 0; j < 4; ++j) v[r][j] = ((const f32x4*)(x0 + r * rs) + lane)[64 * j];
    const f32x4* wr = (const f32x4*)w + lane;
#pragma unroll
    for (int r = 0; r < 4; ++r) { float a = 0.f;
#pragma unroll
        for (int j = 0; j < 4; ++j) a += (v[r][j].x * v[r][j].x + v[r][j].y * v[r][j].y) + (v[r][j].z * v[r][j].z + v[r][j].w * v[r][j].w);
        s[r] = 1.0f / sqrtf(wave_sum(a) * (1.0f / DM) + 1e-6f); }
#pragma unroll
    for (int j = 0; j < 4; ++j) { const f32x4 ww = wr[64 * j];
#pragma unroll
        for (int r = 0; r < 4; ++r) { u32x2 o; o.x = pg8::pk_f16(v[r][j].x * s[r] * ww.x, v[r][j].y * s[r] * ww.y); o.y = pg8::pk_f16(v[r][j].z * s[r] * ww.z, v[r][j].w * s[r] * ww.w); ((u32x2*)(o0 + r * rs) + lane)[64 * j] = o; } }
}
__device__ __forceinline__ void rms_row4_f32(float* x0, size_t rs, const float* w, int lane) {
    f32x4 v[4][4]; float s[4];
#pragma unroll
    for (int r = 0; r < 4; ++r)
#pragma unroll
        for (int j = 0; j < 4; ++j) v[r][j] = ((const f32x4*)(x0 + r * rs) + lane)[64 * j];
    const f32x4* wr = (const f32x4*)w + lane;
#pragma unroll
    for (int r = 0; r < 4; ++r) { float a = 0.f;
#pragma unroll
        for (int j = 0; j < 4; ++j) a += (v[r][j].x * v[r][j].x + v[r][j].y * v[r][j].y) + (v[r][j].z * v[r][j].z + v[r][j].w * v[r][j].w);
        s[r] = rsq_(wave_sum(a) * (1.0f / DM) + 1e-6f); }
#pragma unroll
    for (int j = 0; j < 4; ++j) { const f32x4 ww = wr[64 * j];
#pragma unroll
        for (int r = 0; r < 4; ++r) ((f32x4*)(x0 + r * rs) + lane)[64 * j] = v[r][j] * s[r] * ww; }
}

#define SHV(col) ({ const float cur_ = (float)urow[(col)]; const float prev_ = hp ? (float)prow[(col)] : 0.f; cur_ + mu[(col)] * (prev_ - cur_); })

__device__ __forceinline__ void store_row64_f16(f16* dst, const float (&S)[64]) {
#pragma unroll
    for (int q = 0; q < 8; ++q) { u32x4 w; w.x = pg8::pk_f16(S[8 * q], S[8 * q + 1]); w.y = pg8::pk_f16(S[8 * q + 2], S[8 * q + 3]); w.z = pg8::pk_f16(S[8 * q + 4], S[8 * q + 5]); w.w = pg8::pk_f16(S[8 * q + 6], S[8 * q + 7]); *(u32x4*)(dst + 8 * q) = w; }
}


constexpr int RWA_REC = 1040  , RWA_VROW = 136, RWA_VPL = 16 * RWA_REC, RWA_INV = RWA_VPL + 16 * RWA_VROW, RWA_BYTES = 18944;
constexpr int C_VD0 = 3712, C_VD1 = 3744;
constexpr int PRM_MU = 0, PRM_A0 = 1280, PRM_KK = 1664, PRM_KA = 2048, PRM_RK = 2432, PRM_V0 = 2816, PRM_HALVES = 3200, PRM_W0_BYTE = 6400, PRM_BYTES = PRM_W0_BYTE + 1536;
typedef float f32x2 __attribute__((ext_vector_type(2)));
typedef _Float16 f16x4 __attribute__((ext_vector_type(4)));
__device__ __forceinline__ float fmix_lo(float a, unsigned b, float c) { float d; asm("v_fma_mix_f32 %0, %1, %2, %3 op_sel:[0,0,0] op_sel_hi:[0,1,0]" : "=v"(d) : "v"(a), "v"(b), "v"(c)); return d; }
__device__ __forceinline__ float fmix_hi(float a, unsigned b, float c) { float d; asm("v_fma_mix_f32 %0, %1, %2, %3 op_sel:[0,1,0] op_sel_hi:[0,1,0]" : "=v"(d) : "v"(a), "v"(b), "v"(c)); return d; }
__device__ __forceinline__ float mmix_lo(float a, unsigned b) { float d; asm("v_fma_mix_f32 %0, %1, %2, 0 op_sel:[0,0,0] op_sel_hi:[0,1,0]" : "=v"(d) : "v"(a), "v"(b)); return d; }
__device__ __forceinline__ float mmix_hi(float a, unsigned b) { float d; asm("v_fma_mix_f32 %0, %1, %2, 0 op_sel:[0,1,0] op_sel_hi:[0,1,0]" : "=v"(d) : "v"(a), "v"(b)); return d; }
__device__ __forceinline__ float mul_asm(float a, float b) { float d; asm("v_mul_f32 %0, %1, %2" : "=v"(d) : "v"(a), "v"(b)); return d; }
__device__ __forceinline__ float fma_asm(float a, float b, float c) { float d; asm("v_fma_f32 %0, %1, %2, %3" : "=v"(d) : "v"(a), "v"(b), "v"(c)); return d; }
#define FMIX(a, u, j, c) (((j) & 1) ? fmix_hi((a), (u)[(j) >> 1], (c)) : fmix_lo((a), (u)[(j) >> 1], (c)))
#define MMIX(a, u, j) (((j) & 1) ? mmix_hi((a), (u)[(j) >> 1]) : mmix_lo((a), (u)[(j) >> 1]))
__device__ __forceinline__ float fast_tanh(float x) { return 1.0f - 2.0f * __builtin_amdgcn_rcpf(__expf(2.0f * x) + 1.0f); }
__device__ __forceinline__ void lerp8(const char* ub, unsigned uo, unsigned po, bool hp, const char* mub, unsigned col, float (&x)[8]) {
    const f16x8 cu = *(const f16x8*)(ub + (uo + col * 2u)); f16x8 pv = *(const f16x8*)(ub + (po + col * 2u)); const f32x4 m0 = *(const f32x4*)(mub + col * 4u), m1 = *(const f32x4*)(mub + col * 4u + 16u);
#pragma unroll
    for (int j = 0; j < 8; ++j) { const float c = (float)cu[j], p = hp ? (float)pv[j] : 0.f; x[j] = c + (j < 4 ? m0[j] : m1[j - 4]) * (p - c); }
}
__device__ __forceinline__ void lerp4(const char* ub, unsigned uo, unsigned po, bool hp, const char* mub, unsigned col, float (&x)[4]) {
    const f16x4 cu = *(const f16x4*)(ub + (uo + col * 2u)); f16x4 pv = *(const f16x4*)(ub + (po + col * 2u)); const f32x4 m0 = *(const f32x4*)(mub + col * 4u);
#pragma unroll
    for (int j = 0; j < 4; ++j) { const float c = (float)cu[j], p = hp ? (float)pv[j] : 0.f; x[j] = c + m0[j] * (p - c); }
}
__device__ __forceinline__ f16x8 pack8(const float (&x)[8]) { f16x8 r;
#pragma unroll
    for (int j = 0; j < 8; ++j) r[j] = (f16)x[j];
    return r; }

__device__ __forceinline__ void rwkv_waveA(const Args& a, int l, int b, int c, int h, LAS unsigned char* wl, const LAS unsigned char* prmb, int lane) {
    const LAS f16* prm = (const LAS f16*)prmb; const LAS float* prw0 = (const LAS float*)(prmb + PRM_W0_BYTE);
    const char* Ub = (const char*)(a.ws + WS_U); f16* MIX = (f16*)(a.ws + WS_MIX); char* VF = (char*)(a.ws + WS_VF); char* VP = (char*)(a.ws + WS_VP);
    f16* QT = (f16*)(a.ws + WS_QT); f16* PT = (f16*)(a.ws + WS_PT); f16* RL = (f16*)(a.ws + WS_RL); float* BONG = (float*)(a.ws + WS_BON);
    const char* WUPT = (const char*)(a.ws + WS_WUPT) + (size_t)l * 384 * 64 * 2; const char* AUPT = (const char*)(a.ws + WS_AUPT) + (size_t)l * 384 * 64 * 2;
    const char* VUPT = (const char*)(a.ws + WS_VUPT);
    const int bh = b * RW_H + h;
    float P[64], L[64];
#pragma unroll
    for (int k = 0; k < 64; ++k) { P[k] = (k == lane) ? 1.f : 0.f; L[k] = 0.f; }
#pragma unroll 1
    for (int blk = 0; blk < 4; ++blk) {
        const int lane_ = lane_now();
        const int tok = lane_ & 15, fq = lane_ >> 4;
        const int t = c * CH + blk * 16 + tok; const unsigned m = (unsigned)(b * SEQ + t); const bool hp = t > 0;
        const unsigned uo = m * (unsigned)(NU * 2), po = hp ? uo - (unsigned)(NU * 2) : uo;
        f16x8 cW[2], pW[2], cA[2], pA[2], vd0, vd1;
#pragma unroll
        for (int s = 0; s < 2; ++s) { const unsigned cw = (unsigned)(C_WL + 8 * fq + 32 * s) * 2u, ca = (unsigned)(C_AL + 8 * fq + 32 * s) * 2u;
            cW[s] = *(const f16x8*)(Ub + uo + cw); pW[s] = *(const f16x8*)(Ub + po + cw); cA[s] = *(const f16x8*)(Ub + uo + ca); pA[s] = *(const f16x8*)(Ub + po + ca); }
        if (l > 0) { vd0 = *(const f16x8*)(Ub + uo + (unsigned)(C_VD0 + 8 * fq) * 2u); vd1 = *(const f16x8*)(Ub + po + (unsigned)(C_VD1 + 8 * fq) * 2u); }
#define RW_TLOAD(X, nt) f16x8 X##wu0, X##wu1, X##au0, X##au1, X##vu; f16x4 X##cr, X##pr, X##ck, X##pk, X##cv, X##pv, X##vf; { \
            const unsigned n_ = (unsigned)(h * 64 + 16 * (nt) + tok), cb_ = (unsigned)(h * 64 + 16 * (nt) + 4 * fq); \
            X##wu0 = *(const f16x8*)(WUPT + (n_ * 64u + 8u * fq) * 2u); X##wu1 = *(const f16x8*)(WUPT + (n_ * 64u + 8u * fq + 32u) * 2u); \
            X##au0 = *(const f16x8*)(AUPT + (n_ * 64u + 8u * fq) * 2u); X##au1 = *(const f16x8*)(AUPT + (n_ * 64u + 8u * fq + 32u) * 2u); \
            if (l > 0) { X##vu = *(const f16x8*)(VUPT + (n_ * 32u + 8u * fq) * 2u); X##vf = *(const f16x4*)(VF + (m * (unsigned)RW_W + cb_) * 2u); } \
            X##cr = *(const f16x4*)(Ub + uo + ((unsigned)C_R + cb_) * 2u); X##pr = *(const f16x4*)(Ub + po + ((unsigned)C_R + cb_) * 2u); \
            X##ck = *(const f16x4*)(Ub + uo + ((unsigned)C_K + cb_) * 2u); X##pk = *(const f16x4*)(Ub + po + ((unsigned)C_K + cb_) * 2u); \
            X##cv = *(const f16x4*)(Ub + uo + ((unsigned)C_V + cb_) * 2u); X##pv = *(const f16x4*)(Ub + po + ((unsigned)C_V + cb_) * 2u); }
        f16x8 bW[2], bA[2], bVD;
#pragma unroll
        for (int s = 0; s < 2; ++s) { float xw[8], xa[8];
            const f16x8 mw = *(const LAS f16x8*)(prm + PRM_MU + C_WL + 8 * fq + 32 * s), ma = *(const LAS f16x8*)(prm + PRM_MU + C_AL + 8 * fq + 32 * s);
#pragma unroll
            for (int j = 0; j < 8; ++j) { const float cw_ = (float)cW[s][j], pw_ = hp ? (float)pW[s][j] : 0.f, ca_ = (float)cA[s][j], pa_ = hp ? (float)pA[s][j] : 0.f;
                xw[j] = fast_tanh(cw_ + (float)mw[j] * (pw_ - cw_)); xa[j] = ca_ + (float)ma[j] * (pa_ - ca_); }
            bW[s] = pack8(xw); bA[s] = pack8(xa); }
        if (l > 0) { float xv[8];
#pragma unroll
            for (int j = 0; j < 8; ++j) xv[j] = (float)vd0[j] + (hp ? (float)vd1[j] : 0.f);
            bVD = pack8(xv); }
        float ssq = 0.f, bon = 0.f;
        LAS unsigned char* rec = wl + tok * RWA_REC;
#define RW_TCOMP(X, nt) { const int cb = h * 64 + 16 * (nt) + 4 * fq, co = 16 * (nt) + 4 * fq; \
            f32x4 DWn = (f32x4){0.f, 0.f, 0.f, 0.f}, DAn = DWn, Gn = DWn; \
            DWn = __builtin_amdgcn_mfma_f32_16x16x32_f16(X##wu0, bW[0], DWn, 0, 0, 0); DWn = __builtin_amdgcn_mfma_f32_16x16x32_f16(X##wu1, bW[1], DWn, 0, 0, 0); \
            DAn = __builtin_amdgcn_mfma_f32_16x16x32_f16(X##au0, bA[0], DAn, 0, 0, 0); DAn = __builtin_amdgcn_mfma_f32_16x16x32_f16(X##au1, bA[1], DAn, 0, 0, 0); \
            if (l > 0) Gn = __builtin_amdgcn_mfma_f32_16x16x32_f16(X##vu, bVD, Gn, 0, 0, 0); \
            f32x4 wv, al, be; f16x4 km, rr, vo; \
            _Pragma("unroll") for (int i = 0; i < 4; ++i) { const LAS f16* pc = prm + cb + i; \
                const float cr_ = (float)X##cr[i], ck_ = (float)X##ck[i], cv_ = (float)X##cv[i]; \
                const float rs = cr_ + (float)pc[PRM_MU + C_R] * ((hp ? (float)X##pr[i] : 0.f) - cr_), ks = ck_ + (float)pc[PRM_MU + C_K] * ((hp ? (float)X##pk[i] : 0.f) - ck_), vs = cv_ + (float)pc[PRM_MU + C_V] * ((hp ? (float)X##pv[i] : 0.f) - cv_); \
                wv[i] = __expf(-0.6065306597126334f * sigmoidf_(prw0[cb + i] + DWn[i])); \
                const float aa = sigmoidf_((float)pc[PRM_A0] + DAn[i]); \
                float vv = vs; if (l > 0) vv = vs + ((float)X##vf[i] - vs) * sigmoidf_((float)pc[PRM_V0] + Gn[i]); \
                const float kk = ks * (float)pc[PRM_KK]; ssq += kk * kk; \
                const float kmod = ks * (1.0f + (aa - 1.0f) * (float)pc[PRM_KA]); \
                bon += rs * kmod * (float)pc[PRM_RK]; \
                al[i] = -kk; be[i] = kk * aa; km[i] = (f16)kmod; rr[i] = (f16)rs; vo[i] = (f16)vv; \
                asm volatile("" ::: "memory"); } \
            *(LAS f32x4*)(rec + co * 4) = wv; *(LAS f32x4*)(rec + 256 + co * 4) = al; *(LAS f32x4*)(rec + 512 + co * 4) = be; \
            *(LAS f16x4*)(rec + 768 + co * 2) = km; *(LAS f16x4*)(rec + 896 + co * 2) = rr; \
            *(LAS f16x4*)(wl + RWA_VPL + tok * RWA_VROW + co * 2) = vo; \
            *(f16x4*)(VP + (m * (unsigned)RW_W + (unsigned)cb) * 2u) = vo; \
            if (l == 0) *(f16x4*)(VF + (m * (unsigned)RW_W + (unsigned)cb) * 2u) = vo; }
#pragma unroll 1
        for (int nt = 0; nt < 4; ++nt) { RW_TLOAD(T0, nt) RW_TCOMP(T0, nt) asm volatile("" ::: "memory"); }
#undef RW_TLOAD
#undef RW_TCOMP
        ssq += shfl_xor_f(ssq, 16); ssq += shfl_xor_f(ssq, 32);
        bon += shfl_xor_f(bon, 16); bon += shfl_xor_f(bon, 32);
        { const float inv2v = __builtin_amdgcn_rcpf(fmaxf(ssq, 1e-24f));
          if (fq == 0) { *(LAS float*)(wl + RWA_INV + tok * 4) = inv2v; *(float*)((char*)BONG + (m * 8u + (unsigned)h) * 4u) = bon; } }
        const unsigned mb = (unsigned)(b * SEQ + c * CH + blk * 16);
        asm volatile("s_waitcnt lgkmcnt(0)" ::: "memory");
        f32x4 Aa[2], Ab[2], Ac[2];
#define RW_LDA(A, rcp, g) { A[0] = *(const LAS f32x4*)((rcp) + 256 + (g) * 32); A[1] = *(const LAS f32x4*)((rcp) + 256 + (g) * 32 + 16); }
#define RW_SA(A, g) { _Pragma("unroll") for (int j = 0; j < 8; ++j) sP[j] = fma_asm(P[8 * (g) + j], A[j >> 2][j & 3], sP[j]); \
                      _Pragma("unroll") for (int j = 0; j < 8; ++j) sL[j] = fma_asm(L[8 * (g) + j], A[j >> 2][j & 3], sL[j]); }
        RW_LDA(Aa, wl, 0) RW_LDA(Ab, wl, 1)
        float vv = (float)*(const LAS f16*)(wl + RWA_VPL + lane_ * 2); float inv2 = *(const LAS float*)(wl + RWA_INV);
#define RW_LDU(W, B, K4, R4, g) { W[0] = *(const LAS f32x4*)(rc + (g) * 32); W[1] = *(const LAS f32x4*)(rc + (g) * 32 + 16); B[0] = *(const LAS f32x4*)(rc + 512 + (g) * 32); B[1] = *(const LAS f32x4*)(rc + 512 + (g) * 32 + 16); K4 = *(const LAS u32x4*)(rc + 768 + (g) * 16); R4 = *(const LAS u32x4*)(rc + 896 + (g) * 16); }
#define RW_COMP(W, B, K4, R4, g) { float tP[8], tL[8]; \
            _Pragma("unroll") for (int j = 0; j < 8; ++j) tP[j] = mul_asm(saP, B[j >> 2][j & 3]); \
            _Pragma("unroll") for (int j = 0; j < 8; ++j) tL[j] = mul_asm(saL, B[j >> 2][j & 3]); \
            _Pragma("unroll") for (int j = 0; j < 8; ++j) tL[j] = FMIX(vv, K4, j, tL[j]); \
            _Pragma("unroll") for (int j = 0; j < 8; ++j) P[8 * (g) + j] = fma_asm(P[8 * (g) + j], W[j >> 2][j & 3], tP[j]); \
            _Pragma("unroll") for (int j = 0; j < 8; ++j) L[8 * (g) + j] = fma_asm(L[8 * (g) + j], W[j >> 2][j & 3], tL[j]); \
            _Pragma("unroll") for (int j = 0; j < 8; ++j) qa[j] = FMIX(P[8 * (g) + j], R4, j, qa[j]); \
            _Pragma("unroll") for (int j = 0; j < 8; ++j) ya[j] = FMIX(L[8 * (g) + j], R4, j, ya[j]); }
#pragma unroll 1
        for (int t2 = 0; t2 < 16; ++t2) {
            const LAS unsigned char* rc = wl + t2 * RWA_REC;
            f32x4 we[2], wo[2], be[2], bo[2]; u32x4 ke, re, ko, ro;
            RW_LDU(we, be, ke, re, 0)
            float sP[8], sL[8];
#pragma unroll
            for (int j = 0; j < 8; ++j) { sP[j] = 0.f; sL[j] = 0.f; }
            RW_LDA(Ac, rc, 2) RW_SA(Aa, 0)
            RW_LDA(Aa, rc, 3) RW_SA(Ab, 1)
            RW_LDA(Ab, rc, 4) RW_SA(Ac, 2)
            RW_LDA(Ac, rc, 5) RW_SA(Aa, 3)
            RW_LDA(Aa, rc, 6) RW_SA(Ab, 4)
            RW_LDA(Ab, rc, 7) RW_SA(Ac, 5)
            RW_SA(Aa, 6)
            RW_SA(Ab, 7)
            const float saP = inv2 * (((sP[0] + sP[1]) + (sP[2] + sP[3])) + ((sP[4] + sP[5]) + (sP[6] + sP[7]))), saL = inv2 * (((sL[0] + sL[1]) + (sL[2] + sL[3])) + ((sL[4] + sL[5]) + (sL[6] + sL[7])));
            float qa[8], ya[8];
#pragma unroll
            for (int j = 0; j < 8; ++j) { qa[j] = 0.f; ya[j] = 0.f; }
            RW_LDU(wo, bo, ko, ro, 1) RW_COMP(we, be, ke, re, 0)
            RW_LDU(we, be, ke, re, 2) RW_COMP(wo, bo, ko, ro, 1)
            RW_LDU(wo, bo, ko, ro, 3) RW_COMP(we, be, ke, re, 2)
            RW_LDU(we, be, ke, re, 4) RW_COMP(wo, bo, ko, ro, 3)
            RW_LDU(wo, bo, ko, ro, 5) RW_COMP(we, be, ke, re, 4)
            RW_LDU(we, be, ke, re, 6) RW_COMP(wo, bo, ko, ro, 5)
            RW_LDU(wo, bo, ko, ro, 7) RW_COMP(we, be, ke, re, 6)
            const float vvn = (float)*(const LAS f16*)(wl + RWA_VPL + ((t2 + 1) & 15) * RWA_VROW + lane_ * 2); const float inv2n = *(const LAS float*)(wl + RWA_INV + ((t2 + 1) & 15) * 4);
            RW_LDA(Aa, rc + RWA_REC, 0) RW_LDA(Ab, rc + RWA_REC, 1)
            RW_COMP(wo, bo, ko, ro, 7)
            vv = vvn; inv2 = inv2n;
            *(f16*)((char*)MIX + ((mb + t2) * (unsigned)DM + (unsigned)(h * 64 + lane_)) * 2u) = (f16)(((ya[0] + ya[1]) + (ya[2] + ya[3])) + ((ya[4] + ya[5]) + (ya[6] + ya[7])));
            *(f16*)((char*)QT + ((mb + t2) * (unsigned)RW_W + (unsigned)(h * 64 + lane_)) * 2u) = (f16)(((qa[0] + qa[1]) + (qa[2] + qa[3])) + ((qa[4] + qa[5]) + (qa[6] + qa[7])));
        }
#undef RW_LDA
#undef RW_SA
#undef RW_LDU
#undef RW_COMP
    }
    store_row64_f16(RL + (((size_t)bh * NCH + c) * 64 + lane) * 64, L);
    f16* pt = PT + ((size_t)bh * NCH + c) * 4096;
#pragma unroll
    for (int k = 0; k < 64; ++k) pt[k * 64 + lane] = (f16)P[k];
}

constexpr int HGA_REC = 768, HGA_TB = 8  , HGA_V = HGA_TB * HGA_REC, HGA_HEAD = HGA_V + HGA_TB * 128, HGA_BYTES = 2 * HGA_HEAD;
template <int NH>
__device__ __forceinline__ void hgrn_waveA(const Args& a, int l, int b, int c, int h0, LAS unsigned char* wl) {
    char* U = (char*)(a.ws + WS_U); char* MIX = (char*)(a.ws + WS_MIX); f16* HL = (f16*)(a.ws + WS_HL); float* DC = (float*)(a.ws + WS_DC);
    const float* lbr = a.in[16];
    float S[NH][64]; float dpr[NH];
#pragma unroll
    for (int j = 0; j < NH; ++j) { dpr[j] = 1.f;
#pragma unroll
        for (int k = 0; k < 64; ++k) S[j][k] = 0.f; }
#pragma unroll 1
    for (int blk = 0; blk < CH / HGA_TB; ++blk) {
        const int lane_ = lane_now();
        const unsigned mb = (unsigned)(b * SEQ + c * CH + blk * HGA_TB);
        {
            f16 fr[NH][HGA_TB], qr[NH][HGA_TB], vr[NH][HGA_TB];
#pragma unroll
            for (int j = 0; j < NH; ++j)
#pragma unroll
                for (int tk = 0; tk < HGA_TB; ++tk) { const char* ur = U + (mb + tk) * (unsigned)(NU * 2) + (unsigned)((h0 + j) * 64 + lane_) * 2u; fr[j][tk] = *(const f16*)(ur + C_HGF * 2); qr[j][tk] = *(const f16*)(ur + C_HGQ * 2); vr[j][tk] = *(const f16*)(ur + C_HGI * 2); }
#pragma unroll
            for (int j = 0; j < NH; ++j) { const int col = (h0 + j) * 64 + lane_;
                const float lb = (l == 0) ? 0.f : sigmoidf_(lbr[384 + col] - lbr[col]);
                float dp = dpr[j];
#pragma unroll
                for (int tk = 0; tk < HGA_TB; ++tk) {
                    const float f = lb + (1.0f - lb) * sigmoidf_((float)fr[j][tk]);
                    LAS unsigned char* rec = wl + j * HGA_HEAD + tk * HGA_REC;
                    *(LAS float*)(rec + lane_ * 4) = f; *(LAS float*)(rec + 256 + lane_ * 4) = 1.0f - f; *(LAS float*)(rec + 512 + lane_ * 4) = (float)qr[j][tk];
                    *(LAS f16*)(wl + j * HGA_HEAD + HGA_V + tk * 128 + lane_ * 2) = vr[j][tk];
                    dp *= f;
                    *(f16*)(U + (mb + tk) * (unsigned)(NU * 2) + (unsigned)(C_HGQ + col) * 2u) = (f16)((float)qr[j][tk] * dp);
                }
                dpr[j] = dp; }
        }
        asm volatile("s_waitcnt lgkmcnt(0)" ::: "memory");
#define HG_LD(F, K, Q, rcp, g) { F[0] = *(const LAS f32x4*)((rcp) + (g) * 32); F[1] = *(const LAS f32x4*)((rcp) + (g) * 32 + 16); K[0] = *(const LAS f32x4*)((rcp) + 256 + (g) * 32); K[1] = *(const LAS f32x4*)((rcp) + 256 + (g) * 32 + 16); \
            Q[0] = *(const LAS f32x4*)((rcp) + 512 + (g) * 32); Q[1] = *(const LAS f32x4*)((rcp) + 512 + (g) * 32 + 16); }
#define HG_COMP(Sx, vi, F, K, Q, g) { float tt[8]; \
            _Pragma("unroll") for (int jj = 0; jj < 8; ++jj) tt[jj] = mul_asm(vi, K[jj >> 2][jj & 3]); \
            _Pragma("unroll") for (int jj = 0; jj < 8; ++jj) Sx[8 * (g) + jj] = fma_asm(Sx[8 * (g) + jj], F[jj >> 2][jj & 3], tt[jj]); \
            _Pragma("unroll") for (int jj = 0; jj < 8; ++jj) oa[jj] = fma_asm(Sx[8 * (g) + jj], Q[jj >> 2][jj & 3], oa[jj]); }
#define HG_HEAD(Sx, vi, rcp, rcn, oo) { float oa[8]; _Pragma("unroll") for (int jj = 0; jj < 8; ++jj) oa[jj] = 0.f; \
            HG_LD(fo, ko, qo, rcp, 1) HG_COMP(Sx, vi, fe, ke, qe, 0) \
            HG_LD(fe, ke, qe, rcp, 2) HG_COMP(Sx, vi, fo, ko, qo, 1) \
            HG_LD(fo, ko, qo, rcp, 3) HG_COMP(Sx, vi, fe, ke, qe, 2) \
            HG_LD(fe, ke, qe, rcp, 4) HG_COMP(Sx, vi, fo, ko, qo, 3) \
            HG_LD(fo, ko, qo, rcp, 5) HG_COMP(Sx, vi, fe, ke, qe, 4) \
            HG_LD(fe, ke, qe, rcp, 6) HG_COMP(Sx, vi, fo, ko, qo, 5) \
            HG_LD(fo, ko, qo, rcp, 7) HG_COMP(Sx, vi, fe, ke, qe, 6) \
            HG_LD(fe, ke, qe, rcn, 0) HG_COMP(Sx, vi, fo, ko, qo, 7) \
            oo = ((oa[0] + oa[1]) + (oa[2] + oa[3])) + ((oa[4] + oa[5]) + (oa[6] + oa[7])); }
        f32x4 fe[2], ke[2], qe[2], fo[2], ko[2], qo[2];
        HG_LD(fe, ke, qe, wl, 0)
        f16 vh[NH], vn[NH];
#pragma unroll
        for (int j = 0; j < NH; ++j) vh[j] = *(const LAS f16*)(wl + j * HGA_HEAD + HGA_V + lane_ * 2);
#pragma unroll 1
        for (int t2 = 0; t2 < HGA_TB; ++t2) {
            const LAS unsigned char* rc = wl + t2 * HGA_REC;
#pragma unroll
            for (int j = 0; j < NH; ++j) vn[j] = *(const LAS f16*)(wl + j * HGA_HEAD + HGA_V + ((t2 + 1) & (HGA_TB - 1)) * 128 + lane_ * 2);
            float oo[NH];
#pragma unroll
            for (int j = 0; j < NH; ++j) { const float vi = (float)vh[j];
                const LAS unsigned char* rcp = rc + j * HGA_HEAD; const LAS unsigned char* rcn = (j + 1 < NH) ? rc + (j + 1) * HGA_HEAD : rc + HGA_REC;
                HG_HEAD(S[j], vi, rcp, rcn, oo[j]) }
            char* mo = MIX + ((mb + t2) * (unsigned)DM + (unsigned)(384 + h0 * 64 + lane_)) * 2u;
#pragma unroll
            for (int j = 0; j < NH; ++j) { *(f16*)(mo + 128 * j) = (f16)oo[j]; vh[j] = vn[j]; }
        }
#undef HG_LD
#undef HG_COMP
#undef HG_HEAD
    }
    const int lane2 = lane_now();
#pragma unroll
    for (int j = 0; j < NH; ++j) { const int bh = b * 6 + h0 + j; store_row64_f16(HL + (((size_t)bh * NCH + c) * 64 + lane2) * 64, S[j]);
        DC[((size_t)bh * NCH + c) * 64 + lane2] = dpr[j]; }
}

__device__ __forceinline__ void lru_waveA(const Args& a, int l, int b, int c, int g, LAS unsigned char* wl) {
    const int ln = lane_now();
    const char* Ub = (const char*)(a.ws + WS_U); char* MIXb = (char*)(a.ws + WS_MIX); char* CA = (char*)(a.ws + WS_CA); float* LA = (float*)(a.ws + WS_LA); float* LH = (float*)(a.ws + WS_LH);
    const float* cw = a.in[18] + l * 4 * 256 + g * 64; const float* cb = a.in[19] + l * 256 + g * 64;
    const float* ba = a.in[21] + l * 256 + g * 64; const float* bx = a.in[23] + l * 256 + g * 64; const float* lam = a.in[24] + l * 256 + g * 64;
    const char* WAT = (const char*)(a.ws + WS_WAT) + (size_t)(l * 4 + g) * 8192; const char* WXT = (const char*)(a.ws + WS_WXT) + (size_t)(l * 4 + g) * 8192;
    LAS unsigned char* Y = wl;
    const unsigned mrow0 = (unsigned)(b * SEQ + c * CH);
#pragma unroll 1
    for (int ib = 0; ib < 8; ib += 4) {
        f16x8 xr[4][4];
#pragma unroll
        for (int it = 0; it < 4; ++it) { const int item = ln + 64 * (ib + it), tok = item >> 3, co = item & 7; const int t = c * CH + tok;
#pragma unroll
            for (int jj = 0; jj < 4; ++jj) { const int ts = t - 3 + jj; const unsigned row = (ts >= 0) ? mrow0 + (unsigned)(tok - 3 + jj) : mrow0 + (unsigned)tok;
                xr[it][jj] = *(const f16x8*)(Ub + (row * (unsigned)NU + (unsigned)(C_LRUX + g * 64 + 8 * co)) * 2u); } }
#pragma unroll
        for (int it = 0; it < 4; ++it) { const int item = ln + 64 * (ib + it), tok = item >> 3, co = item & 7; const int t = c * CH + tok;
            const f32x4 b0 = *(const f32x4*)(cb + 8 * co), b1 = *(const f32x4*)(cb + 8 * co + 4);
            float y[8] = {b0[0], b0[1], b0[2], b0[3], b1[0], b1[1], b1[2], b1[3]};
#pragma unroll
            for (int jj = 0; jj < 4; ++jj) { const int ts = t - 3 + jj;
                if (ts >= 0) { const f32x4 w0 = *(const f32x4*)(cw + jj * 256 + 8 * co), w1 = *(const f32x4*)(cw + jj * 256 + 8 * co + 4);
#pragma unroll
                    for (int i = 0; i < 8; ++i) y[i] += (i < 4 ? w0[i & 3] : w1[i & 3]) * (float)xr[it][jj][i]; } }
            *(LAS f16x8*)(Y + tok * 144 + co * 16) = pack8(y); } }
    asm volatile("s_waitcnt lgkmcnt(0)" ::: "memory");
    const int tl = ln & 15, fq = ln >> 4;
    float sp[16], cy[16], cp[16];
#pragma unroll
    for (int nt = 0; nt < 4; ++nt) { const f32x4 lm4 = *(const f32x4*)(lam + 16 * nt + 4 * fq);
#pragma unroll
        for (int i = 0; i < 4; ++i) { sp[nt * 4 + i] = log1pf(__expf(-lm4[i])); cy[nt * 4 + i] = 0.f; cp[nt * 4 + i] = 1.f; } }
    f16x8 wfa[4][2], wfx[4][2];
#pragma unroll
    for (int nt = 0; nt < 4; ++nt)
#pragma unroll
        for (int s2 = 0; s2 < 2; ++s2) { const unsigned wo = (unsigned)(((16 * nt + (ln & 15)) * 64 + 8 * (ln >> 4) + 32 * s2) * 2); wfa[nt][s2] = *(const f16x8*)(WAT + wo); wfx[nt][s2] = *(const f16x8*)(WXT + wo); }
#pragma unroll 1
    for (int tt = 0; tt < 4; ++tt) {
        f16x8 by[2];
#pragma unroll
        for (int s2 = 0; s2 < 2; ++s2) by[s2] = *(const LAS f16x8*)(Y + (16 * tt + tl) * 144 + (8 * fq + 32 * s2) * 2);
        const unsigned m = mrow0 + (unsigned)(16 * tt + tl);
#pragma unroll
        for (int nt = 0; nt < 4; ++nt) {
            f32x4 ra = (f32x4){0.f, 0.f, 0.f, 0.f}, rx = ra;
#pragma unroll
            for (int s2 = 0; s2 < 2; ++s2) { ra = __builtin_amdgcn_mfma_f32_16x16x32_f16(wfa[nt][s2], by[s2], ra, 0, 0, 0); rx = __builtin_amdgcn_mfma_f32_16x16x32_f16(wfx[nt][s2], by[s2], rx, 0, 0, 0); }
            const int ch0 = 16 * nt + 4 * fq;
            const f32x4 ba4 = *(const f32x4*)(ba + ch0), bx4 = *(const f32x4*)(bx + ch0);
            const f16x4 y4 = *(const LAS f16x4*)(Y + (16 * tt + tl) * 144 + ch0 * 2);
            f16x4 ho, co;
#pragma unroll
            for (int i = 0; i < 4; ++i) { const int q = nt * 4 + i;
                const float r = sigmoidf_(ra[i] + ba4[i]), ig = sigmoidf_(rx[i] + bx4[i]);
                const float la = -8.0f * r * sp[q];
                float av = __expf(la), uv = sqrtf(one_minus_exp_(2.0f * la)) * (ig * (float)y4[i]);
#define LRU_SCAN(d) { const float ap = __builtin_bit_cast(float, __builtin_amdgcn_update_dpp(0x3f800000, __builtin_bit_cast(int, av), 0x110 + (d), 0xf, 0xf, false)); \
                      const float up = __builtin_bit_cast(float, __builtin_amdgcn_update_dpp(0, __builtin_bit_cast(int, uv), 0x110 + (d), 0xf, 0xf, false)); \
                      uv = av * up + uv; av = av * ap; }
                LRU_SCAN(1) LRU_SCAN(2) LRU_SCAN(4) LRU_SCAN(8)
#undef LRU_SCAN
                const float hl = uv + av * cy[q], ca = av * cp[q];
                ho[i] = (f16)hl; co[i] = (f16)ca;
                cy[q] = __builtin_bit_cast(float, __builtin_amdgcn_ds_bpermute((ln | 15) << 2, __builtin_bit_cast(int, hl)));
                cp[q] = __builtin_bit_cast(float, __builtin_amdgcn_ds_bpermute((ln | 15) << 2, __builtin_bit_cast(int, ca)));
            }
            *(f16x4*)(MIXb + (m * (unsigned)DM + 768u + (unsigned)(g * 64 + ch0)) * 2u) = ho; *(f16x4*)(CA + (m * 256u + (unsigned)(g * 64 + ch0)) * 2u) = co;
        }
    }
    if (tl == 15) {
#pragma unroll
        for (int q = 0; q < 16; ++q) { const int ch = g * 64 + 16 * (q >> 2) + 4 * fq + (q & 3); LA[((size_t)b * NCH + c) * 256 + ch] = cp[q]; LH[((size_t)b * NCH + c) * 256 + ch] = cy[q]; } }
}

__device__ __forceinline__ void phaseA(const Args& a, int l, int task, LAS unsigned char* lds, int tid) {
    asm volatile("" : "+v"(tid));
    const int lane = tid & 63, wave = __builtin_amdgcn_readfirstlane(tid >> 6);
    const int b = task / NCH, c = task % NCH;
    const f16* U = (const f16*)(a.ws + WS_U); f16* MIX = (f16*)(a.ws + WS_MIX); f16* VF = (f16*)(a.ws + WS_VF); f16* VP = (f16*)(a.ws + WS_VP);
    f16* QT = (f16*)(a.ws + WS_QT); f16* PT = (f16*)(a.ws + WS_PT); f16* RL = (f16*)(a.ws + WS_RL); float* BONG = (float*)(a.ws + WS_BON);
    {
        LAS f16* prm = (LAS f16*)(lds + PRM_OFF); LAS float* prw0 = (LAS float*)(lds + PRM_OFF + PRM_W0_BYTE);
        for (int i = tid; i < PRM_HALVES + 384; i += NT) {
            if (i < 1280) prm[i] = (f16)a.in[3][l * RW_SHIFT + i];
            else if (i < PRM_HALVES) { const int q = (i - 1280) / 384, cc = (i - 1280) % 384;
                prm[i] = (f16)((q == 0) ? a.in[6][l * RW_W + cc] : (q == 1) ? a.in[11][l * RW_W + cc] : (q == 2) ? a.in[12][l * RW_W + cc] : (q == 3) ? a.in[13][l * RW_W + cc] : a.in[8][cc]); }
            else prw0[i - PRM_HALVES] = a.in[4][l * RW_W + (i - PRM_HALVES)]; }
        __syncthreads();
        if (wave < RW_H) { rwkv_waveA(a, l, b, c, wave, lds + wave * RWA_BYTES, lds + PRM_OFF, lane);
                           if (wave < 4) lru_waveA(a, l, b, c, wave, lds + wave * RWA_BYTES); }
        else { LAS unsigned char* hw = lds + RW_H * RWA_BYTES + (wave - RW_H) * HGA_BYTES;
               hgrn_waveA<2>(a, l, b, c, 2 * (wave - RW_H), hw); hgrn_waveA<1>(a, l, b, c, 4 + (wave - RW_H), hw); }
        __syncthreads();
    }
}

constexpr int PB_SLOT = 16384, PB_NS = 8, PB_AHEAD = 6, NGRP = NCH / 8;
#define ARENA(ws, off) ((char*)(ws) + WS_U + (size_t)((off) >> 11) * (size_t)(NU * 2) + (size_t)((off) & 2047))
constexpr size_t AR_PGT = 0, AR_LG = 2u << 20, AR_SG = 4u << 20;
#define PB_SWZ(row, o) ((row) * 128 + (((((o) >> 4) ^ ((row) & 7)) << 4) | ((o) & 15)))
template <bool ADD_L>
__device__ __forceinline__ void pb_step(f32x4 (&Sacc)[4], const LAS unsigned char* sl, int xrow, int vl, int fq) {
    f16x8 Bhi[2], Blo[2];
#pragma unroll
    for (int mt = 0; mt < 4; ++mt)
#pragma unroll
        for (int i = 0; i < 4; ++i) { const f16 hi = (f16)Sacc[mt][i]; const f16 lo = (f16)(Sacc[mt][i] - (float)hi); Bhi[mt >> 1][4 * (mt & 1) + i] = hi; Blo[mt >> 1][4 * (mt & 1) + i] = lo; }
#pragma unroll
    for (int mt = 0; mt < 4; ++mt) {
        f32x4 d = (f32x4){0.f, 0.f, 0.f, 0.f};
        if (ADD_L) { const f16x4 l4 = *(const LAS f16x4*)(sl + 8192 + PB_SWZ(xrow, 32 * mt + 8 * fq)); d = (f32x4){(float)l4[0], (float)l4[1], (float)l4[2], (float)l4[3]}; }
#pragma unroll
        for (int s = 0; s < 2; ++s) { const u32x2 a0 = *(const LAS u32x2*)(sl + PB_SWZ(16 * mt + vl, 64 * s + 8 * fq)), a1 = *(const LAS u32x2*)(sl + PB_SWZ(16 * mt + vl, 64 * s + 32 + 8 * fq));
            u32x4 aw; aw.x = a0.x; aw.y = a0.y; aw.z = a1.x; aw.w = a1.y; const f16x8 af = __builtin_bit_cast(f16x8, aw);
            d = __builtin_amdgcn_mfma_f32_16x16x32_f16(af, Bhi[s], d, 0, 0, 0); d = __builtin_amdgcn_mfma_f32_16x16x32_f16(af, Blo[s], d, 0, 0, 0); }
        Sacc[mt] = d; }
}
__device__ __forceinline__ void pb_stage8(const Args& a, LAS unsigned char* lds, int bh, int c0, int wave, int lane) {
    const char* PT = (const char*)(a.ws + WS_PT) + ((size_t)bh * NCH + c0) * 8192; const char* RL = (const char*)(a.ws + WS_RL) + ((size_t)bh * NCH + c0) * 8192;
    const int lq = wave * 64 + lane, lrow = lq >> 3, lpp = lq & 7; const unsigned lsrc = (unsigned)(lrow * 128 + ((lpp ^ (lrow & 7)) << 4));
#pragma unroll
    for (int sl = 0; sl < 8; ++sl) { const unsigned so = (unsigned)(sl * PB_SLOT + wave * 1024); const size_t go = (size_t)sl * 8192 + lsrc;
        __builtin_amdgcn_global_load_lds((const unsigned*)(PT + go), (LAS unsigned*)(lds + so), 16, 0, 0);
        __builtin_amdgcn_global_load_lds((const unsigned*)(RL + go), (LAS unsigned*)(lds + so + 8192), 16, 0, 0); }
    asm volatile("s_waitcnt vmcnt(0)" ::: "memory");
    __builtin_amdgcn_s_barrier();
}
__device__ __forceinline__ void phaseB1(const Args& a, LAS unsigned char* lds, int tid) {
    asm volatile("" : "+v"(tid));
    const int lane = tid & 63, wave = __builtin_amdgcn_readfirstlane(tid >> 6);
    for (int task = blockIdx.x; task < 12 * NGRP; task += gridDim.x) {
        const int bh = task / NGRP, g = task % NGRP, c0 = 8 * g;
        pb_stage8(a, lds, bh, c0, wave, lane);
        const int vt = wave & 3, vl = lane & 15, fq = lane >> 4, xr = 16 * vt + vl;
        f32x4 X[4];
        if (wave < 4) {
#pragma unroll
            for (int mt = 0; mt < 4; ++mt) { const f16x4 l4 = *(const LAS f16x4*)(lds + 8192 + PB_SWZ(xr, 32 * mt + 8 * fq)); X[mt] = (f32x4){(float)l4[0], (float)l4[1], (float)l4[2], (float)l4[3]}; }
#pragma unroll 1
            for (int s = 1; s < 8; ++s) pb_step<true>(X, lds + s * PB_SLOT, xr, vl, fq);
#pragma unroll
            for (int mt = 0; mt < 4; ++mt) { f16x4 o;
#pragma unroll
                for (int i = 0; i < 4; ++i) o[i] = (f16)X[mt][i];
                *(f16x4*)ARENA(a.ws, AR_LG + ((size_t)bh * NGRP + g) * 8192 + (size_t)((xr * 64 + 16 * mt + 4 * fq) * 2)) = o; }
        } else {
#pragma unroll
            for (int mt = 0; mt < 4; ++mt)
#pragma unroll
                for (int i = 0; i < 4; ++i) X[mt][i] = (16 * mt + 4 * fq + i == xr) ? 1.f : 0.f;
#pragma unroll 1
            for (int s = 0; s < 8; ++s) pb_step<false>(X, lds + s * PB_SLOT, xr, vl, fq);
#pragma unroll
            for (int mt = 0; mt < 4; ++mt)
#pragma unroll
                for (int i = 0; i < 4; ++i) *(f16*)ARENA(a.ws, AR_PGT + ((size_t)bh * NGRP + g) * 8192 + (size_t)(((16 * mt + 4 * fq + i) * 64 + xr) * 2)) = (f16)X[mt][i];
        }
        asm volatile("s_waitcnt vmcnt(0) lgkmcnt(0)" ::: "memory");
        __builtin_amdgcn_s_barrier();
    }
}
__device__ __forceinline__ void phaseB3(const Args& a, LAS unsigned char* lds, int tid) {
    asm volatile("" : "+v"(tid));
    const int lane = tid & 63, wave = __builtin_amdgcn_readfirstlane(tid >> 6);
    for (int task = blockIdx.x; task < 12 * NGRP; task += gridDim.x) {
        const int bh = task / NGRP, g = task % NGRP, c0 = 8 * g;
        pb_stage8(a, lds, bh, c0, wave, lane);
        if (wave < 4) {
            const int vt = wave, vl = lane & 15, fq = lane >> 4, xr = 16 * vt + vl;
            char* RL = (char*)(a.ws + WS_RL) + ((size_t)bh * NCH + c0) * 8192;
            f32x4 X[4];
#pragma unroll
            for (int mt = 0; mt < 4; ++mt) { const f16x4 s4 = *(const f16x4*)ARENA(a.ws, AR_SG + ((size_t)bh * NGRP + g) * 8192 + (size_t)((xr * 64 + 16 * mt + 4 * fq) * 2)); X[mt] = (f32x4){(float)s4[0], (float)s4[1], (float)s4[2], (float)s4[3]}; }
#pragma unroll 1
            for (int s = 0; s < 8; ++s) {
#pragma unroll
                for (int mt = 0; mt < 4; ++mt) { f16x4 o;
#pragma unroll
                    for (int i = 0; i < 4; ++i) o[i] = (f16)X[mt][i];
                    *(f16x4*)(RL + (size_t)s * 8192 + (xr * 64 + 16 * mt + 4 * fq) * 2) = o; }
                if (s < 7) pb_step<true>(X, lds + s * PB_SLOT, xr, vl, fq);
            }
        }
        asm volatile("s_waitcnt vmcnt(0) lgkmcnt(0)" ::: "memory");
        __builtin_amdgcn_s_barrier();
    }
}
__device__ __forceinline__ void phaseB(const Args& a, LAS unsigned char* lds, int tid) {
    asm volatile("" : "+v"(tid));
    const int lane = tid & 63, wave = __builtin_amdgcn_readfirstlane(tid >> 6);
    const int bx = blockIdx.x;
    if (bx < 12) {
        const int bh = bx;
        const bool loader = wave >= 4;
        const int vt = wave & 3, vl = lane & 15, fq = lane >> 4, v = 16 * vt + vl;
        const int lq = (wave - 4) * 64 + lane, lrow = lq >> 3, lpp = lq & 7;
        const unsigned lsrc = (unsigned)(lrow * 128 + ((lpp ^ (lrow & 7)) << 4));
#define PB_ISSUE(cc) { const unsigned so = (unsigned)(((cc) & (PB_NS - 1)) * PB_SLOT) + (unsigned)((wave - 4) * 1024); const size_t go = ((size_t)bh * NGRP + (cc)) * 8192 + lsrc; \
            __builtin_amdgcn_global_load_lds((const unsigned*)ARENA(a.ws, AR_PGT + go), (LAS unsigned*)(lds + so), 16, 0, 0); \
            __builtin_amdgcn_global_load_lds((const unsigned*)ARENA(a.ws, AR_PGT + go + 4096), (LAS unsigned*)(lds + so + 4096), 16, 0, 0); \
            __builtin_amdgcn_global_load_lds((const unsigned*)ARENA(a.ws, AR_LG + go), (LAS unsigned*)(lds + so + 8192), 16, 0, 0); \
            __builtin_amdgcn_global_load_lds((const unsigned*)ARENA(a.ws, AR_LG + go + 4096), (LAS unsigned*)(lds + so + 12288), 16, 0, 0); }
        if (loader) {
#pragma unroll
            for (int cc = 0; cc < PB_AHEAD; ++cc) PB_ISSUE(cc)
            asm volatile("s_waitcnt vmcnt(20)" ::: "memory");
        }
        __builtin_amdgcn_s_barrier();
        f32x4 Sacc[4];
#pragma unroll
        for (int mt = 0; mt < 4; ++mt) Sacc[mt] = (f32x4){0.f, 0.f, 0.f, 0.f};
#pragma unroll 1
        for (int c = 0; c < NGRP; ++c) {
            if (loader) {
                if (c + PB_AHEAD < NGRP) { PB_ISSUE(c + PB_AHEAD) asm volatile("s_waitcnt vmcnt(20)" ::: "memory"); }
                else asm volatile("s_waitcnt vmcnt(0)" ::: "memory");
            } else {
#pragma unroll
                for (int mt = 0; mt < 4; ++mt) { f16x4 o;
#pragma unroll
                    for (int i = 0; i < 4; ++i) o[i] = (f16)Sacc[mt][i];
                    *(f16x4*)ARENA(a.ws, AR_SG + ((size_t)bh * NGRP + c) * 8192 + (size_t)((v * 64 + 16 * mt + 4 * fq) * 2)) = o; }
                pb_step<true>(Sacc, lds + (c & (PB_NS - 1)) * PB_SLOT, v, vl, fq);
                asm volatile("s_waitcnt lgkmcnt(0)" ::: "memory");
            }
            __builtin_amdgcn_s_barrier();
        }
#undef PB_ISSUE
        asm volatile("s_waitcnt vmcnt(0)" ::: "memory");
    } else if (bx < 12 + 96) {
        const int idx = (bx - 12) * NT + tid; const int bh = idx >> 12, e = idx & 4095, k = e & 63;
        f16* HL = (f16*)(a.ws + WS_HL); const float* DC = (const float*)(a.ws + WS_DC);
        float s = 0.f;
        for (int c0 = 0; c0 < NCH; c0 += 8) { float Lc[8], d[8];
#pragma unroll
            for (int j = 0; j < 8; ++j) { Lc[j] = (float)HL[((size_t)bh * NCH + c0 + j) * 4096 + e]; d[j] = DC[((size_t)bh * NCH + c0 + j) * 64 + k]; }
#pragma unroll
            for (int j = 0; j < 8; ++j) { HL[((size_t)bh * NCH + c0 + j) * 4096 + e] = (f16)s; s = d[j] * s + Lc[j]; } }
    } else if (bx == 12 + 96) {
        const int bb = tid >> 8, ch = tid & 255; const float* LA = (const float*)(a.ws + WS_LA); float* LH = (float*)(a.ws + WS_LH);
        float cy = 0.f;
        for (int c0 = 0; c0 < NCH; c0 += 8) { float A[8], H[8];
#pragma unroll
            for (int j = 0; j < 8; ++j) { const size_t o = ((size_t)bb * NCH + c0 + j) * 256 + ch; A[j] = LA[o]; H[j] = LH[o]; }
#pragma unroll
            for (int j = 0; j < 8; ++j) { const size_t o = ((size_t)bb * NCH + c0 + j) * 256 + ch; LH[o] = cy; cy = A[j] * cy + H[j]; } }
    }
}

__device__ __forceinline__ void phaseC(const Args& a, int l, int task, LAS unsigned char* lds, int tid) {
    asm volatile("" : "+v"(tid));
    const int lane = tid & 63, wave = __builtin_amdgcn_readfirstlane(tid >> 6);
    const int b = task / NCH, c = task % NCH;
    const int tl = lane & 15, fq = lane >> 4, tt = wave & 3, hg = wave >> 2;
    const unsigned m = (unsigned)(b * SEQ + c * CH + 16 * tt + tl);
    const char* U = (const char*)(a.ws + WS_U); char* MIX = (char*)(a.ws + WS_MIX); const char* VP = (const char*)(a.ws + WS_VP);
    const char* QT = (const char*)(a.ws + WS_QT); const char* RL = (const char*)(a.ws + WS_RL); const char* HL = (const char*)(a.ws + WS_HL); const float* BONG = (const float*)(a.ws + WS_BON);
    const unsigned uo = m * (unsigned)(NU * 2);
#pragma unroll
    for (int hh = 0; hh < 3; ++hh) {
        const int h = 3 * hg + hh; const int bh = b * RW_H + h;
        const char* sl = RL + ((size_t)bh * NCH + c) * 8192;
        f16x8 bq[2];
#pragma unroll
        for (int s = 0; s < 2; ++s) bq[s] = *(const f16x8*)(QT + (m * (unsigned)RW_W + (unsigned)(h * 64 + 8 * fq + 32 * s)) * 2u);
        f32x4 D[4];
#pragma unroll
        for (int vt = 0; vt < 4; ++vt) { const f16x4 yl = *(const f16x4*)(MIX + (m * (unsigned)DM + (unsigned)(h * 64 + 16 * vt + 4 * fq)) * 2u);
            f32x4 d = (f32x4){(float)yl[0], (float)yl[1], (float)yl[2], (float)yl[3]};
#pragma unroll
            for (int s = 0; s < 2; ++s) d = __builtin_amdgcn_mfma_f32_16x16x32_f16(*(const f16x8*)(sl + ((16 * vt + tl) * 64 + 8 * fq + 32 * s) * 2), bq[s], d, 0, 0, 0);
            D[vt] = d; }
        float sm = 0.f;
#pragma unroll
        for (int vt = 0; vt < 4; ++vt) sm += (D[vt][0] + D[vt][1]) + (D[vt][2] + D[vt][3]);
        sm += shfl_xor_f(sm, 16); sm += shfl_xor_f(sm, 32);
        const float mean = sm * (1.0f / 64.0f); float vr = 0.f;
#pragma unroll
        for (int vt = 0; vt < 4; ++vt)
#pragma unroll
            for (int i = 0; i < 4; ++i) { const float d = D[vt][i] - mean; vr += d * d; }
        vr += shfl_xor_f(vr, 16); vr += shfl_xor_f(vr, 32);
        const float rstd = rsq_(vr * (1.0f / 64.0f) + 64e-5f);
        const float bon = BONG[m * 8u + (unsigned)h];
        const float* ln_w = a.in[14] + l * RW_W; const float* ln_b = a.in[15] + l * RW_W;
#pragma unroll
        for (int vt = 0; vt < 4; ++vt) { const unsigned col = (unsigned)(h * 64 + 16 * vt + 4 * fq);
            const f16x4 vp = *(const f16x4*)(VP + (m * (unsigned)RW_W + col) * 2u), z4 = *(const f16x4*)(U + uo + ((unsigned)C_RWZ + col) * 2u);
            const f32x4 lw = *(const f32x4*)(ln_w + col), lb = *(const f32x4*)(ln_b + col);
            f16x4 o;
#pragma unroll
            for (int i = 0; i < 4; ++i) o[i] = (f16)(((D[vt][i] - mean) * rstd * lw[i] + lb[i] + bon * (float)vp[i]) * siluf_((float)z4[i]));
            *(f16x4*)(MIX + (m * (unsigned)DM + col) * 2u) = o; }
    }
#pragma unroll
    for (int hh = 0; hh < 3; ++hh) {
        const int h = 3 * hg + hh; const int bh = b * 6 + h;
        const char* sl = HL + ((size_t)bh * NCH + c) * 8192;
        f16x8 bq[2];
#pragma unroll
        for (int s = 0; s < 2; ++s) bq[s] = *(const f16x8*)(U + uo + (unsigned)(C_HGQ + h * 64 + 8 * fq + 32 * s) * 2u);
        f32x4 D[4];
#pragma unroll
        for (int vt = 0; vt < 4; ++vt) { const f16x4 ol = *(const f16x4*)(MIX + (m * (unsigned)DM + (unsigned)(384 + h * 64 + 16 * vt + 4 * fq)) * 2u);
            f32x4 d = (f32x4){(float)ol[0], (float)ol[1], (float)ol[2], (float)ol[3]};
#pragma unroll
            for (int s = 0; s < 2; ++s) d = __builtin_amdgcn_mfma_f32_16x16x32_f16(*(const f16x8*)(sl + ((16 * vt + tl) * 64 + 8 * fq + 32 * s) * 2), bq[s], d, 0, 0, 0);
            D[vt] = d; }
        float ss = 0.f;
#pragma unroll
        for (int vt = 0; vt < 4; ++vt) ss += (D[vt][0] * D[vt][0] + D[vt][1] * D[vt][1]) + (D[vt][2] * D[vt][2] + D[vt][3] * D[vt][3]);
        ss += shfl_xor_f(ss, 16); ss += shfl_xor_f(ss, 32);
        const float rs = rsq_(ss * (1.0f / 64.0f) + 1e-6f);
        const float* nw = a.in[17] + l * 384;
#pragma unroll
        for (int vt = 0; vt < 4; ++vt) { const unsigned col = (unsigned)(h * 64 + 16 * vt + 4 * fq);
            const f16x4 z4 = *(const f16x4*)(U + uo + ((unsigned)C_HGZ + col) * 2u); const f32x4 w4 = *(const f32x4*)(nw + col);
            f16x4 o;
#pragma unroll
            for (int i = 0; i < 4; ++i) o[i] = (f16)(D[vt][i] * rs * w4[i] * siluf_((float)z4[i]));
            *(f16x4*)(MIX + (m * (unsigned)DM + 384u + col) * 2u) = o; }
    }
    {
        const char* CA = (const char*)(a.ws + WS_CA); const float* LH = (const float*)(a.ws + WS_LH) + ((size_t)b * NCH + c) * 256;
#pragma unroll
        for (int q = 0; q < 4; ++q) { const unsigned ch0 = (unsigned)(128 * hg + 32 * fq + 8 * q);
            const f16x8 hl = *(const f16x8*)(MIX + (m * (unsigned)DM + 768u + ch0) * 2u), ca = *(const f16x8*)(CA + (m * 256u + ch0) * 2u), z8 = *(const f16x8*)(U + uo + ((unsigned)C_LRUZ + ch0) * 2u);
            const f32x4 c0 = *(const f32x4*)(LH + ch0), c1 = *(const f32x4*)(LH + ch0 + 4);
            f16x8 o;
#pragma unroll
            for (int i = 0; i < 8; ++i) o[i] = (f16)(((float)hl[i] + (float)ca[i] * (i < 4 ? c0[i & 3] : c1[i & 3])) * siluf_((float)z8[i]));
            *(f16x8*)(MIX + (m * (unsigned)DM + 768u + ch0) * 2u) = o; }
    }
}
#define XB_TMO      128
#define XB_XCNT(j)  (256  + 64 * (j))
#define XB_XSUB(j)  (1280 + 64 * (j))
#define XB_XGEN(j)  (2304 + 64 * (j))
#define XB_TOP      3328
#define XB_TOPGEN   3392
#define XCD_BAR_WORDS 3456
#define XB_SPIN_CAP (1u << 18)

__device__ __forceinline__ unsigned xb_ld(unsigned* p)              { return __hip_atomic_load(p, __ATOMIC_RELAXED, __HIP_MEMORY_SCOPE_AGENT); }
__device__ __forceinline__ unsigned xb_add(unsigned* p, unsigned v) { return __hip_atomic_fetch_add(p, v, __ATOMIC_RELAXED, __HIP_MEMORY_SCOPE_AGENT); }
__device__ __forceinline__ unsigned xb_xcc_id() { return (unsigned)__builtin_amdgcn_s_getreg((3 << 11) | 20) & 0xFu; }
#define XB_SPIN(cond, bar) do { unsigned _sp = 0; while (cond) { __builtin_amdgcn_s_sleep(1); \
    if ((++_sp & 255u) == 0u) { if (xb_ld(&(bar)[XB_TMO])) break; if (_sp > XB_SPIN_CAP) { atomicAdd(&(bar)[XB_TMO], 1u); break; } } } } while (0)

struct XcdBarrier {
    unsigned* bar; unsigned x; int isw0;
    volatile LAS unsigned* st;
};

__device__ __forceinline__ XcdBarrier xcd_barrier_post(unsigned* bar, volatile LAS unsigned* st, int isw0) {
    XcdBarrier b; b.bar = bar; b.x = xb_xcc_id(); b.st = st; b.isw0 = isw0;
    if (isw0 && lane_now() == 0) (void)xb_add(&bar[XB_XCNT(b.x)], 1u);
    return b;
}
__device__ __forceinline__ void xcd_barrier_complete(unsigned* bar, unsigned x, unsigned& nloc, unsigned& nx) {
    const unsigned G = gridDim.x * gridDim.y * gridDim.z;
    unsigned sum, cnt, mine, sp = 0u;
    for (;;) {
        sum = 0u; cnt = 0u; mine = 0u;
#pragma unroll
        for (unsigned j = 0; j < 16; ++j) { const unsigned c = xb_ld(&bar[XB_XCNT(j)]); sum += c; cnt += (c > 0u) ? 1u : 0u; mine = (j == x) ? c : mine; }
        if (sum == G) break;
        __builtin_amdgcn_s_sleep(1);
        if ((++sp & 255u) == 0u) { if (xb_ld(&bar[XB_TMO])) break; if (sp > XB_SPIN_CAP) { atomicAdd(&bar[XB_TMO], 1u); break; } }
    }
    nloc = mine > 0u ? mine : 1u; nx = cnt > 0u ? cnt : 1u;
}

__device__ __forceinline__ void xcd_barrier(const XcdBarrier& b) {
    asm volatile("s_waitcnt vmcnt(0)" ::: "memory");
    __syncthreads();
    if (b.isw0 && lane_now() == 0) {
        unsigned* bar = b.bar;
        __builtin_amdgcn_s_waitcnt(0);
        unsigned nloc = b.st[0], nx = b.st[1];
        if (nloc == 0u) { xcd_barrier_complete(bar, b.x, nloc, nx); b.st[0] = nloc; b.st[1] = nx; }
        const unsigned old = xb_add(&bar[XB_XSUB(b.x)], 1u);
        const unsigned gen = old / nloc;
        if (old + 1u == (gen + 1u) * nloc) {
            __builtin_amdgcn_fence(__ATOMIC_RELEASE, "agent");
            asm volatile("s_waitcnt vmcnt(0)" ::: "memory");
            const unsigned og = xb_add(&bar[XB_TOP], 1u);
            const unsigned tg = og / nx;
            if (og + 1u == (tg + 1u) * nx) xb_add(&bar[XB_TOPGEN], 1u);
            else XB_SPIN(xb_ld(&bar[XB_TOPGEN]) == tg, bar);
            __builtin_amdgcn_fence(__ATOMIC_ACQUIRE, "agent");
            xb_add(&bar[XB_XGEN(b.x)], 1u);
            asm volatile("s_waitcnt vmcnt(0)" ::: "memory");
        } else {
            XB_SPIN(xb_ld(&bar[XB_XGEN(b.x)]) == gen, bar);
            __builtin_amdgcn_fence(__ATOMIC_ACQUIRE, "agent");
            asm volatile("s_waitcnt vmcnt(0)" ::: "memory");
        }
    }
    __syncthreads();
}

constexpr size_t WS_BAR = 16384;
constexpr size_t WS_PCNT = 32768;
constexpr int MISC_OFF = LDS_BYTES - 16;
__global__ void __launch_bounds__(NT, 2) fwd(Args args) {
    extern __shared__ __attribute__((aligned(16))) unsigned char lds_raw[];
    LAS unsigned char* lds = (LAS unsigned char*)lds_raw;
    cg::grid_group grid = cg::this_grid();
    const int wave = __builtin_amdgcn_readfirstlane((int)threadIdx.x >> 6);
#define TID_NOW() (wave * 64 + lane_now())
    const int tid = TID_NOW(); const int lane = tid & 63;
    if (wave == 0 && lane < 4) ((LAS unsigned*)(lds + MISC_OFF))[lane] = 0u;
    __syncthreads();
    XcdBarrier xbar = xcd_barrier_post((unsigned*)(args.ws + WS_BAR), (volatile LAS unsigned*)(lds + MISC_OFF), __builtin_amdgcn_readfirstlane(wave == 0 ? 1 : 0));
#define GRID_BAR() do { XcdBarrier xb_ = xbar; xb_.st = (volatile LAS unsigned*)(lds + MISC_OFF); asm volatile("" : "+s"(xb_.bar), "+s"(xb_.x)); xcd_barrier(xb_); } while (0)
    const int G = gridDim.x, gw = blockIdx.x * NWAVES + wave, NGW = G * NWAVES;
    unsigned char* ws = args.ws;
    unsigned short* XN = (unsigned short*)(ws + WS_XN);
    {
        LAS float* scr = (LAS float*)(lds + wave * 8704);
        constexpr int I_IN = (DM / 64) * (NIN / 32), I_OUT = (DM / 64) * (DM / 32), NITEMS = DEPTH * (I_IN + I_OUT);
        for (int it = gw; it < NITEMS; it += NGW) {
            int r = it; const int l = r / (I_IN + I_OUT); r -= l * (I_IN + I_OUT);
            if (r < I_IN) p0_transpose_item(args.in[2] + (size_t)l * DM * NIN, DM, NIN, (unsigned short*)(ws + WS_WIN + l * WIN_L), scr, r, lane, l == 0 ? nullptr : args.in[1] + DM);
            else p0_transpose_item(args.in[25] + (size_t)l * DM * DM, DM, DM, (unsigned short*)(ws + WS_WOUT + l * WOUT_L), scr, r - I_IN, lane, nullptr);
        }
        for (int i = gw; i < DEPTH * (NU - NIN) * DM * 2 / 1024; i += NGW) { const int l = i / ((NU - NIN) * DM * 2 / 1024), r = i % ((NU - NIN) * DM * 2 / 1024);
            if (l == 1 && r < 64 * DM * 2 / 1024) continue;
            *(u32x4*)(ws + WS_WIN + l * WIN_L + (size_t)NIN * DM * 2 + (size_t)r * 1024 + lane * 16) = (u32x4){0u, 0u, 0u, 0u}; }
        if (blockIdx.x < 32) {
            LAS f16* TT = (LAS f16*)(lds + 8 * 8704);
            for (int i = tid; i < 64 * RW_W; i += NT) { const int n = i / RW_W, cc = i % RW_W; const float mm = args.in[3][RW_SHIFT + C_V + cc]; TT[n * 392 + cc] = (f16)(((n < 32) ? (1.0f - mm) : mm) * args.in[9][cc * 32 + (n & 31)]); }
            __syncthreads();
            const int tile = blockIdx.x * NWAVES + wave, nt = tile & 3, kt = tile >> 2, tl = lane & 15, fq = lane >> 4;
            const float* wrow = args.in[2] + (size_t)DM * NIN + (size_t)(16 * kt + tl) * NIN + C_V + 8 * fq;
            f32x4 bv[12][2];
#pragma unroll
            for (int s2 = 0; s2 < 12; ++s2) { bv[s2][0] = *(const f32x4*)(wrow + 32 * s2); bv[s2][1] = *(const f32x4*)(wrow + 32 * s2 + 4); }
            f32x4 d = (f32x4){0.f, 0.f, 0.f, 0.f};
#pragma unroll
            for (int s2 = 0; s2 < 12; ++s2) { f16x8 bf;
#pragma unroll
                for (int j = 0; j < 8; ++j) bf[j] = (f16)(j < 4 ? bv[s2][0][j & 3] : bv[s2][1][j & 3]);
                d = __builtin_amdgcn_mfma_f32_16x16x32_f16(*(const LAS f16x8*)(TT + (16 * nt + tl) * 392 + 8 * fq + 32 * s2), bf, d, 0, 0, 0); }
            const float nwk = args.in[1][DM + 16 * kt + tl];
#pragma unroll
            for (int i = 0; i < 4; ++i) ((f16*)(ws + WS_WIN + WIN_L))[(size_t)(NIN + 16 * nt + 4 * fq + i) * DM + 16 * kt + tl] = (f16)(d[i] * nwk);
            __syncthreads();
        }
        for (int i = blockIdx.x * NT + tid; i < 2 * M; i += G * NT) ((float*)(ws + WS_RSS))[i] = 0.f;
        for (int m = gw; m < M; m += 4 * NGW) rms_row4_f16(args.in[0] + (size_t)m * DM, (size_t)NGW * DM, args.in[1], XN + (size_t)m * DM, lane);
        { f16* WUPT = (f16*)(ws + WS_WUPT); f16* AUPT = (f16*)(ws + WS_AUPT); f16* VDNT = (f16*)(ws + WS_VDNT); f16* VUPT = (f16*)(ws + WS_VUPT);
          for (int i = blockIdx.x * NT + tid; i < 122880; i += G * NT) {
              if (i < 49152) { const int ll = i / 24576, r = i % 24576, n = r / 64, k = r % 64; WUPT[i] = (f16)args.in[5][(size_t)ll * 24576 + k * 384 + n]; }
              else if (i < 98304) { const int i2 = i - 49152, ll = i2 / 24576, r = i2 % 24576, n = r / 64, k = r % 64; AUPT[i2] = (f16)args.in[7][(size_t)ll * 24576 + k * 384 + n]; }
              else if (i < 110592) { const int i2 = i - 98304, j2 = i2 / 384, cc = i2 % 384; VDNT[i2] = (f16)args.in[9][cc * 32 + j2]; }
              else { const int i2 = i - 110592, n = i2 / 32, j2 = i2 % 32; VUPT[i2] = (f16)args.in[10][j2 * 384 + n]; } }
          f16* WAT = (f16*)(ws + WS_WAT); f16* WXT = (f16*)(ws + WS_WXT);
          for (int i = blockIdx.x * NT + tid; i < 32768; i += G * NT) { const int lg = i >> 12, r = i & 4095, j = r >> 6, ii = r & 63; WAT[i] = (f16)args.in[20][(size_t)lg * 4096 + ii * 64 + j]; WXT[i] = (f16)args.in[22][(size_t)lg * 4096 + ii * 64 + j]; } }
    }
    if (gridDim.x > 65536u) grid.sync();
    GRID_BAR();
#pragma unroll 1
    for (int l = 0; l < DEPTH; ++l) {
        { pg8::Gemm g{XN, (const unsigned short*)(ws + WS_WIN + l * WIN_L), M, NU, DM}; pg8::StaticOrder S; S.init(M, NU, G, (int)blockIdx.x);
          pg8::EpiF16 E{(unsigned short*)(ws + WS_U), NU, l == 0 ? nullptr : (const float*)(ws + WS_RSS)};
          pg8::gemm_phase<pg8::EpiF16, pg8::StaticOrder, true, true>(lds, g, S, E, wave); }
        GRID_BAR();
        for (int task = blockIdx.x; task < BATCH * NCH; task += G) phaseA(args, l, task, lds, TID_NOW());
        GRID_BAR();
        phaseB1(args, lds, TID_NOW());
        GRID_BAR();
        phaseB(args, lds, TID_NOW());
        GRID_BAR();
        phaseB3(args, lds, TID_NOW());
        GRID_BAR();
        for (int task = blockIdx.x; task < BATCH * NCH; task += G) phaseC(args, l, task, lds, TID_NOW());
        GRID_BAR();
        { pg8::Gemm g{(const unsigned short*)(ws + WS_MIX), (const unsigned short*)(ws + WS_WOUT + l * WOUT_L), M, DM, DM}; pg8::StaticOrder S; S.init(M, DM, G, (int)blockIdx.x);
          if (l + 1 < DEPTH) {
              pg8::EpiRes E{args.in[0], args.out, DM, XN, (float*)(ws + WS_RSS)};
              pg8::gemm_phase<pg8::EpiRes, pg8::StaticOrder, true, true>(lds, g, S, E, wave);
              GRID_BAR();
          } else {
              pg8::EpiResNorm E{args.out, args.out, DM, (float*)(ws + WS_RSS) + M, (unsigned*)(ws + WS_PCNT), args.in[26]};
              pg8::gemm_phase<pg8::EpiResNorm, pg8::StaticOrder, true, true>(lds, g, S, E, wave);
          } }
    }
}

extern "C" void kernel_launch(void* const* d_in, const int* in_sizes, int n_in, void* d_out, int out_size, void* d_ws, size_t ws_size, hipStream_t stream) {
    static int grid = 0;
    if (grid == 0) {
        if (n_in != 27 || in_sizes[0] != M * DM || out_size != M * DM || ws_size < WS_END) { fprintf(stderr, "kernel_launch: unexpected problem: n_in %d in0 %d out %d ws %zu\n", n_in, n_in > 0 ? in_sizes[0] : -1, out_size, ws_size); grid = -1; return; }
        int dev = 0, cus = 0, per_cu = 0;
        hipGetDevice(&dev); hipDeviceGetAttribute(&cus, hipDeviceAttributeMultiprocessorCount, dev);
        if (hipFuncSetAttribute((const void*)fwd, hipFuncAttributeMaxDynamicSharedMemorySize, LDS_BYTES) != hipSuccess) { fprintf(stderr, "kernel_launch: hipFuncSetAttribute failed\n"); grid = -1; return; }
        if (hipOccupancyMaxActiveBlocksPerMultiprocessor(&per_cu, (const void*)fwd, NT, LDS_BYTES) != hipSuccess || per_cu < 1) { fprintf(stderr, "kernel_launch: occupancy query failed (%d)\n", per_cu); grid = -1; return; }
        grid = cus * per_cu;
    }
    if (grid < 0) return;
    if (hipMemsetAsync((char*)d_ws, 0, 65536, stream) != hipSuccess) { fprintf(stderr, "kernel_launch: memset of the barrier words failed\n"); return; }
    Args a{};
    for (int i = 0; i < 27; ++i) a.in[i] = (const float*)d_in[i];
    a.out = (float*)d_out; a.ws = (unsigned char*)d_ws;
    void* kargs[] = {&a};
    hipError_t e = hipLaunchCooperativeKernel((const void*)fwd, dim3(grid), dim3(NT), kargs, LDS_BYTES, stream);
    if (e != hipSuccess) fprintf(stderr, "cooperative launch failed: %s (grid %d)\n", hipGetErrorString(e), grid);
}
```

```cpp
#include <hip/hip_runtime.h>
#include <hip/hip_cooperative_groups.h>
#include <cstdio>
#include <cstdint>
namespace cg = cooperative_groups;
typedef _Float16 f16x8_t __attribute__((ext_vector_type(8)));
#define MK_MFMA(a, b, c) __builtin_amdgcn_mfma_f32_16x16x32_f16(__builtin_bit_cast(f16x8_t, (a)), __builtin_bit_cast(f16x8_t, (b)), (c), 0, 0, 0)
__device__ __forceinline__ int lane_now() { int z; asm volatile("v_mbcnt_lo_u32_b32 %0, -1, 0\n\tv_mbcnt_hi_u32_b32 %0, -1, %0" : "=v"(z)); return z; }
__device__ __forceinline__ float shfl_xor_f(float v, int mask) { const int ln = lane_now(); return __builtin_bit_cast(float, __builtin_amdgcn_ds_bpermute((ln ^ mask) << 2, __builtin_bit_cast(int, v))); }
namespace pg8 {
#define PG8_LAS __attribute__((address_space(3)))
typedef unsigned short bf16_t;
typedef short bf16x8 __attribute__((ext_vector_type(8)));
typedef float f32x4 __attribute__((ext_vector_type(4)));
typedef unsigned u32x4 __attribute__((ext_vector_type(4)));
constexpr int BM = 256, BK = 64, HALF = 128, HTB = HALF * BK * 2  , STAGE_BYTES = 8 * HTB, NXCD = 8, WGM = 8;

__host__ __device__ __forceinline__ int lds_byte(int r, int c) { const int st = (r >> 4) * 2 + (c >> 5), rr = r & 15, cc = c & 31, ob = rr * 64 + cc * 2; return st * 1024 + (ob ^ (((ob >> 9) & 1) << 5)); }
__host__ __device__ __forceinline__ void stage_rc(int b, int& R, int& C) { const int st = b / 1024, sb = b % 1024, swz = sb ^ (((sb >> 9) & 1) << 5); R = (st >> 1) * 16 + swz / 64; C = (st & 1) * 32 + (swz % 64) / 2; }
__host__ __device__ __forceinline__ int perm32(int rho) { const int n = rho >> 4, i = rho & 15; return 8 * (i >> 2) + 4 * n + (i & 3); }

struct Unit { int pm, pn; };
struct Gemm { const bf16_t* A; const bf16_t* Bt; int M, N, K; };

struct StaticOrder {
    int nM, nN, nwg, G, c;
    __host__ __device__ void init(int M, int N, int G_, int c_) { nM = M / BM; nN = N / BM; nwg = nM * nN; G = G_; c = c_; }
    __host__ __device__ bool next(int i, Unit& u) const {
        const long L = (long)i * G + c; if (L >= nwg) return false;
        int wgid = (int)L; { const int q = nwg / NXCD, r = nwg % NXCD, xcd = wgid % NXCD, off = wgid / NXCD; wgid = (xcd < r ? xcd * (q + 1) : r * (q + 1) + (xcd - r) * q) + off; }
        const int nig = WGM * nN, gid = wgid / nig, fm = gid * WGM, gsz = (nM - fm) < WGM ? (nM - fm) : WGM;
        u.pm = fm + ((wgid % nig) % gsz); u.pn = (wgid % nig) / gsz; return true;
    }
    __device__ __forceinline__ void a_ready(const Unit&) const {}
    __device__ __forceinline__ void done(const Unit&) const {}
};

__device__ __forceinline__ unsigned pk_f16(float lo, float hi) { typedef _Float16 h2 __attribute__((ext_vector_type(2))); h2 v; v.x = (_Float16)lo; v.y = (_Float16)hi; return __builtin_bit_cast(unsigned, v); }
typedef unsigned u32x2 __attribute__((ext_vector_type(2)));
struct EpiF16 {
    static constexpr bool PERM = true, AFTER_DRAIN = false;
    bf16_t* O; int ldc; const float* rss;
    __device__ __forceinline__ void operator()(const f32x4 (&acc)[2][2][4][2], const Unit& u, int wr, int wc, int fr, int fq) const {
        const int row0 = u.pm * BM + wr * 64 + fr; const int col0 = u.pn * BM + wc * 32 + 8 * fq;
#pragma unroll
        for (int ai = 0; ai < 2; ++ai)
#pragma unroll
            for (int m = 0; m < 4; ++m) { const int row = row0 + ai * HALF + m * 16; bf16_t* rowp = O + (size_t)row * ldc + col0;
                const float sc = rss ? 1.0f / sqrtf(rss[row] * (1.0f / 1024.0f) + 1e-6f) : 1.0f;
#pragma unroll
                for (int bj = 0; bj < 2; ++bj) { const f32x4 v0 = acc[ai][bj][m][0] * sc, v1 = acc[ai][bj][m][1] * sc;
                    u32x4 w; w.x = pk_f16(v0[0], v0[1]); w.y = pk_f16(v0[2], v0[3]); w.z = pk_f16(v1[0], v1[1]); w.w = pk_f16(v1[2], v1[3]);
                    *(u32x4*)(rowp + bj * HALF) = w; } }
    }
};
struct EpiRes {
    static constexpr bool PERM = false, AFTER_DRAIN = false;
    const float* base; float* out; int ldc; bf16_t* xh; float* rss;
    __device__ __forceinline__ void operator()(const f32x4 (&acc)[2][2][4][2], const Unit& u, int wr, int wc, int fr, int fq) const {
        const int row0 = u.pm * BM + wr * 64 + fr; const int col0 = u.pn * BM + wc * 32 + 4 * fq;
#pragma unroll
        for (int ai = 0; ai < 2; ++ai)
#pragma unroll
            for (int m = 0; m < 4; ++m) { const size_t off = (size_t)(row0 + ai * HALF + m * 16) * ldc + col0; float ss = 0.f;
#pragma unroll
                for (int bj = 0; bj < 2; ++bj)
#pragma unroll
                    for (int n = 0; n < 2; ++n) { const size_t o = off + bj * HALF + n * 16; const f32x4 b = *(const f32x4*)(base + o); const f32x4 x = b + acc[ai][bj][m][n]; *(f32x4*)(out + o) = x;
                        if (xh) { u32x2 h; h.x = pk_f16(x[0], x[1]); h.y = pk_f16(x[2], x[3]); *(u32x2*)(xh + o) = h; ss += (x[0] * x[0] + x[1] * x[1]) + (x[2] * x[2] + x[3] * x[3]); } }
                if (xh) { ss += shfl_xor_f(ss, 16); ss += shfl_xor_f(ss, 32); if (fq == 0) atomicAdd(rss + row0 + ai * HALF + m * 16, ss); }
                asm volatile("" ::: "memory"); }
    }
};

struct EpiResNorm {
    static constexpr bool PERM = false, AFTER_DRAIN = false;
    const float* base; float* out; int ldc; float* rss2; unsigned* cnt; const float* w;
    __device__ __forceinline__ void operator()(f32x4 (&acc)[2][2][4][2], const Unit& u, int wr, int wc, int fr, int fq) const {
        const int row0 = u.pm * BM + wr * 64 + fr; const int col0 = u.pn * BM + wc * 32 + 4 * fq;
#pragma unroll
        for (int ai = 0; ai < 2; ++ai)
#pragma unroll
            for (int m = 0; m < 4; ++m) { const size_t off = (size_t)(row0 + ai * HALF + m * 16) * ldc + col0; float ss = 0.f;
#pragma unroll
                for (int bj = 0; bj < 2; ++bj)
#pragma unroll
                    for (int n = 0; n < 2; ++n) { const size_t o = off + bj * HALF + n * 16; const f32x4 x = *(const f32x4*)(base + o) + acc[ai][bj][m][n]; acc[ai][bj][m][n] = x;
                        ss += (x[0] * x[0] + x[1] * x[1]) + (x[2] * x[2] + x[3] * x[3]); }
                ss += shfl_xor_f(ss, 16); ss += shfl_xor_f(ss, 32); if (fq == 0) atomicAdd(rss2 + row0 + ai * HALF + m * 16, ss);
                asm volatile("" ::: "memory"); }
        asm volatile("s_waitcnt vmcnt(0)" ::: "memory");
        unsigned* pc = cnt + 64 * u.pm;
        if (lane_now() == 0) __hip_atomic_fetch_add(pc, 1u, __ATOMIC_RELAXED, __HIP_MEMORY_SCOPE_AGENT);
        for (unsigned spin = 0; spin < (1u << 22); ++spin) { if ((unsigned)__builtin_amdgcn_readfirstlane((int)__hip_atomic_load(pc, __ATOMIC_RELAXED, __HIP_MEMORY_SCOPE_AGENT)) >= 32u) break; __builtin_amdgcn_s_sleep(2); }
#pragma unroll
        for (int ai = 0; ai < 2; ++ai)
#pragma unroll
            for (int m = 0; m < 4; ++m) { const int row = row0 + ai * HALF + m * 16; const size_t off = (size_t)row * ldc + col0;
                const float rs = 1.0f / sqrtf(__hip_atomic_load(rss2 + row, __ATOMIC_RELAXED, __HIP_MEMORY_SCOPE_AGENT) * (1.0f / 1024.0f) + 1e-6f);
#pragma unroll
                for (int bj = 0; bj < 2; ++bj)
#pragma unroll
                    for (int n = 0; n < 2; ++n) { const size_t o = off + bj * HALF + n * 16; const f32x4 ww = *(const f32x4*)(w + col0 + bj * HALF + n * 16); *(f32x4*)(out + o) = acc[ai][bj][m][n] * rs * ww; } }
    }
};

template <class Epi, class Sched, bool ALIGN_EPI = false, bool SP2 = false>
__device__ __forceinline__ void gemm_phase(PG8_LAS unsigned char* lds, const Gemm g, const Sched& S, const Epi& E, const int wave_) {
    int wv_ = wave_; asm volatile("" : "+s"(wv_)); int tid_ = lane_now() + 64 * wv_; const int tid = tid_, wid = wv_, lane = tid & 63, wr = wid >> 2, wc = wid & 3, fr = lane & 15, fq = lane >> 4;
    const int K = g.K, nt = K / BK;
    unsigned voffA[2], voffB[2];
#pragma unroll
    for (int i = 0; i < 2; ++i) { int R, C; stage_rc(tid * 16 + i * 8192, R, C); const int Rb = Epi::PERM ? ((R & ~31) + perm32(R & 31)) : R;
        voffA[i] = (unsigned)(R * K + C) * 2u; voffB[i] = (unsigned)(Rb * K + C) * 2u; }
    const size_t kstep = (size_t)(BK * 2);
    const size_t hstep = (size_t)HALF * K * 2;
    const size_t tstep = 2 * hstep;
    const unsigned ldsw = (unsigned)wid * 1024u;
    const int aoff = lds_byte(wr * 64 + fr, fq * 8), boff = lds_byte(wc * 32 + fr, fq * 8);
#define PG8_SA(b, h) (((b) * 2 + (h)) * HTB)
#define PG8_SB(b, h) ((4 + (b) * 2 + (h)) * HTB)
#define PG8_STAGE(bufoff, gbase, voff) do { _Pragma("unroll") for (int _i = 0; _i < 2; ++_i) \
        __builtin_amdgcn_global_load_lds((const unsigned*)((const char*)(gbase) + (voff)[_i]), (PG8_LAS unsigned*)(lds + (bufoff) + ldsw + _i * 8192), 16, 0, 0); } while (0)
#define PG8_LDA(dst, b, h) do { _Pragma("unroll") for (int m = 0; m < 4; ++m) _Pragma("unroll") for (int k = 0; k < 2; ++k) dst[m][k] = *(const PG8_LAS bf16x8*)(lds + PG8_SA(b, h) + aoff + m * 2048 + k * 1024); } while (0)
#define PG8_LDB(dst, b, h) do { _Pragma("unroll") for (int n = 0; n < 2; ++n) _Pragma("unroll") for (int k = 0; k < 2; ++k) dst[n][k] = *(const PG8_LAS bf16x8*)(lds + PG8_SB(b, h) + boff + n * 2048 + k * 1024); } while (0)
#define PG8_MMA(ai, bj, At, Bt) do { __builtin_amdgcn_s_setprio(1); _Pragma("unroll") for (int m = 0; m < 4; ++m) _Pragma("unroll") for (int n = 0; n < 2; ++n) _Pragma("unroll") for (int k = 0; k < 2; ++k) \
        acc[ai][bj][m][n] = MK_MFMA(Bt[n][k], At[m][k], acc[ai][bj][m][n]); __builtin_amdgcn_s_setprio(0); } while (0)
#define PG8_WAIT_V(n) asm volatile("s_waitcnt vmcnt(" #n ")" ::: "memory")
#define PG8_WAIT_L(n) asm volatile("s_waitcnt lgkmcnt(" #n ")" ::: "memory")
#define PG8_BAR __builtin_amdgcn_s_barrier()
#define PG8_SCHED __builtin_amdgcn_sched_barrier(0)
    Unit cur, nxt; int ui = 0;
    if (!S.next(0, cur)) return;
    f32x4 acc[2][2][4][2];
#pragma unroll
    for (int a = 0; a < 2; ++a)
#pragma unroll
        for (int b = 0; b < 2; ++b)
#pragma unroll
            for (int m = 0; m < 4; ++m)
#pragma unroll
                for (int n = 0; n < 2; ++n) acc[a][b][m][n] = (f32x4){0.f, 0.f, 0.f, 0.f};
    bf16x8 At[4][2], B0[2][2], B1[2][2];
    const char* cA = (const char*)g.A + (size_t)cur.pm * tstep; const char* cB = (const char*)g.Bt + (size_t)cur.pn * tstep;
    S.a_ready(cur);
    if constexpr (SP2) {
        PG8_STAGE(PG8_SB(0, 0), cB, voffB); PG8_STAGE(PG8_SB(0, 1), cB + hstep, voffB); PG8_STAGE(PG8_SA(0, 0), cA, voffA); PG8_STAGE(PG8_SA(0, 1), cA + hstep, voffA);
        if (wr == 1) PG8_BAR;
        PG8_WAIT_V(2); PG8_BAR;
        PG8_STAGE(PG8_SB(1, 0), cB + kstep, voffB); PG8_STAGE(PG8_SA(1, 0), cA + kstep, voffA); PG8_STAGE(PG8_SB(1, 1), cB + hstep + kstep, voffB);
        PG8_WAIT_V(6); PG8_BAR;
    } else {
        PG8_STAGE(PG8_SB(0, 0), cB, voffB); PG8_STAGE(PG8_SA(0, 0), cA, voffA); PG8_STAGE(PG8_SB(0, 1), cB + hstep, voffB); PG8_STAGE(PG8_SA(0, 1), cA + hstep, voffA);
        if (wr == 1) PG8_BAR;
        PG8_WAIT_V(4); PG8_BAR;
        PG8_STAGE(PG8_SB(1, 0), cB + kstep, voffB); PG8_STAGE(PG8_SA(1, 0), cA + kstep, voffA); PG8_STAGE(PG8_SB(1, 1), cB + hstep + kstep, voffB);
        PG8_WAIT_V(6); PG8_BAR;
    }
    for (;;) {
        const bool has_next = S.next(ui + 1, nxt);
        const char* nA = has_next ? (const char*)g.A + (size_t)nxt.pm * tstep : cA; const char* nB = has_next ? (const char*)g.Bt + (size_t)nxt.pn * tstep : cB;
        for (int t = 0; t < nt; t += 2) {
            const bool last = (t == nt - 2);
            const char* a1 = cA + (size_t)(t + 1) * kstep;
            const char* a2 = last ? nA : cA + (size_t)(t + 2) * kstep; const char* b2 = last ? nB : cB + (size_t)(t + 2) * kstep;
            const char* a3 = a2 + kstep; const char* b3 = b2 + kstep;
            if (last && has_next) S.a_ready(nxt);
            if constexpr (SP2) {
            PG8_LDB(B0, 0, 0); PG8_LDB(B1, 0, 1); PG8_SCHED; PG8_LDA(At, 0, 0); PG8_STAGE(PG8_SA(1, 1), a1 + hstep, voffA);
            PG8_WAIT_V(8); PG8_WAIT_L(0); PG8_BAR; PG8_MMA(0, 0, At, B0); PG8_MMA(0, 1, At, B1); PG8_BAR; PG8_SCHED;
            PG8_LDA(At, 0, 1); PG8_STAGE(PG8_SB(0, 0), b2, voffB); PG8_STAGE(PG8_SB(0, 1), b2 + hstep, voffB); PG8_STAGE(PG8_SA(0, 0), a2, voffA);
            PG8_WAIT_V(8); PG8_WAIT_L(0); PG8_BAR; PG8_MMA(1, 0, At, B0); PG8_MMA(1, 1, At, B1); PG8_BAR; PG8_SCHED;
            PG8_LDB(B0, 1, 0); PG8_LDB(B1, 1, 1); PG8_SCHED; PG8_LDA(At, 1, 0); PG8_STAGE(PG8_SA(0, 1), a2 + hstep, voffA);
            PG8_WAIT_V(8); PG8_WAIT_L(0); PG8_BAR; PG8_MMA(0, 0, At, B0); PG8_MMA(0, 1, At, B1); PG8_BAR; PG8_SCHED;
            PG8_LDA(At, 1, 1); PG8_STAGE(PG8_SB(1, 0), b3, voffB); PG8_STAGE(PG8_SB(1, 1), b3 + hstep, voffB); PG8_STAGE(PG8_SA(1, 0), a3, voffA);
            PG8_WAIT_V(8); PG8_WAIT_L(0); PG8_BAR; PG8_MMA(1, 0, At, B0); PG8_MMA(1, 1, At, B1); PG8_BAR; PG8_SCHED;
            } else {
            PG8_LDB(B0, 0, 0); PG8_SCHED; PG8_LDA(At, 0, 0); PG8_STAGE(PG8_SA(1, 1), a1 + hstep, voffA);
            PG8_WAIT_L(8); PG8_BAR; PG8_WAIT_L(0); PG8_MMA(0, 0, At, B0); PG8_BAR; PG8_SCHED;
            PG8_LDB(B1, 0, 1); PG8_STAGE(PG8_SB(0, 0), b2, voffB);
            PG8_BAR; PG8_WAIT_L(0); PG8_MMA(0, 1, At, B1); PG8_BAR;
            PG8_LDA(At, 0, 1); PG8_STAGE(PG8_SA(0, 0), a2, voffA);
            PG8_BAR; PG8_WAIT_L(0); PG8_MMA(1, 0, At, B0); PG8_BAR; PG8_SCHED;
            PG8_STAGE(PG8_SB(0, 1), b2 + hstep, voffB);
            PG8_WAIT_V(6); PG8_BAR; PG8_MMA(1, 1, At, B1); PG8_BAR;
            PG8_LDB(B0, 1, 0); PG8_SCHED; PG8_LDA(At, 1, 0); PG8_STAGE(PG8_SA(0, 1), a2 + hstep, voffA);
            PG8_WAIT_L(8); PG8_BAR; PG8_WAIT_L(0); PG8_MMA(0, 0, At, B0); PG8_BAR; PG8_SCHED;
            PG8_LDB(B1, 1, 1); PG8_STAGE(PG8_SB(1, 0), b3, voffB);
            PG8_BAR; PG8_WAIT_L(0); PG8_MMA(0, 1, At, B1); PG8_BAR;
            PG8_LDA(At, 1, 1); PG8_STAGE(PG8_SA(1, 0), a3, voffA);
            PG8_BAR; PG8_WAIT_L(0); PG8_MMA(1, 0, At, B0); PG8_BAR; PG8_SCHED;
            PG8_STAGE(PG8_SB(1, 1), b3 + hstep, voffB);
            PG8_WAIT_V(6); PG8_BAR; PG8_MMA(1, 1, At, B1); PG8_BAR;
            }
        }
        if constexpr (ALIGN_EPI) { if (wr == 0) PG8_BAR; }
        if constexpr (!Epi::AFTER_DRAIN) { E(acc, cur, wr, wc, fr, fq); S.done(cur); }
        if (!has_next) break;
#pragma unroll
        for (int a = 0; a < 2; ++a)
#pragma unroll
            for (int b = 0; b < 2; ++b)
#pragma unroll
                for (int m = 0; m < 4; ++m)
#pragma unroll
                    for (int n = 0; n < 2; ++n) acc[a][b][m][n] = (f32x4){0.f, 0.f, 0.f, 0.f};
        cur = nxt; cA = nA; cB = nB; ++ui;
        if constexpr (ALIGN_EPI) { if (wr == 1) PG8_BAR; }
    }
    PG8_WAIT_V(0);
    if constexpr (!ALIGN_EPI) { if (wr == 0) PG8_BAR; }
    PG8_BAR;
    if constexpr (Epi::AFTER_DRAIN) { E.fused(acc, cur, wr, wc, fr, fq, lds, wid, lane); S.done(cur); }
#undef PG8_SA
#undef PG8_SB
#undef PG8_STAGE
#undef PG8_LDA
#undef PG8_LDB
#undef PG8_MMA
#undef PG8_WAIT_V
#undef PG8_WAIT_L
#undef PG8_BAR
#undef PG8_SCHED
}
}

constexpr int BATCH = 2, SEQ = 8192, DM = 1024, DEPTH = 2, M = BATCH * SEQ;
constexpr int RW_H = 6, HD = 64, RW_W = 384, RW_SHIFT = 1280;
constexpr int NIN = 3712, NU = 3840;
constexpr int C_R = 0, C_K = 384, C_V = 768, C_WL = 1152, C_AL = 1216, C_RWZ = 1280, C_HGQ = 1664, C_HGF = 2048, C_HGI = 2432, C_HGZ = 2816, C_LRUX = 3200, C_LRUZ = 3456;
constexpr int CH = 64;
constexpr int NWAVES = 8, NT = NWAVES * 64;
constexpr int LDS_BYTES = 163840;
constexpr int PRM_OFF = 142336;
constexpr size_t MiB = 1u << 20;
constexpr size_t WS_WUPT = 65536, WS_AUPT = WS_WUPT + 98304, WS_VDNT = WS_AUPT + 98304, WS_VUPT = WS_VDNT + 24576, WS_WAT = WS_VUPT + 24576, WS_WXT = WS_WAT + 65536;
constexpr size_t WS_WIN = 1 * MiB, WIN_L = (size_t)NU * DM * 2;
constexpr size_t WS_WOUT = 16 * MiB, WOUT_L = (size_t)DM * DM * 2;
constexpr size_t WS_XN = 20 * MiB;
constexpr size_t WS_QT = 20 * MiB;
constexpr size_t WS_PT = 32 * MiB;
constexpr size_t WS_CA = 44 * MiB;
constexpr size_t WS_U = 52 * MiB;
constexpr size_t WS_MIX = 172 * MiB;
constexpr size_t WS_VF = 204 * MiB;
constexpr size_t WS_VP = 216 * MiB;
constexpr size_t WS_RL = 228 * MiB;
constexpr size_t WS_HL = 240 * MiB;
constexpr size_t WS_BON = 252 * MiB;
constexpr size_t WS_DC = WS_BON + 512 * 1024;
constexpr size_t WS_LA = WS_DC + 512 * 1024;
constexpr size_t WS_LH = WS_LA + 256 * 1024;
constexpr size_t WS_RSS = WS_LH + 256 * 1024;
constexpr size_t WS_END = 254 * MiB;
constexpr int NCH = SEQ / CH;

#define LAS __attribute__((address_space(3)))
typedef float f32x4 __attribute__((ext_vector_type(4)));
typedef unsigned u32x2 __attribute__((ext_vector_type(2)));
typedef unsigned u32x4 __attribute__((ext_vector_type(4)));
typedef _Float16 f16;
typedef _Float16 f16x8 __attribute__((ext_vector_type(8)));
#define LDS_WAIT() asm volatile("s_waitcnt lgkmcnt(0)" ::: "memory")

struct Args { const float* in[27]; float* out; unsigned char* ws; };

__device__ __forceinline__ float wave_sum(float v) {
#pragma unroll
    for (int o = 1; o < 64; o <<= 1) v += shfl_xor_f(v, o);
    return v;
}
__device__ __forceinline__ float sigmoidf_(float x) { return __builtin_amdgcn_rcpf(1.0f + __expf(-x)); }
__device__ __forceinline__ float rsq_(float x) { return __builtin_amdgcn_rsqf(x); }
__device__ __forceinline__ float one_minus_exp_(float x) { return (x > -0.03f) ? -x * (1.0f + x * (0.5f + x * (1.0f / 6.0f + x * (1.0f / 24.0f)))) : 1.0f - __expf(x); }
__device__ __forceinline__ float siluf_(float x) { return x * __builtin_amdgcn_rcpf(1.0f + __expf(-x)); }

__device__ __forceinline__ void p0_transpose_item(const float* W, int K, int N, unsigned short* WT, LAS float* scr, int item, int lane, const float* rsc) {
    const int nblk = N / 32, kb = item / nblk, nb = item % nblk, k0 = 64 * kb, n0 = 32 * nb;
    float tv[32];
#pragma unroll
    for (int i = 0; i < 32; ++i) { const int kk = 2 * i + (lane >> 5); tv[i] = W[(size_t)(k0 + kk) * N + n0 + (lane & 31)]; }
#pragma unroll
    for (int i = 0; i < 32; ++i) { const int kk = 2 * i + (lane >> 5); scr[kk * 33 + (lane & 31)] = tv[i] * (rsc ? rsc[k0 + kk] : 1.0f); }
    LDS_WAIT(); asm volatile("" ::: "memory");
    const int c = lane & 7;
#pragma unroll
    for (int j = 0; j < 4; ++j) { const int n = (lane >> 3) + 8 * j; const LAS float* s = scr + (8 * c) * 33 + n;
        u32x4 o; o.x = pg8::pk_f16(s[0 * 33], s[1 * 33]); o.y = pg8::pk_f16(s[2 * 33], s[3 * 33]); o.z = pg8::pk_f16(s[4 * 33], s[5 * 33]); o.w = pg8::pk_f16(s[6 * 33], s[7 * 33]);
        *(u32x4*)(WT + (size_t)(n0 + n) * K + k0 + 8 * c) = o; }
    LDS_WAIT(); asm volatile("" ::: "memory");
}
__device__ __forceinline__ void rms_row_f16(const float* xrow, const float* w, unsigned short* orow, int lane) {
    const f32x4* xr = (const f32x4*)xrow + lane; const f32x4* wr = (const f32x4*)w + lane;
    f32x4 v[4]; float s = 0.f;
#pragma unroll
    for (int j = 0; j < 4; ++j) { v[j] = xr[64 * j]; s += (v[j].x * v[j].x + v[j].y * v[j].y) + (v[j].z * v[j].z + v[j].w * v[j].w); }
    const float rs = 1.0f / sqrtf(wave_sum(s) * (1.0f / DM) + 1e-6f);
    u32x2* o8 = (u32x2*)orow + lane;
#pragma unroll
    for (int j = 0; j < 4; ++j) { const f32x4 ww = wr[64 * j]; u32x2 o; o.x = pg8::pk_f16(v[j].x * rs * ww.x, v[j].y * rs * ww.y); o.y = pg8::pk_f16(v[j].z * rs * ww.z, v[j].w * rs * ww.w); o8[64 * j] = o; }
}
__device__ __forceinline__ void rms_row_f32(float* xrow, const float* w, int lane) {
    f32x4* xr = (f32x4*)xrow + lane; const f32x4* wr = (const f32x4*)w + lane;
    f32x4 v[4]; float s = 0.f;
#pragma unroll
    for (int j = 0; j < 4; ++j) { v[j] = xr[64 * j]; s += (v[j].x * v[j].x + v[j].y * v[j].y) + (v[j].z * v[j].z + v[j].w * v[j].w); }
    const float rs = 1.0f / sqrtf(wave_sum(s) * (1.0f / DM) + 1e-6f);
#pragma unroll
    for (int j = 0; j < 4; ++j) { const f32x4 ww = wr[64 * j]; xr[64 * j] = v[j] * rs * ww; }
}

__device__ __forceinline__ void rms_row2_f32(float* xa, float* xb, const float* w, int lane) {
    f32x4* ra = (f32x4*)xa + lane; f32x4* rb = (f32x4*)xb + lane; const f32x4* wr = (const f32x4*)w + lane;
    f32x4 va[4], vb[4]; float sa = 0.f, sb = 0.f;
#pragma unroll
    for (int j = 0; j < 4; ++j) { va[j] = ra[64 * j]; vb[j] = rb[64 * j]; }
#pragma unroll
    for (int j = 0; j < 4; ++j) { sa += (va[j].x * va[j].x + va[j].y * va[j].y) + (va[j].z * va[j].z + va[j].w * va[j].w); sb += (vb[j].x * vb[j].x + vb[j].y * vb[j].y) + (vb[j].z * vb[j].z + vb[j].w * vb[j].w); }
    const float rsa = 1.0f / sqrtf(wave_sum(sa) * (1.0f / DM) + 1e-6f), rsb = 1.0f / sqrtf(wave_sum(sb) * (1.0f / DM) + 1e-6f);
#pragma unroll
    for (int j = 0; j < 4; ++j) { const f32x4 ww = wr[64 * j]; ra[64 * j] = va[j] * rsa * ww; rb[64 * j] = vb[j] * rsb * ww; }
}
__device__ __forceinline__ void rms_row4_f16(const float* x0, size_t rs, const float* w, unsigned short* o0, int lane) {
    f32x4 v[4][4]; float s[4];
#pragma unroll
    for (int r = 0; r < 4; ++r)
#pragma unroll
        for (int j = 0; j < 4; ++j) v[r][j] = ((const f32x4*)(x0 + r * rs) + lane)[64 * j];
    const f32x4* wr = (const f32x4*)w + lane;
#pragma unroll
    for (int r = 0; r < 4; ++r) { float a = 0.f;
#pragma unroll
        for (int j = 0; j < 4; ++j) a += (v[r][j].x * v[r][j].x + v[r][j].y * v[r][j].y) + (v[r][j].z * v[r][j].z + v[r][j].w * v[r][j].w);
        s[r] = 1.0f / sqrtf(wave_sum(a) * (1.0f / DM) + 1e-6f); }
#pragma unroll
    for (int j = 0; j < 4; ++j) { const f32x4 ww = wr[64 * j];
#pragma unroll
        for (int r = 0; r < 4; ++r) { u32x2 o; o.x = pg8::pk_f16(v[r][j].x * s[r] * ww.x, v[r][j].y * s[r] * ww.y); o.y = pg8::pk_f16(v[r][j].z * s[r] * ww.z, v[r][j].w * s[r] * ww.w); ((u32x2*)(o0 + r * rs) + lane)[64 * j] = o; } }
}
__device__ __forceinline__ void rms_row4_f32(float* x0, size_t rs, const float* w, int lane) {
    f32x4 v[4][4]; float s[4];
#pragma unroll
    for (int r = 0; r < 4; ++r)
#pragma unroll
        for (int j = 0; j < 4; ++j) v[r][j] = ((const f32x4*)(x0 + r * rs) + lane)[64 * j];
    const f32x4* wr = (const f32x4*)w + lane;
#pragma unroll
    for (int r = 0; r < 4; ++r) { float a = 0.f;
#pragma unroll
        for (int j = 0; j < 4; ++j) a += (v[r][j].x * v[r][j].x + v[r][j].y * v[r][j].y) + (v[r][j].z * v[r][j].z + v[r][j].w * v[r][j].w);
        s[r] = rsq_(wave_sum(a) * (1.0f / DM) + 1e-6f); }
#pragma unroll
    for (int j = 0; j < 4; ++j) { const f32x4 ww = wr[64 * j];
#pragma unroll
        for (int r = 0; r < 4; ++r) ((f32x4*)(x0 + r * rs) + lane)[64 * j] = v[r][j] * s[r] * ww; }
}

#define SHV(col) ({ const float cur_ = (float)urow[(col)]; const float prev_ = hp ? (float)prow[(col)] : 0.f; cur_ + mu[(col)] * (prev_ - cur_); })

__device__ __forceinline__ void store_row64_f16(f16* dst, const float (&S)[64]) {
#pragma unroll
    for (int q = 0; q < 8; ++q) { u32x4 w; w.x = pg8::pk_f16(S[8 * q], S[8 * q + 1]); w.y = pg8::pk_f16(S[8 * q + 2], S[8 * q + 3]); w.z = pg8::pk_f16(S[8 * q + 4], S[8 * q + 5]); w.w = pg8::pk_f16(S[8 * q + 6], S[8 * q + 7]); *(u32x4*)(dst + 8 * q) = w; }
}


constexpr int RWT_ROW = 144, RWT_A = 0, RWT_R = 2304, RWT_B = 4608, RWT_K = 6912;
constexpr int RWC_B = 9216, RWC_K = 11264, RWC_V = 13312;
constexpr int RWF_G16 = 15360, RWF_RHO = 15616, RWA_INV = 15872, RWA_BYTES = 18944;
constexpr int C_VD0 = 3712, C_VD1 = 3744;
constexpr int PRM_MU = 0, PRM_A0 = 1280, PRM_KK = 1664, PRM_KA = 2048, PRM_RK = 2432, PRM_V0 = 2816, PRM_HALVES = 3200, PRM_W0_BYTE = 6400, PRM_BYTES = PRM_W0_BYTE + 1536;
typedef float f32x2 __attribute__((ext_vector_type(2)));
typedef _Float16 f16x4 __attribute__((ext_vector_type(4)));
__device__ __forceinline__ float fmix_lo(float a, unsigned b, float c) { float d; asm("v_fma_mix_f32 %0, %1, %2, %3 op_sel:[0,0,0] op_sel_hi:[0,1,0]" : "=v"(d) : "v"(a), "v"(b), "v"(c)); return d; }
__device__ __forceinline__ float fmix_hi(float a, unsigned b, float c) { float d; asm("v_fma_mix_f32 %0, %1, %2, %3 op_sel:[0,1,0] op_sel_hi:[0,1,0]" : "=v"(d) : "v"(a), "v"(b), "v"(c)); return d; }
__device__ __forceinline__ float mmix_lo(float a, unsigned b) { float d; asm("v_fma_mix_f32 %0, %1, %2, 0 op_sel:[0,0,0] op_sel_hi:[0,1,0]" : "=v"(d) : "v"(a), "v"(b)); return d; }
__device__ __forceinline__ float mmix_hi(float a, unsigned b) { float d; asm("v_fma_mix_f32 %0, %1, %2, 0 op_sel:[0,1,0] op_sel_hi:[0,1,0]" : "=v"(d) : "v"(a), "v"(b)); return d; }
__device__ __forceinline__ float mul_asm(float a, float b) { float d; asm("v_mul_f32 %0, %1, %2" : "=v"(d) : "v"(a), "v"(b)); return d; }
__device__ __forceinline__ float fma_asm(float a, float b, float c) { float d; asm("v_fma_f32 %0, %1, %2, %3" : "=v"(d) : "v"(a), "v"(b), "v"(c)); return d; }
#define FMIX(a, u, j, c) (((j) & 1) ? fmix_hi((a), (u)[(j) >> 1], (c)) : fmix_lo((a), (u)[(j) >> 1], (c)))
#define MMIX(a, u, j) (((j) & 1) ? mmix_hi((a), (u)[(j) >> 1]) : mmix_lo((a), (u)[(j) >> 1]))
__device__ __forceinline__ float fast_tanh(float x) { return 1.0f - 2.0f * __builtin_amdgcn_rcpf(__expf(2.0f * x) + 1.0f); }
__device__ __forceinline__ void lerp8(const char* ub, unsigned uo, unsigned po, bool hp, const char* mub, unsigned col, float (&x)[8]) {
    const f16x8 cu = *(const f16x8*)(ub + (uo + col * 2u)); f16x8 pv = *(const f16x8*)(ub + (po + col * 2u)); const f32x4 m0 = *(const f32x4*)(mub + col * 4u), m1 = *(const f32x4*)(mub + col * 4u + 16u);
#pragma unroll
    for (int j = 0; j < 8; ++j) { const float c = (float)cu[j], p = hp ? (float)pv[j] : 0.f; x[j] = c + (j < 4 ? m0[j] : m1[j - 4]) * (p - c); }
}
__device__ __forceinline__ void lerp4(const char* ub, unsigned uo, unsigned po, bool hp, const char* mub, unsigned col, float (&x)[4]) {
    const f16x4 cu = *(const f16x4*)(ub + (uo + col * 2u)); f16x4 pv = *(const f16x4*)(ub + (po + col * 2u)); const f32x4 m0 = *(const f32x4*)(mub + col * 4u);
#pragma unroll
    for (int j = 0; j < 4; ++j) { const float c = (float)cu[j], p = hp ? (float)pv[j] : 0.f; x[j] = c + m0[j] * (p - c); }
}
__device__ __forceinline__ f16x8 pack8(const float (&x)[8]) { f16x8 r;
#pragma unroll
    for (int j = 0; j < 8; ++j) r[j] = (f16)x[j];
    return r; }

template <int CTRL> __device__ __forceinline__ float dpp_f(float x) { return __builtin_bit_cast(float, __builtin_amdgcn_update_dpp(0, __builtin_bit_cast(int, x), CTRL, 0xF, 0xF, true)); }
__device__ __forceinline__ float row_prefix16(float x) { x += dpp_f<0x111>(x); x += dpp_f<0x112>(x); x += dpp_f<0x114>(x); x += dpp_f<0x118>(x); return x; }
__device__ __forceinline__ float bperm_f(int byteaddr, float x) { return __builtin_bit_cast(float, __builtin_amdgcn_ds_bpermute(byteaddr, __builtin_bit_cast(int, x))); }
__device__ __forceinline__ f16x4 cvt4(const f32x4 v) { f16x4 r; r[0] = (f16)v[0]; r[1] = (f16)v[1]; r[2] = (f16)v[2]; r[3] = (f16)v[3]; return r; }
#define MF16(A, B, C) __builtin_amdgcn_mfma_f32_16x16x16f16((A), (B), (C), 0, 0, 0)
#define MF32(A, B, C) __builtin_amdgcn_mfma_f32_16x16x32_f16((A), (B), (C), 0, 0, 0)

__device__ __forceinline__ void rwkv_waveA(const Args& a, int l, int b, int c, int h, LAS unsigned char* wl, const LAS unsigned char* prmb, int lane) {
    const LAS f16* prm = (const LAS f16*)prmb; const LAS float* prw0 = (const LAS float*)(prmb + PRM_W0_BYTE);
    const char* Ub = (const char*)(a.ws + WS_U); f16* MIX = (f16*)(a.ws + WS_MIX); char* VF = (char*)(a.ws + WS_VF); char* VP = (char*)(a.ws + WS_VP);
    f16* QT = (f16*)(a.ws + WS_QT); f16* PT = (f16*)(a.ws + WS_PT); f16* RL = (f16*)(a.ws + WS_RL); float* BONG = (float*)(a.ws + WS_BON);
    const char* WUPT = (const char*)(a.ws + WS_WUPT) + (size_t)l * 384 * 64 * 2; const char* AUPT = (const char*)(a.ws + WS_AUPT) + (size_t)l * 384 * 64 * 2;
    const char* VUPT = (const char*)(a.ws + WS_VUPT);
    const int bh = b * RW_H + h;
    f32x4 XT[4][8];
#pragma unroll
    for (int ct = 0; ct < 4; ++ct)
#pragma unroll
        for (int vt = 0; vt < 8; ++vt)
#pragma unroll
            for (int r = 0; r < 4; ++r) XT[ct][vt][r] = (vt == ct && (lane & 15) == 4 * (lane >> 4) + r) ? 1.f : 0.f;
#pragma unroll 1
    for (int blk = 0; blk < 4; ++blk) {
        const int lane_ = lane_now();
        const int tok = lane_ & 15, fq = lane_ >> 4;
        const int t = c * CH + blk * 16 + tok; const unsigned m = (unsigned)(b * SEQ + t); const bool hp = t > 0;
        const unsigned uo = m * (unsigned)(NU * 2), po = hp ? uo - (unsigned)(NU * 2) : uo;
        f16x8 cW[2], pW[2], cA[2], pA[2], vd0, vd1;
#pragma unroll
        for (int s = 0; s < 2; ++s) { const unsigned cw = (unsigned)(C_WL + 8 * fq + 32 * s) * 2u, ca = (unsigned)(C_AL + 8 * fq + 32 * s) * 2u;
            cW[s] = *(const f16x8*)(Ub + uo + cw); pW[s] = *(const f16x8*)(Ub + po + cw); cA[s] = *(const f16x8*)(Ub + uo + ca); pA[s] = *(const f16x8*)(Ub + po + ca); }
        vd0 = *(const f16x8*)(Ub + uo + (unsigned)(C_VD0 + 8 * fq) * 2u); vd1 = *(const f16x8*)(Ub + po + (unsigned)(C_VD1 + 8 * fq) * 2u);
#define RW_TLOAD(X, nt) f16x8 X##wu0, X##wu1, X##au0, X##au1, X##vu; f16x4 X##cr, X##pr, X##ck, X##pk, X##cv, X##pv, X##vf; { \
            const unsigned n_ = (unsigned)(h * 64 + 16 * (nt) + tok), cb_ = (unsigned)(h * 64 + 16 * (nt) + 4 * fq); \
            X##wu0 = *(const f16x8*)(WUPT + (n_ * 64u + 8u * fq) * 2u); X##wu1 = *(const f16x8*)(WUPT + (n_ * 64u + 8u * fq + 32u) * 2u); \
            X##au0 = *(const f16x8*)(AUPT + (n_ * 64u + 8u * fq) * 2u); X##au1 = *(const f16x8*)(AUPT + (n_ * 64u + 8u * fq + 32u) * 2u); \
            if (l > 0) { X##vu = *(const f16x8*)(VUPT + (n_ * 32u + 8u * fq) * 2u); X##vf = *(const f16x4*)(VF + (m * (unsigned)RW_W + cb_) * 2u); } \
            X##cr = *(const f16x4*)(Ub + uo + ((unsigned)C_R + cb_) * 2u); X##pr = *(const f16x4*)(Ub + po + ((unsigned)C_R + cb_) * 2u); \
            X##ck = *(const f16x4*)(Ub + uo + ((unsigned)C_K + cb_) * 2u); X##pk = *(const f16x4*)(Ub + po + ((unsigned)C_K + cb_) * 2u); \
            X##cv = *(const f16x4*)(Ub + uo + ((unsigned)C_V + cb_) * 2u); X##pv = *(const f16x4*)(Ub + po + ((unsigned)C_V + cb_) * 2u); }
        f16x8 bW[2], bA[2], bVD;
#pragma unroll
        for (int s = 0; s < 2; ++s) { float xw[8], xa[8];
            const f16x8 mw = *(const LAS f16x8*)(prm + PRM_MU + C_WL + 8 * fq + 32 * s), ma = *(const LAS f16x8*)(prm + PRM_MU + C_AL + 8 * fq + 32 * s);
#pragma unroll
            for (int j = 0; j < 8; ++j) { const float cw_ = (float)cW[s][j], pw_ = hp ? (float)pW[s][j] : 0.f, ca_ = (float)cA[s][j], pa_ = hp ? (float)pA[s][j] : 0.f;
                xw[j] = fast_tanh(cw_ + (float)mw[j] * (pw_ - cw_)); xa[j] = ca_ + (float)ma[j] * (pa_ - ca_); }
            bW[s] = pack8(xw); bA[s] = pack8(xa); }
        { float xv[8];
#pragma unroll
            for (int j = 0; j < 8; ++j) xv[j] = (float)vd0[j] + (hp ? (float)vd1[j] : 0.f);
            bVD = pack8(xv); }
        float ssq = 0.f, bon = 0.f;
        const int bp7 = ((lane_ & 48) | 7) << 2, bp15 = ((lane_ & 48) | 15) << 2;
#define RW_TCOMP(X, nt) { const int cb = h * 64 + 16 * (nt) + 4 * fq, co = 16 * (nt) + 4 * fq; \
            f32x4 DWn = (f32x4){0.f, 0.f, 0.f, 0.f}, DAn = DWn, Gn = DWn; \
            DWn = __builtin_amdgcn_mfma_f32_16x16x32_f16(X##wu0, bW[0], DWn, 0, 0, 0); DWn = __builtin_amdgcn_mfma_f32_16x16x32_f16(X##wu1, bW[1], DWn, 0, 0, 0); \
            DAn = __builtin_amdgcn_mfma_f32_16x16x32_f16(X##au0, bA[0], DAn, 0, 0, 0); DAn = __builtin_amdgcn_mfma_f32_16x16x32_f16(X##au1, bA[1], DAn, 0, 0, 0); \
            if (l > 0) Gn = __builtin_amdgcn_mfma_f32_16x16x32_f16(X##vu, bVD, Gn, 0, 0, 0); \
            f16x4 ah, rh, bh, kh, bb, kb, vo; f32x4 rho4, g164; \
            _Pragma("unroll") for (int i = 0; i < 4; ++i) { const LAS f16* pc = prm + cb + i; \
                const float cr_ = (float)X##cr[i], ck_ = (float)X##ck[i], cv_ = (float)X##cv[i]; \
                const float rs = cr_ + (float)pc[PRM_MU + C_R] * ((hp ? (float)X##pr[i] : 0.f) - cr_), ks = ck_ + (float)pc[PRM_MU + C_K] * ((hp ? (float)X##pk[i] : 0.f) - ck_), vs = cv_ + (float)pc[PRM_MU + C_V] * ((hp ? (float)X##pv[i] : 0.f) - cv_); \
                const float g2 = -0.875036877f * sigmoidf_(prw0[cb + i] + DWn[i]);                   \
                const float Gi = row_prefix16(g2), G8 = bperm_f(bp7, Gi), G16 = bperm_f(bp15, Gi); \
                const float e1 = __builtin_amdgcn_exp2f(Gi - G8), e1m = __builtin_amdgcn_exp2f((Gi - g2) - G8), einv = __builtin_amdgcn_exp2f(G8 - Gi), esuf = __builtin_amdgcn_exp2f(G16 - Gi); \
                rho4[i] = __builtin_amdgcn_exp2f(G8); g164[i] = __builtin_amdgcn_exp2f(G16); \
                const float aa = sigmoidf_((float)pc[PRM_A0] + DAn[i]); \
                float vv = vs; if (l > 0) vv = vs + ((float)X##vf[i] - vs) * sigmoidf_((float)pc[PRM_V0] + Gn[i]); \
                const float kk = ks * (float)pc[PRM_KK]; ssq += kk * kk; \
                const float kmod = ks * (1.0f + (aa - 1.0f) * (float)pc[PRM_KA]); \
                bon += rs * kmod * (float)pc[PRM_RK]; \
                const float bq = kk * aa; \
                ah[i] = (f16)(-kk * e1m); rh[i] = (f16)(rs * e1); bh[i] = (f16)(bq * einv); kh[i] = (f16)(kmod * einv); bb[i] = (f16)(bq * esuf); kb[i] = (f16)(kmod * esuf); vo[i] = (f16)vv; \
                asm volatile("" ::: "memory"); } \
            *(LAS f16x4*)(wl + RWT_A + tok * RWT_ROW + co * 2) = ah; *(LAS f16x4*)(wl + RWT_R + tok * RWT_ROW + co * 2) = rh; \
            *(LAS f16x4*)(wl + RWT_B + tok * RWT_ROW + co * 2) = bh; *(LAS f16x4*)(wl + RWT_K + tok * RWT_ROW + co * 2) = kh; \
            _Pragma("unroll") for (int i = 0; i < 4; ++i) { *(LAS f16*)(wl + RWC_B + (co + i) * 32 + tok * 2) = bb[i]; *(LAS f16*)(wl + RWC_K + (co + i) * 32 + tok * 2) = kb[i]; *(LAS f16*)(wl + RWC_V + (co + i) * 32 + tok * 2) = vo[i]; } \
            if (tok == 0) { *(LAS f32x4*)(wl + RWF_RHO + co * 4) = rho4; *(LAS f32x4*)(wl + RWF_G16 + co * 4) = g164; } \
            *(f16x4*)(VP + (m * (unsigned)RW_W + (unsigned)cb) * 2u) = vo; \
            if (l == 0) *(f16x4*)(VF + (m * (unsigned)RW_W + (unsigned)cb) * 2u) = vo; }
#pragma unroll 1
        for (int nt = 0; nt < 4; ++nt) { RW_TLOAD(T0, nt) RW_TCOMP(T0, nt) asm volatile("" ::: "memory"); }
#undef RW_TLOAD
#undef RW_TCOMP
        ssq += shfl_xor_f(ssq, 16); ssq += shfl_xor_f(ssq, 32);
        bon += shfl_xor_f(bon, 16); bon += shfl_xor_f(bon, 32);
        { const float inv2v = __builtin_amdgcn_rcpf(fmaxf(ssq, 1e-24f));
          if (fq == 0) { *(LAS float*)(wl + RWA_INV + tok * 4) = inv2v; *(float*)((char*)BONG + (m * 8u + (unsigned)h) * 4u) = bon; } }
        const unsigned mb = (unsigned)(b * SEQ + c * CH + blk * 16);
        const int q4 = fq * 4;
        f16x4 N1, N1T, MkH, NbH, NkH;
        { f16x8 fa[2], fr[2], fb[2], fk[2];
#pragma unroll
          for (int s = 0; s < 2; ++s) { const int o = tok * RWT_ROW + (32 * s + q4) * 2;
#define RW_FRAG(F, T) { const f16x4 lo_ = *(const LAS f16x4*)(wl + (T) + o), hi_ = *(const LAS f16x4*)(wl + (T) + o + 32); F[s] = (f16x8){lo_[0], lo_[1], lo_[2], lo_[3], hi_[0], hi_[1], hi_[2], hi_[3]}; }
              RW_FRAG(fa, RWT_A) RW_FRAG(fr, RWT_R) RW_FRAG(fb, RWT_B) RW_FRAG(fk, RWT_K)
#undef RW_FRAG
          }
          const f32x4 z4 = (f32x4){0.f, 0.f, 0.f, 0.f};
          f32x4 Mb = MF32(fb[1], fa[1], MF32(fb[0], fa[0], z4)), MbT = MF32(fa[1], fb[1], MF32(fa[0], fb[0], z4));
          f32x4 Mk = MF32(fk[1], fa[1], MF32(fk[0], fa[0], z4)), Nb = MF32(fb[1], fr[1], MF32(fb[0], fr[0], z4)), Nk = MF32(fk[1], fr[1], MF32(fk[0], fr[0], z4));
          const f32x4 ivr = *(const LAS f32x4*)(wl + RWA_INV + q4 * 4); const float ivc = *(const LAS float*)(wl + RWA_INV + tok * 4);
#pragma unroll
          for (int r = 0; r < 4; ++r) { const int j = q4 + r;
              Mb[r] = (j < tok) ? Mb[r] * ivr[r] : 0.f; MbT[r] = (tok < j) ? MbT[r] * ivc : 0.f; Mk[r] = (j < tok) ? Mk[r] : 0.f; Nb[r] = (j <= tok) ? Nb[r] : 0.f; Nk[r] = (j <= tok) ? Nk[r] : 0.f; }
          N1 = cvt4(Mb); N1T = cvt4(MbT); MkH = cvt4(Mk); NbH = cvt4(Nb); NkH = cvt4(Nk); }
        const f16x4 N2 = cvt4(MF16(N1T, N1, ((f32x4){0.f, 0.f, 0.f, 0.f}))), N2T = cvt4(MF16(N1, N1T, ((f32x4){0.f, 0.f, 0.f, 0.f})));
        const f16x4 N4 = cvt4(MF16(N2T, N2, ((f32x4){0.f, 0.f, 0.f, 0.f}))), N4T = cvt4(MF16(N2, N2T, ((f32x4){0.f, 0.f, 0.f, 0.f})));
        const f16x4 N8 = cvt4(MF16(N4T, N4, ((f32x4){0.f, 0.f, 0.f, 0.f})));
#pragma unroll
        for (int hq = 0; hq < 4; ++hq) {
            constexpr int NTQ = 2; const int hv = hq >> 1;
            asm volatile("" ::: "memory");
            const f32x4 ivr2 = *(const LAS f32x4*)(wl + RWA_INV + q4 * 4);
            f32x4 G[NTQ], Y[NTQ]; f16x4 vf[NTQ];
            { f16x8 fa[2], fr[2];
#pragma unroll
              for (int s = 0; s < 2; ++s) { const int o = tok * RWT_ROW + (32 * s + q4) * 2;
#define RW_FRAG(F, T) { const f16x4 lo_ = *(const LAS f16x4*)(wl + (T) + o), hi_ = *(const LAS f16x4*)(wl + (T) + o + 32); F[s] = (f16x8){lo_[0], lo_[1], lo_[2], lo_[3], hi_[0], hi_[1], hi_[2], hi_[3]}; }
                  RW_FRAG(fa, RWT_A) RW_FRAG(fr, RWT_R)
#undef RW_FRAG
              }
#pragma unroll
              for (int t = 0; t < NTQ; ++t) { const int vt = 2 * hq + t; f16x8 xb[2];
#pragma unroll
                for (int s = 0; s < 2; ++s) { const f32x4 r0 = *(const LAS f32x4*)(wl + RWF_RHO + (32 * s + q4) * 4), r1 = *(const LAS f32x4*)(wl + RWF_RHO + (32 * s + 16 + q4) * 4);
                    const f32x4 x0 = XT[2 * s][vt] * r0, x1 = XT[2 * s + 1][vt] * r1;
                    xb[s] = (f16x8){(f16)x0[0], (f16)x0[1], (f16)x0[2], (f16)x0[3], (f16)x1[0], (f16)x1[1], (f16)x1[2], (f16)x1[3]}; }
                G[t] = MF32(fa[1], xb[1], MF32(fa[0], xb[0], ((f32x4){0.f, 0.f, 0.f, 0.f})));
                Y[t] = MF32(fr[1], xb[1], MF32(fr[0], xb[0], ((f32x4){0.f, 0.f, 0.f, 0.f})));
                if (hv) { vf[t] = *(const LAS f16x4*)(wl + RWC_V + (16 * (vt - 4) + tok) * 32 + q4 * 2); G[t] = MF16(MkH, vf[t], G[t]); } } }
#pragma unroll
            for (int t = 0; t < NTQ; ++t) G[t] = MF16(N1, cvt4(G[t]), G[t]);
#pragma unroll
            for (int t = 0; t < NTQ; ++t) G[t] = MF16(N2, cvt4(G[t]), G[t]);
#pragma unroll
            for (int t = 0; t < NTQ; ++t) G[t] = MF16(N4, cvt4(G[t]), G[t]);
#pragma unroll
            for (int t = 0; t < NTQ; ++t) G[t] = MF16(N8, cvt4(G[t]), G[t]);
#pragma unroll
            for (int t = 0; t < NTQ; ++t) { const int vt = 2 * hq + t; const int tc = vt & 3;
                const f16x4 uh = cvt4(G[t] * ivr2);
                Y[t] = MF16(NbH, uh, Y[t]); if (hv) Y[t] = MF16(NkH, vf[t], Y[t]);
                char* yo = hv ? (char*)MIX + ((mb + (unsigned)q4) * (unsigned)DM + (unsigned)(h * 64 + 16 * tc + tok)) * 2u : (char*)QT + ((mb + (unsigned)q4) * (unsigned)RW_W + (unsigned)(h * 64 + 16 * tc + tok)) * 2u;
#pragma unroll
                for (int r = 0; r < 4; ++r) *(f16*)(yo + (unsigned)r * (hv ? (unsigned)(DM * 2) : (unsigned)(RW_W * 2))) = (f16)Y[t][r];
#pragma unroll
                for (int ct = 0; ct < 4; ++ct) { const f32x4 g16 = *(const LAS f32x4*)(wl + RWF_G16 + (16 * ct + q4) * 4);
                    const f16x4 bt = *(const LAS f16x4*)(wl + RWC_B + (16 * ct + tok) * 32 + q4 * 2);
                    f32x4 xn = MF16(bt, uh, XT[ct][vt] * g16);
                    if (hv) { const f16x4 kt = *(const LAS f16x4*)(wl + RWC_K + (16 * ct + tok) * 32 + q4 * 2); xn = MF16(kt, vf[t], xn); }
                    XT[ct][vt] = xn; } }
        }
        asm volatile("" ::: "memory");
    }
    { const int lane2 = lane_now(); const int n2 = lane2 & 15, q2 = (lane2 >> 4) * 4;
      f16* rl = RL + ((size_t)bh * NCH + c) * 4096;
      f16* pt = PT + ((size_t)bh * NCH + c) * 4096;
#pragma unroll
      for (int ct = 0; ct < 4; ++ct)
#pragma unroll
          for (int t = 0; t < 4; ++t) { *(f16x4*)(rl + (16 * t + n2) * 64 + 16 * ct + q2) = cvt4(XT[ct][4 + t]);
#pragma unroll
              for (int r = 0; r < 4; ++r) pt[(16 * ct + q2 + r) * 64 + 16 * t + n2] = (f16)XT[ct][t][r]; } }
}

constexpr int HGA_REC = 768, HGA_TB = 8  , HGA_V = HGA_TB * HGA_REC, HGA_HEAD = HGA_V + HGA_TB * 128, HGA_BYTES = 2 * HGA_HEAD;
template <int NH>
__device__ __forceinline__ void hgrn_waveA(const Args& a, int l, int b, int c, int h0, LAS unsigned char* wl) {
    char* U = (char*)(a.ws + WS_U); char* MIX = (char*)(a.ws + WS_MIX); f16* HL = (f16*)(a.ws + WS_HL); float* DC = (float*)(a.ws + WS_DC);
    const float* lbr = a.in[16];
    float S[NH][64]; float dpr[NH];
#pragma unroll
    for (int j = 0; j < NH; ++j) { dpr[j] = 1.f;
#pragma unroll
        for (int k = 0; k < 64; ++k) S[j][k] = 0.f; }
#pragma unroll 1
    for (int blk = 0; blk < CH / HGA_TB; ++blk) {
        const int lane_ = lane_now();
        const unsigned mb = (unsigned)(b * SEQ + c * CH + blk * HGA_TB);
        {
            f16 fr[NH][HGA_TB], qr[NH][HGA_TB], vr[NH][HGA_TB];
#pragma unroll
            for (int j = 0; j < NH; ++j)
#pragma unroll
                for (int tk = 0; tk < HGA_TB; ++tk) { const char* ur = U + (mb + tk) * (unsigned)(NU * 2) + (unsigned)((h0 + j) * 64 + lane_) * 2u; fr[j][tk] = *(const f16*)(ur + C_HGF * 2); qr[j][tk] = *(const f16*)(ur + C_HGQ * 2); vr[j][tk] = *(const f16*)(ur + C_HGI * 2); }
#pragma unroll
            for (int j = 0; j < NH; ++j) { const int col = (h0 + j) * 64 + lane_;
                const float lb = (l == 0) ? 0.f : sigmoidf_(lbr[384 + col] - lbr[col]);
                float dp = dpr[j];
#pragma unroll
                for (int tk = 0; tk < HGA_TB; ++tk) {
                    const float f = lb + (1.0f - lb) * sigmoidf_((float)fr[j][tk]);
                    LAS unsigned char* rec = wl + j * HGA_HEAD + tk * HGA_REC;
                    *(LAS float*)(rec + lane_ * 4) = f; *(LAS float*)(rec + 256 + lane_ * 4) = 1.0f - f; *(LAS float*)(rec + 512 + lane_ * 4) = (float)qr[j][tk];
                    *(LAS f16*)(wl + j * HGA_HEAD + HGA_V + tk * 128 + lane_ * 2) = vr[j][tk];
                    dp *= f;
                    *(f16*)(U + (mb + tk) * (unsigned)(NU * 2) + (unsigned)(C_HGQ + col) * 2u) = (f16)((float)qr[j][tk] * dp);
                }
                dpr[j] = dp; }
        }
        asm volatile("s_waitcnt lgkmcnt(0)" ::: "memory");
#define HG_LD(F, K, Q, rcp, g) { F[0] = *(const LAS f32x4*)((rcp) + (g) * 32); F[1] = *(const LAS f32x4*)((rcp) + (g) * 32 + 16); K[0] = *(const LAS f32x4*)((rcp) + 256 + (g) * 32); K[1] = *(const LAS f32x4*)((rcp) + 256 + (g) * 32 + 16); \
            Q[0] = *(const LAS f32x4*)((rcp) + 512 + (g) * 32); Q[1] = *(const LAS f32x4*)((rcp) + 512 + (g) * 32 + 16); }
#define HG_COMP(Sx, vi, F, K, Q, g) { float tt[8]; \
            _Pragma("unroll") for (int jj = 0; jj < 8; ++jj) tt[jj] = mul_asm(vi, K[jj >> 2][jj & 3]); \
            _Pragma("unroll") for (int jj = 0; jj < 8; ++jj) Sx[8 * (g) + jj] = fma_asm(Sx[8 * (g) + jj], F[jj >> 2][jj & 3], tt[jj]); \
            _Pragma("unroll") for (int jj = 0; jj < 8; ++jj) oa[jj] = fma_asm(Sx[8 * (g) + jj], Q[jj >> 2][jj & 3], oa[jj]); }
#define HG_HEAD(Sx, vi, rcp, rcn, oo) { float oa[8]; _Pragma("unroll") for (int jj = 0; jj < 8; ++jj) oa[jj] = 0.f; \
            HG_LD(fo, ko, qo, rcp, 1) HG_COMP(Sx, vi, fe, ke, qe, 0) \
            HG_LD(fe, ke, qe, rcp, 2) HG_COMP(Sx, vi, fo, ko, qo, 1) \
            HG_LD(fo, ko, qo, rcp, 3) HG_COMP(Sx, vi, fe, ke, qe, 2) \
            HG_LD(fe, ke, qe, rcp, 4) HG_COMP(Sx, vi, fo, ko, qo, 3) \
            HG_LD(fo, ko, qo, rcp, 5) HG_COMP(Sx, vi, fe, ke, qe, 4) \
            HG_LD(fe, ke, qe, rcp, 6) HG_COMP(Sx, vi, fo, ko, qo, 5) \
            HG_LD(fo, ko, qo, rcp, 7) HG_COMP(Sx, vi, fe, ke, qe, 6) \
            HG_LD(fe, ke, qe, rcn, 0) HG_COMP(Sx, vi, fo, ko, qo, 7) \
            oo = ((oa[0] + oa[1]) + (oa[2] + oa[3])) + ((oa[4] + oa[5]) + (oa[6] + oa[7])); }
        f32x4 fe[2], ke[2], qe[2], fo[2], ko[2], qo[2];
        HG_LD(fe, ke, qe, wl, 0)
        f16 vh[NH], vn[NH];
#pragma unroll
        for (int j = 0; j < NH; ++j) vh[j] = *(const LAS f16*)(wl + j * HGA_HEAD + HGA_V + lane_ * 2);
#pragma unroll 1
        for (int t2 = 0; t2 < HGA_TB; ++t2) {
            const LAS unsigned char* rc = wl + t2 * HGA_REC;
#pragma unroll
            for (int j = 0; j < NH; ++j) vn[j] = *(const LAS f16*)(wl + j * HGA_HEAD + HGA_V + ((t2 + 1) & (HGA_TB - 1)) * 128 + lane_ * 2);
            float oo[NH];
#pragma unroll
            for (int j = 0; j < NH; ++j) { const float vi = (float)vh[j];
                const LAS unsigned char* rcp = rc + j * HGA_HEAD; const LAS unsigned char* rcn = (j + 1 < NH) ? rc + (j + 1) * HGA_HEAD : rc + HGA_REC;
                HG_HEAD(S[j], vi, rcp, rcn, oo[j]) }
            char* mo = MIX + ((mb + t2) * (unsigned)DM + (unsigned)(384 + h0 * 64 + lane_)) * 2u;
#pragma unroll
            for (int j = 0; j < NH; ++j) { *(f16*)(mo + 128 * j) = (f16)oo[j]; vh[j] = vn[j]; }
        }
#undef HG_LD
#undef HG_COMP
#undef HG_HEAD
    }
    const int lane2 = lane_now();
#pragma unroll
    for (int j = 0; j < NH; ++j) { const int bh = b * 6 + h0 + j; store_row64_f16(HL + (((size_t)bh * NCH + c) * 64 + lane2) * 64, S[j]);
        DC[((size_t)bh * NCH + c) * 64 + lane2] = dpr[j]; }
}

__device__ __forceinline__ void lru_waveA(const Args& a, int l, int b, int c, int g, LAS unsigned char* wl) {
    const int ln = lane_now();
    const char* Ub = (const char*)(a.ws + WS_U); char* MIXb = (char*)(a.ws + WS_MIX); char* CA = (char*)(a.ws + WS_CA); float* LA = (float*)(a.ws + WS_LA); float* LH = (float*)(a.ws + WS_LH);
    const float* cw = a.in[18] + l * 4 * 256 + g * 64; const float* cb = a.in[19] + l * 256 + g * 64;
    const float* ba = a.in[21] + l * 256 + g * 64; const float* bx = a.in[23] + l * 256 + g * 64; const float* lam = a.in[24] + l * 256 + g * 64;
    const char* WAT = (const char*)(a.ws + WS_WAT) + (size_t)(l * 4 + g) * 8192; const char* WXT = (const char*)(a.ws + WS_WXT) + (size_t)(l * 4 + g) * 8192;
    LAS unsigned char* Y = wl;
    const unsigned mrow0 = (unsigned)(b * SEQ + c * CH);
#pragma unroll 1
    for (int ib = 0; ib < 8; ib += 4) {
        f16x8 xr[4][4];
#pragma unroll
        for (int it = 0; it < 4; ++it) { const int item = ln + 64 * (ib + it), tok = item >> 3, co = item & 7; const int t = c * CH + tok;
#pragma unroll
            for (int jj = 0; jj < 4; ++jj) { const int ts = t - 3 + jj; const unsigned row = (ts >= 0) ? mrow0 + (unsigned)(tok - 3 + jj) : mrow0 + (unsigned)tok;
                xr[it][jj] = *(const f16x8*)(Ub + (row * (unsigned)NU + (unsigned)(C_LRUX + g * 64 + 8 * co)) * 2u); } }
#pragma unroll
        for (int it = 0; it < 4; ++it) { const int item = ln + 64 * (ib + it), tok = item >> 3, co = item & 7; const int t = c * CH + tok;
            const f32x4 b0 = *(const f32x4*)(cb + 8 * co), b1 = *(const f32x4*)(cb + 8 * co + 4);
            float y[8] = {b0[0], b0[1], b0[2], b0[3], b1[0], b1[1], b1[2], b1[3]};
#pragma unroll
            for (int jj = 0; jj < 4; ++jj) { const int ts = t - 3 + jj;
                if (ts >= 0) { const f32x4 w0 = *(const f32x4*)(cw + jj * 256 + 8 * co), w1 = *(const f32x4*)(cw + jj * 256 + 8 * co + 4);
#pragma unroll
                    for (int i = 0; i < 8; ++i) y[i] += (i < 4 ? w0[i & 3] : w1[i & 3]) * (float)xr[it][jj][i]; } }
            *(LAS f16x8*)(Y + tok * 144 + co * 16) = pack8(y); } }
    asm volatile("s_waitcnt lgkmcnt(0)" ::: "memory");
    const int tl = ln & 15, fq = ln >> 4;
    float sp[16], cy[16], cp[16];
#pragma unroll
    for (int nt = 0; nt < 4; ++nt) { const f32x4 lm4 = *(const f32x4*)(lam + 16 * nt + 4 * fq);
#pragma unroll
        for (int i = 0; i < 4; ++i) { sp[nt * 4 + i] = log1pf(__expf(-lm4[i])); cy[nt * 4 + i] = 0.f; cp[nt * 4 + i] = 1.f; } }
    f16x8 wfa[4][2], wfx[4][2];
#pragma unroll
    for (int nt = 0; nt < 4; ++nt)
#pragma unroll
        for (int s2 = 0; s2 < 2; ++s2) { const unsigned wo = (unsigned)(((16 * nt + (ln & 15)) * 64 + 8 * (ln >> 4) + 32 * s2) * 2); wfa[nt][s2] = *(const f16x8*)(WAT + wo); wfx[nt][s2] = *(const f16x8*)(WXT + wo); }
#pragma unroll 1
    for (int tt = 0; tt < 4; ++tt) {
        f16x8 by[2];
#pragma unroll
        for (int s2 = 0; s2 < 2; ++s2) by[s2] = *(const LAS f16x8*)(Y + (16 * tt + tl) * 144 + (8 * fq + 32 * s2) * 2);
        const unsigned m = mrow0 + (unsigned)(16 * tt + tl);
#pragma unroll
        for (int nt = 0; nt < 4; ++nt) {
            f32x4 ra = (f32x4){0.f, 0.f, 0.f, 0.f}, rx = ra;
#pragma unroll
            for (int s2 = 0; s2 < 2; ++s2) { ra = __builtin_amdgcn_mfma_f32_16x16x32_f16(wfa[nt][s2], by[s2], ra, 0, 0, 0); rx = __builtin_amdgcn_mfma_f32_16x16x32_f16(wfx[nt][s2], by[s2], rx, 0, 0, 0); }
            const int ch0 = 16 * nt + 4 * fq;
            const f32x4 ba4 = *(const f32x4*)(ba + ch0), bx4 = *(const f32x4*)(bx + ch0);
            const f16x4 y4 = *(const LAS f16x4*)(Y + (16 * tt + tl) * 144 + ch0 * 2);
            f16x4 ho, co;
#pragma unroll
            for (int i = 0; i < 4; ++i) { const int q = nt * 4 + i;
                const float r = sigmoidf_(ra[i] + ba4[i]), ig = sigmoidf_(rx[i] + bx4[i]);
                const float la = -8.0f * r * sp[q];
                float av = __expf(la), uv = sqrtf(one_minus_exp_(2.0f * la)) * (ig * (float)y4[i]);
#define LRU_SCAN(d) { const float ap = __builtin_bit_cast(float, __builtin_amdgcn_update_dpp(0x3f800000, __builtin_bit_cast(int, av), 0x110 + (d), 0xf, 0xf, false)); \
                      const float up = __builtin_bit_cast(float, __builtin_amdgcn_update_dpp(0, __builtin_bit_cast(int, uv), 0x110 + (d), 0xf, 0xf, false)); \
                      uv = av * up + uv; av = av * ap; }
                LRU_SCAN(1) LRU_SCAN(2) LRU_SCAN(4) LRU_SCAN(8)
#undef LRU_SCAN
                const float hl = uv + av * cy[q], ca = av * cp[q];
                ho[i] = (f16)hl; co[i] = (f16)ca;
                cy[q] = __builtin_bit_cast(float, __builtin_amdgcn_ds_bpermute((ln | 15) << 2, __builtin_bit_cast(int, hl)));
                cp[q] = __builtin_bit_cast(float, __builtin_amdgcn_ds_bpermute((ln | 15) << 2, __builtin_bit_cast(int, ca)));
            }
            *(f16x4*)(MIXb + (m * (unsigned)DM + 768u + (unsigned)(g * 64 + ch0)) * 2u) = ho; *(f16x4*)(CA + (m * 256u + (unsigned)(g * 64 + ch0)) * 2u) = co;
        }
    }
    if (tl == 15) {
#pragma unroll
        for (int q = 0; q < 16; ++q) { const int ch = g * 64 + 16 * (q >> 2) + 4 * fq + (q & 3); LA[((size_t)b * NCH + c) * 256 + ch] = cp[q]; LH[((size_t)b * NCH + c) * 256 + ch] = cy[q]; } }
}

__device__ __forceinline__ void phaseA(const Args& a, int l, int task, LAS unsigned char* lds, int tid) {
    asm volatile("" : "+v"(tid));
    const int lane = tid & 63, wave = __builtin_amdgcn_readfirstlane(tid >> 6);
    const int b = task / NCH, c = task % NCH;
    const f16* U = (const f16*)(a.ws + WS_U); f16* MIX = (f16*)(a.ws + WS_MIX); f16* VF = (f16*)(a.ws + WS_VF); f16* VP = (f16*)(a.ws + WS_VP);
    f16* QT = (f16*)(a.ws + WS_QT); f16* PT = (f16*)(a.ws + WS_PT); f16* RL = (f16*)(a.ws + WS_RL); float* BONG = (float*)(a.ws + WS_BON);
    {
        LAS f16* prm = (LAS f16*)(lds + PRM_OFF); LAS float* prw0 = (LAS float*)(lds + PRM_OFF + PRM_W0_BYTE);
        for (int i = tid; i < PRM_HALVES + 384; i += NT) {
            if (i < 1280) prm[i] = (f16)a.in[3][l * RW_SHIFT + i];
            else if (i < PRM_HALVES) { const int q = (i - 1280) / 384, cc = (i - 1280) % 384;
                prm[i] = (f16)((q == 0) ? a.in[6][l * RW_W + cc] : (q == 1) ? a.in[11][l * RW_W + cc] : (q == 2) ? a.in[12][l * RW_W + cc] : (q == 3) ? a.in[13][l * RW_W + cc] : a.in[8][cc]); }
            else prw0[i - PRM_HALVES] = a.in[4][l * RW_W + (i - PRM_HALVES)]; }
        __syncthreads();
        if (wave < RW_H) { rwkv_waveA(a, l, b, c, wave, lds + wave * RWA_BYTES, lds + PRM_OFF, lane);
                           if (wave < 4) lru_waveA(a, l, b, c, wave, lds + wave * RWA_BYTES); }
        else { LAS unsigned char* hw = lds + RW_H * RWA_BYTES + (wave - RW_H) * HGA_BYTES;
               hgrn_waveA<2>(a, l, b, c, 2 * (wave - RW_H), hw); hgrn_waveA<1>(a, l, b, c, 4 + (wave - RW_H), hw); }
        __syncthreads();
    }
}

constexpr int PB_SLOT = 16384, PB_NS = 8, PB_AHEAD = 6, NGRP = NCH / 8;
#define ARENA(ws, off) ((char*)(ws) + WS_U + (size_t)((off) >> 11) * (size_t)(NU * 2) + (size_t)((off) & 2047))
constexpr size_t AR_PGT = 0, AR_LG = 2u << 20, AR_SG = 4u << 20;
#define PB_SWZ(row, o) ((row) * 128 + (((((o) >> 4) ^ ((row) & 7)) << 4) | ((o) & 15)))
template <bool ADD_L>
__device__ __forceinline__ void pb_step(f32x4 (&Sacc)[4], const LAS unsigned char* sl, int xrow, int vl, int fq) {
    f16x8 Bhi[2], Blo[2];
#pragma unroll
    for (int mt = 0; mt < 4; ++mt)
#pragma unroll
        for (int i = 0; i < 4; ++i) { const f16 hi = (f16)Sacc[mt][i]; const f16 lo = (f16)(Sacc[mt][i] - (float)hi); Bhi[mt >> 1][4 * (mt & 1) + i] = hi; Blo[mt >> 1][4 * (mt & 1) + i] = lo; }
#pragma unroll
    for (int mt = 0; mt < 4; ++mt) {
        f32x4 d = (f32x4){0.f, 0.f, 0.f, 0.f};
        if (ADD_L) { const f16x4 l4 = *(const LAS f16x4*)(sl + 8192 + PB_SWZ(xrow, 32 * mt + 8 * fq)); d = (f32x4){(float)l4[0], (float)l4[1], (float)l4[2], (float)l4[3]}; }
#pragma unroll
        for (int s = 0; s < 2; ++s) { const u32x2 a0 = *(const LAS u32x2*)(sl + PB_SWZ(16 * mt + vl, 64 * s + 8 * fq)), a1 = *(const LAS u32x2*)(sl + PB_SWZ(16 * mt + vl, 64 * s + 32 + 8 * fq));
            u32x4 aw; aw.x = a0.x; aw.y = a0.y; aw.z = a1.x; aw.w = a1.y; const f16x8 af = __builtin_bit_cast(f16x8, aw);
            d = __builtin_amdgcn_mfma_f32_16x16x32_f16(af, Bhi[s], d, 0, 0, 0); d = __builtin_amdgcn_mfma_f32_16x16x32_f16(af, Blo[s], d, 0, 0, 0); }
        Sacc[mt] = d; }
}
__device__ __forceinline__ void pb_stage8(const Args& a, LAS unsigned char* lds, int bh, int c0, int wave, int lane) {
    const char* PT = (const char*)(a.ws + WS_PT) + ((size_t)bh * NCH + c0) * 8192; const char* RL = (const char*)(a.ws + WS_RL) + ((size_t)bh * NCH + c0) * 8192;
    const int lq = wave * 64 + lane, lrow = lq >> 3, lpp = lq & 7; const unsigned lsrc = (unsigned)(lrow * 128 + ((lpp ^ (lrow & 7)) << 4));
#pragma unroll
    for (int sl = 0; sl < 8; ++sl) { const unsigned so = (unsigned)(sl * PB_SLOT + wave * 1024); const size_t go = (size_t)sl * 8192 + lsrc;
        __builtin_amdgcn_global_load_lds((const unsigned*)(PT + go), (LAS unsigned*)(lds + so), 16, 0, 0);
        __builtin_amdgcn_global_load_lds((const unsigned*)(RL + go), (LAS unsigned*)(lds + so + 8192), 16, 0, 0); }
    asm volatile("s_waitcnt vmcnt(0)" ::: "memory");
    __builtin_amdgcn_s_barrier();
}
__device__ __forceinline__ void phaseB1(const Args& a, LAS unsigned char* lds, int tid) {
    asm volatile("" : "+v"(tid));
    const int lane = tid & 63, wave = __builtin_amdgcn_readfirstlane(tid >> 6);
    for (int task = blockIdx.x; task < 12 * NGRP; task += gridDim.x) {
        const int bh = task / NGRP, g = task % NGRP, c0 = 8 * g;
        pb_stage8(a, lds, bh, c0, wave, lane);
        const int vt = wave & 3, vl = lane & 15, fq = lane >> 4, xr = 16 * vt + vl;
        f32x4 X[4];
        if (wave < 4) {
#pragma unroll
            for (int mt = 0; mt < 4; ++mt) { const f16x4 l4 = *(const LAS f16x4*)(lds + 8192 + PB_SWZ(xr, 32 * mt + 8 * fq)); X[mt] = (f32x4){(float)l4[0], (float)l4[1], (float)l4[2], (float)l4[3]}; }
#pragma unroll 1
            for (int s = 1; s < 8; ++s) pb_step<true>(X, lds + s * PB_SLOT, xr, vl, fq);
#pragma unroll
            for (int mt = 0; mt < 4; ++mt) { f16x4 o;
#pragma unroll
                for (int i = 0; i < 4; ++i) o[i] = (f16)X[mt][i];
                *(f16x4*)ARENA(a.ws, AR_LG + ((size_t)bh * NGRP + g) * 8192 + (size_t)((xr * 64 + 16 * mt + 4 * fq) * 2)) = o; }
        } else {
#pragma unroll
            for (int mt = 0; mt < 4; ++mt)
#pragma unroll
                for (int i = 0; i < 4; ++i) X[mt][i] = (16 * mt + 4 * fq + i == xr) ? 1.f : 0.f;
#pragma unroll 1
            for (int s = 0; s < 8; ++s) pb_step<false>(X, lds + s * PB_SLOT, xr, vl, fq);
#pragma unroll
            for (int mt = 0; mt < 4; ++mt)
#pragma unroll
                for (int i = 0; i < 4; ++i) *(f16*)ARENA(a.ws, AR_PGT + ((size_t)bh * NGRP + g) * 8192 + (size_t)(((16 * mt + 4 * fq + i) * 64 + xr) * 2)) = (f16)X[mt][i];
        }
        asm volatile("s_waitcnt vmcnt(0) lgkmcnt(0)" ::: "memory");
        __builtin_amdgcn_s_barrier();
    }
}
__device__ __forceinline__ void phaseB3(const Args& a, LAS unsigned char* lds, int tid) {
    asm volatile("" : "+v"(tid));
    const int lane = tid & 63, wave = __builtin_amdgcn_readfirstlane(tid >> 6);
    for (int task = blockIdx.x; task < 12 * NGRP; task += gridDim.x) {
        const int bh = task / NGRP, g = task % NGRP, c0 = 8 * g;
        pb_stage8(a, lds, bh, c0, wave, lane);
        if (wave < 4) {
            const int vt = wave, vl = lane & 15, fq = lane >> 4, xr = 16 * vt + vl;
            char* RL = (char*)(a.ws + WS_RL) + ((size_t)bh * NCH + c0) * 8192;
            f32x4 X[4];
#pragma unroll
            for (int mt = 0; mt < 4; ++mt) { const f16x4 s4 = *(const f16x4*)ARENA(a.ws, AR_SG + ((size_t)bh * NGRP + g) * 8192 + (size_t)((xr * 64 + 16 * mt + 4 * fq) * 2)); X[mt] = (f32x4){(float)s4[0], (float)s4[1], (float)s4[2], (float)s4[3]}; }
#pragma unroll 1
            for (int s = 0; s < 8; ++s) {
#pragma unroll
                for (int mt = 0; mt < 4; ++mt) { f16x4 o;
#pragma unroll
                    for (int i = 0; i < 4; ++i) o[i] = (f16)X[mt][i];
                    *(f16x4*)(RL + (size_t)s * 8192 + (xr * 64 + 16 * mt + 4 * fq) * 2) = o; }
                if (s < 7) pb_step<true>(X, lds + s * PB_SLOT, xr, vl, fq);
            }
        }
        asm volatile("s_waitcnt vmcnt(0) lgkmcnt(0)" ::: "memory");
        __builtin_amdgcn_s_barrier();
    }
}
__device__ __forceinline__ void phaseB(const Args& a, LAS unsigned char* lds, int tid) {
    asm volatile("" : "+v"(tid));
    const int lane = tid & 63, wave = __builtin_amdgcn_readfirstlane(tid >> 6);
    const int bx = blockIdx.x;
    if (bx < 12) {
        const int bh = bx;
        const bool loader = wave >= 4;
        const int vt = wave & 3, vl = lane & 15, fq = lane >> 4, v = 16 * vt + vl;
        const int lq = (wave - 4) * 64 + lane, lrow = lq >> 3, lpp = lq & 7;
        const unsigned lsrc = (unsigned)(lrow * 128 + ((lpp ^ (lrow & 7)) << 4));
#define PB_ISSUE(cc) { const unsigned so = (unsigned)(((cc) & (PB_NS - 1)) * PB_SLOT) + (unsigned)((wave - 4) * 1024); const size_t go = ((size_t)bh * NGRP + (cc)) * 8192 + lsrc; \
            __builtin_amdgcn_global_load_lds((const unsigned*)ARENA(a.ws, AR_PGT + go), (LAS unsigned*)(lds + so), 16, 0, 0); \
            __builtin_amdgcn_global_load_lds((const unsigned*)ARENA(a.ws, AR_PGT + go + 4096), (LAS unsigned*)(lds + so + 4096), 16, 0, 0); \
            __builtin_amdgcn_global_load_lds((const unsigned*)ARENA(a.ws, AR_LG + go), (LAS unsigned*)(lds + so + 8192), 16, 0, 0); \
            __builtin_amdgcn_global_load_lds((const unsigned*)ARENA(a.ws, AR_LG + go + 4096), (LAS unsigned*)(lds + so + 12288), 16, 0, 0); }
        if (loader) {
#pragma unroll
            for (int cc = 0; cc < PB_AHEAD; ++cc) PB_ISSUE(cc)
            asm volatile("s_waitcnt vmcnt(20)" ::: "memory");
        }
        __builtin_amdgcn_s_barrier();
        f32x4 Sacc[4];
#pragma unroll
        for (int mt = 0; mt < 4; ++mt) Sacc[mt] = (f32x4){0.f, 0.f, 0.f, 0.f};
#pragma unroll 1
        for (int c = 0; c < NGRP; ++c) {
            if (loader) {
                if (c + PB_AHEAD < NGRP) { PB_ISSUE(c + PB_AHEAD) asm volatile("s_waitcnt vmcnt(20)" ::: "memory"); }
                else asm volatile("s_waitcnt vmcnt(0)" ::: "memory");
            } else {
#pragma unroll
                for (int mt = 0; mt < 4; ++mt) { f16x4 o;
#pragma unroll
                    for (int i = 0; i < 4; ++i) o[i] = (f16)Sacc[mt][i];
                    *(f16x4*)ARENA(a.ws, AR_SG + ((size_t)bh * NGRP + c) * 8192 + (size_t)((v * 64 + 16 * mt + 4 * fq) * 2)) = o; }
                pb_step<true>(Sacc, lds + (c & (PB_NS - 1)) * PB_SLOT, v, vl, fq);
                asm volatile("s_waitcnt lgkmcnt(0)" ::: "memory");
            }
            __builtin_amdgcn_s_barrier();
        }
#undef PB_ISSUE
        asm volatile("s_waitcnt vmcnt(0)" ::: "memory");
    } else if (bx < 12 + 96) {
        const int idx = (bx - 12) * NT + tid; const int bh = idx >> 12, e = idx & 4095, k = e & 63;
        f16* HL = (f16*)(a.ws + WS_HL); const float* DC = (const float*)(a.ws + WS_DC);
        float s = 0.f;
        for (int c0 = 0; c0 < NCH; c0 += 8) { float Lc[8], d[8];
#pragma unroll
            for (int j = 0; j < 8; ++j) { Lc[j] = (float)HL[((size_t)bh * NCH + c0 + j) * 4096 + e]; d[j] = DC[((size_t)bh * NCH + c0 + j) * 64 + k]; }
#pragma unroll
            for (int j = 0; j < 8; ++j) { HL[((size_t)bh * NCH + c0 + j) * 4096 + e] = (f16)s; s = d[j] * s + Lc[j]; } }
    } else if (bx == 12 + 96) {
        const int bb = tid >> 8, ch = tid & 255; const float* LA = (const float*)(a.ws + WS_LA); float* LH = (float*)(a.ws + WS_LH);
        float cy = 0.f;
        for (int c0 = 0; c0 < NCH; c0 += 8) { float A[8], H[8];
#pragma unroll
            for (int j = 0; j < 8; ++j) { const size_t o = ((size_t)bb * NCH + c0 + j) * 256 + ch; A[j] = LA[o]; H[j] = LH[o]; }
#pragma unroll
            for (int j = 0; j < 8; ++j) { const size_t o = ((size_t)bb * NCH + c0 + j) * 256 + ch; LH[o] = cy; cy = A[j] * cy + H[j]; } }
    }
}

__device__ __forceinline__ void phaseC(const Args& a, int l, int task, LAS unsigned char* lds, int tid) {
    asm volatile("" : "+v"(tid));
    const int lane = tid & 63, wave = __builtin_amdgcn_readfirstlane(tid >> 6);
    const int b = task / NCH, c = task % NCH;
    const int tl = lane & 15, fq = lane >> 4, tt = wave & 3, hg = wave >> 2;
    const unsigned m = (unsigned)(b * SEQ + c * CH + 16 * tt + tl);
    const char* U = (const char*)(a.ws + WS_U); char* MIX = (char*)(a.ws + WS_MIX); const char* VP = (const char*)(a.ws + WS_VP);
    const char* QT = (const char*)(a.ws + WS_QT); const char* RL = (const char*)(a.ws + WS_RL); const char* HL = (const char*)(a.ws + WS_HL); const float* BONG = (const float*)(a.ws + WS_BON);
    const unsigned uo = m * (unsigned)(NU * 2);
#pragma unroll
    for (int hh = 0; hh < 3; ++hh) {
        const int h = 3 * hg + hh; const int bh = b * RW_H + h;
        const char* sl = RL + ((size_t)bh * NCH + c) * 8192;
        f16x8 bq[2];
#pragma unroll
        for (int s = 0; s < 2; ++s) bq[s] = *(const f16x8*)(QT + (m * (unsigned)RW_W + (unsigned)(h * 64 + 8 * fq + 32 * s)) * 2u);
        f32x4 D[4];
#pragma unroll
        for (int vt = 0; vt < 4; ++vt) { const f16x4 yl = *(const f16x4*)(MIX + (m * (unsigned)DM + (unsigned)(h * 64 + 16 * vt + 4 * fq)) * 2u);
            f32x4 d = (f32x4){(float)yl[0], (float)yl[1], (float)yl[2], (float)yl[3]};
#pragma unroll
            for (int s = 0; s < 2; ++s) d = __builtin_amdgcn_mfma_f32_16x16x32_f16(*(const f16x8*)(sl + ((16 * vt + tl) * 64 + 8 * fq + 32 * s) * 2), bq[s], d, 0, 0, 0);
            D[vt] = d; }
        float sm = 0.f;
#pragma unroll
        for (int vt = 0; vt < 4; ++vt) sm += (D[vt][0] + D[vt][1]) + (D[vt][2] + D[vt][3]);
        sm += shfl_xor_f(sm, 16); sm += shfl_xor_f(sm, 32);
        const float mean = sm * (1.0f / 64.0f); float vr = 0.f;
#pragma unroll
        for (int vt = 0; vt < 4; ++vt)
#pragma unroll
            for (int i = 0; i < 4; ++i) { const float d = D[vt][i] - mean; vr += d * d; }
        vr += shfl_xor_f(vr, 16); vr += shfl_xor_f(vr, 32);
        const float rstd = rsq_(vr * (1.0f / 64.0f) + 64e-5f);
        const float bon = BONG[m * 8u + (unsigned)h];
        const float* ln_w = a.in[14] + l * RW_W; const float* ln_b = a.in[15] + l * RW_W;
#pragma unroll
        for (int vt = 0; vt < 4; ++vt) { const unsigned col = (unsigned)(h * 64 + 16 * vt + 4 * fq);
            const f16x4 vp = *(const f16x4*)(VP + (m * (unsigned)RW_W + col) * 2u), z4 = *(const f16x4*)(U + uo + ((unsigned)C_RWZ + col) * 2u);
            const f32x4 lw = *(const f32x4*)(ln_w + col), lb = *(const f32x4*)(ln_b + col);
            f16x4 o;
#pragma unroll
            for (int i = 0; i < 4; ++i) o[i] = (f16)(((D[vt][i] - mean) * rstd * lw[i] + lb[i] + bon * (float)vp[i]) * siluf_((float)z4[i]));
            *(f16x4*)(MIX + (m * (unsigned)DM + col) * 2u) = o; }
    }
#pragma unroll
    for (int hh = 0; hh < 3; ++hh) {
        const int h = 3 * hg + hh; const int bh = b * 6 + h;
        const char* sl = HL + ((size_t)bh * NCH + c) * 8192;
        f16x8 bq[2];
#pragma unroll
        for (int s = 0; s < 2; ++s) bq[s] = *(const f16x8*)(U + uo + (unsigned)(C_HGQ + h * 64 + 8 * fq + 32 * s) * 2u);
        f32x4 D[4];
#pragma unroll
        for (int vt = 0; vt < 4; ++vt) { const f16x4 ol = *(const f16x4*)(MIX + (m * (unsigned)DM + (unsigned)(384 + h * 64 + 16 * vt + 4 * fq)) * 2u);
            f32x4 d = (f32x4){(float)ol[0], (float)ol[1], (float)ol[2], (float)ol[3]};
#pragma unroll
            for (int s = 0; s < 2; ++s) d = __builtin_amdgcn_mfma_f32_16x16x32_f16(*(const f16x8*)(sl + ((16 * vt + tl) * 64 + 8 * fq + 32 * s) * 2), bq[s], d, 0, 0, 0);
            D[vt] = d; }
        float ss = 0.f;
#pragma unroll
        for (int vt = 0; vt < 4; ++vt) ss += (D[vt][0] * D[vt][0] + D[vt][1] * D[vt][1]) + (D[vt][2] * D[vt][2] + D[vt][3] * D[vt][3]);
        ss += shfl_xor_f(ss, 16); ss += shfl_xor_f(ss, 32);
        const float rs = rsq_(ss * (1.0f / 64.0f) + 1e-6f);
        const float* nw = a.in[17] + l * 384;
#pragma unroll
        for (int vt = 0; vt < 4; ++vt) { const unsigned col = (unsigned)(h * 64 + 16 * vt + 4 * fq);
            const f16x4 z4 = *(const f16x4*)(U + uo + ((unsigned)C_HGZ + col) * 2u); const f32x4 w4 = *(const f32x4*)(nw + col);
            f16x4 o;
#pragma unroll
            for (int i = 0; i < 4; ++i) o[i] = (f16)(D[vt][i] * rs * w4[i] * siluf_((float)z4[i]));
            *(f16x4*)(MIX + (m * (unsigned)DM + 384u + col) * 2u) = o; }
    }
    {
        const char* CA = (const char*)(a.ws + WS_CA); const float* LH = (const float*)(a.ws + WS_LH) + ((size_t)b * NCH + c) * 256;
#pragma unroll
        for (int q = 0; q < 4; ++q) { const unsigned ch0 = (unsigned)(128 * hg + 32 * fq + 8 * q);
            const f16x8 hl = *(const f16x8*)(MIX + (m * (unsigned)DM + 768u + ch0) * 2u), ca = *(const f16x8*)(CA + (m * 256u + ch0) * 2u), z8 = *(const f16x8*)(U + uo + ((unsigned)C_LRUZ + ch0) * 2u);
            const f32x4 c0 = *(const f32x4*)(LH + ch0), c1 = *(const f32x4*)(LH + ch0 + 4);
            f16x8 o;
#pragma unroll
            for (int i = 0; i < 8; ++i) o[i] = (f16)(((float)hl[i] + (float)ca[i] * (i < 4 ? c0[i & 3] : c1[i & 3])) * siluf_((float)z8[i]));
            *(f16x8*)(MIX + (m * (unsigned)DM + 768u + ch0) * 2u) = o; }
    }
}
#define XB_TMO      128
#define XB_XCNT(j)  (256  + 64 * (j))
#define XB_XSUB(j)  (1280 + 64 * (j))
#define XB_XGEN(j)  (2304 + 64 * (j))
#define XB_TOP      3328
#define XB_TOPGEN   3392
#define XCD_BAR_WORDS 3456
#define XB_SPIN_CAP (1u << 18)

__device__ __forceinline__ unsigned xb_ld(unsigned* p)              { return __hip_atomic_load(p, __ATOMIC_RELAXED, __HIP_MEMORY_SCOPE_AGENT); }
__device__ __forceinline__ unsigned xb_add(unsigned* p, unsigned v) { return __hip_atomic_fetch_add(p, v, __ATOMIC_RELAXED, __HIP_MEMORY_SCOPE_AGENT); }
__device__ __forceinline__ unsigned xb_xcc_id() { return (unsigned)__builtin_amdgcn_s_getreg((3 << 11) | 20) & 0xFu; }
#define XB_SPIN(cond, bar) do { unsigned _sp = 0; while (cond) { __builtin_amdgcn_s_sleep(1); \
    if ((++_sp & 255u) == 0u) { if (xb_ld(&(bar)[XB_TMO])) break; if (_sp > XB_SPIN_CAP) { atomicAdd(&(bar)[XB_TMO], 1u); break; } } } } while (0)

struct XcdBarrier {
    unsigned* bar; unsigned x; int isw0;
    volatile LAS unsigned* st;
};

__device__ __forceinline__ XcdBarrier xcd_barrier_post(unsigned* bar, volatile LAS unsigned* st, int isw0) {
    XcdBarrier b; b.bar = bar; b.x = xb_xcc_id(); b.st = st; b.isw0 = isw0;
    if (isw0 && lane_now() == 0) (void)xb_add(&bar[XB_XCNT(b.x)], 1u);
    return b;
}
__device__ __forceinline__ void xcd_barrier_complete(unsigned* bar, unsigned x, unsigned& nloc, unsigned& nx) {
    const unsigned G = gridDim.x * gridDim.y * gridDim.z;
    unsigned sum, cnt, mine, sp = 0u;
    for (;;) {
        sum = 0u; cnt = 0u; mine = 0u;
#pragma unroll
        for (unsigned j = 0; j < 16; ++j) { const unsigned c = xb_ld(&bar[XB_XCNT(j)]); sum += c; cnt += (c > 0u) ? 1u : 0u; mine = (j == x) ? c : mine; }
        if (sum == G) break;
        __builtin_amdgcn_s_sleep(1);
        if ((++sp & 255u) == 0u) { if (xb_ld(&bar[XB_TMO])) break; if (sp > XB_SPIN_CAP) { atomicAdd(&bar[XB_TMO], 1u); break; } }
    }
    nloc = mine > 0u ? mine : 1u; nx = cnt > 0u ? cnt : 1u;
}

__device__ __forceinline__ void xcd_barrier(const XcdBarrier& b) {
    asm volatile("s_waitcnt vmcnt(0)" ::: "memory");
    __syncthreads();
    if (b.isw0 && lane_now() == 0) {
        unsigned* bar = b.bar;
        __builtin_amdgcn_s_waitcnt(0);
        unsigned nloc = b.st[0], nx = b.st[1];
        if (nloc == 0u) { xcd_barrier_complete(bar, b.x, nloc, nx); b.st[0] = nloc; b.st[1] = nx; }
        const unsigned old = xb_add(&bar[XB_XSUB(b.x)], 1u);
        const unsigned gen = old / nloc;
        if (old + 1u == (gen + 1u) * nloc) {
            __builtin_amdgcn_fence(__ATOMIC_RELEASE, "agent");
            asm volatile("s_waitcnt vmcnt(0)" ::: "memory");
            const unsigned og = xb_add(&bar[XB_TOP], 1u);
            const unsigned tg = og / nx;
            if (og + 1u == (tg + 1u) * nx) xb_add(&bar[XB_TOPGEN], 1u);
            else XB_SPIN(xb_ld(&bar[XB_TOPGEN]) == tg, bar);
            __builtin_amdgcn_fence(__ATOMIC_ACQUIRE, "agent");
            xb_add(&bar[XB_XGEN(b.x)], 1u);
            asm volatile("s_waitcnt vmcnt(0)" ::: "memory");
        } else {
            XB_SPIN(xb_ld(&bar[XB_XGEN(b.x)]) == gen, bar);
            __builtin_amdgcn_fence(__ATOMIC_ACQUIRE, "agent");
            asm volatile("s_waitcnt vmcnt(0)" ::: "memory");
        }
    }
    __syncthreads();
}

constexpr size_t WS_BAR = 16384;
constexpr size_t WS_PCNT = 32768;
constexpr int MISC_OFF = LDS_BYTES - 16;
__global__ void __launch_bounds__(NT, 2) fwd(Args args) {
    extern __shared__ __attribute__((aligned(16))) unsigned char lds_raw[];
    LAS unsigned char* lds = (LAS unsigned char*)lds_raw;
    cg::grid_group grid = cg::this_grid();
    const int wave = __builtin_amdgcn_readfirstlane((int)threadIdx.x >> 6);
#define TID_NOW() (wave * 64 + lane_now())
    const int tid = TID_NOW(); const int lane = tid & 63;
    if (wave == 0 && lane < 4) ((LAS unsigned*)(lds + MISC_OFF))[lane] = 0u;
    __syncthreads();
    XcdBarrier xbar = xcd_barrier_post((unsigned*)(args.ws + WS_BAR), (volatile LAS unsigned*)(lds + MISC_OFF), __builtin_amdgcn_readfirstlane(wave == 0 ? 1 : 0));
#define GRID_BAR() do { XcdBarrier xb_ = xbar; xb_.st = (volatile LAS unsigned*)(lds + MISC_OFF); asm volatile("" : "+s"(xb_.bar), "+s"(xb_.x)); xcd_barrier(xb_); } while (0)
    const int G = gridDim.x, gw = blockIdx.x * NWAVES + wave, NGW = G * NWAVES;
    unsigned char* ws = args.ws;
    unsigned short* XN = (unsigned short*)(ws + WS_XN);
    {
        LAS float* scr = (LAS float*)(lds + wave * 8704);
        constexpr int I_IN = (DM / 64) * (NIN / 32), I_OUT = (DM / 64) * (DM / 32), NITEMS = DEPTH * (I_IN + I_OUT);
        for (int it = gw; it < NITEMS; it += NGW) {
            int r = it; const int l = r / (I_IN + I_OUT); r -= l * (I_IN + I_OUT);
            if (r < I_IN) p0_transpose_item(args.in[2] + (size_t)l * DM * NIN, DM, NIN, (unsigned short*)(ws + WS_WIN + l * WIN_L), scr, r, lane, l == 0 ? nullptr : args.in[1] + DM);
            else p0_transpose_item(args.in[25] + (size_t)l * DM * DM, DM, DM, (unsigned short*)(ws + WS_WOUT + l * WOUT_L), scr, r - I_IN, lane, nullptr);
        }
        for (int i = gw; i < DEPTH * (NU - NIN) * DM * 2 / 1024; i += NGW) { const int l = i / ((NU - NIN) * DM * 2 / 1024), r = i % ((NU - NIN) * DM * 2 / 1024);
            if (l == 1 && r < 64 * DM * 2 / 1024) continue;
            *(u32x4*)(ws + WS_WIN + l * WIN_L + (size_t)NIN * DM * 2 + (size_t)r * 1024 + lane * 16) = (u32x4){0u, 0u, 0u, 0u}; }
        if (blockIdx.x < 32) {
            LAS f16* TT = (LAS f16*)(lds + 8 * 8704);
            for (int i = tid; i < 64 * RW_W; i += NT) { const int n = i / RW_W, cc = i % RW_W; const float mm = args.in[3][RW_SHIFT + C_V + cc]; TT[n * 392 + cc] = (f16)(((n < 32) ? (1.0f - mm) : mm) * args.in[9][cc * 32 + (n & 31)]); }
            __syncthreads();
            const int tile = blockIdx.x * NWAVES + wave, nt = tile & 3, kt = tile >> 2, tl = lane & 15, fq = lane >> 4;
            const float* wrow = args.in[2] + (size_t)DM * NIN + (size_t)(16 * kt + tl) * NIN + C_V + 8 * fq;
            f32x4 bv[12][2];
#pragma unroll
            for (int s2 = 0; s2 < 12; ++s2) { bv[s2][0] = *(const f32x4*)(wrow + 32 * s2); bv[s2][1] = *(const f32x4*)(wrow + 32 * s2 + 4); }
            f32x4 d = (f32x4){0.f, 0.f, 0.f, 0.f};
#pragma unroll
            for (int s2 = 0; s2 < 12; ++s2) { f16x8 bf;
#pragma unroll
                for (int j = 0; j < 8; ++j) bf[j] = (f16)(j < 4 ? bv[s2][0][j & 3] : bv[s2][1][j & 3]);
                d = __builtin_amdgcn_mfma_f32_16x16x32_f16(*(const LAS f16x8*)(TT + (16 * nt + tl) * 392 + 8 * fq + 32 * s2), bf, d, 0, 0, 0); }
            const float nwk = args.in[1][DM + 16 * kt + tl];
#pragma unroll
            for (int i = 0; i < 4; ++i) ((f16*)(ws + WS_WIN + WIN_L))[(size_t)(NIN + 16 * nt + 4 * fq + i) * DM + 16 * kt + tl] = (f16)(d[i] * nwk);
            __syncthreads();
        }
        for (int i = blockIdx.x * NT + tid; i < 2 * M; i += G * NT) ((float*)(ws + WS_RSS))[i] = 0.f;
        for (int m = gw; m < M; m += 4 * NGW) rms_row4_f16(args.in[0] + (size_t)m * DM, (size_t)NGW * DM, args.in[1], XN + (size_t)m * DM, lane);
        { f16* WUPT = (f16*)(ws + WS_WUPT); f16* AUPT = (f16*)(ws + WS_AUPT); f16* VDNT = (f16*)(ws + WS_VDNT); f16* VUPT = (f16*)(ws + WS_VUPT);
          for (int i = blockIdx.x * NT + tid; i < 122880; i += G * NT) {
              if (i < 49152) { const int ll = i / 24576, r = i % 24576, n = r / 64, k = r % 64; WUPT[i] = (f16)args.in[5][(size_t)ll * 24576 + k * 384 + n]; }
              else if (i < 98304) { const int i2 = i - 49152, ll = i2 / 24576, r = i2 % 24576, n = r / 64, k = r % 64; AUPT[i2] = (f16)args.in[7][(size_t)ll * 24576 + k * 384 + n]; }
              else if (i < 110592) { const int i2 = i - 98304, j2 = i2 / 384, cc = i2 % 384; VDNT[i2] = (f16)args.in[9][cc * 32 + j2]; }
              else { const int i2 = i - 110592, n = i2 / 32, j2 = i2 % 32; VUPT[i2] = (f16)args.in[10][j2 * 384 + n]; } }
          f16* WAT = (f16*)(ws + WS_WAT); f16* WXT = (f16*)(ws + WS_WXT);
          for (int i = blockIdx.x * NT + tid; i < 32768; i += G * NT) { const int lg = i >> 12, r = i & 4095, j = r >> 6, ii = r & 63; WAT[i] = (f16)args.in[20][(size_t)lg * 4096 + ii * 64 + j]; WXT[i] = (f16)args.in[22][(size_t)lg * 4096 + ii * 64 + j]; } }
    }
    if (gridDim.x > 65536u) grid.sync();
    GRID_BAR();
#pragma unroll 1
    for (int l = 0; l < DEPTH; ++l) {
        { pg8::Gemm g{XN, (const unsigned short*)(ws + WS_WIN + l * WIN_L), M, NU, DM}; pg8::StaticOrder S; S.init(M, NU, G, (int)blockIdx.x);
          pg8::EpiF16 E{(unsigned short*)(ws + WS_U), NU, l == 0 ? nullptr : (const float*)(ws + WS_RSS)};
          pg8::gemm_phase<pg8::EpiF16, pg8::StaticOrder, true, true>(lds, g, S, E, wave); }
        GRID_BAR();
        for (int task = blockIdx.x; task < BATCH * NCH; task += G) phaseA(args, l, task, lds, TID_NOW());
        GRID_BAR();
        phaseB1(args, lds, TID_NOW());
        GRID_BAR();
        phaseB(args, lds, TID_NOW());
        GRID_BAR();
        phaseB3(args, lds, TID_NOW());
        GRID_BAR();
        for (int task = blockIdx.x; task < BATCH * NCH; task += G) phaseC(args, l, task, lds, TID_NOW());
        GRID_BAR();
        { pg8::Gemm g{(const unsigned short*)(ws + WS_MIX), (const unsigned short*)(ws + WS_WOUT + l * WOUT_L), M, DM, DM}; pg8::StaticOrder S; S.init(M, DM, G, (int)blockIdx.x);
          if (l + 1 < DEPTH) {
              pg8::EpiRes E{args.in[0], args.out, DM, XN, (float*)(ws + WS_RSS)};
              pg8::gemm_phase<pg8::EpiRes, pg8::StaticOrder, true, true>(lds, g, S, E, wave);
              GRID_BAR();
          } else {
              pg8::EpiResNorm E{args.out, args.out, DM, (float*)(ws + WS_RSS) + M, (unsigned*)(ws + WS_PCNT), args.in[26]};
              pg8::gemm_phase<pg8::EpiResNorm, pg8::StaticOrder, true, true>(lds, g, S, E, wave);
          } }
    }
}

extern "C" void kernel_launch(void* const* d_in, const int* in_sizes, int n_in, void* d_out, int out_size, void* d_ws, size_t ws_size, hipStream_t stream) {
    static int grid = 0;
    if (grid == 0) {
        if (n_in != 27 || in_sizes[0] != M * DM || out_size != M * DM || ws_size < WS_END) { fprintf(stderr, "kernel_launch: unexpected problem: n_in %d in0 %d out %d ws %zu\n", n_in, n_in > 0 ? in_sizes[0] : -1, out_size, ws_size); grid = -1; return; }
        int dev = 0, cus = 0, per_cu = 0;
        hipGetDevice(&dev); hipDeviceGetAttribute(&cus, hipDeviceAttributeMultiprocessorCount, dev);
        if (hipFuncSetAttribute((const void*)fwd, hipFuncAttributeMaxDynamicSharedMemorySize, LDS_BYTES) != hipSuccess) { fprintf(stderr, "kernel_launch: hipFuncSetAttribute failed\n"); grid = -1; return; }
        if (hipOccupancyMaxActiveBlocksPerMultiprocessor(&per_cu, (const void*)fwd, NT, LDS_BYTES) != hipSuccess || per_cu < 1) { fprintf(stderr, "kernel_launch: occupancy query failed (%d)\n", per_cu); grid = -1; return; }
        grid = cus * per_cu;
    }
    if (grid < 0) return;
    if (hipMemsetAsync((char*)d_ws, 0, 65536, stream) != hipSuccess) { fprintf(stderr, "kernel_launch: memset of the barrier words failed\n"); return; }
    Args a{};
    for (int i = 0; i < 27; ++i) a.in[i] = (const float*)d_in[i];
    a.out = (float*)d_out; a.ws = (unsigned char*)d_ws;
    void* kargs[] = {&a};
    hipError_t e = hipLaunchCooperativeKernel((const void*)fwd, dim3(grid), dim3(NT), kargs, LDS_BYTES, stream);
    if (e != hipSuccess) fprintf(stderr, "cooperative launch failed: %s (grid %d)\n", hipGetErrorString(e), grid);
}
```

```cpp
#include <hip/hip_runtime.h>
#include <hip/hip_cooperative_groups.h>
#include <cstdio>
#include <cstdint>
namespace cg = cooperative_groups;
typedef _Float16 f16x8_t __attribute__((ext_vector_type(8)));
#define MK_MFMA(a, b, c) __builtin_amdgcn_mfma_f32_16x16x32_f16(__builtin_bit_cast(f16x8_t, (a)), __builtin_bit_cast(f16x8_t, (b)), (c), 0, 0, 0)
__device__ __forceinline__ int lane_now() { int z; asm volatile("v_mbcnt_lo_u32_b32 %0, -1, 0\n\tv_mbcnt_hi_u32_b32 %0, -1, %0" : "=v"(z)); return z; }
__device__ __forceinline__ float shfl_xor_f(float v, int mask) { const int ln = lane_now(); return __builtin_bit_cast(float, __builtin_amdgcn_ds_bpermute((ln ^ mask) << 2, __builtin_bit_cast(int, v))); }
namespace pg8 {
#define PG8_LAS __attribute__((address_space(3)))
typedef unsigned short bf16_t;
typedef short bf16x8 __attribute__((ext_vector_type(8)));
typedef float f32x4 __attribute__((ext_vector_type(4)));
typedef unsigned u32x4 __attribute__((ext_vector_type(4)));
constexpr int BM = 256, BK = 64, HALF = 128, HTB = HALF * BK * 2  , STAGE_BYTES = 8 * HTB, NXCD = 8, WGM = 8;

__host__ __device__ __forceinline__ int lds_byte(int r, int c) { const int st = (r >> 4) * 2 + (c >> 5), rr = r & 15, cc = c & 31, ob = rr * 64 + cc * 2; return st * 1024 + (ob ^ (((ob >> 9) & 1) << 5)); }
__host__ __device__ __forceinline__ void stage_rc(int b, int& R, int& C) { const int st = b / 1024, sb = b % 1024, swz = sb ^ (((sb >> 9) & 1) << 5); R = (st >> 1) * 16 + swz / 64; C = (st & 1) * 32 + (swz % 64) / 2; }
__host__ __device__ __forceinline__ int perm32(int rho) { const int n = rho >> 4, i = rho & 15; return 8 * (i >> 2) + 4 * n + (i & 3); }

struct Unit { int pm, pn; };
struct Gemm { const bf16_t* A; const bf16_t* Bt; int M, N, K; };

struct StaticOrder {
    int nM, nN, nwg, G, c;
    __host__ __device__ void init(int M, int N, int G_, int c_) { nM = M / BM; nN = N / BM; nwg = nM * nN; G = G_; c = c_; }
    __host__ __device__ bool next(int i, Unit& u) const {
        const long L = (long)i * G + c; if (L >= nwg) return false;
        int wgid = (int)L; { const int q = nwg / NXCD, r = nwg % NXCD, xcd = wgid % NXCD, off = wgid / NXCD; wgid = (xcd < r ? xcd * (q + 1) : r * (q + 1) + (xcd - r) * q) + off; }
        const int nig = WGM * nN, gid = wgid / nig, fm = gid * WGM, gsz = (nM - fm) < WGM ? (nM - fm) : WGM;
        u.pm = fm + ((wgid % nig) % gsz); u.pn = (wgid % nig) / gsz; return true;
    }
    __device__ __forceinline__ void a_ready(const Unit&) const {}
    __device__ __forceinline__ void done(const Unit&) const {}
};

__device__ __forceinline__ unsigned pk_f16(float lo, float hi) { typedef _Float16 h2 __attribute__((ext_vector_type(2))); h2 v; v.x = (_Float16)lo; v.y = (_Float16)hi; return __builtin_bit_cast(unsigned, v); }
typedef unsigned u32x2 __attribute__((ext_vector_type(2)));
struct EpiF16 {
    static constexpr bool PERM = true, AFTER_DRAIN = false;
    bf16_t* O; int ldc; const float* rss;
    __device__ __forceinline__ void operator()(const f32x4 (&acc)[2][2][4][2], const Unit& u, int wr, int wc, int fr, int fq) const {
        const int row0 = u.pm * BM + wr * 64 + fr; const int col0 = u.pn * BM + wc * 32 + 8 * fq;
#pragma unroll
        for (int ai = 0; ai < 2; ++ai)
#pragma unroll
            for (int m = 0; m < 4; ++m) { const int row = row0 + ai * HALF + m * 16; bf16_t* rowp = O + (size_t)row * ldc + col0;
                const float sc = rss ? 1.0f / sqrtf(rss[row] * (1.0f / 1024.0f) + 1e-6f) : 1.0f;
#pragma unroll
                for (int bj = 0; bj < 2; ++bj) { const f32x4 v0 = acc[ai][bj][m][0] * sc, v1 = acc[ai][bj][m][1] * sc;
                    u32x4 w; w.x = pk_f16(v0[0], v0[1]); w.y = pk_f16(v0[2], v0[3]); w.z = pk_f16(v1[0], v1[1]); w.w = pk_f16(v1[2], v1[3]);
                    *(u32x4*)(rowp + bj * HALF) = w; } }
    }
};
struct EpiRes {
    static constexpr bool PERM = false, AFTER_DRAIN = false;
    const float* base; float* out; int ldc; bf16_t* xh; float* rss;
    __device__ __forceinline__ void operator()(const f32x4 (&acc)[2][2][4][2], const Unit& u, int wr, int wc, int fr, int fq) const {
        const int row0 = u.pm * BM + wr * 64 + fr; const int col0 = u.pn * BM + wc * 32 + 4 * fq;
#pragma unroll
        for (int ai = 0; ai < 2; ++ai)
#pragma unroll
            for (int m = 0; m < 4; ++m) { const size_t off = (size_t)(row0 + ai * HALF + m * 16) * ldc + col0; float ss = 0.f;
#pragma unroll
                for (int bj = 0; bj < 2; ++bj)
#pragma unroll
                    for (int n = 0; n < 2; ++n) { const size_t o = off + bj * HALF + n * 16; const f32x4 b = *(const f32x4*)(base + o); const f32x4 x = b + acc[ai][bj][m][n]; *(f32x4*)(out + o) = x;
                        if (xh) { u32x2 h; h.x = pk_f16(x[0], x[1]); h.y = pk_f16(x[2], x[3]); *(u32x2*)(xh + o) = h; ss += (x[0] * x[0] + x[1] * x[1]) + (x[2] * x[2] + x[3] * x[3]); } }
                if (xh) { ss += shfl_xor_f(ss, 16); ss += shfl_xor_f(ss, 32); if (fq == 0) atomicAdd(rss + row0 + ai * HALF + m * 16, ss); }
                asm volatile("" ::: "memory"); }
    }
};

struct EpiResNorm {
    static constexpr bool PERM = false, AFTER_DRAIN = false;
    const float* base; float* out; int ldc; float* rss2; unsigned* cnt; const float* w;
    __device__ __forceinline__ void operator()(f32x4 (&acc)[2][2][4][2], const Unit& u, int wr, int wc, int fr, int fq) const {
        const int row0 = u.pm * BM + wr * 64 + fr; const int col0 = u.pn * BM + wc * 32 + 4 * fq;
#pragma unroll
        for (int ai = 0; ai < 2; ++ai)
#pragma unroll
            for (int m = 0; m < 4; ++m) { const size_t off = (size_t)(row0 + ai * HALF + m * 16) * ldc + col0; float ss = 0.f;
#pragma unroll
                for (int bj = 0; bj < 2; ++bj)
#pragma unroll
                    for (int n = 0; n < 2; ++n) { const size_t o = off + bj * HALF + n * 16; const f32x4 x = *(const f32x4*)(base + o) + acc[ai][bj][m][n]; acc[ai][bj][m][n] = x;
                        ss += (x[0] * x[0] + x[1] * x[1]) + (x[2] * x[2] + x[3] * x[3]); }
                ss += shfl_xor_f(ss, 16); ss += shfl_xor_f(ss, 32); if (fq == 0) atomicAdd(rss2 + row0 + ai * HALF + m * 16, ss);
                asm volatile("" ::: "memory"); }
        asm volatile("s_waitcnt vmcnt(0)" ::: "memory");
        unsigned* pc = cnt + 64 * u.pm;
        if (lane_now() == 0) __hip_atomic_fetch_add(pc, 1u, __ATOMIC_RELAXED, __HIP_MEMORY_SCOPE_AGENT);
        for (unsigned spin = 0; spin < (1u << 22); ++spin) { if ((unsigned)__builtin_amdgcn_readfirstlane((int)__hip_atomic_load(pc, __ATOMIC_RELAXED, __HIP_MEMORY_SCOPE_AGENT)) >= 32u) break; __builtin_amdgcn_s_sleep(2); }
#pragma unroll
        for (int ai = 0; ai < 2; ++ai)
#pragma unroll
            for (int m = 0; m < 4; ++m) { const int row = row0 + ai * HALF + m * 16; const size_t off = (size_t)row * ldc + col0;
                const float rs = 1.0f / sqrtf(__hip_atomic_load(rss2 + row, __ATOMIC_RELAXED, __HIP_MEMORY_SCOPE_AGENT) * (1.0f / 1024.0f) + 1e-6f);
#pragma unroll
                for (int bj = 0; bj < 2; ++bj)
#pragma unroll
                    for (int n = 0; n < 2; ++n) { const size_t o = off + bj * HALF + n * 16; const f32x4 ww = *(const f32x4*)(w + col0 + bj * HALF + n * 16); *(f32x4*)(out + o) = acc[ai][bj][m][n] * rs * ww; } }
    }
};

template <class Epi, class Sched, bool ALIGN_EPI = false, bool SP2 = false>
__device__ __forceinline__ void gemm_phase(PG8_LAS unsigned char* lds, const Gemm g, const Sched& S, const Epi& E, const int wave_) {
    int wv_ = wave_; asm volatile("" : "+s"(wv_)); int tid_ = lane_now() + 64 * wv_; const int tid = tid_, wid = wv_, lane = tid & 63, wr = wid >> 2, wc = wid & 3, fr = lane & 15, fq = lane >> 4;
    const int K = g.K, nt = K / BK;
    unsigned voffA[2], voffB[2];
#pragma unroll
    for (int i = 0; i < 2; ++i) { int R, C; stage_rc(tid * 16 + i * 8192, R, C); const int Rb = Epi::PERM ? ((R & ~31) + perm32(R & 31)) : R;
        voffA[i] = (unsigned)(R * K + C) * 2u; voffB[i] = (unsigned)(Rb * K + C) * 2u; }
    const size_t kstep = (size_t)(BK * 2);
    const size_t hstep = (size_t)HALF * K * 2;
    const size_t tstep = 2 * hstep;
    const unsigned ldsw = (unsigned)wid * 1024u;
    const int aoff = lds_byte(wr * 64 + fr, fq * 8), boff = lds_byte(wc * 32 + fr, fq * 8);
#define PG8_SA(b, h) (((b) * 2 + (h)) * HTB)
#define PG8_SB(b, h) ((4 + (b) * 2 + (h)) * HTB)
#define PG8_STAGE(bufoff, gbase, voff) do { _Pragma("unroll") for (int _i = 0; _i < 2; ++_i) \
        __builtin_amdgcn_global_load_lds((const unsigned*)((const char*)(gbase) + (voff)[_i]), (PG8_LAS unsigned*)(lds + (bufoff) + ldsw + _i * 8192), 16, 0, 0); } while (0)
#define PG8_LDA(dst, b, h) do { _Pragma("unroll") for (int m = 0; m < 4; ++m) _Pragma("unroll") for (int k = 0; k < 2; ++k) dst[m][k] = *(const PG8_LAS bf16x8*)(lds + PG8_SA(b, h) + aoff + m * 2048 + k * 1024); } while (0)
#define PG8_LDB(dst, b, h) do { _Pragma("unroll") for (int n = 0; n < 2; ++n) _Pragma("unroll") for (int k = 0; k < 2; ++k) dst[n][k] = *(const PG8_LAS bf16x8*)(lds + PG8_SB(b, h) + boff + n * 2048 + k * 1024); } while (0)
#define PG8_MMA(ai, bj, At, Bt) do { __builtin_amdgcn_s_setprio(1); _Pragma("unroll") for (int m = 0; m < 4; ++m) _Pragma("unroll") for (int n = 0; n < 2; ++n) _Pragma("unroll") for (int k = 0; k < 2; ++k) \
        acc[ai][bj][m][n] = MK_MFMA(Bt[n][k], At[m][k], acc[ai][bj][m][n]); __builtin_amdgcn_s_setprio(0); } while (0)
#define PG8_WAIT_V(n) asm volatile("s_waitcnt vmcnt(" #n ")" ::: "memory")
#define PG8_WAIT_L(n) asm volatile("s_waitcnt lgkmcnt(" #n ")" ::: "memory")
#define PG8_BAR __builtin_amdgcn_s_barrier()
#define PG8_SCHED __builtin_amdgcn_sched_barrier(0)
    Unit cur, nxt; int ui = 0;
    if (!S.next(0, cur)) return;
    f32x4 acc[2][2][4][2];
#pragma unroll
    for (int a = 0; a < 2; ++a)
#pragma unroll
        for (int b = 0; b < 2; ++b)
#pragma unroll
            for (int m = 0; m < 4; ++m)
#pragma unroll
                for (int n = 0; n < 2; ++n) acc[a][b][m][n] = (f32x4){0.f, 0.f, 0.f, 0.f};
    bf16x8 At[4][2], B0[2][2], B1[2][2];
    const char* cA = (const char*)g.A + (size_t)cur.pm * tstep; const char* cB = (const char*)g.Bt + (size_t)cur.pn * tstep;
    S.a_ready(cur);
    if constexpr (SP2) {
        PG8_STAGE(PG8_SB(0, 0), cB, voffB); PG8_STAGE(PG8_SB(0, 1), cB + hstep, voffB); PG8_STAGE(PG8_SA(0, 0), cA, voffA); PG8_STAGE(PG8_SA(0, 1), cA + hstep, voffA);
        if (wr == 1) PG8_BAR;
        PG8_WAIT_V(2); PG8_BAR;
        PG8_STAGE(PG8_SB(1, 0), cB + kstep, voffB); PG8_STAGE(PG8_SA(1, 0), cA + kstep, voffA); PG8_STAGE(PG8_SB(1, 1), cB + hstep + kstep, voffB);
        PG8_WAIT_V(6); PG8_BAR;
    } else {
        PG8_STAGE(PG8_SB(0, 0), cB, voffB); PG8_STAGE(PG8_SA(0, 0), cA, voffA); PG8_STAGE(PG8_SB(0, 1), cB + hstep, voffB); PG8_STAGE(PG8_SA(0, 1), cA + hstep, voffA);
        if (wr == 1) PG8_BAR;
        PG8_WAIT_V(4); PG8_BAR;
        PG8_STAGE(PG8_SB(1, 0), cB + kstep, voffB); PG8_STAGE(PG8_SA(1, 0), cA + kstep, voffA); PG8_STAGE(PG8_SB(1, 1), cB + hstep + kstep, voffB);
        PG8_WAIT_V(6); PG8_BAR;
    }
    for (;;) {
        const bool has_next = S.next(ui + 1, nxt);
        const char* nA = has_next ? (const char*)g.A + (size_t)nxt.pm * tstep : cA; const char* nB = has_next ? (const char*)g.Bt + (size_t)nxt.pn * tstep : cB;
        for (int t = 0; t < nt; t += 2) {
            const bool last = (t == nt - 2);
            const char* a1 = cA + (size_t)(t + 1) * kstep;
            const char* a2 = last ? nA : cA + (size_t)(t + 2) * kstep; const char* b2 = last ? nB : cB + (size_t)(t + 2) * kstep;
            const char* a3 = a2 + kstep; const char* b3 = b2 + kstep;
            if (last && has_next) S.a_ready(nxt);
            if constexpr (SP2) {
            PG8_LDB(B0, 0, 0); PG8_LDB(B1, 0, 1); PG8_SCHED; PG8_LDA(At, 0, 0); PG8_STAGE(PG8_SA(1, 1), a1 + hstep, voffA);
            PG8_WAIT_V(8); PG8_WAIT_L(0); PG8_BAR; PG8_MMA(0, 0, At, B0); PG8_MMA(0, 1, At, B1); PG8_BAR; PG8_SCHED;
            PG8_LDA(At, 0, 1); PG8_STAGE(PG8_SB(0, 0), b2, voffB); PG8_STAGE(PG8_SB(0, 1), b2 + hstep, voffB); PG8_STAGE(PG8_SA(0, 0), a2, voffA);
            PG8_WAIT_V(8); PG8_WAIT_L(0); PG8_BAR; PG8_MMA(1, 0, At, B0); PG8_MMA(1, 1, At, B1); PG8_BAR; PG8_SCHED;
            PG8_LDB(B0, 1, 0); PG8_LDB(B1, 1, 1); PG8_SCHED; PG8_LDA(At, 1, 0); PG8_STAGE(PG8_SA(0, 1), a2 + hstep, voffA);
            PG8_WAIT_V(8); PG8_WAIT_L(0); PG8_BAR; PG8_MMA(0, 0, At, B0); PG8_MMA(0, 1, At, B1); PG8_BAR; PG8_SCHED;
            PG8_LDA(At, 1, 1); PG8_STAGE(PG8_SB(1, 0), b3, voffB); PG8_STAGE(PG8_SB(1, 1), b3 + hstep, voffB); PG8_STAGE(PG8_SA(1, 0), a3, voffA);
            PG8_WAIT_V(8); PG8_WAIT_L(0); PG8_BAR; PG8_MMA(1, 0, At, B0); PG8_MMA(1, 1, At, B1); PG8_BAR; PG8_SCHED;
            } else {
            PG8_LDB(B0, 0, 0); PG8_SCHED; PG8_LDA(At, 0, 0); PG8_STAGE(PG8_SA(1, 1), a1 + hstep, voffA);
            PG8_WAIT_L(8); PG8_BAR; PG8_WAIT_L(0); PG8_MMA(0, 0, At, B0); PG8_BAR; PG8_SCHED;
            PG8_LDB(B1, 0, 1); PG8_STAGE(PG8_SB(0, 0), b2, voffB);
            PG8_BAR; PG8_WAIT_L(0); PG8_MMA(0, 1, At, B1); PG8_BAR;
            PG8_LDA(At, 0, 1); PG8_STAGE(PG8_SA(0, 0), a2, voffA);
            PG8_BAR; PG8_WAIT_L(0); PG8_MMA(1, 0, At, B0); PG8_BAR; PG8_SCHED;
            PG8_STAGE(PG8_SB(0, 1), b2 + hstep, voffB);
            PG8_WAIT_V(6); PG8_BAR; PG8_MMA(1, 1, At, B1); PG8_BAR;
            PG8_LDB(B0, 1, 0); PG8_SCHED; PG8_LDA(At, 1, 0); PG8_STAGE(PG8_SA(0, 1), a2 + hstep, voffA);
            PG8_WAIT_L(8); PG8_BAR; PG8_WAIT_L(0); PG8_MMA(0, 0, At, B0); PG8_BAR; PG8_SCHED;
            PG8_LDB(B1, 1, 1); PG8_STAGE(PG8_SB(1, 0), b3, voffB);
            PG8_BAR; PG8_WAIT_L(0); PG8_MMA(0, 1, At, B1); PG8_BAR;
            PG8_LDA(At, 1, 1); PG8_STAGE(PG8_SA(1, 0), a3, voffA);
            PG8_BAR; PG8_WAIT_L(0); PG8_MMA(1, 0, At, B0); PG8_BAR; PG8_SCHED;
            PG8_STAGE(PG8_SB(1, 1), b3 + hstep, voffB);
            PG8_WAIT_V(6); PG8_BAR; PG8_MMA(1, 1, At, B1); PG8_BAR;
            }
        }
        if constexpr (ALIGN_EPI) { if (wr == 0) PG8_BAR; }
        if constexpr (!Epi::AFTER_DRAIN) { E(acc, cur, wr, wc, fr, fq); S.done(cur); }
        if (!has_next) break;
#pragma unroll
        for (int a = 0; a < 2; ++a)
#pragma unroll
            for (int b = 0; b < 2; ++b)
#pragma unroll
                for (int m = 0; m < 4; ++m)
#pragma unroll
                    for (int n = 0; n < 2; ++n) acc[a][b][m][n] = (f32x4){0.f, 0.f, 0.f, 0.f};
        cur = nxt; cA = nA; cB = nB; ++ui;
        if constexpr (ALIGN_EPI) { if (wr == 1) PG8_BAR; }
    }
    PG8_WAIT_V(0);
    if constexpr (!ALIGN_EPI) { if (wr == 0) PG8_BAR; }
    PG8_BAR;
    if constexpr (Epi::AFTER_DRAIN) { E.fused(acc, cur, wr, wc, fr, fq, lds, wid, lane); S.done(cur); }
#undef PG8_SA
#undef PG8_SB
#undef PG8_STAGE
#undef PG8_LDA
#undef PG8_LDB
#undef PG8_MMA
#undef PG8_WAIT_V
#undef PG8_WAIT_L
#undef PG8_BAR
#undef PG8_SCHED
}
}

constexpr int BATCH = 2, SEQ = 8192, DM = 1024, DEPTH = 2, M = BATCH * SEQ;
constexpr int RW_H = 6, HD = 64, RW_W = 384, RW_SHIFT = 1280;
constexpr int NIN = 3712, NU = 3840;
constexpr int C_R = 0, C_K = 384, C_V = 768, C_WL = 1152, C_AL = 1216, C_RWZ = 1280, C_HGQ = 1664, C_HGF = 2048, C_HGI = 2432, C_HGZ = 2816, C_LRUX = 3200, C_LRUZ = 3456;
constexpr int CH = 64;
constexpr int NWAVES = 8, NT = NWAVES * 64;
constexpr int LDS_BYTES = 163840;
constexpr int PRM_OFF = 142336;
constexpr size_t MiB = 1u << 20;
constexpr size_t WS_WUPT = 65536, WS_AUPT = WS_WUPT + 98304, WS_VDNT = WS_AUPT + 98304, WS_VUPT = WS_VDNT + 24576, WS_WAT = WS_VUPT + 24576, WS_WXT = WS_WAT + 65536;
constexpr size_t WS_WIN = 1 * MiB, WIN_L = (size_t)NU * DM * 2;
constexpr size_t WS_WOUT = 16 * MiB, WOUT_L = (size_t)DM * DM * 2;
constexpr size_t WS_XN = 20 * MiB;
constexpr size_t WS_QT = 20 * MiB;
constexpr size_t WS_PT = 32 * MiB;
constexpr size_t WS_CA = 44 * MiB;
constexpr size_t WS_U = 52 * MiB;
constexpr size_t WS_MIX = 172 * MiB;
constexpr size_t WS_VF = 204 * MiB;
constexpr size_t WS_VP = 216 * MiB;
constexpr size_t WS_RL = 228 * MiB;
constexpr size_t WS_HL = 240 * MiB;
constexpr size_t WS_BON = 252 * MiB;
constexpr size_t WS_DC = WS_BON + 512 * 1024;
constexpr size_t WS_LA = WS_DC + 512 * 1024;
constexpr size_t WS_LH = WS_LA + 256 * 1024;
constexpr size_t WS_RSS = WS_LH + 256 * 1024;
constexpr size_t WS_END = 254 * MiB;
constexpr int NCH = SEQ / CH;

#define LAS __attribute__((address_space(3)))
typedef float f32x4 __attribute__((ext_vector_type(4)));
typedef unsigned u32x2 __attribute__((ext_vector_type(2)));
typedef unsigned u32x4 __attribute__((ext_vector_type(4)));
typedef _Float16 f16;
typedef _Float16 f16x8 __attribute__((ext_vector_type(8)));
#define LDS_WAIT() asm volatile("s_waitcnt lgkmcnt(0)" ::: "memory")

struct Args { const float* in[27]; float* out; unsigned char* ws; };

__device__ __forceinline__ float wave_sum(float v) {
#pragma unroll
    for (int o = 1; o < 64; o <<= 1) v += shfl_xor_f(v, o);
    return v;
}
__device__ __forceinline__ float sigmoidf_(float x) { return __builtin_amdgcn_rcpf(1.0f + __expf(-x)); }
__device__ __forceinline__ float rsq_(float x) { return __builtin_amdgcn_rsqf(x); }
__device__ __forceinline__ float one_minus_exp_(float x) { return (x > -0.03f) ? -x * (1.0f + x * (0.5f + x * (1.0f / 6.0f + x * (1.0f / 24.0f)))) : 1.0f - __expf(x); }
__device__ __forceinline__ float siluf_(float x) { return x * __builtin_amdgcn_rcpf(1.0f + __expf(-x)); }

__device__ __forceinline__ void p0_transpose_item(const float* W, int K, int N, unsigned short* WT, LAS float* scr, int item, int lane, const float* rsc) {
    const int nblk = N / 32, kb = item / nblk, nb = item % nblk, k0 = 64 * kb, n0 = 32 * nb;
    float tv[32];
#pragma unroll
    for (int i = 0; i < 32; ++i) { const int kk = 2 * i + (lane >> 5); tv[i] = W[(size_t)(k0 + kk) * N + n0 + (lane & 31)]; }
#pragma unroll
    for (int i = 0; i < 32; ++i) { const int kk = 2 * i + (lane >> 5); scr[kk * 33 + (lane & 31)] = tv[i] * (rsc ? rsc[k0 + kk] : 1.0f); }
    LDS_WAIT(); asm volatile("" ::: "memory");
    const int c = lane & 7;
#pragma unroll
    for (int j = 0; j < 4; ++j) { const int n = (lane >> 3) + 8 * j; const LAS float* s = scr + (8 * c) * 33 + n;
        u32x4 o; o.x = pg8::pk_f16(s[0 * 33], s[1 * 33]); o.y = pg8::pk_f16(s[2 * 33], s[3 * 33]); o.z = pg8::pk_f16(s[4 * 33], s[5 * 33]); o.w = pg8::pk_f16(s[6 * 33], s[7 * 33]);
        *(u32x4*)(WT + (size_t)(n0 + n) * K + k0 + 8 * c) = o; }
    LDS_WAIT(); asm volatile("" ::: "memory");
}
__device__ __forceinline__ void rms_row_f16(const float* xrow, const float* w, unsigned short* orow, int lane) {
    const f32x4* xr = (const f32x4*)xrow + lane; const f32x4* wr = (const f32x4*)w + lane;
    f32x4 v[4]; float s = 0.f;
#pragma unroll
    for (int j = 0; j < 4; ++j) { v[j] = xr[64 * j]; s += (v[j].x * v[j].x + v[j].y * v[j].y) + (v[j].z * v[j].z + v[j].w * v[j].w); }
    const float rs = 1.0f / sqrtf(wave_sum(s) * (1.0f / DM) + 1e-6f);
    u32x2* o8 = (u32x2*)orow + lane;
#pragma unroll
    for (int j = 0; j < 4; ++j) { const f32x4 ww = wr[64 * j]; u32x2 o; o.x = pg8::pk_f16(v[j].x * rs * ww.x, v[j].y * rs * ww.y); o.y = pg8::pk_f16(v[j].z * rs * ww.z, v[j].w * rs * ww.w); o8[64 * j] = o; }
}
__device__ __forceinline__ void rms_row_f32(float* xrow, const float* w, int lane) {
    f32x4* xr = (f32x4*)xrow + lane; const f32x4* wr = (const f32x4*)w + lane;
    f32x4 v[4]; float s = 0.f;
#pragma unroll
    for (int j = 0; j < 4; ++j) { v[j] = xr[64 * j]; s += (v[j].x * v[j].x + v[j].y * v[j].y) + (v[j].z * v[j].z + v[j].w * v[j].w); }
    const float rs = 1.0f / sqrtf(wave_sum(s) * (1.0f / DM) + 1e-6f);
#pragma unroll
    for (int j = 0; j < 4; ++j) { const f32x4 ww = wr[64 * j]; xr[64 * j] = v[j] * rs * ww; }
}

__device__ __forceinline__ void rms_row2_f32(float* xa, float* xb, const float* w, int lane) {
    f32x4* ra = (f32x4*)xa + lane; f32x4* rb = (f32x4*)xb + lane; const f32x4* wr = (const f32x4*)w + lane;
    f32x4 va[4], vb[4]; float sa = 0.f, sb = 0.f;
#pragma unroll
    for (int j = 0; j < 4; ++j) { va[j] = ra[64 * j]; vb[j] = rb[64 * j]; }
#pragma unroll
    for (int j = 0; j < 4; ++j) { sa += (va[j].x * va[j].x + va[j].y * va[j].y) + (va[j].z * va[j].z + va[j].w * va[j].w); sb += (vb[j].x * vb[j].x + vb[j].y * vb[j].y) + (vb[j].z * vb[j].z + vb[j].w * vb[j].w); }
    const float rsa = 1.0f / sqrtf(wave_sum(sa) * (1.0f / DM) + 1e-6f), rsb = 1.0f / sqrtf(wave_sum(sb) * (1.0f / DM) + 1e-6f);
#pragma unroll
    for (int j = 0; j < 4; ++j) { const f32x4 ww = wr[64 * j]; ra[64 * j] = va[j] * rsa * ww; rb[64 * j] = vb[j] * rsb * ww; }
}
__device__ __forceinline__ void rms_row4_f16(const float* x0, size_t rs, const float* w, unsigned short* o0, int lane) {
    f32x4 v[4][4]; float s[4];
#pragma unroll
    for (int r = 0; r < 4; ++r)
#pragma unroll
        for (int j = 0; j < 4; ++j) v[r][j] = ((const f32x4*)(x0 + r * rs) + lane)[64 * j];
    const f32x4* wr = (const f32x4*)w + lane;
#pragma unroll
    for (int r = 0; r < 4; ++r) { float a = 0.f;
#pragma unroll
        for (int j = 0; j < 4; ++j) a += (v[r][j].x * v[r][j].x + v[r][j].y * v[r][j].y) + (v[r][j].z * v[r][j].z + v[r][j].w * v[r][j].w);
        s[r] = 1.0f / sqrtf(wave_sum(a) * (1.0f / DM) + 1e-6f); }
#pragma unroll
    for (int j = 0; j < 4; ++j) { const f32x4 ww = wr[64 * j];
#pragma unroll
        for (int r = 0; r < 4; ++r) { u32x2 o; o.x = pg8::pk_f16(v[r][j].x * s[r] * ww.x, v[r][j].y * s[r] * ww.y); o.y = pg8::pk_f16(v[r][j].z * s[r] * ww.z, v[r][j].w * s[r] * ww.w); ((u32x2*)(o0 + r * rs) + lane)[64 * j] = o; } }
}
__device__ __forceinline__ void rms_row4_f32(float* x0, size_t rs, const float* w, int lane) {
    f32x4 v[4][4]; float s[4];
#pragma unroll
    for (int r = 0; r < 4; ++r)
#pragma unroll
        for (int j = 0; j < 4; ++j) v[r][j] = ((const f32x4*)(x0 + r * rs) + lane)[64 * j];
    const f32x4* wr = (const f32x4*)w + lane;
#pragma unroll
    for (int r = 0; r < 4; ++r) { float a = 0.f;
#pragma unroll
        for (int j = 0; j < 4; ++j) a += (v[r][j].x * v[r][j].x + v[r][j].y * v[r][j].y) + (v[r][j].z * v[r][j].z + v[r][j].w * v[r][j].w);
        s[r] = rsq_(wave_sum(a) * (1.0f / DM) + 1e-6f); }
#pragma unroll
    for (int j = 0; j < 4; ++j) { const f32x4 ww = wr[64 * j];
#pragma unroll
        for (int r = 0; r < 4; ++r) ((f32x4*)(x0 + r * rs) + lane)[64 * j] = v[r][j] * s[r] * ww; }
}

#define SHV(col) ({ const float cur_ = (float)urow[(col)]; const float prev_ = hp ? (float)prow[(col)] : 0.f; cur_ + mu[(col)] * (prev_ - cur_); })

__device__ __forceinline__ void store_row64_f16(f16* dst, const float (&S)[64]) {
#pragma unroll
    for (int q = 0; q < 8; ++q) { u32x4 w; w.x = pg8::pk_f16(S[8 * q], S[8 * q + 1]); w.y = pg8::pk_f16(S[8 * q + 2], S[8 * q + 3]); w.z = pg8::pk_f16(S[8 * q + 4], S[8 * q + 5]); w.w = pg8::pk_f16(S[8 * q + 6], S[8 * q + 7]); *(u32x4*)(dst + 8 * q) = w; }
}


constexpr int RWT_ROW = 144, RWT_A = 0, RWT_R = 2304, RWT_B = 4608, RWT_K = 6912;
constexpr int RWC_B = 9216, RWC_K = 11264, RWC_V = 13312;
constexpr int RWF_G16 = 15360, RWF_RHO = 15616, RWA_INV = 15872, RWA_BYTES = 18944;
constexpr int C_VD0 = 3712, C_VD1 = 3744;
constexpr int PRM_MU = 0, PRM_A0 = 1280, PRM_KK = 1664, PRM_KA = 2048, PRM_RK = 2432, PRM_V0 = 2816, PRM_HALVES = 3200, PRM_W0_BYTE = 6400, PRM_BYTES = PRM_W0_BYTE + 1536;
typedef float f32x2 __attribute__((ext_vector_type(2)));
typedef _Float16 f16x4 __attribute__((ext_vector_type(4)));
__device__ __forceinline__ float fmix_lo(float a, unsigned b, float c) { float d; asm("v_fma_mix_f32 %0, %1, %2, %3 op_sel:[0,0,0] op_sel_hi:[0,1,0]" : "=v"(d) : "v"(a), "v"(b), "v"(c)); return d; }
__device__ __forceinline__ float fmix_hi(float a, unsigned b, float c) { float d; asm("v_fma_mix_f32 %0, %1, %2, %3 op_sel:[0,1,0] op_sel_hi:[0,1,0]" : "=v"(d) : "v"(a), "v"(b), "v"(c)); return d; }
__device__ __forceinline__ float mmix_lo(float a, unsigned b) { float d; asm("v_fma_mix_f32 %0, %1, %2, 0 op_sel:[0,0,0] op_sel_hi:[0,1,0]" : "=v"(d) : "v"(a), "v"(b)); return d; }
__device__ __forceinline__ float mmix_hi(float a, unsigned b) { float d; asm("v_fma_mix_f32 %0, %1, %2, 0 op_sel:[0,1,0] op_sel_hi:[0,1,0]" : "=v"(d) : "v"(a), "v"(b)); return d; }
__device__ __forceinline__ float mul_asm(float a, float b) { float d; asm("v_mul_f32 %0, %1, %2" : "=v"(d) : "v"(a), "v"(b)); return d; }
__device__ __forceinline__ float fma_asm(float a, float b, float c) { float d; asm("v_fma_f32 %0, %1, %2, %3" : "=v"(d) : "v"(a), "v"(b), "v"(c)); return d; }
#define FMIX(a, u, j, c) (((j) & 1) ? fmix_hi((a), (u)[(j) >> 1], (c)) : fmix_lo((a), (u)[(j) >> 1], (c)))
#define MMIX(a, u, j) (((j) & 1) ? mmix_hi((a), (u)[(j) >> 1]) : mmix_lo((a), (u)[(j) >> 1]))
__device__ __forceinline__ float fast_tanh(float x) { return 1.0f - 2.0f * __builtin_amdgcn_rcpf(__expf(2.0f * x) + 1.0f); }
__device__ __forceinline__ void lerp8(const char* ub, unsigned uo, unsigned po, bool hp, const char* mub, unsigned col, float (&x)[8]) {
    const f16x8 cu = *(const f16x8*)(ub + (uo + col * 2u)); f16x8 pv = *(const f16x8*)(ub + (po + col * 2u)); const f32x4 m0 = *(const f32x4*)(mub + col * 4u), m1 = *(const f32x4*)(mub + col * 4u + 16u);
#pragma unroll
    for (int j = 0; j < 8; ++j) { const float c = (float)cu[j], p = hp ? (float)pv[j] : 0.f; x[j] = c + (j < 4 ? m0[j] : m1[j - 4]) * (p - c); }
}
__device__ __forceinline__ void lerp4(const char* ub, unsigned uo, unsigned po, bool hp, const char* mub, unsigned col, float (&x)[4]) {
    const f16x4 cu = *(const f16x4*)(ub + (uo + col * 2u)); f16x4 pv = *(const f16x4*)(ub + (po + col * 2u)); const f32x4 m0 = *(const f32x4*)(mub + col * 4u);
#pragma unroll
    for (int j = 0; j < 4; ++j) { const float c = (float)cu[j], p = hp ? (float)pv[j] : 0.f; x[j] = c + m0[j] * (p - c); }
}
__device__ __forceinline__ f16x8 pack8(const float (&x)[8]) { f16x8 r;
#pragma unroll
    for (int j = 0; j < 8; ++j) r[j] = (f16)x[j];
    return r; }

template <int CTRL> __device__ __forceinline__ float dpp_f(float x) { return __builtin_bit_cast(float, __builtin_amdgcn_update_dpp(0, __builtin_bit_cast(int, x), CTRL, 0xF, 0xF, true)); }
__device__ __forceinline__ float row_prefix16(float x) { x += dpp_f<0x111>(x); x += dpp_f<0x112>(x); x += dpp_f<0x114>(x); x += dpp_f<0x118>(x); return x; }
__device__ __forceinline__ float bperm_f(int byteaddr, float x) { return __builtin_bit_cast(float, __builtin_amdgcn_ds_bpermute(byteaddr, __builtin_bit_cast(int, x))); }
__device__ __forceinline__ f16x4 cvt4(const f32x4 v) { f16x4 r; r[0] = (f16)v[0]; r[1] = (f16)v[1]; r[2] = (f16)v[2]; r[3] = (f16)v[3]; return r; }
#define MF16(A, B, C) __builtin_amdgcn_mfma_f32_16x16x16f16((A), (B), (C), 0, 0, 0)
#define MF32(A, B, C) __builtin_amdgcn_mfma_f32_16x16x32_f16((A), (B), (C), 0, 0, 0)

__device__ __forceinline__ void rwkv_waveA(const Args& a, int l, int b, int c, int h, LAS unsigned char* wl, const LAS unsigned char* prmb, int lane) {
    const LAS f16* prm = (const LAS f16*)prmb; const LAS float* prw0 = (const LAS float*)(prmb + PRM_W0_BYTE);
    const char* Ub = (const char*)(a.ws + WS_U); f16* MIX = (f16*)(a.ws + WS_MIX); char* VF = (char*)(a.ws + WS_VF); char* VP = (char*)(a.ws + WS_VP);
    f16* QT = (f16*)(a.ws + WS_QT); f16* PT = (f16*)(a.ws + WS_PT); f16* RL = (f16*)(a.ws + WS_RL); float* BONG = (float*)(a.ws + WS_BON);
    const char* WUPT = (const char*)(a.ws + WS_WUPT) + (size_t)l * 384 * 64 * 2; const char* AUPT = (const char*)(a.ws + WS_AUPT) + (size_t)l * 384 * 64 * 2;
    const char* VUPT = (const char*)(a.ws + WS_VUPT);
    const int bh = b * RW_H + h;
    f32x4 XT[4][8];
#pragma unroll
    for (int ct = 0; ct < 4; ++ct)
#pragma unroll
        for (int vt = 0; vt < 8; ++vt)
#pragma unroll
            for (int r = 0; r < 4; ++r) XT[ct][vt][r] = (vt == ct && (lane & 15) == 4 * (lane >> 4) + r) ? 1.f : 0.f;
#pragma unroll 1
    for (int blk = 0; blk < 4; ++blk) {
        const int lane_ = lane_now();
        const int tok = lane_ & 15, fq = lane_ >> 4;
        const int t = c * CH + blk * 16 + tok; const unsigned m = (unsigned)(b * SEQ + t); const bool hp = t > 0;
        const unsigned uo = m * (unsigned)(NU * 2), po = hp ? uo - (unsigned)(NU * 2) : uo;
        f16x8 cW[2], pW[2], cA[2], pA[2], vd0, vd1;
#pragma unroll
        for (int s = 0; s < 2; ++s) { const unsigned cw = (unsigned)(C_WL + 8 * fq + 32 * s) * 2u, ca = (unsigned)(C_AL + 8 * fq + 32 * s) * 2u;
            cW[s] = *(const f16x8*)(Ub + uo + cw); pW[s] = *(const f16x8*)(Ub + po + cw); cA[s] = *(const f16x8*)(Ub + uo + ca); pA[s] = *(const f16x8*)(Ub + po + ca); }
        vd0 = *(const f16x8*)(Ub + uo + (unsigned)(C_VD0 + 8 * fq) * 2u); vd1 = *(const f16x8*)(Ub + po + (unsigned)(C_VD1 + 8 * fq) * 2u);
#define RW_TLOAD(X, nt) f16x8 X##wu0, X##wu1, X##au0, X##au1, X##vu; f16x4 X##cr, X##pr, X##ck, X##pk, X##cv, X##pv, X##vf; { \
            const unsigned n_ = (unsigned)(h * 64 + 16 * (nt) + tok), cb_ = (unsigned)(h * 64 + 16 * (nt) + 4 * fq); \
            X##wu0 = *(const f16x8*)(WUPT + (n_ * 64u + 8u * fq) * 2u); X##wu1 = *(const f16x8*)(WUPT + (n_ * 64u + 8u * fq + 32u) * 2u); \
            X##au0 = *(const f16x8*)(AUPT + (n_ * 64u + 8u * fq) * 2u); X##au1 = *(const f16x8*)(AUPT + (n_ * 64u + 8u * fq + 32u) * 2u); \
            if (l > 0) { X##vu = *(const f16x8*)(VUPT + (n_ * 32u + 8u * fq) * 2u); X##vf = *(const f16x4*)(VF + (m * (unsigned)RW_W + cb_) * 2u); } \
            X##cr = *(const f16x4*)(Ub + uo + ((unsigned)C_R + cb_) * 2u); X##pr = *(const f16x4*)(Ub + po + ((unsigned)C_R + cb_) * 2u); \
            X##ck = *(const f16x4*)(Ub + uo + ((unsigned)C_K + cb_) * 2u); X##pk = *(const f16x4*)(Ub + po + ((unsigned)C_K + cb_) * 2u); \
            X##cv = *(const f16x4*)(Ub + uo + ((unsigned)C_V + cb_) * 2u); X##pv = *(const f16x4*)(Ub + po + ((unsigned)C_V + cb_) * 2u); }
        f16x8 bW[2], bA[2], bVD;
#pragma unroll
        for (int s = 0; s < 2; ++s) { float xw[8], xa[8];
            const f16x8 mw = *(const LAS f16x8*)(prm + PRM_MU + C_WL + 8 * fq + 32 * s), ma = *(const LAS f16x8*)(prm + PRM_MU + C_AL + 8 * fq + 32 * s);
#pragma unroll
            for (int j = 0; j < 8; ++j) { const float cw_ = (float)cW[s][j], pw_ = hp ? (float)pW[s][j] : 0.f, ca_ = (float)cA[s][j], pa_ = hp ? (float)pA[s][j] : 0.f;
                xw[j] = fast_tanh(cw_ + (float)mw[j] * (pw_ - cw_)); xa[j] = ca_ + (float)ma[j] * (pa_ - ca_); }
            bW[s] = pack8(xw); bA[s] = pack8(xa); }
        { float xv[8];
#pragma unroll
            for (int j = 0; j < 8; ++j) xv[j] = (float)vd0[j] + (hp ? (float)vd1[j] : 0.f);
            bVD = pack8(xv); }
        float ssq = 0.f, bon = 0.f;
        const int bp7 = ((lane_ & 48) | 7) << 2, bp15 = ((lane_ & 48) | 15) << 2;
#define RW_TCOMP(X, nt) { const int cb = h * 64 + 16 * (nt) + 4 * fq, co = 16 * (nt) + 4 * fq; \
            f32x4 DWn = (f32x4){0.f, 0.f, 0.f, 0.f}, DAn = DWn, Gn = DWn; \
            DWn = __builtin_amdgcn_mfma_f32_16x16x32_f16(X##wu0, bW[0], DWn, 0, 0, 0); DWn = __builtin_amdgcn_mfma_f32_16x16x32_f16(X##wu1, bW[1], DWn, 0, 0, 0); \
            DAn = __builtin_amdgcn_mfma_f32_16x16x32_f16(X##au0, bA[0], DAn, 0, 0, 0); DAn = __builtin_amdgcn_mfma_f32_16x16x32_f16(X##au1, bA[1], DAn, 0, 0, 0); \
            if (l > 0) Gn = __builtin_amdgcn_mfma_f32_16x16x32_f16(X##vu, bVD, Gn, 0, 0, 0); \
            f16x4 ah, rh, bh, kh, bb, kb, vo; f32x4 rho4, g164; \
            _Pragma("unroll") for (int i = 0; i < 4; ++i) { const LAS f16* pc = prm + cb + i; \
                const float cr_ = (float)X##cr[i], ck_ = (float)X##ck[i], cv_ = (float)X##cv[i]; \
                const float rs = cr_ + (float)pc[PRM_MU + C_R] * ((hp ? (float)X##pr[i] : 0.f) - cr_), ks = ck_ + (float)pc[PRM_MU + C_K] * ((hp ? (float)X##pk[i] : 0.f) - ck_), vs = cv_ + (float)pc[PRM_MU + C_V] * ((hp ? (float)X##pv[i] : 0.f) - cv_); \
                const float g2 = -0.875036877f * sigmoidf_(prw0[cb + i] + DWn[i]);                   \
                const float Gi = row_prefix16(g2), G8 = bperm_f(bp7, Gi), G16 = bperm_f(bp15, Gi); \
                const float e1 = __builtin_amdgcn_exp2f(Gi - G8), e1m = __builtin_amdgcn_exp2f((Gi - g2) - G8), einv = __builtin_amdgcn_exp2f(G8 - Gi), esuf = __builtin_amdgcn_exp2f(G16 - Gi); \
                rho4[i] = __builtin_amdgcn_exp2f(G8); g164[i] = __builtin_amdgcn_exp2f(G16); \
                const float aa = sigmoidf_((float)pc[PRM_A0] + DAn[i]); \
                float vv = vs; if (l > 0) vv = vs + ((float)X##vf[i] - vs) * sigmoidf_((float)pc[PRM_V0] + Gn[i]); \
                const float kk = ks * (float)pc[PRM_KK]; ssq += kk * kk; \
                const float kmod = ks * (1.0f + (aa - 1.0f) * (float)pc[PRM_KA]); \
                bon += rs * kmod * (float)pc[PRM_RK]; \
                const float bq = kk * aa; \
                ah[i] = (f16)(-kk * e1m); rh[i] = (f16)(rs * e1); bh[i] = (f16)(bq * einv); kh[i] = (f16)(kmod * einv); bb[i] = (f16)(bq * esuf); kb[i] = (f16)(kmod * esuf); vo[i] = (f16)vv; \
                asm volatile("" ::: "memory"); } \
            *(LAS f16x4*)(wl + RWT_A + tok * RWT_ROW + co * 2) = ah; *(LAS f16x4*)(wl + RWT_R + tok * RWT_ROW + co * 2) = rh; \
            *(LAS f16x4*)(wl + RWT_B + tok * RWT_ROW + co * 2) = bh; *(LAS f16x4*)(wl + RWT_K + tok * RWT_ROW + co * 2) = kh; \
            _Pragma("unroll") for (int i = 0; i < 4; ++i) { *(LAS f16*)(wl + RWC_B + (co + i) * 32 + tok * 2) = bb[i]; *(LAS f16*)(wl + RWC_K + (co + i) * 32 + tok * 2) = kb[i]; *(LAS f16*)(wl + RWC_V + (co + i) * 32 + tok * 2) = vo[i]; } \
            if (tok == 0) { *(LAS f32x4*)(wl + RWF_RHO + co * 4) = rho4; *(LAS f32x4*)(wl + RWF_G16 + co * 4) = g164; } \
            *(f16x4*)(VP + (m * (unsigned)RW_W + (unsigned)cb) * 2u) = vo; \
            if (l == 0) *(f16x4*)(VF + (m * (unsigned)RW_W + (unsigned)cb) * 2u) = vo; }
#pragma unroll 1
        for (int nt = 0; nt < 4; ++nt) { RW_TLOAD(T0, nt) RW_TCOMP(T0, nt) asm volatile("" ::: "memory"); }
#undef RW_TLOAD
#undef RW_TCOMP
        ssq += shfl_xor_f(ssq, 16); ssq += shfl_xor_f(ssq, 32);
        bon += shfl_xor_f(bon, 16); bon += shfl_xor_f(bon, 32);
        { const float inv2v = __builtin_amdgcn_rcpf(fmaxf(ssq, 1e-24f));
          if (fq == 0) { *(LAS float*)(wl + RWA_INV + tok * 4) = inv2v; *(float*)((char*)BONG + (m * 8u + (unsigned)h) * 4u) = bon; } }
        const unsigned mb = (unsigned)(b * SEQ + c * CH + blk * 16);
        const int q4 = fq * 4;
        f16x4 N1, N1T, MkH, NbH, NkH;
        { f16x8 fa[2], fr[2], fb[2], fk[2];
#pragma unroll
          for (int s = 0; s < 2; ++s) { const int o = tok * RWT_ROW + (32 * s + q4) * 2;
#define RW_FRAG(F, T) { const f16x4 lo_ = *(const LAS f16x4*)(wl + (T) + o), hi_ = *(const LAS f16x4*)(wl + (T) + o + 32); F[s] = (f16x8){lo_[0], lo_[1], lo_[2], lo_[3], hi_[0], hi_[1], hi_[2], hi_[3]}; }
              RW_FRAG(fa, RWT_A) RW_FRAG(fr, RWT_R) RW_FRAG(fb, RWT_B) RW_FRAG(fk, RWT_K)
#undef RW_FRAG
          }
          const f32x4 z4 = (f32x4){0.f, 0.f, 0.f, 0.f};
          f32x4 Mb = MF32(fb[1], fa[1], MF32(fb[0], fa[0], z4)), MbT = MF32(fa[1], fb[1], MF32(fa[0], fb[0], z4));
          f32x4 Mk = MF32(fk[1], fa[1], MF32(fk[0], fa[0], z4)), Nb = MF32(fb[1], fr[1], MF32(fb[0], fr[0], z4)), Nk = MF32(fk[1], fr[1], MF32(fk[0], fr[0], z4));
          const f32x4 ivr = *(const LAS f32x4*)(wl + RWA_INV + q4 * 4); const float ivc = *(const LAS float*)(wl + RWA_INV + tok * 4);
#pragma unroll
          for (int r = 0; r < 4; ++r) { const int j = q4 + r;
              Mb[r] = (j < tok) ? Mb[r] * ivr[r] : 0.f; MbT[r] = (tok < j) ? MbT[r] * ivc : 0.f; Mk[r] = (j < tok) ? Mk[r] : 0.f; Nb[r] = (j <= tok) ? Nb[r] : 0.f; Nk[r] = (j <= tok) ? Nk[r] : 0.f; }
          N1 = cvt4(Mb); N1T = cvt4(MbT); MkH = cvt4(Mk); NbH = cvt4(Nb); NkH = cvt4(Nk); }
        const f16x4 N2 = cvt4(MF16(N1T, N1, ((f32x4){0.f, 0.f, 0.f, 0.f}))), N2T = cvt4(MF16(N1, N1T, ((f32x4){0.f, 0.f, 0.f, 0.f})));
        const f16x4 N4 = cvt4(MF16(N2T, N2, ((f32x4){0.f, 0.f, 0.f, 0.f}))), N4T = cvt4(MF16(N2, N2T, ((f32x4){0.f, 0.f, 0.f, 0.f})));
        const f16x4 N8 = cvt4(MF16(N4T, N4, ((f32x4){0.f, 0.f, 0.f, 0.f})));
#pragma unroll
        for (int hq = 0; hq < 4; ++hq) {
            constexpr int NTQ = 2; const int hv = hq >> 1;
            asm volatile("" ::: "memory");
            const f32x4 ivr2 = *(const LAS f32x4*)(wl + RWA_INV + q4 * 4);
            f32x4 G[NTQ], Y[NTQ]; f16x4 vf[NTQ];
            { f16x8 fa[2], fr[2];
#pragma unroll
              for (int s = 0; s < 2; ++s) { const int o = tok * RWT_ROW + (32 * s + q4) * 2;
#define RW_FRAG(F, T) { const f16x4 lo_ = *(const LAS f16x4*)(wl + (T) + o), hi_ = *(const LAS f16x4*)(wl + (T) + o + 32); F[s] = (f16x8){lo_[0], lo_[1], lo_[2], lo_[3], hi_[0], hi_[1], hi_[2], hi_[3]}; }
                  RW_FRAG(fa, RWT_A) RW_FRAG(fr, RWT_R)
#undef RW_FRAG
              }
#pragma unroll
              for (int t = 0; t < NTQ; ++t) { const int vt = 2 * hq + t; f16x8 xb[2];
#pragma unroll
                for (int s = 0; s < 2; ++s) { const f32x4 r0 = *(const LAS f32x4*)(wl + RWF_RHO + (32 * s + q4) * 4), r1 = *(const LAS f32x4*)(wl + RWF_RHO + (32 * s + 16 + q4) * 4);
                    const f32x4 x0 = XT[2 * s][vt] * r0, x1 = XT[2 * s + 1][vt] * r1;
                    xb[s] = (f16x8){(f16)x0[0], (f16)x0[1], (f16)x0[2], (f16)x0[3], (f16)x1[0], (f16)x1[1], (f16)x1[2], (f16)x1[3]}; }
                G[t] = MF32(fa[1], xb[1], MF32(fa[0], xb[0], ((f32x4){0.f, 0.f, 0.f, 0.f})));
                Y[t] = MF32(fr[1], xb[1], MF32(fr[0], xb[0], ((f32x4){0.f, 0.f, 0.f, 0.f})));
                if (hv) { vf[t] = *(const LAS f16x4*)(wl + RWC_V + (16 * (vt - 4) + tok) * 32 + q4 * 2); G[t] = MF16(MkH, vf[t], G[t]); } } }
#pragma unroll
            for (int t = 0; t < NTQ; ++t) G[t] = MF16(N1, cvt4(G[t]), G[t]);
#pragma unroll
            for (int t = 0; t < NTQ; ++t) G[t] = MF16(N2, cvt4(G[t]), G[t]);
#pragma unroll
            for (int t = 0; t < NTQ; ++t) G[t] = MF16(N4, cvt4(G[t]), G[t]);
#pragma unroll
            for (int t = 0; t < NTQ; ++t) G[t] = MF16(N8, cvt4(G[t]), G[t]);
#pragma unroll
            for (int t = 0; t < NTQ; ++t) { const int vt = 2 * hq + t; const int tc = vt & 3;
                const f16x4 uh = cvt4(G[t] * ivr2);
                Y[t] = MF16(NbH, uh, Y[t]); if (hv) Y[t] = MF16(NkH, vf[t], Y[t]);
                char* yo = hv ? (char*)MIX + ((mb + (unsigned)q4) * (unsigned)DM + (unsigned)(h * 64 + 16 * tc + tok)) * 2u : (char*)QT + ((mb + (unsigned)q4) * (unsigned)RW_W + (unsigned)(h * 64 + 16 * tc + tok)) * 2u;
#pragma unroll
                for (int r = 0; r < 4; ++r) *(f16*)(yo + (unsigned)r * (hv ? (unsigned)(DM * 2) : (unsigned)(RW_W * 2))) = (f16)Y[t][r];
#pragma unroll
                for (int ct = 0; ct < 4; ++ct) { const f32x4 g16 = *(const LAS f32x4*)(wl + RWF_G16 + (16 * ct + q4) * 4);
                    const f16x4 bt = *(const LAS f16x4*)(wl + RWC_B + (16 * ct + tok) * 32 + q4 * 2);
                    f32x4 xn = MF16(bt, uh, XT[ct][vt] * g16);
                    if (hv) { const f16x4 kt = *(const LAS f16x4*)(wl + RWC_K + (16 * ct + tok) * 32 + q4 * 2); xn = MF16(kt, vf[t], xn); }
                    XT[ct][vt] = xn; } }
        }
        asm volatile("" ::: "memory");
    }
    { const int lane2 = lane_now(); const int n2 = lane2 & 15, q2 = (lane2 >> 4) * 4;
      f16* rl = RL + ((size_t)bh * NCH + c) * 4096;
      f16* pt = PT + ((size_t)bh * NCH + c) * 4096;
#pragma unroll
      for (int ct = 0; ct < 4; ++ct)
#pragma unroll
          for (int t = 0; t < 4; ++t) { *(f16x4*)(rl + (16 * t + n2) * 64 + 16 * ct + q2) = cvt4(XT[ct][4 + t]);
#pragma unroll
              for (int r = 0; r < 4; ++r) pt[(16 * ct + q2 + r) * 64 + 16 * t + n2] = (f16)XT[ct][t][r]; } }
}

constexpr int HGA_REC = 768, HGA_TB = 8  , HGA_V = HGA_TB * HGA_REC, HGA_HEAD = HGA_V + HGA_TB * 128, HGA_BYTES = 2 * HGA_HEAD;
template <int NH>
__device__ __forceinline__ void hgrn_waveA(const Args& a, int l, int b, int c, int h0, LAS unsigned char* wl) {
    char* U = (char*)(a.ws + WS_U); char* MIX = (char*)(a.ws + WS_MIX); f16* HL = (f16*)(a.ws + WS_HL); float* DC = (float*)(a.ws + WS_DC);
    const float* lbr = a.in[16];
    float S[NH][64]; float dpr[NH];
#pragma unroll
    for (int j = 0; j < NH; ++j) { dpr[j] = 1.f;
#pragma unroll
        for (int k = 0; k < 64; ++k) S[j][k] = 0.f; }
#pragma unroll 1
    for (int blk = 0; blk < CH / HGA_TB; ++blk) {
        const int lane_ = lane_now();
        const unsigned mb = (unsigned)(b * SEQ + c * CH + blk * HGA_TB);
        {
            f16 fr[NH][HGA_TB], qr[NH][HGA_TB], vr[NH][HGA_TB];
#pragma unroll
            for (int j = 0; j < NH; ++j)
#pragma unroll
                for (int tk = 0; tk < HGA_TB; ++tk) { const char* ur = U + (mb + tk) * (unsigned)(NU * 2) + (unsigned)((h0 + j) * 64 + lane_) * 2u; fr[j][tk] = *(const f16*)(ur + C_HGF * 2); qr[j][tk] = *(const f16*)(ur + C_HGQ * 2); vr[j][tk] = *(const f16*)(ur + C_HGI * 2); }
#pragma unroll
            for (int j = 0; j < NH; ++j) { const int col = (h0 + j) * 64 + lane_;
                const float lb = (l == 0) ? 0.f : sigmoidf_(lbr[384 + col] - lbr[col]);
                float dp = dpr[j];
#pragma unroll
                for (int tk = 0; tk < HGA_TB; ++tk) {
                    const float f = lb + (1.0f - lb) * sigmoidf_((float)fr[j][tk]);
                    LAS unsigned char* rec = wl + j * HGA_HEAD + tk * HGA_REC;
                    *(LAS float*)(rec + lane_ * 4) = f; *(LAS float*)(rec + 256 + lane_ * 4) = 1.0f - f; *(LAS float*)(rec + 512 + lane_ * 4) = (float)qr[j][tk];
                    *(LAS f16*)(wl + j * HGA_HEAD + HGA_V + tk * 128 + lane_ * 2) = vr[j][tk];
                    dp *= f;
                    *(f16*)(U + (mb + tk) * (unsigned)(NU * 2) + (unsigned)(C_HGQ + col) * 2u) = (f16)((float)qr[j][tk] * dp);
                }
                dpr[j] = dp; }
        }
        asm volatile("s_waitcnt lgkmcnt(0)" ::: "memory");
#define HG_LD(F, K, Q, rcp, g) { F[0] = *(const LAS f32x4*)((rcp) + (g) * 32); F[1] = *(const LAS f32x4*)((rcp) + (g) * 32 + 16); K[0] = *(const LAS f32x4*)((rcp) + 256 + (g) * 32); K[1] = *(const LAS f32x4*)((rcp) + 256 + (g) * 32 + 16); \
            Q[0] = *(const LAS f32x4*)((rcp) + 512 + (g) * 32); Q[1] = *(const LAS f32x4*)((rcp) + 512 + (g) * 32 + 16); }
#define HG_COMP(Sx, vi, F, K, Q, g) { float tt[8]; \
            _Pragma("unroll") for (int jj = 0; jj < 8; ++jj) tt[jj] = mul_asm(vi, K[jj >> 2][jj & 3]); \
            _Pragma("unroll") for (int jj = 0; jj < 8; ++jj) Sx[8 * (g) + jj] = fma_asm(Sx[8 * (g) + jj], F[jj >> 2][jj & 3], tt[jj]); \
            _Pragma("unroll") for (int jj = 0; jj < 8; ++jj) oa[jj] = fma_asm(Sx[8 * (g) + jj], Q[jj >> 2][jj & 3], oa[jj]); }
#define HG_HEAD(Sx, vi, rcp, rcn, oo) { float oa[8]; _Pragma("unroll") for (int jj = 0; jj < 8; ++jj) oa[jj] = 0.f; \
            HG_LD(fo, ko, qo, rcp, 1) HG_COMP(Sx, vi, fe, ke, qe, 0) \
            HG_LD(fe, ke, qe, rcp, 2) HG_COMP(Sx, vi, fo, ko, qo, 1) \
            HG_LD(fo, ko, qo, rcp, 3) HG_COMP(Sx, vi, fe, ke, qe, 2) \
            HG_LD(fe, ke, qe, rcp, 4) HG_COMP(Sx, vi, fo, ko, qo, 3) \
            HG_LD(fo, ko, qo, rcp, 5) HG_COMP(Sx, vi, fe, ke, qe, 4) \
            HG_LD(fe, ke, qe, rcp, 6) HG_COMP(Sx, vi, fo, ko, qo, 5) \
            HG_LD(fo, ko, qo, rcp, 7) HG_COMP(Sx, vi, fe, ke, qe, 6) \
            HG_LD(fe, ke, qe, rcn, 0) HG_COMP(Sx, vi, fo, ko, qo, 7) \
            oo = ((oa[0] + oa[1]) + (oa[2] + oa[3])) + ((oa[4] + oa[5]) + (oa[6] + oa[7])); }
        f32x4 fe[2], ke[2], qe[2], fo[2], ko[2], qo[2];
        HG_LD(fe, ke, qe, wl, 0)
        f16 vh[NH], vn[NH];
#pragma unroll
        for (int j = 0; j < NH; ++j) vh[j] = *(const LAS f16*)(wl + j * HGA_HEAD + HGA_V + lane_ * 2);
#pragma unroll 1
        for (int t2 = 0; t2 < HGA_TB; ++t2) {
            const LAS unsigned char* rc = wl + t2 * HGA_REC;
#pragma unroll
            for (int j = 0; j < NH; ++j) vn[j] = *(const LAS f16*)(wl + j * HGA_HEAD + HGA_V + ((t2 + 1) & (HGA_TB - 1)) * 128 + lane_ * 2);
            float oo[NH];
#pragma unroll
            for (int j = 0; j < NH; ++j) { const float vi = (float)vh[j];
                const LAS unsigned char* rcp = rc + j * HGA_HEAD; const LAS unsigned char* rcn = (j + 1 < NH) ? rc + (j + 1) * HGA_HEAD : rc + HGA_REC;
                HG_HEAD(S[j], vi, rcp, rcn, oo[j]) }
            char* mo = MIX + ((mb + t2) * (unsigned)DM + (unsigned)(384 + h0 * 64 + lane_)) * 2u;
#pragma unroll
            for (int j = 0; j < NH; ++j) { *(f16*)(mo + 128 * j) = (f16)oo[j]; vh[j] = vn[j]; }
        }
#undef HG_LD
#undef HG_COMP
#undef HG_HEAD
    }
    const int lane2 = lane_now();
#pragma unroll
    for (int j = 0; j < NH; ++j) { const int bh = b * 6 + h0 + j; store_row64_f16(HL + (((size_t)bh * NCH + c) * 64 + lane2) * 64, S[j]);
        DC[((size_t)bh * NCH + c) * 64 + lane2] = dpr[j]; }
}

__device__ __forceinline__ void lru_waveA(const Args& a, int l, int b, int c, int g, LAS unsigned char* wl) {
    const int ln = lane_now();
    const char* Ub = (const char*)(a.ws + WS_U); char* MIXb = (char*)(a.ws + WS_MIX); char* CA = (char*)(a.ws + WS_CA); float* LA = (float*)(a.ws + WS_LA); float* LH = (float*)(a.ws + WS_LH);
    const float* cw = a.in[18] + l * 4 * 256 + g * 64; const float* cb = a.in[19] + l * 256 + g * 64;
    const float* ba = a.in[21] + l * 256 + g * 64; const float* bx = a.in[23] + l * 256 + g * 64; const float* lam = a.in[24] + l * 256 + g * 64;
    const char* WAT = (const char*)(a.ws + WS_WAT) + (size_t)(l * 4 + g) * 8192; const char* WXT = (const char*)(a.ws + WS_WXT) + (size_t)(l * 4 + g) * 8192;
    LAS unsigned char* Y = wl;
    const unsigned mrow0 = (unsigned)(b * SEQ + c * CH);
#pragma unroll 1
    for (int ib = 0; ib < 8; ib += 4) {
        f16x8 xr[4][4];
#pragma unroll
        for (int it = 0; it < 4; ++it) { const int item = ln + 64 * (ib + it), tok = item >> 3, co = item & 7; const int t = c * CH + tok;
#pragma unroll
            for (int jj = 0; jj < 4; ++jj) { const int ts = t - 3 + jj; const unsigned row = (ts >= 0) ? mrow0 + (unsigned)(tok - 3 + jj) : mrow0 + (unsigned)tok;
                xr[it][jj] = *(const f16x8*)(Ub + (row * (unsigned)NU + (unsigned)(C_LRUX + g * 64 + 8 * co)) * 2u); } }
#pragma unroll
        for (int it = 0; it < 4; ++it) { const int item = ln + 64 * (ib + it), tok = item >> 3, co = item & 7; const int t = c * CH + tok;
            const f32x4 b0 = *(const f32x4*)(cb + 8 * co), b1 = *(const f32x4*)(cb + 8 * co + 4);
            float y[8] = {b0[0], b0[1], b0[2], b0[3], b1[0], b1[1], b1[2], b1[3]};
#pragma unroll
            for (int jj = 0; jj < 4; ++jj) { const int ts = t - 3 + jj;
                if (ts >= 0) { const f32x4 w0 = *(const f32x4*)(cw + jj * 256 + 8 * co), w1 = *(const f32x4*)(cw + jj * 256 + 8 * co + 4);
#pragma unroll
                    for (int i = 0; i < 8; ++i) y[i] += (i < 4 ? w0[i & 3] : w1[i & 3]) * (float)xr[it][jj][i]; } }
            *(LAS f16x8*)(Y + tok * 144 + co * 16) = pack8(y); } }
    asm volatile("s_waitcnt lgkmcnt(0)" ::: "memory");
    const int tl = ln & 15, fq = ln >> 4;
    float sp[16], cy[16], cp[16];
#pragma unroll
    for (int nt = 0; nt < 4; ++nt) { const f32x4 lm4 = *(const f32x4*)(lam + 16 * nt + 4 * fq);
#pragma unroll
        for (int i = 0; i < 4; ++i) { sp[nt * 4 + i] = log1pf(__expf(-lm4[i])); cy[nt * 4 + i] = 0.f; cp[nt * 4 + i] = 1.f; } }
    f16x8 wfa[4][2], wfx[4][2];
#pragma unroll
    for (int nt = 0; nt < 4; ++nt)
#pragma unroll
        for (int s2 = 0; s2 < 2; ++s2) { const unsigned wo = (unsigned)(((16 * nt + (ln & 15)) * 64 + 8 * (ln >> 4) + 32 * s2) * 2); wfa[nt][s2] = *(const f16x8*)(WAT + wo); wfx[nt][s2] = *(const f16x8*)(WXT + wo); }
#pragma unroll 1
    for (int tt = 0; tt < 4; ++tt) {
        f16x8 by[2];
#pragma unroll
        for (int s2 = 0; s2 < 2; ++s2) by[s2] = *(const LAS f16x8*)(Y + (16 * tt + tl) * 144 + (8 * fq + 32 * s2) * 2);
        const unsigned m = mrow0 + (unsigned)(16 * tt + tl);
#pragma unroll
        for (int nt = 0; nt < 4; ++nt) {
            f32x4 ra = (f32x4){0.f, 0.f, 0.f, 0.f}, rx = ra;
#pragma unroll
            for (int s2 = 0; s2 < 2; ++s2) { ra = __builtin_amdgcn_mfma_f32_16x16x32_f16(wfa[nt][s2], by[s2], ra, 0, 0, 0); rx = __builtin_amdgcn_mfma_f32_16x16x32_f16(wfx[nt][s2], by[s2], rx, 0, 0, 0); }
            const int ch0 = 16 * nt + 4 * fq;
            const f32x4 ba4 = *(const f32x4*)(ba + ch0), bx4 = *(const f32x4*)(bx + ch0);
            const f16x4 y4 = *(const LAS f16x4*)(Y + (16 * tt + tl) * 144 + ch0 * 2);
            f16x4 ho, co;
#pragma unroll
            for (int i = 0; i < 4; ++i) { const int q = nt * 4 + i;
                const float r = sigmoidf_(ra[i] + ba4[i]), ig = sigmoidf_(rx[i] + bx4[i]);
                const float la = -8.0f * r * sp[q];
                float av = __expf(la), uv = sqrtf(one_minus_exp_(2.0f * la)) * (ig * (float)y4[i]);
#define LRU_SCAN(d) { const float ap = __builtin_bit_cast(float, __builtin_amdgcn_update_dpp(0x3f800000, __builtin_bit_cast(int, av), 0x110 + (d), 0xf, 0xf, false)); \
                      const float up = __builtin_bit_cast(float, __builtin_amdgcn_update_dpp(0, __builtin_bit_cast(int, uv), 0x110 + (d), 0xf, 0xf, false)); \
                      uv = av * up + uv; av = av * ap; }
                LRU_SCAN(1) LRU_SCAN(2) LRU_SCAN(4) LRU_SCAN(8)
#undef LRU_SCAN
                const float hl = uv + av * cy[q], ca = av * cp[q];
                ho[i] = (f16)hl; co[i] = (f16)ca;
                cy[q] = __builtin_bit_cast(float, __builtin_amdgcn_ds_bpermute((ln | 15) << 2, __builtin_bit_cast(int, hl)));
                cp[q] = __builtin_bit_cast(float, __builtin_amdgcn_ds_bpermute((ln | 15) << 2, __builtin_bit_cast(int, ca)));
            }
            *(f16x4*)(MIXb + (m * (unsigned)DM + 768u + (unsigned)(g * 64 + ch0)) * 2u) = ho; *(f16x4*)(CA + (m * 256u + (unsigned)(g * 64 + ch0)) * 2u) = co;
        }
    }
    if (tl == 15) {
#pragma unroll
        for (int q = 0; q < 16; ++q) { const int ch = g * 64 + 16 * (q >> 2) + 4 * fq + (q & 3); LA[((size_t)b * NCH + c) * 256 + ch] = cp[q]; LH[((size_t)b * NCH + c) * 256 + ch] = cy[q]; } }
}

__device__ __forceinline__ void phaseA(const Args& a, int l, int task, LAS unsigned char* lds, int tid) {
    asm volatile("" : "+v"(tid));
    const int lane = tid & 63, wave = __builtin_amdgcn_readfirstlane(tid >> 6);
    const int b = task / NCH, c = task % NCH;
    const f16* U = (const f16*)(a.ws + WS_U); f16* MIX = (f16*)(a.ws + WS_MIX); f16* VF = (f16*)(a.ws + WS_VF); f16* VP = (f16*)(a.ws + WS_VP);
    f16* QT = (f16*)(a.ws + WS_QT); f16* PT = (f16*)(a.ws + WS_PT); f16* RL = (f16*)(a.ws + WS_RL); float* BONG = (float*)(a.ws + WS_BON);
    {
        LAS f16* prm = (LAS f16*)(lds + PRM_OFF); LAS float* prw0 = (LAS float*)(lds + PRM_OFF + PRM_W0_BYTE);
        for (int i = tid; i < PRM_HALVES + 384; i += NT) {
            if (i < 1280) prm[i] = (f16)a.in[3][l * RW_SHIFT + i];
            else if (i < PRM_HALVES) { const int q = (i - 1280) / 384, cc = (i - 1280) % 384;
                prm[i] = (f16)((q == 0) ? a.in[6][l * RW_W + cc] : (q == 1) ? a.in[11][l * RW_W + cc] : (q == 2) ? a.in[12][l * RW_W + cc] : (q == 3) ? a.in[13][l * RW_W + cc] : a.in[8][cc]); }
            else prw0[i - PRM_HALVES] = a.in[4][l * RW_W + (i - PRM_HALVES)]; }
        __syncthreads();
        if (wave < RW_H) { rwkv_waveA(a, l, b, c, wave, lds + wave * RWA_BYTES, lds + PRM_OFF, lane);
                           hgrn_waveA<1>(a, l, b, c, wave, lds + wave * RWA_BYTES); }
        else { LAS unsigned char* hw = lds + RW_H * RWA_BYTES + (wave - RW_H) * HGA_BYTES;
               lru_waveA(a, l, b, c, 2 * (wave - RW_H), hw); lru_waveA(a, l, b, c, 2 * (wave - RW_H) + 1, hw); }
        __syncthreads();
    }
}

constexpr int PB_SLOT = 16384, PB_NS = 8, PB_AHEAD = 6, NGRP = NCH / 8;
#define ARENA(ws, off) ((char*)(ws) + WS_U + (size_t)((off) >> 11) * (size_t)(NU * 2) + (size_t)((off) & 2047))
constexpr size_t AR_PGT = 0, AR_LG = 2u << 20, AR_SG = 4u << 20;
#define PB_SWZ(row, o) ((row) * 128 + (((((o) >> 4) ^ ((row) & 7)) << 4) | ((o) & 15)))
template <bool ADD_L>
__device__ __forceinline__ void pb_step(f32x4 (&Sacc)[4], const LAS unsigned char* sl, int xrow, int vl, int fq) {
    f16x8 Bhi[2], Blo[2];
#pragma unroll
    for (int mt = 0; mt < 4; ++mt)
#pragma unroll
        for (int i = 0; i < 4; ++i) { const f16 hi = (f16)Sacc[mt][i]; const f16 lo = (f16)(Sacc[mt][i] - (float)hi); Bhi[mt >> 1][4 * (mt & 1) + i] = hi; Blo[mt >> 1][4 * (mt & 1) + i] = lo; }
#pragma unroll
    for (int mt = 0; mt < 4; ++mt) {
        f32x4 d = (f32x4){0.f, 0.f, 0.f, 0.f};
        if (ADD_L) { const f16x4 l4 = *(const LAS f16x4*)(sl + 8192 + PB_SWZ(xrow, 32 * mt + 8 * fq)); d = (f32x4){(float)l4[0], (float)l4[1], (float)l4[2], (float)l4[3]}; }
#pragma unroll
        for (int s = 0; s < 2; ++s) { const u32x2 a0 = *(const LAS u32x2*)(sl + PB_SWZ(16 * mt + vl, 64 * s + 8 * fq)), a1 = *(const LAS u32x2*)(sl + PB_SWZ(16 * mt + vl, 64 * s + 32 + 8 * fq));
            u32x4 aw; aw.x = a0.x; aw.y = a0.y; aw.z = a1.x; aw.w = a1.y; const f16x8 af = __builtin_bit_cast(f16x8, aw);
            d = __builtin_amdgcn_mfma_f32_16x16x32_f16(af, Bhi[s], d, 0, 0, 0); d = __builtin_amdgcn_mfma_f32_16x16x32_f16(af, Blo[s], d, 0, 0, 0); }
        Sacc[mt] = d; }
}
__device__ __forceinline__ void pb_stage8(const Args& a, LAS unsigned char* lds, int bh, int c0, int wave, int lane) {
    const char* PT = (const char*)(a.ws + WS_PT) + ((size_t)bh * NCH + c0) * 8192; const char* RL = (const char*)(a.ws + WS_RL) + ((size_t)bh * NCH + c0) * 8192;
    const int lq = wave * 64 + lane, lrow = lq >> 3, lpp = lq & 7; const unsigned lsrc = (unsigned)(lrow * 128 + ((lpp ^ (lrow & 7)) << 4));
#pragma unroll
    for (int sl = 0; sl < 8; ++sl) { const unsigned so = (unsigned)(sl * PB_SLOT + wave * 1024); const size_t go = (size_t)sl * 8192 + lsrc;
        __builtin_amdgcn_global_load_lds((const unsigned*)(PT + go), (LAS unsigned*)(lds + so), 16, 0, 0);
        __builtin_amdgcn_global_load_lds((const unsigned*)(RL + go), (LAS unsigned*)(lds + so + 8192), 16, 0, 0); }
    asm volatile("s_waitcnt vmcnt(0)" ::: "memory");
    __builtin_amdgcn_s_barrier();
}
__device__ __forceinline__ void phaseB1(const Args& a, LAS unsigned char* lds, int tid) {
    asm volatile("" : "+v"(tid));
    const int lane = tid & 63, wave = __builtin_amdgcn_readfirstlane(tid >> 6);
    for (int task = blockIdx.x; task < 12 * NGRP; task += gridDim.x) {
        const int bh = task / NGRP, g = task % NGRP, c0 = 8 * g;
        pb_stage8(a, lds, bh, c0, wave, lane);
        const int vt = wave & 3, vl = lane & 15, fq = lane >> 4, xr = 16 * vt + vl;
        f32x4 X[4];
        if (wave < 4) {
#pragma unroll
            for (int mt = 0; mt < 4; ++mt) { const f16x4 l4 = *(const LAS f16x4*)(lds + 8192 + PB_SWZ(xr, 32 * mt + 8 * fq)); X[mt] = (f32x4){(float)l4[0], (float)l4[1], (float)l4[2], (float)l4[3]}; }
#pragma unroll 1
            for (int s = 1; s < 8; ++s) pb_step<true>(X, lds + s * PB_SLOT, xr, vl, fq);
#pragma unroll
            for (int mt = 0; mt < 4; ++mt) { f16x4 o;
#pragma unroll
                for (int i = 0; i < 4; ++i) o[i] = (f16)X[mt][i];
                *(f16x4*)ARENA(a.ws, AR_LG + ((size_t)bh * NGRP + g) * 8192 + (size_t)((xr * 64 + 16 * mt + 4 * fq) * 2)) = o; }
        } else {
#pragma unroll
            for (int mt = 0; mt < 4; ++mt)
#pragma unroll
                for (int i = 0; i < 4; ++i) X[mt][i] = (16 * mt + 4 * fq + i == xr) ? 1.f : 0.f;
#pragma unroll 1
            for (int s = 0; s < 8; ++s) pb_step<false>(X, lds + s * PB_SLOT, xr, vl, fq);
#pragma unroll
            for (int mt = 0; mt < 4; ++mt)
#pragma unroll
                for (int i = 0; i < 4; ++i) *(f16*)ARENA(a.ws, AR_PGT + ((size_t)bh * NGRP + g) * 8192 + (size_t)(((16 * mt + 4 * fq + i) * 64 + xr) * 2)) = (f16)X[mt][i];
        }
        asm volatile("s_waitcnt vmcnt(0) lgkmcnt(0)" ::: "memory");
        __builtin_amdgcn_s_barrier();
    }
}
__device__ __forceinline__ void phaseB3(const Args& a, LAS unsigned char* lds, int tid) {
    asm volatile("" : "+v"(tid));
    const int lane = tid & 63, wave = __builtin_amdgcn_readfirstlane(tid >> 6);
    for (int task = blockIdx.x; task < 12 * NGRP; task += gridDim.x) {
        const int bh = task / NGRP, g = task % NGRP, c0 = 8 * g;
        pb_stage8(a, lds, bh, c0, wave, lane);
        if (wave < 4) {
            const int vt = wave, vl = lane & 15, fq = lane >> 4, xr = 16 * vt + vl;
            char* RL = (char*)(a.ws + WS_RL) + ((size_t)bh * NCH + c0) * 8192;
            f32x4 X[4];
#pragma unroll
            for (int mt = 0; mt < 4; ++mt) { const f16x4 s4 = *(const f16x4*)ARENA(a.ws, AR_SG + ((size_t)bh * NGRP + g) * 8192 + (size_t)((xr * 64 + 16 * mt + 4 * fq) * 2)); X[mt] = (f32x4){(float)s4[0], (float)s4[1], (float)s4[2], (float)s4[3]}; }
#pragma unroll 1
            for (int s = 0; s < 8; ++s) {
#pragma unroll
                for (int mt = 0; mt < 4; ++mt) { f16x4 o;
#pragma unroll
                    for (int i = 0; i < 4; ++i) o[i] = (f16)X[mt][i];
                    *(f16x4*)(RL + (size_t)s * 8192 + (xr * 64 + 16 * mt + 4 * fq) * 2) = o; }
                if (s < 7) pb_step<true>(X, lds + s * PB_SLOT, xr, vl, fq);
            }
        }
        asm volatile("s_waitcnt vmcnt(0) lgkmcnt(0)" ::: "memory");
        __builtin_amdgcn_s_barrier();
    }
}
__device__ __forceinline__ void phaseB(const Args& a, LAS unsigned char* lds, int tid) {
    asm volatile("" : "+v"(tid));
    const int lane = tid & 63, wave = __builtin_amdgcn_readfirstlane(tid >> 6);
    const int bx = blockIdx.x;
    if (bx < 12) {
        const int bh = bx;
        const bool loader = wave >= 4;
        const int vt = wave & 3, vl = lane & 15, fq = lane >> 4, v = 16 * vt + vl;
        const int lq = (wave - 4) * 64 + lane, lrow = lq >> 3, lpp = lq & 7;
        const unsigned lsrc = (unsigned)(lrow * 128 + ((lpp ^ (lrow & 7)) << 4));
#define PB_ISSUE(cc) { const unsigned so = (unsigned)(((cc) & (PB_NS - 1)) * PB_SLOT) + (unsigned)((wave - 4) * 1024); const size_t go = ((size_t)bh * NGRP + (cc)) * 8192 + lsrc; \
            __builtin_amdgcn_global_load_lds((const unsigned*)ARENA(a.ws, AR_PGT + go), (LAS unsigned*)(lds + so), 16, 0, 0); \
            __builtin_amdgcn_global_load_lds((const unsigned*)ARENA(a.ws, AR_PGT + go + 4096), (LAS unsigned*)(lds + so + 4096), 16, 0, 0); \
            __builtin_amdgcn_global_load_lds((const unsigned*)ARENA(a.ws, AR_LG + go), (LAS unsigned*)(lds + so + 8192), 16, 0, 0); \
            __builtin_amdgcn_global_load_lds((const unsigned*)ARENA(a.ws, AR_LG + go + 4096), (LAS unsigned*)(lds + so + 12288), 16, 0, 0); }
        if (loader) {
#pragma unroll
            for (int cc = 0; cc < PB_AHEAD; ++cc) PB_ISSUE(cc)
            asm volatile("s_waitcnt vmcnt(20)" ::: "memory");
        }
        __builtin_amdgcn_s_barrier();
        f32x4 Sacc[4];
#pragma unroll
        for (int mt = 0; mt < 4; ++mt) Sacc[mt] = (f32x4){0.f, 0.f, 0.f, 0.f};
#pragma unroll 1
        for (int c = 0; c < NGRP; ++c) {
            if (loader) {
                if (c + PB_AHEAD < NGRP) { PB_ISSUE(c + PB_AHEAD) asm volatile("s_waitcnt vmcnt(20)" ::: "memory"); }
                else asm volatile("s_waitcnt vmcnt(0)" ::: "memory");
            } else {
#pragma unroll
                for (int mt = 0; mt < 4; ++mt) { f16x4 o;
#pragma unroll
                    for (int i = 0; i < 4; ++i) o[i] = (f16)Sacc[mt][i];
                    *(f16x4*)ARENA(a.ws, AR_SG + ((size_t)bh * NGRP + c) * 8192 + (size_t)((v * 64 + 16 * mt + 4 * fq) * 2)) = o; }
                pb_step<true>(Sacc, lds + (c & (PB_NS - 1)) * PB_SLOT, v, vl, fq);
                asm volatile("s_waitcnt lgkmcnt(0)" ::: "memory");
            }
            __builtin_amdgcn_s_barrier();
        }
#undef PB_ISSUE
        asm volatile("s_waitcnt vmcnt(0)" ::: "memory");
    } else if (bx < 12 + 96) {
        const int idx = (bx - 12) * NT + tid; const int bh = idx >> 12, e = idx & 4095, k = e & 63;
        f16* HL = (f16*)(a.ws + WS_HL); const float* DC = (const float*)(a.ws + WS_DC);
        float s = 0.f;
        for (int c0 = 0; c0 < NCH; c0 += 8) { float Lc[8], d[8];
#pragma unroll
            for (int j = 0; j < 8; ++j) { Lc[j] = (float)HL[((size_t)bh * NCH + c0 + j) * 4096 + e]; d[j] = DC[((size_t)bh * NCH + c0 + j) * 64 + k]; }
#pragma unroll
            for (int j = 0; j < 8; ++j) { HL[((size_t)bh * NCH + c0 + j) * 4096 + e] = (f16)s; s = d[j] * s + Lc[j]; } }
    } else if (bx == 12 + 96) {
        const int bb = tid >> 8, ch = tid & 255; const float* LA = (const float*)(a.ws + WS_LA); float* LH = (float*)(a.ws + WS_LH);
        float cy = 0.f;
        for (int c0 = 0; c0 < NCH; c0 += 8) { float A[8], H[8];
#pragma unroll
            for (int j = 0; j < 8; ++j) { const size_t o = ((size_t)bb * NCH + c0 + j) * 256 + ch; A[j] = LA[o]; H[j] = LH[o]; }
#pragma unroll
            for (int j = 0; j < 8; ++j) { const size_t o = ((size_t)bb * NCH + c0 + j) * 256 + ch; LH[o] = cy; cy = A[j] * cy + H[j]; } }
    }
}

__device__ __forceinline__ void phaseC(const Args& a, int l, int task, LAS unsigned char* lds, int tid) {
    asm volatile("" : "+v"(tid));
    const int lane = tid & 63, wave = __builtin_amdgcn_readfirstlane(tid >> 6);
    const int b = task / NCH, c = task % NCH;
    const int tl = lane & 15, fq = lane >> 4, tt = wave & 3, hg = wave >> 2;
    const unsigned m = (unsigned)(b * SEQ + c * CH + 16 * tt + tl);
    const char* U = (const char*)(a.ws + WS_U); char* MIX = (char*)(a.ws + WS_MIX); const char* VP = (const char*)(a.ws + WS_VP);
    const char* QT = (const char*)(a.ws + WS_QT); const char* RL = (const char*)(a.ws + WS_RL); const char* HL = (const char*)(a.ws + WS_HL); const float* BONG = (const float*)(a.ws + WS_BON);
    const unsigned uo = m * (unsigned)(NU * 2);
#pragma unroll
    for (int hh = 0; hh < 3; ++hh) {
        const int h = 3 * hg + hh; const int bh = b * RW_H + h;
        const char* sl = RL + ((size_t)bh * NCH + c) * 8192;
        f16x8 bq[2];
#pragma unroll
        for (int s = 0; s < 2; ++s) bq[s] = *(const f16x8*)(QT + (m * (unsigned)RW_W + (unsigned)(h * 64 + 8 * fq + 32 * s)) * 2u);
        f32x4 D[4];
#pragma unroll
        for (int vt = 0; vt < 4; ++vt) { const f16x4 yl = *(const f16x4*)(MIX + (m * (unsigned)DM + (unsigned)(h * 64 + 16 * vt + 4 * fq)) * 2u);
            f32x4 d = (f32x4){(float)yl[0], (float)yl[1], (float)yl[2], (float)yl[3]};
#pragma unroll
            for (int s = 0; s < 2; ++s) d = __builtin_amdgcn_mfma_f32_16x16x32_f16(*(const f16x8*)(sl + ((16 * vt + tl) * 64 + 8 * fq + 32 * s) * 2), bq[s], d, 0, 0, 0);
            D[vt] = d; }
        float sm = 0.f;
#pragma unroll
        for (int vt = 0; vt < 4; ++vt) sm += (D[vt][0] + D[vt][1]) + (D[vt][2] + D[vt][3]);
        sm += shfl_xor_f(sm, 16); sm += shfl_xor_f(sm, 32);
        const float mean = sm * (1.0f / 64.0f); float vr = 0.f;
#pragma unroll
        for (int vt = 0; vt < 4; ++vt)
#pragma unroll
            for (int i = 0; i < 4; ++i) { const float d = D[vt][i] - mean; vr += d * d; }
        vr += shfl_xor_f(vr, 16); vr += shfl_xor_f(vr, 32);
        const float rstd = rsq_(vr * (1.0f / 64.0f) + 64e-5f);
        const float bon = BONG[m * 8u + (unsigned)h];
        const float* ln_w = a.in[14] + l * RW_W; const float* ln_b = a.in[15] + l * RW_W;
#pragma unroll
        for (int vt = 0; vt < 4; ++vt) { const unsigned col = (unsigned)(h * 64 + 16 * vt + 4 * fq);
            const f16x4 vp = *(const f16x4*)(VP + (m * (unsigned)RW_W + col) * 2u), z4 = *(const f16x4*)(U + uo + ((unsigned)C_RWZ + col) * 2u);
            const f32x4 lw = *(const f32x4*)(ln_w + col), lb = *(const f32x4*)(ln_b + col);
            f16x4 o;
#pragma unroll
            for (int i = 0; i < 4; ++i) o[i] = (f16)(((D[vt][i] - mean) * rstd * lw[i] + lb[i] + bon * (float)vp[i]) * siluf_((float)z4[i]));
            *(f16x4*)(MIX + (m * (unsigned)DM + col) * 2u) = o; }
    }
#pragma unroll
    for (int hh = 0; hh < 3; ++hh) {
        const int h = 3 * hg + hh; const int bh = b * 6 + h;
        const char* sl = HL + ((size_t)bh * NCH + c) * 8192;
        f16x8 bq[2];
#pragma unroll
        for (int s = 0; s < 2; ++s) bq[s] = *(const f16x8*)(U + uo + (unsigned)(C_HGQ + h * 64 + 8 * fq + 32 * s) * 2u);
        f32x4 D[4];
#pragma unroll
        for (int vt = 0; vt < 4; ++vt) { const f16x4 ol = *(const f16x4*)(MIX + (m * (unsigned)DM + (unsigned)(384 + h * 64 + 16 * vt + 4 * fq)) * 2u);
            f32x4 d = (f32x4){(float)ol[0], (float)ol[1], (float)ol[2], (float)ol[3]};
#pragma unroll
            for (int s = 0; s < 2; ++s) d = __builtin_amdgcn_mfma_f32_16x16x32_f16(*(const f16x8*)(sl + ((16 * vt + tl) * 64 + 8 * fq + 32 * s) * 2), bq[s], d, 0, 0, 0);
            D[vt] = d; }
        float ss = 0.f;
#pragma unroll
        for (int vt = 0; vt < 4; ++vt) ss += (D[vt][0] * D[vt][0] + D[vt][1] * D[vt][1]) + (D[vt][2] * D[vt][2] + D[vt][3] * D[vt][3]);
        ss += shfl_xor_f(ss, 16); ss += shfl_xor_f(ss, 32);
        const float rs = rsq_(ss * (1.0f / 64.0f) + 1e-6f);
        const float* nw = a.in[17] + l * 384;
#pragma unroll
        for (int vt = 0; vt < 4; ++vt) { const unsigned col = (unsigned)(h * 64 + 16 * vt + 4 * fq);
            const f16x4 z4 = *(const f16x4*)(U + uo + ((unsigned)C_HGZ + col) * 2u); const f32x4 w4 = *(const f32x4*)(nw + col);
            f16x4 o;
#pragma unroll
            for (int i = 0; i < 4; ++i) o[i] = (f16)(D[vt][i] * rs * w4[i] * siluf_((float)z4[i]));
            *(f16x4*)(MIX + (m * (unsigned)DM + 384u + col) * 2u) = o; }
    }
    {
        const char* CA = (const char*)(a.ws + WS_CA); const float* LH = (const float*)(a.ws + WS_LH) + ((size_t)b * NCH + c) * 256;
#pragma unroll
        for (int q = 0; q < 4; ++q) { const unsigned ch0 = (unsigned)(128 * hg + 32 * fq + 8 * q);
            const f16x8 hl = *(const f16x8*)(MIX + (m * (unsigned)DM + 768u + ch0) * 2u), ca = *(const f16x8*)(CA + (m * 256u + ch0) * 2u), z8 = *(const f16x8*)(U + uo + ((unsigned)C_LRUZ + ch0) * 2u);
            const f32x4 c0 = *(const f32x4*)(LH + ch0), c1 = *(const f32x4*)(LH + ch0 + 4);
            f16x8 o;
#pragma unroll
            for (int i = 0; i < 8; ++i) o[i] = (f16)(((float)hl[i] + (float)ca[i] * (i < 4 ? c0[i & 3] : c1[i & 3])) * siluf_((float)z8[i]));
            *(f16x8*)(MIX + (m * (unsigned)DM + 768u + ch0) * 2u) = o; }
    }
}
#define XB_TMO      128
#define XB_XCNT(j)  (256  + 64 * (j))
#define XB_XSUB(j)  (1280 + 64 * (j))
#define XB_XGEN(j)  (2304 + 64 * (j))
#define XB_TOP      3328
#define XB_TOPGEN   3392
#define XCD_BAR_WORDS 3456
#define XB_SPIN_CAP (1u << 18)

__device__ __forceinline__ unsigned xb_ld(unsigned* p)              { return __hip_atomic_load(p, __ATOMIC_RELAXED, __HIP_MEMORY_SCOPE_AGENT); }
__device__ __forceinline__ unsigned xb_add(unsigned* p, unsigned v) { return __hip_atomic_fetch_add(p, v, __ATOMIC_RELAXED, __HIP_MEMORY_SCOPE_AGENT); }
__device__ __forceinline__ unsigned xb_xcc_id() { return (unsigned)__builtin_amdgcn_s_getreg((3 << 11) | 20) & 0xFu; }
#define XB_SPIN(cond, bar) do { unsigned _sp = 0; while (cond) { __builtin_amdgcn_s_sleep(1); \
    if ((++_sp & 255u) == 0u) { if (xb_ld(&(bar)[XB_TMO])) break; if (_sp > XB_SPIN_CAP) { atomicAdd(&(bar)[XB_TMO], 1u); break; } } } } while (0)

struct XcdBarrier {
    unsigned* bar; unsigned x; int isw0;
    volatile LAS unsigned* st;
};

__device__ __forceinline__ XcdBarrier xcd_barrier_post(unsigned* bar, volatile LAS unsigned* st, int isw0) {
    XcdBarrier b; b.bar = bar; b.x = xb_xcc_id(); b.st = st; b.isw0 = isw0;
    if (isw0 && lane_now() == 0) (void)xb_add(&bar[XB_XCNT(b.x)], 1u);
    return b;
}
__device__ __forceinline__ void xcd_barrier_complete(unsigned* bar, unsigned x, unsigned& nloc, unsigned& nx) {
    const unsigned G = gridDim.x * gridDim.y * gridDim.z;
    unsigned sum, cnt, mine, sp = 0u;
    for (;;) {
        sum = 0u; cnt = 0u; mine = 0u;
#pragma unroll
        for (unsigned j = 0; j < 16; ++j) { const unsigned c = xb_ld(&bar[XB_XCNT(j)]); sum += c; cnt += (c > 0u) ? 1u : 0u; mine = (j == x) ? c : mine; }
        if (sum == G) break;
        __builtin_amdgcn_s_sleep(1);
        if ((++sp & 255u) == 0u) { if (xb_ld(&bar[XB_TMO])) break; if (sp > XB_SPIN_CAP) { atomicAdd(&bar[XB_TMO], 1u); break; } }
    }
    nloc = mine > 0u ? mine : 1u; nx = cnt > 0u ? cnt : 1u;
}

__device__ __forceinline__ void xcd_barrier(const XcdBarrier& b) {
    asm volatile("s_waitcnt vmcnt(0)" ::: "memory");
    __syncthreads();
    if (b.isw0 && lane_now() == 0) {
        unsigned* bar = b.bar;
        __builtin_amdgcn_s_waitcnt(0);
        unsigned nloc = b.st[0], nx = b.st[1];
        if (nloc == 0u) { xcd_barrier_complete(bar, b.x, nloc, nx); b.st[0] = nloc; b.st[1] = nx; }
        const unsigned old = xb_add(&bar[XB_XSUB(b.x)], 1u);
        const unsigned gen = old / nloc;
        if (old + 1u == (gen + 1u) * nloc) {
            __builtin_amdgcn_fence(__ATOMIC_RELEASE, "agent");
            asm volatile("s_waitcnt vmcnt(0)" ::: "memory");
            const unsigned og = xb_add(&bar[XB_TOP], 1u);
            const unsigned tg = og / nx;
            if (og + 1u == (tg + 1u) * nx) xb_add(&bar[XB_TOPGEN], 1u);
            else XB_SPIN(xb_ld(&bar[XB_TOPGEN]) == tg, bar);
            __builtin_amdgcn_fence(__ATOMIC_ACQUIRE, "agent");
            xb_add(&bar[XB_XGEN(b.x)], 1u);
            asm volatile("s_waitcnt vmcnt(0)" ::: "memory");
        } else {
            XB_SPIN(xb_ld(&bar[XB_XGEN(b.x)]) == gen, bar);
            __builtin_amdgcn_fence(__ATOMIC_ACQUIRE, "agent");
            asm volatile("s_waitcnt vmcnt(0)" ::: "memory");
        }
    }
    __syncthreads();
}

constexpr size_t WS_BAR = 16384;
constexpr size_t WS_PCNT = 32768;
constexpr int MISC_OFF = LDS_BYTES - 16;
__global__ void __launch_bounds__(NT, 2) fwd(Args args) {
    extern __shared__ __attribute__((aligned(16))) unsigned char lds_raw[];
    LAS unsigned char* lds = (LAS unsigned char*)lds_raw;
    cg::grid_group grid = cg::this_grid();
    const int wave = __builtin_amdgcn_readfirstlane((int)threadIdx.x >> 6);
#define TID_NOW() (wave * 64 + lane_now())
    const int tid = TID_NOW(); const int lane = tid & 63;
    if (wave == 0 && lane < 4) ((LAS unsigned*)(lds + MISC_OFF))[lane] = 0u;
    __syncthreads();
    XcdBarrier xbar = xcd_barrier_post((unsigned*)(args.ws + WS_BAR), (volatile LAS unsigned*)(lds + MISC_OFF), __builtin_amdgcn_readfirstlane(wave == 0 ? 1 : 0));
#define GRID_BAR() do { XcdBarrier xb_ = xbar; xb_.st = (volatile LAS unsigned*)(lds + MISC_OFF); asm volatile("" : "+s"(xb_.bar), "+s"(xb_.x)); xcd_barrier(xb_); } while (0)
    const int G = gridDim.x, gw = blockIdx.x * NWAVES + wave, NGW = G * NWAVES;
    unsigned char* ws = args.ws;
    unsigned short* XN = (unsigned short*)(ws + WS_XN);
    {
        LAS float* scr = (LAS float*)(lds + wave * 8704);
        constexpr int I_IN = (DM / 64) * (NIN / 32), I_OUT = (DM / 64) * (DM / 32), NITEMS = DEPTH * (I_IN + I_OUT);
        for (int it = gw; it < NITEMS; it += NGW) {
            int r = it; const int l = r / (I_IN + I_OUT); r -= l * (I_IN + I_OUT);
            if (r < I_IN) p0_transpose_item(args.in[2] + (size_t)l * DM * NIN, DM, NIN, (unsigned short*)(ws + WS_WIN + l * WIN_L), scr, r, lane, l == 0 ? nullptr : args.in[1] + DM);
            else p0_transpose_item(args.in[25] + (size_t)l * DM * DM, DM, DM, (unsigned short*)(ws + WS_WOUT + l * WOUT_L), scr, r - I_IN, lane, nullptr);
        }
        for (int i = gw; i < DEPTH * (NU - NIN) * DM * 2 / 1024; i += NGW) { const int l = i / ((NU - NIN) * DM * 2 / 1024), r = i % ((NU - NIN) * DM * 2 / 1024);
            if (l == 1 && r < 64 * DM * 2 / 1024) continue;
            *(u32x4*)(ws + WS_WIN + l * WIN_L + (size_t)NIN * DM * 2 + (size_t)r * 1024 + lane * 16) = (u32x4){0u, 0u, 0u, 0u}; }
        if (blockIdx.x < 32) {
            LAS f16* TT = (LAS f16*)(lds + 8 * 8704);
            for (int i = tid; i < 64 * RW_W; i += NT) { const int n = i / RW_W, cc = i % RW_W; const float mm = args.in[3][RW_SHIFT + C_V + cc]; TT[n * 392 + cc] = (f16)(((n < 32) ? (1.0f - mm) : mm) * args.in[9][cc * 32 + (n & 31)]); }
            __syncthreads();
            const int tile = blockIdx.x * NWAVES + wave, nt = tile & 3, kt = tile >> 2, tl = lane & 15, fq = lane >> 4;
            const float* wrow = args.in[2] + (size_t)DM * NIN + (size_t)(16 * kt + tl) * NIN + C_V + 8 * fq;
            f32x4 bv[12][2];
#pragma unroll
            for (int s2 = 0; s2 < 12; ++s2) { bv[s2][0] = *(const f32x4*)(wrow + 32 * s2); bv[s2][1] = *(const f32x4*)(wrow + 32 * s2 + 4); }
            f32x4 d = (f32x4){0.f, 0.f, 0.f, 0.f};
#pragma unroll
            for (int s2 = 0; s2 < 12; ++s2) { f16x8 bf;
#pragma unroll
                for (int j = 0; j < 8; ++j) bf[j] = (f16)(j < 4 ? bv[s2][0][j & 3] : bv[s2][1][j & 3]);
                d = __builtin_amdgcn_mfma_f32_16x16x32_f16(*(const LAS f16x8*)(TT + (16 * nt + tl) * 392 + 8 * fq + 32 * s2), bf, d, 0, 0, 0); }
            const float nwk = args.in[1][DM + 16 * kt + tl];
#pragma unroll
            for (int i = 0; i < 4; ++i) ((f16*)(ws + WS_WIN + WIN_L))[(size_t)(NIN + 16 * nt + 4 * fq + i) * DM + 16 * kt + tl] = (f16)(d[i] * nwk);
            __syncthreads();
        }
        for (int i = blockIdx.x * NT + tid; i < 2 * M; i += G * NT) ((float*)(ws + WS_RSS))[i] = 0.f;
        for (int m = gw; m < M; m += 4 * NGW) rms_row4_f16(args.in[0] + (size_t)m * DM, (size_t)NGW * DM, args.in[1], XN + (size_t)m * DM, lane);
        { f16* WUPT = (f16*)(ws + WS_WUPT); f16* AUPT = (f16*)(ws + WS_AUPT); f16* VDNT = (f16*)(ws + WS_VDNT); f16* VUPT = (f16*)(ws + WS_VUPT);
          for (int i = blockIdx.x * NT + tid; i < 122880; i += G * NT) {
              if (i < 49152) { const int ll = i / 24576, r = i % 24576, n = r / 64, k = r % 64; WUPT[i] = (f16)args.in[5][(size_t)ll * 24576 + k * 384 + n]; }
              else if (i < 98304) { const int i2 = i - 49152, ll = i2 / 24576, r = i2 % 24576, n = r / 64, k = r % 64; AUPT[i2] = (f16)args.in[7][(size_t)ll * 24576 + k * 384 + n]; }
              else if (i < 110592) { const int i2 = i - 98304, j2 = i2 / 384, cc = i2 % 384; VDNT[i2] = (f16)args.in[9][cc * 32 + j2]; }
              else { const int i2 = i - 110592, n = i2 / 32, j2 = i2 % 32; VUPT[i2] = (f16)args.in[10][j2 * 384 + n]; } }
          f16* WAT = (f16*)(ws + WS_WAT); f16* WXT = (f16*)(ws + WS_WXT);
          for (int i = blockIdx.x * NT + tid; i < 32768; i += G * NT) { const int lg = i >> 12, r = i & 4095, j = r >> 6, ii = r & 63; WAT[i] = (f16)args.in[20][(size_t)lg * 4096 + ii * 64 + j]; WXT[i] = (f16)args.in[22][(size_t)lg * 4096 + ii * 64 + j]; } }
    }
    if (gridDim.x > 65536u) grid.sync();
    GRID_BAR();
#pragma unroll 1
    for (int l = 0; l < DEPTH; ++l) {
        { pg8::Gemm g{XN, (const unsigned short*)(ws + WS_WIN + l * WIN_L), M, NU, DM}; pg8::StaticOrder S; S.init(M, NU, G, (int)blockIdx.x);
          pg8::EpiF16 E{(unsigned short*)(ws + WS_U), NU, l == 0 ? nullptr : (const float*)(ws + WS_RSS)};
          pg8::gemm_phase<pg8::EpiF16, pg8::StaticOrder, true, true>(lds, g, S, E, wave); }
        GRID_BAR();
        for (int task = blockIdx.x; task < BATCH * NCH; task += G) phaseA(args, l, task, lds, TID_NOW());
        GRID_BAR();
        phaseB1(args, lds, TID_NOW());
        GRID_BAR();
        phaseB(args, lds, TID_NOW());
        GRID_BAR();
        phaseB3(args, lds, TID_NOW());
        GRID_BAR();
        for (int task = blockIdx.x; task < BATCH * NCH; task += G) phaseC(args, l, task, lds, TID_NOW());
        GRID_BAR();
        { pg8::Gemm g{(const unsigned short*)(ws + WS_MIX), (const unsigned short*)(ws + WS_WOUT + l * WOUT_L), M, DM, DM}; pg8::StaticOrder S; S.init(M, DM, G, (int)blockIdx.x);
          if (l + 1 < DEPTH) {
              pg8::EpiRes E{args.in[0], args.out, DM, XN, (float*)(ws + WS_RSS)};
              pg8::gemm_phase<pg8::EpiRes, pg8::StaticOrder, true, true>(lds, g, S, E, wave);
              GRID_BAR();
          } else {
              pg8::EpiResNorm E{args.out, args.out, DM, (float*)(ws + WS_RSS) + M, (unsigned*)(ws + WS_PCNT), args.in[26]};
              pg8::gemm_phase<pg8::EpiResNorm, pg8::StaticOrder, true, true>(lds, g, S, E, wave);
          } }
    }
}

extern "C" void kernel_launch(void* const* d_in, const int* in_sizes, int n_in, void* d_out, int out_size, void* d_ws, size_t ws_size, hipStream_t stream) {
    static int grid = 0;
    if (grid == 0) {
        if (n_in != 27 || in_sizes[0] != M * DM || out_size != M * DM || ws_size < WS_END) { fprintf(stderr, "kernel_launch: unexpected problem: n_in %d in0 %d out %d ws %zu\n", n_in, n_in > 0 ? in_sizes[0] : -1, out_size, ws_size); grid = -1; return; }
        int dev = 0, cus = 0, per_cu = 0;
        hipGetDevice(&dev); hipDeviceGetAttribute(&cus, hipDeviceAttributeMultiprocessorCount, dev);
        if (hipFuncSetAttribute((const void*)fwd, hipFuncAttributeMaxDynamicSharedMemorySize, LDS_BYTES) != hipSuccess) { fprintf(stderr, "kernel_launch: hipFuncSetAttribute failed\n"); grid = -1; return; }
        if (hipOccupancyMaxActiveBlocksPerMultiprocessor(&per_cu, (const void*)fwd, NT, LDS_BYTES) != hipSuccess || per_cu < 1) { fprintf(stderr, "kernel_launch: occupancy query failed (%d)\n", per_cu); grid = -1; return; }
        grid = cus * per_cu;
    }
    if (grid < 0) return;
    if (hipMemsetAsync((char*)d_ws, 0, 65536, stream) != hipSuccess) { fprintf(stderr, "kernel_launch: memset of the barrier words failed\n"); return; }
    Args a{};
    for (int i = 0; i < 27; ++i) a.in[i] = (const float*)d_in[i];
    a.out = (float*)d_out; a.ws = (unsigned char*)d_ws;
    void* kargs[] = {&a};
    hipError_t e = hipLaunchCooperativeKernel((const void*)fwd, dim3(grid), dim3(NT), kargs, LDS_BYTES, stream);
    if (e != hipSuccess) fprintf(stderr, "cooperative launch failed: %s (grid %d)\n", hipGetErrorString(e), grid);
}
```

```cpp
#include <hip/hip_runtime.h>
#include <hip/hip_cooperative_groups.h>
#include <cstdio>
#include <cstdint>
namespace cg = cooperative_groups;
typedef _Float16 f16x8_t __attribute__((ext_vector_type(8)));
#define MK_MFMA(a, b, c) __builtin_amdgcn_mfma_f32_16x16x32_f16(__builtin_bit_cast(f16x8_t, (a)), __builtin_bit_cast(f16x8_t, (b)), (c), 0, 0, 0)
__device__ __forceinline__ int lane_now() { int z; asm volatile("v_mbcnt_lo_u32_b32 %0, -1, 0\n\tv_mbcnt_hi_u32_b32 %0, -1, %0" : "=v"(z)); return z; }
__device__ __forceinline__ float shfl_xor_f(float v, int mask) { const int ln = lane_now(); return __builtin_bit_cast(float, __builtin_amdgcn_ds_bpermute((ln ^ mask) << 2, __builtin_bit_cast(int, v))); }
namespace pg8 {
#define PG8_LAS __attribute__((address_space(3)))
typedef unsigned short bf16_t;
typedef short bf16x8 __attribute__((ext_vector_type(8)));
typedef float f32x4 __attribute__((ext_vector_type(4)));
typedef unsigned u32x4 __attribute__((ext_vector_type(4)));
constexpr int BM = 256, BK = 64, HALF = 128, HTB = HALF * BK * 2  , STAGE_BYTES = 8 * HTB, NXCD = 8, WGM = 8;

__host__ __device__ __forceinline__ int lds_byte(int r, int c) { const int st = (r >> 4) * 2 + (c >> 5), rr = r & 15, cc = c & 31, ob = rr * 64 + cc * 2; return st * 1024 + (ob ^ (((ob >> 9) & 1) << 5)); }
__host__ __device__ __forceinline__ void stage_rc(int b, int& R, int& C) { const int st = b / 1024, sb = b % 1024, swz = sb ^ (((sb >> 9) & 1) << 5); R = (st >> 1) * 16 + swz / 64; C = (st & 1) * 32 + (swz % 64) / 2; }
__host__ __device__ __forceinline__ int perm32(int rho) { const int n = rho >> 4, i = rho & 15; return 8 * (i >> 2) + 4 * n + (i & 3); }

struct Unit { int pm, pn; };
struct Gemm { const bf16_t* A; const bf16_t* Bt; int M, N, K; };

struct StaticOrder {
    int nM, nN, nwg, G, c;
    __host__ __device__ void init(int M, int N, int G_, int c_) { nM = M / BM; nN = N / BM; nwg = nM * nN; G = G_; c = c_; }
    __host__ __device__ bool next(int i, Unit& u) const {
        const long L = (long)i * G + c; if (L >= nwg) return false;
        int wgid = (int)L; { const int q = nwg / NXCD, r = nwg % NXCD, xcd = wgid % NXCD, off = wgid / NXCD; wgid = (xcd < r ? xcd * (q + 1) : r * (q + 1) + (xcd - r) * q) + off; }
        const int nig = WGM * nN, gid = wgid / nig, fm = gid * WGM, gsz = (nM - fm) < WGM ? (nM - fm) : WGM;
        u.pm = fm + ((wgid % nig) % gsz); u.pn = (wgid % nig) / gsz; return true;
    }
    __device__ __forceinline__ void a_ready(const Unit&) const {}
    __device__ __forceinline__ void done(const Unit&) const {}
};

__device__ __forceinline__ unsigned pk_f16(float lo, float hi) { typedef _Float16 h2 __attribute__((ext_vector_type(2))); h2 v; v.x = (_Float16)lo; v.y = (_Float16)hi; return __builtin_bit_cast(unsigned, v); }
typedef unsigned u32x2 __attribute__((ext_vector_type(2)));
struct EpiF16 {
    static constexpr bool PERM = true, AFTER_DRAIN = false;
    bf16_t* O; int ldc; const float* rss;
    __device__ __forceinline__ void operator()(const f32x4 (&acc)[2][2][4][2], const Unit& u, int wr, int wc, int fr, int fq) const {
        const int row0 = u.pm * BM + wr * 64 + fr; const int col0 = u.pn * BM + wc * 32 + 8 * fq;
#pragma unroll
        for (int ai = 0; ai < 2; ++ai)
#pragma unroll
            for (int m = 0; m < 4; ++m) { const int row = row0 + ai * HALF + m * 16; bf16_t* rowp = O + (size_t)row * ldc + col0;
                const float sc = rss ? 1.0f / sqrtf(rss[row] * (1.0f / 1024.0f) + 1e-6f) : 1.0f;
#pragma unroll
                for (int bj = 0; bj < 2; ++bj) { const f32x4 v0 = acc[ai][bj][m][0] * sc, v1 = acc[ai][bj][m][1] * sc;
                    u32x4 w; w.x = pk_f16(v0[0], v0[1]); w.y = pk_f16(v0[2], v0[3]); w.z = pk_f16(v1[0], v1[1]); w.w = pk_f16(v1[2], v1[3]);
                    *(u32x4*)(rowp + bj * HALF) = w; } }
    }
};
struct EpiRes {
    static constexpr bool PERM = false, AFTER_DRAIN = false;
    const float* base; float* out; int ldc; bf16_t* xh; float* rss;
    __device__ __forceinline__ void operator()(const f32x4 (&acc)[2][2][4][2], const Unit& u, int wr, int wc, int fr, int fq) const {
        const int row0 = u.pm * BM + wr * 64 + fr; const int col0 = u.pn * BM + wc * 32 + 4 * fq;
#pragma unroll
        for (int ai = 0; ai < 2; ++ai)
#pragma unroll
            for (int m = 0; m < 4; ++m) { const size_t off = (size_t)(row0 + ai * HALF + m * 16) * ldc + col0; float ss = 0.f;
#pragma unroll
                for (int bj = 0; bj < 2; ++bj)
#pragma unroll
                    for (int n = 0; n < 2; ++n) { const size_t o = off + bj * HALF + n * 16; const f32x4 b = *(const f32x4*)(base + o); const f32x4 x = b + acc[ai][bj][m][n]; *(f32x4*)(out + o) = x;
                        if (xh) { u32x2 h; h.x = pk_f16(x[0], x[1]); h.y = pk_f16(x[2], x[3]); *(u32x2*)(xh + o) = h; ss += (x[0] * x[0] + x[1] * x[1]) + (x[2] * x[2] + x[3] * x[3]); } }
                if (xh) { ss += shfl_xor_f(ss, 16); ss += shfl_xor_f(ss, 32); if (fq == 0) atomicAdd(rss + row0 + ai * HALF + m * 16, ss); }
                asm volatile("" ::: "memory"); }
    }
};

struct EpiResNorm {
    static constexpr bool PERM = false, AFTER_DRAIN = false;
    const float* base; float* out; int ldc; float* rss2; unsigned* cnt; const float* w;
    __device__ __forceinline__ void operator()(f32x4 (&acc)[2][2][4][2], const Unit& u, int wr, int wc, int fr, int fq) const {
        const int row0 = u.pm * BM + wr * 64 + fr; const int col0 = u.pn * BM + wc * 32 + 4 * fq;
#pragma unroll
        for (int ai = 0; ai < 2; ++ai)
#pragma unroll
            for (int m = 0; m < 4; ++m) { const size_t off = (size_t)(row0 + ai * HALF + m * 16) * ldc + col0; float ss = 0.f;
#pragma unroll
                for (int bj = 0; bj < 2; ++bj)
#pragma unroll
                    for (int n = 0; n < 2; ++n) { const size_t o = off + bj * HALF + n * 16; const f32x4 x = *(const f32x4*)(base + o) + acc[ai][bj][m][n]; acc[ai][bj][m][n] = x;
                        ss += (x[0] * x[0] + x[1] * x[1]) + (x[2] * x[2] + x[3] * x[3]); }
                ss += shfl_xor_f(ss, 16); ss += shfl_xor_f(ss, 32); if (fq == 0) atomicAdd(rss2 + row0 + ai * HALF + m * 16, ss);
                asm volatile("" ::: "memory"); }
        asm volatile("s_waitcnt vmcnt(0)" ::: "memory");
        unsigned* pc = cnt + 64 * u.pm;
        if (lane_now() == 0) __hip_atomic_fetch_add(pc, 1u, __ATOMIC_RELAXED, __HIP_MEMORY_SCOPE_AGENT);
        for (unsigned spin = 0; spin < (1u << 22); ++spin) { if ((unsigned)__builtin_amdgcn_readfirstlane((int)__hip_atomic_load(pc, __ATOMIC_RELAXED, __HIP_MEMORY_SCOPE_AGENT)) >= 32u) break; __builtin_amdgcn_s_sleep(2); }
#pragma unroll
        for (int ai = 0; ai < 2; ++ai)
#pragma unroll
            for (int m = 0; m < 4; ++m) { const int row = row0 + ai * HALF + m * 16; const size_t off = (size_t)row * ldc + col0;
                const float rs = 1.0f / sqrtf(__hip_atomic_load(rss2 + row, __ATOMIC_RELAXED, __HIP_MEMORY_SCOPE_AGENT) * (1.0f / 1024.0f) + 1e-6f);
#pragma unroll
                for (int bj = 0; bj < 2; ++bj)
#pragma unroll
                    for (int n = 0; n < 2; ++n) { const size_t o = off + bj * HALF + n * 16; const f32x4 ww = *(const f32x4*)(w + col0 + bj * HALF + n * 16); *(f32x4*)(out + o) = acc[ai][bj][m][n] * rs * ww; } }
    }
};

template <class Epi, class Sched, bool ALIGN_EPI = false, bool SP2 = false>
__device__ __forceinline__ void gemm_phase(PG8_LAS unsigned char* lds, const Gemm g, const Sched& S, const Epi& E, const int wave_) {
    int wv_ = wave_; asm volatile("" : "+s"(wv_)); int tid_ = lane_now() + 64 * wv_; const int tid = tid_, wid = wv_, lane = tid & 63, wr = wid >> 2, wc = wid & 3, fr = lane & 15, fq = lane >> 4;
    const int K = g.K, nt = K / BK;
    unsigned voffA[2], voffB[2];
#pragma unroll
    for (int i = 0; i < 2; ++i) { int R, C; stage_rc(tid * 16 + i * 8192, R, C); const int Rb = Epi::PERM ? ((R & ~31) + perm32(R & 31)) : R;
        voffA[i] = (unsigned)(R * K + C) * 2u; voffB[i] = (unsigned)(Rb * K + C) * 2u; }
    const size_t kstep = (size_t)(BK * 2);
    const size_t hstep = (size_t)HALF * K * 2;
    const size_t tstep = 2 * hstep;
    const unsigned ldsw = (unsigned)wid * 1024u;
    const int aoff = lds_byte(wr * 64 + fr, fq * 8), boff = lds_byte(wc * 32 + fr, fq * 8);
#define PG8_SA(b, h) (((b) * 2 + (h)) * HTB)
#define PG8_SB(b, h) ((4 + (b) * 2 + (h)) * HTB)
#define PG8_STAGE(bufoff, gbase, voff) do { _Pragma("unroll") for (int _i = 0; _i < 2; ++_i) \
        __builtin_amdgcn_global_load_lds((const unsigned*)((const char*)(gbase) + (voff)[_i]), (PG8_LAS unsigned*)(lds + (bufoff) + ldsw + _i * 8192), 16, 0, 0); } while (0)
#define PG8_LDA(dst, b, h) do { _Pragma("unroll") for (int m = 0; m < 4; ++m) _Pragma("unroll") for (int k = 0; k < 2; ++k) dst[m][k] = *(const PG8_LAS bf16x8*)(lds + PG8_SA(b, h) + aoff + m * 2048 + k * 1024); } while (0)
#define PG8_LDB(dst, b, h) do { _Pragma("unroll") for (int n = 0; n < 2; ++n) _Pragma("unroll") for (int k = 0; k < 2; ++k) dst[n][k] = *(const PG8_LAS bf16x8*)(lds + PG8_SB(b, h) + boff + n * 2048 + k * 1024); } while (0)
#define PG8_MMA(ai, bj, At, Bt) do { __builtin_amdgcn_s_setprio(1); _Pragma("unroll") for (int m = 0; m < 4; ++m) _Pragma("unroll") for (int n = 0; n < 2; ++n) _Pragma("unroll") for (int k = 0; k < 2; ++k) \
        acc[ai][bj][m][n] = MK_MFMA(Bt[n][k], At[m][k], acc[ai][bj][m][n]); __builtin_amdgcn_s_setprio(0); } while (0)
#define PG8_WAIT_V(n) asm volatile("s_waitcnt vmcnt(" #n ")" ::: "memory")
#define PG8_WAIT_L(n) asm volatile("s_waitcnt lgkmcnt(" #n ")" ::: "memory")
#define PG8_BAR __builtin_amdgcn_s_barrier()
#define PG8_SCHED __builtin_amdgcn_sched_barrier(0)
    Unit cur, nxt; int ui = 0;
    if (!S.next(0, cur)) return;
    f32x4 acc[2][2][4][2];
#pragma unroll
    for (int a = 0; a < 2; ++a)
#pragma unroll
        for (int b = 0; b < 2; ++b)
#pragma unroll
            for (int m = 0; m < 4; ++m)
#pragma unroll
                for (int n = 0; n < 2; ++n) acc[a][b][m][n] = (f32x4){0.f, 0.f, 0.f, 0.f};
    bf16x8 At[4][2], B0[2][2], B1[2][2];
    const char* cA = (const char*)g.A + (size_t)cur.pm * tstep; const char* cB = (const char*)g.Bt + (size_t)cur.pn * tstep;
    S.a_ready(cur);
    if constexpr (SP2) {
        PG8_STAGE(PG8_SB(0, 0), cB, voffB); PG8_STAGE(PG8_SB(0, 1), cB + hstep, voffB); PG8_STAGE(PG8_SA(0, 0), cA, voffA); PG8_STAGE(PG8_SA(0, 1), cA + hstep, voffA);
        if (wr == 1) PG8_BAR;
        PG8_WAIT_V(2); PG8_BAR;
        PG8_STAGE(PG8_SB(1, 0), cB + kstep, voffB); PG8_STAGE(PG8_SA(1, 0), cA + kstep, voffA); PG8_STAGE(PG8_SB(1, 1), cB + hstep + kstep, voffB);
        PG8_WAIT_V(6); PG8_BAR;
    } else {
        PG8_STAGE(PG8_SB(0, 0), cB, voffB); PG8_STAGE(PG8_SA(0, 0), cA, voffA); PG8_STAGE(PG8_SB(0, 1), cB + hstep, voffB); PG8_STAGE(PG8_SA(0, 1), cA + hstep, voffA);
        if (wr == 1) PG8_BAR;
        PG8_WAIT_V(4); PG8_BAR;
        PG8_STAGE(PG8_SB(1, 0), cB + kstep, voffB); PG8_STAGE(PG8_SA(1, 0), cA + kstep, voffA); PG8_STAGE(PG8_SB(1, 1), cB + hstep + kstep, voffB);
        PG8_WAIT_V(6); PG8_BAR;
    }
    for (;;) {
        const bool has_next = S.next(ui + 1, nxt);
        const char* nA = has_next ? (const char*)g.A + (size_t)nxt.pm * tstep : cA; const char* nB = has_next ? (const char*)g.Bt + (size_t)nxt.pn * tstep : cB;
        for (int t = 0; t < nt; t += 2) {
            const bool last = (t == nt - 2);
            const char* a1 = cA + (size_t)(t + 1) * kstep;
            const char* a2 = last ? nA : cA + (size_t)(t + 2) * kstep; const char* b2 = last ? nB : cB + (size_t)(t + 2) * kstep;
            const char* a3 = a2 + kstep; const char* b3 = b2 + kstep;
            if (last && has_next) S.a_ready(nxt);
            if constexpr (SP2) {
            PG8_LDB(B0, 0, 0); PG8_LDB(B1, 0, 1); PG8_SCHED; PG8_LDA(At, 0, 0); PG8_STAGE(PG8_SA(1, 1), a1 + hstep, voffA);
            PG8_WAIT_V(8); PG8_WAIT_L(0); PG8_BAR; PG8_MMA(0, 0, At, B0); PG8_MMA(0, 1, At, B1); PG8_BAR; PG8_SCHED;
            PG8_LDA(At, 0, 1); PG8_STAGE(PG8_SB(0, 0), b2, voffB); PG8_STAGE(PG8_SB(0, 1), b2 + hstep, voffB); PG8_STAGE(PG8_SA(0, 0), a2, voffA);
            PG8_WAIT_V(8); PG8_WAIT_L(0); PG8_BAR; PG8_MMA(1, 0, At, B0); PG8_MMA(1, 1, At, B1); PG8_BAR; PG8_SCHED;
            PG8_LDB(B0, 1, 0); PG8_LDB(B1, 1, 1); PG8_SCHED; PG8_LDA(At, 1, 0); PG8_STAGE(PG8_SA(0, 1), a2 + hstep, voffA);
            PG8_WAIT_V(8); PG8_WAIT_L(0); PG8_BAR; PG8_MMA(0, 0, At, B0); PG8_MMA(0, 1, At, B1); PG8_BAR; PG8_SCHED;
            PG8_LDA(At, 1, 1); PG8_STAGE(PG8_SB(1, 0), b3, voffB); PG8_STAGE(PG8_SB(1, 1), b3 + hstep, voffB); PG8_STAGE(PG8_SA(1, 0), a3, voffA);
            PG8_WAIT_V(8); PG8_WAIT_L(0); PG8_BAR; PG8_MMA(1, 0, At, B0); PG8_MMA(1, 1, At, B1); PG8_BAR; PG8_SCHED;
            } else {
            PG8_LDB(B0, 0, 0); PG8_SCHED; PG8_LDA(At, 0, 0); PG8_STAGE(PG8_SA(1, 1), a1 + hstep, voffA);
            PG8_WAIT_L(8); PG8_BAR; PG8_WAIT_L(0); PG8_MMA(0, 0, At, B0); PG8_BAR; PG8_SCHED;
            PG8_LDB(B1, 0, 1); PG8_STAGE(PG8_SB(0, 0), b2, voffB);
            PG8_BAR; PG8_WAIT_L(0); PG8_MMA(0, 1, At, B1); PG8_BAR;
            PG8_LDA(At, 0, 1); PG8_STAGE(PG8_SA(0, 0), a2, voffA);
            PG8_BAR; PG8_WAIT_L(0); PG8_MMA(1, 0, At, B0); PG8_BAR; PG8_SCHED;
            PG8_STAGE(PG8_SB(0, 1), b2 + hstep, voffB);
            PG8_WAIT_V(6); PG8_BAR; PG8_MMA(1, 1, At, B1); PG8_BAR;
            PG8_LDB(B0, 1, 0); PG8_SCHED; PG8_LDA(At, 1, 0); PG8_STAGE(PG8_SA(0, 1), a2 + hstep, voffA);
            PG8_WAIT_L(8); PG8_BAR; PG8_WAIT_L(0); PG8_MMA(0, 0, At, B0); PG8_BAR; PG8_SCHED;
            PG8_LDB(B1, 1, 1); PG8_STAGE(PG8_SB(1, 0), b3, voffB);
            PG8_BAR; PG8_WAIT_L(0); PG8_MMA(0, 1, At, B1); PG8_BAR;
            PG8_LDA(At, 1, 1); PG8_STAGE(PG8_SA(1, 0), a3, voffA);
            PG8_BAR; PG8_WAIT_L(0); PG8_MMA(1, 0, At, B0); PG8_BAR; PG8_SCHED;
            PG8_STAGE(PG8_SB(1, 1), b3 + hstep, voffB);
            PG8_WAIT_V(6); PG8_BAR; PG8_MMA(1, 1, At, B1); PG8_BAR;
            }
        }
        if constexpr (ALIGN_EPI) { if (wr == 0) PG8_BAR; }
        if constexpr (!Epi::AFTER_DRAIN) { E(acc, cur, wr, wc, fr, fq); S.done(cur); }
        if (!has_next) break;
#pragma unroll
        for (int a = 0; a < 2; ++a)
#pragma unroll
            for (int b = 0; b < 2; ++b)
#pragma unroll
                for (int m = 0; m < 4; ++m)
#pragma unroll
                    for (int n = 0; n < 2; ++n) acc[a][b][m][n] = (f32x4){0.f, 0.f, 0.f, 0.f};
        cur = nxt; cA = nA; cB = nB; ++ui;
        if constexpr (ALIGN_EPI) { if (wr == 1) PG8_BAR; }
    }
    PG8_WAIT_V(0);
    if constexpr (!ALIGN_EPI) { if (wr == 0) PG8_BAR; }
    PG8_BAR;
    if constexpr (Epi::AFTER_DRAIN) { E.fused(acc, cur, wr, wc, fr, fq, lds, wid, lane); S.done(cur); }
#undef PG8_SA
#undef PG8_SB
#undef PG8_STAGE
#undef PG8_LDA
#undef PG8_LDB
#undef PG8_MMA
#undef PG8_WAIT_V
#undef PG8_WAIT_L
#undef PG8_BAR
#undef PG8_SCHED
}
}

constexpr int BATCH = 2, SEQ = 8192, DM = 1024, DEPTH = 2, M = BATCH * SEQ;
constexpr int RW_H = 6, HD = 64, RW_W = 384, RW_SHIFT = 1280;
constexpr int NIN = 3712, NU = 3840;
constexpr int C_R = 0, C_K = 384, C_V = 768, C_WL = 1152, C_AL = 1216, C_RWZ = 1280, C_HGQ = 1664, C_HGF = 2048, C_HGI = 2432, C_HGZ = 2816, C_LRUX = 3200, C_LRUZ = 3456;
constexpr int CH = 64;
constexpr int NWAVES = 8, NT = NWAVES * 64;
constexpr int LDS_BYTES = 163840;
constexpr int PRM_OFF = 142336;
constexpr size_t MiB = 1u << 20;
constexpr size_t WS_WUPT = 65536, WS_AUPT = WS_WUPT + 98304, WS_VDNT = WS_AUPT + 98304, WS_VUPT = WS_VDNT + 24576, WS_WAT = WS_VUPT + 24576, WS_WXT = WS_WAT + 65536;
constexpr size_t WS_WIN = 1 * MiB, WIN_L = (size_t)NU * DM * 2;
constexpr size_t WS_WOUT = 16 * MiB, WOUT_L = (size_t)DM * DM * 2;
constexpr size_t WS_XN = 20 * MiB;
constexpr size_t WS_QT = 20 * MiB;
constexpr size_t WS_PT = 32 * MiB;
constexpr size_t WS_CA = 44 * MiB;
constexpr size_t WS_U = 52 * MiB;
constexpr size_t WS_MIX = 172 * MiB;
constexpr size_t WS_VF = 204 * MiB;
constexpr size_t WS_VP = 216 * MiB;
constexpr size_t WS_RL = 228 * MiB;
constexpr size_t WS_HL = 240 * MiB;
constexpr size_t WS_BON = 252 * MiB;
constexpr size_t WS_DC = WS_BON + 512 * 1024;
constexpr size_t WS_LA = WS_DC + 512 * 1024;
constexpr size_t WS_LH = WS_LA + 256 * 1024;
constexpr size_t WS_RSS = WS_LH + 256 * 1024;
constexpr size_t WS_END = 254 * MiB;
constexpr int NCH = SEQ / CH;

#define LAS __attribute__((address_space(3)))
typedef float f32x4 __attribute__((ext_vector_type(4)));
typedef unsigned u32x2 __attribute__((ext_vector_type(2)));
typedef unsigned u32x4 __attribute__((ext_vector_type(4)));
typedef _Float16 f16;
typedef _Float16 f16x8 __attribute__((ext_vector_type(8)));
#define LDS_WAIT() asm volatile("s_waitcnt lgkmcnt(0)" ::: "memory")

struct Args { const float* in[27]; float* out; unsigned char* ws; };

__device__ __forceinline__ float wave_sum(float v) {
#pragma unroll
    for (int o = 1; o < 64; o <<= 1) v += shfl_xor_f(v, o);
    return v;
}
__device__ __forceinline__ float sigmoidf_(float x) { return __builtin_amdgcn_rcpf(1.0f + __expf(-x)); }
__device__ __forceinline__ float rsq_(float x) { return __builtin_amdgcn_rsqf(x); }
__device__ __forceinline__ float one_minus_exp_(float x) { return (x > -0.03f) ? -x * (1.0f + x * (0.5f + x * (1.0f / 6.0f + x * (1.0f / 24.0f)))) : 1.0f - __expf(x); }
__device__ __forceinline__ float siluf_(float x) { return x * __builtin_amdgcn_rcpf(1.0f + __expf(-x)); }

__device__ __forceinline__ void p0_transpose_item(const float* W, int K, int N, unsigned short* WT, LAS float* scr, int item, int lane, const float* rsc) {
    const int nblk = N / 32, kb = item / nblk, nb = item % nblk, k0 = 64 * kb, n0 = 32 * nb;
    float tv[32];
#pragma unroll
    for (int i = 0; i < 32; ++i) { const int kk = 2 * i + (lane >> 5); tv[i] = W[(size_t)(k0 + kk) * N + n0 + (lane & 31)]; }
#pragma unroll
    for (int i = 0; i < 32; ++i) { const int kk = 2 * i + (lane >> 5); scr[kk * 33 + (lane & 31)] = tv[i] * (rsc ? rsc[k0 + kk] : 1.0f); }
    LDS_WAIT(); asm volatile("" ::: "memory");
    const int c = lane & 7;
#pragma unroll
    for (int j = 0; j < 4; ++j) { const int n = (lane >> 3) + 8 * j; const LAS float* s = scr + (8 * c) * 33 + n;
        u32x4 o; o.x = pg8::pk_f16(s[0 * 33], s[1 * 33]); o.y = pg8::pk_f16(s[2 * 33], s[3 * 33]); o.z = pg8::pk_f16(s[4 * 33], s[5 * 33]); o.w = pg8::pk_f16(s[6 * 33], s[7 * 33]);
        *(u32x4*)(WT + (size_t)(n0 + n) * K + k0 + 8 * c) = o; }
    LDS_WAIT(); asm volatile("" ::: "memory");
}
__device__ __forceinline__ void rms_row_f16(const float* xrow, const float* w, unsigned short* orow, int lane) {
    const f32x4* xr = (const f32x4*)xrow + lane; const f32x4* wr = (const f32x4*)w + lane;
    f32x4 v[4]; float s = 0.f;
#pragma unroll
    for (int j = 0; j < 4; ++j) { v[j] = xr[64 * j]; s += (v[j].x * v[j].x + v[j].y * v[j].y) + (v[j].z * v[j].z + v[j].w * v[j].w); }
    const float rs = 1.0f / sqrtf(wave_sum(s) * (1.0f / DM) + 1e-6f);
    u32x2* o8 = (u32x2*)orow + lane;
#pragma unroll
    for (int j = 0; j < 4; ++j) { const f32x4 ww = wr[64 * j]; u32x2 o; o.x = pg8::pk_f16(v[j].x * rs * ww.x, v[j].y * rs * ww.y); o.y = pg8::pk_f16(v[j].z * rs * ww.z, v[j].w * rs * ww.w); o8[64 * j] = o; }
}
__device__ __forceinline__ void rms_row_f32(float* xrow, const float* w, int lane) {
    f32x4* xr = (f32x4*)xrow + lane; const f32x4* wr = (const f32x4*)w + lane;
    f32x4 v[4]; float s = 0.f;
#pragma unroll
    for (int j = 0; j < 4; ++j) { v[j] = xr[64 * j]; s += (v[j].x * v[j].x + v[j].y * v[j].y) + (v[j].z * v[j].z + v[j].w * v[j].w); }
    const float rs = 1.0f / sqrtf(wave_sum(s) * (1.0f / DM) + 1e-6f);
#pragma unroll
    for (int j = 0; j < 4; ++j) { const f32x4 ww = wr[64 * j]; xr[64 * j] = v[j] * rs * ww; }
}

__device__ __forceinline__ void rms_row2_f32(float* xa, float* xb, const float* w, int lane) {
    f32x4* ra = (f32x4*)xa + lane; f32x4* rb = (f32x4*)xb + lane; const f32x4* wr = (const f32x4*)w + lane;
    f32x4 va[4], vb[4]; float sa = 0.f, sb = 0.f;
#pragma unroll
    for (int j = 0; j < 4; ++j) { va[j] = ra[64 * j]; vb[j] = rb[64 * j]; }
#pragma unroll
    for (int j = 0; j < 4; ++j) { sa += (va[j].x * va[j].x + va[j].y * va[j].y) + (va[j].z * va[j].z + va[j].w * va[j].w); sb += (vb[j].x * vb[j].x + vb[j].y * vb[j].y) + (vb[j].z * vb[j].z + vb[j].w * vb[j].w); }
    const float rsa = 1.0f / sqrtf(wave_sum(sa) * (1.0f / DM) + 1e-6f), rsb = 1.0f / sqrtf(wave_sum(sb) * (1.0f / DM) + 1e-6f);
#pragma unroll
    for (int j = 0; j < 4; ++j) { const f32x4 ww = wr[64 * j]; ra[64 * j] = va[j] * rsa * ww; rb[64 * j] = vb[j] * rsb * ww; }
}
__device__ __forceinline__ void rms_row4_f16(const float* x0, size_t rs, const float* w, unsigned short* o0, int lane) {
    f32x4 v[4][4]; float s[4];
#pragma unroll
    for (int r = 0; r < 4; ++r)
#pragma unroll
        for (int j = 0; j < 4; ++j) v[r][j] = ((const f32x4*)(x0 + r * rs) + lane)[64 * j];
    const f32x4* wr = (const f32x4*)w + lane;
#pragma unroll
    for (int r = 0; r < 4; ++r) { float a = 0.f;
#pragma unroll
        for (int j = 0; j < 4; ++j) a += (v[r][j].x * v[r][j].x + v[r][j].y * v[r][j].y) + (v[r][j].z * v[r][j].z + v[r][j].w * v[r][j].w);
        s[r] = 1.0f / sqrtf(wave_sum(a) * (1.0f / DM) + 1e-6f); }
#pragma unroll
    for (int j = 0; j < 4; ++j) { const f32x4 ww = wr[64 * j];
#pragma unroll
        for (int r = 0; r < 4; ++r) { u32x2 o; o.x = pg8::pk_f16(v[r][j].x * s[r] * ww.x, v[r][j].y * s[r] * ww.y); o.y = pg8::pk_f16(v[r][j].z * s[r] * ww.z, v[r][j].w * s[r] * ww.w); ((u32x2*)(o0 + r * rs) + lane)[64 * j] = o; } }
}
__device__ __forceinline__ void rms_row4_f32(float* x0, size_t rs, const float* w, int lane) {
    f32x4 v[4][4]; float s[4];
#pragma unroll
    for (int r = 0; r < 4; ++r)
#pragma unroll
        for (int j = 0; j < 4; ++j) v[r][j] = ((const f32x4*)(x0 + r * rs) + lane)[64 * j];
    const f32x4* wr = (const f32x4*)w + lane;
#pragma unroll
    for (int r = 0; r < 4; ++r) { float a = 0.f;
#pragma unroll
        for (int j = 0; j < 4; ++j) a += (v[r][j].x * v[r][j].x + v[r][j].y * v[r][j].y) + (v[r][j].z * v[r][j].z + v[r][j].w * v[r][j].w);
        s[r] = rsq_(wave_sum(a) * (1.0f / DM) + 1e-6f); }
#pragma unroll
    for (int j = 0; j < 4; ++j) { const f32x4 ww = wr[64 * j];
#pragma unroll
        for (int r = 0; r < 4; ++r) ((f32x4*)(x0 + r * rs) + lane)[64 * j] = v[r][j] * s[r] * ww; }
}

#define SHV(col) ({ const float cur_ = (float)urow[(col)]; const float prev_ = hp ? (float)prow[(col)] : 0.f; cur_ + mu[(col)] * (prev_ - cur_); })

__device__ __forceinline__ void store_row64_f16(f16* dst, const float (&S)[64]) {
#pragma unroll
    for (int q = 0; q < 8; ++q) { u32x4 w; w.x = pg8::pk_f16(S[8 * q], S[8 * q + 1]); w.y = pg8::pk_f16(S[8 * q + 2], S[8 * q + 3]); w.z = pg8::pk_f16(S[8 * q + 4], S[8 * q + 5]); w.w = pg8::pk_f16(S[8 * q + 6], S[8 * q + 7]); *(u32x4*)(dst + 8 * q) = w; }
}


constexpr int RWT_ROW = 144, RWT_A = 0, RWT_R = 2304, RWT_B = 4608, RWT_K = 6912;
constexpr int RWC_B = 9216, RWC_K = 11264, RWC_V = 13312;
constexpr int RWF_G16 = 15360, RWF_RHO = 15616, RWA_INV = 15872, RWA_BYTES = 18944;
constexpr int C_VD0 = 3712, C_VD1 = 3744;
constexpr int PRM_MU = 0, PRM_A0 = 1280, PRM_KK = 1664, PRM_KA = 2048, PRM_RK = 2432, PRM_V0 = 2816, PRM_HALVES = 3200, PRM_W0_BYTE = 6400, PRM_BYTES = PRM_W0_BYTE + 1536;
typedef float f32x2 __attribute__((ext_vector_type(2)));
typedef _Float16 f16x4 __attribute__((ext_vector_type(4)));
__device__ __forceinline__ float fmix_lo(float a, unsigned b, float c) { float d; asm("v_fma_mix_f32 %0, %1, %2, %3 op_sel:[0,0,0] op_sel_hi:[0,1,0]" : "=v"(d) : "v"(a), "v"(b), "v"(c)); return d; }
__device__ __forceinline__ float fmix_hi(float a, unsigned b, float c) { float d; asm("v_fma_mix_f32 %0, %1, %2, %3 op_sel:[0,1,0] op_sel_hi:[0,1,0]" : "=v"(d) : "v"(a), "v"(b), "v"(c)); return d; }
__device__ __forceinline__ float mmix_lo(float a, unsigned b) { float d; asm("v_fma_mix_f32 %0, %1, %2, 0 op_sel:[0,0,0] op_sel_hi:[0,1,0]" : "=v"(d) : "v"(a), "v"(b)); return d; }
__device__ __forceinline__ float mmix_hi(float a, unsigned b) { float d; asm("v_fma_mix_f32 %0, %1, %2, 0 op_sel:[0,1,0] op_sel_hi:[0,1,0]" : "=v"(d) : "v"(a), "v"(b)); return d; }
__device__ __forceinline__ float mul_asm(float a, float b) { float d; asm("v_mul_f32 %0, %1, %2" : "=v"(d) : "v"(a), "v"(b)); return d; }
__device__ __forceinline__ float fma_asm(float a, float b, float c) { float d; asm("v_fma_f32 %0, %1, %2, %3" : "=v"(d) : "v"(a), "v"(b), "v"(c)); return d; }
#define FMIX(a, u, j, c) (((j) & 1) ? fmix_hi((a), (u)[(j) >> 1], (c)) : fmix_lo((a), (u)[(j) >> 1], (c)))
#define MMIX(a, u, j) (((j) & 1) ? mmix_hi((a), (u)[(j) >> 1]) : mmix_lo((a), (u)[(j) >> 1]))
__device__ __forceinline__ float fast_tanh(float x) { return 1.0f - 2.0f * __builtin_amdgcn_rcpf(__expf(2.0f * x) + 1.0f); }
__device__ __forceinline__ void lerp8(const char* ub, unsigned uo, unsigned po, bool hp, const char* mub, unsigned col, float (&x)[8]) {
    const f16x8 cu = *(const f16x8*)(ub + (uo + col * 2u)); f16x8 pv = *(const f16x8*)(ub + (po + col * 2u)); const f32x4 m0 = *(const f32x4*)(mub + col * 4u), m1 = *(const f32x4*)(mub + col * 4u + 16u);
#pragma unroll
    for (int j = 0; j < 8; ++j) { const float c = (float)cu[j], p = hp ? (float)pv[j] : 0.f; x[j] = c + (j < 4 ? m0[j] : m1[j - 4]) * (p - c); }
}
__device__ __forceinline__ void lerp4(const char* ub, unsigned uo, unsigned po, bool hp, const char* mub, unsigned col, float (&x)[4]) {
    const f16x4 cu = *(const f16x4*)(ub + (uo + col * 2u)); f16x4 pv = *(const f16x4*)(ub + (po + col * 2u)); const f32x4 m0 = *(const f32x4*)(mub + col * 4u);
#pragma unroll
    for (int j = 0; j < 4; ++j) { const float c = (float)cu[j], p = hp ? (float)pv[j] : 0.f; x[j] = c + m0[j] * (p - c); }
}
__device__ __forceinline__ f16x8 pack8(const float (&x)[8]) { f16x8 r;
#pragma unroll
    for (int j = 0; j < 8; ++j) r[j] = (f16)x[j];
    return r; }

template <int CTRL> __device__ __forceinline__ float dpp_f(float x) { return __builtin_bit_cast(float, __builtin_amdgcn_update_dpp(0, __builtin_bit_cast(int, x), CTRL, 0xF, 0xF, true)); }
__device__ __forceinline__ float row_prefix16(float x) { x += dpp_f<0x111>(x); x += dpp_f<0x112>(x); x += dpp_f<0x114>(x); x += dpp_f<0x118>(x); return x; }
__device__ __forceinline__ float bperm_f(int byteaddr, float x) { return __builtin_bit_cast(float, __builtin_amdgcn_ds_bpermute(byteaddr, __builtin_bit_cast(int, x))); }
__device__ __forceinline__ f16x4 cvt4(const f32x4 v) { f16x4 r; r[0] = (f16)v[0]; r[1] = (f16)v[1]; r[2] = (f16)v[2]; r[3] = (f16)v[3]; return r; }
#define MF16(A, B, C) __builtin_amdgcn_mfma_f32_16x16x16f16((A), (B), (C), 0, 0, 0)
#define MF32(A, B, C) __builtin_amdgcn_mfma_f32_16x16x32_f16((A), (B), (C), 0, 0, 0)

__device__ __forceinline__ void rwkv_waveA(const Args& a, int l, int b, int c, int h, LAS unsigned char* wl, const LAS unsigned char* prmb, int lane) {
    const LAS f16* prm = (const LAS f16*)prmb; const LAS float* prw0 = (const LAS float*)(prmb + PRM_W0_BYTE);
    const char* Ub = (const char*)(a.ws + WS_U); f16* MIX = (f16*)(a.ws + WS_MIX); char* VF = (char*)(a.ws + WS_VF); char* VP = (char*)(a.ws + WS_VP);
    f16* QT = (f16*)(a.ws + WS_QT); f16* PT = (f16*)(a.ws + WS_PT); f16* RL = (f16*)(a.ws + WS_RL); float* BONG = (float*)(a.ws + WS_BON);
    const char* WUPT = (const char*)(a.ws + WS_WUPT) + (size_t)l * 384 * 64 * 2; const char* AUPT = (const char*)(a.ws + WS_AUPT) + (size_t)l * 384 * 64 * 2;
    const char* VUPT = (const char*)(a.ws + WS_VUPT);
    const int bh = b * RW_H + h;
    f32x4 XT[4][8];
#pragma unroll
    for (int ct = 0; ct < 4; ++ct)
#pragma unroll
        for (int vt = 0; vt < 8; ++vt)
#pragma unroll
            for (int r = 0; r < 4; ++r) XT[ct][vt][r] = (vt == ct && (lane & 15) == 4 * (lane >> 4) + r) ? 1.f : 0.f;
#pragma unroll 1
    for (int blk = 0; blk < 4; ++blk) {
        const int lane_ = lane_now();
        const int tok = lane_ & 15, fq = lane_ >> 4;
        const int t = c * CH + blk * 16 + tok; const unsigned m = (unsigned)(b * SEQ + t); const bool hp = t > 0;
        const unsigned uo = m * (unsigned)(NU * 2), po = hp ? uo - (unsigned)(NU * 2) : uo;
        f16x8 cW[2], pW[2], cA[2], pA[2], vd0, vd1;
#pragma unroll
        for (int s = 0; s < 2; ++s) { const unsigned cw = (unsigned)(C_WL + 8 * fq + 32 * s) * 2u, ca = (unsigned)(C_AL + 8 * fq + 32 * s) * 2u;
            cW[s] = *(const f16x8*)(Ub + uo + cw); pW[s] = *(const f16x8*)(Ub + po + cw); cA[s] = *(const f16x8*)(Ub + uo + ca); pA[s] = *(const f16x8*)(Ub + po + ca); }
        vd0 = *(const f16x8*)(Ub + uo + (unsigned)(C_VD0 + 8 * fq) * 2u); vd1 = *(const f16x8*)(Ub + po + (unsigned)(C_VD1 + 8 * fq) * 2u);
#define RW_TLOAD(X, nt) f16x8 X##wu0, X##wu1, X##au0, X##au1, X##vu; f16x4 X##cr, X##pr, X##ck, X##pk, X##cv, X##pv, X##vf; { \
            const unsigned n_ = (unsigned)(h * 64 + 16 * (nt) + tok), cb_ = (unsigned)(h * 64 + 16 * (nt) + 4 * fq); \
            X##wu0 = *(const f16x8*)(WUPT + (n_ * 64u + 8u * fq) * 2u); X##wu1 = *(const f16x8*)(WUPT + (n_ * 64u + 8u * fq + 32u) * 2u); \
            X##au0 = *(const f16x8*)(AUPT + (n_ * 64u + 8u * fq) * 2u); X##au1 = *(const f16x8*)(AUPT + (n_ * 64u + 8u * fq + 32u) * 2u); \
            if (l > 0) { X##vu = *(const f16x8*)(VUPT + (n_ * 32u + 8u * fq) * 2u); X##vf = *(const f16x4*)(VF + (m * (unsigned)RW_W + cb_) * 2u); } \
            X##cr = *(const f16x4*)(Ub + uo + ((unsigned)C_R + cb_) * 2u); X##pr = *(const f16x4*)(Ub + po + ((unsigned)C_R + cb_) * 2u); \
            X##ck = *(const f16x4*)(Ub + uo + ((unsigned)C_K + cb_) * 2u); X##pk = *(const f16x4*)(Ub + po + ((unsigned)C_K + cb_) * 2u); \
            X##cv = *(const f16x4*)(Ub + uo + ((unsigned)C_V + cb_) * 2u); X##pv = *(const f16x4*)(Ub + po + ((unsigned)C_V + cb_) * 2u); }
        f16x8 bW[2], bA[2], bVD;
#pragma unroll
        for (int s = 0; s < 2; ++s) { float xw[8], xa[8];
            const f16x8 mw = *(const LAS f16x8*)(prm + PRM_MU + C_WL + 8 * fq + 32 * s), ma = *(const LAS f16x8*)(prm + PRM_MU + C_AL + 8 * fq + 32 * s);
#pragma unroll
            for (int j = 0; j < 8; ++j) { const float cw_ = (float)cW[s][j], pw_ = hp ? (float)pW[s][j] : 0.f, ca_ = (float)cA[s][j], pa_ = hp ? (float)pA[s][j] : 0.f;
                xw[j] = fast_tanh(cw_ + (float)mw[j] * (pw_ - cw_)); xa[j] = ca_ + (float)ma[j] * (pa_ - ca_); }
            bW[s] = pack8(xw); bA[s] = pack8(xa); }
        { float xv[8];
#pragma unroll
            for (int j = 0; j < 8; ++j) xv[j] = (float)vd0[j] + (hp ? (float)vd1[j] : 0.f);
            bVD = pack8(xv); }
        float ssq = 0.f, bon = 0.f;
        const int bp7 = ((lane_ & 48) | 7) << 2, bp15 = ((lane_ & 48) | 15) << 2;
#define RW_TCOMP(X, nt) { const int cb = h * 64 + 16 * (nt) + 4 * fq, co = 16 * (nt) + 4 * fq; \
            f32x4 DWn = (f32x4){0.f, 0.f, 0.f, 0.f}, DAn = DWn, Gn = DWn; \
            DWn = __builtin_amdgcn_mfma_f32_16x16x32_f16(X##wu0, bW[0], DWn, 0, 0, 0); DWn = __builtin_amdgcn_mfma_f32_16x16x32_f16(X##wu1, bW[1], DWn, 0, 0, 0); \
            DAn = __builtin_amdgcn_mfma_f32_16x16x32_f16(X##au0, bA[0], DAn, 0, 0, 0); DAn = __builtin_amdgcn_mfma_f32_16x16x32_f16(X##au1, bA[1], DAn, 0, 0, 0); \
            if (l > 0) Gn = __builtin_amdgcn_mfma_f32_16x16x32_f16(X##vu, bVD, Gn, 0, 0, 0); \
            f16x4 ah, rh, bh, kh, bb, kb, vo; f32x4 rho4, g164; \
            _Pragma("unroll") for (int i = 0; i < 4; ++i) { const LAS f16* pc = prm + cb + i; \
                const float cr_ = (float)X##cr[i], ck_ = (float)X##ck[i], cv_ = (float)X##cv[i]; \
                const float rs = cr_ + (float)pc[PRM_MU + C_R] * ((hp ? (float)X##pr[i] : 0.f) - cr_), ks = ck_ + (float)pc[PRM_MU + C_K] * ((hp ? (float)X##pk[i] : 0.f) - ck_), vs = cv_ + (float)pc[PRM_MU + C_V] * ((hp ? (float)X##pv[i] : 0.f) - cv_); \
                const float g2 = -0.875036877f * sigmoidf_(prw0[cb + i] + DWn[i]);                   \
                const float Gi = row_prefix16(g2), G8 = bperm_f(bp7, Gi), G16 = bperm_f(bp15, Gi); \
                const float e1 = __builtin_amdgcn_exp2f(Gi - G8), e1m = __builtin_amdgcn_exp2f((Gi - g2) - G8), einv = __builtin_amdgcn_exp2f(G8 - Gi), esuf = __builtin_amdgcn_exp2f(G16 - Gi); \
                rho4[i] = __builtin_amdgcn_exp2f(G8); g164[i] = __builtin_amdgcn_exp2f(G16); \
                const float aa = sigmoidf_((float)pc[PRM_A0] + DAn[i]); \
                float vv = vs; if (l > 0) vv = vs + ((float)X##vf[i] - vs) * sigmoidf_((float)pc[PRM_V0] + Gn[i]); \
                const float kk = ks * (float)pc[PRM_KK]; ssq += kk * kk; \
                const float kmod = ks * (1.0f + (aa - 1.0f) * (float)pc[PRM_KA]); \
                bon += rs * kmod * (float)pc[PRM_RK]; \
                const float bq = kk * aa; \
                ah[i] = (f16)(-kk * e1m); rh[i] = (f16)(rs * e1); bh[i] = (f16)(bq * einv); kh[i] = (f16)(kmod * einv); bb[i] = (f16)(bq * esuf); kb[i] = (f16)(kmod * esuf); vo[i] = (f16)vv; \
                asm volatile("" ::: "memory"); } \
            *(LAS f16x4*)(wl + RWT_A + tok * RWT_ROW + co * 2) = ah; *(LAS f16x4*)(wl + RWT_R + tok * RWT_ROW + co * 2) = rh; \
            *(LAS f16x4*)(wl + RWT_B + tok * RWT_ROW + co * 2) = bh; *(LAS f16x4*)(wl + RWT_K + tok * RWT_ROW + co * 2) = kh; \
            _Pragma("unroll") for (int i = 0; i < 4; ++i) { *(LAS f16*)(wl + RWC_B + (co + i) * 32 + tok * 2) = bb[i]; *(LAS f16*)(wl + RWC_K + (co + i) * 32 + tok * 2) = kb[i]; *(LAS f16*)(wl + RWC_V + (co + i) * 32 + tok * 2) = vo[i]; } \
            if (tok == 0) { *(LAS f32x4*)(wl + RWF_RHO + co * 4) = rho4; *(LAS f32x4*)(wl + RWF_G16 + co * 4) = g164; } \
            *(f16x4*)(VP + (m * (unsigned)RW_W + (unsigned)cb) * 2u) = vo; \
            if (l == 0) *(f16x4*)(VF + (m * (unsigned)RW_W + (unsigned)cb) * 2u) = vo; }
#pragma unroll 1
        for (int nt = 0; nt < 4; ++nt) { RW_TLOAD(T0, nt) RW_TCOMP(T0, nt) asm volatile("" ::: "memory"); }
#undef RW_TLOAD
#undef RW_TCOMP
        ssq += shfl_xor_f(ssq, 16); ssq += shfl_xor_f(ssq, 32);
        bon += shfl_xor_f(bon, 16); bon += shfl_xor_f(bon, 32);
        { const float inv2v = __builtin_amdgcn_rcpf(fmaxf(ssq, 1e-24f));
          if (fq == 0) { *(LAS float*)(wl + RWA_INV + tok * 4) = inv2v; *(float*)((char*)BONG + (m * 8u + (unsigned)h) * 4u) = bon; } }
        const unsigned mb = (unsigned)(b * SEQ + c * CH + blk * 16);
        const int q4 = fq * 4;
        f16x4 N1, N1T, MkH, NbH, NkH;
        { f16x8 fa[2], fr[2], fb[2], fk[2];
#pragma unroll
          for (int s = 0; s < 2; ++s) { const int o = tok * RWT_ROW + (32 * s + q4) * 2;
#define RW_FRAG(F, T) { const f16x4 lo_ = *(const LAS f16x4*)(wl + (T) + o), hi_ = *(const LAS f16x4*)(wl + (T) + o + 32); F[s] = (f16x8){lo_[0], lo_[1], lo_[2], lo_[3], hi_[0], hi_[1], hi_[2], hi_[3]}; }
              RW_FRAG(fa, RWT_A) RW_FRAG(fr, RWT_R) RW_FRAG(fb, RWT_B) RW_FRAG(fk, RWT_K)
#undef RW_FRAG
          }
          const f32x4 z4 = (f32x4){0.f, 0.f, 0.f, 0.f};
          f32x4 Mb = MF32(fb[1], fa[1], MF32(fb[0], fa[0], z4)), MbT = MF32(fa[1], fb[1], MF32(fa[0], fb[0], z4));
          f32x4 Mk = MF32(fk[1], fa[1], MF32(fk[0], fa[0], z4)), Nb = MF32(fb[1], fr[1], MF32(fb[0], fr[0], z4)), Nk = MF32(fk[1], fr[1], MF32(fk[0], fr[0], z4));
          const f32x4 ivr = *(const LAS f32x4*)(wl + RWA_INV + q4 * 4); const float ivc = *(const LAS float*)(wl + RWA_INV + tok * 4);
#pragma unroll
          for (int r = 0; r < 4; ++r) { const int j = q4 + r;
              Mb[r] = (j < tok) ? Mb[r] * ivr[r] : 0.f; MbT[r] = (tok < j) ? MbT[r] * ivc : 0.f; Mk[r] = (j < tok) ? Mk[r] : 0.f; Nb[r] = (j <= tok) ? Nb[r] : 0.f; Nk[r] = (j <= tok) ? Nk[r] : 0.f; }
          N1 = cvt4(Mb); N1T = cvt4(MbT); MkH = cvt4(Mk); NbH = cvt4(Nb); NkH = cvt4(Nk); }
        const f16x4 N2 = cvt4(MF16(N1T, N1, ((f32x4){0.f, 0.f, 0.f, 0.f}))), N2T = cvt4(MF16(N1, N1T, ((f32x4){0.f, 0.f, 0.f, 0.f})));
        const f16x4 N4 = cvt4(MF16(N2T, N2, ((f32x4){0.f, 0.f, 0.f, 0.f}))), N4T = cvt4(MF16(N2, N2T, ((f32x4){0.f, 0.f, 0.f, 0.f})));
        const f16x4 N8 = cvt4(MF16(N4T, N4, ((f32x4){0.f, 0.f, 0.f, 0.f})));
#pragma unroll
        for (int hq = 0; hq < 4; ++hq) {
            constexpr int NTQ = 2; const int hv = hq >> 1;
            asm volatile("" ::: "memory");
            const f32x4 ivr2 = *(const LAS f32x4*)(wl + RWA_INV + q4 * 4);
            f32x4 G[NTQ], Y[NTQ]; f16x4 vf[NTQ];
            { f16x8 fa[2], fr[2];
#pragma unroll
              for (int s = 0; s < 2; ++s) { const int o = tok * RWT_ROW + (32 * s + q4) * 2;
#define RW_FRAG(F, T) { const f16x4 lo_ = *(const LAS f16x4*)(wl + (T) + o), hi_ = *(const LAS f16x4*)(wl + (T) + o + 32); F[s] = (f16x8){lo_[0], lo_[1], lo_[2], lo_[3], hi_[0], hi_[1], hi_[2], hi_[3]}; }
                  RW_FRAG(fa, RWT_A) RW_FRAG(fr, RWT_R)
#undef RW_FRAG
              }
#pragma unroll
              for (int t = 0; t < NTQ; ++t) { const int vt = 2 * hq + t; f16x8 xb[2];
#pragma unroll
                for (int s = 0; s < 2; ++s) { const f32x4 r0 = *(const LAS f32x4*)(wl + RWF_RHO + (32 * s + q4) * 4), r1 = *(const LAS f32x4*)(wl + RWF_RHO + (32 * s + 16 + q4) * 4);
                    const f32x4 x0 = XT[2 * s][vt] * r0, x1 = XT[2 * s + 1][vt] * r1;
                    xb[s] = (f16x8){(f16)x0[0], (f16)x0[1], (f16)x0[2], (f16)x0[3], (f16)x1[0], (f16)x1[1], (f16)x1[2], (f16)x1[3]}; }
                G[t] = MF32(fa[1], xb[1], MF32(fa[0], xb[0], ((f32x4){0.f, 0.f, 0.f, 0.f})));
                Y[t] = MF32(fr[1], xb[1], MF32(fr[0], xb[0], ((f32x4){0.f, 0.f, 0.f, 0.f})));
                if (hv) { vf[t] = *(const LAS f16x4*)(wl + RWC_V + (16 * (vt - 4) + tok) * 32 + q4 * 2); G[t] = MF16(MkH, vf[t], G[t]); } } }
#pragma unroll
            for (int t = 0; t < NTQ; ++t) G[t] = MF16(N1, cvt4(G[t]), G[t]);
#pragma unroll
            for (int t = 0; t < NTQ; ++t) G[t] = MF16(N2, cvt4(G[t]), G[t]);
#pragma unroll
            for (int t = 0; t < NTQ; ++t) G[t] = MF16(N4, cvt4(G[t]), G[t]);
#pragma unroll
            for (int t = 0; t < NTQ; ++t) G[t] = MF16(N8, cvt4(G[t]), G[t]);
#pragma unroll
            for (int t = 0; t < NTQ; ++t) { const int vt = 2 * hq + t; const int tc = vt & 3;
                const f16x4 uh = cvt4(G[t] * ivr2);
                Y[t] = MF16(NbH, uh, Y[t]); if (hv) Y[t] = MF16(NkH, vf[t], Y[t]);
                char* yo = hv ? (char*)MIX + ((mb + (unsigned)q4) * (unsigned)DM + (unsigned)(h * 64 + 16 * tc + tok)) * 2u : (char*)QT + ((mb + (unsigned)q4) * (unsigned)RW_W + (unsigned)(h * 64 + 16 * tc + tok)) * 2u;
#pragma unroll
                for (int r = 0; r < 4; ++r) *(f16*)(yo + (unsigned)r * (hv ? (unsigned)(DM * 2) : (unsigned)(RW_W * 2))) = (f16)Y[t][r];
#pragma unroll
                for (int ct = 0; ct < 4; ++ct) { const f32x4 g16 = *(const LAS f32x4*)(wl + RWF_G16 + (16 * ct + q4) * 4);
                    const f16x4 bt = *(const LAS f16x4*)(wl + RWC_B + (16 * ct + tok) * 32 + q4 * 2);
                    f32x4 xn = MF16(bt, uh, XT[ct][vt] * g16);
                    if (hv) { const f16x4 kt = *(const LAS f16x4*)(wl + RWC_K + (16 * ct + tok) * 32 + q4 * 2); xn = MF16(kt, vf[t], xn); }
                    XT[ct][vt] = xn; } }
        }
        asm volatile("" ::: "memory");
    }
    { const int lane2 = lane_now(); const int n2 = lane2 & 15, q2 = (lane2 >> 4) * 4;
      f16* rl = RL + ((size_t)bh * NCH + c) * 4096;
      f16* pt = PT + ((size_t)bh * NCH + c) * 4096;
#pragma unroll
      for (int ct = 0; ct < 4; ++ct)
#pragma unroll
          for (int t = 0; t < 4; ++t) { *(f16x4*)(rl + (16 * t + n2) * 64 + 16 * ct + q2) = cvt4(XT[ct][4 + t]);
#pragma unroll
              for (int r = 0; r < 4; ++r) pt[(16 * ct + q2 + r) * 64 + 16 * t + n2] = (f16)XT[ct][t][r]; } }
}

constexpr int HGA_REC = 768, HGA_TB = 8  , HGA_V = HGA_TB * HGA_REC, HGA_HEAD = HGA_V + HGA_TB * 128, HGA_BYTES = 2 * HGA_HEAD;
template <int NH>
__device__ __forceinline__ void hgrn_waveA(const Args& a, int l, int b, int c, int h0, LAS unsigned char* wl) {
    char* U = (char*)(a.ws + WS_U); char* MIX = (char*)(a.ws + WS_MIX); f16* HL = (f16*)(a.ws + WS_HL); float* DC = (float*)(a.ws + WS_DC);
    const float* lbr = a.in[16];
    float S[NH][64]; float dpr[NH];
#pragma unroll
    for (int j = 0; j < NH; ++j) { dpr[j] = 1.f;
#pragma unroll
        for (int k = 0; k < 64; ++k) S[j][k] = 0.f; }
#pragma unroll 1
    for (int blk = 0; blk < CH / HGA_TB; ++blk) {
        const int lane_ = lane_now();
        const unsigned mb = (unsigned)(b * SEQ + c * CH + blk * HGA_TB);
        {
            f16 fr[NH][HGA_TB], qr[NH][HGA_TB], vr[NH][HGA_TB];
#pragma unroll
            for (int j = 0; j < NH; ++j)
#pragma unroll
                for (int tk = 0; tk < HGA_TB; ++tk) { const char* ur = U + (mb + tk) * (unsigned)(NU * 2) + (unsigned)((h0 + j) * 64 + lane_) * 2u; fr[j][tk] = *(const f16*)(ur + C_HGF * 2); qr[j][tk] = *(const f16*)(ur + C_HGQ * 2); vr[j][tk] = *(const f16*)(ur + C_HGI * 2); }
#pragma unroll
            for (int j = 0; j < NH; ++j) { const int col = (h0 + j) * 64 + lane_;
                const float lb = (l == 0) ? 0.f : sigmoidf_(lbr[384 + col] - lbr[col]);
                float dp = dpr[j];
#pragma unroll
                for (int tk = 0; tk < HGA_TB; ++tk) {
                    const float f = lb + (1.0f - lb) * sigmoidf_((float)fr[j][tk]);
                    LAS unsigned char* rec = wl + j * HGA_HEAD + tk * HGA_REC;
                    *(LAS float*)(rec + lane_ * 4) = f; *(LAS float*)(rec + 256 + lane_ * 4) = 1.0f - f; *(LAS float*)(rec + 512 + lane_ * 4) = (float)qr[j][tk];
                    *(LAS f16*)(wl + j * HGA_HEAD + HGA_V + tk * 128 + lane_ * 2) = vr[j][tk];
                    dp *= f;
                    *(f16*)(U + (mb + tk) * (unsigned)(NU * 2) + (unsigned)(C_HGQ + col) * 2u) = (f16)((float)qr[j][tk] * dp);
                }
                dpr[j] = dp; }
        }
        asm volatile("s_waitcnt lgkmcnt(0)" ::: "memory");
#define HG_LD(F, K, Q, rcp, g) { F[0] = *(const LAS f32x4*)((rcp) + (g) * 32); F[1] = *(const LAS f32x4*)((rcp) + (g) * 32 + 16); K[0] = *(const LAS f32x4*)((rcp) + 256 + (g) * 32); K[1] = *(const LAS f32x4*)((rcp) + 256 + (g) * 32 + 16); \
            Q[0] = *(const LAS f32x4*)((rcp) + 512 + (g) * 32); Q[1] = *(const LAS f32x4*)((rcp) + 512 + (g) * 32 + 16); }
#define HG_COMP(Sx, vi, F, K, Q, g) { float tt[8]; \
            _Pragma("unroll") for (int jj = 0; jj < 8; ++jj) tt[jj] = mul_asm(vi, K[jj >> 2][jj & 3]); \
            _Pragma("unroll") for (int jj = 0; jj < 8; ++jj) Sx[8 * (g) + jj] = fma_asm(Sx[8 * (g) + jj], F[jj >> 2][jj & 3], tt[jj]); \
            _Pragma("unroll") for (int jj = 0; jj < 8; ++jj) oa[jj] = fma_asm(Sx[8 * (g) + jj], Q[jj >> 2][jj & 3], oa[jj]); }
#define HG_HEAD(Sx, vi, rcp, rcn, oo) { float oa[8]; _Pragma("unroll") for (int jj = 0; jj < 8; ++jj) oa[jj] = 0.f; \
            HG_LD(fo, ko, qo, rcp, 1) HG_COMP(Sx, vi, fe, ke, qe, 0) \
            HG_LD(fe, ke, qe, rcp, 2) HG_COMP(Sx, vi, fo, ko, qo, 1) \
            HG_LD(fo, ko, qo, rcp, 3) HG_COMP(Sx, vi, fe, ke, qe, 2) \
            HG_LD(fe, ke, qe, rcp, 4) HG_COMP(Sx, vi, fo, ko, qo, 3) \
            HG_LD(fo, ko, qo, rcp, 5) HG_COMP(Sx, vi, fe, ke, qe, 4) \
            HG_LD(fe, ke, qe, rcp, 6) HG_COMP(Sx, vi, fo, ko, qo, 5) \
            HG_LD(fo, ko, qo, rcp, 7) HG_COMP(Sx, vi, fe, ke, qe, 6) \
            HG_LD(fe, ke, qe, rcn, 0) HG_COMP(Sx, vi, fo, ko, qo, 7) \
            oo = ((oa[0] + oa[1]) + (oa[2] + oa[3])) + ((oa[4] + oa[5]) + (oa[6] + oa[7])); }
        f32x4 fe[2], ke[2], qe[2], fo[2], ko[2], qo[2];
        HG_LD(fe, ke, qe, wl, 0)
        f16 vh[NH], vn[NH];
#pragma unroll
        for (int j = 0; j < NH; ++j) vh[j] = *(const LAS f16*)(wl + j * HGA_HEAD + HGA_V + lane_ * 2);
#pragma unroll 1
        for (int t2 = 0; t2 < HGA_TB; ++t2) {
            const LAS unsigned char* rc = wl + t2 * HGA_REC;
#pragma unroll
            for (int j = 0; j < NH; ++j) vn[j] = *(const LAS f16*)(wl + j * HGA_HEAD + HGA_V + ((t2 + 1) & (HGA_TB - 1)) * 128 + lane_ * 2);
            float oo[NH];
#pragma unroll
            for (int j = 0; j < NH; ++j) { const float vi = (float)vh[j];
                const LAS unsigned char* rcp = rc + j * HGA_HEAD; const LAS unsigned char* rcn = (j + 1 < NH) ? rc + (j + 1) * HGA_HEAD : rc + HGA_REC;
                HG_HEAD(S[j], vi, rcp, rcn, oo[j]) }
            char* mo = MIX + ((mb + t2) * (unsigned)DM + (unsigned)(384 + h0 * 64 + lane_)) * 2u;
#pragma unroll
            for (int j = 0; j < NH; ++j) { *(f16*)(mo + 128 * j) = (f16)oo[j]; vh[j] = vn[j]; }
        }
#undef HG_LD
#undef HG_COMP
#undef HG_HEAD
    }
    const int lane2 = lane_now();
#pragma unroll
    for (int j = 0; j < NH; ++j) { const int bh = b * 6 + h0 + j; store_row64_f16(HL + (((size_t)bh * NCH + c) * 64 + lane2) * 64, S[j]);
        DC[((size_t)bh * NCH + c) * 64 + lane2] = dpr[j]; }
}

__device__ __forceinline__ void lru_waveA(const Args& a, int l, int b, int c, int g, LAS unsigned char* wl) {
    const int ln = lane_now();
    const char* Ub = (const char*)(a.ws + WS_U); char* MIXb = (char*)(a.ws + WS_MIX); char* CA = (char*)(a.ws + WS_CA); float* LA = (float*)(a.ws + WS_LA); float* LH = (float*)(a.ws + WS_LH);
    const float* cw = a.in[18] + l * 4 * 256 + g * 64; const float* cb = a.in[19] + l * 256 + g * 64;
    const float* ba = a.in[21] + l * 256 + g * 64; const float* bx = a.in[23] + l * 256 + g * 64; const float* lam = a.in[24] + l * 256 + g * 64;
    const char* WAT = (const char*)(a.ws + WS_WAT) + (size_t)(l * 4 + g) * 8192; const char* WXT = (const char*)(a.ws + WS_WXT) + (size_t)(l * 4 + g) * 8192;
    LAS unsigned char* Y = wl;
    const unsigned mrow0 = (unsigned)(b * SEQ + c * CH);
#pragma unroll 1
    for (int ib = 0; ib < 8; ib += 4) {
        f16x8 xr[4][4];
#pragma unroll
        for (int it = 0; it < 4; ++it) { const int item = ln + 64 * (ib + it), tok = item >> 3, co = item & 7; const int t = c * CH + tok;
#pragma unroll
            for (int jj = 0; jj < 4; ++jj) { const int ts = t - 3 + jj; const unsigned row = (ts >= 0) ? mrow0 + (unsigned)(tok - 3 + jj) : mrow0 + (unsigned)tok;
                xr[it][jj] = *(const f16x8*)(Ub + (row * (unsigned)NU + (unsigned)(C_LRUX + g * 64 + 8 * co)) * 2u); } }
#pragma unroll
        for (int it = 0; it < 4; ++it) { const int item = ln + 64 * (ib + it), tok = item >> 3, co = item & 7; const int t = c * CH + tok;
            const f32x4 b0 = *(const f32x4*)(cb + 8 * co), b1 = *(const f32x4*)(cb + 8 * co + 4);
            float y[8] = {b0[0], b0[1], b0[2], b0[3], b1[0], b1[1], b1[2], b1[3]};
#pragma unroll
            for (int jj = 0; jj < 4; ++jj) { const int ts = t - 3 + jj;
                if (ts >= 0) { const f32x4 w0 = *(const f32x4*)(cw + jj * 256 + 8 * co), w1 = *(const f32x4*)(cw + jj * 256 + 8 * co + 4);
#pragma unroll
                    for (int i = 0; i < 8; ++i) y[i] += (i < 4 ? w0[i & 3] : w1[i & 3]) * (float)xr[it][jj][i]; } }
            *(LAS f16x8*)(Y + tok * 144 + co * 16) = pack8(y); } }
    asm volatile("s_waitcnt lgkmcnt(0)" ::: "memory");
    const int tl = ln & 15, fq = ln >> 4;
    float sp[16], cy[16], cp[16];
#pragma unroll
    for (int nt = 0; nt < 4; ++nt) { const f32x4 lm4 = *(const f32x4*)(lam + 16 * nt + 4 * fq);
#pragma unroll
        for (int i = 0; i < 4; ++i) { sp[nt * 4 + i] = log1pf(__expf(-lm4[i])); cy[nt * 4 + i] = 0.f; cp[nt * 4 + i] = 1.f; } }
    f16x8 wfa[4][2], wfx[4][2];
#pragma unroll
    for (int nt = 0; nt < 4; ++nt)
#pragma unroll
        for (int s2 = 0; s2 < 2; ++s2) { const unsigned wo = (unsigned)(((16 * nt + (ln & 15)) * 64 + 8 * (ln >> 4) + 32 * s2) * 2); wfa[nt][s2] = *(const f16x8*)(WAT + wo); wfx[nt][s2] = *(const f16x8*)(WXT + wo); }
#pragma unroll 1
    for (int tt = 0; tt < 4; ++tt) {
        f16x8 by[2];
#pragma unroll
        for (int s2 = 0; s2 < 2; ++s2) by[s2] = *(const LAS f16x8*)(Y + (16 * tt + tl) * 144 + (8 * fq + 32 * s2) * 2);
        const unsigned m = mrow0 + (unsigned)(16 * tt + tl);
#pragma unroll
        for (int nt = 0; nt < 4; ++nt) {
            f32x4 ra = (f32x4){0.f, 0.f, 0.f, 0.f}, rx = ra;
#pragma unroll
            for (int s2 = 0; s2 < 2; ++s2) { ra = __builtin_amdgcn_mfma_f32_16x16x32_f16(wfa[nt][s2], by[s2], ra, 0, 0, 0); rx = __builtin_amdgcn_mfma_f32_16x16x32_f16(wfx[nt][s2], by[s2], rx, 0, 0, 0); }
            const int ch0 = 16 * nt + 4 * fq;
            const f32x4 ba4 = *(const f32x4*)(ba + ch0), bx4 = *(const f32x4*)(bx + ch0);
            const f16x4 y4 = *(const LAS f16x4*)(Y + (16 * tt + tl) * 144 + ch0 * 2);
            f16x4 ho, co;
#pragma unroll
            for (int i = 0; i < 4; ++i) { const int q = nt * 4 + i;
                const float r = sigmoidf_(ra[i] + ba4[i]), ig = sigmoidf_(rx[i] + bx4[i]);
                const float la = -8.0f * r * sp[q];
                float av = __expf(la), uv = sqrtf(one_minus_exp_(2.0f * la)) * (ig * (float)y4[i]);
#define LRU_SCAN(d) { const float ap = __builtin_bit_cast(float, __builtin_amdgcn_update_dpp(0x3f800000, __builtin_bit_cast(int, av), 0x110 + (d), 0xf, 0xf, false)); \
                      const float up = __builtin_bit_cast(float, __builtin_amdgcn_update_dpp(0, __builtin_bit_cast(int, uv), 0x110 + (d), 0xf, 0xf, false)); \
                      uv = av * up + uv; av = av * ap; }
                LRU_SCAN(1) LRU_SCAN(2) LRU_SCAN(4) LRU_SCAN(8)
#undef LRU_SCAN
                const float hl = uv + av * cy[q], ca = av * cp[q];
                ho[i] = (f16)hl; co[i] = (f16)ca;
                cy[q] = __builtin_bit_cast(float, __builtin_amdgcn_ds_bpermute((ln | 15) << 2, __builtin_bit_cast(int, hl)));
                cp[q] = __builtin_bit_cast(float, __builtin_amdgcn_ds_bpermute((ln | 15) << 2, __builtin_bit_cast(int, ca)));
            }
            *(f16x4*)(MIXb + (m * (unsigned)DM + 768u + (unsigned)(g * 64 + ch0)) * 2u) = ho; *(f16x4*)(CA + (m * 256u + (unsigned)(g * 64 + ch0)) * 2u) = co;
        }
    }
    if (tl == 15) {
#pragma unroll
        for (int q = 0; q < 16; ++q) { const int ch = g * 64 + 16 * (q >> 2) + 4 * fq + (q & 3); LA[((size_t)b * NCH + c) * 256 + ch] = cp[q]; LH[((size_t)b * NCH + c) * 256 + ch] = cy[q]; } }
}

__device__ __forceinline__ void phaseA(const Args& a, int l, int task, LAS unsigned char* lds, int tid) {
    asm volatile("" : "+v"(tid));
    const int lane = tid & 63, wave = __builtin_amdgcn_readfirstlane(tid >> 6);
    const int b = task / NCH, c = task % NCH;
    const f16* U = (const f16*)(a.ws + WS_U); f16* MIX = (f16*)(a.ws + WS_MIX); f16* VF = (f16*)(a.ws + WS_VF); f16* VP = (f16*)(a.ws + WS_VP);
    f16* QT = (f16*)(a.ws + WS_QT); f16* PT = (f16*)(a.ws + WS_PT); f16* RL = (f16*)(a.ws + WS_RL); float* BONG = (float*)(a.ws + WS_BON);
    {
        LAS f16* prm = (LAS f16*)(lds + PRM_OFF); LAS float* prw0 = (LAS float*)(lds + PRM_OFF + PRM_W0_BYTE);
        for (int i = tid; i < PRM_HALVES + 384; i += NT) {
            if (i < 1280) prm[i] = (f16)a.in[3][l * RW_SHIFT + i];
            else if (i < PRM_HALVES) { const int q = (i - 1280) / 384, cc = (i - 1280) % 384;
                prm[i] = (f16)((q == 0) ? a.in[6][l * RW_W + cc] : (q == 1) ? a.in[11][l * RW_W + cc] : (q == 2) ? a.in[12][l * RW_W + cc] : (q == 3) ? a.in[13][l * RW_W + cc] : a.in[8][cc]); }
            else prw0[i - PRM_HALVES] = a.in[4][l * RW_W + (i - PRM_HALVES)]; }
        __syncthreads();
        if (wave < 4) { rwkv_waveA(a, l, b, c, wave, lds + wave * RWA_BYTES, lds + PRM_OFF, lane);
                        hgrn_waveA<1>(a, l, b, c, wave, lds + wave * RWA_BYTES); }
        else if (wave < RW_H) { hgrn_waveA<1>(a, l, b, c, wave, lds + wave * RWA_BYTES);
                                rwkv_waveA(a, l, b, c, wave, lds + wave * RWA_BYTES, lds + PRM_OFF, lane_now()); }
        else { LAS unsigned char* hw = lds + RW_H * RWA_BYTES + (wave - RW_H) * HGA_BYTES;
               lru_waveA(a, l, b, c, 2 * (wave - RW_H), hw); lru_waveA(a, l, b, c, 2 * (wave - RW_H) + 1, hw); }
        __syncthreads();
    }
}

constexpr int PB_SLOT = 16384, PB_NS = 8, PB_AHEAD = 6, NGRP = NCH / 8;
#define ARENA(ws, off) ((char*)(ws) + WS_U + (size_t)((off) >> 11) * (size_t)(NU * 2) + (size_t)((off) & 2047))
constexpr size_t AR_PGT = 0, AR_LG = 2u << 20, AR_SG = 4u << 20;
#define PB_SWZ(row, o) ((row) * 128 + (((((o) >> 4) ^ ((row) & 7)) << 4) | ((o) & 15)))
template <bool ADD_L>
__device__ __forceinline__ void pb_step(f32x4 (&Sacc)[4], const LAS unsigned char* sl, int xrow, int vl, int fq) {
    f16x8 Bhi[2], Blo[2];
#pragma unroll
    for (int mt = 0; mt < 4; ++mt)
#pragma unroll
        for (int i = 0; i < 4; ++i) { const f16 hi = (f16)Sacc[mt][i]; const f16 lo = (f16)(Sacc[mt][i] - (float)hi); Bhi[mt >> 1][4 * (mt & 1) + i] = hi; Blo[mt >> 1][4 * (mt & 1) + i] = lo; }
#pragma unroll
    for (int mt = 0; mt < 4; ++mt) {
        f32x4 d = (f32x4){0.f, 0.f, 0.f, 0.f};
        if (ADD_L) { const f16x4 l4 = *(const LAS f16x4*)(sl + 8192 + PB_SWZ(xrow, 32 * mt + 8 * fq)); d = (f32x4){(float)l4[0], (float)l4[1], (float)l4[2], (float)l4[3]}; }
#pragma unroll
        for (int s = 0; s < 2; ++s) { const u32x2 a0 = *(const LAS u32x2*)(sl + PB_SWZ(16 * mt + vl, 64 * s + 8 * fq)), a1 = *(const LAS u32x2*)(sl + PB_SWZ(16 * mt + vl, 64 * s + 32 + 8 * fq));
            u32x4 aw; aw.x = a0.x; aw.y = a0.y; aw.z = a1.x; aw.w = a1.y; const f16x8 af = __builtin_bit_cast(f16x8, aw);
            d = __builtin_amdgcn_mfma_f32_16x16x32_f16(af, Bhi[s], d, 0, 0, 0); d = __builtin_amdgcn_mfma_f32_16x16x32_f16(af, Blo[s], d, 0, 0, 0); }
        Sacc[mt] = d; }
}
__device__ __forceinline__ void pb_stage8(const Args& a, LAS unsigned char* lds, int bh, int c0, int wave, int lane) {
    const char* PT = (const char*)(a.ws + WS_PT) + ((size_t)bh * NCH + c0) * 8192; const char* RL = (const char*)(a.ws + WS_RL) + ((size_t)bh * NCH + c0) * 8192;
    const int lq = wave * 64 + lane, lrow = lq >> 3, lpp = lq & 7; const unsigned lsrc = (unsigned)(lrow * 128 + ((lpp ^ (lrow & 7)) << 4));
#pragma unroll
    for (int sl = 0; sl < 8; ++sl) { const unsigned so = (unsigned)(sl * PB_SLOT + wave * 1024); const size_t go = (size_t)sl * 8192 + lsrc;
        __builtin_amdgcn_global_load_lds((const unsigned*)(PT + go), (LAS unsigned*)(lds + so), 16, 0, 0);
        __builtin_amdgcn_global_load_lds((const unsigned*)(RL + go), (LAS unsigned*)(lds + so + 8192), 16, 0, 0); }
    asm volatile("s_waitcnt vmcnt(0)" ::: "memory");
    __builtin_amdgcn_s_barrier();
}
__device__ __forceinline__ void phaseB1(const Args& a, LAS unsigned char* lds, int tid) {
    asm volatile("" : "+v"(tid));
    const int lane = tid & 63, wave = __builtin_amdgcn_readfirstlane(tid >> 6);
    for (int task = blockIdx.x; task < 12 * NGRP; task += gridDim.x) {
        const int bh = task / NGRP, g = task % NGRP, c0 = 8 * g;
        pb_stage8(a, lds, bh, c0, wave, lane);
        const int vt = wave & 3, vl = lane & 15, fq = lane >> 4, xr = 16 * vt + vl;
        f32x4 X[4];
        if (wave < 4) {
#pragma unroll
            for (int mt = 0; mt < 4; ++mt) { const f16x4 l4 = *(const LAS f16x4*)(lds + 8192 + PB_SWZ(xr, 32 * mt + 8 * fq)); X[mt] = (f32x4){(float)l4[0], (float)l4[1], (float)l4[2], (float)l4[3]}; }
#pragma unroll 1
            for (int s = 1; s < 8; ++s) pb_step<true>(X, lds + s * PB_SLOT, xr, vl, fq);
#pragma unroll
            for (int mt = 0; mt < 4; ++mt) { f16x4 o;
#pragma unroll
                for (int i = 0; i < 4; ++i) o[i] = (f16)X[mt][i];
                *(f16x4*)ARENA(a.ws, AR_LG + ((size_t)bh * NGRP + g) * 8192 + (size_t)((xr * 64 + 16 * mt + 4 * fq) * 2)) = o; }
        } else {
#pragma unroll
            for (int mt = 0; mt < 4; ++mt)
#pragma unroll
                for (int i = 0; i < 4; ++i) X[mt][i] = (16 * mt + 4 * fq + i == xr) ? 1.f : 0.f;
#pragma unroll 1
            for (int s = 0; s < 8; ++s) pb_step<false>(X, lds + s * PB_SLOT, xr, vl, fq);
#pragma unroll
            for (int mt = 0; mt < 4; ++mt)
#pragma unroll
                for (int i = 0; i < 4; ++i) *(f16*)ARENA(a.ws, AR_PGT + ((size_t)bh * NGRP + g) * 8192 + (size_t)(((16 * mt + 4 * fq + i) * 64 + xr) * 2)) = (f16)X[mt][i];
        }
        asm volatile("s_waitcnt vmcnt(0) lgkmcnt(0)" ::: "memory");
        __builtin_amdgcn_s_barrier();
    }
}
__device__ __forceinline__ void phaseB3(const Args& a, LAS unsigned char* lds, int tid) {
    asm volatile("" : "+v"(tid));
    const int lane = tid & 63, wave = __builtin_amdgcn_readfirstlane(tid >> 6);
    for (int task = blockIdx.x; task < 12 * NGRP; task += gridDim.x) {
        const int bh = task / NGRP, g = task % NGRP, c0 = 8 * g;
        pb_stage8(a, lds, bh, c0, wave, lane);
        if (wave < 4) {
            const int vt = wave, vl = lane & 15, fq = lane >> 4, xr = 16 * vt + vl;
            char* RL = (char*)(a.ws + WS_RL) + ((size_t)bh * NCH + c0) * 8192;
            f32x4 X[4];
#pragma unroll
            for (int mt = 0; mt < 4; ++mt) { const f16x4 s4 = *(const f16x4*)ARENA(a.ws, AR_SG + ((size_t)bh * NGRP + g) * 8192 + (size_t)((xr * 64 + 16 * mt + 4 * fq) * 2)); X[mt] = (f32x4){(float)s4[0], (float)s4[1], (float)s4[2], (float)s4[3]}; }
#pragma unroll 1
            for (int s = 0; s < 8; ++s) {
#pragma unroll
                for (int mt = 0; mt < 4; ++mt) { f16x4 o;
#pragma unroll
                    for (int i = 0; i < 4; ++i) o[i] = (f16)X[mt][i];
                    *(f16x4*)(RL + (size_t)s * 8192 + (xr * 64 + 16 * mt + 4 * fq) * 2) = o; }
                if (s < 7) pb_step<true>(X, lds + s * PB_SLOT, xr, vl, fq);
            }
        }
        asm volatile("s_waitcnt vmcnt(0) lgkmcnt(0)" ::: "memory");
        __builtin_amdgcn_s_barrier();
    }
}
__device__ __forceinline__ void phaseB(const Args& a, LAS unsigned char* lds, int tid) {
    asm volatile("" : "+v"(tid));
    const int lane = tid & 63, wave = __builtin_amdgcn_readfirstlane(tid >> 6);
    const int bx = blockIdx.x;
    if (bx < 12) {
        const int bh = bx;
        const bool loader = wave >= 4;
        const int vt = wave & 3, vl = lane & 15, fq = lane >> 4, v = 16 * vt + vl;
        const int lq = (wave - 4) * 64 + lane, lrow = lq >> 3, lpp = lq & 7;
        const unsigned lsrc = (unsigned)(lrow * 128 + ((lpp ^ (lrow & 7)) << 4));
#define PB_ISSUE(cc) { const unsigned so = (unsigned)(((cc) & (PB_NS - 1)) * PB_SLOT) + (unsigned)((wave - 4) * 1024); const size_t go = ((size_t)bh * NGRP + (cc)) * 8192 + lsrc; \
            __builtin_amdgcn_global_load_lds((const unsigned*)ARENA(a.ws, AR_PGT + go), (LAS unsigned*)(lds + so), 16, 0, 0); \
            __builtin_amdgcn_global_load_lds((const unsigned*)ARENA(a.ws, AR_PGT + go + 4096), (LAS unsigned*)(lds + so + 4096), 16, 0, 0); \
            __builtin_amdgcn_global_load_lds((const unsigned*)ARENA(a.ws, AR_LG + go), (LAS unsigned*)(lds + so + 8192), 16, 0, 0); \
            __builtin_amdgcn_global_load_lds((const unsigned*)ARENA(a.ws, AR_LG + go + 4096), (LAS unsigned*)(lds + so + 12288), 16, 0, 0); }
        if (loader) {
#pragma unroll
            for (int cc = 0; cc < PB_AHEAD; ++cc) PB_ISSUE(cc)
            asm volatile("s_waitcnt vmcnt(20)" ::: "memory");
        }
        __builtin_amdgcn_s_barrier();
        f32x4 Sacc[4];
#pragma unroll
        for (int mt = 0; mt < 4; ++mt) Sacc[mt] = (f32x4){0.f, 0.f, 0.f, 0.f};
#pragma unroll 1
        for (int c = 0; c < NGRP; ++c) {
            if (loader) {
                if (c + PB_AHEAD < NGRP) { PB_ISSUE(c + PB_AHEAD) asm volatile("s_waitcnt vmcnt(20)" ::: "memory"); }
                else asm volatile("s_waitcnt vmcnt(0)" ::: "memory");
            } else {
#pragma unroll
                for (int mt = 0; mt < 4; ++mt) { f16x4 o;
#pragma unroll
                    for (int i = 0; i < 4; ++i) o[i] = (f16)Sacc[mt][i];
                    *(f16x4*)ARENA(a.ws, AR_SG + ((size_t)bh * NGRP + c) * 8192 + (size_t)((v * 64 + 16 * mt + 4 * fq) * 2)) = o; }
                pb_step<true>(Sacc, lds + (c & (PB_NS - 1)) * PB_SLOT, v, vl, fq);
                asm volatile("s_waitcnt lgkmcnt(0)" ::: "memory");
            }
            __builtin_amdgcn_s_barrier();
        }
#undef PB_ISSUE
        asm volatile("s_waitcnt vmcnt(0)" ::: "memory");
    } else if (bx < 12 + 96) {
        const int idx = (bx - 12) * NT + tid; const int bh = idx >> 12, e = idx & 4095, k = e & 63;
        f16* HL = (f16*)(a.ws + WS_HL); const float* DC = (const float*)(a.ws + WS_DC);
        float s = 0.f;
        for (int c0 = 0; c0 < NCH; c0 += 8) { float Lc[8], d[8];
#pragma unroll
            for (int j = 0; j < 8; ++j) { Lc[j] = (float)HL[((size_t)bh * NCH + c0 + j) * 4096 + e]; d[j] = DC[((size_t)bh * NCH + c0 + j) * 64 + k]; }
#pragma unroll
            for (int j = 0; j < 8; ++j) { HL[((size_t)bh * NCH + c0 + j) * 4096 + e] = (f16)s; s = d[j] * s + Lc[j]; } }
    } else if (bx == 12 + 96) {
        const int bb = tid >> 8, ch = tid & 255; const float* LA = (const float*)(a.ws + WS_LA); float* LH = (float*)(a.ws + WS_LH);
        float cy = 0.f;
        for (int c0 = 0; c0 < NCH; c0 += 8) { float A[8], H[8];
#pragma unroll
            for (int j = 0; j < 8; ++j) { const size_t o = ((size_t)bb * NCH + c0 + j) * 256 + ch; A[j] = LA[o]; H[j] = LH[o]; }
#pragma unroll
            for (int j = 0; j < 8; ++j) { const size_t o = ((size_t)bb * NCH + c0 + j) * 256 + ch; LH[o] = cy; cy = A[j] * cy + H[j]; } }
    }
}

__device__ __forceinline__ void phaseC(const Args& a, int l, int task, LAS unsigned char* lds, int tid) {
    asm volatile("" : "+v"(tid));
    const int lane = tid & 63, wave = __builtin_amdgcn_readfirstlane(tid >> 6);
    const int b = task / NCH, c = task % NCH;
    const int tl = lane & 15, fq = lane >> 4, tt = wave & 3, hg = wave >> 2;
    const unsigned m = (unsigned)(b * SEQ + c * CH + 16 * tt + tl);
    const char* U = (const char*)(a.ws + WS_U); char* MIX = (char*)(a.ws + WS_MIX); const char* VP = (const char*)(a.ws + WS_VP);
    const char* QT = (const char*)(a.ws + WS_QT); const char* RL = (const char*)(a.ws + WS_RL); const char* HL = (const char*)(a.ws + WS_HL); const float* BONG = (const float*)(a.ws + WS_BON);
    const unsigned uo = m * (unsigned)(NU * 2);
#pragma unroll
    for (int hh = 0; hh < 3; ++hh) {
        const int h = 3 * hg + hh; const int bh = b * RW_H + h;
        const char* sl = RL + ((size_t)bh * NCH + c) * 8192;
        f16x8 bq[2];
#pragma unroll
        for (int s = 0; s < 2; ++s) bq[s] = *(const f16x8*)(QT + (m * (unsigned)RW_W + (unsigned)(h * 64 + 8 * fq + 32 * s)) * 2u);
        f32x4 D[4];
#pragma unroll
        for (int vt = 0; vt < 4; ++vt) { const f16x4 yl = *(const f16x4*)(MIX + (m * (unsigned)DM + (unsigned)(h * 64 + 16 * vt + 4 * fq)) * 2u);
            f32x4 d = (f32x4){(float)yl[0], (float)yl[1], (float)yl[2], (float)yl[3]};
#pragma unroll
            for (int s = 0; s < 2; ++s) d = __builtin_amdgcn_mfma_f32_16x16x32_f16(*(const f16x8*)(sl + ((16 * vt + tl) * 64 + 8 * fq + 32 * s) * 2), bq[s], d, 0, 0, 0);
            D[vt] = d; }
        float sm = 0.f;
#pragma unroll
        for (int vt = 0; vt < 4; ++vt) sm += (D[vt][0] + D[vt][1]) + (D[vt][2] + D[vt][3]);
        sm += shfl_xor_f(sm, 16); sm += shfl_xor_f(sm, 32);
        const float mean = sm * (1.0f / 64.0f); float vr = 0.f;
#pragma unroll
        for (int vt = 0; vt < 4; ++vt)
#pragma unroll
            for (int i = 0; i < 4; ++i) { const float d = D[vt][i] - mean; vr += d * d; }
        vr += shfl_xor_f(vr, 16); vr += shfl_xor_f(vr, 32);
        const float rstd = rsq_(vr * (1.0f / 64.0f) + 64e-5f);
        const float bon = BONG[m * 8u + (unsigned)h];
        const float* ln_w = a.in[14] + l * RW_W; const float* ln_b = a.in[15] + l * RW_W;
#pragma unroll
        for (int vt = 0; vt < 4; ++vt) { const unsigned col = (unsigned)(h * 64 + 16 * vt + 4 * fq);
            const f16x4 vp = *(const f16x4*)(VP + (m * (unsigned)RW_W + col) * 2u), z4 = *(const f16x4*)(U + uo + ((unsigned)C_RWZ + col) * 2u);
            const f32x4 lw = *(const f32x4*)(ln_w + col), lb = *(const f32x4*)(ln_b + col);
            f16x4 o;
#pragma unroll
            for (int i = 0; i < 4; ++i) o[i] = (f16)(((D[vt][i] - mean) * rstd * lw[i] + lb[i] + bon * (float)vp[i]) * siluf_((float)z4[i]));
            *(f16x4*)(MIX + (m * (unsigned)DM + col) * 2u) = o; }
    }
#pragma unroll
    for (int hh = 0; hh < 3; ++hh) {
        const int h = 3 * hg + hh; const int bh = b * 6 + h;
        const char* sl = HL + ((size_t)bh * NCH + c) * 8192;
        f16x8 bq[2];
#pragma unroll
        for (int s = 0; s < 2; ++s) bq[s] = *(const f16x8*)(U + uo + (unsigned)(C_HGQ + h * 64 + 8 * fq + 32 * s) * 2u);
        f32x4 D[4];
#pragma unroll
        for (int vt = 0; vt < 4; ++vt) { const f16x4 ol = *(const f16x4*)(MIX + (m * (unsigned)DM + (unsigned)(384 + h * 64 + 16 * vt + 4 * fq)) * 2u);
            f32x4 d = (f32x4){(float)ol[0], (float)ol[1], (float)ol[2], (float)ol[3]};
#pragma unroll
            for (int s = 0; s < 2; ++s) d = __builtin_amdgcn_mfma_f32_16x16x32_f16(*(const f16x8*)(sl + ((16 * vt + tl) * 64 + 8 * fq + 32 * s) * 2), bq[s], d, 0, 0, 0);
            D[vt] = d; }
        float ss = 0.f;
#pragma unroll
        for (int vt = 0; vt < 4; ++vt) ss += (D[vt][0] * D[vt][0] + D[vt][1] * D[vt][1]) + (D[vt][2] * D[vt][2] + D[vt][3] * D[vt][3]);
        ss += shfl_xor_f(ss, 16); ss += shfl_xor_f(ss, 32);
        const float rs = rsq_(ss * (1.0f / 64.0f) + 1e-6f);
        const float* nw = a.in[17] + l * 384;
#pragma unroll
        for (int vt = 0; vt < 4; ++vt) { const unsigned col = (unsigned)(h * 64 + 16 * vt + 4 * fq);
            const f16x4 z4 = *(const f16x4*)(U + uo + ((unsigned)C_HGZ + col) * 2u); const f32x4 w4 = *(const f32x4*)(nw + col);
            f16x4 o;
#pragma unroll
            for (int i = 0; i < 4; ++i) o[i] = (f16)(D[vt][i] * rs * w4[i] * siluf_((float)z4[i]));
            *(f16x4*)(MIX + (m * (unsigned)DM + 384u + col) * 2u) = o; }
    }
    {
        const char* CA = (const char*)(a.ws + WS_CA); const float* LH = (const float*)(a.ws + WS_LH) + ((size_t)b * NCH + c) * 256;
#pragma unroll
        for (int q = 0; q < 4; ++q) { const unsigned ch0 = (unsigned)(128 * hg + 32 * fq + 8 * q);
            const f16x8 hl = *(const f16x8*)(MIX + (m * (unsigned)DM + 768u + ch0) * 2u), ca = *(const f16x8*)(CA + (m * 256u + ch0) * 2u), z8 = *(const f16x8*)(U + uo + ((unsigned)C_LRUZ + ch0) * 2u);
            const f32x4 c0 = *(const f32x4*)(LH + ch0), c1 = *(const f32x4*)(LH + ch0 + 4);
            f16x8 o;
#pragma unroll
            for (int i = 0; i < 8; ++i) o[i] = (f16)(((float)hl[i] + (float)ca[i] * (i < 4 ? c0[i & 3] : c1[i & 3])) * siluf_((float)z8[i]));
            *(f16x8*)(MIX + (m * (unsigned)DM + 768u + ch0) * 2u) = o; }
    }
}
#define XB_TMO      128
#define XB_XCNT(j)  (256  + 64 * (j))
#define XB_XSUB(j)  (1280 + 64 * (j))
#define XB_XGEN(j)  (2304 + 64 * (j))
#define XB_TOP      3328
#define XB_TOPGEN   3392
#define XCD_BAR_WORDS 3456
#define XB_SPIN_CAP (1u << 18)

__device__ __forceinline__ unsigned xb_ld(unsigned* p)              { return __hip_atomic_load(p, __ATOMIC_RELAXED, __HIP_MEMORY_SCOPE_AGENT); }
__device__ __forceinline__ unsigned xb_add(unsigned* p, unsigned v) { return __hip_atomic_fetch_add(p, v, __ATOMIC_RELAXED, __HIP_MEMORY_SCOPE_AGENT); }
__device__ __forceinline__ unsigned xb_xcc_id() { return (unsigned)__builtin_amdgcn_s_getreg((3 << 11) | 20) & 0xFu; }
#define XB_SPIN(cond, bar) do { unsigned _sp = 0; while (cond) { __builtin_amdgcn_s_sleep(1); \
    if ((++_sp & 255u) == 0u) { if (xb_ld(&(bar)[XB_TMO])) break; if (_sp > XB_SPIN_CAP) { atomicAdd(&(bar)[XB_TMO], 1u); break; } } } } while (0)

struct XcdBarrier {
    unsigned* bar; unsigned x; int isw0;
    volatile LAS unsigned* st;
};

__device__ __forceinline__ XcdBarrier xcd_barrier_post(unsigned* bar, volatile LAS unsigned* st, int isw0) {
    XcdBarrier b; b.bar = bar; b.x = xb_xcc_id(); b.st = st; b.isw0 = isw0;
    if (isw0 && lane_now() == 0) (void)xb_add(&bar[XB_XCNT(b.x)], 1u);
    return b;
}
__device__ __forceinline__ void xcd_barrier_complete(unsigned* bar, unsigned x, unsigned& nloc, unsigned& nx) {
    const unsigned G = gridDim.x * gridDim.y * gridDim.z;
    unsigned sum, cnt, mine, sp = 0u;
    for (;;) {
        sum = 0u; cnt = 0u; mine = 0u;
#pragma unroll
        for (unsigned j = 0; j < 16; ++j) { const unsigned c = xb_ld(&bar[XB_XCNT(j)]); sum += c; cnt += (c > 0u) ? 1u : 0u; mine = (j == x) ? c : mine; }
        if (sum == G) break;
        __builtin_amdgcn_s_sleep(1);
        if ((++sp & 255u) == 0u) { if (xb_ld(&bar[XB_TMO])) break; if (sp > XB_SPIN_CAP) { atomicAdd(&bar[XB_TMO], 1u); break; } }
    }
    nloc = mine > 0u ? mine : 1u; nx = cnt > 0u ? cnt : 1u;
}

__device__ __forceinline__ void xcd_barrier(const XcdBarrier& b) {
    asm volatile("s_waitcnt vmcnt(0)" ::: "memory");
    __syncthreads();
    if (b.isw0 && lane_now() == 0) {
        unsigned* bar = b.bar;
        __builtin_amdgcn_s_waitcnt(0);
        unsigned nloc = b.st[0], nx = b.st[1];
        if (nloc == 0u) { xcd_barrier_complete(bar, b.x, nloc, nx); b.st[0] = nloc; b.st[1] = nx; }
        const unsigned old = xb_add(&bar[XB_XSUB(b.x)], 1u);
        const unsigned gen = old / nloc;
        if (old + 1u == (gen + 1u) * nloc) {
            __builtin_amdgcn_fence(__ATOMIC_RELEASE, "agent");
            asm volatile("s_waitcnt vmcnt(0)" ::: "memory");
            const unsigned og = xb_add(&bar[XB_TOP], 1u);
            const unsigned tg = og / nx;
            if (og + 1u == (tg + 1u) * nx) xb_add(&bar[XB_TOPGEN], 1u);
            else XB_SPIN(xb_ld(&bar[XB_TOPGEN]) == tg, bar);
            __builtin_amdgcn_fence(__ATOMIC_ACQUIRE, "agent");
            xb_add(&bar[XB_XGEN(b.x)], 1u);
            asm volatile("s_waitcnt vmcnt(0)" ::: "memory");
        } else {
            XB_SPIN(xb_ld(&bar[XB_XGEN(b.x)]) == gen, bar);
            __builtin_amdgcn_fence(__ATOMIC_ACQUIRE, "agent");
            asm volatile("s_waitcnt vmcnt(0)" ::: "memory");
        }
    }
    __syncthreads();
}

constexpr size_t WS_BAR = 16384;
constexpr size_t WS_PCNT = 32768;
constexpr int MISC_OFF = LDS_BYTES - 16;
__global__ void __launch_bounds__(NT, 2) fwd(Args args) {
    extern __shared__ __attribute__((aligned(16))) unsigned char lds_raw[];
    LAS unsigned char* lds = (LAS unsigned char*)lds_raw;
    cg::grid_group grid = cg::this_grid();
    const int wave = __builtin_amdgcn_readfirstlane((int)threadIdx.x >> 6);
#define TID_NOW() (wave * 64 + lane_now())
    const int tid = TID_NOW(); const int lane = tid & 63;
    if (wave == 0 && lane < 4) ((LAS unsigned*)(lds + MISC_OFF))[lane] = 0u;
    __syncthreads();
    XcdBarrier xbar = xcd_barrier_post((unsigned*)(args.ws + WS_BAR), (volatile LAS unsigned*)(lds + MISC_OFF), __builtin_amdgcn_readfirstlane(wave == 0 ? 1 : 0));
#define GRID_BAR() do { XcdBarrier xb_ = xbar; xb_.st = (volatile LAS unsigned*)(lds + MISC_OFF); asm volatile("" : "+s"(xb_.bar), "+s"(xb_.x)); xcd_barrier(xb_); } while (0)
    const int G = gridDim.x, gw = blockIdx.x * NWAVES + wave, NGW = G * NWAVES;
    unsigned char* ws = args.ws;
    unsigned short* XN = (unsigned short*)(ws + WS_XN);
    {
        LAS float* scr = (LAS float*)(lds + wave * 8704);
        constexpr int I_IN = (DM / 64) * (NIN / 32), I_OUT = (DM / 64) * (DM / 32), NITEMS = DEPTH * (I_IN + I_OUT);
        for (int it = gw; it < NITEMS; it += NGW) {
            int r = it; const int l = r / (I_IN + I_OUT); r -= l * (I_IN + I_OUT);
            if (r < I_IN) p0_transpose_item(args.in[2] + (size_t)l * DM * NIN, DM, NIN, (unsigned short*)(ws + WS_WIN + l * WIN_L), scr, r, lane, l == 0 ? nullptr : args.in[1] + DM);
            else p0_transpose_item(args.in[25] + (size_t)l * DM * DM, DM, DM, (unsigned short*)(ws + WS_WOUT + l * WOUT_L), scr, r - I_IN, lane, nullptr);
        }
        for (int i = gw; i < DEPTH * (NU - NIN) * DM * 2 / 1024; i += NGW) { const int l = i / ((NU - NIN) * DM * 2 / 1024), r = i % ((NU - NIN) * DM * 2 / 1024);
            if (l == 1 && r < 64 * DM * 2 / 1024) continue;
            *(u32x4*)(ws + WS_WIN + l * WIN_L + (size_t)NIN * DM * 2 + (size_t)r * 1024 + lane * 16) = (u32x4){0u, 0u, 0u, 0u}; }
        if (blockIdx.x < 32) {
            LAS f16* TT = (LAS f16*)(lds + 8 * 8704);
            for (int i = tid; i < 64 * RW_W; i += NT) { const int n = i / RW_W, cc = i % RW_W; const float mm = args.in[3][RW_SHIFT + C_V + cc]; TT[n * 392 + cc] = (f16)(((n < 32) ? (1.0f - mm) : mm) * args.in[9][cc * 32 + (n & 31)]); }
            __syncthreads();
            const int tile = blockIdx.x * NWAVES + wave, nt = tile & 3, kt = tile >> 2, tl = lane & 15, fq = lane >> 4;
            const float* wrow = args.in[2] + (size_t)DM * NIN + (size_t)(16 * kt + tl) * NIN + C_V + 8 * fq;
            f32x4 bv[12][2];
#pragma unroll
            for (int s2 = 0; s2 < 12; ++s2) { bv[s2][0] = *(const f32x4*)(wrow + 32 * s2); bv[s2][1] = *(const f32x4*)(wrow + 32 * s2 + 4); }
            f32x4 d = (f32x4){0.f, 0.f, 0.f, 0.f};
#pragma unroll
            for (int s2 = 0; s2 < 12; ++s2) { f16x8 bf;
#pragma unroll
                for (int j = 0; j < 8; ++j) bf[j] = (f16)(j < 4 ? bv[s2][0][j & 3] : bv[s2][1][j & 3]);
                d = __builtin_amdgcn_mfma_f32_16x16x32_f16(*(const LAS f16x8*)(TT + (16 * nt + tl) * 392 + 8 * fq + 32 * s2), bf, d, 0, 0, 0); }
            const float nwk = args.in[1][DM + 16 * kt + tl];
#pragma unroll
            for (int i = 0; i < 4; ++i) ((f16*)(ws + WS_WIN + WIN_L))[(size_t)(NIN + 16 * nt + 4 * fq + i) * DM + 16 * kt + tl] = (f16)(d[i] * nwk);
            __syncthreads();
        }
        for (int i = blockIdx.x * NT + tid; i < 2 * M; i += G * NT) ((float*)(ws + WS_RSS))[i] = 0.f;
        for (int m = gw; m < M; m += 4 * NGW) rms_row4_f16(args.in[0] + (size_t)m * DM, (size_t)NGW * DM, args.in[1], XN + (size_t)m * DM, lane);
        { f16* WUPT = (f16*)(ws + WS_WUPT); f16* AUPT = (f16*)(ws + WS_AUPT); f16* VDNT = (f16*)(ws + WS_VDNT); f16* VUPT = (f16*)(ws + WS_VUPT);
          for (int i = blockIdx.x * NT + tid; i < 122880; i += G * NT) {
              if (i < 49152) { const int ll = i / 24576, r = i % 24576, n = r / 64, k = r % 64; WUPT[i] = (f16)args.in[5][(size_t)ll * 24576 + k * 384 + n]; }
              else if (i < 98304) { const int i2 = i - 49152, ll = i2 / 24576, r = i2 % 24576, n = r / 64, k = r % 64; AUPT[i2] = (f16)args.in[7][(size_t)ll * 24576 + k * 384 + n]; }
              else if (i < 110592) { const int i2 = i - 98304, j2 = i2 / 384, cc = i2 % 384; VDNT[i2] = (f16)args.in[9][cc * 32 + j2]; }
              else { const int i2 = i - 110592, n = i2 / 32, j2 = i2 % 32; VUPT[i2] = (f16)args.in[10][j2 * 384 + n]; } }
          f16* WAT = (f16*)(ws + WS_WAT); f16* WXT = (f16*)(ws + WS_WXT);
          for (int i = blockIdx.x * NT + tid; i < 32768; i += G * NT) { const int lg = i >> 12, r = i & 4095, j = r >> 6, ii = r & 63; WAT[i] = (f16)args.in[20][(size_t)lg * 4096 + ii * 64 + j]; WXT[i] = (f16)args.in[22][(size_t)lg * 4096 + ii * 64 + j]; } }
    }
    if (gridDim.x > 65536u) grid.sync();
    GRID_BAR();
#pragma unroll 1
    for (int l = 0; l < DEPTH; ++l) {
        { pg8::Gemm g{XN, (const unsigned short*)(ws + WS_WIN + l * WIN_L), M, NU, DM}; pg8::StaticOrder S; S.init(M, NU, G, (int)blockIdx.x);
          pg8::EpiF16 E{(unsigned short*)(ws + WS_U), NU, l == 0 ? nullptr : (const float*)(ws + WS_RSS)};
          pg8::gemm_phase<pg8::EpiF16, pg8::StaticOrder, true, true>(lds, g, S, E, wave); }
        GRID_BAR();
        for (int task = blockIdx.x; task < BATCH * NCH; task += G) phaseA(args, l, task, lds, TID_NOW());
        GRID_BAR();
        phaseB1(args, lds, TID_NOW());
        GRID_BAR();
        phaseB(args, lds, TID_NOW());
        GRID_BAR();
        phaseB3(args, lds, TID_NOW());
        GRID_BAR();
        for (int task = blockIdx.x; task < BATCH * NCH; task += G) phaseC(args, l, task, lds, TID_NOW());
        GRID_BAR();
        { pg8::Gemm g{(const unsigned short*)(ws + WS_MIX), (const unsigned short*)(ws + WS_WOUT + l * WOUT_L), M, DM, DM}; pg8::StaticOrder S; S.init(M, DM, G, (int)blockIdx.x);
          if (l + 1 < DEPTH) {
              pg8::EpiRes E{args.in[0], args.out, DM, XN, (float*)(ws + WS_RSS)};
              pg8::gemm_phase<pg8::EpiRes, pg8::StaticOrder, true, true>(lds, g, S, E, wave);
              GRID_BAR();
          } else {
              pg8::EpiResNorm E{args.out, args.out, DM, (float*)(ws + WS_RSS) + M, (unsigned*)(ws + WS_PCNT), args.in[26]};
              pg8::gemm_phase<pg8::EpiResNorm, pg8::StaticOrder, true, true>(lds, g, S, E, wave);
          } }
    }
}

extern "C" void kernel_launch(void* const* d_in, const int* in_sizes, int n_in, void* d_out, int out_size, void* d_ws, size_t ws_size, hipStream_t stream) {
    static int grid = 0;
    if (grid == 0) {
        if (n_in != 27 || in_sizes[0] != M * DM || out_size != M * DM || ws_size < WS_END) { fprintf(stderr, "kernel_launch: unexpected problem: n_in %d in0 %d out %d ws %zu\n", n_in, n_in > 0 ? in_sizes[0] : -1, out_size, ws_size); grid = -1; return; }
        int dev = 0, cus = 0, per_cu = 0;
        hipGetDevice(&dev); hipDeviceGetAttribute(&cus, hipDeviceAttributeMultiprocessorCount, dev);
        if (hipFuncSetAttribute((const void*)fwd, hipFuncAttributeMaxDynamicSharedMemorySize, LDS_BYTES) != hipSuccess) { fprintf(stderr, "kernel_launch: hipFuncSetAttribute failed\n"); grid = -1; return; }
        if (hipOccupancyMaxActiveBlocksPerMultiprocessor(&per_cu, (const void*)fwd, NT, LDS_BYTES) != hipSuccess || per_cu < 1) { fprintf(stderr, "kernel_launch: occupancy query failed (%d)\n", per_cu); grid = -1; return; }
        grid = cus * per_cu;
    }
    if (grid < 0) return;
    if (hipMemsetAsync((char*)d_ws, 0, 65536, stream) != hipSuccess) { fprintf(stderr, "kernel_launch: memset of the barrier words failed\n"); return; }
    Args a{};
    for (int i = 0; i < 27; ++i) a.in[i] = (const float*)d_in[i];
    a.out = (float*)d_out; a.ws = (unsigned char*)d_ws;
    void* kargs[] = {&a};
    hipError_t e = hipLaunchCooperativeKernel((const void*)fwd, dim3(grid), dim3(NT), kargs, LDS_BYTES, stream);
    if (e != hipSuccess) fprintf(stderr, "cooperative launch failed: %s (grid %d)\n", hipGetErrorString(e), grid);
}
```

```cpp
#include <hip/hip_runtime.h>
#include <hip/hip_cooperative_groups.h>
#include <cstdio>
#include <cstdint>
namespace cg = cooperative_groups;
typedef _Float16 f16x8_t __attribute__((ext_vector_type(8)));
#define MK_MFMA(a, b, c) __builtin_amdgcn_mfma_f32_16x16x32_f16(__builtin_bit_cast(f16x8_t, (a)), __builtin_bit_cast(f16x8_t, (b)), (c), 0, 0, 0)
__device__ __forceinline__ int lane_now() { int z; asm volatile("v_mbcnt_lo_u32_b32 %0, -1, 0\n\tv_mbcnt_hi_u32_b32 %0, -1, %0" : "=v"(z)); return z; }
__device__ __forceinline__ float shfl_xor_f(float v, int mask) { const int ln = lane_now(); return __builtin_bit_cast(float, __builtin_amdgcn_ds_bpermute((ln ^ mask) << 2, __builtin_bit_cast(int, v))); }
namespace pg8 {
#define PG8_LAS __attribute__((address_space(3)))
typedef unsigned short bf16_t;
typedef short bf16x8 __attribute__((ext_vector_type(8)));
typedef float f32x4 __attribute__((ext_vector_type(4)));
typedef unsigned u32x4 __attribute__((ext_vector_type(4)));
constexpr int BM = 256, BK = 64, HALF = 128, HTB = HALF * BK * 2  , STAGE_BYTES = 8 * HTB, NXCD = 8, WGM = 8;

__host__ __device__ __forceinline__ int lds_byte(int r, int c) { const int st = (r >> 4) * 2 + (c >> 5), rr = r & 15, cc = c & 31, ob = rr * 64 + cc * 2; return st * 1024 + (ob ^ (((ob >> 9) & 1) << 5)); }
__host__ __device__ __forceinline__ void stage_rc(int b, int& R, int& C) { const int st = b / 1024, sb = b % 1024, swz = sb ^ (((sb >> 9) & 1) << 5); R = (st >> 1) * 16 + swz / 64; C = (st & 1) * 32 + (swz % 64) / 2; }
__host__ __device__ __forceinline__ int perm32(int rho) { const int n = rho >> 4, i = rho & 15; return 8 * (i >> 2) + 4 * n + (i & 3); }

struct Unit { int pm, pn; };
struct Gemm { const bf16_t* A; const bf16_t* Bt; int M, N, K; };

struct StaticOrder {
    int nM, nN, nwg, G, c;
    __host__ __device__ void init(int M, int N, int G_, int c_) { nM = M / BM; nN = N / BM; nwg = nM * nN; G = G_; c = c_; }
    __host__ __device__ bool next(int i, Unit& u) const {
        const long L = (long)i * G + c; if (L >= nwg) return false;
        int wgid = (int)L; { const int q = nwg / NXCD, r = nwg % NXCD, xcd = wgid % NXCD, off = wgid / NXCD; wgid = (xcd < r ? xcd * (q + 1) : r * (q + 1) + (xcd - r) * q) + off; }
        const int nig = WGM * nN, gid = wgid / nig, fm = gid * WGM, gsz = (nM - fm) < WGM ? (nM - fm) : WGM;
        u.pm = fm + ((wgid % nig) % gsz); u.pn = (wgid % nig) / gsz; return true;
    }
    __device__ __forceinline__ void a_ready(const Unit&) const {}
    __device__ __forceinline__ void done(const Unit&) const {}
};

__device__ __forceinline__ unsigned pk_f16(float lo, float hi) { typedef _Float16 h2 __attribute__((ext_vector_type(2))); h2 v; v.x = (_Float16)lo; v.y = (_Float16)hi; return __builtin_bit_cast(unsigned, v); }
typedef unsigned u32x2 __attribute__((ext_vector_type(2)));
struct EpiF16 {
    static constexpr bool PERM = true, AFTER_DRAIN = false;
    bf16_t* O; int ldc; const float* rss;
    __device__ __forceinline__ void operator()(const f32x4 (&acc)[2][2][4][2], const Unit& u, int wr, int wc, int fr, int fq) const {
        const int row0 = u.pm * BM + wr * 64 + fr; const int col0 = u.pn * BM + wc * 32 + 8 * fq;
#pragma unroll
        for (int ai = 0; ai < 2; ++ai)
#pragma unroll
            for (int m = 0; m < 4; ++m) { const int row = row0 + ai * HALF + m * 16; bf16_t* rowp = O + (size_t)row * ldc + col0;
                const float sc = rss ? 1.0f / sqrtf(rss[row] * (1.0f / 1024.0f) + 1e-6f) : 1.0f;
#pragma unroll
                for (int bj = 0; bj < 2; ++bj) { const f32x4 v0 = acc[ai][bj][m][0] * sc, v1 = acc[ai][bj][m][1] * sc;
                    u32x4 w; w.x = pk_f16(v0[0], v0[1]); w.y = pk_f16(v0[2], v0[3]); w.z = pk_f16(v1[0], v1[1]); w.w = pk_f16(v1[2], v1[3]);
                    *(u32x4*)(rowp + bj * HALF) = w; } }
    }
};
struct EpiRes {
    static constexpr bool PERM = false, AFTER_DRAIN = false;
    const float* base; float* out; int ldc; bf16_t* xh; float* rss;
    __device__ __forceinline__ void operator()(const f32x4 (&acc)[2][2][4][2], const Unit& u, int wr, int wc, int fr, int fq) const {
        const int row0 = u.pm * BM + wr * 64 + fr; const int col0 = u.pn * BM + wc * 32 + 4 * fq;
#pragma unroll
        for (int ai = 0; ai < 2; ++ai)
#pragma unroll
            for (int m = 0; m < 4; ++m) { const size_t off = (size_t)(row0 + ai * HALF + m * 16) * ldc + col0; float ss = 0.f;
#pragma unroll
                for (int bj = 0; bj < 2; ++bj)
#pragma unroll
                    for (int n = 0; n < 2; ++n) { const size_t o = off + bj * HALF + n * 16; const f32x4 b = *(const f32x4*)(base + o); const f32x4 x = b + acc[ai][bj][m][n]; *(f32x4*)(out + o) = x;
                        if (xh) { u32x2 h; h.x = pk_f16(x[0], x[1]); h.y = pk_f16(x[2], x[3]); *(u32x2*)(xh + o) = h; ss += (x[0] * x[0] + x[1] * x[1]) + (x[2] * x[2] + x[3] * x[3]); } }
                if (xh) { ss += shfl_xor_f(ss, 16); ss += shfl_xor_f(ss, 32); if (fq == 0) atomicAdd(rss + row0 + ai * HALF + m * 16, ss); }
                asm volatile("" ::: "memory"); }
    }
};

struct EpiResNorm {
    static constexpr bool PERM = false, AFTER_DRAIN = false;
    const float* base; float* out; int ldc; float* rss2; unsigned* cnt; const float* w;
    __device__ __forceinline__ void operator()(f32x4 (&acc)[2][2][4][2], const Unit& u, int wr, int wc, int fr, int fq) const {
        const int row0 = u.pm * BM + wr * 64 + fr; const int col0 = u.pn * BM + wc * 32 + 4 * fq;
#pragma unroll
        for (int ai = 0; ai < 2; ++ai)
#pragma unroll
            for (int m = 0; m < 4; ++m) { const size_t off = (size_t)(row0 + ai * HALF + m * 16) * ldc + col0; float ss = 0.f;
#pragma unroll
                for (int bj = 0; bj < 2; ++bj)
#pragma unroll
                    for (int n = 0; n < 2; ++n) { const size_t o = off + bj * HALF + n * 16; const f32x4 x = *(const f32x4*)(base + o) + acc[ai][bj][m][n]; acc[ai][bj][m][n] = x;
                        ss += (x[0] * x[0] + x[1] * x[1]) + (x[2] * x[2] + x[3] * x[3]); }
                ss += shfl_xor_f(ss, 16); ss += shfl_xor_f(ss, 32); if (fq == 0) atomicAdd(rss2 + row0 + ai * HALF + m * 16, ss);
                asm volatile("" ::: "memory"); }
        asm volatile("s_waitcnt vmcnt(0)" ::: "memory");
        unsigned* pc = cnt + 64 * u.pm;
        if (lane_now() == 0) __hip_atomic_fetch_add(pc, 1u, __ATOMIC_RELAXED, __HIP_MEMORY_SCOPE_AGENT);
        for (unsigned spin = 0; spin < (1u << 22); ++spin) { if ((unsigned)__builtin_amdgcn_readfirstlane((int)__hip_atomic_load(pc, __ATOMIC_RELAXED, __HIP_MEMORY_SCOPE_AGENT)) >= 32u) break; __builtin_amdgcn_s_sleep(2); }
#pragma unroll
        for (int ai = 0; ai < 2; ++ai)
#pragma unroll
            for (int m = 0; m < 4; ++m) { const int row = row0 + ai * HALF + m * 16; const size_t off = (size_t)row * ldc + col0;
                const float rs = 1.0f / sqrtf(__hip_atomic_load(rss2 + row, __ATOMIC_RELAXED, __HIP_MEMORY_SCOPE_AGENT) * (1.0f / 1024.0f) + 1e-6f);
#pragma unroll
                for (int bj = 0; bj < 2; ++bj)
#pragma unroll
                    for (int n = 0; n < 2; ++n) { const size_t o = off + bj * HALF + n * 16; const f32x4 ww = *(const f32x4*)(w + col0 + bj * HALF + n * 16); *(f32x4*)(out + o) = acc[ai][bj][m][n] * rs * ww; } }
    }
};

template <class Epi, class Sched, bool ALIGN_EPI = false, bool SP2 = false>
__device__ __forceinline__ void gemm_phase(PG8_LAS unsigned char* lds, const Gemm g, const Sched& S, const Epi& E, const int wave_) {
    int wv_ = wave_; asm volatile("" : "+s"(wv_)); int tid_ = lane_now() + 64 * wv_; const int tid = tid_, wid = wv_, lane = tid & 63, wr = wid >> 2, wc = wid & 3, fr = lane & 15, fq = lane >> 4;
    const int K = g.K, nt = K / BK;
    unsigned voffA[2], voffB[2];
#pragma unroll
    for (int i = 0; i < 2; ++i) { int R, C; stage_rc(tid * 16 + i * 8192, R, C); const int Rb = Epi::PERM ? ((R & ~31) + perm32(R & 31)) : R;
        voffA[i] = (unsigned)(R * K + C) * 2u; voffB[i] = (unsigned)(Rb * K + C) * 2u; }
    const size_t kstep = (size_t)(BK * 2);
    const size_t hstep = (size_t)HALF * K * 2;
    const size_t tstep = 2 * hstep;
    const unsigned ldsw = (unsigned)wid * 1024u;
    const int aoff = lds_byte(wr * 64 + fr, fq * 8), boff = lds_byte(wc * 32 + fr, fq * 8);
#define PG8_SA(b, h) (((b) * 2 + (h)) * HTB)
#define PG8_SB(b, h) ((4 + (b) * 2 + (h)) * HTB)
#define PG8_STAGE(bufoff, gbase, voff) do { _Pragma("unroll") for (int _i = 0; _i < 2; ++_i) \
        __builtin_amdgcn_global_load_lds((const unsigned*)((const char*)(gbase) + (voff)[_i]), (PG8_LAS unsigned*)(lds + (bufoff) + ldsw + _i * 8192), 16, 0, 0); } while (0)
#define PG8_LDA(dst, b, h) do { _Pragma("unroll") for (int m = 0; m < 4; ++m) _Pragma("unroll") for (int k = 0; k < 2; ++k) dst[m][k] = *(const PG8_LAS bf16x8*)(lds + PG8_SA(b, h) + aoff + m * 2048 + k * 1024); } while (0)
#define PG8_LDB(dst, b, h) do { _Pragma("unroll") for (int n = 0; n < 2; ++n) _Pragma("unroll") for (int k = 0; k < 2; ++k) dst[n][k] = *(const PG8_LAS bf16x8*)(lds + PG8_SB(b, h) + boff + n * 2048 + k * 1024); } while (0)
#define PG8_MMA(ai, bj, At, Bt) do { __builtin_amdgcn_s_setprio(1); _Pragma("unroll") for (int m = 0; m < 4; ++m) _Pragma("unroll") for (int n = 0; n < 2; ++n) _Pragma("unroll") for (int k = 0; k < 2; ++k) \
        acc[ai][bj][m][n] = MK_MFMA(Bt[n][k], At[m][k], acc[ai][bj][m][n]); __builtin_amdgcn_s_setprio(0); } while (0)
#define PG8_WAIT_V(n) asm volatile("s_waitcnt vmcnt(" #n ")" ::: "memory")
#define PG8_WAIT_L(n) asm volatile("s_waitcnt lgkmcnt(" #n ")" ::: "memory")
#define PG8_BAR __builtin_amdgcn_s_barrier()
#define PG8_SCHED __builtin_amdgcn_sched_barrier(0)
    Unit cur, nxt; int ui = 0;
    if (!S.next(0, cur)) return;
    f32x4 acc[2][2][4][2];
#pragma unroll
    for (int a = 0; a < 2; ++a)
#pragma unroll
        for (int b = 0; b < 2; ++b)
#pragma unroll
            for (int m = 0; m < 4; ++m)
#pragma unroll
                for (int n = 0; n < 2; ++n) acc[a][b][m][n] = (f32x4){0.f, 0.f, 0.f, 0.f};
    bf16x8 At[4][2], B0[2][2], B1[2][2];
    const char* cA = (const char*)g.A + (size_t)cur.pm * tstep; const char* cB = (const char*)g.Bt + (size_t)cur.pn * tstep;
    S.a_ready(cur);
    if constexpr (SP2) {
        PG8_STAGE(PG8_SB(0, 0), cB, voffB); PG8_STAGE(PG8_SB(0, 1), cB + hstep, voffB); PG8_STAGE(PG8_SA(0, 0), cA, voffA); PG8_STAGE(PG8_SA(0, 1), cA + hstep, voffA);
        if (wr == 1) PG8_BAR;
        PG8_WAIT_V(2); PG8_BAR;
        PG8_STAGE(PG8_SB(1, 0), cB + kstep, voffB); PG8_STAGE(PG8_SA(1, 0), cA + kstep, voffA); PG8_STAGE(PG8_SB(1, 1), cB + hstep + kstep, voffB);
        PG8_WAIT_V(6); PG8_BAR;
    } else {
        PG8_STAGE(PG8_SB(0, 0), cB, voffB); PG8_STAGE(PG8_SA(0, 0), cA, voffA); PG8_STAGE(PG8_SB(0, 1), cB + hstep, voffB); PG8_STAGE(PG8_SA(0, 1), cA + hstep, voffA);
        if (wr == 1) PG8_BAR;
        PG8_WAIT_V(4); PG8_BAR;
        PG8_STAGE(PG8_SB(1, 0), cB + kstep, voffB); PG8_STAGE(PG8_SA(1, 0), cA + kstep, voffA); PG8_STAGE(PG8_SB(1, 1), cB + hstep + kstep, voffB);
        PG8_WAIT_V(6); PG8_BAR;
    }
    for (;;) {
        const bool has_next = S.next(ui + 1, nxt);
        const char* nA = has_next ? (const char*)g.A + (size_t)nxt.pm * tstep : cA; const char* nB = has_next ? (const char*)g.Bt + (size_t)nxt.pn * tstep : cB;
        for (int t = 0; t < nt; t += 2) {
            const bool last = (t == nt - 2);
            const char* a1 = cA + (size_t)(t + 1) * kstep;
            const char* a2 = last ? nA : cA + (size_t)(t + 2) * kstep; const char* b2 = last ? nB : cB + (size_t)(t + 2) * kstep;
            const char* a3 = a2 + kstep; const char* b3 = b2 + kstep;
            if (last && has_next) S.a_ready(nxt);
            if constexpr (SP2) {
            PG8_LDB(B0, 0, 0); PG8_LDB(B1, 0, 1); PG8_SCHED; PG8_LDA(At, 0, 0); PG8_STAGE(PG8_SA(1, 1), a1 + hstep, voffA);
            PG8_WAIT_V(8); PG8_WAIT_L(0); PG8_BAR; PG8_MMA(0, 0, At, B0); PG8_MMA(0, 1, At, B1); PG8_BAR; PG8_SCHED;
            PG8_LDA(At, 0, 1); PG8_STAGE(PG8_SB(0, 0), b2, voffB); PG8_STAGE(PG8_SB(0, 1), b2 + hstep, voffB); PG8_STAGE(PG8_SA(0, 0), a2, voffA);
            PG8_WAIT_V(8); PG8_WAIT_L(0); PG8_BAR; PG8_MMA(1, 0, At, B0); PG8_MMA(1, 1, At, B1); PG8_BAR; PG8_SCHED;
            PG8_LDB(B0, 1, 0); PG8_LDB(B1, 1, 1); PG8_SCHED; PG8_LDA(At, 1, 0); PG8_STAGE(PG8_SA(0, 1), a2 + hstep, voffA);
            PG8_WAIT_V(8); PG8_WAIT_L(0); PG8_BAR; PG8_MMA(0, 0, At, B0); PG8_MMA(0, 1, At, B1); PG8_BAR; PG8_SCHED;
            PG8_LDA(At, 1, 1); PG8_STAGE(PG8_SB(1, 0), b3, voffB); PG8_STAGE(PG8_SB(1, 1), b3 + hstep, voffB); PG8_STAGE(PG8_SA(1, 0), a3, voffA);
            PG8_WAIT_V(8); PG8_WAIT_L(0); PG8_BAR; PG8_MMA(1, 0, At, B0); PG8_MMA(1, 1, At, B1); PG8_BAR; PG8_SCHED;
            } else {
            PG8_LDB(B0, 0, 0); PG8_SCHED; PG8_LDA(At, 0, 0); PG8_STAGE(PG8_SA(1, 1), a1 + hstep, voffA);
            PG8_WAIT_L(8); PG8_BAR; PG8_WAIT_L(0); PG8_MMA(0, 0, At, B0); PG8_BAR; PG8_SCHED;
            PG8_LDB(B1, 0, 1); PG8_STAGE(PG8_SB(0, 0), b2, voffB);
            PG8_BAR; PG8_WAIT_L(0); PG8_MMA(0, 1, At, B1); PG8_BAR;
            PG8_LDA(At, 0, 1); PG8_STAGE(PG8_SA(0, 0), a2, voffA);
            PG8_BAR; PG8_WAIT_L(0); PG8_MMA(1, 0, At, B0); PG8_BAR; PG8_SCHED;
            PG8_STAGE(PG8_SB(0, 1), b2 + hstep, voffB);
            PG8_WAIT_V(6); PG8_BAR; PG8_MMA(1, 1, At, B1); PG8_BAR;
            PG8_LDB(B0, 1, 0); PG8_SCHED; PG8_LDA(At, 1, 0); PG8_STAGE(PG8_SA(0, 1), a2 + hstep, voffA);
            PG8_WAIT_L(8); PG8_BAR; PG8_WAIT_L(0); PG8_MMA(0, 0, At, B0); PG8_BAR; PG8_SCHED;
            PG8_LDB(B1, 1, 1); PG8_STAGE(PG8_SB(1, 0), b3, voffB);
            PG8_BAR; PG8_WAIT_L(0); PG8_MMA(0, 1, At, B1); PG8_BAR;
            PG8_LDA(At, 1, 1); PG8_STAGE(PG8_SA(1, 0), a3, voffA);
            PG8_BAR; PG8_WAIT_L(0); PG8_MMA(1, 0, At, B0); PG8_BAR; PG8_SCHED;
            PG8_STAGE(PG8_SB(1, 1), b3 + hstep, voffB);
            PG8_WAIT_V(6); PG8_BAR; PG8_MMA(1, 1, At, B1); PG8_BAR;
            }
        }
        if constexpr (ALIGN_EPI) { if (wr == 0) PG8_BAR; }
        if constexpr (!Epi::AFTER_DRAIN) { E(acc, cur, wr, wc, fr, fq); S.done(cur); }
        if (!has_next) break;
#pragma unroll
        for (int a = 0; a < 2; ++a)
#pragma unroll
            for (int b = 0; b < 2; ++b)
#pragma unroll
                for (int m = 0; m < 4; ++m)
#pragma unroll
                    for (int n = 0; n < 2; ++n) acc[a][b][m][n] = (f32x4){0.f, 0.f, 0.f, 0.f};
        cur = nxt; cA = nA; cB = nB; ++ui;
        if constexpr (ALIGN_EPI) { if (wr == 1) PG8_BAR; }
    }
    PG8_WAIT_V(0);
    if constexpr (!ALIGN_EPI) { if (wr == 0) PG8_BAR; }
    PG8_BAR;
    if constexpr (Epi::AFTER_DRAIN) { E.fused(acc, cur, wr, wc, fr, fq, lds, wid, lane); S.done(cur); }
#undef PG8_SA
#undef PG8_SB
#undef PG8_STAGE
#undef PG8_LDA
#undef PG8_LDB
#undef PG8_MMA
#undef PG8_WAIT_V
#undef PG8_WAIT_L
#undef PG8_BAR
#undef PG8_SCHED
}
}

constexpr int BATCH = 2, SEQ = 8192, DM = 1024, DEPTH = 2, M = BATCH * SEQ;
constexpr int RW_H = 6, HD = 64, RW_W = 384, RW_SHIFT = 1280;
constexpr int NIN = 3712, NU = 3840;
constexpr int C_R = 0, C_K = 384, C_V = 768, C_WL = 1152, C_AL = 1216, C_RWZ = 1280, C_HGQ = 1664, C_HGF = 2048, C_HGI = 2432, C_HGZ = 2816, C_LRUX = 3200, C_LRUZ = 3456;
constexpr int CH = 64;
constexpr int NWAVES = 8, NT = NWAVES * 64;
constexpr int LDS_BYTES = 163840;
constexpr int PRM_OFF = 154624;
constexpr size_t MiB = 1u << 20;
constexpr size_t WS_WUPT = 65536, WS_AUPT = WS_WUPT + 98304, WS_VDNT = WS_AUPT + 98304, WS_VUPT = WS_VDNT + 24576, WS_WAT = WS_VUPT + 24576, WS_WXT = WS_WAT + 65536;
constexpr size_t WS_WIN = 1 * MiB, WIN_L = (size_t)NU * DM * 2;
constexpr size_t WS_WOUT = 16 * MiB, WOUT_L = (size_t)DM * DM * 2;
constexpr size_t WS_XN = 20 * MiB;
constexpr size_t WS_QT = 20 * MiB;
constexpr size_t WS_PT = 32 * MiB;
constexpr size_t WS_CA = 44 * MiB;
constexpr size_t WS_U = 52 * MiB;
constexpr size_t WS_MIX = 172 * MiB;
constexpr size_t WS_VF = 204 * MiB;
constexpr size_t WS_VP = 216 * MiB;
constexpr size_t WS_RL = 228 * MiB;
constexpr size_t WS_HL = 240 * MiB;
constexpr size_t WS_BON = 252 * MiB;
constexpr size_t WS_DC = WS_BON + 512 * 1024;
constexpr size_t WS_LA = WS_DC + 512 * 1024;
constexpr size_t WS_LH = WS_LA + 256 * 1024;
constexpr size_t WS_RSS = WS_LH + 256 * 1024;
constexpr size_t WS_END = 254 * MiB;
constexpr int NCH = SEQ / CH;

#define LAS __attribute__((address_space(3)))
typedef float f32x4 __attribute__((ext_vector_type(4)));
typedef unsigned u32x2 __attribute__((ext_vector_type(2)));
typedef unsigned u32x4 __attribute__((ext_vector_type(4)));
typedef _Float16 f16;
typedef _Float16 f16x8 __attribute__((ext_vector_type(8)));
#define LDS_WAIT() asm volatile("s_waitcnt lgkmcnt(0)" ::: "memory")

struct Args { const float* in[27]; float* out; unsigned char* ws; };

__device__ __forceinline__ float wave_sum(float v) {
#pragma unroll
    for (int o = 1; o < 64; o <<= 1) v += shfl_xor_f(v, o);
    return v;
}
__device__ __forceinline__ float sigmoidf_(float x) { return __builtin_amdgcn_rcpf(1.0f + __expf(-x)); }
__device__ __forceinline__ float rsq_(float x) { return __builtin_amdgcn_rsqf(x); }
__device__ __forceinline__ float one_minus_exp_(float x) { return (x > -0.03f) ? -x * (1.0f + x * (0.5f + x * (1.0f / 6.0f + x * (1.0f / 24.0f)))) : 1.0f - __expf(x); }
__device__ __forceinline__ float siluf_(float x) { return x * __builtin_amdgcn_rcpf(1.0f + __expf(-x)); }

__device__ __forceinline__ void p0_transpose_item(const float* W, int K, int N, unsigned short* WT, LAS float* scr, int item, int lane, const float* rsc) {
    const int nblk = N / 32, kb = item / nblk, nb = item % nblk, k0 = 64 * kb, n0 = 32 * nb;
    float tv[32];
#pragma unroll
    for (int i = 0; i < 32; ++i) { const int kk = 2 * i + (lane >> 5); tv[i] = W[(size_t)(k0 + kk) * N + n0 + (lane & 31)]; }
#pragma unroll
    for (int i = 0; i < 32; ++i) { const int kk = 2 * i + (lane >> 5); scr[kk * 33 + (lane & 31)] = tv[i] * (rsc ? rsc[k0 + kk] : 1.0f); }
    LDS_WAIT(); asm volatile("" ::: "memory");
    const int c = lane & 7;
#pragma unroll
    for (int j = 0; j < 4; ++j) { const int n = (lane >> 3) + 8 * j; const LAS float* s = scr + (8 * c) * 33 + n;
        u32x4 o; o.x = pg8::pk_f16(s[0 * 33], s[1 * 33]); o.y = pg8::pk_f16(s[2 * 33], s[3 * 33]); o.z = pg8::pk_f16(s[4 * 33], s[5 * 33]); o.w = pg8::pk_f16(s[6 * 33], s[7 * 33]);
        *(u32x4*)(WT + (size_t)(n0 + n) * K + k0 + 8 * c) = o; }
    LDS_WAIT(); asm volatile("" ::: "memory");
}
__device__ __forceinline__ void rms_row_f16(const float* xrow, const float* w, unsigned short* orow, int lane) {
    const f32x4* xr = (const f32x4*)xrow + lane; const f32x4* wr = (const f32x4*)w + lane;
    f32x4 v[4]; float s = 0.f;
#pragma unroll
    for (int j = 0; j < 4; ++j) { v[j] = xr[64 * j]; s += (v[j].x * v[j].x + v[j].y * v[j].y) + (v[j].z * v[j].z + v[j].w * v[j].w); }
    const float rs = 1.0f / sqrtf(wave_sum(s) * (1.0f / DM) + 1e-6f);
    u32x2* o8 = (u32x2*)orow + lane;
#pragma unroll
    for (int j = 0; j < 4; ++j) { const f32x4 ww = wr[64 * j]; u32x2 o; o.x = pg8::pk_f16(v[j].x * rs * ww.x, v[j].y * rs * ww.y); o.y = pg8::pk_f16(v[j].z * rs * ww.z, v[j].w * rs * ww.w); o8[64 * j] = o; }
}
__device__ __forceinline__ void rms_row_f32(float* xrow, const float* w, int lane) {
    f32x4* xr = (f32x4*)xrow + lane; const f32x4* wr = (const f32x4*)w + lane;
    f32x4 v[4]; float s = 0.f;
#pragma unroll
    for (int j = 0; j < 4; ++j) { v[j] = xr[64 * j]; s += (v[j].x * v[j].x + v[j].y * v[j].y) + (v[j].z * v[j].z + v[j].w * v[j].w); }
    const float rs = 1.0f / sqrtf(wave_sum(s) * (1.0f / DM) + 1e-6f);
#pragma unroll
    for (int j = 0; j < 4; ++j) { const f32x4 ww = wr[64 * j]; xr[64 * j] = v[j] * rs * ww; }
}

__device__ __forceinline__ void rms_row2_f32(float* xa, float* xb, const float* w, int lane) {
    f32x4* ra = (f32x4*)xa + lane; f32x4* rb = (f32x4*)xb + lane; const f32x4* wr = (const f32x4*)w + lane;
    f32x4 va[4], vb[4]; float sa = 0.f, sb = 0.f;
#pragma unroll
    for (int j = 0; j < 4; ++j) { va[j] = ra[64 * j]; vb[j] = rb[64 * j]; }
#pragma unroll
    for (int j = 0; j < 4; ++j) { sa += (va[j].x * va[j].x + va[j].y * va[j].y) + (va[j].z * va[j].z + va[j].w * va[j].w); sb += (vb[j].x * vb[j].x + vb[j].y * vb[j].y) + (vb[j].z * vb[j].z + vb[j].w * vb[j].w); }
    const float rsa = 1.0f / sqrtf(wave_sum(sa) * (1.0f / DM) + 1e-6f), rsb = 1.0f / sqrtf(wave_sum(sb) * (1.0f / DM) + 1e-6f);
#pragma unroll
    for (int j = 0; j < 4; ++j) { const f32x4 ww = wr[64 * j]; ra[64 * j] = va[j] * rsa * ww; rb[64 * j] = vb[j] * rsb * ww; }
}
__device__ __forceinline__ void rms_row4_f16(const float* x0, size_t rs, const float* w, unsigned short* o0, int lane) {
    f32x4 v[4][4]; float s[4];
#pragma unroll
    for (int r = 0; r < 4; ++r)
#pragma unroll
        for (int j = 0; j < 4; ++j) v[r][j] = ((const f32x4*)(x0 + r * rs) + lane)[64 * j];
    const f32x4* wr = (const f32x4*)w + lane;
#pragma unroll
    for (int r = 0; r < 4; ++r) { float a = 0.f;
#pragma unroll
        for (int j = 0; j < 4; ++j) a += (v[r][j].x * v[r][j].x + v[r][j].y * v[r][j].y) + (v[r][j].z * v[r][j].z + v[r][j].w * v[r][j].w);
        s[r] = 1.0f / sqrtf(wave_sum(a) * (1.0f / DM) + 1e-6f); }
#pragma unroll
    for (int j = 0; j < 4; ++j) { const f32x4 ww = wr[64 * j];
#pragma unroll
        for (int r = 0; r < 4; ++r) { u32x2 o; o.x = pg8::pk_f16(v[r][j].x * s[r] * ww.x, v[r][j].y * s[r] * ww.y); o.y = pg8::pk_f16(v[r][j].z * s[r] * ww.z, v[r][j].w * s[r] * ww.w); ((u32x2*)(o0 + r * rs) + lane)[64 * j] = o; } }
}
__device__ __forceinline__ void rms_row4_f32(float* x0, size_t rs, const float* w, int lane) {
    f32x4 v[4][4]; float s[4];
#pragma unroll
    for (int r = 0; r < 4; ++r)
#pragma unroll
        for (int j = 0; j < 4; ++j) v[r][j] = ((const f32x4*)(x0 + r * rs) + lane)[64 * j];
    const f32x4* wr = (const f32x4*)w + lane;
#pragma unroll
    for (int r = 0; r < 4; ++r) { float a = 0.f;
#pragma unroll
        for (int j = 0; j < 4; ++j) a += (v[r][j].x * v[r][j].x + v[r][j].y * v[r][j].y) + (v[r][j].z * v[r][j].z + v[r][j].w * v[r][j].w);
        s[r] = rsq_(wave_sum(a) * (1.0f / DM) + 1e-6f); }
#pragma unroll
    for (int j = 0; j < 4; ++j) { const f32x4 ww = wr[64 * j];
#pragma unroll
        for (int r = 0; r < 4; ++r) ((f32x4*)(x0 + r * rs) + lane)[64 * j] = v[r][j] * s[r] * ww; }
}

#define SHV(col) ({ const float cur_ = (float)urow[(col)]; const float prev_ = hp ? (float)prow[(col)] : 0.f; cur_ + mu[(col)] * (prev_ - cur_); })

__device__ __forceinline__ void store_row64_f16(f16* dst, const float (&S)[64]) {
#pragma unroll
    for (int q = 0; q < 8; ++q) { u32x4 w; w.x = pg8::pk_f16(S[8 * q], S[8 * q + 1]); w.y = pg8::pk_f16(S[8 * q + 2], S[8 * q + 3]); w.z = pg8::pk_f16(S[8 * q + 4], S[8 * q + 5]); w.w = pg8::pk_f16(S[8 * q + 6], S[8 * q + 7]); *(u32x4*)(dst + 8 * q) = w; }
}


constexpr int RWT_ROW = 144, RWT_A = 0, RWT_R = 2304, RWT_B = 4608, RWT_K = 6912;
constexpr int RWC_B = 9216, RWC_K = 11264, RWC_V = 13312;
constexpr int RWF_G16 = 15360, RWF_RHO = 15616, RWA_INV = 15872, RWA_NMAT = 15936  , RWA_XPARK = 18496  , RWA_BYTES = 20992;
constexpr int C_VD0 = 3712, C_VD1 = 3744;
constexpr int PRM_MU = 0, PRM_A0 = 1280, PRM_KK = 1664, PRM_KA = 2048, PRM_RK = 2432, PRM_V0 = 2816, PRM_HALVES = 3200, PRM_W0_BYTE = 6400, PRM_BYTES = PRM_W0_BYTE + 1536;
typedef float f32x2 __attribute__((ext_vector_type(2)));
typedef _Float16 f16x4 __attribute__((ext_vector_type(4)));
__device__ __forceinline__ float fmix_lo(float a, unsigned b, float c) { float d; asm("v_fma_mix_f32 %0, %1, %2, %3 op_sel:[0,0,0] op_sel_hi:[0,1,0]" : "=v"(d) : "v"(a), "v"(b), "v"(c)); return d; }
__device__ __forceinline__ float fmix_hi(float a, unsigned b, float c) { float d; asm("v_fma_mix_f32 %0, %1, %2, %3 op_sel:[0,1,0] op_sel_hi:[0,1,0]" : "=v"(d) : "v"(a), "v"(b), "v"(c)); return d; }
__device__ __forceinline__ float mmix_lo(float a, unsigned b) { float d; asm("v_fma_mix_f32 %0, %1, %2, 0 op_sel:[0,0,0] op_sel_hi:[0,1,0]" : "=v"(d) : "v"(a), "v"(b)); return d; }
__device__ __forceinline__ float mmix_hi(float a, unsigned b) { float d; asm("v_fma_mix_f32 %0, %1, %2, 0 op_sel:[0,1,0] op_sel_hi:[0,1,0]" : "=v"(d) : "v"(a), "v"(b)); return d; }
__device__ __forceinline__ float mul_asm(float a, float b) { float d; asm("v_mul_f32 %0, %1, %2" : "=v"(d) : "v"(a), "v"(b)); return d; }
__device__ __forceinline__ float fma_asm(float a, float b, float c) { float d; asm("v_fma_f32 %0, %1, %2, %3" : "=v"(d) : "v"(a), "v"(b), "v"(c)); return d; }
#define FMIX(a, u, j, c) (((j) & 1) ? fmix_hi((a), (u)[(j) >> 1], (c)) : fmix_lo((a), (u)[(j) >> 1], (c)))
#define MMIX(a, u, j) (((j) & 1) ? mmix_hi((a), (u)[(j) >> 1]) : mmix_lo((a), (u)[(j) >> 1]))
__device__ __forceinline__ float fast_tanh(float x) { return 1.0f - 2.0f * __builtin_amdgcn_rcpf(__expf(2.0f * x) + 1.0f); }
__device__ __forceinline__ void lerp8(const char* ub, unsigned uo, unsigned po, bool hp, const char* mub, unsigned col, float (&x)[8]) {
    const f16x8 cu = *(const f16x8*)(ub + (uo + col * 2u)); f16x8 pv = *(const f16x8*)(ub + (po + col * 2u)); const f32x4 m0 = *(const f32x4*)(mub + col * 4u), m1 = *(const f32x4*)(mub + col * 4u + 16u);
#pragma unroll
    for (int j = 0; j < 8; ++j) { const float c = (float)cu[j], p = hp ? (float)pv[j] : 0.f; x[j] = c + (j < 4 ? m0[j] : m1[j - 4]) * (p - c); }
}
__device__ __forceinline__ void lerp4(const char* ub, unsigned uo, unsigned po, bool hp, const char* mub, unsigned col, float (&x)[4]) {
    const f16x4 cu = *(const f16x4*)(ub + (uo + col * 2u)); f16x4 pv = *(const f16x4*)(ub + (po + col * 2u)); const f32x4 m0 = *(const f32x4*)(mub + col * 4u);
#pragma unroll
    for (int j = 0; j < 4; ++j) { const float c = (float)cu[j], p = hp ? (float)pv[j] : 0.f; x[j] = c + m0[j] * (p - c); }
}
__device__ __forceinline__ f16x8 pack8(const float (&x)[8]) { f16x8 r;
#pragma unroll
    for (int j = 0; j < 8; ++j) r[j] = (f16)x[j];
    return r; }

template <int CTRL> __device__ __forceinline__ float dpp_f(float x) { return __builtin_bit_cast(float, __builtin_amdgcn_update_dpp(0, __builtin_bit_cast(int, x), CTRL, 0xF, 0xF, true)); }
__device__ __forceinline__ float row_prefix16(float x) { x += dpp_f<0x111>(x); x += dpp_f<0x112>(x); x += dpp_f<0x114>(x); x += dpp_f<0x118>(x); return x; }
__device__ __forceinline__ float bperm_f(int byteaddr, float x) { return __builtin_bit_cast(float, __builtin_amdgcn_ds_bpermute(byteaddr, __builtin_bit_cast(int, x))); }
__device__ __forceinline__ f16x4 cvt4(const f32x4 v) { f16x4 r; r[0] = (f16)v[0]; r[1] = (f16)v[1]; r[2] = (f16)v[2]; r[3] = (f16)v[3]; return r; }
#define MF16(A, B, C) __builtin_amdgcn_mfma_f32_16x16x16f16((A), (B), (C), 0, 0, 0)
#define MF32(A, B, C) __builtin_amdgcn_mfma_f32_16x16x32_f16((A), (B), (C), 0, 0, 0)

__device__ __forceinline__ void rwkv_waveA(const Args& a, int l, int b, int c, int h, LAS unsigned char* wl, const LAS unsigned char* prmb, int lane) {
    const LAS f16* prm = (const LAS f16*)prmb; const LAS float* prw0 = (const LAS float*)(prmb + PRM_W0_BYTE);
    const char* Ub = (const char*)(a.ws + WS_U); f16* MIX = (f16*)(a.ws + WS_MIX); char* VF = (char*)(a.ws + WS_VF); char* VP = (char*)(a.ws + WS_VP);
    f16* QT = (f16*)(a.ws + WS_QT); f16* PT = (f16*)(a.ws + WS_PT); f16* RL = (f16*)(a.ws + WS_RL); float* BONG = (float*)(a.ws + WS_BON);
    const char* WUPT = (const char*)(a.ws + WS_WUPT) + (size_t)l * 384 * 64 * 2; const char* AUPT = (const char*)(a.ws + WS_AUPT) + (size_t)l * 384 * 64 * 2;
    const char* VUPT = (const char*)(a.ws + WS_VUPT);
    const int bh = b * RW_H + h;
    f32x4 XT[4][8];
#pragma unroll
    for (int ct = 0; ct < 4; ++ct)
#pragma unroll
        for (int vt = 0; vt < 8; ++vt)
#pragma unroll
            for (int r = 0; r < 4; ++r) XT[ct][vt][r] = (vt == ct && (lane & 15) == 4 * (lane >> 4) + r) ? 1.f : 0.f;
#define XPK(ct, vt) ((vt) == 7 && (ct) >= 2)
#define XPA(ct) (*(LAS f32x4*)(wl + RWA_XPARK + ((ct) - 2) * 1024 + lane_now() * 16))
    XPA(2) = (f32x4){0.f, 0.f, 0.f, 0.f}; XPA(3) = (f32x4){0.f, 0.f, 0.f, 0.f};
#pragma unroll 1
    for (int blk = 0; blk < 4; ++blk) {
        const int lane_ = lane_now();
        const int tok = lane_ & 15, fq = lane_ >> 4;
        const int t = c * CH + blk * 16 + tok; const unsigned m = (unsigned)(b * SEQ + t); const bool hp = t > 0;
        const unsigned uo = m * (unsigned)(NU * 2), po = hp ? uo - (unsigned)(NU * 2) : uo;
        f16x8 cW[2], pW[2], cA[2], pA[2], vd0, vd1;
#pragma unroll
        for (int s = 0; s < 2; ++s) { const unsigned cw = (unsigned)(C_WL + 8 * fq + 32 * s) * 2u, ca = (unsigned)(C_AL + 8 * fq + 32 * s) * 2u;
            cW[s] = *(const f16x8*)(Ub + uo + cw); pW[s] = *(const f16x8*)(Ub + po + cw); cA[s] = *(const f16x8*)(Ub + uo + ca); pA[s] = *(const f16x8*)(Ub + po + ca); }
        vd0 = *(const f16x8*)(Ub + uo + (unsigned)(C_VD0 + 8 * fq) * 2u); vd1 = *(const f16x8*)(Ub + po + (unsigned)(C_VD1 + 8 * fq) * 2u);
#define RW_WLOAD(nt) { const unsigned n_ = (unsigned)(h * 64 + 16 * (nt) + tok);        \
            Wwu0 = *(const f16x8*)(WUPT + (n_ * 64u + 8u * fq) * 2u); Wwu1 = *(const f16x8*)(WUPT + (n_ * 64u + 8u * fq + 32u) * 2u); \
            Wau0 = *(const f16x8*)(AUPT + (n_ * 64u + 8u * fq) * 2u); Wau1 = *(const f16x8*)(AUPT + (n_ * 64u + 8u * fq + 32u) * 2u); \
            if (l > 0) Wvu = *(const f16x8*)(VUPT + (n_ * 32u + 8u * fq) * 2u); }
#define RW_ADECL(X) f16x4 X##cr, X##pr, X##ck, X##pk, X##cv, X##pv, X##vf;
#define RW_ALOAD(X, nt) { const unsigned cb_ = (unsigned)(h * 64 + 16 * (nt) + 4 * fq);        \
            if (l > 0) X##vf = *(const f16x4*)(VF + (m * (unsigned)RW_W + cb_) * 2u); \
            X##cr = *(const f16x4*)(Ub + uo + ((unsigned)C_R + cb_) * 2u); X##pr = *(const f16x4*)(Ub + po + ((unsigned)C_R + cb_) * 2u); \
            X##ck = *(const f16x4*)(Ub + uo + ((unsigned)C_K + cb_) * 2u); X##pk = *(const f16x4*)(Ub + po + ((unsigned)C_K + cb_) * 2u); \
            X##cv = *(const f16x4*)(Ub + uo + ((unsigned)C_V + cb_) * 2u); X##pv = *(const f16x4*)(Ub + po + ((unsigned)C_V + cb_) * 2u); }
        f16x8 Wwu0, Wwu1, Wau0, Wau1, Wvu; RW_ADECL(T0)
        f16x8 bW[2], bA[2], bVD;
#pragma unroll
        for (int s = 0; s < 2; ++s) { float xw[8], xa[8];
            const f16x8 mw = *(const LAS f16x8*)(prm + PRM_MU + C_WL + 8 * fq + 32 * s), ma = *(const LAS f16x8*)(prm + PRM_MU + C_AL + 8 * fq + 32 * s);
#pragma unroll
            for (int j = 0; j < 8; ++j) { const float cw_ = (float)cW[s][j], pw_ = hp ? (float)pW[s][j] : 0.f, ca_ = (float)cA[s][j], pa_ = hp ? (float)pA[s][j] : 0.f;
                xw[j] = fast_tanh(cw_ + (float)mw[j] * (pw_ - cw_)); xa[j] = ca_ + (float)ma[j] * (pa_ - ca_); }
            bW[s] = pack8(xw); bA[s] = pack8(xa); }
        { float xv[8];
#pragma unroll
            for (int j = 0; j < 8; ++j) xv[j] = (float)vd0[j] + (hp ? (float)vd1[j] : 0.f);
            bVD = pack8(xv); }
        float ssq = 0.f, bon = 0.f;
        RW_WLOAD(0) asm volatile("" ::: "memory");
        const int bp7 = ((lane_ & 48) | 7) << 2, bp15 = ((lane_ & 48) | 15) << 2;
        f32x4 DWn, DAn, Gn;
#define RW_TMFMA() { DWn = (f32x4){0.f, 0.f, 0.f, 0.f}; DAn = DWn; Gn = DWn; \
            DWn = __builtin_amdgcn_mfma_f32_16x16x32_f16(Wwu0, bW[0], DWn, 0, 0, 0); DWn = __builtin_amdgcn_mfma_f32_16x16x32_f16(Wwu1, bW[1], DWn, 0, 0, 0); \
            DAn = __builtin_amdgcn_mfma_f32_16x16x32_f16(Wau0, bA[0], DAn, 0, 0, 0); DAn = __builtin_amdgcn_mfma_f32_16x16x32_f16(Wau1, bA[1], DAn, 0, 0, 0); \
            if (l > 0) Gn = __builtin_amdgcn_mfma_f32_16x16x32_f16(Wvu, bVD, Gn, 0, 0, 0); \
            asm volatile("" : "+v"(DWn), "+v"(DAn), "+v"(Gn)); }
#define RW_TCOMP(X, nt) { const int cb = h * 64 + 16 * (nt) + 4 * fq, co = 16 * (nt) + 4 * fq; \
            f16x4 ah, rh, bh, kh, bb, kb, vo; f32x4 rho4, g164; \
            _Pragma("unroll") for (int ip = 0; ip < 4; ip += 2) { f32x2 g2v, Giv, G8v, G16v; \
            _Pragma("unroll") for (int i2 = 0; i2 < 2; ++i2) { g2v[i2] = -0.875036877f * sigmoidf_(prw0[cb + ip + i2] + DWn[ip + i2]);      \
                Giv[i2] = row_prefix16(g2v[i2]); } \
            _Pragma("unroll") for (int i2 = 0; i2 < 2; ++i2) { G8v[i2] = bperm_f(bp7, Giv[i2]); G16v[i2] = bperm_f(bp15, Giv[i2]); }       \
            _Pragma("unroll") for (int i2 = 0; i2 < 2; ++i2) { const int i = ip + i2; const LAS f16* pc = prm + cb + i; \
                const float cr_ = (float)X##cr[i], ck_ = (float)X##ck[i], cv_ = (float)X##cv[i]; \
                const float rs = cr_ + (float)pc[PRM_MU + C_R] * ((hp ? (float)X##pr[i] : 0.f) - cr_), ks = ck_ + (float)pc[PRM_MU + C_K] * ((hp ? (float)X##pk[i] : 0.f) - ck_), vs = cv_ + (float)pc[PRM_MU + C_V] * ((hp ? (float)X##pv[i] : 0.f) - cv_); \
                const float aa = sigmoidf_((float)pc[PRM_A0] + DAn[i]); \
                float vv = vs; if (l > 0) vv = vs + ((float)X##vf[i] - vs) * sigmoidf_((float)pc[PRM_V0] + Gn[i]); \
                const float kk = ks * (float)pc[PRM_KK]; ssq += kk * kk; \
                const float kmod = ks * (1.0f + (aa - 1.0f) * (float)pc[PRM_KA]); \
                bon += rs * kmod * (float)pc[PRM_RK]; \
                const float bq = kk * aa; \
                const float g2 = g2v[i2], Gi = Giv[i2], G8 = G8v[i2], G16 = G16v[i2]; \
                const float e1 = __builtin_amdgcn_exp2f(Gi - G8), e1m = __builtin_amdgcn_exp2f((Gi - g2) - G8), einv = __builtin_amdgcn_exp2f(G8 - Gi), esuf = __builtin_amdgcn_exp2f(G16 - Gi); \
                rho4[i] = __builtin_amdgcn_exp2f(G8); g164[i] = __builtin_amdgcn_exp2f(G16); \
                ah[i] = (f16)(-kk * e1m); rh[i] = (f16)(rs * e1); bh[i] = (f16)(bq * einv); kh[i] = (f16)(kmod * einv); bb[i] = (f16)(bq * esuf); kb[i] = (f16)(kmod * esuf); vo[i] = (f16)vv; asm volatile("" ::: "memory"); } } \
            *(LAS f16x4*)(wl + RWT_A + tok * RWT_ROW + co * 2) = ah; *(LAS f16x4*)(wl + RWT_R + tok * RWT_ROW + co * 2) = rh; \
            *(LAS f16x4*)(wl + RWT_B + tok * RWT_ROW + co * 2) = bh; *(LAS f16x4*)(wl + RWT_K + tok * RWT_ROW + co * 2) = kh; \
            _Pragma("unroll") for (int i = 0; i < 4; ++i) { *(LAS f16*)(wl + RWC_B + (co + i) * 32 + tok * 2) = bb[i]; *(LAS f16*)(wl + RWC_K + (co + i) * 32 + tok * 2) = kb[i]; *(LAS f16*)(wl + RWC_V + (co + i) * 32 + tok * 2) = vo[i]; } \
            if (tok == 0) { *(LAS f32x4*)(wl + RWF_RHO + co * 4) = rho4; *(LAS f32x4*)(wl + RWF_G16 + co * 4) = g164; } \
            *(f16x4*)(VP + (m * (unsigned)RW_W + (unsigned)cb) * 2u) = vo; \
            if (l == 0) *(f16x4*)(VF + (m * (unsigned)RW_W + (unsigned)cb) * 2u) = vo; }
#pragma unroll 1
        for (int nt = 0; nt < 4; ++nt) { const int nn = (nt + 1) & 3;
            RW_ALOAD(T0, nt) asm volatile("" ::: "memory"); RW_TMFMA() asm volatile("" ::: "memory"); RW_WLOAD(nn) asm volatile("" ::: "memory"); RW_TCOMP(T0, nt) asm volatile("" ::: "memory"); }
#undef RW_WLOAD
#undef RW_ALOAD
#undef RW_ADECL
#undef RW_TMFMA
#undef RW_TCOMP
        ssq += shfl_xor_f(ssq, 16); ssq += shfl_xor_f(ssq, 32);
        bon += shfl_xor_f(bon, 16); bon += shfl_xor_f(bon, 32);
        { const float inv2v = __builtin_amdgcn_rcpf(fmaxf(ssq, 1e-24f));
          if (fq == 0) { *(LAS float*)(wl + RWA_INV + tok * 4) = inv2v; *(float*)((char*)BONG + (m * 8u + (unsigned)h) * 4u) = bon; } }
        const unsigned mb = (unsigned)(b * SEQ + c * CH + blk * 16);
        const int q4 = fq * 4;
        f16x4 N1, N1T, MkH, NbH, NkH;
        { f16x8 fa[2], fr[2], fb[2], fk[2];
#pragma unroll
          for (int s = 0; s < 2; ++s) { const int o = tok * RWT_ROW + (32 * s + q4) * 2;
#define RW_FRAG(F, T) { const f16x4 lo_ = *(const LAS f16x4*)(wl + (T) + o), hi_ = *(const LAS f16x4*)(wl + (T) + o + 32); F[s] = (f16x8){lo_[0], lo_[1], lo_[2], lo_[3], hi_[0], hi_[1], hi_[2], hi_[3]}; }
              RW_FRAG(fa, RWT_A) RW_FRAG(fr, RWT_R) RW_FRAG(fb, RWT_B) RW_FRAG(fk, RWT_K)
#undef RW_FRAG
          }
          const f32x4 z4 = (f32x4){0.f, 0.f, 0.f, 0.f};
          f32x4 Mb = MF32(fb[1], fa[1], MF32(fb[0], fa[0], z4)), MbT = MF32(fa[1], fb[1], MF32(fa[0], fb[0], z4));
          f32x4 Mk = MF32(fk[1], fa[1], MF32(fk[0], fa[0], z4)), Nb = MF32(fb[1], fr[1], MF32(fb[0], fr[0], z4)), Nk = MF32(fk[1], fr[1], MF32(fk[0], fr[0], z4));
          const f32x4 ivr = *(const LAS f32x4*)(wl + RWA_INV + q4 * 4); const float ivc = *(const LAS float*)(wl + RWA_INV + tok * 4);
#pragma unroll
          for (int r = 0; r < 4; ++r) { const int j = q4 + r;
              Mb[r] = (j < tok) ? Mb[r] * ivr[r] : 0.f; MbT[r] = (tok < j) ? MbT[r] * ivc : 0.f; Mk[r] = (j < tok) ? Mk[r] : 0.f; Nb[r] = (j <= tok) ? Nb[r] : 0.f; Nk[r] = (j <= tok) ? Nk[r] : 0.f; }
          N1 = cvt4(Mb); N1T = cvt4(MbT); MkH = cvt4(Mk); NbH = cvt4(Nb); NkH = cvt4(Nk); }
        const f16x4 N2 = cvt4(MF16(N1T, N1, ((f32x4){0.f, 0.f, 0.f, 0.f}))), N2T = cvt4(MF16(N1, N1T, ((f32x4){0.f, 0.f, 0.f, 0.f})));
        const f16x4 N4 = cvt4(MF16(N2T, N2, ((f32x4){0.f, 0.f, 0.f, 0.f}))), N4T = cvt4(MF16(N2, N2T, ((f32x4){0.f, 0.f, 0.f, 0.f})));
        const f16x4 N8 = cvt4(MF16(N4T, N4, ((f32x4){0.f, 0.f, 0.f, 0.f})));
        { LAS unsigned char* np = wl + RWA_NMAT + lane_ * 8; *(LAS f16x4*)(np) = N2; *(LAS f16x4*)(np + 512) = N4; *(LAS f16x4*)(np + 1024) = N8; *(LAS f16x4*)(np + 1536) = MkH; *(LAS f16x4*)(np + 2048) = NkH; }
#pragma unroll
        for (int hq = 0; hq < 4; ++hq) {
            constexpr int NTQ = 2; const int hv = hq >> 1;
            asm volatile("" ::: "memory");
            const f32x4 ivr2 = *(const LAS f32x4*)(wl + RWA_INV + q4 * 4);
            f32x4 G[NTQ], Y[NTQ]; f16x4 vf[NTQ];
            { f16x8 fa[2], fr[2];
#pragma unroll
              for (int s = 0; s < 2; ++s) { const int o = tok * RWT_ROW + (32 * s + q4) * 2;
#define RW_FRAG(F, T) { const f16x4 lo_ = *(const LAS f16x4*)(wl + (T) + o), hi_ = *(const LAS f16x4*)(wl + (T) + o + 32); F[s] = (f16x8){lo_[0], lo_[1], lo_[2], lo_[3], hi_[0], hi_[1], hi_[2], hi_[3]}; }
                  RW_FRAG(fa, RWT_A) RW_FRAG(fr, RWT_R)
#undef RW_FRAG
              }
#pragma unroll
              for (int t = 0; t < NTQ; ++t) { const int vt = 2 * hq + t; f16x8 xb[2];
#pragma unroll
                for (int s = 0; s < 2; ++s) { const f32x4 r0 = *(const LAS f32x4*)(wl + RWF_RHO + (32 * s + q4) * 4), r1 = *(const LAS f32x4*)(wl + RWF_RHO + (32 * s + 16 + q4) * 4);
                    const f32x4 x0 = (XPK(2 * s, vt) ? XPA(2 * s) : XT[2 * s][vt]) * r0, x1 = (XPK(2 * s + 1, vt) ? XPA(2 * s + 1) : XT[2 * s + 1][vt]) * r1;
                    xb[s] = (f16x8){(f16)x0[0], (f16)x0[1], (f16)x0[2], (f16)x0[3], (f16)x1[0], (f16)x1[1], (f16)x1[2], (f16)x1[3]}; }
                G[t] = MF32(fa[1], xb[1], MF32(fa[0], xb[0], ((f32x4){0.f, 0.f, 0.f, 0.f})));
                Y[t] = MF32(fr[1], xb[1], MF32(fr[0], xb[0], ((f32x4){0.f, 0.f, 0.f, 0.f})));
                if (hv) { vf[t] = *(const LAS f16x4*)(wl + RWC_V + (16 * (vt - 4) + tok) * 32 + q4 * 2); G[t] = MF16(*(const LAS f16x4*)(wl + RWA_NMAT + 1536 + lane_ * 8), vf[t], G[t]); } } }
#pragma unroll
            for (int t = 0; t < NTQ; ++t) G[t] = MF16(N1, cvt4(G[t]), G[t]);
            { const f16x4 Z = *(const LAS f16x4*)(wl + RWA_NMAT + lane_ * 8);
#pragma unroll
            for (int t = 0; t < NTQ; ++t) G[t] = MF16(Z, cvt4(G[t]), G[t]); }
            { const f16x4 Z = *(const LAS f16x4*)(wl + RWA_NMAT + 512 + lane_ * 8);
#pragma unroll
            for (int t = 0; t < NTQ; ++t) G[t] = MF16(Z, cvt4(G[t]), G[t]); }
            { const f16x4 Z = *(const LAS f16x4*)(wl + RWA_NMAT + 1024 + lane_ * 8);
#pragma unroll
            for (int t = 0; t < NTQ; ++t) G[t] = MF16(Z, cvt4(G[t]), G[t]); }
#pragma unroll
            for (int t = 0; t < NTQ; ++t) { const int vt = 2 * hq + t; const int tc = vt & 3;
                const f16x4 uh = cvt4(G[t] * ivr2);
                Y[t] = MF16(NbH, uh, Y[t]); if (hv) Y[t] = MF16(*(const LAS f16x4*)(wl + RWA_NMAT + 2048 + lane_ * 8), vf[t], Y[t]);
                char* yo = hv ? (char*)MIX + ((mb + (unsigned)q4) * (unsigned)DM + (unsigned)(h * 64 + 16 * tc + tok)) * 2u : (char*)QT + ((mb + (unsigned)q4) * (unsigned)RW_W + (unsigned)(h * 64 + 16 * tc + tok)) * 2u;
#pragma unroll
                for (int r = 0; r < 4; ++r) *(f16*)(yo + (unsigned)r * (hv ? (unsigned)(DM * 2) : (unsigned)(RW_W * 2))) = (f16)Y[t][r];
#pragma unroll
                for (int ct = 0; ct < 4; ++ct) { const f32x4 g16 = *(const LAS f32x4*)(wl + RWF_G16 + (16 * ct + q4) * 4);
                    const f16x4 bt = *(const LAS f16x4*)(wl + RWC_B + (16 * ct + tok) * 32 + q4 * 2);
                    f32x4 xn = MF16(bt, uh, (XPK(ct, vt) ? XPA(ct) : XT[ct][vt]) * g16);
                    if (hv) { const f16x4 kt = *(const LAS f16x4*)(wl + RWC_K + (16 * ct + tok) * 32 + q4 * 2); xn = MF16(kt, vf[t], xn); }
                    if (XPK(ct, vt)) XPA(ct) = xn; else XT[ct][vt] = xn; } }
        }
        asm volatile("" ::: "memory");
    }
    { const int lane2 = lane_now(); const int n2 = lane2 & 15, q2 = (lane2 >> 4) * 4;
      f16* rl = RL + ((size_t)bh * NCH + c) * 4096;
      f16* pt = PT + ((size_t)bh * NCH + c) * 4096;
#pragma unroll
      for (int ct = 0; ct < 4; ++ct)
#pragma unroll
          for (int t = 0; t < 4; ++t) { *(f16x4*)(rl + (16 * t + n2) * 64 + 16 * ct + q2) = cvt4(XPK(ct, 4 + t) ? XPA(ct) : XT[ct][4 + t]);
#pragma unroll
              for (int r = 0; r < 4; ++r) pt[(16 * ct + q2 + r) * 64 + 16 * t + n2] = (f16)XT[ct][t][r]; } }
}

constexpr int HGA_REC = 768, HGA_TB = 8  , HGA_V = HGA_TB * HGA_REC, HGA_HEAD = HGA_V + HGA_TB * 128, HGA_BYTES = 2 * HGA_HEAD;
template <int NH>
__device__ __forceinline__ void hgrn_waveA(const Args& a, int l, int b, int c, int h0, LAS unsigned char* wl) {
    char* U = (char*)(a.ws + WS_U); char* MIX = (char*)(a.ws + WS_MIX); f16* HL = (f16*)(a.ws + WS_HL); float* DC = (float*)(a.ws + WS_DC);
    const float* lbr = a.in[16];
    float S[NH][64]; float dpr[NH];
#pragma unroll
    for (int j = 0; j < NH; ++j) { dpr[j] = 1.f;
#pragma unroll
        for (int k = 0; k < 64; ++k) S[j][k] = 0.f; }
#pragma unroll 1
    for (int blk = 0; blk < CH / HGA_TB; ++blk) {
        const int lane_ = lane_now();
        const unsigned mb = (unsigned)(b * SEQ + c * CH + blk * HGA_TB);
        {
            f16 fr[NH][HGA_TB], qr[NH][HGA_TB], vr[NH][HGA_TB];
#pragma unroll
            for (int j = 0; j < NH; ++j)
#pragma unroll
                for (int tk = 0; tk < HGA_TB; ++tk) { const char* ur = U + (mb + tk) * (unsigned)(NU * 2) + (unsigned)((h0 + j) * 64 + lane_) * 2u; fr[j][tk] = *(const f16*)(ur + C_HGF * 2); qr[j][tk] = *(const f16*)(ur + C_HGQ * 2); vr[j][tk] = *(const f16*)(ur + C_HGI * 2); }
#pragma unroll
            for (int j = 0; j < NH; ++j) { const int col = (h0 + j) * 64 + lane_;
                const float lb = (l == 0) ? 0.f : sigmoidf_(lbr[384 + col] - lbr[col]);
                float dp = dpr[j];
#pragma unroll
                for (int tk = 0; tk < HGA_TB; ++tk) {
                    const float f = lb + (1.0f - lb) * sigmoidf_((float)fr[j][tk]);
                    LAS unsigned char* rec = wl + j * HGA_HEAD + tk * HGA_REC;
                    *(LAS float*)(rec + lane_ * 4) = f; *(LAS float*)(rec + 256 + lane_ * 4) = 1.0f - f; *(LAS float*)(rec + 512 + lane_ * 4) = (float)qr[j][tk];
                    *(LAS f16*)(wl + j * HGA_HEAD + HGA_V + tk * 128 + lane_ * 2) = vr[j][tk];
                    dp *= f;
                    *(f16*)(U + (mb + tk) * (unsigned)(NU * 2) + (unsigned)(C_HGQ + col) * 2u) = (f16)((float)qr[j][tk] * dp);
                }
                dpr[j] = dp; }
        }
        asm volatile("s_waitcnt lgkmcnt(0)" ::: "memory");
#define HG_LD(F, K, Q, rcp, g) { F[0] = *(const LAS f32x4*)((rcp) + (g) * 32); F[1] = *(const LAS f32x4*)((rcp) + (g) * 32 + 16); K[0] = *(const LAS f32x4*)((rcp) + 256 + (g) * 32); K[1] = *(const LAS f32x4*)((rcp) + 256 + (g) * 32 + 16); \
            Q[0] = *(const LAS f32x4*)((rcp) + 512 + (g) * 32); Q[1] = *(const LAS f32x4*)((rcp) + 512 + (g) * 32 + 16); asm volatile("" ::: "memory"); }
#define HG_COMP(Sx, vi, F, K, Q, g) { float tt[8]; \
            _Pragma("unroll") for (int jj = 0; jj < 8; ++jj) tt[jj] = mul_asm(vi, K[jj >> 2][jj & 3]); \
            _Pragma("unroll") for (int jj = 0; jj < 8; ++jj) Sx[8 * (g) + jj] = fma_asm(Sx[8 * (g) + jj], F[jj >> 2][jj & 3], tt[jj]); \
            _Pragma("unroll") for (int jj = 0; jj < 8; ++jj) oa[jj] = fma_asm(Sx[8 * (g) + jj], Q[jj >> 2][jj & 3], oa[jj]); }
#define HG_HEAD(Sx, vi, rcp, rcn, oo) { float oa[8]; _Pragma("unroll") for (int jj = 0; jj < 8; ++jj) oa[jj] = 0.f; \
            HG_LD(fo, ko, qo, rcp, 1) HG_COMP(Sx, vi, fe, ke, qe, 0) \
            HG_LD(fe, ke, qe, rcp, 2) HG_COMP(Sx, vi, fo, ko, qo, 1) \
            HG_LD(fo, ko, qo, rcp, 3) HG_COMP(Sx, vi, fe, ke, qe, 2) \
            HG_LD(fe, ke, qe, rcp, 4) HG_COMP(Sx, vi, fo, ko, qo, 3) \
            HG_LD(fo, ko, qo, rcp, 5) HG_COMP(Sx, vi, fe, ke, qe, 4) \
            HG_LD(fe, ke, qe, rcp, 6) HG_COMP(Sx, vi, fo, ko, qo, 5) \
            HG_LD(fo, ko, qo, rcp, 7) HG_COMP(Sx, vi, fe, ke, qe, 6) \
            HG_LD(fe, ke, qe, rcn, 0) HG_COMP(Sx, vi, fo, ko, qo, 7) \
            oo = ((oa[0] + oa[1]) + (oa[2] + oa[3])) + ((oa[4] + oa[5]) + (oa[6] + oa[7])); }
        f32x4 fe[2], ke[2], qe[2], fo[2], ko[2], qo[2];
        HG_LD(fe, ke, qe, wl, 0)
        f16 vh[NH], vn[NH];
#pragma unroll
        for (int j = 0; j < NH; ++j) vh[j] = *(const LAS f16*)(wl + j * HGA_HEAD + HGA_V + lane_ * 2);
#pragma unroll 1
        for (int t2 = 0; t2 < HGA_TB; ++t2) {
            const LAS unsigned char* rc = wl + t2 * HGA_REC;
#pragma unroll
            for (int j = 0; j < NH; ++j) vn[j] = *(const LAS f16*)(wl + j * HGA_HEAD + HGA_V + ((t2 + 1) & (HGA_TB - 1)) * 128 + lane_ * 2);
            float oo[NH];
#pragma unroll
            for (int j = 0; j < NH; ++j) { const float vi = (float)vh[j];
                const LAS unsigned char* rcp = rc + j * HGA_HEAD; const LAS unsigned char* rcn = (j + 1 < NH) ? rc + (j + 1) * HGA_HEAD : rc + HGA_REC;
                HG_HEAD(S[j], vi, rcp, rcn, oo[j]) }
            char* mo = MIX + ((mb + t2) * (unsigned)DM + (unsigned)(384 + h0 * 64 + lane_)) * 2u;
#pragma unroll
            for (int j = 0; j < NH; ++j) { *(f16*)(mo + 128 * j) = (f16)oo[j]; vh[j] = vn[j]; }
        }
#undef HG_LD
#undef HG_COMP
#undef HG_HEAD
    }
    const int lane2 = lane_now();
#pragma unroll
    for (int j = 0; j < NH; ++j) { const int bh = b * 6 + h0 + j; store_row64_f16(HL + (((size_t)bh * NCH + c) * 64 + lane2) * 64, S[j]);
        DC[((size_t)bh * NCH + c) * 64 + lane2] = dpr[j]; }
}

__device__ __forceinline__ void lru_waveA(const Args& a, int l, int b, int c, int g, LAS unsigned char* wl) {
    const int ln = lane_now();
    const char* Ub = (const char*)(a.ws + WS_U); char* MIXb = (char*)(a.ws + WS_MIX); char* CA = (char*)(a.ws + WS_CA); float* LA = (float*)(a.ws + WS_LA); float* LH = (float*)(a.ws + WS_LH);
    const float* cw = a.in[18] + l * 4 * 256 + g * 64; const float* cb = a.in[19] + l * 256 + g * 64;
    const float* ba = a.in[21] + l * 256 + g * 64; const float* bx = a.in[23] + l * 256 + g * 64; const float* lam = a.in[24] + l * 256 + g * 64;
    const char* WAT = (const char*)(a.ws + WS_WAT) + (size_t)(l * 4 + g) * 8192; const char* WXT = (const char*)(a.ws + WS_WXT) + (size_t)(l * 4 + g) * 8192;
    LAS unsigned char* Y = wl;
    const unsigned mrow0 = (unsigned)(b * SEQ + c * CH);
#pragma unroll 1
    for (int ib = 0; ib < 8; ib += 4) {
        f16x8 xr[4][4];
#pragma unroll
        for (int it = 0; it < 4; ++it) { const int item = ln + 64 * (ib + it), tok = item >> 3, co = item & 7; const int t = c * CH + tok;
#pragma unroll
            for (int jj = 0; jj < 4; ++jj) { const int ts = t - 3 + jj; const unsigned row = (ts >= 0) ? mrow0 + (unsigned)(tok - 3 + jj) : mrow0 + (unsigned)tok;
                xr[it][jj] = *(const f16x8*)(Ub + (row * (unsigned)NU + (unsigned)(C_LRUX + g * 64 + 8 * co)) * 2u); } }
#pragma unroll
        for (int it = 0; it < 4; ++it) { const int item = ln + 64 * (ib + it), tok = item >> 3, co = item & 7; const int t = c * CH + tok;
            const f32x4 b0 = *(const f32x4*)(cb + 8 * co), b1 = *(const f32x4*)(cb + 8 * co + 4);
            float y[8] = {b0[0], b0[1], b0[2], b0[3], b1[0], b1[1], b1[2], b1[3]};
#pragma unroll
            for (int jj = 0; jj < 4; ++jj) { const int ts = t - 3 + jj;
                if (ts >= 0) { const f32x4 w0 = *(const f32x4*)(cw + jj * 256 + 8 * co), w1 = *(const f32x4*)(cw + jj * 256 + 8 * co + 4);
#pragma unroll
                    for (int i = 0; i < 8; ++i) y[i] += (i < 4 ? w0[i & 3] : w1[i & 3]) * (float)xr[it][jj][i]; } }
            *(LAS f16x8*)(Y + tok * 144 + co * 16) = pack8(y); } }
    asm volatile("s_waitcnt lgkmcnt(0)" ::: "memory");
    const int tl = ln & 15, fq = ln >> 4;
    float sp[16], cy[16], cp[16];
#pragma unroll
    for (int nt = 0; nt < 4; ++nt) { const f32x4 lm4 = *(const f32x4*)(lam + 16 * nt + 4 * fq);
#pragma unroll
        for (int i = 0; i < 4; ++i) { sp[nt * 4 + i] = log1pf(__expf(-lm4[i])); cy[nt * 4 + i] = 0.f; cp[nt * 4 + i] = 1.f; } }
    f16x8 wfa[4][2], wfx[4][2];
#pragma unroll
    for (int nt = 0; nt < 4; ++nt)
#pragma unroll
        for (int s2 = 0; s2 < 2; ++s2) { const unsigned wo = (unsigned)(((16 * nt + (ln & 15)) * 64 + 8 * (ln >> 4) + 32 * s2) * 2); wfa[nt][s2] = *(const f16x8*)(WAT + wo); wfx[nt][s2] = *(const f16x8*)(WXT + wo); }
#pragma unroll 1
    for (int tt = 0; tt < 4; ++tt) {
        f16x8 by[2];
#pragma unroll
        for (int s2 = 0; s2 < 2; ++s2) by[s2] = *(const LAS f16x8*)(Y + (16 * tt + tl) * 144 + (8 * fq + 32 * s2) * 2);
        const unsigned m = mrow0 + (unsigned)(16 * tt + tl);
#pragma unroll
        for (int nt = 0; nt < 4; ++nt) {
            f32x4 ra = (f32x4){0.f, 0.f, 0.f, 0.f}, rx = ra;
#pragma unroll
            for (int s2 = 0; s2 < 2; ++s2) { ra = __builtin_amdgcn_mfma_f32_16x16x32_f16(wfa[nt][s2], by[s2], ra, 0, 0, 0); rx = __builtin_amdgcn_mfma_f32_16x16x32_f16(wfx[nt][s2], by[s2], rx, 0, 0, 0); }
            const int ch0 = 16 * nt + 4 * fq;
            const f32x4 ba4 = *(const f32x4*)(ba + ch0), bx4 = *(const f32x4*)(bx + ch0);
            const f16x4 y4 = *(const LAS f16x4*)(Y + (16 * tt + tl) * 144 + ch0 * 2);
            f16x4 ho, co;
#pragma unroll
            for (int i = 0; i < 4; ++i) { const int q = nt * 4 + i;
                const float r = sigmoidf_(ra[i] + ba4[i]), ig = sigmoidf_(rx[i] + bx4[i]);
                const float la = -8.0f * r * sp[q];
                float av = __expf(la), uv = sqrtf(one_minus_exp_(2.0f * la)) * (ig * (float)y4[i]);
#define LRU_SCAN(d) { const float ap = __builtin_bit_cast(float, __builtin_amdgcn_update_dpp(0x3f800000, __builtin_bit_cast(int, av), 0x110 + (d), 0xf, 0xf, false)); \
                      const float up = __builtin_bit_cast(float, __builtin_amdgcn_update_dpp(0, __builtin_bit_cast(int, uv), 0x110 + (d), 0xf, 0xf, false)); \
                      uv = av * up + uv; av = av * ap; }
                LRU_SCAN(1) LRU_SCAN(2) LRU_SCAN(4) LRU_SCAN(8)
#undef LRU_SCAN
                const float hl = uv + av * cy[q], ca = av * cp[q];
                ho[i] = (f16)hl; co[i] = (f16)ca;
                cy[q] = __builtin_bit_cast(float, __builtin_amdgcn_ds_bpermute((ln | 15) << 2, __builtin_bit_cast(int, hl)));
                cp[q] = __builtin_bit_cast(float, __builtin_amdgcn_ds_bpermute((ln | 15) << 2, __builtin_bit_cast(int, ca)));
            }
            *(f16x4*)(MIXb + (m * (unsigned)DM + 768u + (unsigned)(g * 64 + ch0)) * 2u) = ho; *(f16x4*)(CA + (m * 256u + (unsigned)(g * 64 + ch0)) * 2u) = co;
        }
    }
    if (tl == 15) {
#pragma unroll
        for (int q = 0; q < 16; ++q) { const int ch = g * 64 + 16 * (q >> 2) + 4 * fq + (q & 3); LA[((size_t)b * NCH + c) * 256 + ch] = cp[q]; LH[((size_t)b * NCH + c) * 256 + ch] = cy[q]; } }
}

__device__ __forceinline__ void phaseA(const Args& a, int l, int task, LAS unsigned char* lds, int tid) {
    asm volatile("" : "+v"(tid));
    const int lane = tid & 63, wave = __builtin_amdgcn_readfirstlane(tid >> 6);
    const int b = task / NCH, c = task % NCH;
    const f16* U = (const f16*)(a.ws + WS_U); f16* MIX = (f16*)(a.ws + WS_MIX); f16* VF = (f16*)(a.ws + WS_VF); f16* VP = (f16*)(a.ws + WS_VP);
    f16* QT = (f16*)(a.ws + WS_QT); f16* PT = (f16*)(a.ws + WS_PT); f16* RL = (f16*)(a.ws + WS_RL); float* BONG = (float*)(a.ws + WS_BON);
    {
        LAS f16* prm = (LAS f16*)(lds + PRM_OFF); LAS float* prw0 = (LAS float*)(lds + PRM_OFF + PRM_W0_BYTE);
        for (int i = tid; i < PRM_HALVES + 384; i += NT) {
            if (i < 1280) prm[i] = (f16)a.in[3][l * RW_SHIFT + i];
            else if (i < PRM_HALVES) { const int q = (i - 1280) / 384, cc = (i - 1280) % 384;
                prm[i] = (f16)((q == 0) ? a.in[6][l * RW_W + cc] : (q == 1) ? a.in[11][l * RW_W + cc] : (q == 2) ? a.in[12][l * RW_W + cc] : (q == 3) ? a.in[13][l * RW_W + cc] : a.in[8][cc]); }
            else prw0[i - PRM_HALVES] = a.in[4][l * RW_W + (i - PRM_HALVES)]; }
        __syncthreads();
        if (wave < 4) { rwkv_waveA(a, l, b, c, wave, lds + wave * RWA_BYTES, lds + PRM_OFF, lane);
                        hgrn_waveA<1>(a, l, b, c, wave, lds + wave * RWA_BYTES); }
        else if (wave < RW_H) { hgrn_waveA<1>(a, l, b, c, wave, lds + wave * RWA_BYTES);
                                rwkv_waveA(a, l, b, c, wave, lds + wave * RWA_BYTES, lds + PRM_OFF, lane_now()); }
        else { LAS unsigned char* hw = lds + RW_H * RWA_BYTES + (wave - RW_H) * HGA_BYTES;
               lru_waveA(a, l, b, c, 2 * (wave - RW_H), hw); lru_waveA(a, l, b, c, 2 * (wave - RW_H) + 1, hw); }
        __syncthreads();
    }
}

constexpr int PB_SLOT = 16384, PB_NS = 8, PB_AHEAD = 6, NGRP = NCH / 8;
#define ARENA(ws, off) ((char*)(ws) + WS_U + (size_t)((off) >> 11) * (size_t)(NU * 2) + (size_t)((off) & 2047))
constexpr size_t AR_PGT = 0, AR_LG = 2u << 20, AR_SG = 4u << 20;
#define PB_SWZ(row, o) ((row) * 128 + (((((o) >> 4) ^ ((row) & 7)) << 4) | ((o) & 15)))
template <bool ADD_L>
__device__ __forceinline__ void pb_step(f32x4 (&Sacc)[4], const LAS unsigned char* sl, int xrow, int vl, int fq) {
    f16x8 Bhi[2], Blo[2];
#pragma unroll
    for (int mt = 0; mt < 4; ++mt)
#pragma unroll
        for (int i = 0; i < 4; ++i) { const f16 hi = (f16)Sacc[mt][i]; const f16 lo = (f16)(Sacc[mt][i] - (float)hi); Bhi[mt >> 1][4 * (mt & 1) + i] = hi; Blo[mt >> 1][4 * (mt & 1) + i] = lo; }
#pragma unroll
    for (int mt = 0; mt < 4; ++mt) {
        f32x4 d = (f32x4){0.f, 0.f, 0.f, 0.f};
        if (ADD_L) { const f16x4 l4 = *(const LAS f16x4*)(sl + 8192 + PB_SWZ(xrow, 32 * mt + 8 * fq)); d = (f32x4){(float)l4[0], (float)l4[1], (float)l4[2], (float)l4[3]}; }
#pragma unroll
        for (int s = 0; s < 2; ++s) { const u32x2 a0 = *(const LAS u32x2*)(sl + PB_SWZ(16 * mt + vl, 64 * s + 8 * fq)), a1 = *(const LAS u32x2*)(sl + PB_SWZ(16 * mt + vl, 64 * s + 32 + 8 * fq));
            u32x4 aw; aw.x = a0.x; aw.y = a0.y; aw.z = a1.x; aw.w = a1.y; const f16x8 af = __builtin_bit_cast(f16x8, aw);
            d = __builtin_amdgcn_mfma_f32_16x16x32_f16(af, Bhi[s], d, 0, 0, 0); d = __builtin_amdgcn_mfma_f32_16x16x32_f16(af, Blo[s], d, 0, 0, 0); }
        Sacc[mt] = d; }
}
__device__ __forceinline__ void pb_stage8(const Args& a, LAS unsigned char* lds, int bh, int c0, int wave, int lane) {
    const char* PT = (const char*)(a.ws + WS_PT) + ((size_t)bh * NCH + c0) * 8192; const char* RL = (const char*)(a.ws + WS_RL) + ((size_t)bh * NCH + c0) * 8192;
    const int lq = wave * 64 + lane, lrow = lq >> 3, lpp = lq & 7; const unsigned lsrc = (unsigned)(lrow * 128 + ((lpp ^ (lrow & 7)) << 4));
#pragma unroll
    for (int sl = 0; sl < 8; ++sl) { const unsigned so = (unsigned)(sl * PB_SLOT + wave * 1024); const size_t go = (size_t)sl * 8192 + lsrc;
        __builtin_amdgcn_global_load_lds((const unsigned*)(PT + go), (LAS unsigned*)(lds + so), 16, 0, 0);
        __builtin_amdgcn_global_load_lds((const unsigned*)(RL + go), (LAS unsigned*)(lds + so + 8192), 16, 0, 0); }
    asm volatile("s_waitcnt vmcnt(0)" ::: "memory");
    __builtin_amdgcn_s_barrier();
}
__device__ __forceinline__ void phaseB1(const Args& a, LAS unsigned char* lds, int tid) {
    asm volatile("" : "+v"(tid));
    const int lane = tid & 63, wave = __builtin_amdgcn_readfirstlane(tid >> 6);
    for (int task = blockIdx.x; task < 12 * NGRP; task += gridDim.x) {
        const int bh = task / NGRP, g = task % NGRP, c0 = 8 * g;
        pb_stage8(a, lds, bh, c0, wave, lane);
        const int vt = wave & 3, vl = lane & 15, fq = lane >> 4, xr = 16 * vt + vl;
        f32x4 X[4];
        if (wave < 4) {
#pragma unroll
            for (int mt = 0; mt < 4; ++mt) { const f16x4 l4 = *(const LAS f16x4*)(lds + 8192 + PB_SWZ(xr, 32 * mt + 8 * fq)); X[mt] = (f32x4){(float)l4[0], (float)l4[1], (float)l4[2], (float)l4[3]}; }
#pragma unroll 1
            for (int s = 1; s < 8; ++s) pb_step<true>(X, lds + s * PB_SLOT, xr, vl, fq);
#pragma unroll
            for (int mt = 0; mt < 4; ++mt) { f16x4 o;
#pragma unroll
                for (int i = 0; i < 4; ++i) o[i] = (f16)X[mt][i];
                *(f16x4*)ARENA(a.ws, AR_LG + ((size_t)bh * NGRP + g) * 8192 + (size_t)((xr * 64 + 16 * mt + 4 * fq) * 2)) = o; }
        } else {
#pragma unroll
            for (int mt = 0; mt < 4; ++mt)
#pragma unroll
                for (int i = 0; i < 4; ++i) X[mt][i] = (16 * mt + 4 * fq + i == xr) ? 1.f : 0.f;
#pragma unroll 1
            for (int s = 0; s < 8; ++s) pb_step<false>(X, lds + s * PB_SLOT, xr, vl, fq);
#pragma unroll
            for (int mt = 0; mt < 4; ++mt)
#pragma unroll
                for (int i = 0; i < 4; ++i) *(f16*)ARENA(a.ws, AR_PGT + ((size_t)bh * NGRP + g) * 8192 + (size_t)(((16 * mt + 4 * fq + i) * 64 + xr) * 2)) = (f16)X[mt][i];
        }
        asm volatile("s_waitcnt vmcnt(0) lgkmcnt(0)" ::: "memory");
        __builtin_amdgcn_s_barrier();
    }
}
__device__ __forceinline__ void phaseB3(const Args& a, LAS unsigned char* lds, int tid) {
    asm volatile("" : "+v"(tid));
    const int lane = tid & 63, wave = __builtin_amdgcn_readfirstlane(tid >> 6);
    for (int task = blockIdx.x; task < 12 * NGRP; task += gridDim.x) {
        const int bh = task / NGRP, g = task % NGRP, c0 = 8 * g;
        pb_stage8(a, lds, bh, c0, wave, lane);
        if (wave < 4) {
            const int vt = wave, vl = lane & 15, fq = lane >> 4, xr = 16 * vt + vl;
            char* RL = (char*)(a.ws + WS_RL) + ((size_t)bh * NCH + c0) * 8192;
            f32x4 X[4];
#pragma unroll
            for (int mt = 0; mt < 4; ++mt) { const f16x4 s4 = *(const f16x4*)ARENA(a.ws, AR_SG + ((size_t)bh * NGRP + g) * 8192 + (size_t)((xr * 64 + 16 * mt + 4 * fq) * 2)); X[mt] = (f32x4){(float)s4[0], (float)s4[1], (float)s4[2], (float)s4[3]}; }
#pragma unroll 1
            for (int s = 0; s < 8; ++s) {
#pragma unroll
                for (int mt = 0; mt < 4; ++mt) { f16x4 o;
#pragma unroll
                    for (int i = 0; i < 4; ++i) o[i] = (f16)X[mt][i];
                    *(f16x4*)(RL + (size_t)s * 8192 + (xr * 64 + 16 * mt + 4 * fq) * 2) = o; }
                if (s < 7) pb_step<true>(X, lds + s * PB_SLOT, xr, vl, fq);
            }
        }
        asm volatile("s_waitcnt vmcnt(0) lgkmcnt(0)" ::: "memory");
        __builtin_amdgcn_s_barrier();
    }
}
__device__ __forceinline__ void phaseB(const Args& a, LAS unsigned char* lds, int tid) {
    asm volatile("" : "+v"(tid));
    const int lane = tid & 63, wave = __builtin_amdgcn_readfirstlane(tid >> 6);
    const int bx = blockIdx.x;
    if (bx < 12) {
        const int bh = bx;
        const bool loader = wave >= 4;
        const int vt = wave & 3, vl = lane & 15, fq = lane >> 4, v = 16 * vt + vl;
        const int lq = (wave - 4) * 64 + lane, lrow = lq >> 3, lpp = lq & 7;
        const unsigned lsrc = (unsigned)(lrow * 128 + ((lpp ^ (lrow & 7)) << 4));
#define PB_ISSUE(cc) { const unsigned so = (unsigned)(((cc) & (PB_NS - 1)) * PB_SLOT) + (unsigned)((wave - 4) * 1024); const size_t go = ((size_t)bh * NGRP + (cc)) * 8192 + lsrc; \
            __builtin_amdgcn_global_load_lds((const unsigned*)ARENA(a.ws, AR_PGT + go), (LAS unsigned*)(lds + so), 16, 0, 0); \
            __builtin_amdgcn_global_load_lds((const unsigned*)ARENA(a.ws, AR_PGT + go + 4096), (LAS unsigned*)(lds + so + 4096), 16, 0, 0); \
            __builtin_amdgcn_global_load_lds((const unsigned*)ARENA(a.ws, AR_LG + go), (LAS unsigned*)(lds + so + 8192), 16, 0, 0); \
            __builtin_amdgcn_global_load_lds((const unsigned*)ARENA(a.ws, AR_LG + go + 4096), (LAS unsigned*)(lds + so + 12288), 16, 0, 0); }
        if (loader) {
#pragma unroll
            for (int cc = 0; cc < PB_AHEAD; ++cc) PB_ISSUE(cc)
            asm volatile("s_waitcnt vmcnt(20)" ::: "memory");
        }
        __builtin_amdgcn_s_barrier();
        f32x4 Sacc[4];
#pragma unroll
        for (int mt = 0; mt < 4; ++mt) Sacc[mt] = (f32x4){0.f, 0.f, 0.f, 0.f};
#pragma unroll 1
        for (int c = 0; c < NGRP; ++c) {
            if (loader) {
                if (c + PB_AHEAD < NGRP) { PB_ISSUE(c + PB_AHEAD) asm volatile("s_waitcnt vmcnt(20)" ::: "memory"); }
                else asm volatile("s_waitcnt vmcnt(0)" ::: "memory");
            } else {
#pragma unroll
                for (int mt = 0; mt < 4; ++mt) { f16x4 o;
#pragma unroll
                    for (int i = 0; i < 4; ++i) o[i] = (f16)Sacc[mt][i];
                    *(f16x4*)ARENA(a.ws, AR_SG + ((size_t)bh * NGRP + c) * 8192 + (size_t)((v * 64 + 16 * mt + 4 * fq) * 2)) = o; }
                pb_step<true>(Sacc, lds + (c & (PB_NS - 1)) * PB_SLOT, v, vl, fq);
                asm volatile("s_waitcnt lgkmcnt(0)" ::: "memory");
            }
            __builtin_amdgcn_s_barrier();
        }
#undef PB_ISSUE
        asm volatile("s_waitcnt vmcnt(0)" ::: "memory");
    } else if (bx < 12 + 96) {
        const int idx = (bx - 12) * NT + tid; const int bh = idx >> 12, e = idx & 4095, k = e & 63;
        f16* HL = (f16*)(a.ws + WS_HL); const float* DC = (const float*)(a.ws + WS_DC);
        float s = 0.f;
        for (int c0 = 0; c0 < NCH; c0 += 8) { float Lc[8], d[8];
#pragma unroll
            for (int j = 0; j < 8; ++j) { Lc[j] = (float)HL[((size_t)bh * NCH + c0 + j) * 4096 + e]; d[j] = DC[((size_t)bh * NCH + c0 + j) * 64 + k]; }
#pragma unroll
            for (int j = 0; j < 8; ++j) { HL[((size_t)bh * NCH + c0 + j) * 4096 + e] = (f16)s; s = d[j] * s + Lc[j]; } }
    } else if (bx == 12 + 96) {
        const int bb = tid >> 8, ch = tid & 255; const float* LA = (const float*)(a.ws + WS_LA); float* LH = (float*)(a.ws + WS_LH);
        float cy = 0.f;
        for (int c0 = 0; c0 < NCH; c0 += 8) { float A[8], H[8];
#pragma unroll
            for (int j = 0; j < 8; ++j) { const size_t o = ((size_t)bb * NCH + c0 + j) * 256 + ch; A[j] = LA[o]; H[j] = LH[o]; }
#pragma unroll
            for (int j = 0; j < 8; ++j) { const size_t o = ((size_t)bb * NCH + c0 + j) * 256 + ch; LH[o] = cy; cy = A[j] * cy + H[j]; } }
    }
}

__device__ __forceinline__ void phaseC(const Args& a, int l, int task, LAS unsigned char* lds, int tid) {
    asm volatile("" : "+v"(tid));
    const int lane = tid & 63, wave = __builtin_amdgcn_readfirstlane(tid >> 6);
    const int b = task / NCH, c = task % NCH;
    const int tl = lane & 15, fq = lane >> 4, tt = wave & 3, hg = wave >> 2;
    const unsigned m = (unsigned)(b * SEQ + c * CH + 16 * tt + tl);
    const char* U = (const char*)(a.ws + WS_U); char* MIX = (char*)(a.ws + WS_MIX); const char* VP = (const char*)(a.ws + WS_VP);
    const char* QT = (const char*)(a.ws + WS_QT); const char* RL = (const char*)(a.ws + WS_RL); const char* HL = (const char*)(a.ws + WS_HL); const float* BONG = (const float*)(a.ws + WS_BON);
    const unsigned uo = m * (unsigned)(NU * 2);
#pragma unroll
    for (int hh = 0; hh < 3; ++hh) {
        const int h = 3 * hg + hh; const int bh = b * RW_H + h;
        const char* sl = RL + ((size_t)bh * NCH + c) * 8192;
        f16x8 bq[2];
#pragma unroll
        for (int s = 0; s < 2; ++s) bq[s] = *(const f16x8*)(QT + (m * (unsigned)RW_W + (unsigned)(h * 64 + 8 * fq + 32 * s)) * 2u);
        f32x4 D[4];
#pragma unroll
        for (int vt = 0; vt < 4; ++vt) { const f16x4 yl = *(const f16x4*)(MIX + (m * (unsigned)DM + (unsigned)(h * 64 + 16 * vt + 4 * fq)) * 2u);
            f32x4 d = (f32x4){(float)yl[0], (float)yl[1], (float)yl[2], (float)yl[3]};
#pragma unroll
            for (int s = 0; s < 2; ++s) d = __builtin_amdgcn_mfma_f32_16x16x32_f16(*(const f16x8*)(sl + ((16 * vt + tl) * 64 + 8 * fq + 32 * s) * 2), bq[s], d, 0, 0, 0);
            D[vt] = d; }
        float sm = 0.f;
#pragma unroll
        for (int vt = 0; vt < 4; ++vt) sm += (D[vt][0] + D[vt][1]) + (D[vt][2] + D[vt][3]);
        sm += shfl_xor_f(sm, 16); sm += shfl_xor_f(sm, 32);
        const float mean = sm * (1.0f / 64.0f); float vr = 0.f;
#pragma unroll
        for (int vt = 0; vt < 4; ++vt)
#pragma unroll
            for (int i = 0; i < 4; ++i) { const float d = D[vt][i] - mean; vr += d * d; }
        vr += shfl_xor_f(vr, 16); vr += shfl_xor_f(vr, 32);
        const float rstd = rsq_(vr * (1.0f / 64.0f) + 64e-5f);
        const float bon = BONG[m * 8u + (unsigned)h];
        const float* ln_w = a.in[14] + l * RW_W; const float* ln_b = a.in[15] + l * RW_W;
#pragma unroll
        for (int vt = 0; vt < 4; ++vt) { const unsigned col = (unsigned)(h * 64 + 16 * vt + 4 * fq);
            const f16x4 vp = *(const f16x4*)(VP + (m * (unsigned)RW_W + col) * 2u), z4 = *(const f16x4*)(U + uo + ((unsigned)C_RWZ + col) * 2u);
            const f32x4 lw = *(const f32x4*)(ln_w + col), lb = *(const f32x4*)(ln_b + col);
            f16x4 o;
#pragma unroll
            for (int i = 0; i < 4; ++i) o[i] = (f16)(((D[vt][i] - mean) * rstd * lw[i] + lb[i] + bon * (float)vp[i]) * siluf_((float)z4[i]));
            *(f16x4*)(MIX + (m * (unsigned)DM + col) * 2u) = o; }
    }
#pragma unroll
    for (int hh = 0; hh < 3; ++hh) {
        const int h = 3 * hg + hh; const int bh = b * 6 + h;
        const char* sl = HL + ((size_t)bh * NCH + c) * 8192;
        f16x8 bq[2];
#pragma unroll
        for (int s = 0; s < 2; ++s) bq[s] = *(const f16x8*)(U + uo + (unsigned)(C_HGQ + h * 64 + 8 * fq + 32 * s) * 2u);
        f32x4 D[4];
#pragma unroll
        for (int vt = 0; vt < 4; ++vt) { const f16x4 ol = *(const f16x4*)(MIX + (m * (unsigned)DM + (unsigned)(384 + h * 64 + 16 * vt + 4 * fq)) * 2u);
            f32x4 d = (f32x4){(float)ol[0], (float)ol[1], (float)ol[2], (float)ol[3]};
#pragma unroll
            for (int s = 0; s < 2; ++s) d = __builtin_amdgcn_mfma_f32_16x16x32_f16(*(const f16x8*)(sl + ((16 * vt + tl) * 64 + 8 * fq + 32 * s) * 2), bq[s], d, 0, 0, 0);
            D[vt] = d; }
        float ss = 0.f;
#pragma unroll
        for (int vt = 0; vt < 4; ++vt) ss += (D[vt][0] * D[vt][0] + D[vt][1] * D[vt][1]) + (D[vt][2] * D[vt][2] + D[vt][3] * D[vt][3]);
        ss += shfl_xor_f(ss, 16); ss += shfl_xor_f(ss, 32);
        const float rs = rsq_(ss * (1.0f / 64.0f) + 1e-6f);
        const float* nw = a.in[17] + l * 384;
#pragma unroll
        for (int vt = 0; vt < 4; ++vt) { const unsigned col = (unsigned)(h * 64 + 16 * vt + 4 * fq);
            const f16x4 z4 = *(const f16x4*)(U + uo + ((unsigned)C_HGZ + col) * 2u); const f32x4 w4 = *(const f32x4*)(nw + col);
            f16x4 o;
#pragma unroll
            for (int i = 0; i < 4; ++i) o[i] = (f16)(D[vt][i] * rs * w4[i] * siluf_((float)z4[i]));
            *(f16x4*)(MIX + (m * (unsigned)DM + 384u + col) * 2u) = o; }
    }
    {
        const char* CA = (const char*)(a.ws + WS_CA); const float* LH = (const float*)(a.ws + WS_LH) + ((size_t)b * NCH + c) * 256;
#pragma unroll
        for (int q = 0; q < 4; ++q) { const unsigned ch0 = (unsigned)(128 * hg + 32 * fq + 8 * q);
            const f16x8 hl = *(const f16x8*)(MIX + (m * (unsigned)DM + 768u + ch0) * 2u), ca = *(const f16x8*)(CA + (m * 256u + ch0) * 2u), z8 = *(const f16x8*)(U + uo + ((unsigned)C_LRUZ + ch0) * 2u);
            const f32x4 c0 = *(const f32x4*)(LH + ch0), c1 = *(const f32x4*)(LH + ch0 + 4);
            f16x8 o;
#pragma unroll
            for (int i = 0; i < 8; ++i) o[i] = (f16)(((float)hl[i] + (float)ca[i] * (i < 4 ? c0[i & 3] : c1[i & 3])) * siluf_((float)z8[i]));
            *(f16x8*)(MIX + (m * (unsigned)DM + 768u + ch0) * 2u) = o; }
    }
}
#define XB_TMO      128
#define XB_XCNT(j)  (256  + 64 * (j))
#define XB_XSUB(j)  (1280 + 64 * (j))
#define XB_XGEN(j)  (2304 + 64 * (j))
#define XB_TOP      3328
#define XB_TOPGEN   3392
#define XCD_BAR_WORDS 3456
#define XB_SPIN_CAP (1u << 18)

__device__ __forceinline__ unsigned xb_ld(unsigned* p)              { return __hip_atomic_load(p, __ATOMIC_RELAXED, __HIP_MEMORY_SCOPE_AGENT); }
__device__ __forceinline__ unsigned xb_add(unsigned* p, unsigned v) { return __hip_atomic_fetch_add(p, v, __ATOMIC_RELAXED, __HIP_MEMORY_SCOPE_AGENT); }
__device__ __forceinline__ unsigned xb_xcc_id() { return (unsigned)__builtin_amdgcn_s_getreg((3 << 11) | 20) & 0xFu; }
#define XB_SPIN(cond, bar) do { unsigned _sp = 0; while (cond) { __builtin_amdgcn_s_sleep(1); \
    if ((++_sp & 255u) == 0u) { if (xb_ld(&(bar)[XB_TMO])) break; if (_sp > XB_SPIN_CAP) { atomicAdd(&(bar)[XB_TMO], 1u); break; } } } } while (0)

struct XcdBarrier {
    unsigned* bar; unsigned x; int isw0;
    volatile LAS unsigned* st;
};

__device__ __forceinline__ XcdBarrier xcd_barrier_post(unsigned* bar, volatile LAS unsigned* st, int isw0) {
    XcdBarrier b; b.bar = bar; b.x = xb_xcc_id(); b.st = st; b.isw0 = isw0;
    if (isw0 && lane_now() == 0) (void)xb_add(&bar[XB_XCNT(b.x)], 1u);
    return b;
}
__device__ __forceinline__ void xcd_barrier_complete(unsigned* bar, unsigned x, unsigned& nloc, unsigned& nx) {
    const unsigned G = gridDim.x * gridDim.y * gridDim.z;
    unsigned sum, cnt, mine, sp = 0u;
    for (;;) {
        sum = 0u; cnt = 0u; mine = 0u;
#pragma unroll
        for (unsigned j = 0; j < 16; ++j) { const unsigned c = xb_ld(&bar[XB_XCNT(j)]); sum += c; cnt += (c > 0u) ? 1u : 0u; mine = (j == x) ? c : mine; }
        if (sum == G) break;
        __builtin_amdgcn_s_sleep(1);
        if ((++sp & 255u) == 0u) { if (xb_ld(&bar[XB_TMO])) break; if (sp > XB_SPIN_CAP) { atomicAdd(&bar[XB_TMO], 1u); break; } }
    }
    nloc = mine > 0u ? mine : 1u; nx = cnt > 0u ? cnt : 1u;
}

__device__ __forceinline__ void xcd_barrier(const XcdBarrier& b) {
    asm volatile("s_waitcnt vmcnt(0)" ::: "memory");
    __syncthreads();
    if (b.isw0 && lane_now() == 0) {
        unsigned* bar = b.bar;
        __builtin_amdgcn_s_waitcnt(0);
        unsigned nloc = b.st[0], nx = b.st[1];
        if (nloc == 0u) { xcd_barrier_complete(bar, b.x, nloc, nx); b.st[0] = nloc; b.st[1] = nx; }
        const unsigned old = xb_add(&bar[XB_XSUB(b.x)], 1u);
        const unsigned gen = old / nloc;
        if (old + 1u == (gen + 1u) * nloc) {
            __builtin_amdgcn_fence(__ATOMIC_RELEASE, "agent");
            asm volatile("s_waitcnt vmcnt(0)" ::: "memory");
            const unsigned og = xb_add(&bar[XB_TOP], 1u);
            const unsigned tg = og / nx;
            if (og + 1u == (tg + 1u) * nx) xb_add(&bar[XB_TOPGEN], 1u);
            else XB_SPIN(xb_ld(&bar[XB_TOPGEN]) == tg, bar);
            __builtin_amdgcn_fence(__ATOMIC_ACQUIRE, "agent");
            xb_add(&bar[XB_XGEN(b.x)], 1u);
            asm volatile("s_waitcnt vmcnt(0)" ::: "memory");
        } else {
            XB_SPIN(xb_ld(&bar[XB_XGEN(b.x)]) == gen, bar);
            __builtin_amdgcn_fence(__ATOMIC_ACQUIRE, "agent");
            asm volatile("s_waitcnt vmcnt(0)" ::: "memory");
        }
    }
    __syncthreads();
}

constexpr size_t WS_BAR = 16384;
constexpr size_t WS_PCNT = 32768;
constexpr int MISC_OFF = LDS_BYTES - 16;
__global__ void __launch_bounds__(NT, 2) fwd(Args args) {
    extern __shared__ __attribute__((aligned(16))) unsigned char lds_raw[];
    LAS unsigned char* lds = (LAS unsigned char*)lds_raw;
    cg::grid_group grid = cg::this_grid();
    const int wave = __builtin_amdgcn_readfirstlane((int)threadIdx.x >> 6);
#define TID_NOW() (wave * 64 + lane_now())
    const int tid = TID_NOW(); const int lane = tid & 63;
    if (wave == 0 && lane < 4) ((LAS unsigned*)(lds + MISC_OFF))[lane] = 0u;
    __syncthreads();
    XcdBarrier xbar = xcd_barrier_post((unsigned*)(args.ws + WS_BAR), (volatile LAS unsigned*)(lds + MISC_OFF), __builtin_amdgcn_readfirstlane(wave == 0 ? 1 : 0));
#define GRID_BAR() do { XcdBarrier xb_ = xbar; xb_.st = (volatile LAS unsigned*)(lds + MISC_OFF); asm volatile("" : "+s"(xb_.bar), "+s"(xb_.x)); xcd_barrier(xb_); } while (0)
    const int G = gridDim.x, gw = blockIdx.x * NWAVES + wave, NGW = G * NWAVES;
    unsigned char* ws = args.ws;
    unsigned short* XN = (unsigned short*)(ws + WS_XN);
    {
        LAS float* scr = (LAS float*)(lds + wave * 8704);
        constexpr int I_IN = (DM / 64) * (NIN / 32), I_OUT = (DM / 64) * (DM / 32), NITEMS = DEPTH * (I_IN + I_OUT);
        for (int it = gw; it < NITEMS; it += NGW) {
            int r = it; const int l = r / (I_IN + I_OUT); r -= l * (I_IN + I_OUT);
            if (r < I_IN) p0_transpose_item(args.in[2] + (size_t)l * DM * NIN, DM, NIN, (unsigned short*)(ws + WS_WIN + l * WIN_L), scr, r, lane, l == 0 ? nullptr : args.in[1] + DM);
            else p0_transpose_item(args.in[25] + (size_t)l * DM * DM, DM, DM, (unsigned short*)(ws + WS_WOUT + l * WOUT_L), scr, r - I_IN, lane, nullptr);
        }
        for (int i = gw; i < DEPTH * (NU - NIN) * DM * 2 / 1024; i += NGW) { const int l = i / ((NU - NIN) * DM * 2 / 1024), r = i % ((NU - NIN) * DM * 2 / 1024);
            if (l == 1 && r < 64 * DM * 2 / 1024) continue;
            *(u32x4*)(ws + WS_WIN + l * WIN_L + (size_t)NIN * DM * 2 + (size_t)r * 1024 + lane * 16) = (u32x4){0u, 0u, 0u, 0u}; }
        if (blockIdx.x < 32) {
            LAS f16* TT = (LAS f16*)(lds + 8 * 8704);
            for (int i = tid; i < 64 * RW_W; i += NT) { const int n = i / RW_W, cc = i % RW_W; const float mm = args.in[3][RW_SHIFT + C_V + cc]; TT[n * 392 + cc] = (f16)(((n < 32) ? (1.0f - mm) : mm) * args.in[9][cc * 32 + (n & 31)]); }
            __syncthreads();
            const int tile = blockIdx.x * NWAVES + wave, nt = tile & 3, kt = tile >> 2, tl = lane & 15, fq = lane >> 4;
            const float* wrow = args.in[2] + (size_t)DM * NIN + (size_t)(16 * kt + tl) * NIN + C_V + 8 * fq;
            f32x4 bv[12][2];
#pragma unroll
            for (int s2 = 0; s2 < 12; ++s2) { bv[s2][0] = *(const f32x4*)(wrow + 32 * s2); bv[s2][1] = *(const f32x4*)(wrow + 32 * s2 + 4); }
            f32x4 d = (f32x4){0.f, 0.f, 0.f, 0.f};
#pragma unroll
            for (int s2 = 0; s2 < 12; ++s2) { f16x8 bf;
#pragma unroll
                for (int j = 0; j < 8; ++j) bf[j] = (f16)(j < 4 ? bv[s2][0][j & 3] : bv[s2][1][j & 3]);
                d = __builtin_amdgcn_mfma_f32_16x16x32_f16(*(const LAS f16x8*)(TT + (16 * nt + tl) * 392 + 8 * fq + 32 * s2), bf, d, 0, 0, 0); }
            const float nwk = args.in[1][DM + 16 * kt + tl];
#pragma unroll
            for (int i = 0; i < 4; ++i) ((f16*)(ws + WS_WIN + WIN_L))[(size_t)(NIN + 16 * nt + 4 * fq + i) * DM + 16 * kt + tl] = (f16)(d[i] * nwk);
            __syncthreads();
        }
        for (int i = blockIdx.x * NT + tid; i < 2 * M; i += G * NT) ((float*)(ws + WS_RSS))[i] = 0.f;
        for (int m = gw; m < M; m += 4 * NGW) rms_row4_f16(args.in[0] + (size_t)m * DM, (size_t)NGW * DM, args.in[1], XN + (size_t)m * DM, lane);
        { f16* WUPT = (f16*)(ws + WS_WUPT); f16* AUPT = (f16*)(ws + WS_AUPT); f16* VDNT = (f16*)(ws + WS_VDNT); f16* VUPT = (f16*)(ws + WS_VUPT);
          for (int i = blockIdx.x * NT + tid; i < 122880; i += G * NT) {
              if (i < 49152) { const int ll = i / 24576, r = i % 24576, n = r / 64, k = r % 64; WUPT[i] = (f16)args.in[5][(size_t)ll * 24576 + k * 384 + n]; }
              else if (i < 98304) { const int i2 = i - 49152, ll = i2 / 24576, r = i2 % 24576, n = r / 64, k = r % 64; AUPT[i2] = (f16)args.in[7][(size_t)ll * 24576 + k * 384 + n]; }
              else if (i < 110592) { const int i2 = i - 98304, j2 = i2 / 384, cc = i2 % 384; VDNT[i2] = (f16)args.in[9][cc * 32 + j2]; }
              else { const int i2 = i - 110592, n = i2 / 32, j2 = i2 % 32; VUPT[i2] = (f16)args.in[10][j2 * 384 + n]; } }
          f16* WAT = (f16*)(ws + WS_WAT); f16* WXT = (f16*)(ws + WS_WXT);
          for (int i = blockIdx.x * NT + tid; i < 32768; i += G * NT) { const int lg = i >> 12, r = i & 4095, j = r >> 6, ii = r & 63; WAT[i] = (f16)args.in[20][(size_t)lg * 4096 + ii * 64 + j]; WXT[i] = (f16)args.in[22][(size_t)lg * 4096 + ii * 64 + j]; } }
    }
    if (gridDim.x > 65536u) grid.sync();
    GRID_BAR();
#pragma unroll 1
    for (int l = 0; l < DEPTH; ++l) {
        { pg8::Gemm g{XN, (const unsigned short*)(ws + WS_WIN + l * WIN_L), M, NU, DM}; pg8::StaticOrder S; S.init(M, NU, G, (int)blockIdx.x);
          pg8::EpiF16 E{(unsigned short*)(ws + WS_U), NU, l == 0 ? nullptr : (const float*)(ws + WS_RSS)};
          pg8::gemm_phase<pg8::EpiF16, pg8::StaticOrder, true, true>(lds, g, S, E, wave); }
        GRID_BAR();
        for (int task = blockIdx.x; task < BATCH * NCH; task += G) phaseA(args, l, task, lds, TID_NOW());
        GRID_BAR();
        phaseB1(args, lds, TID_NOW());
        GRID_BAR();
        phaseB(args, lds, TID_NOW());
        GRID_BAR();
        phaseB3(args, lds, TID_NOW());
        GRID_BAR();
        for (int task = blockIdx.x; task < BATCH * NCH; task += G) phaseC(args, l, task, lds, TID_NOW());
        GRID_BAR();
        { pg8::Gemm g{(const unsigned short*)(ws + WS_MIX), (const unsigned short*)(ws + WS_WOUT + l * WOUT_L), M, DM, DM}; pg8::StaticOrder S; S.init(M, DM, G, (int)blockIdx.x);
          if (l + 1 < DEPTH) {
              pg8::EpiRes E{args.in[0], args.out, DM, XN, (float*)(ws + WS_RSS)};
              pg8::gemm_phase<pg8::EpiRes, pg8::StaticOrder, true, true>(lds, g, S, E, wave);
              GRID_BAR();
          } else {
              pg8::EpiResNorm E{args.out, args.out, DM, (float*)(ws + WS_RSS) + M, (unsigned*)(ws + WS_PCNT), args.in[26]};
              pg8::gemm_phase<pg8::EpiResNorm, pg8::StaticOrder, true, true>(lds, g, S, E, wave);
          } }
    }
}

extern "C" void kernel_launch(void* const* d_in, const int* in_sizes, int n_in, void* d_out, int out_size, void* d_ws, size_t ws_size, hipStream_t stream) {
    static int grid = 0;
    if (grid == 0) {
        if (n_in != 27 || in_sizes[0] != M * DM || out_size != M * DM || ws_size < WS_END) { fprintf(stderr, "kernel_launch: unexpected problem: n_in %d in0 %d out %d ws %zu\n", n_in, n_in > 0 ? in_sizes[0] : -1, out_size, ws_size); grid = -1; return; }
        int dev = 0, cus = 0, per_cu = 0;
        hipGetDevice(&dev); hipDeviceGetAttribute(&cus, hipDeviceAttributeMultiprocessorCount, dev);
        if (hipFuncSetAttribute((const void*)fwd, hipFuncAttributeMaxDynamicSharedMemorySize, LDS_BYTES) != hipSuccess) { fprintf(stderr, "kernel_launch: hipFuncSetAttribute failed\n"); grid = -1; return; }
        if (hipOccupancyMaxActiveBlocksPerMultiprocessor(&per_cu, (const void*)fwd, NT, LDS_BYTES) != hipSuccess || per_cu < 1) { fprintf(stderr, "kernel_launch: occupancy query failed (%d)\n", per_cu); grid = -1; return; }
        grid = cus * per_cu;
    }
    if (grid < 0) return;
    if (hipMemsetAsync((char*)d_ws, 0, 65536, stream) != hipSuccess) { fprintf(stderr, "kernel_launch: memset of the barrier words failed\n"); return; }
    Args a{};
    for (int i = 0; i < 27; ++i) a.in[i] = (const float*)d_in[i];
    a.out = (float*)d_out; a.ws = (unsigned char*)d_ws;
    void* kargs[] = {&a};
    hipError_t e = hipLaunchCooperativeKernel((const void*)fwd, dim3(grid), dim3(NT), kargs, LDS_BYTES, stream);
    if (e != hipSuccess) fprintf(stderr, "cooperative launch failed: %s (grid %d)\n", hipGetErrorString(e), grid);
}
```

```cpp
#include <hip/hip_runtime.h>
#include <hip/hip_cooperative_groups.h>
#include <cstdio>
#include <cstdint>
namespace cg = cooperative_groups;
typedef _Float16 f16x8_t __attribute__((ext_vector_type(8)));
#define MK_MFMA(a, b, c) __builtin_amdgcn_mfma_f32_16x16x32_f16(__builtin_bit_cast(f16x8_t, (a)), __builtin_bit_cast(f16x8_t, (b)), (c), 0, 0, 0)
__device__ __forceinline__ int lane_now() { int z; asm volatile("v_mbcnt_lo_u32_b32 %0, -1, 0\n\tv_mbcnt_hi_u32_b32 %0, -1, %0" : "=v"(z)); return z; }
__device__ __forceinline__ float shfl_xor_f(float v, int mask) { const int ln = lane_now(); return __builtin_bit_cast(float, __builtin_amdgcn_ds_bpermute((ln ^ mask) << 2, __builtin_bit_cast(int, v))); }
namespace pg8 {
#define PG8_LAS __attribute__((address_space(3)))
typedef unsigned short bf16_t;
typedef short bf16x8 __attribute__((ext_vector_type(8)));
typedef float f32x4 __attribute__((ext_vector_type(4)));
typedef unsigned u32x4 __attribute__((ext_vector_type(4)));
constexpr int BM = 256, BK = 64, HALF = 128, HTB = HALF * BK * 2  , STAGE_BYTES = 8 * HTB, NXCD = 8, WGM = 8;

__host__ __device__ __forceinline__ int lds_byte(int r, int c) { const int st = (r >> 4) * 2 + (c >> 5), rr = r & 15, cc = c & 31, ob = rr * 64 + cc * 2; return st * 1024 + (ob ^ (((ob >> 9) & 1) << 5)); }
__host__ __device__ __forceinline__ void stage_rc(int b, int& R, int& C) { const int st = b / 1024, sb = b % 1024, swz = sb ^ (((sb >> 9) & 1) << 5); R = (st >> 1) * 16 + swz / 64; C = (st & 1) * 32 + (swz % 64) / 2; }
__host__ __device__ __forceinline__ int perm32(int rho) { const int n = rho >> 4, i = rho & 15; return 8 * (i >> 2) + 4 * n + (i & 3); }

struct Unit { int pm, pn; };
struct Gemm { const bf16_t* A; const bf16_t* Bt; int M, N, K; };

struct StaticOrder {
    int nM, nN, nwg, G, c;
    __host__ __device__ void init(int M, int N, int G_, int c_) { nM = M / BM; nN = N / BM; nwg = nM * nN; G = G_; c = c_; }
    __host__ __device__ bool next(int i, Unit& u) const {
        const long L = (long)i * G + c; if (L >= nwg) return false;
        int wgid = (int)L; { const int q = nwg / NXCD, r = nwg % NXCD, xcd = wgid % NXCD, off = wgid / NXCD; wgid = (xcd < r ? xcd * (q + 1) : r * (q + 1) + (xcd - r) * q) + off; }
        const int nig = WGM * nN, gid = wgid / nig, fm = gid * WGM, gsz = (nM - fm) < WGM ? (nM - fm) : WGM;
        u.pm = fm + ((wgid % nig) % gsz); u.pn = (wgid % nig) / gsz; return true;
    }
    __device__ __forceinline__ void a_ready(const Unit&) const {}
    __device__ __forceinline__ void done(const Unit&) const {}
};

__device__ __forceinline__ unsigned pk_f16(float lo, float hi) { typedef _Float16 h2 __attribute__((ext_vector_type(2))); h2 v; v.x = (_Float16)lo; v.y = (_Float16)hi; return __builtin_bit_cast(unsigned, v); }
typedef unsigned u32x2 __attribute__((ext_vector_type(2)));
struct EpiF16 {
    static constexpr bool PERM = true, AFTER_DRAIN = false;
    bf16_t* O; int ldc; const float* rss;
    __device__ __forceinline__ void operator()(const f32x4 (&acc)[2][2][4][2], const Unit& u, int wr, int wc, int fr, int fq) const {
        const int row0 = u.pm * BM + wr * 64 + fr; const int col0 = u.pn * BM + wc * 32 + 8 * fq;
#pragma unroll
        for (int ai = 0; ai < 2; ++ai)
#pragma unroll
            for (int m = 0; m < 4; ++m) { const int row = row0 + ai * HALF + m * 16; bf16_t* rowp = O + (size_t)row * ldc + col0;
                const float sc = rss ? 1.0f / sqrtf(rss[row] * (1.0f / 1024.0f) + 1e-6f) : 1.0f;
#pragma unroll
                for (int bj = 0; bj < 2; ++bj) { const f32x4 v0 = acc[ai][bj][m][0] * sc, v1 = acc[ai][bj][m][1] * sc;
                    u32x4 w; w.x = pk_f16(v0[0], v0[1]); w.y = pk_f16(v0[2], v0[3]); w.z = pk_f16(v1[0], v1[1]); w.w = pk_f16(v1[2], v1[3]);
                    *(u32x4*)(rowp + bj * HALF) = w; } }
    }
};
struct EpiRes {
    static constexpr bool PERM = false, AFTER_DRAIN = false;
    const float* base; float* out; int ldc; bf16_t* xh; float* rss;
    __device__ __forceinline__ void operator()(const f32x4 (&acc)[2][2][4][2], const Unit& u, int wr, int wc, int fr, int fq) const {
        const int row0 = u.pm * BM + wr * 64 + fr; const int col0 = u.pn * BM + wc * 32 + 4 * fq;
#pragma unroll
        for (int ai = 0; ai < 2; ++ai)
#pragma unroll
            for (int m = 0; m < 4; ++m) { const size_t off = (size_t)(row0 + ai * HALF + m * 16) * ldc + col0; float ss = 0.f;
#pragma unroll
                for (int bj = 0; bj < 2; ++bj)
#pragma unroll
                    for (int n = 0; n < 2; ++n) { const size_t o = off + bj * HALF + n * 16; const f32x4 b = *(const f32x4*)(base + o); const f32x4 x = b + acc[ai][bj][m][n]; *(f32x4*)(out + o) = x;
                        if (xh) { u32x2 h; h.x = pk_f16(x[0], x[1]); h.y = pk_f16(x[2], x[3]); *(u32x2*)(xh + o) = h; ss += (x[0] * x[0] + x[1] * x[1]) + (x[2] * x[2] + x[3] * x[3]); } }
                if (xh) { ss += shfl_xor_f(ss, 16); ss += shfl_xor_f(ss, 32); if (fq == 0) atomicAdd(rss + row0 + ai * HALF + m * 16, ss); }
                asm volatile("" ::: "memory"); }
    }
};

struct EpiResNorm {
    static constexpr bool PERM = false, AFTER_DRAIN = false;
    const float* base; float* out; int ldc; float* rss2; unsigned* cnt; const float* w;
    __device__ __forceinline__ void operator()(f32x4 (&acc)[2][2][4][2], const Unit& u, int wr, int wc, int fr, int fq) const {
        const int row0 = u.pm * BM + wr * 64 + fr; const int col0 = u.pn * BM + wc * 32 + 4 * fq;
#pragma unroll
        for (int ai = 0; ai < 2; ++ai)
#pragma unroll
            for (int m = 0; m < 4; ++m) { const size_t off = (size_t)(row0 + ai * HALF + m * 16) * ldc + col0; float ss = 0.f;
#pragma unroll
                for (int bj = 0; bj < 2; ++bj)
#pragma unroll
                    for (int n = 0; n < 2; ++n) { const size_t o = off + bj * HALF + n * 16; const f32x4 x = *(const f32x4*)(base + o) + acc[ai][bj][m][n]; acc[ai][bj][m][n] = x;
                        ss += (x[0] * x[0] + x[1] * x[1]) + (x[2] * x[2] + x[3] * x[3]); }
                ss += shfl_xor_f(ss, 16); ss += shfl_xor_f(ss, 32); if (fq == 0) atomicAdd(rss2 + row0 + ai * HALF + m * 16, ss);
                asm volatile("" ::: "memory"); }
        asm volatile("s_waitcnt vmcnt(0)" ::: "memory");
        unsigned* pc = cnt + 64 * u.pm;
        if (lane_now() == 0) __hip_atomic_fetch_add(pc, 1u, __ATOMIC_RELAXED, __HIP_MEMORY_SCOPE_AGENT);
        for (unsigned spin = 0; spin < (1u << 22); ++spin) { if ((unsigned)__builtin_amdgcn_readfirstlane((int)__hip_atomic_load(pc, __ATOMIC_RELAXED, __HIP_MEMORY_SCOPE_AGENT)) >= 32u) break; __builtin_amdgcn_s_sleep(2); }
#pragma unroll
        for (int ai = 0; ai < 2; ++ai)
#pragma unroll
            for (int m = 0; m < 4; ++m) { const int row = row0 + ai * HALF + m * 16; const size_t off = (size_t)row * ldc + col0;
                const float rs = 1.0f / sqrtf(__hip_atomic_load(rss2 + row, __ATOMIC_RELAXED, __HIP_MEMORY_SCOPE_AGENT) * (1.0f / 1024.0f) + 1e-6f);
#pragma unroll
                for (int bj = 0; bj < 2; ++bj)
#pragma unroll
                    for (int n = 0; n < 2; ++n) { const size_t o = off + bj * HALF + n * 16; const f32x4 ww = *(const f32x4*)(w + col0 + bj * HALF + n * 16); *(f32x4*)(out + o) = acc[ai][bj][m][n] * rs * ww; } }
    }
};

template <class Epi, class Sched, bool ALIGN_EPI = false, bool SP2 = false>
__device__ __forceinline__ void gemm_phase(PG8_LAS unsigned char* lds, const Gemm g, const Sched& S, const Epi& E, const int wave_) {
    int wv_ = wave_; asm volatile("" : "+s"(wv_)); int tid_ = lane_now() + 64 * wv_; const int tid = tid_, wid = wv_, lane = tid & 63, wr = wid >> 2, wc = wid & 3, fr = lane & 15, fq = lane >> 4;
    const int K = g.K, nt = K / BK;
    unsigned voffA[2], voffB[2];
#pragma unroll
    for (int i = 0; i < 2; ++i) { int R, C; stage_rc(tid * 16 + i * 8192, R, C); const int Rb = Epi::PERM ? ((R & ~31) + perm32(R & 31)) : R;
        voffA[i] = (unsigned)(R * K + C) * 2u; voffB[i] = (unsigned)(Rb * K + C) * 2u; }
    const size_t kstep = (size_t)(BK * 2);
    const size_t hstep = (size_t)HALF * K * 2;
    const size_t tstep = 2 * hstep;
    const unsigned ldsw = (unsigned)wid * 1024u;
    const int aoff = lds_byte(wr * 64 + fr, fq * 8), boff = lds_byte(wc * 32 + fr, fq * 8);
#define PG8_SA(b, h) (((b) * 2 + (h)) * HTB)
#define PG8_SB(b, h) ((4 + (b) * 2 + (h)) * HTB)
#define PG8_STAGE(bufoff, gbase, voff) do { _Pragma("unroll") for (int _i = 0; _i < 2; ++_i) \
        __builtin_amdgcn_global_load_lds((const unsigned*)((const char*)(gbase) + (voff)[_i]), (PG8_LAS unsigned*)(lds + (bufoff) + ldsw + _i * 8192), 16, 0, 0); } while (0)
#define PG8_LDA(dst, b, h) do { _Pragma("unroll") for (int m = 0; m < 4; ++m) _Pragma("unroll") for (int k = 0; k < 2; ++k) dst[m][k] = *(const PG8_LAS bf16x8*)(lds + PG8_SA(b, h) + aoff + m * 2048 + k * 1024); } while (0)
#define PG8_LDB(dst, b, h) do { _Pragma("unroll") for (int n = 0; n < 2; ++n) _Pragma("unroll") for (int k = 0; k < 2; ++k) dst[n][k] = *(const PG8_LAS bf16x8*)(lds + PG8_SB(b, h) + boff + n * 2048 + k * 1024); } while (0)
#define PG8_MMA(ai, bj, At, Bt) do { __builtin_amdgcn_s_setprio(1); _Pragma("unroll") for (int m = 0; m < 4; ++m) _Pragma("unroll") for (int n = 0; n < 2; ++n) _Pragma("unroll") for (int k = 0; k < 2; ++k) \
        acc[ai][bj][m][n] = MK_MFMA(Bt[n][k], At[m][k], acc[ai][bj][m][n]); __builtin_amdgcn_s_setprio(0); } while (0)
#define PG8_WAIT_V(n) asm volatile("s_waitcnt vmcnt(" #n ")" ::: "memory")
#define PG8_WAIT_L(n) asm volatile("s_waitcnt lgkmcnt(" #n ")" ::: "memory")
#define PG8_BAR __builtin_amdgcn_s_barrier()
#define PG8_SCHED __builtin_amdgcn_sched_barrier(0)
    Unit cur, nxt; int ui = 0;
    if (!S.next(0, cur)) return;
    f32x4 acc[2][2][4][2];
#pragma unroll
    for (int a = 0; a < 2; ++a)
#pragma unroll
        for (int b = 0; b < 2; ++b)
#pragma unroll
            for (int m = 0; m < 4; ++m)
#pragma unroll
                for (int n = 0; n < 2; ++n) acc[a][b][m][n] = (f32x4){0.f, 0.f, 0.f, 0.f};
    bf16x8 At[4][2], B0[2][2], B1[2][2];
    const char* cA = (const char*)g.A + (size_t)cur.pm * tstep; const char* cB = (const char*)g.Bt + (size_t)cur.pn * tstep;
    S.a_ready(cur);
    if constexpr (SP2) {
        PG8_STAGE(PG8_SB(0, 0), cB, voffB); PG8_STAGE(PG8_SB(0, 1), cB + hstep, voffB); PG8_STAGE(PG8_SA(0, 0), cA, voffA); PG8_STAGE(PG8_SA(0, 1), cA + hstep, voffA);
        if (wr == 1) PG8_BAR;
        PG8_WAIT_V(2); PG8_BAR;
        PG8_STAGE(PG8_SB(1, 0), cB + kstep, voffB); PG8_STAGE(PG8_SA(1, 0), cA + kstep, voffA); PG8_STAGE(PG8_SB(1, 1), cB + hstep + kstep, voffB);
        PG8_WAIT_V(6); PG8_BAR;
    } else {
        PG8_STAGE(PG8_SB(0, 0), cB, voffB); PG8_STAGE(PG8_SA(0, 0), cA, voffA); PG8_STAGE(PG8_SB(0, 1), cB + hstep, voffB); PG8_STAGE(PG8_SA(0, 1), cA + hstep, voffA);
        if (wr == 1) PG8_BAR;
        PG8_WAIT_V(4); PG8_BAR;
        PG8_STAGE(PG8_SB(1, 0), cB + kstep, voffB); PG8_STAGE(PG8_SA(1, 0), cA + kstep, voffA); PG8_STAGE(PG8_SB(1, 1), cB + hstep + kstep, voffB);
        PG8_WAIT_V(6); PG8_BAR;
    }
    for (;;) {
        const bool has_next = S.next(ui + 1, nxt);
        const char* nA = has_next ? (const char*)g.A + (size_t)nxt.pm * tstep : cA; const char* nB = has_next ? (const char*)g.Bt + (size_t)nxt.pn * tstep : cB;
        for (int t = 0; t < nt; t += 2) {
            const bool last = (t == nt - 2);
            const char* a1 = cA + (size_t)(t + 1) * kstep;
            const char* a2 = last ? nA : cA + (size_t)(t + 2) * kstep; const char* b2 = last ? nB : cB + (size_t)(t + 2) * kstep;
            const char* a3 = a2 + kstep; const char* b3 = b2 + kstep;
            if (last && has_next) S.a_ready(nxt);
            if constexpr (SP2) {
            PG8_LDB(B0, 0, 0); PG8_LDB(B1, 0, 1); PG8_SCHED; PG8_LDA(At, 0, 0); PG8_STAGE(PG8_SA(1, 1), a1 + hstep, voffA);
            PG8_WAIT_V(8); PG8_WAIT_L(0); PG8_BAR; PG8_MMA(0, 0, At, B0); PG8_MMA(0, 1, At, B1); PG8_BAR; PG8_SCHED;
            PG8_LDA(At, 0, 1); PG8_STAGE(PG8_SB(0, 0), b2, voffB); PG8_STAGE(PG8_SB(0, 1), b2 + hstep, voffB); PG8_STAGE(PG8_SA(0, 0), a2, voffA);
            PG8_WAIT_V(8); PG8_WAIT_L(0); PG8_BAR; PG8_MMA(1, 0, At, B0); PG8_MMA(1, 1, At, B1); PG8_BAR; PG8_SCHED;
            PG8_LDB(B0, 1, 0); PG8_LDB(B1, 1, 1); PG8_SCHED; PG8_LDA(At, 1, 0); PG8_STAGE(PG8_SA(0, 1), a2 + hstep, voffA);
            PG8_WAIT_V(8); PG8_WAIT_L(0); PG8_BAR; PG8_MMA(0, 0, At, B0); PG8_MMA(0, 1, At, B1); PG8_BAR; PG8_SCHED;
            PG8_LDA(At, 1, 1); PG8_STAGE(PG8_SB(1, 0), b3, voffB); PG8_STAGE(PG8_SB(1, 1), b3 + hstep, voffB); PG8_STAGE(PG8_SA(1, 0), a3, voffA);
            PG8_WAIT_V(8); PG8_WAIT_L(0); PG8_BAR; PG8_MMA(1, 0, At, B0); PG8_MMA(1, 1, At, B1); PG8_BAR; PG8_SCHED;
            } else {
            PG8_LDB(B0, 0, 0); PG8_SCHED; PG8_LDA(At, 0, 0); PG8_STAGE(PG8_SA(1, 1), a1 + hstep, voffA);
            PG8_WAIT_L(8); PG8_BAR; PG8_WAIT_L(0); PG8_MMA(0, 0, At, B0); PG8_BAR; PG8_SCHED;
            PG8_LDB(B1, 0, 1); PG8_STAGE(PG8_SB(0, 0), b2, voffB);
            PG8_BAR; PG8_WAIT_L(0); PG8_MMA(0, 1, At, B1); PG8_BAR;
            PG8_LDA(At, 0, 1); PG8_STAGE(PG8_SA(0, 0), a2, voffA);
            PG8_BAR; PG8_WAIT_L(0); PG8_MMA(1, 0, At, B0); PG8_BAR; PG8_SCHED;
            PG8_STAGE(PG8_SB(0, 1), b2 + hstep, voffB);
            PG8_WAIT_V(6); PG8_BAR; PG8_MMA(1, 1, At, B1); PG8_BAR;
            PG8_LDB(B0, 1, 0); PG8_SCHED; PG8_LDA(At, 1, 0); PG8_STAGE(PG8_SA(0, 1), a2 + hstep, voffA);
            PG8_WAIT_L(8); PG8_BAR; PG8_WAIT_L(0); PG8_MMA(0, 0, At, B0); PG8_BAR; PG8_SCHED;
            PG8_LDB(B1, 1, 1); PG8_STAGE(PG8_SB(1, 0), b3, voffB);
            PG8_BAR; PG8_WAIT_L(0); PG8_MMA(0, 1, At, B1); PG8_BAR;
            PG8_LDA(At, 1, 1); PG8_STAGE(PG8_SA(1, 0), a3, voffA);
            PG8_BAR; PG8_WAIT_L(0); PG8_MMA(1, 0, At, B0); PG8_BAR; PG8_SCHED;
            PG8_STAGE(PG8_SB(1, 1), b3 + hstep, voffB);
            PG8_WAIT_V(6); PG8_BAR; PG8_MMA(1, 1, At, B1); PG8_BAR;
            }
        }
        if constexpr (ALIGN_EPI) { if (wr == 0) PG8_BAR; }
        if constexpr (!Epi::AFTER_DRAIN) { E(acc, cur, wr, wc, fr, fq); S.done(cur); }
        if (!has_next) break;
#pragma unroll
        for (int a = 0; a < 2; ++a)
#pragma unroll
            for (int b = 0; b < 2; ++b)
#pragma unroll
                for (int m = 0; m < 4; ++m)
#pragma unroll
                    for (int n = 0; n < 2; ++n) acc[a][b][m][n] = (f32x4){0.f, 0.f, 0.f, 0.f};
        cur = nxt; cA = nA; cB = nB; ++ui;
        if constexpr (ALIGN_EPI) { if (wr == 1) PG8_BAR; }
    }
    PG8_WAIT_V(0);
    if constexpr (!ALIGN_EPI) { if (wr == 0) PG8_BAR; }
    PG8_BAR;
    if constexpr (Epi::AFTER_DRAIN) { E.fused(acc, cur, wr, wc, fr, fq, lds, wid, lane); S.done(cur); }
#undef PG8_SA
#undef PG8_SB
#undef PG8_STAGE
#undef PG8_LDA
#undef PG8_LDB
#undef PG8_MMA
#undef PG8_WAIT_V
#undef PG8_WAIT_L
#undef PG8_BAR
#undef PG8_SCHED
}
}

constexpr int BATCH = 2, SEQ = 8192, DM = 1024, DEPTH = 2, M = BATCH * SEQ;
constexpr int RW_H = 6, HD = 64, RW_W = 384, RW_SHIFT = 1280;
constexpr int NIN = 3712, NU = 3840;
constexpr int C_R = 0, C_K = 384, C_V = 768, C_WL = 1152, C_AL = 1216, C_RWZ = 1280, C_HGQ = 1664, C_HGF = 2048, C_HGI = 2432, C_HGZ = 2816, C_LRUX = 3200, C_LRUZ = 3456;
constexpr int CH = 64;
constexpr int NWAVES = 8, NT = NWAVES * 64;
constexpr int LDS_BYTES = 163840;
constexpr int PRM_OFF = 154624;
constexpr size_t MiB = 1u << 20;
constexpr size_t WS_WUPT = 65536, WS_AUPT = WS_WUPT + 98304, WS_VDNT = WS_AUPT + 98304, WS_VUPT = WS_VDNT + 24576, WS_WAT = WS_VUPT + 24576, WS_WXT = WS_WAT + 65536;
constexpr size_t WS_WIN = 1 * MiB, WIN_L = (size_t)NU * DM * 2;
constexpr size_t WS_WOUT = 16 * MiB, WOUT_L = (size_t)DM * DM * 2;
constexpr size_t WS_XN = 20 * MiB;
constexpr size_t WS_QT = 20 * MiB;
constexpr size_t WS_PT = 32 * MiB;
constexpr size_t WS_CA = 44 * MiB;
constexpr size_t WS_U = 52 * MiB;
constexpr size_t WS_MIX = 172 * MiB;
constexpr size_t WS_VF = 204 * MiB;
constexpr size_t WS_VP = 216 * MiB;
constexpr size_t WS_RL = 228 * MiB;
constexpr size_t WS_HL = 240 * MiB;
constexpr size_t WS_BON = 252 * MiB;
constexpr size_t WS_DC = WS_BON + 512 * 1024;
constexpr size_t WS_LA = WS_DC + 512 * 1024;
constexpr size_t WS_LH = WS_LA + 256 * 1024;
constexpr size_t WS_RSS = WS_LH + 256 * 1024;
constexpr size_t WS_END = 254 * MiB;
constexpr int NCH = SEQ / CH;

#define LAS __attribute__((address_space(3)))
typedef float f32x4 __attribute__((ext_vector_type(4)));
typedef unsigned u32x2 __attribute__((ext_vector_type(2)));
typedef unsigned u32x4 __attribute__((ext_vector_type(4)));
typedef _Float16 f16;
typedef _Float16 f16x8 __attribute__((ext_vector_type(8)));
#define LDS_WAIT() asm volatile("s_waitcnt lgkmcnt(0)" ::: "memory")

struct Args { const float* in[27]; float* out; unsigned char* ws; };

__device__ __forceinline__ float wave_sum(float v) {
#pragma unroll
    for (int o = 1; o < 64; o <<= 1) v += shfl_xor_f(v, o);
    return v;
}
__device__ __forceinline__ float sigmoidf_(float x) { return __builtin_amdgcn_rcpf(1.0f + __expf(-x)); }
__device__ __forceinline__ float rsq_(float x) { return __builtin_amdgcn_rsqf(x); }
__device__ __forceinline__ float one_minus_exp_(float x) { return (x > -0.03f) ? -x * (1.0f + x * (0.5f + x * (1.0f / 6.0f + x * (1.0f / 24.0f)))) : 1.0f - __expf(x); }
__device__ __forceinline__ float siluf_(float x) { return x * __builtin_amdgcn_rcpf(1.0f + __expf(-x)); }

__device__ __forceinline__ void p0_transpose_item(const float* W, int K, int N, unsigned short* WT, LAS float* scr, int item, int lane, const float* rsc) {
    const int nblk = N / 32, kb = item / nblk, nb = item % nblk, k0 = 64 * kb, n0 = 32 * nb;
    float tv[32];
#pragma unroll
    for (int i = 0; i < 32; ++i) { const int kk = 2 * i + (lane >> 5); tv[i] = W[(size_t)(k0 + kk) * N + n0 + (lane & 31)]; }
#pragma unroll
    for (int i = 0; i < 32; ++i) { const int kk = 2 * i + (lane >> 5); scr[kk * 33 + (lane & 31)] = tv[i] * (rsc ? rsc[k0 + kk] : 1.0f); }
    LDS_WAIT(); asm volatile("" ::: "memory");
    const int c = lane & 7;
#pragma unroll
    for (int j = 0; j < 4; ++j) { const int n = (lane >> 3) + 8 * j; const LAS float* s = scr + (8 * c) * 33 + n;
        u32x4 o; o.x = pg8::pk_f16(s[0 * 33], s[1 * 33]); o.y = pg8::pk_f16(s[2 * 33], s[3 * 33]); o.z = pg8::pk_f16(s[4 * 33], s[5 * 33]); o.w = pg8::pk_f16(s[6 * 33], s[7 * 33]);
        *(u32x4*)(WT + (size_t)(n0 + n) * K + k0 + 8 * c) = o; }
    LDS_WAIT(); asm volatile("" ::: "memory");
}
__device__ __forceinline__ void rms_row_f16(const float* xrow, const float* w, unsigned short* orow, int lane) {
    const f32x4* xr = (const f32x4*)xrow + lane; const f32x4* wr = (const f32x4*)w + lane;
    f32x4 v[4]; float s = 0.f;
#pragma unroll
    for (int j = 0; j < 4; ++j) { v[j] = xr[64 * j]; s += (v[j].x * v[j].x + v[j].y * v[j].y) + (v[j].z * v[j].z + v[j].w * v[j].w); }
    const float rs = 1.0f / sqrtf(wave_sum(s) * (1.0f / DM) + 1e-6f);
    u32x2* o8 = (u32x2*)orow + lane;
#pragma unroll
    for (int j = 0; j < 4; ++j) { const f32x4 ww = wr[64 * j]; u32x2 o; o.x = pg8::pk_f16(v[j].x * rs * ww.x, v[j].y * rs * ww.y); o.y = pg8::pk_f16(v[j].z * rs * ww.z, v[j].w * rs * ww.w); o8[64 * j] = o; }
}
__device__ __forceinline__ void rms_row_f32(float* xrow, const float* w, int lane) {
    f32x4* xr = (f32x4*)xrow + lane; const f32x4* wr = (const f32x4*)w + lane;
    f32x4 v[4]; float s = 0.f;
#pragma unroll
    for (int j = 0; j < 4; ++j) { v[j] = xr[64 * j]; s += (v[j].x * v[j].x + v[j].y * v[j].y) + (v[j].z * v[j].z + v[j].w * v[j].w); }
    const float rs = 1.0f / sqrtf(wave_sum(s) * (1.0f / DM) + 1e-6f);
#pragma unroll
    for (int j = 0; j < 4; ++j) { const f32x4 ww = wr[64 * j]; xr[64 * j] = v[j] * rs * ww; }
}

__device__ __forceinline__ void rms_row2_f32(float* xa, float* xb, const float* w, int lane) {
    f32x4* ra = (f32x4*)xa + lane; f32x4* rb = (f32x4*)xb + lane; const f32x4* wr = (const f32x4*)w + lane;
    f32x4 va[4], vb[4]; float sa = 0.f, sb = 0.f;
#pragma unroll
    for (int j = 0; j < 4; ++j) { va[j] = ra[64 * j]; vb[j] = rb[64 * j]; }
#pragma unroll
    for (int j = 0; j < 4; ++j) { sa += (va[j].x * va[j].x + va[j].y * va[j].y) + (va[j].z * va[j].z + va[j].w * va[j].w); sb += (vb[j].x * vb[j].x + vb[j].y * vb[j].y) + (vb[j].z * vb[j].z + vb[j].w * vb[j].w); }
    const float rsa = 1.0f / sqrtf(wave_sum(sa) * (1.0f / DM) + 1e-6f), rsb = 1.0f / sqrtf(wave_sum(sb) * (1.0f / DM) + 1e-6f);
#pragma unroll
    for (int j = 0; j < 4; ++j) { const f32x4 ww = wr[64 * j]; ra[64 * j] = va[j] * rsa * ww; rb[64 * j] = vb[j] * rsb * ww; }
}
__device__ __forceinline__ void rms_row4_f16(const float* x0, size_t rs, const float* w, unsigned short* o0, int lane) {
    f32x4 v[4][4]; float s[4];
#pragma unroll
    for (int r = 0; r < 4; ++r)
#pragma unroll
        for (int j = 0; j < 4; ++j) v[r][j] = ((const f32x4*)(x0 + r * rs) + lane)[64 * j];
    const f32x4* wr = (const f32x4*)w + lane;
#pragma unroll
    for (int r = 0; r < 4; ++r) { float a = 0.f;
#pragma unroll
        for (int j = 0; j < 4; ++j) a += (v[r][j].x * v[r][j].x + v[r][j].y * v[r][j].y) + (v[r][j].z * v[r][j].z + v[r][j].w * v[r][j].w);
        s[r] = 1.0f / sqrtf(wave_sum(a) * (1.0f / DM) + 1e-6f); }
#pragma unroll
    for (int j = 0; j < 4; ++j) { const f32x4 ww = wr[64 * j];
#pragma unroll
        for (int r = 0; r < 4; ++r) { u32x2 o; o.x = pg8::pk_f16(v[r][j].x * s[r] * ww.x, v[r][j].y * s[r] * ww.y); o.y = pg8::pk_f16(v[r][j].z * s[r] * ww.z, v[r][j].w * s[r] * ww.w); ((u32x2*)(o0 + r * rs) + lane)[64 * j] = o; } }
}
__device__ __forceinline__ void rms_row4_f32(float* x0, size_t rs, const float* w, int lane) {
    f32x4 v[4][4]; float s[4];
#pragma unroll
    for (int r = 0; r < 4; ++r)
#pragma unroll
        for (int j = 0; j < 4; ++j) v[r][j] = ((const f32x4*)(x0 + r * rs) + lane)[64 * j];
    const f32x4* wr = (const f32x4*)w + lane;
#pragma unroll
    for (int r = 0; r < 4; ++r) { float a = 0.f;
#pragma unroll
        for (int j = 0; j < 4; ++j) a += (v[r][j].x * v[r][j].x + v[r][j].y * v[r][j].y) + (v[r][j].z * v[r][j].z + v[r][j].w * v[r][j].w);
        s[r] = rsq_(wave_sum(a) * (1.0f / DM) + 1e-6f); }
#pragma unroll
    for (int j = 0; j < 4; ++j) { const f32x4 ww = wr[64 * j];
#pragma unroll
        for (int r = 0; r < 4; ++r) ((f32x4*)(x0 + r * rs) + lane)[64 * j] = v[r][j] * s[r] * ww; }
}

#define SHV(col) ({ const float cur_ = (float)urow[(col)]; const float prev_ = hp ? (float)prow[(col)] : 0.f; cur_ + mu[(col)] * (prev_ - cur_); })

__device__ __forceinline__ void store_row64_f16(f16* dst, const float (&S)[64]) {
#pragma unroll
    for (int q = 0; q < 8; ++q) { u32x4 w; w.x = pg8::pk_f16(S[8 * q], S[8 * q + 1]); w.y = pg8::pk_f16(S[8 * q + 2], S[8 * q + 3]); w.z = pg8::pk_f16(S[8 * q + 4], S[8 * q + 5]); w.w = pg8::pk_f16(S[8 * q + 6], S[8 * q + 7]); *(u32x4*)(dst + 8 * q) = w; }
}


constexpr int RWT_ROW = 144, RWT_A = 0, RWT_R = 2304, RWT_B = 4608, RWT_K = 6912;
constexpr int RWC_B = 9216, RWC_K = 11264, RWC_V = 13312;
constexpr int RWF_G16 = 15360, RWF_RHO = 15616, RWA_INV = 15872, RWA_NMAT = 15936  , RWA_XPARK = 18496  , RWA_BYTES = 20992;
constexpr int C_VD0 = 3712, C_VD1 = 3744;
constexpr int PRM_MU = 0, PRM_A0 = 1280, PRM_KK = 1664, PRM_KA = 2048, PRM_RK = 2432, PRM_V0 = 2816, PRM_HALVES = 3200, PRM_W0_BYTE = 6400, PRM_BYTES = PRM_W0_BYTE + 1536;
typedef float f32x2 __attribute__((ext_vector_type(2)));
typedef _Float16 f16x4 __attribute__((ext_vector_type(4)));
__device__ __forceinline__ float fmix_lo(float a, unsigned b, float c) { float d; asm("v_fma_mix_f32 %0, %1, %2, %3 op_sel:[0,0,0] op_sel_hi:[0,1,0]" : "=v"(d) : "v"(a), "v"(b), "v"(c)); return d; }
__device__ __forceinline__ float fmix_hi(float a, unsigned b, float c) { float d; asm("v_fma_mix_f32 %0, %1, %2, %3 op_sel:[0,1,0] op_sel_hi:[0,1,0]" : "=v"(d) : "v"(a), "v"(b), "v"(c)); return d; }
__device__ __forceinline__ float mmix_lo(float a, unsigned b) { float d; asm("v_fma_mix_f32 %0, %1, %2, 0 op_sel:[0,0,0] op_sel_hi:[0,1,0]" : "=v"(d) : "v"(a), "v"(b)); return d; }
__device__ __forceinline__ float mmix_hi(float a, unsigned b) { float d; asm("v_fma_mix_f32 %0, %1, %2, 0 op_sel:[0,1,0] op_sel_hi:[0,1,0]" : "=v"(d) : "v"(a), "v"(b)); return d; }
__device__ __forceinline__ float mul_asm(float a, float b) { float d; asm("v_mul_f32 %0, %1, %2" : "=v"(d) : "v"(a), "v"(b)); return d; }
__device__ __forceinline__ float fma_asm(float a, float b, float c) { float d; asm("v_fma_f32 %0, %1, %2, %3" : "=v"(d) : "v"(a), "v"(b), "v"(c)); return d; }
#define FMIX(a, u, j, c) (((j) & 1) ? fmix_hi((a), (u)[(j) >> 1], (c)) : fmix_lo((a), (u)[(j) >> 1], (c)))
#define MMIX(a, u, j) (((j) & 1) ? mmix_hi((a), (u)[(j) >> 1]) : mmix_lo((a), (u)[(j) >> 1]))
__device__ __forceinline__ float fast_tanh(float x) { return 1.0f - 2.0f * __builtin_amdgcn_rcpf(__expf(2.0f * x) + 1.0f); }
__device__ __forceinline__ void lerp8(const char* ub, unsigned uo, unsigned po, bool hp, const char* mub, unsigned col, float (&x)[8]) {
    const f16x8 cu = *(const f16x8*)(ub + (uo + col * 2u)); f16x8 pv = *(const f16x8*)(ub + (po + col * 2u)); const f32x4 m0 = *(const f32x4*)(mub + col * 4u), m1 = *(const f32x4*)(mub + col * 4u + 16u);
#pragma unroll
    for (int j = 0; j < 8; ++j) { const float c = (float)cu[j], p = hp ? (float)pv[j] : 0.f; x[j] = c + (j < 4 ? m0[j] : m1[j - 4]) * (p - c); }
}
__device__ __forceinline__ void lerp4(const char* ub, unsigned uo, unsigned po, bool hp, const char* mub, unsigned col, float (&x)[4]) {
    const f16x4 cu = *(const f16x4*)(ub + (uo + col * 2u)); f16x4 pv = *(const f16x4*)(ub + (po + col * 2u)); const f32x4 m0 = *(const f32x4*)(mub + col * 4u);
#pragma unroll
    for (int j = 0; j < 4; ++j) { const float c = (float)cu[j], p = hp ? (float)pv[j] : 0.f; x[j] = c + m0[j] * (p - c); }
}
__device__ __forceinline__ f16x8 pack8(const float (&x)[8]) { f16x8 r;
#pragma unroll
    for (int j = 0; j < 8; ++j) r[j] = (f16)x[j];
    return r; }

template <int CTRL> __device__ __forceinline__ float dpp_f(float x) { return __builtin_bit_cast(float, __builtin_amdgcn_update_dpp(0, __builtin_bit_cast(int, x), CTRL, 0xF, 0xF, true)); }
__device__ __forceinline__ float row_prefix16(float x) { x += dpp_f<0x111>(x); x += dpp_f<0x112>(x); x += dpp_f<0x114>(x); x += dpp_f<0x118>(x); return x; }
__device__ __forceinline__ float bperm_f(int byteaddr, float x) { return __builtin_bit_cast(float, __builtin_amdgcn_ds_bpermute(byteaddr, __builtin_bit_cast(int, x))); }
__device__ __forceinline__ f16x4 cvt4(const f32x4 v) { f16x4 r; r[0] = (f16)v[0]; r[1] = (f16)v[1]; r[2] = (f16)v[2]; r[3] = (f16)v[3]; return r; }
#define MF16(A, B, C) __builtin_amdgcn_mfma_f32_16x16x16f16((A), (B), (C), 0, 0, 0)
#define MF32(A, B, C) __builtin_amdgcn_mfma_f32_16x16x32_f16((A), (B), (C), 0, 0, 0)

__device__ __forceinline__ void rwkv_waveA(const Args& a, int l, int b, int c, int h, LAS unsigned char* wl, const LAS unsigned char* prmb, int lane) {
    const LAS f16* prm = (const LAS f16*)prmb; const LAS float* prw0 = (const LAS float*)(prmb + PRM_W0_BYTE);
    const char* Ub = (const char*)(a.ws + WS_U); f16* MIX = (f16*)(a.ws + WS_MIX); char* VF = (char*)(a.ws + WS_VF); char* VP = (char*)(a.ws + WS_VP);
    f16* QT = (f16*)(a.ws + WS_QT); f16* PT = (f16*)(a.ws + WS_PT); f16* RL = (f16*)(a.ws + WS_RL); float* BONG = (float*)(a.ws + WS_BON);
    const char* WUPT = (const char*)(a.ws + WS_WUPT) + (size_t)l * 384 * 64 * 2; const char* AUPT = (const char*)(a.ws + WS_AUPT) + (size_t)l * 384 * 64 * 2;
    const char* VUPT = (const char*)(a.ws + WS_VUPT);
    const int bh = b * RW_H + h;
    f32x4 XT[4][8];
#pragma unroll
    for (int ct = 0; ct < 4; ++ct)
#pragma unroll
        for (int vt = 0; vt < 8; ++vt)
#pragma unroll
            for (int r = 0; r < 4; ++r) XT[ct][vt][r] = (vt == ct && (lane & 15) == 4 * (lane >> 4) + r) ? 1.f : 0.f;
#define XPK(ct, vt) ((vt) == 7 && (ct) >= 2)
#define XPA(ct) (*(LAS f32x4*)(wl + RWA_XPARK + ((ct) - 2) * 1024 + lane_now() * 16))
    XPA(2) = (f32x4){0.f, 0.f, 0.f, 0.f}; XPA(3) = (f32x4){0.f, 0.f, 0.f, 0.f};
#pragma unroll 1
    for (int blk = 0; blk < 4; ++blk) {
        const int lane_ = lane_now();
        const int tok = lane_ & 15, fq = lane_ >> 4;
        const int t = c * CH + blk * 16 + tok; const unsigned m = (unsigned)(b * SEQ + t); const bool hp = t > 0;
        const unsigned uo = m * (unsigned)(NU * 2), po = hp ? uo - (unsigned)(NU * 2) : uo;
        f16x8 cW[2], pW[2], cA[2], pA[2], vd0, vd1;
#pragma unroll
        for (int s = 0; s < 2; ++s) { const unsigned cw = (unsigned)(C_WL + 8 * fq + 32 * s) * 2u, ca = (unsigned)(C_AL + 8 * fq + 32 * s) * 2u;
            cW[s] = *(const f16x8*)(Ub + uo + cw); pW[s] = *(const f16x8*)(Ub + po + cw); cA[s] = *(const f16x8*)(Ub + uo + ca); pA[s] = *(const f16x8*)(Ub + po + ca); }
        vd0 = *(const f16x8*)(Ub + uo + (unsigned)(C_VD0 + 8 * fq) * 2u); vd1 = *(const f16x8*)(Ub + po + (unsigned)(C_VD1 + 8 * fq) * 2u);
#define RW_WLOAD(nt) { const unsigned n_ = (unsigned)(h * 64 + 16 * (nt) + tok);        \
            Wwu0 = *(const f16x8*)(WUPT + (n_ * 64u + 8u * fq) * 2u); Wwu1 = *(const f16x8*)(WUPT + (n_ * 64u + 8u * fq + 32u) * 2u); \
            Wau0 = *(const f16x8*)(AUPT + (n_ * 64u + 8u * fq) * 2u); Wau1 = *(const f16x8*)(AUPT + (n_ * 64u + 8u * fq + 32u) * 2u); \
            if (l > 0) Wvu = *(const f16x8*)(VUPT + (n_ * 32u + 8u * fq) * 2u); }
#define RW_ADECL(X) f16x4 X##cr, X##pr, X##ck, X##pk, X##cv, X##pv, X##vf;
#define RW_ALOAD(X, nt) { const unsigned cb_ = (unsigned)(h * 64 + 16 * (nt) + 4 * fq);        \
            if (l > 0) X##vf = *(const f16x4*)(VF + (m * (unsigned)RW_W + cb_) * 2u); \
            X##cr = *(const f16x4*)(Ub + uo + ((unsigned)C_R + cb_) * 2u); X##pr = *(const f16x4*)(Ub + po + ((unsigned)C_R + cb_) * 2u); \
            X##ck = *(const f16x4*)(Ub + uo + ((unsigned)C_K + cb_) * 2u); X##pk = *(const f16x4*)(Ub + po + ((unsigned)C_K + cb_) * 2u); \
            X##cv = *(const f16x4*)(Ub + uo + ((unsigned)C_V + cb_) * 2u); X##pv = *(const f16x4*)(Ub + po + ((unsigned)C_V + cb_) * 2u); }
        f16x8 Wwu0, Wwu1, Wau0, Wau1, Wvu; RW_ADECL(T0) RW_ADECL(T1)
        f16x8 bW[2], bA[2], bVD;
#pragma unroll
        for (int s = 0; s < 2; ++s) { float xw[8], xa[8];
            const f16x8 mw = *(const LAS f16x8*)(prm + PRM_MU + C_WL + 8 * fq + 32 * s), ma = *(const LAS f16x8*)(prm + PRM_MU + C_AL + 8 * fq + 32 * s);
#pragma unroll
            for (int j = 0; j < 8; ++j) { const float cw_ = (float)cW[s][j], pw_ = hp ? (float)pW[s][j] : 0.f, ca_ = (float)cA[s][j], pa_ = hp ? (float)pA[s][j] : 0.f;
                xw[j] = fast_tanh(cw_ + (float)mw[j] * (pw_ - cw_)); xa[j] = ca_ + (float)ma[j] * (pa_ - ca_); }
            bW[s] = pack8(xw); bA[s] = pack8(xa); }
        { float xv[8];
#pragma unroll
            for (int j = 0; j < 8; ++j) xv[j] = (float)vd0[j] + (hp ? (float)vd1[j] : 0.f);
            bVD = pack8(xv); }
        float ssq = 0.f, bon = 0.f;
        RW_ALOAD(T0, 0) asm volatile("" ::: "memory");
        const int bp7 = ((lane_ & 48) | 7) << 2, bp15 = ((lane_ & 48) | 15) << 2;
        f32x4 DWn, DAn, Gn;
#define RW_TMFMA() { DWn = (f32x4){0.f, 0.f, 0.f, 0.f}; DAn = DWn; Gn = DWn; \
            DWn = __builtin_amdgcn_mfma_f32_16x16x32_f16(Wwu0, bW[0], DWn, 0, 0, 0); DWn = __builtin_amdgcn_mfma_f32_16x16x32_f16(Wwu1, bW[1], DWn, 0, 0, 0); \
            DAn = __builtin_amdgcn_mfma_f32_16x16x32_f16(Wau0, bA[0], DAn, 0, 0, 0); DAn = __builtin_amdgcn_mfma_f32_16x16x32_f16(Wau1, bA[1], DAn, 0, 0, 0); \
            if (l > 0) Gn = __builtin_amdgcn_mfma_f32_16x16x32_f16(Wvu, bVD, Gn, 0, 0, 0); \
            asm volatile("" : "+v"(DWn), "+v"(DAn), "+v"(Gn)); }
#define RW_TCOMP(X, nt) { const int cb = h * 64 + 16 * (nt) + 4 * fq, co = 16 * (nt) + 4 * fq; \
            f16x4 ah, rh, bh, kh, bb, kb, vo; f32x4 rho4, g164; \
            const f16x4 pmr = *(const LAS f16x4*)(prm + PRM_MU + C_R + cb), pmk = *(const LAS f16x4*)(prm + PRM_MU + C_K + cb), pmv = *(const LAS f16x4*)(prm + PRM_MU + C_V + cb); \
            const f16x4 pa0 = *(const LAS f16x4*)(prm + PRM_A0 + cb), pkk = *(const LAS f16x4*)(prm + PRM_KK + cb), pka = *(const LAS f16x4*)(prm + PRM_KA + cb), prk = *(const LAS f16x4*)(prm + PRM_RK + cb), pv0 = *(const LAS f16x4*)(prm + PRM_V0 + cb); \
            const f32x4 pw0 = *(const LAS f32x4*)(prw0 + cb); \
            f32x4 g2v, Giv, G8v, G16v; \
            _Pragma("unroll") for (int i = 0; i < 4; ++i) { g2v[i] = -0.875036877f * sigmoidf_(pw0[i] + DWn[i]);      \
                Giv[i] = row_prefix16(g2v[i]); } \
            _Pragma("unroll") for (int i = 0; i < 4; ++i) { G8v[i] = bperm_f(bp7, Giv[i]); G16v[i] = bperm_f(bp15, Giv[i]); }       \
            _Pragma("unroll") for (int i = 0; i < 4; ++i) { \
                const float cr_ = (float)X##cr[i], ck_ = (float)X##ck[i], cv_ = (float)X##cv[i]; \
                const float rs = cr_ + (float)pmr[i] * ((hp ? (float)X##pr[i] : 0.f) - cr_), ks = ck_ + (float)pmk[i] * ((hp ? (float)X##pk[i] : 0.f) - ck_), vs = cv_ + (float)pmv[i] * ((hp ? (float)X##pv[i] : 0.f) - cv_); \
                const float aa = sigmoidf_((float)pa0[i] + DAn[i]); \
                float vv = vs; if (l > 0) vv = vs + ((float)X##vf[i] - vs) * sigmoidf_((float)pv0[i] + Gn[i]); \
                const float kk = ks * (float)pkk[i]; ssq += kk * kk; \
                const float kmod = ks * (1.0f + (aa - 1.0f) * (float)pka[i]); \
                bon += rs * kmod * (float)prk[i]; \
                const float bq = kk * aa; \
                const float g2 = g2v[i], Gi = Giv[i], G8 = G8v[i], G16 = G16v[i]; \
                const float e1 = __builtin_amdgcn_exp2f(Gi - G8), e1m = __builtin_amdgcn_exp2f((Gi - g2) - G8), einv = __builtin_amdgcn_exp2f(G8 - Gi), e168 = __builtin_amdgcn_exp2f(G16 - G8), esuf = e168 * einv; \
                rho4[i] = __builtin_amdgcn_exp2f(G8); g164[i] = rho4[i] * e168; \
                ah[i] = (f16)(-kk * e1m); rh[i] = (f16)(rs * e1); bh[i] = (f16)(bq * einv); kh[i] = (f16)(kmod * einv); bb[i] = (f16)(bq * esuf); kb[i] = (f16)(kmod * esuf); vo[i] = (f16)vv; } \
            *(LAS f16x4*)(wl + RWT_A + tok * RWT_ROW + co * 2) = ah; *(LAS f16x4*)(wl + RWT_R + tok * RWT_ROW + co * 2) = rh; \
            *(LAS f16x4*)(wl + RWT_B + tok * RWT_ROW + co * 2) = bh; *(LAS f16x4*)(wl + RWT_K + tok * RWT_ROW + co * 2) = kh; \
            _Pragma("unroll") for (int i = 0; i < 4; ++i) { *(LAS f16*)(wl + RWC_B + (co + i) * 32 + tok * 2) = bb[i]; *(LAS f16*)(wl + RWC_K + (co + i) * 32 + tok * 2) = kb[i]; *(LAS f16*)(wl + RWC_V + (co + i) * 32 + tok * 2) = vo[i]; } \
            if (tok == 0) { *(LAS f32x4*)(wl + RWF_RHO + co * 4) = rho4; *(LAS f32x4*)(wl + RWF_G16 + co * 4) = g164; } \
            *(f16x4*)(VP + (m * (unsigned)RW_W + (unsigned)cb) * 2u) = vo; \
            if (l == 0) *(f16x4*)(VF + (m * (unsigned)RW_W + (unsigned)cb) * 2u) = vo; }
#pragma unroll 1
        for (int nt = 0; nt < 4; ++nt) { const int nn = (nt + 1) & 3;
            RW_WLOAD(nt) asm volatile("" ::: "memory"); RW_ALOAD(T1, nn) asm volatile("" ::: "memory"); RW_TMFMA() asm volatile("" ::: "memory"); RW_TCOMP(T0, nt) asm volatile("" ::: "memory");
            T0cr = T1cr; T0pr = T1pr; T0ck = T1ck; T0pk = T1pk; T0cv = T1cv; T0pv = T1pv; T0vf = T1vf; }
#undef RW_WLOAD
#undef RW_ALOAD
#undef RW_ADECL
#undef RW_TMFMA
#undef RW_TCOMP
        ssq += shfl_xor_f(ssq, 16); ssq += shfl_xor_f(ssq, 32);
        bon += shfl_xor_f(bon, 16); bon += shfl_xor_f(bon, 32);
        { const float inv2v = __builtin_amdgcn_rcpf(fmaxf(ssq, 1e-24f));
          if (fq == 0) { *(LAS float*)(wl + RWA_INV + tok * 4) = inv2v; *(float*)((char*)BONG + (m * 8u + (unsigned)h) * 4u) = bon; } }
        const unsigned mb = (unsigned)(b * SEQ + c * CH + blk * 16);
        const int q4 = fq * 4;
        f16x4 N1, N1T, MkH, NbH, NkH;
        { f16x8 fa[2], fr[2], fb[2], fk[2];
#pragma unroll
          for (int s = 0; s < 2; ++s) { const int o = tok * RWT_ROW + (32 * s + q4) * 2;
#define RW_FRAG(F, T) { const f16x4 lo_ = *(const LAS f16x4*)(wl + (T) + o), hi_ = *(const LAS f16x4*)(wl + (T) + o + 32); F[s] = (f16x8){lo_[0], lo_[1], lo_[2], lo_[3], hi_[0], hi_[1], hi_[2], hi_[3]}; }
              RW_FRAG(fa, RWT_A) RW_FRAG(fr, RWT_R) RW_FRAG(fb, RWT_B) RW_FRAG(fk, RWT_K)
#undef RW_FRAG
          }
          const f32x4 z4 = (f32x4){0.f, 0.f, 0.f, 0.f};
          f32x4 Mb = MF32(fb[1], fa[1], MF32(fb[0], fa[0], z4)), MbT = MF32(fa[1], fb[1], MF32(fa[0], fb[0], z4));
          f32x4 Mk = MF32(fk[1], fa[1], MF32(fk[0], fa[0], z4)), Nb = MF32(fb[1], fr[1], MF32(fb[0], fr[0], z4)), Nk = MF32(fk[1], fr[1], MF32(fk[0], fr[0], z4));
          const f32x4 ivr = *(const LAS f32x4*)(wl + RWA_INV + q4 * 4); const float ivc = *(const LAS float*)(wl + RWA_INV + tok * 4);
#pragma unroll
          for (int r = 0; r < 4; ++r) { const int j = q4 + r;
              Mb[r] = (j < tok) ? Mb[r] * ivr[r] : 0.f; MbT[r] = (tok < j) ? MbT[r] * ivc : 0.f; Mk[r] = (j < tok) ? Mk[r] : 0.f; Nb[r] = (j <= tok) ? Nb[r] : 0.f; Nk[r] = (j <= tok) ? Nk[r] : 0.f; }
          N1 = cvt4(Mb); N1T = cvt4(MbT); MkH = cvt4(Mk); NbH = cvt4(Nb); NkH = cvt4(Nk); }
        const f16x4 N2 = cvt4(MF16(N1T, N1, ((f32x4){0.f, 0.f, 0.f, 0.f}))), N2T = cvt4(MF16(N1, N1T, ((f32x4){0.f, 0.f, 0.f, 0.f})));
        const f16x4 N4 = cvt4(MF16(N2T, N2, ((f32x4){0.f, 0.f, 0.f, 0.f}))), N4T = cvt4(MF16(N2, N2T, ((f32x4){0.f, 0.f, 0.f, 0.f})));
        const f16x4 N8 = cvt4(MF16(N4T, N4, ((f32x4){0.f, 0.f, 0.f, 0.f})));
        { LAS unsigned char* np = wl + RWA_NMAT + lane_ * 8; *(LAS f16x4*)(np) = N2; *(LAS f16x4*)(np + 512) = N4; *(LAS f16x4*)(np + 1024) = N8; *(LAS f16x4*)(np + 1536) = MkH; *(LAS f16x4*)(np + 2048) = NkH; }
#pragma unroll
        for (int hq = 0; hq < 4; ++hq) {
            constexpr int NTQ = 2; const int hv = hq >> 1;
            asm volatile("" ::: "memory");
            const f32x4 ivr2 = *(const LAS f32x4*)(wl + RWA_INV + q4 * 4);
            f32x4 G[NTQ], Y[NTQ]; f16x4 vf[NTQ];
            { f16x8 fa[2], fr[2];
#pragma unroll
              for (int s = 0; s < 2; ++s) { const int o = tok * RWT_ROW + (32 * s + q4) * 2;
#define RW_FRAG(F, T) { const f16x4 lo_ = *(const LAS f16x4*)(wl + (T) + o), hi_ = *(const LAS f16x4*)(wl + (T) + o + 32); F[s] = (f16x8){lo_[0], lo_[1], lo_[2], lo_[3], hi_[0], hi_[1], hi_[2], hi_[3]}; }
                  RW_FRAG(fa, RWT_A) RW_FRAG(fr, RWT_R)
#undef RW_FRAG
              }
#pragma unroll
              for (int t = 0; t < NTQ; ++t) { const int vt = 2 * hq + t; f16x8 xb[2];
#pragma unroll
                for (int s = 0; s < 2; ++s) { const f32x4 r0 = *(const LAS f32x4*)(wl + RWF_RHO + (32 * s + q4) * 4), r1 = *(const LAS f32x4*)(wl + RWF_RHO + (32 * s + 16 + q4) * 4);
                    const f32x4 x0 = (XPK(2 * s, vt) ? XPA(2 * s) : XT[2 * s][vt]) * r0, x1 = (XPK(2 * s + 1, vt) ? XPA(2 * s + 1) : XT[2 * s + 1][vt]) * r1;
                    xb[s] = (f16x8){(f16)x0[0], (f16)x0[1], (f16)x0[2], (f16)x0[3], (f16)x1[0], (f16)x1[1], (f16)x1[2], (f16)x1[3]}; }
                G[t] = MF32(fa[1], xb[1], MF32(fa[0], xb[0], ((f32x4){0.f, 0.f, 0.f, 0.f})));
                Y[t] = MF32(fr[1], xb[1], MF32(fr[0], xb[0], ((f32x4){0.f, 0.f, 0.f, 0.f})));
                if (hv) { vf[t] = *(const LAS f16x4*)(wl + RWC_V + (16 * (vt - 4) + tok) * 32 + q4 * 2); G[t] = MF16(*(const LAS f16x4*)(wl + RWA_NMAT + 1536 + lane_ * 8), vf[t], G[t]); } } }
#pragma unroll
            for (int t = 0; t < NTQ; ++t) G[t] = MF16(N1, cvt4(G[t]), G[t]);
            { const f16x4 Z = *(const LAS f16x4*)(wl + RWA_NMAT + lane_ * 8);
#pragma unroll
            for (int t = 0; t < NTQ; ++t) G[t] = MF16(Z, cvt4(G[t]), G[t]); }
            { const f16x4 Z = *(const LAS f16x4*)(wl + RWA_NMAT + 512 + lane_ * 8);
#pragma unroll
            for (int t = 0; t < NTQ; ++t) G[t] = MF16(Z, cvt4(G[t]), G[t]); }
            { const f16x4 Z = *(const LAS f16x4*)(wl + RWA_NMAT + 1024 + lane_ * 8);
#pragma unroll
            for (int t = 0; t < NTQ; ++t) G[t] = MF16(Z, cvt4(G[t]), G[t]); }
#pragma unroll
            for (int t = 0; t < NTQ; ++t) { const int vt = 2 * hq + t; const int tc = vt & 3;
                const f16x4 uh = cvt4(G[t] * ivr2);
                Y[t] = MF16(NbH, uh, Y[t]); if (hv) Y[t] = MF16(*(const LAS f16x4*)(wl + RWA_NMAT + 2048 + lane_ * 8), vf[t], Y[t]);
                char* yo = hv ? (char*)MIX + ((mb + (unsigned)q4) * (unsigned)DM + (unsigned)(h * 64 + 16 * tc + tok)) * 2u : (char*)QT + ((mb + (unsigned)q4) * (unsigned)RW_W + (unsigned)(h * 64 + 16 * tc + tok)) * 2u;
#pragma unroll
                for (int r = 0; r < 4; ++r) *(f16*)(yo + (unsigned)r * (hv ? (unsigned)(DM * 2) : (unsigned)(RW_W * 2))) = (f16)Y[t][r];
#pragma unroll
                for (int ct = 0; ct < 4; ++ct) { const f32x4 g16 = *(const LAS f32x4*)(wl + RWF_G16 + (16 * ct + q4) * 4);
                    const f16x4 bt = *(const LAS f16x4*)(wl + RWC_B + (16 * ct + tok) * 32 + q4 * 2);
                    f32x4 xn = MF16(bt, uh, (XPK(ct, vt) ? XPA(ct) : XT[ct][vt]) * g16);
                    if (hv) { const f16x4 kt = *(const LAS f16x4*)(wl + RWC_K + (16 * ct + tok) * 32 + q4 * 2); xn = MF16(kt, vf[t], xn); }
                    if (XPK(ct, vt)) XPA(ct) = xn; else XT[ct][vt] = xn; } }
        }
        asm volatile("" ::: "memory");
    }
    { const int lane2 = lane_now(); const int n2 = lane2 & 15, q2 = (lane2 >> 4) * 4;
      f16* rl = RL + ((size_t)bh * NCH + c) * 4096;
      f16* pt = PT + ((size_t)bh * NCH + c) * 4096;
#pragma unroll
      for (int ct = 0; ct < 4; ++ct)
#pragma unroll
          for (int t = 0; t < 4; ++t) { *(f16x4*)(rl + (16 * t + n2) * 64 + 16 * ct + q2) = cvt4(XPK(ct, 4 + t) ? XPA(ct) : XT[ct][4 + t]);
#pragma unroll
              for (int r = 0; r < 4; ++r) pt[(16 * ct + q2 + r) * 64 + 16 * t + n2] = (f16)XT[ct][t][r]; } }
}

constexpr int HGA_REC = 768, HGA_TB = 8  , HGA_V = HGA_TB * HGA_REC, HGA_HEAD = HGA_V + HGA_TB * 128, HGA_BYTES = 2 * HGA_HEAD;
template <int NH>
__device__ __forceinline__ void hgrn_waveA(const Args& a, int l, int b, int c, int h0, LAS unsigned char* wl) {
    char* U = (char*)(a.ws + WS_U); char* MIX = (char*)(a.ws + WS_MIX); f16* HL = (f16*)(a.ws + WS_HL); float* DC = (float*)(a.ws + WS_DC);
    const float* lbr = a.in[16];
    float S[NH][64]; float dpr[NH];
#pragma unroll
    for (int j = 0; j < NH; ++j) { dpr[j] = 1.f;
#pragma unroll
        for (int k = 0; k < 64; ++k) S[j][k] = 0.f; }
#pragma unroll 1
    for (int blk = 0; blk < CH / HGA_TB; ++blk) {
        const int lane_ = lane_now();
        const unsigned mb = (unsigned)(b * SEQ + c * CH + blk * HGA_TB);
        {
            f16 fr[NH][HGA_TB], qr[NH][HGA_TB], vr[NH][HGA_TB];
#pragma unroll
            for (int j = 0; j < NH; ++j)
#pragma unroll
                for (int tk = 0; tk < HGA_TB; ++tk) { const char* ur = U + (mb + tk) * (unsigned)(NU * 2) + (unsigned)((h0 + j) * 64 + lane_) * 2u; fr[j][tk] = *(const f16*)(ur + C_HGF * 2); qr[j][tk] = *(const f16*)(ur + C_HGQ * 2); vr[j][tk] = *(const f16*)(ur + C_HGI * 2); }
#pragma unroll
            for (int j = 0; j < NH; ++j) { const int col = (h0 + j) * 64 + lane_;
                const float lb = (l == 0) ? 0.f : sigmoidf_(lbr[384 + col] - lbr[col]);
                float dp = dpr[j];
#pragma unroll
                for (int tk = 0; tk < HGA_TB; ++tk) {
                    const float f = lb + (1.0f - lb) * sigmoidf_((float)fr[j][tk]);
                    LAS unsigned char* rec = wl + j * HGA_HEAD + tk * HGA_REC;
                    *(LAS float*)(rec + lane_ * 4) = f; *(LAS float*)(rec + 256 + lane_ * 4) = 1.0f - f; *(LAS float*)(rec + 512 + lane_ * 4) = (float)qr[j][tk];
                    *(LAS f16*)(wl + j * HGA_HEAD + HGA_V + tk * 128 + lane_ * 2) = vr[j][tk];
                    dp *= f;
                    *(f16*)(U + (mb + tk) * (unsigned)(NU * 2) + (unsigned)(C_HGQ + col) * 2u) = (f16)((float)qr[j][tk] * dp);
                }
                dpr[j] = dp; }
        }
        asm volatile("s_waitcnt lgkmcnt(0)" ::: "memory");
#define HG_LD(F, K, Q, rcp, g) { F[0] = *(const LAS f32x4*)((rcp) + (g) * 32); F[1] = *(const LAS f32x4*)((rcp) + (g) * 32 + 16); K[0] = *(const LAS f32x4*)((rcp) + 256 + (g) * 32); K[1] = *(const LAS f32x4*)((rcp) + 256 + (g) * 32 + 16); \
            Q[0] = *(const LAS f32x4*)((rcp) + 512 + (g) * 32); Q[1] = *(const LAS f32x4*)((rcp) + 512 + (g) * 32 + 16); asm volatile("" ::: "memory"); }
#define HG_COMP(Sx, vi, F, K, Q, g) { float tt[8]; \
            _Pragma("unroll") for (int jj = 0; jj < 8; ++jj) tt[jj] = mul_asm(vi, K[jj >> 2][jj & 3]); \
            _Pragma("unroll") for (int jj = 0; jj < 8; ++jj) Sx[8 * (g) + jj] = fma_asm(Sx[8 * (g) + jj], F[jj >> 2][jj & 3], tt[jj]); \
            _Pragma("unroll") for (int jj = 0; jj < 8; ++jj) oa[jj] = fma_asm(Sx[8 * (g) + jj], Q[jj >> 2][jj & 3], oa[jj]); }
#define HG_HEAD(Sx, vi, rcp, rcn, oo) { float oa[8]; _Pragma("unroll") for (int jj = 0; jj < 8; ++jj) oa[jj] = 0.f; \
            HG_LD(fo, ko, qo, rcp, 1) HG_COMP(Sx, vi, fe, ke, qe, 0) \
            HG_LD(fe, ke, qe, rcp, 2) HG_COMP(Sx, vi, fo, ko, qo, 1) \
            HG_LD(fo, ko, qo, rcp, 3) HG_COMP(Sx, vi, fe, ke, qe, 2) \
            HG_LD(fe, ke, qe, rcp, 4) HG_COMP(Sx, vi, fo, ko, qo, 3) \
            HG_LD(fo, ko, qo, rcp, 5) HG_COMP(Sx, vi, fe, ke, qe, 4) \
            HG_LD(fe, ke, qe, rcp, 6) HG_COMP(Sx, vi, fo, ko, qo, 5) \
            HG_LD(fo, ko, qo, rcp, 7) HG_COMP(Sx, vi, fe, ke, qe, 6) \
            HG_LD(fe, ke, qe, rcn, 0) HG_COMP(Sx, vi, fo, ko, qo, 7) \
            oo = ((oa[0] + oa[1]) + (oa[2] + oa[3])) + ((oa[4] + oa[5]) + (oa[6] + oa[7])); }
        f32x4 fe[2], ke[2], qe[2], fo[2], ko[2], qo[2];
        HG_LD(fe, ke, qe, wl, 0)
        f16 vh[NH], vn[NH];
#pragma unroll
        for (int j = 0; j < NH; ++j) vh[j] = *(const LAS f16*)(wl + j * HGA_HEAD + HGA_V + lane_ * 2);
#pragma unroll 1
        for (int t2 = 0; t2 < HGA_TB; ++t2) {
            const LAS unsigned char* rc = wl + t2 * HGA_REC;
#pragma unroll
            for (int j = 0; j < NH; ++j) vn[j] = *(const LAS f16*)(wl + j * HGA_HEAD + HGA_V + ((t2 + 1) & (HGA_TB - 1)) * 128 + lane_ * 2);
            float oo[NH];
#pragma unroll
            for (int j = 0; j < NH; ++j) { const float vi = (float)vh[j];
                const LAS unsigned char* rcp = rc + j * HGA_HEAD; const LAS unsigned char* rcn = (j + 1 < NH) ? rc + (j + 1) * HGA_HEAD : rc + HGA_REC;
                HG_HEAD(S[j], vi, rcp, rcn, oo[j]) }
            char* mo = MIX + ((mb + t2) * (unsigned)DM + (unsigned)(384 + h0 * 64 + lane_)) * 2u;
#pragma unroll
            for (int j = 0; j < NH; ++j) { *(f16*)(mo + 128 * j) = (f16)oo[j]; vh[j] = vn[j]; }
        }
#undef HG_LD
#undef HG_COMP
#undef HG_HEAD
    }
    const int lane2 = lane_now();
#pragma unroll
    for (int j = 0; j < NH; ++j) { const int bh = b * 6 + h0 + j; store_row64_f16(HL + (((size_t)bh * NCH + c) * 64 + lane2) * 64, S[j]);
        DC[((size_t)bh * NCH + c) * 64 + lane2] = dpr[j]; }
}

__device__ __forceinline__ void lru_waveA(const Args& a, int l, int b, int c, int g, LAS unsigned char* wl) {
    const int ln = lane_now();
    const char* Ub = (const char*)(a.ws + WS_U); char* MIXb = (char*)(a.ws + WS_MIX); char* CA = (char*)(a.ws + WS_CA); float* LA = (float*)(a.ws + WS_LA); float* LH = (float*)(a.ws + WS_LH);
    const float* cw = a.in[18] + l * 4 * 256 + g * 64; const float* cb = a.in[19] + l * 256 + g * 64;
    const float* ba = a.in[21] + l * 256 + g * 64; const float* bx = a.in[23] + l * 256 + g * 64; const float* lam = a.in[24] + l * 256 + g * 64;
    const char* WAT = (const char*)(a.ws + WS_WAT) + (size_t)(l * 4 + g) * 8192; const char* WXT = (const char*)(a.ws + WS_WXT) + (size_t)(l * 4 + g) * 8192;
    LAS unsigned char* Y = wl;
    const unsigned mrow0 = (unsigned)(b * SEQ + c * CH);
#pragma unroll 1
    for (int ib = 0; ib < 8; ib += 4) {
        f16x8 xr[4][4];
#pragma unroll
        for (int it = 0; it < 4; ++it) { const int item = ln + 64 * (ib + it), tok = item >> 3, co = item & 7; const int t = c * CH + tok;
#pragma unroll
            for (int jj = 0; jj < 4; ++jj) { const int ts = t - 3 + jj; const unsigned row = (ts >= 0) ? mrow0 + (unsigned)(tok - 3 + jj) : mrow0 + (unsigned)tok;
                xr[it][jj] = *(const f16x8*)(Ub + (row * (unsigned)NU + (unsigned)(C_LRUX + g * 64 + 8 * co)) * 2u); } }
#pragma unroll
        for (int it = 0; it < 4; ++it) { const int item = ln + 64 * (ib + it), tok = item >> 3, co = item & 7; const int t = c * CH + tok;
            const f32x4 b0 = *(const f32x4*)(cb + 8 * co), b1 = *(const f32x4*)(cb + 8 * co + 4);
            float y[8] = {b0[0], b0[1], b0[2], b0[3], b1[0], b1[1], b1[2], b1[3]};
#pragma unroll
            for (int jj = 0; jj < 4; ++jj) { const int ts = t - 3 + jj;
                if (ts >= 0) { const f32x4 w0 = *(const f32x4*)(cw + jj * 256 + 8 * co), w1 = *(const f32x4*)(cw + jj * 256 + 8 * co + 4);
#pragma unroll
                    for (int i = 0; i < 8; ++i) y[i] += (i < 4 ? w0[i & 3] : w1[i & 3]) * (float)xr[it][jj][i]; } }
            *(LAS f16x8*)(Y + tok * 144 + co * 16) = pack8(y); } }
    asm volatile("s_waitcnt lgkmcnt(0)" ::: "memory");
    const int tl = ln & 15, fq = ln >> 4;
    float sp[16], cy[16], cp[16];
#pragma unroll
    for (int nt = 0; nt < 4; ++nt) { const f32x4 lm4 = *(const f32x4*)(lam + 16 * nt + 4 * fq);
#pragma unroll
        for (int i = 0; i < 4; ++i) { sp[nt * 4 + i] = log1pf(__expf(-lm4[i])); cy[nt * 4 + i] = 0.f; cp[nt * 4 + i] = 1.f; } }
    f16x8 wfa[4][2], wfx[4][2];
#pragma unroll
    for (int nt = 0; nt < 4; ++nt)
#pragma unroll
        for (int s2 = 0; s2 < 2; ++s2) { const unsigned wo = (unsigned)(((16 * nt + (ln & 15)) * 64 + 8 * (ln >> 4) + 32 * s2) * 2); wfa[nt][s2] = *(const f16x8*)(WAT + wo); wfx[nt][s2] = *(const f16x8*)(WXT + wo); }
#pragma unroll 1
    for (int tt = 0; tt < 4; ++tt) {
        f16x8 by[2];
#pragma unroll
        for (int s2 = 0; s2 < 2; ++s2) by[s2] = *(const LAS f16x8*)(Y + (16 * tt + tl) * 144 + (8 * fq + 32 * s2) * 2);
        const unsigned m = mrow0 + (unsigned)(16 * tt + tl);
#pragma unroll
        for (int nt = 0; nt < 4; ++nt) {
            f32x4 ra = (f32x4){0.f, 0.f, 0.f, 0.f}, rx = ra;
#pragma unroll
            for (int s2 = 0; s2 < 2; ++s2) { ra = __builtin_amdgcn_mfma_f32_16x16x32_f16(wfa[nt][s2], by[s2], ra, 0, 0, 0); rx = __builtin_amdgcn_mfma_f32_16x16x32_f16(wfx[nt][s2], by[s2], rx, 0, 0, 0); }
            const int ch0 = 16 * nt + 4 * fq;
            const f32x4 ba4 = *(const f32x4*)(ba + ch0), bx4 = *(const f32x4*)(bx + ch0);
            const f16x4 y4 = *(const LAS f16x4*)(Y + (16 * tt + tl) * 144 + ch0 * 2);
            f16x4 ho, co;
#pragma unroll
            for (int i = 0; i < 4; ++i) { const int q = nt * 4 + i;
                const float r = sigmoidf_(ra[i] + ba4[i]), ig = sigmoidf_(rx[i] + bx4[i]);
                const float la = -8.0f * r * sp[q];
                float av = __expf(la), uv = sqrtf(one_minus_exp_(2.0f * la)) * (ig * (float)y4[i]);
#define LRU_SCAN(d) { const float ap = __builtin_bit_cast(float, __builtin_amdgcn_update_dpp(0x3f800000, __builtin_bit_cast(int, av), 0x110 + (d), 0xf, 0xf, false)); \
                      const float up = __builtin_bit_cast(float, __builtin_amdgcn_update_dpp(0, __builtin_bit_cast(int, uv), 0x110 + (d), 0xf, 0xf, false)); \
                      uv = av * up + uv; av = av * ap; }
                LRU_SCAN(1) LRU_SCAN(2) LRU_SCAN(4) LRU_SCAN(8)
#undef LRU_SCAN
                const float hl = uv + av * cy[q], ca = av * cp[q];
                ho[i] = (f16)hl; co[i] = (f16)ca;
                cy[q] = __builtin_bit_cast(float, __builtin_amdgcn_ds_bpermute((ln | 15) << 2, __builtin_bit_cast(int, hl)));
                cp[q] = __builtin_bit_cast(float, __builtin_amdgcn_ds_bpermute((ln | 15) << 2, __builtin_bit_cast(int, ca)));
            }
            *(f16x4*)(MIXb + (m * (unsigned)DM + 768u + (unsigned)(g * 64 + ch0)) * 2u) = ho; *(f16x4*)(CA + (m * 256u + (unsigned)(g * 64 + ch0)) * 2u) = co;
        }
    }
    if (tl == 15) {
#pragma unroll
        for (int q = 0; q < 16; ++q) { const int ch = g * 64 + 16 * (q >> 2) + 4 * fq + (q & 3); LA[((size_t)b * NCH + c) * 256 + ch] = cp[q]; LH[((size_t)b * NCH + c) * 256 + ch] = cy[q]; } }
}

__device__ __forceinline__ void phaseA(const Args& a, int l, int task, LAS unsigned char* lds, int tid) {
    asm volatile("" : "+v"(tid));
    const int lane = tid & 63, wave = __builtin_amdgcn_readfirstlane(tid >> 6);
    const int b = task / NCH, c = task % NCH;
    const f16* U = (const f16*)(a.ws + WS_U); f16* MIX = (f16*)(a.ws + WS_MIX); f16* VF = (f16*)(a.ws + WS_VF); f16* VP = (f16*)(a.ws + WS_VP);
    f16* QT = (f16*)(a.ws + WS_QT); f16* PT = (f16*)(a.ws + WS_PT); f16* RL = (f16*)(a.ws + WS_RL); float* BONG = (float*)(a.ws + WS_BON);
    {
        LAS f16* prm = (LAS f16*)(lds + PRM_OFF); LAS float* prw0 = (LAS float*)(lds + PRM_OFF + PRM_W0_BYTE);
        for (int i = tid; i < PRM_HALVES + 384; i += NT) {
            if (i < 1280) prm[i] = (f16)a.in[3][l * RW_SHIFT + i];
            else if (i < PRM_HALVES) { const int q = (i - 1280) / 384, cc = (i - 1280) % 384;
                prm[i] = (f16)((q == 0) ? a.in[6][l * RW_W + cc] : (q == 1) ? a.in[11][l * RW_W + cc] : (q == 2) ? a.in[12][l * RW_W + cc] : (q == 3) ? a.in[13][l * RW_W + cc] : a.in[8][cc]); }
            else prw0[i - PRM_HALVES] = a.in[4][l * RW_W + (i - PRM_HALVES)]; }
        __syncthreads();
        if (wave < 4) { rwkv_waveA(a, l, b, c, wave, lds + wave * RWA_BYTES, lds + PRM_OFF, lane);
                        hgrn_waveA<1>(a, l, b, c, wave, lds + wave * RWA_BYTES); }
        else if (wave < RW_H) { hgrn_waveA<1>(a, l, b, c, wave, lds + wave * RWA_BYTES);
                                rwkv_waveA(a, l, b, c, wave, lds + wave * RWA_BYTES, lds + PRM_OFF, lane_now()); }
        else { LAS unsigned char* hw = lds + RW_H * RWA_BYTES + (wave - RW_H) * HGA_BYTES;
               lru_waveA(a, l, b, c, 2 * (wave - RW_H), hw); lru_waveA(a, l, b, c, 2 * (wave - RW_H) + 1, hw); }
        __syncthreads();
    }
}

constexpr int PB_SLOT = 16384, PB_NS = 8, PB_AHEAD = 6, NGRP = NCH / 8;
#define ARENA(ws, off) ((char*)(ws) + WS_U + (size_t)((off) >> 11) * (size_t)(NU * 2) + (size_t)((off) & 2047))
constexpr size_t AR_PGT = 0, AR_LG = 2u << 20, AR_SG = 4u << 20;
#define PB_SWZ(row, o) ((row) * 128 + (((((o) >> 4) ^ ((row) & 7)) << 4) | ((o) & 15)))
template <bool ADD_L>
__device__ __forceinline__ void pb_step(f32x4 (&Sacc)[4], const LAS unsigned char* sl, int xrow, int vl, int fq) {
    f16x8 Bhi[2], Blo[2];
#pragma unroll
    for (int mt = 0; mt < 4; ++mt)
#pragma unroll
        for (int i = 0; i < 4; ++i) { const f16 hi = (f16)Sacc[mt][i]; const f16 lo = (f16)(Sacc[mt][i] - (float)hi); Bhi[mt >> 1][4 * (mt & 1) + i] = hi; Blo[mt >> 1][4 * (mt & 1) + i] = lo; }
#pragma unroll
    for (int mt = 0; mt < 4; ++mt) {
        f32x4 d = (f32x4){0.f, 0.f, 0.f, 0.f};
        if (ADD_L) { const f16x4 l4 = *(const LAS f16x4*)(sl + 8192 + PB_SWZ(xrow, 32 * mt + 8 * fq)); d = (f32x4){(float)l4[0], (float)l4[1], (float)l4[2], (float)l4[3]}; }
#pragma unroll
        for (int s = 0; s < 2; ++s) { const u32x2 a0 = *(const LAS u32x2*)(sl + PB_SWZ(16 * mt + vl, 64 * s + 8 * fq)), a1 = *(const LAS u32x2*)(sl + PB_SWZ(16 * mt + vl, 64 * s + 32 + 8 * fq));
            u32x4 aw; aw.x = a0.x; aw.y = a0.y; aw.z = a1.x; aw.w = a1.y; const f16x8 af = __builtin_bit_cast(f16x8, aw);
            d = __builtin_amdgcn_mfma_f32_16x16x32_f16(af, Bhi[s], d, 0, 0, 0); d = __builtin_amdgcn_mfma_f32_16x16x32_f16(af, Blo[s], d, 0, 0, 0); }
        Sacc[mt] = d; }
}
__device__ __forceinline__ void pb_stage8(const Args& a, LAS unsigned char* lds, int bh, int c0, int wave, int lane) {
    const char* PT = (const char*)(a.ws + WS_PT) + ((size_t)bh * NCH + c0) * 8192; const char* RL = (const char*)(a.ws + WS_RL) + ((size_t)bh * NCH + c0) * 8192;
    const int lq = wave * 64 + lane, lrow = lq >> 3, lpp = lq & 7; const unsigned lsrc = (unsigned)(lrow * 128 + ((lpp ^ (lrow & 7)) << 4));
#pragma unroll
    for (int sl = 0; sl < 8; ++sl) { const unsigned so = (unsigned)(sl * PB_SLOT + wave * 1024); const size_t go = (size_t)sl * 8192 + lsrc;
        __builtin_amdgcn_global_load_lds((const unsigned*)(PT + go), (LAS unsigned*)(lds + so), 16, 0, 0);
        __builtin_amdgcn_global_load_lds((const unsigned*)(RL + go), (LAS unsigned*)(lds + so + 8192), 16, 0, 0); }
    asm volatile("s_waitcnt vmcnt(0)" ::: "memory");
    __builtin_amdgcn_s_barrier();
}
__device__ __forceinline__ void phaseB1(const Args& a, LAS unsigned char* lds, int tid) {
    asm volatile("" : "+v"(tid));
    const int lane = tid & 63, wave = __builtin_amdgcn_readfirstlane(tid >> 6);
    for (int task = blockIdx.x; task < 12 * NGRP; task += gridDim.x) {
        const int bh = task / NGRP, g = task % NGRP, c0 = 8 * g;
        pb_stage8(a, lds, bh, c0, wave, lane);
        const int vt = wave & 3, vl = lane & 15, fq = lane >> 4, xr = 16 * vt + vl;
        f32x4 X[4];
        if (wave < 4) {
#pragma unroll
            for (int mt = 0; mt < 4; ++mt) { const f16x4 l4 = *(const LAS f16x4*)(lds + 8192 + PB_SWZ(xr, 32 * mt + 8 * fq)); X[mt] = (f32x4){(float)l4[0], (float)l4[1], (float)l4[2], (float)l4[3]}; }
#pragma unroll 1
            for (int s = 1; s < 8; ++s) pb_step<true>(X, lds + s * PB_SLOT, xr, vl, fq);
#pragma unroll
            for (int mt = 0; mt < 4; ++mt) { f16x4 o;
#pragma unroll
                for (int i = 0; i < 4; ++i) o[i] = (f16)X[mt][i];
                *(f16x4*)ARENA(a.ws, AR_LG + ((size_t)bh * NGRP + g) * 8192 + (size_t)((xr * 64 + 16 * mt + 4 * fq) * 2)) = o; }
        } else {
#pragma unroll
            for (int mt = 0; mt < 4; ++mt)
#pragma unroll
                for (int i = 0; i < 4; ++i) X[mt][i] = (16 * mt + 4 * fq + i == xr) ? 1.f : 0.f;
#pragma unroll 1
            for (int s = 0; s < 8; ++s) pb_step<false>(X, lds + s * PB_SLOT, xr, vl, fq);
#pragma unroll
            for (int mt = 0; mt < 4; ++mt)
#pragma unroll
                for (int i = 0; i < 4; ++i) *(f16*)ARENA(a.ws, AR_PGT + ((size_t)bh * NGRP + g) * 8192 + (size_t)(((16 * mt + 4 * fq + i) * 64 + xr) * 2)) = (f16)X[mt][i];
        }
        asm volatile("s_waitcnt vmcnt(0) lgkmcnt(0)" ::: "memory");
        __builtin_amdgcn_s_barrier();
    }
}
__device__ __forceinline__ void phaseB3(const Args& a, LAS unsigned char* lds, int tid) {
    asm volatile("" : "+v"(tid));
    const int lane = tid & 63, wave = __builtin_amdgcn_readfirstlane(tid >> 6);
    for (int task = blockIdx.x; task < 12 * NGRP; task += gridDim.x) {
        const int bh = task / NGRP, g = task % NGRP, c0 = 8 * g;
        pb_stage8(a, lds, bh, c0, wave, lane);
        if (wave < 4) {
            const int vt = wave, vl = lane & 15, fq = lane >> 4, xr = 16 * vt + vl;
            char* RL = (char*)(a.ws + WS_RL) + ((size_t)bh * NCH + c0) * 8192;
            f32x4 X[4];
#pragma unroll
            for (int mt = 0; mt < 4; ++mt) { const f16x4 s4 = *(const f16x4*)ARENA(a.ws, AR_SG + ((size_t)bh * NGRP + g) * 8192 + (size_t)((xr * 64 + 16 * mt + 4 * fq) * 2)); X[mt] = (f32x4){(float)s4[0], (float)s4[1], (float)s4[2], (float)s4[3]}; }
#pragma unroll 1
            for (int s = 0; s < 8; ++s) {
#pragma unroll
                for (int mt = 0; mt < 4; ++mt) { f16x4 o;
#pragma unroll
                    for (int i = 0; i < 4; ++i) o[i] = (f16)X[mt][i];
                    *(f16x4*)(RL + (size_t)s * 8192 + (xr * 64 + 16 * mt + 4 * fq) * 2) = o; }
                if (s < 7) pb_step<true>(X, lds + s * PB_SLOT, xr, vl, fq);
            }
        }
        asm volatile("s_waitcnt vmcnt(0) lgkmcnt(0)" ::: "memory");
        __builtin_amdgcn_s_barrier();
    }
}
__device__ __forceinline__ void phaseB(const Args& a, LAS unsigned char* lds, int tid) {
    asm volatile("" : "+v"(tid));
    const int lane = tid & 63, wave = __builtin_amdgcn_readfirstlane(tid >> 6);
    const int bx = blockIdx.x;
    if (bx < 12) {
        const int bh = bx;
        const bool loader = wave >= 4;
        const int vt = wave & 3, vl = lane & 15, fq = lane >> 4, v = 16 * vt + vl;
        const int lq = (wave - 4) * 64 + lane, lrow = lq >> 3, lpp = lq & 7;
        const unsigned lsrc = (unsigned)(lrow * 128 + ((lpp ^ (lrow & 7)) << 4));
#define PB_ISSUE(cc) { const unsigned so = (unsigned)(((cc) & (PB_NS - 1)) * PB_SLOT) + (unsigned)((wave - 4) * 1024); const size_t go = ((size_t)bh * NGRP + (cc)) * 8192 + lsrc; \
            __builtin_amdgcn_global_load_lds((const unsigned*)ARENA(a.ws, AR_PGT + go), (LAS unsigned*)(lds + so), 16, 0, 0); \
            __builtin_amdgcn_global_load_lds((const unsigned*)ARENA(a.ws, AR_PGT + go + 4096), (LAS unsigned*)(lds + so + 4096), 16, 0, 0); \
            __builtin_amdgcn_global_load_lds((const unsigned*)ARENA(a.ws, AR_LG + go), (LAS unsigned*)(lds + so + 8192), 16, 0, 0); \
            __builtin_amdgcn_global_load_lds((const unsigned*)ARENA(a.ws, AR_LG + go + 4096), (LAS unsigned*)(lds + so + 12288), 16, 0, 0); }
        if (loader) {
#pragma unroll
            for (int cc = 0; cc < PB_AHEAD; ++cc) PB_ISSUE(cc)
            asm volatile("s_waitcnt vmcnt(20)" ::: "memory");
        }
        __builtin_amdgcn_s_barrier();
        f32x4 Sacc[4];
#pragma unroll
        for (int mt = 0; mt < 4; ++mt) Sacc[mt] = (f32x4){0.f, 0.f, 0.f, 0.f};
#pragma unroll 1
        for (int c = 0; c < NGRP; ++c) {
            if (loader) {
                if (c + PB_AHEAD < NGRP) { PB_ISSUE(c + PB_AHEAD) asm volatile("s_waitcnt vmcnt(20)" ::: "memory"); }
                else asm volatile("s_waitcnt vmcnt(0)" ::: "memory");
            } else {
#pragma unroll
                for (int mt = 0; mt < 4; ++mt) { f16x4 o;
#pragma unroll
                    for (int i = 0; i < 4; ++i) o[i] = (f16)Sacc[mt][i];
                    *(f16x4*)ARENA(a.ws, AR_SG + ((size_t)bh * NGRP + c) * 8192 + (size_t)((v * 64 + 16 * mt + 4 * fq) * 2)) = o; }
                pb_step<true>(Sacc, lds + (c & (PB_NS - 1)) * PB_SLOT, v, vl, fq);
                asm volatile("s_waitcnt lgkmcnt(0)" ::: "memory");
            }
            __builtin_amdgcn_s_barrier();
        }
#undef PB_ISSUE
        asm volatile("s_waitcnt vmcnt(0)" ::: "memory");
    } else if (bx < 12 + 96) {
        const int idx = (bx - 12) * NT + tid; const int bh = idx >> 12, e = idx & 4095, k = e & 63;
        f16* HL = (f16*)(a.ws + WS_HL); const float* DC = (const float*)(a.ws + WS_DC);
        float s = 0.f;
        for (int c0 = 0; c0 < NCH; c0 += 8) { float Lc[8], d[8];
#pragma unroll
            for (int j = 0; j < 8; ++j) { Lc[j] = (float)HL[((size_t)bh * NCH + c0 + j) * 4096 + e]; d[j] = DC[((size_t)bh * NCH + c0 + j) * 64 + k]; }
#pragma unroll
            for (int j = 0; j < 8; ++j) { HL[((size_t)bh * NCH + c0 + j) * 4096 + e] = (f16)s; s = d[j] * s + Lc[j]; } }
    } else if (bx == 12 + 96) {
        const int bb = tid >> 8, ch = tid & 255; const float* LA = (const float*)(a.ws + WS_LA); float* LH = (float*)(a.ws + WS_LH);
        float cy = 0.f;
        for (int c0 = 0; c0 < NCH; c0 += 8) { float A[8], H[8];
#pragma unroll
            for (int j = 0; j < 8; ++j) { const size_t o = ((size_t)bb * NCH + c0 + j) * 256 + ch; A[j] = LA[o]; H[j] = LH[o]; }
#pragma unroll
            for (int j = 0; j < 8; ++j) { const size_t o = ((size_t)bb * NCH + c0 + j) * 256 + ch; LH[o] = cy; cy = A[j] * cy + H[j]; } }
    }
}

__device__ __forceinline__ void phaseC(const Args& a, int l, int task, LAS unsigned char* lds, int tid) {
    asm volatile("" : "+v"(tid));
    const int lane = tid & 63, wave = __builtin_amdgcn_readfirstlane(tid >> 6);
    const int b = task / NCH, c = task % NCH;
    const int tl = lane & 15, fq = lane >> 4, tt = wave & 3, hg = wave >> 2;
    const unsigned m = (unsigned)(b * SEQ + c * CH + 16 * tt + tl);
    const char* U = (const char*)(a.ws + WS_U); char* MIX = (char*)(a.ws + WS_MIX); const char* VP = (const char*)(a.ws + WS_VP);
    const char* QT = (const char*)(a.ws + WS_QT); const char* RL = (const char*)(a.ws + WS_RL); const char* HL = (const char*)(a.ws + WS_HL); const float* BONG = (const float*)(a.ws + WS_BON);
    const unsigned uo = m * (unsigned)(NU * 2);
#pragma unroll
    for (int hh = 0; hh < 3; ++hh) {
        const int h = 3 * hg + hh; const int bh = b * RW_H + h;
        const char* sl = RL + ((size_t)bh * NCH + c) * 8192;
        f16x8 bq[2];
#pragma unroll
        for (int s = 0; s < 2; ++s) bq[s] = *(const f16x8*)(QT + (m * (unsigned)RW_W + (unsigned)(h * 64 + 8 * fq + 32 * s)) * 2u);
        f32x4 D[4];
#pragma unroll
        for (int vt = 0; vt < 4; ++vt) { const f16x4 yl = *(const f16x4*)(MIX + (m * (unsigned)DM + (unsigned)(h * 64 + 16 * vt + 4 * fq)) * 2u);
            f32x4 d = (f32x4){(float)yl[0], (float)yl[1], (float)yl[2], (float)yl[3]};
#pragma unroll
            for (int s = 0; s < 2; ++s) d = __builtin_amdgcn_mfma_f32_16x16x32_f16(*(const f16x8*)(sl + ((16 * vt + tl) * 64 + 8 * fq + 32 * s) * 2), bq[s], d, 0, 0, 0);
            D[vt] = d; }
        float sm = 0.f;
#pragma unroll
        for (int vt = 0; vt < 4; ++vt) sm += (D[vt][0] + D[vt][1]) + (D[vt][2] + D[vt][3]);
        sm += shfl_xor_f(sm, 16); sm += shfl_xor_f(sm, 32);
        const float mean = sm * (1.0f / 64.0f); float vr = 0.f;
#pragma unroll
        for (int vt = 0; vt < 4; ++vt)
#pragma unroll
            for (int i = 0; i < 4; ++i) { const float d = D[vt][i] - mean; vr += d * d; }
        vr += shfl_xor_f(vr, 16); vr += shfl_xor_f(vr, 32);
        const float rstd = rsq_(vr * (1.0f / 64.0f) + 64e-5f);
        const float bon = BONG[m * 8u + (unsigned)h];
        const float* ln_w = a.in[14] + l * RW_W; const float* ln_b = a.in[15] + l * RW_W;
#pragma unroll
        for (int vt = 0; vt < 4; ++vt) { const unsigned col = (unsigned)(h * 64 + 16 * vt + 4 * fq);
            const f16x4 vp = *(const f16x4*)(VP + (m * (unsigned)RW_W + col) * 2u), z4 = *(const f16x4*)(U + uo + ((unsigned)C_RWZ + col) * 2u);
            const f32x4 lw = *(const f32x4*)(ln_w + col), lb = *(const f32x4*)(ln_b + col);
            f16x4 o;
#pragma unroll
            for (int i = 0; i < 4; ++i) o[i] = (f16)(((D[vt][i] - mean) * rstd * lw[i] + lb[i] + bon * (float)vp[i]) * siluf_((float)z4[i]));
            *(f16x4*)(MIX + (m * (unsigned)DM + col) * 2u) = o; }
    }
#pragma unroll
    for (int hh = 0; hh < 3; ++hh) {
        const int h = 3 * hg + hh; const int bh = b * 6 + h;
        const char* sl = HL + ((size_t)bh * NCH + c) * 8192;
        f16x8 bq[2];
#pragma unroll
        for (int s = 0; s < 2; ++s) bq[s] = *(const f16x8*)(U + uo + (unsigned)(C_HGQ + h * 64 + 8 * fq + 32 * s) * 2u);
        f32x4 D[4];
#pragma unroll
        for (int vt = 0; vt < 4; ++vt) { const f16x4 ol = *(const f16x4*)(MIX + (m * (unsigned)DM + (unsigned)(384 + h * 64 + 16 * vt + 4 * fq)) * 2u);
            f32x4 d = (f32x4){(float)ol[0], (float)ol[1], (float)ol[2], (float)ol[3]};
#pragma unroll
            for (int s = 0; s < 2; ++s) d = __builtin_amdgcn_mfma_f32_16x16x32_f16(*(const f16x8*)(sl + ((16 * vt + tl) * 64 + 8 * fq + 32 * s) * 2), bq[s], d, 0, 0, 0);
            D[vt] = d; }
        float ss = 0.f;
#pragma unroll
        for (int vt = 0; vt < 4; ++vt) ss += (D[vt][0] * D[vt][0] + D[vt][1] * D[vt][1]) + (D[vt][2] * D[vt][2] + D[vt][3] * D[vt][3]);
        ss += shfl_xor_f(ss, 16); ss += shfl_xor_f(ss, 32);
        const float rs = rsq_(ss * (1.0f / 64.0f) + 1e-6f);
        const float* nw = a.in[17] + l * 384;
#pragma unroll
        for (int vt = 0; vt < 4; ++vt) { const unsigned col = (unsigned)(h * 64 + 16 * vt + 4 * fq);
            const f16x4 z4 = *(const f16x4*)(U + uo + ((unsigned)C_HGZ + col) * 2u); const f32x4 w4 = *(const f32x4*)(nw + col);
            f16x4 o;
#pragma unroll
            for (int i = 0; i < 4; ++i) o[i] = (f16)(D[vt][i] * rs * w4[i] * siluf_((float)z4[i]));
            *(f16x4*)(MIX + (m * (unsigned)DM + 384u + col) * 2u) = o; }
    }
    {
        const char* CA = (const char*)(a.ws + WS_CA); const float* LH = (const float*)(a.ws + WS_LH) + ((size_t)b * NCH + c) * 256;
#pragma unroll
        for (int q = 0; q < 4; ++q) { const unsigned ch0 = (unsigned)(128 * hg + 32 * fq + 8 * q);
            const f16x8 hl = *(const f16x8*)(MIX + (m * (unsigned)DM + 768u + ch0) * 2u), ca = *(const f16x8*)(CA + (m * 256u + ch0) * 2u), z8 = *(const f16x8*)(U + uo + ((unsigned)C_LRUZ + ch0) * 2u);
            const f32x4 c0 = *(const f32x4*)(LH + ch0), c1 = *(const f32x4*)(LH + ch0 + 4);
            f16x8 o;
#pragma unroll
            for (int i = 0; i < 8; ++i) o[i] = (f16)(((float)hl[i] + (float)ca[i] * (i < 4 ? c0[i & 3] : c1[i & 3])) * siluf_((float)z8[i]));
            *(f16x8*)(MIX + (m * (unsigned)DM + 768u + ch0) * 2u) = o; }
    }
}
#define XB_TMO      128
#define XB_XCNT(j)  (256  + 64 * (j))
#define XB_XSUB(j)  (1280 + 64 * (j))
#define XB_XGEN(j)  (2304 + 64 * (j))
#define XB_TOP      3328
#define XB_TOPGEN   3392
#define XCD_BAR_WORDS 3456
#define XB_SPIN_CAP (1u << 18)

__device__ __forceinline__ unsigned xb_ld(unsigned* p)              { return __hip_atomic_load(p, __ATOMIC_RELAXED, __HIP_MEMORY_SCOPE_AGENT); }
__device__ __forceinline__ unsigned xb_add(unsigned* p, unsigned v) { return __hip_atomic_fetch_add(p, v, __ATOMIC_RELAXED, __HIP_MEMORY_SCOPE_AGENT); }
__device__ __forceinline__ unsigned xb_xcc_id() { return (unsigned)__builtin_amdgcn_s_getreg((3 << 11) | 20) & 0xFu; }
#define XB_SPIN(cond, bar) do { unsigned _sp = 0; while (cond) { __builtin_amdgcn_s_sleep(1); \
    if ((++_sp & 255u) == 0u) { if (xb_ld(&(bar)[XB_TMO])) break; if (_sp > XB_SPIN_CAP) { atomicAdd(&(bar)[XB_TMO], 1u); break; } } } } while (0)

struct XcdBarrier {
    unsigned* bar; unsigned x; int isw0;
    volatile LAS unsigned* st;
};

__device__ __forceinline__ XcdBarrier xcd_barrier_post(unsigned* bar, volatile LAS unsigned* st, int isw0) {
    XcdBarrier b; b.bar = bar; b.x = xb_xcc_id(); b.st = st; b.isw0 = isw0;
    if (isw0 && lane_now() == 0) (void)xb_add(&bar[XB_XCNT(b.x)], 1u);
    return b;
}
__device__ __forceinline__ void xcd_barrier_complete(unsigned* bar, unsigned x, unsigned& nloc, unsigned& nx) {
    const unsigned G = gridDim.x * gridDim.y * gridDim.z;
    unsigned sum, cnt, mine, sp = 0u;
    for (;;) {
        sum = 0u; cnt = 0u; mine = 0u;
#pragma unroll
        for (unsigned j = 0; j < 16; ++j) { const unsigned c = xb_ld(&bar[XB_XCNT(j)]); sum += c; cnt += (c > 0u) ? 1u : 0u; mine = (j == x) ? c : mine; }
        if (sum == G) break;
        __builtin_amdgcn_s_sleep(1);
        if ((++sp & 255u) == 0u) { if (xb_ld(&bar[XB_TMO])) break; if (sp > XB_SPIN_CAP) { atomicAdd(&bar[XB_TMO], 1u); break; } }
    }
    nloc = mine > 0u ? mine : 1u; nx = cnt > 0u ? cnt : 1u;
}

__device__ __forceinline__ void xcd_barrier(const XcdBarrier& b) {
    asm volatile("s_waitcnt vmcnt(0)" ::: "memory");
    __syncthreads();
    if (b.isw0 && lane_now() == 0) {
        unsigned* bar = b.bar;
        __builtin_amdgcn_s_waitcnt(0);
        unsigned nloc = b.st[0], nx = b.st[1];
        if (nloc == 0u) { xcd_barrier_complete(bar, b.x, nloc, nx); b.st[0] = nloc; b.st[1] = nx; }
        const unsigned old = xb_add(&bar[XB_XSUB(b.x)], 1u);
        const unsigned gen = old / nloc;
        if (old + 1u == (gen + 1u) * nloc) {
            __builtin_amdgcn_fence(__ATOMIC_RELEASE, "agent");
            asm volatile("s_waitcnt vmcnt(0)" ::: "memory");
            const unsigned og = xb_add(&bar[XB_TOP], 1u);
            const unsigned tg = og / nx;
            if (og + 1u == (tg + 1u) * nx) xb_add(&bar[XB_TOPGEN], 1u);
            else XB_SPIN(xb_ld(&bar[XB_TOPGEN]) == tg, bar);
            __builtin_amdgcn_fence(__ATOMIC_ACQUIRE, "agent");
            xb_add(&bar[XB_XGEN(b.x)], 1u);
            asm volatile("s_waitcnt vmcnt(0)" ::: "memory");
        } else {
            XB_SPIN(xb_ld(&bar[XB_XGEN(b.x)]) == gen, bar);
            __builtin_amdgcn_fence(__ATOMIC_ACQUIRE, "agent");
            asm volatile("s_waitcnt vmcnt(0)" ::: "memory");
        }
    }
    __syncthreads();
}

constexpr size_t WS_BAR = 16384;
constexpr size_t WS_PCNT = 32768;
constexpr int MISC_OFF = LDS_BYTES - 16;
__global__ void __launch_bounds__(NT, 2) fwd(Args args) {
    extern __shared__ __attribute__((aligned(16))) unsigned char lds_raw[];
    LAS unsigned char* lds = (LAS unsigned char*)lds_raw;
    cg::grid_group grid = cg::this_grid();
    const int wave = __builtin_amdgcn_readfirstlane((int)threadIdx.x >> 6);
#define TID_NOW() (wave * 64 + lane_now())
    const int tid = TID_NOW(); const int lane = tid & 63;
    if (wave == 0 && lane < 4) ((LAS unsigned*)(lds + MISC_OFF))[lane] = 0u;
    __syncthreads();
    XcdBarrier xbar = xcd_barrier_post((unsigned*)(args.ws + WS_BAR), (volatile LAS unsigned*)(lds + MISC_OFF), __builtin_amdgcn_readfirstlane(wave == 0 ? 1 : 0));
#define GRID_BAR() do { XcdBarrier xb_ = xbar; xb_.st = (volatile LAS unsigned*)(lds + MISC_OFF); asm volatile("" : "+s"(xb_.bar), "+s"(xb_.x)); xcd_barrier(xb_); } while (0)
    const int G = gridDim.x, gw = blockIdx.x * NWAVES + wave, NGW = G * NWAVES;
    unsigned char* ws = args.ws;
    unsigned short* XN = (unsigned short*)(ws + WS_XN);
    {
        LAS float* scr = (LAS float*)(lds + wave * 8704);
        constexpr int I_IN = (DM / 64) * (NIN / 32), I_OUT = (DM / 64) * (DM / 32), NITEMS = DEPTH * (I_IN + I_OUT);
        for (int it = gw; it < NITEMS; it += NGW) {
            int r = it; const int l = r / (I_IN + I_OUT); r -= l * (I_IN + I_OUT);
            if (r < I_IN) p0_transpose_item(args.in[2] + (size_t)l * DM * NIN, DM, NIN, (unsigned short*)(ws + WS_WIN + l * WIN_L), scr, r, lane, l == 0 ? nullptr : args.in[1] + DM);
            else p0_transpose_item(args.in[25] + (size_t)l * DM * DM, DM, DM, (unsigned short*)(ws + WS_WOUT + l * WOUT_L), scr, r - I_IN, lane, nullptr);
        }
        for (int i = gw; i < DEPTH * (NU - NIN) * DM * 2 / 1024; i += NGW) { const int l = i / ((NU - NIN) * DM * 2 / 1024), r = i % ((NU - NIN) * DM * 2 / 1024);
            if (l == 1 && r < 64 * DM * 2 / 1024) continue;
            *(u32x4*)(ws + WS_WIN + l * WIN_L + (size_t)NIN * DM * 2 + (size_t)r * 1024 + lane * 16) = (u32x4){0u, 0u, 0u, 0u}; }
        if (blockIdx.x < 32) {
            LAS f16* TT = (LAS f16*)(lds + 8 * 8704);
            for (int i = tid; i < 64 * RW_W; i += NT) { const int n = i / RW_W, cc = i % RW_W; const float mm = args.in[3][RW_SHIFT + C_V + cc]; TT[n * 392 + cc] = (f16)(((n < 32) ? (1.0f - mm) : mm) * args.in[9][cc * 32 + (n & 31)]); }
            __syncthreads();
            const int tile = blockIdx.x * NWAVES + wave, nt = tile & 3, kt = tile >> 2, tl = lane & 15, fq = lane >> 4;
            const float* wrow = args.in[2] + (size_t)DM * NIN + (size_t)(16 * kt + tl) * NIN + C_V + 8 * fq;
            f32x4 bv[12][2];
#pragma unroll
            for (int s2 = 0; s2 < 12; ++s2) { bv[s2][0] = *(const f32x4*)(wrow + 32 * s2); bv[s2][1] = *(const f32x4*)(wrow + 32 * s2 + 4); }
            f32x4 d = (f32x4){0.f, 0.f, 0.f, 0.f};
#pragma unroll
            for (int s2 = 0; s2 < 12; ++s2) { f16x8 bf;
#pragma unroll
                for (int j = 0; j < 8; ++j) bf[j] = (f16)(j < 4 ? bv[s2][0][j & 3] : bv[s2][1][j & 3]);
                d = __builtin_amdgcn_mfma_f32_16x16x32_f16(*(const LAS f16x8*)(TT + (16 * nt + tl) * 392 + 8 * fq + 32 * s2), bf, d, 0, 0, 0); }
            const float nwk = args.in[1][DM + 16 * kt + tl];
#pragma unroll
            for (int i = 0; i < 4; ++i) ((f16*)(ws + WS_WIN + WIN_L))[(size_t)(NIN + 16 * nt + 4 * fq + i) * DM + 16 * kt + tl] = (f16)(d[i] * nwk);
            __syncthreads();
        }
        for (int i = blockIdx.x * NT + tid; i < 2 * M; i += G * NT) ((float*)(ws + WS_RSS))[i] = 0.f;
        for (int m = gw; m < M; m += 4 * NGW) rms_row4_f16(args.in[0] + (size_t)m * DM, (size_t)NGW * DM, args.in[1], XN + (size_t)m * DM, lane);
        { f16* WUPT = (f16*)(ws + WS_WUPT); f16* AUPT = (f16*)(ws + WS_AUPT); f16* VDNT = (f16*)(ws + WS_VDNT); f16* VUPT = (f16*)(ws + WS_VUPT);
          for (int i = blockIdx.x * NT + tid; i < 122880; i += G * NT) {
              if (i < 49152) { const int ll = i / 24576, r = i % 24576, n = r / 64, k = r % 64; WUPT[i] = (f16)args.in[5][(size_t)ll * 24576 + k * 384 + n]; }
              else if (i < 98304) { const int i2 = i - 49152, ll = i2 / 24576, r = i2 % 24576, n = r / 64, k = r % 64; AUPT[i2] = (f16)args.in[7][(size_t)ll * 24576 + k * 384 + n]; }
              else if (i < 110592) { const int i2 = i - 98304, j2 = i2 / 384, cc = i2 % 384; VDNT[i2] = (f16)args.in[9][cc * 32 + j2]; }
              else { const int i2 = i - 110592, n = i2 / 32, j2 = i2 % 32; VUPT[i2] = (f16)args.in[10][j2 * 384 + n]; } }
          f16* WAT = (f16*)(ws + WS_WAT); f16* WXT = (f16*)(ws + WS_WXT);
          for (int i = blockIdx.x * NT + tid; i < 32768; i += G * NT) { const int lg = i >> 12, r = i & 4095, j = r >> 6, ii = r & 63; WAT[i] = (f16)args.in[20][(size_t)lg * 4096 + ii * 64 + j]; WXT[i] = (f16)args.in[22][(size_t)lg * 4096 + ii * 64 + j]; } }
    }
    if (gridDim.x > 65536u) grid.sync();
    GRID_BAR();
#pragma unroll 1
    for (int l = 0; l < DEPTH; ++l) {
        { pg8::Gemm g{XN, (const unsigned short*)(ws + WS_WIN + l * WIN_L), M, NU, DM}; pg8::StaticOrder S; S.init(M, NU, G, (int)blockIdx.x);
          pg8::EpiF16 E{(unsigned short*)(ws + WS_U), NU, l == 0 ? nullptr : (const float*)(ws + WS_RSS)};
          pg8::gemm_phase<pg8::EpiF16, pg8::StaticOrder, true, true>(lds, g, S, E, wave); }
        GRID_BAR();
        for (int task = blockIdx.x; task < BATCH * NCH; task += G) phaseA(args, l, task, lds, TID_NOW());
        GRID_BAR();
        phaseB1(args, lds, TID_NOW());
        GRID_BAR();
        phaseB(args, lds, TID_NOW());
        GRID_BAR();
        phaseB3(args, lds, TID_NOW());
        GRID_BAR();
        for (int task = blockIdx.x; task < BATCH * NCH; task += G) phaseC(args, l, task, lds, TID_NOW());
        GRID_BAR();
        { pg8::Gemm g{(const unsigned short*)(ws + WS_MIX), (const unsigned short*)(ws + WS_WOUT + l * WOUT_L), M, DM, DM}; pg8::StaticOrder S; S.init(M, DM, G, (int)blockIdx.x);
          if (l + 1 < DEPTH) {
              pg8::EpiRes E{args.in[0], args.out, DM, XN, (float*)(ws + WS_RSS)};
              pg8::gemm_phase<pg8::EpiRes, pg8::StaticOrder, true, true>(lds, g, S, E, wave);
              GRID_BAR();
          } else {
              pg8::EpiResNorm E{args.out, args.out, DM, (float*)(ws + WS_RSS) + M, (unsigned*)(ws + WS_PCNT), args.in[26]};
              pg8::gemm_phase<pg8::EpiResNorm, pg8::StaticOrder, true, true>(lds, g, S, E, wave);
          } }
    }
}

extern "C" void kernel_launch(void* const* d_in, const int* in_sizes, int n_in, void* d_out, int out_size, void* d_ws, size_t ws_size, hipStream_t stream) {
    static int grid = 0;
    if (grid == 0) {
        if (n_in != 27 || in_sizes[0] != M * DM || out_size != M * DM || ws_size < WS_END) { fprintf(stderr, "kernel_launch: unexpected problem: n_in %d in0 %d out %d ws %zu\n", n_in, n_in > 0 ? in_sizes[0] : -1, out_size, ws_size); grid = -1; return; }
        int dev = 0, cus = 0, per_cu = 0;
        hipGetDevice(&dev); hipDeviceGetAttribute(&cus, hipDeviceAttributeMultiprocessorCount, dev);
        if (hipFuncSetAttribute((const void*)fwd, hipFuncAttributeMaxDynamicSharedMemorySize, LDS_BYTES) != hipSuccess) { fprintf(stderr, "kernel_launch: hipFuncSetAttribute failed\n"); grid = -1; return; }
        if (hipOccupancyMaxActiveBlocksPerMultiprocessor(&per_cu, (const void*)fwd, NT, LDS_BYTES) != hipSuccess || per_cu < 1) { fprintf(stderr, "kernel_launch: occupancy query failed (%d)\n", per_cu); grid = -1; return; }
        grid = cus * per_cu;
    }
    if (grid < 0) return;
    if (hipMemsetAsync((char*)d_ws, 0, 65536, stream) != hipSuccess) { fprintf(stderr, "kernel_launch: memset of the barrier words failed\n"); return; }
    Args a{};
    for (int i = 0; i < 27; ++i) a.in[i] = (const float*)d_in[i];
    a.out = (float*)d_out; a.ws = (unsigned char*)d_ws;
    void* kargs[] = {&a};
    hipError_t e = hipLaunchCooperativeKernel((const void*)fwd, dim3(grid), dim3(NT), kargs, LDS_BYTES, stream);
    if (e != hipSuccess) fprintf(stderr, "cooperative launch failed: %s (grid %d)\n", hipGetErrorString(e), grid);
}
```

```cpp
#include <hip/hip_runtime.h>
#include <hip/hip_cooperative_groups.h>
#include <cstdio>
#include <cstdint>
namespace cg = cooperative_groups;
typedef _Float16 f16x8_t __attribute__((ext_vector_type(8)));
#define MK_MFMA(a, b, c) __builtin_amdgcn_mfma_f32_16x16x32_f16(__builtin_bit_cast(f16x8_t, (a)), __builtin_bit_cast(f16x8_t, (b)), (c), 0, 0, 0)
__device__ __forceinline__ int lane_now() { int z; asm volatile("v_mbcnt_lo_u32_b32 %0, -1, 0\n\tv_mbcnt_hi_u32_b32 %0, -1, %0" : "=v"(z)); return z; }
__device__ __forceinline__ float shfl_xor_f(float v, int mask) { const int ln = lane_now(); return __builtin_bit_cast(float, __builtin_amdgcn_ds_bpermute((ln ^ mask) << 2, __builtin_bit_cast(int, v))); }
namespace pg8 {
#define PG8_LAS __attribute__((address_space(3)))
typedef unsigned short bf16_t;
typedef short bf16x8 __attribute__((ext_vector_type(8)));
typedef float f32x4 __attribute__((ext_vector_type(4)));
typedef unsigned u32x4 __attribute__((ext_vector_type(4)));
constexpr int BM = 256, BK = 64, HALF = 128, HTB = HALF * BK * 2  , STAGE_BYTES = 8 * HTB, NXCD = 8, WGM = 8;

__host__ __device__ __forceinline__ int lds_byte(int r, int c) { const int st = (r >> 4) * 2 + (c >> 5), rr = r & 15, cc = c & 31, ob = rr * 64 + cc * 2; return st * 1024 + (ob ^ (((ob >> 9) & 1) << 5)); }
__host__ __device__ __forceinline__ void stage_rc(int b, int& R, int& C) { const int st = b / 1024, sb = b % 1024, swz = sb ^ (((sb >> 9) & 1) << 5); R = (st >> 1) * 16 + swz / 64; C = (st & 1) * 32 + (swz % 64) / 2; }
__host__ __device__ __forceinline__ int perm32(int rho) { const int n = rho >> 4, i = rho & 15; return 8 * (i >> 2) + 4 * n + (i & 3); }

struct Unit { int pm, pn; };
struct Gemm { const bf16_t* A; const bf16_t* Bt; int M, N, K; };

struct StaticOrder {
    int nM, nN, nwg, G, c;
    __host__ __device__ void init(int M, int N, int G_, int c_) { nM = M / BM; nN = N / BM; nwg = nM * nN; G = G_; c = c_; }
    __host__ __device__ bool next(int i, Unit& u) const {
        const long L = (long)i * G + c; if (L >= nwg) return false;
        int wgid = (int)L; { const int q = nwg / NXCD, r = nwg % NXCD, xcd = wgid % NXCD, off = wgid / NXCD; wgid = (xcd < r ? xcd * (q + 1) : r * (q + 1) + (xcd - r) * q) + off; }
        const int nig = WGM * nN, gid = wgid / nig, fm = gid * WGM, gsz = (nM - fm) < WGM ? (nM - fm) : WGM;
        u.pm = fm + ((wgid % nig) % gsz); u.pn = (wgid % nig) / gsz; return true;
    }
    __device__ __forceinline__ void a_ready(const Unit&) const {}
    __device__ __forceinline__ void done(const Unit&) const {}
};

__device__ __forceinline__ unsigned pk_f16(float lo, float hi) { typedef _Float16 h2 __attribute__((ext_vector_type(2))); h2 v; v.x = (_Float16)lo; v.y = (_Float16)hi; return __builtin_bit_cast(unsigned, v); }
typedef unsigned u32x2 __attribute__((ext_vector_type(2)));
struct EpiF16 {
    static constexpr bool PERM = true, AFTER_DRAIN = false;
    bf16_t* O; int ldc; const float* rss;
    __device__ __forceinline__ void operator()(const f32x4 (&acc)[2][2][4][2], const Unit& u, int wr, int wc, int fr, int fq) const {
        const int row0 = u.pm * BM + wr * 64 + fr; const int col0 = u.pn * BM + wc * 32 + 8 * fq;
#pragma unroll
        for (int ai = 0; ai < 2; ++ai)
#pragma unroll
            for (int m = 0; m < 4; ++m) { const int row = row0 + ai * HALF + m * 16; bf16_t* rowp = O + (size_t)row * ldc + col0;
                const float sc = rss ? 1.0f / sqrtf(rss[row] * (1.0f / 1024.0f) + 1e-6f) : 1.0f;
#pragma unroll
                for (int bj = 0; bj < 2; ++bj) { const f32x4 v0 = acc[ai][bj][m][0] * sc, v1 = acc[ai][bj][m][1] * sc;
                    u32x4 w; w.x = pk_f16(v0[0], v0[1]); w.y = pk_f16(v0[2], v0[3]); w.z = pk_f16(v1[0], v1[1]); w.w = pk_f16(v1[2], v1[3]);
                    *(u32x4*)(rowp + bj * HALF) = w; } }
    }
};
struct EpiRes {
    static constexpr bool PERM = false, AFTER_DRAIN = false;
    const float* base; float* out; int ldc; bf16_t* xh; float* rss;
    __device__ __forceinline__ void operator()(const f32x4 (&acc)[2][2][4][2], const Unit& u, int wr, int wc, int fr, int fq) const {
        const int row0 = u.pm * BM + wr * 64 + fr; const int col0 = u.pn * BM + wc * 32 + 4 * fq;
#pragma unroll
        for (int ai = 0; ai < 2; ++ai)
#pragma unroll
            for (int m = 0; m < 4; ++m) { const size_t off = (size_t)(row0 + ai * HALF + m * 16) * ldc + col0; float ss = 0.f;
#pragma unroll
                for (int bj = 0; bj < 2; ++bj)
#pragma unroll
                    for (int n = 0; n < 2; ++n) { const size_t o = off + bj * HALF + n * 16; const f32x4 b = *(const f32x4*)(base + o); const f32x4 x = b + acc[ai][bj][m][n]; *(f32x4*)(out + o) = x;
                        if (xh) { u32x2 h; h.x = pk_f16(x[0], x[1]); h.y = pk_f16(x[2], x[3]); *(u32x2*)(xh + o) = h; ss += (x[0] * x[0] + x[1] * x[1]) + (x[2] * x[2] + x[3] * x[3]); } }
                if (xh) { ss += shfl_xor_f(ss, 16); ss += shfl_xor_f(ss, 32); if (fq == 0) atomicAdd(rss + row0 + ai * HALF + m * 16, ss); }
                asm volatile("" ::: "memory"); }
    }
};

struct EpiResNorm {
    static constexpr bool PERM = false, AFTER_DRAIN = false;
    const float* base; float* out; int ldc; float* rss2; unsigned* cnt; const float* w;
    __device__ __forceinline__ void operator()(f32x4 (&acc)[2][2][4][2], const Unit& u, int wr, int wc, int fr, int fq) const {
        const int row0 = u.pm * BM + wr * 64 + fr; const int col0 = u.pn * BM + wc * 32 + 4 * fq;
#pragma unroll
        for (int ai = 0; ai < 2; ++ai)
#pragma unroll
            for (int m = 0; m < 4; ++m) { const size_t off = (size_t)(row0 + ai * HALF + m * 16) * ldc + col0; float ss = 0.f;
#pragma unroll
                for (int bj = 0; bj < 2; ++bj)
#pragma unroll
                    for (int n = 0; n < 2; ++n) { const size_t o = off + bj * HALF + n * 16; const f32x4 x = *(const f32x4*)(base + o) + acc[ai][bj][m][n]; acc[ai][bj][m][n] = x;
                        ss += (x[0] * x[0] + x[1] * x[1]) + (x[2] * x[2] + x[3] * x[3]); }
                ss += shfl_xor_f(ss, 16); ss += shfl_xor_f(ss, 32); if (fq == 0) atomicAdd(rss2 + row0 + ai * HALF + m * 16, ss);
                asm volatile("" ::: "memory"); }
        asm volatile("s_waitcnt vmcnt(0)" ::: "memory");
        unsigned* pc = cnt + 64 * u.pm;
        if (lane_now() == 0) __hip_atomic_fetch_add(pc, 1u, __ATOMIC_RELAXED, __HIP_MEMORY_SCOPE_AGENT);
        for (unsigned spin = 0; spin < (1u << 22); ++spin) { if ((unsigned)__builtin_amdgcn_readfirstlane((int)__hip_atomic_load(pc, __ATOMIC_RELAXED, __HIP_MEMORY_SCOPE_AGENT)) >= 32u) break; __builtin_amdgcn_s_sleep(2); }
#pragma unroll
        for (int ai = 0; ai < 2; ++ai)
#pragma unroll
            for (int m = 0; m < 4; ++m) { const int row = row0 + ai * HALF + m * 16; const size_t off = (size_t)row * ldc + col0;
                const float rs = 1.0f / sqrtf(__hip_atomic_load(rss2 + row, __ATOMIC_RELAXED, __HIP_MEMORY_SCOPE_AGENT) * (1.0f / 1024.0f) + 1e-6f);
#pragma unroll
                for (int bj = 0; bj < 2; ++bj)
#pragma unroll
                    for (int n = 0; n < 2; ++n) { const size_t o = off + bj * HALF + n * 16; const f32x4 ww = *(const f32x4*)(w + col0 + bj * HALF + n * 16); *(f32x4*)(out + o) = acc[ai][bj][m][n] * rs * ww; } }
    }
};

template <class Epi, class Sched, bool ALIGN_EPI = false, bool SP2 = false>
__device__ __forceinline__ void gemm_phase(PG8_LAS unsigned char* lds, const Gemm g, const Sched& S, const Epi& E, const int wave_) {
    int wv_ = wave_; asm volatile("" : "+s"(wv_)); int tid_ = lane_now() + 64 * wv_; const int tid = tid_, wid = wv_, lane = tid & 63, wr = wid >> 2, wc = wid & 3, fr = lane & 15, fq = lane >> 4;
    const int K = g.K, nt = K / BK;
    unsigned voffA[2], voffB[2];
#pragma unroll
    for (int i = 0; i < 2; ++i) { int R, C; stage_rc(tid * 16 + i * 8192, R, C); const int Rb = Epi::PERM ? ((R & ~31) + perm32(R & 31)) : R;
        voffA[i] = (unsigned)(R * K + C) * 2u; voffB[i] = (unsigned)(Rb * K + C) * 2u; }
    const size_t kstep = (size_t)(BK * 2);
    const size_t hstep = (size_t)HALF * K * 2;
    const size_t tstep = 2 * hstep;
    const unsigned ldsw = (unsigned)wid * 1024u;
    const int aoff = lds_byte(wr * 64 + fr, fq * 8), boff = lds_byte(wc * 32 + fr, fq * 8);
#define PG8_SA(b, h) (((b) * 2 + (h)) * HTB)
#define PG8_SB(b, h) ((4 + (b) * 2 + (h)) * HTB)
#define PG8_STAGE(bufoff, gbase, voff) do { _Pragma("unroll") for (int _i = 0; _i < 2; ++_i) \
        __builtin_amdgcn_global_load_lds((const unsigned*)((const char*)(gbase) + (voff)[_i]), (PG8_LAS unsigned*)(lds + (bufoff) + ldsw + _i * 8192), 16, 0, 0); } while (0)
#define PG8_LDA(dst, b, h) do { _Pragma("unroll") for (int m = 0; m < 4; ++m) _Pragma("unroll") for (int k = 0; k < 2; ++k) dst[m][k] = *(const PG8_LAS bf16x8*)(lds + PG8_SA(b, h) + aoff + m * 2048 + k * 1024); } while (0)
#define PG8_LDB(dst, b, h) do { _Pragma("unroll") for (int n = 0; n < 2; ++n) _Pragma("unroll") for (int k = 0; k < 2; ++k) dst[n][k] = *(const PG8_LAS bf16x8*)(lds + PG8_SB(b, h) + boff + n * 2048 + k * 1024); } while (0)
#define PG8_MMA(ai, bj, At, Bt) do { __builtin_amdgcn_s_setprio(1); _Pragma("unroll") for (int m = 0; m < 4; ++m) _Pragma("unroll") for (int n = 0; n < 2; ++n) _Pragma("unroll") for (int k = 0; k < 2; ++k) \
        acc[ai][bj][m][n] = MK_MFMA(Bt[n][k], At[m][k], acc[ai][bj][m][n]); __builtin_amdgcn_s_setprio(0); } while (0)
#define PG8_WAIT_V(n) asm volatile("s_waitcnt vmcnt(" #n ")" ::: "memory")
#define PG8_WAIT_L(n) asm volatile("s_waitcnt lgkmcnt(" #n ")" ::: "memory")
#define PG8_BAR __builtin_amdgcn_s_barrier()
#define PG8_SCHED __builtin_amdgcn_sched_barrier(0)
    Unit cur, nxt; int ui = 0;
    if (!S.next(0, cur)) return;
    f32x4 acc[2][2][4][2];
#pragma unroll
    for (int a = 0; a < 2; ++a)
#pragma unroll
        for (int b = 0; b < 2; ++b)
#pragma unroll
            for (int m = 0; m < 4; ++m)
#pragma unroll
                for (int n = 0; n < 2; ++n) acc[a][b][m][n] = (f32x4){0.f, 0.f, 0.f, 0.f};
    bf16x8 At[4][2], B0[2][2], B1[2][2];
    const char* cA = (const char*)g.A + (size_t)cur.pm * tstep; const char* cB = (const char*)g.Bt + (size_t)cur.pn * tstep;
    S.a_ready(cur);
    if constexpr (SP2) {
        PG8_STAGE(PG8_SB(0, 0), cB, voffB); PG8_STAGE(PG8_SB(0, 1), cB + hstep, voffB); PG8_STAGE(PG8_SA(0, 0), cA, voffA); PG8_STAGE(PG8_SA(0, 1), cA + hstep, voffA);
        if (wr == 1) PG8_BAR;
        PG8_WAIT_V(2); PG8_BAR;
        PG8_STAGE(PG8_SB(1, 0), cB + kstep, voffB); PG8_STAGE(PG8_SA(1, 0), cA + kstep, voffA); PG8_STAGE(PG8_SB(1, 1), cB + hstep + kstep, voffB);
        PG8_WAIT_V(6); PG8_BAR;
    } else {
        PG8_STAGE(PG8_SB(0, 0), cB, voffB); PG8_STAGE(PG8_SA(0, 0), cA, voffA); PG8_STAGE(PG8_SB(0, 1), cB + hstep, voffB); PG8_STAGE(PG8_SA(0, 1), cA + hstep, voffA);
        if (wr == 1) PG8_BAR;
        PG8_WAIT_V(4); PG8_BAR;
        PG8_STAGE(PG8_SB(1, 0), cB + kstep, voffB); PG8_STAGE(PG8_SA(1, 0), cA + kstep, voffA); PG8_STAGE(PG8_SB(1, 1), cB + hstep + kstep, voffB);
        PG8_WAIT_V(6); PG8_BAR;
    }
    for (;;) {
        const bool has_next = S.next(ui + 1, nxt);
        const char* nA = has_next ? (const char*)g.A + (size_t)nxt.pm * tstep : cA; const char* nB = has_next ? (const char*)g.Bt + (size_t)nxt.pn * tstep : cB;
        for (int t = 0; t < nt; t += 2) {
            const bool last = (t == nt - 2);
            const char* a1 = cA + (size_t)(t + 1) * kstep;
            const char* a2 = last ? nA : cA + (size_t)(t + 2) * kstep; const char* b2 = last ? nB : cB + (size_t)(t + 2) * kstep;
            const char* a3 = a2 + kstep; const char* b3 = b2 + kstep;
            if (last && has_next) S.a_ready(nxt);
            if constexpr (SP2) {
            PG8_LDB(B0, 0, 0); PG8_LDB(B1, 0, 1); PG8_SCHED; PG8_LDA(At, 0, 0); PG8_STAGE(PG8_SA(1, 1), a1 + hstep, voffA);
            PG8_WAIT_V(8); PG8_WAIT_L(0); PG8_BAR; PG8_MMA(0, 0, At, B0); PG8_MMA(0, 1, At, B1); PG8_BAR; PG8_SCHED;
            PG8_LDA(At, 0, 1); PG8_STAGE(PG8_SB(0, 0), b2, voffB); PG8_STAGE(PG8_SB(0, 1), b2 + hstep, voffB); PG8_STAGE(PG8_SA(0, 0), a2, voffA);
            PG8_WAIT_V(8); PG8_WAIT_L(0); PG8_BAR; PG8_MMA(1, 0, At, B0); PG8_MMA(1, 1, At, B1); PG8_BAR; PG8_SCHED;
            PG8_LDB(B0, 1, 0); PG8_LDB(B1, 1, 1); PG8_SCHED; PG8_LDA(At, 1, 0); PG8_STAGE(PG8_SA(0, 1), a2 + hstep, voffA);
            PG8_WAIT_V(8); PG8_WAIT_L(0); PG8_BAR; PG8_MMA(0, 0, At, B0); PG8_MMA(0, 1, At, B1); PG8_BAR; PG8_SCHED;
            PG8_LDA(At, 1, 1); PG8_STAGE(PG8_SB(1, 0), b3, voffB); PG8_STAGE(PG8_SB(1, 1), b3 + hstep, voffB); PG8_STAGE(PG8_SA(1, 0), a3, voffA);
            PG8_WAIT_V(8); PG8_WAIT_L(0); PG8_BAR; PG8_MMA(1, 0, At, B0); PG8_MMA(1, 1, At, B1); PG8_BAR; PG8_SCHED;
            } else {
            PG8_LDB(B0, 0, 0); PG8_SCHED; PG8_LDA(At, 0, 0); PG8_STAGE(PG8_SA(1, 1), a1 + hstep, voffA);
            PG8_WAIT_L(8); PG8_BAR; PG8_WAIT_L(0); PG8_MMA(0, 0, At, B0); PG8_BAR; PG8_SCHED;
            PG8_LDB(B1, 0, 1); PG8_STAGE(PG8_SB(0, 0), b2, voffB);
            PG8_BAR; PG8_WAIT_L(0); PG8_MMA(0, 1, At, B1); PG8_BAR;
            PG8_LDA(At, 0, 1); PG8_STAGE(PG8_SA(0, 0), a2, voffA);
            PG8_BAR; PG8_WAIT_L(0); PG8_MMA(1, 0, At, B0); PG8_BAR; PG8_SCHED;
            PG8_STAGE(PG8_SB(0, 1), b2 + hstep, voffB);
            PG8_WAIT_V(6); PG8_BAR; PG8_MMA(1, 1, At, B1); PG8_BAR;
            PG8_LDB(B0, 1, 0); PG8_SCHED; PG8_LDA(At, 1, 0); PG8_STAGE(PG8_SA(0, 1), a2 + hstep, voffA);
            PG8_WAIT_L(8); PG8_BAR; PG8_WAIT_L(0); PG8_MMA(0, 0, At, B0); PG8_BAR; PG8_SCHED;
            PG8_LDB(B1, 1, 1); PG8_STAGE(PG8_SB(1, 0), b3, voffB);
            PG8_BAR; PG8_WAIT_L(0); PG8_MMA(0, 1, At, B1); PG8_BAR;
            PG8_LDA(At, 1, 1); PG8_STAGE(PG8_SA(1, 0), a3, voffA);
            PG8_BAR; PG8_WAIT_L(0); PG8_MMA(1, 0, At, B0); PG8_BAR; PG8_SCHED;
            PG8_STAGE(PG8_SB(1, 1), b3 + hstep, voffB);
            PG8_WAIT_V(6); PG8_BAR; PG8_MMA(1, 1, At, B1); PG8_BAR;
            }
        }
        if constexpr (ALIGN_EPI) { if (wr == 0) PG8_BAR; }
        if constexpr (!Epi::AFTER_DRAIN) { E(acc, cur, wr, wc, fr, fq); S.done(cur); }
        if (!has_next) break;
#pragma unroll
        for (int a = 0; a < 2; ++a)
#pragma unroll
            for (int b = 0; b < 2; ++b)
#pragma unroll
                for (int m = 0; m < 4; ++m)
#pragma unroll
                    for (int n = 0; n < 2; ++n) acc[a][b][m][n] = (f32x4){0.f, 0.f, 0.f, 0.f};
        cur = nxt; cA = nA; cB = nB; ++ui;
        if constexpr (ALIGN_EPI) { if (wr == 1) PG8_BAR; }
    }
    PG8_WAIT_V(0);
    if constexpr (!ALIGN_EPI) { if (wr == 0) PG8_BAR; }
    PG8_BAR;
    if constexpr (Epi::AFTER_DRAIN) { E.fused(acc, cur, wr, wc, fr, fq, lds, wid, lane); S.done(cur); }
#undef PG8_SA
#undef PG8_SB
#undef PG8_STAGE
#undef PG8_LDA
#undef PG8_LDB
#undef PG8_MMA
#undef PG8_WAIT_V
#undef PG8_WAIT_L
#undef PG8_BAR
#undef PG8_SCHED
}
}

constexpr int BATCH = 2, SEQ = 8192, DM = 1024, DEPTH = 2, M = BATCH * SEQ;
constexpr int RW_H = 6, HD = 64, RW_W = 384, RW_SHIFT = 1280;
constexpr int NIN = 3712, NU = 3840;
constexpr int C_R = 0, C_K = 384, C_V = 768, C_WL = 1152, C_AL = 1216, C_RWZ = 1280, C_HGQ = 1664, C_HGF = 2048, C_HGI = 2432, C_HGZ = 2816, C_LRUX = 3200, C_LRUZ = 3456;
constexpr int CH = 64;
constexpr int NWAVES = 8, NT = NWAVES * 64;
constexpr int LDS_BYTES = 163840;
constexpr int PRM_OFF = 154624;
constexpr size_t MiB = 1u << 20;
constexpr size_t WS_WUPT = 65536, WS_AUPT = WS_WUPT + 98304, WS_VDNT = WS_AUPT + 98304, WS_VUPT = WS_VDNT + 24576, WS_WAT = WS_VUPT + 24576, WS_WXT = WS_WAT + 65536;
constexpr size_t WS_WIN = 1 * MiB, WIN_L = (size_t)NU * DM * 2;
constexpr size_t WS_WOUT = 16 * MiB, WOUT_L = (size_t)DM * DM * 2;
constexpr size_t WS_XN = 20 * MiB;
constexpr size_t WS_QT = 20 * MiB;
constexpr size_t WS_PT = 32 * MiB;
constexpr size_t WS_CA = 44 * MiB;
constexpr size_t WS_U = 52 * MiB;
constexpr size_t WS_MIX = 172 * MiB;
constexpr size_t WS_VF = 204 * MiB;
constexpr size_t WS_VP = 216 * MiB;
constexpr size_t WS_RL = 228 * MiB;
constexpr size_t WS_HL = 240 * MiB;
constexpr size_t WS_BON = 252 * MiB;
constexpr size_t WS_DC = WS_BON + 512 * 1024;
constexpr size_t WS_LA = WS_DC + 512 * 1024;
constexpr size_t WS_LH = WS_LA + 256 * 1024;
constexpr size_t WS_RSS = WS_LH + 256 * 1024;
constexpr size_t WS_END = 254 * MiB;
constexpr int NCH = SEQ / CH;

#define LAS __attribute__((address_space(3)))
typedef float f32x4 __attribute__((ext_vector_type(4)));
typedef unsigned u32x2 __attribute__((ext_vector_type(2)));
typedef unsigned u32x4 __attribute__((ext_vector_type(4)));
typedef _Float16 f16;
typedef _Float16 f16x8 __attribute__((ext_vector_type(8)));
#define LDS_WAIT() asm volatile("s_waitcnt lgkmcnt(0)" ::: "memory")

struct Args { const float* in[27]; float* out; unsigned char* ws; };

__device__ __forceinline__ float wave_sum(float v) {
#pragma unroll
    for (int o = 1; o < 64; o <<= 1) v += shfl_xor_f(v, o);
    return v;
}
__device__ __forceinline__ float sigmoidf_(float x) { return __builtin_amdgcn_rcpf(1.0f + __expf(-x)); }
__device__ __forceinline__ float rsq_(float x) { return __builtin_amdgcn_rsqf(x); }
__device__ __forceinline__ float one_minus_exp_(float x) { return (x > -0.03f) ? -x * (1.0f + x * (0.5f + x * (1.0f / 6.0f + x * (1.0f / 24.0f)))) : 1.0f - __expf(x); }
__device__ __forceinline__ float siluf_(float x) { return x * __builtin_amdgcn_rcpf(1.0f + __expf(-x)); }

__device__ __forceinline__ void p0_transpose_item(const float* W, int K, int N, unsigned short* WT, LAS float* scr, int item, int lane, const float* rsc) {
    const int nblk = N / 32, kb = item / nblk, nb = item % nblk, k0 = 64 * kb, n0 = 32 * nb;
    float tv[32];
#pragma unroll
    for (int i = 0; i < 32; ++i) { const int kk = 2 * i + (lane >> 5); tv[i] = W[(size_t)(k0 + kk) * N + n0 + (lane & 31)]; }
#pragma unroll
    for (int i = 0; i < 32; ++i) { const int kk = 2 * i + (lane >> 5); scr[kk * 33 + (lane & 31)] = tv[i] * (rsc ? rsc[k0 + kk] : 1.0f); }
    LDS_WAIT(); asm volatile("" ::: "memory");
    const int c = lane & 7;
#pragma unroll
    for (int j = 0; j < 4; ++j) { const int n = (lane >> 3) + 8 * j; const LAS float* s = scr + (8 * c) * 33 + n;
        u32x4 o; o.x = pg8::pk_f16(s[0 * 33], s[1 * 33]); o.y = pg8::pk_f16(s[2 * 33], s[3 * 33]); o.z = pg8::pk_f16(s[4 * 33], s[5 * 33]); o.w = pg8::pk_f16(s[6 * 33], s[7 * 33]);
        *(u32x4*)(WT + (size_t)(n0 + n) * K + k0 + 8 * c) = o; }
    LDS_WAIT(); asm volatile("" ::: "memory");
}
__device__ __forceinline__ void rms_row_f16(const float* xrow, const float* w, unsigned short* orow, int lane) {
    const f32x4* xr = (const f32x4*)xrow + lane; const f32x4* wr = (const f32x4*)w + lane;
    f32x4 v[4]; float s = 0.f;
#pragma unroll
    for (int j = 0; j < 4; ++j) { v[j] = xr[64 * j]; s += (v[j].x * v[j].x + v[j].y * v[j].y) + (v[j].z * v[j].z + v[j].w * v[j].w); }
    const float rs = 1.0f / sqrtf(wave_sum(s) * (1.0f / DM) + 1e-6f);
    u32x2* o8 = (u32x2*)orow + lane;
#pragma unroll
    for (int j = 0; j < 4; ++j) { const f32x4 ww = wr[64 * j]; u32x2 o; o.x = pg8::pk_f16(v[j].x * rs * ww.x, v[j].y * rs * ww.y); o.y = pg8::pk_f16(v[j].z * rs * ww.z, v[j].w * rs * ww.w); o8[64 * j] = o; }
}
__device__ __forceinline__ void rms_row_f32(float* xrow, const float* w, int lane) {
    f32x4* xr = (f32x4*)xrow + lane; const f32x4* wr = (const f32x4*)w + lane;
    f32x4 v[4]; float s = 0.f;
#pragma unroll
    for (int j = 0; j < 4; ++j) { v[j] = xr[64 * j]; s += (v[j].x * v[j].x + v[j].y * v[j].y) + (v[j].z * v[j].z + v[j].w * v[j].w); }
    const float rs = 1.0f / sqrtf(wave_sum(s) * (1.0f / DM) + 1e-6f);
#pragma unroll
    for (int j = 0; j < 4; ++j) { const f32x4 ww = wr[64 * j]; xr[64 * j] = v[j] * rs * ww; }
}

__device__ __forceinline__ void rms_row2_f32(float* xa, float* xb, const float* w, int lane) {
    f32x4* ra = (f32x4*)xa + lane; f32x4* rb = (f32x4*)xb + lane; const f32x4* wr = (const f32x4*)w + lane;
    f32x4 va[4], vb[4]; float sa = 0.f, sb = 0.f;
#pragma unroll
    for (int j = 0; j < 4; ++j) { va[j] = ra[64 * j]; vb[j] = rb[64 * j]; }
#pragma unroll
    for (int j = 0; j < 4; ++j) { sa += (va[j].x * va[j].x + va[j].y * va[j].y) + (va[j].z * va[j].z + va[j].w * va[j].w); sb += (vb[j].x * vb[j].x + vb[j].y * vb[j].y) + (vb[j].z * vb[j].z + vb[j].w * vb[j].w); }
    const float rsa = 1.0f / sqrtf(wave_sum(sa) * (1.0f / DM) + 1e-6f), rsb = 1.0f / sqrtf(wave_sum(sb) * (1.0f / DM) + 1e-6f);
#pragma unroll
    for (int j = 0; j < 4; ++j) { const f32x4 ww = wr[64 * j]; ra[64 * j] = va[j] * rsa * ww; rb[64 * j] = vb[j] * rsb * ww; }
}
__device__ __forceinline__ void rms_row4_f16(const float* x0, size_t rs, const float* w, unsigned short* o0, int lane) {
    f32x4 v[4][4]; float s[4];
#pragma unroll
    for (int r = 0; r < 4; ++r)
#pragma unroll
        for (int j = 0; j < 4; ++j) v[r][j] = ((const f32x4*)(x0 + r * rs) + lane)[64 * j];
    const f32x4* wr = (const f32x4*)w + lane;
#pragma unroll
    for (int r = 0; r < 4; ++r) { float a = 0.f;
#pragma unroll
        for (int j = 0; j < 4; ++j) a += (v[r][j].x * v[r][j].x + v[r][j].y * v[r][j].y) + (v[r][j].z * v[r][j].z + v[r][j].w * v[r][j].w);
        s[r] = 1.0f / sqrtf(wave_sum(a) * (1.0f / DM) + 1e-6f); }
#pragma unroll
    for (int j = 0; j < 4; ++j) { const f32x4 ww = wr[64 * j];
#pragma unroll
        for (int r = 0; r < 4; ++r) { u32x2 o; o.x = pg8::pk_f16(v[r][j].x * s[r] * ww.x, v[r][j].y * s[r] * ww.y); o.y = pg8::pk_f16(v[r][j].z * s[r] * ww.z, v[r][j].w * s[r] * ww.w); ((u32x2*)(o0 + r * rs) + lane)[64 * j] = o; } }
}
__device__ __forceinline__ void rms_row4_f32(float* x0, size_t rs, const float* w, int lane) {
    f32x4 v[4][4]; float s[4];
#pragma unroll
    for (int r = 0; r < 4; ++r)
#pragma unroll
        for (int j = 0; j < 4; ++j) v[r][j] = ((const f32x4*)(x0 + r * rs) + lane)[64 * j];
    const f32x4* wr = (const f32x4*)w + lane;
#pragma unroll
    for (int r = 0; r < 4; ++r) { float a = 0.f;
#pragma unroll
        for (int j = 0; j < 4; ++j) a += (v[r][j].x * v[r][j].x + v[r][j].y * v[r][j].y) + (v[r][j].z * v[r][j].z + v[r][j].w * v[r][j].w);
        s[r] = rsq_(wave_sum(a) * (1.0f / DM) + 1e-6f); }
#pragma unroll
    for (int j = 0; j < 4; ++j) { const f32x4 ww = wr[64 * j];
#pragma unroll
        for (int r = 0; r < 4; ++r) ((f32x4*)(x0 + r * rs) + lane)[64 * j] = v[r][j] * s[r] * ww; }
}

#define SHV(col) ({ const float cur_ = (float)urow[(col)]; const float prev_ = hp ? (float)prow[(col)] : 0.f; cur_ + mu[(col)] * (prev_ - cur_); })

__device__ __forceinline__ void store_row64_f16(f16* dst, const float (&S)[64]) {
#pragma unroll
    for (int q = 0; q < 8; ++q) { u32x4 w; w.x = pg8::pk_f16(S[8 * q], S[8 * q + 1]); w.y = pg8::pk_f16(S[8 * q + 2], S[8 * q + 3]); w.z = pg8::pk_f16(S[8 * q + 4], S[8 * q + 5]); w.w = pg8::pk_f16(S[8 * q + 6], S[8 * q + 7]); *(u32x4*)(dst + 8 * q) = w; }
}


constexpr int RWT_ROW = 144, RWT_A = 0, RWT_R = 2304, RWT_B = 4608, RWT_K = 6912;
constexpr int RWC_B = 9216, RWC_K = 11264, RWC_V = 13312;
constexpr int RWF_G16 = 15360, RWF_RHO = 15616, RWA_INV = 15872, RWA_NMAT = 15936  , RWA_XPARK = 18496  , RWA_BYTES = 20992;
constexpr int C_VD0 = 3712, C_VD1 = 3744;
constexpr int PRM_MU = 0, PRM_A0 = 1280, PRM_KK = 1664, PRM_KA = 2048, PRM_RK = 2432, PRM_V0 = 2816, PRM_HALVES = 3200, PRM_W0_BYTE = 6400, PRM_BYTES = PRM_W0_BYTE + 1536;
typedef float f32x2 __attribute__((ext_vector_type(2)));
typedef _Float16 f16x4 __attribute__((ext_vector_type(4)));
__device__ __forceinline__ float fmix_lo(float a, unsigned b, float c) { float d; asm("v_fma_mix_f32 %0, %1, %2, %3 op_sel:[0,0,0] op_sel_hi:[0,1,0]" : "=v"(d) : "v"(a), "v"(b), "v"(c)); return d; }
__device__ __forceinline__ float fmix_hi(float a, unsigned b, float c) { float d; asm("v_fma_mix_f32 %0, %1, %2, %3 op_sel:[0,1,0] op_sel_hi:[0,1,0]" : "=v"(d) : "v"(a), "v"(b), "v"(c)); return d; }
__device__ __forceinline__ float mmix_lo(float a, unsigned b) { float d; asm("v_fma_mix_f32 %0, %1, %2, 0 op_sel:[0,0,0] op_sel_hi:[0,1,0]" : "=v"(d) : "v"(a), "v"(b)); return d; }
__device__ __forceinline__ float mmix_hi(float a, unsigned b) { float d; asm("v_fma_mix_f32 %0, %1, %2, 0 op_sel:[0,1,0] op_sel_hi:[0,1,0]" : "=v"(d) : "v"(a), "v"(b)); return d; }
__device__ __forceinline__ float mul_asm(float a, float b) { float d; asm("v_mul_f32 %0, %1, %2" : "=v"(d) : "v"(a), "v"(b)); return d; }
__device__ __forceinline__ float fma_asm(float a, float b, float c) { float d; asm("v_fma_f32 %0, %1, %2, %3" : "=v"(d) : "v"(a), "v"(b), "v"(c)); return d; }
#define FMIX(a, u, j, c) (((j) & 1) ? fmix_hi((a), (u)[(j) >> 1], (c)) : fmix_lo((a), (u)[(j) >> 1], (c)))
#define MMIX(a, u, j) (((j) & 1) ? mmix_hi((a), (u)[(j) >> 1]) : mmix_lo((a), (u)[(j) >> 1]))
__device__ __forceinline__ float fast_tanh(float x) { return 1.0f - 2.0f * __builtin_amdgcn_rcpf(__expf(2.0f * x) + 1.0f); }
__device__ __forceinline__ void lerp8(const char* ub, unsigned uo, unsigned po, bool hp, const char* mub, unsigned col, float (&x)[8]) {
    const f16x8 cu = *(const f16x8*)(ub + (uo + col * 2u)); f16x8 pv = *(const f16x8*)(ub + (po + col * 2u)); const f32x4 m0 = *(const f32x4*)(mub + col * 4u), m1 = *(const f32x4*)(mub + col * 4u + 16u);
#pragma unroll
    for (int j = 0; j < 8; ++j) { const float c = (float)cu[j], p = hp ? (float)pv[j] : 0.f; x[j] = c + (j < 4 ? m0[j] : m1[j - 4]) * (p - c); }
}
__device__ __forceinline__ void lerp4(const char* ub, unsigned uo, unsigned po, bool hp, const char* mub, unsigned col, float (&x)[4]) {
    const f16x4 cu = *(const f16x4*)(ub + (uo + col * 2u)); f16x4 pv = *(const f16x4*)(ub + (po + col * 2u)); const f32x4 m0 = *(const f32x4*)(mub + col * 4u);
#pragma unroll
    for (int j = 0; j < 4; ++j) { const float c = (float)cu[j], p = hp ? (float)pv[j] : 0.f; x[j] = c + m0[j] * (p - c); }
}
__device__ __forceinline__ f16x8 pack8(const float (&x)[8]) { f16x8 r;
#pragma unroll
    for (int j = 0; j < 8; ++j) r[j] = (f16)x[j];
    return r; }

template <int CTRL> __device__ __forceinline__ float dpp_f(float x) { return __builtin_bit_cast(float, __builtin_amdgcn_update_dpp(0, __builtin_bit_cast(int, x), CTRL, 0xF, 0xF, true)); }
__device__ __forceinline__ float row_prefix16(float x) { x += dpp_f<0x111>(x); x += dpp_f<0x112>(x); x += dpp_f<0x114>(x); x += dpp_f<0x118>(x); return x; }
__device__ __forceinline__ float bperm_f(int byteaddr, float x) { return __builtin_bit_cast(float, __builtin_amdgcn_ds_bpermute(byteaddr, __builtin_bit_cast(int, x))); }
__device__ __forceinline__ f16x4 cvt4(const f32x4 v) { f16x4 r; r[0] = (f16)v[0]; r[1] = (f16)v[1]; r[2] = (f16)v[2]; r[3] = (f16)v[3]; return r; }
#define MF16(A, B, C) __builtin_amdgcn_mfma_f32_16x16x16f16((A), (B), (C), 0, 0, 0)
#define MF32(A, B, C) __builtin_amdgcn_mfma_f32_16x16x32_f16((A), (B), (C), 0, 0, 0)

__device__ __forceinline__ void rwkv_waveA(const Args& a, int l, int b, int c, int h, LAS unsigned char* wl, const LAS unsigned char* prmb, int lane) {
    const LAS f16* prm = (const LAS f16*)prmb; const LAS float* prw0 = (const LAS float*)(prmb + PRM_W0_BYTE);
    const char* Ub = (const char*)(a.ws + WS_U); f16* MIX = (f16*)(a.ws + WS_MIX); char* VF = (char*)(a.ws + WS_VF); char* VP = (char*)(a.ws + WS_VP);
    f16* QT = (f16*)(a.ws + WS_QT); f16* PT = (f16*)(a.ws + WS_PT); f16* RL = (f16*)(a.ws + WS_RL); float* BONG = (float*)(a.ws + WS_BON);
    const char* WUPT = (const char*)(a.ws + WS_WUPT) + (size_t)l * 384 * 64 * 2; const char* AUPT = (const char*)(a.ws + WS_AUPT) + (size_t)l * 384 * 64 * 2;
    const char* VUPT = (const char*)(a.ws + WS_VUPT);
    const int bh = b * RW_H + h;
    f32x4 XT[4][8];
#pragma unroll
    for (int ct = 0; ct < 4; ++ct)
#pragma unroll
        for (int vt = 0; vt < 8; ++vt)
#pragma unroll
            for (int r = 0; r < 4; ++r) XT[ct][vt][r] = (vt == ct && (lane & 15) == 4 * (lane >> 4) + r) ? 1.f : 0.f;
#define XPK(ct, vt) ((vt) == 7 && (ct) >= 2)
#define XPA(ct) (*(LAS f32x4*)(wl + RWA_XPARK + ((ct) - 2) * 1024 + lane_now() * 16))
    XPA(2) = (f32x4){0.f, 0.f, 0.f, 0.f}; XPA(3) = (f32x4){0.f, 0.f, 0.f, 0.f};
#pragma unroll 1
    for (int blk = 0; blk < 4; ++blk) {
        const int lane_ = lane_now();
        const int tok = lane_ & 15, fq = lane_ >> 4;
        const int t = c * CH + blk * 16 + tok; const unsigned m = (unsigned)(b * SEQ + t); const bool hp = t > 0;
        const unsigned uo = m * (unsigned)(NU * 2), po = hp ? uo - (unsigned)(NU * 2) : uo;
        f16x8 cW[2], pW[2], cA[2], pA[2], vd0, vd1;
#pragma unroll
        for (int s = 0; s < 2; ++s) { const unsigned cw = (unsigned)(C_WL + 8 * fq + 32 * s) * 2u, ca = (unsigned)(C_AL + 8 * fq + 32 * s) * 2u;
            cW[s] = *(const f16x8*)(Ub + uo + cw); pW[s] = *(const f16x8*)(Ub + po + cw); cA[s] = *(const f16x8*)(Ub + uo + ca); pA[s] = *(const f16x8*)(Ub + po + ca); }
        vd0 = *(const f16x8*)(Ub + uo + (unsigned)(C_VD0 + 8 * fq) * 2u); vd1 = *(const f16x8*)(Ub + po + (unsigned)(C_VD1 + 8 * fq) * 2u);
#define RW_WLOAD(nt) { const unsigned n_ = (unsigned)(h * 64 + 16 * (nt) + tok);        \
            Wwu0 = *(const f16x8*)(WUPT + (n_ * 64u + 8u * fq) * 2u); Wwu1 = *(const f16x8*)(WUPT + (n_ * 64u + 8u * fq + 32u) * 2u); \
            Wau0 = *(const f16x8*)(AUPT + (n_ * 64u + 8u * fq) * 2u); Wau1 = *(const f16x8*)(AUPT + (n_ * 64u + 8u * fq + 32u) * 2u); \
            if (l > 0) Wvu = *(const f16x8*)(VUPT + (n_ * 32u + 8u * fq) * 2u); }
#define RW_ADECL(X) f16x4 X##cr, X##pr, X##ck, X##pk, X##cv, X##pv, X##vf;
#define RW_ALOAD(X, nt) { const unsigned cb_ = (unsigned)(h * 64 + 16 * (nt) + 4 * fq);        \
            if (l > 0) X##vf = *(const f16x4*)(VF + (m * (unsigned)RW_W + cb_) * 2u); \
            X##cr = *(const f16x4*)(Ub + uo + ((unsigned)C_R + cb_) * 2u); X##pr = *(const f16x4*)(Ub + po + ((unsigned)C_R + cb_) * 2u); \
            X##ck = *(const f16x4*)(Ub + uo + ((unsigned)C_K + cb_) * 2u); X##pk = *(const f16x4*)(Ub + po + ((unsigned)C_K + cb_) * 2u); \
            X##cv = *(const f16x4*)(Ub + uo + ((unsigned)C_V + cb_) * 2u); X##pv = *(const f16x4*)(Ub + po + ((unsigned)C_V + cb_) * 2u); }
        f16x8 Wwu0, Wwu1, Wau0, Wau1, Wvu; RW_ADECL(T0) RW_ADECL(T1)
        f16x8 bW[2], bA[2], bVD;
#pragma unroll
        for (int s = 0; s < 2; ++s) { float xw[8], xa[8];
            const f16x8 mw = *(const LAS f16x8*)(prm + PRM_MU + C_WL + 8 * fq + 32 * s), ma = *(const LAS f16x8*)(prm + PRM_MU + C_AL + 8 * fq + 32 * s);
#pragma unroll
            for (int j = 0; j < 8; ++j) { const float cw_ = (float)cW[s][j], pw_ = hp ? (float)pW[s][j] : 0.f, ca_ = (float)cA[s][j], pa_ = hp ? (float)pA[s][j] : 0.f;
                xw[j] = fast_tanh(cw_ + (float)mw[j] * (pw_ - cw_)); xa[j] = ca_ + (float)ma[j] * (pa_ - ca_); }
            bW[s] = pack8(xw); bA[s] = pack8(xa); }
        { float xv[8];
#pragma unroll
            for (int j = 0; j < 8; ++j) xv[j] = (float)vd0[j] + (hp ? (float)vd1[j] : 0.f);
            bVD = pack8(xv); }
        float ssq = 0.f, bon = 0.f;
        RW_ALOAD(T0, 0) asm volatile("" ::: "memory");
        const int bp7 = ((lane_ & 48) | 7) << 2, bp15 = ((lane_ & 48) | 15) << 2;
        f32x4 DWn, DAn, Gn;
#define RW_TMFMA() { DWn = (f32x4){0.f, 0.f, 0.f, 0.f}; DAn = DWn; Gn = DWn; \
            DWn = __builtin_amdgcn_mfma_f32_16x16x32_f16(Wwu0, bW[0], DWn, 0, 0, 0); DWn = __builtin_amdgcn_mfma_f32_16x16x32_f16(Wwu1, bW[1], DWn, 0, 0, 0); \
            DAn = __builtin_amdgcn_mfma_f32_16x16x32_f16(Wau0, bA[0], DAn, 0, 0, 0); DAn = __builtin_amdgcn_mfma_f32_16x16x32_f16(Wau1, bA[1], DAn, 0, 0, 0); \
            if (l > 0) Gn = __builtin_amdgcn_mfma_f32_16x16x32_f16(Wvu, bVD, Gn, 0, 0, 0); \
            asm volatile("" : "+v"(DWn), "+v"(DAn), "+v"(Gn)); }
#define RW_TCOMP(X, nt) { const int cb = h * 64 + 16 * (nt) + 4 * fq, co = 16 * (nt) + 4 * fq; \
            f16x4 ah, rh, bh, kh, bb, kb, vo; f32x4 rho4, g164; \
            const f16x4 pmr = *(const LAS f16x4*)(prm + PRM_MU + C_R + cb), pmk = *(const LAS f16x4*)(prm + PRM_MU + C_K + cb), pmv = *(const LAS f16x4*)(prm + PRM_MU + C_V + cb); \
            const f16x4 pa0 = *(const LAS f16x4*)(prm + PRM_A0 + cb), pkk = *(const LAS f16x4*)(prm + PRM_KK + cb), pka = *(const LAS f16x4*)(prm + PRM_KA + cb), prk = *(const LAS f16x4*)(prm + PRM_RK + cb), pv0 = *(const LAS f16x4*)(prm + PRM_V0 + cb); \
            const f32x4 pw0 = *(const LAS f32x4*)(prw0 + cb); \
            f32x4 g2v, Giv, G8v, G16v; \
            _Pragma("unroll") for (int i = 0; i < 4; ++i) { g2v[i] = -0.875036877f * sigmoidf_(pw0[i] + DWn[i]);      \
                Giv[i] = row_prefix16(g2v[i]); } \
            _Pragma("unroll") for (int i = 0; i < 4; ++i) { G8v[i] = bperm_f(bp7, Giv[i]); G16v[i] = bperm_f(bp15, Giv[i]); }       \
            _Pragma("unroll") for (int i = 0; i < 4; ++i) { \
                const float cr_ = (float)X##cr[i], ck_ = (float)X##ck[i], cv_ = (float)X##cv[i]; \
                const float rs = cr_ + (float)pmr[i] * ((hp ? (float)X##pr[i] : 0.f) - cr_), ks = ck_ + (float)pmk[i] * ((hp ? (float)X##pk[i] : 0.f) - ck_), vs = cv_ + (float)pmv[i] * ((hp ? (float)X##pv[i] : 0.f) - cv_); \
                const float aa = sigmoidf_((float)pa0[i] + DAn[i]); \
                float vv = vs; if (l > 0) vv = vs + ((float)X##vf[i] - vs) * sigmoidf_((float)pv0[i] + Gn[i]); \
                const float kk = ks * (float)pkk[i]; ssq += kk * kk; \
                const float kmod = ks * (1.0f + (aa - 1.0f) * (float)pka[i]); \
                bon += rs * kmod * (float)prk[i]; \
                const float bq = kk * aa; \
                const float g2 = g2v[i], Gi = Giv[i], G8 = G8v[i], G16 = G16v[i]; \
                const float e1 = __builtin_amdgcn_exp2f(Gi - G8), e1m = __builtin_amdgcn_exp2f((Gi - g2) - G8), einv = __builtin_amdgcn_exp2f(G8 - Gi), e168 = __builtin_amdgcn_exp2f(G16 - G8), esuf = e168 * einv; \
                rho4[i] = __builtin_amdgcn_exp2f(G8); g164[i] = rho4[i] * e168; \
                ah[i] = (f16)(-kk * e1m); rh[i] = (f16)(rs * e1); bh[i] = (f16)(bq * einv); kh[i] = (f16)(kmod * einv); bb[i] = (f16)(bq * esuf); kb[i] = (f16)(kmod * esuf); vo[i] = (f16)vv; } \
            *(LAS f16x4*)(wl + RWT_A + tok * RWT_ROW + co * 2) = ah; *(LAS f16x4*)(wl + RWT_R + tok * RWT_ROW + co * 2) = rh; \
            *(LAS f16x4*)(wl + RWT_B + tok * RWT_ROW + co * 2) = bh; *(LAS f16x4*)(wl + RWT_K + tok * RWT_ROW + co * 2) = kh; \
            _Pragma("unroll") for (int i = 0; i < 4; ++i) { *(LAS f16*)(wl + RWC_B + (co + i) * 32 + tok * 2) = bb[i]; *(LAS f16*)(wl + RWC_K + (co + i) * 32 + tok * 2) = kb[i]; *(LAS f16*)(wl + RWC_V + (co + i) * 32 + tok * 2) = vo[i]; } \
            if (tok == 0) { *(LAS f32x4*)(wl + RWF_RHO + co * 4) = rho4; *(LAS f32x4*)(wl + RWF_G16 + co * 4) = g164; } \
            *(f16x4*)(VP + (m * (unsigned)RW_W + (unsigned)cb) * 2u) = vo; \
            if (l == 0) *(f16x4*)(VF + (m * (unsigned)RW_W + (unsigned)cb) * 2u) = vo; }
#pragma unroll 1
        for (int nt = 0; nt < 4; ++nt) { const int nn = (nt + 1) & 3;
            RW_WLOAD(nt) asm volatile("" ::: "memory"); RW_ALOAD(T1, nn) asm volatile("" ::: "memory"); RW_TMFMA() asm volatile("" ::: "memory"); RW_TCOMP(T0, nt) asm volatile("" ::: "memory");
            T0cr = T1cr; T0pr = T1pr; T0ck = T1ck; T0pk = T1pk; T0cv = T1cv; T0pv = T1pv; T0vf = T1vf; }
#undef RW_WLOAD
#undef RW_ALOAD
#undef RW_ADECL
#undef RW_TMFMA
#undef RW_TCOMP
        ssq += shfl_xor_f(ssq, 16); ssq += shfl_xor_f(ssq, 32);
        bon += shfl_xor_f(bon, 16); bon += shfl_xor_f(bon, 32);
        { const float inv2v = __builtin_amdgcn_rcpf(fmaxf(ssq, 1e-24f));
          if (fq == 0) { *(LAS float*)(wl + RWA_INV + tok * 4) = inv2v; *(float*)((char*)BONG + (m * 8u + (unsigned)h) * 4u) = bon; } }
        const unsigned mb = (unsigned)(b * SEQ + c * CH + blk * 16);
        const int q4 = fq * 4;
        f16x4 N1, N1T, MkH, NbH, NkH;
        { f16x8 fa[2], fr[2], fb[2], fk[2];
#pragma unroll
          for (int s = 0; s < 2; ++s) { const int o = tok * RWT_ROW + (32 * s + q4) * 2;
#define RW_FRAG(F, T) { const f16x4 lo_ = *(const LAS f16x4*)(wl + (T) + o), hi_ = *(const LAS f16x4*)(wl + (T) + o + 32); F[s] = (f16x8){lo_[0], lo_[1], lo_[2], lo_[3], hi_[0], hi_[1], hi_[2], hi_[3]}; }
              RW_FRAG(fa, RWT_A) RW_FRAG(fr, RWT_R) RW_FRAG(fb, RWT_B) RW_FRAG(fk, RWT_K)
#undef RW_FRAG
          }
          const f32x4 z4 = (f32x4){0.f, 0.f, 0.f, 0.f};
          f32x4 Mb = MF32(fb[1], fa[1], MF32(fb[0], fa[0], z4)), MbT = MF32(fa[1], fb[1], MF32(fa[0], fb[0], z4));
          f32x4 Mk = MF32(fk[1], fa[1], MF32(fk[0], fa[0], z4)), Nb = MF32(fb[1], fr[1], MF32(fb[0], fr[0], z4)), Nk = MF32(fk[1], fr[1], MF32(fk[0], fr[0], z4));
          const f32x4 ivr = *(const LAS f32x4*)(wl + RWA_INV + q4 * 4); const float ivc = *(const LAS float*)(wl + RWA_INV + tok * 4);
#pragma unroll
          for (int r = 0; r < 4; ++r) { const int j = q4 + r;
              Mb[r] = (j < tok) ? Mb[r] * ivr[r] : 0.f; MbT[r] = (tok < j) ? MbT[r] * ivc : 0.f; Mk[r] = (j < tok) ? Mk[r] : 0.f; Nb[r] = (j <= tok) ? Nb[r] : 0.f; Nk[r] = (j <= tok) ? Nk[r] : 0.f; }
          N1 = cvt4(Mb); N1T = cvt4(MbT); MkH = cvt4(Mk); NbH = cvt4(Nb); NkH = cvt4(Nk); }
        const f16x4 N2 = cvt4(MF16(N1T, N1, ((f32x4){0.f, 0.f, 0.f, 0.f}))), N2T = cvt4(MF16(N1, N1T, ((f32x4){0.f, 0.f, 0.f, 0.f})));
        const f16x4 N4 = cvt4(MF16(N2T, N2, ((f32x4){0.f, 0.f, 0.f, 0.f}))), N4T = cvt4(MF16(N2, N2T, ((f32x4){0.f, 0.f, 0.f, 0.f})));
        const f16x4 N8 = cvt4(MF16(N4T, N4, ((f32x4){0.f, 0.f, 0.f, 0.f})));
        { LAS unsigned char* np = wl + RWA_NMAT + lane_ * 8; *(LAS f16x4*)(np) = N2; *(LAS f16x4*)(np + 512) = N4; *(LAS f16x4*)(np + 1024) = N8; *(LAS f16x4*)(np + 1536) = MkH; *(LAS f16x4*)(np + 2048) = NkH; }
#pragma unroll
        for (int hq = 0; hq < 4; ++hq) {
            constexpr int NTQ = 2; const int hv = hq >> 1;
            asm volatile("" ::: "memory");
            const f32x4 ivr2 = *(const LAS f32x4*)(wl + RWA_INV + q4 * 4);
            f32x4 G[NTQ], Y[NTQ]; f16x4 vf[NTQ];
            { f16x8 fa[2], fr[2];
#pragma unroll
              for (int s = 0; s < 2; ++s) { const int o = tok * RWT_ROW + (32 * s + q4) * 2;
#define RW_FRAG(F, T) { const f16x4 lo_ = *(const LAS f16x4*)(wl + (T) + o), hi_ = *(const LAS f16x4*)(wl + (T) + o + 32); F[s] = (f16x8){lo_[0], lo_[1], lo_[2], lo_[3], hi_[0], hi_[1], hi_[2], hi_[3]}; }
                  RW_FRAG(fa, RWT_A) RW_FRAG(fr, RWT_R)
#undef RW_FRAG
              }
#pragma unroll
              for (int t = 0; t < NTQ; ++t) { const int vt = 2 * hq + t; f16x8 xb[2];
#pragma unroll
                for (int s = 0; s < 2; ++s) { const f32x4 r0 = *(const LAS f32x4*)(wl + RWF_RHO + (32 * s + q4) * 4), r1 = *(const LAS f32x4*)(wl + RWF_RHO + (32 * s + 16 + q4) * 4);
                    const f32x4 x0 = (XPK(2 * s, vt) ? XPA(2 * s) : XT[2 * s][vt]) * r0, x1 = (XPK(2 * s + 1, vt) ? XPA(2 * s + 1) : XT[2 * s + 1][vt]) * r1;
                    xb[s] = (f16x8){(f16)x0[0], (f16)x0[1], (f16)x0[2], (f16)x0[3], (f16)x1[0], (f16)x1[1], (f16)x1[2], (f16)x1[3]}; }
                G[t] = MF32(fa[1], xb[1], MF32(fa[0], xb[0], ((f32x4){0.f, 0.f, 0.f, 0.f})));
                Y[t] = MF32(fr[1], xb[1], MF32(fr[0], xb[0], ((f32x4){0.f, 0.f, 0.f, 0.f})));
                if (hv) { vf[t] = *(const LAS f16x4*)(wl + RWC_V + (16 * (vt - 4) + tok) * 32 + q4 * 2); G[t] = MF16(*(const LAS f16x4*)(wl + RWA_NMAT + 1536 + lane_ * 8), vf[t], G[t]); } } }
#pragma unroll
            for (int t = 0; t < NTQ; ++t) G[t] = MF16(N1, cvt4(G[t]), G[t]);
            { const f16x4 Z = *(const LAS f16x4*)(wl + RWA_NMAT + lane_ * 8);
#pragma unroll
            for (int t = 0; t < NTQ; ++t) G[t] = MF16(Z, cvt4(G[t]), G[t]); }
            { const f16x4 Z = *(const LAS f16x4*)(wl + RWA_NMAT + 512 + lane_ * 8);
#pragma unroll
            for (int t = 0; t < NTQ; ++t) G[t] = MF16(Z, cvt4(G[t]), G[t]); }
            { const f16x4 Z = *(const LAS f16x4*)(wl + RWA_NMAT + 1024 + lane_ * 8);
#pragma unroll
            for (int t = 0; t < NTQ; ++t) G[t] = MF16(Z, cvt4(G[t]), G[t]); }
#pragma unroll
            for (int t = 0; t < NTQ; ++t) { const int vt = 2 * hq + t; const int tc = vt & 3;
                const f16x4 uh = cvt4(G[t] * ivr2);
                Y[t] = MF16(NbH, uh, Y[t]); if (hv) Y[t] = MF16(*(const LAS f16x4*)(wl + RWA_NMAT + 2048 + lane_ * 8), vf[t], Y[t]);
                char* yo = hv ? (char*)MIX + ((mb + (unsigned)q4) * (unsigned)DM + (unsigned)(h * 64 + 16 * tc + tok)) * 2u : (char*)QT + ((mb + (unsigned)q4) * (unsigned)RW_W + (unsigned)(h * 64 + 16 * tc + tok)) * 2u;
#pragma unroll
                for (int r = 0; r < 4; ++r) *(f16*)(yo + (unsigned)r * (hv ? (unsigned)(DM * 2) : (unsigned)(RW_W * 2))) = (f16)Y[t][r];
#pragma unroll
                for (int ct = 0; ct < 4; ++ct) { const f32x4 g16 = *(const LAS f32x4*)(wl + RWF_G16 + (16 * ct + q4) * 4);
                    const f16x4 bt = *(const LAS f16x4*)(wl + RWC_B + (16 * ct + tok) * 32 + q4 * 2);
                    f32x4 xn = MF16(bt, uh, (XPK(ct, vt) ? XPA(ct) : XT[ct][vt]) * g16);
                    if (hv) { const f16x4 kt = *(const LAS f16x4*)(wl + RWC_K + (16 * ct + tok) * 32 + q4 * 2); xn = MF16(kt, vf[t], xn); }
                    if (XPK(ct, vt)) XPA(ct) = xn; else XT[ct][vt] = xn; } }
        }
        asm volatile("" ::: "memory");
    }
    { const int lane2 = lane_now(); const int n2 = lane2 & 15, q2 = (lane2 >> 4) * 4;
      f16* rl = RL + ((size_t)bh * NCH + c) * 4096;
      f16* pt = PT + ((size_t)bh * NCH + c) * 4096;
#pragma unroll
      for (int ct = 0; ct < 4; ++ct)
#pragma unroll
          for (int t = 0; t < 4; ++t) { *(f16x4*)(rl + (16 * t + n2) * 64 + 16 * ct + q2) = cvt4(XPK(ct, 4 + t) ? XPA(ct) : XT[ct][4 + t]);
#pragma unroll
              for (int r = 0; r < 4; ++r) pt[(16 * ct + q2 + r) * 64 + 16 * t + n2] = (f16)XT[ct][t][r]; } }
}

constexpr int HGA_REC = 768, HGA_TB = 8  , HGA_V = HGA_TB * HGA_REC, HGA_HEAD = HGA_V + HGA_TB * 128, HGA_BYTES = 2 * HGA_HEAD;
template <int NH>
__device__ __forceinline__ void hgrn_waveA(const Args& a, int l, int b, int c, int h0, LAS unsigned char* wl) {
    char* U = (char*)(a.ws + WS_U); char* MIX = (char*)(a.ws + WS_MIX); f16* HL = (f16*)(a.ws + WS_HL); float* DC = (float*)(a.ws + WS_DC);
    const float* lbr = a.in[16];
    float S[NH][64]; float dpr[NH];
#pragma unroll
    for (int j = 0; j < NH; ++j) { dpr[j] = 1.f;
#pragma unroll
        for (int k = 0; k < 64; ++k) S[j][k] = 0.f; }
#pragma unroll 1
    for (int blk = 0; blk < CH / HGA_TB; ++blk) {
        const int lane_ = lane_now();
        const unsigned mb = (unsigned)(b * SEQ + c * CH + blk * HGA_TB);
        {
            f16 fr[NH][HGA_TB], qr[NH][HGA_TB], vr[NH][HGA_TB];
#pragma unroll
            for (int j = 0; j < NH; ++j)
#pragma unroll
                for (int tk = 0; tk < HGA_TB; ++tk) { const char* ur = U + (mb + tk) * (unsigned)(NU * 2) + (unsigned)((h0 + j) * 64 + lane_) * 2u; fr[j][tk] = *(const f16*)(ur + C_HGF * 2); qr[j][tk] = *(const f16*)(ur + C_HGQ * 2); vr[j][tk] = *(const f16*)(ur + C_HGI * 2); }
#pragma unroll
            for (int j = 0; j < NH; ++j) { const int col = (h0 + j) * 64 + lane_;
                const float lb = (l == 0) ? 0.f : sigmoidf_(lbr[384 + col] - lbr[col]);
                float dp = dpr[j];
#pragma unroll
                for (int tk = 0; tk < HGA_TB; ++tk) {
                    const float f = lb + (1.0f - lb) * sigmoidf_((float)fr[j][tk]);
                    LAS unsigned char* rec = wl + j * HGA_HEAD + tk * HGA_REC;
                    *(LAS float*)(rec + lane_ * 4) = f; *(LAS float*)(rec + 256 + lane_ * 4) = 1.0f - f; *(LAS float*)(rec + 512 + lane_ * 4) = (float)qr[j][tk];
                    *(LAS f16*)(wl + j * HGA_HEAD + HGA_V + tk * 128 + lane_ * 2) = vr[j][tk];
                    dp *= f;
                    *(f16*)(U + (mb + tk) * (unsigned)(NU * 2) + (unsigned)(C_HGQ + col) * 2u) = (f16)((float)qr[j][tk] * dp);
                }
                dpr[j] = dp; }
        }
        asm volatile("s_waitcnt lgkmcnt(0)" ::: "memory");
#define HG_LD(F, K, Q, rcp, g) { F[0] = *(const LAS f32x4*)((rcp) + (g) * 32); F[1] = *(const LAS f32x4*)((rcp) + (g) * 32 + 16);   \
            Q[0] = *(const LAS f32x4*)((rcp) + 512 + (g) * 32); Q[1] = *(const LAS f32x4*)((rcp) + 512 + (g) * 32 + 16); asm volatile("" ::: "memory"); }
#define HG_COMP(Sx, vi, F, K, Q, g) { float tt[8]; \
            _Pragma("unroll") for (int jj = 0; jj < 8; ++jj) tt[jj] = fma_asm(nvi, F[jj >> 2][jj & 3], vi); \
            _Pragma("unroll") for (int jj = 0; jj < 8; ++jj) Sx[8 * (g) + jj] = fma_asm(Sx[8 * (g) + jj], F[jj >> 2][jj & 3], tt[jj]); \
            _Pragma("unroll") for (int jj = 0; jj < 8; ++jj) oa[jj] = fma_asm(Sx[8 * (g) + jj], Q[jj >> 2][jj & 3], oa[jj]); }
#define HG_HEAD(Sx, vi, rcp, rcn, oo) { float oa[8]; _Pragma("unroll") for (int jj = 0; jj < 8; ++jj) oa[jj] = 0.f; \
            HG_LD(fo, ko, qo, rcp, 1) HG_COMP(Sx, vi, fe, ke, qe, 0) \
            HG_LD(fe, ke, qe, rcp, 2) HG_COMP(Sx, vi, fo, ko, qo, 1) \
            HG_LD(fo, ko, qo, rcp, 3) HG_COMP(Sx, vi, fe, ke, qe, 2) \
            HG_LD(fe, ke, qe, rcp, 4) HG_COMP(Sx, vi, fo, ko, qo, 3) \
            HG_LD(fo, ko, qo, rcp, 5) HG_COMP(Sx, vi, fe, ke, qe, 4) \
            HG_LD(fe, ke, qe, rcp, 6) HG_COMP(Sx, vi, fo, ko, qo, 5) \
            HG_LD(fo, ko, qo, rcp, 7) HG_COMP(Sx, vi, fe, ke, qe, 6) \
            HG_LD(fe, ke, qe, rcn, 0) HG_COMP(Sx, vi, fo, ko, qo, 7) \
            oo = ((oa[0] + oa[1]) + (oa[2] + oa[3])) + ((oa[4] + oa[5]) + (oa[6] + oa[7])); }
        f32x4 fe[2], ke[2], qe[2], fo[2], ko[2], qo[2];
        HG_LD(fe, ke, qe, wl, 0)
        f16 vh[NH], vn[NH];
#pragma unroll
        for (int j = 0; j < NH; ++j) vh[j] = *(const LAS f16*)(wl + j * HGA_HEAD + HGA_V + lane_ * 2);
#pragma unroll 1
        for (int t2 = 0; t2 < HGA_TB; ++t2) {
            const LAS unsigned char* rc = wl + t2 * HGA_REC;
#pragma unroll
            for (int j = 0; j < NH; ++j) vn[j] = *(const LAS f16*)(wl + j * HGA_HEAD + HGA_V + ((t2 + 1) & (HGA_TB - 1)) * 128 + lane_ * 2);
            float oo[NH];
#pragma unroll
            for (int j = 0; j < NH; ++j) { const float vi = (float)vh[j], nvi = -vi;
                const LAS unsigned char* rcp = rc + j * HGA_HEAD; const LAS unsigned char* rcn = (j + 1 < NH) ? rc + (j + 1) * HGA_HEAD : rc + HGA_REC;
                HG_HEAD(S[j], vi, rcp, rcn, oo[j]) }
            char* mo = MIX + ((mb + t2) * (unsigned)DM + (unsigned)(384 + h0 * 64 + lane_)) * 2u;
#pragma unroll
            for (int j = 0; j < NH; ++j) { *(f16*)(mo + 128 * j) = (f16)oo[j]; vh[j] = vn[j]; }
        }
#undef HG_LD
#undef HG_COMP
#undef HG_HEAD
    }
    const int lane2 = lane_now();
#pragma unroll
    for (int j = 0; j < NH; ++j) { const int bh = b * 6 + h0 + j; store_row64_f16(HL + (((size_t)bh * NCH + c) * 64 + lane2) * 64, S[j]);
        DC[((size_t)bh * NCH + c) * 64 + lane2] = dpr[j]; }
}

__device__ __forceinline__ void lru_waveA(const Args& a, int l, int b, int c, int g, LAS unsigned char* wl) {
    const int ln = lane_now();
    const char* Ub = (const char*)(a.ws + WS_U); char* MIXb = (char*)(a.ws + WS_MIX); char* CA = (char*)(a.ws + WS_CA); float* LA = (float*)(a.ws + WS_LA); float* LH = (float*)(a.ws + WS_LH);
    const float* cw = a.in[18] + l * 4 * 256 + g * 64; const float* cb = a.in[19] + l * 256 + g * 64;
    const float* ba = a.in[21] + l * 256 + g * 64; const float* bx = a.in[23] + l * 256 + g * 64; const float* lam = a.in[24] + l * 256 + g * 64;
    const char* WAT = (const char*)(a.ws + WS_WAT) + (size_t)(l * 4 + g) * 8192; const char* WXT = (const char*)(a.ws + WS_WXT) + (size_t)(l * 4 + g) * 8192;
    LAS unsigned char* Y = wl;
    const unsigned mrow0 = (unsigned)(b * SEQ + c * CH);
#pragma unroll 1
    for (int ib = 0; ib < 8; ib += 4) {
        f16x8 xr[4][4];
#pragma unroll
        for (int it = 0; it < 4; ++it) { const int item = ln + 64 * (ib + it), tok = item >> 3, co = item & 7; const int t = c * CH + tok;
#pragma unroll
            for (int jj = 0; jj < 4; ++jj) { const int ts = t - 3 + jj; const unsigned row = (ts >= 0) ? mrow0 + (unsigned)(tok - 3 + jj) : mrow0 + (unsigned)tok;
                xr[it][jj] = *(const f16x8*)(Ub + (row * (unsigned)NU + (unsigned)(C_LRUX + g * 64 + 8 * co)) * 2u); } }
#pragma unroll
        for (int it = 0; it < 4; ++it) { const int item = ln + 64 * (ib + it), tok = item >> 3, co = item & 7; const int t = c * CH + tok;
            const f32x4 b0 = *(const f32x4*)(cb + 8 * co), b1 = *(const f32x4*)(cb + 8 * co + 4);
            float y[8] = {b0[0], b0[1], b0[2], b0[3], b1[0], b1[1], b1[2], b1[3]};
#pragma unroll
            for (int jj = 0; jj < 4; ++jj) { const int ts = t - 3 + jj;
                if (ts >= 0) { const f32x4 w0 = *(const f32x4*)(cw + jj * 256 + 8 * co), w1 = *(const f32x4*)(cw + jj * 256 + 8 * co + 4);
#pragma unroll
                    for (int i = 0; i < 8; ++i) y[i] += (i < 4 ? w0[i & 3] : w1[i & 3]) * (float)xr[it][jj][i]; } }
            *(LAS f16x8*)(Y + tok * 144 + co * 16) = pack8(y); } }
    asm volatile("s_waitcnt lgkmcnt(0)" ::: "memory");
    const int tl = ln & 15, fq = ln >> 4;
    float sp[16], cy[16], cp[16];
#pragma unroll
    for (int nt = 0; nt < 4; ++nt) { const f32x4 lm4 = *(const f32x4*)(lam + 16 * nt + 4 * fq);
#pragma unroll
        for (int i = 0; i < 4; ++i) { sp[nt * 4 + i] = log1pf(__expf(-lm4[i])); cy[nt * 4 + i] = 0.f; cp[nt * 4 + i] = 1.f; } }
    f16x8 wfa[4][2], wfx[4][2];
#pragma unroll
    for (int nt = 0; nt < 4; ++nt)
#pragma unroll
        for (int s2 = 0; s2 < 2; ++s2) { const unsigned wo = (unsigned)(((16 * nt + (ln & 15)) * 64 + 8 * (ln >> 4) + 32 * s2) * 2); wfa[nt][s2] = *(const f16x8*)(WAT + wo); wfx[nt][s2] = *(const f16x8*)(WXT + wo); }
#pragma unroll 1
    for (int tt = 0; tt < 4; ++tt) {
        f16x8 by[2];
#pragma unroll
        for (int s2 = 0; s2 < 2; ++s2) by[s2] = *(const LAS f16x8*)(Y + (16 * tt + tl) * 144 + (8 * fq + 32 * s2) * 2);
        const unsigned m = mrow0 + (unsigned)(16 * tt + tl);
#pragma unroll
        for (int nt = 0; nt < 4; ++nt) {
            f32x4 ra = (f32x4){0.f, 0.f, 0.f, 0.f}, rx = ra;
#pragma unroll
            for (int s2 = 0; s2 < 2; ++s2) { ra = __builtin_amdgcn_mfma_f32_16x16x32_f16(wfa[nt][s2], by[s2], ra, 0, 0, 0); rx = __builtin_amdgcn_mfma_f32_16x16x32_f16(wfx[nt][s2], by[s2], rx, 0, 0, 0); }
            const int ch0 = 16 * nt + 4 * fq;
            const f32x4 ba4 = *(const f32x4*)(ba + ch0), bx4 = *(const f32x4*)(bx + ch0);
            const f16x4 y4 = *(const LAS f16x4*)(Y + (16 * tt + tl) * 144 + ch0 * 2);
            f16x4 ho, co;
#pragma unroll
            for (int i = 0; i < 4; ++i) { const int q = nt * 4 + i;
                const float r = sigmoidf_(ra[i] + ba4[i]), ig = sigmoidf_(rx[i] + bx4[i]);
                const float la = -8.0f * r * sp[q];
                float av = __expf(la), uv = sqrtf(one_minus_exp_(2.0f * la)) * (ig * (float)y4[i]);
#define LRU_SCAN(d) { const float ap = __builtin_bit_cast(float, __builtin_amdgcn_update_dpp(0x3f800000, __builtin_bit_cast(int, av), 0x110 + (d), 0xf, 0xf, false)); \
                      const float up = __builtin_bit_cast(float, __builtin_amdgcn_update_dpp(0, __builtin_bit_cast(int, uv), 0x110 + (d), 0xf, 0xf, false)); \
                      uv = av * up + uv; av = av * ap; }
                LRU_SCAN(1) LRU_SCAN(2) LRU_SCAN(4) LRU_SCAN(8)
#undef LRU_SCAN
                const float hl = uv + av * cy[q], ca = av * cp[q];
                ho[i] = (f16)hl; co[i] = (f16)ca;
                cy[q] = __builtin_bit_cast(float, __builtin_amdgcn_ds_bpermute((ln | 15) << 2, __builtin_bit_cast(int, hl)));
                cp[q] = __builtin_bit_cast(float, __builtin_amdgcn_ds_bpermute((ln | 15) << 2, __builtin_bit_cast(int, ca)));
            }
            *(f16x4*)(MIXb + (m * (unsigned)DM + 768u + (unsigned)(g * 64 + ch0)) * 2u) = ho; *(f16x4*)(CA + (m * 256u + (unsigned)(g * 64 + ch0)) * 2u) = co;
        }
    }
    if (tl == 15) {
#pragma unroll
        for (int q = 0; q < 16; ++q) { const int ch = g * 64 + 16 * (q >> 2) + 4 * fq + (q & 3); LA[((size_t)b * NCH + c) * 256 + ch] = cp[q]; LH[((size_t)b * NCH + c) * 256 + ch] = cy[q]; } }
}

__device__ __forceinline__ void phaseA(const Args& a, int l, int task, LAS unsigned char* lds, int tid) {
    asm volatile("" : "+v"(tid));
    const int lane = tid & 63, wave = __builtin_amdgcn_readfirstlane(tid >> 6);
    const int b = task / NCH, c = task % NCH;
    const f16* U = (const f16*)(a.ws + WS_U); f16* MIX = (f16*)(a.ws + WS_MIX); f16* VF = (f16*)(a.ws + WS_VF); f16* VP = (f16*)(a.ws + WS_VP);
    f16* QT = (f16*)(a.ws + WS_QT); f16* PT = (f16*)(a.ws + WS_PT); f16* RL = (f16*)(a.ws + WS_RL); float* BONG = (float*)(a.ws + WS_BON);
    {
        LAS f16* prm = (LAS f16*)(lds + PRM_OFF); LAS float* prw0 = (LAS float*)(lds + PRM_OFF + PRM_W0_BYTE);
        for (int i = tid; i < PRM_HALVES + 384; i += NT) {
            if (i < 1280) prm[i] = (f16)a.in[3][l * RW_SHIFT + i];
            else if (i < PRM_HALVES) { const int q = (i - 1280) / 384, cc = (i - 1280) % 384;
                prm[i] = (f16)((q == 0) ? a.in[6][l * RW_W + cc] : (q == 1) ? a.in[11][l * RW_W + cc] : (q == 2) ? a.in[12][l * RW_W + cc] : (q == 3) ? a.in[13][l * RW_W + cc] : a.in[8][cc]); }
            else prw0[i - PRM_HALVES] = a.in[4][l * RW_W + (i - PRM_HALVES)]; }
        __syncthreads();
        if (wave < 4) { rwkv_waveA(a, l, b, c, wave, lds + wave * RWA_BYTES, lds + PRM_OFF, lane);
                        hgrn_waveA<1>(a, l, b, c, wave, lds + wave * RWA_BYTES); }
        else if (wave < RW_H) { hgrn_waveA<1>(a, l, b, c, wave, lds + wave * RWA_BYTES);
                                rwkv_waveA(a, l, b, c, wave, lds + wave * RWA_BYTES, lds + PRM_OFF, lane_now()); }
        else { LAS unsigned char* hw = lds + RW_H * RWA_BYTES + (wave - RW_H) * HGA_BYTES;
               lru_waveA(a, l, b, c, 2 * (wave - RW_H), hw); lru_waveA(a, l, b, c, 2 * (wave - RW_H) + 1, hw); }
        __syncthreads();
    }
}

constexpr int PB_SLOT = 16384, PB_NS = 8, PB_AHEAD = 6, NGRP = NCH / 8;
#define ARENA(ws, off) ((char*)(ws) + WS_U + (size_t)((off) >> 11) * (size_t)(NU * 2) + (size_t)((off) & 2047))
constexpr size_t AR_PGT = 0, AR_LG = 2u << 20, AR_SG = 4u << 20;
#define PB_SWZ(row, o) ((row) * 128 + (((((o) >> 4) ^ ((row) & 7)) << 4) | ((o) & 15)))
template <bool ADD_L>
__device__ __forceinline__ void pb_step(f32x4 (&Sacc)[4], const LAS unsigned char* sl, int xrow, int vl, int fq) {
    f16x8 Bhi[2], Blo[2];
#pragma unroll
    for (int mt = 0; mt < 4; ++mt)
#pragma unroll
        for (int i = 0; i < 4; ++i) { const f16 hi = (f16)Sacc[mt][i]; const f16 lo = (f16)(Sacc[mt][i] - (float)hi); Bhi[mt >> 1][4 * (mt & 1) + i] = hi; Blo[mt >> 1][4 * (mt & 1) + i] = lo; }
#pragma unroll
    for (int mt = 0; mt < 4; ++mt) {
        f32x4 d = (f32x4){0.f, 0.f, 0.f, 0.f};
        if (ADD_L) { const f16x4 l4 = *(const LAS f16x4*)(sl + 8192 + PB_SWZ(xrow, 32 * mt + 8 * fq)); d = (f32x4){(float)l4[0], (float)l4[1], (float)l4[2], (float)l4[3]}; }
#pragma unroll
        for (int s = 0; s < 2; ++s) { const u32x2 a0 = *(const LAS u32x2*)(sl + PB_SWZ(16 * mt + vl, 64 * s + 8 * fq)), a1 = *(const LAS u32x2*)(sl + PB_SWZ(16 * mt + vl, 64 * s + 32 + 8 * fq));
            u32x4 aw; aw.x = a0.x; aw.y = a0.y; aw.z = a1.x; aw.w = a1.y; const f16x8 af = __builtin_bit_cast(f16x8, aw);
            d = __builtin_amdgcn_mfma_f32_16x16x32_f16(af, Bhi[s], d, 0, 0, 0); d = __builtin_amdgcn_mfma_f32_16x16x32_f16(af, Blo[s], d, 0, 0, 0); }
        Sacc[mt] = d; }
}
__device__ __forceinline__ void pb_stage8(const Args& a, LAS unsigned char* lds, int bh, int c0, int wave, int lane) {
    const char* PT = (const char*)(a.ws + WS_PT) + ((size_t)bh * NCH + c0) * 8192; const char* RL = (const char*)(a.ws + WS_RL) + ((size_t)bh * NCH + c0) * 8192;
    const int lq = wave * 64 + lane, lrow = lq >> 3, lpp = lq & 7; const unsigned lsrc = (unsigned)(lrow * 128 + ((lpp ^ (lrow & 7)) << 4));
#pragma unroll
    for (int sl = 0; sl < 8; ++sl) { const unsigned so = (unsigned)(sl * PB_SLOT + wave * 1024); const size_t go = (size_t)sl * 8192 + lsrc;
        __builtin_amdgcn_global_load_lds((const unsigned*)(PT + go), (LAS unsigned*)(lds + so), 16, 0, 0);
        __builtin_amdgcn_global_load_lds((const unsigned*)(RL + go), (LAS unsigned*)(lds + so + 8192), 16, 0, 0); }
    asm volatile("s_waitcnt vmcnt(0)" ::: "memory");
    __builtin_amdgcn_s_barrier();
}
__device__ __forceinline__ void phaseB1(const Args& a, LAS unsigned char* lds, int tid) {
    asm volatile("" : "+v"(tid));
    const int lane = tid & 63, wave = __builtin_amdgcn_readfirstlane(tid >> 6);
    for (int task = blockIdx.x; task < 12 * NGRP; task += gridDim.x) {
        const int bh = task / NGRP, g = task % NGRP, c0 = 8 * g;
        pb_stage8(a, lds, bh, c0, wave, lane);
        const int vt = wave & 3, vl = lane & 15, fq = lane >> 4, xr = 16 * vt + vl;
        f32x4 X[4];
        if (wave < 4) {
#pragma unroll
            for (int mt = 0; mt < 4; ++mt) { const f16x4 l4 = *(const LAS f16x4*)(lds + 8192 + PB_SWZ(xr, 32 * mt + 8 * fq)); X[mt] = (f32x4){(float)l4[0], (float)l4[1], (float)l4[2], (float)l4[3]}; }
#pragma unroll 1
            for (int s = 1; s < 8; ++s) pb_step<true>(X, lds + s * PB_SLOT, xr, vl, fq);
#pragma unroll
            for (int mt = 0; mt < 4; ++mt) { f16x4 o;
#pragma unroll
                for (int i = 0; i < 4; ++i) o[i] = (f16)X[mt][i];
                *(f16x4*)ARENA(a.ws, AR_LG + ((size_t)bh * NGRP + g) * 8192 + (size_t)((xr * 64 + 16 * mt + 4 * fq) * 2)) = o; }
        } else {
#pragma unroll
            for (int mt = 0; mt < 4; ++mt)
#pragma unroll
                for (int i = 0; i < 4; ++i) X[mt][i] = (16 * mt + 4 * fq + i == xr) ? 1.f : 0.f;
#pragma unroll 1
            for (int s = 0; s < 8; ++s) pb_step<false>(X, lds + s * PB_SLOT, xr, vl, fq);
#pragma unroll
            for (int mt = 0; mt < 4; ++mt)
#pragma unroll
                for (int i = 0; i < 4; ++i) *(f16*)ARENA(a.ws, AR_PGT + ((size_t)bh * NGRP + g) * 8192 + (size_t)(((16 * mt + 4 * fq + i) * 64 + xr) * 2)) = (f16)X[mt][i];
        }
        asm volatile("s_waitcnt vmcnt(0) lgkmcnt(0)" ::: "memory");
        __builtin_amdgcn_s_barrier();
    }
}
__device__ __forceinline__ void phaseB3(const Args& a, LAS unsigned char* lds, int tid) {
    asm volatile("" : "+v"(tid));
    const int lane = tid & 63, wave = __builtin_amdgcn_readfirstlane(tid >> 6);
    for (int task = blockIdx.x; task < 12 * NGRP; task += gridDim.x) {
        const int bh = task / NGRP, g = task % NGRP, c0 = 8 * g;
        pb_stage8(a, lds, bh, c0, wave, lane);
        if (wave < 4) {
            const int vt = wave, vl = lane & 15, fq = lane >> 4, xr = 16 * vt + vl;
            char* RL = (char*)(a.ws + WS_RL) + ((size_t)bh * NCH + c0) * 8192;
            f32x4 X[4];
#pragma unroll
            for (int mt = 0; mt < 4; ++mt) { const f16x4 s4 = *(const f16x4*)ARENA(a.ws, AR_SG + ((size_t)bh * NGRP + g) * 8192 + (size_t)((xr * 64 + 16 * mt + 4 * fq) * 2)); X[mt] = (f32x4){(float)s4[0], (float)s4[1], (float)s4[2], (float)s4[3]}; }
#pragma unroll 1
            for (int s = 0; s < 8; ++s) {
#pragma unroll
                for (int mt = 0; mt < 4; ++mt) { f16x4 o;
#pragma unroll
                    for (int i = 0; i < 4; ++i) o[i] = (f16)X[mt][i];
                    *(f16x4*)(RL + (size_t)s * 8192 + (xr * 64 + 16 * mt + 4 * fq) * 2) = o; }
                if (s < 7) pb_step<true>(X, lds + s * PB_SLOT, xr, vl, fq);
            }
        }
        asm volatile("s_waitcnt vmcnt(0) lgkmcnt(0)" ::: "memory");
        __builtin_amdgcn_s_barrier();
    }
}
__device__ __forceinline__ void phaseB(const Args& a, LAS unsigned char* lds, int tid) {
    asm volatile("" : "+v"(tid));
    const int lane = tid & 63, wave = __builtin_amdgcn_readfirstlane(tid >> 6);
    const int bx = blockIdx.x;
    if (bx < 12) {
        const int bh = bx;
        const bool loader = wave >= 4;
        const int vt = wave & 3, vl = lane & 15, fq = lane >> 4, v = 16 * vt + vl;
        const int lq = (wave - 4) * 64 + lane, lrow = lq >> 3, lpp = lq & 7;
        const unsigned lsrc = (unsigned)(lrow * 128 + ((lpp ^ (lrow & 7)) << 4));
#define PB_ISSUE(cc) { const unsigned so = (unsigned)(((cc) & (PB_NS - 1)) * PB_SLOT) + (unsigned)((wave - 4) * 1024); const size_t go = ((size_t)bh * NGRP + (cc)) * 8192 + lsrc; \
            __builtin_amdgcn_global_load_lds((const unsigned*)ARENA(a.ws, AR_PGT + go), (LAS unsigned*)(lds + so), 16, 0, 0); \
            __builtin_amdgcn_global_load_lds((const unsigned*)ARENA(a.ws, AR_PGT + go + 4096), (LAS unsigned*)(lds + so + 4096), 16, 0, 0); \
            __builtin_amdgcn_global_load_lds((const unsigned*)ARENA(a.ws, AR_LG + go), (LAS unsigned*)(lds + so + 8192), 16, 0, 0); \
            __builtin_amdgcn_global_load_lds((const unsigned*)ARENA(a.ws, AR_LG + go + 4096), (LAS unsigned*)(lds + so + 12288), 16, 0, 0); }
        if (loader) {
#pragma unroll
            for (int cc = 0; cc < PB_AHEAD; ++cc) PB_ISSUE(cc)
            asm volatile("s_waitcnt vmcnt(20)" ::: "memory");
        }
        __builtin_amdgcn_s_barrier();
        f32x4 Sacc[4];
#pragma unroll
        for (int mt = 0; mt < 4; ++mt) Sacc[mt] = (f32x4){0.f, 0.f, 0.f, 0.f};
#pragma unroll 1
        for (int c = 0; c < NGRP; ++c) {
            if (loader) {
                if (c + PB_AHEAD < NGRP) { PB_ISSUE(c + PB_AHEAD) asm volatile("s_waitcnt vmcnt(20)" ::: "memory"); }
                else asm volatile("s_waitcnt vmcnt(0)" ::: "memory");
            } else {
#pragma unroll
                for (int mt = 0; mt < 4; ++mt) { f16x4 o;
#pragma unroll
                    for (int i = 0; i < 4; ++i) o[i] = (f16)Sacc[mt][i];
                    *(f16x4*)ARENA(a.ws, AR_SG + ((size_t)bh * NGRP + c) * 8192 + (size_t)((v * 64 + 16 * mt + 4 * fq) * 2)) = o; }
                pb_step<true>(Sacc, lds + (c & (PB_NS - 1)) * PB_SLOT, v, vl, fq);
                asm volatile("s_waitcnt lgkmcnt(0)" ::: "memory");
            }
            __builtin_amdgcn_s_barrier();
        }
#undef PB_ISSUE
        asm volatile("s_waitcnt vmcnt(0)" ::: "memory");
    } else if (bx < 12 + 96) {
        const int idx = (bx - 12) * NT + tid; const int bh = idx >> 12, e = idx & 4095, k = e & 63;
        f16* HL = (f16*)(a.ws + WS_HL); const float* DC = (const float*)(a.ws + WS_DC);
        float s = 0.f;
        for (int c0 = 0; c0 < NCH; c0 += 8) { float Lc[8], d[8];
#pragma unroll
            for (int j = 0; j < 8; ++j) { Lc[j] = (float)HL[((size_t)bh * NCH + c0 + j) * 4096 + e]; d[j] = DC[((size_t)bh * NCH + c0 + j) * 64 + k]; }
#pragma unroll
            for (int j = 0; j < 8; ++j) { HL[((size_t)bh * NCH + c0 + j) * 4096 + e] = (f16)s; s = d[j] * s + Lc[j]; } }
    } else if (bx == 12 + 96) {
        const int bb = tid >> 8, ch = tid & 255; const float* LA = (const float*)(a.ws + WS_LA); float* LH = (float*)(a.ws + WS_LH);
        float cy = 0.f;
        for (int c0 = 0; c0 < NCH; c0 += 8) { float A[8], H[8];
#pragma unroll
            for (int j = 0; j < 8; ++j) { const size_t o = ((size_t)bb * NCH + c0 + j) * 256 + ch; A[j] = LA[o]; H[j] = LH[o]; }
#pragma unroll
            for (int j = 0; j < 8; ++j) { const size_t o = ((size_t)bb * NCH + c0 + j) * 256 + ch; LH[o] = cy; cy = A[j] * cy + H[j]; } }
    }
}

__device__ __forceinline__ void phaseC(const Args& a, int l, int task, LAS unsigned char* lds, int tid) {
    asm volatile("" : "+v"(tid));
    const int lane = tid & 63, wave = __builtin_amdgcn_readfirstlane(tid >> 6);
    const int b = task / NCH, c = task % NCH;
    const int tl = lane & 15, fq = lane >> 4, tt = wave & 3, hg = wave >> 2;
    const unsigned m = (unsigned)(b * SEQ + c * CH + 16 * tt + tl);
    const char* U = (const char*)(a.ws + WS_U); char* MIX = (char*)(a.ws + WS_MIX); const char* VP = (const char*)(a.ws + WS_VP);
    const char* QT = (const char*)(a.ws + WS_QT); const char* RL = (const char*)(a.ws + WS_RL); const char* HL = (const char*)(a.ws + WS_HL); const float* BONG = (const float*)(a.ws + WS_BON);
    const unsigned uo = m * (unsigned)(NU * 2);
#pragma unroll
    for (int hh = 0; hh < 3; ++hh) {
        const int h = 3 * hg + hh; const int bh = b * RW_H + h;
        const char* sl = RL + ((size_t)bh * NCH + c) * 8192;
        f16x8 bq[2];
#pragma unroll
        for (int s = 0; s < 2; ++s) bq[s] = *(const f16x8*)(QT + (m * (unsigned)RW_W + (unsigned)(h * 64 + 8 * fq + 32 * s)) * 2u);
        f32x4 D[4];
#pragma unroll
        for (int vt = 0; vt < 4; ++vt) { const f16x4 yl = *(const f16x4*)(MIX + (m * (unsigned)DM + (unsigned)(h * 64 + 16 * vt + 4 * fq)) * 2u);
            f32x4 d = (f32x4){(float)yl[0], (float)yl[1], (float)yl[2], (float)yl[3]};
#pragma unroll
            for (int s = 0; s < 2; ++s) d = __builtin_amdgcn_mfma_f32_16x16x32_f16(*(const f16x8*)(sl + ((16 * vt + tl) * 64 + 8 * fq + 32 * s) * 2), bq[s], d, 0, 0, 0);
            D[vt] = d; }
        float sm = 0.f;
#pragma unroll
        for (int vt = 0; vt < 4; ++vt) sm += (D[vt][0] + D[vt][1]) + (D[vt][2] + D[vt][3]);
        sm += shfl_xor_f(sm, 16); sm += shfl_xor_f(sm, 32);
        const float mean = sm * (1.0f / 64.0f); float vr = 0.f;
#pragma unroll
        for (int vt = 0; vt < 4; ++vt)
#pragma unroll
            for (int i = 0; i < 4; ++i) { const float d = D[vt][i] - mean; vr += d * d; }
        vr += shfl_xor_f(vr, 16); vr += shfl_xor_f(vr, 32);
        const float rstd = rsq_(vr * (1.0f / 64.0f) + 64e-5f);
        const float bon = BONG[m * 8u + (unsigned)h];
        const float* ln_w = a.in[14] + l * RW_W; const float* ln_b = a.in[15] + l * RW_W;
#pragma unroll
        for (int vt = 0; vt < 4; ++vt) { const unsigned col = (unsigned)(h * 64 + 16 * vt + 4 * fq);
            const f16x4 vp = *(const f16x4*)(VP + (m * (unsigned)RW_W + col) * 2u), z4 = *(const f16x4*)(U + uo + ((unsigned)C_RWZ + col) * 2u);
            const f32x4 lw = *(const f32x4*)(ln_w + col), lb = *(const f32x4*)(ln_b + col);
            f16x4 o;
#pragma unroll
            for (int i = 0; i < 4; ++i) o[i] = (f16)(((D[vt][i] - mean) * rstd * lw[i] + lb[i] + bon * (float)vp[i]) * siluf_((float)z4[i]));
            *(f16x4*)(MIX + (m * (unsigned)DM + col) * 2u) = o; }
    }
#pragma unroll
    for (int hh = 0; hh < 3; ++hh) {
        const int h = 3 * hg + hh; const int bh = b * 6 + h;
        const char* sl = HL + ((size_t)bh * NCH + c) * 8192;
        f16x8 bq[2];
#pragma unroll
        for (int s = 0; s < 2; ++s) bq[s] = *(const f16x8*)(U + uo + (unsigned)(C_HGQ + h * 64 + 8 * fq + 32 * s) * 2u);
        f32x4 D[4];
#pragma unroll
        for (int vt = 0; vt < 4; ++vt) { const f16x4 ol = *(const f16x4*)(MIX + (m * (unsigned)DM + (unsigned)(384 + h * 64 + 16 * vt + 4 * fq)) * 2u);
            f32x4 d = (f32x4){(float)ol[0], (float)ol[1], (float)ol[2], (float)ol[3]};
#pragma unroll
            for (int s = 0; s < 2; ++s) d = __builtin_amdgcn_mfma_f32_16x16x32_f16(*(const f16x8*)(sl + ((16 * vt + tl) * 64 + 8 * fq + 32 * s) * 2), bq[s], d, 0, 0, 0);
            D[vt] = d; }
        float ss = 0.f;
#pragma unroll
        for (int vt = 0; vt < 4; ++vt) ss += (D[vt][0] * D[vt][0] + D[vt][1] * D[vt][1]) + (D[vt][2] * D[vt][2] + D[vt][3] * D[vt][3]);
        ss += shfl_xor_f(ss, 16); ss += shfl_xor_f(ss, 32);
        const float rs = rsq_(ss * (1.0f / 64.0f) + 1e-6f);
        const float* nw = a.in[17] + l * 384;
#pragma unroll
        for (int vt = 0; vt < 4; ++vt) { const unsigned col = (unsigned)(h * 64 + 16 * vt + 4 * fq);
            const f16x4 z4 = *(const f16x4*)(U + uo + ((unsigned)C_HGZ + col) * 2u); const f32x4 w4 = *(const f32x4*)(nw + col);
            f16x4 o;
#pragma unroll
            for (int i = 0; i < 4; ++i) o[i] = (f16)(D[vt][i] * rs * w4[i] * siluf_((float)z4[i]));
            *(f16x4*)(MIX + (m * (unsigned)DM + 384u + col) * 2u) = o; }
    }
    {
        const char* CA = (const char*)(a.ws + WS_CA); const float* LH = (const float*)(a.ws + WS_LH) + ((size_t)b * NCH + c) * 256;
#pragma unroll
        for (int q = 0; q < 4; ++q) { const unsigned ch0 = (unsigned)(128 * hg + 32 * fq + 8 * q);
            const f16x8 hl = *(const f16x8*)(MIX + (m * (unsigned)DM + 768u + ch0) * 2u), ca = *(const f16x8*)(CA + (m * 256u + ch0) * 2u), z8 = *(const f16x8*)(U + uo + ((unsigned)C_LRUZ + ch0) * 2u);
            const f32x4 c0 = *(const f32x4*)(LH + ch0), c1 = *(const f32x4*)(LH + ch0 + 4);
            f16x8 o;
#pragma unroll
            for (int i = 0; i < 8; ++i) o[i] = (f16)(((float)hl[i] + (float)ca[i] * (i < 4 ? c0[i & 3] : c1[i & 3])) * siluf_((float)z8[i]));
            *(f16x8*)(MIX + (m * (unsigned)DM + 768u + ch0) * 2u) = o; }
    }
}
#define XB_TMO      128
#define XB_XCNT(j)  (256  + 64 * (j))
#define XB_XSUB(j)  (1280 + 64 * (j))
#define XB_XGEN(j)  (2304 + 64 * (j))
#define XB_TOP      3328
#define XB_TOPGEN   3392
#define XCD_BAR_WORDS 3456
#define XB_SPIN_CAP (1u << 18)

__device__ __forceinline__ unsigned xb_ld(unsigned* p)              { return __hip_atomic_load(p, __ATOMIC_RELAXED, __HIP_MEMORY_SCOPE_AGENT); }
__device__ __forceinline__ unsigned xb_add(unsigned* p, unsigned v) { return __hip_atomic_fetch_add(p, v, __ATOMIC_RELAXED, __HIP_MEMORY_SCOPE_AGENT); }
__device__ __forceinline__ unsigned xb_xcc_id() { return (unsigned)__builtin_amdgcn_s_getreg((3 << 11) | 20) & 0xFu; }
#define XB_SPIN(cond, bar) do { unsigned _sp = 0; while (cond) { __builtin_amdgcn_s_sleep(1); \
    if ((++_sp & 255u) == 0u) { if (xb_ld(&(bar)[XB_TMO])) break; if (_sp > XB_SPIN_CAP) { atomicAdd(&(bar)[XB_TMO], 1u); break; } } } } while (0)

struct XcdBarrier {
    unsigned* bar; unsigned x; int isw0;
    volatile LAS unsigned* st;
};

__device__ __forceinline__ XcdBarrier xcd_barrier_post(unsigned* bar, volatile LAS unsigned* st, int isw0) {
    XcdBarrier b; b.bar = bar; b.x = xb_xcc_id(); b.st = st; b.isw0 = isw0;
    if (isw0 && lane_now() == 0) (void)xb_add(&bar[XB_XCNT(b.x)], 1u);
    return b;
}
__device__ __forceinline__ void xcd_barrier_complete(unsigned* bar, unsigned x, unsigned& nloc, unsigned& nx) {
    const unsigned G = gridDim.x * gridDim.y * gridDim.z;
    unsigned sum, cnt, mine, sp = 0u;
    for (;;) {
        sum = 0u; cnt = 0u; mine = 0u;
#pragma unroll
        for (unsigned j = 0; j < 16; ++j) { const unsigned c = xb_ld(&bar[XB_XCNT(j)]); sum += c; cnt += (c > 0u) ? 1u : 0u; mine = (j == x) ? c : mine; }
        if (sum == G) break;
        __builtin_amdgcn_s_sleep(1);
        if ((++sp & 255u) == 0u) { if (xb_ld(&bar[XB_TMO])) break; if (sp > XB_SPIN_CAP) { atomicAdd(&bar[XB_TMO], 1u); break; } }
    }
    nloc = mine > 0u ? mine : 1u; nx = cnt > 0u ? cnt : 1u;
}

__device__ __forceinline__ void xcd_barrier(const XcdBarrier& b) {
    asm volatile("s_waitcnt vmcnt(0)" ::: "memory");
    __syncthreads();
    if (b.isw0 && lane_now() == 0) {
        unsigned* bar = b.bar;
        __builtin_amdgcn_s_waitcnt(0);
        unsigned nloc = b.st[0], nx = b.st[1];
        if (nloc == 0u) { xcd_barrier_complete(bar, b.x, nloc, nx); b.st[0] = nloc; b.st[1] = nx; }
        const unsigned old = xb_add(&bar[XB_XSUB(b.x)], 1u);
        const unsigned gen = old / nloc;
        if (old + 1u == (gen + 1u) * nloc) {
            __builtin_amdgcn_fence(__ATOMIC_RELEASE, "agent");
            asm volatile("s_waitcnt vmcnt(0)" ::: "memory");
            const unsigned og = xb_add(&bar[XB_TOP], 1u);
            const unsigned tg = og / nx;
            if (og + 1u == (tg + 1u) * nx) xb_add(&bar[XB_TOPGEN], 1u);
            else XB_SPIN(xb_ld(&bar[XB_TOPGEN]) == tg, bar);
            __builtin_amdgcn_fence(__ATOMIC_ACQUIRE, "agent");
            xb_add(&bar[XB_XGEN(b.x)], 1u);
            asm volatile("s_waitcnt vmcnt(0)" ::: "memory");
        } else {
            XB_SPIN(xb_ld(&bar[XB_XGEN(b.x)]) == gen, bar);
            __builtin_amdgcn_fence(__ATOMIC_ACQUIRE, "agent");
            asm volatile("s_waitcnt vmcnt(0)" ::: "memory");
        }
    }
    __syncthreads();
}

constexpr size_t WS_BAR = 16384;
constexpr size_t WS_PCNT = 32768;
constexpr int MISC_OFF = LDS_BYTES - 16;
__global__ void __launch_bounds__(NT, 2) fwd(Args args) {
    extern __shared__ __attribute__((aligned(16))) unsigned char lds_raw[];
    LAS unsigned char* lds = (LAS unsigned char*)lds_raw;
    cg::grid_group grid = cg::this_grid();
    const int wave = __builtin_amdgcn_readfirstlane((int)threadIdx.x >> 6);
#define TID_NOW() (wave * 64 + lane_now())
    const int tid = TID_NOW(); const int lane = tid & 63;
    if (wave == 0 && lane < 4) ((LAS unsigned*)(lds + MISC_OFF))[lane] = 0u;
    __syncthreads();
    XcdBarrier xbar = xcd_barrier_post((unsigned*)(args.ws + WS_BAR), (volatile LAS unsigned*)(lds + MISC_OFF), __builtin_amdgcn_readfirstlane(wave == 0 ? 1 : 0));
#define GRID_BAR() do { XcdBarrier xb_ = xbar; xb_.st = (volatile LAS unsigned*)(lds + MISC_OFF); asm volatile("" : "+s"(xb_.bar), "+s"(xb_.x)); xcd_barrier(xb_); } while (0)
    const int G = gridDim.x, gw = blockIdx.x * NWAVES + wave, NGW = G * NWAVES;
    unsigned char* ws = args.ws;
    unsigned short* XN = (unsigned short*)(ws + WS_XN);
    {
        LAS float* scr = (LAS float*)(lds + wave * 8704);
        constexpr int I_IN = (DM / 64) * (NIN / 32), I_OUT = (DM / 64) * (DM / 32), NITEMS = DEPTH * (I_IN + I_OUT);
        for (int it = gw; it < NITEMS; it += NGW) {
            int r = it; const int l = r / (I_IN + I_OUT); r -= l * (I_IN + I_OUT);
            if (r < I_IN) p0_transpose_item(args.in[2] + (size_t)l * DM * NIN, DM, NIN, (unsigned short*)(ws + WS_WIN + l * WIN_L), scr, r, lane, l == 0 ? nullptr : args.in[1] + DM);
            else p0_transpose_item(args.in[25] + (size_t)l * DM * DM, DM, DM, (unsigned short*)(ws + WS_WOUT + l * WOUT_L), scr, r - I_IN, lane, nullptr);
        }
        for (int i = gw; i < DEPTH * (NU - NIN) * DM * 2 / 1024; i += NGW) { const int l = i / ((NU - NIN) * DM * 2 / 1024), r = i % ((NU - NIN) * DM * 2 / 1024);
            if (l == 1 && r < 64 * DM * 2 / 1024) continue;
            *(u32x4*)(ws + WS_WIN + l * WIN_L + (size_t)NIN * DM * 2 + (size_t)r * 1024 + lane * 16) = (u32x4){0u, 0u, 0u, 0u}; }
        if (blockIdx.x < 32) {
            LAS f16* TT = (LAS f16*)(lds + 8 * 8704);
            for (int i = tid; i < 64 * RW_W; i += NT) { const int n = i / RW_W, cc = i % RW_W; const float mm = args.in[3][RW_SHIFT + C_V + cc]; TT[n * 392 + cc] = (f16)(((n < 32) ? (1.0f - mm) : mm) * args.in[9][cc * 32 + (n & 31)]); }
            __syncthreads();
            const int tile = blockIdx.x * NWAVES + wave, nt = tile & 3, kt = tile >> 2, tl = lane & 15, fq = lane >> 4;
            const float* wrow = args.in[2] + (size_t)DM * NIN + (size_t)(16 * kt + tl) * NIN + C_V + 8 * fq;
            f32x4 bv[12][2];
#pragma unroll
            for (int s2 = 0; s2 < 12; ++s2) { bv[s2][0] = *(const f32x4*)(wrow + 32 * s2); bv[s2][1] = *(const f32x4*)(wrow + 32 * s2 + 4); }
            f32x4 d = (f32x4){0.f, 0.f, 0.f, 0.f};
#pragma unroll
            for (int s2 = 0; s2 < 12; ++s2) { f16x8 bf;
#pragma unroll
                for (int j = 0; j < 8; ++j) bf[j] = (f16)(j < 4 ? bv[s2][0][j & 3] : bv[s2][1][j & 3]);
                d = __builtin_amdgcn_mfma_f32_16x16x32_f16(*(const LAS f16x8*)(TT + (16 * nt + tl) * 392 + 8 * fq + 32 * s2), bf, d, 0, 0, 0); }
            const float nwk = args.in[1][DM + 16 * kt + tl];
#pragma unroll
            for (int i = 0; i < 4; ++i) ((f16*)(ws + WS_WIN + WIN_L))[(size_t)(NIN + 16 * nt + 4 * fq + i) * DM + 16 * kt + tl] = (f16)(d[i] * nwk);
            __syncthreads();
        }
        for (int i = blockIdx.x * NT + tid; i < 2 * M; i += G * NT) ((float*)(ws + WS_RSS))[i] = 0.f;
        for (int m = gw; m < M; m += 4 * NGW) rms_row4_f16(args.in[0] + (size_t)m * DM, (size_t)NGW * DM, args.in[1], XN + (size_t)m * DM, lane);
        { f16* WUPT = (f16*)(ws + WS_WUPT); f16* AUPT = (f16*)(ws + WS_AUPT); f16* VDNT = (f16*)(ws + WS_VDNT); f16* VUPT = (f16*)(ws + WS_VUPT);
          for (int i = blockIdx.x * NT + tid; i < 122880; i += G * NT) {
              if (i < 49152) { const int ll = i / 24576, r = i % 24576, n = r / 64, k = r % 64; WUPT[i] = (f16)args.in[5][(size_t)ll * 24576 + k * 384 + n]; }
              else if (i < 98304) { const int i2 = i - 49152, ll = i2 / 24576, r = i2 % 24576, n = r / 64, k = r % 64; AUPT[i2] = (f16)args.in[7][(size_t)ll * 24576 + k * 384 + n]; }
              else if (i < 110592) { const int i2 = i - 98304, j2 = i2 / 384, cc = i2 % 384; VDNT[i2] = (f16)args.in[9][cc * 32 + j2]; }
              else { const int i2 = i - 110592, n = i2 / 32, j2 = i2 % 32; VUPT[i2] = (f16)args.in[10][j2 * 384 + n]; } }
          f16* WAT = (f16*)(ws + WS_WAT); f16* WXT = (f16*)(ws + WS_WXT);
          for (int i = blockIdx.x * NT + tid; i < 32768; i += G * NT) { const int lg = i >> 12, r = i & 4095, j = r >> 6, ii = r & 63; WAT[i] = (f16)args.in[20][(size_t)lg * 4096 + ii * 64 + j]; WXT[i] = (f16)args.in[22][(size_t)lg * 4096 + ii * 64 + j]; } }
    }
    if (gridDim.x > 65536u) grid.sync();
    GRID_BAR();
#pragma unroll 1
    for (int l = 0; l < DEPTH; ++l) {
        { pg8::Gemm g{XN, (const unsigned short*)(ws + WS_WIN + l * WIN_L), M, NU, DM}; pg8::StaticOrder S; S.init(M, NU, G, (int)blockIdx.x);
          pg8::EpiF16 E{(unsigned short*)(ws + WS_U), NU, l == 0 ? nullptr : (const float*)(ws + WS_RSS)};
          pg8::gemm_phase<pg8::EpiF16, pg8::StaticOrder, true, true>(lds, g, S, E, wave); }
        GRID_BAR();
        for (int task = blockIdx.x; task < BATCH * NCH; task += G) phaseA(args, l, task, lds, TID_NOW());
        GRID_BAR();
        phaseB1(args, lds, TID_NOW());
        GRID_BAR();
        phaseB(args, lds, TID_NOW());
        GRID_BAR();
        phaseB3(args, lds, TID_NOW());
        GRID_BAR();
        for (int task = blockIdx.x; task < BATCH * NCH; task += G) phaseC(args, l, task, lds, TID_NOW());
        GRID_BAR();
        { pg8::Gemm g{(const unsigned short*)(ws + WS_MIX), (const unsigned short*)(ws + WS_WOUT + l * WOUT_L), M, DM, DM}; pg8::StaticOrder S; S.init(M, DM, G, (int)blockIdx.x);
          if (l + 1 < DEPTH) {
              pg8::EpiRes E{args.in[0], args.out, DM, XN, (float*)(ws + WS_RSS)};
              pg8::gemm_phase<pg8::EpiRes, pg8::StaticOrder, true, true>(lds, g, S, E, wave);
              GRID_BAR();
          } else {
              pg8::EpiResNorm E{args.out, args.out, DM, (float*)(ws + WS_RSS) + M, (unsigned*)(ws + WS_PCNT), args.in[26]};
              pg8::gemm_phase<pg8::EpiResNorm, pg8::StaticOrder, true, true>(lds, g, S, E, wave);
          } }
    }
}

extern "C" void kernel_launch(void* const* d_in, const int* in_sizes, int n_in, void* d_out, int out_size, void* d_ws, size_t ws_size, hipStream_t stream) {
    static int grid = 0;
    if (grid == 0) {
        if (n_in != 27 || in_sizes[0] != M * DM || out_size != M * DM || ws_size < WS_END) { fprintf(stderr, "kernel_launch: unexpected problem: n_in %d in0 %d out %d ws %zu\n", n_in, n_in > 0 ? in_sizes[0] : -1, out_size, ws_size); grid = -1; return; }
        int dev = 0, cus = 0, per_cu = 0;
        hipGetDevice(&dev); hipDeviceGetAttribute(&cus, hipDeviceAttributeMultiprocessorCount, dev);
        if (hipFuncSetAttribute((const void*)fwd, hipFuncAttributeMaxDynamicSharedMemorySize, LDS_BYTES) != hipSuccess) { fprintf(stderr, "kernel_launch: hipFuncSetAttribute failed\n"); grid = -1; return; }
        if (hipOccupancyMaxActiveBlocksPerMultiprocessor(&per_cu, (const void*)fwd, NT, LDS_BYTES) != hipSuccess || per_cu < 1) { fprintf(stderr, "kernel_launch: occupancy query failed (%d)\n", per_cu); grid = -1; return; }
        grid = cus * per_cu;
    }
    if (grid < 0) return;
    if (hipMemsetAsync((char*)d_ws, 0, 65536, stream) != hipSuccess) { fprintf(stderr, "kernel_launch: memset of the barrier words failed\n"); return; }
    Args a{};
    for (int i = 0; i < 27; ++i) a.in[i] = (const float*)d_in[i];
    a.out = (float*)d_out; a.ws = (unsigned char*)d_ws;
    void* kargs[] = {&a};
    hipError_t e = hipLaunchCooperativeKernel((const void*)fwd, dim3(grid), dim3(NT), kargs, LDS_BYTES, stream);
    if (e != hipSuccess) fprintf(stderr, "cooperative launch failed: %s (grid %d)\n", hipGetErrorString(e), grid);
}
```

```cpp
#include <hip/hip_runtime.h>
#include <hip/hip_cooperative_groups.h>
#include <cstdio>
#include <cstdint>
namespace cg = cooperative_groups;
typedef _Float16 f16x8_t __attribute__((ext_vector_type(8)));
#define MK_MFMA(a, b, c) __builtin_amdgcn_mfma_f32_16x16x32_f16(__builtin_bit_cast(f16x8_t, (a)), __builtin_bit_cast(f16x8_t, (b)), (c), 0, 0, 0)
__device__ __forceinline__ int lane_now() { int z; asm volatile("v_mbcnt_lo_u32_b32 %0, -1, 0\n\tv_mbcnt_hi_u32_b32 %0, -1, %0" : "=v"(z)); return z; }
__device__ __forceinline__ float shfl_xor_f(float v, int mask) { const int ln = lane_now(); return __builtin_bit_cast(float, __builtin_amdgcn_ds_bpermute((ln ^ mask) << 2, __builtin_bit_cast(int, v))); }
namespace pg8 {
#define PG8_LAS __attribute__((address_space(3)))
typedef unsigned short bf16_t;
typedef short bf16x8 __attribute__((ext_vector_type(8)));
typedef float f32x4 __attribute__((ext_vector_type(4)));
typedef unsigned u32x4 __attribute__((ext_vector_type(4)));
constexpr int BM = 256, BK = 64, HALF = 128, HTB = HALF * BK * 2  , STAGE_BYTES = 8 * HTB, NXCD = 8, WGM = 4;

__host__ __device__ __forceinline__ int lds_byte(int r, int c) { const int st = (r >> 4) * 2 + (c >> 5), rr = r & 15, cc = c & 31, ob = rr * 64 + cc * 2; return st * 1024 + (ob ^ (((ob >> 9) & 1) << 5)); }
__host__ __device__ __forceinline__ void stage_rc(int b, int& R, int& C) { const int st = b / 1024, sb = b % 1024, swz = sb ^ (((sb >> 9) & 1) << 5); R = (st >> 1) * 16 + swz / 64; C = (st & 1) * 32 + (swz % 64) / 2; }
__host__ __device__ __forceinline__ int perm32(int rho) { const int n = rho >> 4, i = rho & 15; return 8 * (i >> 2) + 4 * n + (i & 3); }

struct Unit { int pm, pn; };
struct Gemm { const bf16_t* A; const bf16_t* Bt; int M, N, K; };

struct StaticOrder {
    int nM, nN, nwg, G, c;
    __host__ __device__ void init(int M, int N, int G_, int c_) { nM = M / BM; nN = N / BM; nwg = nM * nN; G = G_; c = c_; }
    __host__ __device__ bool next(int i, Unit& u) const {
        const long L = (long)i * G + c; if (L >= nwg) return false;
        int wgid = (int)L; { const int q = nwg / NXCD, r = nwg % NXCD, xcd = wgid % NXCD, off = wgid / NXCD; wgid = (xcd < r ? xcd * (q + 1) : r * (q + 1) + (xcd - r) * q) + off; }
        const int nig = WGM * nN, gid = wgid / nig, fm = gid * WGM, gsz = (nM - fm) < WGM ? (nM - fm) : WGM;
        u.pm = fm + ((wgid % nig) % gsz); u.pn = (wgid % nig) / gsz; return true;
    }
    __device__ __forceinline__ void a_ready(const Unit&) const {}
    __device__ __forceinline__ void done(const Unit&) const {}
};

__device__ __forceinline__ unsigned pk_f16(float lo, float hi) { typedef _Float16 h2 __attribute__((ext_vector_type(2))); h2 v; v.x = (_Float16)lo; v.y = (_Float16)hi; return __builtin_bit_cast(unsigned, v); }
typedef unsigned u32x2 __attribute__((ext_vector_type(2)));
struct EpiF16 {
    static constexpr bool PERM = true, AFTER_DRAIN = false;
    bf16_t* O; int ldc; const float* rss;
    __device__ __forceinline__ void operator()(const f32x4 (&acc)[2][2][4][2], const Unit& u, int wr, int wc, int fr, int fq) const {
        const int row0 = u.pm * BM + wr * 64 + fr; const int col0 = u.pn * BM + wc * 32 + 8 * fq;
#pragma unroll
        for (int ai = 0; ai < 2; ++ai)
#pragma unroll
            for (int m = 0; m < 4; ++m) { const int row = row0 + ai * HALF + m * 16; bf16_t* rowp = O + (size_t)row * ldc + col0;
                const float sc = rss ? 1.0f / sqrtf(rss[row] * (1.0f / 1024.0f) + 1e-6f) : 1.0f;
#pragma unroll
                for (int bj = 0; bj < 2; ++bj) { const f32x4 v0 = acc[ai][bj][m][0] * sc, v1 = acc[ai][bj][m][1] * sc;
                    u32x4 w; w.x = pk_f16(v0[0], v0[1]); w.y = pk_f16(v0[2], v0[3]); w.z = pk_f16(v1[0], v1[1]); w.w = pk_f16(v1[2], v1[3]);
                    *(u32x4*)(rowp + bj * HALF) = w; } }
    }
};
struct EpiRes {
    static constexpr bool PERM = true, AFTER_DRAIN = false;
    const float* base; float* out; int ldc; bf16_t* xh; float* rss;
    __device__ __forceinline__ void operator()(const f32x4 (&acc)[2][2][4][2], const Unit& u, int wr, int wc, int fr, int fq) const {
        const int row0 = u.pm * BM + wr * 64 + fr; const int col0 = u.pn * BM + wc * 32 + 8 * fq;
#pragma unroll
        for (int ai = 0; ai < 2; ++ai)
#pragma unroll
            for (int m = 0; m < 4; ++m) { const size_t off = (size_t)(row0 + ai * HALF + m * 16) * ldc + col0; float ss = 0.f;
#pragma unroll
                for (int bj = 0; bj < 2; ++bj) { const size_t o = off + bj * HALF;
                    const f32x4 x0 = *(const f32x4*)(base + o) + acc[ai][bj][m][0], x1 = *(const f32x4*)(base + o + 4) + acc[ai][bj][m][1];
                    if (out) { *(f32x4*)(out + o) = x0; *(f32x4*)(out + o + 4) = x1; }
                    if (xh) { u32x4 h; h.x = pk_f16(x0[0], x0[1]); h.y = pk_f16(x0[2], x0[3]); h.z = pk_f16(x1[0], x1[1]); h.w = pk_f16(x1[2], x1[3]); *(u32x4*)(xh + o) = h;
                        ss += ((x0[0] * x0[0] + x0[1] * x0[1]) + (x0[2] * x0[2] + x0[3] * x0[3])) + ((x1[0] * x1[0] + x1[1] * x1[1]) + (x1[2] * x1[2] + x1[3] * x1[3])); } }
                if (xh) { ss += shfl_xor_f(ss, 16); ss += shfl_xor_f(ss, 32); if (fq == 0) atomicAdd(rss + row0 + ai * HALF + m * 16, ss); }
                asm volatile("" ::: "memory"); }
    }
};

struct EpiResNorm {
    static constexpr bool PERM = true, AFTER_DRAIN = false;
    const unsigned short* baseh; float* out; int ldc; float* rss2; unsigned* cnt; const float* w; unsigned total;
    __device__ __forceinline__ void operator()(f32x4 (&acc)[2][2][4][2], const Unit& u, int wr, int wc, int fr, int fq) const {
        const int row0 = u.pm * BM + wr * 64 + fr; const int col0 = u.pn * BM + wc * 32 + 8 * fq;
#pragma unroll
        for (int ai = 0; ai < 2; ++ai)
#pragma unroll
            for (int m = 0; m < 4; ++m) { const size_t off = (size_t)(row0 + ai * HALF + m * 16) * ldc + col0; float ss = 0.f;
#pragma unroll
                for (int bj = 0; bj < 2; ++bj) { const size_t o = off + bj * HALF; typedef _Float16 h8 __attribute__((ext_vector_type(8))); const h8 bh = *(const h8*)(baseh + o);
                    const f32x4 x0 = (f32x4){(float)bh[0], (float)bh[1], (float)bh[2], (float)bh[3]} + acc[ai][bj][m][0], x1 = (f32x4){(float)bh[4], (float)bh[5], (float)bh[6], (float)bh[7]} + acc[ai][bj][m][1];
                    acc[ai][bj][m][0] = x0; acc[ai][bj][m][1] = x1;
                    ss += ((x0[0] * x0[0] + x0[1] * x0[1]) + (x0[2] * x0[2] + x0[3] * x0[3])) + ((x1[0] * x1[0] + x1[1] * x1[1]) + (x1[2] * x1[2] + x1[3] * x1[3])); }
                ss += shfl_xor_f(ss, 16); ss += shfl_xor_f(ss, 32); if (fq == 0) atomicAdd(rss2 + row0 + ai * HALF + m * 16, ss);
                asm volatile("" ::: "memory"); }
        asm volatile("s_waitcnt vmcnt(0)" ::: "memory");
        unsigned* pc = cnt + 64 * u.pm;
        if (lane_now() == 0) __hip_atomic_fetch_add(pc, 1u, __ATOMIC_RELAXED, __HIP_MEMORY_SCOPE_AGENT);
#define EPI_WAIT(P) for (unsigned spin = 0; spin < (1u << 22); ++spin) { if ((unsigned)__builtin_amdgcn_readfirstlane((int)__hip_atomic_load((P), __ATOMIC_RELAXED, __HIP_MEMORY_SCOPE_AGENT)) >= 32u) break; __builtin_amdgcn_s_sleep(2); }
        EPI_WAIT(pc)
        if (u.pm >= 32) { unsigned* p2 = cnt + 64 * (2 * (u.pm - 32)); EPI_WAIT(p2) EPI_WAIT(p2 + 64) }
#undef EPI_WAIT
#pragma unroll
        for (int ai = 0; ai < 2; ++ai)
#pragma unroll
            for (int m = 0; m < 4; ++m) { const int row = row0 + ai * HALF + m * 16; const size_t off = (size_t)row * ldc + col0;
                const float rs = 1.0f / sqrtf(__hip_atomic_load(rss2 + row, __ATOMIC_RELAXED, __HIP_MEMORY_SCOPE_AGENT) * (1.0f / 1024.0f) + 1e-6f);
#pragma unroll
                for (int bj = 0; bj < 2; ++bj) { const size_t o = off + bj * HALF; const f32x4 w0 = *(const f32x4*)(w + col0 + bj * HALF), w1 = *(const f32x4*)(w + col0 + bj * HALF + 4);
                    *(f32x4*)(out + o) = acc[ai][bj][m][0] * rs * w0; *(f32x4*)(out + o + 4) = acc[ai][bj][m][1] * rs * w1; } }
    }
};

template <class Epi, class Sched, bool ALIGN_EPI = false, bool SP2 = false>
__device__ __forceinline__ void gemm_phase(PG8_LAS unsigned char* lds, const Gemm g, const Sched& S, const Epi& E, const int wave_) {
    int wv_ = wave_; asm volatile("" : "+s"(wv_)); int tid_ = lane_now() + 64 * wv_; const int tid = tid_, wid = wv_, lane = tid & 63, wr = wid >> 2, wc = wid & 3, fr = lane & 15, fq = lane >> 4;
    const int K = g.K, nt = K / BK;
    unsigned voffA[2], voffB[2];
#pragma unroll
    for (int i = 0; i < 2; ++i) { int R, C; stage_rc(tid * 16 + i * 8192, R, C); const int Rb = Epi::PERM ? ((R & ~31) + perm32(R & 31)) : R;
        voffA[i] = (unsigned)(R * K + C) * 2u; voffB[i] = (unsigned)(Rb * K + C) * 2u; }
    const size_t kstep = (size_t)(BK * 2);
    const size_t hstep = (size_t)HALF * K * 2;
    const size_t tstep = 2 * hstep;
    const unsigned ldsw = (unsigned)wid * 1024u;
    const int aoff = lds_byte(wr * 64 + fr, fq * 8), boff = lds_byte(wc * 32 + fr, fq * 8);
#define PG8_SA(b, h) (((b) * 2 + (h)) * HTB)
#define PG8_SB(b, h) ((4 + (b) * 2 + (h)) * HTB)
#define PG8_STAGE(bufoff, gbase, voff) do { _Pragma("unroll") for (int _i = 0; _i < 2; ++_i) \
        __builtin_amdgcn_global_load_lds((const unsigned*)((const char*)(gbase) + (voff)[_i]), (PG8_LAS unsigned*)(lds + (bufoff) + ldsw + _i * 8192), 16, 0, 0); } while (0)
#define PG8_LDA(dst, b, h) do { _Pragma("unroll") for (int m = 0; m < 4; ++m) _Pragma("unroll") for (int k = 0; k < 2; ++k) dst[m][k] = *(const PG8_LAS bf16x8*)(lds + PG8_SA(b, h) + aoff + m * 2048 + k * 1024); } while (0)
#define PG8_LDB(dst, b, h) do { _Pragma("unroll") for (int n = 0; n < 2; ++n) _Pragma("unroll") for (int k = 0; k < 2; ++k) dst[n][k] = *(const PG8_LAS bf16x8*)(lds + PG8_SB(b, h) + boff + n * 2048 + k * 1024); } while (0)
#define PG8_MMA(ai, bj, At, Bt) do { __builtin_amdgcn_s_setprio(1); _Pragma("unroll") for (int m = 0; m < 4; ++m) _Pragma("unroll") for (int n = 0; n < 2; ++n) _Pragma("unroll") for (int k = 0; k < 2; ++k) \
        acc[ai][bj][m][n] = MK_MFMA(Bt[n][k], At[m][k], acc[ai][bj][m][n]); __builtin_amdgcn_s_setprio(0); } while (0)
#define PG8_WAIT_V(n) asm volatile("s_waitcnt vmcnt(" #n ")" ::: "memory")
#define PG8_WAIT_L(n) asm volatile("s_waitcnt lgkmcnt(" #n ")" ::: "memory")
#define PG8_BAR __builtin_amdgcn_s_barrier()
#define PG8_SCHED __builtin_amdgcn_sched_barrier(0)
    Unit cur, nxt; int ui = 0;
    if (!S.next(0, cur)) return;
    f32x4 acc[2][2][4][2];
#pragma unroll
    for (int a = 0; a < 2; ++a)
#pragma unroll
        for (int b = 0; b < 2; ++b)
#pragma unroll
            for (int m = 0; m < 4; ++m)
#pragma unroll
                for (int n = 0; n < 2; ++n) acc[a][b][m][n] = (f32x4){0.f, 0.f, 0.f, 0.f};
    bf16x8 At[4][2], B0[2][2], B1[2][2];
    const char* cA = (const char*)g.A + (size_t)cur.pm * tstep; const char* cB = (const char*)g.Bt + (size_t)cur.pn * tstep;
    S.a_ready(cur);
    if constexpr (SP2) {
        PG8_STAGE(PG8_SB(0, 0), cB, voffB); PG8_STAGE(PG8_SB(0, 1), cB + hstep, voffB); PG8_STAGE(PG8_SA(0, 0), cA, voffA); PG8_STAGE(PG8_SA(0, 1), cA + hstep, voffA);
        if (wr == 1) PG8_BAR;
        PG8_WAIT_V(2); PG8_BAR;
        PG8_STAGE(PG8_SB(1, 0), cB + kstep, voffB); PG8_STAGE(PG8_SA(1, 0), cA + kstep, voffA); PG8_STAGE(PG8_SB(1, 1), cB + hstep + kstep, voffB);
        PG8_WAIT_V(6); PG8_BAR;
    } else {
        PG8_STAGE(PG8_SB(0, 0), cB, voffB); PG8_STAGE(PG8_SA(0, 0), cA, voffA); PG8_STAGE(PG8_SB(0, 1), cB + hstep, voffB); PG8_STAGE(PG8_SA(0, 1), cA + hstep, voffA);
        if (wr == 1) PG8_BAR;
        PG8_WAIT_V(4); PG8_BAR;
        PG8_STAGE(PG8_SB(1, 0), cB + kstep, voffB); PG8_STAGE(PG8_SA(1, 0), cA + kstep, voffA); PG8_STAGE(PG8_SB(1, 1), cB + hstep + kstep, voffB);
        PG8_WAIT_V(6); PG8_BAR;
    }
    for (;;) {
        const bool has_next = S.next(ui + 1, nxt);
        const char* nA = has_next ? (const char*)g.A + (size_t)nxt.pm * tstep : cA; const char* nB = has_next ? (const char*)g.Bt + (size_t)nxt.pn * tstep : cB;
        for (int t = 0; t < nt; t += 2) {
            const bool last = (t == nt - 2);
            const char* a1 = cA + (size_t)(t + 1) * kstep;
            const char* a2 = last ? nA : cA + (size_t)(t + 2) * kstep; const char* b2 = last ? nB : cB + (size_t)(t + 2) * kstep;
            const char* a3 = a2 + kstep; const char* b3 = b2 + kstep;
            if (last && has_next) S.a_ready(nxt);
            if constexpr (SP2) {
            PG8_LDB(B0, 0, 0); PG8_LDB(B1, 0, 1); PG8_SCHED; PG8_LDA(At, 0, 0); PG8_STAGE(PG8_SA(1, 1), a1 + hstep, voffA);
            PG8_WAIT_V(8); PG8_WAIT_L(0); PG8_BAR; PG8_MMA(0, 0, At, B0); PG8_MMA(0, 1, At, B1); PG8_BAR; PG8_SCHED;
            PG8_LDA(At, 0, 1); PG8_STAGE(PG8_SB(0, 0), b2, voffB); PG8_STAGE(PG8_SB(0, 1), b2 + hstep, voffB); PG8_STAGE(PG8_SA(0, 0), a2, voffA);
            PG8_WAIT_V(8); PG8_WAIT_L(0); PG8_BAR; PG8_MMA(1, 0, At, B0); PG8_MMA(1, 1, At, B1); PG8_BAR; PG8_SCHED;
            PG8_LDB(B0, 1, 0); PG8_LDB(B1, 1, 1); PG8_SCHED; PG8_LDA(At, 1, 0); PG8_STAGE(PG8_SA(0, 1), a2 + hstep, voffA);
            PG8_WAIT_V(8); PG8_WAIT_L(0); PG8_BAR; PG8_MMA(0, 0, At, B0); PG8_MMA(0, 1, At, B1); PG8_BAR; PG8_SCHED;
            PG8_LDA(At, 1, 1); PG8_STAGE(PG8_SB(1, 0), b3, voffB); PG8_STAGE(PG8_SB(1, 1), b3 + hstep, voffB); PG8_STAGE(PG8_SA(1, 0), a3, voffA);
            PG8_WAIT_V(8); PG8_WAIT_L(0); PG8_BAR; PG8_MMA(1, 0, At, B0); PG8_MMA(1, 1, At, B1); PG8_BAR; PG8_SCHED;
            } else {
            PG8_LDB(B0, 0, 0); PG8_SCHED; PG8_LDA(At, 0, 0); PG8_STAGE(PG8_SA(1, 1), a1 + hstep, voffA);
            PG8_WAIT_L(8); PG8_BAR; PG8_WAIT_L(0); PG8_MMA(0, 0, At, B0); PG8_BAR; PG8_SCHED;
            PG8_LDB(B1, 0, 1); PG8_STAGE(PG8_SB(0, 0), b2, voffB);
            PG8_BAR; PG8_WAIT_L(0); PG8_MMA(0, 1, At, B1); PG8_BAR;
            PG8_LDA(At, 0, 1); PG8_STAGE(PG8_SA(0, 0), a2, voffA);
            PG8_BAR; PG8_WAIT_L(0); PG8_MMA(1, 0, At, B0); PG8_BAR; PG8_SCHED;
            PG8_STAGE(PG8_SB(0, 1), b2 + hstep, voffB);
            PG8_WAIT_V(6); PG8_BAR; PG8_MMA(1, 1, At, B1); PG8_BAR;
            PG8_LDB(B0, 1, 0); PG8_SCHED; PG8_LDA(At, 1, 0); PG8_STAGE(PG8_SA(0, 1), a2 + hstep, voffA);
            PG8_WAIT_L(8); PG8_BAR; PG8_WAIT_L(0); PG8_MMA(0, 0, At, B0); PG8_BAR; PG8_SCHED;
            PG8_LDB(B1, 1, 1); PG8_STAGE(PG8_SB(1, 0), b3, voffB);
            PG8_BAR; PG8_WAIT_L(0); PG8_MMA(0, 1, At, B1); PG8_BAR;
            PG8_LDA(At, 1, 1); PG8_STAGE(PG8_SA(1, 0), a3, voffA);
            PG8_BAR; PG8_WAIT_L(0); PG8_MMA(1, 0, At, B0); PG8_BAR; PG8_SCHED;
            PG8_STAGE(PG8_SB(1, 1), b3 + hstep, voffB);
            PG8_WAIT_V(6); PG8_BAR; PG8_MMA(1, 1, At, B1); PG8_BAR;
            }
        }
        if constexpr (ALIGN_EPI) { if (wr == 0) PG8_BAR; }
        if constexpr (!Epi::AFTER_DRAIN) { E(acc, cur, wr, wc, fr, fq); S.done(cur); }
        if (!has_next) break;
#pragma unroll
        for (int a = 0; a < 2; ++a)
#pragma unroll
            for (int b = 0; b < 2; ++b)
#pragma unroll
                for (int m = 0; m < 4; ++m)
#pragma unroll
                    for (int n = 0; n < 2; ++n) acc[a][b][m][n] = (f32x4){0.f, 0.f, 0.f, 0.f};
        cur = nxt; cA = nA; cB = nB; ++ui;
        if constexpr (ALIGN_EPI) { if (wr == 1) PG8_BAR; }
    }
    PG8_WAIT_V(0);
    if constexpr (!ALIGN_EPI) { if (wr == 0) PG8_BAR; }
    PG8_BAR;
    if constexpr (Epi::AFTER_DRAIN) { E.fused(acc, cur, wr, wc, fr, fq, lds, wid, lane); S.done(cur); }
#undef PG8_SA
#undef PG8_SB
#undef PG8_STAGE
#undef PG8_LDA
#undef PG8_LDB
#undef PG8_MMA
#undef PG8_WAIT_V
#undef PG8_WAIT_L
#undef PG8_BAR
#undef PG8_SCHED
}
}

constexpr int BATCH = 2, SEQ = 8192, DM = 1024, DEPTH = 2, M = BATCH * SEQ;
constexpr int RW_H = 6, HD = 64, RW_W = 384, RW_SHIFT = 1280;
constexpr int NIN = 3712, NU = 3840;
constexpr int C_R = 0, C_K = 384, C_V = 768, C_WL = 1152, C_AL = 1216, C_RWZ = 1280, C_HGQ = 1664, C_HGF = 2048, C_HGI = 2432, C_HGZ = 2816, C_LRUX = 3200, C_LRUZ = 3456;
constexpr int CH = 64;
constexpr int NWAVES = 8, NT = NWAVES * 64;
constexpr int LDS_BYTES = 163840;
constexpr int PRM_OFF = 155008;
constexpr size_t MiB = 1u << 20;
constexpr size_t WS_WUPT = 65536, WS_AUPT = WS_WUPT + 98304, WS_VDNT = WS_AUPT + 98304, WS_VUPT = WS_VDNT + 24576, WS_WAT = WS_VUPT + 24576, WS_WXT = WS_WAT + 65536;
constexpr size_t WS_PRMT = 512 * 1024;
constexpr size_t WS_WIN = 1 * MiB, WIN_L = (size_t)NU * DM * 2;
constexpr size_t WS_WOUT = 16 * MiB, WOUT_L = (size_t)DM * DM * 2;
constexpr size_t WS_XN = 20 * MiB;
constexpr size_t WS_QT = 20 * MiB;
constexpr size_t WS_PT = 32 * MiB;
constexpr size_t WS_CA = 44 * MiB;
constexpr size_t WS_U = 52 * MiB;
constexpr size_t WS_MIX = 172 * MiB;
constexpr size_t WS_VF = 204 * MiB;
constexpr size_t WS_VP = 216 * MiB;
constexpr size_t WS_RL = 228 * MiB;
constexpr size_t WS_HL = 240 * MiB;
constexpr size_t WS_BON = 252 * MiB;
constexpr size_t WS_DC = WS_BON + 512 * 1024;
constexpr size_t WS_LA = WS_DC + 512 * 1024;
constexpr size_t WS_LH = WS_LA + 256 * 1024;
constexpr size_t WS_RSS = WS_LH + 256 * 1024;
constexpr size_t WS_END = 254 * MiB;
constexpr int NCH = SEQ / CH;

#define LAS __attribute__((address_space(3)))
typedef float f32x4 __attribute__((ext_vector_type(4)));
typedef unsigned u32x2 __attribute__((ext_vector_type(2)));
typedef unsigned u32x4 __attribute__((ext_vector_type(4)));
typedef _Float16 f16;
typedef _Float16 f16x8 __attribute__((ext_vector_type(8)));
#define LDS_WAIT() asm volatile("s_waitcnt lgkmcnt(0)" ::: "memory")

struct Args { const float* in[27]; float* out; unsigned char* ws; };

__device__ __forceinline__ float wave_sum(float v) {
#pragma unroll
    for (int o = 1; o < 64; o <<= 1) v += shfl_xor_f(v, o);
    return v;
}
__device__ __forceinline__ float sigmoidf_(float x) { return __builtin_amdgcn_rcpf(1.0f + __expf(-x)); }
__device__ __forceinline__ float rsq_(float x) { return __builtin_amdgcn_rsqf(x); }
__device__ __forceinline__ float one_minus_exp_(float x) { return (x > -0.03f) ? -x * (1.0f + x * (0.5f + x * (1.0f / 6.0f + x * (1.0f / 24.0f)))) : 1.0f - __expf(x); }
__device__ __forceinline__ float siluf_(float x) { return x * __builtin_amdgcn_rcpf(1.0f + __expf(-x)); }

__device__ __forceinline__ void p0_transpose_item(const float* W, int K, int N, unsigned short* WT, LAS float* scr, int item, int lane, const float* rsc) {
    const int nblk = N / 32, kb = item / nblk, nb = item % nblk, k0 = 64 * kb, n0 = 32 * nb;
    float tv[32];
#pragma unroll
    for (int i = 0; i < 32; ++i) { const int kk = 2 * i + (lane >> 5); tv[i] = W[(size_t)(k0 + kk) * N + n0 + (lane & 31)]; }
#pragma unroll
    for (int i = 0; i < 32; ++i) { const int kk = 2 * i + (lane >> 5); scr[kk * 33 + (lane & 31)] = tv[i] * (rsc ? rsc[k0 + kk] : 1.0f); }
    LDS_WAIT(); asm volatile("" ::: "memory");
    const int c = lane & 7;
#pragma unroll
    for (int j = 0; j < 4; ++j) { const int n = (lane >> 3) + 8 * j; const LAS float* s = scr + (8 * c) * 33 + n;
        u32x4 o; o.x = pg8::pk_f16(s[0 * 33], s[1 * 33]); o.y = pg8::pk_f16(s[2 * 33], s[3 * 33]); o.z = pg8::pk_f16(s[4 * 33], s[5 * 33]); o.w = pg8::pk_f16(s[6 * 33], s[7 * 33]);
        *(u32x4*)(WT + (size_t)(n0 + n) * K + k0 + 8 * c) = o; }
    LDS_WAIT(); asm volatile("" ::: "memory");
}
__device__ __forceinline__ void rms_row_f16(const float* xrow, const float* w, unsigned short* orow, int lane) {
    const f32x4* xr = (const f32x4*)xrow + lane; const f32x4* wr = (const f32x4*)w + lane;
    f32x4 v[4]; float s = 0.f;
#pragma unroll
    for (int j = 0; j < 4; ++j) { v[j] = xr[64 * j]; s += (v[j].x * v[j].x + v[j].y * v[j].y) + (v[j].z * v[j].z + v[j].w * v[j].w); }
    const float rs = 1.0f / sqrtf(wave_sum(s) * (1.0f / DM) + 1e-6f);
    u32x2* o8 = (u32x2*)orow + lane;
#pragma unroll
    for (int j = 0; j < 4; ++j) { const f32x4 ww = wr[64 * j]; u32x2 o; o.x = pg8::pk_f16(v[j].x * rs * ww.x, v[j].y * rs * ww.y); o.y = pg8::pk_f16(v[j].z * rs * ww.z, v[j].w * rs * ww.w); o8[64 * j] = o; }
}
__device__ __forceinline__ void rms_row_f32(float* xrow, const float* w, int lane) {
    f32x4* xr = (f32x4*)xrow + lane; const f32x4* wr = (const f32x4*)w + lane;
    f32x4 v[4]; float s = 0.f;
#pragma unroll
    for (int j = 0; j < 4; ++j) { v[j] = xr[64 * j]; s += (v[j].x * v[j].x + v[j].y * v[j].y) + (v[j].z * v[j].z + v[j].w * v[j].w); }
    const float rs = 1.0f / sqrtf(wave_sum(s) * (1.0f / DM) + 1e-6f);
#pragma unroll
    for (int j = 0; j < 4; ++j) { const f32x4 ww = wr[64 * j]; xr[64 * j] = v[j] * rs * ww; }
}

__device__ __forceinline__ void rms_row2_f32(float* xa, float* xb, const float* w, int lane) {
    f32x4* ra = (f32x4*)xa + lane; f32x4* rb = (f32x4*)xb + lane; const f32x4* wr = (const f32x4*)w + lane;
    f32x4 va[4], vb[4]; float sa = 0.f, sb = 0.f;
#pragma unroll
    for (int j = 0; j < 4; ++j) { va[j] = ra[64 * j]; vb[j] = rb[64 * j]; }
#pragma unroll
    for (int j = 0; j < 4; ++j) { sa += (va[j].x * va[j].x + va[j].y * va[j].y) + (va[j].z * va[j].z + va[j].w * va[j].w); sb += (vb[j].x * vb[j].x + vb[j].y * vb[j].y) + (vb[j].z * vb[j].z + vb[j].w * vb[j].w); }
    const float rsa = 1.0f / sqrtf(wave_sum(sa) * (1.0f / DM) + 1e-6f), rsb = 1.0f / sqrtf(wave_sum(sb) * (1.0f / DM) + 1e-6f);
#pragma unroll
    for (int j = 0; j < 4; ++j) { const f32x4 ww = wr[64 * j]; ra[64 * j] = va[j] * rsa * ww; rb[64 * j] = vb[j] * rsb * ww; }
}
__device__ __forceinline__ void rms_row4_f16(const float* x0, size_t rs, const float* w, unsigned short* o0, int lane) {
    f32x4 v[4][4]; float s[4];
#pragma unroll
    for (int r = 0; r < 4; ++r)
#pragma unroll
        for (int j = 0; j < 4; ++j) v[r][j] = ((const f32x4*)(x0 + r * rs) + lane)[64 * j];
    const f32x4* wr = (const f32x4*)w + lane;
#pragma unroll
    for (int r = 0; r < 4; ++r) { float a = 0.f;
#pragma unroll
        for (int j = 0; j < 4; ++j) a += (v[r][j].x * v[r][j].x + v[r][j].y * v[r][j].y) + (v[r][j].z * v[r][j].z + v[r][j].w * v[r][j].w);
        s[r] = 1.0f / sqrtf(wave_sum(a) * (1.0f / DM) + 1e-6f); }
#pragma unroll
    for (int j = 0; j < 4; ++j) { const f32x4 ww = wr[64 * j];
#pragma unroll
        for (int r = 0; r < 4; ++r) { u32x2 o; o.x = pg8::pk_f16(v[r][j].x * s[r] * ww.x, v[r][j].y * s[r] * ww.y); o.y = pg8::pk_f16(v[r][j].z * s[r] * ww.z, v[r][j].w * s[r] * ww.w); ((u32x2*)(o0 + r * rs) + lane)[64 * j] = o; } }
}
__device__ __forceinline__ void rms_row4_f32(float* x0, size_t rs, const float* w, int lane) {
    f32x4 v[4][4]; float s[4];
#pragma unroll
    for (int r = 0; r < 4; ++r)
#pragma unroll
        for (int j = 0; j < 4; ++j) v[r][j] = ((const f32x4*)(x0 + r * rs) + lane)[64 * j];
    const f32x4* wr = (const f32x4*)w + lane;
#pragma unroll
    for (int r = 0; r < 4; ++r) { float a = 0.f;
#pragma unroll
        for (int j = 0; j < 4; ++j) a += (v[r][j].x * v[r][j].x + v[r][j].y * v[r][j].y) + (v[r][j].z * v[r][j].z + v[r][j].w * v[r][j].w);
        s[r] = rsq_(wave_sum(a) * (1.0f / DM) + 1e-6f); }
#pragma unroll
    for (int j = 0; j < 4; ++j) { const f32x4 ww = wr[64 * j];
#pragma unroll
        for (int r = 0; r < 4; ++r) ((f32x4*)(x0 + r * rs) + lane)[64 * j] = v[r][j] * s[r] * ww; }
}

#define SHV(col) ({ const float cur_ = (float)urow[(col)]; const float prev_ = hp ? (float)prow[(col)] : 0.f; cur_ + mu[(col)] * (prev_ - cur_); })

__device__ __forceinline__ void store_row64_f16(f16* dst, const float (&S)[64]) {
#pragma unroll
    for (int q = 0; q < 8; ++q) { u32x4 w; w.x = pg8::pk_f16(S[8 * q], S[8 * q + 1]); w.y = pg8::pk_f16(S[8 * q + 2], S[8 * q + 3]); w.z = pg8::pk_f16(S[8 * q + 4], S[8 * q + 5]); w.w = pg8::pk_f16(S[8 * q + 6], S[8 * q + 7]); *(u32x4*)(dst + 8 * q) = w; }
}


constexpr int RWT_ROW = 144, RWT_A = 0, RWT_R = 2304, RWT_B = 4608, RWT_K = 6912;
constexpr int RWC_B = 9216, RWC_K = 11264, RWC_V = 13312;
constexpr int RWF_G16 = 15360, RWF_RHO = 15616, RWA_INV = 15872, RWA_NMAT = 15936  , RWA_XPARK = 18496  , RWA_BYTES = 20544;
constexpr int C_VD0 = 3712, C_VD1 = 3744;
constexpr int PRM_MU = 0, PRM_A0 = 1280, PRM_KK = 1664, PRM_KA = 2048, PRM_RK = 2432, PRM_V0 = 2816, PRM_HALVES = 3200, PRM_W0_BYTE = 6400, PRM_BYTES = PRM_W0_BYTE + 1536;
typedef float f32x2 __attribute__((ext_vector_type(2)));
typedef _Float16 f16x4 __attribute__((ext_vector_type(4)));
__device__ __forceinline__ float fmix_lo(float a, unsigned b, float c) { float d; asm("v_fma_mix_f32 %0, %1, %2, %3 op_sel:[0,0,0] op_sel_hi:[0,1,0]" : "=v"(d) : "v"(a), "v"(b), "v"(c)); return d; }
__device__ __forceinline__ float fmix_hi(float a, unsigned b, float c) { float d; asm("v_fma_mix_f32 %0, %1, %2, %3 op_sel:[0,1,0] op_sel_hi:[0,1,0]" : "=v"(d) : "v"(a), "v"(b), "v"(c)); return d; }
__device__ __forceinline__ float mmix_lo(float a, unsigned b) { float d; asm("v_fma_mix_f32 %0, %1, %2, 0 op_sel:[0,0,0] op_sel_hi:[0,1,0]" : "=v"(d) : "v"(a), "v"(b)); return d; }
__device__ __forceinline__ float mmix_hi(float a, unsigned b) { float d; asm("v_fma_mix_f32 %0, %1, %2, 0 op_sel:[0,1,0] op_sel_hi:[0,1,0]" : "=v"(d) : "v"(a), "v"(b)); return d; }
__device__ __forceinline__ float mul_asm(float a, float b) { float d; asm("v_mul_f32 %0, %1, %2" : "=v"(d) : "v"(a), "v"(b)); return d; }
__device__ __forceinline__ float fma_asm(float a, float b, float c) { float d; asm("v_fma_f32 %0, %1, %2, %3" : "=v"(d) : "v"(a), "v"(b), "v"(c)); return d; }
#define FMIX(a, u, j, c) (((j) & 1) ? fmix_hi((a), (u)[(j) >> 1], (c)) : fmix_lo((a), (u)[(j) >> 1], (c)))
#define MMIX(a, u, j) (((j) & 1) ? mmix_hi((a), (u)[(j) >> 1]) : mmix_lo((a), (u)[(j) >> 1]))
__device__ __forceinline__ float fast_tanh(float x) { return 1.0f - 2.0f * __builtin_amdgcn_rcpf(__expf(2.0f * x) + 1.0f); }
__device__ __forceinline__ void lerp8(const char* ub, unsigned uo, unsigned po, bool hp, const char* mub, unsigned col, float (&x)[8]) {
    const f16x8 cu = *(const f16x8*)(ub + (uo + col * 2u)); f16x8 pv = *(const f16x8*)(ub + (po + col * 2u)); const f32x4 m0 = *(const f32x4*)(mub + col * 4u), m1 = *(const f32x4*)(mub + col * 4u + 16u);
#pragma unroll
    for (int j = 0; j < 8; ++j) { const float c = (float)cu[j], p = hp ? (float)pv[j] : 0.f; x[j] = c + (j < 4 ? m0[j] : m1[j - 4]) * (p - c); }
}
__device__ __forceinline__ void lerp4(const char* ub, unsigned uo, unsigned po, bool hp, const char* mub, unsigned col, float (&x)[4]) {
    const f16x4 cu = *(const f16x4*)(ub + (uo + col * 2u)); f16x4 pv = *(const f16x4*)(ub + (po + col * 2u)); const f32x4 m0 = *(const f32x4*)(mub + col * 4u);
#pragma unroll
    for (int j = 0; j < 4; ++j) { const float c = (float)cu[j], p = hp ? (float)pv[j] : 0.f; x[j] = c + m0[j] * (p - c); }
}
__device__ __forceinline__ f16x8 pack8(const float (&x)[8]) { f16x8 r;
#pragma unroll
    for (int j = 0; j < 8; ++j) r[j] = (f16)x[j];
    return r; }

template <int CTRL> __device__ __forceinline__ float dpp_f(float x) { return __builtin_bit_cast(float, __builtin_amdgcn_update_dpp(0, __builtin_bit_cast(int, x), CTRL, 0xF, 0xF, true)); }
__device__ __forceinline__ float row_prefix16(float x) { x += dpp_f<0x111>(x); x += dpp_f<0x112>(x); x += dpp_f<0x114>(x); x += dpp_f<0x118>(x); return x; }
__device__ __forceinline__ float bperm_f(int byteaddr, float x) { return __builtin_bit_cast(float, __builtin_amdgcn_ds_bpermute(byteaddr, __builtin_bit_cast(int, x))); }
__device__ __forceinline__ f16x4 cvt4(const f32x4 v) { f16x4 r; r[0] = (f16)v[0]; r[1] = (f16)v[1]; r[2] = (f16)v[2]; r[3] = (f16)v[3]; return r; }
#define MF16(A, B, C) __builtin_amdgcn_mfma_f32_16x16x16f16((A), (B), (C), 0, 0, 0)
#define MF32(A, B, C) __builtin_amdgcn_mfma_f32_16x16x32_f16((A), (B), (C), 0, 0, 0)

__device__ __forceinline__ void rwkv_waveA(const Args& a, int l, int b, int c, int h, LAS unsigned char* wl, const LAS unsigned char* prmb, int lane) {
    const LAS f16* prm = (const LAS f16*)prmb; const LAS float* prw0 = (const LAS float*)(prmb + PRM_W0_BYTE);
    const char* Ub = (const char*)(a.ws + WS_U); f16* MIX = (f16*)(a.ws + WS_MIX); char* VF = (char*)(a.ws + WS_VF); char* VP = (char*)(a.ws + WS_VP);
    f16* QT = (f16*)(a.ws + WS_QT); f16* PT = (f16*)(a.ws + WS_PT); f16* RL = (f16*)(a.ws + WS_RL); float* BONG = (float*)(a.ws + WS_BON);
    const char* WUPT = (const char*)(a.ws + WS_WUPT) + (size_t)l * 384 * 64 * 2; const char* AUPT = (const char*)(a.ws + WS_AUPT) + (size_t)l * 384 * 64 * 2;
    const char* VUPT = (const char*)(a.ws + WS_VUPT);
    const int bh = b * RW_H + h;
    f32x4 XT[4][8];
#pragma unroll
    for (int ct = 0; ct < 4; ++ct)
#pragma unroll
        for (int vt = 0; vt < 8; ++vt)
#pragma unroll
            for (int r = 0; r < 4; ++r) XT[ct][vt][r] = (vt < 4 && 4 * (lane & 15) + vt == 16 * ct + 4 * (lane >> 4) + r) ? 1.f : 0.f;
#define XPK(ct, vt) ((vt) == 7 && (ct) >= 2)
#define XPA(ct) (*(LAS f32x4*)(wl + RWA_XPARK + ((ct) - 2) * 1024 + lane_now() * 16))
    XPA(2) = (f32x4){0.f, 0.f, 0.f, 0.f}; XPA(3) = (f32x4){0.f, 0.f, 0.f, 0.f};
#pragma unroll 1
    for (int blk = 0; blk < 4; ++blk) {
        const int lane_ = lane_now();
        const int tok = lane_ & 15, fq = lane_ >> 4;
        const int t = c * CH + blk * 16 + tok; const unsigned m = (unsigned)(b * SEQ + t); const bool hp = t > 0;
        const unsigned uo = m * (unsigned)(NU * 2), po = hp ? uo - (unsigned)(NU * 2) : uo;
        f16x8 cW[2], pW[2], cA[2], pA[2], vd0, vd1;
#pragma unroll
        for (int s = 0; s < 2; ++s) { const unsigned cw = (unsigned)(C_WL + 8 * fq + 32 * s) * 2u, ca = (unsigned)(C_AL + 8 * fq + 32 * s) * 2u;
            cW[s] = *(const f16x8*)(Ub + uo + cw); pW[s] = *(const f16x8*)(Ub + po + cw); cA[s] = *(const f16x8*)(Ub + uo + ca); pA[s] = *(const f16x8*)(Ub + po + ca); }
        vd0 = *(const f16x8*)(Ub + uo + (unsigned)(C_VD0 + 8 * fq) * 2u); vd1 = *(const f16x8*)(Ub + po + (unsigned)(C_VD1 + 8 * fq) * 2u);
#define RW_WLOAD(nt) { const unsigned n_ = (unsigned)(h * 64 + 16 * (nt) + tok);        \
            Wwu0 = *(const f16x8*)(WUPT + (n_ * 64u + 8u * fq) * 2u); Wwu1 = *(const f16x8*)(WUPT + (n_ * 64u + 8u * fq + 32u) * 2u); \
            Wau0 = *(const f16x8*)(AUPT + (n_ * 64u + 8u * fq) * 2u); Wau1 = *(const f16x8*)(AUPT + (n_ * 64u + 8u * fq + 32u) * 2u); \
            if (l > 0) Wvu = *(const f16x8*)(VUPT + (n_ * 32u + 8u * fq) * 2u); }
#define RW_ADECL(X) f16x4 X##cr, X##pr, X##ck, X##pk, X##cv, X##pv, X##vf;
#define RW_ALOAD(X, nt) { const unsigned cb_ = (unsigned)(h * 64 + 16 * (nt) + 4 * fq);        \
            if (l > 0) X##vf = *(const f16x4*)(VF + (m * (unsigned)RW_W + cb_) * 2u); \
            X##cr = *(const f16x4*)(Ub + uo + ((unsigned)C_R + cb_) * 2u); X##pr = *(const f16x4*)(Ub + po + ((unsigned)C_R + cb_) * 2u); \
            X##ck = *(const f16x4*)(Ub + uo + ((unsigned)C_K + cb_) * 2u); X##pk = *(const f16x4*)(Ub + po + ((unsigned)C_K + cb_) * 2u); \
            X##cv = *(const f16x4*)(Ub + uo + ((unsigned)C_V + cb_) * 2u); X##pv = *(const f16x4*)(Ub + po + ((unsigned)C_V + cb_) * 2u); }
        f16x8 Wwu0, Wwu1, Wau0, Wau1, Wvu; RW_ADECL(T0) RW_ADECL(T1)
        f16x8 bW[2], bA[2], bVD;
#pragma unroll
        for (int s = 0; s < 2; ++s) { float xw[8], xa[8];
            const f16x8 mw = *(const LAS f16x8*)(prm + PRM_MU + C_WL + 8 * fq + 32 * s), ma = *(const LAS f16x8*)(prm + PRM_MU + C_AL + 8 * fq + 32 * s);
#pragma unroll
            for (int j = 0; j < 8; ++j) { const float cw_ = (float)cW[s][j], pw_ = hp ? (float)pW[s][j] : 0.f, ca_ = (float)cA[s][j], pa_ = hp ? (float)pA[s][j] : 0.f;
                xw[j] = fast_tanh(cw_ + (float)mw[j] * (pw_ - cw_)); xa[j] = ca_ + (float)ma[j] * (pa_ - ca_); }
            bW[s] = pack8(xw); bA[s] = pack8(xa); }
        { float xv[8];
#pragma unroll
            for (int j = 0; j < 8; ++j) xv[j] = (float)vd0[j] + (hp ? (float)vd1[j] : 0.f);
            bVD = pack8(xv); }
        float ssq = 0.f, bon = 0.f;
        RW_ALOAD(T0, 0) asm volatile("" ::: "memory");
        const int bp7 = ((lane_ & 48) | 7) << 2, bp15 = ((lane_ & 48) | 15) << 2;
        f32x4 DWn, DAn, Gn;
#define RW_TMFMA() { DWn = (f32x4){0.f, 0.f, 0.f, 0.f}; DAn = DWn; Gn = DWn; \
            DWn = __builtin_amdgcn_mfma_f32_16x16x32_f16(Wwu0, bW[0], DWn, 0, 0, 0); DWn = __builtin_amdgcn_mfma_f32_16x16x32_f16(Wwu1, bW[1], DWn, 0, 0, 0); \
            DAn = __builtin_amdgcn_mfma_f32_16x16x32_f16(Wau0, bA[0], DAn, 0, 0, 0); DAn = __builtin_amdgcn_mfma_f32_16x16x32_f16(Wau1, bA[1], DAn, 0, 0, 0); \
            if (l > 0) Gn = __builtin_amdgcn_mfma_f32_16x16x32_f16(Wvu, bVD, Gn, 0, 0, 0); \
            asm volatile("" : "+v"(DWn), "+v"(DAn), "+v"(Gn)); }
#define RW_TCOMP(X, nt) { const int cb = h * 64 + 16 * (nt) + 4 * fq, co = 16 * (nt) + 4 * fq; \
            f16x4 ah, rh, bh, kh, bb, kb, vo; f32x4 rho4, g164; \
            const f16x4 pmr = *(const LAS f16x4*)(prm + PRM_MU + C_R + cb), pmk = *(const LAS f16x4*)(prm + PRM_MU + C_K + cb), pmv = *(const LAS f16x4*)(prm + PRM_MU + C_V + cb); \
            const f16x4 pa0 = *(const LAS f16x4*)(prm + PRM_A0 + cb), pkk = *(const LAS f16x4*)(prm + PRM_KK + cb), pka = *(const LAS f16x4*)(prm + PRM_KA + cb), prk = *(const LAS f16x4*)(prm + PRM_RK + cb), pv0 = *(const LAS f16x4*)(prm + PRM_V0 + cb); \
            const f32x4 pw0 = *(const LAS f32x4*)(prw0 + cb); \
            f32x4 g2v, Giv, G8v, G16v; \
            _Pragma("unroll") for (int i = 0; i < 4; ++i) { g2v[i] = -0.875036877f * sigmoidf_(pw0[i] + DWn[i]);      \
                Giv[i] = row_prefix16(g2v[i]); } \
            _Pragma("unroll") for (int i = 0; i < 4; ++i) { G8v[i] = bperm_f(bp7, Giv[i]); G16v[i] = bperm_f(bp15, Giv[i]); }       \
            _Pragma("unroll") for (int i = 0; i < 4; ++i) { \
                const float cr_ = (float)X##cr[i], ck_ = (float)X##ck[i], cv_ = (float)X##cv[i]; \
                const float rs = cr_ + (float)pmr[i] * ((hp ? (float)X##pr[i] : 0.f) - cr_), ks = ck_ + (float)pmk[i] * ((hp ? (float)X##pk[i] : 0.f) - ck_), vs = cv_ + (float)pmv[i] * ((hp ? (float)X##pv[i] : 0.f) - cv_); \
                const float aa = sigmoidf_((float)pa0[i] + DAn[i]); \
                float vv = vs; if (l > 0) vv = vs + ((float)X##vf[i] - vs) * sigmoidf_((float)pv0[i] + Gn[i]); \
                const float kk = ks * (float)pkk[i]; ssq += kk * kk; \
                const float kmod = ks * (1.0f + (aa - 1.0f) * (float)pka[i]); \
                bon += rs * kmod * (float)prk[i]; \
                const float bq = kk * aa; \
                const float g2 = g2v[i], Gi = Giv[i], G8 = G8v[i], G16 = G16v[i]; \
                const float e1 = __builtin_amdgcn_exp2f(Gi - G8), e1m = __builtin_amdgcn_exp2f((Gi - g2) - G8), einv = __builtin_amdgcn_exp2f(G8 - Gi), e168 = __builtin_amdgcn_exp2f(G16 - G8), esuf = e168 * einv; \
                rho4[i] = __builtin_amdgcn_exp2f(G8); g164[i] = rho4[i] * e168; \
                ah[i] = (f16)(-kk * e1m); rh[i] = (f16)(rs * e1); bh[i] = (f16)(bq * einv); kh[i] = (f16)(kmod * einv); bb[i] = (f16)(bq * esuf); kb[i] = (f16)(kmod * esuf); vo[i] = (f16)vv; } \
            *(LAS f16x4*)(wl + RWT_A + tok * RWT_ROW + co * 2) = ah; *(LAS f16x4*)(wl + RWT_R + tok * RWT_ROW + co * 2) = rh; \
            *(LAS f16x4*)(wl + RWT_B + tok * RWT_ROW + co * 2) = bh; *(LAS f16x4*)(wl + RWT_K + tok * RWT_ROW + co * 2) = kh; \
            _Pragma("unroll") for (int i = 0; i < 4; ++i) { *(LAS f16*)(wl + RWC_B + (co + i) * 32 + tok * 2) = bb[i]; *(LAS f16*)(wl + RWC_K + (co + i) * 32 + tok * 2) = kb[i]; *(LAS f16*)(wl + RWC_V + (co + i) * 32 + tok * 2) = vo[i]; } \
            if (tok == 0) { *(LAS f32x4*)(wl + RWF_RHO + co * 4) = rho4; *(LAS f32x4*)(wl + RWF_G16 + co * 4) = g164; } \
            *(f16x4*)(VP + (m * (unsigned)RW_W + (unsigned)cb) * 2u) = vo; \
            if (l == 0) *(f16x4*)(VF + (m * (unsigned)RW_W + (unsigned)cb) * 2u) = vo; }
#pragma unroll 1
        for (int nt = 0; nt < 4; ++nt) { const int nn = (nt + 1) & 3;
            RW_WLOAD(nt) asm volatile("" ::: "memory"); RW_ALOAD(T1, nn) asm volatile("" ::: "memory"); RW_TMFMA() asm volatile("" ::: "memory"); RW_TCOMP(T0, nt) asm volatile("" ::: "memory");
            T0cr = T1cr; T0pr = T1pr; T0ck = T1ck; T0pk = T1pk; T0cv = T1cv; T0pv = T1pv; T0vf = T1vf; }
#undef RW_WLOAD
#undef RW_ALOAD
#undef RW_ADECL
#undef RW_TMFMA
#undef RW_TCOMP
        ssq += shfl_xor_f(ssq, 16); ssq += shfl_xor_f(ssq, 32);
        bon += shfl_xor_f(bon, 16); bon += shfl_xor_f(bon, 32);
        { const float inv2v = __builtin_amdgcn_rcpf(fmaxf(ssq, 1e-24f));
          if (fq == 0) { *(LAS float*)(wl + RWA_INV + tok * 4) = inv2v; *(float*)((char*)BONG + (m * 8u + (unsigned)h) * 4u) = bon; } }
        const unsigned mb = (unsigned)(b * SEQ + c * CH + blk * 16);
        const int q4 = fq * 4;
        f16x4 N1, N1T, MkH, NbH, NkH;
        { f16x8 fa[2], fr[2], fb[2], fk[2];
#pragma unroll
          for (int s = 0; s < 2; ++s) { const int o = tok * RWT_ROW + (32 * s + q4) * 2;
#define RW_FRAG(F, T) { const f16x4 lo_ = *(const LAS f16x4*)(wl + (T) + o), hi_ = *(const LAS f16x4*)(wl + (T) + o + 32); F[s] = (f16x8){lo_[0], lo_[1], lo_[2], lo_[3], hi_[0], hi_[1], hi_[2], hi_[3]}; }
              RW_FRAG(fa, RWT_A) RW_FRAG(fr, RWT_R) RW_FRAG(fb, RWT_B) RW_FRAG(fk, RWT_K)
#undef RW_FRAG
          }
          const f32x4 z4 = (f32x4){0.f, 0.f, 0.f, 0.f};
          f32x4 Mb = MF32(fb[1], fa[1], MF32(fb[0], fa[0], z4)), MbT = MF32(fa[1], fb[1], MF32(fa[0], fb[0], z4));
          f32x4 Mk = MF32(fk[1], fa[1], MF32(fk[0], fa[0], z4)), Nb = MF32(fb[1], fr[1], MF32(fb[0], fr[0], z4)), Nk = MF32(fk[1], fr[1], MF32(fk[0], fr[0], z4));
          const f32x4 ivr = *(const LAS f32x4*)(wl + RWA_INV + q4 * 4); const float ivc = *(const LAS float*)(wl + RWA_INV + tok * 4);
#pragma unroll
          for (int r = 0; r < 4; ++r) { const int j = q4 + r;
              Mb[r] = (j < tok) ? Mb[r] * ivr[r] : 0.f; MbT[r] = (tok < j) ? MbT[r] * ivc : 0.f; Mk[r] = (j < tok) ? Mk[r] : 0.f; Nb[r] = (j <= tok) ? Nb[r] : 0.f; Nk[r] = (j <= tok) ? Nk[r] : 0.f; }
          N1 = cvt4(Mb); N1T = cvt4(MbT); MkH = cvt4(Mk); NbH = cvt4(Nb); NkH = cvt4(Nk); }
        const f16x4 N2 = cvt4(MF16(N1T, N1, ((f32x4){0.f, 0.f, 0.f, 0.f}))), N2T = cvt4(MF16(N1, N1T, ((f32x4){0.f, 0.f, 0.f, 0.f})));
        const f16x4 N4 = cvt4(MF16(N2T, N2, ((f32x4){0.f, 0.f, 0.f, 0.f}))), N4T = cvt4(MF16(N2, N2T, ((f32x4){0.f, 0.f, 0.f, 0.f})));
        const f16x4 N8 = cvt4(MF16(N4T, N4, ((f32x4){0.f, 0.f, 0.f, 0.f})));
        { LAS unsigned char* np = wl + RWA_NMAT + lane_ * 8; *(LAS f16x4*)(np) = N2; *(LAS f16x4*)(np + 512) = N4; *(LAS f16x4*)(np + 1024) = N8; *(LAS f16x4*)(np + 1536) = MkH; *(LAS f16x4*)(np + 2048) = NkH; }
#pragma unroll
        for (int hq = 0; hq < 4; ++hq) {
            constexpr int NTQ = 2; const int hv = hq >> 1;
            asm volatile("" ::: "memory");
            const f32x4 ivr2 = *(const LAS f32x4*)(wl + RWA_INV + q4 * 4);
            f32x4 G[NTQ], Y[NTQ]; f16x4 vf[NTQ];
            { f16x8 fa[2], fr[2];
#pragma unroll
              for (int s = 0; s < 2; ++s) { const int o = tok * RWT_ROW + (32 * s + q4) * 2;
#define RW_FRAG(F, T) { const f16x4 lo_ = *(const LAS f16x4*)(wl + (T) + o), hi_ = *(const LAS f16x4*)(wl + (T) + o + 32); F[s] = (f16x8){lo_[0], lo_[1], lo_[2], lo_[3], hi_[0], hi_[1], hi_[2], hi_[3]}; }
                  RW_FRAG(fa, RWT_A) RW_FRAG(fr, RWT_R)
#undef RW_FRAG
              }
#pragma unroll
              for (int t = 0; t < NTQ; ++t) { const int vt = 2 * hq + t; f16x8 xb[2];
#pragma unroll
                for (int s = 0; s < 2; ++s) { const f32x4 r0 = *(const LAS f32x4*)(wl + RWF_RHO + (32 * s + q4) * 4), r1 = *(const LAS f32x4*)(wl + RWF_RHO + (32 * s + 16 + q4) * 4);
                    const f32x4 x0 = (XPK(2 * s, vt) ? XPA(2 * s) : XT[2 * s][vt]) * r0, x1 = (XPK(2 * s + 1, vt) ? XPA(2 * s + 1) : XT[2 * s + 1][vt]) * r1;
                    xb[s] = (f16x8){(f16)x0[0], (f16)x0[1], (f16)x0[2], (f16)x0[3], (f16)x1[0], (f16)x1[1], (f16)x1[2], (f16)x1[3]}; }
                G[t] = MF32(fa[1], xb[1], MF32(fa[0], xb[0], ((f32x4){0.f, 0.f, 0.f, 0.f})));
                Y[t] = MF32(fr[1], xb[1], MF32(fr[0], xb[0], ((f32x4){0.f, 0.f, 0.f, 0.f})));
                if (hv) { vf[t] = *(const LAS f16x4*)(wl + RWC_V + (4 * tok + (vt - 4)) * 32 + q4 * 2); asm volatile("s_nop 7\n\ts_nop 7" : "+v"(G[t]));
                          G[t] = MF16(*(const LAS f16x4*)(wl + RWA_NMAT + 1536 + lane_ * 8), vf[t], G[t]); } } }
#pragma unroll
            for (int t = 0; t < NTQ; ++t) asm volatile("s_nop 7\n\ts_nop 7" : "+v"(G[t]), "+v"(Y[t]));
#pragma unroll
            for (int t = 0; t < NTQ; ++t) G[t] = MF16(N1, cvt4(G[t]), G[t]);
            { const f16x4 Z = *(const LAS f16x4*)(wl + RWA_NMAT + lane_ * 8);
#pragma unroll
            for (int t = 0; t < NTQ; ++t) G[t] = MF16(Z, cvt4(G[t]), G[t]); }
            { const f16x4 Z = *(const LAS f16x4*)(wl + RWA_NMAT + 512 + lane_ * 8);
#pragma unroll
            for (int t = 0; t < NTQ; ++t) G[t] = MF16(Z, cvt4(G[t]), G[t]); }
            { const f16x4 Z = *(const LAS f16x4*)(wl + RWA_NMAT + 1024 + lane_ * 8);
#pragma unroll
            for (int t = 0; t < NTQ; ++t) G[t] = MF16(Z, cvt4(G[t]), G[t]); }
#pragma unroll
            for (int t = 0; t < NTQ; ++t) { const int vt = 2 * hq + t; const int tc = vt & 3;
                const f16x4 uh = cvt4(G[t] * ivr2);
                Y[t] = MF16(NbH, uh, Y[t]); if (hv) Y[t] = MF16(*(const LAS f16x4*)(wl + RWA_NMAT + 2048 + lane_ * 8), vf[t], Y[t]);
                if (t == NTQ - 1) {
                    char* yo = hv ? (char*)MIX + ((mb + (unsigned)q4) * (unsigned)DM + (unsigned)(h * 64 + 4 * tok + tc - 1)) * 2u : (char*)QT + ((mb + (unsigned)q4) * (unsigned)RW_W + (unsigned)(h * 64 + 4 * tok + tc - 1)) * 2u;
#pragma unroll
                    for (int r = 0; r < 4; ++r) *(unsigned*)(yo + (unsigned)r * (hv ? (unsigned)(DM * 2) : (unsigned)(RW_W * 2))) = pg8::pk_f16(Y[0][r], Y[1][r]); }
#pragma unroll
                for (int ct = 0; ct < 4; ++ct) { const f32x4 g16 = *(const LAS f32x4*)(wl + RWF_G16 + (16 * ct + q4) * 4);
                    const f16x4 bt = *(const LAS f16x4*)(wl + RWC_B + (16 * ct + tok) * 32 + q4 * 2);
                    f32x4 xn = MF16(bt, uh, (XPK(ct, vt) ? XPA(ct) : XT[ct][vt]) * g16);
                    if (hv) { const f16x4 kt = *(const LAS f16x4*)(wl + RWC_K + (16 * ct + tok) * 32 + q4 * 2); xn = MF16(kt, vf[t], xn); }
                    if (XPK(ct, vt)) XPA(ct) = xn; else XT[ct][vt] = xn; } }
        }
        asm volatile("" ::: "memory");
    }
    { const int lane2 = lane_now(); const int n2 = lane2 & 15, q2 = (lane2 >> 4) * 4;
      f16* rl = RL + ((size_t)bh * NCH + c) * 4096;
      f16* pt = PT + ((size_t)bh * NCH + c) * 4096;
#pragma unroll
      for (int ct = 0; ct < 4; ++ct)
#pragma unroll
          for (int t = 0; t < 4; ++t) { *(f16x4*)(rl + (4 * n2 + t) * 64 + 16 * ct + q2) = cvt4(XPK(ct, 4 + t) ? XPA(ct) : XT[ct][4 + t]); }
#pragma unroll
      for (int ct = 0; ct < 4; ++ct)
#pragma unroll
          for (int r = 0; r < 4; ++r) { f16x4 p4; p4[0] = (f16)XT[ct][0][r]; p4[1] = (f16)XT[ct][1][r]; p4[2] = (f16)XT[ct][2][r]; p4[3] = (f16)XT[ct][3][r];
              *(f16x4*)(pt + (16 * ct + q2 + r) * 64 + 4 * n2) = p4; } }
}

constexpr int HGT_ROW = 144, HGT_QG = 0, HGT_LV = 2304;
constexpr int HGC_KB = 11520, HGC_V = 13568;
constexpr int HGF_G16 = 15616, HGM_BYTES = 15872;
constexpr int HGA_BYTES = HGM_BYTES;
typedef short s16x4 __attribute__((ext_vector_type(4)));
typedef short s16x8 __attribute__((ext_vector_type(8)));
#define MFB32(A, B, C) __builtin_amdgcn_mfma_f32_16x16x32_bf16((A), (B), (C), 0, 0, 0)
__device__ __forceinline__ void bf16_split(float x, short& hi, short& lo) { const unsigned u = __builtin_bit_cast(unsigned, x); const float xh = __builtin_bit_cast(float, u & 0xFFFF0000u);
    hi = (short)(u >> 16); lo = (short)(__builtin_bit_cast(unsigned, x - xh) >> 16); }
__device__ __forceinline__ void hgrn_waveM(const Args& a, int l, int b, int c, int h, LAS unsigned char* wl) {
    char* U = (char*)(a.ws + WS_U); char* MIX = (char*)(a.ws + WS_MIX); f16* HL = (f16*)(a.ws + WS_HL); float* DC = (float*)(a.ws + WS_DC);
    f32x4 lbq[4], gcq[4];
    { const int ln = lane_now(); const float* lbr = a.in[16];
#pragma unroll
      for (int nt = 0; nt < 4; ++nt) { const int col = h * 64 + 16 * (ln >> 4) + 4 * nt; const f32x4 u1 = *(const f32x4*)(lbr + 384 + col), u0 = *(const f32x4*)(lbr + col);
#pragma unroll
          for (int i = 0; i < 4; ++i) { lbq[nt][i] = (l == 0) ? 0.f : sigmoidf_(u1[i] - u0[i]); gcq[nt][i] = 0.f; } } }
    f32x4 XD[4][4];
#pragma unroll
    for (int kt = 0; kt < 4; ++kt)
#pragma unroll
        for (int vt = 0; vt < 4; ++vt) XD[kt][vt] = (f32x4){0.f, 0.f, 0.f, 0.f};
    f16x8 fr[2], qr[2], vr[2];
#define HG_LOADS(blk_) { const int ln_ = lane_now(); const unsigned uo_ = ((unsigned)(b * SEQ + c * CH + (blk_) * 16 + (ln_ & 15))) * (unsigned)(NU * 2); \
        _Pragma("unroll") for (int s = 0; s < 2; ++s) { const unsigned cc = (unsigned)(h * 64 + 16 * (ln_ >> 4) + 8 * s) * 2u; \
            fr[s] = *(const f16x8*)(U + uo_ + C_HGF * 2 + cc); qr[s] = *(const f16x8*)(U + uo_ + C_HGQ * 2 + cc); vr[s] = *(const f16x8*)(U + uo_ + C_HGI * 2 + cc); } }
    HG_LOADS(0)
#pragma unroll 1
    for (int blk = 0; blk < 4; ++blk) {
        const int lane_ = lane_now(); const int tok = lane_ & 15, fq = lane_ >> 4, q4 = fq * 4;
        const unsigned mb = (unsigned)(b * SEQ + c * CH + blk * 16); const unsigned uo = (mb + (unsigned)tok) * (unsigned)(NU * 2);
        const int bp15 = ((lane_ & 48) | 15) << 2;
        int bpl[4];
#pragma unroll
        for (int L = 0; L < 4; ++L) { const int sL = 8 >> L; bpl[L] = ((lane_ & 48) | ((tok & ~(2 * sL - 1)) + sL - 1)) << 2; }
        float dg = 0.f;
        f16x8 qcw[2];
#pragma unroll
        for (int nt = 0; nt < 4; ++nt) { const int co = 16 * fq + 4 * nt, eo = 4 * (nt & 1);
            const f32x4 lb4 = lbq[nt], gc4 = gcq[nt];
            f32x4 kapv, Giv, G16v;
#pragma unroll
            for (int i = 0; i < 4; ++i) { const float f = lb4[i] + (1.0f - lb4[i]) * sigmoidf_((float)fr[nt >> 1][eo + i]); kapv[i] = 1.0f - f; Giv[i] = row_prefix16(__builtin_amdgcn_logf(f)); }
#pragma unroll
            for (int i = 0; i < 4; ++i) G16v[i] = bperm_f(bp15, Giv[i]);
            f16x4 qg, kb, qc, lv[4]; f32x4 g164, gcn; f32x4 grf[4];
#pragma unroll
            for (int L = 0; L < 4; ++L)
#pragma unroll
                for (int i = 0; i < 4; ++i) grf[L][i] = bperm_f(bpl[L], Giv[i]);
#pragma unroll
            for (int i = 0; i < 4; ++i) { const float q = (float)qr[nt >> 1][eo + i], Gi = Giv[i];
#pragma unroll
                for (int L = 0; L < 4; ++L) lv[L][i] = (f16)(((tok & (8 >> L)) ? q : kapv[i]) * __builtin_amdgcn_exp2f(-fabsf(Gi - grf[L][i])));
                dg += q * kapv[i];
                qg[i] = (f16)(q * __builtin_amdgcn_exp2f(Gi)); kb[i] = (f16)(kapv[i] * __builtin_amdgcn_exp2f(G16v[i] - Gi));
                qc[i] = (f16)(q * __builtin_amdgcn_exp2f(gc4[i] + Gi)); g164[i] = __builtin_amdgcn_exp2f(G16v[i]); gcn[i] = gc4[i] + G16v[i]; }
            const int to = tok * HGT_ROW + co * 2;
            *(LAS f16x4*)(wl + HGT_QG + to) = qg;
#pragma unroll
            for (int L = 0; L < 4; ++L) *(LAS f16x4*)(wl + HGT_LV + L * 2304 + to) = lv[L];
#pragma unroll
            for (int i = 0; i < 4; ++i) { *(LAS f16*)(wl + HGC_KB + (co + i) * 32 + tok * 2) = kb[i]; *(LAS f16*)(wl + HGC_V + (co + i) * 32 + tok * 2) = vr[nt >> 1][eo + i]; }
            gcq[nt] = gcn;
            if (tok == 0) *(LAS f32x4*)(wl + HGF_G16 + co * 4) = g164;
#pragma unroll
            for (int i = 0; i < 4; ++i) qcw[nt >> 1][eo + i] = qc[i];
        }
#pragma unroll
        for (int s2 = 0; s2 < 2; ++s2) *(f16x8*)(U + uo + C_HGQ * 2 + (unsigned)(h * 64 + 16 * fq + 8 * s2) * 2u) = qcw[s2];
        asm volatile("" ::: "memory");
        if (blk < 3) HG_LOADS(blk + 1)
        asm volatile("" ::: "memory");
        f16x4 ATh; f16x8 fqg[2];
        dg += shfl_xor_f(dg, 16); dg += shfl_xor_f(dg, 32);
        { f32x4 AT = (f32x4){0.f, 0.f, 0.f, 0.f};
#pragma unroll
          for (int L = 0; L < 4; ++L) { const int sL = 8 >> L; const int o8 = tok * HGT_ROW + 8 * fq * 2;
              const f16x8 f0 = *(const LAS f16x8*)(wl + HGT_LV + L * 2304 + o8), f1 = *(const LAS f16x8*)(wl + HGT_LV + L * 2304 + o8 + 64);
              const f32x4 D = MF32(f1, f1, MF32(f0, f0, ((f32x4){0.f, 0.f, 0.f, 0.f})));
#pragma unroll
              for (int r = 0; r < 4; ++r) { const int j = q4 + r;
                  AT[r] += (((j & sL) == 0) && ((tok & sL) != 0) && (((tok ^ j) & ~(2 * sL - 1)) == 0)) ? D[r] : 0.f; } }
#pragma unroll
          for (int r = 0; r < 4; ++r) AT[r] += (q4 + r == tok) ? dg : 0.f;
#pragma unroll
          for (int s = 0; s < 2; ++s) { const int o = tok * HGT_ROW + (32 * s + q4) * 2;
              const f16x4 lo_ = *(const LAS f16x4*)(wl + HGT_QG + o), hi_ = *(const LAS f16x4*)(wl + HGT_QG + o + 32); fqg[s] = (f16x8){lo_[0], lo_[1], lo_[2], lo_[3], hi_[0], hi_[1], hi_[2], hi_[3]}; }
          asm volatile("s_nop 7\n\ts_nop 7" : "+v"(AT)); ATh = cvt4(AT); }
        f32x4 Ov[4];
#pragma unroll
        for (int vt = 0; vt < 4; ++vt) { f16x8 xb[2];
#pragma unroll
            for (int s = 0; s < 2; ++s) { const f32x4 x0 = XD[2 * s][vt], x1 = XD[2 * s + 1][vt];
                xb[s] = (f16x8){(f16)x0[0], (f16)x0[1], (f16)x0[2], (f16)x0[3], (f16)x1[0], (f16)x1[1], (f16)x1[2], (f16)x1[3]}; }
            f32x4 O = MF32(fqg[1], xb[1], MF32(fqg[0], xb[0], ((f32x4){0.f, 0.f, 0.f, 0.f})));
            const f16x4 vf = *(const LAS f16x4*)(wl + HGC_V + (4 * tok + vt) * 32 + q4 * 2);
            asm volatile("s_nop 7\n\ts_nop 7" : "+v"(O));
            O = MF16(ATh, vf, O); asm volatile("s_nop 7\n\ts_nop 7" : "+v"(O));
            Ov[vt] = O;
#pragma unroll
            for (int kt = 0; kt < 4; ++kt) { const f32x4 g16 = *(const LAS f32x4*)(wl + HGF_G16 + (16 * kt + q4) * 4);
                const f16x4 kbt = *(const LAS f16x4*)(wl + HGC_KB + (16 * kt + tok) * 32 + q4 * 2);
                XD[kt][vt] = MF16(kbt, vf, XD[kt][vt] * g16); } }
        { char* mo = MIX + ((mb + (unsigned)q4) * (unsigned)DM + (unsigned)(384 + h * 64 + 4 * tok)) * 2u;
#pragma unroll
          for (int r = 0; r < 4; ++r) { f16x4 o4; o4[0] = (f16)Ov[0][r]; o4[1] = (f16)Ov[1][r]; o4[2] = (f16)Ov[2][r]; o4[3] = (f16)Ov[3][r]; *(f16x4*)(mo + (unsigned)r * (unsigned)(DM * 2)) = o4; } }
        asm volatile("" ::: "memory");
    }
#undef HG_LOADS
    { const int lane2 = lane_now(); const int n2 = lane2 & 15, q2 = (lane2 >> 4) * 4; const int bh = b * 6 + h;
      f16* hl = HL + ((size_t)bh * NCH + c) * 4096;
#pragma unroll
      for (int kt = 0; kt < 4; ++kt)
#pragma unroll
          for (int vt = 0; vt < 4; ++vt) *(f16x4*)(hl + (4 * n2 + vt) * 64 + 16 * kt + q2) = cvt4(XD[kt][vt]);
      if (n2 == 0) {
#pragma unroll
          for (int nt = 0; nt < 4; ++nt) { f32x4 d4;
#pragma unroll
              for (int i = 0; i < 4; ++i) d4[i] = __builtin_amdgcn_exp2f(gcq[nt][i]);
              *(f32x4*)(DC + ((size_t)bh * NCH + c) * 64 + 4 * q2 + 4 * nt) = d4; } } }
}

__device__ __forceinline__ void lru_waveA(const Args& a, int l, int b, int c, int g, LAS unsigned char* wl) {
    const int ln = lane_now();
    const char* Ub = (const char*)(a.ws + WS_U); char* MIXb = (char*)(a.ws + WS_MIX); char* CA = (char*)(a.ws + WS_CA); float* LA = (float*)(a.ws + WS_LA); float* LH = (float*)(a.ws + WS_LH);
    const float* cw = a.in[18] + l * 4 * 256 + g * 64; const float* cb = a.in[19] + l * 256 + g * 64;
    const float* ba = a.in[21] + l * 256 + g * 64; const float* bx = a.in[23] + l * 256 + g * 64; const float* lam = a.in[24] + l * 256 + g * 64;
    const char* WAT = (const char*)(a.ws + WS_WAT) + (size_t)(l * 4 + g) * 8192; const char* WXT = (const char*)(a.ws + WS_WXT) + (size_t)(l * 4 + g) * 8192;
    LAS unsigned char* Y = wl;
    const unsigned mrow0 = (unsigned)(b * SEQ + c * CH);
    { const int co = ln & 7;
      f32x4 cwv[4][2], cbv[2]; cbv[0] = *(const f32x4*)(cb + 8 * co); cbv[1] = *(const f32x4*)(cb + 8 * co + 4);
#pragma unroll
      for (int jj = 0; jj < 4; ++jj) { cwv[jj][0] = *(const f32x4*)(cw + jj * 256 + 8 * co); cwv[jj][1] = *(const f32x4*)(cw + jj * 256 + 8 * co + 4); }
      f16x8 xr[2][4][4];
#pragma unroll
      for (int hb = 0; hb < 2; ++hb)
#pragma unroll
        for (int it = 0; it < 4; ++it) { const int item = ln + 64 * (4 * hb + it), tok = item >> 3; const int t = c * CH + tok;
#pragma unroll
            for (int jj = 0; jj < 4; ++jj) { const int ts = t - 3 + jj; const unsigned row = (ts >= 0) ? mrow0 + (unsigned)(tok - 3 + jj) : mrow0 + (unsigned)tok;
                xr[hb][it][jj] = *(const f16x8*)(Ub + (row * (unsigned)NU + (unsigned)(C_LRUX + g * 64 + 8 * co)) * 2u); } }
#pragma unroll
      for (int hb = 0; hb < 2; ++hb)
#pragma unroll
        for (int it = 0; it < 4; ++it) { const int item = ln + 64 * (4 * hb + it), tok = item >> 3; const int t = c * CH + tok;
            float y[8] = {cbv[0][0], cbv[0][1], cbv[0][2], cbv[0][3], cbv[1][0], cbv[1][1], cbv[1][2], cbv[1][3]};
#pragma unroll
            for (int jj = 0; jj < 4; ++jj) { const int ts = t - 3 + jj;
                if (ts >= 0) {
#pragma unroll
                    for (int i = 0; i < 8; ++i) y[i] += (i < 4 ? cwv[jj][0][i & 3] : cwv[jj][1][i & 3]) * (float)xr[hb][it][jj][i]; } }
            *(LAS f16x8*)(Y + tok * 144 + co * 16) = pack8(y); } }
    asm volatile("s_waitcnt lgkmcnt(0)" ::: "memory");
    const int tl = ln & 15, fq = ln >> 4;
    float sp[16], cy[16], cp[16];
#pragma unroll
    for (int nt = 0; nt < 4; ++nt) { const f32x4 lm4 = *(const f32x4*)(lam + 16 * fq + 4 * nt);
#pragma unroll
        for (int i = 0; i < 4; ++i) { sp[nt * 4 + i] = log1pf(__expf(-lm4[i])); cy[nt * 4 + i] = 0.f; cp[nt * 4 + i] = 1.f; } }
    f16x8 wfa[4][2], wfx[4][2];
#pragma unroll
    for (int nt = 0; nt < 4; ++nt)
#pragma unroll
        for (int s2 = 0; s2 < 2; ++s2) { const unsigned wo = (unsigned)(((16 * ((ln & 15) >> 2) + 4 * nt + (ln & 3)) * 64 + 8 * (ln >> 4) + 32 * s2) * 2);        wfa[nt][s2] = *(const f16x8*)(WAT + wo); wfx[nt][s2] = *(const f16x8*)(WXT + wo); }
    f32x4 bav[4], bxv[4];
#pragma unroll
    for (int nt = 0; nt < 4; ++nt) { bav[nt] = *(const f32x4*)(ba + 16 * fq + 4 * nt); bxv[nt] = *(const f32x4*)(bx + 16 * fq + 4 * nt); }
#pragma unroll 1
    for (int tt = 0; tt < 4; ++tt) {
        f16x8 by[2];
#pragma unroll
        for (int s2 = 0; s2 < 2; ++s2) by[s2] = *(const LAS f16x8*)(Y + (16 * tt + tl) * 144 + (8 * fq + 32 * s2) * 2);
        const unsigned m = mrow0 + (unsigned)(16 * tt + tl);
        f16x8 ho8[2], co8[2];
#pragma unroll
        for (int nt = 0; nt < 4; ++nt) {
            f32x4 ra = (f32x4){0.f, 0.f, 0.f, 0.f}, rx = ra;
#pragma unroll
            for (int s2 = 0; s2 < 2; ++s2) { ra = __builtin_amdgcn_mfma_f32_16x16x32_f16(wfa[nt][s2], by[s2], ra, 0, 0, 0); rx = __builtin_amdgcn_mfma_f32_16x16x32_f16(wfx[nt][s2], by[s2], rx, 0, 0, 0); }
            const int ch0 = 16 * fq + 4 * nt;
            const f32x4 ba4 = bav[nt], bx4 = bxv[nt];
            const f16x4 y4 = *(const LAS f16x4*)(Y + (16 * tt + tl) * 144 + ch0 * 2);
            f16x4 ho, co;
#pragma unroll
            for (int i = 0; i < 4; ++i) { const int q = nt * 4 + i;
                const float r = sigmoidf_(ra[i] + ba4[i]), ig = sigmoidf_(rx[i] + bx4[i]);
                const float la = -8.0f * r * sp[q];
                float av = __expf(la), uv = sqrtf(one_minus_exp_(2.0f * la)) * (ig * (float)y4[i]);
#define LRU_SCAN(d) { const float ap = __builtin_bit_cast(float, __builtin_amdgcn_update_dpp(0x3f800000, __builtin_bit_cast(int, av), 0x110 + (d), 0xf, 0xf, false)); \
                      const float up = __builtin_bit_cast(float, __builtin_amdgcn_update_dpp(0, __builtin_bit_cast(int, uv), 0x110 + (d), 0xf, 0xf, false)); \
                      uv = av * up + uv; av = av * ap; }
                LRU_SCAN(1) LRU_SCAN(2) LRU_SCAN(4) LRU_SCAN(8)
#undef LRU_SCAN
                const float hl = uv + av * cy[q], ca = av * cp[q];
                ho[i] = (f16)hl; co[i] = (f16)ca;
                cy[q] = __builtin_bit_cast(float, __builtin_amdgcn_ds_bpermute((ln | 15) << 2, __builtin_bit_cast(int, hl)));
                cp[q] = __builtin_bit_cast(float, __builtin_amdgcn_ds_bpermute((ln | 15) << 2, __builtin_bit_cast(int, ca)));
            }
#pragma unroll
            for (int i = 0; i < 4; ++i) { ho8[nt >> 1][4 * (nt & 1) + i] = ho[i]; co8[nt >> 1][4 * (nt & 1) + i] = co[i]; }
        }
#pragma unroll
        for (int s2 = 0; s2 < 2; ++s2) { *(f16x8*)(MIXb + (m * (unsigned)DM + 768u + (unsigned)(g * 64 + 16 * fq + 8 * s2)) * 2u) = ho8[s2]; *(f16x8*)(CA + (m * 256u + (unsigned)(g * 64 + 16 * fq + 8 * s2)) * 2u) = co8[s2]; }
    }
    if (tl == 15) {
#pragma unroll
        for (int q = 0; q < 16; ++q) { const int ch = g * 64 + 16 * fq + 4 * (q >> 2) + (q & 3); LA[((size_t)b * NCH + c) * 256 + ch] = cp[q]; LH[((size_t)b * NCH + c) * 256 + ch] = cy[q]; } }
}

__device__ __forceinline__ void phaseA(const Args& a, int l, int task, LAS unsigned char* lds, int tid) {
    asm volatile("" : "+v"(tid));
    const int lane = tid & 63, wave = __builtin_amdgcn_readfirstlane(tid >> 6);
    const int b = task / NCH, c = task % NCH;
    const f16* U = (const f16*)(a.ws + WS_U); f16* MIX = (f16*)(a.ws + WS_MIX); f16* VF = (f16*)(a.ws + WS_VF); f16* VP = (f16*)(a.ws + WS_VP);
    f16* QT = (f16*)(a.ws + WS_QT); f16* PT = (f16*)(a.ws + WS_PT); f16* RL = (f16*)(a.ws + WS_RL); float* BONG = (float*)(a.ws + WS_BON);
    {
        if (wave < 4) { rwkv_waveA(a, l, b, c, wave, lds + wave * RWA_BYTES, lds + PRM_OFF, lane);
                        if (wave >= 2) hgrn_waveM(a, l, b, c, wave, lds + wave * RWA_BYTES); }
        else if (wave < RW_H) { __builtin_amdgcn_s_setprio(2); hgrn_waveM(a, l, b, c, wave, lds + wave * RWA_BYTES); __builtin_amdgcn_s_setprio(0);
                                rwkv_waveA(a, l, b, c, wave, lds + wave * RWA_BYTES, lds + PRM_OFF, lane_now()); }
        else { LAS unsigned char* hw = lds + RW_H * RWA_BYTES + (wave - RW_H) * HGA_BYTES;
               lru_waveA(a, l, b, c, 2 * (wave - RW_H), hw); lru_waveA(a, l, b, c, 2 * (wave - RW_H) + 1, hw);
               hgrn_waveM(a, l, b, c, wave - RW_H, hw); }
        __syncthreads();
    }
}

constexpr int PB_SLOT = 16384, PB_NS = 8, PB_AHEAD = 6, NGRP = NCH / 8;
#define ARENA(ws, off) ((char*)(ws) + WS_U + (size_t)((off) >> 11) * (size_t)(NU * 2) + (size_t)((off) & 2047))
constexpr size_t AR_PGT = 0, AR_LG = 2u << 20, AR_SG = 4u << 20;
#define PB_SWZ(row, o) ((row) * 128 + (((((o) >> 4) ^ ((row) & 7)) << 4) | ((o) & 15)))
template <bool ADD_L>
__device__ __forceinline__ void pb_step(f32x4 (&Sacc)[4], const LAS unsigned char* sl, int xrow, int vl, int fq) {
    f16x8 Bhi[2], Blo[2];
#pragma unroll
    for (int mt = 0; mt < 4; ++mt)
#pragma unroll
        for (int i = 0; i < 4; ++i) { const f16 hi = (f16)Sacc[mt][i]; const f16 lo = (f16)(Sacc[mt][i] - (float)hi); Bhi[mt >> 1][4 * (mt & 1) + i] = hi; Blo[mt >> 1][4 * (mt & 1) + i] = lo; }
#pragma unroll
    for (int mt = 0; mt < 4; ++mt) {
        f32x4 d = (f32x4){0.f, 0.f, 0.f, 0.f};
        if (ADD_L) { const f16x4 l4 = *(const LAS f16x4*)(sl + 8192 + PB_SWZ(xrow, 32 * mt + 8 * fq)); d = (f32x4){(float)l4[0], (float)l4[1], (float)l4[2], (float)l4[3]}; }
#pragma unroll
        for (int s = 0; s < 2; ++s) { const u32x2 a0 = *(const LAS u32x2*)(sl + PB_SWZ(16 * mt + vl, 64 * s + 8 * fq)), a1 = *(const LAS u32x2*)(sl + PB_SWZ(16 * mt + vl, 64 * s + 32 + 8 * fq));
            u32x4 aw; aw.x = a0.x; aw.y = a0.y; aw.z = a1.x; aw.w = a1.y; const f16x8 af = __builtin_bit_cast(f16x8, aw);
            d = __builtin_amdgcn_mfma_f32_16x16x32_f16(af, Bhi[s], d, 0, 0, 0); d = __builtin_amdgcn_mfma_f32_16x16x32_f16(af, Blo[s], d, 0, 0, 0); }
        Sacc[mt] = d; }
}
__device__ __forceinline__ void pb_stage8(const Args& a, LAS unsigned char* lds, int bh, int c0, int wave, int lane) {
    const char* PT = (const char*)(a.ws + WS_PT) + ((size_t)bh * NCH + c0) * 8192; const char* RL = (const char*)(a.ws + WS_RL) + ((size_t)bh * NCH + c0) * 8192;
    const int lq = wave * 64 + lane, lrow = lq >> 3, lpp = lq & 7; const unsigned lsrc = (unsigned)(lrow * 128 + ((lpp ^ (lrow & 7)) << 4));
#pragma unroll
    for (int sl = 0; sl < 8; ++sl) { const unsigned so = (unsigned)(sl * PB_SLOT + wave * 1024); const size_t go = (size_t)sl * 8192 + lsrc;
        __builtin_amdgcn_global_load_lds((const unsigned*)(PT + go), (LAS unsigned*)(lds + so), 16, 0, 0);
        __builtin_amdgcn_global_load_lds((const unsigned*)(RL + go), (LAS unsigned*)(lds + so + 8192), 16, 0, 0); }
    asm volatile("s_waitcnt vmcnt(0)" ::: "memory");
    __builtin_amdgcn_s_barrier();
}
__device__ __forceinline__ void phaseB1(const Args& a, LAS unsigned char* lds, int tid) {
    asm volatile("" : "+v"(tid));
    const int lane = tid & 63, wave = __builtin_amdgcn_readfirstlane(tid >> 6);
    for (int t0 = blockIdx.x; t0 < ((gridDim.x == 256u) ? 256 : 12 * NGRP); t0 += gridDim.x) {
        int task = t0;
        if (gridDim.x == 256u) { const int x = t0 & 7, j = t0 >> 3; if (j >= 24) continue; task = ((x >> 2) * 6 + (j >> 2)) * NGRP + 4 * (x & 3) + (j & 3); }
        const int bh = task / NGRP, g = task % NGRP, c0 = 8 * g;
        pb_stage8(a, lds, bh, c0, wave, lane);
        const int vt = wave & 3, vl = lane & 15, fq = lane >> 4, xr = 16 * vt + vl;
        f32x4 X[4];
        if (wave < 4) {
#pragma unroll
            for (int mt = 0; mt < 4; ++mt) { const f16x4 l4 = *(const LAS f16x4*)(lds + 8192 + PB_SWZ(xr, 32 * mt + 8 * fq)); X[mt] = (f32x4){(float)l4[0], (float)l4[1], (float)l4[2], (float)l4[3]}; }
#pragma unroll 1
            for (int s = 1; s < 8; ++s) pb_step<true>(X, lds + s * PB_SLOT, xr, vl, fq);
#pragma unroll
            for (int mt = 0; mt < 4; ++mt) { f16x4 o;
#pragma unroll
                for (int i = 0; i < 4; ++i) o[i] = (f16)X[mt][i];
                *(f16x4*)ARENA(a.ws, AR_LG + ((size_t)bh * NGRP + g) * 8192 + (size_t)((xr * 64 + 16 * mt + 4 * fq) * 2)) = o; }
        } else {
#pragma unroll
            for (int mt = 0; mt < 4; ++mt)
#pragma unroll
                for (int i = 0; i < 4; ++i) X[mt][i] = (16 * mt + 4 * fq + i == xr) ? 1.f : 0.f;
#pragma unroll 1
            for (int s = 0; s < 8; ++s) pb_step<false>(X, lds + s * PB_SLOT, xr, vl, fq);
#pragma unroll
            for (int mt = 0; mt < 4; ++mt)
#pragma unroll
                for (int i = 0; i < 4; ++i) *(f16*)ARENA(a.ws, AR_PGT + ((size_t)bh * NGRP + g) * 8192 + (size_t)(((16 * mt + 4 * fq + i) * 64 + xr) * 2)) = (f16)X[mt][i];
        }
        asm volatile("s_waitcnt vmcnt(0) lgkmcnt(0)" ::: "memory");
        __builtin_amdgcn_s_barrier();
    }
}
__device__ __forceinline__ void phaseB3(const Args& a, LAS unsigned char* lds, int tid) {
    asm volatile("" : "+v"(tid));
    const int lane = tid & 63, wave = __builtin_amdgcn_readfirstlane(tid >> 6);
    for (int t0 = blockIdx.x; t0 < ((gridDim.x == 256u) ? 256 : 12 * NGRP); t0 += gridDim.x) {
        int task = t0;
        if (gridDim.x == 256u) { const int x = t0 & 7, j = t0 >> 3; if (j >= 24) continue; task = ((x >> 2) * 6 + (j >> 2)) * NGRP + 4 * (x & 3) + (j & 3); }
        const int bh = task / NGRP, g = task % NGRP, c0 = 8 * g;
        pb_stage8(a, lds, bh, c0, wave, lane);
        if (wave < 4) {
            const int vt = wave, vl = lane & 15, fq = lane >> 4, xr = 16 * vt + vl;
            char* RL = (char*)(a.ws + WS_RL) + ((size_t)bh * NCH + c0) * 8192;
            f32x4 X[4];
#pragma unroll
            for (int mt = 0; mt < 4; ++mt) { const f16x4 s4 = *(const f16x4*)ARENA(a.ws, AR_SG + ((size_t)bh * NGRP + g) * 8192 + (size_t)((xr * 64 + 16 * mt + 4 * fq) * 2)); X[mt] = (f32x4){(float)s4[0], (float)s4[1], (float)s4[2], (float)s4[3]}; }
#pragma unroll 1
            for (int s = 0; s < 8; ++s) {
#pragma unroll
                for (int mt = 0; mt < 4; ++mt) { f16x4 o;
#pragma unroll
                    for (int i = 0; i < 4; ++i) o[i] = (f16)X[mt][i];
                    *(f16x4*)(RL + (size_t)s * 8192 + (xr * 64 + 16 * mt + 4 * fq) * 2) = o; }
                if (s < 7) pb_step<true>(X, lds + s * PB_SLOT, xr, vl, fq);
            }
        }
        asm volatile("s_waitcnt vmcnt(0) lgkmcnt(0)" ::: "memory");
        __builtin_amdgcn_s_barrier();
    }
}
__device__ __forceinline__ void phaseB(const Args& a, LAS unsigned char* lds, int tid) {
    asm volatile("" : "+v"(tid));
    const int lane = tid & 63, wave = __builtin_amdgcn_readfirstlane(tid >> 6);
    const int bx = blockIdx.x;
    if (bx < 12) {
        const int bh = bx;
        const bool loader = wave >= 4;
        const int vt = wave & 3, vl = lane & 15, fq = lane >> 4, v = 16 * vt + vl;
        const int lq = (wave - 4) * 64 + lane, lrow = lq >> 3, lpp = lq & 7;
        const unsigned lsrc = (unsigned)(lrow * 128 + ((lpp ^ (lrow & 7)) << 4));
#define PB_ISSUE(cc) { const unsigned so = (unsigned)(((cc) & (PB_NS - 1)) * PB_SLOT) + (unsigned)((wave - 4) * 1024); const size_t go = ((size_t)bh * NGRP + (cc)) * 8192 + lsrc; \
            __builtin_amdgcn_global_load_lds((const unsigned*)ARENA(a.ws, AR_PGT + go), (LAS unsigned*)(lds + so), 16, 0, 0); \
            __builtin_amdgcn_global_load_lds((const unsigned*)ARENA(a.ws, AR_PGT + go + 4096), (LAS unsigned*)(lds + so + 4096), 16, 0, 0); \
            __builtin_amdgcn_global_load_lds((const unsigned*)ARENA(a.ws, AR_LG + go), (LAS unsigned*)(lds + so + 8192), 16, 0, 0); \
            __builtin_amdgcn_global_load_lds((const unsigned*)ARENA(a.ws, AR_LG + go + 4096), (LAS unsigned*)(lds + so + 12288), 16, 0, 0); }
        if (loader) {
#pragma unroll
            for (int cc = 0; cc < PB_AHEAD; ++cc) PB_ISSUE(cc)
            asm volatile("s_waitcnt vmcnt(20)" ::: "memory");
        }
        __builtin_amdgcn_s_barrier();
        f32x4 Sacc[4];
#pragma unroll
        for (int mt = 0; mt < 4; ++mt) Sacc[mt] = (f32x4){0.f, 0.f, 0.f, 0.f};
#pragma unroll 1
        for (int c = 0; c < NGRP; ++c) {
            if (loader) {
                if (c + PB_AHEAD < NGRP) { PB_ISSUE(c + PB_AHEAD) asm volatile("s_waitcnt vmcnt(20)" ::: "memory"); }
                else asm volatile("s_waitcnt vmcnt(0)" ::: "memory");
            } else {
#pragma unroll
                for (int mt = 0; mt < 4; ++mt) { f16x4 o;
#pragma unroll
                    for (int i = 0; i < 4; ++i) o[i] = (f16)Sacc[mt][i];
                    *(f16x4*)ARENA(a.ws, AR_SG + ((size_t)bh * NGRP + c) * 8192 + (size_t)((v * 64 + 16 * mt + 4 * fq) * 2)) = o; }
                pb_step<true>(Sacc, lds + (c & (PB_NS - 1)) * PB_SLOT, v, vl, fq);
                asm volatile("s_waitcnt lgkmcnt(0)" ::: "memory");
            }
            __builtin_amdgcn_s_barrier();
        }
#undef PB_ISSUE
        asm volatile("s_waitcnt vmcnt(0)" ::: "memory");
    } else if (bx < 12 + 96) {
        const int idx = (bx - 12) * NT + tid; const int bh = idx >> 12, e = idx & 4095, k = e & 63;
        f16* HL = (f16*)(a.ws + WS_HL); const float* DC = (const float*)(a.ws + WS_DC);
        float s = 0.f;
        for (int c0 = 0; c0 < NCH; c0 += 8) { float Lc[8], d[8];
#pragma unroll
            for (int j = 0; j < 8; ++j) { Lc[j] = (float)HL[((size_t)bh * NCH + c0 + j) * 4096 + e]; d[j] = DC[((size_t)bh * NCH + c0 + j) * 64 + k]; }
#pragma unroll
            for (int j = 0; j < 8; ++j) { HL[((size_t)bh * NCH + c0 + j) * 4096 + e] = (f16)s; s = d[j] * s + Lc[j]; } }
    } else if (bx == 12 + 96) {
        const int bb = tid >> 8, ch = tid & 255; const float* LA = (const float*)(a.ws + WS_LA); float* LH = (float*)(a.ws + WS_LH);
        float cy = 0.f;
        for (int c0 = 0; c0 < NCH; c0 += 8) { float A[8], H[8];
#pragma unroll
            for (int j = 0; j < 8; ++j) { const size_t o = ((size_t)bb * NCH + c0 + j) * 256 + ch; A[j] = LA[o]; H[j] = LH[o]; }
#pragma unroll
            for (int j = 0; j < 8; ++j) { const size_t o = ((size_t)bb * NCH + c0 + j) * 256 + ch; LH[o] = cy; cy = A[j] * cy + H[j]; } }
    }
}

__device__ __forceinline__ void phaseC(const Args& a, int l, int task, LAS unsigned char* lds, int tid) {
    asm volatile("" : "+v"(tid));
    const int lane = tid & 63, wave = __builtin_amdgcn_readfirstlane(tid >> 6);
    const int b = task / NCH, c = task % NCH;
    const int tl = lane & 15, fq = lane >> 4, tt = wave & 3, hg = wave >> 2;
    const unsigned m = (unsigned)(b * SEQ + c * CH + 16 * tt + tl);
    const char* U = (const char*)(a.ws + WS_U); char* MIX = (char*)(a.ws + WS_MIX); const char* VP = (const char*)(a.ws + WS_VP);
    const char* QT = (const char*)(a.ws + WS_QT); const char* RL = (const char*)(a.ws + WS_RL); const char* HL = (const char*)(a.ws + WS_HL); const float* BONG = (const float*)(a.ws + WS_BON);
    const unsigned uo = m * (unsigned)(NU * 2);
    const int rv = 16 * (tl >> 2) + (tl & 3);
#pragma unroll
    for (int hh = 0; hh < 3; ++hh) {
        const int h = 3 * hg + hh; const int bh = b * RW_H + h;
        const char* sl = RL + ((size_t)bh * NCH + c) * 8192;
        const unsigned col = (unsigned)(h * 64 + 16 * fq);
        f16x8 bq[2], yl[2];
#pragma unroll
        for (int s = 0; s < 2; ++s) { bq[s] = *(const f16x8*)(QT + (m * (unsigned)RW_W + (unsigned)(h * 64 + 8 * fq + 32 * s)) * 2u); yl[s] = *(const f16x8*)(MIX + (m * (unsigned)DM + col + 8u * s) * 2u); }
        f32x4 D[4];
#pragma unroll
        for (int vt = 0; vt < 4; ++vt) { f32x4 d;
#pragma unroll
            for (int i = 0; i < 4; ++i) d[i] = (float)yl[vt >> 1][4 * (vt & 1) + i];
#pragma unroll
            for (int s = 0; s < 2; ++s) d = __builtin_amdgcn_mfma_f32_16x16x32_f16(*(const f16x8*)(sl + ((rv + 4 * vt) * 64 + 8 * fq + 32 * s) * 2), bq[s], d, 0, 0, 0);
            D[vt] = d; }
        float sm = 0.f;
#pragma unroll
        for (int vt = 0; vt < 4; ++vt) sm += (D[vt][0] + D[vt][1]) + (D[vt][2] + D[vt][3]);
        sm += shfl_xor_f(sm, 16); sm += shfl_xor_f(sm, 32);
        const float mean = sm * (1.0f / 64.0f); float vr = 0.f;
#pragma unroll
        for (int vt = 0; vt < 4; ++vt)
#pragma unroll
            for (int i = 0; i < 4; ++i) { const float d = D[vt][i] - mean; vr += d * d; }
        vr += shfl_xor_f(vr, 16); vr += shfl_xor_f(vr, 32);
        const float rstd = rsq_(vr * (1.0f / 64.0f) + 64e-5f);
        const float bon = BONG[m * 8u + (unsigned)h];
        const float* ln_w = a.in[14] + l * RW_W; const float* ln_b = a.in[15] + l * RW_W;
        f16x8 vp[2], z8[2], o[2];
#pragma unroll
        for (int s = 0; s < 2; ++s) { vp[s] = *(const f16x8*)(VP + (m * (unsigned)RW_W + col + 8u * s) * 2u); z8[s] = *(const f16x8*)(U + uo + ((unsigned)C_RWZ + col + 8u * s) * 2u); }
#pragma unroll
        for (int vt = 0; vt < 4; ++vt) { const f32x4 lw = *(const f32x4*)(ln_w + col + 4 * vt), lb = *(const f32x4*)(ln_b + col + 4 * vt);
#pragma unroll
            for (int i = 0; i < 4; ++i) { const int e = 4 * (vt & 1) + i; o[vt >> 1][e] = (f16)(((D[vt][i] - mean) * rstd * lw[i] + lb[i] + bon * (float)vp[vt >> 1][e]) * siluf_((float)z8[vt >> 1][e])); } }
#pragma unroll
        for (int s = 0; s < 2; ++s) *(f16x8*)(MIX + (m * (unsigned)DM + col + 8u * s) * 2u) = o[s];
    }
#pragma unroll
    for (int hh = 0; hh < 3; ++hh) {
        const int h = 3 * hg + hh; const int bh = b * 6 + h;
        const char* sl = HL + ((size_t)bh * NCH + c) * 8192;
        const unsigned col = (unsigned)(h * 64 + 16 * fq);
        f16x8 bq[2], ol[2];
#pragma unroll
        for (int s = 0; s < 2; ++s) { bq[s] = *(const f16x8*)(U + uo + (unsigned)(C_HGQ + h * 64 + 8 * fq + 32 * s) * 2u);
            ol[s] = *(const f16x8*)(MIX + (m * (unsigned)DM + 384u + col + 8u * s) * 2u); }
        f32x4 D[4];
#pragma unroll
        for (int vt = 0; vt < 4; ++vt) { f32x4 d;
#pragma unroll
            for (int i = 0; i < 4; ++i) d[i] = (float)ol[vt >> 1][4 * (vt & 1) + i];
#pragma unroll
            for (int s = 0; s < 2; ++s) d = __builtin_amdgcn_mfma_f32_16x16x32_f16(*(const f16x8*)(sl + ((rv + 4 * vt) * 64 + 8 * fq + 32 * s) * 2), bq[s], d, 0, 0, 0);
            D[vt] = d; }
        float ss = 0.f;
#pragma unroll
        for (int vt = 0; vt < 4; ++vt) ss += (D[vt][0] * D[vt][0] + D[vt][1] * D[vt][1]) + (D[vt][2] * D[vt][2] + D[vt][3] * D[vt][3]);
        ss += shfl_xor_f(ss, 16); ss += shfl_xor_f(ss, 32);
        const float rs = rsq_(ss * (1.0f / 64.0f) + 1e-6f);
        const float* nw = a.in[17] + l * 384;
        f16x8 z8[2], o[2];
#pragma unroll
        for (int s = 0; s < 2; ++s) z8[s] = *(const f16x8*)(U + uo + ((unsigned)C_HGZ + col + 8u * s) * 2u);
#pragma unroll
        for (int vt = 0; vt < 4; ++vt) { const f32x4 w4 = *(const f32x4*)(nw + col + 4 * vt);
#pragma unroll
            for (int i = 0; i < 4; ++i) { const int e = 4 * (vt & 1) + i; o[vt >> 1][e] = (f16)(D[vt][i] * rs * w4[i] * siluf_((float)z8[vt >> 1][e])); } }
#pragma unroll
        for (int s = 0; s < 2; ++s) *(f16x8*)(MIX + (m * (unsigned)DM + 384u + col + 8u * s) * 2u) = o[s];
    }
    {
        const char* CA = (const char*)(a.ws + WS_CA); const float* LH = (const float*)(a.ws + WS_LH) + ((size_t)b * NCH + c) * 256;
#pragma unroll
        for (int q = 0; q < 4; ++q) { const unsigned ch0 = (unsigned)(128 * hg + 32 * fq + 8 * q);
            const f16x8 hl = *(const f16x8*)(MIX + (m * (unsigned)DM + 768u + ch0) * 2u), ca = *(const f16x8*)(CA + (m * 256u + ch0) * 2u), z8 = *(const f16x8*)(U + uo + ((unsigned)C_LRUZ + ch0) * 2u);
            const f32x4 c0 = *(const f32x4*)(LH + ch0), c1 = *(const f32x4*)(LH + ch0 + 4);
            f16x8 o;
#pragma unroll
            for (int i = 0; i < 8; ++i) o[i] = (f16)(((float)hl[i] + (float)ca[i] * (i < 4 ? c0[i & 3] : c1[i & 3])) * siluf_((float)z8[i]));
            *(f16x8*)(MIX + (m * (unsigned)DM + 768u + ch0) * 2u) = o; }
    }
}
#define XB_TMO      128
#define XB_XCNT(j)  (256  + 64 * (j))
#define XB_XSUB(j)  (1280 + 64 * (j))
#define XB_XGEN(j)  (2304 + 64 * (j))
#define XB_TOP      3328
#define XB_TOPGEN   3392
#define XCD_BAR_WORDS 3456
#define XB_SPIN_CAP (1u << 18)

__device__ __forceinline__ unsigned xb_ld(unsigned* p)              { return __hip_atomic_load(p, __ATOMIC_RELAXED, __HIP_MEMORY_SCOPE_AGENT); }
__device__ __forceinline__ unsigned xb_add(unsigned* p, unsigned v) { return __hip_atomic_fetch_add(p, v, __ATOMIC_RELAXED, __HIP_MEMORY_SCOPE_AGENT); }
__device__ __forceinline__ unsigned xb_xcc_id() { return (unsigned)__builtin_amdgcn_s_getreg((3 << 11) | 20) & 0xFu; }
#define XB_SPIN(cond, bar) do { unsigned _sp = 0; while (cond) { __builtin_amdgcn_s_sleep(1); \
    if ((++_sp & 255u) == 0u) { if (xb_ld(&(bar)[XB_TMO])) break; if (_sp > XB_SPIN_CAP) { atomicAdd(&(bar)[XB_TMO], 1u); break; } } } } while (0)

struct XcdBarrier {
    unsigned* bar; unsigned x; int isw0;
    volatile LAS unsigned* st;
};

__device__ __forceinline__ XcdBarrier xcd_barrier_post(unsigned* bar, volatile LAS unsigned* st, int isw0) {
    XcdBarrier b; b.bar = bar; b.x = xb_xcc_id(); b.st = st; b.isw0 = isw0;
    if (isw0 && lane_now() == 0) (void)xb_add(&bar[XB_XCNT(b.x)], 1u);
    return b;
}
__device__ __forceinline__ void xcd_barrier_complete(unsigned* bar, unsigned x, unsigned& nloc, unsigned& nx) {
    const unsigned G = gridDim.x * gridDim.y * gridDim.z;
    unsigned sum, cnt, mine, sp = 0u;
    for (;;) {
        sum = 0u; cnt = 0u; mine = 0u;
#pragma unroll
        for (unsigned j = 0; j < 16; ++j) { const unsigned c = xb_ld(&bar[XB_XCNT(j)]); sum += c; cnt += (c > 0u) ? 1u : 0u; mine = (j == x) ? c : mine; }
        if (sum == G) break;
        __builtin_amdgcn_s_sleep(1);
        if ((++sp & 255u) == 0u) { if (xb_ld(&bar[XB_TMO])) break; if (sp > XB_SPIN_CAP) { atomicAdd(&bar[XB_TMO], 1u); break; } }
    }
    nloc = mine > 0u ? mine : 1u; nx = cnt > 0u ? cnt : 1u;
}

__device__ __forceinline__ void xcd_barrier(const XcdBarrier& b) {
    asm volatile("s_waitcnt vmcnt(0)" ::: "memory");
    __syncthreads();
    if (b.isw0 && lane_now() == 0) {
        unsigned* bar = b.bar;
        __builtin_amdgcn_s_waitcnt(0);
        unsigned nloc = b.st[0], nx = b.st[1];
        if (nloc == 0u) { xcd_barrier_complete(bar, b.x, nloc, nx); b.st[0] = nloc; b.st[1] = nx; }
        const unsigned old = xb_add(&bar[XB_XSUB(b.x)], 1u);
        const unsigned gen = old / nloc;
        if (old + 1u == (gen + 1u) * nloc) {
            __builtin_amdgcn_fence(__ATOMIC_RELEASE, "agent");
            asm volatile("s_waitcnt vmcnt(0)" ::: "memory");
            const unsigned og = xb_add(&bar[XB_TOP], 1u);
            const unsigned tg = og / nx;
            if (og + 1u == (tg + 1u) * nx) xb_add(&bar[XB_TOPGEN], 1u);
            else XB_SPIN(xb_ld(&bar[XB_TOPGEN]) == tg, bar);
            __builtin_amdgcn_fence(__ATOMIC_ACQUIRE, "agent");
            xb_add(&bar[XB_XGEN(b.x)], 1u);
            asm volatile("s_waitcnt vmcnt(0)" ::: "memory");
        } else {
            XB_SPIN(xb_ld(&bar[XB_XGEN(b.x)]) == gen, bar);
            __builtin_amdgcn_fence(__ATOMIC_ACQUIRE, "agent");
            asm volatile("s_waitcnt vmcnt(0)" ::: "memory");
        }
    }
    __syncthreads();
}

constexpr size_t WS_BAR = 16384;
constexpr size_t WS_PCNT = 32768;
constexpr int MISC_OFF = LDS_BYTES - 16;
__global__ void __launch_bounds__(NT, 2) fwd(Args args) {
    extern __shared__ __attribute__((aligned(16))) unsigned char lds_raw[];
    LAS unsigned char* lds = (LAS unsigned char*)lds_raw;
    cg::grid_group grid = cg::this_grid();
    const int wave = __builtin_amdgcn_readfirstlane((int)threadIdx.x >> 6);
#define TID_NOW() (wave * 64 + lane_now())
    const int tid = TID_NOW(); const int lane = tid & 63;
    if (wave == 0 && lane < 4) ((LAS unsigned*)(lds + MISC_OFF))[lane] = 0u;
    __syncthreads();
    XcdBarrier xbar = xcd_barrier_post((unsigned*)(args.ws + WS_BAR), (volatile LAS unsigned*)(lds + MISC_OFF), __builtin_amdgcn_readfirstlane(wave == 0 ? 1 : 0));
#define GRID_BAR() do { XcdBarrier xb_ = xbar; xb_.st = (volatile LAS unsigned*)(lds + MISC_OFF); asm volatile("" : "+s"(xb_.bar), "+s"(xb_.x)); xcd_barrier(xb_); } while (0)
    const int G = gridDim.x, gw = blockIdx.x * NWAVES + wave, NGW = G * NWAVES;
    unsigned char* ws = args.ws;
    unsigned short* XN = (unsigned short*)(ws + WS_XN);
    unsigned short* X1H = (unsigned short*)((char*)args.out + (size_t)M * DM * 2);
    {
        LAS float* scr = (LAS float*)(lds + wave * 8704);
        constexpr int I_IN = (DM / 64) * (NIN / 32), I_OUT = (DM / 64) * (DM / 32), NITEMS = DEPTH * (I_IN + I_OUT);
        if (blockIdx.x >= 32) for (int it = gw - 32 * NWAVES; it < NITEMS; it += NGW - 32 * NWAVES) {
            int r = it; const int l = r / (I_IN + I_OUT); r -= l * (I_IN + I_OUT);
            if (r < I_IN) p0_transpose_item(args.in[2] + (size_t)l * DM * NIN, DM, NIN, (unsigned short*)(ws + WS_WIN + l * WIN_L), scr, r, lane, l == 0 ? nullptr : args.in[1] + DM);
            else p0_transpose_item(args.in[25] + (size_t)l * DM * DM, DM, DM, (unsigned short*)(ws + WS_WOUT + l * WOUT_L), scr, r - I_IN, lane, nullptr);
        }
        for (int i = gw; i < DEPTH * (NU - NIN) * DM * 2 / 1024; i += NGW) { const int l = i / ((NU - NIN) * DM * 2 / 1024), r = i % ((NU - NIN) * DM * 2 / 1024);
            if (l == 1 && r < 64 * DM * 2 / 1024) continue;
            *(u32x4*)(ws + WS_WIN + l * WIN_L + (size_t)NIN * DM * 2 + (size_t)r * 1024 + lane * 16) = (u32x4){0u, 0u, 0u, 0u}; }
        if (blockIdx.x < 32) {
            LAS f16* TT = (LAS f16*)(lds + 8 * 8704);
            const int nt = blockIdx.x & 3, kt = (blockIdx.x >> 2) * NWAVES + wave, tl = lane & 15, fq = lane >> 4;
            for (int i = tid; i < 16 * RW_W; i += NT) { const int n = 16 * nt + i / RW_W, cc = i % RW_W; const float mm = args.in[3][RW_SHIFT + C_V + cc]; TT[(i / RW_W) * 392 + cc] = (f16)(((n < 32) ? (1.0f - mm) : mm) * args.in[9][cc * 32 + (n & 31)]); }
            __syncthreads();
            const float* wrow = args.in[2] + (size_t)DM * NIN + (size_t)(16 * kt + tl) * NIN + C_V + 8 * fq;
            f32x4 bv[12][2];
#pragma unroll
            for (int s2 = 0; s2 < 12; ++s2) { bv[s2][0] = *(const f32x4*)(wrow + 32 * s2); bv[s2][1] = *(const f32x4*)(wrow + 32 * s2 + 4); }
            f32x4 d = (f32x4){0.f, 0.f, 0.f, 0.f};
#pragma unroll
            for (int s2 = 0; s2 < 12; ++s2) { f16x8 bf;
#pragma unroll
                for (int j = 0; j < 8; ++j) bf[j] = (f16)(j < 4 ? bv[s2][0][j & 3] : bv[s2][1][j & 3]);
                d = __builtin_amdgcn_mfma_f32_16x16x32_f16(*(const LAS f16x8*)(TT + tl * 392 + 8 * fq + 32 * s2), bf, d, 0, 0, 0); }
            const float nwk = args.in[1][DM + 16 * kt + tl];
#pragma unroll
            for (int i = 0; i < 4; ++i) ((f16*)(ws + WS_WIN + WIN_L))[(size_t)(NIN + 16 * nt + 4 * fq + i) * DM + 16 * kt + tl] = (f16)(d[i] * nwk);
            __syncthreads();
        }
        for (int i = blockIdx.x * NT + tid; i < 2 * M; i += G * NT) ((float*)(ws + WS_RSS))[i] = 0.f;
        if (G == 256) {
            const int rb = 2048 * (blockIdx.x & 7) + 64 * (blockIdx.x >> 3) + 8 * wave;
            for (int i = 0; i < 2; ++i) rms_row4_f16(args.in[0] + (size_t)(rb + i) * DM, (size_t)2 * DM, args.in[1], XN + (size_t)(rb + i) * DM, lane);
        } else
        for (int m = gw; m < M; m += 4 * NGW) rms_row4_f16(args.in[0] + (size_t)m * DM, (size_t)NGW * DM, args.in[1], XN + (size_t)m * DM, lane);
        { f16* WUPT = (f16*)(ws + WS_WUPT); f16* AUPT = (f16*)(ws + WS_AUPT); f16* VDNT = (f16*)(ws + WS_VDNT); f16* VUPT = (f16*)(ws + WS_VUPT);
          for (int i = blockIdx.x * NT + tid; i < 122880; i += G * NT) {
              if (i < 49152) { const int ll = i / 24576, r = i % 24576, n = r / 64, k = r % 64; WUPT[i] = (f16)args.in[5][(size_t)ll * 24576 + k * 384 + n]; }
              else if (i < 98304) { const int i2 = i - 49152, ll = i2 / 24576, r = i2 % 24576, n = r / 64, k = r % 64; AUPT[i2] = (f16)args.in[7][(size_t)ll * 24576 + k * 384 + n]; }
              else if (i < 110592) { const int i2 = i - 98304, j2 = i2 / 384, cc = i2 % 384; VDNT[i2] = (f16)args.in[9][cc * 32 + j2]; }
              else { const int i2 = i - 110592, n = i2 / 32, j2 = i2 % 32; VUPT[i2] = (f16)args.in[10][j2 * 384 + n]; } }
          for (int i = blockIdx.x * NT + tid; i < DEPTH * (PRM_HALVES + 384); i += G * NT) { const int ll = i / (PRM_HALVES + 384), r = i % (PRM_HALVES + 384);
              unsigned char* tb = ws + WS_PRMT + (size_t)ll * PRM_BYTES;
              if (r < 1280) ((f16*)tb)[r] = (f16)args.in[3][ll * RW_SHIFT + r];
              else if (r < PRM_HALVES) { const int q = (r - 1280) / 384, cc = (r - 1280) % 384;
                  ((f16*)tb)[r] = (f16)((q == 0) ? args.in[6][ll * RW_W + cc] : (q == 1) ? args.in[11][ll * RW_W + cc] : (q == 2) ? args.in[12][ll * RW_W + cc] : (q == 3) ? args.in[13][ll * RW_W + cc] : args.in[8][cc]); }
              else ((float*)(tb + PRM_W0_BYTE))[r - PRM_HALVES] = args.in[4][ll * RW_W + (r - PRM_HALVES)]; }
          f16* WAT = (f16*)(ws + WS_WAT); f16* WXT = (f16*)(ws + WS_WXT);
          for (int i = blockIdx.x * NT + tid; i < 32768; i += G * NT) { const int lg = i >> 12, r = i & 4095, j = r >> 6, ii = r & 63; WAT[i] = (f16)args.in[20][(size_t)lg * 4096 + ii * 64 + j]; WXT[i] = (f16)args.in[22][(size_t)lg * 4096 + ii * 64 + j]; } }
    }
    if (gridDim.x > 65536u) grid.sync();
    GRID_BAR();
#define XCD_TASK(t) ((G == BATCH * NCH) ? ((((t) & 7) << 5) | ((t) >> 3)) : (t))
#pragma unroll 1
    for (int l = 0; l < DEPTH; ++l) {
        { pg8::Gemm g{l == 0 ? XN : X1H, (const unsigned short*)(ws + WS_WIN + l * WIN_L), M, NU, DM}; pg8::StaticOrder S; S.init(M, NU, G, (int)blockIdx.x);
          pg8::EpiF16 E{(unsigned short*)(ws + WS_U), NU, l == 0 ? nullptr : (const float*)(ws + WS_RSS)};
          pg8::gemm_phase<pg8::EpiF16, pg8::StaticOrder, true, true>(lds, g, S, E, wave); }
        { const int t_ = TID_NOW();
          if (t_ < PRM_BYTES / 16) *(LAS u32x4*)(lds + PRM_OFF + t_ * 16) = *(const u32x4*)(ws + WS_PRMT + (size_t)l * PRM_BYTES + (size_t)t_ * 16); }
        GRID_BAR();
        for (int t0 = blockIdx.x; t0 < BATCH * NCH; t0 += G) phaseA(args, l, XCD_TASK(t0), lds, TID_NOW());
        GRID_BAR();
        phaseB1(args, lds, TID_NOW());
        GRID_BAR();
        phaseB(args, lds, TID_NOW());
        GRID_BAR();
        phaseB3(args, lds, TID_NOW());
        GRID_BAR();
        for (int t0 = blockIdx.x; t0 < BATCH * NCH; t0 += G) phaseC(args, l, XCD_TASK(t0), lds, TID_NOW());
        GRID_BAR();
        { pg8::Gemm g{(const unsigned short*)(ws + WS_MIX), (const unsigned short*)(ws + WS_WOUT + l * WOUT_L), M, DM, DM}; pg8::StaticOrder S; S.init(M, DM, G, (int)blockIdx.x);
          if (l + 1 < DEPTH) {
              pg8::EpiRes E{args.in[0], nullptr, DM, X1H, (float*)(ws + WS_RSS)};
              pg8::gemm_phase<pg8::EpiRes, pg8::StaticOrder, true, true>(lds, g, S, E, wave);
              GRID_BAR();
          } else {
              pg8::EpiResNorm E{X1H, args.out, DM, (float*)(ws + WS_RSS) + M, (unsigned*)(ws + WS_PCNT), args.in[26], (unsigned)((M / 256) * (DM / 256) * NWAVES)};
              pg8::gemm_phase<pg8::EpiResNorm, pg8::StaticOrder, true, true>(lds, g, S, E, wave);
          } }
    }
}

extern "C" void kernel_launch(void* const* d_in, const int* in_sizes, int n_in, void* d_out, int out_size, void* d_ws, size_t ws_size, hipStream_t stream) {
    static int grid = 0;
    if (grid == 0) {
        if (n_in != 27 || in_sizes[0] != M * DM || out_size != M * DM || ws_size < WS_END) { fprintf(stderr, "kernel_launch: unexpected problem: n_in %d in0 %d out %d ws %zu\n", n_in, n_in > 0 ? in_sizes[0] : -1, out_size, ws_size); grid = -1; return; }
        int dev = 0, cus = 0, per_cu = 0;
        hipGetDevice(&dev); hipDeviceGetAttribute(&cus, hipDeviceAttributeMultiprocessorCount, dev);
        if (hipFuncSetAttribute((const void*)fwd, hipFuncAttributeMaxDynamicSharedMemorySize, LDS_BYTES) != hipSuccess) { fprintf(stderr, "kernel_launch: hipFuncSetAttribute failed\n"); grid = -1; return; }
        if (hipOccupancyMaxActiveBlocksPerMultiprocessor(&per_cu, (const void*)fwd, NT, LDS_BYTES) != hipSuccess || per_cu < 1) { fprintf(stderr, "kernel_launch: occupancy query failed (%d)\n", per_cu); grid = -1; return; }
        grid = cus * per_cu;
    }
    if (grid < 0) return;
    if (hipMemsetAsync((char*)d_ws, 0, 65536, stream) != hipSuccess) { fprintf(stderr, "kernel_launch: memset of the barrier words failed\n"); return; }
    Args a{};
    for (int i = 0; i < 27; ++i) a.in[i] = (const float*)d_in[i];
    a.out = (float*)d_out; a.ws = (unsigned char*)d_ws;
    void* kargs[] = {&a};
    hipError_t e = hipLaunchCooperativeKernel((const void*)fwd, dim3(grid), dim3(NT), kargs, LDS_BYTES, stream);
    if (e != hipSuccess) fprintf(stderr, "cooperative launch failed: %s (grid %d)\n", hipGetErrorString(e), grid);
}
```
